# Optimizing an MI355X kernel written in HIP

```python
import jax
import jax.numpy as jnp
from jax import lax
import numpy as np


D_MODEL = 2048
BATCH = 2
SEQ = 4096
DEPTH = 4

POOL_WIDTH = D_MODEL // 4
POOL_WINDOWS = (2, 4, 8, 16)
POOL_GROUPS = len(POOL_WINDOWS)
POOL_GROUP_DIM = POOL_WIDTH // POOL_GROUPS

GLA_WIDTH = (3 * D_MODEL) // 8
GLA_HEADS = 4
GLA_QK_WIDTH = GLA_WIDTH // 2
GLA_DK = GLA_QK_WIDTH // GLA_HEADS
GLA_DV = GLA_WIDTH // GLA_HEADS
GLA_LORA = 16
GLA_TAU = 16.0
GLA_CHUNK = 64

RWKV_WIDTH = D_MODEL - POOL_WIDTH - GLA_WIDTH
RWKV_HEAD_DIM = 64
RWKV_HEADS = RWKV_WIDTH // RWKV_HEAD_DIM
RWKV_DECAY_LORA = 64
RWKV_A_LORA = 64
RWKV_G_LORA = 128
RWKV_LNX_EPS = 64e-5

GLA_SPLITS = (GLA_QK_WIDTH, GLA_QK_WIDTH, GLA_WIDTH, GLA_WIDTH, GLA_LORA)
RWKV_SPLITS = (RWKV_WIDTH, RWKV_WIDTH, RWKV_WIDTH, RWKV_DECAY_LORA, RWKV_A_LORA, RWKV_G_LORA)
GLA_IN = sum(GLA_SPLITS)
RWKV_IN = sum(RWKV_SPLITS)
IN_WIDTH = POOL_WIDTH + GLA_IN + RWKV_IN

PEER_HEADS = 8
PEER_QDIM = 256
PEER_NKEYS = 128
PEER_N = PEER_NKEYS * PEER_NKEYS
PEER_TOPK = 16
PEER_TOKEN_BLOCK = 128

NORM_EPS = 1e-6

kernel_name = 'hybrid_pool_gla_rwkv7_peer_adaln'


def _split(t, sizes):
    idx = [int(i) for i in np.cumsum(sizes)[:-1]]
    return jnp.split(t, idx, axis=-1)


def rmsnorm(x, g):
    x32 = x.astype(jnp.float32)
    y = x32 * lax.rsqrt(jnp.mean(x32 * x32, axis=-1, keepdims=True) + NORM_EPS)
    return (y * g.astype(jnp.float32)).astype(x.dtype)


def causal_shift(t):
    return jnp.pad(t, ((0, 0), (1, 0), (0, 0)))[:, :-1]


def pool_group(p, pool_w, pool_scale):
    B, S, _ = p.shape
    p32 = p.astype(jnp.float32)
    cs = jnp.cumsum(p32, axis=1)
    t = jnp.arange(1, S + 1, dtype=jnp.float32)
    outs = []
    for g, win in enumerate(POOL_WINDOWS):
        lo, hi = g * POOL_GROUP_DIM, (g + 1) * POOL_GROUP_DIM
        csg = cs[..., lo:hi]
        prev = jnp.pad(csg, ((0, 0), (win, 0), (0, 0)))[:, :S]
        cnt = jnp.minimum(t, float(win))[None, :, None]
        outs.append((csg - prev) / cnt - p32[..., lo:hi])
    d = jnp.stack(outs, axis=2)
    y = jnp.einsum('bsgc,gcd->bsgd', d, pool_w.astype(jnp.float32)).reshape(B, S, POOL_WIDTH)
    return y * pool_scale


def gla_group(q, k, v, g, a_down, alpha_up, alpha_b, norm_g):
    B, S, _ = q.shape
    f32 = jnp.float32
    hs = lambda t, d: t.astype(f32).reshape(B, S, GLA_HEADS, d)
    q = hs(q, GLA_DK) * (GLA_DK ** -0.5)
    k = hs(k, GLA_DK)
    v = hs(v, GLA_DV)
    log_alpha = hs(jax.nn.log_sigmoid(a_down.astype(f32) @ alpha_up + alpha_b) / GLA_TAU, GLA_DK)
    n_chunks = S // GLA_CHUNK
    chunks = lambda t: t.reshape(B, n_chunks, GLA_CHUNK, GLA_HEADS, -1).transpose(1, 0, 3, 2, 4)
    causal = jnp.tril(jnp.ones((GLA_CHUNK, GLA_CHUNK), dtype=bool))[:, :, None]

    def step(state, inp):
        qc, kc, vc, lac = inp
        b = jnp.cumsum(lac, axis=2)
        inter = jnp.einsum('bhcd,bhde->bhce', qc * jnp.exp(b), state)
        rel = jnp.where(causal, b[:, :, :, None, :] - b[:, :, None, :, :], -jnp.inf)
        att = jnp.einsum('bhid,bhjd,bhijd->bhij', qc, kc, jnp.exp(rel))
        out = inter + jnp.einsum('bhij,bhje->bhie', att, vc)
        b_last = b[:, :, -1:, :]
        state = (jnp.exp(b_last[:, :, 0, :])[..., None] * state
                 + jnp.einsum('bhcd,bhce->bhde', kc * jnp.exp(b_last - b), vc))
        return state, out

    s0 = jnp.zeros((B, GLA_HEADS, GLA_DK, GLA_DV), f32)
    _, o = lax.scan(step, s0, (chunks(q), chunks(k), chunks(v), chunks(log_alpha)))
    o = o.transpose(1, 0, 3, 2, 4).reshape(B, S, GLA_HEADS, GLA_DV)
    o = o * lax.rsqrt(jnp.mean(o * o, axis=-1, keepdims=True) + NORM_EPS)
    return o.reshape(B, S, GLA_WIDTH) * norm_g * jax.nn.silu(g.astype(f32))


def rwkv7_group(y, mu, w0, w2, a0, a2, g2, k_k, k_a, r_k, lnx_g, lnx_b):
    B, S, _ = y.shape
    y = y.astype(jnp.float32)
    y = y + (causal_shift(y) - y) * mu
    r, k, v, wd, ad, gd = _split(y, RWKV_SPLITS)
    w = -jax.nn.softplus(-(w0 + jnp.tanh(wd) @ w2)) - 0.5
    decay = jnp.exp(-jnp.exp(w))
    a = jax.nn.sigmoid(a0 + ad @ a2)
    gate = jax.nn.sigmoid(gd) @ g2
    hs = lambda t: t.reshape(B, S, RWKV_HEADS, RWKV_HEAD_DIM)
    kk = hs(k * k_k)
    kk = kk / jnp.maximum(jnp.sqrt(jnp.sum(kk * kk, axis=-1, keepdims=True)), 1e-12)
    k = k * (1.0 + (a - 1.0) * k_a)
    r, k, v, decay, a = hs(r), hs(k), hs(v), hs(decay), hs(a)
    vec_a = -kk
    vec_b = kk * a

    def step(state, inp):
        r_t, w_t, k_t, v_t, a_t, b_t = inp
        sa = jnp.einsum('bhvk,bhk->bhv', state, a_t)
        state = (state * w_t[:, :, None, :] + sa[..., None] * b_t[:, :, None, :]
                 + v_t[..., None] * k_t[:, :, None, :])
        return state, jnp.einsum('bhvk,bhk->bhv', state, r_t)

    tm = lambda t: jnp.swapaxes(t, 0, 1)
    s0 = jnp.zeros((B, RWKV_HEADS, RWKV_HEAD_DIM, RWKV_HEAD_DIM), jnp.float32)
    _, o = lax.scan(step, s0, (tm(r), tm(decay), tm(k), tm(v), tm(vec_a), tm(vec_b)))
    o = tm(o)
    mean = jnp.mean(o, axis=-1, keepdims=True)
    var = jnp.mean((o - mean) ** 2, axis=-1, keepdims=True)
    o = ((o - mean) * lax.rsqrt(var + RWKV_LNX_EPS)).reshape(B, S, RWKV_WIDTH) * lnx_g + lnx_b
    bonus = jnp.sum(r * k * r_k, axis=-1, keepdims=True) * v
    return (o + bonus.reshape(B, S, RWKV_WIDTH)) * gate


def hybrid_mixer(h, w_in, pool_w, pool_scale, gla_alpha_up, gla_alpha_b, gla_norm_g,
                 rwkv_mu, rwkv_w0, rwkv_w2, rwkv_a0, rwkv_a2, rwkv_g2, rwkv_kk, rwkv_ka, rwkv_rk,
                 rwkv_lnx_g, rwkv_lnx_b, w_out):
    proj = h @ w_in
    p_in, g_in, r_in = _split(proj, (POOL_WIDTH, GLA_IN, RWKV_IN))
    y_pool = pool_group(p_in, pool_w, pool_scale)
    q, k, v, g, a_down = _split(g_in, GLA_SPLITS)
    y_gla = gla_group(q, k, v, g, a_down, gla_alpha_up, gla_alpha_b, gla_norm_g)
    y_rwkv = rwkv7_group(r_in, rwkv_mu, rwkv_w0, rwkv_w2, rwkv_a0, rwkv_a2, rwkv_g2,
                         rwkv_kk, rwkv_ka, rwkv_rk, rwkv_lnx_g, rwkv_lnx_b)
    y = jnp.concatenate([y_pool, y_gla, y_rwkv], axis=-1).astype(h.dtype)
    return y @ w_out


def peer_ffn(h, wq, k1, k2, u_tab, v_tab):
    B, S, D = h.shape
    T = B * S
    ht = h.reshape(T, D)
    q = (ht @ wq).astype(jnp.float32).reshape(T, PEER_HEADS, 2, PEER_QDIM // 2)
    s1 = jnp.einsum('thd,hnd->thn', q[:, :, 0], k1)
    s2 = jnp.einsum('thd,hnd->thn', q[:, :, 1], k2)
    v1, i1 = lax.top_k(s1, PEER_TOPK)
    v2, i2 = lax.top_k(s2, PEER_TOPK)
    cand = (v1[..., :, None] + v2[..., None, :]).reshape(T, PEER_HEADS, PEER_TOPK * PEER_TOPK)
    sc, ci = lax.top_k(cand, PEER_TOPK)
    e_idx = (jnp.take_along_axis(i1, ci // PEER_TOPK, axis=-1) * PEER_NKEYS
             + jnp.take_along_axis(i2, ci % PEER_TOPK, axis=-1))
    gate = jax.nn.softmax(sc, axis=-1)
    nb = T // PEER_TOKEN_BLOCK

    def block(args):
        hb, eb, gb = args
        act = jax.nn.gelu(jnp.einsum('thkd,td->thk', u_tab[eb], hb).astype(jnp.float32), approximate=False)
        coeff = (gb * act).astype(h.dtype)
        return jnp.einsum('thk,thkd->td', coeff, v_tab[eb]).astype(h.dtype)

    out = lax.map(block, (ht.reshape(nb, PEER_TOKEN_BLOCK, D),
                          e_idx.reshape(nb, PEER_TOKEN_BLOCK, PEER_HEADS, PEER_TOPK),
                          gate.reshape(nb, PEER_TOKEN_BLOCK, PEER_HEADS, PEER_TOPK)))
    return out.reshape(B, S, D)


def setup_inputs(seed: int = 0) -> dict:
    key = jax.random.key(seed)
    keys = iter(jax.random.split(key, 40))

    def nrm(shape, std):
        return std * jax.random.normal(next(keys), shape, jnp.float32)

    L, D = DEPTH, D_MODEL
    return {
        'x': nrm((BATCH, SEQ, D), 1.0),
        'c': nrm((BATCH, D), 1.0),
        'ada_w': nrm((L, D, 6 * D), 0.5 * D ** -0.5),
        'ada_b': nrm((L, 6 * D), 0.02),
        'norm1_g': 1.0 + nrm((L, D), 0.02),
        'w_in': nrm((L, D, IN_WIDTH), D ** -0.5),
        'pool_w': nrm((L, POOL_GROUPS, POOL_GROUP_DIM, POOL_GROUP_DIM), POOL_GROUP_DIM ** -0.5),
        'pool_scale': 1.0 + nrm((L, POOL_WIDTH), 0.1),
        'gla_alpha_up': nrm((L, GLA_LORA, GLA_QK_WIDTH), GLA_LORA ** -0.5),
        'gla_alpha_b': nrm((L, GLA_QK_WIDTH), 0.02),
        'gla_norm_g': 1.0 + nrm((L, GLA_WIDTH), 0.02),
        'rwkv_mu': jax.random.uniform(next(keys), (L, RWKV_IN), jnp.float32),
        'rwkv_w0': -0.5 + nrm((L, RWKV_WIDTH), 0.5),
        'rwkv_w2': nrm((L, RWKV_DECAY_LORA, RWKV_WIDTH), 0.5 * RWKV_DECAY_LORA ** -0.5),
        'rwkv_a0': nrm((L, RWKV_WIDTH), 0.1),
        'rwkv_a2': nrm((L, RWKV_A_LORA, RWKV_WIDTH), 0.5 * RWKV_A_LORA ** -0.5),
        'rwkv_g2': nrm((L, RWKV_G_LORA, RWKV_WIDTH), RWKV_G_LORA ** -0.5),
        'rwkv_kk': 0.85 + nrm((L, RWKV_WIDTH), 0.02),
        'rwkv_ka': 1.0 + nrm((L, RWKV_WIDTH), 0.02),
        'rwkv_rk': nrm((L, RWKV_HEADS, RWKV_HEAD_DIM), 0.1),
        'rwkv_lnx_g': 1.0 + nrm((L, RWKV_WIDTH), 0.02),
        'rwkv_lnx_b': nrm((L, RWKV_WIDTH), 0.02),
        'w_out': nrm((L, D, D), D ** -0.5),
        'norm2_g': 1.0 + nrm((L, D), 0.02),
        'peer_wq': nrm((L, D, PEER_HEADS * PEER_QDIM), D ** -0.5),
        'peer_k1': nrm((L, PEER_HEADS, PEER_NKEYS, PEER_QDIM // 2), (PEER_QDIM // 2) ** -0.5),
        'peer_k2': nrm((L, PEER_HEADS, PEER_NKEYS, PEER_QDIM // 2), (PEER_QDIM // 2) ** -0.5),
        'peer_u': nrm((L, PEER_N, D), D ** -0.5),
        'peer_v': nrm((L, PEER_N, D), 0.5),
        'final_g': 1.0 + nrm((D,), 0.02),
    }


def reference(x, c, ada_w, ada_b, norm1_g, w_in, pool_w, pool_scale, gla_alpha_up, gla_alpha_b,
              gla_norm_g, rwkv_mu, rwkv_w0, rwkv_w2, rwkv_a0, rwkv_a2, rwkv_g2, rwkv_kk, rwkv_ka,
              rwkv_rk, rwkv_lnx_g, rwkv_lnx_b, w_out, norm2_g, peer_wq, peer_k1, peer_k2, peer_u,
              peer_v, final_g):
    c_act = jax.nn.silu(c)
    for l in range(DEPTH):
        mod = (c_act @ ada_w[l] + ada_b[l])[:, None, :]
        sh1, sc1, g1, sh2, sc2, g2 = jnp.split(mod, 6, axis=-1)
        h = rmsnorm(x, norm1_g[l]) * (1.0 + sc1) + sh1
        x = x + g1 * hybrid_mixer(h, w_in[l], pool_w[l], pool_scale[l], gla_alpha_up[l], gla_alpha_b[l],
                                  gla_norm_g[l], rwkv_mu[l], rwkv_w0[l], rwkv_w2[l], rwkv_a0[l], rwkv_a2[l],
                                  rwkv_g2[l], rwkv_kk[l], rwkv_ka[l], rwkv_rk[l], rwkv_lnx_g[l],
                                  rwkv_lnx_b[l], w_out[l])
        h = rmsnorm(x, norm2_g[l]) * (1.0 + sc2) + sh2
        x = x + g2 * peer_ffn(h, peer_wq[l], peer_k1[l], peer_k2[l], peer_u[l], peer_v[l])
    return rmsnorm(x, final_g)
```

```cpp
#include <hip/hip_runtime.h>
#include <cstdio>
#include <cstdint>
__device__ __forceinline__ int lane_id_() { int r; asm volatile("v_mbcnt_lo_u32_b32 %0, -1, 0\n\tv_mbcnt_hi_u32_b32 %0, -1, %0" : "=v"(r)); return r; }
__device__ __forceinline__ int tid_from(int wave_s) { return wave_s * 64 + lane_id_(); }
namespace pg8 {
#define PG8_LAS __attribute__((address_space(3)))
typedef unsigned short bf16_t;
typedef short bf16x8 __attribute__((ext_vector_type(8)));
typedef float f32x4 __attribute__((ext_vector_type(4)));
typedef unsigned u32x4 __attribute__((ext_vector_type(4)));
constexpr int BM = 256, BK = 64, HALF = 128, HTB = HALF * BK * 2  , STAGE_BYTES = 8 * HTB, NXCD = 8, WGM = 8;

__host__ __device__ __forceinline__ int lds_byte(int r, int c) { const int st = (r >> 4) * 2 + (c >> 5), rr = r & 15, cc = c & 31, ob = rr * 64 + cc * 2; return st * 1024 + (ob ^ (((ob >> 9) & 1) << 5)); }
__host__ __device__ __forceinline__ void stage_rc(int b, int& R, int& C) { const int st = b / 1024, sb = b % 1024, swz = sb ^ (((sb >> 9) & 1) << 5); R = (st >> 1) * 16 + swz / 64; C = (st & 1) * 32 + (swz % 64) / 2; }
__host__ __device__ __forceinline__ int perm32(int rho) { const int n = rho >> 4, i = rho & 15; return 8 * (i >> 2) + 4 * n + (i & 3); }

struct Unit { int pm, pn; };
struct Gemm { const bf16_t* A; const bf16_t* Bt; int M, N, K; };

struct StaticOrder {
    int nM, nN, nwg, G, c;
    __host__ __device__ void init(int M, int N, int G_, int c_) { nM = M / BM; nN = N / BM; nwg = nM * nN; G = G_; c = c_; }
    __host__ __device__ bool next(int i, Unit& u) const {
        const long L = (long)i * G + c; if (L >= nwg) return false;
        int wgid = (int)L; { const int q = nwg / NXCD, r = nwg % NXCD, xcd = wgid % NXCD, off = wgid / NXCD; wgid = (xcd < r ? xcd * (q + 1) : r * (q + 1) + (xcd - r) * q) + off; }
        const int nig = WGM * nN, gid = wgid / nig, fm = gid * WGM, gsz = (nM - fm) < WGM ? (nM - fm) : WGM;
        u.pm = fm + ((wgid % nig) % gsz); u.pn = (wgid % nig) / gsz; return true;
    }
    __device__ __forceinline__ void a_ready(const Unit&) const {}
    __device__ __forceinline__ void done(const Unit&) const {}
};

template <class Epi, class Sched, bool ALIGN_EPI = false, bool SP2 = false>
__device__ __forceinline__ void gemm_phase(PG8_LAS unsigned char* lds, const Gemm g, const Sched& S, const Epi& E, int wave_s) {
    int tid_o = tid_from(wave_s); asm volatile("" : "+v"(tid_o));
    const int tid = tid_o, wid = __builtin_amdgcn_readfirstlane(tid >> 6), lane = tid & 63, wr = wid >> 2, wc = wid & 3, fr = lane & 15, fq = lane >> 4;
    const int K = g.K, nt = K / BK;
    unsigned voffA[2], voffB[2];
#pragma unroll
    for (int i = 0; i < 2; ++i) { int R, C; stage_rc(tid * 16 + i * 8192, R, C); const int Rb = Epi::PERM ? ((R & ~31) + perm32(R & 31)) : R;
        voffA[i] = (unsigned)(R * K + C) * 2u; voffB[i] = (unsigned)(Rb * K + C) * 2u; }
    const size_t kstep = (size_t)(BK * 2);
    const size_t hstep = (size_t)HALF * K * 2;
    const size_t tstep = 2 * hstep;
    const unsigned ldsw = (unsigned)wid * 1024u;
    const int aoff = lds_byte(wr * 64 + fr, fq * 8), boff = lds_byte(wc * 32 + fr, fq * 8);
#define PG8_SA(b, h) (((b) * 2 + (h)) * HTB)
#define PG8_SB(b, h) ((4 + (b) * 2 + (h)) * HTB)
#define PG8_STAGE(bufoff, gbase, voff) do { _Pragma("unroll") for (int _i = 0; _i < 2; ++_i) \
        __builtin_amdgcn_global_load_lds((const unsigned*)((const char*)(gbase) + (voff)[_i]), (PG8_LAS unsigned*)(lds + (bufoff) + ldsw + _i * 8192), 16, 0, 0); } while (0)
#define PG8_LDA(dst, b, h) do { _Pragma("unroll") for (int m = 0; m < 4; ++m) _Pragma("unroll") for (int k = 0; k < 2; ++k) dst[m][k] = *(const PG8_LAS bf16x8*)(lds + PG8_SA(b, h) + aoff + m * 2048 + k * 1024); } while (0)
#define PG8_LDB(dst, b, h) do { _Pragma("unroll") for (int n = 0; n < 2; ++n) _Pragma("unroll") for (int k = 0; k < 2; ++k) dst[n][k] = *(const PG8_LAS bf16x8*)(lds + PG8_SB(b, h) + boff + n * 2048 + k * 1024); } while (0)
#define PG8_MMA(ai, bj, At, Bt) do { __builtin_amdgcn_s_setprio(1); _Pragma("unroll") for (int m = 0; m < 4; ++m) _Pragma("unroll") for (int n = 0; n < 2; ++n) _Pragma("unroll") for (int k = 0; k < 2; ++k) \
        acc[ai][bj][m][n] = __builtin_amdgcn_mfma_f32_16x16x32_bf16(Bt[n][k], At[m][k], acc[ai][bj][m][n], 0, 0, 0); __builtin_amdgcn_s_setprio(0); } while (0)
#define PG8_WAIT_V(n) asm volatile("s_waitcnt vmcnt(" #n ")" ::: "memory")
#define PG8_WAIT_L(n) asm volatile("s_waitcnt lgkmcnt(" #n ")" ::: "memory")
#define PG8_BAR __builtin_amdgcn_s_barrier()
#define PG8_SCHED __builtin_amdgcn_sched_barrier(0)
    Unit cur, nxt; int ui = 0;
    if (!S.next(0, cur)) return;
    f32x4 acc[2][2][4][2];
#pragma unroll
    for (int a = 0; a < 2; ++a)
#pragma unroll
        for (int b = 0; b < 2; ++b)
#pragma unroll
            for (int m = 0; m < 4; ++m)
#pragma unroll
                for (int n = 0; n < 2; ++n) acc[a][b][m][n] = (f32x4){0.f, 0.f, 0.f, 0.f};
    bf16x8 At[4][2], B0[2][2], B1[2][2];
    const char* cA = (const char*)g.A + (size_t)cur.pm * tstep; const char* cB = (const char*)g.Bt + (size_t)cur.pn * tstep;
    S.a_ready(cur);
    if constexpr (SP2) {
        PG8_STAGE(PG8_SB(0, 0), cB, voffB); PG8_STAGE(PG8_SB(0, 1), cB + hstep, voffB); PG8_STAGE(PG8_SA(0, 0), cA, voffA); PG8_STAGE(PG8_SA(0, 1), cA + hstep, voffA);
        if (wr == 1) PG8_BAR;
        PG8_WAIT_V(2); PG8_BAR;
        PG8_STAGE(PG8_SB(1, 0), cB + kstep, voffB); PG8_STAGE(PG8_SA(1, 0), cA + kstep, voffA); PG8_STAGE(PG8_SB(1, 1), cB + hstep + kstep, voffB);
        PG8_WAIT_V(6); PG8_BAR;
    } else {
        PG8_STAGE(PG8_SB(0, 0), cB, voffB); PG8_STAGE(PG8_SA(0, 0), cA, voffA); PG8_STAGE(PG8_SB(0, 1), cB + hstep, voffB); PG8_STAGE(PG8_SA(0, 1), cA + hstep, voffA);
        if (wr == 1) PG8_BAR;
        PG8_WAIT_V(4); PG8_BAR;
        PG8_STAGE(PG8_SB(1, 0), cB + kstep, voffB); PG8_STAGE(PG8_SA(1, 0), cA + kstep, voffA); PG8_STAGE(PG8_SB(1, 1), cB + hstep + kstep, voffB);
        PG8_WAIT_V(6); PG8_BAR;
    }
    for (;;) {
        const bool has_next = S.next(ui + 1, nxt);
        const char* nA = has_next ? (const char*)g.A + (size_t)nxt.pm * tstep : cA; const char* nB = has_next ? (const char*)g.Bt + (size_t)nxt.pn * tstep : cB;
        for (int t = 0; t < nt; t += 2) {
            const bool last = (t == nt - 2);
            const char* a1 = cA + (size_t)(t + 1) * kstep;
            const char* a2 = last ? nA : cA + (size_t)(t + 2) * kstep; const char* b2 = last ? nB : cB + (size_t)(t + 2) * kstep;
            const char* a3 = a2 + kstep; const char* b3 = b2 + kstep;
            if (last && has_next) S.a_ready(nxt);
            if constexpr (SP2) {
            PG8_LDB(B0, 0, 0); PG8_LDB(B1, 0, 1); PG8_SCHED; PG8_LDA(At, 0, 0); PG8_STAGE(PG8_SA(1, 1), a1 + hstep, voffA);
            PG8_WAIT_V(8); PG8_WAIT_L(0); PG8_BAR; PG8_MMA(0, 0, At, B0); PG8_MMA(0, 1, At, B1); PG8_BAR; PG8_SCHED;
            PG8_LDA(At, 0, 1); PG8_STAGE(PG8_SB(0, 0), b2, voffB); PG8_STAGE(PG8_SB(0, 1), b2 + hstep, voffB); PG8_STAGE(PG8_SA(0, 0), a2, voffA);
            PG8_WAIT_V(8); PG8_WAIT_L(0); PG8_BAR; PG8_MMA(1, 0, At, B0); PG8_MMA(1, 1, At, B1); PG8_BAR; PG8_SCHED;
            PG8_LDB(B0, 1, 0); PG8_LDB(B1, 1, 1); PG8_SCHED; PG8_LDA(At, 1, 0); PG8_STAGE(PG8_SA(0, 1), a2 + hstep, voffA);
            PG8_WAIT_V(8); PG8_WAIT_L(0); PG8_BAR; PG8_MMA(0, 0, At, B0); PG8_MMA(0, 1, At, B1); PG8_BAR; PG8_SCHED;
            PG8_LDA(At, 1, 1); PG8_STAGE(PG8_SB(1, 0), b3, voffB); PG8_STAGE(PG8_SB(1, 1), b3 + hstep, voffB); PG8_STAGE(PG8_SA(1, 0), a3, voffA);
            PG8_WAIT_V(8); PG8_WAIT_L(0); PG8_BAR; PG8_MMA(1, 0, At, B0); PG8_MMA(1, 1, At, B1); PG8_BAR; PG8_SCHED;
            } else {
            PG8_LDB(B0, 0, 0); PG8_SCHED; PG8_LDA(At, 0, 0); PG8_STAGE(PG8_SA(1, 1), a1 + hstep, voffA);
            PG8_WAIT_L(8); PG8_BAR; PG8_WAIT_L(0); PG8_MMA(0, 0, At, B0); PG8_BAR; PG8_SCHED;
            PG8_LDB(B1, 0, 1); PG8_STAGE(PG8_SB(0, 0), b2, voffB);
            PG8_BAR; PG8_WAIT_L(0); PG8_MMA(0, 1, At, B1); PG8_BAR;
            PG8_LDA(At, 0, 1); PG8_STAGE(PG8_SA(0, 0), a2, voffA);
            PG8_BAR; PG8_WAIT_L(0); PG8_MMA(1, 0, At, B0); PG8_BAR; PG8_SCHED;
            PG8_STAGE(PG8_SB(0, 1), b2 + hstep, voffB);
            PG8_WAIT_V(6); PG8_BAR; PG8_MMA(1, 1, At, B1); PG8_BAR;
            PG8_LDB(B0, 1, 0); PG8_SCHED; PG8_LDA(At, 1, 0); PG8_STAGE(PG8_SA(0, 1), a2 + hstep, voffA);
            PG8_WAIT_L(8); PG8_BAR; PG8_WAIT_L(0); PG8_MMA(0, 0, At, B0); PG8_BAR; PG8_SCHED;
            PG8_LDB(B1, 1, 1); PG8_STAGE(PG8_SB(1, 0), b3, voffB);
            PG8_BAR; PG8_WAIT_L(0); PG8_MMA(0, 1, At, B1); PG8_BAR;
            PG8_LDA(At, 1, 1); PG8_STAGE(PG8_SA(1, 0), a3, voffA);
            PG8_BAR; PG8_WAIT_L(0); PG8_MMA(1, 0, At, B0); PG8_BAR; PG8_SCHED;
            PG8_STAGE(PG8_SB(1, 1), b3 + hstep, voffB);
            PG8_WAIT_V(6); PG8_BAR; PG8_MMA(1, 1, At, B1); PG8_BAR;
            }
        }
        if constexpr (ALIGN_EPI) { if (wr == 0) PG8_BAR; }
        if constexpr (!Epi::AFTER_DRAIN) { E(acc, cur, wr, wc, fr, fq); S.done(cur); }
        if (!has_next) break;
#pragma unroll
        for (int a = 0; a < 2; ++a)
#pragma unroll
            for (int b = 0; b < 2; ++b)
#pragma unroll
                for (int m = 0; m < 4; ++m)
#pragma unroll
                    for (int n = 0; n < 2; ++n) acc[a][b][m][n] = (f32x4){0.f, 0.f, 0.f, 0.f};
        cur = nxt; cA = nA; cB = nB; ++ui;
        if constexpr (ALIGN_EPI) { if (wr == 1) PG8_BAR; }
    }
    PG8_WAIT_V(0);
    if constexpr (!ALIGN_EPI) { if (wr == 0) PG8_BAR; }
    PG8_BAR;
    if constexpr (Epi::AFTER_DRAIN) { E.fused(acc, cur, wr, wc, fr, fq, lds, wid, lane); S.done(cur); }
#undef PG8_SA
#undef PG8_SB
#undef PG8_STAGE
#undef PG8_LDA
#undef PG8_LDB
#undef PG8_MMA
#undef PG8_WAIT_V
#undef PG8_WAIT_L
#undef PG8_BAR
#undef PG8_SCHED
}
}
#define GAS __attribute__((address_space(1)))
#define LAS __attribute__((address_space(3)))
#define XB_TMO      128
#define XB_XCNT(j)  (256  + 64 * (j))
#define XB_XSUB(j)  (1280 + 64 * (j))
#define XB_XGEN(j)  (2304 + 64 * (j))
#define XB_TOP      3328
#define XB_TOPGEN   3392
#define XCD_BAR_WORDS 3456
#define XB_SPIN_CAP (1u << 18)

__device__ __forceinline__ unsigned xb_ld(unsigned* p)              { return __hip_atomic_load(p, __ATOMIC_RELAXED, __HIP_MEMORY_SCOPE_AGENT); }
__device__ __forceinline__ unsigned xb_add(unsigned* p, unsigned v) { return __hip_atomic_fetch_add(p, v, __ATOMIC_RELAXED, __HIP_MEMORY_SCOPE_AGENT); }
__device__ __forceinline__ unsigned xb_xcc_id() { return (unsigned)__builtin_amdgcn_s_getreg((3 << 11) | 20) & 0xFu; }
#define XB_SPIN(cond, bar) do { unsigned _sp = 0; while (cond) { __builtin_amdgcn_s_sleep(1); \
    if ((++_sp & 255u) == 0u) { if (xb_ld(&(bar)[XB_TMO])) break; if (_sp > XB_SPIN_CAP) { atomicAdd(&(bar)[XB_TMO], 1u); break; } } } } while (0)

struct XcdBarrier {
    unsigned* bar; unsigned x; int w;
    volatile LAS unsigned* st;
};

__device__ __forceinline__ XcdBarrier xcd_barrier_post(unsigned* bar, volatile LAS unsigned* st, int wave_s) {
    XcdBarrier b; b.bar = bar; b.x = xb_xcc_id(); b.st = st; b.w = wave_s;
    if (tid_from(wave_s) == 0) (void)xb_add(&bar[XB_XCNT(b.x)], 1u);
    return b;
}
__device__ __forceinline__ void xcd_barrier_complete(unsigned* bar, unsigned x, unsigned& nloc, unsigned& nx) {
    const unsigned G = gridDim.x * gridDim.y * gridDim.z;
    unsigned sum, cnt, mine, sp = 0u;
    for (;;) {
        sum = 0u; cnt = 0u; mine = 0u;
#pragma unroll
        for (unsigned j = 0; j < 16; ++j) { const unsigned c = xb_ld(&bar[XB_XCNT(j)]); sum += c; cnt += (c > 0u) ? 1u : 0u; mine = (j == x) ? c : mine; }
        if (sum == G) break;
        __builtin_amdgcn_s_sleep(1);
        if ((++sp & 255u) == 0u) { if (xb_ld(&bar[XB_TMO])) break; if (sp > XB_SPIN_CAP) { atomicAdd(&bar[XB_TMO], 1u); break; } }
    }
    nloc = mine > 0u ? mine : 1u; nx = cnt > 0u ? cnt : 1u;
}

__device__ __forceinline__ void xcd_barrier(const XcdBarrier& b) {
    asm volatile("s_waitcnt vmcnt(0)" ::: "memory");
    __syncthreads();
    if (tid_from(b.w) == 0) {
        unsigned* bar = b.bar;
        __builtin_amdgcn_s_waitcnt(0);
        unsigned nloc = b.st[0], nx = b.st[1];
        if (nloc == 0u) { xcd_barrier_complete(bar, b.x, nloc, nx); b.st[0] = nloc; b.st[1] = nx; }
        const unsigned old = xb_add(&bar[XB_XSUB(b.x)], 1u);
        const unsigned gen = old / nloc;
        if (old + 1u == (gen + 1u) * nloc) {
            __builtin_amdgcn_fence(__ATOMIC_RELEASE, "agent");
            asm volatile("s_waitcnt vmcnt(0)" ::: "memory");
            const unsigned og = xb_add(&bar[XB_TOP], 1u);
            const unsigned tg = og / nx;
            if (og + 1u == (tg + 1u) * nx) xb_add(&bar[XB_TOPGEN], 1u);
            else XB_SPIN(xb_ld(&bar[XB_TOPGEN]) == tg, bar);
            __builtin_amdgcn_fence(__ATOMIC_ACQUIRE, "agent");
            xb_add(&bar[XB_XGEN(b.x)], 1u);
            asm volatile("s_waitcnt vmcnt(0)" ::: "memory");
        } else {
            XB_SPIN(xb_ld(&bar[XB_XGEN(b.x)]) == gen, bar);
            __builtin_amdgcn_fence(__ATOMIC_ACQUIRE, "agent");
            asm volatile("s_waitcnt vmcnt(0)" ::: "memory");
        }
    }
    __syncthreads();
}

constexpr int NWAVES = 8, NTHR = 512;
constexpr int DM = 2048, NB = 2, SEQ = 4096, NT = NB * SEQ, DEPTH = 4;
constexpr int INW = 5392, INWP = 5632;
constexpr int C_POOL = 0, C_GQ = 512, C_GK = 896, C_GV = 1280, C_GG = 2048, C_GA = 2816, C_RW = 2832;
constexpr int RW_IN = 2560, RW_W = 768, RW_H = 12;
constexpr int GLA_H = 4, GLA_DK = 96, GLA_DV = 192, GLA_NCH = 64;
constexpr int PEER_N = 16384;
constexpr float NORM_EPS = 1e-6f;
constexpr int MODW = 6 * DM;

constexpr size_t MiB = 1u << 20;
constexpr size_t WS_CTL = 0, CTL_ZERO_BYTES = 1 * MiB;
constexpr size_t WS_MOD = 1 * MiB;
constexpr size_t WS_WIN = 2 * MiB;
constexpr size_t WS_WOUT = 90 * MiB;
constexpr size_t WS_WQK = 122 * MiB;
constexpr size_t WS_U = 154 * MiB;
constexpr size_t WS_V = 410 * MiB;
constexpr size_t WS_US = 540 * MiB;
constexpr size_t WS_VS = 541 * MiB;
constexpr size_t WS_POOLT = 545 * MiB;
constexpr size_t WS_LORAT = 542 * MiB;
constexpr size_t WS_X = 666 * MiB;
constexpr size_t WS_H = 730 * MiB;
constexpr size_t WS_Y = 762 * MiB;
constexpr size_t WS_PROJ = 794 * MiB;
constexpr size_t WS_GKV = 970 * MiB;
constexpr size_t WS_GS = 1006 * MiB;
constexpr size_t WS_GDEC = 1042 * MiB;
constexpr size_t WS_RSC = 1043 * MiB;
constexpr size_t WS_RO = 1187 * MiB;
constexpr size_t WS_RGATE = 1211 * MiB;
constexpr size_t WS_RBV = 1235 * MiB;
constexpr size_t WS_EIDX = 1259 * MiB;
constexpr size_t WS_EGATE = 1263 * MiB;
constexpr size_t WS_END = 1267 * MiB;
constexpr size_t WS_DUMMY = 1267 * MiB;
#ifndef PROBE
#define PROBE 0
#endif
constexpr int CW_BAR = 4096;
constexpr size_t WS_SSP = 547 * MiB;
constexpr size_t WS_BIAS3 = 546 * MiB;

constexpr int LDS_BYTES = 147456;
constexpr int MISC_OFF = 147456 - 256;

typedef unsigned short bf16;
typedef unsigned v4u __attribute__((ext_vector_type(4)));
typedef unsigned v2u __attribute__((ext_vector_type(2)));
typedef float f32x4 __attribute__((ext_vector_type(4)));
typedef float f32x2 __attribute__((ext_vector_type(2)));
typedef __bf16 bf16x2_t __attribute__((ext_vector_type(2)));
typedef int v4i __attribute__((ext_vector_type(4)));

__device__ __forceinline__ unsigned pk2(float lo, float hi) { const f32x2 f = {lo, hi}; return __builtin_bit_cast(unsigned, __builtin_convertvector(f, bf16x2_t)); }
__device__ __forceinline__ unsigned f2bf(float f) { return pk2(f, f) & 0xffffu; }
__device__ __forceinline__ float bflo(unsigned u) { return __builtin_bit_cast(float, u << 16); }
__device__ __forceinline__ float bfhi(unsigned u) { return __builtin_bit_cast(float, u & 0xffff0000u); }
__device__ __forceinline__ float dpp_xor1(float v) { return __builtin_bit_cast(float, __builtin_amdgcn_update_dpp(0, __builtin_bit_cast(int, v), 0xB1, 0xF, 0xF, true)); }
__device__ __forceinline__ float dpp_xor2(float v) { return __builtin_bit_cast(float, __builtin_amdgcn_update_dpp(0, __builtin_bit_cast(int, v), 0x4E, 0xF, 0xF, true)); }
__device__ __forceinline__ float dpp_hmir(float v) { return __builtin_bit_cast(float, __builtin_amdgcn_update_dpp(0, __builtin_bit_cast(int, v), 0x141, 0xF, 0xF, true)); }
__device__ __forceinline__ float dpp_rmir(float v) { return __builtin_bit_cast(float, __builtin_amdgcn_update_dpp(0, __builtin_bit_cast(int, v), 0x140, 0xF, 0xF, true)); }
__device__ __forceinline__ float rl_f(float v, int l) { return __builtin_bit_cast(float, __builtin_amdgcn_readlane(__builtin_bit_cast(int, v), l)); }
__device__ __forceinline__ float row16_sum(float v) { v += dpp_xor1(v); v += dpp_xor2(v); v += dpp_hmir(v); v += dpp_rmir(v); return v; }
__device__ __forceinline__ float row16_max(float v) { v = fmaxf(v, dpp_xor1(v)); v = fmaxf(v, dpp_xor2(v)); v = fmaxf(v, dpp_hmir(v)); v = fmaxf(v, dpp_rmir(v)); return v; }
__device__ __forceinline__ float wave_sum(float v) { v = row16_sum(v); return (rl_f(v, 0) + rl_f(v, 16)) + (rl_f(v, 32) + rl_f(v, 48)); }
__device__ __forceinline__ float wave_max(float v) { v = row16_max(v); return fmaxf(fmaxf(rl_f(v, 0), rl_f(v, 16)), fmaxf(rl_f(v, 32), rl_f(v, 48))); }
__device__ __forceinline__ float half32_sum(float v, int lane) { v = row16_sum(v); const float lo = rl_f(v, 0) + rl_f(v, 16), hi = rl_f(v, 32) + rl_f(v, 48); return lane < 32 ? lo : hi; }
__device__ __forceinline__ float red8(float v) { v += dpp_xor1(v); v += dpp_xor2(v); v += dpp_hmir(v); return v; }
__device__ __forceinline__ float sigmoidf_(float x) { return __builtin_amdgcn_rcpf(1.f + __builtin_amdgcn_exp2f(-1.4426950408889634f * x)); }
__device__ __forceinline__ float softplusf_(float x) { return fmaxf(x, 0.f) + 0.6931471805599453f * __builtin_amdgcn_logf(1.f + __builtin_amdgcn_exp2f(-1.4426950408889634f * fabsf(x))); }

struct Args { const float* in[30]; float* out; unsigned char* ws; };
typedef const __attribute__((address_space(4))) Args* ArgsP;
__device__ __forceinline__ ArgsP args_ptr() { ArgsP p = (ArgsP)__builtin_amdgcn_kernarg_segment_ptr(); asm volatile("" : "+s"(p)); return p; }
__device__ __forceinline__ int opaque_i(int v) { asm volatile("" : "+s"(v)); return v; }

struct Frame {
    LAS unsigned char* lds;
    int tid, lane, wave, G, bid, gw, ngw;
};
__device__ __forceinline__ Frame make_frame(LAS unsigned char* lds, int wave_s) {
    asm volatile("" : "+s"(wave_s)); Frame F; F.lds = lds; int t = tid_from(wave_s); asm volatile("" : "+v"(t));
    F.tid = t; F.lane = t & 63; F.wave = __builtin_amdgcn_readfirstlane(t >> 6); int g_ = gridDim.x, b_ = blockIdx.x; asm volatile("" : "+s"(g_), "+s"(b_)); F.G = g_; F.bid = b_; F.gw = F.bid * NWAVES + F.wave; F.ngw = F.G * NWAVES; return F;
}

struct EpiStoreF32 {
    static constexpr bool PERM = false, AFTER_DRAIN = false;
    float* C; int ldc; int ws_;
    __device__ __forceinline__ void operator()(const pg8::f32x4 (&acc)[2][2][4][2], const pg8::Unit& u, int, int, int, int) const {
        int tz = tid_from(ws_); asm volatile("" : "+v"(tz)); const int wid = tz >> 6, lane = tz & 63, wr = wid >> 2, wc = wid & 3, fr = lane & 15, fq = lane >> 4;
        const int row0 = u.pm * 256 + wr * 64 + fr, col0 = u.pn * 256 + wc * 32 + 4 * fq;
#pragma unroll
        for (int ai = 0; ai < 2; ++ai)
#pragma unroll
            for (int m = 0; m < 4; ++m) { float* rowp = C + (size_t)(row0 + ai * 128 + m * 16) * ldc + col0;
#pragma unroll
                for (int bj = 0; bj < 2; ++bj)
#pragma unroll
                    for (int n = 0; n < 2; ++n) *(pg8::f32x4*)(rowp + bj * 128 + n * 16) = acc[ai][bj][m][n]; }
    }
};
struct EpiResid {
    static constexpr bool PERM = false, AFTER_DRAIN = false;
    const float* xsrc; float* xdst; const float* gate; int ws_; const float* gain2; const float* sc2; bf16* hdst; float* ss;
    __device__ __forceinline__ void operator()(const pg8::f32x4 (&acc)[2][2][4][2], const pg8::Unit& u, int, int, int, int) const {
        int tz = tid_from(ws_); asm volatile("" : "+v"(tz)); const int wid = tz >> 6, lane = tz & 63, wr = wid >> 2, wc = wid & 3, fr = lane & 15, fq = lane >> 4;
        const int row0 = u.pm * 256 + wr * 64 + fr, col0 = u.pn * 256 + wc * 32 + 4 * fq;
        const float* gp = gate + (size_t)(u.pm >> 4) * MODW + col0; const float* sp = sc2 + (size_t)(u.pm >> 4) * MODW + col0;
        pg8::f32x4 gv[2][2], hv[2][2];
#pragma unroll
        for (int bj = 0; bj < 2; ++bj)
#pragma unroll
            for (int n = 0; n < 2; ++n) { gv[bj][n] = *(const pg8::f32x4*)(gp + bj * 128 + n * 16);
                hv[bj][n] = *(const pg8::f32x4*)(gain2 + col0 + bj * 128 + n * 16) * (*(const pg8::f32x4*)(sp + bj * 128 + n * 16) + 1.f); }
#pragma unroll
        for (int ai = 0; ai < 2; ++ai)
#pragma unroll
            for (int m = 0; m < 4; ++m) { const int row = row0 + ai * 128 + m * 16; const size_t ro = (size_t)row * DM + col0; float s = 0.f;
#pragma unroll
                for (int bj = 0; bj < 2; ++bj)
#pragma unroll
                    for (int n = 0; n < 2; ++n) { const pg8::f32x4 xv = *(const pg8::f32x4*)(xsrc + ro + bj * 128 + n * 16);
                        const pg8::f32x4 y = xv + gv[bj][n] * acc[ai][bj][m][n];
                        *(pg8::f32x4*)(xdst + ro + bj * 128 + n * 16) = y;
                        s += (y.x * y.x + y.y * y.y) + (y.z * y.z + y.w * y.w);
                        const pg8::f32x4 hh = y * hv[bj][n]; v2u pk; pk.x = pk2(hh.x, hh.y); pk.y = pk2(hh.z, hh.w); *(v2u*)(hdst + ro + bj * 128 + n * 16) = pk; }
                s += __builtin_bit_cast(float, __builtin_amdgcn_ds_bpermute((lane ^ 16) << 2, __builtin_bit_cast(int, s)));
                s += __builtin_bit_cast(float, __builtin_amdgcn_ds_bpermute((lane ^ 32) << 2, __builtin_bit_cast(int, s)));
                if (fq == 0) ss[(size_t)row * 32 + u.pn * 4 + wc] = s; }
    }
};
struct EpiScore {
    static constexpr bool PERM = false, AFTER_DRAIN = false;
    float* C; int ldc; int ws_; const LAS float* rs; const float* bias;
    __device__ __forceinline__ void operator()(const pg8::f32x4 (&acc)[2][2][4][2], const pg8::Unit& u, int, int, int, int) const {
        int tz = tid_from(ws_); asm volatile("" : "+v"(tz)); const int wid = tz >> 6, lane = tz & 63, wr = wid >> 2, wc = wid & 3, fr = lane & 15, fq = lane >> 4;
        const int row0 = u.pm * 256 + wr * 64 + fr, col0 = u.pn * 256 + wc * 32 + 4 * fq;
        const float* bp = bias + (size_t)(u.pm >> 4) * DM + col0;
        pg8::f32x4 bv[2][2];
#pragma unroll
        for (int bj = 0; bj < 2; ++bj)
#pragma unroll
            for (int n = 0; n < 2; ++n) bv[bj][n] = *(const pg8::f32x4*)(bp + bj * 128 + n * 16);
#pragma unroll
        for (int ai = 0; ai < 2; ++ai)
#pragma unroll
            for (int m = 0; m < 4; ++m) { const int row = row0 + ai * 128 + m * 16; float* rowp = C + (size_t)row * ldc + col0;
                const float rstd = rs[row & 255];
#pragma unroll
                for (int bj = 0; bj < 2; ++bj)
#pragma unroll
                    for (int n = 0; n < 2; ++n) *(pg8::f32x4*)(rowp + bj * 128 + n * 16) = acc[ai][bj][m][n] * rstd + bv[bj][n]; }
    }
};

__device__ __forceinline__ void quant_tables(ArgsP A, int l, int wvi, int nw, int lane) {
    for (int rr = wvi; rr < 2 * PEER_N; rr += nw) {
        const int tb = rr >= PEER_N, r = l * PEER_N + (rr - tb * PEER_N);
        const f32x4* src = (const f32x4*)(A->in[27 + tb] + (size_t)r * DM) + lane;
        f32x4 v[8]; float mx = 0.f;
#pragma unroll
        for (int j = 0; j < 8; ++j) { v[j] = src[64 * j]; mx = fmaxf(mx, fmaxf(fmaxf(fabsf(v[j].x), fabsf(v[j].y)), fmaxf(fabsf(v[j].z), fabsf(v[j].w)))); }
        mx = wave_max(mx);
        unsigned* dst = (unsigned*)(A->ws + (tb ? WS_V : WS_U)) + (size_t)r * (DM / 4) + lane;
        if (!tb) { const float inv = mx > 0.f ? 127.f / mx : 0.f;
#pragma unroll
            for (int j = 0; j < 8; ++j) { const int q0 = (int)rintf(v[j].x * inv), q1 = (int)rintf(v[j].y * inv), q2 = (int)rintf(v[j].z * inv), q3 = (int)rintf(v[j].w * inv);
                dst[64 * j] = (unsigned)(q0 & 255) | ((unsigned)(q1 & 255) << 8) | ((unsigned)(q2 & 255) << 16) | ((unsigned)(q3 & 255) << 24); }
            if (lane == 0) ((float*)(A->ws + WS_US))[r] = mx * (1.f / 127.f);
        } else { const float inv = mx > 0.f ? 240.f / mx : 0.f;
#pragma unroll
            for (int j = 0; j < 8; ++j) { int p = __builtin_amdgcn_cvt_pk_fp8_f32(v[j].x * inv, v[j].y * inv, 0, false); p = __builtin_amdgcn_cvt_pk_fp8_f32(v[j].z * inv, v[j].w * inv, p, true); dst[64 * j] = (unsigned)p; }
            if (lane == 0) ((float*)(A->ws + WS_VS))[r] = mx * (1.f / 240.f);
        }
    }
}

__device__ __forceinline__ void transpose_item(const float* W, int K, int N, bf16* WT, LAS float* scr, int kb, int nb, int lane) {
    const int k0 = 64 * kb, n0 = 64 * nb, nl = (lane & 15) * 4, kr = lane >> 4;
    f32x4 v[16];
#pragma unroll
    for (int it = 0; it < 16; ++it) v[it] = (n0 + nl < N) ? *(const f32x4*)(W + (size_t)(k0 + it * 4 + kr) * N + n0 + nl) : (f32x4){0.f, 0.f, 0.f, 0.f};
#pragma unroll
    for (int it = 0; it < 16; ++it) { LAS float* s = scr + (it * 4 + kr) * 65 + nl; s[0] = v[it].x; s[1] = v[it].y; s[2] = v[it].z; s[3] = v[it].w; }
    asm volatile("s_waitcnt lgkmcnt(0)" ::: "memory");
    const int c = lane & 7;
#pragma unroll
    for (int j = 0; j < 8; ++j) { const int n = (lane >> 3) + 8 * j; const LAS float* s = scr + (8 * c) * 65 + n;
        v4u o; o.x = pk2(s[0 * 65], s[1 * 65]); o.y = pk2(s[2 * 65], s[3 * 65]); o.z = pk2(s[4 * 65], s[5 * 65]); o.w = pk2(s[6 * 65], s[7 * 65]);
        if (n0 + n < N) *(v4u*)(WT + (size_t)(n0 + n) * K + k0 + 8 * c) = o; }
    asm volatile("s_waitcnt lgkmcnt(0)" ::: "memory");
}

__device__ __forceinline__ void ph_prologue(ArgsP A, LAS unsigned char* lds_, int wv_) {
    const Frame F = make_frame(lds_, wv_);
    LAS float* ldsf = (LAS float*)F.lds;
    const int tid = F.tid, lane = F.lane, wave = F.wave;
    for (int i = tid; i < NB * DM; i += NTHR) { const float c = A->in[1][i]; ldsf[i] = c / (1.f + __expf(-c)); }
    __syncthreads();
    {
        LAS float* red = ldsf + 4096;
        float* MOD = (float*)(A->ws + WS_MOD);
        for (int u = F.bid; u < DEPTH * 96; u += F.G) {
            const int l = u / 96, j0 = (u % 96) * 128;
            const float* W = A->in[2] + (size_t)l * DM * MODW + j0 + lane * 2;
            float a00 = 0.f, a01 = 0.f, a10 = 0.f, a11 = 0.f;
            const int k0 = wave * 256;
#pragma unroll 8
            for (int k = k0; k < k0 + 256; ++k) { const f32x2 w = *(const f32x2*)(W + (size_t)k * MODW); const float c0 = ldsf[k], c1 = ldsf[DM + k];
                a00 += c0 * w.x; a01 += c0 * w.y; a10 += c1 * w.x; a11 += c1 * w.y; }
            red[(wave * 2 + 0) * 128 + lane * 2] = a00; red[(wave * 2 + 0) * 128 + lane * 2 + 1] = a01;
            red[(wave * 2 + 1) * 128 + lane * 2] = a10; red[(wave * 2 + 1) * 128 + lane * 2 + 1] = a11;
            __syncthreads();
            if (tid < 256) { const int b = tid >> 7, j = tid & 127; float s = 0.f;
#pragma unroll
                for (int w = 0; w < 8; ++w) s += red[(w * 2 + b) * 128 + j];
                s += A->in[3][(size_t)l * MODW + j0 + j];
                MOD[(size_t)(l * 2 + b) * MODW + j0 + j] = s; }
            __syncthreads();
        }
    }
    {
        LAS float* scr = ldsf + wave * 4160;
        constexpr int NBI = (INW + 63) / 64;
        constexpr int I_IN = 32 * NBI, I_OUT = 32 * 32, I_L = I_IN + I_OUT;
        for (int it = F.gw; it < DEPTH * I_L; it += F.ngw) {
            const int l = it / I_L; int r = it % I_L;
            if (r < I_IN) transpose_item(A->in[5] + (size_t)l * DM * INW, DM, INW, (bf16*)(A->ws + WS_WIN) + (size_t)l * INWP * DM, scr, r / NBI, r % NBI, lane);
            else { r -= I_IN; transpose_item(A->in[22] + (size_t)l * DM * DM, DM, DM, (bf16*)(A->ws + WS_WOUT) + (size_t)l * DM * DM, scr, r / 32, r % 32, lane); }
        }
        constexpr int PADV = (INWP - INW) * DM / 8;
        for (int i = F.bid * NTHR + tid; i < DEPTH * PADV; i += F.G * NTHR) { const int l = i / PADV, r = i % PADV;
            ((v4u*)((bf16*)(A->ws + WS_WIN) + (size_t)l * INWP * DM + (size_t)INW * DM))[r] = (v4u){0u, 0u, 0u, 0u}; }
    }
    __syncthreads();
    {
        LAS float* Ks = ldsf;
        LAS float* Ws = ldsf + 128 * 132;
        for (int u = F.bid; u < DEPTH * 16 * 32; u += F.G) {
            const int l = u >> 9, hh = (u >> 5) & 15, jt = u & 31, h = hh >> 1, half = hh & 1, j0 = jt * 64;
            const float* ksrc = (half ? A->in[26] : A->in[25]) + ((size_t)l * 8 + h) * 128 * 128;
            const float* wsrc = A->in[24] + (size_t)l * DM * DM + h * 256 + half * 128;
            {   f32x4 kq[8], wq4[4];
#pragma unroll
                for (int it = 0; it < 8; ++it) { const int i = tid + it * NTHR, n = i >> 5, d4 = (i & 31) * 4; kq[it] = *(const f32x4*)(ksrc + n * 128 + d4); }
#pragma unroll
                for (int it = 0; it < 4; ++it) { const int i = tid + it * NTHR, jj = i >> 5, d4 = (i & 31) * 4; wq4[it] = *(const f32x4*)(wsrc + (size_t)(j0 + jj) * DM + d4); }
#pragma unroll
                for (int it = 0; it < 8; ++it) { const int i = tid + it * NTHR, n = i >> 5, d4 = (i & 31) * 4; *(LAS f32x4*)(Ks + n * 132 + d4) = kq[it]; }
#pragma unroll
                for (int it = 0; it < 4; ++it) { const int i = tid + it * NTHR, jj = i >> 5, d4 = (i & 31) * 4; *(LAS f32x4*)(Ws + jj * 132 + d4) = wq4[it]; }
            }
            __syncthreads();
            { const int li = lane & 15, lq = lane >> 4;
                f32x4 acc[4] = {{0.f, 0.f, 0.f, 0.f}, {0.f, 0.f, 0.f, 0.f}, {0.f, 0.f, 0.f, 0.f}, {0.f, 0.f, 0.f, 0.f}};
#pragma unroll 4
                for (int ks = 0; ks < 32; ++ks) { const float a = Ks[(wave * 16 + li) * 132 + 4 * ks + lq];
#pragma unroll
                    for (int jt = 0; jt < 4; ++jt) acc[jt] = __builtin_amdgcn_mfma_f32_16x16x4f32(a, Ws[(jt * 16 + li) * 132 + 4 * ks + lq], acc[jt], 0, 0, 0); }
                bf16* dst = (bf16*)(A->ws + WS_WQK) + (size_t)l * DM * DM + (size_t)(h * 256 + half * 128 + wave * 16 + lq * 4) * DM + j0 + li;
#pragma unroll
                for (int jt = 0; jt < 4; ++jt) { dst[(size_t)0 * DM + jt * 16] = (bf16)f2bf(acc[jt].x); dst[(size_t)1 * DM + jt * 16] = (bf16)f2bf(acc[jt].y); dst[(size_t)2 * DM + jt * 16] = (bf16)f2bf(acc[jt].z); dst[(size_t)3 * DM + jt * 16] = (bf16)f2bf(acc[jt].w); } }
            __syncthreads();
        }
    }
    {
        bf16* PT = (bf16*)(A->ws + WS_POOLT);
        for (int i = F.bid * NTHR + tid; i < DEPTH * 4 * 128 * 128; i += F.G * NTHR) { const int lg = i >> 14, r = i & 16383, dcol = r >> 7, c = r & 127;
            PT[i] = (bf16)f2bf(A->in[6][(size_t)lg * 16384 + c * 128 + dcol]); }
    }
    {
        bf16* LT = (bf16*)(A->ws + WS_LORAT);
        for (int i = F.bid * NTHR + tid; i < DEPTH * RW_W * 256; i += F.G * NTHR) { const int l = i / (RW_W * 256), r = i % (RW_W * 256), c = r >> 8, j = r & 255;
            const float v = j < 64 ? A->in[13][((size_t)l * 64 + j) * RW_W + c] : (j < 128 ? A->in[15][((size_t)l * 64 + (j - 64)) * RW_W + c] : A->in[16][((size_t)l * 128 + (j - 128)) * RW_W + c]);
            LT[i] = (bf16)f2bf(v); }
    }
    quant_tables(A, 0, F.gw, F.ngw, lane);
}

__device__ __forceinline__ void ph_norm(const float* xsrc, const float* gain, const float* sh, const float* sc, bf16* hout, LAS unsigned char* lds_, int wv_) {
    const Frame F = make_frame(lds_, wv_);
    for (int m = F.gw; m < NT; m += F.ngw) {
        const int b = m >> 12;
        const f32x4* xr = (const f32x4*)(xsrc + (size_t)m * DM) + F.lane;
        f32x4 v[8]; float ss = 0.f;
#pragma unroll
        for (int j = 0; j < 8; ++j) { v[j] = xr[64 * j]; ss += (v[j].x * v[j].x + v[j].y * v[j].y) + (v[j].z * v[j].z + v[j].w * v[j].w); }
        const float rstd = rsqrtf(wave_sum(ss) * (1.f / DM) + NORM_EPS);
        v2u* o8 = (v2u*)(hout + (size_t)m * DM) + F.lane;
#pragma unroll
        for (int j = 0; j < 8; ++j) { const int col = j * 256 + F.lane * 4;
            const f32x4 g = *(const f32x4*)(gain + col), s1 = *(const f32x4*)(sc + (size_t)b * MODW + col), s0 = *(const f32x4*)(sh + (size_t)b * MODW + col);
            const f32x4 y = v[j] * rstd * g * (s1 + 1.f) + s0;
            v2u o; o.x = pk2(y.x, y.y); o.y = pk2(y.z, y.w); o8[64 * j] = o; }
    }
}
__device__ __forceinline__ void ph_final(const float* xsrc, const float* gain, float* out, LAS unsigned char* lds_, int wv_) {
    const Frame F = make_frame(lds_, wv_);
    for (int m = F.gw; m < NT; m += F.ngw) {
        const f32x4* xr = (const f32x4*)(xsrc + (size_t)m * DM) + F.lane;
        f32x4 v[8]; float ss = 0.f;
#pragma unroll
        for (int j = 0; j < 8; ++j) { v[j] = xr[64 * j]; ss += (v[j].x * v[j].x + v[j].y * v[j].y) + (v[j].z * v[j].z + v[j].w * v[j].w); }
        const float rstd = rsqrtf(wave_sum(ss) * (1.f / DM) + NORM_EPS);
        f32x4* o = (f32x4*)(out + (size_t)m * DM) + F.lane;
#pragma unroll
        for (int j = 0; j < 8; ++j) { const f32x4 g = *(const f32x4*)(gain + j * 256 + F.lane * 4); o[64 * j] = v[j] * rstd * g; }
    }
}

__device__ __forceinline__ void pool_unit(ArgsP A, const Frame& F_in, int l, int unit) {
    Frame F = F_in; asm volatile("" : "+v"(F.tid)); F.lane = F.tid & 63;
    const int tile = unit >> 2, g = unit & 3, t0 = tile * 32, s0 = t0 & (SEQ - 1), tid = F.tid, lane = F.lane, w = F.wave;
    const int win = 2 << g;
    const float* proj = (const float*)(A->ws + WS_PROJ);
    LAS float* ps = (LAS float*)F.lds;
    LAS unsigned short* ds = (LAS unsigned short*)(F.lds + 24064);
    const int rt = w >> 2, ct0 = (w & 3) * 2, li = lane & 15, lq = lane >> 4;
    typedef short b8 __attribute__((ext_vector_type(8)));
    b8 bw[2][4];
    { const unsigned short* PT = (const unsigned short*)(A->ws + WS_POOLT) + ((size_t)l * 4 + g) * 16384;
#pragma unroll
        for (int j = 0; j < 2; ++j)
#pragma unroll
            for (int ks = 0; ks < 4; ++ks) bw[j][ks] = *(const b8*)(PT + (size_t)((ct0 + j) * 16 + li) * 128 + ks * 32 + lq * 8); }
    {   f32x4 pq[3];
#pragma unroll
        for (int it = 0; it < 3; ++it) { const int i = tid + it * NTHR, r = i >> 5, c4 = i & 31; const int s = s0 - 15 + r;
            pq[it] = (i < 47 * 32 && s >= 0) ? *(const f32x4*)(proj + (size_t)(t0 - 15 + r) * INWP + C_POOL + g * 128 + c4 * 4) : (f32x4){0.f, 0.f, 0.f, 0.f}; }
#pragma unroll
        for (int it = 0; it < 3; ++it) { const int i = tid + it * NTHR; if (i < 47 * 32) *(LAS f32x4*)(ps + i * 4) = pq[it]; }
    }
    __syncthreads();
    for (int i = tid; i < 32 * 128; i += NTHR) { const int tok = i >> 7, c = i & 127; float sum = 0.f;
        for (int ww = 0; ww < win; ++ww) sum += ps[(tok + 15 - ww) * 128 + c];
        const int cnt = (s0 + tok + 1) < win ? (s0 + tok + 1) : win;
        ds[tok * 136 + c] = (unsigned short)f2bf(sum * __builtin_amdgcn_rcpf((float)cnt) - ps[(tok + 15) * 128 + c]); }
    __syncthreads();
    f32x4 acc[2] = {{0.f, 0.f, 0.f, 0.f}, {0.f, 0.f, 0.f, 0.f}};
#pragma unroll
    for (int ks = 0; ks < 4; ++ks) { const b8 a = *(const LAS b8*)(ds + (rt * 16 + li) * 136 + ks * 32 + lq * 8);
#pragma unroll
        for (int j = 0; j < 2; ++j) acc[j] = __builtin_amdgcn_mfma_f32_16x16x32_bf16(a, bw[j][ks], acc[j], 0, 0, 0); }
    bf16* Y = (bf16*)(A->ws + WS_Y);
#pragma unroll
    for (int j = 0; j < 2; ++j) { const int dcol = (ct0 + j) * 16 + li; const float scale = A->in[7][(size_t)l * 512 + g * 128 + dcol]; const int tk = t0 + rt * 16 + lq * 4;
        Y[(size_t)(tk + 0) * DM + g * 128 + dcol] = (bf16)f2bf(acc[j].x * scale); Y[(size_t)(tk + 1) * DM + g * 128 + dcol] = (bf16)f2bf(acc[j].y * scale);
        Y[(size_t)(tk + 2) * DM + g * 128 + dcol] = (bf16)f2bf(acc[j].z * scale); Y[(size_t)(tk + 3) * DM + g * 128 + dcol] = (bf16)f2bf(acc[j].w * scale); }
    __syncthreads();
}

__device__ __forceinline__ void gla_bcum(ArgsP A, const Frame& F, int l, int h, int t0, LAS float* bcum, LAS float* ad, LAS float* up) {
    const float* proj = (const float*)(A->ws + WS_PROJ);
    const int tid = F.tid;
    {
        const float a0 = proj[(size_t)(t0 + (tid >> 4)) * INWP + C_GA + (tid & 15)], a1 = proj[(size_t)(t0 + 32 + (tid >> 4)) * INWP + C_GA + (tid & 15)];
        const float* upg = A->in[8] + (size_t)l * 16 * 384 + h * 96;
        const float u0 = upg[(tid / 96) * 384 + tid % 96], u1 = upg[((tid + 512) / 96) * 384 + (tid + 512) % 96], u2 = upg[((tid + 1024) / 96) * 384 + (tid + 1024) % 96];
        ad[tid] = a0; ad[tid + 512] = a1; up[tid] = u0; up[tid + 512] = u1; up[tid + 1024] = u2;
    }
    __syncthreads();
    for (int i = tid; i < 64 * 96; i += NTHR) { const int tok = i / 96, d = i % 96; float x = A->in[9][(size_t)l * 384 + h * 96 + d];
#pragma unroll
        for (int j = 0; j < 16; ++j) x += ad[tok * 16 + j] * up[j * 96 + d];
        bcum[i] = -softplusf_(-x) * (1.f / 16.f); }
    __syncthreads();
    if (tid < 384) { const int d = tid % 96, seg = tid / 96; float acc = 0.f;
#pragma unroll
        for (int k = 0; k < 16; ++k) { acc += bcum[(seg * 16 + k) * 96 + d]; bcum[(seg * 16 + k) * 96 + d] = acc; }
        ad[seg * 96 + d] = acc; }
    __syncthreads();
    if (tid < 384) { const int d = tid % 96, seg = tid / 96; float pre = 0.f;
#pragma unroll
        for (int s2 = 0; s2 < 3; ++s2) pre += (s2 < seg) ? ad[s2 * 96 + d] : 0.f;
        if (seg > 0) {
#pragma unroll
            for (int k = 0; k < 16; ++k) bcum[(seg * 16 + k) * 96 + d] += pre; } }
    __syncthreads();
}

__device__ __forceinline__ void gla_scan_unit(ArgsP A, const Frame& F, int unit) {
    const int idx = unit * NTHR + F.tid, bh = idx / 18432, rem = idx % 18432, d = rem % 96;
    const float* KV = (const float*)(A->ws + WS_GKV) + (size_t)bh * 64 * 18432 + rem;
    float* GS = (float*)(A->ws + WS_GS) + (size_t)bh * 64 * 18432 + rem;
    const float* DEC = (const float*)(A->ws + WS_GDEC) + (size_t)bh * 64 * 96 + d;
    float S = 0.f;
#pragma unroll 1
    for (int c0 = 0; c0 < 64; c0 += 16) {
        float kv[16], dc[16];
#pragma unroll
        for (int j = 0; j < 16; ++j) { kv[j] = KV[(size_t)(c0 + j) * 18432]; dc[j] = DEC[(c0 + j) * 96]; }
#pragma unroll
        for (int j = 0; j < 16; ++j) { GS[(size_t)(c0 + j) * 18432] = S; S = dc[j] * S + kv[j]; }
    }
}

typedef short bf16x8_t __attribute__((ext_vector_type(8)));
constexpr int RS = 68;
__device__ __forceinline__ f32x4 tile_mm64(const LAS bf16* Am, int arow0, const LAS bf16* Bm, int brow0, f32x4 acc, int lane) {
    const int r = lane & 15, kq = (lane >> 4) * 8;
#pragma unroll
    for (int ks = 0; ks < 2; ++ks) {
        const bf16x8_t a = *(const LAS bf16x8_t*)(Am + (arow0 + r) * RS + ks * 32 + kq);
        const bf16x8_t b = *(const LAS bf16x8_t*)(Bm + (brow0 + r) * RS + ks * 32 + kq);
        acc = __builtin_amdgcn_mfma_f32_16x16x32_bf16(a, b, acc, 0, 0, 0);
    }
    return acc;
}
constexpr int RA_BT = 0, RA_KT = 8704, RA_AT = 17408, RA_RT = 26112, RA_RABS = 34816, RA_BHT = 43520, RA_KHT = 52224, RA_VT = 60928, RA_AABS = 69632,
              RA_MBAT = 86272, RA_MKA = 103680, RA_NBRT = 121088, RA_GC = 129792, RA_WT = 130048, RA_NKRT = 132096, RA_END = 140800, RA_PRE = 94976;
constexpr int RA_Z = RA_BT, RA_QST = RA_AT, RA_QOT = RA_RT, RA_LO = 0, RA_RES = 34816;
constexpr size_t RWO_POT = 0, RWO_PST = 12 * MiB, RWO_GT = 24 * MiB, RWO_OLT = 48 * MiB, RWO_SC = 72 * MiB;

__device__ __forceinline__ void rwkvA_unit(ArgsP A, const Frame& F_in, int l, int unit) {
    Frame F = F_in; asm volatile("" : "+v"(F.tid)); F.lane = F.tid & 63;

    const int bh = unit >> 6, c = unit & 63, b = bh / RW_H, h = bh % RW_H, t0 = b * SEQ + c * 64, s0 = c * 64, tid = F.tid, lane = F.lane, w = F.wave;
    const float* proj = (const float*)(A->ws + WS_PROJ);
    const float* mu = A->in[11] + (size_t)l * RW_IN;
    LAS unsigned char* L = F.lds;
    const int n = lane, cc = h * 64 + n;
    const int rt1 = w >> 1, ct1 = (w & 1) * 2, li1 = lane & 15, lq1 = lane >> 4;
    f32x4 yc[8], yp[8];
#pragma unroll
    for (int it = 0; it < 8; ++it) { const int g = tid + it * NTHR, tok = g >> 6, j4 = (g & 63) * 4; const float* rp = proj + ((size_t)t0 + tok) * INWP + C_RW + 2304 + j4;
        yc[it] = *(const f32x4*)rp; yp[it] = (s0 + tok > 0) ? *(const f32x4*)(rp - INWP) : (f32x4){0.f, 0.f, 0.f, 0.f}; }
    bf16x8_t bw[2][8];
    { const bf16* LT = (const bf16*)(A->ws + WS_LORAT) + ((size_t)l * RW_W + h * 64) * 256;
#pragma unroll
        for (int j = 0; j < 2; ++j)
#pragma unroll
            for (int ks = 0; ks < 8; ++ks) bw[j][ks] = *(const bf16x8_t*)(LT + (size_t)((ct1 + j) * 16 + li1) * 256 + ks * 32 + lq1 * 8); }
    float rr[9], kr[9], vr[9];
#pragma unroll
    for (int i = 0; i < 9; ++i) { const int tok = w * 8 + i - 1; const bool ok = (s0 + tok >= 0); const float* row = proj + ((size_t)t0 + tok) * INWP + C_RW;
        rr[i] = ok ? row[cc] : 0.f; kr[i] = ok ? row[768 + cc] : 0.f; vr[i] = ok ? row[1536 + cc] : 0.f; }
    const float w0c = A->in[12][(size_t)l * RW_W + cc], a0c = A->in[14][(size_t)l * RW_W + cc], kkc = A->in[17][(size_t)l * RW_W + cc], kac = A->in[18][(size_t)l * RW_W + cc], rkc = A->in[19][(size_t)l * RW_W + cc];
    const float mur = mu[cc], muk = mu[768 + cc], muv = mu[1536 + cc];
    {   LAS bf16* lo = (LAS bf16*)(L + RA_LO);
#pragma unroll
        for (int it = 0; it < 8; ++it) { const int g = tid + it * NTHR, tok = g >> 6, j4 = (g & 63) * 4; const f32x4 m4 = *(const f32x4*)(mu + 2304 + j4);
            const f32x4 ym = yc[it] + (yp[it] - yc[it]) * m4;
            const float sc = j4 < 64 ? 2.f : 1.f; f32x4 sg; sg.x = sigmoidf_(ym.x * sc); sg.y = sigmoidf_(ym.y * sc); sg.z = sigmoidf_(ym.z * sc); sg.w = sigmoidf_(ym.w * sc);
            const f32x4 o = j4 < 64 ? sg * 2.f - 1.f : (j4 < 128 ? ym : sg);
            v2u pk; pk.x = pk2(o.x, o.y); pk.y = pk2(o.z, o.w); *(LAS v2u*)(lo + tok * 264 + j4) = pk; }
    }
    __syncthreads();
    {
        const int rt = rt1, ct0 = ct1, li = li1, lq = lq1;
        const LAS bf16* lo = (const LAS bf16*)(L + RA_LO);
        LAS float* res = (LAS float*)(L + RA_RES);
        f32x4 acc[3][2];
#pragma unroll
        for (int p = 0; p < 3; ++p)
#pragma unroll
            for (int j = 0; j < 2; ++j) acc[p][j] = (f32x4){0.f, 0.f, 0.f, 0.f};
#pragma unroll
        for (int ks = 0; ks < 8; ++ks) { const bf16x8_t a = *(const LAS bf16x8_t*)(lo + (rt * 16 + li) * 264 + ks * 32 + lq * 8);
            const int p = ks < 2 ? 0 : (ks < 4 ? 1 : 2);
#pragma unroll
            for (int j = 0; j < 2; ++j) acc[p][j] = __builtin_amdgcn_mfma_f32_16x16x32_bf16(a, bw[j][ks], acc[p][j], 0, 0, 0); }
#pragma unroll
        for (int p = 0; p < 3; ++p)
#pragma unroll
            for (int j = 0; j < 2; ++j) { LAS float* rp = res + p * 64 * 68 + (rt * 16 + lq * 4) * 68 + (ct0 + j) * 16 + li;
                rp[0] = acc[p][j].x; rp[68] = acc[p][j].y; rp[136] = acc[p][j].z; rp[204] = acc[p][j].w; }
    }
    __syncthreads();
    float r_[8], k_[8], v_[8], av_[8], bb_[8], lw_[8];
    {
        const LAS float* res = (const LAS float*)(L + RA_RES);
        float wl[8], al[8], gl[8];
#pragma unroll
        for (int i = 0; i < 8; ++i) { wl[i] = res[(w * 8 + i) * 68 + n]; al[i] = res[64 * 68 + (w * 8 + i) * 68 + n]; gl[i] = res[2 * 64 * 68 + (w * 8 + i) * 68 + n]; }
        float* GATE = (float*)(A->ws + WS_RGATE); float* BV = (float*)(A->ws + WS_RBV);
#pragma unroll
        for (int i = 0; i < 8; ++i) { const int tok = w * 8 + i; const size_t t = (size_t)t0 + tok;
            float r = rr[i + 1], k = kr[i + 1], v = vr[i + 1];
            r += (rr[i] - r) * mur; k += (kr[i] - k) * muk; v += (vr[i] - v) * muv;
            const float wraw = -softplusf_(-(w0c + wl[i])) - 0.5f;
            const float a = sigmoidf_(a0c + al[i]);
            float kk = k * kkc; kk = kk * __builtin_amdgcn_rsqf(fmaxf(wave_sum(kk * kk), 1e-24f));
            const float k2 = k * (1.f + (a - 1.f) * kac);
            const float bonus = wave_sum(r * k2 * rkc);
            r_[i] = r; k_[i] = k2; v_[i] = v; av_[i] = -kk; bb_[i] = kk * a; lw_[i] = -__expf(wraw);
            GATE[t * RW_W + cc] = gl[i]; BV[t * RW_W + cc] = bonus * v; }
    }
    LAS float* wt = (LAS float*)(L + RA_WT);
#pragma unroll
    for (int i = 1; i < 8; ++i) lw_[i] += lw_[i - 1];
    wt[w * 64 + n] = lw_[7];
    __syncthreads();
    float pre = 0.f, mid = 0.f, last = 0.f;
#pragma unroll
    for (int ww = 0; ww < 8; ++ww) { const float x = wt[ww * 64 + n]; pre += (ww < w) ? x : 0.f; mid += (ww < 4) ? x : 0.f; last += x; }
    {
        LAS bf16* Bt = (LAS bf16*)(L + RA_BT); LAS bf16* Kt = (LAS bf16*)(L + RA_KT); LAS bf16* At = (LAS bf16*)(L + RA_AT); LAS bf16* Rt = (LAS bf16*)(L + RA_RT);
        LAS bf16* Rab = (LAS bf16*)(L + RA_RABS); LAS bf16* BhT = (LAS bf16*)(L + RA_BHT); LAS bf16* KhT = (LAS bf16*)(L + RA_KHT); LAS bf16* VT = (LAS bf16*)(L + RA_VT);
        LAS float* AabT = (LAS float*)(L + RA_AABS);
#pragma unroll
        for (int i = 0; i < 8; ++i) { const int t = w * 8 + i; const float lw = pre + lw_[i], lwm1 = pre + (i > 0 ? lw_[i - 1] : 0.f);
            const float eg = __expf(lw - mid), egi = __expf(mid - lw), egm1 = __expf(lwm1 - mid), eh = __expf(last - lw);
            Bt[t * RS + n] = (bf16)f2bf(bb_[i] * egi); Kt[t * RS + n] = (bf16)f2bf(k_[i] * egi); At[t * RS + n] = (bf16)f2bf(av_[i] * egm1); Rt[t * RS + n] = (bf16)f2bf(r_[i] * eg);
            Rab[t * RS + n] = (bf16)f2bf(r_[i] * __expf(lw)); AabT[n * 65 + t] = av_[i] * __expf(lwm1);
            BhT[n * RS + t] = (bf16)f2bf(bb_[i] * eh); KhT[n * RS + t] = (bf16)f2bf(k_[i] * eh); VT[n * RS + t] = (bf16)f2bf(v_[i]); }
        if (w == 0) ((LAS float*)(L + RA_GC))[n] = __expf(last);
    }
    __syncthreads();
    const int rt = w >> 1, ct0 = (w & 1) * 2, li = lane & 15, lq = lane >> 4;
#define FRAG(mat_, row_, ks_) (*(const LAS bf16x8_t*)((mat_) + ((row_) + li) * RS + (ks_) * 32 + lq * 8))
#define MM(a_, b_, c_) __builtin_amdgcn_mfma_f32_16x16x32_bf16(a_, b_, c_, 0, 0, 0)
    {
        const LAS bf16* Bt = (const LAS bf16*)(L + RA_BT); const LAS bf16* Kt = (const LAS bf16*)(L + RA_KT); const LAS bf16* At = (const LAS bf16*)(L + RA_AT); const LAS bf16* Rt = (const LAS bf16*)(L + RA_RT);
        LAS bf16* MbaT = (LAS bf16*)(L + RA_MBAT); LAS float* Mka = (LAS float*)(L + RA_MKA); LAS bf16* NbrT = (LAS bf16*)(L + RA_NBRT);
        bf16x8_t aB[2], aK[2], bA[2][2], bR[2][2];
#pragma unroll
        for (int ks = 0; ks < 2; ++ks) { aB[ks] = FRAG(Bt, rt * 16, ks); aK[ks] = FRAG(Kt, rt * 16, ks);
#pragma unroll
            for (int j = 0; j < 2; ++j) { bA[j][ks] = FRAG(At, (ct0 + j) * 16, ks); bR[j][ks] = FRAG(Rt, (ct0 + j) * 16, ks); } }
#pragma unroll
        for (int j = 0; j < 2; ++j) { const int ct = ct0 + j, tcol = ct * 16 + li, srow = rt * 16 + lq * 4;
            const f32x4 z = {0.f, 0.f, 0.f, 0.f};
            f32x4 mba = MM(aB[1], bA[j][1], MM(aB[0], bA[j][0], z)), nbr = MM(aB[1], bR[j][1], MM(aB[0], bR[j][0], z));
            f32x4 mka = MM(aK[1], bA[j][1], MM(aK[0], bA[j][0], z)), nk = MM(aK[1], bR[j][1], MM(aK[0], bR[j][0], z));
            mba.x = (srow + 0 < tcol) ? mba.x : 0.f; mba.y = (srow + 1 < tcol) ? mba.y : 0.f; mba.z = (srow + 2 < tcol) ? mba.z : 0.f; mba.w = (srow + 3 < tcol) ? mba.w : 0.f;
            mka.x = (srow + 0 < tcol) ? mka.x : 0.f; mka.y = (srow + 1 < tcol) ? mka.y : 0.f; mka.z = (srow + 2 < tcol) ? mka.z : 0.f; mka.w = (srow + 3 < tcol) ? mka.w : 0.f;
            nbr.x = (srow + 0 <= tcol) ? nbr.x : 0.f; nbr.y = (srow + 1 <= tcol) ? nbr.y : 0.f; nbr.z = (srow + 2 <= tcol) ? nbr.z : 0.f; nbr.w = (srow + 3 <= tcol) ? nbr.w : 0.f;
            nk.x = (srow + 0 <= tcol) ? nk.x : 0.f; nk.y = (srow + 1 <= tcol) ? nk.y : 0.f; nk.z = (srow + 2 <= tcol) ? nk.z : 0.f; nk.w = (srow + 3 <= tcol) ? nk.w : 0.f;
            { v2u pm; pm.x = pk2(mba.x, mba.y); pm.y = pk2(mba.z, mba.w); *(LAS v2u*)(MbaT + tcol * RS + srow) = pm; }
            Mka[(srow + 0) * RS + tcol] = mka.x; Mka[(srow + 1) * RS + tcol] = mka.y; Mka[(srow + 2) * RS + tcol] = mka.z; Mka[(srow + 3) * RS + tcol] = mka.w;
            v2u pk; pk.x = pk2(nbr.x, nbr.y); pk.y = pk2(nbr.z, nbr.w); *(LAS v2u*)(NbrT + tcol * RS + srow) = pk;
            { v2u pn; pn.x = pk2(nk.x, nk.y); pn.y = pk2(nk.z, nk.w); *(LAS v2u*)((LAS bf16*)(L + RA_NKRT) + tcol * RS + srow) = pn; } }
    }
    __syncthreads();
    {
        int t4 = tid; asm volatile("" : "+v"(t4)); const int row = t4 >> 2, q = t4 & 3, l4 = t4 & 63, li4 = l4 & 15, lq4 = l4 >> 4;
        const LAS bf16* MbaT = (const LAS bf16*)(L + RA_MBAT);
        const LAS float* Yrow = (row < 64) ? ((const LAS float*)(L + RA_AABS) + row * 65) : ((const LAS float*)(L + RA_MKA) + (row - 64) * RS);
        LAS bf16* Z = (LAS bf16*)(L + RA_Z); LAS float* pre = (LAS float*)(L + RA_PRE);
        for (int i = t4; i < 1088; i += NTHR) ((LAS v4u*)Z)[i] = (v4u){0u, 0u, 0u, 0u};
        __syncthreads();
#pragma unroll 1
        for (int jb = 0; jb < 4; ++jb) {
            if (jb > 0) {
                f32x4 acc = {0.f, 0.f, 0.f, 0.f};
#pragma unroll
                for (int ks = 0; ks < 2; ++ks) { const bf16x8_t a = *(const LAS bf16x8_t*)(Z + (w * 16 + li4) * RS + ks * 32 + lq4 * 8);
                    const bf16x8_t bm = *(const LAS bf16x8_t*)(MbaT + (jb * 16 + li4) * RS + ks * 32 + lq4 * 8);
                    acc = __builtin_amdgcn_mfma_f32_16x16x32_bf16(a, bm, acc, 0, 0, 0); }
                LAS float* pp = pre + (w * 16 + lq4 * 4) * 16 + li4;
                pp[0] = acc.x; pp[16] = acc.y; pp[32] = acc.z; pp[48] = acc.w;
                __syncthreads();
            }
            float yv[16]; v2u mv[16];
#pragma unroll
            for (int u = 0; u < 16; ++u) { yv[u] = Yrow[jb * 16 + u] + (jb > 0 ? pre[row * 16 + u] : 0.f); mv[u] = *(const LAS v2u*)(MbaT + (jb * 16 + u) * RS + jb * 16 + q * 4); }
            float zb[4] = {0.f, 0.f, 0.f, 0.f};
#pragma unroll
            for (int u = 0; u < 16; ++u) {
                float part = (zb[0] * bflo(mv[u].x) + zb[1] * bfhi(mv[u].x)) + (zb[2] * bflo(mv[u].y) + zb[3] * bfhi(mv[u].y));
                part += dpp_xor1(part); part += dpp_xor2(part);
                const float zt = yv[u] + part;
                zb[u & 3] = (q == (u >> 2)) ? zt : zb[u & 3];
            }
            { v2u pk; pk.x = pk2(zb[0], zb[1]); pk.y = pk2(zb[2], zb[3]); *(LAS v2u*)(Z + row * RS + jb * 16 + q * 4) = pk; }
            __syncthreads();
        }
    }
    {
        int t5 = tid; asm volatile("" : "+v"(t5)); const int li = t5 & 15, lq = (t5 >> 4) & 3;
        const LAS bf16* Z = (const LAS bf16*)(L + RA_Z); const LAS bf16* NbrT = (const LAS bf16*)(L + RA_NBRT); const LAS bf16* BhT = (const LAS bf16*)(L + RA_BHT);
        const LAS bf16* Rab = (const LAS bf16*)(L + RA_RABS); const LAS bf16* KhT = (const LAS bf16*)(L + RA_KHT); const LAS float* gC = (const LAS float*)(L + RA_GC);
        LAS bf16* QsT = (LAS bf16*)(L + RA_QST); LAS bf16* QoT = (LAS bf16*)(L + RA_QOT);
        bf16* PoT = (bf16*)(A->ws + WS_RSC + RWO_POT) + (size_t)unit * 4096; bf16* PsT = (bf16*)(A->ws + WS_RSC + RWO_PST) + (size_t)unit * 4096;
        bf16x8_t zW[2], zX[2], bN[2][2], bH[2][2]; v2u rb[2], kb[2], nb2[2]; float gc[2];
#pragma unroll
        for (int ks = 0; ks < 2; ++ks) { zW[ks] = FRAG(Z, rt * 16, ks); zX[ks] = FRAG(Z, 64 + rt * 16, ks);
#pragma unroll
            for (int j = 0; j < 2; ++j) { bN[j][ks] = FRAG(NbrT, (ct0 + j) * 16, ks); bH[j][ks] = FRAG(BhT, (ct0 + j) * 16, ks); } }
#pragma unroll
        for (int j = 0; j < 2; ++j) { const int col = (ct0 + j) * 16 + li, rw = rt * 16 + lq * 4; rb[j] = *(const LAS v2u*)(Rab + col * RS + rw); kb[j] = *(const LAS v2u*)(KhT + col * RS + rw); nb2[j] = *(const LAS v2u*)((const LAS bf16*)(L + RA_NKRT) + col * RS + rw); gc[j] = gC[col]; }
#pragma unroll
        for (int j = 0; j < 2; ++j) { const int col = (ct0 + j) * 16 + li, rw = rt * 16 + lq * 4;
            { f32x4 acc = {bflo(rb[j].x), bfhi(rb[j].x), bflo(rb[j].y), bfhi(rb[j].y)};
                acc = MM(zW[1], bN[j][1], MM(zW[0], bN[j][0], acc));
                v2u pk; pk.x = pk2(acc.x, acc.y); pk.y = pk2(acc.z, acc.w); *(v2u*)(PoT + (size_t)col * 64 + rw) = pk; }
            { f32x4 acc = {(rw + 0 == col) ? gc[j] : 0.f, (rw + 1 == col) ? gc[j] : 0.f, (rw + 2 == col) ? gc[j] : 0.f, (rw + 3 == col) ? gc[j] : 0.f};
                acc = MM(zW[1], bH[j][1], MM(zW[0], bH[j][0], acc));
                v2u pk; pk.x = pk2(acc.x, acc.y); pk.y = pk2(acc.z, acc.w); *(v2u*)(PsT + (size_t)col * 64 + rw) = pk; }
            { f32x4 acc = {bflo(nb2[j].x), bfhi(nb2[j].x), bflo(nb2[j].y), bfhi(nb2[j].y)};
                acc = MM(zX[1], bN[j][1], MM(zX[0], bN[j][0], acc));
                v2u pk; pk.x = pk2(acc.x, acc.y); pk.y = pk2(acc.z, acc.w); *(LAS v2u*)(QoT + col * RS + rw) = pk; }
            { f32x4 acc = {bflo(kb[j].x), bfhi(kb[j].x), bflo(kb[j].y), bfhi(kb[j].y)};
                acc = MM(zX[1], bH[j][1], MM(zX[0], bH[j][0], acc));
                v2u pk; pk.x = pk2(acc.x, acc.y); pk.y = pk2(acc.z, acc.w); *(LAS v2u*)(QsT + col * RS + rw) = pk; }
        }
    }
    __syncthreads();
    {
        int t6 = tid; asm volatile("" : "+v"(t6)); const int li = t6 & 15, lq = (t6 >> 4) & 3;
        const LAS bf16* VT = (const LAS bf16*)(L + RA_VT);
        const bool isO = (w & 1);
        const LAS bf16* Bm = (const LAS bf16*)(L + (isO ? RA_QOT : RA_QST));
        float* dst = (float*)(A->ws + WS_RSC + (isO ? RWO_OLT : RWO_GT)) + (size_t)unit * 4096;
        bf16x8_t av[2], bq[4][2];
#pragma unroll
        for (int ks = 0; ks < 2; ++ks) { av[ks] = FRAG(VT, rt * 16, ks);
#pragma unroll
            for (int j = 0; j < 4; ++j) bq[j][ks] = FRAG(Bm, j * 16, ks); }
#pragma unroll
        for (int j = 0; j < 4; ++j) { const f32x4 z = {0.f, 0.f, 0.f, 0.f};
            const f32x4 acc = MM(av[1], bq[j][1], MM(av[0], bq[j][0], z));
            *(f32x4*)(dst + (size_t)(j * 16 + li) * 64 + rt * 16 + lq * 4) = acc; }
    }
#undef FRAG
#undef MM
    __syncthreads();
}

__device__ __forceinline__ void rwkvB_scan(ArgsP A, const Frame& F, int unit) {
    const int bh = unit >> 2, rq = unit & 3;
    const int tid = F.tid, lane = F.lane, w = F.wave, ct = w & 3, li = lane & 15, lq = lane >> 4;
    const bool writer = (w < 4);
    const bf16* PsT = (const bf16*)(A->ws + WS_RSC + RWO_PST) + (size_t)bh * 64 * 4096; const float* GT = (const float*)(A->ws + WS_RSC + RWO_GT) + (size_t)bh * 64 * 4096;
    bf16* SC = (bf16*)(A->ws + WS_RSC + RWO_SC) + (size_t)bh * 64 * 4096;
    f32x4 S = {0.f, 0.f, 0.f, 0.f};
    constexpr int PF = 4;
    bf16x8_t pb[PF][2]; f32x4 gq[PF];
    const int col = ct * 16 + li;
#define SLOAD(slot, cc_) do { _Pragma("unroll") for (int ks = 0; ks < 2; ++ks) pb[slot][ks] = *(const bf16x8_t*)(PsT + (size_t)(cc_) * 4096 + (size_t)col * 64 + ks * 32 + lq * 8); \
        gq[slot] = *(const f32x4*)(GT + (size_t)(cc_) * 4096 + (size_t)col * 64 + rq * 16 + lq * 4); } while (0)
#define SSTEP(slot, cc_) do { LAS bf16* Sl = (LAS bf16*)(F.lds + ((cc_) & 1) * 2176); \
        if (writer) { const int rw_ = lq * 4; Sl[(rw_ + 0) * RS + col] = (bf16)f2bf(S.x); Sl[(rw_ + 1) * RS + col] = (bf16)f2bf(S.y); Sl[(rw_ + 2) * RS + col] = (bf16)f2bf(S.z); Sl[(rw_ + 3) * RS + col] = (bf16)f2bf(S.w); } \
        asm volatile("s_waitcnt lgkmcnt(0)" ::: "memory"); __builtin_amdgcn_s_barrier(); asm volatile("" ::: "memory");        \
        if (tid < 128) { const int v_ = tid >> 3, k8_ = (tid & 7) * 8; *(v4u*)(SC + (size_t)(cc_) * 4096 + (rq * 16 + v_) * 64 + k8_) = *(const LAS v4u*)(Sl + v_ * RS + k8_); } \
        f32x4 acc_ = gq[slot]; \
        _Pragma("unroll") for (int ks = 0; ks < 2; ++ks) { const bf16x8_t a_ = *(const LAS bf16x8_t*)(Sl + li * RS + ks * 32 + lq * 8); \
            acc_ = __builtin_amdgcn_mfma_f32_16x16x32_bf16(a_, pb[slot][ks], acc_, 0, 0, 0); } \
        S = acc_; } while (0)
    SLOAD(0, 0); SLOAD(1, 1); SLOAD(2, 2); SLOAD(3, 3);
#pragma unroll 1
    for (int c = 0; c < 64; c += 4) {
        const int cn = (c + 4 < 64) ? c + 4 : 60;
        SSTEP(0, c);     SLOAD(0, cn);
        SSTEP(1, c + 1); SLOAD(1, cn + 1);
        SSTEP(2, c + 2); SLOAD(2, cn + 2);
        SSTEP(3, c + 3); SLOAD(3, cn + 3);
    }
#undef SLOAD
#undef SSTEP
    __syncthreads();
}

__device__ __forceinline__ void rwkvC_unit(ArgsP A, const Frame& F_in, int l, int unit) {
    Frame F = F_in; asm volatile("" : "+v"(F.tid)); F.lane = F.tid & 63;

    const int bh = unit >> 6, c = unit & 63, b = bh / RW_H, h = bh % RW_H, t0 = b * SEQ + c * 64, tid = F.tid, lane = F.lane, w = F.wave;
    const int rt = w >> 1, ct0 = (w & 1) * 2, li = lane & 15, lq = lane >> 4;
    LAS bf16* Sl = (LAS bf16*)F.lds; LAS bf16* Pl = (LAS bf16*)(F.lds + 8704); LAS float* ob = (LAS float*)(F.lds + 17408);
    { const int r = tid >> 3, k8 = (tid & 7) * 8;
        *(LAS v4u*)(Sl + r * RS + k8) = *(const v4u*)((const bf16*)(A->ws + WS_RSC + RWO_SC) + (size_t)unit * 4096 + r * 64 + k8);
        *(LAS v4u*)(Pl + r * RS + k8) = *(const v4u*)((const bf16*)(A->ws + WS_RSC + RWO_POT) + (size_t)unit * 4096 + r * 64 + k8); }
    __syncthreads();
    const float* OlT = (const float*)(A->ws + WS_RSC + RWO_OLT) + (size_t)unit * 4096;
#pragma unroll
    for (int j = 0; j < 2; ++j) { const int tcol = (ct0 + j) * 16 + li, vr = rt * 16 + lq * 4;
        f32x4 acc = *(const f32x4*)(OlT + (size_t)tcol * 64 + vr);
        acc = tile_mm64(Sl, rt * 16, Pl, (ct0 + j) * 16, acc, lane);
        *(LAS f32x4*)(ob + tcol * 68 + vr) = acc; }
    __syncthreads();
    { const int t = tid >> 3, q = tid & 7; const size_t tg = (size_t)t0 + t;
        const f32x4 o0 = *(const LAS f32x4*)(ob + t * 68 + q * 8), o1 = *(const LAS f32x4*)(ob + t * 68 + q * 8 + 4);
        const float mean = red8((o0.x + o0.y) + (o0.z + o0.w) + (o1.x + o1.y) + (o1.z + o1.w)) * (1.f / 64.f);
        const f32x4 d0 = o0 - mean, d1 = o1 - mean;
        const float var = red8((d0.x * d0.x + d0.y * d0.y) + (d0.z * d0.z + d0.w * d0.w) + (d1.x * d1.x + d1.y * d1.y) + (d1.z * d1.z + d1.w * d1.w)) * (1.f / 64.f);
        const float rs = rsqrtf(var + 64e-5f);
        const int cc = h * 64 + q * 8;
        const f32x4 g0 = *(const f32x4*)(A->in[20] + (size_t)l * RW_W + cc), g1 = *(const f32x4*)(A->in[20] + (size_t)l * RW_W + cc + 4);
        const f32x4 b0 = *(const f32x4*)(A->in[21] + (size_t)l * RW_W + cc), b1 = *(const f32x4*)(A->in[21] + (size_t)l * RW_W + cc + 4);
        const f32x4 bv0 = *(const f32x4*)((const float*)(A->ws + WS_RBV) + tg * RW_W + cc), bv1 = *(const f32x4*)((const float*)(A->ws + WS_RBV) + tg * RW_W + cc + 4);
        const f32x4 ga0 = *(const f32x4*)((const float*)(A->ws + WS_RGATE) + tg * RW_W + cc), ga1 = *(const f32x4*)((const float*)(A->ws + WS_RGATE) + tg * RW_W + cc + 4);
        const f32x4 y0 = (d0 * rs * g0 + b0 + bv0) * ga0, y1 = (d1 * rs * g1 + b1 + bv1) * ga1;
        v4u o; o.x = pk2(y0.x, y0.y); o.y = pk2(y0.z, y0.w); o.z = pk2(y1.x, y1.y); o.w = pk2(y1.z, y1.w);
        *(v4u*)((bf16*)(A->ws + WS_Y) + tg * DM + 1280 + cc) = o; }
    __syncthreads();
}

constexpr size_t RWO_GQ = 84 * MiB, RWO_GK = 92 * MiB, RWO_GVT = 100 * MiB, RWO_GEM = 116 * MiB;
constexpr int GQS = 104, GTS = 72;
template <int NKS> __device__ __forceinline__ f32x4 tile_mm(const LAS bf16* Am, int sa, int arow0, const LAS bf16* Bm, int sb, int brow0, f32x4 acc, int lane) {
    const int r = lane & 15, kq = (lane >> 4) * 8;
#pragma unroll
    for (int ks = 0; ks < NKS; ++ks) {
        const bf16x8_t a = *(const LAS bf16x8_t*)(Am + (arow0 + r) * sa + ks * 32 + kq);
        const bf16x8_t b = *(const LAS bf16x8_t*)(Bm + (brow0 + r) * sb + ks * 32 + kq);
        acc = __builtin_amdgcn_mfma_f32_16x16x32_bf16(a, b, acc, 0, 0, 0);
    }
    return acc;
}

__device__ __forceinline__ int gsw(int row) { return ((row >> 2) ^ (row >> 5)) & 7; }
__device__ __forceinline__ f32x4 tile_mm_sw(const LAS bf16* Am, int arow0, const LAS bf16* Bm, int brow0, f32x4 acc, int lane) {
    const int r = lane & 15, cq = lane >> 4, fa = gsw(arow0 + r), fb = gsw(brow0 + r);
#pragma unroll
    for (int ks = 0; ks < 2; ++ks) {
        const bf16x8_t a = *(const LAS bf16x8_t*)(Am + (arow0 + r) * GTS + (((ks * 4 + cq) ^ fa) << 3));
        const bf16x8_t b = *(const LAS bf16x8_t*)(Bm + (brow0 + r) * GTS + (((ks * 4 + cq) ^ fb) << 3));
        acc = __builtin_amdgcn_mfma_f32_16x16x32_bf16(a, b, acc, 0, 0, 0);
    }
    return acc;
}
__device__ __forceinline__ void gla1_unit(ArgsP A, const Frame& F_in, int l, int unit) {
    Frame F = F_in; asm volatile("" : "+v"(F.tid)); F.lane = F.tid & 63;
    const int bh = unit >> 6, c = unit & 63, b = bh >> 2, h = bh & 3, t0 = b * SEQ + c * 64, tid = F.tid, lane = F.lane, w = F.wave;
    const float* proj = (const float*)(A->ws + WS_PROJ);
    LAS float* bcum = (LAS float*)F.lds;
    LAS float* ad = bcum + 6144;
    LAS float* up = ad + 1024;
    LAS bf16* KtT = (LAS bf16*)(F.lds + 34816);
    LAS bf16* VT = (LAS bf16*)(F.lds + 48640);
    f32x4 qq[3], kq[3], vq[6];
#pragma unroll
    for (int it = 0; it < 3; ++it) { const int i = tid + it * NTHR, tok = i / 24, d4 = i % 24; const float* rp = proj + (size_t)(t0 + tok) * INWP + h * 96 + d4 * 4;
        qq[it] = *(const f32x4*)(rp + C_GQ); kq[it] = *(const f32x4*)(rp + C_GK); }
#pragma unroll
    for (int it = 0; it < 6; ++it) { const int i = tid + it * NTHR, tok = i / 48, e4 = i % 48; vq[it] = *(const f32x4*)(proj + (size_t)(t0 + tok) * INWP + C_GV + h * 192 + e4 * 4); }
    gla_bcum(A, F, l, h, t0, bcum, ad, up);
    const float qs = 0.10206207261596575f;
    bf16* Qg = (bf16*)(A->ws + WS_RSC + RWO_GQ) + (size_t)unit * 6144; bf16* Kg = (bf16*)(A->ws + WS_RSC + RWO_GK) + (size_t)unit * 6144;
#pragma unroll
    for (int it = 0; it < 3; ++it) { const int i = tid + it * NTHR, tok = i / 24, d = (i % 24) * 4;
        const float qv[4] = {qq[it].x, qq[it].y, qq[it].z, qq[it].w}, kv[4] = {kq[it].x, kq[it].y, kq[it].z, kq[it].w}; float qo[4], ko[4];
#pragma unroll
        for (int e = 0; e < 4; ++e) { const float m = bcum[31 * 96 + d + e], bb = bcum[tok * 96 + d + e];
            qo[e] = qv[e] * qs * __expf(bb - m); ko[e] = kv[e] * __expf(m - bb); KtT[(d + e) * GTS + ((((tok >> 3) ^ gsw(d + e)) << 3) | (tok & 7))] = (bf16)f2bf(ko[e]); }
        v2u pq, pk; pq.x = pk2(qo[0], qo[1]); pq.y = pk2(qo[2], qo[3]); pk.x = pk2(ko[0], ko[1]); pk.y = pk2(ko[2], ko[3]);
        *(v2u*)(Qg + tok * 96 + d) = pq; *(v2u*)(Kg + tok * 96 + d) = pk; }
#pragma unroll
    for (int it = 0; it < 6; ++it) { const int i = tid + it * NTHR, tok = i / 48, e = (i % 48) * 4;
        const int ts = tok >> 3, tl = tok & 7;
        VT[(e + 0) * GTS + (((ts ^ gsw(e + 0)) << 3) | tl)] = (bf16)f2bf(vq[it].x); VT[(e + 1) * GTS + (((ts ^ gsw(e + 1)) << 3) | tl)] = (bf16)f2bf(vq[it].y);
        VT[(e + 2) * GTS + (((ts ^ gsw(e + 2)) << 3) | tl)] = (bf16)f2bf(vq[it].z); VT[(e + 3) * GTS + (((ts ^ gsw(e + 3)) << 3) | tl)] = (bf16)f2bf(vq[it].w); }
    if (tid < 96) { ((float*)(A->ws + WS_RSC + RWO_GEM))[(size_t)unit * 96 + tid] = __expf(bcum[31 * 96 + tid]);
        ((float*)(A->ws + WS_GDEC))[(size_t)unit * 96 + tid] = __expf(bcum[63 * 96 + tid]); }
    __syncthreads();
    { bf16* VTg = (bf16*)(A->ws + WS_RSC + RWO_GVT) + (size_t)unit * 12288;
#pragma unroll
        for (int it = 0; it < 3; ++it) { const int i = tid + it * NTHR, e = i >> 3, t8 = (i & 7) * 8; *(v4u*)(VTg + e * 64 + t8) = *(const LAS v4u*)(VT + e * GTS + ((((i & 7) ^ gsw(e))) << 3)); } }
    { const int li = lane & 15, lq = lane >> 4;
        float* KVg = (float*)(A->ws + WS_GKV) + (size_t)unit * 18432;
#pragma unroll
        for (int a = 0; a < 3; ++a) { const int dt = (w & 1) * 3 + a, d0 = dt * 16 + lq * 4;
            const float s0 = __expf(bcum[63 * 96 + d0] - bcum[31 * 96 + d0]), s1 = __expf(bcum[63 * 96 + d0 + 1] - bcum[31 * 96 + d0 + 1]),
                        s2 = __expf(bcum[63 * 96 + d0 + 2] - bcum[31 * 96 + d0 + 2]), s3 = __expf(bcum[63 * 96 + d0 + 3] - bcum[31 * 96 + d0 + 3]);
#pragma unroll
            for (int bb = 0; bb < 3; ++bb) { const int et = (w >> 1) * 3 + bb; const f32x4 z = {0.f, 0.f, 0.f, 0.f};
                f32x4 acc = tile_mm_sw(KtT, dt * 16, VT, et * 16, z, lane);
                acc.x *= s0; acc.y *= s1; acc.z *= s2; acc.w *= s3;
                *(f32x4*)(KVg + (size_t)(et * 16 + li) * 96 + d0) = acc; } } }
    __syncthreads();
}

__device__ __forceinline__ void gla3_unit(ArgsP A, const Frame& F_in, int l, int unit) {
    Frame F = F_in; asm volatile("" : "+v"(F.tid)); F.lane = F.tid & 63;
    const int bh = unit >> 6, c = unit & 63, b = bh >> 2, h = bh & 3, t0 = b * SEQ + c * 64, tid = F.tid, lane = F.lane, w = F.wave;
    const int li = lane & 15, lq = lane >> 4;
    const float* proj = (const float*)(A->ws + WS_PROJ);
    LAS bf16* Qs = (LAS bf16*)F.lds;
    LAS bf16* Ks = (LAS bf16*)(F.lds + 13312);
    LAS bf16* VT = (LAS bf16*)(F.lds + 26624);
    LAS bf16* ST = (LAS bf16*)(F.lds + 54272);
    LAS bf16* att = (LAS bf16*)(F.lds + 94208);
    LAS float* ssq = (LAS float*)(F.lds + 103424);
    LAS float* em = (LAS float*)(F.lds + 103936);
    LAS float* ob = (LAS float*)(F.lds + 26624);
    {
        const v4u* Qg = (const v4u*)((const bf16*)(A->ws + WS_RSC + RWO_GQ) + (size_t)unit * 6144); const v4u* Kg = (const v4u*)((const bf16*)(A->ws + WS_RSC + RWO_GK) + (size_t)unit * 6144);
        const v4u* VTg = (const v4u*)((const bf16*)(A->ws + WS_RSC + RWO_GVT) + (size_t)unit * 12288);
        const f32x4* GS = (const f32x4*)((const float*)(A->ws + WS_GS) + (size_t)unit * 18432);
        v4u q0 = Qg[tid], k0 = Kg[tid], q1 = {0u, 0u, 0u, 0u}, k1 = {0u, 0u, 0u, 0u};
        if (tid < 256) { q1 = Qg[512 + tid]; k1 = Kg[512 + tid]; }
        v4u vt[3]; f32x4 sg[9];
#pragma unroll
        for (int it = 0; it < 3; ++it) vt[it] = VTg[tid + it * NTHR];
#pragma unroll
        for (int it = 0; it < 9; ++it) sg[it] = GS[tid + it * NTHR];
        if (tid < 96) em[tid] = ((const float*)(A->ws + WS_RSC + RWO_GEM))[(size_t)unit * 96 + tid];
        { const int i = tid, t = i / 12, c8 = (i % 12) * 8; *(LAS v4u*)(Qs + t * GQS + c8) = q0; *(LAS v4u*)(Ks + t * GQS + c8) = k0; }
        if (tid < 256) { const int i = 512 + tid, t = i / 12, c8 = (i % 12) * 8; *(LAS v4u*)(Qs + t * GQS + c8) = q1; *(LAS v4u*)(Ks + t * GQS + c8) = k1; }
#pragma unroll
        for (int it = 0; it < 3; ++it) { const int i = tid + it * NTHR, e = i >> 3, t8 = (i & 7) * 8; *(LAS v4u*)(VT + e * GTS + t8) = vt[it]; }
        __syncthreads();
#pragma unroll
        for (int it = 0; it < 9; ++it) { const int i = tid + it * NTHR, e = i / 24, d = (i % 24) * 4; const f32x4 m4 = *(const LAS f32x4*)(em + d);
            v2u pk; pk.x = pk2(sg[it].x * m4.x, sg[it].y * m4.y); pk.y = pk2(sg[it].z * m4.z, sg[it].w * m4.w); *(LAS v2u*)(ST + e * GQS + d) = pk; }
    }
    __syncthreads();
#pragma unroll
    for (int a = 0; a < 2; ++a) { const int jt = w >> 1, it = (w & 1) * 2 + a; const f32x4 z = {0.f, 0.f, 0.f, 0.f};
        f32x4 acc = z;
        if (jt <= it) acc = tile_mm<3>(Ks, GQS, jt * 16, Qs, GQS, it * 16, z, lane);
        const int i = it * 16 + li, j0 = jt * 16 + lq * 4;
        acc.x = (j0 + 0 <= i) ? acc.x : 0.f; acc.y = (j0 + 1 <= i) ? acc.y : 0.f; acc.z = (j0 + 2 <= i) ? acc.z : 0.f; acc.w = (j0 + 3 <= i) ? acc.w : 0.f;
        v2u pk; pk.x = pk2(acc.x, acc.y); pk.y = pk2(acc.z, acc.w); *(LAS v2u*)(att + i * GTS + j0) = pk; }
    __syncthreads();
    f32x4 o[6];
    { const int it = w >> 1;
#pragma unroll
        for (int a = 0; a < 6; ++a) { const int et = (w & 1) * 6 + a; const f32x4 z = {0.f, 0.f, 0.f, 0.f};
            f32x4 acc = tile_mm<2>(att, GTS, it * 16, VT, GTS, et * 16, z, lane);
            o[a] = tile_mm<3>(Qs, GQS, it * 16, ST, GQS, et * 16, acc, lane); }
        float s0 = 0.f, s1 = 0.f, s2 = 0.f, s3 = 0.f;
#pragma unroll
        for (int a = 0; a < 6; ++a) { s0 += o[a].x * o[a].x; s1 += o[a].y * o[a].y; s2 += o[a].z * o[a].z; s3 += o[a].w * o[a].w; }
        s0 = row16_sum(s0); s1 = row16_sum(s1); s2 = row16_sum(s2); s3 = row16_sum(s3);
        if (li == 0) { const int r0 = it * 16 + lq * 4; ssq[(r0 + 0) * 2 + (w & 1)] = s0; ssq[(r0 + 1) * 2 + (w & 1)] = s1; ssq[(r0 + 2) * 2 + (w & 1)] = s2; ssq[(r0 + 3) * 2 + (w & 1)] = s3; }
    }
    __syncthreads();
    { const int it = w >> 1, r0 = it * 16 + lq * 4;
#pragma unroll
        for (int a = 0; a < 6; ++a) { const int e = ((w & 1) * 6 + a) * 16 + li;
            ob[(r0 + 0) * 196 + e] = o[a].x; ob[(r0 + 1) * 196 + e] = o[a].y; ob[(r0 + 2) * 196 + e] = o[a].z; ob[(r0 + 3) * 196 + e] = o[a].w; } }
    __syncthreads();
    { bf16* Y = (bf16*)(A->ws + WS_Y);
        f32x4 gv[6];
#pragma unroll
        for (int k = 0; k < 6; ++k) { const int i = tid + k * NTHR, t = i / 48, e = (i % 48) * 4; gv[k] = *(const f32x4*)(proj + (size_t)(t0 + t) * INWP + C_GG + h * 192 + e); }
#pragma unroll
        for (int k = 0; k < 6; ++k) { const int i = tid + k * NTHR, t = i / 48, e = (i % 48) * 4;
            const float rstd = rsqrtf((ssq[t * 2] + ssq[t * 2 + 1]) * (1.f / 192.f) + NORM_EPS);
            const f32x4 ov = *(const LAS f32x4*)(ob + t * 196 + e); const f32x4 ng = *(const f32x4*)(A->in[10] + (size_t)l * 768 + h * 192 + e);
            f32x4 y; y.x = ov.x * rstd * ng.x * gv[k].x * sigmoidf_(gv[k].x); y.y = ov.y * rstd * ng.y * gv[k].y * sigmoidf_(gv[k].y);
            y.z = ov.z * rstd * ng.z * gv[k].z * sigmoidf_(gv[k].z); y.w = ov.w * rstd * ng.w * gv[k].w * sigmoidf_(gv[k].w);
            v2u pk; pk.x = pk2(y.x, y.y); pk.y = pk2(y.z, y.w); *(v2u*)(Y + (size_t)(t0 + t) * DM + 512 + h * 192 + e) = pk; } }
    __syncthreads();
}

#define INS16(L, P, x, px) do { { const bool c_ = (x) > L[15]; L[15] = c_ ? (x) : L[15]; P[15] = c_ ? (px) : P[15]; } \
    _Pragma("unroll") for (int r_ = 14; r_ >= 0; --r_) { const bool c_ = L[r_ + 1] > L[r_]; const float tl_ = L[r_]; const int tp_ = P[r_]; \
        L[r_] = c_ ? L[r_ + 1] : tl_; L[r_ + 1] = c_ ? tl_ : L[r_ + 1]; P[r_] = c_ ? P[r_ + 1] : tp_; P[r_ + 1] = c_ ? tp_ : P[r_ + 1]; } } while (0)

__device__ __forceinline__ float gelu_as(float v) {
    const float av = fabsf(v), t = __builtin_amdgcn_rcpf(av * 0.2316418882f + 1.0f);
    float q = t * 0.5307027145f + (-0.7265760135f); q = q * t + 0.7107068705f; q = q * t + (-0.142248368f); q = q * t + 0.127414796f; q = q * t;
    const float e = __builtin_amdgcn_exp2f((v * v) * (-0.72134752044f));
    const float m = v * (q * e);
    return v < 0.f ? m : v - m;
}
__device__ __forceinline__ int row16_sum_i(int v) {
    v += __builtin_amdgcn_update_dpp(0, v, 0xB1, 0xF, 0xF, true); v += __builtin_amdgcn_update_dpp(0, v, 0x4E, 0xF, 0xF, true);
    v += __builtin_amdgcn_update_dpp(0, v, 0x141, 0xF, 0xF, true); v += __builtin_amdgcn_update_dpp(0, v, 0x140, 0xF, 0xF, true); return v;
}
__device__ __forceinline__ void ph_peer2(ArgsP A, LAS unsigned char* lds_, int wv_, int l, const float* g2, const float* sh2, const float* ngain, const float* nsh, const float* nsc, const bool last, const bool dry = false) {
    const Frame F = make_frame(lds_, wv_);
    const int lane = F.lane;
    const float* SCO = (const float*)(A->ws + WS_PROJ);
    const unsigned char* U8 = A->ws + WS_U + (size_t)l * PEER_N * DM; const unsigned char* V8 = A->ws + WS_V + (size_t)l * PEER_N * DM;
    const float* US = (const float*)(A->ws + WS_US) + (size_t)l * PEER_N; const float* VS = (const float*)(A->ws + WS_VS) + (size_t)l * PEER_N;
    float* X = (float*)(A->ws + WS_X); bf16* H = (bf16*)(A->ws + WS_H); const float* ssr = (const float*)(A->ws + WS_SSP) + (size_t)l * NT * 32;
    LAS int* es = (LAS int*)F.lds + F.wave * 2048; LAS float* gs = (LAS float*)F.lds + F.wave * 2048 + 1024;
    LAS v4u* hl = (LAS v4u*)(F.lds + 65536 + F.wave * 3072);
    LAS float* dl = (LAS float*)(F.lds + 65536 + F.wave * 3072 + 2048); LAS float* cfl = dl + 128;
    for (int tb = F.gw * 4; tb < NT; tb += F.ngw * 4) {
        {
            int P2[16]; float gt[16];
            const int prob = tb * 16 + lane, half = lane & 1;
            const f32x4* s4 = (const f32x4*)(SCO + (size_t)prob * 128);
            float L[16]; int P[16];
#pragma unroll
            for (int r = 0; r < 16; ++r) { L[r] = -3.0e38f; P[r] = 0; }
            f32x4 nv[4];
#pragma unroll
            for (int i = 0; i < 4; ++i) nv[i] = s4[i];
#pragma unroll 1
            for (int q = 0; q < 8; ++q) {
                f32x4 v[4];
#pragma unroll
                for (int i = 0; i < 4; ++i) v[i] = nv[i];
                if (q < 7) {
#pragma unroll
                    for (int i = 0; i < 4; ++i) nv[i] = s4[4 * (q + 1) + i]; }
                _Pragma("unroll") for (int r = 0; r < 16; ++r) asm volatile("" : "+v"(L[r]), "+v"(P[r]));
#pragma unroll
                for (int i = 0; i < 4; ++i) { const int ib = 16 * q + 4 * i;
                    INS16(L, P, v[i].x, ib); INS16(L, P, v[i].y, ib + 1); INS16(L, P, v[i].z, ib + 2); INS16(L, P, v[i].w, ib + 3); }
            }
            float v1[16], v2[16]; int i1[16], i2[16];
#pragma unroll
            for (int r = 0; r < 16; ++r) { const float ol = dpp_xor1(L[r]); const int op = __builtin_amdgcn_update_dpp(0, P[r], 0xB1, 0xF, 0xF, true);
                v1[r] = half ? ol : L[r]; v2[r] = half ? L[r] : ol; i1[r] = half ? op : P[r]; i2[r] = half ? P[r] : op; }
            float L2[16];
#pragma unroll
            for (int r = 0; r < 16; ++r) { L2[r] = -3.0e38f; P2[r] = 0; }
#pragma unroll
            for (int a = 0; a < 16; ++a)
#pragma unroll
                for (int bq = 0; bq < 16; ++bq) if ((a + 1) * (bq + 1) <= 16) { const float cv = v1[a] + v2[bq]; const int ce = i1[a] * 128 + i2[bq]; INS16(L2, P2, cv, ce); }
            float sum = 0.f;
#pragma unroll
            for (int r = 0; r < 16; ++r) { gt[r] = __expf(L2[r] - L2[0]); sum += gt[r]; }
            const float inv = 1.f / sum;
#pragma unroll
            for (int r = 0; r < 16; ++r) { es[r * 64 + lane] = P2[r]; gs[r * 64 + lane] = gt[r] * inv; }
            asm volatile("s_waitcnt lgkmcnt(0)" ::: "memory");
        }
#pragma unroll 1
        for (int k = 0; k < 4; ++k) {
            const int t = tb + k, b = t >> 12;
            float hs;
            {
                float hf[32]; float mx = 0.f;
                const v4u* hp = (const v4u*)(H + (size_t)t * DM);
#pragma unroll
                for (int jj = 0; jj < 2; ++jj)
#pragma unroll
                    for (int c = 0; c < 2; ++c) { const v4u hv = hp[(jj * 64 + lane) * 2 + c]; const int o = jj * 16 + c * 8;
                        hf[o + 0] = bflo(hv.x); hf[o + 1] = bfhi(hv.x); hf[o + 2] = bflo(hv.y); hf[o + 3] = bfhi(hv.y); hf[o + 4] = bflo(hv.z); hf[o + 5] = bfhi(hv.z); hf[o + 6] = bflo(hv.w); hf[o + 7] = bfhi(hv.w); }
                { const float rstd = rsqrtf(wave_sum(lane < 32 ? ssr[(size_t)t * 32 + lane] : 0.f) * (1.f / DM) + NORM_EPS);
#pragma unroll
                    for (int jj = 0; jj < 2; ++jj)
#pragma unroll
                        for (int q = 0; q < 4; ++q) { const f32x4 s4 = *(const f32x4*)(sh2 + (size_t)b * MODW + (jj * 64 + lane) * 16 + 4 * q);
                            hf[jj * 16 + 4 * q] = hf[jj * 16 + 4 * q] * rstd + s4.x; hf[jj * 16 + 4 * q + 1] = hf[jj * 16 + 4 * q + 1] * rstd + s4.y;
                            hf[jj * 16 + 4 * q + 2] = hf[jj * 16 + 4 * q + 2] * rstd + s4.z; hf[jj * 16 + 4 * q + 3] = hf[jj * 16 + 4 * q + 3] * rstd + s4.w; } }
#pragma unroll
                for (int i = 0; i < 32; ++i) mx = fmaxf(mx, fabsf(hf[i]));
                mx = wave_max(mx);
                const float inv = mx > 0.f ? 127.f / mx : 0.f; hs = mx * (1.f / 127.f);
#pragma unroll
                for (int jj = 0; jj < 2; ++jj) { v4u q;
                    unsigned qd[4];
#pragma unroll
                    for (int d = 0; d < 4; ++d) { const int o = jj * 16 + 4 * d; const int q0 = (int)rintf(hf[o] * inv), q1 = (int)rintf(hf[o + 1] * inv), q2 = (int)rintf(hf[o + 2] * inv), q3 = (int)rintf(hf[o + 3] * inv);
                        qd[d] = (unsigned)(q0 & 255) | ((unsigned)(q1 & 255) << 8) | ((unsigned)(q2 & 255) << 16) | ((unsigned)(q3 & 255) << 24); }
                    q.x = qd[0]; q.y = qd[1]; q.z = qd[2]; q.w = qd[3]; hl[jj * 64 + lane] = q; }
                asm volatile("s_waitcnt lgkmcnt(0)" ::: "memory");
            }
            const int li = lane & 15, lq = lane >> 4;
            {
                v4i ub0[8], ub1[8];
#define ULOAD(buf, hh_, sg_) do { const int my_e_ = es[li * 64 + k * 16 + 2 * (hh_)]; const unsigned char* ub_ = U8 + (size_t)my_e_ * DM + lq * 16 + (sg_) * 512; \
    _Pragma("unroll") for (int s8 = 0; s8 < 8; ++s8) buf[s8] = *(const v4i*)(ub_ + s8 * 64); } while (0)
#define UCONS(buf, sg_) do { _Pragma("unroll") for (int s8 = 0; s8 < 8; ++s8) { const v4i hb_ = *(const LAS v4i*)(hl + ((sg_) * 8 + s8) * 4 + lq); acc = __builtin_amdgcn_mfma_i32_16x16x64_i8(buf[s8], hb_, acc, 0, 0, 0); } } while (0)
                ULOAD(ub0, 0, 0); ULOAD(ub1, 0, 1);
#pragma unroll 1
                for (int hh = 0; hh < 8; ++hh) {
                    v4i acc = {0, 0, 0, 0};
                    UCONS(ub0, 0); ULOAD(ub0, hh, 2);
                    UCONS(ub1, 1); ULOAD(ub1, hh, 3);
                    UCONS(ub0, 2); if (hh < 7) ULOAD(ub0, hh + 1, 0);
                    UCONS(ub1, 3); if (hh < 7) ULOAD(ub1, hh + 1, 1);
                    if (li == 0) { f32x4 d; d.x = (float)acc.x; d.y = (float)acc.y; d.z = (float)acc.z; d.w = (float)acc.w; *(LAS f32x4*)(dl + hh * 16 + 4 * lq) = d; }
                }
#undef ULOAD
#undef UCONS
            }
#pragma unroll
            for (int c = 0; c < 2; ++c) { const int x = lane + 64 * c, hh = x >> 4, r = x & 15; const int e = es[r * 64 + k * 16 + 2 * hh]; const float g = gs[r * 64 + k * 16 + 2 * hh];
                cfl[x] = g * VS[e] * gelu_as(dl[x] * (US[e] * hs)); }
            float out[32];
#pragma unroll
            for (int i = 0; i < 32; ++i) out[i] = 0.f;
            {
                v4u vb0[4][2], vb1[4][2], vb2[4][2]; float c0[4], c1[4], c2[4];
#define VLOAD(buf, cfb, bi_) do { const int bq_ = (bi_) < 32 ? (bi_) : 31; _Pragma("unroll") for (int i = 0; i < 4; ++i) { const int x_ = bq_ * 4 + i; const int e_ = __builtin_amdgcn_readfirstlane(es[(x_ & 15) * 64 + k * 16 + 2 * (x_ >> 4)]); \
        const float cv_ = __builtin_bit_cast(float, __builtin_amdgcn_readfirstlane(__builtin_bit_cast(int, cfl[x_]))); cfb[i] = (bi_) < 32 ? cv_ : 0.f; const v4u* vp_ = (const v4u*)(V8 + (size_t)e_ * DM) + lane; buf[i][0] = vp_[0]; buf[i][1] = vp_[64]; } } while (0)
#define VCONS(buf, cfb) do { _Pragma("unroll") for (int i = 0; i < 4; ++i) { const f32x2 c2_ = {cfb[i], cfb[i]}; \
        _Pragma("unroll") for (int jj = 0; jj < 2; ++jj) { const unsigned wd_[4] = {buf[i][jj].x, buf[i][jj].y, buf[i][jj].z, buf[i][jj].w}; \
            _Pragma("unroll") for (int d = 0; d < 4; ++d) { const int o_ = jj * 16 + 4 * d; \
                const f32x2 f0_ = __builtin_amdgcn_cvt_pk_f32_fp8((int)wd_[d], false), f1_ = __builtin_amdgcn_cvt_pk_f32_fp8((int)wd_[d], true); \
                f32x2 a0_ = {out[o_], out[o_ + 1]}, a1_ = {out[o_ + 2], out[o_ + 3]}; \
                a0_ = __builtin_elementwise_fma(c2_, f0_, a0_); a1_ = __builtin_elementwise_fma(c2_, f1_, a1_); \
                out[o_] = a0_.x; out[o_ + 1] = a0_.y; out[o_ + 2] = a1_.x; out[o_ + 3] = a1_.y; } } } } while (0)
                VLOAD(vb0, c0, 0); VLOAD(vb1, c1, 1); VLOAD(vb2, c2, 2);
#pragma unroll 1
                for (int bi = 0; bi < 33; bi += 3) {
                    VCONS(vb0, c0); VLOAD(vb0, c0, bi + 3);
                    VCONS(vb1, c1); VLOAD(vb1, c1, bi + 4);
                    VCONS(vb2, c2); VLOAD(vb2, c2, bi + 5);
                }
#undef VLOAD
#undef VCONS
            }
            f32x4 xn[2][4]; float ss = 0.f;
            const f32x4* xr = (const f32x4*)(X + (size_t)t * DM); const f32x4* gr = (const f32x4*)(g2 + (size_t)b * MODW);
#pragma unroll
            for (int jj = 0; jj < 2; ++jj)
#pragma unroll
                for (int q = 0; q < 4; ++q) { const int ix = (jj * 64 + lane) * 4 + q; const f32x4 xv = xr[ix], gv = gr[ix]; f32x4 o4; o4.x = out[jj * 16 + 4 * q]; o4.y = out[jj * 16 + 4 * q + 1]; o4.z = out[jj * 16 + 4 * q + 2]; o4.w = out[jj * 16 + 4 * q + 3];
                    const f32x4 y = xv + gv * o4; xn[jj][q] = y; ss += (y.x * y.x + y.y * y.y) + (y.z * y.z + y.w * y.w); }
            const float rstd = rsqrtf(wave_sum(ss) * (1.f / DM) + NORM_EPS);
            if (!last) {
                f32x4* xw = (f32x4*)((dry ? (float*)(A->ws + WS_DUMMY) : X) + (size_t)t * DM); v4u* hw = (v4u*)((dry ? (bf16*)(A->ws + WS_DUMMY + 64 * MiB) : H) + (size_t)t * DM);
#pragma unroll
                for (int jj = 0; jj < 2; ++jj) { f32x4 y[4];
#pragma unroll
                    for (int q = 0; q < 4; ++q) { const int ix = (jj * 64 + lane) * 4 + q; xw[ix] = xn[jj][q];
                        const f32x4 g = ((const f32x4*)ngain)[ix], s1 = ((const f32x4*)(nsc + (size_t)b * MODW))[ix], s0 = ((const f32x4*)(nsh + (size_t)b * MODW))[ix];
                        y[q] = xn[jj][q] * rstd * g * (s1 + 1.f) + s0; }
                    v4u o; o.x = pk2(y[0].x, y[0].y); o.y = pk2(y[0].z, y[0].w); o.z = pk2(y[1].x, y[1].y); o.w = pk2(y[1].z, y[1].w); hw[(jj * 64 + lane) * 2] = o;
                    o.x = pk2(y[2].x, y[2].y); o.y = pk2(y[2].z, y[2].w); o.z = pk2(y[3].x, y[3].y); o.w = pk2(y[3].z, y[3].w); hw[(jj * 64 + lane) * 2 + 1] = o; }
            } else {
                f32x4* ow = (f32x4*)((dry ? (float*)(A->ws + WS_DUMMY) : A->out) + (size_t)t * DM);
#pragma unroll
                for (int jj = 0; jj < 2; ++jj)
#pragma unroll
                    for (int q = 0; q < 4; ++q) { const int ix = (jj * 64 + lane) * 4 + q; ow[ix] = xn[jj][q] * rstd * ((const f32x4*)ngain)[ix]; }
            }
        }
    }
}

#ifndef PEER_SL_SHIFT
#define PEER_SL_SHIFT 10
#endif
__device__ __forceinline__ void ph_peer4(ArgsP A, LAS unsigned char* lds_, int wv_, int l, const float* g2, const float* sh2, const float* ngain, const float* nsh, const float* nsc, const bool last, const bool dry = false) {
    const Frame F = make_frame(lds_, wv_);
    const int lane = F.lane, li = lane & 15, lq = lane >> 4;
    const float* SCO = (const float*)(A->ws + WS_PROJ);
    const unsigned char* U8 = A->ws + WS_U + (size_t)l * PEER_N * DM; const unsigned char* V8 = A->ws + WS_V + (size_t)l * PEER_N * DM;
    const float* US = (const float*)(A->ws + WS_US) + (size_t)l * PEER_N; const float* VS = (const float*)(A->ws + WS_VS) + (size_t)l * PEER_N;
    float* X = (float*)(A->ws + WS_X); bf16* H = (bf16*)(A->ws + WS_H); const float* ssr = (const float*)(A->ws + WS_SSP) + (size_t)l * NT * 32;
    LAS unsigned char* wl = F.lds + F.wave * 15104;
    LAS int* es = (LAS int*)wl; LAS float* gs = (LAS float*)(wl + 4096);
    LAS v4u* hl = (LAS v4u*)wl;
    LAS int* se = (LAS int*)(wl + 8448);
    LAS float* sg = (LAS float*)(wl + 10496);
    LAS int* st = (LAS int*)(wl + 12544);
    LAS float* dl = (LAS float*)(wl + 14592);
    LAS float* hsl = dl + 64;
    for (int tb = F.gw * 4; tb < NT; tb += F.ngw * 4) {
        {
            int P2[16]; float gt[16];
            const int prob = tb * 16 + lane, half = lane & 1;
            const f32x4* s4 = (const f32x4*)(SCO + (size_t)prob * 128);
            float L[16]; int P[16];
#pragma unroll
            for (int r = 0; r < 16; ++r) { L[r] = -3.0e38f; P[r] = 0; }
            f32x4 nv[4];
#pragma unroll
            for (int i = 0; i < 4; ++i) nv[i] = s4[i];
#pragma unroll 1
            for (int q = 0; q < 8; ++q) {
                f32x4 v[4];
#pragma unroll
                for (int i = 0; i < 4; ++i) v[i] = nv[i];
                if (q < 7) {
#pragma unroll
                    for (int i = 0; i < 4; ++i) nv[i] = s4[4 * (q + 1) + i]; }
                _Pragma("unroll") for (int r = 0; r < 16; ++r) asm volatile("" : "+v"(L[r]), "+v"(P[r]));
#pragma unroll
                for (int i = 0; i < 4; ++i) { const int ib = 16 * q + 4 * i;
                    INS16(L, P, v[i].x, ib); INS16(L, P, v[i].y, ib + 1); INS16(L, P, v[i].z, ib + 2); INS16(L, P, v[i].w, ib + 3); }
            }
            float v1[16], v2[16]; int i1[16], i2[16];
#pragma unroll
            for (int r = 0; r < 16; ++r) { const float ol = dpp_xor1(L[r]); const int op = __builtin_amdgcn_update_dpp(0, P[r], 0xB1, 0xF, 0xF, true);
                v1[r] = half ? ol : L[r]; v2[r] = half ? L[r] : ol; i1[r] = half ? op : P[r]; i2[r] = half ? P[r] : op; }
            float L2[16];
#pragma unroll
            for (int r = 0; r < 16; ++r) { L2[r] = -3.0e38f; P2[r] = 0; }
#pragma unroll
            for (int a = 0; a < 16; ++a)
#pragma unroll
                for (int bq = 0; bq < 16; ++bq) if ((a + 1) * (bq + 1) <= 16) { const float cv = v1[a] + v2[bq]; const int ce = i1[a] * 128 + i2[bq]; INS16(L2, P2, cv, ce); }
            float sum = 0.f;
#pragma unroll
            for (int r = 0; r < 16; ++r) { gt[r] = __expf(L2[r] - L2[0]); sum += gt[r]; }
            const float inv = 1.f / sum;
#pragma unroll
            for (int r = 0; r < 16; ++r) { es[r * 64 + lane] = P2[r]; gs[r * 64 + lane] = gt[r] * inv; }
            asm volatile("s_waitcnt lgkmcnt(0)" ::: "memory");
        }
        {
            int ee[8]; float gg[8];
#pragma unroll
            for (int j = 0; j < 8; ++j) { const int x = j * 64 + lane, k = x >> 7, y = x & 127; ee[j] = es[(y & 15) * 64 + k * 16 + 2 * (y >> 4)]; gg[j] = gs[(y & 15) * 64 + k * 16 + 2 * (y >> 4)]; }
            int base = 0;
#pragma unroll
            for (int p = 0; p < 2; ++p) {
#pragma unroll 1
                for (int s = 0; s < (16384 >> PEER_SL_SHIFT); ++s) {
#pragma unroll
                    for (int jj = 0; jj < 4; ++jj) { const int j = p * 4 + jj; const bool in = (ee[j] >> PEER_SL_SHIFT) == s; const unsigned long long m = __builtin_amdgcn_ballot_w64(in);
                        if (in) { const int pos = base + (int)__builtin_amdgcn_mbcnt_hi((unsigned)(m >> 32), __builtin_amdgcn_mbcnt_lo((unsigned)m, 0u)); se[pos] = ee[j]; sg[pos] = gg[j]; st[pos] = j >> 1; }
                        base += __builtin_popcountll(m); }
                }
            }
        }
        asm volatile("s_waitcnt lgkmcnt(0)" ::: "memory");
#pragma unroll 1
        for (int k = 0; k < 4; ++k) {
            const int t = tb + k, b = t >> 12;
            float hf[32]; float mx = 0.f;
            const v4u* hp = (const v4u*)(H + (size_t)t * DM);
#pragma unroll
            for (int jj = 0; jj < 2; ++jj)
#pragma unroll
                for (int c = 0; c < 2; ++c) { const v4u hv = hp[(jj * 64 + lane) * 2 + c]; const int o = jj * 16 + c * 8;
                    hf[o + 0] = bflo(hv.x); hf[o + 1] = bfhi(hv.x); hf[o + 2] = bflo(hv.y); hf[o + 3] = bfhi(hv.y); hf[o + 4] = bflo(hv.z); hf[o + 5] = bfhi(hv.z); hf[o + 6] = bflo(hv.w); hf[o + 7] = bfhi(hv.w); }
            { const float rstd = rsqrtf(wave_sum(lane < 32 ? ssr[(size_t)t * 32 + lane] : 0.f) * (1.f / DM) + NORM_EPS);
#pragma unroll
                for (int jj = 0; jj < 2; ++jj)
#pragma unroll
                    for (int q = 0; q < 4; ++q) { const f32x4 s4 = *(const f32x4*)(sh2 + (size_t)b * MODW + (jj * 64 + lane) * 16 + 4 * q);
                        hf[jj * 16 + 4 * q] = hf[jj * 16 + 4 * q] * rstd + s4.x; hf[jj * 16 + 4 * q + 1] = hf[jj * 16 + 4 * q + 1] * rstd + s4.y;
                        hf[jj * 16 + 4 * q + 2] = hf[jj * 16 + 4 * q + 2] * rstd + s4.z; hf[jj * 16 + 4 * q + 3] = hf[jj * 16 + 4 * q + 3] * rstd + s4.w; } }
#pragma unroll
            for (int i = 0; i < 32; ++i) mx = fmaxf(mx, fabsf(hf[i]));
            mx = wave_max(mx);
            const float inv = mx > 0.f ? 127.f / mx : 0.f;
            if (lane == 0) hsl[k] = mx * (1.f / 127.f);
#pragma unroll
            for (int jj = 0; jj < 2; ++jj) { unsigned qd[4];
#pragma unroll
                for (int d = 0; d < 4; ++d) { const int o = jj * 16 + 4 * d; const int q0 = (int)rintf(hf[o] * inv), q1 = (int)rintf(hf[o + 1] * inv), q2 = (int)rintf(hf[o + 2] * inv), q3 = (int)rintf(hf[o + 3] * inv);
                    qd[d] = (unsigned)(q0 & 255) | ((unsigned)(q1 & 255) << 8) | ((unsigned)(q2 & 255) << 16) | ((unsigned)(q3 & 255) << 24); }
                v4u q; q.x = qd[0]; q.y = qd[1]; q.z = qd[2]; q.w = qd[3]; hl[k * 132 + jj * 64 + lane] = q; }
        }
        asm volatile("s_waitcnt lgkmcnt(0)" ::: "memory");
        {
            v4i ub0[8], ub1[8];
            int lu = lane; asm volatile("" : "+v"(lu)); const int li = lu & 15, lq = lu >> 4;
            const LAS v4u* hb = hl + (li & 3) * 132 + lq;
#define ULOAD(buf, g_, sg_) do { const int my_e_ = se[(g_) * 16 + li]; const unsigned char* ub_ = U8 + (size_t)my_e_ * DM + lq * 16 + (sg_) * 512; \
    _Pragma("unroll") for (int s8 = 0; s8 < 8; ++s8) buf[s8] = *(const v4i*)(ub_ + s8 * 64); } while (0)
#define UCONS(buf, sg_) do { _Pragma("unroll") for (int s8 = 0; s8 < 8; ++s8) { const v4i hb_ = *(const LAS v4i*)(hb + ((sg_) * 8 + s8) * 4); acc = __builtin_amdgcn_mfma_i32_16x16x64_i8(buf[s8], hb_, acc, 0, 0, 0); } } while (0)
            ULOAD(ub0, 0, 0); ULOAD(ub1, 0, 1);
#pragma unroll 1
            for (int g = 0; g < 32; ++g) {
                const int gn = g + 1 < 32 ? g + 1 : 31;
                v4i acc = {0, 0, 0, 0};
                UCONS(ub0, 0); ULOAD(ub0, g, 2);
                UCONS(ub1, 1); ULOAD(ub1, g, 3);
                UCONS(ub0, 2); ULOAD(ub0, gn, 0);
                UCONS(ub1, 3); ULOAD(ub1, gn, 1);
                if (li < 4) { dl[(4 * lq + 0) * 4 + li] = (float)acc.x; dl[(4 * lq + 1) * 4 + li] = (float)acc.y; dl[(4 * lq + 2) * 4 + li] = (float)acc.z; dl[(4 * lq + 3) * 4 + li] = (float)acc.w; }
                if (lane < 16) { const int x = g * 16 + lane; const int e = se[x], tk = st[x];
                    sg[x] = sg[x] * VS[e] * gelu_as(dl[lane * 4 + tk] * (US[e] * hsl[tk])); }
            }
#undef ULOAD
#undef UCONS
        }
        asm volatile("s_waitcnt lgkmcnt(0)" ::: "memory");
#define PEER_EPILOGUE(kk_, kt_) do { const int t = tb + (kt_), b = t >> 12; float (&out_k)[32] = out[kk_]; \
            f32x4 xn[2][4]; float ss = 0.f; \
            const f32x4* xr = (const f32x4*)(X + (size_t)t * DM); const f32x4* gr = (const f32x4*)(g2 + (size_t)b * MODW); \
            _Pragma("unroll") \
            for (int jj = 0; jj < 2; ++jj) \
            _Pragma("unroll") \
                for (int q = 0; q < 4; ++q) { const int ix = (jj * 64 + lane) * 4 + q; const f32x4 xv = xr[ix], gv = gr[ix]; f32x4 o4; o4.x = out_k[jj * 16 + 4 * q]; o4.y = out_k[jj * 16 + 4 * q + 1]; o4.z = out_k[jj * 16 + 4 * q + 2]; o4.w = out_k[jj * 16 + 4 * q + 3]; \
                    const f32x4 y = xv + gv * o4; xn[jj][q] = y; ss += (y.x * y.x + y.y * y.y) + (y.z * y.z + y.w * y.w); } \
            const float rstd = rsqrtf(wave_sum(ss) * (1.f / DM) + NORM_EPS); \
            if (!last) { \
                f32x4* xw = (f32x4*)((dry ? (float*)(A->ws + WS_DUMMY) : X) + (size_t)t * DM); v4u* hw = (v4u*)((dry ? (bf16*)(A->ws + WS_DUMMY + 64 * MiB) : H) + (size_t)t * DM); \
            _Pragma("unroll") \
                for (int jj = 0; jj < 2; ++jj) { f32x4 y[4]; \
            _Pragma("unroll") \
                    for (int q = 0; q < 4; ++q) { const int ix = (jj * 64 + lane) * 4 + q; xw[ix] = xn[jj][q]; \
                        const f32x4 g = ((const f32x4*)ngain)[ix], s1 = ((const f32x4*)(nsc + (size_t)b * MODW))[ix], s0 = ((const f32x4*)(nsh + (size_t)b * MODW))[ix]; \
                        y[q] = xn[jj][q] * rstd * g * (s1 + 1.f) + s0; } \
                    v4u o; o.x = pk2(y[0].x, y[0].y); o.y = pk2(y[0].z, y[0].w); o.z = pk2(y[1].x, y[1].y); o.w = pk2(y[1].z, y[1].w); hw[(jj * 64 + lane) * 2] = o; \
                    o.x = pk2(y[2].x, y[2].y); o.y = pk2(y[2].z, y[2].w); o.z = pk2(y[3].x, y[3].y); o.w = pk2(y[3].z, y[3].w); hw[(jj * 64 + lane) * 2 + 1] = o; } \
            } else { \
                f32x4* ow = (f32x4*)((dry ? (float*)(A->ws + WS_DUMMY) : A->out) + (size_t)t * DM); \
            _Pragma("unroll") \
                for (int jj = 0; jj < 2; ++jj) \
            _Pragma("unroll") \
                    for (int q = 0; q < 4; ++q) { const int ix = (jj * 64 + lane) * 4 + q; ow[ix] = xn[jj][q] * rstd * ((const f32x4*)ngain)[ix]; } \
            } \
        } while (0)
#define VLOAD(buf, cfb, tkb, bi_) do { _Pragma("unroll") for (int i = 0; i < 4; ++i) { const int x_ = (bi_) * 4 + i; const int e_ = __builtin_amdgcn_readfirstlane(se[x_]); \
        cfb[i] = __builtin_bit_cast(float, __builtin_amdgcn_readfirstlane(__builtin_bit_cast(int, sg[x_]))); tkb[i] = __builtin_amdgcn_readfirstlane(st[x_]) & 1; \
        const v4u* vp_ = (const v4u*)(V8 + (size_t)e_ * DM) + lane_v; buf[i][0] = vp_[0]; buf[i][1] = vp_[64]; } } while (0)
#define VACC(kk_, bv_, cv_) do { const f32x2 c2_ = {cv_, cv_}; \
        _Pragma("unroll") for (int jj = 0; jj < 2; ++jj) { const unsigned wd_[4] = {bv_[jj].x, bv_[jj].y, bv_[jj].z, bv_[jj].w}; \
            _Pragma("unroll") for (int d = 0; d < 4; ++d) { const int o_ = jj * 16 + 4 * d; \
                const f32x2 f0_ = __builtin_amdgcn_cvt_pk_f32_fp8((int)wd_[d], false), f1_ = __builtin_amdgcn_cvt_pk_f32_fp8((int)wd_[d], true); \
                f32x2 a0_ = {out[kk_][o_], out[kk_][o_ + 1]}, a1_ = {out[kk_][o_ + 2], out[kk_][o_ + 3]}; \
                a0_ = __builtin_elementwise_fma(c2_, f0_, a0_); a1_ = __builtin_elementwise_fma(c2_, f1_, a1_); \
                out[kk_][o_] = a0_.x; out[kk_][o_ + 1] = a0_.y; out[kk_][o_ + 2] = a1_.x; out[kk_][o_ + 3] = a1_.y; } } } while (0)
#define VCONS(buf, cfb, tkb) do { _Pragma("unroll") for (int i = 0; i < 4; ++i) { if (tkb[i] == 0) VACC(0, buf[i], cfb[i]); else VACC(1, buf[i], cfb[i]); } } while (0)
#pragma unroll 1
        for (int p = 0; p < 2; ++p) {
            int lane_v = F.lane; asm volatile("" : "+v"(lane_v));
            float out[2][32];
#pragma unroll
            for (int k = 0; k < 2; ++k)
#pragma unroll
                for (int i = 0; i < 32; ++i) out[k][i] = 0.f;
            {
                v4u vb0[4][2], vb1[4][2]; float c0[4], c1[4]; int t0v[4], t1v[4];
                const int bb = p * 64;
                VLOAD(vb0, c0, t0v, bb); VLOAD(vb1, c1, t1v, bb + 1);
#pragma unroll 1
                for (int bi = 0; bi < 64; bi += 2) {
                    const int b2 = bb + (bi + 2 < 64 ? bi + 2 : 62), b3 = bb + (bi + 3 < 64 ? bi + 3 : 63);
                    VCONS(vb0, c0, t0v); VLOAD(vb0, c0, t0v, b2);
                    VCONS(vb1, c1, t1v); VLOAD(vb1, c1, t1v, b3);
                }
            }
            PEER_EPILOGUE(0, 2 * p); PEER_EPILOGUE(1, 2 * p + 1);
        }
#undef VLOAD
#undef VACC
#undef VCONS
#undef PEER_EPILOGUE
    }
}

__device__ __forceinline__ void PH_norm1_l0(LAS unsigned char* lds, int wv) { ArgsP A = args_ptr(); const float* MOD = (const float*)(A->ws + WS_MOD);
    ph_norm(A->in[0], A->in[4], MOD + 0 * DM, MOD + 1 * DM, (bf16*)(A->ws + WS_H), lds, wv);
    { const Frame F = make_frame(lds, wv); float* B3 = (float*)(A->ws + WS_BIAS3);
        for (int o = F.gw; o < DEPTH * 2 * DM; o += F.ngw) { const int l = o >> 12, b = (o >> 11) & 1, n = o & 2047;
            const float* sh = MOD + (size_t)(l * 2 + b) * MODW + 3 * DM; const v4u* wr = (const v4u*)((const bf16*)(A->ws + WS_WQK) + ((size_t)l * DM + n) * DM);
            float s = 0.f;
#pragma unroll
            for (int j = 0; j < 4; ++j) { const v4u wv4 = wr[j * 64 + F.lane]; const f32x4 s0 = *(const f32x4*)(sh + (j * 64 + F.lane) * 8), s1 = *(const f32x4*)(sh + (j * 64 + F.lane) * 8 + 4);
                s += bflo(wv4.x) * s0.x + bfhi(wv4.x) * s0.y + bflo(wv4.y) * s0.z + bfhi(wv4.y) * s0.w + bflo(wv4.z) * s1.x + bfhi(wv4.z) * s1.y + bflo(wv4.w) * s1.z + bfhi(wv4.w) * s1.w; }
            s = wave_sum(s);
            if (F.lane == 0) B3[o] = s; } } }
__device__ __forceinline__ void PH_gemm1(LAS unsigned char* lds, int wv, int l_) { ArgsP A = args_ptr(); const int l = opaque_i(l_);
    pg8::Gemm g{(const bf16*)(A->ws + WS_H), (const bf16*)(A->ws + WS_WIN) + (size_t)l * INWP * DM, NT, INWP, DM}; pg8::StaticOrder S; S.init(NT, INWP, gridDim.x, blockIdx.x);
    EpiStoreF32 E{(float*)(A->ws + WS_PROJ), INWP, wv};
    pg8::gemm_phase<EpiStoreF32, pg8::StaticOrder, true, true>(lds, g, S, E, wv); }
__device__ __forceinline__ void PH_mixA(LAS unsigned char* lds, int wv, int l_) { ArgsP A = args_ptr(); const int l = opaque_i(l_);
    const Frame F = make_frame(lds, wv);
#ifdef PROBE_A
    for (int u = F.bid; u < 2048; u += F.G) {
        if (u < 1536) { if (PROBE_A == 1) rwkvA_unit(A, F, l, u); }
        else { if (PROBE_A == 2) gla1_unit(A, F, l, u - 1536); }
    }
#endif
    for (int u = F.bid; u < 2048; u += F.G) {
        if (u < 1536) rwkvA_unit(A, F, l, u);
        else gla1_unit(A, F, l, u - 1536);
    }
    if (l + 1 < DEPTH) quant_tables(A, l + 1, F.gw, F.ngw, F.lane);
}
__device__ __forceinline__ void PH_mixB(LAS unsigned char* lds, int wv, int l_) { ArgsP A = args_ptr(); const int l = opaque_i(l_);
    const Frame F = make_frame(lds, wv);
    if (F.G >= 192) {
        if (F.bid < 96) rwkvB_scan(A, F, F.bid);
        else { const int nb = F.G - 96, b2 = F.bid - 96;
            for (int u = b2; u < 288; u += nb) gla_scan_unit(A, F, u);
            for (int u = b2; u < 1024; u += nb) pool_unit(A, F, l, u); }
    } else {
        for (int u = F.bid; u < 288; u += F.G) gla_scan_unit(A, F, u);
        for (int u = F.bid; u < 1024; u += F.G) pool_unit(A, F, l, u);
        for (int u = F.bid; u < 96; u += F.G) rwkvB_scan(A, F, u);
    } }
__device__ __forceinline__ void PH_mixC(LAS unsigned char* lds, int wv, int l_) { ArgsP A = args_ptr(); const int l = opaque_i(l_);
    const Frame F = make_frame(lds, wv);
#ifdef PROBE_C
    for (int u = F.bid; u < 2048; u += F.G) { if (u < 512) { if (PROBE_C == 1) gla3_unit(A, F, l, u); } else { if (PROBE_C == 2) rwkvC_unit(A, F, l, u - 512); } }
#endif
    for (int u = F.bid; u < 2048; u += F.G) { if (u < 512) gla3_unit(A, F, l, u); else rwkvC_unit(A, F, l, u - 512); } }
__device__ __forceinline__ void PH_gemm2(LAS unsigned char* lds, int wv, int l_, bool dry = false) { ArgsP A = args_ptr(); const int l = opaque_i(l_);
    const float* modl = (const float*)(A->ws + WS_MOD) + (size_t)l * 2 * MODW; float* X = (float*)(A->ws + WS_X);
    pg8::Gemm g{(const bf16*)(A->ws + WS_Y), (const bf16*)(A->ws + WS_WOUT) + (size_t)l * DM * DM, NT, DM, DM}; pg8::StaticOrder S; S.init(NT, DM, gridDim.x, blockIdx.x);
    EpiResid E{(l == 0) ? A->in[0] : (const float*)X, dry ? (float*)(A->ws + WS_DUMMY) : X, modl + 2 * DM, wv, A->in[23] + (size_t)l * DM, modl + 4 * DM,
               dry ? (bf16*)(A->ws + WS_DUMMY + 64 * MiB) : (bf16*)(A->ws + WS_H), (dry ? (float*)(A->ws + WS_DUMMY) : (float*)(A->ws + WS_SSP) + (size_t)l * NT * 32)};
    pg8::gemm_phase<EpiResid, pg8::StaticOrder, true, true>(lds, g, S, E, wv); }
__device__ __forceinline__ void PH_norm2(LAS unsigned char* lds, int wv, int l_) { ArgsP A = args_ptr(); const int l = opaque_i(l_);
    const float* modl = (const float*)(A->ws + WS_MOD) + (size_t)l * 2 * MODW;
    ph_norm((const float*)(A->ws + WS_X), A->in[23] + (size_t)l * DM, modl + 3 * DM, modl + 4 * DM, (bf16*)(A->ws + WS_H), lds, wv); }
__device__ __forceinline__ void PH_gemm3(LAS unsigned char* lds, int wv, int l_) { ArgsP A = args_ptr(); const int l = opaque_i(l_);
    pg8::Gemm g{(const bf16*)(A->ws + WS_H), (const bf16*)(A->ws + WS_WQK) + (size_t)l * DM * DM, NT, DM, DM}; pg8::StaticOrder S; S.init(NT, DM, gridDim.x, blockIdx.x);
    LAS float* rs = (LAS float*)(lds + 131072);
    { pg8::Unit u0; const int t = tid_from(wv); if (S.next(0, u0) && t < 256) { const f32x4* sp = (const f32x4*)((const float*)(A->ws + WS_SSP) + ((size_t)l * NT + u0.pm * 256 + t) * 32); float s = 0.f;
#pragma unroll
            for (int j = 0; j < 8; ++j) { const f32x4 v = sp[j]; s += (v.x + v.y) + (v.z + v.w); }
            rs[t] = rsqrtf(s * (1.f / DM) + NORM_EPS); }
        __syncthreads(); }
    EpiScore E{(float*)(A->ws + WS_PROJ), DM, wv, rs, (const float*)(A->ws + WS_BIAS3) + (size_t)l * 2 * DM};
    pg8::gemm_phase<EpiScore, pg8::StaticOrder, true, true>(lds, g, S, E, wv); }
__device__ __forceinline__ void PH_peer(LAS unsigned char* lds, int wv, int l_, bool dry = false) { ArgsP A = args_ptr(); const int l = opaque_i(l_);
    const float* MOD = (const float*)(A->ws + WS_MOD); const float* modl = MOD + (size_t)l * 2 * MODW;
    const bool last = (l == DEPTH - 1);
    const float* nmod = MOD + (size_t)(last ? l : l + 1) * 2 * MODW;
#ifndef PEER_ORDERED
#define PEER_ORDERED 1
#endif
    if (PEER_ORDERED) ph_peer4(A, lds, wv, l, modl + 5 * DM, modl + 3 * DM, last ? A->in[29] : A->in[4] + (size_t)(l + 1) * DM, nmod + 0 * DM, nmod + 1 * DM, last, dry);
    else ph_peer2(A, lds, wv, l, modl + 5 * DM, modl + 3 * DM, last ? A->in[29] : A->in[4] + (size_t)(l + 1) * DM, nmod + 0 * DM, nmod + 1 * DM, last, dry); }

__global__ void __launch_bounds__(NTHR, 2) mega_fwd(Args args) {
    extern __shared__ __attribute__((aligned(16))) unsigned char lds_raw[];
    LAS unsigned char* lds = (LAS unsigned char*)lds_raw;
    volatile LAS unsigned* MISC = (volatile LAS unsigned*)(lds + MISC_OFF);
    const int wv = __builtin_amdgcn_readfirstlane((int)(threadIdx.x >> 6));
    if (wv == 0) MISC[lane_id_()] = 0u;
    __syncthreads();
    XcdBarrier bar = xcd_barrier_post((unsigned*)(args_ptr()->ws + WS_CTL) + CW_BAR, MISC + 8, wv);
#define GRID_BAR() do { XcdBarrier b_ = bar; b_.bar = (unsigned*)(args_ptr()->ws + WS_CTL) + CW_BAR; asm volatile("" : "+s"(b_.x), "+s"(b_.w)); xcd_barrier(b_); if (PROBE & 512) xcd_barrier(b_); } while (0)

    ph_prologue(args_ptr(), lds, wv);
    GRID_BAR();
#if PROBE & 1
    ph_prologue(args_ptr(), lds, wv); GRID_BAR();
#endif
    PH_norm1_l0(lds, wv);
    GRID_BAR();
    for (int l = 0; l < DEPTH; ++l) {
#if PROBE & 2
        PH_gemm1(lds, wv, l); GRID_BAR();
#endif
        PH_gemm1(lds, wv, l); GRID_BAR();
#if PROBE & 4
        PH_mixA(lds, wv, l);  GRID_BAR();
#endif
        PH_mixA(lds, wv, l);  GRID_BAR();
#if PROBE & 8
        PH_mixB(lds, wv, l);  GRID_BAR();
#endif
        PH_mixB(lds, wv, l);  GRID_BAR();
#if PROBE & 16
        PH_mixC(lds, wv, l);  GRID_BAR();
#endif
        PH_mixC(lds, wv, l);  GRID_BAR();
#if PROBE & 32
        PH_gemm2(lds, wv, l, true); GRID_BAR();
#endif
        PH_gemm2(lds, wv, l); GRID_BAR();
#if PROBE & 128
        PH_gemm3(lds, wv, l); GRID_BAR();
#endif
        PH_gemm3(lds, wv, l); GRID_BAR();
#if PROBE & 256
        PH_peer(lds, wv, l, true); GRID_BAR();
#endif
        PH_peer(lds, wv, l);
        if (l + 1 < DEPTH) GRID_BAR();
    }
}

extern "C" void kernel_launch(void* const* d_in, const int* in_sizes, int n_in, void* d_out, int out_size, void* d_ws, size_t ws_size, hipStream_t stream) {
    static int grid = 0;
    if (grid == 0) {
        if (n_in != 30 || out_size != NT * DM || ws_size < WS_END + 96 * MiB) { fprintf(stderr, "kernel_launch: unexpected shapes (n_in %d out %d ws %zu)\n", n_in, out_size, ws_size); grid = -1; return; }
        int dev = 0, cus = 0, per_cu = 0;
        if (hipGetDevice(&dev) != hipSuccess || hipDeviceGetAttribute(&cus, hipDeviceAttributeMultiprocessorCount, dev) != hipSuccess) { grid = -1; return; }
        if (hipFuncSetAttribute((const void*)mega_fwd, hipFuncAttributeMaxDynamicSharedMemorySize, LDS_BYTES) != hipSuccess) { fprintf(stderr, "kernel_launch: hipFuncSetAttribute failed\n"); grid = -1; return; }
        if (hipOccupancyMaxActiveBlocksPerMultiprocessor(&per_cu, (const void*)mega_fwd, NTHR, LDS_BYTES) != hipSuccess || per_cu < 1) { fprintf(stderr, "kernel_launch: occupancy query says %d\n", per_cu); (void)hipGetLastError(); per_cu = 1; }
        grid = cus;
    }
    if (grid < 0) return;
    (void)in_sizes;
    if (hipMemsetAsync((char*)d_ws + WS_CTL, 0, CTL_ZERO_BYTES, stream) != hipSuccess) return;
    Args a{};
    for (int i = 0; i < 30; ++i) a.in[i] = (const float*)d_in[i];
    a.out = (float*)d_out; a.ws = (unsigned char*)d_ws;
    hipLaunchKernelGGL(mega_fwd, dim3(grid), dim3(NTHR), LDS_BYTES, stream, a);
}
```

```cpp
#include <hip/hip_runtime.h>
#include <cstdio>
#include <cstdint>
__device__ __forceinline__ int lane_id_() { int r; asm volatile("v_mbcnt_lo_u32_b32 %0, -1, 0\n\tv_mbcnt_hi_u32_b32 %0, -1, %0" : "=v"(r)); return r; }
__device__ __forceinline__ int tid_from(int wave_s) { return wave_s * 64 + lane_id_(); }
namespace pg8 {
#define PG8_LAS __attribute__((address_space(3)))
typedef unsigned short bf16_t;
typedef short bf16x8 __attribute__((ext_vector_type(8)));
typedef float f32x4 __attribute__((ext_vector_type(4)));
typedef unsigned u32x4 __attribute__((ext_vector_type(4)));
constexpr int BM = 256, BK = 64, HALF = 128, HTB = HALF * BK * 2  , STAGE_BYTES = 8 * HTB, NXCD = 8, WGM = 8;

__host__ __device__ __forceinline__ int lds_byte(int r, int c) { const int st = (r >> 4) * 2 + (c >> 5), rr = r & 15, cc = c & 31, ob = rr * 64 + cc * 2; return st * 1024 + (ob ^ (((ob >> 9) & 1) << 5)); }
__host__ __device__ __forceinline__ void stage_rc(int b, int& R, int& C) { const int st = b / 1024, sb = b % 1024, swz = sb ^ (((sb >> 9) & 1) << 5); R = (st >> 1) * 16 + swz / 64; C = (st & 1) * 32 + (swz % 64) / 2; }
__host__ __device__ __forceinline__ int perm32(int rho) { const int n = rho >> 4, i = rho & 15; return 8 * (i >> 2) + 4 * n + (i & 3); }

struct Unit { int pm, pn; };
struct Gemm { const bf16_t* A; const bf16_t* Bt; int M, N, K; };

struct StaticOrder {
    int nM, nN, nwg, G, c;
    __host__ __device__ void init(int M, int N, int G_, int c_) { nM = M / BM; nN = N / BM; nwg = nM * nN; G = G_; c = c_; }
    __host__ __device__ bool next(int i, Unit& u) const {
        const long L = (long)i * G + c; if (L >= nwg) return false;
        int wgid = (int)L; { const int q = nwg / NXCD, r = nwg % NXCD, xcd = wgid % NXCD, off = wgid / NXCD; wgid = (xcd < r ? xcd * (q + 1) : r * (q + 1) + (xcd - r) * q) + off; }
        const int nig = WGM * nN, gid = wgid / nig, fm = gid * WGM, gsz = (nM - fm) < WGM ? (nM - fm) : WGM;
        u.pm = fm + ((wgid % nig) % gsz); u.pn = (wgid % nig) / gsz; return true;
    }
    __device__ __forceinline__ void a_ready(const Unit&) const {}
    __device__ __forceinline__ void done(const Unit&) const {}
};

template <class Epi, class Sched, bool ALIGN_EPI = false, bool SP2 = false>
__device__ __forceinline__ void gemm_phase(PG8_LAS unsigned char* lds, const Gemm g, const Sched& S, const Epi& E, int wave_s) {
    int tid_o = tid_from(wave_s); asm volatile("" : "+v"(tid_o));
    const int tid = tid_o, wid = __builtin_amdgcn_readfirstlane(tid >> 6), lane = tid & 63, wr = wid >> 2, wc = wid & 3, fr = lane & 15, fq = lane >> 4;
    const int K = g.K, nt = K / BK;
    unsigned voffA[2], voffB[2];
#pragma unroll
    for (int i = 0; i < 2; ++i) { int R, C; stage_rc(tid * 16 + i * 8192, R, C); const int Rb = Epi::PERM ? ((R & ~31) + perm32(R & 31)) : R;
        voffA[i] = (unsigned)(R * K + C) * 2u; voffB[i] = (unsigned)(Rb * K + C) * 2u; }
    const size_t kstep = (size_t)(BK * 2);
    const size_t hstep = (size_t)HALF * K * 2;
    const size_t tstep = 2 * hstep;
    const unsigned ldsw = (unsigned)wid * 1024u;
    const int aoff = lds_byte(wr * 64 + fr, fq * 8), boff = lds_byte(wc * 32 + fr, fq * 8);
#define PG8_SA(b, h) (((b) * 2 + (h)) * HTB)
#define PG8_SB(b, h) ((4 + (b) * 2 + (h)) * HTB)
#define PG8_STAGE(bufoff, gbase, voff) do { _Pragma("unroll") for (int _i = 0; _i < 2; ++_i) \
        __builtin_amdgcn_global_load_lds((const unsigned*)((const char*)(gbase) + (voff)[_i]), (PG8_LAS unsigned*)(lds + (bufoff) + ldsw + _i * 8192), 16, 0, 0); } while (0)
#define PG8_LDA(dst, b, h) do { _Pragma("unroll") for (int m = 0; m < 4; ++m) _Pragma("unroll") for (int k = 0; k < 2; ++k) dst[m][k] = *(const PG8_LAS bf16x8*)(lds + PG8_SA(b, h) + aoff + m * 2048 + k * 1024); } while (0)
#define PG8_LDB(dst, b, h) do { _Pragma("unroll") for (int n = 0; n < 2; ++n) _Pragma("unroll") for (int k = 0; k < 2; ++k) dst[n][k] = *(const PG8_LAS bf16x8*)(lds + PG8_SB(b, h) + boff + n * 2048 + k * 1024); } while (0)
#define PG8_MMA(ai, bj, At, Bt) do { __builtin_amdgcn_s_setprio(1); _Pragma("unroll") for (int m = 0; m < 4; ++m) _Pragma("unroll") for (int n = 0; n < 2; ++n) _Pragma("unroll") for (int k = 0; k < 2; ++k) \
        acc[ai][bj][m][n] = __builtin_amdgcn_mfma_f32_16x16x32_bf16(Bt[n][k], At[m][k], acc[ai][bj][m][n], 0, 0, 0); __builtin_amdgcn_s_setprio(0); } while (0)
#define PG8_WAIT_V(n) asm volatile("s_waitcnt vmcnt(" #n ")" ::: "memory")
#define PG8_WAIT_L(n) asm volatile("s_waitcnt lgkmcnt(" #n ")" ::: "memory")
#define PG8_BAR __builtin_amdgcn_s_barrier()
#define PG8_SCHED __builtin_amdgcn_sched_barrier(0)
    Unit cur, nxt; int ui = 0;
    if (!S.next(0, cur)) return;
    f32x4 acc[2][2][4][2];
#pragma unroll
    for (int a = 0; a < 2; ++a)
#pragma unroll
        for (int b = 0; b < 2; ++b)
#pragma unroll
            for (int m = 0; m < 4; ++m)
#pragma unroll
                for (int n = 0; n < 2; ++n) acc[a][b][m][n] = (f32x4){0.f, 0.f, 0.f, 0.f};
    bf16x8 At[4][2], B0[2][2], B1[2][2];
    const char* cA = (const char*)g.A + (size_t)cur.pm * tstep; const char* cB = (const char*)g.Bt + (size_t)cur.pn * tstep;
    S.a_ready(cur);
    if constexpr (SP2) {
        PG8_STAGE(PG8_SB(0, 0), cB, voffB); PG8_STAGE(PG8_SB(0, 1), cB + hstep, voffB); PG8_STAGE(PG8_SA(0, 0), cA, voffA); PG8_STAGE(PG8_SA(0, 1), cA + hstep, voffA);
        if (wr == 1) PG8_BAR;
        PG8_WAIT_V(2); PG8_BAR;
        PG8_STAGE(PG8_SB(1, 0), cB + kstep, voffB); PG8_STAGE(PG8_SA(1, 0), cA + kstep, voffA); PG8_STAGE(PG8_SB(1, 1), cB + hstep + kstep, voffB);
        PG8_WAIT_V(6); PG8_BAR;
    } else {
        PG8_STAGE(PG8_SB(0, 0), cB, voffB); PG8_STAGE(PG8_SA(0, 0), cA, voffA); PG8_STAGE(PG8_SB(0, 1), cB + hstep, voffB); PG8_STAGE(PG8_SA(0, 1), cA + hstep, voffA);
        if (wr == 1) PG8_BAR;
        PG8_WAIT_V(4); PG8_BAR;
        PG8_STAGE(PG8_SB(1, 0), cB + kstep, voffB); PG8_STAGE(PG8_SA(1, 0), cA + kstep, voffA); PG8_STAGE(PG8_SB(1, 1), cB + hstep + kstep, voffB);
        PG8_WAIT_V(6); PG8_BAR;
    }
    for (;;) {
        const bool has_next = S.next(ui + 1, nxt);
        const char* nA = has_next ? (const char*)g.A + (size_t)nxt.pm * tstep : cA; const char* nB = has_next ? (const char*)g.Bt + (size_t)nxt.pn * tstep : cB;
        for (int t = 0; t < nt; t += 2) {
            const bool last = (t == nt - 2);
            const char* a1 = cA + (size_t)(t + 1) * kstep;
            const char* a2 = last ? nA : cA + (size_t)(t + 2) * kstep; const char* b2 = last ? nB : cB + (size_t)(t + 2) * kstep;
            const char* a3 = a2 + kstep; const char* b3 = b2 + kstep;
            if (last && has_next) S.a_ready(nxt);
            if constexpr (SP2) {
            PG8_LDB(B0, 0, 0); PG8_LDB(B1, 0, 1); PG8_SCHED; PG8_LDA(At, 0, 0); PG8_STAGE(PG8_SA(1, 1), a1 + hstep, voffA);
            PG8_WAIT_V(8); PG8_WAIT_L(0); PG8_BAR; PG8_MMA(0, 0, At, B0); PG8_MMA(0, 1, At, B1); PG8_BAR; PG8_SCHED;
            PG8_LDA(At, 0, 1); PG8_STAGE(PG8_SB(0, 0), b2, voffB); PG8_STAGE(PG8_SB(0, 1), b2 + hstep, voffB); PG8_STAGE(PG8_SA(0, 0), a2, voffA);
            PG8_WAIT_V(8); PG8_WAIT_L(0); PG8_BAR; PG8_MMA(1, 0, At, B0); PG8_MMA(1, 1, At, B1); PG8_BAR; PG8_SCHED;
            PG8_LDB(B0, 1, 0); PG8_LDB(B1, 1, 1); PG8_SCHED; PG8_LDA(At, 1, 0); PG8_STAGE(PG8_SA(0, 1), a2 + hstep, voffA);
            PG8_WAIT_V(8); PG8_WAIT_L(0); PG8_BAR; PG8_MMA(0, 0, At, B0); PG8_MMA(0, 1, At, B1); PG8_BAR; PG8_SCHED;
            PG8_LDA(At, 1, 1); PG8_STAGE(PG8_SB(1, 0), b3, voffB); PG8_STAGE(PG8_SB(1, 1), b3 + hstep, voffB); PG8_STAGE(PG8_SA(1, 0), a3, voffA);
            PG8_WAIT_V(8); PG8_WAIT_L(0); PG8_BAR; PG8_MMA(1, 0, At, B0); PG8_MMA(1, 1, At, B1); PG8_BAR; PG8_SCHED;
            } else {
            PG8_LDB(B0, 0, 0); PG8_SCHED; PG8_LDA(At, 0, 0); PG8_STAGE(PG8_SA(1, 1), a1 + hstep, voffA);
            PG8_WAIT_L(8); PG8_BAR; PG8_WAIT_L(0); PG8_MMA(0, 0, At, B0); PG8_BAR; PG8_SCHED;
            PG8_LDB(B1, 0, 1); PG8_STAGE(PG8_SB(0, 0), b2, voffB);
            PG8_BAR; PG8_WAIT_L(0); PG8_MMA(0, 1, At, B1); PG8_BAR;
            PG8_LDA(At, 0, 1); PG8_STAGE(PG8_SA(0, 0), a2, voffA);
            PG8_BAR; PG8_WAIT_L(0); PG8_MMA(1, 0, At, B0); PG8_BAR; PG8_SCHED;
            PG8_STAGE(PG8_SB(0, 1), b2 + hstep, voffB);
            PG8_WAIT_V(6); PG8_BAR; PG8_MMA(1, 1, At, B1); PG8_BAR;
            PG8_LDB(B0, 1, 0); PG8_SCHED; PG8_LDA(At, 1, 0); PG8_STAGE(PG8_SA(0, 1), a2 + hstep, voffA);
            PG8_WAIT_L(8); PG8_BAR; PG8_WAIT_L(0); PG8_MMA(0, 0, At, B0); PG8_BAR; PG8_SCHED;
            PG8_LDB(B1, 1, 1); PG8_STAGE(PG8_SB(1, 0), b3, voffB);
            PG8_BAR; PG8_WAIT_L(0); PG8_MMA(0, 1, At, B1); PG8_BAR;
            PG8_LDA(At, 1, 1); PG8_STAGE(PG8_SA(1, 0), a3, voffA);
            PG8_BAR; PG8_WAIT_L(0); PG8_MMA(1, 0, At, B0); PG8_BAR; PG8_SCHED;
            PG8_STAGE(PG8_SB(1, 1), b3 + hstep, voffB);
            PG8_WAIT_V(6); PG8_BAR; PG8_MMA(1, 1, At, B1); PG8_BAR;
            }
        }
        if constexpr (ALIGN_EPI) { if (wr == 0) PG8_BAR; }
        if constexpr (!Epi::AFTER_DRAIN) { E(acc, cur, wr, wc, fr, fq); S.done(cur); }
        if (!has_next) break;
#pragma unroll
        for (int a = 0; a < 2; ++a)
#pragma unroll
            for (int b = 0; b < 2; ++b)
#pragma unroll
                for (int m = 0; m < 4; ++m)
#pragma unroll
                    for (int n = 0; n < 2; ++n) acc[a][b][m][n] = (f32x4){0.f, 0.f, 0.f, 0.f};
        cur = nxt; cA = nA; cB = nB; ++ui;
        if constexpr (ALIGN_EPI) { if (wr == 1) PG8_BAR; }
    }
    PG8_WAIT_V(0);
    if constexpr (!ALIGN_EPI) { if (wr == 0) PG8_BAR; }
    PG8_BAR;
    if constexpr (Epi::AFTER_DRAIN) { E.fused(acc, cur, wr, wc, fr, fq, lds, wid, lane); S.done(cur); }
#undef PG8_SA
#undef PG8_SB
#undef PG8_STAGE
#undef PG8_LDA
#undef PG8_LDB
#undef PG8_MMA
#undef PG8_WAIT_V
#undef PG8_WAIT_L
#undef PG8_BAR
#undef PG8_SCHED
}
}
#define GAS __attribute__((address_space(1)))
#define LAS __attribute__((address_space(3)))
#define XB_TMO      128
#define XB_XCNT(j)  (256  + 64 * (j))
#define XB_XSUB(j)  (1280 + 64 * (j))
#define XB_XGEN(j)  (2304 + 64 * (j))
#define XB_TOP      3328
#define XB_TOPGEN   3392
#define XCD_BAR_WORDS 3456
#define XB_SPIN_CAP (1u << 18)

__device__ __forceinline__ unsigned xb_ld(unsigned* p)              { return __hip_atomic_load(p, __ATOMIC_RELAXED, __HIP_MEMORY_SCOPE_AGENT); }
__device__ __forceinline__ unsigned xb_add(unsigned* p, unsigned v) { return __hip_atomic_fetch_add(p, v, __ATOMIC_RELAXED, __HIP_MEMORY_SCOPE_AGENT); }
__device__ __forceinline__ unsigned xb_xcc_id() { return (unsigned)__builtin_amdgcn_s_getreg((3 << 11) | 20) & 0xFu; }
#define XB_SPIN(cond, bar) do { unsigned _sp = 0; while (cond) { __builtin_amdgcn_s_sleep(1); \
    if ((++_sp & 255u) == 0u) { if (xb_ld(&(bar)[XB_TMO])) break; if (_sp > XB_SPIN_CAP) { atomicAdd(&(bar)[XB_TMO], 1u); break; } } } } while (0)

struct XcdBarrier {
    unsigned* bar; unsigned x; int w;
    volatile LAS unsigned* st;
};

__device__ __forceinline__ XcdBarrier xcd_barrier_post(unsigned* bar, volatile LAS unsigned* st, int wave_s) {
    XcdBarrier b; b.bar = bar; b.x = xb_xcc_id(); b.st = st; b.w = wave_s;
    if (tid_from(wave_s) == 0) (void)xb_add(&bar[XB_XCNT(b.x)], 1u);
    return b;
}
__device__ __forceinline__ void xcd_barrier_complete(unsigned* bar, unsigned x, unsigned& nloc, unsigned& nx) {
    const unsigned G = gridDim.x * gridDim.y * gridDim.z;
    unsigned sum, cnt, mine, sp = 0u;
    for (;;) {
        sum = 0u; cnt = 0u; mine = 0u;
#pragma unroll
        for (unsigned j = 0; j < 16; ++j) { const unsigned c = xb_ld(&bar[XB_XCNT(j)]); sum += c; cnt += (c > 0u) ? 1u : 0u; mine = (j == x) ? c : mine; }
        if (sum == G) break;
        __builtin_amdgcn_s_sleep(1);
        if ((++sp & 255u) == 0u) { if (xb_ld(&bar[XB_TMO])) break; if (sp > XB_SPIN_CAP) { atomicAdd(&bar[XB_TMO], 1u); break; } }
    }
    nloc = mine > 0u ? mine : 1u; nx = cnt > 0u ? cnt : 1u;
}

__device__ __forceinline__ void xcd_barrier(const XcdBarrier& b) {
    asm volatile("s_waitcnt vmcnt(0)" ::: "memory");
    __syncthreads();
    if (tid_from(b.w) == 0) {
        unsigned* bar = b.bar;
        __builtin_amdgcn_s_waitcnt(0);
        unsigned nloc = b.st[0], nx = b.st[1];
        if (nloc == 0u) { xcd_barrier_complete(bar, b.x, nloc, nx); b.st[0] = nloc; b.st[1] = nx; }
        const unsigned old = xb_add(&bar[XB_XSUB(b.x)], 1u);
        const unsigned gen = old / nloc;
        if (old + 1u == (gen + 1u) * nloc) {
            __builtin_amdgcn_fence(__ATOMIC_RELEASE, "agent");
            asm volatile("s_waitcnt vmcnt(0)" ::: "memory");
            const unsigned og = xb_add(&bar[XB_TOP], 1u);
            const unsigned tg = og / nx;
            if (og + 1u == (tg + 1u) * nx) xb_add(&bar[XB_TOPGEN], 1u);
            else XB_SPIN(xb_ld(&bar[XB_TOPGEN]) == tg, bar);
            __builtin_amdgcn_fence(__ATOMIC_ACQUIRE, "agent");
            xb_add(&bar[XB_XGEN(b.x)], 1u);
            asm volatile("s_waitcnt vmcnt(0)" ::: "memory");
        } else {
            XB_SPIN(xb_ld(&bar[XB_XGEN(b.x)]) == gen, bar);
            __builtin_amdgcn_fence(__ATOMIC_ACQUIRE, "agent");
            asm volatile("s_waitcnt vmcnt(0)" ::: "memory");
        }
    }
    __syncthreads();
}

constexpr int NWAVES = 8, NTHR = 512;
constexpr int DM = 2048, NB = 2, SEQ = 4096, NT = NB * SEQ, DEPTH = 4;
constexpr int INW = 5392, INWP = 5632;
constexpr int C_POOL = 0, C_GQ = 512, C_GK = 896, C_GV = 1280, C_GG = 2048, C_GA = 2816, C_RW = 2832;
constexpr int RW_IN = 2560, RW_W = 768, RW_H = 12;
constexpr int GLA_H = 4, GLA_DK = 96, GLA_DV = 192, GLA_NCH = 64;
constexpr int PEER_N = 16384;
constexpr float NORM_EPS = 1e-6f;
constexpr int MODW = 6 * DM;

constexpr size_t MiB = 1u << 20;
constexpr size_t WS_CTL = 0, CTL_ZERO_BYTES = 1 * MiB;
constexpr size_t WS_MOD = 1 * MiB;
constexpr size_t WS_WIN = 2 * MiB;
constexpr size_t WS_WOUT = 90 * MiB;
constexpr size_t WS_WQK = 122 * MiB;
constexpr size_t WS_U = 154 * MiB;
constexpr size_t WS_V = 410 * MiB;
constexpr size_t WS_US = 540 * MiB;
constexpr size_t WS_VS = 541 * MiB;
constexpr size_t WS_POOLT = 545 * MiB;
constexpr size_t WS_LORAT = 542 * MiB;
constexpr size_t WS_X = 666 * MiB;
constexpr size_t WS_H = 730 * MiB;
constexpr size_t WS_Y = 762 * MiB;
constexpr size_t WS_PROJ = 794 * MiB;
constexpr size_t WS_GKV = 970 * MiB;
constexpr size_t WS_GS = 1006 * MiB;
constexpr size_t WS_GDEC = 1042 * MiB;
constexpr size_t WS_RSC = 1043 * MiB;
constexpr size_t WS_RO = 1187 * MiB;
constexpr size_t WS_RGATE = 1211 * MiB;
constexpr size_t WS_RBV = 1235 * MiB;
constexpr size_t WS_EIDX = 1259 * MiB;
constexpr size_t WS_EGATE = 1263 * MiB;
constexpr size_t WS_END = 1267 * MiB;
constexpr size_t WS_DUMMY = 1267 * MiB;
#ifndef PROBE
#define PROBE 0
#endif
constexpr int CW_BAR = 4096;
constexpr size_t WS_SSP = 547 * MiB;
constexpr size_t WS_BIAS3 = 546 * MiB;

constexpr int LDS_BYTES = 147456;
constexpr int MISC_OFF = 147456 - 256;

typedef unsigned short bf16;
typedef unsigned v4u __attribute__((ext_vector_type(4)));
typedef unsigned v2u __attribute__((ext_vector_type(2)));
typedef float f32x4 __attribute__((ext_vector_type(4)));
typedef float f32x2 __attribute__((ext_vector_type(2)));
typedef __bf16 bf16x2_t __attribute__((ext_vector_type(2)));
typedef int v4i __attribute__((ext_vector_type(4)));

__device__ __forceinline__ unsigned pk2(float lo, float hi) { const f32x2 f = {lo, hi}; return __builtin_bit_cast(unsigned, __builtin_convertvector(f, bf16x2_t)); }
__device__ __forceinline__ unsigned f2bf(float f) { return pk2(f, f) & 0xffffu; }
__device__ __forceinline__ float bflo(unsigned u) { return __builtin_bit_cast(float, u << 16); }
__device__ __forceinline__ float bfhi(unsigned u) { return __builtin_bit_cast(float, u & 0xffff0000u); }
__device__ __forceinline__ float dpp_xor1(float v) { return __builtin_bit_cast(float, __builtin_amdgcn_update_dpp(0, __builtin_bit_cast(int, v), 0xB1, 0xF, 0xF, true)); }
__device__ __forceinline__ float dpp_xor2(float v) { return __builtin_bit_cast(float, __builtin_amdgcn_update_dpp(0, __builtin_bit_cast(int, v), 0x4E, 0xF, 0xF, true)); }
__device__ __forceinline__ float dpp_hmir(float v) { return __builtin_bit_cast(float, __builtin_amdgcn_update_dpp(0, __builtin_bit_cast(int, v), 0x141, 0xF, 0xF, true)); }
__device__ __forceinline__ float dpp_rmir(float v) { return __builtin_bit_cast(float, __builtin_amdgcn_update_dpp(0, __builtin_bit_cast(int, v), 0x140, 0xF, 0xF, true)); }
__device__ __forceinline__ float rl_f(float v, int l) { return __builtin_bit_cast(float, __builtin_amdgcn_readlane(__builtin_bit_cast(int, v), l)); }
__device__ __forceinline__ float row16_sum(float v) { v += dpp_xor1(v); v += dpp_xor2(v); v += dpp_hmir(v); v += dpp_rmir(v); return v; }
__device__ __forceinline__ float row16_max(float v) { v = fmaxf(v, dpp_xor1(v)); v = fmaxf(v, dpp_xor2(v)); v = fmaxf(v, dpp_hmir(v)); v = fmaxf(v, dpp_rmir(v)); return v; }
__device__ __forceinline__ float wave_sum(float v) { v = row16_sum(v); return (rl_f(v, 0) + rl_f(v, 16)) + (rl_f(v, 32) + rl_f(v, 48)); }
__device__ __forceinline__ float wave_max(float v) { v = row16_max(v); return fmaxf(fmaxf(rl_f(v, 0), rl_f(v, 16)), fmaxf(rl_f(v, 32), rl_f(v, 48))); }
__device__ __forceinline__ float half32_sum(float v, int lane) { v = row16_sum(v); const float lo = rl_f(v, 0) + rl_f(v, 16), hi = rl_f(v, 32) + rl_f(v, 48); return lane < 32 ? lo : hi; }
__device__ __forceinline__ float red8(float v) { v += dpp_xor1(v); v += dpp_xor2(v); v += dpp_hmir(v); return v; }
__device__ __forceinline__ float sigmoidf_(float x) { return __builtin_amdgcn_rcpf(1.f + __builtin_amdgcn_exp2f(-1.4426950408889634f * x)); }
__device__ __forceinline__ float softplusf_(float x) { return fmaxf(x, 0.f) + 0.6931471805599453f * __builtin_amdgcn_logf(1.f + __builtin_amdgcn_exp2f(-1.4426950408889634f * fabsf(x))); }

struct Args { const float* in[30]; float* out; unsigned char* ws; };
typedef const __attribute__((address_space(4))) Args* ArgsP;
__device__ __forceinline__ ArgsP args_ptr() { ArgsP p = (ArgsP)__builtin_amdgcn_kernarg_segment_ptr(); asm volatile("" : "+s"(p)); return p; }
__device__ __forceinline__ int opaque_i(int v) { asm volatile("" : "+s"(v)); return v; }

struct Frame {
    LAS unsigned char* lds;
    int tid, lane, wave, G, bid, gw, ngw;
};
__device__ __forceinline__ Frame make_frame(LAS unsigned char* lds, int wave_s) {
    asm volatile("" : "+s"(wave_s)); Frame F; F.lds = lds; int t = tid_from(wave_s); asm volatile("" : "+v"(t));
    F.tid = t; F.lane = t & 63; F.wave = __builtin_amdgcn_readfirstlane(t >> 6); int g_ = gridDim.x, b_ = blockIdx.x; asm volatile("" : "+s"(g_), "+s"(b_)); F.G = g_; F.bid = b_; F.gw = F.bid * NWAVES + F.wave; F.ngw = F.G * NWAVES; return F;
}

struct EpiStoreF32 {
    static constexpr bool PERM = false, AFTER_DRAIN = false;
    float* C; int ldc; int ws_;
    __device__ __forceinline__ void operator()(const pg8::f32x4 (&acc)[2][2][4][2], const pg8::Unit& u, int, int, int, int) const {
        int tz = tid_from(ws_); asm volatile("" : "+v"(tz)); const int wid = tz >> 6, lane = tz & 63, wr = wid >> 2, wc = wid & 3, fr = lane & 15, fq = lane >> 4;
        const int row0 = u.pm * 256 + wr * 64 + fr, col0 = u.pn * 256 + wc * 32 + 4 * fq;
#pragma unroll
        for (int ai = 0; ai < 2; ++ai)
#pragma unroll
            for (int m = 0; m < 4; ++m) { float* rowp = C + (size_t)(row0 + ai * 128 + m * 16) * ldc + col0;
#pragma unroll
                for (int bj = 0; bj < 2; ++bj)
#pragma unroll
                    for (int n = 0; n < 2; ++n) *(pg8::f32x4*)(rowp + bj * 128 + n * 16) = acc[ai][bj][m][n]; }
    }
};
struct EpiResid {
    static constexpr bool PERM = false, AFTER_DRAIN = false;
    const float* xsrc; float* xdst; const float* gate; int ws_; const float* gain2; const float* sc2; bf16* hdst; float* ss;
    __device__ __forceinline__ void operator()(const pg8::f32x4 (&acc)[2][2][4][2], const pg8::Unit& u, int, int, int, int) const {
        int tz = tid_from(ws_); asm volatile("" : "+v"(tz)); const int wid = tz >> 6, lane = tz & 63, wr = wid >> 2, wc = wid & 3, fr = lane & 15, fq = lane >> 4;
        const int row0 = u.pm * 256 + wr * 64 + fr, col0 = u.pn * 256 + wc * 32 + 4 * fq;
        const float* gp = gate + (size_t)(u.pm >> 4) * MODW + col0; const float* sp = sc2 + (size_t)(u.pm >> 4) * MODW + col0;
        pg8::f32x4 gv[2][2], hv[2][2];
#pragma unroll
        for (int bj = 0; bj < 2; ++bj)
#pragma unroll
            for (int n = 0; n < 2; ++n) { gv[bj][n] = *(const pg8::f32x4*)(gp + bj * 128 + n * 16);
                hv[bj][n] = *(const pg8::f32x4*)(gain2 + col0 + bj * 128 + n * 16) * (*(const pg8::f32x4*)(sp + bj * 128 + n * 16) + 1.f); }
#pragma unroll
        for (int ai = 0; ai < 2; ++ai)
#pragma unroll
            for (int m = 0; m < 4; ++m) { const int row = row0 + ai * 128 + m * 16; const size_t ro = (size_t)row * DM + col0; float s = 0.f;
#pragma unroll
                for (int bj = 0; bj < 2; ++bj)
#pragma unroll
                    for (int n = 0; n < 2; ++n) { const pg8::f32x4 xv = *(const pg8::f32x4*)(xsrc + ro + bj * 128 + n * 16);
                        const pg8::f32x4 y = xv + gv[bj][n] * acc[ai][bj][m][n];
                        *(pg8::f32x4*)(xdst + ro + bj * 128 + n * 16) = y;
                        s += (y.x * y.x + y.y * y.y) + (y.z * y.z + y.w * y.w);
                        const pg8::f32x4 hh = y * hv[bj][n]; v2u pk; pk.x = pk2(hh.x, hh.y); pk.y = pk2(hh.z, hh.w); *(v2u*)(hdst + ro + bj * 128 + n * 16) = pk; }
                s += __builtin_bit_cast(float, __builtin_amdgcn_ds_bpermute((lane ^ 16) << 2, __builtin_bit_cast(int, s)));
                s += __builtin_bit_cast(float, __builtin_amdgcn_ds_bpermute((lane ^ 32) << 2, __builtin_bit_cast(int, s)));
                if (fq == 0) ss[(size_t)row * 32 + u.pn * 4 + wc] = s; }
    }
};
struct EpiScore {
    static constexpr bool PERM = false, AFTER_DRAIN = false;
    float* C; int ldc; int ws_; const LAS float* rs; const float* bias;
    __device__ __forceinline__ void operator()(const pg8::f32x4 (&acc)[2][2][4][2], const pg8::Unit& u, int, int, int, int) const {
        int tz = tid_from(ws_); asm volatile("" : "+v"(tz)); const int wid = tz >> 6, lane = tz & 63, wr = wid >> 2, wc = wid & 3, fr = lane & 15, fq = lane >> 4;
        const int row0 = u.pm * 256 + wr * 64 + fr, col0 = u.pn * 256 + wc * 32 + 4 * fq;
        const float* bp = bias + (size_t)(u.pm >> 4) * DM + col0;
        pg8::f32x4 bv[2][2];
#pragma unroll
        for (int bj = 0; bj < 2; ++bj)
#pragma unroll
            for (int n = 0; n < 2; ++n) bv[bj][n] = *(const pg8::f32x4*)(bp + bj * 128 + n * 16);
#pragma unroll
        for (int ai = 0; ai < 2; ++ai)
#pragma unroll
            for (int m = 0; m < 4; ++m) { const int row = row0 + ai * 128 + m * 16; float* rowp = C + (size_t)row * ldc + col0;
                const float rstd = rs[row & 255];
#pragma unroll
                for (int bj = 0; bj < 2; ++bj)
#pragma unroll
                    for (int n = 0; n < 2; ++n) *(pg8::f32x4*)(rowp + bj * 128 + n * 16) = acc[ai][bj][m][n] * rstd + bv[bj][n]; }
    }
};

__device__ __forceinline__ void quant_tables(ArgsP A, int l, int wvi, int nw, int lane) {
    for (int rr = wvi; rr < 2 * PEER_N; rr += nw) {
        const int tb = rr >= PEER_N, r = l * PEER_N + (rr - tb * PEER_N);
        const f32x4* src = (const f32x4*)(A->in[27 + tb] + (size_t)r * DM) + lane;
        f32x4 v[8]; float mx = 0.f;
#pragma unroll
        for (int j = 0; j < 8; ++j) { v[j] = src[64 * j]; mx = fmaxf(mx, fmaxf(fmaxf(fabsf(v[j].x), fabsf(v[j].y)), fmaxf(fabsf(v[j].z), fabsf(v[j].w)))); }
        mx = wave_max(mx);
        unsigned* dst = (unsigned*)(A->ws + (tb ? WS_V : WS_U)) + (size_t)r * (DM / 4) + lane;
        if (!tb) { const float inv = mx > 0.f ? 7.f / mx : 0.f;
            unsigned* dst4 = (unsigned*)(A->ws + WS_U) + (size_t)r * (DM / 8) + lane;
#pragma unroll
            for (int j = 0; j < 4; ++j) { unsigned wd = 0u;
                const float lo4[4] = {v[j].x, v[j].y, v[j].z, v[j].w}, hi4[4] = {v[j + 4].x, v[j + 4].y, v[j + 4].z, v[j + 4].w};
#pragma unroll
                for (int i = 0; i < 4; ++i) { const unsigned nl = (unsigned)((int)rintf(lo4[i] * inv) + 8), nh = (unsigned)((int)rintf(hi4[i] * inv) + 8); wd |= (nl | (nh << 4)) << (8 * i); }
                dst4[64 * j] = wd; }
            if (lane == 0) ((float*)(A->ws + WS_US))[r] = mx * (1.f / 7.f);
        } else { const float inv = mx > 0.f ? 240.f / mx : 0.f;
#pragma unroll
            for (int j = 0; j < 8; ++j) { int p = __builtin_amdgcn_cvt_pk_fp8_f32(v[j].x * inv, v[j].y * inv, 0, false); p = __builtin_amdgcn_cvt_pk_fp8_f32(v[j].z * inv, v[j].w * inv, p, true); dst[64 * j] = (unsigned)p; }
            if (lane == 0) ((float*)(A->ws + WS_VS))[r] = mx * (1.f / 240.f);
        }
    }
}

__device__ __forceinline__ void transpose_item(const float* W, int K, int N, bf16* WT, LAS float* scr, int kb, int nb, int lane) {
    const int k0 = 64 * kb, n0 = 64 * nb, nl = (lane & 15) * 4, kr = lane >> 4;
    f32x4 v[16];
#pragma unroll
    for (int it = 0; it < 16; ++it) v[it] = (n0 + nl < N) ? *(const f32x4*)(W + (size_t)(k0 + it * 4 + kr) * N + n0 + nl) : (f32x4){0.f, 0.f, 0.f, 0.f};
#pragma unroll
    for (int it = 0; it < 16; ++it) { LAS float* s = scr + (it * 4 + kr) * 65 + nl; s[0] = v[it].x; s[1] = v[it].y; s[2] = v[it].z; s[3] = v[it].w; }
    asm volatile("s_waitcnt lgkmcnt(0)" ::: "memory");
    const int c = lane & 7;
#pragma unroll
    for (int j = 0; j < 8; ++j) { const int n = (lane >> 3) + 8 * j; const LAS float* s = scr + (8 * c) * 65 + n;
        v4u o; o.x = pk2(s[0 * 65], s[1 * 65]); o.y = pk2(s[2 * 65], s[3 * 65]); o.z = pk2(s[4 * 65], s[5 * 65]); o.w = pk2(s[6 * 65], s[7 * 65]);
        if (n0 + n < N) *(v4u*)(WT + (size_t)(n0 + n) * K + k0 + 8 * c) = o; }
    asm volatile("s_waitcnt lgkmcnt(0)" ::: "memory");
}

__device__ __forceinline__ void ph_prologue(ArgsP A, LAS unsigned char* lds_, int wv_) {
    const Frame F = make_frame(lds_, wv_);
    LAS float* ldsf = (LAS float*)F.lds;
    const int tid = F.tid, lane = F.lane, wave = F.wave;
    for (int i = tid; i < NB * DM; i += NTHR) { const float c = A->in[1][i]; ldsf[i] = c / (1.f + __expf(-c)); }
    __syncthreads();
    {
        LAS float* red = ldsf + 4096;
        float* MOD = (float*)(A->ws + WS_MOD);
        for (int u = F.bid; u < DEPTH * 96; u += F.G) {
            const int l = u / 96, j0 = (u % 96) * 128;
            const float* W = A->in[2] + (size_t)l * DM * MODW + j0 + lane * 2;
            float a00 = 0.f, a01 = 0.f, a10 = 0.f, a11 = 0.f;
            const int k0 = wave * 256;
#pragma unroll 8
            for (int k = k0; k < k0 + 256; ++k) { const f32x2 w = *(const f32x2*)(W + (size_t)k * MODW); const float c0 = ldsf[k], c1 = ldsf[DM + k];
                a00 += c0 * w.x; a01 += c0 * w.y; a10 += c1 * w.x; a11 += c1 * w.y; }
            red[(wave * 2 + 0) * 128 + lane * 2] = a00; red[(wave * 2 + 0) * 128 + lane * 2 + 1] = a01;
            red[(wave * 2 + 1) * 128 + lane * 2] = a10; red[(wave * 2 + 1) * 128 + lane * 2 + 1] = a11;
            __syncthreads();
            if (tid < 256) { const int b = tid >> 7, j = tid & 127; float s = 0.f;
#pragma unroll
                for (int w = 0; w < 8; ++w) s += red[(w * 2 + b) * 128 + j];
                s += A->in[3][(size_t)l * MODW + j0 + j];
                MOD[(size_t)(l * 2 + b) * MODW + j0 + j] = s; }
            __syncthreads();
        }
    }
    {
        LAS float* scr = ldsf + wave * 4160;
        constexpr int NBI = (INW + 63) / 64;
        constexpr int I_IN = 32 * NBI, I_OUT = 32 * 32, I_L = I_IN + I_OUT;
        for (int it = F.gw; it < DEPTH * I_L; it += F.ngw) {
            const int l = it / I_L; int r = it % I_L;
            if (r < I_IN) transpose_item(A->in[5] + (size_t)l * DM * INW, DM, INW, (bf16*)(A->ws + WS_WIN) + (size_t)l * INWP * DM, scr, r / NBI, r % NBI, lane);
            else { r -= I_IN; transpose_item(A->in[22] + (size_t)l * DM * DM, DM, DM, (bf16*)(A->ws + WS_WOUT) + (size_t)l * DM * DM, scr, r / 32, r % 32, lane); }
        }
        constexpr int PADV = (INWP - INW) * DM / 8;
        for (int i = F.bid * NTHR + tid; i < DEPTH * PADV; i += F.G * NTHR) { const int l = i / PADV, r = i % PADV;
            ((v4u*)((bf16*)(A->ws + WS_WIN) + (size_t)l * INWP * DM + (size_t)INW * DM))[r] = (v4u){0u, 0u, 0u, 0u}; }
    }
    __syncthreads();
    {
        LAS float* Ks = ldsf;
        LAS float* Ws = ldsf + 128 * 132;
        for (int u = F.bid; u < DEPTH * 16 * 32; u += F.G) {
            const int l = u >> 9, hh = (u >> 5) & 15, jt = u & 31, h = hh >> 1, half = hh & 1, j0 = jt * 64;
            const float* ksrc = (half ? A->in[26] : A->in[25]) + ((size_t)l * 8 + h) * 128 * 128;
            const float* wsrc = A->in[24] + (size_t)l * DM * DM + h * 256 + half * 128;
            {   f32x4 kq[8], wq4[4];
#pragma unroll
                for (int it = 0; it < 8; ++it) { const int i = tid + it * NTHR, n = i >> 5, d4 = (i & 31) * 4; kq[it] = *(const f32x4*)(ksrc + n * 128 + d4); }
#pragma unroll
                for (int it = 0; it < 4; ++it) { const int i = tid + it * NTHR, jj = i >> 5, d4 = (i & 31) * 4; wq4[it] = *(const f32x4*)(wsrc + (size_t)(j0 + jj) * DM + d4); }
#pragma unroll
                for (int it = 0; it < 8; ++it) { const int i = tid + it * NTHR, n = i >> 5, d4 = (i & 31) * 4; *(LAS f32x4*)(Ks + n * 132 + d4) = kq[it]; }
#pragma unroll
                for (int it = 0; it < 4; ++it) { const int i = tid + it * NTHR, jj = i >> 5, d4 = (i & 31) * 4; *(LAS f32x4*)(Ws + jj * 132 + d4) = wq4[it]; }
            }
            __syncthreads();
            { const int li = lane & 15, lq = lane >> 4;
                f32x4 acc[4] = {{0.f, 0.f, 0.f, 0.f}, {0.f, 0.f, 0.f, 0.f}, {0.f, 0.f, 0.f, 0.f}, {0.f, 0.f, 0.f, 0.f}};
#pragma unroll 4
                for (int ks = 0; ks < 32; ++ks) { const float a = Ks[(wave * 16 + li) * 132 + 4 * ks + lq];
#pragma unroll
                    for (int jt = 0; jt < 4; ++jt) acc[jt] = __builtin_amdgcn_mfma_f32_16x16x4f32(a, Ws[(jt * 16 + li) * 132 + 4 * ks + lq], acc[jt], 0, 0, 0); }
                bf16* dst = (bf16*)(A->ws + WS_WQK) + (size_t)l * DM * DM + (size_t)(h * 256 + half * 128 + wave * 16 + lq * 4) * DM + j0 + li;
#pragma unroll
                for (int jt = 0; jt < 4; ++jt) { dst[(size_t)0 * DM + jt * 16] = (bf16)f2bf(acc[jt].x); dst[(size_t)1 * DM + jt * 16] = (bf16)f2bf(acc[jt].y); dst[(size_t)2 * DM + jt * 16] = (bf16)f2bf(acc[jt].z); dst[(size_t)3 * DM + jt * 16] = (bf16)f2bf(acc[jt].w); } }
            __syncthreads();
        }
    }
    {
        bf16* PT = (bf16*)(A->ws + WS_POOLT);
        for (int i = F.bid * NTHR + tid; i < DEPTH * 4 * 128 * 128; i += F.G * NTHR) { const int lg = i >> 14, r = i & 16383, dcol = r >> 7, c = r & 127;
            PT[i] = (bf16)f2bf(A->in[6][(size_t)lg * 16384 + c * 128 + dcol]); }
    }
    {
        bf16* LT = (bf16*)(A->ws + WS_LORAT);
        for (int i = F.bid * NTHR + tid; i < DEPTH * RW_W * 256; i += F.G * NTHR) { const int l = i / (RW_W * 256), r = i % (RW_W * 256), c = r >> 8, j = r & 255;
            const float v = j < 64 ? A->in[13][((size_t)l * 64 + j) * RW_W + c] : (j < 128 ? A->in[15][((size_t)l * 64 + (j - 64)) * RW_W + c] : A->in[16][((size_t)l * 128 + (j - 128)) * RW_W + c]);
            LT[i] = (bf16)f2bf(v); }
    }
    quant_tables(A, 0, F.gw, F.ngw, lane);
}

__device__ __forceinline__ void ph_norm(const float* xsrc, const float* gain, const float* sh, const float* sc, bf16* hout, LAS unsigned char* lds_, int wv_) {
    const Frame F = make_frame(lds_, wv_);
    for (int m = F.gw; m < NT; m += F.ngw) {
        const int b = m >> 12;
        const f32x4* xr = (const f32x4*)(xsrc + (size_t)m * DM) + F.lane;
        f32x4 v[8]; float ss = 0.f;
#pragma unroll
        for (int j = 0; j < 8; ++j) { v[j] = xr[64 * j]; ss += (v[j].x * v[j].x + v[j].y * v[j].y) + (v[j].z * v[j].z + v[j].w * v[j].w); }
        const float rstd = rsqrtf(wave_sum(ss) * (1.f / DM) + NORM_EPS);
        v2u* o8 = (v2u*)(hout + (size_t)m * DM) + F.lane;
#pragma unroll
        for (int j = 0; j < 8; ++j) { const int col = j * 256 + F.lane * 4;
            const f32x4 g = *(const f32x4*)(gain + col), s1 = *(const f32x4*)(sc + (size_t)b * MODW + col), s0 = *(const f32x4*)(sh + (size_t)b * MODW + col);
            const f32x4 y = v[j] * rstd * g * (s1 + 1.f) + s0;
            v2u o; o.x = pk2(y.x, y.y); o.y = pk2(y.z, y.w); o8[64 * j] = o; }
    }
}
__device__ __forceinline__ void ph_final(const float* xsrc, const float* gain, float* out, LAS unsigned char* lds_, int wv_) {
    const Frame F = make_frame(lds_, wv_);
    for (int m = F.gw; m < NT; m += F.ngw) {
        const f32x4* xr = (const f32x4*)(xsrc + (size_t)m * DM) + F.lane;
        f32x4 v[8]; float ss = 0.f;
#pragma unroll
        for (int j = 0; j < 8; ++j) { v[j] = xr[64 * j]; ss += (v[j].x * v[j].x + v[j].y * v[j].y) + (v[j].z * v[j].z + v[j].w * v[j].w); }
        const float rstd = rsqrtf(wave_sum(ss) * (1.f / DM) + NORM_EPS);
        f32x4* o = (f32x4*)(out + (size_t)m * DM) + F.lane;
#pragma unroll
        for (int j = 0; j < 8; ++j) { const f32x4 g = *(const f32x4*)(gain + j * 256 + F.lane * 4); o[64 * j] = v[j] * rstd * g; }
    }
}

__device__ __forceinline__ void pool_unit(ArgsP A, const Frame& F_in, int l, int unit) {
    Frame F = F_in; asm volatile("" : "+v"(F.tid)); F.lane = F.tid & 63;
    const int tile = unit >> 2, g = unit & 3, t0 = tile * 32, s0 = t0 & (SEQ - 1), tid = F.tid, lane = F.lane, w = F.wave;
    const int win = 2 << g;
    const float* proj = (const float*)(A->ws + WS_PROJ);
    LAS float* ps = (LAS float*)F.lds;
    LAS unsigned short* ds = (LAS unsigned short*)(F.lds + 24064);
    const int rt = w >> 2, ct0 = (w & 3) * 2, li = lane & 15, lq = lane >> 4;
    typedef short b8 __attribute__((ext_vector_type(8)));
    b8 bw[2][4];
    { const unsigned short* PT = (const unsigned short*)(A->ws + WS_POOLT) + ((size_t)l * 4 + g) * 16384;
#pragma unroll
        for (int j = 0; j < 2; ++j)
#pragma unroll
            for (int ks = 0; ks < 4; ++ks) bw[j][ks] = *(const b8*)(PT + (size_t)((ct0 + j) * 16 + li) * 128 + ks * 32 + lq * 8); }
    {   f32x4 pq[3];
#pragma unroll
        for (int it = 0; it < 3; ++it) { const int i = tid + it * NTHR, r = i >> 5, c4 = i & 31; const int s = s0 - 15 + r;
            pq[it] = (i < 47 * 32 && s >= 0) ? *(const f32x4*)(proj + (size_t)(t0 - 15 + r) * INWP + C_POOL + g * 128 + c4 * 4) : (f32x4){0.f, 0.f, 0.f, 0.f}; }
#pragma unroll
        for (int it = 0; it < 3; ++it) { const int i = tid + it * NTHR; if (i < 47 * 32) *(LAS f32x4*)(ps + i * 4) = pq[it]; }
    }
    __syncthreads();
    for (int i = tid; i < 32 * 128; i += NTHR) { const int tok = i >> 7, c = i & 127; float sum = 0.f;
        for (int ww = 0; ww < win; ++ww) sum += ps[(tok + 15 - ww) * 128 + c];
        const int cnt = (s0 + tok + 1) < win ? (s0 + tok + 1) : win;
        ds[tok * 136 + c] = (unsigned short)f2bf(sum * __builtin_amdgcn_rcpf((float)cnt) - ps[(tok + 15) * 128 + c]); }
    __syncthreads();
    f32x4 acc[2] = {{0.f, 0.f, 0.f, 0.f}, {0.f, 0.f, 0.f, 0.f}};
#pragma unroll
    for (int ks = 0; ks < 4; ++ks) { const b8 a = *(const LAS b8*)(ds + (rt * 16 + li) * 136 + ks * 32 + lq * 8);
#pragma unroll
        for (int j = 0; j < 2; ++j) acc[j] = __builtin_amdgcn_mfma_f32_16x16x32_bf16(a, bw[j][ks], acc[j], 0, 0, 0); }
    bf16* Y = (bf16*)(A->ws + WS_Y);
#pragma unroll
    for (int j = 0; j < 2; ++j) { const int dcol = (ct0 + j) * 16 + li; const float scale = A->in[7][(size_t)l * 512 + g * 128 + dcol]; const int tk = t0 + rt * 16 + lq * 4;
        Y[(size_t)(tk + 0) * DM + g * 128 + dcol] = (bf16)f2bf(acc[j].x * scale); Y[(size_t)(tk + 1) * DM + g * 128 + dcol] = (bf16)f2bf(acc[j].y * scale);
        Y[(size_t)(tk + 2) * DM + g * 128 + dcol] = (bf16)f2bf(acc[j].z * scale); Y[(size_t)(tk + 3) * DM + g * 128 + dcol] = (bf16)f2bf(acc[j].w * scale); }
    __syncthreads();
}

__device__ __forceinline__ void gla_bcum(ArgsP A, const Frame& F, int l, int h, int t0, LAS float* bcum, LAS float* ad, LAS float* up) {
    const float* proj = (const float*)(A->ws + WS_PROJ);
    const int tid = F.tid;
    {
        const float a0 = proj[(size_t)(t0 + (tid >> 4)) * INWP + C_GA + (tid & 15)], a1 = proj[(size_t)(t0 + 32 + (tid >> 4)) * INWP + C_GA + (tid & 15)];
        const float* upg = A->in[8] + (size_t)l * 16 * 384 + h * 96;
        const float u0 = upg[(tid / 96) * 384 + tid % 96], u1 = upg[((tid + 512) / 96) * 384 + (tid + 512) % 96], u2 = upg[((tid + 1024) / 96) * 384 + (tid + 1024) % 96];
        ad[tid] = a0; ad[tid + 512] = a1; up[tid] = u0; up[tid + 512] = u1; up[tid + 1024] = u2;
    }
    __syncthreads();
    for (int i = tid; i < 64 * 96; i += NTHR) { const int tok = i / 96, d = i % 96; float x = A->in[9][(size_t)l * 384 + h * 96 + d];
#pragma unroll
        for (int j = 0; j < 16; ++j) x += ad[tok * 16 + j] * up[j * 96 + d];
        bcum[i] = -softplusf_(-x) * (1.f / 16.f); }
    __syncthreads();
    if (tid < 384) { const int d = tid % 96, seg = tid / 96; float acc = 0.f;
#pragma unroll
        for (int k = 0; k < 16; ++k) { acc += bcum[(seg * 16 + k) * 96 + d]; bcum[(seg * 16 + k) * 96 + d] = acc; }
        ad[seg * 96 + d] = acc; }
    __syncthreads();
    if (tid < 384) { const int d = tid % 96, seg = tid / 96; float pre = 0.f;
#pragma unroll
        for (int s2 = 0; s2 < 3; ++s2) pre += (s2 < seg) ? ad[s2 * 96 + d] : 0.f;
        if (seg > 0) {
#pragma unroll
            for (int k = 0; k < 16; ++k) bcum[(seg * 16 + k) * 96 + d] += pre; } }
    __syncthreads();
}

__device__ __forceinline__ void gla_scan_unit(ArgsP A, const Frame& F, int unit) {
    const int idx = unit * NTHR + F.tid, bh = idx / 18432, rem = idx % 18432, d = rem % 96;
    const float* KV = (const float*)(A->ws + WS_GKV) + (size_t)bh * 64 * 18432 + rem;
    float* GS = (float*)(A->ws + WS_GS) + (size_t)bh * 64 * 18432 + rem;
    const float* DEC = (const float*)(A->ws + WS_GDEC) + (size_t)bh * 64 * 96 + d;
    float S = 0.f;
#pragma unroll 1
    for (int c0 = 0; c0 < 64; c0 += 16) {
        float kv[16], dc[16];
#pragma unroll
        for (int j = 0; j < 16; ++j) { kv[j] = KV[(size_t)(c0 + j) * 18432]; dc[j] = DEC[(c0 + j) * 96]; }
#pragma unroll
        for (int j = 0; j < 16; ++j) { GS[(size_t)(c0 + j) * 18432] = S; S = dc[j] * S + kv[j]; }
    }
}

typedef short bf16x8_t __attribute__((ext_vector_type(8)));
constexpr int RS = 68;
__device__ __forceinline__ f32x4 tile_mm64(const LAS bf16* Am, int arow0, const LAS bf16* Bm, int brow0, f32x4 acc, int lane) {
    const int r = lane & 15, kq = (lane >> 4) * 8;
#pragma unroll
    for (int ks = 0; ks < 2; ++ks) {
        const bf16x8_t a = *(const LAS bf16x8_t*)(Am + (arow0 + r) * RS + ks * 32 + kq);
        const bf16x8_t b = *(const LAS bf16x8_t*)(Bm + (brow0 + r) * RS + ks * 32 + kq);
        acc = __builtin_amdgcn_mfma_f32_16x16x32_bf16(a, b, acc, 0, 0, 0);
    }
    return acc;
}
constexpr int RA_BT = 0, RA_KT = 8704, RA_AT = 17408, RA_RT = 26112, RA_RABS = 34816, RA_BHT = 43520, RA_KHT = 52224, RA_VT = 60928, RA_AABS = 69632,
              RA_MBAT = 86272, RA_MKA = 103680, RA_NBRT = 121088, RA_GC = 129792, RA_WT = 130048, RA_NKRT = 132096, RA_END = 140800, RA_PRE = 94976;
constexpr int RA_Z = RA_BT, RA_QST = RA_AT, RA_QOT = RA_RT, RA_LO = 0, RA_RES = 34816;
constexpr size_t RWO_POT = 0, RWO_PST = 12 * MiB, RWO_GT = 24 * MiB, RWO_OLT = 48 * MiB, RWO_SC = 72 * MiB;

__device__ __forceinline__ void rwkvA_unit(ArgsP A, const Frame& F_in, int l, int unit) {
    Frame F = F_in; asm volatile("" : "+v"(F.tid)); F.lane = F.tid & 63;

    const int bh = unit >> 6, c = unit & 63, b = bh / RW_H, h = bh % RW_H, t0 = b * SEQ + c * 64, s0 = c * 64, tid = F.tid, lane = F.lane, w = F.wave;
    const float* proj = (const float*)(A->ws + WS_PROJ);
    const float* mu = A->in[11] + (size_t)l * RW_IN;
    LAS unsigned char* L = F.lds;
    const int n = lane, cc = h * 64 + n;
    const int rt1 = w >> 1, ct1 = (w & 1) * 2, li1 = lane & 15, lq1 = lane >> 4;
    f32x4 yc[8], yp[8];
#pragma unroll
    for (int it = 0; it < 8; ++it) { const int g = tid + it * NTHR, tok = g >> 6, j4 = (g & 63) * 4; const float* rp = proj + ((size_t)t0 + tok) * INWP + C_RW + 2304 + j4;
        yc[it] = *(const f32x4*)rp; yp[it] = (s0 + tok > 0) ? *(const f32x4*)(rp - INWP) : (f32x4){0.f, 0.f, 0.f, 0.f}; }
    bf16x8_t bw[2][8];
    { const bf16* LT = (const bf16*)(A->ws + WS_LORAT) + ((size_t)l * RW_W + h * 64) * 256;
#pragma unroll
        for (int j = 0; j < 2; ++j)
#pragma unroll
            for (int ks = 0; ks < 8; ++ks) bw[j][ks] = *(const bf16x8_t*)(LT + (size_t)((ct1 + j) * 16 + li1) * 256 + ks * 32 + lq1 * 8); }
    float rr[9], kr[9], vr[9];
#pragma unroll
    for (int i = 0; i < 9; ++i) { const int tok = w * 8 + i - 1; const bool ok = (s0 + tok >= 0); const float* row = proj + ((size_t)t0 + tok) * INWP + C_RW;
        rr[i] = ok ? row[cc] : 0.f; kr[i] = ok ? row[768 + cc] : 0.f; vr[i] = ok ? row[1536 + cc] : 0.f; }
    const float w0c = A->in[12][(size_t)l * RW_W + cc], a0c = A->in[14][(size_t)l * RW_W + cc], kkc = A->in[17][(size_t)l * RW_W + cc], kac = A->in[18][(size_t)l * RW_W + cc], rkc = A->in[19][(size_t)l * RW_W + cc];
    const float mur = mu[cc], muk = mu[768 + cc], muv = mu[1536 + cc];
    {   LAS bf16* lo = (LAS bf16*)(L + RA_LO);
#pragma unroll
        for (int it = 0; it < 8; ++it) { const int g = tid + it * NTHR, tok = g >> 6, j4 = (g & 63) * 4; const f32x4 m4 = *(const f32x4*)(mu + 2304 + j4);
            const f32x4 ym = yc[it] + (yp[it] - yc[it]) * m4;
            const float sc = j4 < 64 ? 2.f : 1.f; f32x4 sg; sg.x = sigmoidf_(ym.x * sc); sg.y = sigmoidf_(ym.y * sc); sg.z = sigmoidf_(ym.z * sc); sg.w = sigmoidf_(ym.w * sc);
            const f32x4 o = j4 < 64 ? sg * 2.f - 1.f : (j4 < 128 ? ym : sg);
            v2u pk; pk.x = pk2(o.x, o.y); pk.y = pk2(o.z, o.w); *(LAS v2u*)(lo + tok * 264 + j4) = pk; }
    }
    __syncthreads();
    {
        const int rt = rt1, ct0 = ct1, li = li1, lq = lq1;
        const LAS bf16* lo = (const LAS bf16*)(L + RA_LO);
        LAS float* res = (LAS float*)(L + RA_RES);
        f32x4 acc[3][2];
#pragma unroll
        for (int p = 0; p < 3; ++p)
#pragma unroll
            for (int j = 0; j < 2; ++j) acc[p][j] = (f32x4){0.f, 0.f, 0.f, 0.f};
#pragma unroll
        for (int ks = 0; ks < 8; ++ks) { const bf16x8_t a = *(const LAS bf16x8_t*)(lo + (rt * 16 + li) * 264 + ks * 32 + lq * 8);
            const int p = ks < 2 ? 0 : (ks < 4 ? 1 : 2);
#pragma unroll
            for (int j = 0; j < 2; ++j) acc[p][j] = __builtin_amdgcn_mfma_f32_16x16x32_bf16(a, bw[j][ks], acc[p][j], 0, 0, 0); }
#pragma unroll
        for (int p = 0; p < 3; ++p)
#pragma unroll
            for (int j = 0; j < 2; ++j) { LAS float* rp = res + p * 64 * 68 + (rt * 16 + lq * 4) * 68 + (ct0 + j) * 16 + li;
                rp[0] = acc[p][j].x; rp[68] = acc[p][j].y; rp[136] = acc[p][j].z; rp[204] = acc[p][j].w; }
    }
    __syncthreads();
    float r_[8], k_[8], v_[8], av_[8], bb_[8], lw_[8];
    {
        const LAS float* res = (const LAS float*)(L + RA_RES);
        float wl[8], al[8], gl[8];
#pragma unroll
        for (int i = 0; i < 8; ++i) { wl[i] = res[(w * 8 + i) * 68 + n]; al[i] = res[64 * 68 + (w * 8 + i) * 68 + n]; gl[i] = res[2 * 64 * 68 + (w * 8 + i) * 68 + n]; }
        float* GATE = (float*)(A->ws + WS_RGATE); float* BV = (float*)(A->ws + WS_RBV);
#pragma unroll
        for (int i = 0; i < 8; ++i) { const int tok = w * 8 + i; const size_t t = (size_t)t0 + tok;
            float r = rr[i + 1], k = kr[i + 1], v = vr[i + 1];
            r += (rr[i] - r) * mur; k += (kr[i] - k) * muk; v += (vr[i] - v) * muv;
            const float wraw = -softplusf_(-(w0c + wl[i])) - 0.5f;
            const float a = sigmoidf_(a0c + al[i]);
            float kk = k * kkc; kk = kk * __builtin_amdgcn_rsqf(fmaxf(wave_sum(kk * kk), 1e-24f));
            const float k2 = k * (1.f + (a - 1.f) * kac);
            const float bonus = wave_sum(r * k2 * rkc);
            r_[i] = r; k_[i] = k2; v_[i] = v; av_[i] = -kk; bb_[i] = kk * a; lw_[i] = -__expf(wraw);
            GATE[t * RW_W + cc] = gl[i]; BV[t * RW_W + cc] = bonus * v; }
    }
    LAS float* wt = (LAS float*)(L + RA_WT);
#pragma unroll
    for (int i = 1; i < 8; ++i) lw_[i] += lw_[i - 1];
    wt[w * 64 + n] = lw_[7];
    __syncthreads();
    float pre = 0.f, mid = 0.f, last = 0.f;
#pragma unroll
    for (int ww = 0; ww < 8; ++ww) { const float x = wt[ww * 64 + n]; pre += (ww < w) ? x : 0.f; mid += (ww < 4) ? x : 0.f; last += x; }
    {
        LAS bf16* Bt = (LAS bf16*)(L + RA_BT); LAS bf16* Kt = (LAS bf16*)(L + RA_KT); LAS bf16* At = (LAS bf16*)(L + RA_AT); LAS bf16* Rt = (LAS bf16*)(L + RA_RT);
        LAS bf16* Rab = (LAS bf16*)(L + RA_RABS); LAS bf16* BhT = (LAS bf16*)(L + RA_BHT); LAS bf16* KhT = (LAS bf16*)(L + RA_KHT); LAS bf16* VT = (LAS bf16*)(L + RA_VT);
        LAS float* AabT = (LAS float*)(L + RA_AABS);
#pragma unroll
        for (int i = 0; i < 8; ++i) { const int t = w * 8 + i; const float lw = pre + lw_[i], lwm1 = pre + (i > 0 ? lw_[i - 1] : 0.f);
            const float eg = __expf(lw - mid), egi = __expf(mid - lw), egm1 = __expf(lwm1 - mid), eh = __expf(last - lw);
            Bt[t * RS + n] = (bf16)f2bf(bb_[i] * egi); Kt[t * RS + n] = (bf16)f2bf(k_[i] * egi); At[t * RS + n] = (bf16)f2bf(av_[i] * egm1); Rt[t * RS + n] = (bf16)f2bf(r_[i] * eg);
            Rab[t * RS + n] = (bf16)f2bf(r_[i] * __expf(lw)); AabT[n * 65 + t] = av_[i] * __expf(lwm1);
            BhT[n * RS + t] = (bf16)f2bf(bb_[i] * eh); KhT[n * RS + t] = (bf16)f2bf(k_[i] * eh); VT[n * RS + t] = (bf16)f2bf(v_[i]); }
        if (w == 0) ((LAS float*)(L + RA_GC))[n] = __expf(last);
    }
    __syncthreads();
    const int rt = w >> 1, ct0 = (w & 1) * 2, li = lane & 15, lq = lane >> 4;
#define FRAG(mat_, row_, ks_) (*(const LAS bf16x8_t*)((mat_) + ((row_) + li) * RS + (ks_) * 32 + lq * 8))
#define MM(a_, b_, c_) __builtin_amdgcn_mfma_f32_16x16x32_bf16(a_, b_, c_, 0, 0, 0)
    {
        const LAS bf16* Bt = (const LAS bf16*)(L + RA_BT); const LAS bf16* Kt = (const LAS bf16*)(L + RA_KT); const LAS bf16* At = (const LAS bf16*)(L + RA_AT); const LAS bf16* Rt = (const LAS bf16*)(L + RA_RT);
        LAS bf16* MbaT = (LAS bf16*)(L + RA_MBAT); LAS float* Mka = (LAS float*)(L + RA_MKA); LAS bf16* NbrT = (LAS bf16*)(L + RA_NBRT);
        bf16x8_t aB[2], aK[2], bA[2][2], bR[2][2];
#pragma unroll
        for (int ks = 0; ks < 2; ++ks) { aB[ks] = FRAG(Bt, rt * 16, ks); aK[ks] = FRAG(Kt, rt * 16, ks);
#pragma unroll
            for (int j = 0; j < 2; ++j) { bA[j][ks] = FRAG(At, (ct0 + j) * 16, ks); bR[j][ks] = FRAG(Rt, (ct0 + j) * 16, ks); } }
#pragma unroll
        for (int j = 0; j < 2; ++j) { const int ct = ct0 + j, tcol = ct * 16 + li, srow = rt * 16 + lq * 4;
            const f32x4 z = {0.f, 0.f, 0.f, 0.f};
            f32x4 mba = MM(aB[1], bA[j][1], MM(aB[0], bA[j][0], z)), nbr = MM(aB[1], bR[j][1], MM(aB[0], bR[j][0], z));
            f32x4 mka = MM(aK[1], bA[j][1], MM(aK[0], bA[j][0], z)), nk = MM(aK[1], bR[j][1], MM(aK[0], bR[j][0], z));
            mba.x = (srow + 0 < tcol) ? mba.x : 0.f; mba.y = (srow + 1 < tcol) ? mba.y : 0.f; mba.z = (srow + 2 < tcol) ? mba.z : 0.f; mba.w = (srow + 3 < tcol) ? mba.w : 0.f;
            mka.x = (srow + 0 < tcol) ? mka.x : 0.f; mka.y = (srow + 1 < tcol) ? mka.y : 0.f; mka.z = (srow + 2 < tcol) ? mka.z : 0.f; mka.w = (srow + 3 < tcol) ? mka.w : 0.f;
            nbr.x = (srow + 0 <= tcol) ? nbr.x : 0.f; nbr.y = (srow + 1 <= tcol) ? nbr.y : 0.f; nbr.z = (srow + 2 <= tcol) ? nbr.z : 0.f; nbr.w = (srow + 3 <= tcol) ? nbr.w : 0.f;
            nk.x = (srow + 0 <= tcol) ? nk.x : 0.f; nk.y = (srow + 1 <= tcol) ? nk.y : 0.f; nk.z = (srow + 2 <= tcol) ? nk.z : 0.f; nk.w = (srow + 3 <= tcol) ? nk.w : 0.f;
            { v2u pm; pm.x = pk2(mba.x, mba.y); pm.y = pk2(mba.z, mba.w); *(LAS v2u*)(MbaT + tcol * RS + srow) = pm; }
            Mka[(srow + 0) * RS + tcol] = mka.x; Mka[(srow + 1) * RS + tcol] = mka.y; Mka[(srow + 2) * RS + tcol] = mka.z; Mka[(srow + 3) * RS + tcol] = mka.w;
            v2u pk; pk.x = pk2(nbr.x, nbr.y); pk.y = pk2(nbr.z, nbr.w); *(LAS v2u*)(NbrT + tcol * RS + srow) = pk;
            { v2u pn; pn.x = pk2(nk.x, nk.y); pn.y = pk2(nk.z, nk.w); *(LAS v2u*)((LAS bf16*)(L + RA_NKRT) + tcol * RS + srow) = pn; } }
    }
    __syncthreads();
    {
        int t4 = tid; asm volatile("" : "+v"(t4)); const int row = t4 >> 2, q = t4 & 3, l4 = t4 & 63, li4 = l4 & 15, lq4 = l4 >> 4;
        const LAS bf16* MbaT = (const LAS bf16*)(L + RA_MBAT);
        const LAS float* Yrow = (row < 64) ? ((const LAS float*)(L + RA_AABS) + row * 65) : ((const LAS float*)(L + RA_MKA) + (row - 64) * RS);
        LAS bf16* Z = (LAS bf16*)(L + RA_Z); LAS float* pre = (LAS float*)(L + RA_PRE);
        for (int i = t4; i < 1088; i += NTHR) ((LAS v4u*)Z)[i] = (v4u){0u, 0u, 0u, 0u};
        __syncthreads();
#pragma unroll 1
        for (int jb = 0; jb < 4; ++jb) {
            if (jb > 0) {
                f32x4 acc = {0.f, 0.f, 0.f, 0.f};
#pragma unroll
                for (int ks = 0; ks < 2; ++ks) { const bf16x8_t a = *(const LAS bf16x8_t*)(Z + (w * 16 + li4) * RS + ks * 32 + lq4 * 8);
                    const bf16x8_t bm = *(const LAS bf16x8_t*)(MbaT + (jb * 16 + li4) * RS + ks * 32 + lq4 * 8);
                    acc = __builtin_amdgcn_mfma_f32_16x16x32_bf16(a, bm, acc, 0, 0, 0); }
                LAS float* pp = pre + (w * 16 + lq4 * 4) * 16 + li4;
                pp[0] = acc.x; pp[16] = acc.y; pp[32] = acc.z; pp[48] = acc.w;
                __syncthreads();
            }
            float yv[16]; v2u mv[16];
#pragma unroll
            for (int u = 0; u < 16; ++u) { yv[u] = Yrow[jb * 16 + u] + (jb > 0 ? pre[row * 16 + u] : 0.f); mv[u] = *(const LAS v2u*)(MbaT + (jb * 16 + u) * RS + jb * 16 + q * 4); }
            float zb[4] = {0.f, 0.f, 0.f, 0.f};
#pragma unroll
            for (int u = 0; u < 16; ++u) {
                float part = (zb[0] * bflo(mv[u].x) + zb[1] * bfhi(mv[u].x)) + (zb[2] * bflo(mv[u].y) + zb[3] * bfhi(mv[u].y));
                part += dpp_xor1(part); part += dpp_xor2(part);
                const float zt = yv[u] + part;
                zb[u & 3] = (q == (u >> 2)) ? zt : zb[u & 3];
            }
            { v2u pk; pk.x = pk2(zb[0], zb[1]); pk.y = pk2(zb[2], zb[3]); *(LAS v2u*)(Z + row * RS + jb * 16 + q * 4) = pk; }
            __syncthreads();
        }
    }
    {
        int t5 = tid; asm volatile("" : "+v"(t5)); const int li = t5 & 15, lq = (t5 >> 4) & 3;
        const LAS bf16* Z = (const LAS bf16*)(L + RA_Z); const LAS bf16* NbrT = (const LAS bf16*)(L + RA_NBRT); const LAS bf16* BhT = (const LAS bf16*)(L + RA_BHT);
        const LAS bf16* Rab = (const LAS bf16*)(L + RA_RABS); const LAS bf16* KhT = (const LAS bf16*)(L + RA_KHT); const LAS float* gC = (const LAS float*)(L + RA_GC);
        LAS bf16* QsT = (LAS bf16*)(L + RA_QST); LAS bf16* QoT = (LAS bf16*)(L + RA_QOT);
        bf16* PoT = (bf16*)(A->ws + WS_RSC + RWO_POT) + (size_t)unit * 4096; bf16* PsT = (bf16*)(A->ws + WS_RSC + RWO_PST) + (size_t)unit * 4096;
        bf16x8_t zW[2], zX[2], bN[2][2], bH[2][2]; v2u rb[2], kb[2], nb2[2]; float gc[2];
#pragma unroll
        for (int ks = 0; ks < 2; ++ks) { zW[ks] = FRAG(Z, rt * 16, ks); zX[ks] = FRAG(Z, 64 + rt * 16, ks);
#pragma unroll
            for (int j = 0; j < 2; ++j) { bN[j][ks] = FRAG(NbrT, (ct0 + j) * 16, ks); bH[j][ks] = FRAG(BhT, (ct0 + j) * 16, ks); } }
#pragma unroll
        for (int j = 0; j < 2; ++j) { const int col = (ct0 + j) * 16 + li, rw = rt * 16 + lq * 4; rb[j] = *(const LAS v2u*)(Rab + col * RS + rw); kb[j] = *(const LAS v2u*)(KhT + col * RS + rw); nb2[j] = *(const LAS v2u*)((const LAS bf16*)(L + RA_NKRT) + col * RS + rw); gc[j] = gC[col]; }
#pragma unroll
        for (int j = 0; j < 2; ++j) { const int col = (ct0 + j) * 16 + li, rw = rt * 16 + lq * 4;
            { f32x4 acc = {bflo(rb[j].x), bfhi(rb[j].x), bflo(rb[j].y), bfhi(rb[j].y)};
                acc = MM(zW[1], bN[j][1], MM(zW[0], bN[j][0], acc));
                v2u pk; pk.x = pk2(acc.x, acc.y); pk.y = pk2(acc.z, acc.w); *(v2u*)(PoT + (size_t)col * 64 + rw) = pk; }
            { f32x4 acc = {(rw + 0 == col) ? gc[j] : 0.f, (rw + 1 == col) ? gc[j] : 0.f, (rw + 2 == col) ? gc[j] : 0.f, (rw + 3 == col) ? gc[j] : 0.f};
                acc = MM(zW[1], bH[j][1], MM(zW[0], bH[j][0], acc));
                v2u pk; pk.x = pk2(acc.x, acc.y); pk.y = pk2(acc.z, acc.w); *(v2u*)(PsT + (size_t)col * 64 + rw) = pk; }
            { f32x4 acc = {bflo(nb2[j].x), bfhi(nb2[j].x), bflo(nb2[j].y), bfhi(nb2[j].y)};
                acc = MM(zX[1], bN[j][1], MM(zX[0], bN[j][0], acc));
                v2u pk; pk.x = pk2(acc.x, acc.y); pk.y = pk2(acc.z, acc.w); *(LAS v2u*)(QoT + col * RS + rw) = pk; }
            { f32x4 acc = {bflo(kb[j].x), bfhi(kb[j].x), bflo(kb[j].y), bfhi(kb[j].y)};
                acc = MM(zX[1], bH[j][1], MM(zX[0], bH[j][0], acc));
                v2u pk; pk.x = pk2(acc.x, acc.y); pk.y = pk2(acc.z, acc.w); *(LAS v2u*)(QsT + col * RS + rw) = pk; }
        }
    }
    __syncthreads();
    {
        int t6 = tid; asm volatile("" : "+v"(t6)); const int li = t6 & 15, lq = (t6 >> 4) & 3;
        const LAS bf16* VT = (const LAS bf16*)(L + RA_VT);
        const bool isO = (w & 1);
        const LAS bf16* Bm = (const LAS bf16*)(L + (isO ? RA_QOT : RA_QST));
        float* dst = (float*)(A->ws + WS_RSC + (isO ? RWO_OLT : RWO_GT)) + (size_t)unit * 4096;
        bf16x8_t av[2], bq[4][2];
#pragma unroll
        for (int ks = 0; ks < 2; ++ks) { av[ks] = FRAG(VT, rt * 16, ks);
#pragma unroll
            for (int j = 0; j < 4; ++j) bq[j][ks] = FRAG(Bm, j * 16, ks); }
#pragma unroll
        for (int j = 0; j < 4; ++j) { const f32x4 z = {0.f, 0.f, 0.f, 0.f};
            const f32x4 acc = MM(av[1], bq[j][1], MM(av[0], bq[j][0], z));
            *(f32x4*)(dst + (size_t)(j * 16 + li) * 64 + rt * 16 + lq * 4) = acc; }
    }
#undef FRAG
#undef MM
    __syncthreads();
}

__device__ __forceinline__ void rwkvB_scan(ArgsP A, const Frame& F, int unit) {
    const int bh = unit >> 2, rq = unit & 3;
    const int tid = F.tid, lane = F.lane, w = F.wave, ct = w & 3, li = lane & 15, lq = lane >> 4;
    const bool writer = (w < 4);
    const bf16* PsT = (const bf16*)(A->ws + WS_RSC + RWO_PST) + (size_t)bh * 64 * 4096; const float* GT = (const float*)(A->ws + WS_RSC + RWO_GT) + (size_t)bh * 64 * 4096;
    bf16* SC = (bf16*)(A->ws + WS_RSC + RWO_SC) + (size_t)bh * 64 * 4096;
    f32x4 S = {0.f, 0.f, 0.f, 0.f};
    constexpr int PF = 4;
    bf16x8_t pb[PF][2]; f32x4 gq[PF];
    const int col = ct * 16 + li;
#define SLOAD(slot, cc_) do { _Pragma("unroll") for (int ks = 0; ks < 2; ++ks) pb[slot][ks] = *(const bf16x8_t*)(PsT + (size_t)(cc_) * 4096 + (size_t)col * 64 + ks * 32 + lq * 8); \
        gq[slot] = *(const f32x4*)(GT + (size_t)(cc_) * 4096 + (size_t)col * 64 + rq * 16 + lq * 4); } while (0)
#define SSTEP(slot, cc_) do { LAS bf16* Sl = (LAS bf16*)(F.lds + ((cc_) & 1) * 2176); \
        if (writer) { const int rw_ = lq * 4; Sl[(rw_ + 0) * RS + col] = (bf16)f2bf(S.x); Sl[(rw_ + 1) * RS + col] = (bf16)f2bf(S.y); Sl[(rw_ + 2) * RS + col] = (bf16)f2bf(S.z); Sl[(rw_ + 3) * RS + col] = (bf16)f2bf(S.w); } \
        asm volatile("s_waitcnt lgkmcnt(0)" ::: "memory"); __builtin_amdgcn_s_barrier(); asm volatile("" ::: "memory");        \
        if (tid < 128) { const int v_ = tid >> 3, k8_ = (tid & 7) * 8; *(v4u*)(SC + (size_t)(cc_) * 4096 + (rq * 16 + v_) * 64 + k8_) = *(const LAS v4u*)(Sl + v_ * RS + k8_); } \
        f32x4 acc_ = gq[slot]; \
        _Pragma("unroll") for (int ks = 0; ks < 2; ++ks) { const bf16x8_t a_ = *(const LAS bf16x8_t*)(Sl + li * RS + ks * 32 + lq * 8); \
            acc_ = __builtin_amdgcn_mfma_f32_16x16x32_bf16(a_, pb[slot][ks], acc_, 0, 0, 0); } \
        S = acc_; } while (0)
    SLOAD(0, 0); SLOAD(1, 1); SLOAD(2, 2); SLOAD(3, 3);
#pragma unroll 1
    for (int c = 0; c < 64; c += 4) {
        const int cn = (c + 4 < 64) ? c + 4 : 60;
        SSTEP(0, c);     SLOAD(0, cn);
        SSTEP(1, c + 1); SLOAD(1, cn + 1);
        SSTEP(2, c + 2); SLOAD(2, cn + 2);
        SSTEP(3, c + 3); SLOAD(3, cn + 3);
    }
#undef SLOAD
#undef SSTEP
    __syncthreads();
}

__device__ __forceinline__ void rwkvC_unit(ArgsP A, const Frame& F_in, int l, int unit) {
    Frame F = F_in; asm volatile("" : "+v"(F.tid)); F.lane = F.tid & 63;

    const int bh = unit >> 6, c = unit & 63, b = bh / RW_H, h = bh % RW_H, t0 = b * SEQ + c * 64, tid = F.tid, lane = F.lane, w = F.wave;
    const int rt = w >> 1, ct0 = (w & 1) * 2, li = lane & 15, lq = lane >> 4;
    LAS bf16* Sl = (LAS bf16*)F.lds; LAS bf16* Pl = (LAS bf16*)(F.lds + 8704); LAS float* ob = (LAS float*)(F.lds + 17408);
    { const int r = tid >> 3, k8 = (tid & 7) * 8;
        *(LAS v4u*)(Sl + r * RS + k8) = *(const v4u*)((const bf16*)(A->ws + WS_RSC + RWO_SC) + (size_t)unit * 4096 + r * 64 + k8);
        *(LAS v4u*)(Pl + r * RS + k8) = *(const v4u*)((const bf16*)(A->ws + WS_RSC + RWO_POT) + (size_t)unit * 4096 + r * 64 + k8); }
    __syncthreads();
    const float* OlT = (const float*)(A->ws + WS_RSC + RWO_OLT) + (size_t)unit * 4096;
#pragma unroll
    for (int j = 0; j < 2; ++j) { const int tcol = (ct0 + j) * 16 + li, vr = rt * 16 + lq * 4;
        f32x4 acc = *(const f32x4*)(OlT + (size_t)tcol * 64 + vr);
        acc = tile_mm64(Sl, rt * 16, Pl, (ct0 + j) * 16, acc, lane);
        *(LAS f32x4*)(ob + tcol * 68 + vr) = acc; }
    __syncthreads();
    { const int t = tid >> 3, q = tid & 7; const size_t tg = (size_t)t0 + t;
        const f32x4 o0 = *(const LAS f32x4*)(ob + t * 68 + q * 8), o1 = *(const LAS f32x4*)(ob + t * 68 + q * 8 + 4);
        const float mean = red8((o0.x + o0.y) + (o0.z + o0.w) + (o1.x + o1.y) + (o1.z + o1.w)) * (1.f / 64.f);
        const f32x4 d0 = o0 - mean, d1 = o1 - mean;
        const float var = red8((d0.x * d0.x + d0.y * d0.y) + (d0.z * d0.z + d0.w * d0.w) + (d1.x * d1.x + d1.y * d1.y) + (d1.z * d1.z + d1.w * d1.w)) * (1.f / 64.f);
        const float rs = rsqrtf(var + 64e-5f);
        const int cc = h * 64 + q * 8;
        const f32x4 g0 = *(const f32x4*)(A->in[20] + (size_t)l * RW_W + cc), g1 = *(const f32x4*)(A->in[20] + (size_t)l * RW_W + cc + 4);
        const f32x4 b0 = *(const f32x4*)(A->in[21] + (size_t)l * RW_W + cc), b1 = *(const f32x4*)(A->in[21] + (size_t)l * RW_W + cc + 4);
        const f32x4 bv0 = *(const f32x4*)((const float*)(A->ws + WS_RBV) + tg * RW_W + cc), bv1 = *(const f32x4*)((const float*)(A->ws + WS_RBV) + tg * RW_W + cc + 4);
        const f32x4 ga0 = *(const f32x4*)((const float*)(A->ws + WS_RGATE) + tg * RW_W + cc), ga1 = *(const f32x4*)((const float*)(A->ws + WS_RGATE) + tg * RW_W + cc + 4);
        const f32x4 y0 = (d0 * rs * g0 + b0 + bv0) * ga0, y1 = (d1 * rs * g1 + b1 + bv1) * ga1;
        v4u o; o.x = pk2(y0.x, y0.y); o.y = pk2(y0.z, y0.w); o.z = pk2(y1.x, y1.y); o.w = pk2(y1.z, y1.w);
        *(v4u*)((bf16*)(A->ws + WS_Y) + tg * DM + 1280 + cc) = o; }
    __syncthreads();
}

constexpr size_t RWO_GQ = 84 * MiB, RWO_GK = 92 * MiB, RWO_GVT = 100 * MiB, RWO_GEM = 116 * MiB;
constexpr int GQS = 104, GTS = 72;
template <int NKS> __device__ __forceinline__ f32x4 tile_mm(const LAS bf16* Am, int sa, int arow0, const LAS bf16* Bm, int sb, int brow0, f32x4 acc, int lane) {
    const int r = lane & 15, kq = (lane >> 4) * 8;
#pragma unroll
    for (int ks = 0; ks < NKS; ++ks) {
        const bf16x8_t a = *(const LAS bf16x8_t*)(Am + (arow0 + r) * sa + ks * 32 + kq);
        const bf16x8_t b = *(const LAS bf16x8_t*)(Bm + (brow0 + r) * sb + ks * 32 + kq);
        acc = __builtin_amdgcn_mfma_f32_16x16x32_bf16(a, b, acc, 0, 0, 0);
    }
    return acc;
}

__device__ __forceinline__ int gsw(int row) { return ((row >> 2) ^ (row >> 5)) & 7; }
__device__ __forceinline__ f32x4 tile_mm_sw(const LAS bf16* Am, int arow0, const LAS bf16* Bm, int brow0, f32x4 acc, int lane) {
    const int r = lane & 15, cq = lane >> 4, fa = gsw(arow0 + r), fb = gsw(brow0 + r);
#pragma unroll
    for (int ks = 0; ks < 2; ++ks) {
        const bf16x8_t a = *(const LAS bf16x8_t*)(Am + (arow0 + r) * GTS + (((ks * 4 + cq) ^ fa) << 3));
        const bf16x8_t b = *(const LAS bf16x8_t*)(Bm + (brow0 + r) * GTS + (((ks * 4 + cq) ^ fb) << 3));
        acc = __builtin_amdgcn_mfma_f32_16x16x32_bf16(a, b, acc, 0, 0, 0);
    }
    return acc;
}
__device__ __forceinline__ void gla1_unit(ArgsP A, const Frame& F_in, int l, int unit) {
    Frame F = F_in; asm volatile("" : "+v"(F.tid)); F.lane = F.tid & 63;
    const int bh = unit >> 6, c = unit & 63, b = bh >> 2, h = bh & 3, t0 = b * SEQ + c * 64, tid = F.tid, lane = F.lane, w = F.wave;
    const float* proj = (const float*)(A->ws + WS_PROJ);
    LAS float* bcum = (LAS float*)F.lds;
    LAS float* ad = bcum + 6144;
    LAS float* up = ad + 1024;
    LAS bf16* KtT = (LAS bf16*)(F.lds + 34816);
    LAS bf16* VT = (LAS bf16*)(F.lds + 48640);
    f32x4 qq[3], kq[3], vq[6];
#pragma unroll
    for (int it = 0; it < 3; ++it) { const int i = tid + it * NTHR, tok = i / 24, d4 = i % 24; const float* rp = proj + (size_t)(t0 + tok) * INWP + h * 96 + d4 * 4;
        qq[it] = *(const f32x4*)(rp + C_GQ); kq[it] = *(const f32x4*)(rp + C_GK); }
#pragma unroll
    for (int it = 0; it < 6; ++it) { const int i = tid + it * NTHR, tok = i / 48, e4 = i % 48; vq[it] = *(const f32x4*)(proj + (size_t)(t0 + tok) * INWP + C_GV + h * 192 + e4 * 4); }
    gla_bcum(A, F, l, h, t0, bcum, ad, up);
    const float qs = 0.10206207261596575f;
    bf16* Qg = (bf16*)(A->ws + WS_RSC + RWO_GQ) + (size_t)unit * 6144; bf16* Kg = (bf16*)(A->ws + WS_RSC + RWO_GK) + (size_t)unit * 6144;
#pragma unroll
    for (int it = 0; it < 3; ++it) { const int i = tid + it * NTHR, tok = i / 24, d = (i % 24) * 4;
        const float qv[4] = {qq[it].x, qq[it].y, qq[it].z, qq[it].w}, kv[4] = {kq[it].x, kq[it].y, kq[it].z, kq[it].w}; float qo[4], ko[4];
#pragma unroll
        for (int e = 0; e < 4; ++e) { const float m = bcum[31 * 96 + d + e], bb = bcum[tok * 96 + d + e];
            qo[e] = qv[e] * qs * __expf(bb - m); ko[e] = kv[e] * __expf(m - bb); KtT[(d + e) * GTS + ((((tok >> 3) ^ gsw(d + e)) << 3) | (tok & 7))] = (bf16)f2bf(ko[e]); }
        v2u pq, pk; pq.x = pk2(qo[0], qo[1]); pq.y = pk2(qo[2], qo[3]); pk.x = pk2(ko[0], ko[1]); pk.y = pk2(ko[2], ko[3]);
        *(v2u*)(Qg + tok * 96 + d) = pq; *(v2u*)(Kg + tok * 96 + d) = pk; }
#pragma unroll
    for (int it = 0; it < 6; ++it) { const int i = tid + it * NTHR, tok = i / 48, e = (i % 48) * 4;
        const int ts = tok >> 3, tl = tok & 7;
        VT[(e + 0) * GTS + (((ts ^ gsw(e + 0)) << 3) | tl)] = (bf16)f2bf(vq[it].x); VT[(e + 1) * GTS + (((ts ^ gsw(e + 1)) << 3) | tl)] = (bf16)f2bf(vq[it].y);
        VT[(e + 2) * GTS + (((ts ^ gsw(e + 2)) << 3) | tl)] = (bf16)f2bf(vq[it].z); VT[(e + 3) * GTS + (((ts ^ gsw(e + 3)) << 3) | tl)] = (bf16)f2bf(vq[it].w); }
    if (tid < 96) { ((float*)(A->ws + WS_RSC + RWO_GEM))[(size_t)unit * 96 + tid] = __expf(bcum[31 * 96 + tid]);
        ((float*)(A->ws + WS_GDEC))[(size_t)unit * 96 + tid] = __expf(bcum[63 * 96 + tid]); }
    __syncthreads();
    { bf16* VTg = (bf16*)(A->ws + WS_RSC + RWO_GVT) + (size_t)unit * 12288;
#pragma unroll
        for (int it = 0; it < 3; ++it) { const int i = tid + it * NTHR, e = i >> 3, t8 = (i & 7) * 8; *(v4u*)(VTg + e * 64 + t8) = *(const LAS v4u*)(VT + e * GTS + ((((i & 7) ^ gsw(e))) << 3)); } }
    { const int li = lane & 15, lq = lane >> 4;
        float* KVg = (float*)(A->ws + WS_GKV) + (size_t)unit * 18432;
#pragma unroll
        for (int a = 0; a < 3; ++a) { const int dt = (w & 1) * 3 + a, d0 = dt * 16 + lq * 4;
            const float s0 = __expf(bcum[63 * 96 + d0] - bcum[31 * 96 + d0]), s1 = __expf(bcum[63 * 96 + d0 + 1] - bcum[31 * 96 + d0 + 1]),
                        s2 = __expf(bcum[63 * 96 + d0 + 2] - bcum[31 * 96 + d0 + 2]), s3 = __expf(bcum[63 * 96 + d0 + 3] - bcum[31 * 96 + d0 + 3]);
#pragma unroll
            for (int bb = 0; bb < 3; ++bb) { const int et = (w >> 1) * 3 + bb; const f32x4 z = {0.f, 0.f, 0.f, 0.f};
                f32x4 acc = tile_mm_sw(KtT, dt * 16, VT, et * 16, z, lane);
                acc.x *= s0; acc.y *= s1; acc.z *= s2; acc.w *= s3;
                *(f32x4*)(KVg + (size_t)(et * 16 + li) * 96 + d0) = acc; } } }
    __syncthreads();
}

__device__ __forceinline__ void gla3_unit(ArgsP A, const Frame& F_in, int l, int unit) {
    Frame F = F_in; asm volatile("" : "+v"(F.tid)); F.lane = F.tid & 63;
    const int bh = unit >> 6, c = unit & 63, b = bh >> 2, h = bh & 3, t0 = b * SEQ + c * 64, tid = F.tid, lane = F.lane, w = F.wave;
    const int li = lane & 15, lq = lane >> 4;
    const float* proj = (const float*)(A->ws + WS_PROJ);
    LAS bf16* Qs = (LAS bf16*)F.lds;
    LAS bf16* Ks = (LAS bf16*)(F.lds + 13312);
    LAS bf16* VT = (LAS bf16*)(F.lds + 26624);
    LAS bf16* ST = (LAS bf16*)(F.lds + 54272);
    LAS bf16* att = (LAS bf16*)(F.lds + 94208);
    LAS float* ssq = (LAS float*)(F.lds + 103424);
    LAS float* em = (LAS float*)(F.lds + 103936);
    LAS float* ob = (LAS float*)(F.lds + 26624);
    {
        const v4u* Qg = (const v4u*)((const bf16*)(A->ws + WS_RSC + RWO_GQ) + (size_t)unit * 6144); const v4u* Kg = (const v4u*)((const bf16*)(A->ws + WS_RSC + RWO_GK) + (size_t)unit * 6144);
        const v4u* VTg = (const v4u*)((const bf16*)(A->ws + WS_RSC + RWO_GVT) + (size_t)unit * 12288);
        const f32x4* GS = (const f32x4*)((const float*)(A->ws + WS_GS) + (size_t)unit * 18432);
        v4u q0 = Qg[tid], k0 = Kg[tid], q1 = {0u, 0u, 0u, 0u}, k1 = {0u, 0u, 0u, 0u};
        if (tid < 256) { q1 = Qg[512 + tid]; k1 = Kg[512 + tid]; }
        v4u vt[3]; f32x4 sg[9];
#pragma unroll
        for (int it = 0; it < 3; ++it) vt[it] = VTg[tid + it * NTHR];
#pragma unroll
        for (int it = 0; it < 9; ++it) sg[it] = GS[tid + it * NTHR];
        if (tid < 96) em[tid] = ((const float*)(A->ws + WS_RSC + RWO_GEM))[(size_t)unit * 96 + tid];
        { const int i = tid, t = i / 12, c8 = (i % 12) * 8; *(LAS v4u*)(Qs + t * GQS + c8) = q0; *(LAS v4u*)(Ks + t * GQS + c8) = k0; }
        if (tid < 256) { const int i = 512 + tid, t = i / 12, c8 = (i % 12) * 8; *(LAS v4u*)(Qs + t * GQS + c8) = q1; *(LAS v4u*)(Ks + t * GQS + c8) = k1; }
#pragma unroll
        for (int it = 0; it < 3; ++it) { const int i = tid + it * NTHR, e = i >> 3, t8 = (i & 7) * 8; *(LAS v4u*)(VT + e * GTS + t8) = vt[it]; }
        __syncthreads();
#pragma unroll
        for (int it = 0; it < 9; ++it) { const int i = tid + it * NTHR, e = i / 24, d = (i % 24) * 4; const f32x4 m4 = *(const LAS f32x4*)(em + d);
            v2u pk; pk.x = pk2(sg[it].x * m4.x, sg[it].y * m4.y); pk.y = pk2(sg[it].z * m4.z, sg[it].w * m4.w); *(LAS v2u*)(ST + e * GQS + d) = pk; }
    }
    __syncthreads();
#pragma unroll
    for (int a = 0; a < 2; ++a) { const int jt = w >> 1, it = (w & 1) * 2 + a; const f32x4 z = {0.f, 0.f, 0.f, 0.f};
        f32x4 acc = z;
        if (jt <= it) acc = tile_mm<3>(Ks, GQS, jt * 16, Qs, GQS, it * 16, z, lane);
        const int i = it * 16 + li, j0 = jt * 16 + lq * 4;
        acc.x = (j0 + 0 <= i) ? acc.x : 0.f; acc.y = (j0 + 1 <= i) ? acc.y : 0.f; acc.z = (j0 + 2 <= i) ? acc.z : 0.f; acc.w = (j0 + 3 <= i) ? acc.w : 0.f;
        v2u pk; pk.x = pk2(acc.x, acc.y); pk.y = pk2(acc.z, acc.w); *(LAS v2u*)(att + i * GTS + j0) = pk; }
    __syncthreads();
    f32x4 o[6];
    { const int it = w >> 1;
#pragma unroll
        for (int a = 0; a < 6; ++a) { const int et = (w & 1) * 6 + a; const f32x4 z = {0.f, 0.f, 0.f, 0.f};
            f32x4 acc = tile_mm<2>(att, GTS, it * 16, VT, GTS, et * 16, z, lane);
            o[a] = tile_mm<3>(Qs, GQS, it * 16, ST, GQS, et * 16, acc, lane); }
        float s0 = 0.f, s1 = 0.f, s2 = 0.f, s3 = 0.f;
#pragma unroll
        for (int a = 0; a < 6; ++a) { s0 += o[a].x * o[a].x; s1 += o[a].y * o[a].y; s2 += o[a].z * o[a].z; s3 += o[a].w * o[a].w; }
        s0 = row16_sum(s0); s1 = row16_sum(s1); s2 = row16_sum(s2); s3 = row16_sum(s3);
        if (li == 0) { const int r0 = it * 16 + lq * 4; ssq[(r0 + 0) * 2 + (w & 1)] = s0; ssq[(r0 + 1) * 2 + (w & 1)] = s1; ssq[(r0 + 2) * 2 + (w & 1)] = s2; ssq[(r0 + 3) * 2 + (w & 1)] = s3; }
    }
    __syncthreads();
    { const int it = w >> 1, r0 = it * 16 + lq * 4;
#pragma unroll
        for (int a = 0; a < 6; ++a) { const int e = ((w & 1) * 6 + a) * 16 + li;
            ob[(r0 + 0) * 196 + e] = o[a].x; ob[(r0 + 1) * 196 + e] = o[a].y; ob[(r0 + 2) * 196 + e] = o[a].z; ob[(r0 + 3) * 196 + e] = o[a].w; } }
    __syncthreads();
    { bf16* Y = (bf16*)(A->ws + WS_Y);
        f32x4 gv[6];
#pragma unroll
        for (int k = 0; k < 6; ++k) { const int i = tid + k * NTHR, t = i / 48, e = (i % 48) * 4; gv[k] = *(const f32x4*)(proj + (size_t)(t0 + t) * INWP + C_GG + h * 192 + e); }
#pragma unroll
        for (int k = 0; k < 6; ++k) { const int i = tid + k * NTHR, t = i / 48, e = (i % 48) * 4;
            const float rstd = rsqrtf((ssq[t * 2] + ssq[t * 2 + 1]) * (1.f / 192.f) + NORM_EPS);
            const f32x4 ov = *(const LAS f32x4*)(ob + t * 196 + e); const f32x4 ng = *(const f32x4*)(A->in[10] + (size_t)l * 768 + h * 192 + e);
            f32x4 y; y.x = ov.x * rstd * ng.x * gv[k].x * sigmoidf_(gv[k].x); y.y = ov.y * rstd * ng.y * gv[k].y * sigmoidf_(gv[k].y);
            y.z = ov.z * rstd * ng.z * gv[k].z * sigmoidf_(gv[k].z); y.w = ov.w * rstd * ng.w * gv[k].w * sigmoidf_(gv[k].w);
            v2u pk; pk.x = pk2(y.x, y.y); pk.y = pk2(y.z, y.w); *(v2u*)(Y + (size_t)(t0 + t) * DM + 512 + h * 192 + e) = pk; } }
    __syncthreads();
}

#define INS16(L, P, x, px) do { { const bool c_ = (x) > L[15]; L[15] = c_ ? (x) : L[15]; P[15] = c_ ? (px) : P[15]; } \
    _Pragma("unroll") for (int r_ = 14; r_ >= 0; --r_) { const bool c_ = L[r_ + 1] > L[r_]; const float tl_ = L[r_]; const int tp_ = P[r_]; \
        L[r_] = c_ ? L[r_ + 1] : tl_; L[r_ + 1] = c_ ? tl_ : L[r_ + 1]; P[r_] = c_ ? P[r_ + 1] : tp_; P[r_ + 1] = c_ ? tp_ : P[r_ + 1]; } } while (0)

__device__ __forceinline__ float gelu_as(float v) {
    const float av = fabsf(v), t = __builtin_amdgcn_rcpf(av * 0.2316418882f + 1.0f);
    float q = t * 0.5307027145f + (-0.7265760135f); q = q * t + 0.7107068705f; q = q * t + (-0.142248368f); q = q * t + 0.127414796f; q = q * t;
    const float e = __builtin_amdgcn_exp2f((v * v) * (-0.72134752044f));
    const float m = v * (q * e);
    return v < 0.f ? m : v - m;
}
__device__ __forceinline__ int row16_sum_i(int v) {
    v += __builtin_amdgcn_update_dpp(0, v, 0xB1, 0xF, 0xF, true); v += __builtin_amdgcn_update_dpp(0, v, 0x4E, 0xF, 0xF, true);
    v += __builtin_amdgcn_update_dpp(0, v, 0x141, 0xF, 0xF, true); v += __builtin_amdgcn_update_dpp(0, v, 0x140, 0xF, 0xF, true); return v;
}
__device__ __forceinline__ void ph_peer2(ArgsP A, LAS unsigned char* lds_, int wv_, int l, const float* g2, const float* sh2, const float* ngain, const float* nsh, const float* nsc, const bool last, const bool dry = false) {
    const Frame F = make_frame(lds_, wv_);
    const int lane = F.lane;
    const float* SCO = (const float*)(A->ws + WS_PROJ);
    const unsigned char* U8 = A->ws + WS_U + (size_t)l * PEER_N * DM; const unsigned char* V8 = A->ws + WS_V + (size_t)l * PEER_N * DM;
    const float* US = (const float*)(A->ws + WS_US) + (size_t)l * PEER_N; const float* VS = (const float*)(A->ws + WS_VS) + (size_t)l * PEER_N;
    float* X = (float*)(A->ws + WS_X); bf16* H = (bf16*)(A->ws + WS_H); const float* ssr = (const float*)(A->ws + WS_SSP) + (size_t)l * NT * 32;
    LAS int* es = (LAS int*)F.lds + F.wave * 2048; LAS float* gs = (LAS float*)F.lds + F.wave * 2048 + 1024;
    LAS v4u* hl = (LAS v4u*)(F.lds + 65536 + F.wave * 3072);
    LAS float* dl = (LAS float*)(F.lds + 65536 + F.wave * 3072 + 2048); LAS float* cfl = dl + 128;
    for (int tb = F.gw * 4; tb < NT; tb += F.ngw * 4) {
        {
            int P2[16]; float gt[16];
            const int prob = tb * 16 + lane, half = lane & 1;
            const f32x4* s4 = (const f32x4*)(SCO + (size_t)prob * 128);
            float L[16]; int P[16];
#pragma unroll
            for (int r = 0; r < 16; ++r) { L[r] = -3.0e38f; P[r] = 0; }
            f32x4 nv[4];
#pragma unroll
            for (int i = 0; i < 4; ++i) nv[i] = s4[i];
#pragma unroll 1
            for (int q = 0; q < 8; ++q) {
                f32x4 v[4];
#pragma unroll
                for (int i = 0; i < 4; ++i) v[i] = nv[i];
                if (q < 7) {
#pragma unroll
                    for (int i = 0; i < 4; ++i) nv[i] = s4[4 * (q + 1) + i]; }
                _Pragma("unroll") for (int r = 0; r < 16; ++r) asm volatile("" : "+v"(L[r]), "+v"(P[r]));
#pragma unroll
                for (int i = 0; i < 4; ++i) { const int ib = 16 * q + 4 * i;
                    INS16(L, P, v[i].x, ib); INS16(L, P, v[i].y, ib + 1); INS16(L, P, v[i].z, ib + 2); INS16(L, P, v[i].w, ib + 3); }
            }
            float v1[16], v2[16]; int i1[16], i2[16];
#pragma unroll
            for (int r = 0; r < 16; ++r) { const float ol = dpp_xor1(L[r]); const int op = __builtin_amdgcn_update_dpp(0, P[r], 0xB1, 0xF, 0xF, true);
                v1[r] = half ? ol : L[r]; v2[r] = half ? L[r] : ol; i1[r] = half ? op : P[r]; i2[r] = half ? P[r] : op; }
            float L2[16];
#pragma unroll
            for (int r = 0; r < 16; ++r) { L2[r] = -3.0e38f; P2[r] = 0; }
#pragma unroll
            for (int a = 0; a < 16; ++a)
#pragma unroll
                for (int bq = 0; bq < 16; ++bq) if ((a + 1) * (bq + 1) <= 16) { const float cv = v1[a] + v2[bq]; const int ce = i1[a] * 128 + i2[bq]; INS16(L2, P2, cv, ce); }
            float sum = 0.f;
#pragma unroll
            for (int r = 0; r < 16; ++r) { gt[r] = __expf(L2[r] - L2[0]); sum += gt[r]; }
            const float inv = 1.f / sum;
#pragma unroll
            for (int r = 0; r < 16; ++r) { es[r * 64 + lane] = P2[r]; gs[r * 64 + lane] = gt[r] * inv; }
            asm volatile("s_waitcnt lgkmcnt(0)" ::: "memory");
        }
#pragma unroll 1
        for (int k = 0; k < 4; ++k) {
            const int t = tb + k, b = t >> 12;
            float hs;
            {
                float hf[32]; float mx = 0.f;
                const v4u* hp = (const v4u*)(H + (size_t)t * DM);
#pragma unroll
                for (int jj = 0; jj < 2; ++jj)
#pragma unroll
                    for (int c = 0; c < 2; ++c) { const v4u hv = hp[(jj * 64 + lane) * 2 + c]; const int o = jj * 16 + c * 8;
                        hf[o + 0] = bflo(hv.x); hf[o + 1] = bfhi(hv.x); hf[o + 2] = bflo(hv.y); hf[o + 3] = bfhi(hv.y); hf[o + 4] = bflo(hv.z); hf[o + 5] = bfhi(hv.z); hf[o + 6] = bflo(hv.w); hf[o + 7] = bfhi(hv.w); }
                { const float rstd = rsqrtf(wave_sum(lane < 32 ? ssr[(size_t)t * 32 + lane] : 0.f) * (1.f / DM) + NORM_EPS);
#pragma unroll
                    for (int jj = 0; jj < 2; ++jj)
#pragma unroll
                        for (int q = 0; q < 4; ++q) { const f32x4 s4 = *(const f32x4*)(sh2 + (size_t)b * MODW + (jj * 64 + lane) * 16 + 4 * q);
                            hf[jj * 16 + 4 * q] = hf[jj * 16 + 4 * q] * rstd + s4.x; hf[jj * 16 + 4 * q + 1] = hf[jj * 16 + 4 * q + 1] * rstd + s4.y;
                            hf[jj * 16 + 4 * q + 2] = hf[jj * 16 + 4 * q + 2] * rstd + s4.z; hf[jj * 16 + 4 * q + 3] = hf[jj * 16 + 4 * q + 3] * rstd + s4.w; } }
#pragma unroll
                for (int i = 0; i < 32; ++i) mx = fmaxf(mx, fabsf(hf[i]));
                mx = wave_max(mx);
                const float inv = mx > 0.f ? 127.f / mx : 0.f; hs = mx * (1.f / 127.f);
#pragma unroll
                for (int jj = 0; jj < 2; ++jj) { v4u q;
                    unsigned qd[4];
#pragma unroll
                    for (int d = 0; d < 4; ++d) { const int o = jj * 16 + 4 * d; const int q0 = (int)rintf(hf[o] * inv), q1 = (int)rintf(hf[o + 1] * inv), q2 = (int)rintf(hf[o + 2] * inv), q3 = (int)rintf(hf[o + 3] * inv);
                        qd[d] = (unsigned)(q0 & 255) | ((unsigned)(q1 & 255) << 8) | ((unsigned)(q2 & 255) << 16) | ((unsigned)(q3 & 255) << 24); }
                    q.x = qd[0]; q.y = qd[1]; q.z = qd[2]; q.w = qd[3]; hl[jj * 64 + lane] = q; }
                asm volatile("s_waitcnt lgkmcnt(0)" ::: "memory");
            }
            const int li = lane & 15, lq = lane >> 4;
            {
                v4i ub0[8], ub1[8];
#define ULOAD(buf, hh_, sg_) do { const int my_e_ = es[li * 64 + k * 16 + 2 * (hh_)]; const unsigned char* ub_ = U8 + (size_t)my_e_ * DM + lq * 16 + (sg_) * 512; \
    _Pragma("unroll") for (int s8 = 0; s8 < 8; ++s8) buf[s8] = *(const v4i*)(ub_ + s8 * 64); } while (0)
#define UCONS(buf, sg_) do { _Pragma("unroll") for (int s8 = 0; s8 < 8; ++s8) { const v4i hb_ = *(const LAS v4i*)(hl + ((sg_) * 8 + s8) * 4 + lq); acc = __builtin_amdgcn_mfma_i32_16x16x64_i8(buf[s8], hb_, acc, 0, 0, 0); } } while (0)
                ULOAD(ub0, 0, 0); ULOAD(ub1, 0, 1);
#pragma unroll 1
                for (int hh = 0; hh < 8; ++hh) {
                    v4i acc = {0, 0, 0, 0};
                    UCONS(ub0, 0); ULOAD(ub0, hh, 2);
                    UCONS(ub1, 1); ULOAD(ub1, hh, 3);
                    UCONS(ub0, 2); if (hh < 7) ULOAD(ub0, hh + 1, 0);
                    UCONS(ub1, 3); if (hh < 7) ULOAD(ub1, hh + 1, 1);
                    if (li == 0) { f32x4 d; d.x = (float)acc.x; d.y = (float)acc.y; d.z = (float)acc.z; d.w = (float)acc.w; *(LAS f32x4*)(dl + hh * 16 + 4 * lq) = d; }
                }
#undef ULOAD
#undef UCONS
            }
#pragma unroll
            for (int c = 0; c < 2; ++c) { const int x = lane + 64 * c, hh = x >> 4, r = x & 15; const int e = es[r * 64 + k * 16 + 2 * hh]; const float g = gs[r * 64 + k * 16 + 2 * hh];
                cfl[x] = g * VS[e] * gelu_as(dl[x] * (US[e] * hs)); }
            float out[32];
#pragma unroll
            for (int i = 0; i < 32; ++i) out[i] = 0.f;
            {
                v4u vb0[4][2], vb1[4][2], vb2[4][2]; float c0[4], c1[4], c2[4];
#define VLOAD(buf, cfb, bi_) do { const int bq_ = (bi_) < 32 ? (bi_) : 31; _Pragma("unroll") for (int i = 0; i < 4; ++i) { const int x_ = bq_ * 4 + i; const int e_ = __builtin_amdgcn_readfirstlane(es[(x_ & 15) * 64 + k * 16 + 2 * (x_ >> 4)]); \
        const float cv_ = __builtin_bit_cast(float, __builtin_amdgcn_readfirstlane(__builtin_bit_cast(int, cfl[x_]))); cfb[i] = (bi_) < 32 ? cv_ : 0.f; const v4u* vp_ = (const v4u*)(V8 + (size_t)e_ * DM) + lane; buf[i][0] = vp_[0]; buf[i][1] = vp_[64]; } } while (0)
#define VCONS(buf, cfb) do { _Pragma("unroll") for (int i = 0; i < 4; ++i) { const f32x2 c2_ = {cfb[i], cfb[i]}; \
        _Pragma("unroll") for (int jj = 0; jj < 2; ++jj) { const unsigned wd_[4] = {buf[i][jj].x, buf[i][jj].y, buf[i][jj].z, buf[i][jj].w}; \
            _Pragma("unroll") for (int d = 0; d < 4; ++d) { const int o_ = jj * 16 + 4 * d; \
                const f32x2 f0_ = __builtin_amdgcn_cvt_pk_f32_fp8((int)wd_[d], false), f1_ = __builtin_amdgcn_cvt_pk_f32_fp8((int)wd_[d], true); \
                f32x2 a0_ = {out[o_], out[o_ + 1]}, a1_ = {out[o_ + 2], out[o_ + 3]}; \
                a0_ = __builtin_elementwise_fma(c2_, f0_, a0_); a1_ = __builtin_elementwise_fma(c2_, f1_, a1_); \
                out[o_] = a0_.x; out[o_ + 1] = a0_.y; out[o_ + 2] = a1_.x; out[o_ + 3] = a1_.y; } } } } while (0)
                VLOAD(vb0, c0, 0); VLOAD(vb1, c1, 1); VLOAD(vb2, c2, 2);
#pragma unroll 1
                for (int bi = 0; bi < 33; bi += 3) {
                    VCONS(vb0, c0); VLOAD(vb0, c0, bi + 3);
                    VCONS(vb1, c1); VLOAD(vb1, c1, bi + 4);
                    VCONS(vb2, c2); VLOAD(vb2, c2, bi + 5);
                }
#undef VLOAD
#undef VCONS
            }
            f32x4 xn[2][4]; float ss = 0.f;
            const f32x4* xr = (const f32x4*)(X + (size_t)t * DM); const f32x4* gr = (const f32x4*)(g2 + (size_t)b * MODW);
#pragma unroll
            for (int jj = 0; jj < 2; ++jj)
#pragma unroll
                for (int q = 0; q < 4; ++q) { const int ix = (jj * 64 + lane) * 4 + q; const f32x4 xv = xr[ix], gv = gr[ix]; f32x4 o4; o4.x = out[jj * 16 + 4 * q]; o4.y = out[jj * 16 + 4 * q + 1]; o4.z = out[jj * 16 + 4 * q + 2]; o4.w = out[jj * 16 + 4 * q + 3];
                    const f32x4 y = xv + gv * o4; xn[jj][q] = y; ss += (y.x * y.x + y.y * y.y) + (y.z * y.z + y.w * y.w); }
            const float rstd = rsqrtf(wave_sum(ss) * (1.f / DM) + NORM_EPS);
            if (!last) {
                f32x4* xw = (f32x4*)((dry ? (float*)(A->ws + WS_DUMMY) : X) + (size_t)t * DM); v4u* hw = (v4u*)((dry ? (bf16*)(A->ws + WS_DUMMY + 64 * MiB) : H) + (size_t)t * DM);
#pragma unroll
                for (int jj = 0; jj < 2; ++jj) { f32x4 y[4];
#pragma unroll
                    for (int q = 0; q < 4; ++q) { const int ix = (jj * 64 + lane) * 4 + q; xw[ix] = xn[jj][q];
                        const f32x4 g = ((const f32x4*)ngain)[ix], s1 = ((const f32x4*)(nsc + (size_t)b * MODW))[ix], s0 = ((const f32x4*)(nsh + (size_t)b * MODW))[ix];
                        y[q] = xn[jj][q] * rstd * g * (s1 + 1.f) + s0; }
                    v4u o; o.x = pk2(y[0].x, y[0].y); o.y = pk2(y[0].z, y[0].w); o.z = pk2(y[1].x, y[1].y); o.w = pk2(y[1].z, y[1].w); hw[(jj * 64 + lane) * 2] = o;
                    o.x = pk2(y[2].x, y[2].y); o.y = pk2(y[2].z, y[2].w); o.z = pk2(y[3].x, y[3].y); o.w = pk2(y[3].z, y[3].w); hw[(jj * 64 + lane) * 2 + 1] = o; }
            } else {
                f32x4* ow = (f32x4*)((dry ? (float*)(A->ws + WS_DUMMY) : A->out) + (size_t)t * DM);
#pragma unroll
                for (int jj = 0; jj < 2; ++jj)
#pragma unroll
                    for (int q = 0; q < 4; ++q) { const int ix = (jj * 64 + lane) * 4 + q; ow[ix] = xn[jj][q] * rstd * ((const f32x4*)ngain)[ix]; }
            }
        }
    }
}

#ifndef PEER_SL_SHIFT
#define PEER_SL_SHIFT 10
#endif
__device__ __forceinline__ void ph_peer4(ArgsP A, LAS unsigned char* lds_, int wv_, int l, const float* g2, const float* sh2, const float* ngain, const float* nsh, const float* nsc, const bool last, const bool dry = false) {
    const Frame F = make_frame(lds_, wv_);
    const int lane = F.lane, li = lane & 15, lq = lane >> 4;
    const float* SCO = (const float*)(A->ws + WS_PROJ);
    const unsigned char* U4 = A->ws + WS_U + (size_t)l * PEER_N * (DM / 2); const unsigned char* V8 = A->ws + WS_V + (size_t)l * PEER_N * DM;
    const float* US = (const float*)(A->ws + WS_US) + (size_t)l * PEER_N; const float* VS = (const float*)(A->ws + WS_VS) + (size_t)l * PEER_N;
    float* X = (float*)(A->ws + WS_X); bf16* H = (bf16*)(A->ws + WS_H); const float* ssr = (const float*)(A->ws + WS_SSP) + (size_t)l * NT * 32;
    LAS unsigned char* wl = F.lds + F.wave * 15104;
    LAS int* es = (LAS int*)wl; LAS float* gs = (LAS float*)(wl + 4096);
    LAS v4u* hl = (LAS v4u*)wl;
    LAS int* se = (LAS int*)(wl + 8448);
    LAS float* sg = (LAS float*)(wl + 10496);
    LAS int* st = (LAS int*)(wl + 12544);
    LAS float* dl = (LAS float*)(wl + 14592);
    LAS float* hsl = dl + 64; LAS int* hsi = (LAS int*)(dl + 68);
    for (int tb = F.gw * 4; tb < NT; tb += F.ngw * 4) {
        {
            int P2[16]; float gt[16];
            const int prob = tb * 16 + lane, half = lane & 1;
            const f32x4* s4 = (const f32x4*)(SCO + (size_t)prob * 128);
            float L[16]; int P[16];
#pragma unroll
            for (int r = 0; r < 16; ++r) { L[r] = -3.0e38f; P[r] = 0; }
            f32x4 nv[4];
#pragma unroll
            for (int i = 0; i < 4; ++i) nv[i] = s4[i];
#pragma unroll 1
            for (int q = 0; q < 8; ++q) {
                f32x4 v[4];
#pragma unroll
                for (int i = 0; i < 4; ++i) v[i] = nv[i];
                if (q < 7) {
#pragma unroll
                    for (int i = 0; i < 4; ++i) nv[i] = s4[4 * (q + 1) + i]; }
                _Pragma("unroll") for (int r = 0; r < 16; ++r) asm volatile("" : "+v"(L[r]), "+v"(P[r]));
#pragma unroll
                for (int i = 0; i < 4; ++i) { const int ib = 16 * q + 4 * i;
                    INS16(L, P, v[i].x, ib); INS16(L, P, v[i].y, ib + 1); INS16(L, P, v[i].z, ib + 2); INS16(L, P, v[i].w, ib + 3); }
            }
            float v1[16], v2[16]; int i1[16], i2[16];
#pragma unroll
            for (int r = 0; r < 16; ++r) { const float ol = dpp_xor1(L[r]); const int op = __builtin_amdgcn_update_dpp(0, P[r], 0xB1, 0xF, 0xF, true);
                v1[r] = half ? ol : L[r]; v2[r] = half ? L[r] : ol; i1[r] = half ? op : P[r]; i2[r] = half ? P[r] : op; }
            float L2[16];
#pragma unroll
            for (int r = 0; r < 16; ++r) { L2[r] = -3.0e38f; P2[r] = 0; }
#pragma unroll
            for (int a = 0; a < 16; ++a)
#pragma unroll
                for (int bq = 0; bq < 16; ++bq) if ((a + 1) * (bq + 1) <= 16) { const float cv = v1[a] + v2[bq]; const int ce = i1[a] * 128 + i2[bq]; INS16(L2, P2, cv, ce); }
            float sum = 0.f;
#pragma unroll
            for (int r = 0; r < 16; ++r) { gt[r] = __expf(L2[r] - L2[0]); sum += gt[r]; }
            const float inv = 1.f / sum;
#pragma unroll
            for (int r = 0; r < 16; ++r) { es[r * 64 + lane] = P2[r]; gs[r * 64 + lane] = gt[r] * inv; }
            asm volatile("s_waitcnt lgkmcnt(0)" ::: "memory");
        }
        {
            int ee[8]; float gg[8];
#pragma unroll
            for (int j = 0; j < 8; ++j) { const int x = j * 64 + lane, k = x >> 7, y = x & 127; ee[j] = es[(y & 15) * 64 + k * 16 + 2 * (y >> 4)]; gg[j] = gs[(y & 15) * 64 + k * 16 + 2 * (y >> 4)]; }
            int base = 0;
#pragma unroll
            for (int p = 0; p < 2; ++p) {
#pragma unroll 1
                for (int s = 0; s < (16384 >> PEER_SL_SHIFT); ++s) {
#pragma unroll
                    for (int jj = 0; jj < 4; ++jj) { const int j = p * 4 + jj; const bool in = (ee[j] >> PEER_SL_SHIFT) == s; const unsigned long long m = __builtin_amdgcn_ballot_w64(in);
                        if (in) { const int pos = base + (int)__builtin_amdgcn_mbcnt_hi((unsigned)(m >> 32), __builtin_amdgcn_mbcnt_lo((unsigned)m, 0u)); se[pos] = ee[j]; sg[pos] = gg[j]; st[pos] = j >> 1; }
                        base += __builtin_popcountll(m); }
                }
            }
        }
        asm volatile("s_waitcnt lgkmcnt(0)" ::: "memory");
#pragma unroll 1
        for (int k = 0; k < 4; ++k) {
            const int t = tb + k, b = t >> 12;
            float hf[32]; float mx = 0.f;
            const v4u* hp = (const v4u*)(H + (size_t)t * DM);
#pragma unroll
            for (int jj = 0; jj < 2; ++jj)
#pragma unroll
                for (int c = 0; c < 2; ++c) { const v4u hv = hp[(jj * 64 + lane) * 2 + c]; const int o = jj * 16 + c * 8;
                    hf[o + 0] = bflo(hv.x); hf[o + 1] = bfhi(hv.x); hf[o + 2] = bflo(hv.y); hf[o + 3] = bfhi(hv.y); hf[o + 4] = bflo(hv.z); hf[o + 5] = bfhi(hv.z); hf[o + 6] = bflo(hv.w); hf[o + 7] = bfhi(hv.w); }
            { const float rstd = rsqrtf(wave_sum(lane < 32 ? ssr[(size_t)t * 32 + lane] : 0.f) * (1.f / DM) + NORM_EPS);
#pragma unroll
                for (int jj = 0; jj < 2; ++jj)
#pragma unroll
                    for (int q = 0; q < 4; ++q) { const f32x4 s4 = *(const f32x4*)(sh2 + (size_t)b * MODW + (jj * 64 + lane) * 16 + 4 * q);
                        hf[jj * 16 + 4 * q] = hf[jj * 16 + 4 * q] * rstd + s4.x; hf[jj * 16 + 4 * q + 1] = hf[jj * 16 + 4 * q + 1] * rstd + s4.y;
                        hf[jj * 16 + 4 * q + 2] = hf[jj * 16 + 4 * q + 2] * rstd + s4.z; hf[jj * 16 + 4 * q + 3] = hf[jj * 16 + 4 * q + 3] * rstd + s4.w; } }
#pragma unroll
            for (int i = 0; i < 32; ++i) mx = fmaxf(mx, fabsf(hf[i]));
            mx = wave_max(mx);
            const float inv = mx > 0.f ? 127.f / mx : 0.f;
            if (lane == 0) hsl[k] = mx * (1.f / 127.f);
            int hsum = 0;
#pragma unroll
            for (int jj = 0; jj < 2; ++jj) { unsigned qd[4];
#pragma unroll
                for (int d = 0; d < 4; ++d) { const int o = jj * 16 + 4 * d; const int q0 = (int)rintf(hf[o] * inv), q1 = (int)rintf(hf[o + 1] * inv), q2 = (int)rintf(hf[o + 2] * inv), q3 = (int)rintf(hf[o + 3] * inv);
                    qd[d] = (unsigned)(q0 & 255) | ((unsigned)(q1 & 255) << 8) | ((unsigned)(q2 & 255) << 16) | ((unsigned)(q3 & 255) << 24); hsum += (q0 + q1) + (q2 + q3); }
                v4u q; q.x = qd[0]; q.y = qd[1]; q.z = qd[2]; q.w = qd[3]; hl[k * 132 + jj * 64 + lane] = q; }
            { hsum = row16_sum_i(hsum); const int hs_all = __builtin_amdgcn_readlane(hsum, 0) + __builtin_amdgcn_readlane(hsum, 16) + __builtin_amdgcn_readlane(hsum, 32) + __builtin_amdgcn_readlane(hsum, 48);
                if (lane == 0) hsi[k] = hs_all; }
        }
        asm volatile("s_waitcnt lgkmcnt(0)" ::: "memory");
        {
            v4i ub0[8], ub1[8];
            int lu = lane; asm volatile("" : "+v"(lu)); const int li = lu & 15, lq = lu >> 4;
            const LAS v4u* hb = hl + (li & 3) * 132 + lq;
#define ULOAD(buf, g_, sg_) do { const int my_e_ = se[(g_) * 16 + li]; const unsigned char* ub_ = U4 + (size_t)my_e_ * (DM / 2) + lq * 16 + (sg_) * 512; \
    _Pragma("unroll") for (int s8 = 0; s8 < 8; ++s8) buf[s8] = *(const v4i*)(ub_ + s8 * 64); } while (0)
#define UCONS(buf, sg_) do { _Pragma("unroll") for (int s8 = 0; s8 < 8; ++s8) { const int c_ = (sg_) * 8 + s8; \
        const v4i lo_ = buf[s8] & 0x0F0F0F0F, hi_ = (buf[s8] >> 4) & 0x0F0F0F0F; \
        const v4i hb0_ = *(const LAS v4i*)(hb + c_ * 4), hb1_ = *(const LAS v4i*)(hb + 64 + c_ * 4); \
        acc = __builtin_amdgcn_mfma_i32_16x16x64_i8(lo_, hb0_, acc, 0, 0, 0); acc = __builtin_amdgcn_mfma_i32_16x16x64_i8(hi_, hb1_, acc, 0, 0, 0); } } while (0)
            ULOAD(ub0, 0, 0);
#pragma unroll 1
            for (int g = 0; g < 32; ++g) {
                const int gn = g + 1 < 32 ? g + 1 : 31;
                v4i acc = {0, 0, 0, 0};
                ULOAD(ub1, g, 1);
                UCONS(ub0, 0); ULOAD(ub0, gn, 0);
                UCONS(ub1, 1);
                if (li < 4) { const int hc = 8 * hsi[li];
                    dl[(4 * lq + 0) * 4 + li] = (float)(acc.x - hc); dl[(4 * lq + 1) * 4 + li] = (float)(acc.y - hc); dl[(4 * lq + 2) * 4 + li] = (float)(acc.z - hc); dl[(4 * lq + 3) * 4 + li] = (float)(acc.w - hc); }
                if (lane < 16) { const int x = g * 16 + lane; const int e = se[x], tk = st[x];
                    sg[x] = sg[x] * VS[e] * gelu_as(dl[lane * 4 + tk] * (US[e] * hsl[tk])); }
            }
#undef ULOAD
#undef UCONS
        }
        asm volatile("s_waitcnt lgkmcnt(0)" ::: "memory");
#define PEER_EPILOGUE(kk_, kt_) do { const int t = tb + (kt_), b = t >> 12; float (&out_k)[32] = out[kk_]; \
            f32x4 xn[2][4]; float ss = 0.f; \
            const f32x4* xr = (const f32x4*)(X + (size_t)t * DM); const f32x4* gr = (const f32x4*)(g2 + (size_t)b * MODW); \
            _Pragma("unroll") \
            for (int jj = 0; jj < 2; ++jj) \
            _Pragma("unroll") \
                for (int q = 0; q < 4; ++q) { const int ix = (jj * 64 + lane) * 4 + q; const f32x4 xv = xr[ix], gv = gr[ix]; f32x4 o4; o4.x = out_k[jj * 16 + 4 * q]; o4.y = out_k[jj * 16 + 4 * q + 1]; o4.z = out_k[jj * 16 + 4 * q + 2]; o4.w = out_k[jj * 16 + 4 * q + 3]; \
                    const f32x4 y = xv + gv * o4; xn[jj][q] = y; ss += (y.x * y.x + y.y * y.y) + (y.z * y.z + y.w * y.w); } \
            const float rstd = rsqrtf(wave_sum(ss) * (1.f / DM) + NORM_EPS); \
            if (!last) { \
                f32x4* xw = (f32x4*)((dry ? (float*)(A->ws + WS_DUMMY) : X) + (size_t)t * DM); v4u* hw = (v4u*)((dry ? (bf16*)(A->ws + WS_DUMMY + 64 * MiB) : H) + (size_t)t * DM); \
            _Pragma("unroll") \
                for (int jj = 0; jj < 2; ++jj) { f32x4 y[4]; \
            _Pragma("unroll") \
                    for (int q = 0; q < 4; ++q) { const int ix = (jj * 64 + lane) * 4 + q; xw[ix] = xn[jj][q]; \
                        const f32x4 g = ((const f32x4*)ngain)[ix], s1 = ((const f32x4*)(nsc + (size_t)b * MODW))[ix], s0 = ((const f32x4*)(nsh + (size_t)b * MODW))[ix]; \
                        y[q] = xn[jj][q] * rstd * g * (s1 + 1.f) + s0; } \
                    v4u o; o.x = pk2(y[0].x, y[0].y); o.y = pk2(y[0].z, y[0].w); o.z = pk2(y[1].x, y[1].y); o.w = pk2(y[1].z, y[1].w); hw[(jj * 64 + lane) * 2] = o; \
                    o.x = pk2(y[2].x, y[2].y); o.y = pk2(y[2].z, y[2].w); o.z = pk2(y[3].x, y[3].y); o.w = pk2(y[3].z, y[3].w); hw[(jj * 64 + lane) * 2 + 1] = o; } \
            } else { \
                f32x4* ow = (f32x4*)((dry ? (float*)(A->ws + WS_DUMMY) : A->out) + (size_t)t * DM); \
            _Pragma("unroll") \
                for (int jj = 0; jj < 2; ++jj) \
            _Pragma("unroll") \
                    for (int q = 0; q < 4; ++q) { const int ix = (jj * 64 + lane) * 4 + q; ow[ix] = xn[jj][q] * rstd * ((const f32x4*)ngain)[ix]; } \
            } \
        } while (0)
#define VLOAD(buf, cfb, tkb, bi_) do { _Pragma("unroll") for (int i = 0; i < 4; ++i) { const int x_ = (bi_) * 4 + i; const int e_ = __builtin_amdgcn_readfirstlane(se[x_]); \
        cfb[i] = __builtin_bit_cast(float, __builtin_amdgcn_readfirstlane(__builtin_bit_cast(int, sg[x_]))); tkb[i] = __builtin_amdgcn_readfirstlane(st[x_]) & 1; \
        const v4u* vp_ = (const v4u*)(V8 + (size_t)e_ * DM) + lane_v; buf[i][0] = vp_[0]; buf[i][1] = vp_[64]; } } while (0)
#define VACC(kk_, bv_, cv_) do { const f32x2 c2_ = {cv_, cv_}; \
        _Pragma("unroll") for (int jj = 0; jj < 2; ++jj) { const unsigned wd_[4] = {bv_[jj].x, bv_[jj].y, bv_[jj].z, bv_[jj].w}; \
            _Pragma("unroll") for (int d = 0; d < 4; ++d) { const int o_ = jj * 16 + 4 * d; \
                const f32x2 f0_ = __builtin_amdgcn_cvt_pk_f32_fp8((int)wd_[d], false), f1_ = __builtin_amdgcn_cvt_pk_f32_fp8((int)wd_[d], true); \
                f32x2 a0_ = {out[kk_][o_], out[kk_][o_ + 1]}, a1_ = {out[kk_][o_ + 2], out[kk_][o_ + 3]}; \
                a0_ = __builtin_elementwise_fma(c2_, f0_, a0_); a1_ = __builtin_elementwise_fma(c2_, f1_, a1_); \
                out[kk_][o_] = a0_.x; out[kk_][o_ + 1] = a0_.y; out[kk_][o_ + 2] = a1_.x; out[kk_][o_ + 3] = a1_.y; } } } while (0)
#define VCONS(buf, cfb, tkb) do { _Pragma("unroll") for (int i = 0; i < 4; ++i) { if (tkb[i] == 0) VACC(0, buf[i], cfb[i]); else VACC(1, buf[i], cfb[i]); } } while (0)
#pragma unroll 1
        for (int p = 0; p < 2; ++p) {
            int lane_v = F.lane; asm volatile("" : "+v"(lane_v));
            float out[2][32];
#pragma unroll
            for (int k = 0; k < 2; ++k)
#pragma unroll
                for (int i = 0; i < 32; ++i) out[k][i] = 0.f;
            {
                v4u vb0[4][2], vb1[4][2]; float c0[4], c1[4]; int t0v[4], t1v[4];
                const int bb = p * 64;
                VLOAD(vb0, c0, t0v, bb); VLOAD(vb1, c1, t1v, bb + 1);
#pragma unroll 1
                for (int bi = 0; bi < 64; bi += 2) {
                    const int b2 = bb + (bi + 2 < 64 ? bi + 2 : 62), b3 = bb + (bi + 3 < 64 ? bi + 3 : 63);
                    VCONS(vb0, c0, t0v); VLOAD(vb0, c0, t0v, b2);
                    VCONS(vb1, c1, t1v); VLOAD(vb1, c1, t1v, b3);
                }
            }
            PEER_EPILOGUE(0, 2 * p); PEER_EPILOGUE(1, 2 * p + 1);
        }
#undef VLOAD
#undef VACC
#undef VCONS
#undef PEER_EPILOGUE
    }
}

__device__ __forceinline__ void PH_norm1_l0(LAS unsigned char* lds, int wv) { ArgsP A = args_ptr(); const float* MOD = (const float*)(A->ws + WS_MOD);
    ph_norm(A->in[0], A->in[4], MOD + 0 * DM, MOD + 1 * DM, (bf16*)(A->ws + WS_H), lds, wv);
    { const Frame F = make_frame(lds, wv); float* B3 = (float*)(A->ws + WS_BIAS3);
        for (int o = F.gw; o < DEPTH * 2 * DM; o += F.ngw) { const int l = o >> 12, b = (o >> 11) & 1, n = o & 2047;
            const float* sh = MOD + (size_t)(l * 2 + b) * MODW + 3 * DM; const v4u* wr = (const v4u*)((const bf16*)(A->ws + WS_WQK) + ((size_t)l * DM + n) * DM);
            float s = 0.f;
#pragma unroll
            for (int j = 0; j < 4; ++j) { const v4u wv4 = wr[j * 64 + F.lane]; const f32x4 s0 = *(const f32x4*)(sh + (j * 64 + F.lane) * 8), s1 = *(const f32x4*)(sh + (j * 64 + F.lane) * 8 + 4);
                s += bflo(wv4.x) * s0.x + bfhi(wv4.x) * s0.y + bflo(wv4.y) * s0.z + bfhi(wv4.y) * s0.w + bflo(wv4.z) * s1.x + bfhi(wv4.z) * s1.y + bflo(wv4.w) * s1.z + bfhi(wv4.w) * s1.w; }
            s = wave_sum(s);
            if (F.lane == 0) B3[o] = s; } } }
__device__ __forceinline__ void PH_gemm1(LAS unsigned char* lds, int wv, int l_) { ArgsP A = args_ptr(); const int l = opaque_i(l_);
    pg8::Gemm g{(const bf16*)(A->ws + WS_H), (const bf16*)(A->ws + WS_WIN) + (size_t)l * INWP * DM, NT, INWP, DM}; pg8::StaticOrder S; S.init(NT, INWP, gridDim.x, blockIdx.x);
    EpiStoreF32 E{(float*)(A->ws + WS_PROJ), INWP, wv};
    pg8::gemm_phase<EpiStoreF32, pg8::StaticOrder, true, true>(lds, g, S, E, wv); }
__device__ __forceinline__ void PH_mixA(LAS unsigned char* lds, int wv, int l_) { ArgsP A = args_ptr(); const int l = opaque_i(l_);
    const Frame F = make_frame(lds, wv);
#ifdef PROBE_A
    for (int u = F.bid; u < 2048; u += F.G) {
        if (u < 1536) { if (PROBE_A == 1) rwkvA_unit(A, F, l, u); }
        else { if (PROBE_A == 2) gla1_unit(A, F, l, u - 1536); }
    }
#endif
    for (int u = F.bid; u < 2048; u += F.G) {
        if (u < 1536) rwkvA_unit(A, F, l, u);
        else gla1_unit(A, F, l, u - 1536);
    }
    if (l + 1 < DEPTH) quant_tables(A, l + 1, F.gw, F.ngw, F.lane);
}
__device__ __forceinline__ void PH_mixB(LAS unsigned char* lds, int wv, int l_) { ArgsP A = args_ptr(); const int l = opaque_i(l_);
    const Frame F = make_frame(lds, wv);
    if (F.G >= 192) {
        if (F.bid < 96) rwkvB_scan(A, F, F.bid);
        else { const int nb = F.G - 96, b2 = F.bid - 96;
            for (int u = b2; u < 288; u += nb) gla_scan_unit(A, F, u);
            for (int u = b2; u < 1024; u += nb) pool_unit(A, F, l, u); }
    } else {
        for (int u = F.bid; u < 288; u += F.G) gla_scan_unit(A, F, u);
        for (int u = F.bid; u < 1024; u += F.G) pool_unit(A, F, l, u);
        for (int u = F.bid; u < 96; u += F.G) rwkvB_scan(A, F, u);
    } }
__device__ __forceinline__ void PH_mixC(LAS unsigned char* lds, int wv, int l_) { ArgsP A = args_ptr(); const int l = opaque_i(l_);
    const Frame F = make_frame(lds, wv);
#ifdef PROBE_C
    for (int u = F.bid; u < 2048; u += F.G) { if (u < 512) { if (PROBE_C == 1) gla3_unit(A, F, l, u); } else { if (PROBE_C == 2) rwkvC_unit(A, F, l, u - 512); } }
#endif
    for (int u = F.bid; u < 2048; u += F.G) { if (u < 512) gla3_unit(A, F, l, u); else rwkvC_unit(A, F, l, u - 512); } }
__device__ __forceinline__ void PH_gemm2(LAS unsigned char* lds, int wv, int l_, bool dry = false) { ArgsP A = args_ptr(); const int l = opaque_i(l_);
    const float* modl = (const float*)(A->ws + WS_MOD) + (size_t)l * 2 * MODW; float* X = (float*)(A->ws + WS_X);
    pg8::Gemm g{(const bf16*)(A->ws + WS_Y), (const bf16*)(A->ws + WS_WOUT) + (size_t)l * DM * DM, NT, DM, DM}; pg8::StaticOrder S; S.init(NT, DM, gridDim.x, blockIdx.x);
    EpiResid E{(l == 0) ? A->in[0] : (const float*)X, dry ? (float*)(A->ws + WS_DUMMY) : X, modl + 2 * DM, wv, A->in[23] + (size_t)l * DM, modl + 4 * DM,
               dry ? (bf16*)(A->ws + WS_DUMMY + 64 * MiB) : (bf16*)(A->ws + WS_H), (dry ? (float*)(A->ws + WS_DUMMY) : (float*)(A->ws + WS_SSP) + (size_t)l * NT * 32)};
    pg8::gemm_phase<EpiResid, pg8::StaticOrder, true, true>(lds, g, S, E, wv); }
__device__ __forceinline__ void PH_norm2(LAS unsigned char* lds, int wv, int l_) { ArgsP A = args_ptr(); const int l = opaque_i(l_);
    const float* modl = (const float*)(A->ws + WS_MOD) + (size_t)l * 2 * MODW;
    ph_norm((const float*)(A->ws + WS_X), A->in[23] + (size_t)l * DM, modl + 3 * DM, modl + 4 * DM, (bf16*)(A->ws + WS_H), lds, wv); }
__device__ __forceinline__ void PH_gemm3(LAS unsigned char* lds, int wv, int l_) { ArgsP A = args_ptr(); const int l = opaque_i(l_);
    pg8::Gemm g{(const bf16*)(A->ws + WS_H), (const bf16*)(A->ws + WS_WQK) + (size_t)l * DM * DM, NT, DM, DM}; pg8::StaticOrder S; S.init(NT, DM, gridDim.x, blockIdx.x);
    LAS float* rs = (LAS float*)(lds + 131072);
    { pg8::Unit u0; const int t = tid_from(wv); if (S.next(0, u0) && t < 256) { const f32x4* sp = (const f32x4*)((const float*)(A->ws + WS_SSP) + ((size_t)l * NT + u0.pm * 256 + t) * 32); float s = 0.f;
#pragma unroll
            for (int j = 0; j < 8; ++j) { const f32x4 v = sp[j]; s += (v.x + v.y) + (v.z + v.w); }
            rs[t] = rsqrtf(s * (1.f / DM) + NORM_EPS); }
        __syncthreads(); }
    EpiScore E{(float*)(A->ws + WS_PROJ), DM, wv, rs, (const float*)(A->ws + WS_BIAS3) + (size_t)l * 2 * DM};
    pg8::gemm_phase<EpiScore, pg8::StaticOrder, true, true>(lds, g, S, E, wv); }
__device__ __forceinline__ void PH_peer(LAS unsigned char* lds, int wv, int l_, bool dry = false) { ArgsP A = args_ptr(); const int l = opaque_i(l_);
    const float* MOD = (const float*)(A->ws + WS_MOD); const float* modl = MOD + (size_t)l * 2 * MODW;
    const bool last = (l == DEPTH - 1);
    const float* nmod = MOD + (size_t)(last ? l : l + 1) * 2 * MODW;
#ifndef PEER_ORDERED
#define PEER_ORDERED 1
#endif
    if (PEER_ORDERED) ph_peer4(A, lds, wv, l, modl + 5 * DM, modl + 3 * DM, last ? A->in[29] : A->in[4] + (size_t)(l + 1) * DM, nmod + 0 * DM, nmod + 1 * DM, last, dry);
    else ph_peer2(A, lds, wv, l, modl + 5 * DM, modl + 3 * DM, last ? A->in[29] : A->in[4] + (size_t)(l + 1) * DM, nmod + 0 * DM, nmod + 1 * DM, last, dry); }

__global__ void __launch_bounds__(NTHR, 2) mega_fwd(Args args) {
    extern __shared__ __attribute__((aligned(16))) unsigned char lds_raw[];
    LAS unsigned char* lds = (LAS unsigned char*)lds_raw;
    volatile LAS unsigned* MISC = (volatile LAS unsigned*)(lds + MISC_OFF);
    const int wv = __builtin_amdgcn_readfirstlane((int)(threadIdx.x >> 6));
    if (wv == 0) MISC[lane_id_()] = 0u;
    __syncthreads();
    XcdBarrier bar = xcd_barrier_post((unsigned*)(args_ptr()->ws + WS_CTL) + CW_BAR, MISC + 8, wv);
#define GRID_BAR() do { XcdBarrier b_ = bar; b_.bar = (unsigned*)(args_ptr()->ws + WS_CTL) + CW_BAR; asm volatile("" : "+s"(b_.x), "+s"(b_.w)); xcd_barrier(b_); if (PROBE & 512) xcd_barrier(b_); } while (0)

    ph_prologue(args_ptr(), lds, wv);
    GRID_BAR();
#if PROBE & 1
    ph_prologue(args_ptr(), lds, wv); GRID_BAR();
#endif
    PH_norm1_l0(lds, wv);
    GRID_BAR();
    for (int l = 0; l < DEPTH; ++l) {
#if PROBE & 2
        PH_gemm1(lds, wv, l); GRID_BAR();
#endif
        PH_gemm1(lds, wv, l); GRID_BAR();
#if PROBE & 4
        PH_mixA(lds, wv, l);  GRID_BAR();
#endif
        PH_mixA(lds, wv, l);  GRID_BAR();
#if PROBE & 8
        PH_mixB(lds, wv, l);  GRID_BAR();
#endif
        PH_mixB(lds, wv, l);  GRID_BAR();
#if PROBE & 16
        PH_mixC(lds, wv, l);  GRID_BAR();
#endif
        PH_mixC(lds, wv, l);  GRID_BAR();
#if PROBE & 32
        PH_gemm2(lds, wv, l, true); GRID_BAR();
#endif
        PH_gemm2(lds, wv, l); GRID_BAR();
#if PROBE & 128
        PH_gemm3(lds, wv, l); GRID_BAR();
#endif
        PH_gemm3(lds, wv, l); GRID_BAR();
#if PROBE & 256
        PH_peer(lds, wv, l, true); GRID_BAR();
#endif
        PH_peer(lds, wv, l);
        if (l + 1 < DEPTH) GRID_BAR();
    }
}

extern "C" void kernel_launch(void* const* d_in, const int* in_sizes, int n_in, void* d_out, int out_size, void* d_ws, size_t ws_size, hipStream_t stream) {
    static int grid = 0;
    if (grid == 0) {
        if (n_in != 30 || out_size != NT * DM || ws_size < WS_END + 96 * MiB) { fprintf(stderr, "kernel_launch: unexpected shapes (n_in %d out %d ws %zu)\n", n_in, out_size, ws_size); grid = -1; return; }
        int dev = 0, cus = 0, per_cu = 0;
        if (hipGetDevice(&dev) != hipSuccess || hipDeviceGetAttribute(&cus, hipDeviceAttributeMultiprocessorCount, dev) != hipSuccess) { grid = -1; return; }
        if (hipFuncSetAttribute((const void*)mega_fwd, hipFuncAttributeMaxDynamicSharedMemorySize, LDS_BYTES) != hipSuccess) { fprintf(stderr, "kernel_launch: hipFuncSetAttribute failed\n"); grid = -1; return; }
        if (hipOccupancyMaxActiveBlocksPerMultiprocessor(&per_cu, (const void*)mega_fwd, NTHR, LDS_BYTES) != hipSuccess || per_cu < 1) { fprintf(stderr, "kernel_launch: occupancy query says %d\n", per_cu); (void)hipGetLastError(); per_cu = 1; }
        grid = cus;
    }
    if (grid < 0) return;
    (void)in_sizes;
    if (hipMemsetAsync((char*)d_ws + WS_CTL, 0, CTL_ZERO_BYTES, stream) != hipSuccess) return;
    Args a{};
    for (int i = 0; i < 30; ++i) a.in[i] = (const float*)d_in[i];
    a.out = (float*)d_out; a.ws = (unsigned char*)d_ws;
    hipLaunchKernelGGL(mega_fwd, dim3(grid), dim3(NTHR), LDS_BYTES, stream, a);
}
```

```cpp
#include <hip/hip_runtime.h>
#include <cstdio>
#include <cstdint>
__device__ __forceinline__ int lane_id_() { int r; asm volatile("v_mbcnt_lo_u32_b32 %0, -1, 0\n\tv_mbcnt_hi_u32_b32 %0, -1, %0" : "=v"(r)); return r; }
__device__ __forceinline__ int tid_from(int wave_s) { return wave_s * 64 + lane_id_(); }
namespace pg8 {
#define PG8_LAS __attribute__((address_space(3)))
typedef unsigned short bf16_t;
typedef short bf16x8 __attribute__((ext_vector_type(8)));
typedef float f32x4 __attribute__((ext_vector_type(4)));
typedef unsigned u32x4 __attribute__((ext_vector_type(4)));
constexpr int BM = 256, BK = 64, HALF = 128, HTB = HALF * BK * 2  , STAGE_BYTES = 8 * HTB, NXCD = 8, WGM = 8;

__host__ __device__ __forceinline__ int lds_byte(int r, int c) { const int st = (r >> 4) * 2 + (c >> 5), rr = r & 15, cc = c & 31, ob = rr * 64 + cc * 2; return st * 1024 + (ob ^ (((ob >> 9) & 1) << 5)); }
__host__ __device__ __forceinline__ void stage_rc(int b, int& R, int& C) { const int st = b / 1024, sb = b % 1024, swz = sb ^ (((sb >> 9) & 1) << 5); R = (st >> 1) * 16 + swz / 64; C = (st & 1) * 32 + (swz % 64) / 2; }
__host__ __device__ __forceinline__ int perm32(int rho) { const int n = rho >> 4, i = rho & 15; return 8 * (i >> 2) + 4 * n + (i & 3); }

struct Unit { int pm, pn; };
struct Gemm { const bf16_t* A; const bf16_t* Bt; int M, N, K; };

struct StaticOrder {
    int nM, nN, nwg, G, c;
    __host__ __device__ void init(int M, int N, int G_, int c_) { nM = M / BM; nN = N / BM; nwg = nM * nN; G = G_; c = c_; }
    __host__ __device__ bool next(int i, Unit& u) const {
        const long L = (long)i * G + c; if (L >= nwg) return false;
        int wgid = (int)L; { const int q = nwg / NXCD, r = nwg % NXCD, xcd = wgid % NXCD, off = wgid / NXCD; wgid = (xcd < r ? xcd * (q + 1) : r * (q + 1) + (xcd - r) * q) + off; }
        const int nig = WGM * nN, gid = wgid / nig, fm = gid * WGM, gsz = (nM - fm) < WGM ? (nM - fm) : WGM;
        u.pm = fm + ((wgid % nig) % gsz); u.pn = (wgid % nig) / gsz; return true;
    }
    __device__ __forceinline__ void a_ready(const Unit&) const {}
    __device__ __forceinline__ void done(const Unit&) const {}
};

template <class Epi, class Sched, bool ALIGN_EPI = false, bool SP2 = false>
__device__ __forceinline__ void gemm_phase(PG8_LAS unsigned char* lds, const Gemm g, const Sched& S, const Epi& E, int wave_s) {
    int tid_o = tid_from(wave_s); asm volatile("" : "+v"(tid_o));
    const int tid = tid_o, wid = __builtin_amdgcn_readfirstlane(tid >> 6), lane = tid & 63, wr = wid >> 2, wc = wid & 3, fr = lane & 15, fq = lane >> 4;
    const int K = g.K, nt = K / BK;
    unsigned voffA[2], voffB[2];
#pragma unroll
    for (int i = 0; i < 2; ++i) { int R, C; stage_rc(tid * 16 + i * 8192, R, C); const int Rb = Epi::PERM ? ((R & ~31) + perm32(R & 31)) : R;
        voffA[i] = (unsigned)(R * K + C) * 2u; voffB[i] = (unsigned)(Rb * K + C) * 2u; }
    const size_t kstep = (size_t)(BK * 2);
    const size_t hstep = (size_t)HALF * K * 2;
    const size_t tstep = 2 * hstep;
    const unsigned ldsw = (unsigned)wid * 1024u;
    const int aoff = lds_byte(wr * 64 + fr, fq * 8), boff = lds_byte(wc * 32 + fr, fq * 8);
#define PG8_SA(b, h) (((b) * 2 + (h)) * HTB)
#define PG8_SB(b, h) ((4 + (b) * 2 + (h)) * HTB)
#define PG8_STAGE(bufoff, gbase, voff) do { _Pragma("unroll") for (int _i = 0; _i < 2; ++_i) \
        __builtin_amdgcn_global_load_lds((const unsigned*)((const char*)(gbase) + (voff)[_i]), (PG8_LAS unsigned*)(lds + (bufoff) + ldsw + _i * 8192), 16, 0, 0); } while (0)
#define PG8_LDA(dst, b, h) do { _Pragma("unroll") for (int m = 0; m < 4; ++m) _Pragma("unroll") for (int k = 0; k < 2; ++k) dst[m][k] = *(const PG8_LAS bf16x8*)(lds + PG8_SA(b, h) + aoff + m * 2048 + k * 1024); } while (0)
#define PG8_LDB(dst, b, h) do { _Pragma("unroll") for (int n = 0; n < 2; ++n) _Pragma("unroll") for (int k = 0; k < 2; ++k) dst[n][k] = *(const PG8_LAS bf16x8*)(lds + PG8_SB(b, h) + boff + n * 2048 + k * 1024); } while (0)
#define PG8_MMA(ai, bj, At, Bt) do { __builtin_amdgcn_s_setprio(1); _Pragma("unroll") for (int m = 0; m < 4; ++m) _Pragma("unroll") for (int n = 0; n < 2; ++n) _Pragma("unroll") for (int k = 0; k < 2; ++k) \
        acc[ai][bj][m][n] = __builtin_amdgcn_mfma_f32_16x16x32_bf16(Bt[n][k], At[m][k], acc[ai][bj][m][n], 0, 0, 0); __builtin_amdgcn_s_setprio(0); } while (0)
#define PG8_WAIT_V(n) asm volatile("s_waitcnt vmcnt(" #n ")" ::: "memory")
#define PG8_WAIT_L(n) asm volatile("s_waitcnt lgkmcnt(" #n ")" ::: "memory")
#define PG8_BAR __builtin_amdgcn_s_barrier()
#define PG8_SCHED __builtin_amdgcn_sched_barrier(0)
    Unit cur, nxt; int ui = 0;
    if (!S.next(0, cur)) return;
    f32x4 acc[2][2][4][2];
#pragma unroll
    for (int a = 0; a < 2; ++a)
#pragma unroll
        for (int b = 0; b < 2; ++b)
#pragma unroll
            for (int m = 0; m < 4; ++m)
#pragma unroll
                for (int n = 0; n < 2; ++n) acc[a][b][m][n] = (f32x4){0.f, 0.f, 0.f, 0.f};
    bf16x8 At[4][2], B0[2][2], B1[2][2];
    const char* cA = (const char*)g.A + (size_t)cur.pm * tstep; const char* cB = (const char*)g.Bt + (size_t)cur.pn * tstep;
    S.a_ready(cur);
    if constexpr (SP2) {
        PG8_STAGE(PG8_SB(0, 0), cB, voffB); PG8_STAGE(PG8_SB(0, 1), cB + hstep, voffB); PG8_STAGE(PG8_SA(0, 0), cA, voffA); PG8_STAGE(PG8_SA(0, 1), cA + hstep, voffA);
        if (wr == 1) PG8_BAR;
        PG8_WAIT_V(2); PG8_BAR;
        PG8_STAGE(PG8_SB(1, 0), cB + kstep, voffB); PG8_STAGE(PG8_SA(1, 0), cA + kstep, voffA); PG8_STAGE(PG8_SB(1, 1), cB + hstep + kstep, voffB);
        PG8_WAIT_V(6); PG8_BAR;
    } else {
        PG8_STAGE(PG8_SB(0, 0), cB, voffB); PG8_STAGE(PG8_SA(0, 0), cA, voffA); PG8_STAGE(PG8_SB(0, 1), cB + hstep, voffB); PG8_STAGE(PG8_SA(0, 1), cA + hstep, voffA);
        if (wr == 1) PG8_BAR;
        PG8_WAIT_V(4); PG8_BAR;
        PG8_STAGE(PG8_SB(1, 0), cB + kstep, voffB); PG8_STAGE(PG8_SA(1, 0), cA + kstep, voffA); PG8_STAGE(PG8_SB(1, 1), cB + hstep + kstep, voffB);
        PG8_WAIT_V(6); PG8_BAR;
    }
    for (;;) {
        const bool has_next = S.next(ui + 1, nxt);
        const char* nA = has_next ? (const char*)g.A + (size_t)nxt.pm * tstep : cA; const char* nB = has_next ? (const char*)g.Bt + (size_t)nxt.pn * tstep : cB;
        for (int t = 0; t < nt; t += 2) {
            const bool last = (t == nt - 2);
            const char* a1 = cA + (size_t)(t + 1) * kstep;
            const char* a2 = last ? nA : cA + (size_t)(t + 2) * kstep; const char* b2 = last ? nB : cB + (size_t)(t + 2) * kstep;
            const char* a3 = a2 + kstep; const char* b3 = b2 + kstep;
            if (last && has_next) S.a_ready(nxt);
            if constexpr (SP2) {
            PG8_LDB(B0, 0, 0); PG8_LDB(B1, 0, 1); PG8_SCHED; PG8_LDA(At, 0, 0); PG8_STAGE(PG8_SA(1, 1), a1 + hstep, voffA);
            PG8_WAIT_V(8); PG8_WAIT_L(0); PG8_BAR; PG8_MMA(0, 0, At, B0); PG8_MMA(0, 1, At, B1); PG8_BAR; PG8_SCHED;
            PG8_LDA(At, 0, 1); PG8_STAGE(PG8_SB(0, 0), b2, voffB); PG8_STAGE(PG8_SB(0, 1), b2 + hstep, voffB); PG8_STAGE(PG8_SA(0, 0), a2, voffA);
            PG8_WAIT_V(8); PG8_WAIT_L(0); PG8_BAR; PG8_MMA(1, 0, At, B0); PG8_MMA(1, 1, At, B1); PG8_BAR; PG8_SCHED;
            PG8_LDB(B0, 1, 0); PG8_LDB(B1, 1, 1); PG8_SCHED; PG8_LDA(At, 1, 0); PG8_STAGE(PG8_SA(0, 1), a2 + hstep, voffA);
            PG8_WAIT_V(8); PG8_WAIT_L(0); PG8_BAR; PG8_MMA(0, 0, At, B0); PG8_MMA(0, 1, At, B1); PG8_BAR; PG8_SCHED;
            PG8_LDA(At, 1, 1); PG8_STAGE(PG8_SB(1, 0), b3, voffB); PG8_STAGE(PG8_SB(1, 1), b3 + hstep, voffB); PG8_STAGE(PG8_SA(1, 0), a3, voffA);
            PG8_WAIT_V(8); PG8_WAIT_L(0); PG8_BAR; PG8_MMA(1, 0, At, B0); PG8_MMA(1, 1, At, B1); PG8_BAR; PG8_SCHED;
            } else {
            PG8_LDB(B0, 0, 0); PG8_SCHED; PG8_LDA(At, 0, 0); PG8_STAGE(PG8_SA(1, 1), a1 + hstep, voffA);
            PG8_WAIT_L(8); PG8_BAR; PG8_WAIT_L(0); PG8_MMA(0, 0, At, B0); PG8_BAR; PG8_SCHED;
            PG8_LDB(B1, 0, 1); PG8_STAGE(PG8_SB(0, 0), b2, voffB);
            PG8_BAR; PG8_WAIT_L(0); PG8_MMA(0, 1, At, B1); PG8_BAR;
            PG8_LDA(At, 0, 1); PG8_STAGE(PG8_SA(0, 0), a2, voffA);
            PG8_BAR; PG8_WAIT_L(0); PG8_MMA(1, 0, At, B0); PG8_BAR; PG8_SCHED;
            PG8_STAGE(PG8_SB(0, 1), b2 + hstep, voffB);
            PG8_WAIT_V(6); PG8_BAR; PG8_MMA(1, 1, At, B1); PG8_BAR;
            PG8_LDB(B0, 1, 0); PG8_SCHED; PG8_LDA(At, 1, 0); PG8_STAGE(PG8_SA(0, 1), a2 + hstep, voffA);
            PG8_WAIT_L(8); PG8_BAR; PG8_WAIT_L(0); PG8_MMA(0, 0, At, B0); PG8_BAR; PG8_SCHED;
            PG8_LDB(B1, 1, 1); PG8_STAGE(PG8_SB(1, 0), b3, voffB);
            PG8_BAR; PG8_WAIT_L(0); PG8_MMA(0, 1, At, B1); PG8_BAR;
            PG8_LDA(At, 1, 1); PG8_STAGE(PG8_SA(1, 0), a3, voffA);
            PG8_BAR; PG8_WAIT_L(0); PG8_MMA(1, 0, At, B0); PG8_BAR; PG8_SCHED;
            PG8_STAGE(PG8_SB(1, 1), b3 + hstep, voffB);
            PG8_WAIT_V(6); PG8_BAR; PG8_MMA(1, 1, At, B1); PG8_BAR;
            }
        }
        if constexpr (ALIGN_EPI) { if (wr == 0) PG8_BAR; }
        if constexpr (!Epi::AFTER_DRAIN) { E(acc, cur, wr, wc, fr, fq); S.done(cur); }
        if (!has_next) break;
#pragma unroll
        for (int a = 0; a < 2; ++a)
#pragma unroll
            for (int b = 0; b < 2; ++b)
#pragma unroll
                for (int m = 0; m < 4; ++m)
#pragma unroll
                    for (int n = 0; n < 2; ++n) acc[a][b][m][n] = (f32x4){0.f, 0.f, 0.f, 0.f};
        cur = nxt; cA = nA; cB = nB; ++ui;
        if constexpr (ALIGN_EPI) { if (wr == 1) PG8_BAR; }
    }
    PG8_WAIT_V(0);
    if constexpr (!ALIGN_EPI) { if (wr == 0) PG8_BAR; }
    PG8_BAR;
    if constexpr (Epi::AFTER_DRAIN) { E.fused(acc, cur, wr, wc, fr, fq, lds, wid, lane); S.done(cur); }
#undef PG8_SA
#undef PG8_SB
#undef PG8_STAGE
#undef PG8_LDA
#undef PG8_LDB
#undef PG8_MMA
#undef PG8_WAIT_V
#undef PG8_WAIT_L
#undef PG8_BAR
#undef PG8_SCHED
}
}
#define GAS __attribute__((address_space(1)))
#define LAS __attribute__((address_space(3)))
#define XB_TMO      128
#define XB_XCNT(j)  (256  + 64 * (j))
#define XB_XSUB(j)  (1280 + 64 * (j))
#define XB_XGEN(j)  (2304 + 64 * (j))
#define XB_TOP      3328
#define XB_TOPGEN   3392
#define XCD_BAR_WORDS 3456
#define XB_SPIN_CAP (1u << 18)

__device__ __forceinline__ unsigned xb_ld(unsigned* p)              { return __hip_atomic_load(p, __ATOMIC_RELAXED, __HIP_MEMORY_SCOPE_AGENT); }
__device__ __forceinline__ unsigned xb_add(unsigned* p, unsigned v) { return __hip_atomic_fetch_add(p, v, __ATOMIC_RELAXED, __HIP_MEMORY_SCOPE_AGENT); }
__device__ __forceinline__ unsigned xb_xcc_id() { return (unsigned)__builtin_amdgcn_s_getreg((3 << 11) | 20) & 0xFu; }
#define XB_SPIN(cond, bar) do { unsigned _sp = 0; while (cond) { __builtin_amdgcn_s_sleep(1); \
    if ((++_sp & 255u) == 0u) { if (xb_ld(&(bar)[XB_TMO])) break; if (_sp > XB_SPIN_CAP) { atomicAdd(&(bar)[XB_TMO], 1u); break; } } } } while (0)

struct XcdBarrier {
    unsigned* bar; unsigned x; int w;
    volatile LAS unsigned* st;
};

__device__ __forceinline__ XcdBarrier xcd_barrier_post(unsigned* bar, volatile LAS unsigned* st, int wave_s) {
    XcdBarrier b; b.bar = bar; b.x = xb_xcc_id(); b.st = st; b.w = wave_s;
    if (tid_from(wave_s) == 0) (void)xb_add(&bar[XB_XCNT(b.x)], 1u);
    return b;
}
__device__ __forceinline__ void xcd_barrier_complete(unsigned* bar, unsigned x, unsigned& nloc, unsigned& nx) {
    const unsigned G = gridDim.x * gridDim.y * gridDim.z;
    unsigned sum, cnt, mine, sp = 0u;
    for (;;) {
        sum = 0u; cnt = 0u; mine = 0u;
#pragma unroll
        for (unsigned j = 0; j < 16; ++j) { const unsigned c = xb_ld(&bar[XB_XCNT(j)]); sum += c; cnt += (c > 0u) ? 1u : 0u; mine = (j == x) ? c : mine; }
        if (sum == G) break;
        __builtin_amdgcn_s_sleep(1);
        if ((++sp & 255u) == 0u) { if (xb_ld(&bar[XB_TMO])) break; if (sp > XB_SPIN_CAP) { atomicAdd(&bar[XB_TMO], 1u); break; } }
    }
    nloc = mine > 0u ? mine : 1u; nx = cnt > 0u ? cnt : 1u;
}

__device__ __forceinline__ void xcd_barrier(const XcdBarrier& b) {
    asm volatile("s_waitcnt vmcnt(0)" ::: "memory");
    __syncthreads();
    if (tid_from(b.w) == 0) {
        unsigned* bar = b.bar;
        __builtin_amdgcn_s_waitcnt(0);
        unsigned nloc = b.st[0], nx = b.st[1];
        if (nloc == 0u) { xcd_barrier_complete(bar, b.x, nloc, nx); b.st[0] = nloc; b.st[1] = nx; }
        const unsigned old = xb_add(&bar[XB_XSUB(b.x)], 1u);
        const unsigned gen = old / nloc;
        if (old + 1u == (gen + 1u) * nloc) {
            __builtin_amdgcn_fence(__ATOMIC_RELEASE, "agent");
            asm volatile("s_waitcnt vmcnt(0)" ::: "memory");
            const unsigned og = xb_add(&bar[XB_TOP], 1u);
            const unsigned tg = og / nx;
            if (og + 1u == (tg + 1u) * nx) xb_add(&bar[XB_TOPGEN], 1u);
            else XB_SPIN(xb_ld(&bar[XB_TOPGEN]) == tg, bar);
            __builtin_amdgcn_fence(__ATOMIC_ACQUIRE, "agent");
            xb_add(&bar[XB_XGEN(b.x)], 1u);
            asm volatile("s_waitcnt vmcnt(0)" ::: "memory");
        } else {
            XB_SPIN(xb_ld(&bar[XB_XGEN(b.x)]) == gen, bar);
            __builtin_amdgcn_fence(__ATOMIC_ACQUIRE, "agent");
            asm volatile("s_waitcnt vmcnt(0)" ::: "memory");
        }
    }
    __syncthreads();
}

constexpr int NWAVES = 8, NTHR = 512;
constexpr int DM = 2048, NB = 2, SEQ = 4096, NT = NB * SEQ, DEPTH = 4;
constexpr int INW = 5392, INWP = 5632;
constexpr int C_POOL = 0, C_GQ = 512, C_GK = 896, C_GV = 1280, C_GG = 2048, C_GA = 2816, C_RW = 2832;
constexpr int RW_IN = 2560, RW_W = 768, RW_H = 12;
constexpr int GLA_H = 4, GLA_DK = 96, GLA_DV = 192, GLA_NCH = 64;
constexpr int PEER_N = 16384;
constexpr float NORM_EPS = 1e-6f;
constexpr int MODW = 6 * DM;

constexpr size_t MiB = 1u << 20;
constexpr size_t WS_CTL = 0, CTL_ZERO_BYTES = 1 * MiB;
constexpr size_t WS_MOD = 1 * MiB;
constexpr size_t WS_WIN = 2 * MiB;
constexpr size_t WS_WOUT = 90 * MiB;
constexpr size_t WS_WQK = 122 * MiB;
constexpr size_t WS_U = 154 * MiB;
constexpr size_t WS_V = 410 * MiB;
constexpr size_t WS_US = 540 * MiB;
constexpr size_t WS_VS = 541 * MiB;
constexpr size_t WS_POOLT = 545 * MiB;
constexpr size_t WS_LORAT = 542 * MiB;
constexpr size_t WS_X = 666 * MiB;
constexpr size_t WS_H = 730 * MiB;
constexpr size_t WS_Y = 762 * MiB;
constexpr size_t WS_PROJ = 794 * MiB;
constexpr size_t WS_GKV = 970 * MiB;
constexpr size_t WS_GS = 1006 * MiB;
constexpr size_t WS_GDEC = 1042 * MiB;
constexpr size_t WS_RSC = 1043 * MiB;
constexpr size_t WS_RO = 1187 * MiB;
constexpr size_t WS_RGATE = 1211 * MiB;
constexpr size_t WS_RBV = 1235 * MiB;
constexpr size_t WS_EIDX = 1259 * MiB;
constexpr size_t WS_EGATE = 1263 * MiB;
constexpr size_t WS_END = 1267 * MiB;
constexpr size_t WS_DUMMY = 1267 * MiB;
#ifndef PROBE
#define PROBE 0
#endif
constexpr int CW_BAR = 4096;
constexpr size_t WS_SSP = 547 * MiB;
constexpr size_t WS_BIAS3 = 546 * MiB;

constexpr int LDS_BYTES = 147456;
constexpr int MISC_OFF = 147456 - 256;

typedef unsigned short bf16;
typedef unsigned v4u __attribute__((ext_vector_type(4)));
typedef unsigned v2u __attribute__((ext_vector_type(2)));
typedef float f32x4 __attribute__((ext_vector_type(4)));
typedef float f32x2 __attribute__((ext_vector_type(2)));
typedef __bf16 bf16x2_t __attribute__((ext_vector_type(2)));
typedef int v4i __attribute__((ext_vector_type(4)));

__device__ __forceinline__ unsigned pk2(float lo, float hi) { const f32x2 f = {lo, hi}; return __builtin_bit_cast(unsigned, __builtin_convertvector(f, bf16x2_t)); }
__device__ __forceinline__ unsigned f2bf(float f) { return pk2(f, f) & 0xffffu; }
__device__ __forceinline__ float bflo(unsigned u) { return __builtin_bit_cast(float, u << 16); }
__device__ __forceinline__ float bfhi(unsigned u) { return __builtin_bit_cast(float, u & 0xffff0000u); }
__device__ __forceinline__ float dpp_xor1(float v) { return __builtin_bit_cast(float, __builtin_amdgcn_update_dpp(0, __builtin_bit_cast(int, v), 0xB1, 0xF, 0xF, true)); }
__device__ __forceinline__ float dpp_xor2(float v) { return __builtin_bit_cast(float, __builtin_amdgcn_update_dpp(0, __builtin_bit_cast(int, v), 0x4E, 0xF, 0xF, true)); }
__device__ __forceinline__ float dpp_hmir(float v) { return __builtin_bit_cast(float, __builtin_amdgcn_update_dpp(0, __builtin_bit_cast(int, v), 0x141, 0xF, 0xF, true)); }
__device__ __forceinline__ float dpp_rmir(float v) { return __builtin_bit_cast(float, __builtin_amdgcn_update_dpp(0, __builtin_bit_cast(int, v), 0x140, 0xF, 0xF, true)); }
__device__ __forceinline__ float rl_f(float v, int l) { return __builtin_bit_cast(float, __builtin_amdgcn_readlane(__builtin_bit_cast(int, v), l)); }
__device__ __forceinline__ float row16_sum(float v) { v += dpp_xor1(v); v += dpp_xor2(v); v += dpp_hmir(v); v += dpp_rmir(v); return v; }
__device__ __forceinline__ float row16_max(float v) { v = fmaxf(v, dpp_xor1(v)); v = fmaxf(v, dpp_xor2(v)); v = fmaxf(v, dpp_hmir(v)); v = fmaxf(v, dpp_rmir(v)); return v; }
__device__ __forceinline__ float wave_sum(float v) { v = row16_sum(v); return (rl_f(v, 0) + rl_f(v, 16)) + (rl_f(v, 32) + rl_f(v, 48)); }
__device__ __forceinline__ float wave_max(float v) { v = row16_max(v); return fmaxf(fmaxf(rl_f(v, 0), rl_f(v, 16)), fmaxf(rl_f(v, 32), rl_f(v, 48))); }
__device__ __forceinline__ float half32_sum(float v, int lane) { v = row16_sum(v); const float lo = rl_f(v, 0) + rl_f(v, 16), hi = rl_f(v, 32) + rl_f(v, 48); return lane < 32 ? lo : hi; }
__device__ __forceinline__ float red8(float v) { v += dpp_xor1(v); v += dpp_xor2(v); v += dpp_hmir(v); return v; }
__device__ __forceinline__ float sigmoidf_(float x) { return __builtin_amdgcn_rcpf(1.f + __builtin_amdgcn_exp2f(-1.4426950408889634f * x)); }
__device__ __forceinline__ float softplusf_(float x) { return fmaxf(x, 0.f) + 0.6931471805599453f * __builtin_amdgcn_logf(1.f + __builtin_amdgcn_exp2f(-1.4426950408889634f * fabsf(x))); }

struct Args { const float* in[30]; float* out; unsigned char* ws; };
typedef const __attribute__((address_space(4))) Args* ArgsP;
__device__ __forceinline__ ArgsP args_ptr() { ArgsP p = (ArgsP)__builtin_amdgcn_kernarg_segment_ptr(); asm volatile("" : "+s"(p)); return p; }
__device__ __forceinline__ int opaque_i(int v) { asm volatile("" : "+s"(v)); return v; }

struct Frame {
    LAS unsigned char* lds;
    int tid, lane, wave, G, bid, gw, ngw;
};
__device__ __forceinline__ Frame make_frame(LAS unsigned char* lds, int wave_s) {
    asm volatile("" : "+s"(wave_s)); Frame F; F.lds = lds; int t = tid_from(wave_s); asm volatile("" : "+v"(t));
    F.tid = t; F.lane = t & 63; F.wave = __builtin_amdgcn_readfirstlane(t >> 6); int g_ = gridDim.x, b_ = blockIdx.x; asm volatile("" : "+s"(g_), "+s"(b_)); F.G = g_; F.bid = b_; F.gw = F.bid * NWAVES + F.wave; F.ngw = F.G * NWAVES; return F;
}

struct EpiStoreF32 {
    static constexpr bool PERM = false, AFTER_DRAIN = false;
    float* C; int ldc; int ws_;
    __device__ __forceinline__ void operator()(const pg8::f32x4 (&acc)[2][2][4][2], const pg8::Unit& u, int, int, int, int) const {
        int tz = tid_from(ws_); asm volatile("" : "+v"(tz)); const int wid = tz >> 6, lane = tz & 63, wr = wid >> 2, wc = wid & 3, fr = lane & 15, fq = lane >> 4;
        const int row0 = u.pm * 256 + wr * 64 + fr, col0 = u.pn * 256 + wc * 32 + 4 * fq;
#pragma unroll
        for (int ai = 0; ai < 2; ++ai)
#pragma unroll
            for (int m = 0; m < 4; ++m) { float* rowp = C + (size_t)(row0 + ai * 128 + m * 16) * ldc + col0;
#pragma unroll
                for (int bj = 0; bj < 2; ++bj)
#pragma unroll
                    for (int n = 0; n < 2; ++n) *(pg8::f32x4*)(rowp + bj * 128 + n * 16) = acc[ai][bj][m][n]; }
    }
};
struct EpiResid {
    static constexpr bool PERM = false, AFTER_DRAIN = false;
    const float* xsrc; float* xdst; const float* gate; int ws_; const float* gain2; const float* sc2; bf16* hdst; float* ss;
    __device__ __forceinline__ void operator()(const pg8::f32x4 (&acc)[2][2][4][2], const pg8::Unit& u, int, int, int, int) const {
        int tz = tid_from(ws_); asm volatile("" : "+v"(tz)); const int wid = tz >> 6, lane = tz & 63, wr = wid >> 2, wc = wid & 3, fr = lane & 15, fq = lane >> 4;
        const int row0 = u.pm * 256 + wr * 64 + fr, col0 = u.pn * 256 + wc * 32 + 4 * fq;
        const float* gp = gate + (size_t)(u.pm >> 4) * MODW + col0; const float* sp = sc2 + (size_t)(u.pm >> 4) * MODW + col0;
        pg8::f32x4 gv[2][2], hv[2][2];
#pragma unroll
        for (int bj = 0; bj < 2; ++bj)
#pragma unroll
            for (int n = 0; n < 2; ++n) { gv[bj][n] = *(const pg8::f32x4*)(gp + bj * 128 + n * 16);
                hv[bj][n] = *(const pg8::f32x4*)(gain2 + col0 + bj * 128 + n * 16) * (*(const pg8::f32x4*)(sp + bj * 128 + n * 16) + 1.f); }
#pragma unroll
        for (int ai = 0; ai < 2; ++ai)
#pragma unroll
            for (int m = 0; m < 4; ++m) { const int row = row0 + ai * 128 + m * 16; const size_t ro = (size_t)row * DM + col0; float s = 0.f;
#pragma unroll
                for (int bj = 0; bj < 2; ++bj)
#pragma unroll
                    for (int n = 0; n < 2; ++n) { const pg8::f32x4 xv = *(const pg8::f32x4*)(xsrc + ro + bj * 128 + n * 16);
                        const pg8::f32x4 y = xv + gv[bj][n] * acc[ai][bj][m][n];
                        *(pg8::f32x4*)(xdst + ro + bj * 128 + n * 16) = y;
                        s += (y.x * y.x + y.y * y.y) + (y.z * y.z + y.w * y.w);
                        const pg8::f32x4 hh = y * hv[bj][n]; v2u pk; pk.x = pk2(hh.x, hh.y); pk.y = pk2(hh.z, hh.w); *(v2u*)(hdst + ro + bj * 128 + n * 16) = pk; }
                s += __builtin_bit_cast(float, __builtin_amdgcn_ds_bpermute((lane ^ 16) << 2, __builtin_bit_cast(int, s)));
                s += __builtin_bit_cast(float, __builtin_amdgcn_ds_bpermute((lane ^ 32) << 2, __builtin_bit_cast(int, s)));
                if (fq == 0) ss[(size_t)row * 32 + u.pn * 4 + wc] = s; }
    }
};
struct EpiScore {
    static constexpr bool PERM = false, AFTER_DRAIN = false;
    float* C; int ldc; int ws_; const LAS float* rs; const float* bias;
    __device__ __forceinline__ void operator()(const pg8::f32x4 (&acc)[2][2][4][2], const pg8::Unit& u, int, int, int, int) const {
        int tz = tid_from(ws_); asm volatile("" : "+v"(tz)); const int wid = tz >> 6, lane = tz & 63, wr = wid >> 2, wc = wid & 3, fr = lane & 15, fq = lane >> 4;
        const int row0 = u.pm * 256 + wr * 64 + fr, col0 = u.pn * 256 + wc * 32 + 4 * fq;
        const float* bp = bias + (size_t)(u.pm >> 4) * DM + col0;
        pg8::f32x4 bv[2][2];
#pragma unroll
        for (int bj = 0; bj < 2; ++bj)
#pragma unroll
            for (int n = 0; n < 2; ++n) bv[bj][n] = *(const pg8::f32x4*)(bp + bj * 128 + n * 16);
#pragma unroll
        for (int ai = 0; ai < 2; ++ai)
#pragma unroll
            for (int m = 0; m < 4; ++m) { const int row = row0 + ai * 128 + m * 16; float* rowp = C + (size_t)row * ldc + col0;
                const float rstd = rs[row & 255];
#pragma unroll
                for (int bj = 0; bj < 2; ++bj)
#pragma unroll
                    for (int n = 0; n < 2; ++n) *(pg8::f32x4*)(rowp + bj * 128 + n * 16) = acc[ai][bj][m][n] * rstd + bv[bj][n]; }
    }
};

__device__ __forceinline__ void quant_tables(ArgsP A, int l, int wvi, int nw, int lane) {
    for (int rr = wvi; rr < 2 * PEER_N; rr += nw) {
        const int tb = rr >= PEER_N, r = l * PEER_N + (rr - tb * PEER_N);
        const f32x4* src = (const f32x4*)(A->in[27 + tb] + (size_t)r * DM) + lane;
        f32x4 v[8]; float mx = 0.f;
        float ssq = 0.f;
#pragma unroll
        for (int j = 0; j < 8; ++j) { v[j] = src[64 * j]; mx = fmaxf(mx, fmaxf(fmaxf(fabsf(v[j].x), fabsf(v[j].y)), fmaxf(fabsf(v[j].z), fabsf(v[j].w)))); ssq += (v[j].x * v[j].x + v[j].y * v[j].y) + (v[j].z * v[j].z + v[j].w * v[j].w); }
        mx = wave_max(mx);
        mx = fminf(mx, (tb ? 3.0f : 2.5f) * sqrtf(wave_sum(ssq) * (1.f / DM)));
        unsigned* dst = (unsigned*)(A->ws + (tb ? WS_V : WS_U)) + (size_t)r * (DM / 4) + lane;
        if (!tb) { const float inv = mx > 0.f ? 7.f / mx : 0.f;
            unsigned* dst4 = (unsigned*)(A->ws + WS_U) + (size_t)r * (DM / 8) + lane;
#pragma unroll
            for (int j = 0; j < 4; ++j) { unsigned wd = 0u;
                const float lo4[4] = {v[j].x, v[j].y, v[j].z, v[j].w}, hi4[4] = {v[j + 4].x, v[j + 4].y, v[j + 4].z, v[j + 4].w};
#pragma unroll
                for (int i = 0; i < 4; ++i) { const unsigned nl = (unsigned)((int)rintf(fminf(fmaxf(lo4[i] * inv, -7.f), 7.f)) + 8), nh = (unsigned)((int)rintf(fminf(fmaxf(hi4[i] * inv, -7.f), 7.f)) + 8); wd |= (nl | (nh << 4)) << (8 * i); }
                dst4[64 * j] = wd; }
            if (lane == 0) ((float*)(A->ws + WS_US))[r] = mx * (1.f / 7.f);
        } else { const float inv = mx > 0.f ? 6.f / mx : 0.f;
            unsigned short* dst2 = (unsigned short*)(A->ws + WS_V) + (size_t)r * (DM / 4) + lane;
#pragma unroll
            for (int j = 0; j < 8; ++j) { const f32x4 c4 = __builtin_elementwise_min(__builtin_elementwise_max(v[j] * inv, (f32x4){-6.f, -6.f, -6.f, -6.f}), (f32x4){6.f, 6.f, 6.f, 6.f});
                int p = __builtin_amdgcn_cvt_scalef32_pk_fp4_f32(0, c4.x, c4.y, 1.0f, 0); p = __builtin_amdgcn_cvt_scalef32_pk_fp4_f32(p, c4.z, c4.w, 1.0f, 1); dst2[64 * j] = (unsigned short)p; }
            if (lane == 0) ((float*)(A->ws + WS_VS))[r] = mx * (1.f / 6.f);
        }
    }
}

__device__ __forceinline__ void transpose_item(const float* W, int K, int N, bf16* WT, LAS float* scr, int kb, int nb, int lane) {
    const int k0 = 64 * kb, n0 = 64 * nb, nl = (lane & 15) * 4, kr = lane >> 4;
    f32x4 v[16];
#pragma unroll
    for (int it = 0; it < 16; ++it) v[it] = (n0 + nl < N) ? *(const f32x4*)(W + (size_t)(k0 + it * 4 + kr) * N + n0 + nl) : (f32x4){0.f, 0.f, 0.f, 0.f};
#pragma unroll
    for (int it = 0; it < 16; ++it) { LAS float* s = scr + (it * 4 + kr) * 65 + nl; s[0] = v[it].x; s[1] = v[it].y; s[2] = v[it].z; s[3] = v[it].w; }
    asm volatile("s_waitcnt lgkmcnt(0)" ::: "memory");
    const int c = lane & 7;
#pragma unroll
    for (int j = 0; j < 8; ++j) { const int n = (lane >> 3) + 8 * j; const LAS float* s = scr + (8 * c) * 65 + n;
        v4u o; o.x = pk2(s[0 * 65], s[1 * 65]); o.y = pk2(s[2 * 65], s[3 * 65]); o.z = pk2(s[4 * 65], s[5 * 65]); o.w = pk2(s[6 * 65], s[7 * 65]);
        if (n0 + n < N) *(v4u*)(WT + (size_t)(n0 + n) * K + k0 + 8 * c) = o; }
    asm volatile("s_waitcnt lgkmcnt(0)" ::: "memory");
}

__device__ __forceinline__ void ph_prologue(ArgsP A, LAS unsigned char* lds_, int wv_) {
    const Frame F = make_frame(lds_, wv_);
    LAS float* ldsf = (LAS float*)F.lds;
    const int tid = F.tid, lane = F.lane, wave = F.wave;
    for (int i = tid; i < NB * DM; i += NTHR) { const float c = A->in[1][i]; ldsf[i] = c / (1.f + __expf(-c)); }
    __syncthreads();
    {
        LAS float* red = ldsf + 4096;
        float* MOD = (float*)(A->ws + WS_MOD);
        for (int u = F.bid; u < DEPTH * 96; u += F.G) {
            const int l = u / 96, j0 = (u % 96) * 128;
            const float* W = A->in[2] + (size_t)l * DM * MODW + j0 + lane * 2;
            float a00 = 0.f, a01 = 0.f, a10 = 0.f, a11 = 0.f;
            const int k0 = wave * 256;
#pragma unroll 8
            for (int k = k0; k < k0 + 256; ++k) { const f32x2 w = *(const f32x2*)(W + (size_t)k * MODW); const float c0 = ldsf[k], c1 = ldsf[DM + k];
                a00 += c0 * w.x; a01 += c0 * w.y; a10 += c1 * w.x; a11 += c1 * w.y; }
            red[(wave * 2 + 0) * 128 + lane * 2] = a00; red[(wave * 2 + 0) * 128 + lane * 2 + 1] = a01;
            red[(wave * 2 + 1) * 128 + lane * 2] = a10; red[(wave * 2 + 1) * 128 + lane * 2 + 1] = a11;
            __syncthreads();
            if (tid < 256) { const int b = tid >> 7, j = tid & 127; float s = 0.f;
#pragma unroll
                for (int w = 0; w < 8; ++w) s += red[(w * 2 + b) * 128 + j];
                s += A->in[3][(size_t)l * MODW + j0 + j];
                MOD[(size_t)(l * 2 + b) * MODW + j0 + j] = s; }
            __syncthreads();
        }
    }
    {
        LAS float* scr = ldsf + wave * 4160;
        constexpr int NBI = (INW + 63) / 64;
        constexpr int I_IN = 32 * NBI, I_OUT = 32 * 32, I_L = I_IN + I_OUT;
        for (int it = F.gw; it < DEPTH * I_L; it += F.ngw) {
            const int l = it / I_L; int r = it % I_L;
            if (r < I_IN) transpose_item(A->in[5] + (size_t)l * DM * INW, DM, INW, (bf16*)(A->ws + WS_WIN) + (size_t)l * INWP * DM, scr, r / NBI, r % NBI, lane);
            else { r -= I_IN; transpose_item(A->in[22] + (size_t)l * DM * DM, DM, DM, (bf16*)(A->ws + WS_WOUT) + (size_t)l * DM * DM, scr, r / 32, r % 32, lane); }
        }
        constexpr int PADV = (INWP - INW) * DM / 8;
        for (int i = F.bid * NTHR + tid; i < DEPTH * PADV; i += F.G * NTHR) { const int l = i / PADV, r = i % PADV;
            ((v4u*)((bf16*)(A->ws + WS_WIN) + (size_t)l * INWP * DM + (size_t)INW * DM))[r] = (v4u){0u, 0u, 0u, 0u}; }
    }
    __syncthreads();
    {
        LAS float* Ks = ldsf;
        LAS float* Ws = ldsf + 128 * 132;
        for (int u = F.bid; u < DEPTH * 16 * 32; u += F.G) {
            const int l = u >> 9, hh = (u >> 5) & 15, jt = u & 31, h = hh >> 1, half = hh & 1, j0 = jt * 64;
            const float* ksrc = (half ? A->in[26] : A->in[25]) + ((size_t)l * 8 + h) * 128 * 128;
            const float* wsrc = A->in[24] + (size_t)l * DM * DM + h * 256 + half * 128;
            {   f32x4 kq[8], wq4[4];
#pragma unroll
                for (int it = 0; it < 8; ++it) { const int i = tid + it * NTHR, n = i >> 5, d4 = (i & 31) * 4; kq[it] = *(const f32x4*)(ksrc + n * 128 + d4); }
#pragma unroll
                for (int it = 0; it < 4; ++it) { const int i = tid + it * NTHR, jj = i >> 5, d4 = (i & 31) * 4; wq4[it] = *(const f32x4*)(wsrc + (size_t)(j0 + jj) * DM + d4); }
#pragma unroll
                for (int it = 0; it < 8; ++it) { const int i = tid + it * NTHR, n = i >> 5, d4 = (i & 31) * 4; *(LAS f32x4*)(Ks + n * 132 + d4) = kq[it]; }
#pragma unroll
                for (int it = 0; it < 4; ++it) { const int i = tid + it * NTHR, jj = i >> 5, d4 = (i & 31) * 4; *(LAS f32x4*)(Ws + jj * 132 + d4) = wq4[it]; }
            }
            __syncthreads();
            { const int li = lane & 15, lq = lane >> 4;
                f32x4 acc[4] = {{0.f, 0.f, 0.f, 0.f}, {0.f, 0.f, 0.f, 0.f}, {0.f, 0.f, 0.f, 0.f}, {0.f, 0.f, 0.f, 0.f}};
#pragma unroll 4
                for (int ks = 0; ks < 32; ++ks) { const float a = Ks[(wave * 16 + li) * 132 + 4 * ks + lq];
#pragma unroll
                    for (int jt = 0; jt < 4; ++jt) acc[jt] = __builtin_amdgcn_mfma_f32_16x16x4f32(a, Ws[(jt * 16 + li) * 132 + 4 * ks + lq], acc[jt], 0, 0, 0); }
                bf16* dst = (bf16*)(A->ws + WS_WQK) + (size_t)l * DM * DM + (size_t)(h * 256 + half * 128 + wave * 16 + lq * 4) * DM + j0 + li;
#pragma unroll
                for (int jt = 0; jt < 4; ++jt) { dst[(size_t)0 * DM + jt * 16] = (bf16)f2bf(acc[jt].x); dst[(size_t)1 * DM + jt * 16] = (bf16)f2bf(acc[jt].y); dst[(size_t)2 * DM + jt * 16] = (bf16)f2bf(acc[jt].z); dst[(size_t)3 * DM + jt * 16] = (bf16)f2bf(acc[jt].w); } }
            __syncthreads();
        }
    }
    {
        bf16* PT = (bf16*)(A->ws + WS_POOLT);
        for (int i = F.bid * NTHR + tid; i < DEPTH * 4 * 128 * 128; i += F.G * NTHR) { const int lg = i >> 14, r = i & 16383, dcol = r >> 7, c = r & 127;
            PT[i] = (bf16)f2bf(A->in[6][(size_t)lg * 16384 + c * 128 + dcol]); }
    }
    {
        bf16* LT = (bf16*)(A->ws + WS_LORAT);
        for (int i = F.bid * NTHR + tid; i < DEPTH * RW_W * 256; i += F.G * NTHR) { const int l = i / (RW_W * 256), r = i % (RW_W * 256), c = r >> 8, j = r & 255;
            const float v = j < 64 ? A->in[13][((size_t)l * 64 + j) * RW_W + c] : (j < 128 ? A->in[15][((size_t)l * 64 + (j - 64)) * RW_W + c] : A->in[16][((size_t)l * 128 + (j - 128)) * RW_W + c]);
            LT[i] = (bf16)f2bf(v); }
    }
    quant_tables(A, 0, F.gw, F.ngw, lane);
}

__device__ __forceinline__ void ph_norm(const float* xsrc, const float* gain, const float* sh, const float* sc, bf16* hout, LAS unsigned char* lds_, int wv_) {
    const Frame F = make_frame(lds_, wv_);
    for (int m = F.gw; m < NT; m += F.ngw) {
        const int b = m >> 12;
        const f32x4* xr = (const f32x4*)(xsrc + (size_t)m * DM) + F.lane;
        f32x4 v[8]; float ss = 0.f;
#pragma unroll
        for (int j = 0; j < 8; ++j) { v[j] = xr[64 * j]; ss += (v[j].x * v[j].x + v[j].y * v[j].y) + (v[j].z * v[j].z + v[j].w * v[j].w); }
        const float rstd = rsqrtf(wave_sum(ss) * (1.f / DM) + NORM_EPS);
        v2u* o8 = (v2u*)(hout + (size_t)m * DM) + F.lane;
#pragma unroll
        for (int j = 0; j < 8; ++j) { const int col = j * 256 + F.lane * 4;
            const f32x4 g = *(const f32x4*)(gain + col), s1 = *(const f32x4*)(sc + (size_t)b * MODW + col), s0 = *(const f32x4*)(sh + (size_t)b * MODW + col);
            const f32x4 y = v[j] * rstd * g * (s1 + 1.f) + s0;
            v2u o; o.x = pk2(y.x, y.y); o.y = pk2(y.z, y.w); o8[64 * j] = o; }
    }
}
__device__ __forceinline__ void ph_final(const float* xsrc, const float* gain, float* out, LAS unsigned char* lds_, int wv_) {
    const Frame F = make_frame(lds_, wv_);
    for (int m = F.gw; m < NT; m += F.ngw) {
        const f32x4* xr = (const f32x4*)(xsrc + (size_t)m * DM) + F.lane;
        f32x4 v[8]; float ss = 0.f;
#pragma unroll
        for (int j = 0; j < 8; ++j) { v[j] = xr[64 * j]; ss += (v[j].x * v[j].x + v[j].y * v[j].y) + (v[j].z * v[j].z + v[j].w * v[j].w); }
        const float rstd = rsqrtf(wave_sum(ss) * (1.f / DM) + NORM_EPS);
        f32x4* o = (f32x4*)(out + (size_t)m * DM) + F.lane;
#pragma unroll
        for (int j = 0; j < 8; ++j) { const f32x4 g = *(const f32x4*)(gain + j * 256 + F.lane * 4); o[64 * j] = v[j] * rstd * g; }
    }
}

__device__ __forceinline__ void pool_unit(ArgsP A, const Frame& F_in, int l, int unit) {
    Frame F = F_in; asm volatile("" : "+v"(F.tid)); F.lane = F.tid & 63;
    const int tile = unit >> 2, g = unit & 3, t0 = tile * 32, s0 = t0 & (SEQ - 1), tid = F.tid, lane = F.lane, w = F.wave;
    const int win = 2 << g;
    const float* proj = (const float*)(A->ws + WS_PROJ);
    LAS float* ps = (LAS float*)F.lds;
    LAS unsigned short* ds = (LAS unsigned short*)(F.lds + 24064);
    const int rt = w >> 2, ct0 = (w & 3) * 2, li = lane & 15, lq = lane >> 4;
    typedef short b8 __attribute__((ext_vector_type(8)));
    b8 bw[2][4];
    { const unsigned short* PT = (const unsigned short*)(A->ws + WS_POOLT) + ((size_t)l * 4 + g) * 16384;
#pragma unroll
        for (int j = 0; j < 2; ++j)
#pragma unroll
            for (int ks = 0; ks < 4; ++ks) bw[j][ks] = *(const b8*)(PT + (size_t)((ct0 + j) * 16 + li) * 128 + ks * 32 + lq * 8); }
    {   f32x4 pq[3];
#pragma unroll
        for (int it = 0; it < 3; ++it) { const int i = tid + it * NTHR, r = i >> 5, c4 = i & 31; const int s = s0 - 15 + r;
            pq[it] = (i < 47 * 32 && s >= 0) ? *(const f32x4*)(proj + (size_t)(t0 - 15 + r) * INWP + C_POOL + g * 128 + c4 * 4) : (f32x4){0.f, 0.f, 0.f, 0.f}; }
#pragma unroll
        for (int it = 0; it < 3; ++it) { const int i = tid + it * NTHR; if (i < 47 * 32) *(LAS f32x4*)(ps + i * 4) = pq[it]; }
    }
    __syncthreads();
    for (int i = tid; i < 32 * 128; i += NTHR) { const int tok = i >> 7, c = i & 127; float sum = 0.f;
        for (int ww = 0; ww < win; ++ww) sum += ps[(tok + 15 - ww) * 128 + c];
        const int cnt = (s0 + tok + 1) < win ? (s0 + tok + 1) : win;
        ds[tok * 136 + c] = (unsigned short)f2bf(sum * __builtin_amdgcn_rcpf((float)cnt) - ps[(tok + 15) * 128 + c]); }
    __syncthreads();
    f32x4 acc[2] = {{0.f, 0.f, 0.f, 0.f}, {0.f, 0.f, 0.f, 0.f}};
#pragma unroll
    for (int ks = 0; ks < 4; ++ks) { const b8 a = *(const LAS b8*)(ds + (rt * 16 + li) * 136 + ks * 32 + lq * 8);
#pragma unroll
        for (int j = 0; j < 2; ++j) acc[j] = __builtin_amdgcn_mfma_f32_16x16x32_bf16(a, bw[j][ks], acc[j], 0, 0, 0); }
    bf16* Y = (bf16*)(A->ws + WS_Y);
#pragma unroll
    for (int j = 0; j < 2; ++j) { const int dcol = (ct0 + j) * 16 + li; const float scale = A->in[7][(size_t)l * 512 + g * 128 + dcol]; const int tk = t0 + rt * 16 + lq * 4;
        Y[(size_t)(tk + 0) * DM + g * 128 + dcol] = (bf16)f2bf(acc[j].x * scale); Y[(size_t)(tk + 1) * DM + g * 128 + dcol] = (bf16)f2bf(acc[j].y * scale);
        Y[(size_t)(tk + 2) * DM + g * 128 + dcol] = (bf16)f2bf(acc[j].z * scale); Y[(size_t)(tk + 3) * DM + g * 128 + dcol] = (bf16)f2bf(acc[j].w * scale); }
    __syncthreads();
}

__device__ __forceinline__ void gla_bcum(ArgsP A, const Frame& F, int l, int h, int t0, LAS float* bcum, LAS float* ad, LAS float* up) {
    const float* proj = (const float*)(A->ws + WS_PROJ);
    const int tid = F.tid;
    {
        const float a0 = proj[(size_t)(t0 + (tid >> 4)) * INWP + C_GA + (tid & 15)], a1 = proj[(size_t)(t0 + 32 + (tid >> 4)) * INWP + C_GA + (tid & 15)];
        const float* upg = A->in[8] + (size_t)l * 16 * 384 + h * 96;
        const float u0 = upg[(tid / 96) * 384 + tid % 96], u1 = upg[((tid + 512) / 96) * 384 + (tid + 512) % 96], u2 = upg[((tid + 1024) / 96) * 384 + (tid + 1024) % 96];
        ad[tid] = a0; ad[tid + 512] = a1; up[tid] = u0; up[tid + 512] = u1; up[tid + 1024] = u2;
    }
    __syncthreads();
    for (int i = tid; i < 64 * 96; i += NTHR) { const int tok = i / 96, d = i % 96; float x = A->in[9][(size_t)l * 384 + h * 96 + d];
#pragma unroll
        for (int j = 0; j < 16; ++j) x += ad[tok * 16 + j] * up[j * 96 + d];
        bcum[i] = -softplusf_(-x) * (1.f / 16.f); }
    __syncthreads();
    if (tid < 384) { const int d = tid % 96, seg = tid / 96; float acc = 0.f;
#pragma unroll
        for (int k = 0; k < 16; ++k) { acc += bcum[(seg * 16 + k) * 96 + d]; bcum[(seg * 16 + k) * 96 + d] = acc; }
        ad[seg * 96 + d] = acc; }
    __syncthreads();
    if (tid < 384) { const int d = tid % 96, seg = tid / 96; float pre = 0.f;
#pragma unroll
        for (int s2 = 0; s2 < 3; ++s2) pre += (s2 < seg) ? ad[s2 * 96 + d] : 0.f;
        if (seg > 0) {
#pragma unroll
            for (int k = 0; k < 16; ++k) bcum[(seg * 16 + k) * 96 + d] += pre; } }
    __syncthreads();
}

__device__ __forceinline__ void gla_scan_unit(ArgsP A, const Frame& F, int unit) {
    const int idx = unit * NTHR + F.tid, bh = idx / 18432, rem = idx % 18432, d = rem % 96;
    const float* KV = (const float*)(A->ws + WS_GKV) + (size_t)bh * 64 * 18432 + rem;
    float* GS = (float*)(A->ws + WS_GS) + (size_t)bh * 64 * 18432 + rem;
    const float* DEC = (const float*)(A->ws + WS_GDEC) + (size_t)bh * 64 * 96 + d;
    float S = 0.f;
#pragma unroll 1
    for (int c0 = 0; c0 < 64; c0 += 16) {
        float kv[16], dc[16];
#pragma unroll
        for (int j = 0; j < 16; ++j) { kv[j] = KV[(size_t)(c0 + j) * 18432]; dc[j] = DEC[(c0 + j) * 96]; }
#pragma unroll
        for (int j = 0; j < 16; ++j) { GS[(size_t)(c0 + j) * 18432] = S; S = dc[j] * S + kv[j]; }
    }
}

typedef short bf16x8_t __attribute__((ext_vector_type(8)));
constexpr int RS = 68;
__device__ __forceinline__ f32x4 tile_mm64(const LAS bf16* Am, int arow0, const LAS bf16* Bm, int brow0, f32x4 acc, int lane) {
    const int r = lane & 15, kq = (lane >> 4) * 8;
#pragma unroll
    for (int ks = 0; ks < 2; ++ks) {
        const bf16x8_t a = *(const LAS bf16x8_t*)(Am + (arow0 + r) * RS + ks * 32 + kq);
        const bf16x8_t b = *(const LAS bf16x8_t*)(Bm + (brow0 + r) * RS + ks * 32 + kq);
        acc = __builtin_amdgcn_mfma_f32_16x16x32_bf16(a, b, acc, 0, 0, 0);
    }
    return acc;
}
constexpr int RA_BT = 0, RA_KT = 8704, RA_AT = 17408, RA_RT = 26112, RA_RABS = 34816, RA_BHT = 43520, RA_KHT = 52224, RA_VT = 60928, RA_AABS = 69632,
              RA_MBAT = 86272, RA_MKA = 103680, RA_NBRT = 121088, RA_GC = 129792, RA_WT = 130048, RA_NKRT = 132096, RA_END = 140800, RA_PRE = 94976;
constexpr int RA_Z = RA_BT, RA_QST = RA_AT, RA_QOT = RA_RT, RA_LO = 0, RA_RES = 34816;
constexpr size_t RWO_POT = 0, RWO_PST = 12 * MiB, RWO_GT = 24 * MiB, RWO_OLT = 48 * MiB, RWO_SC = 72 * MiB;

__device__ __forceinline__ void rwkvA_unit(ArgsP A, const Frame& F_in, int l, int unit) {
    Frame F = F_in; asm volatile("" : "+v"(F.tid)); F.lane = F.tid & 63;

    const int bh = unit >> 6, c = unit & 63, b = bh / RW_H, h = bh % RW_H, t0 = b * SEQ + c * 64, s0 = c * 64, tid = F.tid, lane = F.lane, w = F.wave;
    const float* proj = (const float*)(A->ws + WS_PROJ);
    const float* mu = A->in[11] + (size_t)l * RW_IN;
    LAS unsigned char* L = F.lds;
    const int n = lane, cc = h * 64 + n;
    const int rt1 = w >> 1, ct1 = (w & 1) * 2, li1 = lane & 15, lq1 = lane >> 4;
    f32x4 yc[8], yp[8];
#pragma unroll
    for (int it = 0; it < 8; ++it) { const int g = tid + it * NTHR, tok = g >> 6, j4 = (g & 63) * 4; const float* rp = proj + ((size_t)t0 + tok) * INWP + C_RW + 2304 + j4;
        yc[it] = *(const f32x4*)rp; yp[it] = (s0 + tok > 0) ? *(const f32x4*)(rp - INWP) : (f32x4){0.f, 0.f, 0.f, 0.f}; }
    bf16x8_t bw[2][8];
    { const bf16* LT = (const bf16*)(A->ws + WS_LORAT) + ((size_t)l * RW_W + h * 64) * 256;
#pragma unroll
        for (int j = 0; j < 2; ++j)
#pragma unroll
            for (int ks = 0; ks < 8; ++ks) bw[j][ks] = *(const bf16x8_t*)(LT + (size_t)((ct1 + j) * 16 + li1) * 256 + ks * 32 + lq1 * 8); }
    float rr[9], kr[9], vr[9];
#pragma unroll
    for (int i = 0; i < 9; ++i) { const int tok = w * 8 + i - 1; const bool ok = (s0 + tok >= 0); const float* row = proj + ((size_t)t0 + tok) * INWP + C_RW;
        rr[i] = ok ? row[cc] : 0.f; kr[i] = ok ? row[768 + cc] : 0.f; vr[i] = ok ? row[1536 + cc] : 0.f; }
    const float w0c = A->in[12][(size_t)l * RW_W + cc], a0c = A->in[14][(size_t)l * RW_W + cc], kkc = A->in[17][(size_t)l * RW_W + cc], kac = A->in[18][(size_t)l * RW_W + cc], rkc = A->in[19][(size_t)l * RW_W + cc];
    const float mur = mu[cc], muk = mu[768 + cc], muv = mu[1536 + cc];
    {   LAS bf16* lo = (LAS bf16*)(L + RA_LO);
#pragma unroll
        for (int it = 0; it < 8; ++it) { const int g = tid + it * NTHR, tok = g >> 6, j4 = (g & 63) * 4; const f32x4 m4 = *(const f32x4*)(mu + 2304 + j4);
            const f32x4 ym = yc[it] + (yp[it] - yc[it]) * m4;
            const float sc = j4 < 64 ? 2.f : 1.f; f32x4 sg; sg.x = sigmoidf_(ym.x * sc); sg.y = sigmoidf_(ym.y * sc); sg.z = sigmoidf_(ym.z * sc); sg.w = sigmoidf_(ym.w * sc);
            const f32x4 o = j4 < 64 ? sg * 2.f - 1.f : (j4 < 128 ? ym : sg);
            v2u pk; pk.x = pk2(o.x, o.y); pk.y = pk2(o.z, o.w); *(LAS v2u*)(lo + tok * 264 + j4) = pk; }
    }
    __syncthreads();
    {
        const int rt = rt1, ct0 = ct1, li = li1, lq = lq1;
        const LAS bf16* lo = (const LAS bf16*)(L + RA_LO);
        LAS float* res = (LAS float*)(L + RA_RES);
        f32x4 acc[3][2];
#pragma unroll
        for (int p = 0; p < 3; ++p)
#pragma unroll
            for (int j = 0; j < 2; ++j) acc[p][j] = (f32x4){0.f, 0.f, 0.f, 0.f};
#pragma unroll
        for (int ks = 0; ks < 8; ++ks) { const bf16x8_t a = *(const LAS bf16x8_t*)(lo + (rt * 16 + li) * 264 + ks * 32 + lq * 8);
            const int p = ks < 2 ? 0 : (ks < 4 ? 1 : 2);
#pragma unroll
            for (int j = 0; j < 2; ++j) acc[p][j] = __builtin_amdgcn_mfma_f32_16x16x32_bf16(a, bw[j][ks], acc[p][j], 0, 0, 0); }
#pragma unroll
        for (int p = 0; p < 3; ++p)
#pragma unroll
            for (int j = 0; j < 2; ++j) { LAS float* rp = res + p * 64 * 68 + (rt * 16 + lq * 4) * 68 + (ct0 + j) * 16 + li;
                rp[0] = acc[p][j].x; rp[68] = acc[p][j].y; rp[136] = acc[p][j].z; rp[204] = acc[p][j].w; }
    }
    __syncthreads();
    float r_[8], k_[8], v_[8], av_[8], bb_[8], lw_[8];
    {
        const LAS float* res = (const LAS float*)(L + RA_RES);
        float wl[8], al[8], gl[8];
#pragma unroll
        for (int i = 0; i < 8; ++i) { wl[i] = res[(w * 8 + i) * 68 + n]; al[i] = res[64 * 68 + (w * 8 + i) * 68 + n]; gl[i] = res[2 * 64 * 68 + (w * 8 + i) * 68 + n]; }
        float* GATE = (float*)(A->ws + WS_RGATE); float* BV = (float*)(A->ws + WS_RBV);
#pragma unroll
        for (int i = 0; i < 8; ++i) { const int tok = w * 8 + i; const size_t t = (size_t)t0 + tok;
            float r = rr[i + 1], k = kr[i + 1], v = vr[i + 1];
            r += (rr[i] - r) * mur; k += (kr[i] - k) * muk; v += (vr[i] - v) * muv;
            const float wraw = -softplusf_(-(w0c + wl[i])) - 0.5f;
            const float a = sigmoidf_(a0c + al[i]);
            float kk = k * kkc; kk = kk * __builtin_amdgcn_rsqf(fmaxf(wave_sum(kk * kk), 1e-24f));
            const float k2 = k * (1.f + (a - 1.f) * kac);
            const float bonus = wave_sum(r * k2 * rkc);
            r_[i] = r; k_[i] = k2; v_[i] = v; av_[i] = -kk; bb_[i] = kk * a; lw_[i] = -__expf(wraw);
            GATE[t * RW_W + cc] = gl[i]; BV[t * RW_W + cc] = bonus * v; }
    }
    LAS float* wt = (LAS float*)(L + RA_WT);
#pragma unroll
    for (int i = 1; i < 8; ++i) lw_[i] += lw_[i - 1];
    wt[w * 64 + n] = lw_[7];
    __syncthreads();
    float pre = 0.f, mid = 0.f, last = 0.f;
#pragma unroll
    for (int ww = 0; ww < 8; ++ww) { const float x = wt[ww * 64 + n]; pre += (ww < w) ? x : 0.f; mid += (ww < 4) ? x : 0.f; last += x; }
    {
        LAS bf16* Bt = (LAS bf16*)(L + RA_BT); LAS bf16* Kt = (LAS bf16*)(L + RA_KT); LAS bf16* At = (LAS bf16*)(L + RA_AT); LAS bf16* Rt = (LAS bf16*)(L + RA_RT);
        LAS bf16* Rab = (LAS bf16*)(L + RA_RABS); LAS bf16* BhT = (LAS bf16*)(L + RA_BHT); LAS bf16* KhT = (LAS bf16*)(L + RA_KHT); LAS bf16* VT = (LAS bf16*)(L + RA_VT);
        LAS float* AabT = (LAS float*)(L + RA_AABS);
#pragma unroll
        for (int i = 0; i < 8; ++i) { const int t = w * 8 + i; const float lw = pre + lw_[i], lwm1 = pre + (i > 0 ? lw_[i - 1] : 0.f);
            const float eg = __expf(lw - mid), egi = __expf(mid - lw), egm1 = __expf(lwm1 - mid), eh = __expf(last - lw);
            Bt[t * RS + n] = (bf16)f2bf(bb_[i] * egi); Kt[t * RS + n] = (bf16)f2bf(k_[i] * egi); At[t * RS + n] = (bf16)f2bf(av_[i] * egm1); Rt[t * RS + n] = (bf16)f2bf(r_[i] * eg);
            Rab[t * RS + n] = (bf16)f2bf(r_[i] * __expf(lw)); AabT[n * 65 + t] = av_[i] * __expf(lwm1);
            BhT[n * RS + t] = (bf16)f2bf(bb_[i] * eh); KhT[n * RS + t] = (bf16)f2bf(k_[i] * eh); VT[n * RS + t] = (bf16)f2bf(v_[i]); }
        if (w == 0) ((LAS float*)(L + RA_GC))[n] = __expf(last);
    }
    __syncthreads();
    const int rt = w >> 1, ct0 = (w & 1) * 2, li = lane & 15, lq = lane >> 4;
#define FRAG(mat_, row_, ks_) (*(const LAS bf16x8_t*)((mat_) + ((row_) + li) * RS + (ks_) * 32 + lq * 8))
#define MM(a_, b_, c_) __builtin_amdgcn_mfma_f32_16x16x32_bf16(a_, b_, c_, 0, 0, 0)
    {
        const LAS bf16* Bt = (const LAS bf16*)(L + RA_BT); const LAS bf16* Kt = (const LAS bf16*)(L + RA_KT); const LAS bf16* At = (const LAS bf16*)(L + RA_AT); const LAS bf16* Rt = (const LAS bf16*)(L + RA_RT);
        LAS bf16* MbaT = (LAS bf16*)(L + RA_MBAT); LAS float* Mka = (LAS float*)(L + RA_MKA); LAS bf16* NbrT = (LAS bf16*)(L + RA_NBRT);
        bf16x8_t aB[2], aK[2], bA[2][2], bR[2][2];
#pragma unroll
        for (int ks = 0; ks < 2; ++ks) { aB[ks] = FRAG(Bt, rt * 16, ks); aK[ks] = FRAG(Kt, rt * 16, ks);
#pragma unroll
            for (int j = 0; j < 2; ++j) { bA[j][ks] = FRAG(At, (ct0 + j) * 16, ks); bR[j][ks] = FRAG(Rt, (ct0 + j) * 16, ks); } }
#pragma unroll
        for (int j = 0; j < 2; ++j) { const int ct = ct0 + j, tcol = ct * 16 + li, srow = rt * 16 + lq * 4;
            const f32x4 z = {0.f, 0.f, 0.f, 0.f};
            f32x4 mba = MM(aB[1], bA[j][1], MM(aB[0], bA[j][0], z)), nbr = MM(aB[1], bR[j][1], MM(aB[0], bR[j][0], z));
            f32x4 mka = MM(aK[1], bA[j][1], MM(aK[0], bA[j][0], z)), nk = MM(aK[1], bR[j][1], MM(aK[0], bR[j][0], z));
            mba.x = (srow + 0 < tcol) ? mba.x : 0.f; mba.y = (srow + 1 < tcol) ? mba.y : 0.f; mba.z = (srow + 2 < tcol) ? mba.z : 0.f; mba.w = (srow + 3 < tcol) ? mba.w : 0.f;
            mka.x = (srow + 0 < tcol) ? mka.x : 0.f; mka.y = (srow + 1 < tcol) ? mka.y : 0.f; mka.z = (srow + 2 < tcol) ? mka.z : 0.f; mka.w = (srow + 3 < tcol) ? mka.w : 0.f;
            nbr.x = (srow + 0 <= tcol) ? nbr.x : 0.f; nbr.y = (srow + 1 <= tcol) ? nbr.y : 0.f; nbr.z = (srow + 2 <= tcol) ? nbr.z : 0.f; nbr.w = (srow + 3 <= tcol) ? nbr.w : 0.f;
            nk.x = (srow + 0 <= tcol) ? nk.x : 0.f; nk.y = (srow + 1 <= tcol) ? nk.y : 0.f; nk.z = (srow + 2 <= tcol) ? nk.z : 0.f; nk.w = (srow + 3 <= tcol) ? nk.w : 0.f;
            { v2u pm; pm.x = pk2(mba.x, mba.y); pm.y = pk2(mba.z, mba.w); *(LAS v2u*)(MbaT + tcol * RS + srow) = pm; }
            Mka[(srow + 0) * RS + tcol] = mka.x; Mka[(srow + 1) * RS + tcol] = mka.y; Mka[(srow + 2) * RS + tcol] = mka.z; Mka[(srow + 3) * RS + tcol] = mka.w;
            v2u pk; pk.x = pk2(nbr.x, nbr.y); pk.y = pk2(nbr.z, nbr.w); *(LAS v2u*)(NbrT + tcol * RS + srow) = pk;
            { v2u pn; pn.x = pk2(nk.x, nk.y); pn.y = pk2(nk.z, nk.w); *(LAS v2u*)((LAS bf16*)(L + RA_NKRT) + tcol * RS + srow) = pn; } }
    }
    __syncthreads();
    {
        int t4 = tid; asm volatile("" : "+v"(t4)); const int row = t4 >> 2, q = t4 & 3, l4 = t4 & 63, li4 = l4 & 15, lq4 = l4 >> 4;
        const LAS bf16* MbaT = (const LAS bf16*)(L + RA_MBAT);
        const LAS float* Yrow = (row < 64) ? ((const LAS float*)(L + RA_AABS) + row * 65) : ((const LAS float*)(L + RA_MKA) + (row - 64) * RS);
        LAS bf16* Z = (LAS bf16*)(L + RA_Z); LAS float* pre = (LAS float*)(L + RA_PRE);
        for (int i = t4; i < 1088; i += NTHR) ((LAS v4u*)Z)[i] = (v4u){0u, 0u, 0u, 0u};
        __syncthreads();
#pragma unroll 1
        for (int jb = 0; jb < 4; ++jb) {
            if (jb > 0) {
                f32x4 acc = {0.f, 0.f, 0.f, 0.f};
#pragma unroll
                for (int ks = 0; ks < 2; ++ks) { const bf16x8_t a = *(const LAS bf16x8_t*)(Z + (w * 16 + li4) * RS + ks * 32 + lq4 * 8);
                    const bf16x8_t bm = *(const LAS bf16x8_t*)(MbaT + (jb * 16 + li4) * RS + ks * 32 + lq4 * 8);
                    acc = __builtin_amdgcn_mfma_f32_16x16x32_bf16(a, bm, acc, 0, 0, 0); }
                LAS float* pp = pre + (w * 16 + lq4 * 4) * 16 + li4;
                pp[0] = acc.x; pp[16] = acc.y; pp[32] = acc.z; pp[48] = acc.w;
                __syncthreads();
            }
            float yv[16]; v2u mv[16];
#pragma unroll
            for (int u = 0; u < 16; ++u) { yv[u] = Yrow[jb * 16 + u] + (jb > 0 ? pre[row * 16 + u] : 0.f); mv[u] = *(const LAS v2u*)(MbaT + (jb * 16 + u) * RS + jb * 16 + q * 4); }
            float zb[4] = {0.f, 0.f, 0.f, 0.f};
#pragma unroll
            for (int u = 0; u < 16; ++u) {
                float part = (zb[0] * bflo(mv[u].x) + zb[1] * bfhi(mv[u].x)) + (zb[2] * bflo(mv[u].y) + zb[3] * bfhi(mv[u].y));
                part += dpp_xor1(part); part += dpp_xor2(part);
                const float zt = yv[u] + part;
                zb[u & 3] = (q == (u >> 2)) ? zt : zb[u & 3];
            }
            { v2u pk; pk.x = pk2(zb[0], zb[1]); pk.y = pk2(zb[2], zb[3]); *(LAS v2u*)(Z + row * RS + jb * 16 + q * 4) = pk; }
            __syncthreads();
        }
    }
    {
        int t5 = tid; asm volatile("" : "+v"(t5)); const int li = t5 & 15, lq = (t5 >> 4) & 3;
        const LAS bf16* Z = (const LAS bf16*)(L + RA_Z); const LAS bf16* NbrT = (const LAS bf16*)(L + RA_NBRT); const LAS bf16* BhT = (const LAS bf16*)(L + RA_BHT);
        const LAS bf16* Rab = (const LAS bf16*)(L + RA_RABS); const LAS bf16* KhT = (const LAS bf16*)(L + RA_KHT); const LAS float* gC = (const LAS float*)(L + RA_GC);
        LAS bf16* QsT = (LAS bf16*)(L + RA_QST); LAS bf16* QoT = (LAS bf16*)(L + RA_QOT);
        bf16* PoT = (bf16*)(A->ws + WS_RSC + RWO_POT) + (size_t)unit * 4096; bf16* PsT = (bf16*)(A->ws + WS_RSC + RWO_PST) + (size_t)unit * 4096;
        bf16x8_t zW[2], zX[2], bN[2][2], bH[2][2]; v2u rb[2], kb[2], nb2[2]; float gc[2];
#pragma unroll
        for (int ks = 0; ks < 2; ++ks) { zW[ks] = FRAG(Z, rt * 16, ks); zX[ks] = FRAG(Z, 64 + rt * 16, ks);
#pragma unroll
            for (int j = 0; j < 2; ++j) { bN[j][ks] = FRAG(NbrT, (ct0 + j) * 16, ks); bH[j][ks] = FRAG(BhT, (ct0 + j) * 16, ks); } }
#pragma unroll
        for (int j = 0; j < 2; ++j) { const int col = (ct0 + j) * 16 + li, rw = rt * 16 + lq * 4; rb[j] = *(const LAS v2u*)(Rab + col * RS + rw); kb[j] = *(const LAS v2u*)(KhT + col * RS + rw); nb2[j] = *(const LAS v2u*)((const LAS bf16*)(L + RA_NKRT) + col * RS + rw); gc[j] = gC[col]; }
#pragma unroll
        for (int j = 0; j < 2; ++j) { const int col = (ct0 + j) * 16 + li, rw = rt * 16 + lq * 4;
            { f32x4 acc = {bflo(rb[j].x), bfhi(rb[j].x), bflo(rb[j].y), bfhi(rb[j].y)};
                acc = MM(zW[1], bN[j][1], MM(zW[0], bN[j][0], acc));
                v2u pk; pk.x = pk2(acc.x, acc.y); pk.y = pk2(acc.z, acc.w); *(v2u*)(PoT + (size_t)col * 64 + rw) = pk; }
            { f32x4 acc = {(rw + 0 == col) ? gc[j] : 0.f, (rw + 1 == col) ? gc[j] : 0.f, (rw + 2 == col) ? gc[j] : 0.f, (rw + 3 == col) ? gc[j] : 0.f};
                acc = MM(zW[1], bH[j][1], MM(zW[0], bH[j][0], acc));
                v2u pk; pk.x = pk2(acc.x, acc.y); pk.y = pk2(acc.z, acc.w); *(v2u*)(PsT + (size_t)col * 64 + rw) = pk; }
            { f32x4 acc = {bflo(nb2[j].x), bfhi(nb2[j].x), bflo(nb2[j].y), bfhi(nb2[j].y)};
                acc = MM(zX[1], bN[j][1], MM(zX[0], bN[j][0], acc));
                v2u pk; pk.x = pk2(acc.x, acc.y); pk.y = pk2(acc.z, acc.w); *(LAS v2u*)(QoT + col * RS + rw) = pk; }
            { f32x4 acc = {bflo(kb[j].x), bfhi(kb[j].x), bflo(kb[j].y), bfhi(kb[j].y)};
                acc = MM(zX[1], bH[j][1], MM(zX[0], bH[j][0], acc));
                v2u pk; pk.x = pk2(acc.x, acc.y); pk.y = pk2(acc.z, acc.w); *(LAS v2u*)(QsT + col * RS + rw) = pk; }
        }
    }
    __syncthreads();
    {
        int t6 = tid; asm volatile("" : "+v"(t6)); const int li = t6 & 15, lq = (t6 >> 4) & 3;
        const LAS bf16* VT = (const LAS bf16*)(L + RA_VT);
        const bool isO = (w & 1);
        const LAS bf16* Bm = (const LAS bf16*)(L + (isO ? RA_QOT : RA_QST));
        float* dst = (float*)(A->ws + WS_RSC + (isO ? RWO_OLT : RWO_GT)) + (size_t)unit * 4096;
        bf16x8_t av[2], bq[4][2];
#pragma unroll
        for (int ks = 0; ks < 2; ++ks) { av[ks] = FRAG(VT, rt * 16, ks);
#pragma unroll
            for (int j = 0; j < 4; ++j) bq[j][ks] = FRAG(Bm, j * 16, ks); }
#pragma unroll
        for (int j = 0; j < 4; ++j) { const f32x4 z = {0.f, 0.f, 0.f, 0.f};
            const f32x4 acc = MM(av[1], bq[j][1], MM(av[0], bq[j][0], z));
            *(f32x4*)(dst + (size_t)(j * 16 + li) * 64 + rt * 16 + lq * 4) = acc; }
    }
#undef FRAG
#undef MM
    __syncthreads();
}

__device__ __forceinline__ void rwkvB_scan(ArgsP A, const Frame& F, int unit) {
    const int bh = unit >> 2, rq = unit & 3;
    const int tid = F.tid, lane = F.lane, w = F.wave, ct = w & 3, li = lane & 15, lq = lane >> 4;
    const bool writer = (w < 4);
    const bf16* PsT = (const bf16*)(A->ws + WS_RSC + RWO_PST) + (size_t)bh * 64 * 4096; const float* GT = (const float*)(A->ws + WS_RSC + RWO_GT) + (size_t)bh * 64 * 4096;
    bf16* SC = (bf16*)(A->ws + WS_RSC + RWO_SC) + (size_t)bh * 64 * 4096;
    f32x4 S = {0.f, 0.f, 0.f, 0.f};
    constexpr int PF = 4;
    bf16x8_t pb[PF][2]; f32x4 gq[PF];
    const int col = ct * 16 + li;
#define SLOAD(slot, cc_) do { _Pragma("unroll") for (int ks = 0; ks < 2; ++ks) pb[slot][ks] = *(const bf16x8_t*)(PsT + (size_t)(cc_) * 4096 + (size_t)col * 64 + ks * 32 + lq * 8); \
        gq[slot] = *(const f32x4*)(GT + (size_t)(cc_) * 4096 + (size_t)col * 64 + rq * 16 + lq * 4); } while (0)
#define SSTEP(slot, cc_) do { LAS bf16* Sl = (LAS bf16*)(F.lds + ((cc_) & 1) * 2176); \
        if (writer) { const int rw_ = lq * 4; Sl[(rw_ + 0) * RS + col] = (bf16)f2bf(S.x); Sl[(rw_ + 1) * RS + col] = (bf16)f2bf(S.y); Sl[(rw_ + 2) * RS + col] = (bf16)f2bf(S.z); Sl[(rw_ + 3) * RS + col] = (bf16)f2bf(S.w); } \
        asm volatile("s_waitcnt lgkmcnt(0)" ::: "memory"); __builtin_amdgcn_s_barrier(); asm volatile("" ::: "memory");        \
        if (tid < 128) { const int v_ = tid >> 3, k8_ = (tid & 7) * 8; *(v4u*)(SC + (size_t)(cc_) * 4096 + (rq * 16 + v_) * 64 + k8_) = *(const LAS v4u*)(Sl + v_ * RS + k8_); } \
        f32x4 acc_ = gq[slot]; \
        _Pragma("unroll") for (int ks = 0; ks < 2; ++ks) { const bf16x8_t a_ = *(const LAS bf16x8_t*)(Sl + li * RS + ks * 32 + lq * 8); \
            acc_ = __builtin_amdgcn_mfma_f32_16x16x32_bf16(a_, pb[slot][ks], acc_, 0, 0, 0); } \
        S = acc_; } while (0)
    SLOAD(0, 0); SLOAD(1, 1); SLOAD(2, 2); SLOAD(3, 3);
#pragma unroll 1
    for (int c = 0; c < 64; c += 4) {
        const int cn = (c + 4 < 64) ? c + 4 : 60;
        SSTEP(0, c);     SLOAD(0, cn);
        SSTEP(1, c + 1); SLOAD(1, cn + 1);
        SSTEP(2, c + 2); SLOAD(2, cn + 2);
        SSTEP(3, c + 3); SLOAD(3, cn + 3);
    }
#undef SLOAD
#undef SSTEP
    __syncthreads();
}

__device__ __forceinline__ void rwkvC_unit(ArgsP A, const Frame& F_in, int l, int unit) {
    Frame F = F_in; asm volatile("" : "+v"(F.tid)); F.lane = F.tid & 63;

    const int bh = unit >> 6, c = unit & 63, b = bh / RW_H, h = bh % RW_H, t0 = b * SEQ + c * 64, tid = F.tid, lane = F.lane, w = F.wave;
    const int rt = w >> 1, ct0 = (w & 1) * 2, li = lane & 15, lq = lane >> 4;
    LAS bf16* Sl = (LAS bf16*)F.lds; LAS bf16* Pl = (LAS bf16*)(F.lds + 8704); LAS float* ob = (LAS float*)(F.lds + 17408);
    { const int r = tid >> 3, k8 = (tid & 7) * 8;
        *(LAS v4u*)(Sl + r * RS + k8) = *(const v4u*)((const bf16*)(A->ws + WS_RSC + RWO_SC) + (size_t)unit * 4096 + r * 64 + k8);
        *(LAS v4u*)(Pl + r * RS + k8) = *(const v4u*)((const bf16*)(A->ws + WS_RSC + RWO_POT) + (size_t)unit * 4096 + r * 64 + k8); }
    __syncthreads();
    const float* OlT = (const float*)(A->ws + WS_RSC + RWO_OLT) + (size_t)unit * 4096;
#pragma unroll
    for (int j = 0; j < 2; ++j) { const int tcol = (ct0 + j) * 16 + li, vr = rt * 16 + lq * 4;
        f32x4 acc = *(const f32x4*)(OlT + (size_t)tcol * 64 + vr);
        acc = tile_mm64(Sl, rt * 16, Pl, (ct0 + j) * 16, acc, lane);
        *(LAS f32x4*)(ob + tcol * 68 + vr) = acc; }
    __syncthreads();
    { const int t = tid >> 3, q = tid & 7; const size_t tg = (size_t)t0 + t;
        const f32x4 o0 = *(const LAS f32x4*)(ob + t * 68 + q * 8), o1 = *(const LAS f32x4*)(ob + t * 68 + q * 8 + 4);
        const float mean = red8((o0.x + o0.y) + (o0.z + o0.w) + (o1.x + o1.y) + (o1.z + o1.w)) * (1.f / 64.f);
        const f32x4 d0 = o0 - mean, d1 = o1 - mean;
        const float var = red8((d0.x * d0.x + d0.y * d0.y) + (d0.z * d0.z + d0.w * d0.w) + (d1.x * d1.x + d1.y * d1.y) + (d1.z * d1.z + d1.w * d1.w)) * (1.f / 64.f);
        const float rs = rsqrtf(var + 64e-5f);
        const int cc = h * 64 + q * 8;
        const f32x4 g0 = *(const f32x4*)(A->in[20] + (size_t)l * RW_W + cc), g1 = *(const f32x4*)(A->in[20] + (size_t)l * RW_W + cc + 4);
        const f32x4 b0 = *(const f32x4*)(A->in[21] + (size_t)l * RW_W + cc), b1 = *(const f32x4*)(A->in[21] + (size_t)l * RW_W + cc + 4);
        const f32x4 bv0 = *(const f32x4*)((const float*)(A->ws + WS_RBV) + tg * RW_W + cc), bv1 = *(const f32x4*)((const float*)(A->ws + WS_RBV) + tg * RW_W + cc + 4);
        const f32x4 ga0 = *(const f32x4*)((const float*)(A->ws + WS_RGATE) + tg * RW_W + cc), ga1 = *(const f32x4*)((const float*)(A->ws + WS_RGATE) + tg * RW_W + cc + 4);
        const f32x4 y0 = (d0 * rs * g0 + b0 + bv0) * ga0, y1 = (d1 * rs * g1 + b1 + bv1) * ga1;
        v4u o; o.x = pk2(y0.x, y0.y); o.y = pk2(y0.z, y0.w); o.z = pk2(y1.x, y1.y); o.w = pk2(y1.z, y1.w);
        *(v4u*)((bf16*)(A->ws + WS_Y) + tg * DM + 1280 + cc) = o; }
    __syncthreads();
}

constexpr size_t RWO_GQ = 84 * MiB, RWO_GK = 92 * MiB, RWO_GVT = 100 * MiB, RWO_GEM = 116 * MiB;
constexpr int GQS = 104, GTS = 72;
template <int NKS> __device__ __forceinline__ f32x4 tile_mm(const LAS bf16* Am, int sa, int arow0, const LAS bf16* Bm, int sb, int brow0, f32x4 acc, int lane) {
    const int r = lane & 15, kq = (lane >> 4) * 8;
#pragma unroll
    for (int ks = 0; ks < NKS; ++ks) {
        const bf16x8_t a = *(const LAS bf16x8_t*)(Am + (arow0 + r) * sa + ks * 32 + kq);
        const bf16x8_t b = *(const LAS bf16x8_t*)(Bm + (brow0 + r) * sb + ks * 32 + kq);
        acc = __builtin_amdgcn_mfma_f32_16x16x32_bf16(a, b, acc, 0, 0, 0);
    }
    return acc;
}

__device__ __forceinline__ int gsw(int row) { return ((row >> 2) ^ (row >> 5)) & 7; }
__device__ __forceinline__ f32x4 tile_mm_sw(const LAS bf16* Am, int arow0, const LAS bf16* Bm, int brow0, f32x4 acc, int lane) {
    const int r = lane & 15, cq = lane >> 4, fa = gsw(arow0 + r), fb = gsw(brow0 + r);
#pragma unroll
    for (int ks = 0; ks < 2; ++ks) {
        const bf16x8_t a = *(const LAS bf16x8_t*)(Am + (arow0 + r) * GTS + (((ks * 4 + cq) ^ fa) << 3));
        const bf16x8_t b = *(const LAS bf16x8_t*)(Bm + (brow0 + r) * GTS + (((ks * 4 + cq) ^ fb) << 3));
        acc = __builtin_amdgcn_mfma_f32_16x16x32_bf16(a, b, acc, 0, 0, 0);
    }
    return acc;
}
__device__ __forceinline__ void gla1_unit(ArgsP A, const Frame& F_in, int l, int unit) {
    Frame F = F_in; asm volatile("" : "+v"(F.tid)); F.lane = F.tid & 63;
    const int bh = unit >> 6, c = unit & 63, b = bh >> 2, h = bh & 3, t0 = b * SEQ + c * 64, tid = F.tid, lane = F.lane, w = F.wave;
    const float* proj = (const float*)(A->ws + WS_PROJ);
    LAS float* bcum = (LAS float*)F.lds;
    LAS float* ad = bcum + 6144;
    LAS float* up = ad + 1024;
    LAS bf16* KtT = (LAS bf16*)(F.lds + 34816);
    LAS bf16* VT = (LAS bf16*)(F.lds + 48640);
    f32x4 qq[3], kq[3], vq[6];
#pragma unroll
    for (int it = 0; it < 3; ++it) { const int i = tid + it * NTHR, tok = i / 24, d4 = i % 24; const float* rp = proj + (size_t)(t0 + tok) * INWP + h * 96 + d4 * 4;
        qq[it] = *(const f32x4*)(rp + C_GQ); kq[it] = *(const f32x4*)(rp + C_GK); }
#pragma unroll
    for (int it = 0; it < 6; ++it) { const int i = tid + it * NTHR, tok = i / 48, e4 = i % 48; vq[it] = *(const f32x4*)(proj + (size_t)(t0 + tok) * INWP + C_GV + h * 192 + e4 * 4); }
    gla_bcum(A, F, l, h, t0, bcum, ad, up);
    const float qs = 0.10206207261596575f;
    bf16* Qg = (bf16*)(A->ws + WS_RSC + RWO_GQ) + (size_t)unit * 6144; bf16* Kg = (bf16*)(A->ws + WS_RSC + RWO_GK) + (size_t)unit * 6144;
#pragma unroll
    for (int it = 0; it < 3; ++it) { const int i = tid + it * NTHR, tok = i / 24, d = (i % 24) * 4;
        const float qv[4] = {qq[it].x, qq[it].y, qq[it].z, qq[it].w}, kv[4] = {kq[it].x, kq[it].y, kq[it].z, kq[it].w}; float qo[4], ko[4];
#pragma unroll
        for (int e = 0; e < 4; ++e) { const float m = bcum[31 * 96 + d + e], bb = bcum[tok * 96 + d + e];
            qo[e] = qv[e] * qs * __expf(bb - m); ko[e] = kv[e] * __expf(m - bb); KtT[(d + e) * GTS + ((((tok >> 3) ^ gsw(d + e)) << 3) | (tok & 7))] = (bf16)f2bf(ko[e]); }
        v2u pq, pk; pq.x = pk2(qo[0], qo[1]); pq.y = pk2(qo[2], qo[3]); pk.x = pk2(ko[0], ko[1]); pk.y = pk2(ko[2], ko[3]);
        *(v2u*)(Qg + tok * 96 + d) = pq; *(v2u*)(Kg + tok * 96 + d) = pk; }
#pragma unroll
    for (int it = 0; it < 6; ++it) { const int i = tid + it * NTHR, tok = i / 48, e = (i % 48) * 4;
        const int ts = tok >> 3, tl = tok & 7;
        VT[(e + 0) * GTS + (((ts ^ gsw(e + 0)) << 3) | tl)] = (bf16)f2bf(vq[it].x); VT[(e + 1) * GTS + (((ts ^ gsw(e + 1)) << 3) | tl)] = (bf16)f2bf(vq[it].y);
        VT[(e + 2) * GTS + (((ts ^ gsw(e + 2)) << 3) | tl)] = (bf16)f2bf(vq[it].z); VT[(e + 3) * GTS + (((ts ^ gsw(e + 3)) << 3) | tl)] = (bf16)f2bf(vq[it].w); }
    if (tid < 96) { ((float*)(A->ws + WS_RSC + RWO_GEM))[(size_t)unit * 96 + tid] = __expf(bcum[31 * 96 + tid]);
        ((float*)(A->ws + WS_GDEC))[(size_t)unit * 96 + tid] = __expf(bcum[63 * 96 + tid]); }
    __syncthreads();
    { bf16* VTg = (bf16*)(A->ws + WS_RSC + RWO_GVT) + (size_t)unit * 12288;
#pragma unroll
        for (int it = 0; it < 3; ++it) { const int i = tid + it * NTHR, e = i >> 3, t8 = (i & 7) * 8; *(v4u*)(VTg + e * 64 + t8) = *(const LAS v4u*)(VT + e * GTS + ((((i & 7) ^ gsw(e))) << 3)); } }
    { const int li = lane & 15, lq = lane >> 4;
        float* KVg = (float*)(A->ws + WS_GKV) + (size_t)unit * 18432;
#pragma unroll
        for (int a = 0; a < 3; ++a) { const int dt = (w & 1) * 3 + a, d0 = dt * 16 + lq * 4;
            const float s0 = __expf(bcum[63 * 96 + d0] - bcum[31 * 96 + d0]), s1 = __expf(bcum[63 * 96 + d0 + 1] - bcum[31 * 96 + d0 + 1]),
                        s2 = __expf(bcum[63 * 96 + d0 + 2] - bcum[31 * 96 + d0 + 2]), s3 = __expf(bcum[63 * 96 + d0 + 3] - bcum[31 * 96 + d0 + 3]);
#pragma unroll
            for (int bb = 0; bb < 3; ++bb) { const int et = (w >> 1) * 3 + bb; const f32x4 z = {0.f, 0.f, 0.f, 0.f};
                f32x4 acc = tile_mm_sw(KtT, dt * 16, VT, et * 16, z, lane);
                acc.x *= s0; acc.y *= s1; acc.z *= s2; acc.w *= s3;
                *(f32x4*)(KVg + (size_t)(et * 16 + li) * 96 + d0) = acc; } } }
    __syncthreads();
}

__device__ __forceinline__ void gla3_unit(ArgsP A, const Frame& F_in, int l, int unit) {
    Frame F = F_in; asm volatile("" : "+v"(F.tid)); F.lane = F.tid & 63;
    const int bh = unit >> 6, c = unit & 63, b = bh >> 2, h = bh & 3, t0 = b * SEQ + c * 64, tid = F.tid, lane = F.lane, w = F.wave;
    const int li = lane & 15, lq = lane >> 4;
    const float* proj = (const float*)(A->ws + WS_PROJ);
    LAS bf16* Qs = (LAS bf16*)F.lds;
    LAS bf16* Ks = (LAS bf16*)(F.lds + 13312);
    LAS bf16* VT = (LAS bf16*)(F.lds + 26624);
    LAS bf16* ST = (LAS bf16*)(F.lds + 54272);
    LAS bf16* att = (LAS bf16*)(F.lds + 94208);
    LAS float* ssq = (LAS float*)(F.lds + 103424);
    LAS float* em = (LAS float*)(F.lds + 103936);
    LAS float* ob = (LAS float*)(F.lds + 26624);
    {
        const v4u* Qg = (const v4u*)((const bf16*)(A->ws + WS_RSC + RWO_GQ) + (size_t)unit * 6144); const v4u* Kg = (const v4u*)((const bf16*)(A->ws + WS_RSC + RWO_GK) + (size_t)unit * 6144);
        const v4u* VTg = (const v4u*)((const bf16*)(A->ws + WS_RSC + RWO_GVT) + (size_t)unit * 12288);
        const f32x4* GS = (const f32x4*)((const float*)(A->ws + WS_GS) + (size_t)unit * 18432);
        v4u q0 = Qg[tid], k0 = Kg[tid], q1 = {0u, 0u, 0u, 0u}, k1 = {0u, 0u, 0u, 0u};
        if (tid < 256) { q1 = Qg[512 + tid]; k1 = Kg[512 + tid]; }
        v4u vt[3]; f32x4 sg[9];
#pragma unroll
        for (int it = 0; it < 3; ++it) vt[it] = VTg[tid + it * NTHR];
#pragma unroll
        for (int it = 0; it < 9; ++it) sg[it] = GS[tid + it * NTHR];
        if (tid < 96) em[tid] = ((const float*)(A->ws + WS_RSC + RWO_GEM))[(size_t)unit * 96 + tid];
        { const int i = tid, t = i / 12, c8 = (i % 12) * 8; *(LAS v4u*)(Qs + t * GQS + c8) = q0; *(LAS v4u*)(Ks + t * GQS + c8) = k0; }
        if (tid < 256) { const int i = 512 + tid, t = i / 12, c8 = (i % 12) * 8; *(LAS v4u*)(Qs + t * GQS + c8) = q1; *(LAS v4u*)(Ks + t * GQS + c8) = k1; }
#pragma unroll
        for (int it = 0; it < 3; ++it) { const int i = tid + it * NTHR, e = i >> 3, t8 = (i & 7) * 8; *(LAS v4u*)(VT + e * GTS + t8) = vt[it]; }
        __syncthreads();
#pragma unroll
        for (int it = 0; it < 9; ++it) { const int i = tid + it * NTHR, e = i / 24, d = (i % 24) * 4; const f32x4 m4 = *(const LAS f32x4*)(em + d);
            v2u pk; pk.x = pk2(sg[it].x * m4.x, sg[it].y * m4.y); pk.y = pk2(sg[it].z * m4.z, sg[it].w * m4.w); *(LAS v2u*)(ST + e * GQS + d) = pk; }
    }
    __syncthreads();
#pragma unroll
    for (int a = 0; a < 2; ++a) { const int jt = w >> 1, it = (w & 1) * 2 + a; const f32x4 z = {0.f, 0.f, 0.f, 0.f};
        f32x4 acc = z;
        if (jt <= it) acc = tile_mm<3>(Ks, GQS, jt * 16, Qs, GQS, it * 16, z, lane);
        const int i = it * 16 + li, j0 = jt * 16 + lq * 4;
        acc.x = (j0 + 0 <= i) ? acc.x : 0.f; acc.y = (j0 + 1 <= i) ? acc.y : 0.f; acc.z = (j0 + 2 <= i) ? acc.z : 0.f; acc.w = (j0 + 3 <= i) ? acc.w : 0.f;
        v2u pk; pk.x = pk2(acc.x, acc.y); pk.y = pk2(acc.z, acc.w); *(LAS v2u*)(att + i * GTS + j0) = pk; }
    __syncthreads();
    f32x4 o[6];
    { const int it = w >> 1;
#pragma unroll
        for (int a = 0; a < 6; ++a) { const int et = (w & 1) * 6 + a; const f32x4 z = {0.f, 0.f, 0.f, 0.f};
            f32x4 acc = tile_mm<2>(att, GTS, it * 16, VT, GTS, et * 16, z, lane);
            o[a] = tile_mm<3>(Qs, GQS, it * 16, ST, GQS, et * 16, acc, lane); }
        float s0 = 0.f, s1 = 0.f, s2 = 0.f, s3 = 0.f;
#pragma unroll
        for (int a = 0; a < 6; ++a) { s0 += o[a].x * o[a].x; s1 += o[a].y * o[a].y; s2 += o[a].z * o[a].z; s3 += o[a].w * o[a].w; }
        s0 = row16_sum(s0); s1 = row16_sum(s1); s2 = row16_sum(s2); s3 = row16_sum(s3);
        if (li == 0) { const int r0 = it * 16 + lq * 4; ssq[(r0 + 0) * 2 + (w & 1)] = s0; ssq[(r0 + 1) * 2 + (w & 1)] = s1; ssq[(r0 + 2) * 2 + (w & 1)] = s2; ssq[(r0 + 3) * 2 + (w & 1)] = s3; }
    }
    __syncthreads();
    { const int it = w >> 1, r0 = it * 16 + lq * 4;
#pragma unroll
        for (int a = 0; a < 6; ++a) { const int e = ((w & 1) * 6 + a) * 16 + li;
            ob[(r0 + 0) * 196 + e] = o[a].x; ob[(r0 + 1) * 196 + e] = o[a].y; ob[(r0 + 2) * 196 + e] = o[a].z; ob[(r0 + 3) * 196 + e] = o[a].w; } }
    __syncthreads();
    { bf16* Y = (bf16*)(A->ws + WS_Y);
        f32x4 gv[6];
#pragma unroll
        for (int k = 0; k < 6; ++k) { const int i = tid + k * NTHR, t = i / 48, e = (i % 48) * 4; gv[k] = *(const f32x4*)(proj + (size_t)(t0 + t) * INWP + C_GG + h * 192 + e); }
#pragma unroll
        for (int k = 0; k < 6; ++k) { const int i = tid + k * NTHR, t = i / 48, e = (i % 48) * 4;
            const float rstd = rsqrtf((ssq[t * 2] + ssq[t * 2 + 1]) * (1.f / 192.f) + NORM_EPS);
            const f32x4 ov = *(const LAS f32x4*)(ob + t * 196 + e); const f32x4 ng = *(const f32x4*)(A->in[10] + (size_t)l * 768 + h * 192 + e);
            f32x4 y; y.x = ov.x * rstd * ng.x * gv[k].x * sigmoidf_(gv[k].x); y.y = ov.y * rstd * ng.y * gv[k].y * sigmoidf_(gv[k].y);
            y.z = ov.z * rstd * ng.z * gv[k].z * sigmoidf_(gv[k].z); y.w = ov.w * rstd * ng.w * gv[k].w * sigmoidf_(gv[k].w);
            v2u pk; pk.x = pk2(y.x, y.y); pk.y = pk2(y.z, y.w); *(v2u*)(Y + (size_t)(t0 + t) * DM + 512 + h * 192 + e) = pk; } }
    __syncthreads();
}

#define INS16(L, P, x, px) do { { const bool c_ = (x) > L[15]; L[15] = c_ ? (x) : L[15]; P[15] = c_ ? (px) : P[15]; } \
    _Pragma("unroll") for (int r_ = 14; r_ >= 0; --r_) { const bool c_ = L[r_ + 1] > L[r_]; const float tl_ = L[r_]; const int tp_ = P[r_]; \
        L[r_] = c_ ? L[r_ + 1] : tl_; L[r_ + 1] = c_ ? tl_ : L[r_ + 1]; P[r_] = c_ ? P[r_ + 1] : tp_; P[r_ + 1] = c_ ? tp_ : P[r_ + 1]; } } while (0)

__device__ __forceinline__ float gelu_as(float v) {
    const float av = fabsf(v), t = __builtin_amdgcn_rcpf(av * 0.2316418882f + 1.0f);
    float q = t * 0.5307027145f + (-0.7265760135f); q = q * t + 0.7107068705f; q = q * t + (-0.142248368f); q = q * t + 0.127414796f; q = q * t;
    const float e = __builtin_amdgcn_exp2f((v * v) * (-0.72134752044f));
    const float m = v * (q * e);
    return v < 0.f ? m : v - m;
}
__device__ __forceinline__ int row16_sum_i(int v) {
    v += __builtin_amdgcn_update_dpp(0, v, 0xB1, 0xF, 0xF, true); v += __builtin_amdgcn_update_dpp(0, v, 0x4E, 0xF, 0xF, true);
    v += __builtin_amdgcn_update_dpp(0, v, 0x141, 0xF, 0xF, true); v += __builtin_amdgcn_update_dpp(0, v, 0x140, 0xF, 0xF, true); return v;
}
__device__ __forceinline__ void ph_peer2(ArgsP A, LAS unsigned char* lds_, int wv_, int l, const float* g2, const float* sh2, const float* ngain, const float* nsh, const float* nsc, const bool last, const bool dry = false) {
    const Frame F = make_frame(lds_, wv_);
    const int lane = F.lane;
    const float* SCO = (const float*)(A->ws + WS_PROJ);
    const unsigned char* U8 = A->ws + WS_U + (size_t)l * PEER_N * DM; const unsigned char* V8 = A->ws + WS_V + (size_t)l * PEER_N * DM;
    const float* US = (const float*)(A->ws + WS_US) + (size_t)l * PEER_N; const float* VS = (const float*)(A->ws + WS_VS) + (size_t)l * PEER_N;
    float* X = (float*)(A->ws + WS_X); bf16* H = (bf16*)(A->ws + WS_H); const float* ssr = (const float*)(A->ws + WS_SSP) + (size_t)l * NT * 32;
    LAS int* es = (LAS int*)F.lds + F.wave * 2048; LAS float* gs = (LAS float*)F.lds + F.wave * 2048 + 1024;
    LAS v4u* hl = (LAS v4u*)(F.lds + 65536 + F.wave * 3072);
    LAS float* dl = (LAS float*)(F.lds + 65536 + F.wave * 3072 + 2048); LAS float* cfl = dl + 128;
    for (int tb = F.gw * 4; tb < NT; tb += F.ngw * 4) {
        {
            int P2[16]; float gt[16];
            const int prob = tb * 16 + lane, half = lane & 1;
            const f32x4* s4 = (const f32x4*)(SCO + (size_t)prob * 128);
            float L[16]; int P[16];
#pragma unroll
            for (int r = 0; r < 16; ++r) { L[r] = -3.0e38f; P[r] = 0; }
            f32x4 nv[4];
#pragma unroll
            for (int i = 0; i < 4; ++i) nv[i] = s4[i];
#pragma unroll 1
            for (int q = 0; q < 8; ++q) {
                f32x4 v[4];
#pragma unroll
                for (int i = 0; i < 4; ++i) v[i] = nv[i];
                if (q < 7) {
#pragma unroll
                    for (int i = 0; i < 4; ++i) nv[i] = s4[4 * (q + 1) + i]; }
                _Pragma("unroll") for (int r = 0; r < 16; ++r) asm volatile("" : "+v"(L[r]), "+v"(P[r]));
#pragma unroll
                for (int i = 0; i < 4; ++i) { const int ib = 16 * q + 4 * i;
                    INS16(L, P, v[i].x, ib); INS16(L, P, v[i].y, ib + 1); INS16(L, P, v[i].z, ib + 2); INS16(L, P, v[i].w, ib + 3); }
            }
            float v1[16], v2[16]; int i1[16], i2[16];
#pragma unroll
            for (int r = 0; r < 16; ++r) { const float ol = dpp_xor1(L[r]); const int op = __builtin_amdgcn_update_dpp(0, P[r], 0xB1, 0xF, 0xF, true);
                v1[r] = half ? ol : L[r]; v2[r] = half ? L[r] : ol; i1[r] = half ? op : P[r]; i2[r] = half ? P[r] : op; }
            float L2[16];
#pragma unroll
            for (int r = 0; r < 16; ++r) { L2[r] = -3.0e38f; P2[r] = 0; }
#pragma unroll
            for (int a = 0; a < 16; ++a)
#pragma unroll
                for (int bq = 0; bq < 16; ++bq) if ((a + 1) * (bq + 1) <= 16) { const float cv = v1[a] + v2[bq]; const int ce = i1[a] * 128 + i2[bq]; INS16(L2, P2, cv, ce); }
            float sum = 0.f;
#pragma unroll
            for (int r = 0; r < 16; ++r) { gt[r] = __expf(L2[r] - L2[0]); sum += gt[r]; }
            const float inv = 1.f / sum;
#pragma unroll
            for (int r = 0; r < 16; ++r) { es[r * 64 + lane] = P2[r]; gs[r * 64 + lane] = gt[r] * inv; }
            asm volatile("s_waitcnt lgkmcnt(0)" ::: "memory");
        }
#pragma unroll 1
        for (int k = 0; k < 4; ++k) {
            const int t = tb + k, b = t >> 12;
            float hs;
            {
                float hf[32]; float mx = 0.f;
                const v4u* hp = (const v4u*)(H + (size_t)t * DM);
#pragma unroll
                for (int jj = 0; jj < 2; ++jj)
#pragma unroll
                    for (int c = 0; c < 2; ++c) { const v4u hv = hp[(jj * 64 + lane) * 2 + c]; const int o = jj * 16 + c * 8;
                        hf[o + 0] = bflo(hv.x); hf[o + 1] = bfhi(hv.x); hf[o + 2] = bflo(hv.y); hf[o + 3] = bfhi(hv.y); hf[o + 4] = bflo(hv.z); hf[o + 5] = bfhi(hv.z); hf[o + 6] = bflo(hv.w); hf[o + 7] = bfhi(hv.w); }
                { const float rstd = rsqrtf(wave_sum(lane < 32 ? ssr[(size_t)t * 32 + lane] : 0.f) * (1.f / DM) + NORM_EPS);
#pragma unroll
                    for (int jj = 0; jj < 2; ++jj)
#pragma unroll
                        for (int q = 0; q < 4; ++q) { const f32x4 s4 = *(const f32x4*)(sh2 + (size_t)b * MODW + (jj * 64 + lane) * 16 + 4 * q);
                            hf[jj * 16 + 4 * q] = hf[jj * 16 + 4 * q] * rstd + s4.x; hf[jj * 16 + 4 * q + 1] = hf[jj * 16 + 4 * q + 1] * rstd + s4.y;
                            hf[jj * 16 + 4 * q + 2] = hf[jj * 16 + 4 * q + 2] * rstd + s4.z; hf[jj * 16 + 4 * q + 3] = hf[jj * 16 + 4 * q + 3] * rstd + s4.w; } }
#pragma unroll
                for (int i = 0; i < 32; ++i) mx = fmaxf(mx, fabsf(hf[i]));
                mx = wave_max(mx);
                const float inv = mx > 0.f ? 127.f / mx : 0.f; hs = mx * (1.f / 127.f);
#pragma unroll
                for (int jj = 0; jj < 2; ++jj) { v4u q;
                    unsigned qd[4];
#pragma unroll
                    for (int d = 0; d < 4; ++d) { const int o = jj * 16 + 4 * d; const int q0 = (int)rintf(hf[o] * inv), q1 = (int)rintf(hf[o + 1] * inv), q2 = (int)rintf(hf[o + 2] * inv), q3 = (int)rintf(hf[o + 3] * inv);
                        qd[d] = (unsigned)(q0 & 255) | ((unsigned)(q1 & 255) << 8) | ((unsigned)(q2 & 255) << 16) | ((unsigned)(q3 & 255) << 24); }
                    q.x = qd[0]; q.y = qd[1]; q.z = qd[2]; q.w = qd[3]; hl[jj * 64 + lane] = q; }
                asm volatile("s_waitcnt lgkmcnt(0)" ::: "memory");
            }
            const int li = lane & 15, lq = lane >> 4;
            {
                v4i ub0[8], ub1[8];
#define ULOAD(buf, hh_, sg_) do { const int my_e_ = es[li * 64 + k * 16 + 2 * (hh_)]; const unsigned char* ub_ = U8 + (size_t)my_e_ * DM + lq * 16 + (sg_) * 512; \
    _Pragma("unroll") for (int s8 = 0; s8 < 8; ++s8) buf[s8] = *(const v4i*)(ub_ + s8 * 64); } while (0)
#define UCONS(buf, sg_) do { _Pragma("unroll") for (int s8 = 0; s8 < 8; ++s8) { const v4i hb_ = *(const LAS v4i*)(hl + ((sg_) * 8 + s8) * 4 + lq); acc = __builtin_amdgcn_mfma_i32_16x16x64_i8(buf[s8], hb_, acc, 0, 0, 0); } } while (0)
                ULOAD(ub0, 0, 0); ULOAD(ub1, 0, 1);
#pragma unroll 1
                for (int hh = 0; hh < 8; ++hh) {
                    v4i acc = {0, 0, 0, 0};
                    UCONS(ub0, 0); ULOAD(ub0, hh, 2);
                    UCONS(ub1, 1); ULOAD(ub1, hh, 3);
                    UCONS(ub0, 2); if (hh < 7) ULOAD(ub0, hh + 1, 0);
                    UCONS(ub1, 3); if (hh < 7) ULOAD(ub1, hh + 1, 1);
                    if (li == 0) { f32x4 d; d.x = (float)acc.x; d.y = (float)acc.y; d.z = (float)acc.z; d.w = (float)acc.w; *(LAS f32x4*)(dl + hh * 16 + 4 * lq) = d; }
                }
#undef ULOAD
#undef UCONS
            }
#pragma unroll
            for (int c = 0; c < 2; ++c) { const int x = lane + 64 * c, hh = x >> 4, r = x & 15; const int e = es[r * 64 + k * 16 + 2 * hh]; const float g = gs[r * 64 + k * 16 + 2 * hh];
                cfl[x] = g * VS[e] * gelu_as(dl[x] * (US[e] * hs)); }
            float out[32];
#pragma unroll
            for (int i = 0; i < 32; ++i) out[i] = 0.f;
            {
                v4u vb0[4][2], vb1[4][2], vb2[4][2]; float c0[4], c1[4], c2[4];
#define VLOAD(buf, cfb, bi_) do { const int bq_ = (bi_) < 32 ? (bi_) : 31; _Pragma("unroll") for (int i = 0; i < 4; ++i) { const int x_ = bq_ * 4 + i; const int e_ = __builtin_amdgcn_readfirstlane(es[(x_ & 15) * 64 + k * 16 + 2 * (x_ >> 4)]); \
        const float cv_ = __builtin_bit_cast(float, __builtin_amdgcn_readfirstlane(__builtin_bit_cast(int, cfl[x_]))); cfb[i] = (bi_) < 32 ? cv_ : 0.f; const v4u* vp_ = (const v4u*)(V8 + (size_t)e_ * DM) + lane; buf[i][0] = vp_[0]; buf[i][1] = vp_[64]; } } while (0)
#define VCONS(buf, cfb) do { _Pragma("unroll") for (int i = 0; i < 4; ++i) { const f32x2 c2_ = {cfb[i], cfb[i]}; \
        _Pragma("unroll") for (int jj = 0; jj < 2; ++jj) { const unsigned wd_[4] = {buf[i][jj].x, buf[i][jj].y, buf[i][jj].z, buf[i][jj].w}; \
            _Pragma("unroll") for (int d = 0; d < 4; ++d) { const int o_ = jj * 16 + 4 * d; \
                const f32x2 f0_ = __builtin_amdgcn_cvt_pk_f32_fp8((int)wd_[d], false), f1_ = __builtin_amdgcn_cvt_pk_f32_fp8((int)wd_[d], true); \
                f32x2 a0_ = {out[o_], out[o_ + 1]}, a1_ = {out[o_ + 2], out[o_ + 3]}; \
                a0_ = __builtin_elementwise_fma(c2_, f0_, a0_); a1_ = __builtin_elementwise_fma(c2_, f1_, a1_); \
                out[o_] = a0_.x; out[o_ + 1] = a0_.y; out[o_ + 2] = a1_.x; out[o_ + 3] = a1_.y; } } } } while (0)
                VLOAD(vb0, c0, 0); VLOAD(vb1, c1, 1); VLOAD(vb2, c2, 2);
#pragma unroll 1
                for (int bi = 0; bi < 33; bi += 3) {
                    VCONS(vb0, c0); VLOAD(vb0, c0, bi + 3);
                    VCONS(vb1, c1); VLOAD(vb1, c1, bi + 4);
                    VCONS(vb2, c2); VLOAD(vb2, c2, bi + 5);
                }
#undef VLOAD
#undef VCONS
            }
            f32x4 xn[2][4]; float ss = 0.f;
            const f32x4* xr = (const f32x4*)(X + (size_t)t * DM); const f32x4* gr = (const f32x4*)(g2 + (size_t)b * MODW);
#pragma unroll
            for (int jj = 0; jj < 2; ++jj)
#pragma unroll
                for (int q = 0; q < 4; ++q) { const int ix = (jj * 64 + lane) * 4 + q; const f32x4 xv = xr[ix], gv = gr[ix]; f32x4 o4; o4.x = out[jj * 16 + 4 * q]; o4.y = out[jj * 16 + 4 * q + 1]; o4.z = out[jj * 16 + 4 * q + 2]; o4.w = out[jj * 16 + 4 * q + 3];
                    const f32x4 y = xv + gv * o4; xn[jj][q] = y; ss += (y.x * y.x + y.y * y.y) + (y.z * y.z + y.w * y.w); }
            const float rstd = rsqrtf(wave_sum(ss) * (1.f / DM) + NORM_EPS);
            if (!last) {
                f32x4* xw = (f32x4*)((dry ? (float*)(A->ws + WS_DUMMY) : X) + (size_t)t * DM); v4u* hw = (v4u*)((dry ? (bf16*)(A->ws + WS_DUMMY + 64 * MiB) : H) + (size_t)t * DM);
#pragma unroll
                for (int jj = 0; jj < 2; ++jj) { f32x4 y[4];
#pragma unroll
                    for (int q = 0; q < 4; ++q) { const int ix = (jj * 64 + lane) * 4 + q; xw[ix] = xn[jj][q];
                        const f32x4 g = ((const f32x4*)ngain)[ix], s1 = ((const f32x4*)(nsc + (size_t)b * MODW))[ix], s0 = ((const f32x4*)(nsh + (size_t)b * MODW))[ix];
                        y[q] = xn[jj][q] * rstd * g * (s1 + 1.f) + s0; }
                    v4u o; o.x = pk2(y[0].x, y[0].y); o.y = pk2(y[0].z, y[0].w); o.z = pk2(y[1].x, y[1].y); o.w = pk2(y[1].z, y[1].w); hw[(jj * 64 + lane) * 2] = o;
                    o.x = pk2(y[2].x, y[2].y); o.y = pk2(y[2].z, y[2].w); o.z = pk2(y[3].x, y[3].y); o.w = pk2(y[3].z, y[3].w); hw[(jj * 64 + lane) * 2 + 1] = o; }
            } else {
                f32x4* ow = (f32x4*)((dry ? (float*)(A->ws + WS_DUMMY) : A->out) + (size_t)t * DM);
#pragma unroll
                for (int jj = 0; jj < 2; ++jj)
#pragma unroll
                    for (int q = 0; q < 4; ++q) { const int ix = (jj * 64 + lane) * 4 + q; ow[ix] = xn[jj][q] * rstd * ((const f32x4*)ngain)[ix]; }
            }
        }
    }
}

#ifndef PEER_SL_SHIFT
#define PEER_SL_SHIFT 10
#endif
__device__ __forceinline__ void ph_peer4(ArgsP A, LAS unsigned char* lds_, int wv_, int l, const float* g2, const float* sh2, const float* ngain, const float* nsh, const float* nsc, const bool last, const bool dry = false) {
    const Frame F = make_frame(lds_, wv_);
    const int lane = F.lane, li = lane & 15, lq = lane >> 4;
    const float* SCO = (const float*)(A->ws + WS_PROJ);
    const unsigned char* U4 = A->ws + WS_U + (size_t)l * PEER_N * (DM / 2); const unsigned char* V4 = A->ws + WS_V + (size_t)l * PEER_N * (DM / 2);
    const float* US = (const float*)(A->ws + WS_US) + (size_t)l * PEER_N; const float* VS = (const float*)(A->ws + WS_VS) + (size_t)l * PEER_N;
    float* X = (float*)(A->ws + WS_X); bf16* H = (bf16*)(A->ws + WS_H); const float* ssr = (const float*)(A->ws + WS_SSP) + (size_t)l * NT * 32;
    LAS unsigned char* wl = F.lds + F.wave * 15104;
    LAS int* es = (LAS int*)wl; LAS float* gs = (LAS float*)(wl + 4096);
    LAS v4u* hl = (LAS v4u*)wl;
    LAS int* se = (LAS int*)(wl + 8448);
    LAS float* sg = (LAS float*)(wl + 10496);
    LAS int* st = (LAS int*)(wl + 12544);
    LAS float* dl = (LAS float*)(wl + 14592);
    LAS float* hsl = dl + 64; LAS int* hsi = (LAS int*)(dl + 68);
    for (int tb = F.gw * 4; tb < NT; tb += F.ngw * 4) {
        {
            int P2[16]; float gt[16];
            const int prob = tb * 16 + lane, half = lane & 1;
            const f32x4* s4 = (const f32x4*)(SCO + (size_t)prob * 128);
            float L[16]; int P[16];
#pragma unroll
            for (int r = 0; r < 16; ++r) { L[r] = -3.0e38f; P[r] = 0; }
            f32x4 nv[4];
#pragma unroll
            for (int i = 0; i < 4; ++i) nv[i] = s4[i];
#pragma unroll 1
            for (int q = 0; q < 8; ++q) {
                f32x4 v[4];
#pragma unroll
                for (int i = 0; i < 4; ++i) v[i] = nv[i];
                if (q < 7) {
#pragma unroll
                    for (int i = 0; i < 4; ++i) nv[i] = s4[4 * (q + 1) + i]; }
                _Pragma("unroll") for (int r = 0; r < 16; ++r) asm volatile("" : "+v"(L[r]), "+v"(P[r]));
#pragma unroll
                for (int i = 0; i < 4; ++i) { const int ib = 16 * q + 4 * i;
                    INS16(L, P, v[i].x, ib); INS16(L, P, v[i].y, ib + 1); INS16(L, P, v[i].z, ib + 2); INS16(L, P, v[i].w, ib + 3); }
            }
            float v1[16], v2[16]; int i1[16], i2[16];
#pragma unroll
            for (int r = 0; r < 16; ++r) { const float ol = dpp_xor1(L[r]); const int op = __builtin_amdgcn_update_dpp(0, P[r], 0xB1, 0xF, 0xF, true);
                v1[r] = half ? ol : L[r]; v2[r] = half ? L[r] : ol; i1[r] = half ? op : P[r]; i2[r] = half ? P[r] : op; }
            float L2[16];
#pragma unroll
            for (int r = 0; r < 16; ++r) { L2[r] = -3.0e38f; P2[r] = 0; }
#pragma unroll
            for (int a = 0; a < 16; ++a)
#pragma unroll
                for (int bq = 0; bq < 16; ++bq) if ((a + 1) * (bq + 1) <= 16) { const float cv = v1[a] + v2[bq]; const int ce = i1[a] * 128 + i2[bq]; INS16(L2, P2, cv, ce); }
            float sum = 0.f;
#pragma unroll
            for (int r = 0; r < 16; ++r) { gt[r] = __expf(L2[r] - L2[0]); sum += gt[r]; }
            const float inv = 1.f / sum;
#pragma unroll
            for (int r = 0; r < 16; ++r) { es[r * 64 + lane] = P2[r]; gs[r * 64 + lane] = gt[r] * inv; }
            asm volatile("s_waitcnt lgkmcnt(0)" ::: "memory");
        }
        {
            int ee[8]; float gg[8];
#pragma unroll
            for (int j = 0; j < 8; ++j) { const int x = j * 64 + lane, k = x >> 7, y = x & 127; ee[j] = es[(y & 15) * 64 + k * 16 + 2 * (y >> 4)]; gg[j] = gs[(y & 15) * 64 + k * 16 + 2 * (y >> 4)]; }
            int base = 0;
#pragma unroll
            for (int p = 0; p < 2; ++p) {
#pragma unroll 1
                for (int s = 0; s < (16384 >> PEER_SL_SHIFT); ++s) {
#pragma unroll
                    for (int jj = 0; jj < 4; ++jj) { const int j = p * 4 + jj; const bool in = (ee[j] >> PEER_SL_SHIFT) == s; const unsigned long long m = __builtin_amdgcn_ballot_w64(in);
                        if (in) { const int pos = base + (int)__builtin_amdgcn_mbcnt_hi((unsigned)(m >> 32), __builtin_amdgcn_mbcnt_lo((unsigned)m, 0u)); se[pos] = ee[j]; sg[pos] = gg[j]; st[pos] = j >> 1; }
                        base += __builtin_popcountll(m); }
                }
            }
        }
        asm volatile("s_waitcnt lgkmcnt(0)" ::: "memory");
#pragma unroll 1
        for (int k = 0; k < 4; ++k) {
            const int t = tb + k, b = t >> 12;
            float hf[32]; float mx = 0.f;
            const v4u* hp = (const v4u*)(H + (size_t)t * DM);
#pragma unroll
            for (int jj = 0; jj < 2; ++jj)
#pragma unroll
                for (int c = 0; c < 2; ++c) { const v4u hv = hp[(jj * 64 + lane) * 2 + c]; const int o = jj * 16 + c * 8;
                    hf[o + 0] = bflo(hv.x); hf[o + 1] = bfhi(hv.x); hf[o + 2] = bflo(hv.y); hf[o + 3] = bfhi(hv.y); hf[o + 4] = bflo(hv.z); hf[o + 5] = bfhi(hv.z); hf[o + 6] = bflo(hv.w); hf[o + 7] = bfhi(hv.w); }
            { const float rstd = rsqrtf(wave_sum(lane < 32 ? ssr[(size_t)t * 32 + lane] : 0.f) * (1.f / DM) + NORM_EPS);
#pragma unroll
                for (int jj = 0; jj < 2; ++jj)
#pragma unroll
                    for (int q = 0; q < 4; ++q) { const f32x4 s4 = *(const f32x4*)(sh2 + (size_t)b * MODW + (jj * 64 + lane) * 16 + 4 * q);
                        hf[jj * 16 + 4 * q] = hf[jj * 16 + 4 * q] * rstd + s4.x; hf[jj * 16 + 4 * q + 1] = hf[jj * 16 + 4 * q + 1] * rstd + s4.y;
                        hf[jj * 16 + 4 * q + 2] = hf[jj * 16 + 4 * q + 2] * rstd + s4.z; hf[jj * 16 + 4 * q + 3] = hf[jj * 16 + 4 * q + 3] * rstd + s4.w; } }
#pragma unroll
            for (int i = 0; i < 32; ++i) mx = fmaxf(mx, fabsf(hf[i]));
            mx = wave_max(mx);
            const float inv = mx > 0.f ? 127.f / mx : 0.f;
            if (lane == 0) hsl[k] = mx * (1.f / 127.f);
            int hsum = 0;
#pragma unroll
            for (int jj = 0; jj < 2; ++jj) { unsigned qd[4];
#pragma unroll
                for (int d = 0; d < 4; ++d) { const int o = jj * 16 + 4 * d; const int q0 = (int)rintf(hf[o] * inv), q1 = (int)rintf(hf[o + 1] * inv), q2 = (int)rintf(hf[o + 2] * inv), q3 = (int)rintf(hf[o + 3] * inv);
                    qd[d] = (unsigned)(q0 & 255) | ((unsigned)(q1 & 255) << 8) | ((unsigned)(q2 & 255) << 16) | ((unsigned)(q3 & 255) << 24); hsum += (q0 + q1) + (q2 + q3); }
                v4u q; q.x = qd[0]; q.y = qd[1]; q.z = qd[2]; q.w = qd[3]; hl[k * 132 + jj * 64 + lane] = q; }
            { hsum = row16_sum_i(hsum); const int hs_all = __builtin_amdgcn_readlane(hsum, 0) + __builtin_amdgcn_readlane(hsum, 16) + __builtin_amdgcn_readlane(hsum, 32) + __builtin_amdgcn_readlane(hsum, 48);
                if (lane == 0) hsi[k] = hs_all; }
        }
        asm volatile("s_waitcnt lgkmcnt(0)" ::: "memory");
        {
            v4i ub0[8], ub1[8];
            int lu = lane; asm volatile("" : "+v"(lu)); const int li = lu & 15, lq = lu >> 4;
            const LAS v4u* hb = hl + (li & 3) * 132 + lq;
#define ULOAD(buf, g_, sg_) do { const int my_e_ = se[(g_) * 16 + li]; const unsigned char* ub_ = U4 + (size_t)my_e_ * (DM / 2) + lq * 16 + (sg_) * 512; \
    _Pragma("unroll") for (int s8 = 0; s8 < 8; ++s8) buf[s8] = *(const v4i*)(ub_ + s8 * 64); } while (0)
#define UCONS(buf, sg_) do { _Pragma("unroll") for (int s8 = 0; s8 < 8; ++s8) { const int c_ = (sg_) * 8 + s8; \
        const v4i lo_ = buf[s8] & 0x0F0F0F0F, hi_ = (buf[s8] >> 4) & 0x0F0F0F0F; \
        const v4i hb0_ = *(const LAS v4i*)(hb + c_ * 4), hb1_ = *(const LAS v4i*)(hb + 64 + c_ * 4); \
        acc = __builtin_amdgcn_mfma_i32_16x16x64_i8(lo_, hb0_, acc, 0, 0, 0); acc = __builtin_amdgcn_mfma_i32_16x16x64_i8(hi_, hb1_, acc, 0, 0, 0); } } while (0)
            ULOAD(ub0, 0, 0);
#pragma unroll 1
            for (int g = 0; g < 32; ++g) {
                const int gn = g + 1 < 32 ? g + 1 : 31;
                v4i acc = {0, 0, 0, 0};
                ULOAD(ub1, g, 1);
                UCONS(ub0, 0); ULOAD(ub0, gn, 0);
                UCONS(ub1, 1);
                if (li < 4) { const int hc = 8 * hsi[li];
                    dl[(4 * lq + 0) * 4 + li] = (float)(acc.x - hc); dl[(4 * lq + 1) * 4 + li] = (float)(acc.y - hc); dl[(4 * lq + 2) * 4 + li] = (float)(acc.z - hc); dl[(4 * lq + 3) * 4 + li] = (float)(acc.w - hc); }
                if (lane < 16) { const int x = g * 16 + lane; const int e = se[x], tk = st[x];
                    sg[x] = sg[x] * VS[e] * gelu_as(dl[lane * 4 + tk] * (US[e] * hsl[tk])); }
            }
#undef ULOAD
#undef UCONS
        }
        asm volatile("s_waitcnt lgkmcnt(0)" ::: "memory");
#define PEER_EPILOGUE(kk_, kt_) do { const int t = tb + (kt_), b = t >> 12; float (&out_k)[32] = out[kk_]; \
            f32x4 xn[2][4]; float ss = 0.f; \
            const f32x4* xr = (const f32x4*)(X + (size_t)t * DM); const f32x4* gr = (const f32x4*)(g2 + (size_t)b * MODW); \
            _Pragma("unroll") \
            for (int jj = 0; jj < 2; ++jj) \
            _Pragma("unroll") \
                for (int q = 0; q < 4; ++q) { const int ix = (jj * 64 + lane) * 4 + q; const f32x4 xv = xr[ix], gv = gr[ix]; f32x4 o4; o4.x = out_k[jj * 16 + 4 * q]; o4.y = out_k[jj * 16 + 4 * q + 1]; o4.z = out_k[jj * 16 + 4 * q + 2]; o4.w = out_k[jj * 16 + 4 * q + 3]; \
                    const f32x4 y = xv + gv * o4; xn[jj][q] = y; ss += (y.x * y.x + y.y * y.y) + (y.z * y.z + y.w * y.w); } \
            const float rstd = rsqrtf(wave_sum(ss) * (1.f / DM) + NORM_EPS); \
            if (!last) { \
                f32x4* xw = (f32x4*)((dry ? (float*)(A->ws + WS_DUMMY) : X) + (size_t)t * DM); v4u* hw = (v4u*)((dry ? (bf16*)(A->ws + WS_DUMMY + 64 * MiB) : H) + (size_t)t * DM); \
            _Pragma("unroll") \
                for (int jj = 0; jj < 2; ++jj) { f32x4 y[4]; \
            _Pragma("unroll") \
                    for (int q = 0; q < 4; ++q) { const int ix = (jj * 64 + lane) * 4 + q; xw[ix] = xn[jj][q]; \
                        const f32x4 g = ((const f32x4*)ngain)[ix], s1 = ((const f32x4*)(nsc + (size_t)b * MODW))[ix], s0 = ((const f32x4*)(nsh + (size_t)b * MODW))[ix]; \
                        y[q] = xn[jj][q] * rstd * g * (s1 + 1.f) + s0; } \
                    v4u o; o.x = pk2(y[0].x, y[0].y); o.y = pk2(y[0].z, y[0].w); o.z = pk2(y[1].x, y[1].y); o.w = pk2(y[1].z, y[1].w); hw[(jj * 64 + lane) * 2] = o; \
                    o.x = pk2(y[2].x, y[2].y); o.y = pk2(y[2].z, y[2].w); o.z = pk2(y[3].x, y[3].y); o.w = pk2(y[3].z, y[3].w); hw[(jj * 64 + lane) * 2 + 1] = o; } \
            } else { \
                f32x4* ow = (f32x4*)((dry ? (float*)(A->ws + WS_DUMMY) : A->out) + (size_t)t * DM); \
            _Pragma("unroll") \
                for (int jj = 0; jj < 2; ++jj) \
            _Pragma("unroll") \
                    for (int q = 0; q < 4; ++q) { const int ix = (jj * 64 + lane) * 4 + q; ow[ix] = xn[jj][q] * rstd * ((const f32x4*)ngain)[ix]; } \
            } \
        } while (0)
#define VLOAD(buf, cfb, tkb, bi_) do { _Pragma("unroll") for (int i = 0; i < 4; ++i) { const int x_ = (bi_) * 4 + i; const int e_ = __builtin_amdgcn_readfirstlane(se[x_]); \
        cfb[i] = __builtin_bit_cast(float, __builtin_amdgcn_readfirstlane(__builtin_bit_cast(int, sg[x_]))); tkb[i] = __builtin_amdgcn_readfirstlane(st[x_]) & 1; \
        const v2u* vp_ = (const v2u*)(V4 + (size_t)e_ * (DM / 2)) + lane_v; buf[i][0] = vp_[0]; buf[i][1] = vp_[64]; } } while (0)
#define VACC(kk_, bv_, cv_) do { const f32x2 c2_ = {cv_, cv_}; \
        _Pragma("unroll") for (int jj = 0; jj < 2; ++jj) { const unsigned wd_[2] = {bv_[jj].x, bv_[jj].y}; \
            _Pragma("unroll") for (int d = 0; d < 2; ++d) { const int o_ = jj * 16 + 8 * d; \
                const f32x2 f0_ = __builtin_amdgcn_cvt_scalef32_pk_f32_fp4((int)wd_[d], 1.0f, 0), f1_ = __builtin_amdgcn_cvt_scalef32_pk_f32_fp4((int)wd_[d], 1.0f, 1), \
                            f2_ = __builtin_amdgcn_cvt_scalef32_pk_f32_fp4((int)wd_[d], 1.0f, 2), f3_ = __builtin_amdgcn_cvt_scalef32_pk_f32_fp4((int)wd_[d], 1.0f, 3); \
                f32x2 a0_ = {out[kk_][o_], out[kk_][o_ + 1]}, a1_ = {out[kk_][o_ + 2], out[kk_][o_ + 3]}, a2_ = {out[kk_][o_ + 4], out[kk_][o_ + 5]}, a3_ = {out[kk_][o_ + 6], out[kk_][o_ + 7]}; \
                a0_ = __builtin_elementwise_fma(c2_, f0_, a0_); a1_ = __builtin_elementwise_fma(c2_, f1_, a1_); a2_ = __builtin_elementwise_fma(c2_, f2_, a2_); a3_ = __builtin_elementwise_fma(c2_, f3_, a3_); \
                out[kk_][o_] = a0_.x; out[kk_][o_ + 1] = a0_.y; out[kk_][o_ + 2] = a1_.x; out[kk_][o_ + 3] = a1_.y; out[kk_][o_ + 4] = a2_.x; out[kk_][o_ + 5] = a2_.y; out[kk_][o_ + 6] = a3_.x; out[kk_][o_ + 7] = a3_.y; } } } while (0)
#define VCONS(buf, cfb, tkb) do { _Pragma("unroll") for (int i = 0; i < 4; ++i) { if (tkb[i] == 0) VACC(0, buf[i], cfb[i]); else VACC(1, buf[i], cfb[i]); } } while (0)
#pragma unroll 1
        for (int p = 0; p < 2; ++p) {
            int lane_v = F.lane; asm volatile("" : "+v"(lane_v));
            float out[2][32];
#pragma unroll
            for (int k = 0; k < 2; ++k)
#pragma unroll
                for (int i = 0; i < 32; ++i) out[k][i] = 0.f;
            {
                v2u vb0[4][2], vb1[4][2]; float c0[4], c1[4]; int t0v[4], t1v[4];
                const int bb = p * 64;
                VLOAD(vb0, c0, t0v, bb); VLOAD(vb1, c1, t1v, bb + 1);
#pragma unroll 1
                for (int bi = 0; bi < 64; bi += 2) {
                    const int b2 = bb + (bi + 2 < 64 ? bi + 2 : 62), b3 = bb + (bi + 3 < 64 ? bi + 3 : 63);
                    VCONS(vb0, c0, t0v); VLOAD(vb0, c0, t0v, b2);
                    VCONS(vb1, c1, t1v); VLOAD(vb1, c1, t1v, b3);
                }
            }
            PEER_EPILOGUE(0, 2 * p); PEER_EPILOGUE(1, 2 * p + 1);
        }
#undef VLOAD
#undef VACC
#undef VCONS
#undef PEER_EPILOGUE
    }
}

__device__ __forceinline__ void PH_norm1_l0(LAS unsigned char* lds, int wv) { ArgsP A = args_ptr(); const float* MOD = (const float*)(A->ws + WS_MOD);
    ph_norm(A->in[0], A->in[4], MOD + 0 * DM, MOD + 1 * DM, (bf16*)(A->ws + WS_H), lds, wv);
    { const Frame F = make_frame(lds, wv); float* B3 = (float*)(A->ws + WS_BIAS3);
        for (int o = F.gw; o < DEPTH * 2 * DM; o += F.ngw) { const int l = o >> 12, b = (o >> 11) & 1, n = o & 2047;
            const float* sh = MOD + (size_t)(l * 2 + b) * MODW + 3 * DM; const v4u* wr = (const v4u*)((const bf16*)(A->ws + WS_WQK) + ((size_t)l * DM + n) * DM);
            float s = 0.f;
#pragma unroll
            for (int j = 0; j < 4; ++j) { const v4u wv4 = wr[j * 64 + F.lane]; const f32x4 s0 = *(const f32x4*)(sh + (j * 64 + F.lane) * 8), s1 = *(const f32x4*)(sh + (j * 64 + F.lane) * 8 + 4);
                s += bflo(wv4.x) * s0.x + bfhi(wv4.x) * s0.y + bflo(wv4.y) * s0.z + bfhi(wv4.y) * s0.w + bflo(wv4.z) * s1.x + bfhi(wv4.z) * s1.y + bflo(wv4.w) * s1.z + bfhi(wv4.w) * s1.w; }
            s = wave_sum(s);
            if (F.lane == 0) B3[o] = s; } } }
__device__ __forceinline__ void PH_gemm1(LAS unsigned char* lds, int wv, int l_) { ArgsP A = args_ptr(); const int l = opaque_i(l_);
    pg8::Gemm g{(const bf16*)(A->ws + WS_H), (const bf16*)(A->ws + WS_WIN) + (size_t)l * INWP * DM, NT, INWP, DM}; pg8::StaticOrder S; S.init(NT, INWP, gridDim.x, blockIdx.x);
    EpiStoreF32 E{(float*)(A->ws + WS_PROJ), INWP, wv};
    pg8::gemm_phase<EpiStoreF32, pg8::StaticOrder, true, true>(lds, g, S, E, wv); }
__device__ __forceinline__ void PH_mixA(LAS unsigned char* lds, int wv, int l_) { ArgsP A = args_ptr(); const int l = opaque_i(l_);
    const Frame F = make_frame(lds, wv);
#ifdef PROBE_A
    for (int u = F.bid; u < 2048; u += F.G) {
        if (u < 1536) { if (PROBE_A == 1) rwkvA_unit(A, F, l, u); }
        else { if (PROBE_A == 2) gla1_unit(A, F, l, u - 1536); }
    }
#endif
    for (int u = F.bid; u < 2048; u += F.G) {
        if (u < 1536) rwkvA_unit(A, F, l, u);
        else gla1_unit(A, F, l, u - 1536);
    }
    if (l + 1 < DEPTH) quant_tables(A, l + 1, F.gw, F.ngw, F.lane);
}
__device__ __forceinline__ void PH_mixB(LAS unsigned char* lds, int wv, int l_) { ArgsP A = args_ptr(); const int l = opaque_i(l_);
    const Frame F = make_frame(lds, wv);
    if (F.G >= 192) {
        if (F.bid < 96) rwkvB_scan(A, F, F.bid);
        else { const int nb = F.G - 96, b2 = F.bid - 96;
            for (int u = b2; u < 288; u += nb) gla_scan_unit(A, F, u);
            for (int u = b2; u < 1024; u += nb) pool_unit(A, F, l, u); }
    } else {
        for (int u = F.bid; u < 288; u += F.G) gla_scan_unit(A, F, u);
        for (int u = F.bid; u < 1024; u += F.G) pool_unit(A, F, l, u);
        for (int u = F.bid; u < 96; u += F.G) rwkvB_scan(A, F, u);
    } }
__device__ __forceinline__ void PH_mixC(LAS unsigned char* lds, int wv, int l_) { ArgsP A = args_ptr(); const int l = opaque_i(l_);
    const Frame F = make_frame(lds, wv);
#ifdef PROBE_C
    for (int u = F.bid; u < 2048; u += F.G) { if (u < 512) { if (PROBE_C == 1) gla3_unit(A, F, l, u); } else { if (PROBE_C == 2) rwkvC_unit(A, F, l, u - 512); } }
#endif
    for (int u = F.bid; u < 2048; u += F.G) { if (u < 512) gla3_unit(A, F, l, u); else rwkvC_unit(A, F, l, u - 512); } }
__device__ __forceinline__ void PH_gemm2(LAS unsigned char* lds, int wv, int l_, bool dry = false) { ArgsP A = args_ptr(); const int l = opaque_i(l_);
    const float* modl = (const float*)(A->ws + WS_MOD) + (size_t)l * 2 * MODW; float* X = (float*)(A->ws + WS_X);
    pg8::Gemm g{(const bf16*)(A->ws + WS_Y), (const bf16*)(A->ws + WS_WOUT) + (size_t)l * DM * DM, NT, DM, DM}; pg8::StaticOrder S; S.init(NT, DM, gridDim.x, blockIdx.x);
    EpiResid E{(l == 0) ? A->in[0] : (const float*)X, dry ? (float*)(A->ws + WS_DUMMY) : X, modl + 2 * DM, wv, A->in[23] + (size_t)l * DM, modl + 4 * DM,
               dry ? (bf16*)(A->ws + WS_DUMMY + 64 * MiB) : (bf16*)(A->ws + WS_H), (dry ? (float*)(A->ws + WS_DUMMY) : (float*)(A->ws + WS_SSP) + (size_t)l * NT * 32)};
    pg8::gemm_phase<EpiResid, pg8::StaticOrder, true, true>(lds, g, S, E, wv); }
__device__ __forceinline__ void PH_norm2(LAS unsigned char* lds, int wv, int l_) { ArgsP A = args_ptr(); const int l = opaque_i(l_);
    const float* modl = (const float*)(A->ws + WS_MOD) + (size_t)l * 2 * MODW;
    ph_norm((const float*)(A->ws + WS_X), A->in[23] + (size_t)l * DM, modl + 3 * DM, modl + 4 * DM, (bf16*)(A->ws + WS_H), lds, wv); }
__device__ __forceinline__ void PH_gemm3(LAS unsigned char* lds, int wv, int l_) { ArgsP A = args_ptr(); const int l = opaque_i(l_);
    pg8::Gemm g{(const bf16*)(A->ws + WS_H), (const bf16*)(A->ws + WS_WQK) + (size_t)l * DM * DM, NT, DM, DM}; pg8::StaticOrder S; S.init(NT, DM, gridDim.x, blockIdx.x);
    LAS float* rs = (LAS float*)(lds + 131072);
    { pg8::Unit u0; const int t = tid_from(wv); if (S.next(0, u0) && t < 256) { const f32x4* sp = (const f32x4*)((const float*)(A->ws + WS_SSP) + ((size_t)l * NT + u0.pm * 256 + t) * 32); float s = 0.f;
#pragma unroll
            for (int j = 0; j < 8; ++j) { const f32x4 v = sp[j]; s += (v.x + v.y) + (v.z + v.w); }
            rs[t] = rsqrtf(s * (1.f / DM) + NORM_EPS); }
        __syncthreads(); }
    EpiScore E{(float*)(A->ws + WS_PROJ), DM, wv, rs, (const float*)(A->ws + WS_BIAS3) + (size_t)l * 2 * DM};
    pg8::gemm_phase<EpiScore, pg8::StaticOrder, true, true>(lds, g, S, E, wv); }
__device__ __forceinline__ void PH_peer(LAS unsigned char* lds, int wv, int l_, bool dry = false) { ArgsP A = args_ptr(); const int l = opaque_i(l_);
    const float* MOD = (const float*)(A->ws + WS_MOD); const float* modl = MOD + (size_t)l * 2 * MODW;
    const bool last = (l == DEPTH - 1);
    const float* nmod = MOD + (size_t)(last ? l : l + 1) * 2 * MODW;
#ifndef PEER_ORDERED
#define PEER_ORDERED 1
#endif
    if (PEER_ORDERED) ph_peer4(A, lds, wv, l, modl + 5 * DM, modl + 3 * DM, last ? A->in[29] : A->in[4] + (size_t)(l + 1) * DM, nmod + 0 * DM, nmod + 1 * DM, last, dry);
    else ph_peer2(A, lds, wv, l, modl + 5 * DM, modl + 3 * DM, last ? A->in[29] : A->in[4] + (size_t)(l + 1) * DM, nmod + 0 * DM, nmod + 1 * DM, last, dry); }

__global__ void __launch_bounds__(NTHR, 2) mega_fwd(Args args) {
    extern __shared__ __attribute__((aligned(16))) unsigned char lds_raw[];
    LAS unsigned char* lds = (LAS unsigned char*)lds_raw;
    volatile LAS unsigned* MISC = (volatile LAS unsigned*)(lds + MISC_OFF);
    const int wv = __builtin_amdgcn_readfirstlane((int)(threadIdx.x >> 6));
    if (wv == 0) MISC[lane_id_()] = 0u;
    __syncthreads();
    XcdBarrier bar = xcd_barrier_post((unsigned*)(args_ptr()->ws + WS_CTL) + CW_BAR, MISC + 8, wv);
#define GRID_BAR() do { XcdBarrier b_ = bar; b_.bar = (unsigned*)(args_ptr()->ws + WS_CTL) + CW_BAR; asm volatile("" : "+s"(b_.x), "+s"(b_.w)); xcd_barrier(b_); if (PROBE & 512) xcd_barrier(b_); } while (0)

    ph_prologue(args_ptr(), lds, wv);
    GRID_BAR();
#if PROBE & 1
    ph_prologue(args_ptr(), lds, wv); GRID_BAR();
#endif
    PH_norm1_l0(lds, wv);
    GRID_BAR();
    for (int l = 0; l < DEPTH; ++l) {
#if PROBE & 2
        PH_gemm1(lds, wv, l); GRID_BAR();
#endif
        PH_gemm1(lds, wv, l); GRID_BAR();
#if PROBE & 4
        PH_mixA(lds, wv, l);  GRID_BAR();
#endif
        PH_mixA(lds, wv, l);  GRID_BAR();
#if PROBE & 8
        PH_mixB(lds, wv, l);  GRID_BAR();
#endif
        PH_mixB(lds, wv, l);  GRID_BAR();
#if PROBE & 16
        PH_mixC(lds, wv, l);  GRID_BAR();
#endif
        PH_mixC(lds, wv, l);  GRID_BAR();
#if PROBE & 32
        PH_gemm2(lds, wv, l, true); GRID_BAR();
#endif
        PH_gemm2(lds, wv, l); GRID_BAR();
#if PROBE & 128
        PH_gemm3(lds, wv, l); GRID_BAR();
#endif
        PH_gemm3(lds, wv, l); GRID_BAR();
#if PROBE & 256
        PH_peer(lds, wv, l, true); GRID_BAR();
#endif
        PH_peer(lds, wv, l);
        if (l + 1 < DEPTH) GRID_BAR();
    }
}

extern "C" void kernel_launch(void* const* d_in, const int* in_sizes, int n_in, void* d_out, int out_size, void* d_ws, size_t ws_size, hipStream_t stream) {
    static int grid = 0;
    if (grid == 0) {
        if (n_in != 30 || out_size != NT * DM || ws_size < WS_END + 96 * MiB) { fprintf(stderr, "kernel_launch: unexpected shapes (n_in %d out %d ws %zu)\n", n_in, out_size, ws_size); grid = -1; return; }
        int dev = 0, cus = 0, per_cu = 0;
        if (hipGetDevice(&dev) != hipSuccess || hipDeviceGetAttribute(&cus, hipDeviceAttributeMultiprocessorCount, dev) != hipSuccess) { grid = -1; return; }
        if (hipFuncSetAttribute((const void*)mega_fwd, hipFuncAttributeMaxDynamicSharedMemorySize, LDS_BYTES) != hipSuccess) { fprintf(stderr, "kernel_launch: hipFuncSetAttribute failed\n"); grid = -1; return; }
        if (hipOccupancyMaxActiveBlocksPerMultiprocessor(&per_cu, (const void*)mega_fwd, NTHR, LDS_BYTES) != hipSuccess || per_cu < 1) { fprintf(stderr, "kernel_launch: occupancy query says %d\n", per_cu); (void)hipGetLastError(); per_cu = 1; }
        grid = cus;
    }
    if (grid < 0) return;
    (void)in_sizes;
    if (hipMemsetAsync((char*)d_ws + WS_CTL, 0, CTL_ZERO_BYTES, stream) != hipSuccess) return;
    Args a{};
    for (int i = 0; i < 30; ++i) a.in[i] = (const float*)d_in[i];
    a.out = (float*)d_out; a.ws = (unsigned char*)d_ws;
    hipLaunchKernelGGL(mega_fwd, dim3(grid), dim3(NTHR), LDS_BYTES, stream, a);
}
```

```cpp
#include <hip/hip_runtime.h>
#include <cstdio>
#include <cstdint>
__device__ __forceinline__ int lane_id_() { int r; asm volatile("v_mbcnt_lo_u32_b32 %0, -1, 0\n\tv_mbcnt_hi_u32_b32 %0, -1, %0" : "=v"(r)); return r; }
__device__ __forceinline__ int tid_from(int wave_s) { return wave_s * 64 + lane_id_(); }
namespace pg8 {
#define PG8_LAS __attribute__((address_space(3)))
typedef unsigned short bf16_t;
typedef short bf16x8 __attribute__((ext_vector_type(8)));
typedef float f32x4 __attribute__((ext_vector_type(4)));
typedef unsigned u32x4 __attribute__((ext_vector_type(4)));
constexpr int BM = 256, BK = 64, HALF = 128, HTB = HALF * BK * 2  , STAGE_BYTES = 8 * HTB, NXCD = 8, WGM = 8;

__host__ __device__ __forceinline__ int lds_byte(int r, int c) { const int st = (r >> 4) * 2 + (c >> 5), rr = r & 15, cc = c & 31, ob = rr * 64 + cc * 2; return st * 1024 + (ob ^ (((ob >> 9) & 1) << 5)); }
__host__ __device__ __forceinline__ void stage_rc(int b, int& R, int& C) { const int st = b / 1024, sb = b % 1024, swz = sb ^ (((sb >> 9) & 1) << 5); R = (st >> 1) * 16 + swz / 64; C = (st & 1) * 32 + (swz % 64) / 2; }
__host__ __device__ __forceinline__ int perm32(int rho) { const int n = rho >> 4, i = rho & 15; return 8 * (i >> 2) + 4 * n + (i & 3); }

struct Unit { int pm, pn; };
struct Gemm { const bf16_t* A; const bf16_t* Bt; int M, N, K; };

struct StaticOrder {
    int nM, nN, nwg, G, c;
    __host__ __device__ void init(int M, int N, int G_, int c_) { nM = M / BM; nN = N / BM; nwg = nM * nN; G = G_; c = c_; }
    __host__ __device__ bool next(int i, Unit& u) const {
        const long L = (long)i * G + c; if (L >= nwg) return false;
        int wgid = (int)L; { const int q = nwg / NXCD, r = nwg % NXCD, xcd = wgid % NXCD, off = wgid / NXCD; wgid = (xcd < r ? xcd * (q + 1) : r * (q + 1) + (xcd - r) * q) + off; }
        const int nig = WGM * nN, gid = wgid / nig, fm = gid * WGM, gsz = (nM - fm) < WGM ? (nM - fm) : WGM;
        u.pm = fm + ((wgid % nig) % gsz); u.pn = (wgid % nig) / gsz; return true;
    }
    __device__ __forceinline__ void a_ready(const Unit&) const {}
    __device__ __forceinline__ void done(const Unit&) const {}
};

template <class Epi, class Sched, bool ALIGN_EPI = false, bool SP2 = false>
__device__ __forceinline__ void gemm_phase(PG8_LAS unsigned char* lds, const Gemm g, const Sched& S, const Epi& E, int wave_s) {
    int tid_o = tid_from(wave_s); asm volatile("" : "+v"(tid_o));
    const int tid = tid_o, wid = __builtin_amdgcn_readfirstlane(tid >> 6), lane = tid & 63, wr = wid >> 2, wc = wid & 3, fr = lane & 15, fq = lane >> 4;
    const int K = g.K, nt = K / BK;
    unsigned voffA[2], voffB[2];
#pragma unroll
    for (int i = 0; i < 2; ++i) { int R, C; stage_rc(tid * 16 + i * 8192, R, C); const int Rb = Epi::PERM ? ((R & ~31) + perm32(R & 31)) : R;
        voffA[i] = (unsigned)(R * K + C) * 2u; voffB[i] = (unsigned)(Rb * K + C) * 2u; }
    const size_t kstep = (size_t)(BK * 2);
    const size_t hstep = (size_t)HALF * K * 2;
    const size_t tstep = 2 * hstep;
    const unsigned ldsw = (unsigned)wid * 1024u;
    const int aoff = lds_byte(wr * 64 + fr, fq * 8), boff = lds_byte(wc * 32 + fr, fq * 8);
#define PG8_SA(b, h) (((b) * 2 + (h)) * HTB)
#define PG8_SB(b, h) ((4 + (b) * 2 + (h)) * HTB)
#define PG8_STAGE(bufoff, gbase, voff) do { _Pragma("unroll") for (int _i = 0; _i < 2; ++_i) \
        __builtin_amdgcn_global_load_lds((const unsigned*)((const char*)(gbase) + (voff)[_i]), (PG8_LAS unsigned*)(lds + (bufoff) + ldsw + _i * 8192), 16, 0, 0); } while (0)
#define PG8_LDA(dst, b, h) do { _Pragma("unroll") for (int m = 0; m < 4; ++m) _Pragma("unroll") for (int k = 0; k < 2; ++k) dst[m][k] = *(const PG8_LAS bf16x8*)(lds + PG8_SA(b, h) + aoff + m * 2048 + k * 1024); } while (0)
#define PG8_LDB(dst, b, h) do { _Pragma("unroll") for (int n = 0; n < 2; ++n) _Pragma("unroll") for (int k = 0; k < 2; ++k) dst[n][k] = *(const PG8_LAS bf16x8*)(lds + PG8_SB(b, h) + boff + n * 2048 + k * 1024); } while (0)
#define PG8_MMA(ai, bj, At, Bt) do { __builtin_amdgcn_s_setprio(1); _Pragma("unroll") for (int m = 0; m < 4; ++m) _Pragma("unroll") for (int n = 0; n < 2; ++n) _Pragma("unroll") for (int k = 0; k < 2; ++k) \
        acc[ai][bj][m][n] = __builtin_amdgcn_mfma_f32_16x16x32_bf16(Bt[n][k], At[m][k], acc[ai][bj][m][n], 0, 0, 0); __builtin_amdgcn_s_setprio(0); } while (0)
#define PG8_WAIT_V(n) asm volatile("s_waitcnt vmcnt(" #n ")" ::: "memory")
#define PG8_WAIT_L(n) asm volatile("s_waitcnt lgkmcnt(" #n ")" ::: "memory")
#define PG8_BAR __builtin_amdgcn_s_barrier()
#define PG8_SCHED __builtin_amdgcn_sched_barrier(0)
    Unit cur, nxt; int ui = 0;
    if (!S.next(0, cur)) return;
    f32x4 acc[2][2][4][2];
#pragma unroll
    for (int a = 0; a < 2; ++a)
#pragma unroll
        for (int b = 0; b < 2; ++b)
#pragma unroll
            for (int m = 0; m < 4; ++m)
#pragma unroll
                for (int n = 0; n < 2; ++n) acc[a][b][m][n] = (f32x4){0.f, 0.f, 0.f, 0.f};
    bf16x8 At[4][2], B0[2][2], B1[2][2];
    const char* cA = (const char*)g.A + (size_t)cur.pm * tstep; const char* cB = (const char*)g.Bt + (size_t)cur.pn * tstep;
    S.a_ready(cur);
    if constexpr (SP2) {
        PG8_STAGE(PG8_SB(0, 0), cB, voffB); PG8_STAGE(PG8_SB(0, 1), cB + hstep, voffB); PG8_STAGE(PG8_SA(0, 0), cA, voffA); PG8_STAGE(PG8_SA(0, 1), cA + hstep, voffA);
        if (wr == 1) PG8_BAR;
        PG8_WAIT_V(2); PG8_BAR;
        PG8_STAGE(PG8_SB(1, 0), cB + kstep, voffB); PG8_STAGE(PG8_SA(1, 0), cA + kstep, voffA); PG8_STAGE(PG8_SB(1, 1), cB + hstep + kstep, voffB);
        PG8_WAIT_V(6); PG8_BAR;
    } else {
        PG8_STAGE(PG8_SB(0, 0), cB, voffB); PG8_STAGE(PG8_SA(0, 0), cA, voffA); PG8_STAGE(PG8_SB(0, 1), cB + hstep, voffB); PG8_STAGE(PG8_SA(0, 1), cA + hstep, voffA);
        if (wr == 1) PG8_BAR;
        PG8_WAIT_V(4); PG8_BAR;
        PG8_STAGE(PG8_SB(1, 0), cB + kstep, voffB); PG8_STAGE(PG8_SA(1, 0), cA + kstep, voffA); PG8_STAGE(PG8_SB(1, 1), cB + hstep + kstep, voffB);
        PG8_WAIT_V(6); PG8_BAR;
    }
    for (;;) {
        const bool has_next = S.next(ui + 1, nxt);
        const char* nA = has_next ? (const char*)g.A + (size_t)nxt.pm * tstep : cA; const char* nB = has_next ? (const char*)g.Bt + (size_t)nxt.pn * tstep : cB;
        for (int t = 0; t < nt; t += 2) {
            const bool last = (t == nt - 2);
            const char* a1 = cA + (size_t)(t + 1) * kstep;
            const char* a2 = last ? nA : cA + (size_t)(t + 2) * kstep; const char* b2 = last ? nB : cB + (size_t)(t + 2) * kstep;
            const char* a3 = a2 + kstep; const char* b3 = b2 + kstep;
            if (last && has_next) S.a_ready(nxt);
            if constexpr (SP2) {
            PG8_LDB(B0, 0, 0); PG8_LDB(B1, 0, 1); PG8_SCHED; PG8_LDA(At, 0, 0); PG8_STAGE(PG8_SA(1, 1), a1 + hstep, voffA);
            PG8_WAIT_V(8); PG8_WAIT_L(0); PG8_BAR; PG8_MMA(0, 0, At, B0); PG8_MMA(0, 1, At, B1); PG8_BAR; PG8_SCHED;
            PG8_LDA(At, 0, 1); PG8_STAGE(PG8_SB(0, 0), b2, voffB); PG8_STAGE(PG8_SB(0, 1), b2 + hstep, voffB); PG8_STAGE(PG8_SA(0, 0), a2, voffA);
            PG8_WAIT_V(8); PG8_WAIT_L(0); PG8_BAR; PG8_MMA(1, 0, At, B0); PG8_MMA(1, 1, At, B1); PG8_BAR; PG8_SCHED;
            PG8_LDB(B0, 1, 0); PG8_LDB(B1, 1, 1); PG8_SCHED; PG8_LDA(At, 1, 0); PG8_STAGE(PG8_SA(0, 1), a2 + hstep, voffA);
            PG8_WAIT_V(8); PG8_WAIT_L(0); PG8_BAR; PG8_MMA(0, 0, At, B0); PG8_MMA(0, 1, At, B1); PG8_BAR; PG8_SCHED;
            PG8_LDA(At, 1, 1); PG8_STAGE(PG8_SB(1, 0), b3, voffB); PG8_STAGE(PG8_SB(1, 1), b3 + hstep, voffB); PG8_STAGE(PG8_SA(1, 0), a3, voffA);
            PG8_WAIT_V(8); PG8_WAIT_L(0); PG8_BAR; PG8_MMA(1, 0, At, B0); PG8_MMA(1, 1, At, B1); PG8_BAR; PG8_SCHED;
            } else {
            PG8_LDB(B0, 0, 0); PG8_SCHED; PG8_LDA(At, 0, 0); PG8_STAGE(PG8_SA(1, 1), a1 + hstep, voffA);
            PG8_WAIT_L(8); PG8_BAR; PG8_WAIT_L(0); PG8_MMA(0, 0, At, B0); PG8_BAR; PG8_SCHED;
            PG8_LDB(B1, 0, 1); PG8_STAGE(PG8_SB(0, 0), b2, voffB);
            PG8_BAR; PG8_WAIT_L(0); PG8_MMA(0, 1, At, B1); PG8_BAR;
            PG8_LDA(At, 0, 1); PG8_STAGE(PG8_SA(0, 0), a2, voffA);
            PG8_BAR; PG8_WAIT_L(0); PG8_MMA(1, 0, At, B0); PG8_BAR; PG8_SCHED;
            PG8_STAGE(PG8_SB(0, 1), b2 + hstep, voffB);
            PG8_WAIT_V(6); PG8_BAR; PG8_MMA(1, 1, At, B1); PG8_BAR;
            PG8_LDB(B0, 1, 0); PG8_SCHED; PG8_LDA(At, 1, 0); PG8_STAGE(PG8_SA(0, 1), a2 + hstep, voffA);
            PG8_WAIT_L(8); PG8_BAR; PG8_WAIT_L(0); PG8_MMA(0, 0, At, B0); PG8_BAR; PG8_SCHED;
            PG8_LDB(B1, 1, 1); PG8_STAGE(PG8_SB(1, 0), b3, voffB);
            PG8_BAR; PG8_WAIT_L(0); PG8_MMA(0, 1, At, B1); PG8_BAR;
            PG8_LDA(At, 1, 1); PG8_STAGE(PG8_SA(1, 0), a3, voffA);
            PG8_BAR; PG8_WAIT_L(0); PG8_MMA(1, 0, At, B0); PG8_BAR; PG8_SCHED;
            PG8_STAGE(PG8_SB(1, 1), b3 + hstep, voffB);
            PG8_WAIT_V(6); PG8_BAR; PG8_MMA(1, 1, At, B1); PG8_BAR;
            }
        }
        if constexpr (ALIGN_EPI) { if (wr == 0) PG8_BAR; }
        if constexpr (!Epi::AFTER_DRAIN) { E(acc, cur, wr, wc, fr, fq); S.done(cur); }
        if (!has_next) break;
#pragma unroll
        for (int a = 0; a < 2; ++a)
#pragma unroll
            for (int b = 0; b < 2; ++b)
#pragma unroll
                for (int m = 0; m < 4; ++m)
#pragma unroll
                    for (int n = 0; n < 2; ++n) acc[a][b][m][n] = (f32x4){0.f, 0.f, 0.f, 0.f};
        cur = nxt; cA = nA; cB = nB; ++ui;
        if constexpr (ALIGN_EPI) { if (wr == 1) PG8_BAR; }
    }
    PG8_WAIT_V(0);
    if constexpr (!ALIGN_EPI) { if (wr == 0) PG8_BAR; }
    PG8_BAR;
    if constexpr (Epi::AFTER_DRAIN) { E.fused(acc, cur, wr, wc, fr, fq, lds, wid, lane); S.done(cur); }
#undef PG8_SA
#undef PG8_SB
#undef PG8_STAGE
#undef PG8_LDA
#undef PG8_LDB
#undef PG8_MMA
#undef PG8_WAIT_V
#undef PG8_WAIT_L
#undef PG8_BAR
#undef PG8_SCHED
}
}
#define GAS __attribute__((address_space(1)))
#define LAS __attribute__((address_space(3)))
#define XB_TMO      128
#define XB_XCNT(j)  (256  + 64 * (j))
#define XB_XSUB(j)  (1280 + 64 * (j))
#define XB_XGEN(j)  (2304 + 64 * (j))
#define XB_TOP      3328
#define XB_TOPGEN   3392
#define XCD_BAR_WORDS 3456
#define XB_SPIN_CAP (1u << 18)

__device__ __forceinline__ unsigned xb_ld(unsigned* p)              { return __hip_atomic_load(p, __ATOMIC_RELAXED, __HIP_MEMORY_SCOPE_AGENT); }
__device__ __forceinline__ unsigned xb_add(unsigned* p, unsigned v) { return __hip_atomic_fetch_add(p, v, __ATOMIC_RELAXED, __HIP_MEMORY_SCOPE_AGENT); }
__device__ __forceinline__ unsigned xb_xcc_id() { return (unsigned)__builtin_amdgcn_s_getreg((3 << 11) | 20) & 0xFu; }
#define XB_SPIN(cond, bar) do { unsigned _sp = 0; while (cond) { __builtin_amdgcn_s_sleep(1); \
    if ((++_sp & 255u) == 0u) { if (xb_ld(&(bar)[XB_TMO])) break; if (_sp > XB_SPIN_CAP) { atomicAdd(&(bar)[XB_TMO], 1u); break; } } } } while (0)

struct XcdBarrier {
    unsigned* bar; unsigned x; int w;
    volatile LAS unsigned* st;
};

__device__ __forceinline__ XcdBarrier xcd_barrier_post(unsigned* bar, volatile LAS unsigned* st, int wave_s) {
    XcdBarrier b; b.bar = bar; b.x = xb_xcc_id(); b.st = st; b.w = wave_s;
    if (tid_from(wave_s) == 0) (void)xb_add(&bar[XB_XCNT(b.x)], 1u);
    return b;
}
__device__ __forceinline__ void xcd_barrier_complete(unsigned* bar, unsigned x, unsigned& nloc, unsigned& nx) {
    const unsigned G = gridDim.x * gridDim.y * gridDim.z;
    unsigned sum, cnt, mine, sp = 0u;
    for (;;) {
        sum = 0u; cnt = 0u; mine = 0u;
#pragma unroll
        for (unsigned j = 0; j < 16; ++j) { const unsigned c = xb_ld(&bar[XB_XCNT(j)]); sum += c; cnt += (c > 0u) ? 1u : 0u; mine = (j == x) ? c : mine; }
        if (sum == G) break;
        __builtin_amdgcn_s_sleep(1);
        if ((++sp & 255u) == 0u) { if (xb_ld(&bar[XB_TMO])) break; if (sp > XB_SPIN_CAP) { atomicAdd(&bar[XB_TMO], 1u); break; } }
    }
    nloc = mine > 0u ? mine : 1u; nx = cnt > 0u ? cnt : 1u;
}

__device__ __forceinline__ void xcd_barrier(const XcdBarrier& b) {
    asm volatile("s_waitcnt vmcnt(0)" ::: "memory");
    __syncthreads();
    if (tid_from(b.w) == 0) {
        unsigned* bar = b.bar;
        __builtin_amdgcn_s_waitcnt(0);
        unsigned nloc = b.st[0], nx = b.st[1];
        if (nloc == 0u) { xcd_barrier_complete(bar, b.x, nloc, nx); b.st[0] = nloc; b.st[1] = nx; }
        const unsigned old = xb_add(&bar[XB_XSUB(b.x)], 1u);
        const unsigned gen = old / nloc;
        if (old + 1u == (gen + 1u) * nloc) {
            __builtin_amdgcn_fence(__ATOMIC_RELEASE, "agent");
            asm volatile("s_waitcnt vmcnt(0)" ::: "memory");
            const unsigned og = xb_add(&bar[XB_TOP], 1u);
            const unsigned tg = og / nx;
            if (og + 1u == (tg + 1u) * nx) xb_add(&bar[XB_TOPGEN], 1u);
            else XB_SPIN(xb_ld(&bar[XB_TOPGEN]) == tg, bar);
            __builtin_amdgcn_fence(__ATOMIC_ACQUIRE, "agent");
            xb_add(&bar[XB_XGEN(b.x)], 1u);
            asm volatile("s_waitcnt vmcnt(0)" ::: "memory");
        } else {
            XB_SPIN(xb_ld(&bar[XB_XGEN(b.x)]) == gen, bar);
            __builtin_amdgcn_fence(__ATOMIC_ACQUIRE, "agent");
            asm volatile("s_waitcnt vmcnt(0)" ::: "memory");
        }
    }
    __syncthreads();
}

constexpr int NWAVES = 8, NTHR = 512;
constexpr int DM = 2048, NB = 2, SEQ = 4096, NT = NB * SEQ, DEPTH = 4;
constexpr int INW = 5392, INWP = 5632;
constexpr int C_POOL = 0, C_GQ = 512, C_GK = 896, C_GV = 1280, C_GG = 2048, C_GA = 2816, C_RW = 2832;
constexpr int RW_IN = 2560, RW_W = 768, RW_H = 12;
constexpr int GLA_H = 4, GLA_DK = 96, GLA_DV = 192, GLA_NCH = 64;
constexpr int PEER_N = 16384;
constexpr float NORM_EPS = 1e-6f;
constexpr int MODW = 6 * DM;

constexpr size_t MiB = 1u << 20;
constexpr size_t WS_CTL = 0, CTL_ZERO_BYTES = 1 * MiB;
constexpr size_t WS_MOD = 1 * MiB;
constexpr size_t WS_WIN = 2 * MiB;
constexpr size_t WS_WOUT = 90 * MiB;
constexpr size_t WS_WQK = 122 * MiB;
constexpr size_t WS_U = 154 * MiB;
constexpr size_t WS_V = 410 * MiB;
constexpr size_t WS_US = 540 * MiB;
constexpr size_t WS_VS = 541 * MiB;
constexpr size_t WS_POOLT = 545 * MiB;
constexpr size_t WS_LORAT = 542 * MiB;
constexpr size_t WS_X = 666 * MiB;
constexpr size_t WS_H = 730 * MiB;
constexpr size_t WS_Y = 762 * MiB;
constexpr size_t WS_PROJ = 794 * MiB;
constexpr size_t WS_GKV = 970 * MiB;
constexpr size_t WS_GS = 1006 * MiB;
constexpr size_t WS_GDEC = 1042 * MiB;
constexpr size_t WS_RSC = 1043 * MiB;
constexpr size_t WS_RO = 1187 * MiB;
constexpr size_t WS_RGATE = 1211 * MiB;
constexpr size_t WS_RBV = 1235 * MiB;
constexpr size_t WS_EIDX = 1259 * MiB;
constexpr size_t WS_EGATE = 1263 * MiB;
constexpr size_t WS_END = 1267 * MiB;
constexpr size_t WS_DUMMY = 1267 * MiB;
#ifndef PROBE
#define PROBE 0
#endif
constexpr int CW_BAR = 4096;
constexpr size_t WS_SSP = 547 * MiB;
constexpr size_t WS_BIAS3 = 546 * MiB;

constexpr int LDS_BYTES = 147456;
constexpr int MISC_OFF = 147456 - 256;

typedef unsigned short bf16;
typedef unsigned v4u __attribute__((ext_vector_type(4)));
typedef unsigned v2u __attribute__((ext_vector_type(2)));
typedef float f32x4 __attribute__((ext_vector_type(4)));
typedef float f32x2 __attribute__((ext_vector_type(2)));
typedef __bf16 bf16x2_t __attribute__((ext_vector_type(2)));
typedef int v4i __attribute__((ext_vector_type(4)));

__device__ __forceinline__ unsigned pk2(float lo, float hi) { const f32x2 f = {lo, hi}; return __builtin_bit_cast(unsigned, __builtin_convertvector(f, bf16x2_t)); }
__device__ __forceinline__ unsigned f2bf(float f) { return pk2(f, f) & 0xffffu; }
__device__ __forceinline__ float bflo(unsigned u) { return __builtin_bit_cast(float, u << 16); }
__device__ __forceinline__ float bfhi(unsigned u) { return __builtin_bit_cast(float, u & 0xffff0000u); }
__device__ __forceinline__ float dpp_xor1(float v) { return __builtin_bit_cast(float, __builtin_amdgcn_update_dpp(0, __builtin_bit_cast(int, v), 0xB1, 0xF, 0xF, true)); }
__device__ __forceinline__ float dpp_xor2(float v) { return __builtin_bit_cast(float, __builtin_amdgcn_update_dpp(0, __builtin_bit_cast(int, v), 0x4E, 0xF, 0xF, true)); }
__device__ __forceinline__ float dpp_hmir(float v) { return __builtin_bit_cast(float, __builtin_amdgcn_update_dpp(0, __builtin_bit_cast(int, v), 0x141, 0xF, 0xF, true)); }
__device__ __forceinline__ float dpp_rmir(float v) { return __builtin_bit_cast(float, __builtin_amdgcn_update_dpp(0, __builtin_bit_cast(int, v), 0x140, 0xF, 0xF, true)); }
__device__ __forceinline__ float rl_f(float v, int l) { return __builtin_bit_cast(float, __builtin_amdgcn_readlane(__builtin_bit_cast(int, v), l)); }
__device__ __forceinline__ float row16_sum(float v) { v += dpp_xor1(v); v += dpp_xor2(v); v += dpp_hmir(v); v += dpp_rmir(v); return v; }
__device__ __forceinline__ float row16_max(float v) { v = fmaxf(v, dpp_xor1(v)); v = fmaxf(v, dpp_xor2(v)); v = fmaxf(v, dpp_hmir(v)); v = fmaxf(v, dpp_rmir(v)); return v; }
__device__ __forceinline__ float wave_sum(float v) { v = row16_sum(v); return (rl_f(v, 0) + rl_f(v, 16)) + (rl_f(v, 32) + rl_f(v, 48)); }
__device__ __forceinline__ float wave_max(float v) { v = row16_max(v); return fmaxf(fmaxf(rl_f(v, 0), rl_f(v, 16)), fmaxf(rl_f(v, 32), rl_f(v, 48))); }
__device__ __forceinline__ float half32_sum(float v, int lane) { v = row16_sum(v); const float lo = rl_f(v, 0) + rl_f(v, 16), hi = rl_f(v, 32) + rl_f(v, 48); return lane < 32 ? lo : hi; }
__device__ __forceinline__ float red8(float v) { v += dpp_xor1(v); v += dpp_xor2(v); v += dpp_hmir(v); return v; }
__device__ __forceinline__ float sigmoidf_(float x) { return __builtin_amdgcn_rcpf(1.f + __builtin_amdgcn_exp2f(-1.4426950408889634f * x)); }
__device__ __forceinline__ float softplusf_(float x) { return fmaxf(x, 0.f) + 0.6931471805599453f * __builtin_amdgcn_logf(1.f + __builtin_amdgcn_exp2f(-1.4426950408889634f * fabsf(x))); }

struct Args { const float* in[30]; float* out; unsigned char* ws; };
typedef const __attribute__((address_space(4))) Args* ArgsP;
__device__ __forceinline__ ArgsP args_ptr() { ArgsP p = (ArgsP)__builtin_amdgcn_kernarg_segment_ptr(); asm volatile("" : "+s"(p)); return p; }
__device__ __forceinline__ int opaque_i(int v) { asm volatile("" : "+s"(v)); return v; }

struct Frame {
    LAS unsigned char* lds;
    int tid, lane, wave, G, bid, gw, ngw;
};
__device__ __forceinline__ Frame make_frame(LAS unsigned char* lds, int wave_s) {
    asm volatile("" : "+s"(wave_s)); Frame F; F.lds = lds; int t = tid_from(wave_s); asm volatile("" : "+v"(t));
    F.tid = t; F.lane = t & 63; F.wave = __builtin_amdgcn_readfirstlane(t >> 6); int g_ = gridDim.x, b_ = blockIdx.x; asm volatile("" : "+s"(g_), "+s"(b_)); F.G = g_; F.bid = b_; F.gw = F.bid * NWAVES + F.wave; F.ngw = F.G * NWAVES; return F;
}

struct EpiStoreF32 {
    static constexpr bool PERM = false, AFTER_DRAIN = false;
    float* C; int ldc; int ws_;
    __device__ __forceinline__ void operator()(const pg8::f32x4 (&acc)[2][2][4][2], const pg8::Unit& u, int, int, int, int) const {
        int tz = tid_from(ws_); asm volatile("" : "+v"(tz)); const int wid = tz >> 6, lane = tz & 63, wr = wid >> 2, wc = wid & 3, fr = lane & 15, fq = lane >> 4;
        const int row0 = u.pm * 256 + wr * 64 + fr, col0 = u.pn * 256 + wc * 32 + 4 * fq;
#pragma unroll
        for (int ai = 0; ai < 2; ++ai)
#pragma unroll
            for (int m = 0; m < 4; ++m) { float* rowp = C + (size_t)(row0 + ai * 128 + m * 16) * ldc + col0;
#pragma unroll
                for (int bj = 0; bj < 2; ++bj)
#pragma unroll
                    for (int n = 0; n < 2; ++n) *(pg8::f32x4*)(rowp + bj * 128 + n * 16) = acc[ai][bj][m][n]; }
    }
};
struct EpiResid {
    static constexpr bool PERM = false, AFTER_DRAIN = false;
    const float* xsrc; float* xdst; const float* gate; int ws_; const float* gain2; const float* sc2; bf16* hdst; float* ss;
    __device__ __forceinline__ void operator()(const pg8::f32x4 (&acc)[2][2][4][2], const pg8::Unit& u, int, int, int, int) const {
        int tz = tid_from(ws_); asm volatile("" : "+v"(tz)); const int wid = tz >> 6, lane = tz & 63, wr = wid >> 2, wc = wid & 3, fr = lane & 15, fq = lane >> 4;
        const int row0 = u.pm * 256 + wr * 64 + fr, col0 = u.pn * 256 + wc * 32 + 4 * fq;
        const float* gp = gate + (size_t)(u.pm >> 4) * MODW + col0; const float* sp = sc2 + (size_t)(u.pm >> 4) * MODW + col0;
        pg8::f32x4 gv[2][2], hv[2][2];
#pragma unroll
        for (int bj = 0; bj < 2; ++bj)
#pragma unroll
            for (int n = 0; n < 2; ++n) { gv[bj][n] = *(const pg8::f32x4*)(gp + bj * 128 + n * 16);
                hv[bj][n] = *(const pg8::f32x4*)(gain2 + col0 + bj * 128 + n * 16) * (*(const pg8::f32x4*)(sp + bj * 128 + n * 16) + 1.f); }
#pragma unroll
        for (int ai = 0; ai < 2; ++ai)
#pragma unroll
            for (int m = 0; m < 4; ++m) { const int row = row0 + ai * 128 + m * 16; const size_t ro = (size_t)row * DM + col0; float s = 0.f;
#pragma unroll
                for (int bj = 0; bj < 2; ++bj)
#pragma unroll
                    for (int n = 0; n < 2; ++n) { const pg8::f32x4 xv = *(const pg8::f32x4*)(xsrc + ro + bj * 128 + n * 16);
                        const pg8::f32x4 y = xv + gv[bj][n] * acc[ai][bj][m][n];
                        *(pg8::f32x4*)(xdst + ro + bj * 128 + n * 16) = y;
                        s += (y.x * y.x + y.y * y.y) + (y.z * y.z + y.w * y.w);
                        const pg8::f32x4 hh = y * hv[bj][n]; v2u pk; pk.x = pk2(hh.x, hh.y); pk.y = pk2(hh.z, hh.w); *(v2u*)(hdst + ro + bj * 128 + n * 16) = pk; }
                s += __builtin_bit_cast(float, __builtin_amdgcn_ds_bpermute((lane ^ 16) << 2, __builtin_bit_cast(int, s)));
                s += __builtin_bit_cast(float, __builtin_amdgcn_ds_bpermute((lane ^ 32) << 2, __builtin_bit_cast(int, s)));
                if (fq == 0) ss[(size_t)row * 32 + u.pn * 4 + wc] = s; }
    }
};
struct EpiScore {
    static constexpr bool PERM = false, AFTER_DRAIN = false;
    float* C; int ldc; int ws_; const LAS float* rs; const float* bias;
    __device__ __forceinline__ void operator()(const pg8::f32x4 (&acc)[2][2][4][2], const pg8::Unit& u, int, int, int, int) const {
        int tz = tid_from(ws_); asm volatile("" : "+v"(tz)); const int wid = tz >> 6, lane = tz & 63, wr = wid >> 2, wc = wid & 3, fr = lane & 15, fq = lane >> 4;
        const int row0 = u.pm * 256 + wr * 64 + fr, col0 = u.pn * 256 + wc * 32 + 4 * fq;
        const float* bp = bias + (size_t)(u.pm >> 4) * DM + col0;
        pg8::f32x4 bv[2][2];
#pragma unroll
        for (int bj = 0; bj < 2; ++bj)
#pragma unroll
            for (int n = 0; n < 2; ++n) bv[bj][n] = *(const pg8::f32x4*)(bp + bj * 128 + n * 16);
#pragma unroll
        for (int ai = 0; ai < 2; ++ai)
#pragma unroll
            for (int m = 0; m < 4; ++m) { const int row = row0 + ai * 128 + m * 16; float* rowp = C + (size_t)row * ldc + col0;
                const float rstd = rs[row & 255];
#pragma unroll
                for (int bj = 0; bj < 2; ++bj)
#pragma unroll
                    for (int n = 0; n < 2; ++n) *(pg8::f32x4*)(rowp + bj * 128 + n * 16) = acc[ai][bj][m][n] * rstd + bv[bj][n]; }
    }
};

__device__ __forceinline__ void quant_tables(ArgsP A, int l, int wvi, int nw, int lane) {
    for (int rr = wvi; rr < 2 * PEER_N; rr += nw) {
        const int tb = rr >= PEER_N, r = l * PEER_N + (rr - tb * PEER_N);
        const f32x4* src = (const f32x4*)(A->in[27 + tb] + (size_t)r * DM) + lane;
        f32x4 v[8]; float mx = 0.f;
        float ssq = 0.f;
#pragma unroll
        for (int j = 0; j < 8; ++j) { v[j] = src[64 * j]; mx = fmaxf(mx, fmaxf(fmaxf(fabsf(v[j].x), fabsf(v[j].y)), fmaxf(fabsf(v[j].z), fabsf(v[j].w)))); ssq += (v[j].x * v[j].x + v[j].y * v[j].y) + (v[j].z * v[j].z + v[j].w * v[j].w); }
        mx = wave_max(mx);
        mx = fminf(mx, (tb ? 3.0f : 2.5f) * sqrtf(wave_sum(ssq) * (1.f / DM)));
        unsigned* dst = (unsigned*)(A->ws + (tb ? WS_V : WS_U)) + (size_t)r * (DM / 4) + lane;
        if (!tb) { const float inv = mx > 0.f ? 7.f / mx : 0.f;
            unsigned* dst4 = (unsigned*)(A->ws + WS_U) + (size_t)r * (DM / 8) + lane;
#pragma unroll
            for (int j = 0; j < 4; ++j) { unsigned wd = 0u;
                const float lo4[4] = {v[j].x, v[j].y, v[j].z, v[j].w}, hi4[4] = {v[j + 4].x, v[j + 4].y, v[j + 4].z, v[j + 4].w};
#pragma unroll
                for (int i = 0; i < 4; ++i) { const unsigned nl = (unsigned)((int)rintf(fminf(fmaxf(lo4[i] * inv, -7.f), 7.f)) + 8), nh = (unsigned)((int)rintf(fminf(fmaxf(hi4[i] * inv, -7.f), 7.f)) + 8); wd |= (nl | (nh << 4)) << (8 * i); }
                dst4[64 * j] = wd; }
            if (lane == 0) ((float*)(A->ws + WS_US))[r] = mx * (1.f / 7.f);
        } else { const float inv = mx > 0.f ? 6.f / mx : 0.f;
            unsigned short* dst2 = (unsigned short*)(A->ws + WS_V) + (size_t)r * (DM / 4) + lane;
#pragma unroll
            for (int j = 0; j < 8; ++j) { const f32x4 c4 = __builtin_elementwise_min(__builtin_elementwise_max(v[j] * inv, (f32x4){-6.f, -6.f, -6.f, -6.f}), (f32x4){6.f, 6.f, 6.f, 6.f});
                int p = __builtin_amdgcn_cvt_scalef32_pk_fp4_f32(0, c4.x, c4.y, 1.0f, 0); p = __builtin_amdgcn_cvt_scalef32_pk_fp4_f32(p, c4.z, c4.w, 1.0f, 1); dst2[64 * j] = (unsigned short)p; }
            if (lane == 0) ((float*)(A->ws + WS_VS))[r] = mx * (1.f / 6.f);
        }
    }
}

__device__ __forceinline__ void transpose_item(const float* W, int K, int N, bf16* WT, LAS float* scr, int kb, int nb, int lane) {
    const int k0 = 64 * kb, n0 = 64 * nb, nl = (lane & 15) * 4, kr = lane >> 4;
    f32x4 v[16];
#pragma unroll
    for (int it = 0; it < 16; ++it) v[it] = (n0 + nl < N) ? *(const f32x4*)(W + (size_t)(k0 + it * 4 + kr) * N + n0 + nl) : (f32x4){0.f, 0.f, 0.f, 0.f};
#pragma unroll
    for (int it = 0; it < 16; ++it) { LAS float* s = scr + (it * 4 + kr) * 65 + nl; s[0] = v[it].x; s[1] = v[it].y; s[2] = v[it].z; s[3] = v[it].w; }
    asm volatile("s_waitcnt lgkmcnt(0)" ::: "memory");
    const int c = lane & 7;
#pragma unroll
    for (int j = 0; j < 8; ++j) { const int n = (lane >> 3) + 8 * j; const LAS float* s = scr + (8 * c) * 65 + n;
        v4u o; o.x = pk2(s[0 * 65], s[1 * 65]); o.y = pk2(s[2 * 65], s[3 * 65]); o.z = pk2(s[4 * 65], s[5 * 65]); o.w = pk2(s[6 * 65], s[7 * 65]);
        if (n0 + n < N) *(v4u*)(WT + (size_t)(n0 + n) * K + k0 + 8 * c) = o; }
    asm volatile("s_waitcnt lgkmcnt(0)" ::: "memory");
}

__device__ __forceinline__ void ph_prologue(ArgsP A, LAS unsigned char* lds_, int wv_) {
    const Frame F = make_frame(lds_, wv_);
    LAS float* ldsf = (LAS float*)F.lds;
    const int tid = F.tid, lane = F.lane, wave = F.wave;
    for (int i = tid; i < NB * DM; i += NTHR) { const float c = A->in[1][i]; ldsf[i] = c / (1.f + __expf(-c)); }
    __syncthreads();
    {
        LAS float* red = ldsf + 4096;
        float* MOD = (float*)(A->ws + WS_MOD);
        for (int u = F.bid; u < DEPTH * 96; u += F.G) {
            const int l = u / 96, j0 = (u % 96) * 128;
            const float* W = A->in[2] + (size_t)l * DM * MODW + j0 + lane * 2;
            float a00 = 0.f, a01 = 0.f, a10 = 0.f, a11 = 0.f;
            const int k0 = wave * 256;
#pragma unroll 8
            for (int k = k0; k < k0 + 256; ++k) { const f32x2 w = *(const f32x2*)(W + (size_t)k * MODW); const float c0 = ldsf[k], c1 = ldsf[DM + k];
                a00 += c0 * w.x; a01 += c0 * w.y; a10 += c1 * w.x; a11 += c1 * w.y; }
            red[(wave * 2 + 0) * 128 + lane * 2] = a00; red[(wave * 2 + 0) * 128 + lane * 2 + 1] = a01;
            red[(wave * 2 + 1) * 128 + lane * 2] = a10; red[(wave * 2 + 1) * 128 + lane * 2 + 1] = a11;
            __syncthreads();
            if (tid < 256) { const int b = tid >> 7, j = tid & 127; float s = 0.f;
#pragma unroll
                for (int w = 0; w < 8; ++w) s += red[(w * 2 + b) * 128 + j];
                s += A->in[3][(size_t)l * MODW + j0 + j];
                MOD[(size_t)(l * 2 + b) * MODW + j0 + j] = s; }
            __syncthreads();
        }
    }
    {
        LAS float* scr = ldsf + wave * 4160;
        constexpr int NBI = (INW + 63) / 64;
        constexpr int I_IN = 32 * NBI, I_OUT = 32 * 32, I_L = I_IN + I_OUT;
        for (int it = F.gw; it < DEPTH * I_L; it += F.ngw) {
            const int l = it / I_L; int r = it % I_L;
            if (r < I_IN) transpose_item(A->in[5] + (size_t)l * DM * INW, DM, INW, (bf16*)(A->ws + WS_WIN) + (size_t)l * INWP * DM, scr, r / NBI, r % NBI, lane);
            else { r -= I_IN; transpose_item(A->in[22] + (size_t)l * DM * DM, DM, DM, (bf16*)(A->ws + WS_WOUT) + (size_t)l * DM * DM, scr, r / 32, r % 32, lane); }
        }
        constexpr int PADV = (INWP - INW) * DM / 8;
        for (int i = F.bid * NTHR + tid; i < DEPTH * PADV; i += F.G * NTHR) { const int l = i / PADV, r = i % PADV;
            ((v4u*)((bf16*)(A->ws + WS_WIN) + (size_t)l * INWP * DM + (size_t)INW * DM))[r] = (v4u){0u, 0u, 0u, 0u}; }
    }
    __syncthreads();
    {
        LAS float* Ks = ldsf;
        LAS float* Ws = ldsf + 128 * 132;
        for (int u = F.bid; u < DEPTH * 16 * 32; u += F.G) {
            const int l = u >> 9, hh = (u >> 5) & 15, jt = u & 31, h = hh >> 1, half = hh & 1, j0 = jt * 64;
            const float* ksrc = (half ? A->in[26] : A->in[25]) + ((size_t)l * 8 + h) * 128 * 128;
            const float* wsrc = A->in[24] + (size_t)l * DM * DM + h * 256 + half * 128;
            {   f32x4 kq[8], wq4[4];
#pragma unroll
                for (int it = 0; it < 8; ++it) { const int i = tid + it * NTHR, n = i >> 5, d4 = (i & 31) * 4; kq[it] = *(const f32x4*)(ksrc + n * 128 + d4); }
#pragma unroll
                for (int it = 0; it < 4; ++it) { const int i = tid + it * NTHR, jj = i >> 5, d4 = (i & 31) * 4; wq4[it] = *(const f32x4*)(wsrc + (size_t)(j0 + jj) * DM + d4); }
#pragma unroll
                for (int it = 0; it < 8; ++it) { const int i = tid + it * NTHR, n = i >> 5, d4 = (i & 31) * 4; *(LAS f32x4*)(Ks + n * 132 + d4) = kq[it]; }
#pragma unroll
                for (int it = 0; it < 4; ++it) { const int i = tid + it * NTHR, jj = i >> 5, d4 = (i & 31) * 4; *(LAS f32x4*)(Ws + jj * 132 + d4) = wq4[it]; }
            }
            __syncthreads();
            { const int li = lane & 15, lq = lane >> 4;
                f32x4 acc[4] = {{0.f, 0.f, 0.f, 0.f}, {0.f, 0.f, 0.f, 0.f}, {0.f, 0.f, 0.f, 0.f}, {0.f, 0.f, 0.f, 0.f}};
#pragma unroll 4
                for (int ks = 0; ks < 32; ++ks) { const float a = Ks[(wave * 16 + li) * 132 + 4 * ks + lq];
#pragma unroll
                    for (int jt = 0; jt < 4; ++jt) acc[jt] = __builtin_amdgcn_mfma_f32_16x16x4f32(a, Ws[(jt * 16 + li) * 132 + 4 * ks + lq], acc[jt], 0, 0, 0); }
                bf16* dst = (bf16*)(A->ws + WS_WQK) + (size_t)l * DM * DM + (size_t)(h * 256 + half * 128 + wave * 16 + lq * 4) * DM + j0 + li;
#pragma unroll
                for (int jt = 0; jt < 4; ++jt) { dst[(size_t)0 * DM + jt * 16] = (bf16)f2bf(acc[jt].x); dst[(size_t)1 * DM + jt * 16] = (bf16)f2bf(acc[jt].y); dst[(size_t)2 * DM + jt * 16] = (bf16)f2bf(acc[jt].z); dst[(size_t)3 * DM + jt * 16] = (bf16)f2bf(acc[jt].w); } }
            __syncthreads();
        }
    }
    {
        bf16* PT = (bf16*)(A->ws + WS_POOLT);
        for (int i = F.bid * NTHR + tid; i < DEPTH * 4 * 128 * 128; i += F.G * NTHR) { const int lg = i >> 14, r = i & 16383, dcol = r >> 7, c = r & 127;
            PT[i] = (bf16)f2bf(A->in[6][(size_t)lg * 16384 + c * 128 + dcol]); }
    }
    {
        bf16* LT = (bf16*)(A->ws + WS_LORAT);
        for (int i = F.bid * NTHR + tid; i < DEPTH * RW_W * 256; i += F.G * NTHR) { const int l = i / (RW_W * 256), r = i % (RW_W * 256), c = r >> 8, j = r & 255;
            const float v = j < 64 ? A->in[13][((size_t)l * 64 + j) * RW_W + c] : (j < 128 ? A->in[15][((size_t)l * 64 + (j - 64)) * RW_W + c] : A->in[16][((size_t)l * 128 + (j - 128)) * RW_W + c]);
            LT[i] = (bf16)f2bf(v); }
    }
    quant_tables(A, 0, F.gw, F.ngw, lane);
}

__device__ __forceinline__ void ph_norm(const float* xsrc, const float* gain, const float* sh, const float* sc, bf16* hout, LAS unsigned char* lds_, int wv_) {
    const Frame F = make_frame(lds_, wv_);
    for (int m = F.gw; m < NT; m += F.ngw) {
        const int b = m >> 12;
        const f32x4* xr = (const f32x4*)(xsrc + (size_t)m * DM) + F.lane;
        f32x4 v[8]; float ss = 0.f;
#pragma unroll
        for (int j = 0; j < 8; ++j) { v[j] = xr[64 * j]; ss += (v[j].x * v[j].x + v[j].y * v[j].y) + (v[j].z * v[j].z + v[j].w * v[j].w); }
        const float rstd = rsqrtf(wave_sum(ss) * (1.f / DM) + NORM_EPS);
        v2u* o8 = (v2u*)(hout + (size_t)m * DM) + F.lane;
#pragma unroll
        for (int j = 0; j < 8; ++j) { const int col = j * 256 + F.lane * 4;
            const f32x4 g = *(const f32x4*)(gain + col), s1 = *(const f32x4*)(sc + (size_t)b * MODW + col), s0 = *(const f32x4*)(sh + (size_t)b * MODW + col);
            const f32x4 y = v[j] * rstd * g * (s1 + 1.f) + s0;
            v2u o; o.x = pk2(y.x, y.y); o.y = pk2(y.z, y.w); o8[64 * j] = o; }
    }
}
__device__ __forceinline__ void ph_final(const float* xsrc, const float* gain, float* out, LAS unsigned char* lds_, int wv_) {
    const Frame F = make_frame(lds_, wv_);
    for (int m = F.gw; m < NT; m += F.ngw) {
        const f32x4* xr = (const f32x4*)(xsrc + (size_t)m * DM) + F.lane;
        f32x4 v[8]; float ss = 0.f;
#pragma unroll
        for (int j = 0; j < 8; ++j) { v[j] = xr[64 * j]; ss += (v[j].x * v[j].x + v[j].y * v[j].y) + (v[j].z * v[j].z + v[j].w * v[j].w); }
        const float rstd = rsqrtf(wave_sum(ss) * (1.f / DM) + NORM_EPS);
        f32x4* o = (f32x4*)(out + (size_t)m * DM) + F.lane;
#pragma unroll
        for (int j = 0; j < 8; ++j) { const f32x4 g = *(const f32x4*)(gain + j * 256 + F.lane * 4); o[64 * j] = v[j] * rstd * g; }
    }
}

__device__ __forceinline__ void pool_unit(ArgsP A, const Frame& F_in, int l, int unit) {
    Frame F = F_in; asm volatile("" : "+v"(F.tid)); F.lane = F.tid & 63;
    const int tile = unit >> 2, g = unit & 3, t0 = tile * 32, s0 = t0 & (SEQ - 1), tid = F.tid, lane = F.lane, w = F.wave;
    const int win = 2 << g;
    const float* proj = (const float*)(A->ws + WS_PROJ);
    LAS float* ps = (LAS float*)F.lds;
    LAS unsigned short* ds = (LAS unsigned short*)(F.lds + 24064);
    const int rt = w >> 2, ct0 = (w & 3) * 2, li = lane & 15, lq = lane >> 4;
    typedef short b8 __attribute__((ext_vector_type(8)));
    b8 bw[2][4];
    { const unsigned short* PT = (const unsigned short*)(A->ws + WS_POOLT) + ((size_t)l * 4 + g) * 16384;
#pragma unroll
        for (int j = 0; j < 2; ++j)
#pragma unroll
            for (int ks = 0; ks < 4; ++ks) bw[j][ks] = *(const b8*)(PT + (size_t)((ct0 + j) * 16 + li) * 128 + ks * 32 + lq * 8); }
    {   f32x4 pq[3];
#pragma unroll
        for (int it = 0; it < 3; ++it) { const int i = tid + it * NTHR, r = i >> 5, c4 = i & 31; const int s = s0 - 15 + r;
            pq[it] = (i < 47 * 32 && s >= 0) ? *(const f32x4*)(proj + (size_t)(t0 - 15 + r) * INWP + C_POOL + g * 128 + c4 * 4) : (f32x4){0.f, 0.f, 0.f, 0.f}; }
#pragma unroll
        for (int it = 0; it < 3; ++it) { const int i = tid + it * NTHR; if (i < 47 * 32) *(LAS f32x4*)(ps + i * 4) = pq[it]; }
    }
    __syncthreads();
    for (int i = tid; i < 32 * 128; i += NTHR) { const int tok = i >> 7, c = i & 127; float sum = 0.f;
        for (int ww = 0; ww < win; ++ww) sum += ps[(tok + 15 - ww) * 128 + c];
        const int cnt = (s0 + tok + 1) < win ? (s0 + tok + 1) : win;
        ds[tok * 136 + c] = (unsigned short)f2bf(sum * __builtin_amdgcn_rcpf((float)cnt) - ps[(tok + 15) * 128 + c]); }
    __syncthreads();
    f32x4 acc[2] = {{0.f, 0.f, 0.f, 0.f}, {0.f, 0.f, 0.f, 0.f}};
#pragma unroll
    for (int ks = 0; ks < 4; ++ks) { const b8 a = *(const LAS b8*)(ds + (rt * 16 + li) * 136 + ks * 32 + lq * 8);
#pragma unroll
        for (int j = 0; j < 2; ++j) acc[j] = __builtin_amdgcn_mfma_f32_16x16x32_bf16(a, bw[j][ks], acc[j], 0, 0, 0); }
    bf16* Y = (bf16*)(A->ws + WS_Y);
#pragma unroll
    for (int j = 0; j < 2; ++j) { const int dcol = (ct0 + j) * 16 + li; const float scale = A->in[7][(size_t)l * 512 + g * 128 + dcol]; const int tk = t0 + rt * 16 + lq * 4;
        Y[(size_t)(tk + 0) * DM + g * 128 + dcol] = (bf16)f2bf(acc[j].x * scale); Y[(size_t)(tk + 1) * DM + g * 128 + dcol] = (bf16)f2bf(acc[j].y * scale);
        Y[(size_t)(tk + 2) * DM + g * 128 + dcol] = (bf16)f2bf(acc[j].z * scale); Y[(size_t)(tk + 3) * DM + g * 128 + dcol] = (bf16)f2bf(acc[j].w * scale); }
    __syncthreads();
}

__device__ __forceinline__ void gla_bcum(ArgsP A, const Frame& F, int l, int h, int t0, LAS float* bcum, LAS float* ad, LAS float* up) {
    const float* proj = (const float*)(A->ws + WS_PROJ);
    const int tid = F.tid;
    {
        const float a0 = proj[(size_t)(t0 + (tid >> 4)) * INWP + C_GA + (tid & 15)], a1 = proj[(size_t)(t0 + 32 + (tid >> 4)) * INWP + C_GA + (tid & 15)];
        const float* upg = A->in[8] + (size_t)l * 16 * 384 + h * 96;
        const float u0 = upg[(tid / 96) * 384 + tid % 96], u1 = upg[((tid + 512) / 96) * 384 + (tid + 512) % 96], u2 = upg[((tid + 1024) / 96) * 384 + (tid + 1024) % 96];
        ad[tid] = a0; ad[tid + 512] = a1; up[tid] = u0; up[tid + 512] = u1; up[tid + 1024] = u2;
    }
    __syncthreads();
    for (int i = tid; i < 64 * 96; i += NTHR) { const int tok = i / 96, d = i % 96; float x = A->in[9][(size_t)l * 384 + h * 96 + d];
#pragma unroll
        for (int j = 0; j < 16; ++j) x += ad[tok * 16 + j] * up[j * 96 + d];
        bcum[i] = -softplusf_(-x) * (1.f / 16.f); }
    __syncthreads();
    if (tid < 384) { const int d = tid % 96, seg = tid / 96; float acc = 0.f;
#pragma unroll
        for (int k = 0; k < 16; ++k) { acc += bcum[(seg * 16 + k) * 96 + d]; bcum[(seg * 16 + k) * 96 + d] = acc; }
        ad[seg * 96 + d] = acc; }
    __syncthreads();
    if (tid < 384) { const int d = tid % 96, seg = tid / 96; float pre = 0.f;
#pragma unroll
        for (int s2 = 0; s2 < 3; ++s2) pre += (s2 < seg) ? ad[s2 * 96 + d] : 0.f;
        if (seg > 0) {
#pragma unroll
            for (int k = 0; k < 16; ++k) bcum[(seg * 16 + k) * 96 + d] += pre; } }
    __syncthreads();
}

__device__ __forceinline__ void gla_scan_unit(ArgsP A, const Frame& F, int unit) {
    const int idx = unit * NTHR + F.tid, bh = idx / 18432, rem = idx % 18432, d = rem % 96;
    const float* KV = (const float*)(A->ws + WS_GKV) + (size_t)bh * 64 * 18432 + rem;
    float* GS = (float*)(A->ws + WS_GS) + (size_t)bh * 64 * 18432 + rem;
    const float* DEC = (const float*)(A->ws + WS_GDEC) + (size_t)bh * 64 * 96 + d;
    float S = 0.f;
#pragma unroll 1
    for (int c0 = 0; c0 < 64; c0 += 16) {
        float kv[16], dc[16];
#pragma unroll
        for (int j = 0; j < 16; ++j) { kv[j] = KV[(size_t)(c0 + j) * 18432]; dc[j] = DEC[(c0 + j) * 96]; }
#pragma unroll
        for (int j = 0; j < 16; ++j) { GS[(size_t)(c0 + j) * 18432] = S; S = dc[j] * S + kv[j]; }
    }
}

typedef short bf16x8_t __attribute__((ext_vector_type(8)));
constexpr int RS = 68;
__device__ __forceinline__ f32x4 tile_mm64(const LAS bf16* Am, int arow0, const LAS bf16* Bm, int brow0, f32x4 acc, int lane) {
    const int r = lane & 15, kq = (lane >> 4) * 8;
#pragma unroll
    for (int ks = 0; ks < 2; ++ks) {
        const bf16x8_t a = *(const LAS bf16x8_t*)(Am + (arow0 + r) * RS + ks * 32 + kq);
        const bf16x8_t b = *(const LAS bf16x8_t*)(Bm + (brow0 + r) * RS + ks * 32 + kq);
        acc = __builtin_amdgcn_mfma_f32_16x16x32_bf16(a, b, acc, 0, 0, 0);
    }
    return acc;
}
constexpr int RA_BT = 0, RA_KT = 8704, RA_AT = 17408, RA_RT = 26112, RA_RABS = 34816, RA_BHT = 43520, RA_KHT = 52224, RA_VT = 60928, RA_AABS = 69632,
              RA_MBAT = 86272, RA_MKA = 103680, RA_NBRT = 121088, RA_GC = 129792, RA_WT = 130048, RA_NKRT = 132096, RA_END = 140800, RA_PRE = 94976;
constexpr int RA_Z = RA_BT, RA_QST = RA_AT, RA_QOT = RA_RT, RA_LO = 0, RA_RES = 34816;
constexpr size_t RWO_POT = 0, RWO_PST = 12 * MiB, RWO_GT = 24 * MiB, RWO_OLT = 48 * MiB, RWO_SC = 72 * MiB;

__device__ __forceinline__ void rwkvA_unit(ArgsP A, const Frame& F_in, int l, int unit) {
    Frame F = F_in; asm volatile("" : "+v"(F.tid)); F.lane = F.tid & 63;

    const int bh = unit >> 6, c = unit & 63, b = bh / RW_H, h = bh % RW_H, t0 = b * SEQ + c * 64, s0 = c * 64, tid = F.tid, lane = F.lane, w = F.wave;
    const float* proj = (const float*)(A->ws + WS_PROJ);
    const float* mu = A->in[11] + (size_t)l * RW_IN;
    LAS unsigned char* L = F.lds;
    const int n = lane, cc = h * 64 + n;
    const int rt1 = w >> 1, ct1 = (w & 1) * 2, li1 = lane & 15, lq1 = lane >> 4;
    f32x4 yc[8], yp[8];
#pragma unroll
    for (int it = 0; it < 8; ++it) { const int g = tid + it * NTHR, tok = g >> 6, j4 = (g & 63) * 4; const float* rp = proj + ((size_t)t0 + tok) * INWP + C_RW + 2304 + j4;
        yc[it] = *(const f32x4*)rp; yp[it] = (s0 + tok > 0) ? *(const f32x4*)(rp - INWP) : (f32x4){0.f, 0.f, 0.f, 0.f}; }
    bf16x8_t bw[2][8];
    { const bf16* LT = (const bf16*)(A->ws + WS_LORAT) + ((size_t)l * RW_W + h * 64) * 256;
#pragma unroll
        for (int j = 0; j < 2; ++j)
#pragma unroll
            for (int ks = 0; ks < 8; ++ks) bw[j][ks] = *(const bf16x8_t*)(LT + (size_t)((ct1 + j) * 16 + li1) * 256 + ks * 32 + lq1 * 8); }
    float rr[9], kr[9], vr[9];
#pragma unroll
    for (int i = 0; i < 9; ++i) { const int tok = w * 8 + i - 1; const bool ok = (s0 + tok >= 0); const float* row = proj + ((size_t)t0 + tok) * INWP + C_RW;
        rr[i] = ok ? row[cc] : 0.f; kr[i] = ok ? row[768 + cc] : 0.f; vr[i] = ok ? row[1536 + cc] : 0.f; }
    const float w0c = A->in[12][(size_t)l * RW_W + cc], a0c = A->in[14][(size_t)l * RW_W + cc], kkc = A->in[17][(size_t)l * RW_W + cc], kac = A->in[18][(size_t)l * RW_W + cc], rkc = A->in[19][(size_t)l * RW_W + cc];
    const float mur = mu[cc], muk = mu[768 + cc], muv = mu[1536 + cc];
    {   LAS bf16* lo = (LAS bf16*)(L + RA_LO);
#pragma unroll
        for (int it = 0; it < 8; ++it) { const int g = tid + it * NTHR, tok = g >> 6, j4 = (g & 63) * 4; const f32x4 m4 = *(const f32x4*)(mu + 2304 + j4);
            const f32x4 ym = yc[it] + (yp[it] - yc[it]) * m4;
            const float sc = j4 < 64 ? 2.f : 1.f; f32x4 sg; sg.x = sigmoidf_(ym.x * sc); sg.y = sigmoidf_(ym.y * sc); sg.z = sigmoidf_(ym.z * sc); sg.w = sigmoidf_(ym.w * sc);
            const f32x4 o = j4 < 64 ? sg * 2.f - 1.f : (j4 < 128 ? ym : sg);
            v2u pk; pk.x = pk2(o.x, o.y); pk.y = pk2(o.z, o.w); *(LAS v2u*)(lo + tok * 264 + j4) = pk; }
    }
    __syncthreads();
    {
        const int rt = rt1, ct0 = ct1, li = li1, lq = lq1;
        const LAS bf16* lo = (const LAS bf16*)(L + RA_LO);
        LAS float* res = (LAS float*)(L + RA_RES);
        f32x4 acc[3][2];
#pragma unroll
        for (int p = 0; p < 3; ++p)
#pragma unroll
            for (int j = 0; j < 2; ++j) acc[p][j] = (f32x4){0.f, 0.f, 0.f, 0.f};
#pragma unroll
        for (int ks = 0; ks < 8; ++ks) { const bf16x8_t a = *(const LAS bf16x8_t*)(lo + (rt * 16 + li) * 264 + ks * 32 + lq * 8);
            const int p = ks < 2 ? 0 : (ks < 4 ? 1 : 2);
#pragma unroll
            for (int j = 0; j < 2; ++j) acc[p][j] = __builtin_amdgcn_mfma_f32_16x16x32_bf16(a, bw[j][ks], acc[p][j], 0, 0, 0); }
#pragma unroll
        for (int p = 0; p < 3; ++p)
#pragma unroll
            for (int j = 0; j < 2; ++j) { LAS float* rp = res + p * 64 * 68 + (rt * 16 + lq * 4) * 68 + (ct0 + j) * 16 + li;
                rp[0] = acc[p][j].x; rp[68] = acc[p][j].y; rp[136] = acc[p][j].z; rp[204] = acc[p][j].w; }
    }
    __syncthreads();
    float r_[8], k_[8], v_[8], av_[8], bb_[8], lw_[8];
    {
        const LAS float* res = (const LAS float*)(L + RA_RES);
        float wl[8], al[8], gl[8];
#pragma unroll
        for (int i = 0; i < 8; ++i) { wl[i] = res[(w * 8 + i) * 68 + n]; al[i] = res[64 * 68 + (w * 8 + i) * 68 + n]; gl[i] = res[2 * 64 * 68 + (w * 8 + i) * 68 + n]; }
        float* GATE = (float*)(A->ws + WS_RGATE); float* BV = (float*)(A->ws + WS_RBV);
#pragma unroll
        for (int i = 0; i < 8; ++i) { const int tok = w * 8 + i; const size_t t = (size_t)t0 + tok;
            float r = rr[i + 1], k = kr[i + 1], v = vr[i + 1];
            r += (rr[i] - r) * mur; k += (kr[i] - k) * muk; v += (vr[i] - v) * muv;
            const float wraw = -softplusf_(-(w0c + wl[i])) - 0.5f;
            const float a = sigmoidf_(a0c + al[i]);
            float kk = k * kkc; kk = kk * __builtin_amdgcn_rsqf(fmaxf(wave_sum(kk * kk), 1e-24f));
            const float k2 = k * (1.f + (a - 1.f) * kac);
            const float bonus = wave_sum(r * k2 * rkc);
            r_[i] = r; k_[i] = k2; v_[i] = v; av_[i] = -kk; bb_[i] = kk * a; lw_[i] = -__expf(wraw);
            GATE[t * RW_W + cc] = gl[i]; BV[t * RW_W + cc] = bonus * v; }
    }
    LAS float* wt = (LAS float*)(L + RA_WT);
#pragma unroll
    for (int i = 1; i < 8; ++i) lw_[i] += lw_[i - 1];
    wt[w * 64 + n] = lw_[7];
    __syncthreads();
    float pre = 0.f, mid = 0.f, last = 0.f;
#pragma unroll
    for (int ww = 0; ww < 8; ++ww) { const float x = wt[ww * 64 + n]; pre += (ww < w) ? x : 0.f; mid += (ww < 4) ? x : 0.f; last += x; }
    {
        LAS bf16* Bt = (LAS bf16*)(L + RA_BT); LAS bf16* Kt = (LAS bf16*)(L + RA_KT); LAS bf16* At = (LAS bf16*)(L + RA_AT); LAS bf16* Rt = (LAS bf16*)(L + RA_RT);
        LAS bf16* Rab = (LAS bf16*)(L + RA_RABS); LAS bf16* BhT = (LAS bf16*)(L + RA_BHT); LAS bf16* KhT = (LAS bf16*)(L + RA_KHT); LAS bf16* VT = (LAS bf16*)(L + RA_VT);
        LAS float* AabT = (LAS float*)(L + RA_AABS);
#pragma unroll
        for (int i = 0; i < 8; ++i) { const int t = w * 8 + i; const float lw = pre + lw_[i], lwm1 = pre + (i > 0 ? lw_[i - 1] : 0.f);
            const float eg = __expf(lw - mid), egi = __expf(mid - lw), egm1 = __expf(lwm1 - mid), eh = __expf(last - lw);
            Bt[t * RS + n] = (bf16)f2bf(bb_[i] * egi); Kt[t * RS + n] = (bf16)f2bf(k_[i] * egi); At[t * RS + n] = (bf16)f2bf(av_[i] * egm1); Rt[t * RS + n] = (bf16)f2bf(r_[i] * eg);
            Rab[t * RS + n] = (bf16)f2bf(r_[i] * __expf(lw)); AabT[n * 65 + t] = av_[i] * __expf(lwm1);
            BhT[n * RS + t] = (bf16)f2bf(bb_[i] * eh); KhT[n * RS + t] = (bf16)f2bf(k_[i] * eh); VT[n * RS + t] = (bf16)f2bf(v_[i]); }
        if (w == 0) ((LAS float*)(L + RA_GC))[n] = __expf(last);
    }
    __syncthreads();
    const int rt = w >> 1, ct0 = (w & 1) * 2, li = lane & 15, lq = lane >> 4;
#define FRAG(mat_, row_, ks_) (*(const LAS bf16x8_t*)((mat_) + ((row_) + li) * RS + (ks_) * 32 + lq * 8))
#define MM(a_, b_, c_) __builtin_amdgcn_mfma_f32_16x16x32_bf16(a_, b_, c_, 0, 0, 0)
    {
        const LAS bf16* Bt = (const LAS bf16*)(L + RA_BT); const LAS bf16* Kt = (const LAS bf16*)(L + RA_KT); const LAS bf16* At = (const LAS bf16*)(L + RA_AT); const LAS bf16* Rt = (const LAS bf16*)(L + RA_RT);
        LAS bf16* MbaT = (LAS bf16*)(L + RA_MBAT); LAS float* Mka = (LAS float*)(L + RA_MKA); LAS bf16* NbrT = (LAS bf16*)(L + RA_NBRT);
        bf16x8_t aB[2], aK[2], bA[2][2], bR[2][2];
#pragma unroll
        for (int ks = 0; ks < 2; ++ks) { aB[ks] = FRAG(Bt, rt * 16, ks); aK[ks] = FRAG(Kt, rt * 16, ks);
#pragma unroll
            for (int j = 0; j < 2; ++j) { bA[j][ks] = FRAG(At, (ct0 + j) * 16, ks); bR[j][ks] = FRAG(Rt, (ct0 + j) * 16, ks); } }
#pragma unroll
        for (int j = 0; j < 2; ++j) { const int ct = ct0 + j, tcol = ct * 16 + li, srow = rt * 16 + lq * 4;
            const f32x4 z = {0.f, 0.f, 0.f, 0.f};
            f32x4 mba = MM(aB[1], bA[j][1], MM(aB[0], bA[j][0], z)), nbr = MM(aB[1], bR[j][1], MM(aB[0], bR[j][0], z));
            f32x4 mka = MM(aK[1], bA[j][1], MM(aK[0], bA[j][0], z)), nk = MM(aK[1], bR[j][1], MM(aK[0], bR[j][0], z));
            mba.x = (srow + 0 < tcol) ? mba.x : 0.f; mba.y = (srow + 1 < tcol) ? mba.y : 0.f; mba.z = (srow + 2 < tcol) ? mba.z : 0.f; mba.w = (srow + 3 < tcol) ? mba.w : 0.f;
            mka.x = (srow + 0 < tcol) ? mka.x : 0.f; mka.y = (srow + 1 < tcol) ? mka.y : 0.f; mka.z = (srow + 2 < tcol) ? mka.z : 0.f; mka.w = (srow + 3 < tcol) ? mka.w : 0.f;
            nbr.x = (srow + 0 <= tcol) ? nbr.x : 0.f; nbr.y = (srow + 1 <= tcol) ? nbr.y : 0.f; nbr.z = (srow + 2 <= tcol) ? nbr.z : 0.f; nbr.w = (srow + 3 <= tcol) ? nbr.w : 0.f;
            nk.x = (srow + 0 <= tcol) ? nk.x : 0.f; nk.y = (srow + 1 <= tcol) ? nk.y : 0.f; nk.z = (srow + 2 <= tcol) ? nk.z : 0.f; nk.w = (srow + 3 <= tcol) ? nk.w : 0.f;
            { v2u pm; pm.x = pk2(mba.x, mba.y); pm.y = pk2(mba.z, mba.w); *(LAS v2u*)(MbaT + tcol * RS + srow) = pm; }
            Mka[(srow + 0) * RS + tcol] = mka.x; Mka[(srow + 1) * RS + tcol] = mka.y; Mka[(srow + 2) * RS + tcol] = mka.z; Mka[(srow + 3) * RS + tcol] = mka.w;
            v2u pk; pk.x = pk2(nbr.x, nbr.y); pk.y = pk2(nbr.z, nbr.w); *(LAS v2u*)(NbrT + tcol * RS + srow) = pk;
            { v2u pn; pn.x = pk2(nk.x, nk.y); pn.y = pk2(nk.z, nk.w); *(LAS v2u*)((LAS bf16*)(L + RA_NKRT) + tcol * RS + srow) = pn; } }
    }
    __syncthreads();
    {
        int t4 = tid; asm volatile("" : "+v"(t4)); const int row = t4 >> 2, q = t4 & 3, l4 = t4 & 63, li4 = l4 & 15, lq4 = l4 >> 4;
        const LAS bf16* MbaT = (const LAS bf16*)(L + RA_MBAT);
        const LAS float* Yrow = (row < 64) ? ((const LAS float*)(L + RA_AABS) + row * 65) : ((const LAS float*)(L + RA_MKA) + (row - 64) * RS);
        LAS bf16* Z = (LAS bf16*)(L + RA_Z); LAS float* pre = (LAS float*)(L + RA_PRE);
        for (int i = t4; i < 1088; i += NTHR) ((LAS v4u*)Z)[i] = (v4u){0u, 0u, 0u, 0u};
        __syncthreads();
#pragma unroll 1
        for (int jb = 0; jb < 4; ++jb) {
            if (jb > 0) {
                f32x4 acc = {0.f, 0.f, 0.f, 0.f};
#pragma unroll
                for (int ks = 0; ks < 2; ++ks) { const bf16x8_t a = *(const LAS bf16x8_t*)(Z + (w * 16 + li4) * RS + ks * 32 + lq4 * 8);
                    const bf16x8_t bm = *(const LAS bf16x8_t*)(MbaT + (jb * 16 + li4) * RS + ks * 32 + lq4 * 8);
                    acc = __builtin_amdgcn_mfma_f32_16x16x32_bf16(a, bm, acc, 0, 0, 0); }
                LAS float* pp = pre + (w * 16 + lq4 * 4) * 16 + li4;
                pp[0] = acc.x; pp[16] = acc.y; pp[32] = acc.z; pp[48] = acc.w;
                __syncthreads();
            }
            float yv[16]; v2u mv[16];
#pragma unroll
            for (int u = 0; u < 16; ++u) { yv[u] = Yrow[jb * 16 + u] + (jb > 0 ? pre[row * 16 + u] : 0.f); mv[u] = *(const LAS v2u*)(MbaT + (jb * 16 + u) * RS + jb * 16 + q * 4); }
            float zb[4] = {0.f, 0.f, 0.f, 0.f};
#pragma unroll
            for (int u = 0; u < 16; ++u) {
                float part = (zb[0] * bflo(mv[u].x) + zb[1] * bfhi(mv[u].x)) + (zb[2] * bflo(mv[u].y) + zb[3] * bfhi(mv[u].y));
                part += dpp_xor1(part); part += dpp_xor2(part);
                const float zt = yv[u] + part;
                zb[u & 3] = (q == (u >> 2)) ? zt : zb[u & 3];
            }
            { v2u pk; pk.x = pk2(zb[0], zb[1]); pk.y = pk2(zb[2], zb[3]); *(LAS v2u*)(Z + row * RS + jb * 16 + q * 4) = pk; }
            __syncthreads();
        }
    }
    {
        int t5 = tid; asm volatile("" : "+v"(t5)); const int li = t5 & 15, lq = (t5 >> 4) & 3;
        const LAS bf16* Z = (const LAS bf16*)(L + RA_Z); const LAS bf16* NbrT = (const LAS bf16*)(L + RA_NBRT); const LAS bf16* BhT = (const LAS bf16*)(L + RA_BHT);
        const LAS bf16* Rab = (const LAS bf16*)(L + RA_RABS); const LAS bf16* KhT = (const LAS bf16*)(L + RA_KHT); const LAS float* gC = (const LAS float*)(L + RA_GC);
        LAS bf16* QsT = (LAS bf16*)(L + RA_QST); LAS bf16* QoT = (LAS bf16*)(L + RA_QOT);
        bf16* PoT = (bf16*)(A->ws + WS_RSC + RWO_POT) + (size_t)unit * 4096; bf16* PsT = (bf16*)(A->ws + WS_RSC + RWO_PST) + (size_t)unit * 4096;
        bf16x8_t zW[2], zX[2], bN[2][2], bH[2][2]; v2u rb[2], kb[2], nb2[2]; float gc[2];
#pragma unroll
        for (int ks = 0; ks < 2; ++ks) { zW[ks] = FRAG(Z, rt * 16, ks); zX[ks] = FRAG(Z, 64 + rt * 16, ks);
#pragma unroll
            for (int j = 0; j < 2; ++j) { bN[j][ks] = FRAG(NbrT, (ct0 + j) * 16, ks); bH[j][ks] = FRAG(BhT, (ct0 + j) * 16, ks); } }
#pragma unroll
        for (int j = 0; j < 2; ++j) { const int col = (ct0 + j) * 16 + li, rw = rt * 16 + lq * 4; rb[j] = *(const LAS v2u*)(Rab + col * RS + rw); kb[j] = *(const LAS v2u*)(KhT + col * RS + rw); nb2[j] = *(const LAS v2u*)((const LAS bf16*)(L + RA_NKRT) + col * RS + rw); gc[j] = gC[col]; }
#pragma unroll
        for (int j = 0; j < 2; ++j) { const int col = (ct0 + j) * 16 + li, rw = rt * 16 + lq * 4;
            { f32x4 acc = {bflo(rb[j].x), bfhi(rb[j].x), bflo(rb[j].y), bfhi(rb[j].y)};
                acc = MM(zW[1], bN[j][1], MM(zW[0], bN[j][0], acc));
                v2u pk; pk.x = pk2(acc.x, acc.y); pk.y = pk2(acc.z, acc.w); *(v2u*)(PoT + (size_t)col * 64 + rw) = pk; }
            { f32x4 acc = {(rw + 0 == col) ? gc[j] : 0.f, (rw + 1 == col) ? gc[j] : 0.f, (rw + 2 == col) ? gc[j] : 0.f, (rw + 3 == col) ? gc[j] : 0.f};
                acc = MM(zW[1], bH[j][1], MM(zW[0], bH[j][0], acc));
                v2u pk; pk.x = pk2(acc.x, acc.y); pk.y = pk2(acc.z, acc.w); *(v2u*)(PsT + (size_t)col * 64 + rw) = pk; }
            { f32x4 acc = {bflo(nb2[j].x), bfhi(nb2[j].x), bflo(nb2[j].y), bfhi(nb2[j].y)};
                acc = MM(zX[1], bN[j][1], MM(zX[0], bN[j][0], acc));
                v2u pk; pk.x = pk2(acc.x, acc.y); pk.y = pk2(acc.z, acc.w); *(LAS v2u*)(QoT + col * RS + rw) = pk; }
            { f32x4 acc = {bflo(kb[j].x), bfhi(kb[j].x), bflo(kb[j].y), bfhi(kb[j].y)};
                acc = MM(zX[1], bH[j][1], MM(zX[0], bH[j][0], acc));
                v2u pk; pk.x = pk2(acc.x, acc.y); pk.y = pk2(acc.z, acc.w); *(LAS v2u*)(QsT + col * RS + rw) = pk; }
        }
    }
    __syncthreads();
    {
        int t6 = tid; asm volatile("" : "+v"(t6)); const int li = t6 & 15, lq = (t6 >> 4) & 3;
        const LAS bf16* VT = (const LAS bf16*)(L + RA_VT);
        const bool isO = (w & 1);
        const LAS bf16* Bm = (const LAS bf16*)(L + (isO ? RA_QOT : RA_QST));
        float* dst = (float*)(A->ws + WS_RSC + (isO ? RWO_OLT : RWO_GT)) + (size_t)unit * 4096;
        bf16x8_t av[2], bq[4][2];
#pragma unroll
        for (int ks = 0; ks < 2; ++ks) { av[ks] = FRAG(VT, rt * 16, ks);
#pragma unroll
            for (int j = 0; j < 4; ++j) bq[j][ks] = FRAG(Bm, j * 16, ks); }
#pragma unroll
        for (int j = 0; j < 4; ++j) { const f32x4 z = {0.f, 0.f, 0.f, 0.f};
            const f32x4 acc = MM(av[1], bq[j][1], MM(av[0], bq[j][0], z));
            *(f32x4*)(dst + (size_t)(j * 16 + li) * 64 + rt * 16 + lq * 4) = acc; }
    }
#undef FRAG
#undef MM
    __syncthreads();
}

__device__ __forceinline__ void rwkvB_scan(ArgsP A, const Frame& F, int unit) {
    const int bh = unit >> 2, rq = unit & 3;
    const int tid = F.tid, lane = F.lane, w = F.wave, ct = w & 3, li = lane & 15, lq = lane >> 4;
    const bool writer = (w < 4);
    const bf16* PsT = (const bf16*)(A->ws + WS_RSC + RWO_PST) + (size_t)bh * 64 * 4096; const float* GT = (const float*)(A->ws + WS_RSC + RWO_GT) + (size_t)bh * 64 * 4096;
    bf16* SC = (bf16*)(A->ws + WS_RSC + RWO_SC) + (size_t)bh * 64 * 4096;
    f32x4 S = {0.f, 0.f, 0.f, 0.f};
    constexpr int PF = 4;
    bf16x8_t pb[PF][2]; f32x4 gq[PF];
    const int col = ct * 16 + li;
#define SLOAD(slot, cc_) do { _Pragma("unroll") for (int ks = 0; ks < 2; ++ks) pb[slot][ks] = *(const bf16x8_t*)(PsT + (size_t)(cc_) * 4096 + (size_t)col * 64 + ks * 32 + lq * 8); \
        gq[slot] = *(const f32x4*)(GT + (size_t)(cc_) * 4096 + (size_t)col * 64 + rq * 16 + lq * 4); } while (0)
#define SSTEP(slot, cc_) do { LAS bf16* Sl = (LAS bf16*)(F.lds + ((cc_) & 1) * 2176); \
        if (writer) { const int rw_ = lq * 4; Sl[(rw_ + 0) * RS + col] = (bf16)f2bf(S.x); Sl[(rw_ + 1) * RS + col] = (bf16)f2bf(S.y); Sl[(rw_ + 2) * RS + col] = (bf16)f2bf(S.z); Sl[(rw_ + 3) * RS + col] = (bf16)f2bf(S.w); } \
        asm volatile("s_waitcnt lgkmcnt(0)" ::: "memory"); __builtin_amdgcn_s_barrier(); asm volatile("" ::: "memory");        \
        if (tid < 128) { const int v_ = tid >> 3, k8_ = (tid & 7) * 8; *(v4u*)(SC + (size_t)(cc_) * 4096 + (rq * 16 + v_) * 64 + k8_) = *(const LAS v4u*)(Sl + v_ * RS + k8_); } \
        f32x4 acc_ = gq[slot]; \
        _Pragma("unroll") for (int ks = 0; ks < 2; ++ks) { const bf16x8_t a_ = *(const LAS bf16x8_t*)(Sl + li * RS + ks * 32 + lq * 8); \
            acc_ = __builtin_amdgcn_mfma_f32_16x16x32_bf16(a_, pb[slot][ks], acc_, 0, 0, 0); } \
        S = acc_; } while (0)
    SLOAD(0, 0); SLOAD(1, 1); SLOAD(2, 2); SLOAD(3, 3);
#pragma unroll 1
    for (int c = 0; c < 64; c += 4) {
        const int cn = (c + 4 < 64) ? c + 4 : 60;
        SSTEP(0, c);     SLOAD(0, cn);
        SSTEP(1, c + 1); SLOAD(1, cn + 1);
        SSTEP(2, c + 2); SLOAD(2, cn + 2);
        SSTEP(3, c + 3); SLOAD(3, cn + 3);
    }
#undef SLOAD
#undef SSTEP
    __syncthreads();
}

__device__ __forceinline__ void rwkvC_unit(ArgsP A, const Frame& F_in, int l, int unit) {
    Frame F = F_in; asm volatile("" : "+v"(F.tid)); F.lane = F.tid & 63;

    const int bh = unit >> 6, c = unit & 63, b = bh / RW_H, h = bh % RW_H, t0 = b * SEQ + c * 64, tid = F.tid, lane = F.lane, w = F.wave;
    const int rt = w >> 1, ct0 = (w & 1) * 2, li = lane & 15, lq = lane >> 4;
    LAS bf16* Sl = (LAS bf16*)F.lds; LAS bf16* Pl = (LAS bf16*)(F.lds + 8704); LAS float* ob = (LAS float*)(F.lds + 17408);
    { const int r = tid >> 3, k8 = (tid & 7) * 8;
        *(LAS v4u*)(Sl + r * RS + k8) = *(const v4u*)((const bf16*)(A->ws + WS_RSC + RWO_SC) + (size_t)unit * 4096 + r * 64 + k8);
        *(LAS v4u*)(Pl + r * RS + k8) = *(const v4u*)((const bf16*)(A->ws + WS_RSC + RWO_POT) + (size_t)unit * 4096 + r * 64 + k8); }
    __syncthreads();
    const float* OlT = (const float*)(A->ws + WS_RSC + RWO_OLT) + (size_t)unit * 4096;
#pragma unroll
    for (int j = 0; j < 2; ++j) { const int tcol = (ct0 + j) * 16 + li, vr = rt * 16 + lq * 4;
        f32x4 acc = *(const f32x4*)(OlT + (size_t)tcol * 64 + vr);
        acc = tile_mm64(Sl, rt * 16, Pl, (ct0 + j) * 16, acc, lane);
        *(LAS f32x4*)(ob + tcol * 68 + vr) = acc; }
    __syncthreads();
    { const int t = tid >> 3, q = tid & 7; const size_t tg = (size_t)t0 + t;
        const f32x4 o0 = *(const LAS f32x4*)(ob + t * 68 + q * 8), o1 = *(const LAS f32x4*)(ob + t * 68 + q * 8 + 4);
        const float mean = red8((o0.x + o0.y) + (o0.z + o0.w) + (o1.x + o1.y) + (o1.z + o1.w)) * (1.f / 64.f);
        const f32x4 d0 = o0 - mean, d1 = o1 - mean;
        const float var = red8((d0.x * d0.x + d0.y * d0.y) + (d0.z * d0.z + d0.w * d0.w) + (d1.x * d1.x + d1.y * d1.y) + (d1.z * d1.z + d1.w * d1.w)) * (1.f / 64.f);
        const float rs = rsqrtf(var + 64e-5f);
        const int cc = h * 64 + q * 8;
        const f32x4 g0 = *(const f32x4*)(A->in[20] + (size_t)l * RW_W + cc), g1 = *(const f32x4*)(A->in[20] + (size_t)l * RW_W + cc + 4);
        const f32x4 b0 = *(const f32x4*)(A->in[21] + (size_t)l * RW_W + cc), b1 = *(const f32x4*)(A->in[21] + (size_t)l * RW_W + cc + 4);
        const f32x4 bv0 = *(const f32x4*)((const float*)(A->ws + WS_RBV) + tg * RW_W + cc), bv1 = *(const f32x4*)((const float*)(A->ws + WS_RBV) + tg * RW_W + cc + 4);
        const f32x4 ga0 = *(const f32x4*)((const float*)(A->ws + WS_RGATE) + tg * RW_W + cc), ga1 = *(const f32x4*)((const float*)(A->ws + WS_RGATE) + tg * RW_W + cc + 4);
        const f32x4 y0 = (d0 * rs * g0 + b0 + bv0) * ga0, y1 = (d1 * rs * g1 + b1 + bv1) * ga1;
        v4u o; o.x = pk2(y0.x, y0.y); o.y = pk2(y0.z, y0.w); o.z = pk2(y1.x, y1.y); o.w = pk2(y1.z, y1.w);
        *(v4u*)((bf16*)(A->ws + WS_Y) + tg * DM + 1280 + cc) = o; }
    __syncthreads();
}

constexpr size_t RWO_GQ = 84 * MiB, RWO_GK = 92 * MiB, RWO_GVT = 100 * MiB, RWO_GEM = 116 * MiB;
constexpr int GQS = 104, GTS = 72;
template <int NKS> __device__ __forceinline__ f32x4 tile_mm(const LAS bf16* Am, int sa, int arow0, const LAS bf16* Bm, int sb, int brow0, f32x4 acc, int lane) {
    const int r = lane & 15, kq = (lane >> 4) * 8;
#pragma unroll
    for (int ks = 0; ks < NKS; ++ks) {
        const bf16x8_t a = *(const LAS bf16x8_t*)(Am + (arow0 + r) * sa + ks * 32 + kq);
        const bf16x8_t b = *(const LAS bf16x8_t*)(Bm + (brow0 + r) * sb + ks * 32 + kq);
        acc = __builtin_amdgcn_mfma_f32_16x16x32_bf16(a, b, acc, 0, 0, 0);
    }
    return acc;
}

__device__ __forceinline__ int gsw(int row) { return ((row >> 2) ^ (row >> 5)) & 7; }
__device__ __forceinline__ f32x4 tile_mm_sw(const LAS bf16* Am, int arow0, const LAS bf16* Bm, int brow0, f32x4 acc, int lane) {
    const int r = lane & 15, cq = lane >> 4, fa = gsw(arow0 + r), fb = gsw(brow0 + r);
#pragma unroll
    for (int ks = 0; ks < 2; ++ks) {
        const bf16x8_t a = *(const LAS bf16x8_t*)(Am + (arow0 + r) * GTS + (((ks * 4 + cq) ^ fa) << 3));
        const bf16x8_t b = *(const LAS bf16x8_t*)(Bm + (brow0 + r) * GTS + (((ks * 4 + cq) ^ fb) << 3));
        acc = __builtin_amdgcn_mfma_f32_16x16x32_bf16(a, b, acc, 0, 0, 0);
    }
    return acc;
}
__device__ __forceinline__ void gla1_unit(ArgsP A, const Frame& F_in, int l, int unit) {
    Frame F = F_in; asm volatile("" : "+v"(F.tid)); F.lane = F.tid & 63;
    const int bh = unit >> 6, c = unit & 63, b = bh >> 2, h = bh & 3, t0 = b * SEQ + c * 64, tid = F.tid, lane = F.lane, w = F.wave;
    const float* proj = (const float*)(A->ws + WS_PROJ);
    LAS float* bcum = (LAS float*)F.lds;
    LAS float* ad = bcum + 6144;
    LAS float* up = ad + 1024;
    LAS bf16* KtT = (LAS bf16*)(F.lds + 34816);
    LAS bf16* VT = (LAS bf16*)(F.lds + 48640);
    f32x4 qq[3], kq[3], vq[6];
#pragma unroll
    for (int it = 0; it < 3; ++it) { const int i = tid + it * NTHR, tok = i / 24, d4 = i % 24; const float* rp = proj + (size_t)(t0 + tok) * INWP + h * 96 + d4 * 4;
        qq[it] = *(const f32x4*)(rp + C_GQ); kq[it] = *(const f32x4*)(rp + C_GK); }
#pragma unroll
    for (int it = 0; it < 6; ++it) { const int i = tid + it * NTHR, tok = i / 48, e4 = i % 48; vq[it] = *(const f32x4*)(proj + (size_t)(t0 + tok) * INWP + C_GV + h * 192 + e4 * 4); }
    gla_bcum(A, F, l, h, t0, bcum, ad, up);
    const float qs = 0.10206207261596575f;
    bf16* Qg = (bf16*)(A->ws + WS_RSC + RWO_GQ) + (size_t)unit * 6144; bf16* Kg = (bf16*)(A->ws + WS_RSC + RWO_GK) + (size_t)unit * 6144;
#pragma unroll
    for (int it = 0; it < 3; ++it) { const int i = tid + it * NTHR, tok = i / 24, d = (i % 24) * 4;
        const float qv[4] = {qq[it].x, qq[it].y, qq[it].z, qq[it].w}, kv[4] = {kq[it].x, kq[it].y, kq[it].z, kq[it].w}; float qo[4], ko[4];
#pragma unroll
        for (int e = 0; e < 4; ++e) { const float m = bcum[31 * 96 + d + e], bb = bcum[tok * 96 + d + e];
            qo[e] = qv[e] * qs * __expf(bb - m); ko[e] = kv[e] * __expf(m - bb); KtT[(d + e) * GTS + ((((tok >> 3) ^ gsw(d + e)) << 3) | (tok & 7))] = (bf16)f2bf(ko[e]); }
        v2u pq, pk; pq.x = pk2(qo[0], qo[1]); pq.y = pk2(qo[2], qo[3]); pk.x = pk2(ko[0], ko[1]); pk.y = pk2(ko[2], ko[3]);
        *(v2u*)(Qg + tok * 96 + d) = pq; *(v2u*)(Kg + tok * 96 + d) = pk; }
#pragma unroll
    for (int it = 0; it < 6; ++it) { const int i = tid + it * NTHR, tok = i / 48, e = (i % 48) * 4;
        const int ts = tok >> 3, tl = tok & 7;
        VT[(e + 0) * GTS + (((ts ^ gsw(e + 0)) << 3) | tl)] = (bf16)f2bf(vq[it].x); VT[(e + 1) * GTS + (((ts ^ gsw(e + 1)) << 3) | tl)] = (bf16)f2bf(vq[it].y);
        VT[(e + 2) * GTS + (((ts ^ gsw(e + 2)) << 3) | tl)] = (bf16)f2bf(vq[it].z); VT[(e + 3) * GTS + (((ts ^ gsw(e + 3)) << 3) | tl)] = (bf16)f2bf(vq[it].w); }
    if (tid < 96) { ((float*)(A->ws + WS_RSC + RWO_GEM))[(size_t)unit * 96 + tid] = __expf(bcum[31 * 96 + tid]);
        ((float*)(A->ws + WS_GDEC))[(size_t)unit * 96 + tid] = __expf(bcum[63 * 96 + tid]); }
    __syncthreads();
    { bf16* VTg = (bf16*)(A->ws + WS_RSC + RWO_GVT) + (size_t)unit * 12288;
#pragma unroll
        for (int it = 0; it < 3; ++it) { const int i = tid + it * NTHR, e = i >> 3, t8 = (i & 7) * 8; *(v4u*)(VTg + e * 64 + t8) = *(const LAS v4u*)(VT + e * GTS + ((((i & 7) ^ gsw(e))) << 3)); } }
    { const int li = lane & 15, lq = lane >> 4;
        float* KVg = (float*)(A->ws + WS_GKV) + (size_t)unit * 18432;
#pragma unroll
        for (int a = 0; a < 3; ++a) { const int dt = (w & 1) * 3 + a, d0 = dt * 16 + lq * 4;
            const float s0 = __expf(bcum[63 * 96 + d0] - bcum[31 * 96 + d0]), s1 = __expf(bcum[63 * 96 + d0 + 1] - bcum[31 * 96 + d0 + 1]),
                        s2 = __expf(bcum[63 * 96 + d0 + 2] - bcum[31 * 96 + d0 + 2]), s3 = __expf(bcum[63 * 96 + d0 + 3] - bcum[31 * 96 + d0 + 3]);
#pragma unroll
            for (int bb = 0; bb < 3; ++bb) { const int et = (w >> 1) * 3 + bb; const f32x4 z = {0.f, 0.f, 0.f, 0.f};
                f32x4 acc = tile_mm_sw(KtT, dt * 16, VT, et * 16, z, lane);
                acc.x *= s0; acc.y *= s1; acc.z *= s2; acc.w *= s3;
                *(f32x4*)(KVg + (size_t)(et * 16 + li) * 96 + d0) = acc; } } }
    __syncthreads();
}

__device__ __forceinline__ void gla3_unit(ArgsP A, const Frame& F_in, int l, int unit) {
    Frame F = F_in; asm volatile("" : "+v"(F.tid)); F.lane = F.tid & 63;
    const int bh = unit >> 6, c = unit & 63, b = bh >> 2, h = bh & 3, t0 = b * SEQ + c * 64, tid = F.tid, lane = F.lane, w = F.wave;
    const int li = lane & 15, lq = lane >> 4;
    const float* proj = (const float*)(A->ws + WS_PROJ);
    LAS bf16* Qs = (LAS bf16*)F.lds;
    LAS bf16* Ks = (LAS bf16*)(F.lds + 13312);
    LAS bf16* VT = (LAS bf16*)(F.lds + 26624);
    LAS bf16* ST = (LAS bf16*)(F.lds + 54272);
    LAS bf16* att = (LAS bf16*)(F.lds + 94208);
    LAS float* ssq = (LAS float*)(F.lds + 103424);
    LAS float* em = (LAS float*)(F.lds + 103936);
    LAS float* ob = (LAS float*)(F.lds + 26624);
    {
        const v4u* Qg = (const v4u*)((const bf16*)(A->ws + WS_RSC + RWO_GQ) + (size_t)unit * 6144); const v4u* Kg = (const v4u*)((const bf16*)(A->ws + WS_RSC + RWO_GK) + (size_t)unit * 6144);
        const v4u* VTg = (const v4u*)((const bf16*)(A->ws + WS_RSC + RWO_GVT) + (size_t)unit * 12288);
        const f32x4* GS = (const f32x4*)((const float*)(A->ws + WS_GS) + (size_t)unit * 18432);
        v4u q0 = Qg[tid], k0 = Kg[tid], q1 = {0u, 0u, 0u, 0u}, k1 = {0u, 0u, 0u, 0u};
        if (tid < 256) { q1 = Qg[512 + tid]; k1 = Kg[512 + tid]; }
        v4u vt[3]; f32x4 sg[9];
#pragma unroll
        for (int it = 0; it < 3; ++it) vt[it] = VTg[tid + it * NTHR];
#pragma unroll
        for (int it = 0; it < 9; ++it) sg[it] = GS[tid + it * NTHR];
        if (tid < 96) em[tid] = ((const float*)(A->ws + WS_RSC + RWO_GEM))[(size_t)unit * 96 + tid];
        { const int i = tid, t = i / 12, c8 = (i % 12) * 8; *(LAS v4u*)(Qs + t * GQS + c8) = q0; *(LAS v4u*)(Ks + t * GQS + c8) = k0; }
        if (tid < 256) { const int i = 512 + tid, t = i / 12, c8 = (i % 12) * 8; *(LAS v4u*)(Qs + t * GQS + c8) = q1; *(LAS v4u*)(Ks + t * GQS + c8) = k1; }
#pragma unroll
        for (int it = 0; it < 3; ++it) { const int i = tid + it * NTHR, e = i >> 3, t8 = (i & 7) * 8; *(LAS v4u*)(VT + e * GTS + t8) = vt[it]; }
        __syncthreads();
#pragma unroll
        for (int it = 0; it < 9; ++it) { const int i = tid + it * NTHR, e = i / 24, d = (i % 24) * 4; const f32x4 m4 = *(const LAS f32x4*)(em + d);
            v2u pk; pk.x = pk2(sg[it].x * m4.x, sg[it].y * m4.y); pk.y = pk2(sg[it].z * m4.z, sg[it].w * m4.w); *(LAS v2u*)(ST + e * GQS + d) = pk; }
    }
    __syncthreads();
#pragma unroll
    for (int a = 0; a < 2; ++a) { const int jt = w >> 1, it = (w & 1) * 2 + a; const f32x4 z = {0.f, 0.f, 0.f, 0.f};
        f32x4 acc = z;
        if (jt <= it) acc = tile_mm<3>(Ks, GQS, jt * 16, Qs, GQS, it * 16, z, lane);
        const int i = it * 16 + li, j0 = jt * 16 + lq * 4;
        acc.x = (j0 + 0 <= i) ? acc.x : 0.f; acc.y = (j0 + 1 <= i) ? acc.y : 0.f; acc.z = (j0 + 2 <= i) ? acc.z : 0.f; acc.w = (j0 + 3 <= i) ? acc.w : 0.f;
        v2u pk; pk.x = pk2(acc.x, acc.y); pk.y = pk2(acc.z, acc.w); *(LAS v2u*)(att + i * GTS + j0) = pk; }
    __syncthreads();
    f32x4 o[6];
    { const int it = w >> 1;
#pragma unroll
        for (int a = 0; a < 6; ++a) { const int et = (w & 1) * 6 + a; const f32x4 z = {0.f, 0.f, 0.f, 0.f};
            f32x4 acc = tile_mm<2>(att, GTS, it * 16, VT, GTS, et * 16, z, lane);
            o[a] = tile_mm<3>(Qs, GQS, it * 16, ST, GQS, et * 16, acc, lane); }
        float s0 = 0.f, s1 = 0.f, s2 = 0.f, s3 = 0.f;
#pragma unroll
        for (int a = 0; a < 6; ++a) { s0 += o[a].x * o[a].x; s1 += o[a].y * o[a].y; s2 += o[a].z * o[a].z; s3 += o[a].w * o[a].w; }
        s0 = row16_sum(s0); s1 = row16_sum(s1); s2 = row16_sum(s2); s3 = row16_sum(s3);
        if (li == 0) { const int r0 = it * 16 + lq * 4; ssq[(r0 + 0) * 2 + (w & 1)] = s0; ssq[(r0 + 1) * 2 + (w & 1)] = s1; ssq[(r0 + 2) * 2 + (w & 1)] = s2; ssq[(r0 + 3) * 2 + (w & 1)] = s3; }
    }
    __syncthreads();
    { const int it = w >> 1, r0 = it * 16 + lq * 4;
#pragma unroll
        for (int a = 0; a < 6; ++a) { const int e = ((w & 1) * 6 + a) * 16 + li;
            ob[(r0 + 0) * 196 + e] = o[a].x; ob[(r0 + 1) * 196 + e] = o[a].y; ob[(r0 + 2) * 196 + e] = o[a].z; ob[(r0 + 3) * 196 + e] = o[a].w; } }
    __syncthreads();
    { bf16* Y = (bf16*)(A->ws + WS_Y);
        f32x4 gv[6];
#pragma unroll
        for (int k = 0; k < 6; ++k) { const int i = tid + k * NTHR, t = i / 48, e = (i % 48) * 4; gv[k] = *(const f32x4*)(proj + (size_t)(t0 + t) * INWP + C_GG + h * 192 + e); }
#pragma unroll
        for (int k = 0; k < 6; ++k) { const int i = tid + k * NTHR, t = i / 48, e = (i % 48) * 4;
            const float rstd = rsqrtf((ssq[t * 2] + ssq[t * 2 + 1]) * (1.f / 192.f) + NORM_EPS);
            const f32x4 ov = *(const LAS f32x4*)(ob + t * 196 + e); const f32x4 ng = *(const f32x4*)(A->in[10] + (size_t)l * 768 + h * 192 + e);
            f32x4 y; y.x = ov.x * rstd * ng.x * gv[k].x * sigmoidf_(gv[k].x); y.y = ov.y * rstd * ng.y * gv[k].y * sigmoidf_(gv[k].y);
            y.z = ov.z * rstd * ng.z * gv[k].z * sigmoidf_(gv[k].z); y.w = ov.w * rstd * ng.w * gv[k].w * sigmoidf_(gv[k].w);
            v2u pk; pk.x = pk2(y.x, y.y); pk.y = pk2(y.z, y.w); *(v2u*)(Y + (size_t)(t0 + t) * DM + 512 + h * 192 + e) = pk; } }
    __syncthreads();
}

#define INS16(L, P, x, px) do { { const bool c_ = (x) > L[15]; L[15] = c_ ? (x) : L[15]; P[15] = c_ ? (px) : P[15]; } \
    _Pragma("unroll") for (int r_ = 14; r_ >= 0; --r_) { const bool c_ = L[r_ + 1] > L[r_]; const float tl_ = L[r_]; const int tp_ = P[r_]; \
        L[r_] = c_ ? L[r_ + 1] : tl_; L[r_ + 1] = c_ ? tl_ : L[r_ + 1]; P[r_] = c_ ? P[r_ + 1] : tp_; P[r_ + 1] = c_ ? tp_ : P[r_ + 1]; } } while (0)

__device__ __forceinline__ float gelu_as(float v) {
    const float av = fabsf(v), t = __builtin_amdgcn_rcpf(av * 0.2316418882f + 1.0f);
    float q = t * 0.5307027145f + (-0.7265760135f); q = q * t + 0.7107068705f; q = q * t + (-0.142248368f); q = q * t + 0.127414796f; q = q * t;
    const float e = __builtin_amdgcn_exp2f((v * v) * (-0.72134752044f));
    const float m = v * (q * e);
    return v < 0.f ? m : v - m;
}
__device__ __forceinline__ int row16_sum_i(int v) {
    v += __builtin_amdgcn_update_dpp(0, v, 0xB1, 0xF, 0xF, true); v += __builtin_amdgcn_update_dpp(0, v, 0x4E, 0xF, 0xF, true);
    v += __builtin_amdgcn_update_dpp(0, v, 0x141, 0xF, 0xF, true); v += __builtin_amdgcn_update_dpp(0, v, 0x140, 0xF, 0xF, true); return v;
}
#ifndef PEER_SL_SHIFT
#define PEER_SL_SHIFT 10
#endif
__device__ __forceinline__ void ph_peer4(ArgsP A, LAS unsigned char* lds_, int wv_, int l, const float* g2, const float* sh2, const float* ngain, const float* nsh, const float* nsc, const bool last, const bool dry = false) {
    const Frame F = make_frame(lds_, wv_);
    const int lane = F.lane, li = lane & 15, lq = lane >> 4;
    const float* SCO = (const float*)(A->ws + WS_PROJ);
    const unsigned char* U4 = A->ws + WS_U + (size_t)l * PEER_N * (DM / 2); const unsigned char* V4 = A->ws + WS_V + (size_t)l * PEER_N * (DM / 2);
    const float* US = (const float*)(A->ws + WS_US) + (size_t)l * PEER_N; const float* VS = (const float*)(A->ws + WS_VS) + (size_t)l * PEER_N;
    float* X = (float*)(A->ws + WS_X); bf16* H = (bf16*)(A->ws + WS_H); const float* ssr = (const float*)(A->ws + WS_SSP) + (size_t)l * NT * 32;
    LAS unsigned char* wl = F.lds + F.wave * 15104;
    LAS int* es = (LAS int*)wl; LAS float* gs = (LAS float*)(wl + 4096);
    LAS v4u* hl = (LAS v4u*)wl;
    LAS int* se = (LAS int*)(wl + 8448);
    LAS float* sg = (LAS float*)(wl + 10496);
    LAS int* st = (LAS int*)(wl + 12544);
    LAS float* dl = (LAS float*)(wl + 14592);
    LAS float* hsl = dl + 64; LAS int* hsi = (LAS int*)(dl + 68);
    for (int tb = F.gw * 4; tb < NT; tb += F.ngw * 4) {
        {
            int P2[16]; float gt[16];
            const int prob = tb * 16 + lane, half = lane & 1;
            const f32x4* s4 = (const f32x4*)(SCO + (size_t)prob * 128);
            float L[16]; int P[16];
#pragma unroll
            for (int r = 0; r < 16; ++r) { L[r] = -3.0e38f; P[r] = 0; }
            f32x4 nv[4];
#pragma unroll
            for (int i = 0; i < 4; ++i) nv[i] = s4[i];
#pragma unroll 1
            for (int q = 0; q < 8; ++q) {
                f32x4 v[4];
#pragma unroll
                for (int i = 0; i < 4; ++i) v[i] = nv[i];
                if (q < 7) {
#pragma unroll
                    for (int i = 0; i < 4; ++i) nv[i] = s4[4 * (q + 1) + i]; }
                _Pragma("unroll") for (int r = 0; r < 16; ++r) asm volatile("" : "+v"(L[r]), "+v"(P[r]));
#pragma unroll
                for (int i = 0; i < 4; ++i) { const int ib = 16 * q + 4 * i;
                    INS16(L, P, v[i].x, ib); INS16(L, P, v[i].y, ib + 1); INS16(L, P, v[i].z, ib + 2); INS16(L, P, v[i].w, ib + 3); }
            }
            float v1[16], v2[16]; int i1[16], i2[16];
#pragma unroll
            for (int r = 0; r < 16; ++r) { const float ol = dpp_xor1(L[r]); const int op = __builtin_amdgcn_update_dpp(0, P[r], 0xB1, 0xF, 0xF, true);
                v1[r] = half ? ol : L[r]; v2[r] = half ? L[r] : ol; i1[r] = half ? op : P[r]; i2[r] = half ? P[r] : op; }
            float L2[16];
#pragma unroll
            for (int r = 0; r < 16; ++r) { L2[r] = -3.0e38f; P2[r] = 0; }
#pragma unroll
            for (int a = 0; a < 16; ++a)
#pragma unroll
                for (int bq = 0; bq < 16; ++bq) if ((a + 1) * (bq + 1) <= 16) { const float cv = v1[a] + v2[bq]; const int ce = i1[a] * 128 + i2[bq]; INS16(L2, P2, cv, ce); }
            float sum = 0.f;
#pragma unroll
            for (int r = 0; r < 16; ++r) { gt[r] = __expf(L2[r] - L2[0]); sum += gt[r]; }
            const float inv = 1.f / sum;
#pragma unroll
            for (int r = 0; r < 16; ++r) { es[r * 64 + lane] = P2[r]; gs[r * 64 + lane] = gt[r] * inv; }
            asm volatile("s_waitcnt lgkmcnt(0)" ::: "memory");
        }
        {
            int ee[8]; float gg[8];
#pragma unroll
            for (int j = 0; j < 8; ++j) { const int x = j * 64 + lane, k = x >> 7, y = x & 127; ee[j] = es[(y & 15) * 64 + k * 16 + 2 * (y >> 4)]; gg[j] = gs[(y & 15) * 64 + k * 16 + 2 * (y >> 4)]; }
            int base = 0;
#pragma unroll
            for (int p = 0; p < 2; ++p) {
#pragma unroll 1
                for (int s = 0; s < (16384 >> PEER_SL_SHIFT); ++s) {
#pragma unroll
                    for (int jj = 0; jj < 4; ++jj) { const int j = p * 4 + jj; const bool in = (ee[j] >> PEER_SL_SHIFT) == s; const unsigned long long m = __builtin_amdgcn_ballot_w64(in);
                        if (in) { const int pos = base + (int)__builtin_amdgcn_mbcnt_hi((unsigned)(m >> 32), __builtin_amdgcn_mbcnt_lo((unsigned)m, 0u)); se[pos] = ee[j]; sg[pos] = gg[j]; st[pos] = j >> 1; }
                        base += __builtin_popcountll(m); }
                }
            }
        }
        asm volatile("s_waitcnt lgkmcnt(0)" ::: "memory");
#pragma unroll 1
        for (int k = 0; k < 4; ++k) {
            const int t = tb + k, b = t >> 12;
            float hf[32]; float mx = 0.f;
            const v4u* hp = (const v4u*)(H + (size_t)t * DM);
#pragma unroll
            for (int jj = 0; jj < 2; ++jj)
#pragma unroll
                for (int c = 0; c < 2; ++c) { const v4u hv = hp[(jj * 64 + lane) * 2 + c]; const int o = jj * 16 + c * 8;
                    hf[o + 0] = bflo(hv.x); hf[o + 1] = bfhi(hv.x); hf[o + 2] = bflo(hv.y); hf[o + 3] = bfhi(hv.y); hf[o + 4] = bflo(hv.z); hf[o + 5] = bfhi(hv.z); hf[o + 6] = bflo(hv.w); hf[o + 7] = bfhi(hv.w); }
            { const float rstd = rsqrtf(wave_sum(lane < 32 ? ssr[(size_t)t * 32 + lane] : 0.f) * (1.f / DM) + NORM_EPS);
#pragma unroll
                for (int jj = 0; jj < 2; ++jj)
#pragma unroll
                    for (int q = 0; q < 4; ++q) { const f32x4 s4 = *(const f32x4*)(sh2 + (size_t)b * MODW + (jj * 64 + lane) * 16 + 4 * q);
                        hf[jj * 16 + 4 * q] = hf[jj * 16 + 4 * q] * rstd + s4.x; hf[jj * 16 + 4 * q + 1] = hf[jj * 16 + 4 * q + 1] * rstd + s4.y;
                        hf[jj * 16 + 4 * q + 2] = hf[jj * 16 + 4 * q + 2] * rstd + s4.z; hf[jj * 16 + 4 * q + 3] = hf[jj * 16 + 4 * q + 3] * rstd + s4.w; } }
#pragma unroll
            for (int i = 0; i < 32; ++i) mx = fmaxf(mx, fabsf(hf[i]));
            mx = wave_max(mx);
            const float inv = mx > 0.f ? 127.f / mx : 0.f;
            if (lane == 0) hsl[k] = mx * (1.f / 127.f);
            int hsum = 0;
#pragma unroll
            for (int jj = 0; jj < 2; ++jj) { unsigned qd[4];
#pragma unroll
                for (int d = 0; d < 4; ++d) { const int o = jj * 16 + 4 * d; const int q0 = (int)rintf(hf[o] * inv), q1 = (int)rintf(hf[o + 1] * inv), q2 = (int)rintf(hf[o + 2] * inv), q3 = (int)rintf(hf[o + 3] * inv);
                    qd[d] = (unsigned)(q0 & 255) | ((unsigned)(q1 & 255) << 8) | ((unsigned)(q2 & 255) << 16) | ((unsigned)(q3 & 255) << 24); hsum += (q0 + q1) + (q2 + q3); }
                v4u q; q.x = qd[0]; q.y = qd[1]; q.z = qd[2]; q.w = qd[3]; hl[k * 132 + jj * 64 + lane] = q; }
            { hsum = row16_sum_i(hsum); const int hs_all = __builtin_amdgcn_readlane(hsum, 0) + __builtin_amdgcn_readlane(hsum, 16) + __builtin_amdgcn_readlane(hsum, 32) + __builtin_amdgcn_readlane(hsum, 48);
                if (lane == 0) hsi[k] = hs_all; }
        }
        asm volatile("s_waitcnt lgkmcnt(0)" ::: "memory");
        {
            v4i ub0[8], ub1[8];
            int lu = lane; asm volatile("" : "+v"(lu)); const int li = lu & 15, lq = lu >> 4;
            const LAS v4u* hb = hl + (li & 3) * 132 + lq;
#define ULOAD(buf, g_, sg_) do { const int my_e_ = se[(g_) * 16 + li]; const unsigned char* ub_ = U4 + (size_t)my_e_ * (DM / 2) + lq * 16 + (sg_) * 512; \
    _Pragma("unroll") for (int s8 = 0; s8 < 8; ++s8) buf[s8] = *(const v4i*)(ub_ + s8 * 64); } while (0)
#define UCONS(buf, sg_) do { _Pragma("unroll") for (int s8 = 0; s8 < 8; ++s8) { const int c_ = (sg_) * 8 + s8; \
        const v4i lo_ = buf[s8] & 0x0F0F0F0F, hi_ = (buf[s8] >> 4) & 0x0F0F0F0F; \
        const v4i hb0_ = *(const LAS v4i*)(hb + c_ * 4), hb1_ = *(const LAS v4i*)(hb + 64 + c_ * 4); \
        acc = __builtin_amdgcn_mfma_i32_16x16x64_i8(lo_, hb0_, acc, 0, 0, 0); acc = __builtin_amdgcn_mfma_i32_16x16x64_i8(hi_, hb1_, acc, 0, 0, 0); } } while (0)
            ULOAD(ub0, 0, 0);
#pragma unroll 1
            for (int g = 0; g < 32; ++g) {
                const int gn = g + 1 < 32 ? g + 1 : 31;
                v4i acc = {0, 0, 0, 0};
                ULOAD(ub1, g, 1);
                UCONS(ub0, 0); ULOAD(ub0, gn, 0);
                UCONS(ub1, 1);
                if (li < 4) { const int hc = 8 * hsi[li];
                    dl[(4 * lq + 0) * 4 + li] = (float)(acc.x - hc); dl[(4 * lq + 1) * 4 + li] = (float)(acc.y - hc); dl[(4 * lq + 2) * 4 + li] = (float)(acc.z - hc); dl[(4 * lq + 3) * 4 + li] = (float)(acc.w - hc); }
                if (lane < 16) { const int x = g * 16 + lane; const int e = se[x], tk = st[x];
                    sg[x] = sg[x] * VS[e] * gelu_as(dl[lane * 4 + tk] * (US[e] * hsl[tk])); }
            }
#undef ULOAD
#undef UCONS
        }
        asm volatile("s_waitcnt lgkmcnt(0)" ::: "memory");
#define PEER_EPILOGUE(kk_, kt_) do { const int t = tb + (kt_), b = t >> 12; float (&out_k)[32] = out[kk_]; \
            f32x4 xn[2][4]; float ss = 0.f; \
            const f32x4* xr = (const f32x4*)(X + (size_t)t * DM); const f32x4* gr = (const f32x4*)(g2 + (size_t)b * MODW); \
            _Pragma("unroll") \
            for (int jj = 0; jj < 2; ++jj) \
            _Pragma("unroll") \
                for (int q = 0; q < 4; ++q) { const int ix = (jj * 64 + lane) * 4 + q; const f32x4 xv = xr[ix], gv = gr[ix]; f32x4 o4; o4.x = out_k[jj * 16 + 4 * q]; o4.y = out_k[jj * 16 + 4 * q + 1]; o4.z = out_k[jj * 16 + 4 * q + 2]; o4.w = out_k[jj * 16 + 4 * q + 3]; \
                    const f32x4 y = xv + gv * o4; xn[jj][q] = y; ss += (y.x * y.x + y.y * y.y) + (y.z * y.z + y.w * y.w); } \
            const float rstd = rsqrtf(wave_sum(ss) * (1.f / DM) + NORM_EPS); \
            if (!last) { \
                f32x4* xw = (f32x4*)((dry ? (float*)(A->ws + WS_DUMMY) : X) + (size_t)t * DM); v4u* hw = (v4u*)((dry ? (bf16*)(A->ws + WS_DUMMY + 64 * MiB) : H) + (size_t)t * DM); \
            _Pragma("unroll") \
                for (int jj = 0; jj < 2; ++jj) { f32x4 y[4]; \
            _Pragma("unroll") \
                    for (int q = 0; q < 4; ++q) { const int ix = (jj * 64 + lane) * 4 + q; xw[ix] = xn[jj][q]; \
                        const f32x4 g = ((const f32x4*)ngain)[ix], s1 = ((const f32x4*)(nsc + (size_t)b * MODW))[ix], s0 = ((const f32x4*)(nsh + (size_t)b * MODW))[ix]; \
                        y[q] = xn[jj][q] * rstd * g * (s1 + 1.f) + s0; } \
                    v4u o; o.x = pk2(y[0].x, y[0].y); o.y = pk2(y[0].z, y[0].w); o.z = pk2(y[1].x, y[1].y); o.w = pk2(y[1].z, y[1].w); hw[(jj * 64 + lane) * 2] = o; \
                    o.x = pk2(y[2].x, y[2].y); o.y = pk2(y[2].z, y[2].w); o.z = pk2(y[3].x, y[3].y); o.w = pk2(y[3].z, y[3].w); hw[(jj * 64 + lane) * 2 + 1] = o; } \
            } else { \
                f32x4* ow = (f32x4*)((dry ? (float*)(A->ws + WS_DUMMY) : A->out) + (size_t)t * DM); \
            _Pragma("unroll") \
                for (int jj = 0; jj < 2; ++jj) \
            _Pragma("unroll") \
                    for (int q = 0; q < 4; ++q) { const int ix = (jj * 64 + lane) * 4 + q; ow[ix] = xn[jj][q] * rstd * ((const f32x4*)ngain)[ix]; } \
            } \
        } while (0)
#define VLOAD(buf, cfb, tkb, bi_) do { _Pragma("unroll") for (int i = 0; i < 4; ++i) { const int x_ = (bi_) * 4 + i; const int e_ = __builtin_amdgcn_readfirstlane(se[x_]); \
        cfb[i] = __builtin_bit_cast(float, __builtin_amdgcn_readfirstlane(__builtin_bit_cast(int, sg[x_]))); tkb[i] = __builtin_amdgcn_readfirstlane(st[x_]) & 1; \
        const v2u* vp_ = (const v2u*)(V4 + (size_t)e_ * (DM / 2)) + lane_v; buf[i][0] = vp_[0]; buf[i][1] = vp_[64]; } } while (0)
#define VACC(kk_, bv_, cv_) do { const f32x2 c2_ = {cv_, cv_}; \
        _Pragma("unroll") for (int jj = 0; jj < 2; ++jj) { const unsigned wd_[2] = {bv_[jj].x, bv_[jj].y}; \
            _Pragma("unroll") for (int d = 0; d < 2; ++d) { const int o_ = jj * 16 + 8 * d; \
                const f32x2 f0_ = __builtin_amdgcn_cvt_scalef32_pk_f32_fp4((int)wd_[d], 1.0f, 0), f1_ = __builtin_amdgcn_cvt_scalef32_pk_f32_fp4((int)wd_[d], 1.0f, 1), \
                            f2_ = __builtin_amdgcn_cvt_scalef32_pk_f32_fp4((int)wd_[d], 1.0f, 2), f3_ = __builtin_amdgcn_cvt_scalef32_pk_f32_fp4((int)wd_[d], 1.0f, 3); \
                f32x2 a0_ = {out[kk_][o_], out[kk_][o_ + 1]}, a1_ = {out[kk_][o_ + 2], out[kk_][o_ + 3]}, a2_ = {out[kk_][o_ + 4], out[kk_][o_ + 5]}, a3_ = {out[kk_][o_ + 6], out[kk_][o_ + 7]}; \
                a0_ = __builtin_elementwise_fma(c2_, f0_, a0_); a1_ = __builtin_elementwise_fma(c2_, f1_, a1_); a2_ = __builtin_elementwise_fma(c2_, f2_, a2_); a3_ = __builtin_elementwise_fma(c2_, f3_, a3_); \
                out[kk_][o_] = a0_.x; out[kk_][o_ + 1] = a0_.y; out[kk_][o_ + 2] = a1_.x; out[kk_][o_ + 3] = a1_.y; out[kk_][o_ + 4] = a2_.x; out[kk_][o_ + 5] = a2_.y; out[kk_][o_ + 6] = a3_.x; out[kk_][o_ + 7] = a3_.y; } } } while (0)
#define VCONS(buf, cfb, tkb) do { _Pragma("unroll") for (int i = 0; i < 4; ++i) { if (tkb[i] == 0) VACC(0, buf[i], cfb[i]); else VACC(1, buf[i], cfb[i]); } } while (0)
#pragma unroll 1
        for (int p = 0; p < 2; ++p) {
            int lane_v = F.lane; asm volatile("" : "+v"(lane_v));
            float out[2][32];
#pragma unroll
            for (int k = 0; k < 2; ++k)
#pragma unroll
                for (int i = 0; i < 32; ++i) out[k][i] = 0.f;
            {
                v2u vb0[4][2], vb1[4][2]; float c0[4], c1[4]; int t0v[4], t1v[4];
                const int bb = p * 64;
                VLOAD(vb0, c0, t0v, bb); VLOAD(vb1, c1, t1v, bb + 1);
#pragma unroll 1
                for (int bi = 0; bi < 64; bi += 2) {
                    const int b2 = bb + (bi + 2 < 64 ? bi + 2 : 62), b3 = bb + (bi + 3 < 64 ? bi + 3 : 63);
                    VCONS(vb0, c0, t0v); VLOAD(vb0, c0, t0v, b2);
                    VCONS(vb1, c1, t1v); VLOAD(vb1, c1, t1v, b3);
                }
            }
            PEER_EPILOGUE(0, 2 * p); PEER_EPILOGUE(1, 2 * p + 1);
        }
#undef VLOAD
#undef VACC
#undef VCONS
#undef PEER_EPILOGUE
    }
}

__device__ __forceinline__ void PH_norm1_l0(LAS unsigned char* lds, int wv) { ArgsP A = args_ptr(); const float* MOD = (const float*)(A->ws + WS_MOD);
    ph_norm(A->in[0], A->in[4], MOD + 0 * DM, MOD + 1 * DM, (bf16*)(A->ws + WS_H), lds, wv);
    { const Frame F = make_frame(lds, wv); float* B3 = (float*)(A->ws + WS_BIAS3);
        for (int o = F.gw; o < DEPTH * 2 * DM; o += F.ngw) { const int l = o >> 12, b = (o >> 11) & 1, n = o & 2047;
            const float* sh = MOD + (size_t)(l * 2 + b) * MODW + 3 * DM; const v4u* wr = (const v4u*)((const bf16*)(A->ws + WS_WQK) + ((size_t)l * DM + n) * DM);
            float s = 0.f;
#pragma unroll
            for (int j = 0; j < 4; ++j) { const v4u wv4 = wr[j * 64 + F.lane]; const f32x4 s0 = *(const f32x4*)(sh + (j * 64 + F.lane) * 8), s1 = *(const f32x4*)(sh + (j * 64 + F.lane) * 8 + 4);
                s += bflo(wv4.x) * s0.x + bfhi(wv4.x) * s0.y + bflo(wv4.y) * s0.z + bfhi(wv4.y) * s0.w + bflo(wv4.z) * s1.x + bfhi(wv4.z) * s1.y + bflo(wv4.w) * s1.z + bfhi(wv4.w) * s1.w; }
            s = wave_sum(s);
            if (F.lane == 0) B3[o] = s; } } }
__device__ __forceinline__ void PH_gemm1(LAS unsigned char* lds, int wv, int l_) { ArgsP A = args_ptr(); const int l = opaque_i(l_);
    pg8::Gemm g{(const bf16*)(A->ws + WS_H), (const bf16*)(A->ws + WS_WIN) + (size_t)l * INWP * DM, NT, INWP, DM}; pg8::StaticOrder S; S.init(NT, INWP, gridDim.x, blockIdx.x);
    EpiStoreF32 E{(float*)(A->ws + WS_PROJ), INWP, wv};
    pg8::gemm_phase<EpiStoreF32, pg8::StaticOrder, true, true>(lds, g, S, E, wv); }
__device__ __forceinline__ void PH_mixA(LAS unsigned char* lds, int wv, int l_) { ArgsP A = args_ptr(); const int l = opaque_i(l_);
    const Frame F = make_frame(lds, wv);
#ifdef PROBE_A
    for (int u = F.bid; u < 2048; u += F.G) {
        if (u < 1536) { if (PROBE_A == 1) rwkvA_unit(A, F, l, u); }
        else { if (PROBE_A == 2) gla1_unit(A, F, l, u - 1536); }
    }
#endif
    for (int u = F.bid; u < 2048; u += F.G) {
        if (u < 1536) rwkvA_unit(A, F, l, u);
        else gla1_unit(A, F, l, u - 1536);
    }
    if (l + 1 < DEPTH) quant_tables(A, l + 1, F.gw, F.ngw, F.lane);
}
__device__ __forceinline__ void PH_mixB(LAS unsigned char* lds, int wv, int l_) { ArgsP A = args_ptr(); const int l = opaque_i(l_);
    const Frame F = make_frame(lds, wv);
    if (F.G >= 192) {
        if (F.bid < 96) rwkvB_scan(A, F, F.bid);
        else { const int nb = F.G - 96, b2 = F.bid - 96;
            for (int u = b2; u < 288; u += nb) gla_scan_unit(A, F, u);
            for (int u = b2; u < 1024; u += nb) pool_unit(A, F, l, u); }
    } else {
        for (int u = F.bid; u < 288; u += F.G) gla_scan_unit(A, F, u);
        for (int u = F.bid; u < 1024; u += F.G) pool_unit(A, F, l, u);
        for (int u = F.bid; u < 96; u += F.G) rwkvB_scan(A, F, u);
    } }
__device__ __forceinline__ void PH_mixC(LAS unsigned char* lds, int wv, int l_) { ArgsP A = args_ptr(); const int l = opaque_i(l_);
    const Frame F = make_frame(lds, wv);
#ifdef PROBE_C
    for (int u = F.bid; u < 2048; u += F.G) { if (u < 512) { if (PROBE_C == 1) gla3_unit(A, F, l, u); } else { if (PROBE_C == 2) rwkvC_unit(A, F, l, u - 512); } }
#endif
    for (int u = F.bid; u < 2048; u += F.G) { if (u < 512) gla3_unit(A, F, l, u); else rwkvC_unit(A, F, l, u - 512); } }
__device__ __forceinline__ void PH_gemm2(LAS unsigned char* lds, int wv, int l_, bool dry = false) { ArgsP A = args_ptr(); const int l = opaque_i(l_);
    const float* modl = (const float*)(A->ws + WS_MOD) + (size_t)l * 2 * MODW; float* X = (float*)(A->ws + WS_X);
    pg8::Gemm g{(const bf16*)(A->ws + WS_Y), (const bf16*)(A->ws + WS_WOUT) + (size_t)l * DM * DM, NT, DM, DM}; pg8::StaticOrder S; S.init(NT, DM, gridDim.x, blockIdx.x);
    EpiResid E{(l == 0) ? A->in[0] : (const float*)X, dry ? (float*)(A->ws + WS_DUMMY) : X, modl + 2 * DM, wv, A->in[23] + (size_t)l * DM, modl + 4 * DM,
               dry ? (bf16*)(A->ws + WS_DUMMY + 64 * MiB) : (bf16*)(A->ws + WS_H), (dry ? (float*)(A->ws + WS_DUMMY) : (float*)(A->ws + WS_SSP) + (size_t)l * NT * 32)};
    pg8::gemm_phase<EpiResid, pg8::StaticOrder, true, true>(lds, g, S, E, wv); }
__device__ __forceinline__ void PH_norm2(LAS unsigned char* lds, int wv, int l_) { ArgsP A = args_ptr(); const int l = opaque_i(l_);
    const float* modl = (const float*)(A->ws + WS_MOD) + (size_t)l * 2 * MODW;
    ph_norm((const float*)(A->ws + WS_X), A->in[23] + (size_t)l * DM, modl + 3 * DM, modl + 4 * DM, (bf16*)(A->ws + WS_H), lds, wv); }
__device__ __forceinline__ void PH_gemm3(LAS unsigned char* lds, int wv, int l_) { ArgsP A = args_ptr(); const int l = opaque_i(l_);
    pg8::Gemm g{(const bf16*)(A->ws + WS_H), (const bf16*)(A->ws + WS_WQK) + (size_t)l * DM * DM, NT, DM, DM}; pg8::StaticOrder S; S.init(NT, DM, gridDim.x, blockIdx.x);
    LAS float* rs = (LAS float*)(lds + 131072);
    { pg8::Unit u0; const int t = tid_from(wv); if (S.next(0, u0) && t < 256) { const f32x4* sp = (const f32x4*)((const float*)(A->ws + WS_SSP) + ((size_t)l * NT + u0.pm * 256 + t) * 32); float s = 0.f;
#pragma unroll
            for (int j = 0; j < 8; ++j) { const f32x4 v = sp[j]; s += (v.x + v.y) + (v.z + v.w); }
            rs[t] = rsqrtf(s * (1.f / DM) + NORM_EPS); }
        __syncthreads(); }
    EpiScore E{(float*)(A->ws + WS_PROJ), DM, wv, rs, (const float*)(A->ws + WS_BIAS3) + (size_t)l * 2 * DM};
    pg8::gemm_phase<EpiScore, pg8::StaticOrder, true, true>(lds, g, S, E, wv); }
__device__ __forceinline__ void PH_peer(LAS unsigned char* lds, int wv, int l_, bool dry = false) { ArgsP A = args_ptr(); const int l = opaque_i(l_);
    const float* MOD = (const float*)(A->ws + WS_MOD); const float* modl = MOD + (size_t)l * 2 * MODW;
    const bool last = (l == DEPTH - 1);
    const float* nmod = MOD + (size_t)(last ? l : l + 1) * 2 * MODW;
    ph_peer4(A, lds, wv, l, modl + 5 * DM, modl + 3 * DM, last ? A->in[29] : A->in[4] + (size_t)(l + 1) * DM, nmod + 0 * DM, nmod + 1 * DM, last, dry); }

__global__ void __launch_bounds__(NTHR, 2) mega_fwd(Args args) {
    extern __shared__ __attribute__((aligned(16))) unsigned char lds_raw[];
    LAS unsigned char* lds = (LAS unsigned char*)lds_raw;
    volatile LAS unsigned* MISC = (volatile LAS unsigned*)(lds + MISC_OFF);
    const int wv = __builtin_amdgcn_readfirstlane((int)(threadIdx.x >> 6));
    if (wv == 0) MISC[lane_id_()] = 0u;
    __syncthreads();
    XcdBarrier bar = xcd_barrier_post((unsigned*)(args_ptr()->ws + WS_CTL) + CW_BAR, MISC + 8, wv);
#define GRID_BAR() do { XcdBarrier b_ = bar; b_.bar = (unsigned*)(args_ptr()->ws + WS_CTL) + CW_BAR; asm volatile("" : "+s"(b_.x), "+s"(b_.w)); xcd_barrier(b_); if (PROBE & 512) xcd_barrier(b_); } while (0)

    ph_prologue(args_ptr(), lds, wv);
    GRID_BAR();
#if PROBE & 1
    ph_prologue(args_ptr(), lds, wv); GRID_BAR();
#endif
    PH_norm1_l0(lds, wv);
    GRID_BAR();
    for (int l = 0; l < DEPTH; ++l) {
#if PROBE & 2
        PH_gemm1(lds, wv, l); GRID_BAR();
#endif
        PH_gemm1(lds, wv, l); GRID_BAR();
#if PROBE & 4
        PH_mixA(lds, wv, l);  GRID_BAR();
#endif
        PH_mixA(lds, wv, l);  GRID_BAR();
#if PROBE & 8
        PH_mixB(lds, wv, l);  GRID_BAR();
#endif
        PH_mixB(lds, wv, l);  GRID_BAR();
#if PROBE & 16
        PH_mixC(lds, wv, l);  GRID_BAR();
#endif
        PH_mixC(lds, wv, l);  GRID_BAR();
#if PROBE & 32
        PH_gemm2(lds, wv, l, true); GRID_BAR();
#endif
        PH_gemm2(lds, wv, l); GRID_BAR();
#if PROBE & 128
        PH_gemm3(lds, wv, l); GRID_BAR();
#endif
        PH_gemm3(lds, wv, l); GRID_BAR();
#if PROBE & 256
        PH_peer(lds, wv, l, true); GRID_BAR();
#endif
        PH_peer(lds, wv, l);
        if (l + 1 < DEPTH) GRID_BAR();
    }
}

extern "C" void kernel_launch(void* const* d_in, const int* in_sizes, int n_in, void* d_out, int out_size, void* d_ws, size_t ws_size, hipStream_t stream) {
    static int grid = 0;
    if (grid == 0) {
        if (n_in != 30 || out_size != NT * DM || ws_size < WS_END + 96 * MiB) { fprintf(stderr, "kernel_launch: unexpected shapes (n_in %d out %d ws %zu)\n", n_in, out_size, ws_size); grid = -1; return; }
        int dev = 0, cus = 0, per_cu = 0;
        if (hipGetDevice(&dev) != hipSuccess || hipDeviceGetAttribute(&cus, hipDeviceAttributeMultiprocessorCount, dev) != hipSuccess) { grid = -1; return; }
        if (hipFuncSetAttribute((const void*)mega_fwd, hipFuncAttributeMaxDynamicSharedMemorySize, LDS_BYTES) != hipSuccess) { fprintf(stderr, "kernel_launch: hipFuncSetAttribute failed\n"); grid = -1; return; }
        if (hipOccupancyMaxActiveBlocksPerMultiprocessor(&per_cu, (const void*)mega_fwd, NTHR, LDS_BYTES) != hipSuccess || per_cu < 1) { fprintf(stderr, "kernel_launch: occupancy query says %d\n", per_cu); (void)hipGetLastError(); per_cu = 1; }
        grid = cus;
    }
    if (grid < 0) return;
    (void)in_sizes;
    if (hipMemsetAsync((char*)d_ws + WS_CTL, 0, CTL_ZERO_BYTES, stream) != hipSuccess) return;
    Args a{};
    for (int i = 0; i < 30; ++i) a.in[i] = (const float*)d_in[i];
    a.out = (float*)d_out; a.ws = (unsigned char*)d_ws;
    hipLaunchKernelGGL(mega_fwd, dim3(grid), dim3(NTHR), LDS_BYTES, stream, a);
}
```

```cpp
#include <hip/hip_runtime.h>
#include <cstdio>
#include <cstdint>
__device__ __forceinline__ int lane_id_() { int r; asm volatile("v_mbcnt_lo_u32_b32 %0, -1, 0\n\tv_mbcnt_hi_u32_b32 %0, -1, %0" : "=v"(r)); return r; }
__device__ __forceinline__ int tid_from(int wave_s) { return wave_s * 64 + lane_id_(); }
namespace pg8 {
#define PG8_LAS __attribute__((address_space(3)))
typedef unsigned short bf16_t;
typedef short bf16x8 __attribute__((ext_vector_type(8)));
typedef float f32x4 __attribute__((ext_vector_type(4)));
typedef unsigned u32x4 __attribute__((ext_vector_type(4)));
constexpr int BM = 256, BK = 64, HALF = 128, HTB = HALF * BK * 2  , STAGE_BYTES = 8 * HTB, NXCD = 8, WGM = 8;

__host__ __device__ __forceinline__ int lds_byte(int r, int c) { const int st = (r >> 4) * 2 + (c >> 5), rr = r & 15, cc = c & 31, ob = rr * 64 + cc * 2; return st * 1024 + (ob ^ (((ob >> 9) & 1) << 5)); }
__host__ __device__ __forceinline__ void stage_rc(int b, int& R, int& C) { const int st = b / 1024, sb = b % 1024, swz = sb ^ (((sb >> 9) & 1) << 5); R = (st >> 1) * 16 + swz / 64; C = (st & 1) * 32 + (swz % 64) / 2; }
__host__ __device__ __forceinline__ int perm32(int rho) { const int n = rho >> 4, i = rho & 15; return 8 * (i >> 2) + 4 * n + (i & 3); }

struct Unit { int pm, pn; };
struct Gemm { const bf16_t* A; const bf16_t* Bt; int M, N, K; };

struct StaticOrder {
    int nM, nN, nwg, G, c;
    __host__ __device__ void init(int M, int N, int G_, int c_) { nM = M / BM; nN = N / BM; nwg = nM * nN; G = G_; c = c_; }
    __host__ __device__ bool next(int i, Unit& u) const {
        const long L = (long)i * G + c; if (L >= nwg) return false;
        int wgid = (int)L; { const int q = nwg / NXCD, r = nwg % NXCD, xcd = wgid % NXCD, off = wgid / NXCD; wgid = (xcd < r ? xcd * (q + 1) : r * (q + 1) + (xcd - r) * q) + off; }
        const int nig = WGM * nN, gid = wgid / nig, fm = gid * WGM, gsz = (nM - fm) < WGM ? (nM - fm) : WGM;
        u.pm = fm + ((wgid % nig) % gsz); u.pn = (wgid % nig) / gsz; return true;
    }
    __device__ __forceinline__ void a_ready(const Unit&) const {}
    __device__ __forceinline__ void done(const Unit&) const {}
};

template <class Epi, class Sched, bool ALIGN_EPI = false, bool SP2 = false>
__device__ __forceinline__ void gemm_phase(PG8_LAS unsigned char* lds, const Gemm g, const Sched& S, const Epi& E, int wave_s) {
    int tid_o = tid_from(wave_s); asm volatile("" : "+v"(tid_o));
    const int tid = tid_o, wid = __builtin_amdgcn_readfirstlane(tid >> 6), lane = tid & 63, wr = wid >> 2, wc = wid & 3, fr = lane & 15, fq = lane >> 4;
    const int K = g.K, nt = K / BK;
    unsigned voffA[2], voffB[2];
#pragma unroll
    for (int i = 0; i < 2; ++i) { int R, C; stage_rc(tid * 16 + i * 8192, R, C); const int Rb = Epi::PERM ? ((R & ~31) + perm32(R & 31)) : R;
        voffA[i] = (unsigned)(R * K + C) * 2u; voffB[i] = (unsigned)(Rb * K + C) * 2u; }
    const size_t kstep = (size_t)(BK * 2);
    const size_t hstep = (size_t)HALF * K * 2;
    const size_t tstep = 2 * hstep;
    const unsigned ldsw = (unsigned)wid * 1024u;
    const int aoff = lds_byte(wr * 64 + fr, fq * 8), boff = lds_byte(wc * 32 + fr, fq * 8);
#define PG8_SA(b, h) (((b) * 2 + (h)) * HTB)
#define PG8_SB(b, h) ((4 + (b) * 2 + (h)) * HTB)
#define PG8_STAGE(bufoff, gbase, voff) do { _Pragma("unroll") for (int _i = 0; _i < 2; ++_i) \
        __builtin_amdgcn_global_load_lds((const unsigned*)((const char*)(gbase) + (voff)[_i]), (PG8_LAS unsigned*)(lds + (bufoff) + ldsw + _i * 8192), 16, 0, 0); } while (0)
#define PG8_LDA(dst, b, h) do { _Pragma("unroll") for (int m = 0; m < 4; ++m) _Pragma("unroll") for (int k = 0; k < 2; ++k) dst[m][k] = *(const PG8_LAS bf16x8*)(lds + PG8_SA(b, h) + aoff + m * 2048 + k * 1024); } while (0)
#define PG8_LDB(dst, b, h) do { _Pragma("unroll") for (int n = 0; n < 2; ++n) _Pragma("unroll") for (int k = 0; k < 2; ++k) dst[n][k] = *(const PG8_LAS bf16x8*)(lds + PG8_SB(b, h) + boff + n * 2048 + k * 1024); } while (0)
#define PG8_MMA(ai, bj, At, Bt) do { __builtin_amdgcn_s_setprio(1); _Pragma("unroll") for (int m = 0; m < 4; ++m) _Pragma("unroll") for (int n = 0; n < 2; ++n) _Pragma("unroll") for (int k = 0; k < 2; ++k) \
        acc[ai][bj][m][n] = __builtin_amdgcn_mfma_f32_16x16x32_bf16(Bt[n][k], At[m][k], acc[ai][bj][m][n], 0, 0, 0); __builtin_amdgcn_s_setprio(0); } while (0)
#define PG8_WAIT_V(n) asm volatile("s_waitcnt vmcnt(" #n ")" ::: "memory")
#define PG8_WAIT_L(n) asm volatile("s_waitcnt lgkmcnt(" #n ")" ::: "memory")
#define PG8_BAR __builtin_amdgcn_s_barrier()
#define PG8_SCHED __builtin_amdgcn_sched_barrier(0)
    Unit cur, nxt; int ui = 0;
    if (!S.next(0, cur)) return;
    f32x4 acc[2][2][4][2];
#pragma unroll
    for (int a = 0; a < 2; ++a)
#pragma unroll
        for (int b = 0; b < 2; ++b)
#pragma unroll
            for (int m = 0; m < 4; ++m)
#pragma unroll
                for (int n = 0; n < 2; ++n) acc[a][b][m][n] = (f32x4){0.f, 0.f, 0.f, 0.f};
    bf16x8 At[4][2], B0[2][2], B1[2][2];
    const char* cA = (const char*)g.A + (size_t)cur.pm * tstep; const char* cB = (const char*)g.Bt + (size_t)cur.pn * tstep;
    S.a_ready(cur);
    if constexpr (SP2) {
        PG8_STAGE(PG8_SB(0, 0), cB, voffB); PG8_STAGE(PG8_SB(0, 1), cB + hstep, voffB); PG8_STAGE(PG8_SA(0, 0), cA, voffA); PG8_STAGE(PG8_SA(0, 1), cA + hstep, voffA);
        if (wr == 1) PG8_BAR;
        PG8_WAIT_V(2); PG8_BAR;
        PG8_STAGE(PG8_SB(1, 0), cB + kstep, voffB); PG8_STAGE(PG8_SA(1, 0), cA + kstep, voffA); PG8_STAGE(PG8_SB(1, 1), cB + hstep + kstep, voffB);
        PG8_WAIT_V(6); PG8_BAR;
    } else {
        PG8_STAGE(PG8_SB(0, 0), cB, voffB); PG8_STAGE(PG8_SA(0, 0), cA, voffA); PG8_STAGE(PG8_SB(0, 1), cB + hstep, voffB); PG8_STAGE(PG8_SA(0, 1), cA + hstep, voffA);
        if (wr == 1) PG8_BAR;
        PG8_WAIT_V(4); PG8_BAR;
        PG8_STAGE(PG8_SB(1, 0), cB + kstep, voffB); PG8_STAGE(PG8_SA(1, 0), cA + kstep, voffA); PG8_STAGE(PG8_SB(1, 1), cB + hstep + kstep, voffB);
        PG8_WAIT_V(6); PG8_BAR;
    }
    for (;;) {
        const bool has_next = S.next(ui + 1, nxt);
        const char* nA = has_next ? (const char*)g.A + (size_t)nxt.pm * tstep : cA; const char* nB = has_next ? (const char*)g.Bt + (size_t)nxt.pn * tstep : cB;
        for (int t = 0; t < nt; t += 2) {
            const bool last = (t == nt - 2);
            const char* a1 = cA + (size_t)(t + 1) * kstep;
            const char* a2 = last ? nA : cA + (size_t)(t + 2) * kstep; const char* b2 = last ? nB : cB + (size_t)(t + 2) * kstep;
            const char* a3 = a2 + kstep; const char* b3 = b2 + kstep;
            if (last && has_next) S.a_ready(nxt);
            if constexpr (SP2) {
            PG8_LDB(B0, 0, 0); PG8_LDB(B1, 0, 1); PG8_SCHED; PG8_LDA(At, 0, 0); PG8_STAGE(PG8_SA(1, 1), a1 + hstep, voffA);
            PG8_WAIT_V(8); PG8_WAIT_L(0); PG8_BAR; PG8_MMA(0, 0, At, B0); PG8_MMA(0, 1, At, B1); PG8_BAR; PG8_SCHED;
            PG8_LDA(At, 0, 1); PG8_STAGE(PG8_SB(0, 0), b2, voffB); PG8_STAGE(PG8_SB(0, 1), b2 + hstep, voffB); PG8_STAGE(PG8_SA(0, 0), a2, voffA);
            PG8_WAIT_V(8); PG8_WAIT_L(0); PG8_BAR; PG8_MMA(1, 0, At, B0); PG8_MMA(1, 1, At, B1); PG8_BAR; PG8_SCHED;
            PG8_LDB(B0, 1, 0); PG8_LDB(B1, 1, 1); PG8_SCHED; PG8_LDA(At, 1, 0); PG8_STAGE(PG8_SA(0, 1), a2 + hstep, voffA);
            PG8_WAIT_V(8); PG8_WAIT_L(0); PG8_BAR; PG8_MMA(0, 0, At, B0); PG8_MMA(0, 1, At, B1); PG8_BAR; PG8_SCHED;
            PG8_LDA(At, 1, 1); PG8_STAGE(PG8_SB(1, 0), b3, voffB); PG8_STAGE(PG8_SB(1, 1), b3 + hstep, voffB); PG8_STAGE(PG8_SA(1, 0), a3, voffA);
            PG8_WAIT_V(8); PG8_WAIT_L(0); PG8_BAR; PG8_MMA(1, 0, At, B0); PG8_MMA(1, 1, At, B1); PG8_BAR; PG8_SCHED;
            } else {
            PG8_LDB(B0, 0, 0); PG8_SCHED; PG8_LDA(At, 0, 0); PG8_STAGE(PG8_SA(1, 1), a1 + hstep, voffA);
            PG8_WAIT_L(8); PG8_BAR; PG8_WAIT_L(0); PG8_MMA(0, 0, At, B0); PG8_BAR; PG8_SCHED;
            PG8_LDB(B1, 0, 1); PG8_STAGE(PG8_SB(0, 0), b2, voffB);
            PG8_BAR; PG8_WAIT_L(0); PG8_MMA(0, 1, At, B1); PG8_BAR;
            PG8_LDA(At, 0, 1); PG8_STAGE(PG8_SA(0, 0), a2, voffA);
            PG8_BAR; PG8_WAIT_L(0); PG8_MMA(1, 0, At, B0); PG8_BAR; PG8_SCHED;
            PG8_STAGE(PG8_SB(0, 1), b2 + hstep, voffB);
            PG8_WAIT_V(6); PG8_BAR; PG8_MMA(1, 1, At, B1); PG8_BAR;
            PG8_LDB(B0, 1, 0); PG8_SCHED; PG8_LDA(At, 1, 0); PG8_STAGE(PG8_SA(0, 1), a2 + hstep, voffA);
            PG8_WAIT_L(8); PG8_BAR; PG8_WAIT_L(0); PG8_MMA(0, 0, At, B0); PG8_BAR; PG8_SCHED;
            PG8_LDB(B1, 1, 1); PG8_STAGE(PG8_SB(1, 0), b3, voffB);
            PG8_BAR; PG8_WAIT_L(0); PG8_MMA(0, 1, At, B1); PG8_BAR;
            PG8_LDA(At, 1, 1); PG8_STAGE(PG8_SA(1, 0), a3, voffA);
            PG8_BAR; PG8_WAIT_L(0); PG8_MMA(1, 0, At, B0); PG8_BAR; PG8_SCHED;
            PG8_STAGE(PG8_SB(1, 1), b3 + hstep, voffB);
            PG8_WAIT_V(6); PG8_BAR; PG8_MMA(1, 1, At, B1); PG8_BAR;
            }
        }
        if constexpr (ALIGN_EPI) { if (wr == 0) PG8_BAR; }
        if constexpr (!Epi::AFTER_DRAIN) { E(acc, cur, wr, wc, fr, fq); S.done(cur); }
        if (!has_next) break;
#pragma unroll
        for (int a = 0; a < 2; ++a)
#pragma unroll
            for (int b = 0; b < 2; ++b)
#pragma unroll
                for (int m = 0; m < 4; ++m)
#pragma unroll
                    for (int n = 0; n < 2; ++n) acc[a][b][m][n] = (f32x4){0.f, 0.f, 0.f, 0.f};
        cur = nxt; cA = nA; cB = nB; ++ui;
        if constexpr (ALIGN_EPI) { if (wr == 1) PG8_BAR; }
    }
    PG8_WAIT_V(0);
    if constexpr (!ALIGN_EPI) { if (wr == 0) PG8_BAR; }
    PG8_BAR;
    if constexpr (Epi::AFTER_DRAIN) { E.fused(acc, cur, wr, wc, fr, fq, lds, wid, lane); S.done(cur); }
#undef PG8_SA
#undef PG8_SB
#undef PG8_STAGE
#undef PG8_LDA
#undef PG8_LDB
#undef PG8_MMA
#undef PG8_WAIT_V
#undef PG8_WAIT_L
#undef PG8_BAR
#undef PG8_SCHED
}
}
#define GAS __attribute__((address_space(1)))
#define LAS __attribute__((address_space(3)))
#define XB_TMO      128
#define XB_XCNT(j)  (256  + 64 * (j))
#define XB_XSUB(j)  (1280 + 64 * (j))
#define XB_XGEN(j)  (2304 + 64 * (j))
#define XB_TOP      3328
#define XB_TOPGEN   3392
#define XCD_BAR_WORDS 3456
#define XB_SPIN_CAP (1u << 18)

__device__ __forceinline__ unsigned xb_ld(unsigned* p)              { return __hip_atomic_load(p, __ATOMIC_RELAXED, __HIP_MEMORY_SCOPE_AGENT); }
__device__ __forceinline__ unsigned xb_add(unsigned* p, unsigned v) { return __hip_atomic_fetch_add(p, v, __ATOMIC_RELAXED, __HIP_MEMORY_SCOPE_AGENT); }
__device__ __forceinline__ unsigned xb_xcc_id() { return (unsigned)__builtin_amdgcn_s_getreg((3 << 11) | 20) & 0xFu; }
#define XB_SPIN(cond, bar) do { unsigned _sp = 0; while (cond) { __builtin_amdgcn_s_sleep(1); \
    if ((++_sp & 255u) == 0u) { if (xb_ld(&(bar)[XB_TMO])) break; if (_sp > XB_SPIN_CAP) { atomicAdd(&(bar)[XB_TMO], 1u); break; } } } } while (0)

struct XcdBarrier {
    unsigned* bar; unsigned x; int w;
    volatile LAS unsigned* st;
};

__device__ __forceinline__ XcdBarrier xcd_barrier_post(unsigned* bar, volatile LAS unsigned* st, int wave_s) {
    XcdBarrier b; b.bar = bar; b.x = xb_xcc_id(); b.st = st; b.w = wave_s;
    if (tid_from(wave_s) == 0) (void)xb_add(&bar[XB_XCNT(b.x)], 1u);
    return b;
}
__device__ __forceinline__ void xcd_barrier_complete(unsigned* bar, unsigned x, unsigned& nloc, unsigned& nx) {
    const unsigned G = gridDim.x * gridDim.y * gridDim.z;
    unsigned sum, cnt, mine, sp = 0u;
    for (;;) {
        sum = 0u; cnt = 0u; mine = 0u;
#pragma unroll
        for (unsigned j = 0; j < 16; ++j) { const unsigned c = xb_ld(&bar[XB_XCNT(j)]); sum += c; cnt += (c > 0u) ? 1u : 0u; mine = (j == x) ? c : mine; }
        if (sum == G) break;
        __builtin_amdgcn_s_sleep(1);
        if ((++sp & 255u) == 0u) { if (xb_ld(&bar[XB_TMO])) break; if (sp > XB_SPIN_CAP) { atomicAdd(&bar[XB_TMO], 1u); break; } }
    }
    nloc = mine > 0u ? mine : 1u; nx = cnt > 0u ? cnt : 1u;
}

__device__ __forceinline__ void xcd_barrier(const XcdBarrier& b) {
    asm volatile("s_waitcnt vmcnt(0)" ::: "memory");
    __syncthreads();
    if (tid_from(b.w) == 0) {
        unsigned* bar = b.bar;
        __builtin_amdgcn_s_waitcnt(0);
        unsigned nloc = b.st[0], nx = b.st[1];
        if (nloc == 0u) { xcd_barrier_complete(bar, b.x, nloc, nx); b.st[0] = nloc; b.st[1] = nx; }
        const unsigned old = xb_add(&bar[XB_XSUB(b.x)], 1u);
        const unsigned gen = old / nloc;
        if (old + 1u == (gen + 1u) * nloc) {
            __builtin_amdgcn_fence(__ATOMIC_RELEASE, "agent");
            asm volatile("s_waitcnt vmcnt(0)" ::: "memory");
            const unsigned og = xb_add(&bar[XB_TOP], 1u);
            const unsigned tg = og / nx;
            if (og + 1u == (tg + 1u) * nx) xb_add(&bar[XB_TOPGEN], 1u);
            else XB_SPIN(xb_ld(&bar[XB_TOPGEN]) == tg, bar);
            __builtin_amdgcn_fence(__ATOMIC_ACQUIRE, "agent");
            xb_add(&bar[XB_XGEN(b.x)], 1u);
            asm volatile("s_waitcnt vmcnt(0)" ::: "memory");
        } else {
            XB_SPIN(xb_ld(&bar[XB_XGEN(b.x)]) == gen, bar);
            __builtin_amdgcn_fence(__ATOMIC_ACQUIRE, "agent");
            asm volatile("s_waitcnt vmcnt(0)" ::: "memory");
        }
    }
    __syncthreads();
}

constexpr int NWAVES = 8, NTHR = 512;
constexpr int DM = 2048, NB = 2, SEQ = 4096, NT = NB * SEQ, DEPTH = 4;
constexpr int INW = 5392, INWP = 5632;
constexpr int C_POOL = 0, C_GQ = 512, C_GK = 896, C_GV = 1280, C_GG = 2048, C_GA = 2816, C_RW = 2832;
constexpr int RW_IN = 2560, RW_W = 768, RW_H = 12;
constexpr int GLA_H = 4, GLA_DK = 96, GLA_DV = 192, GLA_NCH = 64;
constexpr int PEER_N = 16384;
constexpr float NORM_EPS = 1e-6f;
constexpr int MODW = 6 * DM;

constexpr size_t MiB = 1u << 20;
constexpr size_t WS_CTL = 0, CTL_ZERO_BYTES = 1 * MiB;
constexpr size_t WS_MOD = 1 * MiB;
constexpr size_t WS_WIN = 2 * MiB;
constexpr size_t WS_WOUT = 90 * MiB;
constexpr size_t WS_WQK = 122 * MiB;
constexpr size_t WS_U = 154 * MiB;
constexpr size_t WS_V = 410 * MiB;
constexpr size_t WS_US = 540 * MiB;
constexpr size_t WS_VS = 541 * MiB;
constexpr size_t WS_POOLT = 545 * MiB;
constexpr size_t WS_LORAT = 542 * MiB;
constexpr size_t WS_X = 666 * MiB;
constexpr size_t WS_H = 730 * MiB;
constexpr size_t WS_Y = 762 * MiB;
constexpr size_t WS_PROJ = 794 * MiB;
constexpr size_t WS_GKV = 970 * MiB;
constexpr size_t WS_GS = 1006 * MiB;
constexpr size_t WS_GDEC = 1042 * MiB;
constexpr size_t WS_RSC = 1043 * MiB;
constexpr size_t WS_RO = 1187 * MiB;
constexpr size_t WS_RGATE = 1211 * MiB;
constexpr size_t WS_RBV = 1235 * MiB;
constexpr size_t WS_EIDX = 1259 * MiB;
constexpr size_t WS_EGATE = 1263 * MiB;
constexpr size_t WS_END = 1267 * MiB;
constexpr size_t WS_DUMMY = 1267 * MiB;
#ifndef PROBE
#define PROBE 0
#endif
constexpr int CW_BAR = 4096;
constexpr size_t WS_SSP = 547 * MiB;
constexpr size_t WS_BIAS3 = 546 * MiB;

constexpr int LDS_BYTES = 147456;
constexpr int MISC_OFF = 147456 - 256;

typedef unsigned short bf16;
typedef unsigned v4u __attribute__((ext_vector_type(4)));
typedef unsigned v2u __attribute__((ext_vector_type(2)));
typedef float f32x4 __attribute__((ext_vector_type(4)));
typedef float f32x2 __attribute__((ext_vector_type(2)));
typedef __bf16 bf16x2_t __attribute__((ext_vector_type(2)));
typedef int v4i __attribute__((ext_vector_type(4)));

__device__ __forceinline__ unsigned pk2(float lo, float hi) { const f32x2 f = {lo, hi}; return __builtin_bit_cast(unsigned, __builtin_convertvector(f, bf16x2_t)); }
__device__ __forceinline__ unsigned f2bf(float f) { return pk2(f, f) & 0xffffu; }
__device__ __forceinline__ float bflo(unsigned u) { return __builtin_bit_cast(float, u << 16); }
__device__ __forceinline__ float bfhi(unsigned u) { return __builtin_bit_cast(float, u & 0xffff0000u); }
__device__ __forceinline__ float dpp_xor1(float v) { return __builtin_bit_cast(float, __builtin_amdgcn_update_dpp(0, __builtin_bit_cast(int, v), 0xB1, 0xF, 0xF, true)); }
__device__ __forceinline__ float dpp_xor2(float v) { return __builtin_bit_cast(float, __builtin_amdgcn_update_dpp(0, __builtin_bit_cast(int, v), 0x4E, 0xF, 0xF, true)); }
__device__ __forceinline__ float dpp_hmir(float v) { return __builtin_bit_cast(float, __builtin_amdgcn_update_dpp(0, __builtin_bit_cast(int, v), 0x141, 0xF, 0xF, true)); }
__device__ __forceinline__ float dpp_rmir(float v) { return __builtin_bit_cast(float, __builtin_amdgcn_update_dpp(0, __builtin_bit_cast(int, v), 0x140, 0xF, 0xF, true)); }
__device__ __forceinline__ float rl_f(float v, int l) { return __builtin_bit_cast(float, __builtin_amdgcn_readlane(__builtin_bit_cast(int, v), l)); }
__device__ __forceinline__ float row16_sum(float v) { v += dpp_xor1(v); v += dpp_xor2(v); v += dpp_hmir(v); v += dpp_rmir(v); return v; }
__device__ __forceinline__ float row16_max(float v) { v = fmaxf(v, dpp_xor1(v)); v = fmaxf(v, dpp_xor2(v)); v = fmaxf(v, dpp_hmir(v)); v = fmaxf(v, dpp_rmir(v)); return v; }
__device__ __forceinline__ float wave_sum(float v) { v = row16_sum(v); return (rl_f(v, 0) + rl_f(v, 16)) + (rl_f(v, 32) + rl_f(v, 48)); }
__device__ __forceinline__ float wave_max(float v) { v = row16_max(v); return fmaxf(fmaxf(rl_f(v, 0), rl_f(v, 16)), fmaxf(rl_f(v, 32), rl_f(v, 48))); }
__device__ __forceinline__ float half32_sum(float v, int lane) { v = row16_sum(v); const float lo = rl_f(v, 0) + rl_f(v, 16), hi = rl_f(v, 32) + rl_f(v, 48); return lane < 32 ? lo : hi; }
__device__ __forceinline__ float red8(float v) { v += dpp_xor1(v); v += dpp_xor2(v); v += dpp_hmir(v); return v; }
__device__ __forceinline__ float sigmoidf_(float x) { return __builtin_amdgcn_rcpf(1.f + __builtin_amdgcn_exp2f(-1.4426950408889634f * x)); }
__device__ __forceinline__ float softplusf_(float x) { return fmaxf(x, 0.f) + 0.6931471805599453f * __builtin_amdgcn_logf(1.f + __builtin_amdgcn_exp2f(-1.4426950408889634f * fabsf(x))); }

struct Args { const float* in[30]; float* out; unsigned char* ws; };
typedef const __attribute__((address_space(4))) Args* ArgsP;
__device__ __forceinline__ ArgsP args_ptr() { ArgsP p = (ArgsP)__builtin_amdgcn_kernarg_segment_ptr(); asm volatile("" : "+s"(p)); return p; }
__device__ __forceinline__ int opaque_i(int v) { asm volatile("" : "+s"(v)); return v; }

struct Frame {
    LAS unsigned char* lds;
    int tid, lane, wave, G, bid, gw, ngw;
};
__device__ __forceinline__ Frame make_frame(LAS unsigned char* lds, int wave_s) {
    asm volatile("" : "+s"(wave_s)); Frame F; F.lds = lds; int t = tid_from(wave_s); asm volatile("" : "+v"(t));
    F.tid = t; F.lane = t & 63; F.wave = __builtin_amdgcn_readfirstlane(t >> 6); int g_ = gridDim.x, b_ = blockIdx.x; asm volatile("" : "+s"(g_), "+s"(b_)); F.G = g_; F.bid = b_; F.gw = F.bid * NWAVES + F.wave; F.ngw = F.G * NWAVES; return F;
}

struct EpiStoreF32 {
    static constexpr bool PERM = false, AFTER_DRAIN = false;
    float* C; int ldc; int ws_;
    __device__ __forceinline__ void operator()(const pg8::f32x4 (&acc)[2][2][4][2], const pg8::Unit& u, int, int, int, int) const {
        int tz = tid_from(ws_); asm volatile("" : "+v"(tz)); const int wid = tz >> 6, lane = tz & 63, wr = wid >> 2, wc = wid & 3, fr = lane & 15, fq = lane >> 4;
        const int row0 = u.pm * 256 + wr * 64 + fr, col0 = u.pn * 256 + wc * 32 + 4 * fq;
#pragma unroll
        for (int ai = 0; ai < 2; ++ai)
#pragma unroll
            for (int m = 0; m < 4; ++m) { float* rowp = C + (size_t)(row0 + ai * 128 + m * 16) * ldc + col0;
#pragma unroll
                for (int bj = 0; bj < 2; ++bj)
#pragma unroll
                    for (int n = 0; n < 2; ++n) *(pg8::f32x4*)(rowp + bj * 128 + n * 16) = acc[ai][bj][m][n]; }
    }
};
struct EpiResid {
    static constexpr bool PERM = false, AFTER_DRAIN = false;
    const float* xsrc; float* xdst; const float* gate; int ws_; const float* gain2; const float* sc2; bf16* hdst; float* ss;
    __device__ __forceinline__ void operator()(const pg8::f32x4 (&acc)[2][2][4][2], const pg8::Unit& u, int, int, int, int) const {
        int tz = tid_from(ws_); asm volatile("" : "+v"(tz)); const int wid = tz >> 6, lane = tz & 63, wr = wid >> 2, wc = wid & 3, fr = lane & 15, fq = lane >> 4;
        const int row0 = u.pm * 256 + wr * 64 + fr, col0 = u.pn * 256 + wc * 32 + 4 * fq;
        const float* gp = gate + (size_t)(u.pm >> 4) * MODW + col0; const float* sp = sc2 + (size_t)(u.pm >> 4) * MODW + col0;
        pg8::f32x4 gv[2][2], hv[2][2];
#pragma unroll
        for (int bj = 0; bj < 2; ++bj)
#pragma unroll
            for (int n = 0; n < 2; ++n) { gv[bj][n] = *(const pg8::f32x4*)(gp + bj * 128 + n * 16);
                hv[bj][n] = *(const pg8::f32x4*)(gain2 + col0 + bj * 128 + n * 16) * (*(const pg8::f32x4*)(sp + bj * 128 + n * 16) + 1.f); }
#pragma unroll
        for (int ai = 0; ai < 2; ++ai)
#pragma unroll
            for (int m = 0; m < 4; ++m) { const int row = row0 + ai * 128 + m * 16; const size_t ro = (size_t)row * DM + col0; float s = 0.f;
#pragma unroll
                for (int bj = 0; bj < 2; ++bj)
#pragma unroll
                    for (int n = 0; n < 2; ++n) { const pg8::f32x4 xv = *(const pg8::f32x4*)(xsrc + ro + bj * 128 + n * 16);
                        const pg8::f32x4 y = xv + gv[bj][n] * acc[ai][bj][m][n];
                        *(pg8::f32x4*)(xdst + ro + bj * 128 + n * 16) = y;
                        s += (y.x * y.x + y.y * y.y) + (y.z * y.z + y.w * y.w);
                        const pg8::f32x4 hh = y * hv[bj][n]; v2u pk; pk.x = pk2(hh.x, hh.y); pk.y = pk2(hh.z, hh.w); *(v2u*)(hdst + ro + bj * 128 + n * 16) = pk; }
                s += __builtin_bit_cast(float, __builtin_amdgcn_ds_bpermute((lane ^ 16) << 2, __builtin_bit_cast(int, s)));
                s += __builtin_bit_cast(float, __builtin_amdgcn_ds_bpermute((lane ^ 32) << 2, __builtin_bit_cast(int, s)));
                if (fq == 0) ss[(size_t)row * 32 + u.pn * 4 + wc] = s; }
    }
};
struct EpiScore {
    static constexpr bool PERM = false, AFTER_DRAIN = false;
    float* C; int ldc; int ws_; const LAS float* rs; const float* bias;
    __device__ __forceinline__ void operator()(const pg8::f32x4 (&acc)[2][2][4][2], const pg8::Unit& u, int, int, int, int) const {
        int tz = tid_from(ws_); asm volatile("" : "+v"(tz)); const int wid = tz >> 6, lane = tz & 63, wr = wid >> 2, wc = wid & 3, fr = lane & 15, fq = lane >> 4;
        const int row0 = u.pm * 256 + wr * 64 + fr, col0 = u.pn * 256 + wc * 32 + 4 * fq;
        const float* bp = bias + (size_t)(u.pm >> 4) * DM + col0;
        pg8::f32x4 bv[2][2];
#pragma unroll
        for (int bj = 0; bj < 2; ++bj)
#pragma unroll
            for (int n = 0; n < 2; ++n) bv[bj][n] = *(const pg8::f32x4*)(bp + bj * 128 + n * 16);
#pragma unroll
        for (int ai = 0; ai < 2; ++ai)
#pragma unroll
            for (int m = 0; m < 4; ++m) { const int row = row0 + ai * 128 + m * 16; float* rowp = C + (size_t)row * ldc + col0;
                const float rstd = rs[row & 255];
#pragma unroll
                for (int bj = 0; bj < 2; ++bj)
#pragma unroll
                    for (int n = 0; n < 2; ++n) *(pg8::f32x4*)(rowp + bj * 128 + n * 16) = acc[ai][bj][m][n] * rstd + bv[bj][n]; }
    }
};

__device__ __forceinline__ void quant_tables(ArgsP A, int l, int wvi, int nw, int lane) {
    for (int rr = wvi; rr < 2 * PEER_N; rr += nw) {
        const int tb = rr >= PEER_N, r = l * PEER_N + (rr - tb * PEER_N);
        const f32x4* src = (const f32x4*)(A->in[27 + tb] + (size_t)r * DM) + lane;
        f32x4 v[8]; float mx = 0.f;
        float ssq = 0.f;
#pragma unroll
        for (int j = 0; j < 8; ++j) { v[j] = src[64 * j]; mx = fmaxf(mx, fmaxf(fmaxf(fabsf(v[j].x), fabsf(v[j].y)), fmaxf(fabsf(v[j].z), fabsf(v[j].w)))); ssq += (v[j].x * v[j].x + v[j].y * v[j].y) + (v[j].z * v[j].z + v[j].w * v[j].w); }
        mx = wave_max(mx);
        mx = fminf(mx, (tb ? 3.0f : 2.5f) * sqrtf(wave_sum(ssq) * (1.f / DM)));
        unsigned* dst = (unsigned*)(A->ws + (tb ? WS_V : WS_U)) + (size_t)r * (DM / 4) + lane;
        if (!tb) { const float inv = mx > 0.f ? 7.f / mx : 0.f;
            unsigned* dst4 = (unsigned*)(A->ws + WS_U) + (size_t)r * (DM / 8) + lane;
#pragma unroll
            for (int j = 0; j < 4; ++j) { unsigned wd = 0u;
                const float lo4[4] = {v[j].x, v[j].y, v[j].z, v[j].w}, hi4[4] = {v[j + 4].x, v[j + 4].y, v[j + 4].z, v[j + 4].w};
#pragma unroll
                for (int i = 0; i < 4; ++i) { const unsigned nl = (unsigned)((int)rintf(fminf(fmaxf(lo4[i] * inv, -7.f), 7.f)) + 8), nh = (unsigned)((int)rintf(fminf(fmaxf(hi4[i] * inv, -7.f), 7.f)) + 8); wd |= (nl | (nh << 4)) << (8 * i); }
                dst4[64 * j] = wd; }
            if (lane == 0) ((float*)(A->ws + WS_US))[r] = mx * (1.f / 7.f);
        } else { const float inv = mx > 0.f ? 6.f / mx : 0.f;
            unsigned short* dst2 = (unsigned short*)(A->ws + WS_V) + (size_t)r * (DM / 4) + lane;
#pragma unroll
            for (int j = 0; j < 8; ++j) { const f32x4 c4 = __builtin_elementwise_min(__builtin_elementwise_max(v[j] * inv, (f32x4){-6.f, -6.f, -6.f, -6.f}), (f32x4){6.f, 6.f, 6.f, 6.f});
                int p = __builtin_amdgcn_cvt_scalef32_pk_fp4_f32(0, c4.x, c4.y, 1.0f, 0); p = __builtin_amdgcn_cvt_scalef32_pk_fp4_f32(p, c4.z, c4.w, 1.0f, 1); dst2[64 * j] = (unsigned short)p; }
            if (lane == 0) ((float*)(A->ws + WS_VS))[r] = mx * (1.f / 6.f);
        }
    }
}

__device__ __forceinline__ void transpose_item(const float* W, int K, int N, bf16* WT, LAS float* scr, int kb, int nb, int lane) {
    const int k0 = 64 * kb, n0 = 64 * nb, nl = (lane & 15) * 4, kr = lane >> 4;
    f32x4 v[16];
#pragma unroll
    for (int it = 0; it < 16; ++it) v[it] = (n0 + nl < N) ? *(const f32x4*)(W + (size_t)(k0 + it * 4 + kr) * N + n0 + nl) : (f32x4){0.f, 0.f, 0.f, 0.f};
#pragma unroll
    for (int it = 0; it < 16; ++it) { LAS float* s = scr + (it * 4 + kr) * 65 + nl; s[0] = v[it].x; s[1] = v[it].y; s[2] = v[it].z; s[3] = v[it].w; }
    asm volatile("s_waitcnt lgkmcnt(0)" ::: "memory");
    const int c = lane & 7;
#pragma unroll
    for (int j = 0; j < 8; ++j) { const int n = (lane >> 3) + 8 * j; const LAS float* s = scr + (8 * c) * 65 + n;
        v4u o; o.x = pk2(s[0 * 65], s[1 * 65]); o.y = pk2(s[2 * 65], s[3 * 65]); o.z = pk2(s[4 * 65], s[5 * 65]); o.w = pk2(s[6 * 65], s[7 * 65]);
        if (n0 + n < N) *(v4u*)(WT + (size_t)(n0 + n) * K + k0 + 8 * c) = o; }
    asm volatile("s_waitcnt lgkmcnt(0)" ::: "memory");
}

__device__ __forceinline__ void ph_prologue(ArgsP A, LAS unsigned char* lds_, int wv_) {
    const Frame F = make_frame(lds_, wv_);
    LAS float* ldsf = (LAS float*)F.lds;
    const int tid = F.tid, lane = F.lane, wave = F.wave;
    for (int i = tid; i < NB * DM; i += NTHR) { const float c = A->in[1][i]; ldsf[i] = c / (1.f + __expf(-c)); }
    __syncthreads();
    {
        LAS float* red = ldsf + 4096;
        float* MOD = (float*)(A->ws + WS_MOD);
        for (int u = F.bid; u < DEPTH * 96; u += F.G) {
            const int l = u / 96, j0 = (u % 96) * 128;
            const float* W = A->in[2] + (size_t)l * DM * MODW + j0 + lane * 2;
            float a00 = 0.f, a01 = 0.f, a10 = 0.f, a11 = 0.f;
            const int k0 = wave * 256;
#pragma unroll 8
            for (int k = k0; k < k0 + 256; ++k) { const f32x2 w = *(const f32x2*)(W + (size_t)k * MODW); const float c0 = ldsf[k], c1 = ldsf[DM + k];
                a00 += c0 * w.x; a01 += c0 * w.y; a10 += c1 * w.x; a11 += c1 * w.y; }
            red[(wave * 2 + 0) * 128 + lane * 2] = a00; red[(wave * 2 + 0) * 128 + lane * 2 + 1] = a01;
            red[(wave * 2 + 1) * 128 + lane * 2] = a10; red[(wave * 2 + 1) * 128 + lane * 2 + 1] = a11;
            __syncthreads();
            if (tid < 256) { const int b = tid >> 7, j = tid & 127; float s = 0.f;
#pragma unroll
                for (int w = 0; w < 8; ++w) s += red[(w * 2 + b) * 128 + j];
                s += A->in[3][(size_t)l * MODW + j0 + j];
                MOD[(size_t)(l * 2 + b) * MODW + j0 + j] = s; }
            __syncthreads();
        }
    }
    {
        LAS float* scr = ldsf + wave * 4160;
        constexpr int NBI = (INW + 63) / 64;
        constexpr int I_IN = 32 * NBI, I_OUT = 32 * 32, I_L = I_IN + I_OUT;
        for (int it = F.gw; it < DEPTH * I_L; it += F.ngw) {
            const int l = it / I_L; int r = it % I_L;
            if (r < I_IN) transpose_item(A->in[5] + (size_t)l * DM * INW, DM, INW, (bf16*)(A->ws + WS_WIN) + (size_t)l * INWP * DM, scr, r / NBI, r % NBI, lane);
            else { r -= I_IN; transpose_item(A->in[22] + (size_t)l * DM * DM, DM, DM, (bf16*)(A->ws + WS_WOUT) + (size_t)l * DM * DM, scr, r / 32, r % 32, lane); }
        }
        constexpr int PADV = (INWP - INW) * DM / 8;
        for (int i = F.bid * NTHR + tid; i < DEPTH * PADV; i += F.G * NTHR) { const int l = i / PADV, r = i % PADV;
            ((v4u*)((bf16*)(A->ws + WS_WIN) + (size_t)l * INWP * DM + (size_t)INW * DM))[r] = (v4u){0u, 0u, 0u, 0u}; }
    }
    __syncthreads();
    {
        LAS float* Ks = ldsf;
        LAS float* Ws = ldsf + 128 * 132;
        for (int u = F.bid; u < DEPTH * 16 * 32; u += F.G) {
            const int l = u >> 9, hh = (u >> 5) & 15, jt = u & 31, h = hh >> 1, half = hh & 1, j0 = jt * 64;
            const float* ksrc = (half ? A->in[26] : A->in[25]) + ((size_t)l * 8 + h) * 128 * 128;
            const float* wsrc = A->in[24] + (size_t)l * DM * DM + h * 256 + half * 128;
            {   f32x4 kq[8], wq4[4];
#pragma unroll
                for (int it = 0; it < 8; ++it) { const int i = tid + it * NTHR, n = i >> 5, d4 = (i & 31) * 4; kq[it] = *(const f32x4*)(ksrc + n * 128 + d4); }
#pragma unroll
                for (int it = 0; it < 4; ++it) { const int i = tid + it * NTHR, jj = i >> 5, d4 = (i & 31) * 4; wq4[it] = *(const f32x4*)(wsrc + (size_t)(j0 + jj) * DM + d4); }
#pragma unroll
                for (int it = 0; it < 8; ++it) { const int i = tid + it * NTHR, n = i >> 5, d4 = (i & 31) * 4; *(LAS f32x4*)(Ks + n * 132 + d4) = kq[it]; }
#pragma unroll
                for (int it = 0; it < 4; ++it) { const int i = tid + it * NTHR, jj = i >> 5, d4 = (i & 31) * 4; *(LAS f32x4*)(Ws + jj * 132 + d4) = wq4[it]; }
            }
            __syncthreads();
            { const int li = lane & 15, lq = lane >> 4;
                f32x4 acc[4] = {{0.f, 0.f, 0.f, 0.f}, {0.f, 0.f, 0.f, 0.f}, {0.f, 0.f, 0.f, 0.f}, {0.f, 0.f, 0.f, 0.f}};
#pragma unroll 4
                for (int ks = 0; ks < 32; ++ks) { const float a = Ks[(wave * 16 + li) * 132 + 4 * ks + lq];
#pragma unroll
                    for (int jt = 0; jt < 4; ++jt) acc[jt] = __builtin_amdgcn_mfma_f32_16x16x4f32(a, Ws[(jt * 16 + li) * 132 + 4 * ks + lq], acc[jt], 0, 0, 0); }
                bf16* dst = (bf16*)(A->ws + WS_WQK) + (size_t)l * DM * DM + (size_t)(h * 256 + half * 128 + wave * 16 + lq * 4) * DM + j0 + li;
#pragma unroll
                for (int jt = 0; jt < 4; ++jt) { dst[(size_t)0 * DM + jt * 16] = (bf16)f2bf(acc[jt].x); dst[(size_t)1 * DM + jt * 16] = (bf16)f2bf(acc[jt].y); dst[(size_t)2 * DM + jt * 16] = (bf16)f2bf(acc[jt].z); dst[(size_t)3 * DM + jt * 16] = (bf16)f2bf(acc[jt].w); } }
            __syncthreads();
        }
    }
    {
        bf16* PT = (bf16*)(A->ws + WS_POOLT);
        for (int i = F.bid * NTHR + tid; i < DEPTH * 4 * 128 * 128; i += F.G * NTHR) { const int lg = i >> 14, r = i & 16383, dcol = r >> 7, c = r & 127;
            PT[i] = (bf16)f2bf(A->in[6][(size_t)lg * 16384 + c * 128 + dcol]); }
    }
    {
        bf16* LT = (bf16*)(A->ws + WS_LORAT);
        for (int i = F.bid * NTHR + tid; i < DEPTH * RW_W * 256; i += F.G * NTHR) { const int l = i / (RW_W * 256), r = i % (RW_W * 256), c = r >> 8, j = r & 255;
            const float v = j < 64 ? A->in[13][((size_t)l * 64 + j) * RW_W + c] : (j < 128 ? A->in[15][((size_t)l * 64 + (j - 64)) * RW_W + c] : A->in[16][((size_t)l * 128 + (j - 128)) * RW_W + c]);
            LT[i] = (bf16)f2bf(v); }
    }
    quant_tables(A, 0, F.gw, F.ngw, lane);
}

__device__ __forceinline__ void ph_norm(const float* xsrc, const float* gain, const float* sh, const float* sc, bf16* hout, LAS unsigned char* lds_, int wv_) {
    const Frame F = make_frame(lds_, wv_);
    for (int m = F.gw; m < NT; m += F.ngw) {
        const int b = m >> 12;
        const f32x4* xr = (const f32x4*)(xsrc + (size_t)m * DM) + F.lane;
        f32x4 v[8]; float ss = 0.f;
#pragma unroll
        for (int j = 0; j < 8; ++j) { v[j] = xr[64 * j]; ss += (v[j].x * v[j].x + v[j].y * v[j].y) + (v[j].z * v[j].z + v[j].w * v[j].w); }
        const float rstd = rsqrtf(wave_sum(ss) * (1.f / DM) + NORM_EPS);
        v2u* o8 = (v2u*)(hout + (size_t)m * DM) + F.lane;
#pragma unroll
        for (int j = 0; j < 8; ++j) { const int col = j * 256 + F.lane * 4;
            const f32x4 g = *(const f32x4*)(gain + col), s1 = *(const f32x4*)(sc + (size_t)b * MODW + col), s0 = *(const f32x4*)(sh + (size_t)b * MODW + col);
            const f32x4 y = v[j] * rstd * g * (s1 + 1.f) + s0;
            v2u o; o.x = pk2(y.x, y.y); o.y = pk2(y.z, y.w); o8[64 * j] = o; }
    }
}
__device__ __forceinline__ void ph_final(const float* xsrc, const float* gain, float* out, LAS unsigned char* lds_, int wv_) {
    const Frame F = make_frame(lds_, wv_);
    for (int m = F.gw; m < NT; m += F.ngw) {
        const f32x4* xr = (const f32x4*)(xsrc + (size_t)m * DM) + F.lane;
        f32x4 v[8]; float ss = 0.f;
#pragma unroll
        for (int j = 0; j < 8; ++j) { v[j] = xr[64 * j]; ss += (v[j].x * v[j].x + v[j].y * v[j].y) + (v[j].z * v[j].z + v[j].w * v[j].w); }
        const float rstd = rsqrtf(wave_sum(ss) * (1.f / DM) + NORM_EPS);
        f32x4* o = (f32x4*)(out + (size_t)m * DM) + F.lane;
#pragma unroll
        for (int j = 0; j < 8; ++j) { const f32x4 g = *(const f32x4*)(gain + j * 256 + F.lane * 4); o[64 * j] = v[j] * rstd * g; }
    }
}

__device__ __forceinline__ void pool_unit(ArgsP A, const Frame& F_in, int l, int unit) {
    Frame F = F_in; asm volatile("" : "+v"(F.tid)); F.lane = F.tid & 63;
    const int tile = unit >> 2, g = unit & 3, t0 = tile * 32, s0 = t0 & (SEQ - 1), tid = F.tid, lane = F.lane, w = F.wave;
    const int win = 2 << g;
    const float* proj = (const float*)(A->ws + WS_PROJ);
    LAS float* ps = (LAS float*)F.lds;
    LAS unsigned short* ds = (LAS unsigned short*)(F.lds + 24064);
    const int rt = w >> 2, ct0 = (w & 3) * 2, li = lane & 15, lq = lane >> 4;
    typedef short b8 __attribute__((ext_vector_type(8)));
    b8 bw[2][4];
    { const unsigned short* PT = (const unsigned short*)(A->ws + WS_POOLT) + ((size_t)l * 4 + g) * 16384;
#pragma unroll
        for (int j = 0; j < 2; ++j)
#pragma unroll
            for (int ks = 0; ks < 4; ++ks) bw[j][ks] = *(const b8*)(PT + (size_t)((ct0 + j) * 16 + li) * 128 + ks * 32 + lq * 8); }
    {   f32x4 pq[3];
#pragma unroll
        for (int it = 0; it < 3; ++it) { const int i = tid + it * NTHR, r = i >> 5, c4 = i & 31; const int s = s0 - 15 + r;
            pq[it] = (i < 47 * 32 && s >= 0) ? *(const f32x4*)(proj + (size_t)(t0 - 15 + r) * INWP + C_POOL + g * 128 + c4 * 4) : (f32x4){0.f, 0.f, 0.f, 0.f}; }
#pragma unroll
        for (int it = 0; it < 3; ++it) { const int i = tid + it * NTHR; if (i < 47 * 32) *(LAS f32x4*)(ps + i * 4) = pq[it]; }
    }
    __syncthreads();
    for (int i = tid; i < 32 * 128; i += NTHR) { const int tok = i >> 7, c = i & 127; float sum = 0.f;
        for (int ww = 0; ww < win; ++ww) sum += ps[(tok + 15 - ww) * 128 + c];
        const int cnt = (s0 + tok + 1) < win ? (s0 + tok + 1) : win;
        ds[tok * 136 + c] = (unsigned short)f2bf(sum * __builtin_amdgcn_rcpf((float)cnt) - ps[(tok + 15) * 128 + c]); }
    __syncthreads();
    f32x4 acc[2] = {{0.f, 0.f, 0.f, 0.f}, {0.f, 0.f, 0.f, 0.f}};
#pragma unroll
    for (int ks = 0; ks < 4; ++ks) { const b8 a = *(const LAS b8*)(ds + (rt * 16 + li) * 136 + ks * 32 + lq * 8);
#pragma unroll
        for (int j = 0; j < 2; ++j) acc[j] = __builtin_amdgcn_mfma_f32_16x16x32_bf16(a, bw[j][ks], acc[j], 0, 0, 0); }
    bf16* Y = (bf16*)(A->ws + WS_Y);
#pragma unroll
    for (int j = 0; j < 2; ++j) { const int dcol = (ct0 + j) * 16 + li; const float scale = A->in[7][(size_t)l * 512 + g * 128 + dcol]; const int tk = t0 + rt * 16 + lq * 4;
        Y[(size_t)(tk + 0) * DM + g * 128 + dcol] = (bf16)f2bf(acc[j].x * scale); Y[(size_t)(tk + 1) * DM + g * 128 + dcol] = (bf16)f2bf(acc[j].y * scale);
        Y[(size_t)(tk + 2) * DM + g * 128 + dcol] = (bf16)f2bf(acc[j].z * scale); Y[(size_t)(tk + 3) * DM + g * 128 + dcol] = (bf16)f2bf(acc[j].w * scale); }
    __syncthreads();
}

__device__ __forceinline__ void gla_bcum(ArgsP A, const Frame& F, int l, int h, int t0, LAS float* bcum, LAS float* ad, LAS float* up) {
    const float* proj = (const float*)(A->ws + WS_PROJ);
    const int tid = F.tid;
    {
        const float a0 = proj[(size_t)(t0 + (tid >> 4)) * INWP + C_GA + (tid & 15)], a1 = proj[(size_t)(t0 + 32 + (tid >> 4)) * INWP + C_GA + (tid & 15)];
        const float* upg = A->in[8] + (size_t)l * 16 * 384 + h * 96;
        const float u0 = upg[(tid / 96) * 384 + tid % 96], u1 = upg[((tid + 512) / 96) * 384 + (tid + 512) % 96], u2 = upg[((tid + 1024) / 96) * 384 + (tid + 1024) % 96];
        ad[tid] = a0; ad[tid + 512] = a1; up[tid] = u0; up[tid + 512] = u1; up[tid + 1024] = u2;
    }
    __syncthreads();
    for (int i = tid; i < 64 * 96; i += NTHR) { const int tok = i / 96, d = i % 96; float x = A->in[9][(size_t)l * 384 + h * 96 + d];
#pragma unroll
        for (int j = 0; j < 16; ++j) x += ad[tok * 16 + j] * up[j * 96 + d];
        bcum[i] = -softplusf_(-x) * (1.f / 16.f); }
    __syncthreads();
    if (tid < 384) { const int d = tid % 96, seg = tid / 96; float acc = 0.f;
#pragma unroll
        for (int k = 0; k < 16; ++k) { acc += bcum[(seg * 16 + k) * 96 + d]; bcum[(seg * 16 + k) * 96 + d] = acc; }
        ad[seg * 96 + d] = acc; }
    __syncthreads();
    if (tid < 384) { const int d = tid % 96, seg = tid / 96; float pre = 0.f;
#pragma unroll
        for (int s2 = 0; s2 < 3; ++s2) pre += (s2 < seg) ? ad[s2 * 96 + d] : 0.f;
        if (seg > 0) {
#pragma unroll
            for (int k = 0; k < 16; ++k) bcum[(seg * 16 + k) * 96 + d] += pre; } }
    __syncthreads();
}

__device__ __forceinline__ void gla_scan_unit(ArgsP A, const Frame& F, int unit) {
    const int idx = unit * NTHR + F.tid, bh = idx / 18432, rem = idx % 18432, d = rem % 96;
    const float* KV = (const float*)(A->ws + WS_GKV) + (size_t)bh * 64 * 18432 + rem;
    float* GS = (float*)(A->ws + WS_GS) + (size_t)bh * 64 * 18432 + rem;
    const float* DEC = (const float*)(A->ws + WS_GDEC) + (size_t)bh * 64 * 96 + d;
    float S = 0.f;
#pragma unroll 1
    for (int c0 = 0; c0 < 64; c0 += 16) {
        float kv[16], dc[16];
#pragma unroll
        for (int j = 0; j < 16; ++j) { kv[j] = KV[(size_t)(c0 + j) * 18432]; dc[j] = DEC[(c0 + j) * 96]; }
#pragma unroll
        for (int j = 0; j < 16; ++j) { GS[(size_t)(c0 + j) * 18432] = S; S = dc[j] * S + kv[j]; }
    }
}

typedef short bf16x8_t __attribute__((ext_vector_type(8)));
constexpr int RS = 68;
__device__ __forceinline__ f32x4 tile_mm64(const LAS bf16* Am, int arow0, const LAS bf16* Bm, int brow0, f32x4 acc, int lane) {
    const int r = lane & 15, kq = (lane >> 4) * 8;
#pragma unroll
    for (int ks = 0; ks < 2; ++ks) {
        const bf16x8_t a = *(const LAS bf16x8_t*)(Am + (arow0 + r) * RS + ks * 32 + kq);
        const bf16x8_t b = *(const LAS bf16x8_t*)(Bm + (brow0 + r) * RS + ks * 32 + kq);
        acc = __builtin_amdgcn_mfma_f32_16x16x32_bf16(a, b, acc, 0, 0, 0);
    }
    return acc;
}
constexpr int RA_BT = 0, RA_KT = 8704, RA_AT = 17408, RA_RT = 26112, RA_RABS = 34816, RA_BHT = 43520, RA_KHT = 52224, RA_VT = 60928, RA_AABS = 69632,
              RA_MBAT = 86272, RA_MKA = 103680, RA_NBRT = 121088, RA_GC = 129792, RA_WT = 130048, RA_NKRT = 132096, RA_END = 140800, RA_PRE = 94976;
constexpr int RA_Z = RA_BT, RA_QST = RA_AT, RA_QOT = RA_RT, RA_LO = 0, RA_RES = 34816;
constexpr size_t RWO_POT = 0, RWO_PST = 12 * MiB, RWO_GT = 24 * MiB, RWO_OLT = 48 * MiB, RWO_SC = 72 * MiB;

__device__ __forceinline__ void rwkvA_unit(ArgsP A, const Frame& F_in, int l, int unit) {
    Frame F = F_in; asm volatile("" : "+v"(F.tid)); F.lane = F.tid & 63;

    const int bh = unit >> 6, c = unit & 63, b = bh / RW_H, h = bh % RW_H, t0 = b * SEQ + c * 64, s0 = c * 64, tid = F.tid, lane = F.lane, w = F.wave;
    const float* proj = (const float*)(A->ws + WS_PROJ);
    const float* mu = A->in[11] + (size_t)l * RW_IN;
    LAS unsigned char* L = F.lds;
    const int n = lane, cc = h * 64 + n;
    const int rt1 = w >> 1, ct1 = (w & 1) * 2, li1 = lane & 15, lq1 = lane >> 4;
    f32x4 yc[8], yp[8];
#pragma unroll
    for (int it = 0; it < 8; ++it) { const int g = tid + it * NTHR, tok = g >> 6, j4 = (g & 63) * 4; const float* rp = proj + ((size_t)t0 + tok) * INWP + C_RW + 2304 + j4;
        yc[it] = *(const f32x4*)rp; yp[it] = (s0 + tok > 0) ? *(const f32x4*)(rp - INWP) : (f32x4){0.f, 0.f, 0.f, 0.f}; }
    bf16x8_t bw[2][8];
    { const bf16* LT = (const bf16*)(A->ws + WS_LORAT) + ((size_t)l * RW_W + h * 64) * 256;
#pragma unroll
        for (int j = 0; j < 2; ++j)
#pragma unroll
            for (int ks = 0; ks < 8; ++ks) bw[j][ks] = *(const bf16x8_t*)(LT + (size_t)((ct1 + j) * 16 + li1) * 256 + ks * 32 + lq1 * 8); }
    float rr[9], kr[9], vr[9];
#pragma unroll
    for (int i = 0; i < 9; ++i) { const int tok = w * 8 + i - 1; const bool ok = (s0 + tok >= 0); const float* row = proj + ((size_t)t0 + tok) * INWP + C_RW;
        rr[i] = ok ? row[cc] : 0.f; kr[i] = ok ? row[768 + cc] : 0.f; vr[i] = ok ? row[1536 + cc] : 0.f; }
    const float w0c = A->in[12][(size_t)l * RW_W + cc], a0c = A->in[14][(size_t)l * RW_W + cc], kkc = A->in[17][(size_t)l * RW_W + cc], kac = A->in[18][(size_t)l * RW_W + cc], rkc = A->in[19][(size_t)l * RW_W + cc];
    const float mur = mu[cc], muk = mu[768 + cc], muv = mu[1536 + cc];
    {   LAS bf16* lo = (LAS bf16*)(L + RA_LO);
#pragma unroll
        for (int it = 0; it < 8; ++it) { const int g = tid + it * NTHR, tok = g >> 6, j4 = (g & 63) * 4; const f32x4 m4 = *(const f32x4*)(mu + 2304 + j4);
            const f32x4 ym = yc[it] + (yp[it] - yc[it]) * m4;
            const float sc = j4 < 64 ? 2.f : 1.f; f32x4 sg; sg.x = sigmoidf_(ym.x * sc); sg.y = sigmoidf_(ym.y * sc); sg.z = sigmoidf_(ym.z * sc); sg.w = sigmoidf_(ym.w * sc);
            const f32x4 o = j4 < 64 ? sg * 2.f - 1.f : (j4 < 128 ? ym : sg);
            v2u pk; pk.x = pk2(o.x, o.y); pk.y = pk2(o.z, o.w); *(LAS v2u*)(lo + tok * 264 + j4) = pk; }
    }
    __syncthreads();
    {
        const int rt = rt1, ct0 = ct1, li = li1, lq = lq1;
        const LAS bf16* lo = (const LAS bf16*)(L + RA_LO);
        LAS float* res = (LAS float*)(L + RA_RES);
        f32x4 acc[3][2];
#pragma unroll
        for (int p = 0; p < 3; ++p)
#pragma unroll
            for (int j = 0; j < 2; ++j) acc[p][j] = (f32x4){0.f, 0.f, 0.f, 0.f};
#pragma unroll
        for (int ks = 0; ks < 8; ++ks) { const bf16x8_t a = *(const LAS bf16x8_t*)(lo + (rt * 16 + li) * 264 + ks * 32 + lq * 8);
            const int p = ks < 2 ? 0 : (ks < 4 ? 1 : 2);
#pragma unroll
            for (int j = 0; j < 2; ++j) acc[p][j] = __builtin_amdgcn_mfma_f32_16x16x32_bf16(a, bw[j][ks], acc[p][j], 0, 0, 0); }
#pragma unroll
        for (int p = 0; p < 3; ++p)
#pragma unroll
            for (int j = 0; j < 2; ++j) { LAS float* rp = res + p * 64 * 68 + (rt * 16 + lq * 4) * 68 + (ct0 + j) * 16 + li;
                rp[0] = acc[p][j].x; rp[68] = acc[p][j].y; rp[136] = acc[p][j].z; rp[204] = acc[p][j].w; }
    }
    __syncthreads();
    float r_[8], k_[8], v_[8], av_[8], bb_[8], lw_[8];
    {
        const LAS float* res = (const LAS float*)(L + RA_RES);
        float wl[8], al[8], gl[8];
#pragma unroll
        for (int i = 0; i < 8; ++i) { wl[i] = res[(w * 8 + i) * 68 + n]; al[i] = res[64 * 68 + (w * 8 + i) * 68 + n]; gl[i] = res[2 * 64 * 68 + (w * 8 + i) * 68 + n]; }
        float* GATE = (float*)(A->ws + WS_RGATE); float* BV = (float*)(A->ws + WS_RBV);
#pragma unroll
        for (int i = 0; i < 8; ++i) { const int tok = w * 8 + i; const size_t t = (size_t)t0 + tok;
            float r = rr[i + 1], k = kr[i + 1], v = vr[i + 1];
            r += (rr[i] - r) * mur; k += (kr[i] - k) * muk; v += (vr[i] - v) * muv;
            const float wraw = -softplusf_(-(w0c + wl[i])) - 0.5f;
            const float a = sigmoidf_(a0c + al[i]);
            float kk = k * kkc; kk = kk * __builtin_amdgcn_rsqf(fmaxf(wave_sum(kk * kk), 1e-24f));
            const float k2 = k * (1.f + (a - 1.f) * kac);
            const float bonus = wave_sum(r * k2 * rkc);
            r_[i] = r; k_[i] = k2; v_[i] = v; av_[i] = -kk; bb_[i] = kk * a; lw_[i] = -__expf(wraw);
            GATE[t * RW_W + cc] = gl[i]; BV[t * RW_W + cc] = bonus * v; }
    }
    LAS float* wt = (LAS float*)(L + RA_WT);
#pragma unroll
    for (int i = 1; i < 8; ++i) lw_[i] += lw_[i - 1];
    wt[w * 64 + n] = lw_[7];
    __syncthreads();
    float pre = 0.f, mid = 0.f, last = 0.f;
#pragma unroll
    for (int ww = 0; ww < 8; ++ww) { const float x = wt[ww * 64 + n]; pre += (ww < w) ? x : 0.f; mid += (ww < 4) ? x : 0.f; last += x; }
    {
        LAS bf16* Bt = (LAS bf16*)(L + RA_BT); LAS bf16* Kt = (LAS bf16*)(L + RA_KT); LAS bf16* At = (LAS bf16*)(L + RA_AT); LAS bf16* Rt = (LAS bf16*)(L + RA_RT);
        LAS bf16* Rab = (LAS bf16*)(L + RA_RABS); LAS bf16* BhT = (LAS bf16*)(L + RA_BHT); LAS bf16* KhT = (LAS bf16*)(L + RA_KHT); LAS bf16* VT = (LAS bf16*)(L + RA_VT);
        LAS float* AabT = (LAS float*)(L + RA_AABS);
#pragma unroll
        for (int i = 0; i < 8; ++i) { const int t = w * 8 + i; const float lw = pre + lw_[i], lwm1 = pre + (i > 0 ? lw_[i - 1] : 0.f);
            const float eg = __expf(lw - mid), egi = __expf(mid - lw), egm1 = __expf(lwm1 - mid), eh = __expf(last - lw);
            Bt[t * RS + n] = (bf16)f2bf(bb_[i] * egi); Kt[t * RS + n] = (bf16)f2bf(k_[i] * egi); At[t * RS + n] = (bf16)f2bf(av_[i] * egm1); Rt[t * RS + n] = (bf16)f2bf(r_[i] * eg);
            Rab[t * RS + n] = (bf16)f2bf(r_[i] * __expf(lw)); AabT[n * 65 + t] = av_[i] * __expf(lwm1);
            BhT[n * RS + t] = (bf16)f2bf(bb_[i] * eh); KhT[n * RS + t] = (bf16)f2bf(k_[i] * eh); VT[n * RS + t] = (bf16)f2bf(v_[i]); }
        if (w == 0) ((LAS float*)(L + RA_GC))[n] = __expf(last);
    }
    __syncthreads();
    const int rt = w >> 1, ct0 = (w & 1) * 2, li = lane & 15, lq = lane >> 4;
#define FRAG(mat_, row_, ks_) (*(const LAS bf16x8_t*)((mat_) + ((row_) + li) * RS + (ks_) * 32 + lq * 8))
#define MM(a_, b_, c_) __builtin_amdgcn_mfma_f32_16x16x32_bf16(a_, b_, c_, 0, 0, 0)
    {
        const LAS bf16* Bt = (const LAS bf16*)(L + RA_BT); const LAS bf16* Kt = (const LAS bf16*)(L + RA_KT); const LAS bf16* At = (const LAS bf16*)(L + RA_AT); const LAS bf16* Rt = (const LAS bf16*)(L + RA_RT);
        LAS bf16* MbaT = (LAS bf16*)(L + RA_MBAT); LAS float* Mka = (LAS float*)(L + RA_MKA); LAS bf16* NbrT = (LAS bf16*)(L + RA_NBRT);
        bf16x8_t aB[2], aK[2], bA[2][2], bR[2][2];
#pragma unroll
        for (int ks = 0; ks < 2; ++ks) { aB[ks] = FRAG(Bt, rt * 16, ks); aK[ks] = FRAG(Kt, rt * 16, ks);
#pragma unroll
            for (int j = 0; j < 2; ++j) { bA[j][ks] = FRAG(At, (ct0 + j) * 16, ks); bR[j][ks] = FRAG(Rt, (ct0 + j) * 16, ks); } }
#pragma unroll
        for (int j = 0; j < 2; ++j) { const int ct = ct0 + j, tcol = ct * 16 + li, srow = rt * 16 + lq * 4;
            const f32x4 z = {0.f, 0.f, 0.f, 0.f};
            f32x4 mba = MM(aB[1], bA[j][1], MM(aB[0], bA[j][0], z)), nbr = MM(aB[1], bR[j][1], MM(aB[0], bR[j][0], z));
            f32x4 mka = MM(aK[1], bA[j][1], MM(aK[0], bA[j][0], z)), nk = MM(aK[1], bR[j][1], MM(aK[0], bR[j][0], z));
            mba.x = (srow + 0 < tcol) ? mba.x : 0.f; mba.y = (srow + 1 < tcol) ? mba.y : 0.f; mba.z = (srow + 2 < tcol) ? mba.z : 0.f; mba.w = (srow + 3 < tcol) ? mba.w : 0.f;
            mka.x = (srow + 0 < tcol) ? mka.x : 0.f; mka.y = (srow + 1 < tcol) ? mka.y : 0.f; mka.z = (srow + 2 < tcol) ? mka.z : 0.f; mka.w = (srow + 3 < tcol) ? mka.w : 0.f;
            nbr.x = (srow + 0 <= tcol) ? nbr.x : 0.f; nbr.y = (srow + 1 <= tcol) ? nbr.y : 0.f; nbr.z = (srow + 2 <= tcol) ? nbr.z : 0.f; nbr.w = (srow + 3 <= tcol) ? nbr.w : 0.f;
            nk.x = (srow + 0 <= tcol) ? nk.x : 0.f; nk.y = (srow + 1 <= tcol) ? nk.y : 0.f; nk.z = (srow + 2 <= tcol) ? nk.z : 0.f; nk.w = (srow + 3 <= tcol) ? nk.w : 0.f;
            { v2u pm; pm.x = pk2(mba.x, mba.y); pm.y = pk2(mba.z, mba.w); *(LAS v2u*)(MbaT + tcol * RS + srow) = pm; }
            Mka[(srow + 0) * RS + tcol] = mka.x; Mka[(srow + 1) * RS + tcol] = mka.y; Mka[(srow + 2) * RS + tcol] = mka.z; Mka[(srow + 3) * RS + tcol] = mka.w;
            v2u pk; pk.x = pk2(nbr.x, nbr.y); pk.y = pk2(nbr.z, nbr.w); *(LAS v2u*)(NbrT + tcol * RS + srow) = pk;
            { v2u pn; pn.x = pk2(nk.x, nk.y); pn.y = pk2(nk.z, nk.w); *(LAS v2u*)((LAS bf16*)(L + RA_NKRT) + tcol * RS + srow) = pn; } }
    }
    __syncthreads();
    {
        int t4 = tid; asm volatile("" : "+v"(t4)); const int row = t4 >> 2, q = t4 & 3, l4 = t4 & 63, li4 = l4 & 15, lq4 = l4 >> 4;
        const LAS bf16* MbaT = (const LAS bf16*)(L + RA_MBAT);
        const LAS float* Yrow = (row < 64) ? ((const LAS float*)(L + RA_AABS) + row * 65) : ((const LAS float*)(L + RA_MKA) + (row - 64) * RS);
        LAS bf16* Z = (LAS bf16*)(L + RA_Z); LAS float* pre = (LAS float*)(L + RA_PRE);
        for (int i = t4; i < 1088; i += NTHR) ((LAS v4u*)Z)[i] = (v4u){0u, 0u, 0u, 0u};
        __syncthreads();
#pragma unroll 1
        for (int jb = 0; jb < 4; ++jb) {
            if (jb > 0) {
                f32x4 acc = {0.f, 0.f, 0.f, 0.f};
#pragma unroll
                for (int ks = 0; ks < 2; ++ks) { const bf16x8_t a = *(const LAS bf16x8_t*)(Z + (w * 16 + li4) * RS + ks * 32 + lq4 * 8);
                    const bf16x8_t bm = *(const LAS bf16x8_t*)(MbaT + (jb * 16 + li4) * RS + ks * 32 + lq4 * 8);
                    acc = __builtin_amdgcn_mfma_f32_16x16x32_bf16(a, bm, acc, 0, 0, 0); }
                LAS float* pp = pre + (w * 16 + lq4 * 4) * 16 + li4;
                pp[0] = acc.x; pp[16] = acc.y; pp[32] = acc.z; pp[48] = acc.w;
                __syncthreads();
            }
            float yv[16]; v2u mv[16];
#pragma unroll
            for (int u = 0; u < 16; ++u) { yv[u] = Yrow[jb * 16 + u] + (jb > 0 ? pre[row * 16 + u] : 0.f); mv[u] = *(const LAS v2u*)(MbaT + (jb * 16 + u) * RS + jb * 16 + q * 4); }
            float zb[4] = {0.f, 0.f, 0.f, 0.f};
#pragma unroll
            for (int u = 0; u < 16; ++u) {
                float part = (zb[0] * bflo(mv[u].x) + zb[1] * bfhi(mv[u].x)) + (zb[2] * bflo(mv[u].y) + zb[3] * bfhi(mv[u].y));
                part += dpp_xor1(part); part += dpp_xor2(part);
                const float zt = yv[u] + part;
                zb[u & 3] = (q == (u >> 2)) ? zt : zb[u & 3];
            }
            { v2u pk; pk.x = pk2(zb[0], zb[1]); pk.y = pk2(zb[2], zb[3]); *(LAS v2u*)(Z + row * RS + jb * 16 + q * 4) = pk; }
            __syncthreads();
        }
    }
    {
        int t5 = tid; asm volatile("" : "+v"(t5)); const int li = t5 & 15, lq = (t5 >> 4) & 3;
        const LAS bf16* Z = (const LAS bf16*)(L + RA_Z); const LAS bf16* NbrT = (const LAS bf16*)(L + RA_NBRT); const LAS bf16* BhT = (const LAS bf16*)(L + RA_BHT);
        const LAS bf16* Rab = (const LAS bf16*)(L + RA_RABS); const LAS bf16* KhT = (const LAS bf16*)(L + RA_KHT); const LAS float* gC = (const LAS float*)(L + RA_GC);
        LAS bf16* QsT = (LAS bf16*)(L + RA_QST); LAS bf16* QoT = (LAS bf16*)(L + RA_QOT);
        bf16* PoT = (bf16*)(A->ws + WS_RSC + RWO_POT) + (size_t)unit * 4096; bf16* PsT = (bf16*)(A->ws + WS_RSC + RWO_PST) + (size_t)unit * 4096;
        bf16x8_t zW[2], zX[2], bN[2][2], bH[2][2]; v2u rb[2], kb[2], nb2[2]; float gc[2];
#pragma unroll
        for (int ks = 0; ks < 2; ++ks) { zW[ks] = FRAG(Z, rt * 16, ks); zX[ks] = FRAG(Z, 64 + rt * 16, ks);
#pragma unroll
            for (int j = 0; j < 2; ++j) { bN[j][ks] = FRAG(NbrT, (ct0 + j) * 16, ks); bH[j][ks] = FRAG(BhT, (ct0 + j) * 16, ks); } }
#pragma unroll
        for (int j = 0; j < 2; ++j) { const int col = (ct0 + j) * 16 + li, rw = rt * 16 + lq * 4; rb[j] = *(const LAS v2u*)(Rab + col * RS + rw); kb[j] = *(const LAS v2u*)(KhT + col * RS + rw); nb2[j] = *(const LAS v2u*)((const LAS bf16*)(L + RA_NKRT) + col * RS + rw); gc[j] = gC[col]; }
#pragma unroll
        for (int j = 0; j < 2; ++j) { const int col = (ct0 + j) * 16 + li, rw = rt * 16 + lq * 4;
            { f32x4 acc = {bflo(rb[j].x), bfhi(rb[j].x), bflo(rb[j].y), bfhi(rb[j].y)};
                acc = MM(zW[1], bN[j][1], MM(zW[0], bN[j][0], acc));
                v2u pk; pk.x = pk2(acc.x, acc.y); pk.y = pk2(acc.z, acc.w); *(v2u*)(PoT + (size_t)col * 64 + rw) = pk; }
            { f32x4 acc = {(rw + 0 == col) ? gc[j] : 0.f, (rw + 1 == col) ? gc[j] : 0.f, (rw + 2 == col) ? gc[j] : 0.f, (rw + 3 == col) ? gc[j] : 0.f};
                acc = MM(zW[1], bH[j][1], MM(zW[0], bH[j][0], acc));
                v2u pk; pk.x = pk2(acc.x, acc.y); pk.y = pk2(acc.z, acc.w); *(v2u*)(PsT + (size_t)col * 64 + rw) = pk; }
            { f32x4 acc = {bflo(nb2[j].x), bfhi(nb2[j].x), bflo(nb2[j].y), bfhi(nb2[j].y)};
                acc = MM(zX[1], bN[j][1], MM(zX[0], bN[j][0], acc));
                v2u pk; pk.x = pk2(acc.x, acc.y); pk.y = pk2(acc.z, acc.w); *(LAS v2u*)(QoT + col * RS + rw) = pk; }
            { f32x4 acc = {bflo(kb[j].x), bfhi(kb[j].x), bflo(kb[j].y), bfhi(kb[j].y)};
                acc = MM(zX[1], bH[j][1], MM(zX[0], bH[j][0], acc));
                v2u pk; pk.x = pk2(acc.x, acc.y); pk.y = pk2(acc.z, acc.w); *(LAS v2u*)(QsT + col * RS + rw) = pk; }
        }
    }
    __syncthreads();
    {
        int t6 = tid; asm volatile("" : "+v"(t6)); const int li = t6 & 15, lq = (t6 >> 4) & 3;
        const LAS bf16* VT = (const LAS bf16*)(L + RA_VT);
        const bool isO = (w & 1);
        const LAS bf16* Bm = (const LAS bf16*)(L + (isO ? RA_QOT : RA_QST));
        float* dst = (float*)(A->ws + WS_RSC + (isO ? RWO_OLT : RWO_GT)) + (size_t)unit * 4096;
        bf16x8_t av[2], bq[4][2];
#pragma unroll
        for (int ks = 0; ks < 2; ++ks) { av[ks] = FRAG(VT, rt * 16, ks);
#pragma unroll
            for (int j = 0; j < 4; ++j) bq[j][ks] = FRAG(Bm, j * 16, ks); }
#pragma unroll
        for (int j = 0; j < 4; ++j) { const f32x4 z = {0.f, 0.f, 0.f, 0.f};
            const f32x4 acc = MM(av[1], bq[j][1], MM(av[0], bq[j][0], z));
            *(f32x4*)(dst + (size_t)(j * 16 + li) * 64 + rt * 16 + lq * 4) = acc; }
    }
#undef FRAG
#undef MM
    __syncthreads();
}

__device__ __forceinline__ void rwkvB_scan(ArgsP A, const Frame& F, int unit) {
    const int bh = unit >> 2, rq = unit & 3;
    const int tid = F.tid, lane = F.lane, w = F.wave, ct = w & 3, li = lane & 15, lq = lane >> 4;
    const bool writer = (w < 4);
    const bf16* PsT = (const bf16*)(A->ws + WS_RSC + RWO_PST) + (size_t)bh * 64 * 4096; const float* GT = (const float*)(A->ws + WS_RSC + RWO_GT) + (size_t)bh * 64 * 4096;
    bf16* SC = (bf16*)(A->ws + WS_RSC + RWO_SC) + (size_t)bh * 64 * 4096;
    f32x4 S = {0.f, 0.f, 0.f, 0.f};
    constexpr int PF = 4;
    bf16x8_t pb[PF][2]; f32x4 gq[PF];
    const int col = ct * 16 + li;
#define SLOAD(slot, cc_) do { _Pragma("unroll") for (int ks = 0; ks < 2; ++ks) pb[slot][ks] = *(const bf16x8_t*)(PsT + (size_t)(cc_) * 4096 + (size_t)col * 64 + ks * 32 + lq * 8); \
        gq[slot] = *(const f32x4*)(GT + (size_t)(cc_) * 4096 + (size_t)col * 64 + rq * 16 + lq * 4); } while (0)
#define SSTEP(slot, cc_) do { LAS bf16* Sl = (LAS bf16*)(F.lds + ((cc_) & 1) * 2176); \
        if (writer) { const int rw_ = lq * 4; Sl[(rw_ + 0) * RS + col] = (bf16)f2bf(S.x); Sl[(rw_ + 1) * RS + col] = (bf16)f2bf(S.y); Sl[(rw_ + 2) * RS + col] = (bf16)f2bf(S.z); Sl[(rw_ + 3) * RS + col] = (bf16)f2bf(S.w); } \
        asm volatile("s_waitcnt lgkmcnt(0)" ::: "memory"); __builtin_amdgcn_s_barrier(); asm volatile("" ::: "memory");        \
        if (tid < 128) { const int v_ = tid >> 3, k8_ = (tid & 7) * 8; *(v4u*)(SC + (size_t)(cc_) * 4096 + (rq * 16 + v_) * 64 + k8_) = *(const LAS v4u*)(Sl + v_ * RS + k8_); } \
        f32x4 acc_ = gq[slot]; \
        _Pragma("unroll") for (int ks = 0; ks < 2; ++ks) { const bf16x8_t a_ = *(const LAS bf16x8_t*)(Sl + li * RS + ks * 32 + lq * 8); \
            acc_ = __builtin_amdgcn_mfma_f32_16x16x32_bf16(a_, pb[slot][ks], acc_, 0, 0, 0); } \
        S = acc_; } while (0)
    SLOAD(0, 0); SLOAD(1, 1); SLOAD(2, 2); SLOAD(3, 3);
#pragma unroll 1
    for (int c = 0; c < 64; c += 4) {
        const int cn = (c + 4 < 64) ? c + 4 : 60;
        SSTEP(0, c);     SLOAD(0, cn);
        SSTEP(1, c + 1); SLOAD(1, cn + 1);
        SSTEP(2, c + 2); SLOAD(2, cn + 2);
        SSTEP(3, c + 3); SLOAD(3, cn + 3);
    }
#undef SLOAD
#undef SSTEP
    __syncthreads();
}

__device__ __forceinline__ void rwkvC_unit(ArgsP A, const Frame& F_in, int l, int unit) {
    Frame F = F_in; asm volatile("" : "+v"(F.tid)); F.lane = F.tid & 63;

    const int bh = unit >> 6, c = unit & 63, b = bh / RW_H, h = bh % RW_H, t0 = b * SEQ + c * 64, tid = F.tid, lane = F.lane, w = F.wave;
    const int rt = w >> 1, ct0 = (w & 1) * 2, li = lane & 15, lq = lane >> 4;
    LAS bf16* Sl = (LAS bf16*)F.lds; LAS bf16* Pl = (LAS bf16*)(F.lds + 8704); LAS float* ob = (LAS float*)(F.lds + 17408);
    { const int r = tid >> 3, k8 = (tid & 7) * 8;
        *(LAS v4u*)(Sl + r * RS + k8) = *(const v4u*)((const bf16*)(A->ws + WS_RSC + RWO_SC) + (size_t)unit * 4096 + r * 64 + k8);
        *(LAS v4u*)(Pl + r * RS + k8) = *(const v4u*)((const bf16*)(A->ws + WS_RSC + RWO_POT) + (size_t)unit * 4096 + r * 64 + k8); }
    __syncthreads();
    const float* OlT = (const float*)(A->ws + WS_RSC + RWO_OLT) + (size_t)unit * 4096;
#pragma unroll
    for (int j = 0; j < 2; ++j) { const int tcol = (ct0 + j) * 16 + li, vr = rt * 16 + lq * 4;
        f32x4 acc = *(const f32x4*)(OlT + (size_t)tcol * 64 + vr);
        acc = tile_mm64(Sl, rt * 16, Pl, (ct0 + j) * 16, acc, lane);
        *(LAS f32x4*)(ob + tcol * 68 + vr) = acc; }
    __syncthreads();
    { const int t = tid >> 3, q = tid & 7; const size_t tg = (size_t)t0 + t;
        const f32x4 o0 = *(const LAS f32x4*)(ob + t * 68 + q * 8), o1 = *(const LAS f32x4*)(ob + t * 68 + q * 8 + 4);
        const float mean = red8((o0.x + o0.y) + (o0.z + o0.w) + (o1.x + o1.y) + (o1.z + o1.w)) * (1.f / 64.f);
        const f32x4 d0 = o0 - mean, d1 = o1 - mean;
        const float var = red8((d0.x * d0.x + d0.y * d0.y) + (d0.z * d0.z + d0.w * d0.w) + (d1.x * d1.x + d1.y * d1.y) + (d1.z * d1.z + d1.w * d1.w)) * (1.f / 64.f);
        const float rs = rsqrtf(var + 64e-5f);
        const int cc = h * 64 + q * 8;
        const f32x4 g0 = *(const f32x4*)(A->in[20] + (size_t)l * RW_W + cc), g1 = *(const f32x4*)(A->in[20] + (size_t)l * RW_W + cc + 4);
        const f32x4 b0 = *(const f32x4*)(A->in[21] + (size_t)l * RW_W + cc), b1 = *(const f32x4*)(A->in[21] + (size_t)l * RW_W + cc + 4);
        const f32x4 bv0 = *(const f32x4*)((const float*)(A->ws + WS_RBV) + tg * RW_W + cc), bv1 = *(const f32x4*)((const float*)(A->ws + WS_RBV) + tg * RW_W + cc + 4);
        const f32x4 ga0 = *(const f32x4*)((const float*)(A->ws + WS_RGATE) + tg * RW_W + cc), ga1 = *(const f32x4*)((const float*)(A->ws + WS_RGATE) + tg * RW_W + cc + 4);
        const f32x4 y0 = (d0 * rs * g0 + b0 + bv0) * ga0, y1 = (d1 * rs * g1 + b1 + bv1) * ga1;
        v4u o; o.x = pk2(y0.x, y0.y); o.y = pk2(y0.z, y0.w); o.z = pk2(y1.x, y1.y); o.w = pk2(y1.z, y1.w);
        *(v4u*)((bf16*)(A->ws + WS_Y) + tg * DM + 1280 + cc) = o; }
    __syncthreads();
}

constexpr size_t RWO_GQ = 84 * MiB, RWO_GK = 92 * MiB, RWO_GVT = 100 * MiB, RWO_GEM = 116 * MiB;
constexpr int GQS = 104, GTS = 72;
template <int NKS> __device__ __forceinline__ f32x4 tile_mm(const LAS bf16* Am, int sa, int arow0, const LAS bf16* Bm, int sb, int brow0, f32x4 acc, int lane) {
    const int r = lane & 15, kq = (lane >> 4) * 8;
#pragma unroll
    for (int ks = 0; ks < NKS; ++ks) {
        const bf16x8_t a = *(const LAS bf16x8_t*)(Am + (arow0 + r) * sa + ks * 32 + kq);
        const bf16x8_t b = *(const LAS bf16x8_t*)(Bm + (brow0 + r) * sb + ks * 32 + kq);
        acc = __builtin_amdgcn_mfma_f32_16x16x32_bf16(a, b, acc, 0, 0, 0);
    }
    return acc;
}

__device__ __forceinline__ int gsw(int row) { return ((row >> 2) ^ (row >> 5)) & 7; }
__device__ __forceinline__ f32x4 tile_mm_sw(const LAS bf16* Am, int arow0, const LAS bf16* Bm, int brow0, f32x4 acc, int lane) {
    const int r = lane & 15, cq = lane >> 4, fa = gsw(arow0 + r), fb = gsw(brow0 + r);
#pragma unroll
    for (int ks = 0; ks < 2; ++ks) {
        const bf16x8_t a = *(const LAS bf16x8_t*)(Am + (arow0 + r) * GTS + (((ks * 4 + cq) ^ fa) << 3));
        const bf16x8_t b = *(const LAS bf16x8_t*)(Bm + (brow0 + r) * GTS + (((ks * 4 + cq) ^ fb) << 3));
        acc = __builtin_amdgcn_mfma_f32_16x16x32_bf16(a, b, acc, 0, 0, 0);
    }
    return acc;
}
__device__ __forceinline__ void gla1_unit(ArgsP A, const Frame& F_in, int l, int unit) {
    Frame F = F_in; asm volatile("" : "+v"(F.tid)); F.lane = F.tid & 63;
    const int bh = unit >> 6, c = unit & 63, b = bh >> 2, h = bh & 3, t0 = b * SEQ + c * 64, tid = F.tid, lane = F.lane, w = F.wave;
    const float* proj = (const float*)(A->ws + WS_PROJ);
    LAS float* bcum = (LAS float*)F.lds;
    LAS float* ad = bcum + 6144;
    LAS float* up = ad + 1024;
    LAS bf16* KtT = (LAS bf16*)(F.lds + 34816);
    LAS bf16* VT = (LAS bf16*)(F.lds + 48640);
    f32x4 qq[3], kq[3], vq[6];
#pragma unroll
    for (int it = 0; it < 3; ++it) { const int i = tid + it * NTHR, tok = i / 24, d4 = i % 24; const float* rp = proj + (size_t)(t0 + tok) * INWP + h * 96 + d4 * 4;
        qq[it] = *(const f32x4*)(rp + C_GQ); kq[it] = *(const f32x4*)(rp + C_GK); }
#pragma unroll
    for (int it = 0; it < 6; ++it) { const int i = tid + it * NTHR, tok = i / 48, e4 = i % 48; vq[it] = *(const f32x4*)(proj + (size_t)(t0 + tok) * INWP + C_GV + h * 192 + e4 * 4); }
    gla_bcum(A, F, l, h, t0, bcum, ad, up);
    const float qs = 0.10206207261596575f;
    bf16* Qg = (bf16*)(A->ws + WS_RSC + RWO_GQ) + (size_t)unit * 6144; bf16* Kg = (bf16*)(A->ws + WS_RSC + RWO_GK) + (size_t)unit * 6144;
#pragma unroll
    for (int it = 0; it < 3; ++it) { const int i = tid + it * NTHR, tok = i / 24, d = (i % 24) * 4;
        const float qv[4] = {qq[it].x, qq[it].y, qq[it].z, qq[it].w}, kv[4] = {kq[it].x, kq[it].y, kq[it].z, kq[it].w}; float qo[4], ko[4];
#pragma unroll
        for (int e = 0; e < 4; ++e) { const float m = bcum[31 * 96 + d + e], bb = bcum[tok * 96 + d + e];
            qo[e] = qv[e] * qs * __expf(bb - m); ko[e] = kv[e] * __expf(m - bb); KtT[(d + e) * GTS + ((((tok >> 3) ^ gsw(d + e)) << 3) | (tok & 7))] = (bf16)f2bf(ko[e]); }
        v2u pq, pk; pq.x = pk2(qo[0], qo[1]); pq.y = pk2(qo[2], qo[3]); pk.x = pk2(ko[0], ko[1]); pk.y = pk2(ko[2], ko[3]);
        *(v2u*)(Qg + tok * 96 + d) = pq; *(v2u*)(Kg + tok * 96 + d) = pk; }
#pragma unroll
    for (int it = 0; it < 6; ++it) { const int i = tid + it * NTHR, tok = i / 48, e = (i % 48) * 4;
        const int ts = tok >> 3, tl = tok & 7;
        VT[(e + 0) * GTS + (((ts ^ gsw(e + 0)) << 3) | tl)] = (bf16)f2bf(vq[it].x); VT[(e + 1) * GTS + (((ts ^ gsw(e + 1)) << 3) | tl)] = (bf16)f2bf(vq[it].y);
        VT[(e + 2) * GTS + (((ts ^ gsw(e + 2)) << 3) | tl)] = (bf16)f2bf(vq[it].z); VT[(e + 3) * GTS + (((ts ^ gsw(e + 3)) << 3) | tl)] = (bf16)f2bf(vq[it].w); }
    if (tid < 96) { ((float*)(A->ws + WS_RSC + RWO_GEM))[(size_t)unit * 96 + tid] = __expf(bcum[31 * 96 + tid]);
        ((float*)(A->ws + WS_GDEC))[(size_t)unit * 96 + tid] = __expf(bcum[63 * 96 + tid]); }
    __syncthreads();
    { bf16* VTg = (bf16*)(A->ws + WS_RSC + RWO_GVT) + (size_t)unit * 12288;
#pragma unroll
        for (int it = 0; it < 3; ++it) { const int i = tid + it * NTHR, e = i >> 3, t8 = (i & 7) * 8; *(v4u*)(VTg + e * 64 + t8) = *(const LAS v4u*)(VT + e * GTS + ((((i & 7) ^ gsw(e))) << 3)); } }
    { const int li = lane & 15, lq = lane >> 4;
        float* KVg = (float*)(A->ws + WS_GKV) + (size_t)unit * 18432;
#pragma unroll
        for (int a = 0; a < 3; ++a) { const int dt = (w & 1) * 3 + a, d0 = dt * 16 + lq * 4;
            const float s0 = __expf(bcum[63 * 96 + d0] - bcum[31 * 96 + d0]), s1 = __expf(bcum[63 * 96 + d0 + 1] - bcum[31 * 96 + d0 + 1]),
                        s2 = __expf(bcum[63 * 96 + d0 + 2] - bcum[31 * 96 + d0 + 2]), s3 = __expf(bcum[63 * 96 + d0 + 3] - bcum[31 * 96 + d0 + 3]);
#pragma unroll
            for (int bb = 0; bb < 3; ++bb) { const int et = (w >> 1) * 3 + bb; const f32x4 z = {0.f, 0.f, 0.f, 0.f};
                f32x4 acc = tile_mm_sw(KtT, dt * 16, VT, et * 16, z, lane);
                acc.x *= s0; acc.y *= s1; acc.z *= s2; acc.w *= s3;
                *(f32x4*)(KVg + (size_t)(et * 16 + li) * 96 + d0) = acc; } } }
    __syncthreads();
}

__device__ __forceinline__ void gla3_unit(ArgsP A, const Frame& F_in, int l, int unit) {
    Frame F = F_in; asm volatile("" : "+v"(F.tid)); F.lane = F.tid & 63;
    const int bh = unit >> 6, c = unit & 63, b = bh >> 2, h = bh & 3, t0 = b * SEQ + c * 64, tid = F.tid, lane = F.lane, w = F.wave;
    const int li = lane & 15, lq = lane >> 4;
    const float* proj = (const float*)(A->ws + WS_PROJ);
    LAS bf16* Qs = (LAS bf16*)F.lds;
    LAS bf16* Ks = (LAS bf16*)(F.lds + 13312);
    LAS bf16* VT = (LAS bf16*)(F.lds + 26624);
    LAS bf16* ST = (LAS bf16*)(F.lds + 54272);
    LAS bf16* att = (LAS bf16*)(F.lds + 94208);
    LAS float* ssq = (LAS float*)(F.lds + 103424);
    LAS float* em = (LAS float*)(F.lds + 103936);
    LAS float* ob = (LAS float*)(F.lds + 26624);
    {
        const v4u* Qg = (const v4u*)((const bf16*)(A->ws + WS_RSC + RWO_GQ) + (size_t)unit * 6144); const v4u* Kg = (const v4u*)((const bf16*)(A->ws + WS_RSC + RWO_GK) + (size_t)unit * 6144);
        const v4u* VTg = (const v4u*)((const bf16*)(A->ws + WS_RSC + RWO_GVT) + (size_t)unit * 12288);
        const f32x4* GS = (const f32x4*)((const float*)(A->ws + WS_GS) + (size_t)unit * 18432);
        v4u q0 = Qg[tid], k0 = Kg[tid], q1 = {0u, 0u, 0u, 0u}, k1 = {0u, 0u, 0u, 0u};
        if (tid < 256) { q1 = Qg[512 + tid]; k1 = Kg[512 + tid]; }
        v4u vt[3]; f32x4 sg[9];
#pragma unroll
        for (int it = 0; it < 3; ++it) vt[it] = VTg[tid + it * NTHR];
#pragma unroll
        for (int it = 0; it < 9; ++it) sg[it] = GS[tid + it * NTHR];
        if (tid < 96) em[tid] = ((const float*)(A->ws + WS_RSC + RWO_GEM))[(size_t)unit * 96 + tid];
        { const int i = tid, t = i / 12, c8 = (i % 12) * 8; *(LAS v4u*)(Qs + t * GQS + c8) = q0; *(LAS v4u*)(Ks + t * GQS + c8) = k0; }
        if (tid < 256) { const int i = 512 + tid, t = i / 12, c8 = (i % 12) * 8; *(LAS v4u*)(Qs + t * GQS + c8) = q1; *(LAS v4u*)(Ks + t * GQS + c8) = k1; }
#pragma unroll
        for (int it = 0; it < 3; ++it) { const int i = tid + it * NTHR, e = i >> 3, t8 = (i & 7) * 8; *(LAS v4u*)(VT + e * GTS + t8) = vt[it]; }
        __syncthreads();
#pragma unroll
        for (int it = 0; it < 9; ++it) { const int i = tid + it * NTHR, e = i / 24, d = (i % 24) * 4; const f32x4 m4 = *(const LAS f32x4*)(em + d);
            v2u pk; pk.x = pk2(sg[it].x * m4.x, sg[it].y * m4.y); pk.y = pk2(sg[it].z * m4.z, sg[it].w * m4.w); *(LAS v2u*)(ST + e * GQS + d) = pk; }
    }
    __syncthreads();
#pragma unroll
    for (int a = 0; a < 2; ++a) { const int jt = w >> 1, it = (w & 1) * 2 + a; const f32x4 z = {0.f, 0.f, 0.f, 0.f};
        f32x4 acc = z;
        if (jt <= it) acc = tile_mm<3>(Ks, GQS, jt * 16, Qs, GQS, it * 16, z, lane);
        const int i = it * 16 + li, j0 = jt * 16 + lq * 4;
        acc.x = (j0 + 0 <= i) ? acc.x : 0.f; acc.y = (j0 + 1 <= i) ? acc.y : 0.f; acc.z = (j0 + 2 <= i) ? acc.z : 0.f; acc.w = (j0 + 3 <= i) ? acc.w : 0.f;
        v2u pk; pk.x = pk2(acc.x, acc.y); pk.y = pk2(acc.z, acc.w); *(LAS v2u*)(att + i * GTS + j0) = pk; }
    __syncthreads();
    f32x4 o[6];
    { const int it = w >> 1;
#pragma unroll
        for (int a = 0; a < 6; ++a) { const int et = (w & 1) * 6 + a; const f32x4 z = {0.f, 0.f, 0.f, 0.f};
            f32x4 acc = tile_mm<2>(att, GTS, it * 16, VT, GTS, et * 16, z, lane);
            o[a] = tile_mm<3>(Qs, GQS, it * 16, ST, GQS, et * 16, acc, lane); }
        float s0 = 0.f, s1 = 0.f, s2 = 0.f, s3 = 0.f;
#pragma unroll
        for (int a = 0; a < 6; ++a) { s0 += o[a].x * o[a].x; s1 += o[a].y * o[a].y; s2 += o[a].z * o[a].z; s3 += o[a].w * o[a].w; }
        s0 = row16_sum(s0); s1 = row16_sum(s1); s2 = row16_sum(s2); s3 = row16_sum(s3);
        if (li == 0) { const int r0 = it * 16 + lq * 4; ssq[(r0 + 0) * 2 + (w & 1)] = s0; ssq[(r0 + 1) * 2 + (w & 1)] = s1; ssq[(r0 + 2) * 2 + (w & 1)] = s2; ssq[(r0 + 3) * 2 + (w & 1)] = s3; }
    }
    __syncthreads();
    { const int it = w >> 1, r0 = it * 16 + lq * 4;
#pragma unroll
        for (int a = 0; a < 6; ++a) { const int e = ((w & 1) * 6 + a) * 16 + li;
            ob[(r0 + 0) * 196 + e] = o[a].x; ob[(r0 + 1) * 196 + e] = o[a].y; ob[(r0 + 2) * 196 + e] = o[a].z; ob[(r0 + 3) * 196 + e] = o[a].w; } }
    __syncthreads();
    { bf16* Y = (bf16*)(A->ws + WS_Y);
        f32x4 gv[6];
#pragma unroll
        for (int k = 0; k < 6; ++k) { const int i = tid + k * NTHR, t = i / 48, e = (i % 48) * 4; gv[k] = *(const f32x4*)(proj + (size_t)(t0 + t) * INWP + C_GG + h * 192 + e); }
#pragma unroll
        for (int k = 0; k < 6; ++k) { const int i = tid + k * NTHR, t = i / 48, e = (i % 48) * 4;
            const float rstd = rsqrtf((ssq[t * 2] + ssq[t * 2 + 1]) * (1.f / 192.f) + NORM_EPS);
            const f32x4 ov = *(const LAS f32x4*)(ob + t * 196 + e); const f32x4 ng = *(const f32x4*)(A->in[10] + (size_t)l * 768 + h * 192 + e);
            f32x4 y; y.x = ov.x * rstd * ng.x * gv[k].x * sigmoidf_(gv[k].x); y.y = ov.y * rstd * ng.y * gv[k].y * sigmoidf_(gv[k].y);
            y.z = ov.z * rstd * ng.z * gv[k].z * sigmoidf_(gv[k].z); y.w = ov.w * rstd * ng.w * gv[k].w * sigmoidf_(gv[k].w);
            v2u pk; pk.x = pk2(y.x, y.y); pk.y = pk2(y.z, y.w); *(v2u*)(Y + (size_t)(t0 + t) * DM + 512 + h * 192 + e) = pk; } }
    __syncthreads();
}

#define INS16(L, P, x, px) do { { const bool c_ = (x) > L[15]; L[15] = c_ ? (x) : L[15]; P[15] = c_ ? (px) : P[15]; } \
    _Pragma("unroll") for (int r_ = 14; r_ >= 0; --r_) { const bool c_ = L[r_ + 1] > L[r_]; const float tl_ = L[r_]; const int tp_ = P[r_]; \
        L[r_] = c_ ? L[r_ + 1] : tl_; L[r_ + 1] = c_ ? tl_ : L[r_ + 1]; P[r_] = c_ ? P[r_ + 1] : tp_; P[r_ + 1] = c_ ? tp_ : P[r_ + 1]; } } while (0)

__device__ __forceinline__ float gelu_as(float v) {
    const float av = fabsf(v), t = __builtin_amdgcn_rcpf(av * 0.2316418882f + 1.0f);
    float q = t * 0.5307027145f + (-0.7265760135f); q = q * t + 0.7107068705f; q = q * t + (-0.142248368f); q = q * t + 0.127414796f; q = q * t;
    const float e = __builtin_amdgcn_exp2f((v * v) * (-0.72134752044f));
    const float m = v * (q * e);
    return v < 0.f ? m : v - m;
}
__device__ __forceinline__ int row16_sum_i(int v) {
    v += __builtin_amdgcn_update_dpp(0, v, 0xB1, 0xF, 0xF, true); v += __builtin_amdgcn_update_dpp(0, v, 0x4E, 0xF, 0xF, true);
    v += __builtin_amdgcn_update_dpp(0, v, 0x141, 0xF, 0xF, true); v += __builtin_amdgcn_update_dpp(0, v, 0x140, 0xF, 0xF, true); return v;
}
#ifndef PEER_SL_SHIFT
#define PEER_SL_SHIFT 10
#endif
__device__ __forceinline__ void ph_peer4(ArgsP A, LAS unsigned char* lds_, int wv_, int l, const float* g2, const float* sh2, const float* ngain, const float* nsh, const float* nsc, const bool last, const bool dry = false) {
    const Frame F = make_frame(lds_, wv_);
    const int lane = F.lane, li = lane & 15, lq = lane >> 4;
    const float* SCO = (const float*)(A->ws + WS_PROJ);
    const unsigned char* U4 = A->ws + WS_U + (size_t)l * PEER_N * (DM / 2); const unsigned char* V4 = A->ws + WS_V + (size_t)l * PEER_N * (DM / 2);
    const float* US = (const float*)(A->ws + WS_US) + (size_t)l * PEER_N; const float* VS = (const float*)(A->ws + WS_VS) + (size_t)l * PEER_N;
    float* X = (float*)(A->ws + WS_X); bf16* H = (bf16*)(A->ws + WS_H); const float* ssr = (const float*)(A->ws + WS_SSP) + (size_t)l * NT * 32;
    LAS unsigned char* wl = F.lds + F.wave * 15104;
    LAS int* es = (LAS int*)wl; LAS float* gs = (LAS float*)(wl + 4096);
    LAS v4u* hl = (LAS v4u*)wl;
    LAS int* se = (LAS int*)(wl + 8448);
    LAS float* sg = (LAS float*)(wl + 10496);
    LAS int* st = (LAS int*)(wl + 12544);
    LAS float* dl = (LAS float*)(wl + 14592);
    LAS float* hsl = dl + 64; LAS int* hsi = (LAS int*)(dl + 68);
    for (int tb = F.gw * 4; tb < NT; tb += F.ngw * 4) {
        {
            int P2[16]; float gt[16];
            const int prob = tb * 16 + lane, half = lane & 1;
            const f32x4* s4 = (const f32x4*)(SCO + (size_t)prob * 128);
            int KK[16];
#pragma unroll
            for (int r = 0; r < 16; ++r) KK[r] = (int)0x80000000;
            f32x4 nv[4];
#pragma unroll
            for (int i = 0; i < 4; ++i) nv[i] = s4[i];
#define KINS(x_, idx_) do { const int b_ = __builtin_bit_cast(int, (float)(x_)); int k_ = b_ ^ ((b_ >> 31) & 0x7fffffff); k_ = (k_ & ~127) | (127 - (idx_)); \
        _Pragma("unroll") for (int r_ = 0; r_ < 16; ++r_) { const int hi_ = KK[r_] > k_ ? KK[r_] : k_; k_ = KK[r_] > k_ ? k_ : KK[r_]; KK[r_] = hi_; } } while (0)
#pragma unroll 1
            for (int q = 0; q < 8; ++q) {
                f32x4 v[4];
#pragma unroll
                for (int i = 0; i < 4; ++i) v[i] = nv[i];
                if (q < 7) {
#pragma unroll
                    for (int i = 0; i < 4; ++i) nv[i] = s4[4 * (q + 1) + i]; }
                _Pragma("unroll") for (int r = 0; r < 16; ++r) asm volatile("" : "+v"(KK[r]));
#pragma unroll
                for (int i = 0; i < 4; ++i) { const int ib = 16 * q + 4 * i;
                    KINS(v[i].x, ib); KINS(v[i].y, ib + 1); KINS(v[i].z, ib + 2); KINS(v[i].w, ib + 3); }
            }
#undef KINS
            float L[16]; int P[16];
#pragma unroll
            for (int r = 0; r < 16; ++r) { P[r] = 127 - (KK[r] & 127); const int kv = KK[r] & ~127; L[r] = __builtin_bit_cast(float, kv ^ ((kv >> 31) & 0x7fffffff)); }
            float v1[16], v2[16]; int i1[16], i2[16];
#pragma unroll
            for (int r = 0; r < 16; ++r) { const float ol = dpp_xor1(L[r]); const int op = __builtin_amdgcn_update_dpp(0, P[r], 0xB1, 0xF, 0xF, true);
                v1[r] = half ? ol : L[r]; v2[r] = half ? L[r] : ol; i1[r] = half ? op : P[r]; i2[r] = half ? P[r] : op; }
            float L2[16];
#pragma unroll
            for (int r = 0; r < 16; ++r) { L2[r] = -3.0e38f; P2[r] = 0; }
#pragma unroll
            for (int a = 0; a < 16; ++a)
#pragma unroll
                for (int bq = 0; bq < 16; ++bq) if ((a + 1) * (bq + 1) <= 16) { const float cv = v1[a] + v2[bq]; const int ce = i1[a] * 128 + i2[bq]; INS16(L2, P2, cv, ce); }
            float sum = 0.f;
#pragma unroll
            for (int r = 0; r < 16; ++r) { gt[r] = __expf(L2[r] - L2[0]); sum += gt[r]; }
            const float inv = 1.f / sum;
#pragma unroll
            for (int r = 0; r < 16; ++r) { es[r * 64 + lane] = P2[r]; gs[r * 64 + lane] = gt[r] * inv; }
            asm volatile("s_waitcnt lgkmcnt(0)" ::: "memory");
        }
        {
            int ee[8]; float gg[8];
#pragma unroll
            for (int j = 0; j < 8; ++j) { const int x = j * 64 + lane, k = x >> 7, y = x & 127; ee[j] = es[(y & 15) * 64 + k * 16 + 2 * (y >> 4)]; gg[j] = gs[(y & 15) * 64 + k * 16 + 2 * (y >> 4)]; }
            int base = 0;
#pragma unroll
            for (int p = 0; p < 2; ++p) {
#pragma unroll 1
                for (int s = 0; s < (16384 >> PEER_SL_SHIFT); ++s) {
#pragma unroll
                    for (int jj = 0; jj < 4; ++jj) { const int j = p * 4 + jj; const bool in = (ee[j] >> PEER_SL_SHIFT) == s; const unsigned long long m = __builtin_amdgcn_ballot_w64(in);
                        if (in) { const int pos = base + (int)__builtin_amdgcn_mbcnt_hi((unsigned)(m >> 32), __builtin_amdgcn_mbcnt_lo((unsigned)m, 0u)); se[pos] = ee[j]; sg[pos] = gg[j]; st[pos] = j >> 1; }
                        base += __builtin_popcountll(m); }
                }
            }
        }
        asm volatile("s_waitcnt lgkmcnt(0)" ::: "memory");
#pragma unroll 1
        for (int k = 0; k < 4; ++k) {
            const int t = tb + k, b = t >> 12;
            float hf[32]; float mx = 0.f;
            const v4u* hp = (const v4u*)(H + (size_t)t * DM);
#pragma unroll
            for (int jj = 0; jj < 2; ++jj)
#pragma unroll
                for (int c = 0; c < 2; ++c) { const v4u hv = hp[(jj * 64 + lane) * 2 + c]; const int o = jj * 16 + c * 8;
                    hf[o + 0] = bflo(hv.x); hf[o + 1] = bfhi(hv.x); hf[o + 2] = bflo(hv.y); hf[o + 3] = bfhi(hv.y); hf[o + 4] = bflo(hv.z); hf[o + 5] = bfhi(hv.z); hf[o + 6] = bflo(hv.w); hf[o + 7] = bfhi(hv.w); }
            { const float rstd = rsqrtf(wave_sum(lane < 32 ? ssr[(size_t)t * 32 + lane] : 0.f) * (1.f / DM) + NORM_EPS);
#pragma unroll
                for (int jj = 0; jj < 2; ++jj)
#pragma unroll
                    for (int q = 0; q < 4; ++q) { const f32x4 s4 = *(const f32x4*)(sh2 + (size_t)b * MODW + (jj * 64 + lane) * 16 + 4 * q);
                        hf[jj * 16 + 4 * q] = hf[jj * 16 + 4 * q] * rstd + s4.x; hf[jj * 16 + 4 * q + 1] = hf[jj * 16 + 4 * q + 1] * rstd + s4.y;
                        hf[jj * 16 + 4 * q + 2] = hf[jj * 16 + 4 * q + 2] * rstd + s4.z; hf[jj * 16 + 4 * q + 3] = hf[jj * 16 + 4 * q + 3] * rstd + s4.w; } }
#pragma unroll
            for (int i = 0; i < 32; ++i) mx = fmaxf(mx, fabsf(hf[i]));
            mx = wave_max(mx);
            const float inv = mx > 0.f ? 127.f / mx : 0.f;
            if (lane == 0) hsl[k] = mx * (1.f / 127.f);
            int hsum = 0;
#pragma unroll
            for (int jj = 0; jj < 2; ++jj) { unsigned qd[4];
#pragma unroll
                for (int d = 0; d < 4; ++d) { const int o = jj * 16 + 4 * d; const int q0 = (int)rintf(hf[o] * inv), q1 = (int)rintf(hf[o + 1] * inv), q2 = (int)rintf(hf[o + 2] * inv), q3 = (int)rintf(hf[o + 3] * inv);
                    qd[d] = (unsigned)(q0 & 255) | ((unsigned)(q1 & 255) << 8) | ((unsigned)(q2 & 255) << 16) | ((unsigned)(q3 & 255) << 24); hsum += (q0 + q1) + (q2 + q3); }
                v4u q; q.x = qd[0]; q.y = qd[1]; q.z = qd[2]; q.w = qd[3]; hl[k * 132 + jj * 64 + lane] = q; }
            { hsum = row16_sum_i(hsum); const int hs_all = __builtin_amdgcn_readlane(hsum, 0) + __builtin_amdgcn_readlane(hsum, 16) + __builtin_amdgcn_readlane(hsum, 32) + __builtin_amdgcn_readlane(hsum, 48);
                if (lane == 0) hsi[k] = hs_all; }
        }
        asm volatile("s_waitcnt lgkmcnt(0)" ::: "memory");
        {
            v4i ub0[8], ub1[8];
            int lu = lane; asm volatile("" : "+v"(lu)); const int li = lu & 15, lq = lu >> 4;
            const LAS v4u* hb = hl + (li & 3) * 132 + lq;
#define ULOAD(buf, g_, sg_) do { const int my_e_ = se[(g_) * 16 + li]; const unsigned char* ub_ = U4 + (size_t)my_e_ * (DM / 2) + lq * 16 + (sg_) * 512; \
    _Pragma("unroll") for (int s8 = 0; s8 < 8; ++s8) buf[s8] = *(const v4i*)(ub_ + s8 * 64); } while (0)
#define UCONS(buf, sg_) do { _Pragma("unroll") for (int s8 = 0; s8 < 8; ++s8) { const int c_ = (sg_) * 8 + s8; \
        const v4i lo_ = buf[s8] & 0x0F0F0F0F, hi_ = (buf[s8] >> 4) & 0x0F0F0F0F; \
        const v4i hb0_ = *(const LAS v4i*)(hb + c_ * 4), hb1_ = *(const LAS v4i*)(hb + 64 + c_ * 4); \
        acc = __builtin_amdgcn_mfma_i32_16x16x64_i8(lo_, hb0_, acc, 0, 0, 0); acc = __builtin_amdgcn_mfma_i32_16x16x64_i8(hi_, hb1_, acc, 0, 0, 0); } } while (0)
            ULOAD(ub0, 0, 0);
#pragma unroll 1
            for (int g = 0; g < 32; ++g) {
                const int gn = g + 1 < 32 ? g + 1 : 31;
                v4i acc = {0, 0, 0, 0};
                ULOAD(ub1, g, 1);
                UCONS(ub0, 0); ULOAD(ub0, gn, 0);
                UCONS(ub1, 1);
                if (li < 4) { const int hc = 8 * hsi[li];
                    dl[(4 * lq + 0) * 4 + li] = (float)(acc.x - hc); dl[(4 * lq + 1) * 4 + li] = (float)(acc.y - hc); dl[(4 * lq + 2) * 4 + li] = (float)(acc.z - hc); dl[(4 * lq + 3) * 4 + li] = (float)(acc.w - hc); }
                if (lane < 16) { const int x = g * 16 + lane; const int e = se[x], tk = st[x];
                    sg[x] = sg[x] * VS[e] * gelu_as(dl[lane * 4 + tk] * (US[e] * hsl[tk])); }
            }
#undef ULOAD
#undef UCONS
        }
        asm volatile("s_waitcnt lgkmcnt(0)" ::: "memory");
#define PEER_EPILOGUE(kk_, kt_) do { const int t = tb + (kt_), b = t >> 12; float (&out_k)[32] = out[kk_]; \
            f32x4 xn[2][4]; float ss = 0.f; \
            const f32x4* xr = (const f32x4*)(X + (size_t)t * DM); const f32x4* gr = (const f32x4*)(g2 + (size_t)b * MODW); \
            _Pragma("unroll") \
            for (int jj = 0; jj < 2; ++jj) \
            _Pragma("unroll") \
                for (int q = 0; q < 4; ++q) { const int ix = (jj * 64 + lane) * 4 + q; const f32x4 xv = xr[ix], gv = gr[ix]; f32x4 o4; o4.x = out_k[jj * 16 + 4 * q]; o4.y = out_k[jj * 16 + 4 * q + 1]; o4.z = out_k[jj * 16 + 4 * q + 2]; o4.w = out_k[jj * 16 + 4 * q + 3]; \
                    const f32x4 y = xv + gv * o4; xn[jj][q] = y; ss += (y.x * y.x + y.y * y.y) + (y.z * y.z + y.w * y.w); } \
            const float rstd = rsqrtf(wave_sum(ss) * (1.f / DM) + NORM_EPS); \
            if (!last) { \
                f32x4* xw = (f32x4*)((dry ? (float*)(A->ws + WS_DUMMY) : X) + (size_t)t * DM); v4u* hw = (v4u*)((dry ? (bf16*)(A->ws + WS_DUMMY + 64 * MiB) : H) + (size_t)t * DM); \
            _Pragma("unroll") \
                for (int jj = 0; jj < 2; ++jj) { f32x4 y[4]; \
            _Pragma("unroll") \
                    for (int q = 0; q < 4; ++q) { const int ix = (jj * 64 + lane) * 4 + q; xw[ix] = xn[jj][q]; \
                        const f32x4 g = ((const f32x4*)ngain)[ix], s1 = ((const f32x4*)(nsc + (size_t)b * MODW))[ix], s0 = ((const f32x4*)(nsh + (size_t)b * MODW))[ix]; \
                        y[q] = xn[jj][q] * rstd * g * (s1 + 1.f) + s0; } \
                    v4u o; o.x = pk2(y[0].x, y[0].y); o.y = pk2(y[0].z, y[0].w); o.z = pk2(y[1].x, y[1].y); o.w = pk2(y[1].z, y[1].w); hw[(jj * 64 + lane) * 2] = o; \
                    o.x = pk2(y[2].x, y[2].y); o.y = pk2(y[2].z, y[2].w); o.z = pk2(y[3].x, y[3].y); o.w = pk2(y[3].z, y[3].w); hw[(jj * 64 + lane) * 2 + 1] = o; } \
            } else { \
                f32x4* ow = (f32x4*)((dry ? (float*)(A->ws + WS_DUMMY) : A->out) + (size_t)t * DM); \
            _Pragma("unroll") \
                for (int jj = 0; jj < 2; ++jj) \
            _Pragma("unroll") \
                    for (int q = 0; q < 4; ++q) { const int ix = (jj * 64 + lane) * 4 + q; ow[ix] = xn[jj][q] * rstd * ((const f32x4*)ngain)[ix]; } \
            } \
        } while (0)
#define VLOAD(buf, cfb, tkb, bi_) do { _Pragma("unroll") for (int i = 0; i < 4; ++i) { const int x_ = (bi_) * 4 + i; const int e_ = __builtin_amdgcn_readfirstlane(se[x_]); \
        cfb[i] = __builtin_bit_cast(float, __builtin_amdgcn_readfirstlane(__builtin_bit_cast(int, sg[x_]))); tkb[i] = __builtin_amdgcn_readfirstlane(st[x_]) & 1; \
        const v2u* vp_ = (const v2u*)(V4 + (size_t)e_ * (DM / 2)) + lane_v; buf[i][0] = vp_[0]; buf[i][1] = vp_[64]; } } while (0)
#define VACC(kk_, bv_, cv_) do { const f32x2 c2_ = {cv_, cv_}; \
        _Pragma("unroll") for (int jj = 0; jj < 2; ++jj) { const unsigned wd_[2] = {bv_[jj].x, bv_[jj].y}; \
            _Pragma("unroll") for (int d = 0; d < 2; ++d) { const int o_ = jj * 16 + 8 * d; \
                const f32x2 f0_ = __builtin_amdgcn_cvt_scalef32_pk_f32_fp4((int)wd_[d], 1.0f, 0), f1_ = __builtin_amdgcn_cvt_scalef32_pk_f32_fp4((int)wd_[d], 1.0f, 1), \
                            f2_ = __builtin_amdgcn_cvt_scalef32_pk_f32_fp4((int)wd_[d], 1.0f, 2), f3_ = __builtin_amdgcn_cvt_scalef32_pk_f32_fp4((int)wd_[d], 1.0f, 3); \
                f32x2 a0_ = {out[kk_][o_], out[kk_][o_ + 1]}, a1_ = {out[kk_][o_ + 2], out[kk_][o_ + 3]}, a2_ = {out[kk_][o_ + 4], out[kk_][o_ + 5]}, a3_ = {out[kk_][o_ + 6], out[kk_][o_ + 7]}; \
                a0_ = __builtin_elementwise_fma(c2_, f0_, a0_); a1_ = __builtin_elementwise_fma(c2_, f1_, a1_); a2_ = __builtin_elementwise_fma(c2_, f2_, a2_); a3_ = __builtin_elementwise_fma(c2_, f3_, a3_); \
                out[kk_][o_] = a0_.x; out[kk_][o_ + 1] = a0_.y; out[kk_][o_ + 2] = a1_.x; out[kk_][o_ + 3] = a1_.y; out[kk_][o_ + 4] = a2_.x; out[kk_][o_ + 5] = a2_.y; out[kk_][o_ + 6] = a3_.x; out[kk_][o_ + 7] = a3_.y; } } } while (0)
#define VCONS(buf, cfb, tkb) do { _Pragma("unroll") for (int i = 0; i < 4; ++i) { if (tkb[i] == 0) VACC(0, buf[i], cfb[i]); else VACC(1, buf[i], cfb[i]); } } while (0)
#pragma unroll 1
        for (int p = 0; p < 2; ++p) {
            int lane_v = F.lane; asm volatile("" : "+v"(lane_v));
            float out[2][32];
#pragma unroll
            for (int k = 0; k < 2; ++k)
#pragma unroll
                for (int i = 0; i < 32; ++i) out[k][i] = 0.f;
            {
                v2u vb0[4][2], vb1[4][2]; float c0[4], c1[4]; int t0v[4], t1v[4];
                const int bb = p * 64;
                VLOAD(vb0, c0, t0v, bb); VLOAD(vb1, c1, t1v, bb + 1);
#pragma unroll 1
                for (int bi = 0; bi < 64; bi += 2) {
                    const int b2 = bb + (bi + 2 < 64 ? bi + 2 : 62), b3 = bb + (bi + 3 < 64 ? bi + 3 : 63);
                    VCONS(vb0, c0, t0v); VLOAD(vb0, c0, t0v, b2);
                    VCONS(vb1, c1, t1v); VLOAD(vb1, c1, t1v, b3);
                }
            }
            PEER_EPILOGUE(0, 2 * p); PEER_EPILOGUE(1, 2 * p + 1);
        }
#undef VLOAD
#undef VACC
#undef VCONS
#undef PEER_EPILOGUE
    }
}

__device__ __forceinline__ void PH_norm1_l0(LAS unsigned char* lds, int wv) { ArgsP A = args_ptr(); const float* MOD = (const float*)(A->ws + WS_MOD);
    ph_norm(A->in[0], A->in[4], MOD + 0 * DM, MOD + 1 * DM, (bf16*)(A->ws + WS_H), lds, wv);
    { const Frame F = make_frame(lds, wv); float* B3 = (float*)(A->ws + WS_BIAS3);
        for (int o = F.gw; o < DEPTH * 2 * DM; o += F.ngw) { const int l = o >> 12, b = (o >> 11) & 1, n = o & 2047;
            const float* sh = MOD + (size_t)(l * 2 + b) * MODW + 3 * DM; const v4u* wr = (const v4u*)((const bf16*)(A->ws + WS_WQK) + ((size_t)l * DM + n) * DM);
            float s = 0.f;
#pragma unroll
            for (int j = 0; j < 4; ++j) { const v4u wv4 = wr[j * 64 + F.lane]; const f32x4 s0 = *(const f32x4*)(sh + (j * 64 + F.lane) * 8), s1 = *(const f32x4*)(sh + (j * 64 + F.lane) * 8 + 4);
                s += bflo(wv4.x) * s0.x + bfhi(wv4.x) * s0.y + bflo(wv4.y) * s0.z + bfhi(wv4.y) * s0.w + bflo(wv4.z) * s1.x + bfhi(wv4.z) * s1.y + bflo(wv4.w) * s1.z + bfhi(wv4.w) * s1.w; }
            s = wave_sum(s);
            if (F.lane == 0) B3[o] = s; } } }
__device__ __forceinline__ void PH_gemm1(LAS unsigned char* lds, int wv, int l_) { ArgsP A = args_ptr(); const int l = opaque_i(l_);
    pg8::Gemm g{(const bf16*)(A->ws + WS_H), (const bf16*)(A->ws + WS_WIN) + (size_t)l * INWP * DM, NT, INWP, DM}; pg8::StaticOrder S; S.init(NT, INWP, gridDim.x, blockIdx.x);
    EpiStoreF32 E{(float*)(A->ws + WS_PROJ), INWP, wv};
    pg8::gemm_phase<EpiStoreF32, pg8::StaticOrder, true, true>(lds, g, S, E, wv); }
__device__ __forceinline__ void PH_mixA(LAS unsigned char* lds, int wv, int l_) { ArgsP A = args_ptr(); const int l = opaque_i(l_);
    const Frame F = make_frame(lds, wv);
#ifdef PROBE_A
    for (int u = F.bid; u < 2048; u += F.G) {
        if (u < 1536) { if (PROBE_A == 1) rwkvA_unit(A, F, l, u); }
        else { if (PROBE_A == 2) gla1_unit(A, F, l, u - 1536); }
    }
#endif
    for (int u = F.bid; u < 2048; u += F.G) {
        if (u < 1536) rwkvA_unit(A, F, l, u);
        else gla1_unit(A, F, l, u - 1536);
    }
    if (l + 1 < DEPTH) quant_tables(A, l + 1, F.gw, F.ngw, F.lane);
}
__device__ __forceinline__ void PH_mixB(LAS unsigned char* lds, int wv, int l_) { ArgsP A = args_ptr(); const int l = opaque_i(l_);
    const Frame F = make_frame(lds, wv);
    if (F.G >= 192) {
        if (F.bid < 96) rwkvB_scan(A, F, F.bid);
        else { const int nb = F.G - 96, b2 = F.bid - 96;
            for (int u = b2; u < 288; u += nb) gla_scan_unit(A, F, u);
            for (int u = b2; u < 1024; u += nb) pool_unit(A, F, l, u); }
    } else {
        for (int u = F.bid; u < 288; u += F.G) gla_scan_unit(A, F, u);
        for (int u = F.bid; u < 1024; u += F.G) pool_unit(A, F, l, u);
        for (int u = F.bid; u < 96; u += F.G) rwkvB_scan(A, F, u);
    } }
__device__ __forceinline__ void PH_mixC(LAS unsigned char* lds, int wv, int l_) { ArgsP A = args_ptr(); const int l = opaque_i(l_);
    const Frame F = make_frame(lds, wv);
#ifdef PROBE_C
    for (int u = F.bid; u < 2048; u += F.G) { if (u < 512) { if (PROBE_C == 1) gla3_unit(A, F, l, u); } else { if (PROBE_C == 2) rwkvC_unit(A, F, l, u - 512); } }
#endif
    for (int u = F.bid; u < 2048; u += F.G) { if (u < 512) gla3_unit(A, F, l, u); else rwkvC_unit(A, F, l, u - 512); } }
__device__ __forceinline__ void PH_gemm2(LAS unsigned char* lds, int wv, int l_, bool dry = false) { ArgsP A = args_ptr(); const int l = opaque_i(l_);
    const float* modl = (const float*)(A->ws + WS_MOD) + (size_t)l * 2 * MODW; float* X = (float*)(A->ws + WS_X);
    pg8::Gemm g{(const bf16*)(A->ws + WS_Y), (const bf16*)(A->ws + WS_WOUT) + (size_t)l * DM * DM, NT, DM, DM}; pg8::StaticOrder S; S.init(NT, DM, gridDim.x, blockIdx.x);
    EpiResid E{(l == 0) ? A->in[0] : (const float*)X, dry ? (float*)(A->ws + WS_DUMMY) : X, modl + 2 * DM, wv, A->in[23] + (size_t)l * DM, modl + 4 * DM,
               dry ? (bf16*)(A->ws + WS_DUMMY + 64 * MiB) : (bf16*)(A->ws + WS_H), (dry ? (float*)(A->ws + WS_DUMMY) : (float*)(A->ws + WS_SSP) + (size_t)l * NT * 32)};
    pg8::gemm_phase<EpiResid, pg8::StaticOrder, true, true>(lds, g, S, E, wv); }
__device__ __forceinline__ void PH_norm2(LAS unsigned char* lds, int wv, int l_) { ArgsP A = args_ptr(); const int l = opaque_i(l_);
    const float* modl = (const float*)(A->ws + WS_MOD) + (size_t)l * 2 * MODW;
    ph_norm((const float*)(A->ws + WS_X), A->in[23] + (size_t)l * DM, modl + 3 * DM, modl + 4 * DM, (bf16*)(A->ws + WS_H), lds, wv); }
__device__ __forceinline__ void PH_gemm3(LAS unsigned char* lds, int wv, int l_) { ArgsP A = args_ptr(); const int l = opaque_i(l_);
    pg8::Gemm g{(const bf16*)(A->ws + WS_H), (const bf16*)(A->ws + WS_WQK) + (size_t)l * DM * DM, NT, DM, DM}; pg8::StaticOrder S; S.init(NT, DM, gridDim.x, blockIdx.x);
    LAS float* rs = (LAS float*)(lds + 131072);
    { pg8::Unit u0; const int t = tid_from(wv); if (S.next(0, u0) && t < 256) { const f32x4* sp = (const f32x4*)((const float*)(A->ws + WS_SSP) + ((size_t)l * NT + u0.pm * 256 + t) * 32); float s = 0.f;
#pragma unroll
            for (int j = 0; j < 8; ++j) { const f32x4 v = sp[j]; s += (v.x + v.y) + (v.z + v.w); }
            rs[t] = rsqrtf(s * (1.f / DM) + NORM_EPS); }
        __syncthreads(); }
    EpiScore E{(float*)(A->ws + WS_PROJ), DM, wv, rs, (const float*)(A->ws + WS_BIAS3) + (size_t)l * 2 * DM};
    pg8::gemm_phase<EpiScore, pg8::StaticOrder, true, true>(lds, g, S, E, wv); }
__device__ __forceinline__ void PH_peer(LAS unsigned char* lds, int wv, int l_, bool dry = false) { ArgsP A = args_ptr(); const int l = opaque_i(l_);
    const float* MOD = (const float*)(A->ws + WS_MOD); const float* modl = MOD + (size_t)l * 2 * MODW;
    const bool last = (l == DEPTH - 1);
    const float* nmod = MOD + (size_t)(last ? l : l + 1) * 2 * MODW;
    ph_peer4(A, lds, wv, l, modl + 5 * DM, modl + 3 * DM, last ? A->in[29] : A->in[4] + (size_t)(l + 1) * DM, nmod + 0 * DM, nmod + 1 * DM, last, dry); }

__global__ void __launch_bounds__(NTHR, 2) mega_fwd(Args args) {
    extern __shared__ __attribute__((aligned(16))) unsigned char lds_raw[];
    LAS unsigned char* lds = (LAS unsigned char*)lds_raw;
    volatile LAS unsigned* MISC = (volatile LAS unsigned*)(lds + MISC_OFF);
    const int wv = __builtin_amdgcn_readfirstlane((int)(threadIdx.x >> 6));
    if (wv == 0) MISC[lane_id_()] = 0u;
    __syncthreads();
    XcdBarrier bar = xcd_barrier_post((unsigned*)(args_ptr()->ws + WS_CTL) + CW_BAR, MISC + 8, wv);
#define GRID_BAR() do { XcdBarrier b_ = bar; b_.bar = (unsigned*)(args_ptr()->ws + WS_CTL) + CW_BAR; asm volatile("" : "+s"(b_.x), "+s"(b_.w)); xcd_barrier(b_); if (PROBE & 512) xcd_barrier(b_); } while (0)

    ph_prologue(args_ptr(), lds, wv);
    GRID_BAR();
#if PROBE & 1
    ph_prologue(args_ptr(), lds, wv); GRID_BAR();
#endif
    PH_norm1_l0(lds, wv);
    GRID_BAR();
    for (int l = 0; l < DEPTH; ++l) {
#if PROBE & 2
        PH_gemm1(lds, wv, l); GRID_BAR();
#endif
        PH_gemm1(lds, wv, l); GRID_BAR();
#if PROBE & 4
        PH_mixA(lds, wv, l);  GRID_BAR();
#endif
        PH_mixA(lds, wv, l);  GRID_BAR();
#if PROBE & 8
        PH_mixB(lds, wv, l);  GRID_BAR();
#endif
        PH_mixB(lds, wv, l);  GRID_BAR();
#if PROBE & 16
        PH_mixC(lds, wv, l);  GRID_BAR();
#endif
        PH_mixC(lds, wv, l);  GRID_BAR();
#if PROBE & 32
        PH_gemm2(lds, wv, l, true); GRID_BAR();
#endif
        PH_gemm2(lds, wv, l); GRID_BAR();
#if PROBE & 128
        PH_gemm3(lds, wv, l); GRID_BAR();
#endif
        PH_gemm3(lds, wv, l); GRID_BAR();
#if PROBE & 256
        PH_peer(lds, wv, l, true); GRID_BAR();
#endif
        PH_peer(lds, wv, l);
        if (l + 1 < DEPTH) GRID_BAR();
    }
}

extern "C" void kernel_launch(void* const* d_in, const int* in_sizes, int n_in, void* d_out, int out_size, void* d_ws, size_t ws_size, hipStream_t stream) {
    static int grid = 0;
    if (grid == 0) {
        if (n_in != 30 || out_size != NT * DM || ws_size < WS_END + 96 * MiB) { fprintf(stderr, "kernel_launch: unexpected shapes (n_in %d out %d ws %zu)\n", n_in, out_size, ws_size); grid = -1; return; }
        int dev = 0, cus = 0, per_cu = 0;
        if (hipGetDevice(&dev) != hipSuccess || hipDeviceGetAttribute(&cus, hipDeviceAttributeMultiprocessorCount, dev) != hipSuccess) { grid = -1; return; }
        if (hipFuncSetAttribute((const void*)mega_fwd, hipFuncAttributeMaxDynamicSharedMemorySize, LDS_BYTES) != hipSuccess) { fprintf(stderr, "kernel_launch: hipFuncSetAttribute failed\n"); grid = -1; return; }
        if (hipOccupancyMaxActiveBlocksPerMultiprocessor(&per_cu, (const void*)mega_fwd, NTHR, LDS_BYTES) != hipSuccess || per_cu < 1) { fprintf(stderr, "kernel_launch: occupancy query says %d\n", per_cu); (void)hipGetLastError(); per_cu = 1; }
        grid = cus;
    }
    if (grid < 0) return;
    (void)in_sizes;
    if (hipMemsetAsync((char*)d_ws + WS_CTL, 0, CTL_ZERO_BYTES, stream) != hipSuccess) return;
    Args a{};
    for (int i = 0; i < 30; ++i) a.in[i] = (const float*)d_in[i];
    a.out = (float*)d_out; a.ws = (unsigned char*)d_ws;
    hipLaunchKernelGGL(mega_fwd, dim3(grid), dim3(NTHR), LDS_BYTES, stream, a);
}
```

```cpp
#include <hip/hip_runtime.h>
#include <cstdio>
#include <cstdint>
__device__ __forceinline__ int lane_id_() { int r; asm volatile("v_mbcnt_lo_u32_b32 %0, -1, 0\n\tv_mbcnt_hi_u32_b32 %0, -1, %0" : "=v"(r)); return r; }
__device__ __forceinline__ int tid_from(int wave_s) { return wave_s * 64 + lane_id_(); }
namespace pg8 {
#define PG8_LAS __attribute__((address_space(3)))
typedef unsigned short bf16_t;
typedef short bf16x8 __attribute__((ext_vector_type(8)));
typedef float f32x4 __attribute__((ext_vector_type(4)));
typedef unsigned u32x4 __attribute__((ext_vector_type(4)));
constexpr int BM = 256, BK = 64, HALF = 128, HTB = HALF * BK * 2  , STAGE_BYTES = 8 * HTB, NXCD = 8, WGM = 8;

__host__ __device__ __forceinline__ int lds_byte(int r, int c) { const int st = (r >> 4) * 2 + (c >> 5), rr = r & 15, cc = c & 31, ob = rr * 64 + cc * 2; return st * 1024 + (ob ^ (((ob >> 9) & 1) << 5)); }
__host__ __device__ __forceinline__ void stage_rc(int b, int& R, int& C) { const int st = b / 1024, sb = b % 1024, swz = sb ^ (((sb >> 9) & 1) << 5); R = (st >> 1) * 16 + swz / 64; C = (st & 1) * 32 + (swz % 64) / 2; }
__host__ __device__ __forceinline__ int perm32(int rho) { const int n = rho >> 4, i = rho & 15; return 8 * (i >> 2) + 4 * n + (i & 3); }

struct Unit { int pm, pn; };
struct Gemm { const bf16_t* A; const bf16_t* Bt; int M, N, K; };

struct StaticOrder {
    int nM, nN, nwg, G, c;
    __host__ __device__ void init(int M, int N, int G_, int c_) { nM = M / BM; nN = N / BM; nwg = nM * nN; G = G_; c = c_; }
    __host__ __device__ bool next(int i, Unit& u) const {
        const long L = (long)i * G + c; if (L >= nwg) return false;
        int wgid = (int)L; { const int q = nwg / NXCD, r = nwg % NXCD, xcd = wgid % NXCD, off = wgid / NXCD; wgid = (xcd < r ? xcd * (q + 1) : r * (q + 1) + (xcd - r) * q) + off; }
        const int nig = WGM * nN, gid = wgid / nig, fm = gid * WGM, gsz = (nM - fm) < WGM ? (nM - fm) : WGM;
        u.pm = fm + ((wgid % nig) % gsz); u.pn = (wgid % nig) / gsz; return true;
    }
    __device__ __forceinline__ void a_ready(const Unit&) const {}
    __device__ __forceinline__ void done(const Unit&) const {}
};

template <class Epi, class Sched, bool ALIGN_EPI = false, bool SP2 = false>
__device__ __forceinline__ void gemm_phase(PG8_LAS unsigned char* lds, const Gemm g, const Sched& S, const Epi& E, int wave_s) {
    int tid_o = tid_from(wave_s); asm volatile("" : "+v"(tid_o));
    const int tid = tid_o, wid = __builtin_amdgcn_readfirstlane(tid >> 6), lane = tid & 63, wr = wid >> 2, wc = wid & 3, fr = lane & 15, fq = lane >> 4;
    const int K = g.K, nt = K / BK;
    unsigned voffA[2], voffB[2];
#pragma unroll
    for (int i = 0; i < 2; ++i) { int R, C; stage_rc(tid * 16 + i * 8192, R, C); const int Rb = Epi::PERM ? ((R & ~31) + perm32(R & 31)) : R;
        voffA[i] = (unsigned)(R * K + C) * 2u; voffB[i] = (unsigned)(Rb * K + C) * 2u; }
    const size_t kstep = (size_t)(BK * 2);
    const size_t hstep = (size_t)HALF * K * 2;
    const size_t tstep = 2 * hstep;
    const unsigned ldsw = (unsigned)wid * 1024u;
    const int aoff = lds_byte(wr * 64 + fr, fq * 8), boff = lds_byte(wc * 32 + fr, fq * 8);
#define PG8_SA(b, h) (((b) * 2 + (h)) * HTB)
#define PG8_SB(b, h) ((4 + (b) * 2 + (h)) * HTB)
#define PG8_STAGE(bufoff, gbase, voff) do { _Pragma("unroll") for (int _i = 0; _i < 2; ++_i) \
        __builtin_amdgcn_global_load_lds((const unsigned*)((const char*)(gbase) + (voff)[_i]), (PG8_LAS unsigned*)(lds + (bufoff) + ldsw + _i * 8192), 16, 0, 0); } while (0)
#define PG8_LDA(dst, b, h) do { _Pragma("unroll") for (int m = 0; m < 4; ++m) _Pragma("unroll") for (int k = 0; k < 2; ++k) dst[m][k] = *(const PG8_LAS bf16x8*)(lds + PG8_SA(b, h) + aoff + m * 2048 + k * 1024); } while (0)
#define PG8_LDB(dst, b, h) do { _Pragma("unroll") for (int n = 0; n < 2; ++n) _Pragma("unroll") for (int k = 0; k < 2; ++k) dst[n][k] = *(const PG8_LAS bf16x8*)(lds + PG8_SB(b, h) + boff + n * 2048 + k * 1024); } while (0)
#define PG8_MMA(ai, bj, At, Bt) do { __builtin_amdgcn_s_setprio(1); _Pragma("unroll") for (int m = 0; m < 4; ++m) _Pragma("unroll") for (int n = 0; n < 2; ++n) _Pragma("unroll") for (int k = 0; k < 2; ++k) \
        acc[ai][bj][m][n] = __builtin_amdgcn_mfma_f32_16x16x32_bf16(Bt[n][k], At[m][k], acc[ai][bj][m][n], 0, 0, 0); __builtin_amdgcn_s_setprio(0); } while (0)
#define PG8_WAIT_V(n) asm volatile("s_waitcnt vmcnt(" #n ")" ::: "memory")
#define PG8_WAIT_L(n) asm volatile("s_waitcnt lgkmcnt(" #n ")" ::: "memory")
#define PG8_BAR __builtin_amdgcn_s_barrier()
#define PG8_SCHED __builtin_amdgcn_sched_barrier(0)
    Unit cur, nxt; int ui = 0;
    if (!S.next(0, cur)) return;
    f32x4 acc[2][2][4][2];
#pragma unroll
    for (int a = 0; a < 2; ++a)
#pragma unroll
        for (int b = 0; b < 2; ++b)
#pragma unroll
            for (int m = 0; m < 4; ++m)
#pragma unroll
                for (int n = 0; n < 2; ++n) acc[a][b][m][n] = (f32x4){0.f, 0.f, 0.f, 0.f};
    bf16x8 At[4][2], B0[2][2], B1[2][2];
    const char* cA = (const char*)g.A + (size_t)cur.pm * tstep; const char* cB = (const char*)g.Bt + (size_t)cur.pn * tstep;
    S.a_ready(cur);
    if constexpr (SP2) {
        PG8_STAGE(PG8_SB(0, 0), cB, voffB); PG8_STAGE(PG8_SB(0, 1), cB + hstep, voffB); PG8_STAGE(PG8_SA(0, 0), cA, voffA); PG8_STAGE(PG8_SA(0, 1), cA + hstep, voffA);
        if (wr == 1) PG8_BAR;
        PG8_WAIT_V(2); PG8_BAR;
        PG8_STAGE(PG8_SB(1, 0), cB + kstep, voffB); PG8_STAGE(PG8_SA(1, 0), cA + kstep, voffA); PG8_STAGE(PG8_SB(1, 1), cB + hstep + kstep, voffB);
        PG8_WAIT_V(6); PG8_BAR;
    } else {
        PG8_STAGE(PG8_SB(0, 0), cB, voffB); PG8_STAGE(PG8_SA(0, 0), cA, voffA); PG8_STAGE(PG8_SB(0, 1), cB + hstep, voffB); PG8_STAGE(PG8_SA(0, 1), cA + hstep, voffA);
        if (wr == 1) PG8_BAR;
        PG8_WAIT_V(4); PG8_BAR;
        PG8_STAGE(PG8_SB(1, 0), cB + kstep, voffB); PG8_STAGE(PG8_SA(1, 0), cA + kstep, voffA); PG8_STAGE(PG8_SB(1, 1), cB + hstep + kstep, voffB);
        PG8_WAIT_V(6); PG8_BAR;
    }
    for (;;) {
        const bool has_next = S.next(ui + 1, nxt);
        const char* nA = has_next ? (const char*)g.A + (size_t)nxt.pm * tstep : cA; const char* nB = has_next ? (const char*)g.Bt + (size_t)nxt.pn * tstep : cB;
        for (int t = 0; t < nt; t += 2) {
            const bool last = (t == nt - 2);
            const char* a1 = cA + (size_t)(t + 1) * kstep;
            const char* a2 = last ? nA : cA + (size_t)(t + 2) * kstep; const char* b2 = last ? nB : cB + (size_t)(t + 2) * kstep;
            const char* a3 = a2 + kstep; const char* b3 = b2 + kstep;
            if (last && has_next) S.a_ready(nxt);
            if constexpr (SP2) {
            PG8_LDB(B0, 0, 0); PG8_LDB(B1, 0, 1); PG8_SCHED; PG8_LDA(At, 0, 0); PG8_STAGE(PG8_SA(1, 1), a1 + hstep, voffA);
            PG8_WAIT_V(8); PG8_WAIT_L(0); PG8_BAR; PG8_MMA(0, 0, At, B0); PG8_MMA(0, 1, At, B1); PG8_BAR; PG8_SCHED;
            PG8_LDA(At, 0, 1); PG8_STAGE(PG8_SB(0, 0), b2, voffB); PG8_STAGE(PG8_SB(0, 1), b2 + hstep, voffB); PG8_STAGE(PG8_SA(0, 0), a2, voffA);
            PG8_WAIT_V(8); PG8_WAIT_L(0); PG8_BAR; PG8_MMA(1, 0, At, B0); PG8_MMA(1, 1, At, B1); PG8_BAR; PG8_SCHED;
            PG8_LDB(B0, 1, 0); PG8_LDB(B1, 1, 1); PG8_SCHED; PG8_LDA(At, 1, 0); PG8_STAGE(PG8_SA(0, 1), a2 + hstep, voffA);
            PG8_WAIT_V(8); PG8_WAIT_L(0); PG8_BAR; PG8_MMA(0, 0, At, B0); PG8_MMA(0, 1, At, B1); PG8_BAR; PG8_SCHED;
            PG8_LDA(At, 1, 1); PG8_STAGE(PG8_SB(1, 0), b3, voffB); PG8_STAGE(PG8_SB(1, 1), b3 + hstep, voffB); PG8_STAGE(PG8_SA(1, 0), a3, voffA);
            PG8_WAIT_V(8); PG8_WAIT_L(0); PG8_BAR; PG8_MMA(1, 0, At, B0); PG8_MMA(1, 1, At, B1); PG8_BAR; PG8_SCHED;
            } else {
            PG8_LDB(B0, 0, 0); PG8_SCHED; PG8_LDA(At, 0, 0); PG8_STAGE(PG8_SA(1, 1), a1 + hstep, voffA);
            PG8_WAIT_L(8); PG8_BAR; PG8_WAIT_L(0); PG8_MMA(0, 0, At, B0); PG8_BAR; PG8_SCHED;
            PG8_LDB(B1, 0, 1); PG8_STAGE(PG8_SB(0, 0), b2, voffB);
            PG8_BAR; PG8_WAIT_L(0); PG8_MMA(0, 1, At, B1); PG8_BAR;
            PG8_LDA(At, 0, 1); PG8_STAGE(PG8_SA(0, 0), a2, voffA);
            PG8_BAR; PG8_WAIT_L(0); PG8_MMA(1, 0, At, B0); PG8_BAR; PG8_SCHED;
            PG8_STAGE(PG8_SB(0, 1), b2 + hstep, voffB);
            PG8_WAIT_V(6); PG8_BAR; PG8_MMA(1, 1, At, B1); PG8_BAR;
            PG8_LDB(B0, 1, 0); PG8_SCHED; PG8_LDA(At, 1, 0); PG8_STAGE(PG8_SA(0, 1), a2 + hstep, voffA);
            PG8_WAIT_L(8); PG8_BAR; PG8_WAIT_L(0); PG8_MMA(0, 0, At, B0); PG8_BAR; PG8_SCHED;
            PG8_LDB(B1, 1, 1); PG8_STAGE(PG8_SB(1, 0), b3, voffB);
            PG8_BAR; PG8_WAIT_L(0); PG8_MMA(0, 1, At, B1); PG8_BAR;
            PG8_LDA(At, 1, 1); PG8_STAGE(PG8_SA(1, 0), a3, voffA);
            PG8_BAR; PG8_WAIT_L(0); PG8_MMA(1, 0, At, B0); PG8_BAR; PG8_SCHED;
            PG8_STAGE(PG8_SB(1, 1), b3 + hstep, voffB);
            PG8_WAIT_V(6); PG8_BAR; PG8_MMA(1, 1, At, B1); PG8_BAR;
            }
        }
        if constexpr (ALIGN_EPI) { if (wr == 0) PG8_BAR; }
        if constexpr (!Epi::AFTER_DRAIN) { E(acc, cur, wr, wc, fr, fq); S.done(cur); }
        if (!has_next) break;
#pragma unroll
        for (int a = 0; a < 2; ++a)
#pragma unroll
            for (int b = 0; b < 2; ++b)
#pragma unroll
                for (int m = 0; m < 4; ++m)
#pragma unroll
                    for (int n = 0; n < 2; ++n) acc[a][b][m][n] = (f32x4){0.f, 0.f, 0.f, 0.f};
        cur = nxt; cA = nA; cB = nB; ++ui;
        if constexpr (ALIGN_EPI) { if (wr == 1) PG8_BAR; }
    }
    PG8_WAIT_V(0);
    if constexpr (!ALIGN_EPI) { if (wr == 0) PG8_BAR; }
    PG8_BAR;
    if constexpr (Epi::AFTER_DRAIN) { E.fused(acc, cur, wr, wc, fr, fq, lds, wid, lane); S.done(cur); }
#undef PG8_SA
#undef PG8_SB
#undef PG8_STAGE
#undef PG8_LDA
#undef PG8_LDB
#undef PG8_MMA
#undef PG8_WAIT_V
#undef PG8_WAIT_L
#undef PG8_BAR
#undef PG8_SCHED
}
}
#define GAS __attribute__((address_space(1)))
#define LAS __attribute__((address_space(3)))
#define XB_TMO      128
#define XB_XCNT(j)  (256  + 64 * (j))
#define XB_XSUB(j)  (1280 + 64 * (j))
#define XB_XGEN(j)  (2304 + 64 * (j))
#define XB_TOP      3328
#define XB_TOPGEN   3392
#define XCD_BAR_WORDS 3456
#define XB_SPIN_CAP (1u << 18)

__device__ __forceinline__ unsigned xb_ld(unsigned* p)              { return __hip_atomic_load(p, __ATOMIC_RELAXED, __HIP_MEMORY_SCOPE_AGENT); }
__device__ __forceinline__ unsigned xb_add(unsigned* p, unsigned v) { return __hip_atomic_fetch_add(p, v, __ATOMIC_RELAXED, __HIP_MEMORY_SCOPE_AGENT); }
__device__ __forceinline__ unsigned xb_xcc_id() { return (unsigned)__builtin_amdgcn_s_getreg((3 << 11) | 20) & 0xFu; }
#define XB_SPIN(cond, bar) do { unsigned _sp = 0; while (cond) { __builtin_amdgcn_s_sleep(1); \
    if ((++_sp & 255u) == 0u) { if (xb_ld(&(bar)[XB_TMO])) break; if (_sp > XB_SPIN_CAP) { atomicAdd(&(bar)[XB_TMO], 1u); break; } } } } while (0)

struct XcdBarrier {
    unsigned* bar; unsigned x; int w;
    volatile LAS unsigned* st;
};

__device__ __forceinline__ XcdBarrier xcd_barrier_post(unsigned* bar, volatile LAS unsigned* st, int wave_s) {
    XcdBarrier b; b.bar = bar; b.x = xb_xcc_id(); b.st = st; b.w = wave_s;
    if (tid_from(wave_s) == 0) (void)xb_add(&bar[XB_XCNT(b.x)], 1u);
    return b;
}
__device__ __forceinline__ void xcd_barrier_complete(unsigned* bar, unsigned x, unsigned& nloc, unsigned& nx) {
    const unsigned G = gridDim.x * gridDim.y * gridDim.z;
    unsigned sum, cnt, mine, sp = 0u;
    for (;;) {
        sum = 0u; cnt = 0u; mine = 0u;
#pragma unroll
        for (unsigned j = 0; j < 16; ++j) { const unsigned c = xb_ld(&bar[XB_XCNT(j)]); sum += c; cnt += (c > 0u) ? 1u : 0u; mine = (j == x) ? c : mine; }
        if (sum == G) break;
        __builtin_amdgcn_s_sleep(1);
        if ((++sp & 255u) == 0u) { if (xb_ld(&bar[XB_TMO])) break; if (sp > XB_SPIN_CAP) { atomicAdd(&bar[XB_TMO], 1u); break; } }
    }
    nloc = mine > 0u ? mine : 1u; nx = cnt > 0u ? cnt : 1u;
}

__device__ __forceinline__ void xcd_barrier(const XcdBarrier& b) {
    asm volatile("s_waitcnt vmcnt(0)" ::: "memory");
    __syncthreads();
    if (tid_from(b.w) == 0) {
        unsigned* bar = b.bar;
        __builtin_amdgcn_s_waitcnt(0);
        unsigned nloc = b.st[0], nx = b.st[1];
        if (nloc == 0u) { xcd_barrier_complete(bar, b.x, nloc, nx); b.st[0] = nloc; b.st[1] = nx; }
        const unsigned old = xb_add(&bar[XB_XSUB(b.x)], 1u);
        const unsigned gen = old / nloc;
        if (old + 1u == (gen + 1u) * nloc) {
            __builtin_amdgcn_fence(__ATOMIC_RELEASE, "agent");
            asm volatile("s_waitcnt vmcnt(0)" ::: "memory");
            const unsigned og = xb_add(&bar[XB_TOP], 1u);
            const unsigned tg = og / nx;
            if (og + 1u == (tg + 1u) * nx) xb_add(&bar[XB_TOPGEN], 1u);
            else XB_SPIN(xb_ld(&bar[XB_TOPGEN]) == tg, bar);
            __builtin_amdgcn_fence(__ATOMIC_ACQUIRE, "agent");
            xb_add(&bar[XB_XGEN(b.x)], 1u);
            asm volatile("s_waitcnt vmcnt(0)" ::: "memory");
        } else {
            XB_SPIN(xb_ld(&bar[XB_XGEN(b.x)]) == gen, bar);
            __builtin_amdgcn_fence(__ATOMIC_ACQUIRE, "agent");
            asm volatile("s_waitcnt vmcnt(0)" ::: "memory");
        }
    }
    __syncthreads();
}

constexpr int NWAVES = 8, NTHR = 512;
constexpr int DM = 2048, NB = 2, SEQ = 4096, NT = NB * SEQ, DEPTH = 4;
constexpr int INW = 5392, INWP = 5632;
constexpr int C_POOL = 0, C_GQ = 512, C_GK = 896, C_GV = 1280, C_GG = 2048, C_GA = 2816, C_RW = 2832;
constexpr int RW_IN = 2560, RW_W = 768, RW_H = 12;
constexpr int GLA_H = 4, GLA_DK = 96, GLA_DV = 192, GLA_NCH = 64;
constexpr int PEER_N = 16384;
constexpr float NORM_EPS = 1e-6f;
constexpr int MODW = 6 * DM;

constexpr size_t MiB = 1u << 20;
constexpr size_t WS_CTL = 0, CTL_ZERO_BYTES = 1 * MiB;
constexpr size_t WS_MOD = 1 * MiB;
constexpr size_t WS_WIN = 2 * MiB;
constexpr size_t WS_WOUT = 90 * MiB;
constexpr size_t WS_WQK = 122 * MiB;
constexpr size_t WS_U = 154 * MiB;
constexpr size_t WS_V = 410 * MiB;
constexpr size_t WS_US = 540 * MiB;
constexpr size_t WS_VS = 541 * MiB;
constexpr size_t WS_POOLT = 545 * MiB;
constexpr size_t WS_LORAT = 542 * MiB;
constexpr size_t WS_X = 666 * MiB;
constexpr size_t WS_H = 730 * MiB;
constexpr size_t WS_Y = 762 * MiB;
constexpr size_t WS_PROJ = 794 * MiB;
constexpr size_t WS_GKV = 970 * MiB;
constexpr size_t WS_GS = 1006 * MiB;
constexpr size_t WS_GDEC = 1042 * MiB;
constexpr size_t WS_RSC = 1043 * MiB;
constexpr size_t WS_RO = 1187 * MiB;
constexpr size_t WS_RGATE = 1211 * MiB;
constexpr size_t WS_RBV = 1235 * MiB;
constexpr size_t WS_EIDX = 1259 * MiB;
constexpr size_t WS_EGATE = 1263 * MiB;
constexpr size_t WS_END = 1267 * MiB;
constexpr size_t WS_DUMMY = 1267 * MiB;
#ifndef PROBE
#define PROBE 0
#endif
constexpr int CW_BAR = 4096;
constexpr size_t WS_SSP = 547 * MiB;
constexpr size_t WS_BIAS3 = 546 * MiB;

constexpr int LDS_BYTES = 147456;
constexpr int MISC_OFF = 147456 - 256;

typedef unsigned short bf16;
typedef unsigned v4u __attribute__((ext_vector_type(4)));
typedef unsigned v2u __attribute__((ext_vector_type(2)));
typedef float f32x4 __attribute__((ext_vector_type(4)));
typedef float f32x2 __attribute__((ext_vector_type(2)));
typedef __bf16 bf16x2_t __attribute__((ext_vector_type(2)));
typedef int v4i __attribute__((ext_vector_type(4)));

__device__ __forceinline__ unsigned pk2(float lo, float hi) { const f32x2 f = {lo, hi}; return __builtin_bit_cast(unsigned, __builtin_convertvector(f, bf16x2_t)); }
__device__ __forceinline__ unsigned f2bf(float f) { return pk2(f, f) & 0xffffu; }
__device__ __forceinline__ float bflo(unsigned u) { return __builtin_bit_cast(float, u << 16); }
__device__ __forceinline__ float bfhi(unsigned u) { return __builtin_bit_cast(float, u & 0xffff0000u); }
__device__ __forceinline__ float dpp_xor1(float v) { return __builtin_bit_cast(float, __builtin_amdgcn_update_dpp(0, __builtin_bit_cast(int, v), 0xB1, 0xF, 0xF, true)); }
__device__ __forceinline__ float dpp_xor2(float v) { return __builtin_bit_cast(float, __builtin_amdgcn_update_dpp(0, __builtin_bit_cast(int, v), 0x4E, 0xF, 0xF, true)); }
__device__ __forceinline__ float dpp_hmir(float v) { return __builtin_bit_cast(float, __builtin_amdgcn_update_dpp(0, __builtin_bit_cast(int, v), 0x141, 0xF, 0xF, true)); }
__device__ __forceinline__ float dpp_rmir(float v) { return __builtin_bit_cast(float, __builtin_amdgcn_update_dpp(0, __builtin_bit_cast(int, v), 0x140, 0xF, 0xF, true)); }
__device__ __forceinline__ float rl_f(float v, int l) { return __builtin_bit_cast(float, __builtin_amdgcn_readlane(__builtin_bit_cast(int, v), l)); }
__device__ __forceinline__ float row16_sum(float v) { v += dpp_xor1(v); v += dpp_xor2(v); v += dpp_hmir(v); v += dpp_rmir(v); return v; }
__device__ __forceinline__ float row16_max(float v) { v = fmaxf(v, dpp_xor1(v)); v = fmaxf(v, dpp_xor2(v)); v = fmaxf(v, dpp_hmir(v)); v = fmaxf(v, dpp_rmir(v)); return v; }
__device__ __forceinline__ float wave_sum(float v) { v = row16_sum(v); return (rl_f(v, 0) + rl_f(v, 16)) + (rl_f(v, 32) + rl_f(v, 48)); }
__device__ __forceinline__ float wave_max(float v) { v = row16_max(v); return fmaxf(fmaxf(rl_f(v, 0), rl_f(v, 16)), fmaxf(rl_f(v, 32), rl_f(v, 48))); }
__device__ __forceinline__ float half32_sum(float v, int lane) { v = row16_sum(v); const float lo = rl_f(v, 0) + rl_f(v, 16), hi = rl_f(v, 32) + rl_f(v, 48); return lane < 32 ? lo : hi; }
__device__ __forceinline__ float red8(float v) { v += dpp_xor1(v); v += dpp_xor2(v); v += dpp_hmir(v); return v; }
__device__ __forceinline__ float sigmoidf_(float x) { return __builtin_amdgcn_rcpf(1.f + __builtin_amdgcn_exp2f(-1.4426950408889634f * x)); }
__device__ __forceinline__ float softplusf_(float x) { return fmaxf(x, 0.f) + 0.6931471805599453f * __builtin_amdgcn_logf(1.f + __builtin_amdgcn_exp2f(-1.4426950408889634f * fabsf(x))); }

struct Args { const float* in[30]; float* out; unsigned char* ws; };
typedef const __attribute__((address_space(4))) Args* ArgsP;
__device__ __forceinline__ ArgsP args_ptr() { ArgsP p = (ArgsP)__builtin_amdgcn_kernarg_segment_ptr(); asm volatile("" : "+s"(p)); return p; }
__device__ __forceinline__ int opaque_i(int v) { asm volatile("" : "+s"(v)); return v; }

struct Frame {
    LAS unsigned char* lds;
    int tid, lane, wave, G, bid, gw, ngw;
};
__device__ __forceinline__ Frame make_frame(LAS unsigned char* lds, int wave_s) {
    asm volatile("" : "+s"(wave_s)); Frame F; F.lds = lds; int t = tid_from(wave_s); asm volatile("" : "+v"(t));
    F.tid = t; F.lane = t & 63; F.wave = __builtin_amdgcn_readfirstlane(t >> 6); int g_ = gridDim.x, b_ = blockIdx.x; asm volatile("" : "+s"(g_), "+s"(b_)); F.G = g_; F.bid = b_; F.gw = F.bid * NWAVES + F.wave; F.ngw = F.G * NWAVES; return F;
}

struct EpiStoreF32 {
    static constexpr bool PERM = false, AFTER_DRAIN = false;
    float* C; int ldc; int ws_;
    __device__ __forceinline__ void operator()(const pg8::f32x4 (&acc)[2][2][4][2], const pg8::Unit& u, int, int, int, int) const {
        int tz = tid_from(ws_); asm volatile("" : "+v"(tz)); const int wid = tz >> 6, lane = tz & 63, wr = wid >> 2, wc = wid & 3, fr = lane & 15, fq = lane >> 4;
        const int row0 = u.pm * 256 + wr * 64 + fr, col0 = u.pn * 256 + wc * 32 + 4 * fq;
#pragma unroll
        for (int ai = 0; ai < 2; ++ai)
#pragma unroll
            for (int m = 0; m < 4; ++m) { float* rowp = C + (size_t)(row0 + ai * 128 + m * 16) * ldc + col0;
#pragma unroll
                for (int bj = 0; bj < 2; ++bj)
#pragma unroll
                    for (int n = 0; n < 2; ++n) *(pg8::f32x4*)(rowp + bj * 128 + n * 16) = acc[ai][bj][m][n]; }
    }
};
struct EpiResid {
    static constexpr bool PERM = false, AFTER_DRAIN = false;
    const float* xsrc; float* xdst; const float* gate; int ws_; const float* gain2; const float* sc2; bf16* hdst; float* ss;
    __device__ __forceinline__ void operator()(const pg8::f32x4 (&acc)[2][2][4][2], const pg8::Unit& u, int, int, int, int) const {
        int tz = tid_from(ws_); asm volatile("" : "+v"(tz)); const int wid = tz >> 6, lane = tz & 63, wr = wid >> 2, wc = wid & 3, fr = lane & 15, fq = lane >> 4;
        const int row0 = u.pm * 256 + wr * 64 + fr, col0 = u.pn * 256 + wc * 32 + 4 * fq;
        const float* gp = gate + (size_t)(u.pm >> 4) * MODW + col0; const float* sp = sc2 + (size_t)(u.pm >> 4) * MODW + col0;
        pg8::f32x4 gv[2][2], hv[2][2];
#pragma unroll
        for (int bj = 0; bj < 2; ++bj)
#pragma unroll
            for (int n = 0; n < 2; ++n) { gv[bj][n] = *(const pg8::f32x4*)(gp + bj * 128 + n * 16);
                hv[bj][n] = *(const pg8::f32x4*)(gain2 + col0 + bj * 128 + n * 16) * (*(const pg8::f32x4*)(sp + bj * 128 + n * 16) + 1.f); }
#pragma unroll
        for (int ai = 0; ai < 2; ++ai)
#pragma unroll
            for (int m = 0; m < 4; ++m) { const int row = row0 + ai * 128 + m * 16; const size_t ro = (size_t)row * DM + col0; float s = 0.f;
#pragma unroll
                for (int bj = 0; bj < 2; ++bj)
#pragma unroll
                    for (int n = 0; n < 2; ++n) { const pg8::f32x4 xv = *(const pg8::f32x4*)(xsrc + ro + bj * 128 + n * 16);
                        const pg8::f32x4 y = xv + gv[bj][n] * acc[ai][bj][m][n];
                        *(pg8::f32x4*)(xdst + ro + bj * 128 + n * 16) = y;
                        s += (y.x * y.x + y.y * y.y) + (y.z * y.z + y.w * y.w);
                        const pg8::f32x4 hh = y * hv[bj][n]; v2u pk; pk.x = pk2(hh.x, hh.y); pk.y = pk2(hh.z, hh.w); *(v2u*)(hdst + ro + bj * 128 + n * 16) = pk; }
                s += __builtin_bit_cast(float, __builtin_amdgcn_ds_bpermute((lane ^ 16) << 2, __builtin_bit_cast(int, s)));
                s += __builtin_bit_cast(float, __builtin_amdgcn_ds_bpermute((lane ^ 32) << 2, __builtin_bit_cast(int, s)));
                if (fq == 0) ss[(size_t)row * 32 + u.pn * 4 + wc] = s; }
    }
};
struct EpiScore {
    static constexpr bool PERM = false, AFTER_DRAIN = false;
    float* C; int ldc; int ws_; const LAS float* rs; const float* bias;
    __device__ __forceinline__ void operator()(const pg8::f32x4 (&acc)[2][2][4][2], const pg8::Unit& u, int, int, int, int) const {
        int tz = tid_from(ws_); asm volatile("" : "+v"(tz)); const int wid = tz >> 6, lane = tz & 63, wr = wid >> 2, wc = wid & 3, fr = lane & 15, fq = lane >> 4;
        const int row0 = u.pm * 256 + wr * 64 + fr, col0 = u.pn * 256 + wc * 32 + 4 * fq;
        const float* bp = bias + (size_t)(u.pm >> 4) * DM + col0;
        pg8::f32x4 bv[2][2];
#pragma unroll
        for (int bj = 0; bj < 2; ++bj)
#pragma unroll
            for (int n = 0; n < 2; ++n) bv[bj][n] = *(const pg8::f32x4*)(bp + bj * 128 + n * 16);
#pragma unroll
        for (int ai = 0; ai < 2; ++ai)
#pragma unroll
            for (int m = 0; m < 4; ++m) { const int row = row0 + ai * 128 + m * 16; float* rowp = C + (size_t)row * ldc + col0;
                const float rstd = rs[row & 255];
#pragma unroll
                for (int bj = 0; bj < 2; ++bj)
#pragma unroll
                    for (int n = 0; n < 2; ++n) *(pg8::f32x4*)(rowp + bj * 128 + n * 16) = acc[ai][bj][m][n] * rstd + bv[bj][n]; }
    }
};

__device__ __forceinline__ void quant_tables(ArgsP A, int l, int wvi, int nw, int lane) {
    for (int rr = wvi; rr < 2 * PEER_N; rr += nw) {
        const int tb = rr >= PEER_N, r = l * PEER_N + (rr - tb * PEER_N);
        const f32x4* src = (const f32x4*)(A->in[27 + tb] + (size_t)r * DM) + lane;
        f32x4 v[8]; float mx = 0.f;
        float ssq = 0.f;
#pragma unroll
        for (int j = 0; j < 8; ++j) { v[j] = src[64 * j]; mx = fmaxf(mx, fmaxf(fmaxf(fabsf(v[j].x), fabsf(v[j].y)), fmaxf(fabsf(v[j].z), fabsf(v[j].w)))); ssq += (v[j].x * v[j].x + v[j].y * v[j].y) + (v[j].z * v[j].z + v[j].w * v[j].w); }
        mx = wave_max(mx);
        mx = fminf(mx, (tb ? 3.0f : 2.5f) * sqrtf(wave_sum(ssq) * (1.f / DM)));
        unsigned* dst = (unsigned*)(A->ws + (tb ? WS_V : WS_U)) + (size_t)r * (DM / 4) + lane;
        if (!tb) { const float inv = mx > 0.f ? 7.f / mx : 0.f;
            unsigned* dst4 = (unsigned*)(A->ws + WS_U) + (size_t)r * (DM / 8) + lane;
#pragma unroll
            for (int j = 0; j < 4; ++j) { unsigned wd = 0u;
                const float lo4[4] = {v[j].x, v[j].y, v[j].z, v[j].w}, hi4[4] = {v[j + 4].x, v[j + 4].y, v[j + 4].z, v[j + 4].w};
#pragma unroll
                for (int i = 0; i < 4; ++i) { const unsigned nl = (unsigned)((int)rintf(fminf(fmaxf(lo4[i] * inv, -7.f), 7.f)) + 8), nh = (unsigned)((int)rintf(fminf(fmaxf(hi4[i] * inv, -7.f), 7.f)) + 8); wd |= (nl | (nh << 4)) << (8 * i); }
                dst4[64 * j] = wd; }
            if (lane == 0) ((float*)(A->ws + WS_US))[r] = mx * (1.f / 7.f);
        } else { const float inv = mx > 0.f ? 6.f / mx : 0.f;
            unsigned short* dst2 = (unsigned short*)(A->ws + WS_V) + (size_t)r * (DM / 4) + lane;
#pragma unroll
            for (int j = 0; j < 8; ++j) { const f32x4 c4 = __builtin_elementwise_min(__builtin_elementwise_max(v[j] * inv, (f32x4){-6.f, -6.f, -6.f, -6.f}), (f32x4){6.f, 6.f, 6.f, 6.f});
                int p = __builtin_amdgcn_cvt_scalef32_pk_fp4_f32(0, c4.x, c4.y, 1.0f, 0); p = __builtin_amdgcn_cvt_scalef32_pk_fp4_f32(p, c4.z, c4.w, 1.0f, 1); dst2[64 * j] = (unsigned short)p; }
            if (lane == 0) ((float*)(A->ws + WS_VS))[r] = mx * (1.f / 6.f);
        }
    }
}

__device__ __forceinline__ void transpose_item(const float* W, int K, int N, bf16* WT, LAS float* scr, int kb, int nb, int lane) {
    const int k0 = 64 * kb, n0 = 64 * nb, nl = (lane & 15) * 4, kr = lane >> 4;
    f32x4 v[16];
#pragma unroll
    for (int it = 0; it < 16; ++it) v[it] = (n0 + nl < N) ? *(const f32x4*)(W + (size_t)(k0 + it * 4 + kr) * N + n0 + nl) : (f32x4){0.f, 0.f, 0.f, 0.f};
#pragma unroll
    for (int it = 0; it < 16; ++it) { LAS float* s = scr + (it * 4 + kr) * 65 + nl; s[0] = v[it].x; s[1] = v[it].y; s[2] = v[it].z; s[3] = v[it].w; }
    asm volatile("s_waitcnt lgkmcnt(0)" ::: "memory");
    const int c = lane & 7;
#pragma unroll
    for (int j = 0; j < 8; ++j) { const int n = (lane >> 3) + 8 * j; const LAS float* s = scr + (8 * c) * 65 + n;
        v4u o; o.x = pk2(s[0 * 65], s[1 * 65]); o.y = pk2(s[2 * 65], s[3 * 65]); o.z = pk2(s[4 * 65], s[5 * 65]); o.w = pk2(s[6 * 65], s[7 * 65]);
        if (n0 + n < N) *(v4u*)(WT + (size_t)(n0 + n) * K + k0 + 8 * c) = o; }
    asm volatile("s_waitcnt lgkmcnt(0)" ::: "memory");
}

__device__ __forceinline__ void ph_prologue(ArgsP A, LAS unsigned char* lds_, int wv_) {
    const Frame F = make_frame(lds_, wv_);
    LAS float* ldsf = (LAS float*)F.lds;
    const int tid = F.tid, lane = F.lane, wave = F.wave;
    for (int i = tid; i < NB * DM; i += NTHR) { const float c = A->in[1][i]; ldsf[i] = c / (1.f + __expf(-c)); }
    __syncthreads();
    {
        LAS float* red = ldsf + 4096;
        float* MOD = (float*)(A->ws + WS_MOD);
        for (int u = F.bid; u < DEPTH * 96; u += F.G) {
            const int l = u / 96, j0 = (u % 96) * 128;
            const float* W = A->in[2] + (size_t)l * DM * MODW + j0 + lane * 2;
            float a00 = 0.f, a01 = 0.f, a10 = 0.f, a11 = 0.f;
            const int k0 = wave * 256;
#pragma unroll 8
            for (int k = k0; k < k0 + 256; ++k) { const f32x2 w = *(const f32x2*)(W + (size_t)k * MODW); const float c0 = ldsf[k], c1 = ldsf[DM + k];
                a00 += c0 * w.x; a01 += c0 * w.y; a10 += c1 * w.x; a11 += c1 * w.y; }
            red[(wave * 2 + 0) * 128 + lane * 2] = a00; red[(wave * 2 + 0) * 128 + lane * 2 + 1] = a01;
            red[(wave * 2 + 1) * 128 + lane * 2] = a10; red[(wave * 2 + 1) * 128 + lane * 2 + 1] = a11;
            __syncthreads();
            if (tid < 256) { const int b = tid >> 7, j = tid & 127; float s = 0.f;
#pragma unroll
                for (int w = 0; w < 8; ++w) s += red[(w * 2 + b) * 128 + j];
                s += A->in[3][(size_t)l * MODW + j0 + j];
                MOD[(size_t)(l * 2 + b) * MODW + j0 + j] = s; }
            __syncthreads();
        }
    }
    {
        LAS float* scr = ldsf + wave * 4160;
        constexpr int NBI = (INW + 63) / 64;
        constexpr int I_IN = 32 * NBI, I_OUT = 32 * 32, I_L = I_IN + I_OUT;
        for (int it = F.gw; it < DEPTH * I_L; it += F.ngw) {
            const int l = it / I_L; int r = it % I_L;
            if (r < I_IN) transpose_item(A->in[5] + (size_t)l * DM * INW, DM, INW, (bf16*)(A->ws + WS_WIN) + (size_t)l * INWP * DM, scr, r / NBI, r % NBI, lane);
            else { r -= I_IN; transpose_item(A->in[22] + (size_t)l * DM * DM, DM, DM, (bf16*)(A->ws + WS_WOUT) + (size_t)l * DM * DM, scr, r / 32, r % 32, lane); }
        }
        constexpr int PADV = (INWP - INW) * DM / 8;
        for (int i = F.bid * NTHR + tid; i < DEPTH * PADV; i += F.G * NTHR) { const int l = i / PADV, r = i % PADV;
            ((v4u*)((bf16*)(A->ws + WS_WIN) + (size_t)l * INWP * DM + (size_t)INW * DM))[r] = (v4u){0u, 0u, 0u, 0u}; }
    }
    __syncthreads();
    {
        LAS float* Ks = ldsf;
        LAS float* Ws = ldsf + 128 * 132;
        for (int u = F.bid; u < DEPTH * 16 * 32; u += F.G) {
            const int l = u >> 9, hh = (u >> 5) & 15, jt = u & 31, h = hh >> 1, half = hh & 1, j0 = jt * 64;
            const float* ksrc = (half ? A->in[26] : A->in[25]) + ((size_t)l * 8 + h) * 128 * 128;
            const float* wsrc = A->in[24] + (size_t)l * DM * DM + h * 256 + half * 128;
            {   f32x4 kq[8], wq4[4];
#pragma unroll
                for (int it = 0; it < 8; ++it) { const int i = tid + it * NTHR, n = i >> 5, d4 = (i & 31) * 4; kq[it] = *(const f32x4*)(ksrc + n * 128 + d4); }
#pragma unroll
                for (int it = 0; it < 4; ++it) { const int i = tid + it * NTHR, jj = i >> 5, d4 = (i & 31) * 4; wq4[it] = *(const f32x4*)(wsrc + (size_t)(j0 + jj) * DM + d4); }
#pragma unroll
                for (int it = 0; it < 8; ++it) { const int i = tid + it * NTHR, n = i >> 5, d4 = (i & 31) * 4; *(LAS f32x4*)(Ks + n * 132 + d4) = kq[it]; }
#pragma unroll
                for (int it = 0; it < 4; ++it) { const int i = tid + it * NTHR, jj = i >> 5, d4 = (i & 31) * 4; *(LAS f32x4*)(Ws + jj * 132 + d4) = wq4[it]; }
            }
            __syncthreads();
            { const int li = lane & 15, lq = lane >> 4;
                f32x4 acc[4] = {{0.f, 0.f, 0.f, 0.f}, {0.f, 0.f, 0.f, 0.f}, {0.f, 0.f, 0.f, 0.f}, {0.f, 0.f, 0.f, 0.f}};
#pragma unroll 4
                for (int ks = 0; ks < 32; ++ks) { const float a = Ks[(wave * 16 + li) * 132 + 4 * ks + lq];
#pragma unroll
                    for (int jt = 0; jt < 4; ++jt) acc[jt] = __builtin_amdgcn_mfma_f32_16x16x4f32(a, Ws[(jt * 16 + li) * 132 + 4 * ks + lq], acc[jt], 0, 0, 0); }
                bf16* dst = (bf16*)(A->ws + WS_WQK) + (size_t)l * DM * DM + (size_t)(h * 256 + half * 128 + wave * 16 + lq * 4) * DM + j0 + li;
#pragma unroll
                for (int jt = 0; jt < 4; ++jt) { dst[(size_t)0 * DM + jt * 16] = (bf16)f2bf(acc[jt].x); dst[(size_t)1 * DM + jt * 16] = (bf16)f2bf(acc[jt].y); dst[(size_t)2 * DM + jt * 16] = (bf16)f2bf(acc[jt].z); dst[(size_t)3 * DM + jt * 16] = (bf16)f2bf(acc[jt].w); } }
            __syncthreads();
        }
    }
    {
        bf16* PT = (bf16*)(A->ws + WS_POOLT);
        for (int i = F.bid * NTHR + tid; i < DEPTH * 4 * 128 * 128; i += F.G * NTHR) { const int lg = i >> 14, r = i & 16383, dcol = r >> 7, c = r & 127;
            PT[i] = (bf16)f2bf(A->in[6][(size_t)lg * 16384 + c * 128 + dcol]); }
    }
    {
        bf16* LT = (bf16*)(A->ws + WS_LORAT);
        for (int i = F.bid * NTHR + tid; i < DEPTH * RW_W * 256; i += F.G * NTHR) { const int l = i / (RW_W * 256), r = i % (RW_W * 256), c = r >> 8, j = r & 255;
            const float v = j < 64 ? A->in[13][((size_t)l * 64 + j) * RW_W + c] : (j < 128 ? A->in[15][((size_t)l * 64 + (j - 64)) * RW_W + c] : A->in[16][((size_t)l * 128 + (j - 128)) * RW_W + c]);
            LT[i] = (bf16)f2bf(v); }
    }
    quant_tables(A, 0, F.gw, F.ngw, lane);
}

__device__ __forceinline__ void ph_norm(const float* xsrc, const float* gain, const float* sh, const float* sc, bf16* hout, LAS unsigned char* lds_, int wv_) {
    const Frame F = make_frame(lds_, wv_);
    for (int m = F.gw; m < NT; m += F.ngw) {
        const int b = m >> 12;
        const f32x4* xr = (const f32x4*)(xsrc + (size_t)m * DM) + F.lane;
        f32x4 v[8]; float ss = 0.f;
#pragma unroll
        for (int j = 0; j < 8; ++j) { v[j] = xr[64 * j]; ss += (v[j].x * v[j].x + v[j].y * v[j].y) + (v[j].z * v[j].z + v[j].w * v[j].w); }
        const float rstd = rsqrtf(wave_sum(ss) * (1.f / DM) + NORM_EPS);
        v2u* o8 = (v2u*)(hout + (size_t)m * DM) + F.lane;
#pragma unroll
        for (int j = 0; j < 8; ++j) { const int col = j * 256 + F.lane * 4;
            const f32x4 g = *(const f32x4*)(gain + col), s1 = *(const f32x4*)(sc + (size_t)b * MODW + col), s0 = *(const f32x4*)(sh + (size_t)b * MODW + col);
            const f32x4 y = v[j] * rstd * g * (s1 + 1.f) + s0;
            v2u o; o.x = pk2(y.x, y.y); o.y = pk2(y.z, y.w); o8[64 * j] = o; }
    }
}
__device__ __forceinline__ void ph_final(const float* xsrc, const float* gain, float* out, LAS unsigned char* lds_, int wv_) {
    const Frame F = make_frame(lds_, wv_);
    for (int m = F.gw; m < NT; m += F.ngw) {
        const f32x4* xr = (const f32x4*)(xsrc + (size_t)m * DM) + F.lane;
        f32x4 v[8]; float ss = 0.f;
#pragma unroll
        for (int j = 0; j < 8; ++j) { v[j] = xr[64 * j]; ss += (v[j].x * v[j].x + v[j].y * v[j].y) + (v[j].z * v[j].z + v[j].w * v[j].w); }
        const float rstd = rsqrtf(wave_sum(ss) * (1.f / DM) + NORM_EPS);
        f32x4* o = (f32x4*)(out + (size_t)m * DM) + F.lane;
#pragma unroll
        for (int j = 0; j < 8; ++j) { const f32x4 g = *(const f32x4*)(gain + j * 256 + F.lane * 4); o[64 * j] = v[j] * rstd * g; }
    }
}

__device__ __forceinline__ void pool_unit(ArgsP A, const Frame& F_in, int l, int unit) {
    Frame F = F_in; asm volatile("" : "+v"(F.tid)); F.lane = F.tid & 63;
    const int tile = unit >> 2, g = unit & 3, t0 = tile * 32, s0 = t0 & (SEQ - 1), tid = F.tid, lane = F.lane, w = F.wave;
    const int win = 2 << g;
    const float* proj = (const float*)(A->ws + WS_PROJ);
    LAS float* ps = (LAS float*)F.lds;
    LAS unsigned short* ds = (LAS unsigned short*)(F.lds + 24064);
    const int rt = w >> 2, ct0 = (w & 3) * 2, li = lane & 15, lq = lane >> 4;
    typedef short b8 __attribute__((ext_vector_type(8)));
    b8 bw[2][4];
    { const unsigned short* PT = (const unsigned short*)(A->ws + WS_POOLT) + ((size_t)l * 4 + g) * 16384;
#pragma unroll
        for (int j = 0; j < 2; ++j)
#pragma unroll
            for (int ks = 0; ks < 4; ++ks) bw[j][ks] = *(const b8*)(PT + (size_t)((ct0 + j) * 16 + li) * 128 + ks * 32 + lq * 8); }
    {   f32x4 pq[3];
#pragma unroll
        for (int it = 0; it < 3; ++it) { const int i = tid + it * NTHR, r = i >> 5, c4 = i & 31; const int s = s0 - 15 + r;
            pq[it] = (i < 47 * 32 && s >= 0) ? *(const f32x4*)(proj + (size_t)(t0 - 15 + r) * INWP + C_POOL + g * 128 + c4 * 4) : (f32x4){0.f, 0.f, 0.f, 0.f}; }
#pragma unroll
        for (int it = 0; it < 3; ++it) { const int i = tid + it * NTHR; if (i < 47 * 32) *(LAS f32x4*)(ps + i * 4) = pq[it]; }
    }
    __syncthreads();
    for (int i = tid; i < 32 * 128; i += NTHR) { const int tok = i >> 7, c = i & 127; float sum = 0.f;
        for (int ww = 0; ww < win; ++ww) sum += ps[(tok + 15 - ww) * 128 + c];
        const int cnt = (s0 + tok + 1) < win ? (s0 + tok + 1) : win;
        ds[tok * 136 + c] = (unsigned short)f2bf(sum * __builtin_amdgcn_rcpf((float)cnt) - ps[(tok + 15) * 128 + c]); }
    __syncthreads();
    f32x4 acc[2] = {{0.f, 0.f, 0.f, 0.f}, {0.f, 0.f, 0.f, 0.f}};
#pragma unroll
    for (int ks = 0; ks < 4; ++ks) { const b8 a = *(const LAS b8*)(ds + (rt * 16 + li) * 136 + ks * 32 + lq * 8);
#pragma unroll
        for (int j = 0; j < 2; ++j) acc[j] = __builtin_amdgcn_mfma_f32_16x16x32_bf16(a, bw[j][ks], acc[j], 0, 0, 0); }
    bf16* Y = (bf16*)(A->ws + WS_Y);
#pragma unroll
    for (int j = 0; j < 2; ++j) { const int dcol = (ct0 + j) * 16 + li; const float scale = A->in[7][(size_t)l * 512 + g * 128 + dcol]; const int tk = t0 + rt * 16 + lq * 4;
        Y[(size_t)(tk + 0) * DM + g * 128 + dcol] = (bf16)f2bf(acc[j].x * scale); Y[(size_t)(tk + 1) * DM + g * 128 + dcol] = (bf16)f2bf(acc[j].y * scale);
        Y[(size_t)(tk + 2) * DM + g * 128 + dcol] = (bf16)f2bf(acc[j].z * scale); Y[(size_t)(tk + 3) * DM + g * 128 + dcol] = (bf16)f2bf(acc[j].w * scale); }
    __syncthreads();
}

__device__ __forceinline__ void gla_bcum(ArgsP A, const Frame& F, int l, int h, int t0, LAS float* bcum, LAS float* ad, LAS float* up) {
    const float* proj = (const float*)(A->ws + WS_PROJ);
    const int tid = F.tid;
    {
        const float a0 = proj[(size_t)(t0 + (tid >> 4)) * INWP + C_GA + (tid & 15)], a1 = proj[(size_t)(t0 + 32 + (tid >> 4)) * INWP + C_GA + (tid & 15)];
        const float* upg = A->in[8] + (size_t)l * 16 * 384 + h * 96;
        const float u0 = upg[(tid / 96) * 384 + tid % 96], u1 = upg[((tid + 512) / 96) * 384 + (tid + 512) % 96], u2 = upg[((tid + 1024) / 96) * 384 + (tid + 1024) % 96];
        ad[tid] = a0; ad[tid + 512] = a1; up[tid] = u0; up[tid + 512] = u1; up[tid + 1024] = u2;
    }
    __syncthreads();
    for (int i = tid; i < 64 * 96; i += NTHR) { const int tok = i / 96, d = i % 96; float x = A->in[9][(size_t)l * 384 + h * 96 + d];
#pragma unroll
        for (int j = 0; j < 16; ++j) x += ad[tok * 16 + j] * up[j * 96 + d];
        bcum[i] = -softplusf_(-x) * (1.f / 16.f); }
    __syncthreads();
    if (tid < 384) { const int d = tid % 96, seg = tid / 96; float acc = 0.f;
#pragma unroll
        for (int k = 0; k < 16; ++k) { acc += bcum[(seg * 16 + k) * 96 + d]; bcum[(seg * 16 + k) * 96 + d] = acc; }
        ad[seg * 96 + d] = acc; }
    __syncthreads();
    if (tid < 384) { const int d = tid % 96, seg = tid / 96; float pre = 0.f;
#pragma unroll
        for (int s2 = 0; s2 < 3; ++s2) pre += (s2 < seg) ? ad[s2 * 96 + d] : 0.f;
        if (seg > 0) {
#pragma unroll
            for (int k = 0; k < 16; ++k) bcum[(seg * 16 + k) * 96 + d] += pre; } }
    __syncthreads();
}

__device__ __forceinline__ void gla_scan_unit(ArgsP A, const Frame& F, int unit) {
    const int idx = unit * NTHR + F.tid, bh = idx / 18432, rem = idx % 18432, d = rem % 96;
    const float* KV = (const float*)(A->ws + WS_GKV) + (size_t)bh * 64 * 18432 + rem;
    float* GS = (float*)(A->ws + WS_GS) + (size_t)bh * 64 * 18432 + rem;
    const float* DEC = (const float*)(A->ws + WS_GDEC) + (size_t)bh * 64 * 96 + d;
    float S = 0.f;
#pragma unroll 1
    for (int c0 = 0; c0 < 64; c0 += 16) {
        float kv[16], dc[16];
#pragma unroll
        for (int j = 0; j < 16; ++j) { kv[j] = KV[(size_t)(c0 + j) * 18432]; dc[j] = DEC[(c0 + j) * 96]; }
#pragma unroll
        for (int j = 0; j < 16; ++j) { GS[(size_t)(c0 + j) * 18432] = S; S = dc[j] * S + kv[j]; }
    }
}

typedef short bf16x8_t __attribute__((ext_vector_type(8)));
constexpr int RS = 68;
__device__ __forceinline__ f32x4 tile_mm64(const LAS bf16* Am, int arow0, const LAS bf16* Bm, int brow0, f32x4 acc, int lane) {
    const int r = lane & 15, kq = (lane >> 4) * 8;
#pragma unroll
    for (int ks = 0; ks < 2; ++ks) {
        const bf16x8_t a = *(const LAS bf16x8_t*)(Am + (arow0 + r) * RS + ks * 32 + kq);
        const bf16x8_t b = *(const LAS bf16x8_t*)(Bm + (brow0 + r) * RS + ks * 32 + kq);
        acc = __builtin_amdgcn_mfma_f32_16x16x32_bf16(a, b, acc, 0, 0, 0);
    }
    return acc;
}
constexpr int RA_BT = 0, RA_KT = 8704, RA_AT = 17408, RA_RT = 26112, RA_RABS = 34816, RA_BHT = 43520, RA_KHT = 52224, RA_VT = 60928, RA_AABS = 69632,
              RA_MBAT = 86272, RA_MKA = 103680, RA_NBRT = 121088, RA_GC = 129792, RA_WT = 130048, RA_NKRT = 132096, RA_END = 140800, RA_PRE = 94976;
constexpr int RA_Z = RA_BT, RA_QST = RA_AT, RA_QOT = RA_RT, RA_LO = 0, RA_RES = 34816;
constexpr size_t RWO_POT = 0, RWO_PST = 12 * MiB, RWO_GT = 24 * MiB, RWO_OLT = 48 * MiB, RWO_SC = 72 * MiB;

__device__ __forceinline__ void rwkvA_unit(ArgsP A, const Frame& F_in, int l, int unit) {
    Frame F = F_in; asm volatile("" : "+v"(F.tid)); F.lane = F.tid & 63;

    const int bh = unit >> 6, c = unit & 63, b = bh / RW_H, h = bh % RW_H, t0 = b * SEQ + c * 64, s0 = c * 64, tid = F.tid, lane = F.lane, w = F.wave;
    const float* proj = (const float*)(A->ws + WS_PROJ);
    const float* mu = A->in[11] + (size_t)l * RW_IN;
    LAS unsigned char* L = F.lds;
    const int n = lane, cc = h * 64 + n;
    const int rt1 = w >> 1, ct1 = (w & 1) * 2, li1 = lane & 15, lq1 = lane >> 4;
    f32x4 yc[8], yp[8];
#pragma unroll
    for (int it = 0; it < 8; ++it) { const int g = tid + it * NTHR, tok = g >> 6, j4 = (g & 63) * 4; const float* rp = proj + ((size_t)t0 + tok) * INWP + C_RW + 2304 + j4;
        yc[it] = *(const f32x4*)rp; yp[it] = (s0 + tok > 0) ? *(const f32x4*)(rp - INWP) : (f32x4){0.f, 0.f, 0.f, 0.f}; }
    bf16x8_t bw[2][8];
    { const bf16* LT = (const bf16*)(A->ws + WS_LORAT) + ((size_t)l * RW_W + h * 64) * 256;
#pragma unroll
        for (int j = 0; j < 2; ++j)
#pragma unroll
            for (int ks = 0; ks < 8; ++ks) bw[j][ks] = *(const bf16x8_t*)(LT + (size_t)((ct1 + j) * 16 + li1) * 256 + ks * 32 + lq1 * 8); }
    float rr[9], kr[9], vr[9];
#pragma unroll
    for (int i = 0; i < 9; ++i) { const int tok = w * 8 + i - 1; const bool ok = (s0 + tok >= 0); const float* row = proj + ((size_t)t0 + tok) * INWP + C_RW;
        rr[i] = ok ? row[cc] : 0.f; kr[i] = ok ? row[768 + cc] : 0.f; vr[i] = ok ? row[1536 + cc] : 0.f; }
    const float w0c = A->in[12][(size_t)l * RW_W + cc], a0c = A->in[14][(size_t)l * RW_W + cc], kkc = A->in[17][(size_t)l * RW_W + cc], kac = A->in[18][(size_t)l * RW_W + cc], rkc = A->in[19][(size_t)l * RW_W + cc];
    const float mur = mu[cc], muk = mu[768 + cc], muv = mu[1536 + cc];
    {   LAS bf16* lo = (LAS bf16*)(L + RA_LO);
#pragma unroll
        for (int it = 0; it < 8; ++it) { const int g = tid + it * NTHR, tok = g >> 6, j4 = (g & 63) * 4; const f32x4 m4 = *(const f32x4*)(mu + 2304 + j4);
            const f32x4 ym = yc[it] + (yp[it] - yc[it]) * m4;
            const float sc = j4 < 64 ? 2.f : 1.f; f32x4 sg; sg.x = sigmoidf_(ym.x * sc); sg.y = sigmoidf_(ym.y * sc); sg.z = sigmoidf_(ym.z * sc); sg.w = sigmoidf_(ym.w * sc);
            const f32x4 o = j4 < 64 ? sg * 2.f - 1.f : (j4 < 128 ? ym : sg);
            v2u pk; pk.x = pk2(o.x, o.y); pk.y = pk2(o.z, o.w); *(LAS v2u*)(lo + tok * 264 + j4) = pk; }
    }
    __syncthreads();
    {
        const int rt = rt1, ct0 = ct1, li = li1, lq = lq1;
        const LAS bf16* lo = (const LAS bf16*)(L + RA_LO);
        LAS float* res = (LAS float*)(L + RA_RES);
        f32x4 acc[3][2];
#pragma unroll
        for (int p = 0; p < 3; ++p)
#pragma unroll
            for (int j = 0; j < 2; ++j) acc[p][j] = (f32x4){0.f, 0.f, 0.f, 0.f};
#pragma unroll
        for (int ks = 0; ks < 8; ++ks) { const bf16x8_t a = *(const LAS bf16x8_t*)(lo + (rt * 16 + li) * 264 + ks * 32 + lq * 8);
            const int p = ks < 2 ? 0 : (ks < 4 ? 1 : 2);
#pragma unroll
            for (int j = 0; j < 2; ++j) acc[p][j] = __builtin_amdgcn_mfma_f32_16x16x32_bf16(a, bw[j][ks], acc[p][j], 0, 0, 0); }
#pragma unroll
        for (int p = 0; p < 3; ++p)
#pragma unroll
            for (int j = 0; j < 2; ++j) { LAS float* rp = res + p * 64 * 68 + (rt * 16 + lq * 4) * 68 + (ct0 + j) * 16 + li;
                rp[0] = acc[p][j].x; rp[68] = acc[p][j].y; rp[136] = acc[p][j].z; rp[204] = acc[p][j].w; }
    }
    __syncthreads();
    float r_[8], k_[8], v_[8], av_[8], bb_[8], lw_[8];
    {
        const LAS float* res = (const LAS float*)(L + RA_RES);
        float wl[8], al[8], gl[8];
#pragma unroll
        for (int i = 0; i < 8; ++i) { wl[i] = res[(w * 8 + i) * 68 + n]; al[i] = res[64 * 68 + (w * 8 + i) * 68 + n]; gl[i] = res[2 * 64 * 68 + (w * 8 + i) * 68 + n]; }
        float* GATE = (float*)(A->ws + WS_RGATE); float* BV = (float*)(A->ws + WS_RBV);
#pragma unroll
        for (int i = 0; i < 8; ++i) { const int tok = w * 8 + i; const size_t t = (size_t)t0 + tok;
            float r = rr[i + 1], k = kr[i + 1], v = vr[i + 1];
            r += (rr[i] - r) * mur; k += (kr[i] - k) * muk; v += (vr[i] - v) * muv;
            const float wraw = -softplusf_(-(w0c + wl[i])) - 0.5f;
            const float a = sigmoidf_(a0c + al[i]);
            float kk = k * kkc; kk = kk * __builtin_amdgcn_rsqf(fmaxf(wave_sum(kk * kk), 1e-24f));
            const float k2 = k * (1.f + (a - 1.f) * kac);
            const float bonus = wave_sum(r * k2 * rkc);
            r_[i] = r; k_[i] = k2; v_[i] = v; av_[i] = -kk; bb_[i] = kk * a; lw_[i] = -__expf(wraw);
            GATE[t * RW_W + cc] = gl[i]; BV[t * RW_W + cc] = bonus * v; }
    }
    LAS float* wt = (LAS float*)(L + RA_WT);
#pragma unroll
    for (int i = 1; i < 8; ++i) lw_[i] += lw_[i - 1];
    wt[w * 64 + n] = lw_[7];
    __syncthreads();
    float pre = 0.f, mid = 0.f, last = 0.f;
#pragma unroll
    for (int ww = 0; ww < 8; ++ww) { const float x = wt[ww * 64 + n]; pre += (ww < w) ? x : 0.f; mid += (ww < 4) ? x : 0.f; last += x; }
    {
        LAS bf16* Bt = (LAS bf16*)(L + RA_BT); LAS bf16* Kt = (LAS bf16*)(L + RA_KT); LAS bf16* At = (LAS bf16*)(L + RA_AT); LAS bf16* Rt = (LAS bf16*)(L + RA_RT);
        LAS bf16* Rab = (LAS bf16*)(L + RA_RABS); LAS bf16* BhT = (LAS bf16*)(L + RA_BHT); LAS bf16* KhT = (LAS bf16*)(L + RA_KHT); LAS bf16* VT = (LAS bf16*)(L + RA_VT);
        LAS float* AabT = (LAS float*)(L + RA_AABS);
#pragma unroll
        for (int i = 0; i < 8; ++i) { const int t = w * 8 + i; const float lw = pre + lw_[i], lwm1 = pre + (i > 0 ? lw_[i - 1] : 0.f);
            const float eg = __expf(lw - mid), egi = __expf(mid - lw), egm1 = __expf(lwm1 - mid), eh = __expf(last - lw);
            Bt[t * RS + n] = (bf16)f2bf(bb_[i] * egi); Kt[t * RS + n] = (bf16)f2bf(k_[i] * egi); At[t * RS + n] = (bf16)f2bf(av_[i] * egm1); Rt[t * RS + n] = (bf16)f2bf(r_[i] * eg);
            Rab[t * RS + n] = (bf16)f2bf(r_[i] * __expf(lw)); AabT[n * 65 + t] = av_[i] * __expf(lwm1);
            BhT[n * RS + t] = (bf16)f2bf(bb_[i] * eh); KhT[n * RS + t] = (bf16)f2bf(k_[i] * eh); VT[n * RS + t] = (bf16)f2bf(v_[i]); }
        if (w == 0) ((LAS float*)(L + RA_GC))[n] = __expf(last);
    }
    __syncthreads();
    const int rt = w >> 1, ct0 = (w & 1) * 2, li = lane & 15, lq = lane >> 4;
#define FRAG(mat_, row_, ks_) (*(const LAS bf16x8_t*)((mat_) + ((row_) + li) * RS + (ks_) * 32 + lq * 8))
#define MM(a_, b_, c_) __builtin_amdgcn_mfma_f32_16x16x32_bf16(a_, b_, c_, 0, 0, 0)
    {
        const LAS bf16* Bt = (const LAS bf16*)(L + RA_BT); const LAS bf16* Kt = (const LAS bf16*)(L + RA_KT); const LAS bf16* At = (const LAS bf16*)(L + RA_AT); const LAS bf16* Rt = (const LAS bf16*)(L + RA_RT);
        LAS bf16* MbaT = (LAS bf16*)(L + RA_MBAT); LAS float* Mka = (LAS float*)(L + RA_MKA); LAS bf16* NbrT = (LAS bf16*)(L + RA_NBRT);
        bf16x8_t aB[2], aK[2], bA[2][2], bR[2][2];
#pragma unroll
        for (int ks = 0; ks < 2; ++ks) { aB[ks] = FRAG(Bt, rt * 16, ks); aK[ks] = FRAG(Kt, rt * 16, ks);
#pragma unroll
            for (int j = 0; j < 2; ++j) { bA[j][ks] = FRAG(At, (ct0 + j) * 16, ks); bR[j][ks] = FRAG(Rt, (ct0 + j) * 16, ks); } }
#pragma unroll
        for (int j = 0; j < 2; ++j) { const int ct = ct0 + j, tcol = ct * 16 + li, srow = rt * 16 + lq * 4;
            const f32x4 z = {0.f, 0.f, 0.f, 0.f};
            f32x4 mba = MM(aB[1], bA[j][1], MM(aB[0], bA[j][0], z)), nbr = MM(aB[1], bR[j][1], MM(aB[0], bR[j][0], z));
            f32x4 mka = MM(aK[1], bA[j][1], MM(aK[0], bA[j][0], z)), nk = MM(aK[1], bR[j][1], MM(aK[0], bR[j][0], z));
            mba.x = (srow + 0 < tcol) ? mba.x : 0.f; mba.y = (srow + 1 < tcol) ? mba.y : 0.f; mba.z = (srow + 2 < tcol) ? mba.z : 0.f; mba.w = (srow + 3 < tcol) ? mba.w : 0.f;
            mka.x = (srow + 0 < tcol) ? mka.x : 0.f; mka.y = (srow + 1 < tcol) ? mka.y : 0.f; mka.z = (srow + 2 < tcol) ? mka.z : 0.f; mka.w = (srow + 3 < tcol) ? mka.w : 0.f;
            nbr.x = (srow + 0 <= tcol) ? nbr.x : 0.f; nbr.y = (srow + 1 <= tcol) ? nbr.y : 0.f; nbr.z = (srow + 2 <= tcol) ? nbr.z : 0.f; nbr.w = (srow + 3 <= tcol) ? nbr.w : 0.f;
            nk.x = (srow + 0 <= tcol) ? nk.x : 0.f; nk.y = (srow + 1 <= tcol) ? nk.y : 0.f; nk.z = (srow + 2 <= tcol) ? nk.z : 0.f; nk.w = (srow + 3 <= tcol) ? nk.w : 0.f;
            { v2u pm; pm.x = pk2(mba.x, mba.y); pm.y = pk2(mba.z, mba.w); *(LAS v2u*)(MbaT + tcol * RS + srow) = pm; }
            Mka[(srow + 0) * RS + tcol] = mka.x; Mka[(srow + 1) * RS + tcol] = mka.y; Mka[(srow + 2) * RS + tcol] = mka.z; Mka[(srow + 3) * RS + tcol] = mka.w;
            v2u pk; pk.x = pk2(nbr.x, nbr.y); pk.y = pk2(nbr.z, nbr.w); *(LAS v2u*)(NbrT + tcol * RS + srow) = pk;
            { v2u pn; pn.x = pk2(nk.x, nk.y); pn.y = pk2(nk.z, nk.w); *(LAS v2u*)((LAS bf16*)(L + RA_NKRT) + tcol * RS + srow) = pn; } }
    }
    __syncthreads();
    {
        int t4 = tid; asm volatile("" : "+v"(t4)); const int row = t4 >> 2, q = t4 & 3, l4 = t4 & 63, li4 = l4 & 15, lq4 = l4 >> 4;
        const LAS bf16* MbaT = (const LAS bf16*)(L + RA_MBAT);
        const LAS float* Yrow = (row < 64) ? ((const LAS float*)(L + RA_AABS) + row * 65) : ((const LAS float*)(L + RA_MKA) + (row - 64) * RS);
        LAS bf16* Z = (LAS bf16*)(L + RA_Z); LAS float* pre = (LAS float*)(L + RA_PRE);
        for (int i = t4; i < 1088; i += NTHR) ((LAS v4u*)Z)[i] = (v4u){0u, 0u, 0u, 0u};
        __syncthreads();
#pragma unroll 1
        for (int jb = 0; jb < 4; ++jb) {
            if (jb > 0) {
                f32x4 acc = {0.f, 0.f, 0.f, 0.f};
#pragma unroll
                for (int ks = 0; ks < 2; ++ks) { const bf16x8_t a = *(const LAS bf16x8_t*)(Z + (w * 16 + li4) * RS + ks * 32 + lq4 * 8);
                    const bf16x8_t bm = *(const LAS bf16x8_t*)(MbaT + (jb * 16 + li4) * RS + ks * 32 + lq4 * 8);
                    acc = __builtin_amdgcn_mfma_f32_16x16x32_bf16(a, bm, acc, 0, 0, 0); }
                LAS float* pp = pre + (w * 16 + lq4 * 4) * 16 + li4;
                pp[0] = acc.x; pp[16] = acc.y; pp[32] = acc.z; pp[48] = acc.w;
                __syncthreads();
            }
            float yv[16]; v2u mv[16];
#pragma unroll
            for (int u = 0; u < 16; ++u) { yv[u] = Yrow[jb * 16 + u] + (jb > 0 ? pre[row * 16 + u] : 0.f); mv[u] = *(const LAS v2u*)(MbaT + (jb * 16 + u) * RS + jb * 16 + q * 4); }
            float zb[4] = {0.f, 0.f, 0.f, 0.f};
#pragma unroll
            for (int u = 0; u < 16; ++u) {
                float part = (zb[0] * bflo(mv[u].x) + zb[1] * bfhi(mv[u].x)) + (zb[2] * bflo(mv[u].y) + zb[3] * bfhi(mv[u].y));
                part += dpp_xor1(part); part += dpp_xor2(part);
                const float zt = yv[u] + part;
                zb[u & 3] = (q == (u >> 2)) ? zt : zb[u & 3];
            }
            { v2u pk; pk.x = pk2(zb[0], zb[1]); pk.y = pk2(zb[2], zb[3]); *(LAS v2u*)(Z + row * RS + jb * 16 + q * 4) = pk; }
            __syncthreads();
        }
    }
    {
        int t5 = tid; asm volatile("" : "+v"(t5)); const int li = t5 & 15, lq = (t5 >> 4) & 3;
        const LAS bf16* Z = (const LAS bf16*)(L + RA_Z); const LAS bf16* NbrT = (const LAS bf16*)(L + RA_NBRT); const LAS bf16* BhT = (const LAS bf16*)(L + RA_BHT);
        const LAS bf16* Rab = (const LAS bf16*)(L + RA_RABS); const LAS bf16* KhT = (const LAS bf16*)(L + RA_KHT); const LAS float* gC = (const LAS float*)(L + RA_GC);
        LAS bf16* QsT = (LAS bf16*)(L + RA_QST); LAS bf16* QoT = (LAS bf16*)(L + RA_QOT);
        bf16* PoT = (bf16*)(A->ws + WS_RSC + RWO_POT) + (size_t)unit * 4096; bf16* PsT = (bf16*)(A->ws + WS_RSC + RWO_PST) + (size_t)unit * 4096;
        bf16x8_t zW[2], zX[2], bN[2][2], bH[2][2]; v2u rb[2], kb[2], nb2[2]; float gc[2];
#pragma unroll
        for (int ks = 0; ks < 2; ++ks) { zW[ks] = FRAG(Z, rt * 16, ks); zX[ks] = FRAG(Z, 64 + rt * 16, ks);
#pragma unroll
            for (int j = 0; j < 2; ++j) { bN[j][ks] = FRAG(NbrT, (ct0 + j) * 16, ks); bH[j][ks] = FRAG(BhT, (ct0 + j) * 16, ks); } }
#pragma unroll
        for (int j = 0; j < 2; ++j) { const int col = (ct0 + j) * 16 + li, rw = rt * 16 + lq * 4; rb[j] = *(const LAS v2u*)(Rab + col * RS + rw); kb[j] = *(const LAS v2u*)(KhT + col * RS + rw); nb2[j] = *(const LAS v2u*)((const LAS bf16*)(L + RA_NKRT) + col * RS + rw); gc[j] = gC[col]; }
#pragma unroll
        for (int j = 0; j < 2; ++j) { const int col = (ct0 + j) * 16 + li, rw = rt * 16 + lq * 4;
            { f32x4 acc = {bflo(rb[j].x), bfhi(rb[j].x), bflo(rb[j].y), bfhi(rb[j].y)};
                acc = MM(zW[1], bN[j][1], MM(zW[0], bN[j][0], acc));
                v2u pk; pk.x = pk2(acc.x, acc.y); pk.y = pk2(acc.z, acc.w); *(v2u*)(PoT + (size_t)col * 64 + rw) = pk; }
            { f32x4 acc = {(rw + 0 == col) ? gc[j] : 0.f, (rw + 1 == col) ? gc[j] : 0.f, (rw + 2 == col) ? gc[j] : 0.f, (rw + 3 == col) ? gc[j] : 0.f};
                acc = MM(zW[1], bH[j][1], MM(zW[0], bH[j][0], acc));
                v2u pk; pk.x = pk2(acc.x, acc.y); pk.y = pk2(acc.z, acc.w); *(v2u*)(PsT + (size_t)col * 64 + rw) = pk; }
            { f32x4 acc = {bflo(nb2[j].x), bfhi(nb2[j].x), bflo(nb2[j].y), bfhi(nb2[j].y)};
                acc = MM(zX[1], bN[j][1], MM(zX[0], bN[j][0], acc));
                v2u pk; pk.x = pk2(acc.x, acc.y); pk.y = pk2(acc.z, acc.w); *(LAS v2u*)(QoT + col * RS + rw) = pk; }
            { f32x4 acc = {bflo(kb[j].x), bfhi(kb[j].x), bflo(kb[j].y), bfhi(kb[j].y)};
                acc = MM(zX[1], bH[j][1], MM(zX[0], bH[j][0], acc));
                v2u pk; pk.x = pk2(acc.x, acc.y); pk.y = pk2(acc.z, acc.w); *(LAS v2u*)(QsT + col * RS + rw) = pk; }
        }
    }
    __syncthreads();
    {
        int t6 = tid; asm volatile("" : "+v"(t6)); const int li = t6 & 15, lq = (t6 >> 4) & 3;
        const LAS bf16* VT = (const LAS bf16*)(L + RA_VT);
        const bool isO = (w & 1);
        const LAS bf16* Bm = (const LAS bf16*)(L + (isO ? RA_QOT : RA_QST));
        float* dst = (float*)(A->ws + WS_RSC + (isO ? RWO_OLT : RWO_GT)) + (size_t)unit * 4096;
        bf16x8_t av[2], bq[4][2];
#pragma unroll
        for (int ks = 0; ks < 2; ++ks) { av[ks] = FRAG(VT, rt * 16, ks);
#pragma unroll
            for (int j = 0; j < 4; ++j) bq[j][ks] = FRAG(Bm, j * 16, ks); }
#pragma unroll
        for (int j = 0; j < 4; ++j) { const f32x4 z = {0.f, 0.f, 0.f, 0.f};
            const f32x4 acc = MM(av[1], bq[j][1], MM(av[0], bq[j][0], z));
            *(f32x4*)(dst + (size_t)(j * 16 + li) * 64 + rt * 16 + lq * 4) = acc; }
    }
#undef FRAG
#undef MM
    __syncthreads();
}

__device__ __forceinline__ void rwkvB_scan(ArgsP A, const Frame& F, int unit) {
    const int bh = unit >> 2, rq = unit & 3;
    const int tid = F.tid, lane = F.lane, w = F.wave, ct = w & 3, li = lane & 15, lq = lane >> 4;
    const bool writer = (w < 4);
    const bf16* PsT = (const bf16*)(A->ws + WS_RSC + RWO_PST) + (size_t)bh * 64 * 4096; const float* GT = (const float*)(A->ws + WS_RSC + RWO_GT) + (size_t)bh * 64 * 4096;
    bf16* SC = (bf16*)(A->ws + WS_RSC + RWO_SC) + (size_t)bh * 64 * 4096;
    f32x4 S = {0.f, 0.f, 0.f, 0.f};
    constexpr int PF = 4;
    bf16x8_t pb[PF][2]; f32x4 gq[PF];
    const int col = ct * 16 + li;
#define SLOAD(slot, cc_) do { _Pragma("unroll") for (int ks = 0; ks < 2; ++ks) pb[slot][ks] = *(const bf16x8_t*)(PsT + (size_t)(cc_) * 4096 + (size_t)col * 64 + ks * 32 + lq * 8); \
        gq[slot] = *(const f32x4*)(GT + (size_t)(cc_) * 4096 + (size_t)col * 64 + rq * 16 + lq * 4); } while (0)
#define SSTEP(slot, cc_) do { LAS bf16* Sl = (LAS bf16*)(F.lds + ((cc_) & 1) * 2176); \
        if (writer) { const int rw_ = lq * 4; Sl[(rw_ + 0) * RS + col] = (bf16)f2bf(S.x); Sl[(rw_ + 1) * RS + col] = (bf16)f2bf(S.y); Sl[(rw_ + 2) * RS + col] = (bf16)f2bf(S.z); Sl[(rw_ + 3) * RS + col] = (bf16)f2bf(S.w); } \
        asm volatile("s_waitcnt lgkmcnt(0)" ::: "memory"); __builtin_amdgcn_s_barrier(); asm volatile("" ::: "memory");        \
        if (tid < 128) { const int v_ = tid >> 3, k8_ = (tid & 7) * 8; *(v4u*)(SC + (size_t)(cc_) * 4096 + (rq * 16 + v_) * 64 + k8_) = *(const LAS v4u*)(Sl + v_ * RS + k8_); } \
        f32x4 acc_ = gq[slot]; \
        _Pragma("unroll") for (int ks = 0; ks < 2; ++ks) { const bf16x8_t a_ = *(const LAS bf16x8_t*)(Sl + li * RS + ks * 32 + lq * 8); \
            acc_ = __builtin_amdgcn_mfma_f32_16x16x32_bf16(a_, pb[slot][ks], acc_, 0, 0, 0); } \
        S = acc_; } while (0)
    SLOAD(0, 0); SLOAD(1, 1); SLOAD(2, 2); SLOAD(3, 3);
#pragma unroll 1
    for (int c = 0; c < 64; c += 4) {
        const int cn = (c + 4 < 64) ? c + 4 : 60;
        SSTEP(0, c);     SLOAD(0, cn);
        SSTEP(1, c + 1); SLOAD(1, cn + 1);
        SSTEP(2, c + 2); SLOAD(2, cn + 2);
        SSTEP(3, c + 3); SLOAD(3, cn + 3);
    }
#undef SLOAD
#undef SSTEP
    __syncthreads();
}

__device__ __forceinline__ void rwkvC_unit(ArgsP A, const Frame& F_in, int l, int unit) {
    Frame F = F_in; asm volatile("" : "+v"(F.tid)); F.lane = F.tid & 63;

    const int bh = unit >> 6, c = unit & 63, b = bh / RW_H, h = bh % RW_H, t0 = b * SEQ + c * 64, tid = F.tid, lane = F.lane, w = F.wave;
    const int rt = w >> 1, ct0 = (w & 1) * 2, li = lane & 15, lq = lane >> 4;
    LAS bf16* Sl = (LAS bf16*)F.lds; LAS bf16* Pl = (LAS bf16*)(F.lds + 8704); LAS float* ob = (LAS float*)(F.lds + 17408);
    { const int r = tid >> 3, k8 = (tid & 7) * 8;
        *(LAS v4u*)(Sl + r * RS + k8) = *(const v4u*)((const bf16*)(A->ws + WS_RSC + RWO_SC) + (size_t)unit * 4096 + r * 64 + k8);
        *(LAS v4u*)(Pl + r * RS + k8) = *(const v4u*)((const bf16*)(A->ws + WS_RSC + RWO_POT) + (size_t)unit * 4096 + r * 64 + k8); }
    __syncthreads();
    const float* OlT = (const float*)(A->ws + WS_RSC + RWO_OLT) + (size_t)unit * 4096;
#pragma unroll
    for (int j = 0; j < 2; ++j) { const int tcol = (ct0 + j) * 16 + li, vr = rt * 16 + lq * 4;
        f32x4 acc = *(const f32x4*)(OlT + (size_t)tcol * 64 + vr);
        acc = tile_mm64(Sl, rt * 16, Pl, (ct0 + j) * 16, acc, lane);
        *(LAS f32x4*)(ob + tcol * 68 + vr) = acc; }
    __syncthreads();
    { const int t = tid >> 3, q = tid & 7; const size_t tg = (size_t)t0 + t;
        const f32x4 o0 = *(const LAS f32x4*)(ob + t * 68 + q * 8), o1 = *(const LAS f32x4*)(ob + t * 68 + q * 8 + 4);
        const float mean = red8((o0.x + o0.y) + (o0.z + o0.w) + (o1.x + o1.y) + (o1.z + o1.w)) * (1.f / 64.f);
        const f32x4 d0 = o0 - mean, d1 = o1 - mean;
        const float var = red8((d0.x * d0.x + d0.y * d0.y) + (d0.z * d0.z + d0.w * d0.w) + (d1.x * d1.x + d1.y * d1.y) + (d1.z * d1.z + d1.w * d1.w)) * (1.f / 64.f);
        const float rs = rsqrtf(var + 64e-5f);
        const int cc = h * 64 + q * 8;
        const f32x4 g0 = *(const f32x4*)(A->in[20] + (size_t)l * RW_W + cc), g1 = *(const f32x4*)(A->in[20] + (size_t)l * RW_W + cc + 4);
        const f32x4 b0 = *(const f32x4*)(A->in[21] + (size_t)l * RW_W + cc), b1 = *(const f32x4*)(A->in[21] + (size_t)l * RW_W + cc + 4);
        const f32x4 bv0 = *(const f32x4*)((const float*)(A->ws + WS_RBV) + tg * RW_W + cc), bv1 = *(const f32x4*)((const float*)(A->ws + WS_RBV) + tg * RW_W + cc + 4);
        const f32x4 ga0 = *(const f32x4*)((const float*)(A->ws + WS_RGATE) + tg * RW_W + cc), ga1 = *(const f32x4*)((const float*)(A->ws + WS_RGATE) + tg * RW_W + cc + 4);
        const f32x4 y0 = (d0 * rs * g0 + b0 + bv0) * ga0, y1 = (d1 * rs * g1 + b1 + bv1) * ga1;
        v4u o; o.x = pk2(y0.x, y0.y); o.y = pk2(y0.z, y0.w); o.z = pk2(y1.x, y1.y); o.w = pk2(y1.z, y1.w);
        *(v4u*)((bf16*)(A->ws + WS_Y) + tg * DM + 1280 + cc) = o; }
    __syncthreads();
}

constexpr size_t RWO_GQ = 84 * MiB, RWO_GK = 92 * MiB, RWO_GVT = 100 * MiB, RWO_GEM = 116 * MiB;
constexpr int GQS = 104, GTS = 72;
template <int NKS> __device__ __forceinline__ f32x4 tile_mm(const LAS bf16* Am, int sa, int arow0, const LAS bf16* Bm, int sb, int brow0, f32x4 acc, int lane) {
    const int r = lane & 15, kq = (lane >> 4) * 8;
#pragma unroll
    for (int ks = 0; ks < NKS; ++ks) {
        const bf16x8_t a = *(const LAS bf16x8_t*)(Am + (arow0 + r) * sa + ks * 32 + kq);
        const bf16x8_t b = *(const LAS bf16x8_t*)(Bm + (brow0 + r) * sb + ks * 32 + kq);
        acc = __builtin_amdgcn_mfma_f32_16x16x32_bf16(a, b, acc, 0, 0, 0);
    }
    return acc;
}

__device__ __forceinline__ int gsw(int row) { return ((row >> 2) ^ (row >> 5)) & 7; }
__device__ __forceinline__ f32x4 tile_mm_sw(const LAS bf16* Am, int arow0, const LAS bf16* Bm, int brow0, f32x4 acc, int lane) {
    const int r = lane & 15, cq = lane >> 4, fa = gsw(arow0 + r), fb = gsw(brow0 + r);
#pragma unroll
    for (int ks = 0; ks < 2; ++ks) {
        const bf16x8_t a = *(const LAS bf16x8_t*)(Am + (arow0 + r) * GTS + (((ks * 4 + cq) ^ fa) << 3));
        const bf16x8_t b = *(const LAS bf16x8_t*)(Bm + (brow0 + r) * GTS + (((ks * 4 + cq) ^ fb) << 3));
        acc = __builtin_amdgcn_mfma_f32_16x16x32_bf16(a, b, acc, 0, 0, 0);
    }
    return acc;
}
__device__ __forceinline__ void gla1_unit(ArgsP A, const Frame& F_in, int l, int unit) {
    Frame F = F_in; asm volatile("" : "+v"(F.tid)); F.lane = F.tid & 63;
    const int bh = unit >> 6, c = unit & 63, b = bh >> 2, h = bh & 3, t0 = b * SEQ + c * 64, tid = F.tid, lane = F.lane, w = F.wave;
    const float* proj = (const float*)(A->ws + WS_PROJ);
    LAS float* bcum = (LAS float*)F.lds;
    LAS float* ad = bcum + 6144;
    LAS float* up = ad + 1024;
    LAS bf16* KtT = (LAS bf16*)(F.lds + 34816);
    LAS bf16* VT = (LAS bf16*)(F.lds + 48640);
    f32x4 qq[3], kq[3], vq[6];
#pragma unroll
    for (int it = 0; it < 3; ++it) { const int i = tid + it * NTHR, tok = i / 24, d4 = i % 24; const float* rp = proj + (size_t)(t0 + tok) * INWP + h * 96 + d4 * 4;
        qq[it] = *(const f32x4*)(rp + C_GQ); kq[it] = *(const f32x4*)(rp + C_GK); }
#pragma unroll
    for (int it = 0; it < 6; ++it) { const int i = tid + it * NTHR, tok = i / 48, e4 = i % 48; vq[it] = *(const f32x4*)(proj + (size_t)(t0 + tok) * INWP + C_GV + h * 192 + e4 * 4); }
    gla_bcum(A, F, l, h, t0, bcum, ad, up);
    const float qs = 0.10206207261596575f;
    bf16* Qg = (bf16*)(A->ws + WS_RSC + RWO_GQ) + (size_t)unit * 6144; bf16* Kg = (bf16*)(A->ws + WS_RSC + RWO_GK) + (size_t)unit * 6144;
#pragma unroll
    for (int it = 0; it < 3; ++it) { const int i = tid + it * NTHR, tok = i / 24, d = (i % 24) * 4;
        const float qv[4] = {qq[it].x, qq[it].y, qq[it].z, qq[it].w}, kv[4] = {kq[it].x, kq[it].y, kq[it].z, kq[it].w}; float qo[4], ko[4];
#pragma unroll
        for (int e = 0; e < 4; ++e) { const float m = bcum[31 * 96 + d + e], bb = bcum[tok * 96 + d + e];
            qo[e] = qv[e] * qs * __expf(bb - m); ko[e] = kv[e] * __expf(m - bb); KtT[(d + e) * GTS + ((((tok >> 3) ^ gsw(d + e)) << 3) | (tok & 7))] = (bf16)f2bf(ko[e]); }
        v2u pq, pk; pq.x = pk2(qo[0], qo[1]); pq.y = pk2(qo[2], qo[3]); pk.x = pk2(ko[0], ko[1]); pk.y = pk2(ko[2], ko[3]);
        *(v2u*)(Qg + tok * 96 + d) = pq; *(v2u*)(Kg + tok * 96 + d) = pk; }
#pragma unroll
    for (int it = 0; it < 6; ++it) { const int i = tid + it * NTHR, tok = i / 48, e = (i % 48) * 4;
        const int ts = tok >> 3, tl = tok & 7;
        VT[(e + 0) * GTS + (((ts ^ gsw(e + 0)) << 3) | tl)] = (bf16)f2bf(vq[it].x); VT[(e + 1) * GTS + (((ts ^ gsw(e + 1)) << 3) | tl)] = (bf16)f2bf(vq[it].y);
        VT[(e + 2) * GTS + (((ts ^ gsw(e + 2)) << 3) | tl)] = (bf16)f2bf(vq[it].z); VT[(e + 3) * GTS + (((ts ^ gsw(e + 3)) << 3) | tl)] = (bf16)f2bf(vq[it].w); }
    if (tid < 96) { ((float*)(A->ws + WS_RSC + RWO_GEM))[(size_t)unit * 96 + tid] = __expf(bcum[31 * 96 + tid]);
        ((float*)(A->ws + WS_GDEC))[(size_t)unit * 96 + tid] = __expf(bcum[63 * 96 + tid]); }
    __syncthreads();
    { bf16* VTg = (bf16*)(A->ws + WS_RSC + RWO_GVT) + (size_t)unit * 12288;
#pragma unroll
        for (int it = 0; it < 3; ++it) { const int i = tid + it * NTHR, e = i >> 3, t8 = (i & 7) * 8; *(v4u*)(VTg + e * 64 + t8) = *(const LAS v4u*)(VT + e * GTS + ((((i & 7) ^ gsw(e))) << 3)); } }
    { const int li = lane & 15, lq = lane >> 4;
        float* KVg = (float*)(A->ws + WS_GKV) + (size_t)unit * 18432;
#pragma unroll
        for (int a = 0; a < 3; ++a) { const int dt = (w & 1) * 3 + a, d0 = dt * 16 + lq * 4;
            const float s0 = __expf(bcum[63 * 96 + d0] - bcum[31 * 96 + d0]), s1 = __expf(bcum[63 * 96 + d0 + 1] - bcum[31 * 96 + d0 + 1]),
                        s2 = __expf(bcum[63 * 96 + d0 + 2] - bcum[31 * 96 + d0 + 2]), s3 = __expf(bcum[63 * 96 + d0 + 3] - bcum[31 * 96 + d0 + 3]);
#pragma unroll
            for (int bb = 0; bb < 3; ++bb) { const int et = (w >> 1) * 3 + bb; const f32x4 z = {0.f, 0.f, 0.f, 0.f};
                f32x4 acc = tile_mm_sw(KtT, dt * 16, VT, et * 16, z, lane);
                acc.x *= s0; acc.y *= s1; acc.z *= s2; acc.w *= s3;
                *(f32x4*)(KVg + (size_t)(et * 16 + li) * 96 + d0) = acc; } } }
    __syncthreads();
}

__device__ __forceinline__ void gla3_unit(ArgsP A, const Frame& F_in, int l, int unit) {
    Frame F = F_in; asm volatile("" : "+v"(F.tid)); F.lane = F.tid & 63;
    const int bh = unit >> 6, c = unit & 63, b = bh >> 2, h = bh & 3, t0 = b * SEQ + c * 64, tid = F.tid, lane = F.lane, w = F.wave;
    const int li = lane & 15, lq = lane >> 4;
    const float* proj = (const float*)(A->ws + WS_PROJ);
    LAS bf16* Qs = (LAS bf16*)F.lds;
    LAS bf16* Ks = (LAS bf16*)(F.lds + 13312);
    LAS bf16* VT = (LAS bf16*)(F.lds + 26624);
    LAS bf16* ST = (LAS bf16*)(F.lds + 54272);
    LAS bf16* att = (LAS bf16*)(F.lds + 94208);
    LAS float* ssq = (LAS float*)(F.lds + 103424);
    LAS float* em = (LAS float*)(F.lds + 103936);
    LAS float* ob = (LAS float*)(F.lds + 26624);
    {
        const v4u* Qg = (const v4u*)((const bf16*)(A->ws + WS_RSC + RWO_GQ) + (size_t)unit * 6144); const v4u* Kg = (const v4u*)((const bf16*)(A->ws + WS_RSC + RWO_GK) + (size_t)unit * 6144);
        const v4u* VTg = (const v4u*)((const bf16*)(A->ws + WS_RSC + RWO_GVT) + (size_t)unit * 12288);
        const f32x4* GS = (const f32x4*)((const float*)(A->ws + WS_GS) + (size_t)unit * 18432);
        v4u q0 = Qg[tid], k0 = Kg[tid], q1 = {0u, 0u, 0u, 0u}, k1 = {0u, 0u, 0u, 0u};
        if (tid < 256) { q1 = Qg[512 + tid]; k1 = Kg[512 + tid]; }
        v4u vt[3]; f32x4 sg[9];
#pragma unroll
        for (int it = 0; it < 3; ++it) vt[it] = VTg[tid + it * NTHR];
#pragma unroll
        for (int it = 0; it < 9; ++it) sg[it] = GS[tid + it * NTHR];
        if (tid < 96) em[tid] = ((const float*)(A->ws + WS_RSC + RWO_GEM))[(size_t)unit * 96 + tid];
        { const int i = tid, t = i / 12, c8 = (i % 12) * 8; *(LAS v4u*)(Qs + t * GQS + c8) = q0; *(LAS v4u*)(Ks + t * GQS + c8) = k0; }
        if (tid < 256) { const int i = 512 + tid, t = i / 12, c8 = (i % 12) * 8; *(LAS v4u*)(Qs + t * GQS + c8) = q1; *(LAS v4u*)(Ks + t * GQS + c8) = k1; }
#pragma unroll
        for (int it = 0; it < 3; ++it) { const int i = tid + it * NTHR, e = i >> 3, t8 = (i & 7) * 8; *(LAS v4u*)(VT + e * GTS + t8) = vt[it]; }
        __syncthreads();
#pragma unroll
        for (int it = 0; it < 9; ++it) { const int i = tid + it * NTHR, e = i / 24, d = (i % 24) * 4; const f32x4 m4 = *(const LAS f32x4*)(em + d);
            v2u pk; pk.x = pk2(sg[it].x * m4.x, sg[it].y * m4.y); pk.y = pk2(sg[it].z * m4.z, sg[it].w * m4.w); *(LAS v2u*)(ST + e * GQS + d) = pk; }
    }
    __syncthreads();
#pragma unroll
    for (int a = 0; a < 2; ++a) { const int jt = w >> 1, it = (w & 1) * 2 + a; const f32x4 z = {0.f, 0.f, 0.f, 0.f};
        f32x4 acc = z;
        if (jt <= it) acc = tile_mm<3>(Ks, GQS, jt * 16, Qs, GQS, it * 16, z, lane);
        const int i = it * 16 + li, j0 = jt * 16 + lq * 4;
        acc.x = (j0 + 0 <= i) ? acc.x : 0.f; acc.y = (j0 + 1 <= i) ? acc.y : 0.f; acc.z = (j0 + 2 <= i) ? acc.z : 0.f; acc.w = (j0 + 3 <= i) ? acc.w : 0.f;
        v2u pk; pk.x = pk2(acc.x, acc.y); pk.y = pk2(acc.z, acc.w); *(LAS v2u*)(att + i * GTS + j0) = pk; }
    __syncthreads();
    f32x4 o[6];
    { const int it = w >> 1;
#pragma unroll
        for (int a = 0; a < 6; ++a) { const int et = (w & 1) * 6 + a; const f32x4 z = {0.f, 0.f, 0.f, 0.f};
            f32x4 acc = tile_mm<2>(att, GTS, it * 16, VT, GTS, et * 16, z, lane);
            o[a] = tile_mm<3>(Qs, GQS, it * 16, ST, GQS, et * 16, acc, lane); }
        float s0 = 0.f, s1 = 0.f, s2 = 0.f, s3 = 0.f;
#pragma unroll
        for (int a = 0; a < 6; ++a) { s0 += o[a].x * o[a].x; s1 += o[a].y * o[a].y; s2 += o[a].z * o[a].z; s3 += o[a].w * o[a].w; }
        s0 = row16_sum(s0); s1 = row16_sum(s1); s2 = row16_sum(s2); s3 = row16_sum(s3);
        if (li == 0) { const int r0 = it * 16 + lq * 4; ssq[(r0 + 0) * 2 + (w & 1)] = s0; ssq[(r0 + 1) * 2 + (w & 1)] = s1; ssq[(r0 + 2) * 2 + (w & 1)] = s2; ssq[(r0 + 3) * 2 + (w & 1)] = s3; }
    }
    __syncthreads();
    { const int it = w >> 1, r0 = it * 16 + lq * 4;
#pragma unroll
        for (int a = 0; a < 6; ++a) { const int e = ((w & 1) * 6 + a) * 16 + li;
            ob[(r0 + 0) * 196 + e] = o[a].x; ob[(r0 + 1) * 196 + e] = o[a].y; ob[(r0 + 2) * 196 + e] = o[a].z; ob[(r0 + 3) * 196 + e] = o[a].w; } }
    __syncthreads();
    { bf16* Y = (bf16*)(A->ws + WS_Y);
        f32x4 gv[6];
#pragma unroll
        for (int k = 0; k < 6; ++k) { const int i = tid + k * NTHR, t = i / 48, e = (i % 48) * 4; gv[k] = *(const f32x4*)(proj + (size_t)(t0 + t) * INWP + C_GG + h * 192 + e); }
#pragma unroll
        for (int k = 0; k < 6; ++k) { const int i = tid + k * NTHR, t = i / 48, e = (i % 48) * 4;
            const float rstd = rsqrtf((ssq[t * 2] + ssq[t * 2 + 1]) * (1.f / 192.f) + NORM_EPS);
            const f32x4 ov = *(const LAS f32x4*)(ob + t * 196 + e); const f32x4 ng = *(const f32x4*)(A->in[10] + (size_t)l * 768 + h * 192 + e);
            f32x4 y; y.x = ov.x * rstd * ng.x * gv[k].x * sigmoidf_(gv[k].x); y.y = ov.y * rstd * ng.y * gv[k].y * sigmoidf_(gv[k].y);
            y.z = ov.z * rstd * ng.z * gv[k].z * sigmoidf_(gv[k].z); y.w = ov.w * rstd * ng.w * gv[k].w * sigmoidf_(gv[k].w);
            v2u pk; pk.x = pk2(y.x, y.y); pk.y = pk2(y.z, y.w); *(v2u*)(Y + (size_t)(t0 + t) * DM + 512 + h * 192 + e) = pk; } }
    __syncthreads();
}

#define INS16(L, P, x, px) do { { const bool c_ = (x) > L[15]; L[15] = c_ ? (x) : L[15]; P[15] = c_ ? (px) : P[15]; } \
    _Pragma("unroll") for (int r_ = 14; r_ >= 0; --r_) { const bool c_ = L[r_ + 1] > L[r_]; const float tl_ = L[r_]; const int tp_ = P[r_]; \
        L[r_] = c_ ? L[r_ + 1] : tl_; L[r_ + 1] = c_ ? tl_ : L[r_ + 1]; P[r_] = c_ ? P[r_ + 1] : tp_; P[r_ + 1] = c_ ? tp_ : P[r_ + 1]; } } while (0)

__device__ __forceinline__ float gelu_as(float v) {
    const float av = fabsf(v), t = __builtin_amdgcn_rcpf(av * 0.2316418882f + 1.0f);
    float q = t * 0.5307027145f + (-0.7265760135f); q = q * t + 0.7107068705f; q = q * t + (-0.142248368f); q = q * t + 0.127414796f; q = q * t;
    const float e = __builtin_amdgcn_exp2f((v * v) * (-0.72134752044f));
    const float m = v * (q * e);
    return v < 0.f ? m : v - m;
}
__device__ __forceinline__ int row16_sum_i(int v) {
    v += __builtin_amdgcn_update_dpp(0, v, 0xB1, 0xF, 0xF, true); v += __builtin_amdgcn_update_dpp(0, v, 0x4E, 0xF, 0xF, true);
    v += __builtin_amdgcn_update_dpp(0, v, 0x141, 0xF, 0xF, true); v += __builtin_amdgcn_update_dpp(0, v, 0x140, 0xF, 0xF, true); return v;
}
#ifndef PEER_SL_SHIFT
#define PEER_SL_SHIFT 10
#endif
__device__ __forceinline__ void ph_peer4(ArgsP A, LAS unsigned char* lds_, int wv_, int l, const float* g2, const float* sh2, const float* ngain, const float* nsh, const float* nsc, const bool last, const bool dry = false) {
    const Frame F = make_frame(lds_, wv_);
    const int lane = F.lane, li = lane & 15, lq = lane >> 4;
    const float* SCO = (const float*)(A->ws + WS_PROJ);
    const unsigned char* U4 = A->ws + WS_U + (size_t)l * PEER_N * (DM / 2); const unsigned char* V4 = A->ws + WS_V + (size_t)l * PEER_N * (DM / 2);
    const float* US = (const float*)(A->ws + WS_US) + (size_t)l * PEER_N; const float* VS = (const float*)(A->ws + WS_VS) + (size_t)l * PEER_N;
    float* X = (float*)(A->ws + WS_X); bf16* H = (bf16*)(A->ws + WS_H); const float* ssr = (const float*)(A->ws + WS_SSP) + (size_t)l * NT * 32;
    LAS unsigned char* wl = F.lds + F.wave * 15104;
    LAS int* es = (LAS int*)wl; LAS float* gs = (LAS float*)(wl + 4096);
    LAS v4u* hl = (LAS v4u*)wl;
    LAS int* se = (LAS int*)(wl + 8448);
    LAS float* sg = (LAS float*)(wl + 10496);
    LAS int* st = (LAS int*)(wl + 12544);
    LAS float* dl = (LAS float*)(wl + 14592);
    LAS float* hsl = dl + 64; LAS int* hsi = (LAS int*)(dl + 68);
    for (int tb = F.gw * 4; tb < NT; tb += F.ngw * 4) {
        {
            int P2[16]; float gt[16];
            const int prob = tb * 16 + lane, half = lane & 1;
            const f32x4* s4 = (const f32x4*)(SCO + (size_t)prob * 128);
            int KK[16];
#pragma unroll
            for (int r = 0; r < 16; ++r) KK[r] = (int)0x80000000;
            f32x4 nv[4];
#pragma unroll
            for (int i = 0; i < 4; ++i) nv[i] = s4[i];
#define KINS(x_, idx_) do { const int b_ = __builtin_bit_cast(int, (float)(x_)); int k_ = b_ ^ ((b_ >> 31) & 0x7fffffff); k_ = (k_ & ~127) | (127 - (idx_)); \
        _Pragma("unroll") for (int r_ = 0; r_ < 16; ++r_) { const int hi_ = KK[r_] > k_ ? KK[r_] : k_; k_ = KK[r_] > k_ ? k_ : KK[r_]; KK[r_] = hi_; } } while (0)
#pragma unroll 1
            for (int q = 0; q < 8; ++q) {
                f32x4 v[4];
#pragma unroll
                for (int i = 0; i < 4; ++i) v[i] = nv[i];
                if (q < 7) {
#pragma unroll
                    for (int i = 0; i < 4; ++i) nv[i] = s4[4 * (q + 1) + i]; }
                _Pragma("unroll") for (int r = 0; r < 16; ++r) asm volatile("" : "+v"(KK[r]));
#pragma unroll
                for (int i = 0; i < 4; ++i) { const int ib = 16 * q + 4 * i;
                    KINS(v[i].x, ib); KINS(v[i].y, ib + 1); KINS(v[i].z, ib + 2); KINS(v[i].w, ib + 3); }
            }
#undef KINS
            float v1[16], v2[16];
            LAS int* gsi = (LAS int*)gs;
#pragma unroll
            for (int r = 0; r < 16; ++r) { const int ok = __builtin_amdgcn_update_dpp(0, KK[r], 0xB1, 0xF, 0xF, true);
                const int k1 = half ? ok : KK[r], k2 = half ? KK[r] : ok; const int a1 = k1 & ~127, a2 = k2 & ~127;
                v1[r] = __builtin_bit_cast(float, a1 ^ ((a1 >> 31) & 0x7fffffff)); v2[r] = __builtin_bit_cast(float, a2 ^ ((a2 >> 31) & 0x7fffffff));
                es[r * 64 + lane] = 127 - (k1 & 127); gsi[r * 64 + lane] = 127 - (k2 & 127); }
            int Q[16];
#define MKKEY2(a_, b_) ({ const int bb_ = __builtin_bit_cast(int, v1[a_] + v2[b_]); const int kk_ = bb_ ^ ((bb_ >> 31) & 0x7fffffff); (kk_ & ~255) | (255 - ((a_) * 16 + (b_))); })
#pragma unroll
            for (int bq = 0; bq < 16; ++bq) Q[bq] = MKKEY2(0, bq);
#pragma unroll
            for (int a = 1; a < 16; ++a)
#pragma unroll
                for (int bq = 0; bq < 16; ++bq) if ((a + 1) * (bq + 1) <= 16) { int k_ = MKKEY2(a, bq);
#pragma unroll
                    for (int r = (a + 1) * (bq + 1) - 1; r < 16; ++r) { const int hi_ = Q[r] > k_ ? Q[r] : k_; k_ = Q[r] > k_ ? k_ : Q[r]; Q[r] = hi_; } }
#undef MKKEY2
            float L2[16];
#pragma unroll
            for (int r = 0; r < 16; ++r) { const int ab = 255 - (Q[r] & 255); const int qv = Q[r] & ~255; L2[r] = __builtin_bit_cast(float, qv ^ ((qv >> 31) & 0x7fffffff));
                P2[r] = es[(ab >> 4) * 64 + lane] * 128 + gsi[(ab & 15) * 64 + lane]; }
            float sum = 0.f;
#pragma unroll
            for (int r = 0; r < 16; ++r) { gt[r] = __expf(L2[r] - L2[0]); sum += gt[r]; }
            const float inv = 1.f / sum;
#pragma unroll
            for (int r = 0; r < 16; ++r) { es[r * 64 + lane] = P2[r]; gs[r * 64 + lane] = gt[r] * inv; }
            asm volatile("s_waitcnt lgkmcnt(0)" ::: "memory");
        }
        {
            int ee[8]; float gg[8];
#pragma unroll
            for (int j = 0; j < 8; ++j) { const int x = j * 64 + lane, k = x >> 7, y = x & 127; ee[j] = es[(y & 15) * 64 + k * 16 + 2 * (y >> 4)]; gg[j] = gs[(y & 15) * 64 + k * 16 + 2 * (y >> 4)]; }
            int base = 0;
#pragma unroll
            for (int p = 0; p < 2; ++p) {
#pragma unroll 1
                for (int s = 0; s < (16384 >> PEER_SL_SHIFT); ++s) {
#pragma unroll
                    for (int jj = 0; jj < 4; ++jj) { const int j = p * 4 + jj; const bool in = (ee[j] >> PEER_SL_SHIFT) == s; const unsigned long long m = __builtin_amdgcn_ballot_w64(in);
                        if (in) { const int pos = base + (int)__builtin_amdgcn_mbcnt_hi((unsigned)(m >> 32), __builtin_amdgcn_mbcnt_lo((unsigned)m, 0u)); se[pos] = ee[j]; sg[pos] = gg[j]; st[pos] = j >> 1; }
                        base += __builtin_popcountll(m); }
                }
            }
        }
        asm volatile("s_waitcnt lgkmcnt(0)" ::: "memory");
#pragma unroll 1
        for (int k = 0; k < 4; ++k) {
            const int t = tb + k, b = t >> 12;
            float hf[32]; float mx = 0.f;
            const v4u* hp = (const v4u*)(H + (size_t)t * DM);
#pragma unroll
            for (int jj = 0; jj < 2; ++jj)
#pragma unroll
                for (int c = 0; c < 2; ++c) { const v4u hv = hp[(jj * 64 + lane) * 2 + c]; const int o = jj * 16 + c * 8;
                    hf[o + 0] = bflo(hv.x); hf[o + 1] = bfhi(hv.x); hf[o + 2] = bflo(hv.y); hf[o + 3] = bfhi(hv.y); hf[o + 4] = bflo(hv.z); hf[o + 5] = bfhi(hv.z); hf[o + 6] = bflo(hv.w); hf[o + 7] = bfhi(hv.w); }
            { const float rstd = rsqrtf(wave_sum(lane < 32 ? ssr[(size_t)t * 32 + lane] : 0.f) * (1.f / DM) + NORM_EPS);
#pragma unroll
                for (int jj = 0; jj < 2; ++jj)
#pragma unroll
                    for (int q = 0; q < 4; ++q) { const f32x4 s4 = *(const f32x4*)(sh2 + (size_t)b * MODW + (jj * 64 + lane) * 16 + 4 * q);
                        hf[jj * 16 + 4 * q] = hf[jj * 16 + 4 * q] * rstd + s4.x; hf[jj * 16 + 4 * q + 1] = hf[jj * 16 + 4 * q + 1] * rstd + s4.y;
                        hf[jj * 16 + 4 * q + 2] = hf[jj * 16 + 4 * q + 2] * rstd + s4.z; hf[jj * 16 + 4 * q + 3] = hf[jj * 16 + 4 * q + 3] * rstd + s4.w; } }
#pragma unroll
            for (int i = 0; i < 32; ++i) mx = fmaxf(mx, fabsf(hf[i]));
            mx = wave_max(mx);
            const float inv = mx > 0.f ? 127.f / mx : 0.f;
            if (lane == 0) hsl[k] = mx * (1.f / 127.f);
            int hsum = 0;
#pragma unroll
            for (int jj = 0; jj < 2; ++jj) { unsigned qd[4];
#pragma unroll
                for (int d = 0; d < 4; ++d) { const int o = jj * 16 + 4 * d; const int q0 = (int)rintf(hf[o] * inv), q1 = (int)rintf(hf[o + 1] * inv), q2 = (int)rintf(hf[o + 2] * inv), q3 = (int)rintf(hf[o + 3] * inv);
                    qd[d] = (unsigned)(q0 & 255) | ((unsigned)(q1 & 255) << 8) | ((unsigned)(q2 & 255) << 16) | ((unsigned)(q3 & 255) << 24); hsum += (q0 + q1) + (q2 + q3); }
                v4u q; q.x = qd[0]; q.y = qd[1]; q.z = qd[2]; q.w = qd[3]; hl[k * 132 + jj * 64 + lane] = q; }
            { hsum = row16_sum_i(hsum); const int hs_all = __builtin_amdgcn_readlane(hsum, 0) + __builtin_amdgcn_readlane(hsum, 16) + __builtin_amdgcn_readlane(hsum, 32) + __builtin_amdgcn_readlane(hsum, 48);
                if (lane == 0) hsi[k] = hs_all; }
        }
        asm volatile("s_waitcnt lgkmcnt(0)" ::: "memory");
        {
            v4i ub0[8], ub1[8];
            int lu = lane; asm volatile("" : "+v"(lu)); const int li = lu & 15, lq = lu >> 4;
            const LAS v4u* hb = hl + (li & 3) * 132 + lq;
#define ULOAD(buf, g_, sg_) do { const int my_e_ = se[(g_) * 16 + li]; const unsigned char* ub_ = U4 + (size_t)my_e_ * (DM / 2) + lq * 16 + (sg_) * 512; \
    _Pragma("unroll") for (int s8 = 0; s8 < 8; ++s8) buf[s8] = *(const v4i*)(ub_ + s8 * 64); } while (0)
#define UCONS(buf, sg_) do { _Pragma("unroll") for (int s8 = 0; s8 < 8; ++s8) { const int c_ = (sg_) * 8 + s8; \
        const v4i lo_ = buf[s8] & 0x0F0F0F0F, hi_ = (buf[s8] >> 4) & 0x0F0F0F0F; \
        const v4i hb0_ = *(const LAS v4i*)(hb + c_ * 4), hb1_ = *(const LAS v4i*)(hb + 64 + c_ * 4); \
        acc = __builtin_amdgcn_mfma_i32_16x16x64_i8(lo_, hb0_, acc, 0, 0, 0); acc = __builtin_amdgcn_mfma_i32_16x16x64_i8(hi_, hb1_, acc, 0, 0, 0); } } while (0)
            ULOAD(ub0, 0, 0);
#pragma unroll 1
            for (int g = 0; g < 32; ++g) {
                const int gn = g + 1 < 32 ? g + 1 : 31;
                v4i acc = {0, 0, 0, 0};
                ULOAD(ub1, g, 1);
                UCONS(ub0, 0); ULOAD(ub0, gn, 0);
                UCONS(ub1, 1);
                if (li < 4) { const int hc = 8 * hsi[li];
                    dl[(4 * lq + 0) * 4 + li] = (float)(acc.x - hc); dl[(4 * lq + 1) * 4 + li] = (float)(acc.y - hc); dl[(4 * lq + 2) * 4 + li] = (float)(acc.z - hc); dl[(4 * lq + 3) * 4 + li] = (float)(acc.w - hc); }
                if (lane < 16) { const int x = g * 16 + lane; const int e = se[x], tk = st[x];
                    sg[x] = sg[x] * VS[e] * gelu_as(dl[lane * 4 + tk] * (US[e] * hsl[tk])); }
            }
#undef ULOAD
#undef UCONS
        }
        asm volatile("s_waitcnt lgkmcnt(0)" ::: "memory");
#define PEER_EPILOGUE(kk_, kt_) do { const int t = tb + (kt_), b = t >> 12; float (&out_k)[32] = out[kk_]; \
            f32x4 xn[2][4]; float ss = 0.f; \
            const f32x4* xr = (const f32x4*)(X + (size_t)t * DM); const f32x4* gr = (const f32x4*)(g2 + (size_t)b * MODW); \
            _Pragma("unroll") \
            for (int jj = 0; jj < 2; ++jj) \
            _Pragma("unroll") \
                for (int q = 0; q < 4; ++q) { const int ix = (jj * 64 + lane) * 4 + q; const f32x4 xv = xr[ix], gv = gr[ix]; f32x4 o4; o4.x = out_k[jj * 16 + 4 * q]; o4.y = out_k[jj * 16 + 4 * q + 1]; o4.z = out_k[jj * 16 + 4 * q + 2]; o4.w = out_k[jj * 16 + 4 * q + 3]; \
                    const f32x4 y = xv + gv * o4; xn[jj][q] = y; ss += (y.x * y.x + y.y * y.y) + (y.z * y.z + y.w * y.w); } \
            const float rstd = rsqrtf(wave_sum(ss) * (1.f / DM) + NORM_EPS); \
            if (!last) { \
                f32x4* xw = (f32x4*)((dry ? (float*)(A->ws + WS_DUMMY) : X) + (size_t)t * DM); v4u* hw = (v4u*)((dry ? (bf16*)(A->ws + WS_DUMMY + 64 * MiB) : H) + (size_t)t * DM); \
            _Pragma("unroll") \
                for (int jj = 0; jj < 2; ++jj) { f32x4 y[4]; \
            _Pragma("unroll") \
                    for (int q = 0; q < 4; ++q) { const int ix = (jj * 64 + lane) * 4 + q; xw[ix] = xn[jj][q]; \
                        const f32x4 g = ((const f32x4*)ngain)[ix], s1 = ((const f32x4*)(nsc + (size_t)b * MODW))[ix], s0 = ((const f32x4*)(nsh + (size_t)b * MODW))[ix]; \
                        y[q] = xn[jj][q] * rstd * g * (s1 + 1.f) + s0; } \
                    v4u o; o.x = pk2(y[0].x, y[0].y); o.y = pk2(y[0].z, y[0].w); o.z = pk2(y[1].x, y[1].y); o.w = pk2(y[1].z, y[1].w); hw[(jj * 64 + lane) * 2] = o; \
                    o.x = pk2(y[2].x, y[2].y); o.y = pk2(y[2].z, y[2].w); o.z = pk2(y[3].x, y[3].y); o.w = pk2(y[3].z, y[3].w); hw[(jj * 64 + lane) * 2 + 1] = o; } \
            } else { \
                f32x4* ow = (f32x4*)((dry ? (float*)(A->ws + WS_DUMMY) : A->out) + (size_t)t * DM); \
            _Pragma("unroll") \
                for (int jj = 0; jj < 2; ++jj) \
            _Pragma("unroll") \
                    for (int q = 0; q < 4; ++q) { const int ix = (jj * 64 + lane) * 4 + q; ow[ix] = xn[jj][q] * rstd * ((const f32x4*)ngain)[ix]; } \
            } \
        } while (0)
#define VLOAD(buf, cfb, tkb, bi_) do { _Pragma("unroll") for (int i = 0; i < 4; ++i) { const int x_ = (bi_) * 4 + i; const int e_ = __builtin_amdgcn_readfirstlane(se[x_]); \
        cfb[i] = __builtin_bit_cast(float, __builtin_amdgcn_readfirstlane(__builtin_bit_cast(int, sg[x_]))); tkb[i] = __builtin_amdgcn_readfirstlane(st[x_]) & 1; \
        const v2u* vp_ = (const v2u*)(V4 + (size_t)e_ * (DM / 2)) + lane_v; buf[i][0] = vp_[0]; buf[i][1] = vp_[64]; } } while (0)
#define VACC(kk_, bv_, cv_) do { const f32x2 c2_ = {cv_, cv_}; \
        _Pragma("unroll") for (int jj = 0; jj < 2; ++jj) { const unsigned wd_[2] = {bv_[jj].x, bv_[jj].y}; \
            _Pragma("unroll") for (int d = 0; d < 2; ++d) { const int o_ = jj * 16 + 8 * d; \
                const f32x2 f0_ = __builtin_amdgcn_cvt_scalef32_pk_f32_fp4((int)wd_[d], 1.0f, 0), f1_ = __builtin_amdgcn_cvt_scalef32_pk_f32_fp4((int)wd_[d], 1.0f, 1), \
                            f2_ = __builtin_amdgcn_cvt_scalef32_pk_f32_fp4((int)wd_[d], 1.0f, 2), f3_ = __builtin_amdgcn_cvt_scalef32_pk_f32_fp4((int)wd_[d], 1.0f, 3); \
                f32x2 a0_ = {out[kk_][o_], out[kk_][o_ + 1]}, a1_ = {out[kk_][o_ + 2], out[kk_][o_ + 3]}, a2_ = {out[kk_][o_ + 4], out[kk_][o_ + 5]}, a3_ = {out[kk_][o_ + 6], out[kk_][o_ + 7]}; \
                a0_ = __builtin_elementwise_fma(c2_, f0_, a0_); a1_ = __builtin_elementwise_fma(c2_, f1_, a1_); a2_ = __builtin_elementwise_fma(c2_, f2_, a2_); a3_ = __builtin_elementwise_fma(c2_, f3_, a3_); \
                out[kk_][o_] = a0_.x; out[kk_][o_ + 1] = a0_.y; out[kk_][o_ + 2] = a1_.x; out[kk_][o_ + 3] = a1_.y; out[kk_][o_ + 4] = a2_.x; out[kk_][o_ + 5] = a2_.y; out[kk_][o_ + 6] = a3_.x; out[kk_][o_ + 7] = a3_.y; } } } while (0)
#define VCONS(buf, cfb, tkb) do { _Pragma("unroll") for (int i = 0; i < 4; ++i) { if (tkb[i] == 0) VACC(0, buf[i], cfb[i]); else VACC(1, buf[i], cfb[i]); } } while (0)
#pragma unroll 1
        for (int p = 0; p < 2; ++p) {
            int lane_v = F.lane; asm volatile("" : "+v"(lane_v));
            float out[2][32];
#pragma unroll
            for (int k = 0; k < 2; ++k)
#pragma unroll
                for (int i = 0; i < 32; ++i) out[k][i] = 0.f;
            {
                v2u vb0[4][2], vb1[4][2]; float c0[4], c1[4]; int t0v[4], t1v[4];
                const int bb = p * 64;
                VLOAD(vb0, c0, t0v, bb); VLOAD(vb1, c1, t1v, bb + 1);
#pragma unroll 1
                for (int bi = 0; bi < 64; bi += 2) {
                    const int b2 = bb + (bi + 2 < 64 ? bi + 2 : 62), b3 = bb + (bi + 3 < 64 ? bi + 3 : 63);
                    VCONS(vb0, c0, t0v); VLOAD(vb0, c0, t0v, b2);
                    VCONS(vb1, c1, t1v); VLOAD(vb1, c1, t1v, b3);
                }
            }
            PEER_EPILOGUE(0, 2 * p); PEER_EPILOGUE(1, 2 * p + 1);
        }
#undef VLOAD
#undef VACC
#undef VCONS
#undef PEER_EPILOGUE
    }
}

__device__ __forceinline__ void PH_norm1_l0(LAS unsigned char* lds, int wv) { ArgsP A = args_ptr(); const float* MOD = (const float*)(A->ws + WS_MOD);
    ph_norm(A->in[0], A->in[4], MOD + 0 * DM, MOD + 1 * DM, (bf16*)(A->ws + WS_H), lds, wv);
    { const Frame F = make_frame(lds, wv); float* B3 = (float*)(A->ws + WS_BIAS3);
        for (int o = F.gw; o < DEPTH * 2 * DM; o += F.ngw) { const int l = o >> 12, b = (o >> 11) & 1, n = o & 2047;
            const float* sh = MOD + (size_t)(l * 2 + b) * MODW + 3 * DM; const v4u* wr = (const v4u*)((const bf16*)(A->ws + WS_WQK) + ((size_t)l * DM + n) * DM);
            float s = 0.f;
#pragma unroll
            for (int j = 0; j < 4; ++j) { const v4u wv4 = wr[j * 64 + F.lane]; const f32x4 s0 = *(const f32x4*)(sh + (j * 64 + F.lane) * 8), s1 = *(const f32x4*)(sh + (j * 64 + F.lane) * 8 + 4);
                s += bflo(wv4.x) * s0.x + bfhi(wv4.x) * s0.y + bflo(wv4.y) * s0.z + bfhi(wv4.y) * s0.w + bflo(wv4.z) * s1.x + bfhi(wv4.z) * s1.y + bflo(wv4.w) * s1.z + bfhi(wv4.w) * s1.w; }
            s = wave_sum(s);
            if (F.lane == 0) B3[o] = s; } } }
__device__ __forceinline__ void PH_gemm1(LAS unsigned char* lds, int wv, int l_) { ArgsP A = args_ptr(); const int l = opaque_i(l_);
    pg8::Gemm g{(const bf16*)(A->ws + WS_H), (const bf16*)(A->ws + WS_WIN) + (size_t)l * INWP * DM, NT, INWP, DM}; pg8::StaticOrder S; S.init(NT, INWP, gridDim.x, blockIdx.x);
    EpiStoreF32 E{(float*)(A->ws + WS_PROJ), INWP, wv};
    pg8::gemm_phase<EpiStoreF32, pg8::StaticOrder, true, true>(lds, g, S, E, wv); }
__device__ __forceinline__ void PH_mixA(LAS unsigned char* lds, int wv, int l_) { ArgsP A = args_ptr(); const int l = opaque_i(l_);
    const Frame F = make_frame(lds, wv);
#ifdef PROBE_A
    for (int u = F.bid; u < 2048; u += F.G) {
        if (u < 1536) { if (PROBE_A == 1) rwkvA_unit(A, F, l, u); }
        else { if (PROBE_A == 2) gla1_unit(A, F, l, u - 1536); }
    }
#endif
    for (int u = F.bid; u < 2048; u += F.G) {
        if (u < 1536) rwkvA_unit(A, F, l, u);
        else gla1_unit(A, F, l, u - 1536);
    }
    if (l + 1 < DEPTH) quant_tables(A, l + 1, F.gw, F.ngw, F.lane);
}
__device__ __forceinline__ void PH_mixB(LAS unsigned char* lds, int wv, int l_) { ArgsP A = args_ptr(); const int l = opaque_i(l_);
    const Frame F = make_frame(lds, wv);
    if (F.G >= 192) {
        if (F.bid < 96) rwkvB_scan(A, F, F.bid);
        else { const int nb = F.G - 96, b2 = F.bid - 96;
            for (int u = b2; u < 288; u += nb) gla_scan_unit(A, F, u);
            for (int u = b2; u < 1024; u += nb) pool_unit(A, F, l, u); }
    } else {
        for (int u = F.bid; u < 288; u += F.G) gla_scan_unit(A, F, u);
        for (int u = F.bid; u < 1024; u += F.G) pool_unit(A, F, l, u);
        for (int u = F.bid; u < 96; u += F.G) rwkvB_scan(A, F, u);
    } }
__device__ __forceinline__ void PH_mixC(LAS unsigned char* lds, int wv, int l_) { ArgsP A = args_ptr(); const int l = opaque_i(l_);
    const Frame F = make_frame(lds, wv);
#ifdef PROBE_C
    for (int u = F.bid; u < 2048; u += F.G) { if (u < 512) { if (PROBE_C == 1) gla3_unit(A, F, l, u); } else { if (PROBE_C == 2) rwkvC_unit(A, F, l, u - 512); } }
#endif
    for (int u = F.bid; u < 2048; u += F.G) { if (u < 512) gla3_unit(A, F, l, u); else rwkvC_unit(A, F, l, u - 512); } }
__device__ __forceinline__ void PH_gemm2(LAS unsigned char* lds, int wv, int l_, bool dry = false) { ArgsP A = args_ptr(); const int l = opaque_i(l_);
    const float* modl = (const float*)(A->ws + WS_MOD) + (size_t)l * 2 * MODW; float* X = (float*)(A->ws + WS_X);
    pg8::Gemm g{(const bf16*)(A->ws + WS_Y), (const bf16*)(A->ws + WS_WOUT) + (size_t)l * DM * DM, NT, DM, DM}; pg8::StaticOrder S; S.init(NT, DM, gridDim.x, blockIdx.x);
    EpiResid E{(l == 0) ? A->in[0] : (const float*)X, dry ? (float*)(A->ws + WS_DUMMY) : X, modl + 2 * DM, wv, A->in[23] + (size_t)l * DM, modl + 4 * DM,
               dry ? (bf16*)(A->ws + WS_DUMMY + 64 * MiB) : (bf16*)(A->ws + WS_H), (dry ? (float*)(A->ws + WS_DUMMY) : (float*)(A->ws + WS_SSP) + (size_t)l * NT * 32)};
    pg8::gemm_phase<EpiResid, pg8::StaticOrder, true, true>(lds, g, S, E, wv); }
__device__ __forceinline__ void PH_norm2(LAS unsigned char* lds, int wv, int l_) { ArgsP A = args_ptr(); const int l = opaque_i(l_);
    const float* modl = (const float*)(A->ws + WS_MOD) + (size_t)l * 2 * MODW;
    ph_norm((const float*)(A->ws + WS_X), A->in[23] + (size_t)l * DM, modl + 3 * DM, modl + 4 * DM, (bf16*)(A->ws + WS_H), lds, wv); }
__device__ __forceinline__ void PH_gemm3(LAS unsigned char* lds, int wv, int l_) { ArgsP A = args_ptr(); const int l = opaque_i(l_);
    pg8::Gemm g{(const bf16*)(A->ws + WS_H), (const bf16*)(A->ws + WS_WQK) + (size_t)l * DM * DM, NT, DM, DM}; pg8::StaticOrder S; S.init(NT, DM, gridDim.x, blockIdx.x);
    LAS float* rs = (LAS float*)(lds + 131072);
    { pg8::Unit u0; const int t = tid_from(wv); if (S.next(0, u0) && t < 256) { const f32x4* sp = (const f32x4*)((const float*)(A->ws + WS_SSP) + ((size_t)l * NT + u0.pm * 256 + t) * 32); float s = 0.f;
#pragma unroll
            for (int j = 0; j < 8; ++j) { const f32x4 v = sp[j]; s += (v.x + v.y) + (v.z + v.w); }
            rs[t] = rsqrtf(s * (1.f / DM) + NORM_EPS); }
        __syncthreads(); }
    EpiScore E{(float*)(A->ws + WS_PROJ), DM, wv, rs, (const float*)(A->ws + WS_BIAS3) + (size_t)l * 2 * DM};
    pg8::gemm_phase<EpiScore, pg8::StaticOrder, true, true>(lds, g, S, E, wv); }
__device__ __forceinline__ void PH_peer(LAS unsigned char* lds, int wv, int l_, bool dry = false) { ArgsP A = args_ptr(); const int l = opaque_i(l_);
    const float* MOD = (const float*)(A->ws + WS_MOD); const float* modl = MOD + (size_t)l * 2 * MODW;
    const bool last = (l == DEPTH - 1);
    const float* nmod = MOD + (size_t)(last ? l : l + 1) * 2 * MODW;
    ph_peer4(A, lds, wv, l, modl + 5 * DM, modl + 3 * DM, last ? A->in[29] : A->in[4] + (size_t)(l + 1) * DM, nmod + 0 * DM, nmod + 1 * DM, last, dry); }

__global__ void __launch_bounds__(NTHR, 2) mega_fwd(Args args) {
    extern __shared__ __attribute__((aligned(16))) unsigned char lds_raw[];
    LAS unsigned char* lds = (LAS unsigned char*)lds_raw;
    volatile LAS unsigned* MISC = (volatile LAS unsigned*)(lds + MISC_OFF);
    const int wv = __builtin_amdgcn_readfirstlane((int)(threadIdx.x >> 6));
    if (wv == 0) MISC[lane_id_()] = 0u;
    __syncthreads();
    XcdBarrier bar = xcd_barrier_post((unsigned*)(args_ptr()->ws + WS_CTL) + CW_BAR, MISC + 8, wv);
#define GRID_BAR() do { XcdBarrier b_ = bar; b_.bar = (unsigned*)(args_ptr()->ws + WS_CTL) + CW_BAR; asm volatile("" : "+s"(b_.x), "+s"(b_.w)); xcd_barrier(b_); if (PROBE & 512) xcd_barrier(b_); } while (0)

    ph_prologue(args_ptr(), lds, wv);
    GRID_BAR();
#if PROBE & 1
    ph_prologue(args_ptr(), lds, wv); GRID_BAR();
#endif
    PH_norm1_l0(lds, wv);
    GRID_BAR();
    for (int l = 0; l < DEPTH; ++l) {
#if PROBE & 2
        PH_gemm1(lds, wv, l); GRID_BAR();
#endif
        PH_gemm1(lds, wv, l); GRID_BAR();
#if PROBE & 4
        PH_mixA(lds, wv, l);  GRID_BAR();
#endif
        PH_mixA(lds, wv, l);  GRID_BAR();
#if PROBE & 8
        PH_mixB(lds, wv, l);  GRID_BAR();
#endif
        PH_mixB(lds, wv, l);  GRID_BAR();
#if PROBE & 16
        PH_mixC(lds, wv, l);  GRID_BAR();
#endif
        PH_mixC(lds, wv, l);  GRID_BAR();
#if PROBE & 32
        PH_gemm2(lds, wv, l, true); GRID_BAR();
#endif
        PH_gemm2(lds, wv, l); GRID_BAR();
#if PROBE & 128
        PH_gemm3(lds, wv, l); GRID_BAR();
#endif
        PH_gemm3(lds, wv, l); GRID_BAR();
#if PROBE & 256
        PH_peer(lds, wv, l, true); GRID_BAR();
#endif
        PH_peer(lds, wv, l);
        if (l + 1 < DEPTH) GRID_BAR();
    }
}

extern "C" void kernel_launch(void* const* d_in, const int* in_sizes, int n_in, void* d_out, int out_size, void* d_ws, size_t ws_size, hipStream_t stream) {
    static int grid = 0;
    if (grid == 0) {
        if (n_in != 30 || out_size != NT * DM || ws_size < WS_END + 96 * MiB) { fprintf(stderr, "kernel_launch: unexpected shapes (n_in %d out %d ws %zu)\n", n_in, out_size, ws_size); grid = -1; return; }
        int dev = 0, cus = 0, per_cu = 0;
        if (hipGetDevice(&dev) != hipSuccess || hipDeviceGetAttribute(&cus, hipDeviceAttributeMultiprocessorCount, dev) != hipSuccess) { grid = -1; return; }
        if (hipFuncSetAttribute((const void*)mega_fwd, hipFuncAttributeMaxDynamicSharedMemorySize, LDS_BYTES) != hipSuccess) { fprintf(stderr, "kernel_launch: hipFuncSetAttribute failed\n"); grid = -1; return; }
        if (hipOccupancyMaxActiveBlocksPerMultiprocessor(&per_cu, (const void*)mega_fwd, NTHR, LDS_BYTES) != hipSuccess || per_cu < 1) { fprintf(stderr, "kernel_launch: occupancy query says %d\n", per_cu); (void)hipGetLastError(); per_cu = 1; }
        grid = cus;
    }
    if (grid < 0) return;
    (void)in_sizes;
    if (hipMemsetAsync((char*)d_ws + WS_CTL, 0, CTL_ZERO_BYTES, stream) != hipSuccess) return;
    Args a{};
    for (int i = 0; i < 30; ++i) a.in[i] = (const float*)d_in[i];
    a.out = (float*)d_out; a.ws = (unsigned char*)d_ws;
    hipLaunchKernelGGL(mega_fwd, dim3(grid), dim3(NTHR), LDS_BYTES, stream, a);
}
```

```cpp
#include <hip/hip_runtime.h>
#include <cstdio>
#include <cstdint>
__device__ __forceinline__ int lane_id_() { int r; asm volatile("v_mbcnt_lo_u32_b32 %0, -1, 0\n\tv_mbcnt_hi_u32_b32 %0, -1, %0" : "=v"(r)); return r; }
__device__ __forceinline__ int tid_from(int wave_s) { return wave_s * 64 + lane_id_(); }
namespace pg8 {
#define PG8_LAS __attribute__((address_space(3)))
typedef unsigned short bf16_t;
typedef short bf16x8 __attribute__((ext_vector_type(8)));
typedef float f32x4 __attribute__((ext_vector_type(4)));
typedef unsigned u32x4 __attribute__((ext_vector_type(4)));
constexpr int BM = 256, BK = 64, HALF = 128, HTB = HALF * BK * 2  , STAGE_BYTES = 8 * HTB, NXCD = 8, WGM = 8;

__host__ __device__ __forceinline__ int lds_byte(int r, int c) { const int st = (r >> 4) * 2 + (c >> 5), rr = r & 15, cc = c & 31, ob = rr * 64 + cc * 2; return st * 1024 + (ob ^ (((ob >> 9) & 1) << 5)); }
__host__ __device__ __forceinline__ void stage_rc(int b, int& R, int& C) { const int st = b / 1024, sb = b % 1024, swz = sb ^ (((sb >> 9) & 1) << 5); R = (st >> 1) * 16 + swz / 64; C = (st & 1) * 32 + (swz % 64) / 2; }
__host__ __device__ __forceinline__ int perm32(int rho) { const int n = rho >> 4, i = rho & 15; return 8 * (i >> 2) + 4 * n + (i & 3); }

struct Unit { int pm, pn; };
struct Gemm { const bf16_t* A; const bf16_t* Bt; int M, N, K; };

struct StaticOrder {
    int nM, nN, nwg, G, c;
    __host__ __device__ void init(int M, int N, int G_, int c_) { nM = M / BM; nN = N / BM; nwg = nM * nN; G = G_; c = c_; }
    __host__ __device__ bool next(int i, Unit& u) const {
        const long L = (long)i * G + c; if (L >= nwg) return false;
        int wgid = (int)L; { const int q = nwg / NXCD, r = nwg % NXCD, xcd = wgid % NXCD, off = wgid / NXCD; wgid = (xcd < r ? xcd * (q + 1) : r * (q + 1) + (xcd - r) * q) + off; }
        const int nig = WGM * nN, gid = wgid / nig, fm = gid * WGM, gsz = (nM - fm) < WGM ? (nM - fm) : WGM;
        u.pm = fm + ((wgid % nig) % gsz); u.pn = (wgid % nig) / gsz; return true;
    }
    __device__ __forceinline__ void a_ready(const Unit&) const {}
    __device__ __forceinline__ void done(const Unit&) const {}
};

template <class Epi, class Sched, bool ALIGN_EPI = false, bool SP2 = false>
__device__ __forceinline__ void gemm_phase(PG8_LAS unsigned char* lds, const Gemm g, const Sched& S, const Epi& E, int wave_s) {
    int tid_o = tid_from(wave_s); asm volatile("" : "+v"(tid_o));
    const int tid = tid_o, wid = __builtin_amdgcn_readfirstlane(tid >> 6), lane = tid & 63, wr = wid >> 2, wc = wid & 3, fr = lane & 15, fq = lane >> 4;
    const int K = g.K, nt = K / BK;
    unsigned voffA[2], voffB[2];
#pragma unroll
    for (int i = 0; i < 2; ++i) { int R, C; stage_rc(tid * 16 + i * 8192, R, C); const int Rb = Epi::PERM ? ((R & ~31) + perm32(R & 31)) : R;
        voffA[i] = (unsigned)(R * K + C) * 2u; voffB[i] = (unsigned)(Rb * K + C) * 2u; }
    const size_t kstep = (size_t)(BK * 2);
    const size_t hstep = (size_t)HALF * K * 2;
    const size_t tstep = 2 * hstep;
    const unsigned ldsw = (unsigned)wid * 1024u;
    const int aoff = lds_byte(wr * 64 + fr, fq * 8), boff = lds_byte(wc * 32 + fr, fq * 8);
#define PG8_SA(b, h) (((b) * 2 + (h)) * HTB)
#define PG8_SB(b, h) ((4 + (b) * 2 + (h)) * HTB)
#define PG8_STAGE(bufoff, gbase, voff) do { _Pragma("unroll") for (int _i = 0; _i < 2; ++_i) \
        __builtin_amdgcn_global_load_lds((const unsigned*)((const char*)(gbase) + (voff)[_i]), (PG8_LAS unsigned*)(lds + (bufoff) + ldsw + _i * 8192), 16, 0, 0); } while (0)
#define PG8_LDA(dst, b, h) do { _Pragma("unroll") for (int m = 0; m < 4; ++m) _Pragma("unroll") for (int k = 0; k < 2; ++k) dst[m][k] = *(const PG8_LAS bf16x8*)(lds + PG8_SA(b, h) + aoff + m * 2048 + k * 1024); } while (0)
#define PG8_LDB(dst, b, h) do { _Pragma("unroll") for (int n = 0; n < 2; ++n) _Pragma("unroll") for (int k = 0; k < 2; ++k) dst[n][k] = *(const PG8_LAS bf16x8*)(lds + PG8_SB(b, h) + boff + n * 2048 + k * 1024); } while (0)
#define PG8_MMA(ai, bj, At, Bt) do { __builtin_amdgcn_s_setprio(1); _Pragma("unroll") for (int m = 0; m < 4; ++m) _Pragma("unroll") for (int n = 0; n < 2; ++n) _Pragma("unroll") for (int k = 0; k < 2; ++k) \
        acc[ai][bj][m][n] = __builtin_amdgcn_mfma_f32_16x16x32_bf16(Bt[n][k], At[m][k], acc[ai][bj][m][n], 0, 0, 0); __builtin_amdgcn_s_setprio(0); } while (0)
#define PG8_WAIT_V(n) asm volatile("s_waitcnt vmcnt(" #n ")" ::: "memory")
#define PG8_WAIT_L(n) asm volatile("s_waitcnt lgkmcnt(" #n ")" ::: "memory")
#define PG8_BAR __builtin_amdgcn_s_barrier()
#define PG8_SCHED __builtin_amdgcn_sched_barrier(0)
    Unit cur, nxt; int ui = 0;
    if (!S.next(0, cur)) return;
    f32x4 acc[2][2][4][2];
#pragma unroll
    for (int a = 0; a < 2; ++a)
#pragma unroll
        for (int b = 0; b < 2; ++b)
#pragma unroll
            for (int m = 0; m < 4; ++m)
#pragma unroll
                for (int n = 0; n < 2; ++n) acc[a][b][m][n] = (f32x4){0.f, 0.f, 0.f, 0.f};
    bf16x8 At[4][2], B0[2][2], B1[2][2];
    const char* cA = (const char*)g.A + (size_t)cur.pm * tstep; const char* cB = (const char*)g.Bt + (size_t)cur.pn * tstep;
    S.a_ready(cur);
    if constexpr (SP2) {
        PG8_STAGE(PG8_SB(0, 0), cB, voffB); PG8_STAGE(PG8_SB(0, 1), cB + hstep, voffB); PG8_STAGE(PG8_SA(0, 0), cA, voffA); PG8_STAGE(PG8_SA(0, 1), cA + hstep, voffA);
        if (wr == 1) PG8_BAR;
        PG8_WAIT_V(2); PG8_BAR;
        PG8_STAGE(PG8_SB(1, 0), cB + kstep, voffB); PG8_STAGE(PG8_SA(1, 0), cA + kstep, voffA); PG8_STAGE(PG8_SB(1, 1), cB + hstep + kstep, voffB);
        PG8_WAIT_V(6); PG8_BAR;
    } else {
        PG8_STAGE(PG8_SB(0, 0), cB, voffB); PG8_STAGE(PG8_SA(0, 0), cA, voffA); PG8_STAGE(PG8_SB(0, 1), cB + hstep, voffB); PG8_STAGE(PG8_SA(0, 1), cA + hstep, voffA);
        if (wr == 1) PG8_BAR;
        PG8_WAIT_V(4); PG8_BAR;
        PG8_STAGE(PG8_SB(1, 0), cB + kstep, voffB); PG8_STAGE(PG8_SA(1, 0), cA + kstep, voffA); PG8_STAGE(PG8_SB(1, 1), cB + hstep + kstep, voffB);
        PG8_WAIT_V(6); PG8_BAR;
    }
    for (;;) {
        const bool has_next = S.next(ui + 1, nxt);
        const char* nA = has_next ? (const char*)g.A + (size_t)nxt.pm * tstep : cA; const char* nB = has_next ? (const char*)g.Bt + (size_t)nxt.pn * tstep : cB;
        for (int t = 0; t < nt; t += 2) {
            const bool last = (t == nt - 2);
            const char* a1 = cA + (size_t)(t + 1) * kstep;
            const char* a2 = last ? nA : cA + (size_t)(t + 2) * kstep; const char* b2 = last ? nB : cB + (size_t)(t + 2) * kstep;
            const char* a3 = a2 + kstep; const char* b3 = b2 + kstep;
            if (last && has_next) S.a_ready(nxt);
            if constexpr (SP2) {
            PG8_LDB(B0, 0, 0); PG8_LDB(B1, 0, 1); PG8_SCHED; PG8_LDA(At, 0, 0); PG8_STAGE(PG8_SA(1, 1), a1 + hstep, voffA);
            PG8_WAIT_V(8); PG8_WAIT_L(0); PG8_BAR; PG8_MMA(0, 0, At, B0); PG8_MMA(0, 1, At, B1); PG8_BAR; PG8_SCHED;
            PG8_LDA(At, 0, 1); PG8_STAGE(PG8_SB(0, 0), b2, voffB); PG8_STAGE(PG8_SB(0, 1), b2 + hstep, voffB); PG8_STAGE(PG8_SA(0, 0), a2, voffA);
            PG8_WAIT_V(8); PG8_WAIT_L(0); PG8_BAR; PG8_MMA(1, 0, At, B0); PG8_MMA(1, 1, At, B1); PG8_BAR; PG8_SCHED;
            PG8_LDB(B0, 1, 0); PG8_LDB(B1, 1, 1); PG8_SCHED; PG8_LDA(At, 1, 0); PG8_STAGE(PG8_SA(0, 1), a2 + hstep, voffA);
            PG8_WAIT_V(8); PG8_WAIT_L(0); PG8_BAR; PG8_MMA(0, 0, At, B0); PG8_MMA(0, 1, At, B1); PG8_BAR; PG8_SCHED;
            PG8_LDA(At, 1, 1); PG8_STAGE(PG8_SB(1, 0), b3, voffB); PG8_STAGE(PG8_SB(1, 1), b3 + hstep, voffB); PG8_STAGE(PG8_SA(1, 0), a3, voffA);
            PG8_WAIT_V(8); PG8_WAIT_L(0); PG8_BAR; PG8_MMA(1, 0, At, B0); PG8_MMA(1, 1, At, B1); PG8_BAR; PG8_SCHED;
            } else {
            PG8_LDB(B0, 0, 0); PG8_SCHED; PG8_LDA(At, 0, 0); PG8_STAGE(PG8_SA(1, 1), a1 + hstep, voffA);
            PG8_WAIT_L(8); PG8_BAR; PG8_WAIT_L(0); PG8_MMA(0, 0, At, B0); PG8_BAR; PG8_SCHED;
            PG8_LDB(B1, 0, 1); PG8_STAGE(PG8_SB(0, 0), b2, voffB);
            PG8_BAR; PG8_WAIT_L(0); PG8_MMA(0, 1, At, B1); PG8_BAR;
            PG8_LDA(At, 0, 1); PG8_STAGE(PG8_SA(0, 0), a2, voffA);
            PG8_BAR; PG8_WAIT_L(0); PG8_MMA(1, 0, At, B0); PG8_BAR; PG8_SCHED;
            PG8_STAGE(PG8_SB(0, 1), b2 + hstep, voffB);
            PG8_WAIT_V(6); PG8_BAR; PG8_MMA(1, 1, At, B1); PG8_BAR;
            PG8_LDB(B0, 1, 0); PG8_SCHED; PG8_LDA(At, 1, 0); PG8_STAGE(PG8_SA(0, 1), a2 + hstep, voffA);
            PG8_WAIT_L(8); PG8_BAR; PG8_WAIT_L(0); PG8_MMA(0, 0, At, B0); PG8_BAR; PG8_SCHED;
            PG8_LDB(B1, 1, 1); PG8_STAGE(PG8_SB(1, 0), b3, voffB);
            PG8_BAR; PG8_WAIT_L(0); PG8_MMA(0, 1, At, B1); PG8_BAR;
            PG8_LDA(At, 1, 1); PG8_STAGE(PG8_SA(1, 0), a3, voffA);
            PG8_BAR; PG8_WAIT_L(0); PG8_MMA(1, 0, At, B0); PG8_BAR; PG8_SCHED;
            PG8_STAGE(PG8_SB(1, 1), b3 + hstep, voffB);
            PG8_WAIT_V(6); PG8_BAR; PG8_MMA(1, 1, At, B1); PG8_BAR;
            }
        }
        if constexpr (ALIGN_EPI) { if (wr == 0) PG8_BAR; }
        if constexpr (!Epi::AFTER_DRAIN) { E(acc, cur, wr, wc, fr, fq); S.done(cur); }
        if (!has_next) break;
#pragma unroll
        for (int a = 0; a < 2; ++a)
#pragma unroll
            for (int b = 0; b < 2; ++b)
#pragma unroll
                for (int m = 0; m < 4; ++m)
#pragma unroll
                    for (int n = 0; n < 2; ++n) acc[a][b][m][n] = (f32x4){0.f, 0.f, 0.f, 0.f};
        cur = nxt; cA = nA; cB = nB; ++ui;
        if constexpr (ALIGN_EPI) { if (wr == 1) PG8_BAR; }
    }
    PG8_WAIT_V(0);
    if constexpr (!ALIGN_EPI) { if (wr == 0) PG8_BAR; }
    PG8_BAR;
    if constexpr (Epi::AFTER_DRAIN) { E.fused(acc, cur, wr, wc, fr, fq, lds, wid, lane); S.done(cur); }
#undef PG8_SA
#undef PG8_SB
#undef PG8_STAGE
#undef PG8_LDA
#undef PG8_LDB
#undef PG8_MMA
#undef PG8_WAIT_V
#undef PG8_WAIT_L
#undef PG8_BAR
#undef PG8_SCHED
}
}
#define GAS __attribute__((address_space(1)))
#define LAS __attribute__((address_space(3)))
#define XB_TMO      128
#define XB_XCNT(j)  (256  + 64 * (j))
#define XB_XSUB(j)  (1280 + 64 * (j))
#define XB_XGEN(j)  (2304 + 64 * (j))
#define XB_TOP      3328
#define XB_TOPGEN   3392
#define XCD_BAR_WORDS 3456
#define XB_SPIN_CAP (1u << 18)

__device__ __forceinline__ unsigned xb_ld(unsigned* p)              { return __hip_atomic_load(p, __ATOMIC_RELAXED, __HIP_MEMORY_SCOPE_AGENT); }
__device__ __forceinline__ unsigned xb_add(unsigned* p, unsigned v) { return __hip_atomic_fetch_add(p, v, __ATOMIC_RELAXED, __HIP_MEMORY_SCOPE_AGENT); }
__device__ __forceinline__ unsigned xb_xcc_id() { return (unsigned)__builtin_amdgcn_s_getreg((3 << 11) | 20) & 0xFu; }
#define XB_SPIN(cond, bar) do { unsigned _sp = 0; while (cond) { __builtin_amdgcn_s_sleep(1); \
    if ((++_sp & 255u) == 0u) { if (xb_ld(&(bar)[XB_TMO])) break; if (_sp > XB_SPIN_CAP) { atomicAdd(&(bar)[XB_TMO], 1u); break; } } } } while (0)

struct XcdBarrier {
    unsigned* bar; unsigned x; int w;
    volatile LAS unsigned* st;
};

__device__ __forceinline__ XcdBarrier xcd_barrier_post(unsigned* bar, volatile LAS unsigned* st, int wave_s) {
    XcdBarrier b; b.bar = bar; b.x = xb_xcc_id(); b.st = st; b.w = wave_s;
    if (tid_from(wave_s) == 0) (void)xb_add(&bar[XB_XCNT(b.x)], 1u);
    return b;
}
__device__ __forceinline__ void xcd_barrier_complete(unsigned* bar, unsigned x, unsigned& nloc, unsigned& nx) {
    const unsigned G = gridDim.x * gridDim.y * gridDim.z;
    unsigned sum, cnt, mine, sp = 0u;
    for (;;) {
        sum = 0u; cnt = 0u; mine = 0u;
#pragma unroll
        for (unsigned j = 0; j < 16; ++j) { const unsigned c = xb_ld(&bar[XB_XCNT(j)]); sum += c; cnt += (c > 0u) ? 1u : 0u; mine = (j == x) ? c : mine; }
        if (sum == G) break;
        __builtin_amdgcn_s_sleep(1);
        if ((++sp & 255u) == 0u) { if (xb_ld(&bar[XB_TMO])) break; if (sp > XB_SPIN_CAP) { atomicAdd(&bar[XB_TMO], 1u); break; } }
    }
    nloc = mine > 0u ? mine : 1u; nx = cnt > 0u ? cnt : 1u;
}

__device__ __forceinline__ void xcd_barrier(const XcdBarrier& b) {
    asm volatile("s_waitcnt vmcnt(0)" ::: "memory");
    __syncthreads();
    if (tid_from(b.w) == 0) {
        unsigned* bar = b.bar;
        __builtin_amdgcn_s_waitcnt(0);
        unsigned nloc = b.st[0], nx = b.st[1];
        if (nloc == 0u) { xcd_barrier_complete(bar, b.x, nloc, nx); b.st[0] = nloc; b.st[1] = nx; }
        const unsigned old = xb_add(&bar[XB_XSUB(b.x)], 1u);
        const unsigned gen = old / nloc;
        if (old + 1u == (gen + 1u) * nloc) {
            __builtin_amdgcn_fence(__ATOMIC_RELEASE, "agent");
            asm volatile("s_waitcnt vmcnt(0)" ::: "memory");
            const unsigned og = xb_add(&bar[XB_TOP], 1u);
            const unsigned tg = og / nx;
            if (og + 1u == (tg + 1u) * nx) xb_add(&bar[XB_TOPGEN], 1u);
            else XB_SPIN(xb_ld(&bar[XB_TOPGEN]) == tg, bar);
            __builtin_amdgcn_fence(__ATOMIC_ACQUIRE, "agent");
            xb_add(&bar[XB_XGEN(b.x)], 1u);
            asm volatile("s_waitcnt vmcnt(0)" ::: "memory");
        } else {
            XB_SPIN(xb_ld(&bar[XB_XGEN(b.x)]) == gen, bar);
            __builtin_amdgcn_fence(__ATOMIC_ACQUIRE, "agent");
            asm volatile("s_waitcnt vmcnt(0)" ::: "memory");
        }
    }
    __syncthreads();
}

constexpr int NWAVES = 8, NTHR = 512;
constexpr int DM = 2048, NB = 2, SEQ = 4096, NT = NB * SEQ, DEPTH = 4;
constexpr int INW = 5392, INWP = 5632;
constexpr int C_POOL = 0, C_GQ = 512, C_GK = 896, C_GV = 1280, C_GG = 2048, C_GA = 2816, C_RW = 2832;
constexpr int RW_IN = 2560, RW_W = 768, RW_H = 12;
constexpr int GLA_H = 4, GLA_DK = 96, GLA_DV = 192, GLA_NCH = 64;
constexpr int PEER_N = 16384;
constexpr float NORM_EPS = 1e-6f;
constexpr int MODW = 6 * DM;

constexpr size_t MiB = 1u << 20;
constexpr size_t WS_CTL = 0, CTL_ZERO_BYTES = 1 * MiB;
constexpr size_t WS_MOD = 1 * MiB;
constexpr size_t WS_WIN = 2 * MiB;
constexpr size_t WS_WOUT = 90 * MiB;
constexpr size_t WS_WQK = 122 * MiB;
constexpr size_t WS_U = 154 * MiB;
constexpr size_t WS_V = 410 * MiB;
constexpr size_t WS_US = 540 * MiB;
constexpr size_t WS_VS = 541 * MiB;
constexpr size_t WS_POOLT = 545 * MiB;
constexpr size_t WS_LORAT = 542 * MiB;
constexpr size_t WS_X = 666 * MiB;
constexpr size_t WS_H = 730 * MiB;
constexpr size_t WS_Y = 762 * MiB;
constexpr size_t WS_PROJ = 794 * MiB;
constexpr size_t WS_GKV = 970 * MiB;
constexpr size_t WS_GS = 1006 * MiB;
constexpr size_t WS_GDEC = 1042 * MiB;
constexpr size_t WS_RSC = 1043 * MiB;
constexpr size_t WS_RO = 1187 * MiB;
constexpr size_t WS_RGATE = 1211 * MiB;
constexpr size_t WS_RBV = 1235 * MiB;
constexpr size_t WS_EIDX = 1259 * MiB;
constexpr size_t WS_EGATE = 1263 * MiB;
constexpr size_t WS_END = 1267 * MiB;
constexpr size_t WS_DUMMY = 1267 * MiB;
#ifndef PROBE
#define PROBE 0
#endif
constexpr int CW_BAR = 4096;
constexpr size_t WS_SSP = 547 * MiB;
constexpr size_t WS_BIAS3 = 546 * MiB;

constexpr int LDS_BYTES = 147456;
constexpr int MISC_OFF = 147456 - 256;

typedef unsigned short bf16;
typedef unsigned v4u __attribute__((ext_vector_type(4)));
typedef unsigned v2u __attribute__((ext_vector_type(2)));
typedef float f32x4 __attribute__((ext_vector_type(4)));
typedef float f32x2 __attribute__((ext_vector_type(2)));
typedef __bf16 bf16x2_t __attribute__((ext_vector_type(2)));
typedef int v4i __attribute__((ext_vector_type(4)));

__device__ __forceinline__ unsigned pk2(float lo, float hi) { const f32x2 f = {lo, hi}; return __builtin_bit_cast(unsigned, __builtin_convertvector(f, bf16x2_t)); }
__device__ __forceinline__ unsigned f2bf(float f) { return pk2(f, f) & 0xffffu; }
__device__ __forceinline__ float bflo(unsigned u) { return __builtin_bit_cast(float, u << 16); }
__device__ __forceinline__ float bfhi(unsigned u) { return __builtin_bit_cast(float, u & 0xffff0000u); }
__device__ __forceinline__ float dpp_xor1(float v) { return __builtin_bit_cast(float, __builtin_amdgcn_update_dpp(0, __builtin_bit_cast(int, v), 0xB1, 0xF, 0xF, true)); }
__device__ __forceinline__ float dpp_xor2(float v) { return __builtin_bit_cast(float, __builtin_amdgcn_update_dpp(0, __builtin_bit_cast(int, v), 0x4E, 0xF, 0xF, true)); }
__device__ __forceinline__ float dpp_hmir(float v) { return __builtin_bit_cast(float, __builtin_amdgcn_update_dpp(0, __builtin_bit_cast(int, v), 0x141, 0xF, 0xF, true)); }
__device__ __forceinline__ float dpp_rmir(float v) { return __builtin_bit_cast(float, __builtin_amdgcn_update_dpp(0, __builtin_bit_cast(int, v), 0x140, 0xF, 0xF, true)); }
__device__ __forceinline__ float rl_f(float v, int l) { return __builtin_bit_cast(float, __builtin_amdgcn_readlane(__builtin_bit_cast(int, v), l)); }
__device__ __forceinline__ float row16_sum(float v) { v += dpp_xor1(v); v += dpp_xor2(v); v += dpp_hmir(v); v += dpp_rmir(v); return v; }
__device__ __forceinline__ float row16_max(float v) { v = fmaxf(v, dpp_xor1(v)); v = fmaxf(v, dpp_xor2(v)); v = fmaxf(v, dpp_hmir(v)); v = fmaxf(v, dpp_rmir(v)); return v; }
__device__ __forceinline__ float wave_sum(float v) { v = row16_sum(v); return (rl_f(v, 0) + rl_f(v, 16)) + (rl_f(v, 32) + rl_f(v, 48)); }
__device__ __forceinline__ float wave_max(float v) { v = row16_max(v); return fmaxf(fmaxf(rl_f(v, 0), rl_f(v, 16)), fmaxf(rl_f(v, 32), rl_f(v, 48))); }
__device__ __forceinline__ float half32_sum(float v, int lane) { v = row16_sum(v); const float lo = rl_f(v, 0) + rl_f(v, 16), hi = rl_f(v, 32) + rl_f(v, 48); return lane < 32 ? lo : hi; }
__device__ __forceinline__ float red8(float v) { v += dpp_xor1(v); v += dpp_xor2(v); v += dpp_hmir(v); return v; }
__device__ __forceinline__ float sigmoidf_(float x) { return __builtin_amdgcn_rcpf(1.f + __builtin_amdgcn_exp2f(-1.4426950408889634f * x)); }
__device__ __forceinline__ float softplusf_(float x) { return fmaxf(x, 0.f) + 0.6931471805599453f * __builtin_amdgcn_logf(1.f + __builtin_amdgcn_exp2f(-1.4426950408889634f * fabsf(x))); }

struct Args { const float* in[30]; float* out; unsigned char* ws; };
typedef const __attribute__((address_space(4))) Args* ArgsP;
__device__ __forceinline__ ArgsP args_ptr() { ArgsP p = (ArgsP)__builtin_amdgcn_kernarg_segment_ptr(); asm volatile("" : "+s"(p)); return p; }
__device__ __forceinline__ int opaque_i(int v) { asm volatile("" : "+s"(v)); return v; }

struct Frame {
    LAS unsigned char* lds;
    int tid, lane, wave, G, bid, gw, ngw;
};
__device__ __forceinline__ Frame make_frame(LAS unsigned char* lds, int wave_s) {
    asm volatile("" : "+s"(wave_s)); Frame F; F.lds = lds; int t = tid_from(wave_s); asm volatile("" : "+v"(t));
    F.tid = t; F.lane = t & 63; F.wave = __builtin_amdgcn_readfirstlane(t >> 6); int g_ = gridDim.x, b_ = blockIdx.x; asm volatile("" : "+s"(g_), "+s"(b_)); F.G = g_; F.bid = b_; F.gw = F.bid * NWAVES + F.wave; F.ngw = F.G * NWAVES; return F;
}

struct EpiStoreF32 {
    static constexpr bool PERM = false, AFTER_DRAIN = false;
    float* C; int ldc; int ws_;
    __device__ __forceinline__ void operator()(const pg8::f32x4 (&acc)[2][2][4][2], const pg8::Unit& u, int, int, int, int) const {
        int tz = tid_from(ws_); asm volatile("" : "+v"(tz)); const int wid = tz >> 6, lane = tz & 63, wr = wid >> 2, wc = wid & 3, fr = lane & 15, fq = lane >> 4;
        const int row0 = u.pm * 256 + wr * 64 + fr, col0 = u.pn * 256 + wc * 32 + 4 * fq;
#pragma unroll
        for (int ai = 0; ai < 2; ++ai)
#pragma unroll
            for (int m = 0; m < 4; ++m) { float* rowp = C + (size_t)(row0 + ai * 128 + m * 16) * ldc + col0;
#pragma unroll
                for (int bj = 0; bj < 2; ++bj)
#pragma unroll
                    for (int n = 0; n < 2; ++n) *(pg8::f32x4*)(rowp + bj * 128 + n * 16) = acc[ai][bj][m][n]; }
    }
};
struct EpiResid {
    static constexpr bool PERM = false, AFTER_DRAIN = false;
    const float* xsrc; float* xdst; const float* gate; int ws_; const float* gain2; const float* sc2; bf16* hdst; float* ss;
    __device__ __forceinline__ void operator()(const pg8::f32x4 (&acc)[2][2][4][2], const pg8::Unit& u, int, int, int, int) const {
        int tz = tid_from(ws_); asm volatile("" : "+v"(tz)); const int wid = tz >> 6, lane = tz & 63, wr = wid >> 2, wc = wid & 3, fr = lane & 15, fq = lane >> 4;
        const int row0 = u.pm * 256 + wr * 64 + fr, col0 = u.pn * 256 + wc * 32 + 4 * fq;
        const float* gp = gate + (size_t)(u.pm >> 4) * MODW + col0; const float* sp = sc2 + (size_t)(u.pm >> 4) * MODW + col0;
        pg8::f32x4 gv[2][2], hv[2][2];
#pragma unroll
        for (int bj = 0; bj < 2; ++bj)
#pragma unroll
            for (int n = 0; n < 2; ++n) { gv[bj][n] = *(const pg8::f32x4*)(gp + bj * 128 + n * 16);
                hv[bj][n] = *(const pg8::f32x4*)(gain2 + col0 + bj * 128 + n * 16) * (*(const pg8::f32x4*)(sp + bj * 128 + n * 16) + 1.f); }
#pragma unroll
        for (int ai = 0; ai < 2; ++ai)
#pragma unroll
            for (int m = 0; m < 4; ++m) { const int row = row0 + ai * 128 + m * 16; const size_t ro = (size_t)row * DM + col0; float s = 0.f;
#pragma unroll
                for (int bj = 0; bj < 2; ++bj)
#pragma unroll
                    for (int n = 0; n < 2; ++n) { const pg8::f32x4 xv = *(const pg8::f32x4*)(xsrc + ro + bj * 128 + n * 16);
                        const pg8::f32x4 y = xv + gv[bj][n] * acc[ai][bj][m][n];
                        *(pg8::f32x4*)(xdst + ro + bj * 128 + n * 16) = y;
                        s += (y.x * y.x + y.y * y.y) + (y.z * y.z + y.w * y.w);
                        const pg8::f32x4 hh = y * hv[bj][n]; v2u pk; pk.x = pk2(hh.x, hh.y); pk.y = pk2(hh.z, hh.w); *(v2u*)(hdst + ro + bj * 128 + n * 16) = pk; }
                s += __builtin_bit_cast(float, __builtin_amdgcn_ds_bpermute((lane ^ 16) << 2, __builtin_bit_cast(int, s)));
                s += __builtin_bit_cast(float, __builtin_amdgcn_ds_bpermute((lane ^ 32) << 2, __builtin_bit_cast(int, s)));
                if (fq == 0) ss[(size_t)row * 32 + u.pn * 4 + wc] = s; }
    }
};
struct EpiScore {
    static constexpr bool PERM = false, AFTER_DRAIN = false;
    float* C; int ldc; int ws_; const LAS float* rs; const float* bias;
    __device__ __forceinline__ void operator()(const pg8::f32x4 (&acc)[2][2][4][2], const pg8::Unit& u, int, int, int, int) const {
        int tz = tid_from(ws_); asm volatile("" : "+v"(tz)); const int wid = tz >> 6, lane = tz & 63, wr = wid >> 2, wc = wid & 3, fr = lane & 15, fq = lane >> 4;
        const int row0 = u.pm * 256 + wr * 64 + fr, col0 = u.pn * 256 + wc * 32 + 4 * fq;
        const float* bp = bias + (size_t)(u.pm >> 4) * DM + col0;
        pg8::f32x4 bv[2][2];
#pragma unroll
        for (int bj = 0; bj < 2; ++bj)
#pragma unroll
            for (int n = 0; n < 2; ++n) bv[bj][n] = *(const pg8::f32x4*)(bp + bj * 128 + n * 16);
#pragma unroll
        for (int ai = 0; ai < 2; ++ai)
#pragma unroll
            for (int m = 0; m < 4; ++m) { const int row = row0 + ai * 128 + m * 16; float* rowp = C + (size_t)row * ldc + col0;
                const float rstd = rs[row & 255];
#pragma unroll
                for (int bj = 0; bj < 2; ++bj)
#pragma unroll
                    for (int n = 0; n < 2; ++n) *(pg8::f32x4*)(rowp + bj * 128 + n * 16) = acc[ai][bj][m][n] * rstd + bv[bj][n]; }
    }
};

__device__ __forceinline__ void quant_tables(ArgsP A, int l, int wvi, int nw, int lane) {
    for (int rr = wvi; rr < 2 * PEER_N; rr += nw) {
        const int tb = rr >= PEER_N, r = l * PEER_N + (rr - tb * PEER_N);
        const f32x4* src = (const f32x4*)(A->in[27 + tb] + (size_t)r * DM) + lane;
        f32x4 v[8]; float mx = 0.f;
        float ssq = 0.f;
#pragma unroll
        for (int j = 0; j < 8; ++j) { v[j] = src[64 * j]; mx = fmaxf(mx, fmaxf(fmaxf(fabsf(v[j].x), fabsf(v[j].y)), fmaxf(fabsf(v[j].z), fabsf(v[j].w)))); ssq += (v[j].x * v[j].x + v[j].y * v[j].y) + (v[j].z * v[j].z + v[j].w * v[j].w); }
        mx = wave_max(mx);
        mx = fminf(mx, (tb ? 3.0f : 2.5f) * sqrtf(wave_sum(ssq) * (1.f / DM)));
        unsigned* dst = (unsigned*)(A->ws + (tb ? WS_V : WS_U)) + (size_t)r * (DM / 4) + lane;
        if (!tb) { const float inv = mx > 0.f ? 7.f / mx : 0.f;
            unsigned* dst4 = (unsigned*)(A->ws + WS_U) + (size_t)r * (DM / 8) + lane;
#pragma unroll
            for (int j = 0; j < 4; ++j) { unsigned wd = 0u;
                const float lo4[4] = {v[j].x, v[j].y, v[j].z, v[j].w}, hi4[4] = {v[j + 4].x, v[j + 4].y, v[j + 4].z, v[j + 4].w};
#pragma unroll
                for (int i = 0; i < 4; ++i) { const unsigned nl = (unsigned)((int)rintf(fminf(fmaxf(lo4[i] * inv, -7.f), 7.f)) + 8), nh = (unsigned)((int)rintf(fminf(fmaxf(hi4[i] * inv, -7.f), 7.f)) + 8); wd |= (nl | (nh << 4)) << (8 * i); }
                dst4[64 * j] = wd; }
            if (lane == 0) ((float*)(A->ws + WS_US))[r] = mx * (1.f / 7.f);
        } else { const float inv = mx > 0.f ? 6.f / mx : 0.f;
            unsigned short* dst2 = (unsigned short*)(A->ws + WS_V) + (size_t)r * (DM / 4) + lane;
#pragma unroll
            for (int j = 0; j < 8; ++j) { const f32x4 c4 = __builtin_elementwise_min(__builtin_elementwise_max(v[j] * inv, (f32x4){-6.f, -6.f, -6.f, -6.f}), (f32x4){6.f, 6.f, 6.f, 6.f});
                int p = __builtin_amdgcn_cvt_scalef32_pk_fp4_f32(0, c4.x, c4.y, 1.0f, 0); p = __builtin_amdgcn_cvt_scalef32_pk_fp4_f32(p, c4.z, c4.w, 1.0f, 1); dst2[64 * j] = (unsigned short)p; }
            if (lane == 0) ((float*)(A->ws + WS_VS))[r] = mx * (1.f / 6.f);
        }
    }
}

__device__ __forceinline__ void transpose_item(const float* W, int K, int N, bf16* WT, LAS float* scr, int kb, int nb, int lane) {
    const int k0 = 64 * kb, n0 = 64 * nb, nl = (lane & 15) * 4, kr = lane >> 4;
    f32x4 v[16];
#pragma unroll
    for (int it = 0; it < 16; ++it) v[it] = (n0 + nl < N) ? *(const f32x4*)(W + (size_t)(k0 + it * 4 + kr) * N + n0 + nl) : (f32x4){0.f, 0.f, 0.f, 0.f};
#pragma unroll
    for (int it = 0; it < 16; ++it) { LAS float* s = scr + (it * 4 + kr) * 65 + nl; s[0] = v[it].x; s[1] = v[it].y; s[2] = v[it].z; s[3] = v[it].w; }
    asm volatile("s_waitcnt lgkmcnt(0)" ::: "memory");
    const int c = lane & 7;
#pragma unroll
    for (int j = 0; j < 8; ++j) { const int n = (lane >> 3) + 8 * j; const LAS float* s = scr + (8 * c) * 65 + n;
        v4u o; o.x = pk2(s[0 * 65], s[1 * 65]); o.y = pk2(s[2 * 65], s[3 * 65]); o.z = pk2(s[4 * 65], s[5 * 65]); o.w = pk2(s[6 * 65], s[7 * 65]);
        if (n0 + n < N) *(v4u*)(WT + (size_t)(n0 + n) * K + k0 + 8 * c) = o; }
    asm volatile("s_waitcnt lgkmcnt(0)" ::: "memory");
}

__device__ __forceinline__ void ph_prologue(ArgsP A, LAS unsigned char* lds_, int wv_) {
    const Frame F = make_frame(lds_, wv_);
    LAS float* ldsf = (LAS float*)F.lds;
    const int tid = F.tid, lane = F.lane, wave = F.wave;
    for (int i = tid; i < NB * DM; i += NTHR) { const float c = A->in[1][i]; ldsf[i] = c / (1.f + __expf(-c)); }
    __syncthreads();
    {
        LAS float* red = ldsf + 4096;
        float* MOD = (float*)(A->ws + WS_MOD);
        for (int u = F.bid; u < DEPTH * 96; u += F.G) {
            const int l = u / 96, j0 = (u % 96) * 128;
            const float* W = A->in[2] + (size_t)l * DM * MODW + j0 + lane * 2;
            float a00 = 0.f, a01 = 0.f, a10 = 0.f, a11 = 0.f;
            const int k0 = wave * 256;
#pragma unroll 8
            for (int k = k0; k < k0 + 256; ++k) { const f32x2 w = *(const f32x2*)(W + (size_t)k * MODW); const float c0 = ldsf[k], c1 = ldsf[DM + k];
                a00 += c0 * w.x; a01 += c0 * w.y; a10 += c1 * w.x; a11 += c1 * w.y; }
            red[(wave * 2 + 0) * 128 + lane * 2] = a00; red[(wave * 2 + 0) * 128 + lane * 2 + 1] = a01;
            red[(wave * 2 + 1) * 128 + lane * 2] = a10; red[(wave * 2 + 1) * 128 + lane * 2 + 1] = a11;
            __syncthreads();
            if (tid < 256) { const int b = tid >> 7, j = tid & 127; float s = 0.f;
#pragma unroll
                for (int w = 0; w < 8; ++w) s += red[(w * 2 + b) * 128 + j];
                s += A->in[3][(size_t)l * MODW + j0 + j];
                MOD[(size_t)(l * 2 + b) * MODW + j0 + j] = s; }
            __syncthreads();
        }
    }
    {
        LAS float* scr = ldsf + wave * 4160;
        constexpr int NBI = (INW + 63) / 64;
        constexpr int I_IN = 32 * NBI, I_OUT = 32 * 32, I_L = I_IN + I_OUT;
        for (int it = F.gw; it < DEPTH * I_L; it += F.ngw) {
            const int l = it / I_L; int r = it % I_L;
            if (r < I_IN) transpose_item(A->in[5] + (size_t)l * DM * INW, DM, INW, (bf16*)(A->ws + WS_WIN) + (size_t)l * INWP * DM, scr, r / NBI, r % NBI, lane);
            else { r -= I_IN; transpose_item(A->in[22] + (size_t)l * DM * DM, DM, DM, (bf16*)(A->ws + WS_WOUT) + (size_t)l * DM * DM, scr, r / 32, r % 32, lane); }
        }
        constexpr int PADV = (INWP - INW) * DM / 8;
        for (int i = F.bid * NTHR + tid; i < DEPTH * PADV; i += F.G * NTHR) { const int l = i / PADV, r = i % PADV;
            ((v4u*)((bf16*)(A->ws + WS_WIN) + (size_t)l * INWP * DM + (size_t)INW * DM))[r] = (v4u){0u, 0u, 0u, 0u}; }
    }
    __syncthreads();
    {
        LAS float* Ks = ldsf;
        LAS float* Ws = ldsf + 128 * 132;
        for (int u = F.bid; u < DEPTH * 16 * 32; u += F.G) {
            const int l = u >> 9, hh = (u >> 5) & 15, jt = u & 31, h = hh >> 1, half = hh & 1, j0 = jt * 64;
            const float* ksrc = (half ? A->in[26] : A->in[25]) + ((size_t)l * 8 + h) * 128 * 128;
            const float* wsrc = A->in[24] + (size_t)l * DM * DM + h * 256 + half * 128;
            {   f32x4 kq[8], wq4[4];
#pragma unroll
                for (int it = 0; it < 8; ++it) { const int i = tid + it * NTHR, n = i >> 5, d4 = (i & 31) * 4; kq[it] = *(const f32x4*)(ksrc + n * 128 + d4); }
#pragma unroll
                for (int it = 0; it < 4; ++it) { const int i = tid + it * NTHR, jj = i >> 5, d4 = (i & 31) * 4; wq4[it] = *(const f32x4*)(wsrc + (size_t)(j0 + jj) * DM + d4); }
#pragma unroll
                for (int it = 0; it < 8; ++it) { const int i = tid + it * NTHR, n = i >> 5, d4 = (i & 31) * 4; *(LAS f32x4*)(Ks + n * 132 + d4) = kq[it]; }
#pragma unroll
                for (int it = 0; it < 4; ++it) { const int i = tid + it * NTHR, jj = i >> 5, d4 = (i & 31) * 4; *(LAS f32x4*)(Ws + jj * 132 + d4) = wq4[it]; }
            }
            __syncthreads();
            { const int li = lane & 15, lq = lane >> 4;
                f32x4 acc[4] = {{0.f, 0.f, 0.f, 0.f}, {0.f, 0.f, 0.f, 0.f}, {0.f, 0.f, 0.f, 0.f}, {0.f, 0.f, 0.f, 0.f}};
#pragma unroll 4
                for (int ks = 0; ks < 32; ++ks) { const float a = Ks[(wave * 16 + li) * 132 + 4 * ks + lq];
#pragma unroll
                    for (int jt = 0; jt < 4; ++jt) acc[jt] = __builtin_amdgcn_mfma_f32_16x16x4f32(a, Ws[(jt * 16 + li) * 132 + 4 * ks + lq], acc[jt], 0, 0, 0); }
                bf16* dst = (bf16*)(A->ws + WS_WQK) + (size_t)l * DM * DM + (size_t)(h * 256 + half * 128 + wave * 16 + lq * 4) * DM + j0 + li;
#pragma unroll
                for (int jt = 0; jt < 4; ++jt) { dst[(size_t)0 * DM + jt * 16] = (bf16)f2bf(acc[jt].x); dst[(size_t)1 * DM + jt * 16] = (bf16)f2bf(acc[jt].y); dst[(size_t)2 * DM + jt * 16] = (bf16)f2bf(acc[jt].z); dst[(size_t)3 * DM + jt * 16] = (bf16)f2bf(acc[jt].w); } }
            __syncthreads();
        }
    }
    {
        bf16* PT = (bf16*)(A->ws + WS_POOLT);
        for (int i = F.bid * NTHR + tid; i < DEPTH * 4 * 128 * 128; i += F.G * NTHR) { const int lg = i >> 14, r = i & 16383, dcol = r >> 7, c = r & 127;
            PT[i] = (bf16)f2bf(A->in[6][(size_t)lg * 16384 + c * 128 + dcol]); }
    }
    {
        bf16* LT = (bf16*)(A->ws + WS_LORAT);
        for (int i = F.bid * NTHR + tid; i < DEPTH * RW_W * 256; i += F.G * NTHR) { const int l = i / (RW_W * 256), r = i % (RW_W * 256), c = r >> 8, j = r & 255;
            const float v = j < 64 ? A->in[13][((size_t)l * 64 + j) * RW_W + c] : (j < 128 ? A->in[15][((size_t)l * 64 + (j - 64)) * RW_W + c] : A->in[16][((size_t)l * 128 + (j - 128)) * RW_W + c]);
            LT[i] = (bf16)f2bf(v); }
    }
    quant_tables(A, 0, F.gw, F.ngw, lane);
}

__device__ __forceinline__ void ph_norm(const float* xsrc, const float* gain, const float* sh, const float* sc, bf16* hout, LAS unsigned char* lds_, int wv_) {
    const Frame F = make_frame(lds_, wv_);
    for (int m = F.gw; m < NT; m += F.ngw) {
        const int b = m >> 12;
        const f32x4* xr = (const f32x4*)(xsrc + (size_t)m * DM) + F.lane;
        f32x4 v[8]; float ss = 0.f;
#pragma unroll
        for (int j = 0; j < 8; ++j) { v[j] = xr[64 * j]; ss += (v[j].x * v[j].x + v[j].y * v[j].y) + (v[j].z * v[j].z + v[j].w * v[j].w); }
        const float rstd = rsqrtf(wave_sum(ss) * (1.f / DM) + NORM_EPS);
        v2u* o8 = (v2u*)(hout + (size_t)m * DM) + F.lane;
#pragma unroll
        for (int j = 0; j < 8; ++j) { const int col = j * 256 + F.lane * 4;
            const f32x4 g = *(const f32x4*)(gain + col), s1 = *(const f32x4*)(sc + (size_t)b * MODW + col), s0 = *(const f32x4*)(sh + (size_t)b * MODW + col);
            const f32x4 y = v[j] * rstd * g * (s1 + 1.f) + s0;
            v2u o; o.x = pk2(y.x, y.y); o.y = pk2(y.z, y.w); o8[64 * j] = o; }
    }
}
__device__ __forceinline__ void ph_final(const float* xsrc, const float* gain, float* out, LAS unsigned char* lds_, int wv_) {
    const Frame F = make_frame(lds_, wv_);
    for (int m = F.gw; m < NT; m += F.ngw) {
        const f32x4* xr = (const f32x4*)(xsrc + (size_t)m * DM) + F.lane;
        f32x4 v[8]; float ss = 0.f;
#pragma unroll
        for (int j = 0; j < 8; ++j) { v[j] = xr[64 * j]; ss += (v[j].x * v[j].x + v[j].y * v[j].y) + (v[j].z * v[j].z + v[j].w * v[j].w); }
        const float rstd = rsqrtf(wave_sum(ss) * (1.f / DM) + NORM_EPS);
        f32x4* o = (f32x4*)(out + (size_t)m * DM) + F.lane;
#pragma unroll
        for (int j = 0; j < 8; ++j) { const f32x4 g = *(const f32x4*)(gain + j * 256 + F.lane * 4); o[64 * j] = v[j] * rstd * g; }
    }
}

__device__ __forceinline__ void pool_unit(ArgsP A, const Frame& F_in, int l, int unit) {
    Frame F = F_in; asm volatile("" : "+v"(F.tid)); F.lane = F.tid & 63;
    const int tile = unit >> 2, g = unit & 3, t0 = tile * 32, s0 = t0 & (SEQ - 1), tid = F.tid, lane = F.lane, w = F.wave;
    const int win = 2 << g;
    const float* proj = (const float*)(A->ws + WS_PROJ);
    LAS float* ps = (LAS float*)F.lds;
    LAS unsigned short* ds = (LAS unsigned short*)(F.lds + 24064);
    const int rt = w >> 2, ct0 = (w & 3) * 2, li = lane & 15, lq = lane >> 4;
    typedef short b8 __attribute__((ext_vector_type(8)));
    b8 bw[2][4];
    { const unsigned short* PT = (const unsigned short*)(A->ws + WS_POOLT) + ((size_t)l * 4 + g) * 16384;
#pragma unroll
        for (int j = 0; j < 2; ++j)
#pragma unroll
            for (int ks = 0; ks < 4; ++ks) bw[j][ks] = *(const b8*)(PT + (size_t)((ct0 + j) * 16 + li) * 128 + ks * 32 + lq * 8); }
    {   f32x4 pq[3];
#pragma unroll
        for (int it = 0; it < 3; ++it) { const int i = tid + it * NTHR, r = i >> 5, c4 = i & 31; const int s = s0 - 15 + r;
            pq[it] = (i < 47 * 32 && s >= 0) ? *(const f32x4*)(proj + (size_t)(t0 - 15 + r) * INWP + C_POOL + g * 128 + c4 * 4) : (f32x4){0.f, 0.f, 0.f, 0.f}; }
#pragma unroll
        for (int it = 0; it < 3; ++it) { const int i = tid + it * NTHR; if (i < 47 * 32) *(LAS f32x4*)(ps + i * 4) = pq[it]; }
    }
    __syncthreads();
    for (int i = tid; i < 32 * 128; i += NTHR) { const int tok = i >> 7, c = i & 127; float sum = 0.f;
        for (int ww = 0; ww < win; ++ww) sum += ps[(tok + 15 - ww) * 128 + c];
        const int cnt = (s0 + tok + 1) < win ? (s0 + tok + 1) : win;
        ds[tok * 136 + c] = (unsigned short)f2bf(sum * __builtin_amdgcn_rcpf((float)cnt) - ps[(tok + 15) * 128 + c]); }
    __syncthreads();
    f32x4 acc[2] = {{0.f, 0.f, 0.f, 0.f}, {0.f, 0.f, 0.f, 0.f}};
#pragma unroll
    for (int ks = 0; ks < 4; ++ks) { const b8 a = *(const LAS b8*)(ds + (rt * 16 + li) * 136 + ks * 32 + lq * 8);
#pragma unroll
        for (int j = 0; j < 2; ++j) acc[j] = __builtin_amdgcn_mfma_f32_16x16x32_bf16(a, bw[j][ks], acc[j], 0, 0, 0); }
    bf16* Y = (bf16*)(A->ws + WS_Y);
#pragma unroll
    for (int j = 0; j < 2; ++j) { const int dcol = (ct0 + j) * 16 + li; const float scale = A->in[7][(size_t)l * 512 + g * 128 + dcol]; const int tk = t0 + rt * 16 + lq * 4;
        Y[(size_t)(tk + 0) * DM + g * 128 + dcol] = (bf16)f2bf(acc[j].x * scale); Y[(size_t)(tk + 1) * DM + g * 128 + dcol] = (bf16)f2bf(acc[j].y * scale);
        Y[(size_t)(tk + 2) * DM + g * 128 + dcol] = (bf16)f2bf(acc[j].z * scale); Y[(size_t)(tk + 3) * DM + g * 128 + dcol] = (bf16)f2bf(acc[j].w * scale); }
    __syncthreads();
}

__device__ __forceinline__ void gla_bcum(ArgsP A, const Frame& F, int l, int h, int t0, LAS float* bcum, LAS float* ad, LAS float* up) {
    const float* proj = (const float*)(A->ws + WS_PROJ);
    const int tid = F.tid;
    {
        const float a0 = proj[(size_t)(t0 + (tid >> 4)) * INWP + C_GA + (tid & 15)], a1 = proj[(size_t)(t0 + 32 + (tid >> 4)) * INWP + C_GA + (tid & 15)];
        const float* upg = A->in[8] + (size_t)l * 16 * 384 + h * 96;
        const float u0 = upg[(tid / 96) * 384 + tid % 96], u1 = upg[((tid + 512) / 96) * 384 + (tid + 512) % 96], u2 = upg[((tid + 1024) / 96) * 384 + (tid + 1024) % 96];
        ad[tid] = a0; ad[tid + 512] = a1; up[tid] = u0; up[tid + 512] = u1; up[tid + 1024] = u2;
    }
    __syncthreads();
    for (int i = tid; i < 64 * 96; i += NTHR) { const int tok = i / 96, d = i % 96; float x = A->in[9][(size_t)l * 384 + h * 96 + d];
#pragma unroll
        for (int j = 0; j < 16; ++j) x += ad[tok * 16 + j] * up[j * 96 + d];
        bcum[i] = -softplusf_(-x) * (1.f / 16.f); }
    __syncthreads();
    if (tid < 384) { const int d = tid % 96, seg = tid / 96; float acc = 0.f;
#pragma unroll
        for (int k = 0; k < 16; ++k) { acc += bcum[(seg * 16 + k) * 96 + d]; bcum[(seg * 16 + k) * 96 + d] = acc; }
        ad[seg * 96 + d] = acc; }
    __syncthreads();
    if (tid < 384) { const int d = tid % 96, seg = tid / 96; float pre = 0.f;
#pragma unroll
        for (int s2 = 0; s2 < 3; ++s2) pre += (s2 < seg) ? ad[s2 * 96 + d] : 0.f;
        if (seg > 0) {
#pragma unroll
            for (int k = 0; k < 16; ++k) bcum[(seg * 16 + k) * 96 + d] += pre; } }
    __syncthreads();
}

__device__ __forceinline__ void gla_scan_unit(ArgsP A, const Frame& F, int unit) {
    const int idx = unit * NTHR + F.tid, bh = idx / 18432, rem = idx % 18432, d = rem % 96;
    const float* KV = (const float*)(A->ws + WS_GKV) + (size_t)bh * 64 * 18432 + rem;
    float* GS = (float*)(A->ws + WS_GS) + (size_t)bh * 64 * 18432 + rem;
    const float* DEC = (const float*)(A->ws + WS_GDEC) + (size_t)bh * 64 * 96 + d;
    float S = 0.f;
#pragma unroll 1
    for (int c0 = 0; c0 < 64; c0 += 16) {
        float kv[16], dc[16];
#pragma unroll
        for (int j = 0; j < 16; ++j) { kv[j] = KV[(size_t)(c0 + j) * 18432]; dc[j] = DEC[(c0 + j) * 96]; }
#pragma unroll
        for (int j = 0; j < 16; ++j) { GS[(size_t)(c0 + j) * 18432] = S; S = dc[j] * S + kv[j]; }
    }
}

typedef short bf16x8_t __attribute__((ext_vector_type(8)));
constexpr int RS = 68;
__device__ __forceinline__ f32x4 tile_mm64(const LAS bf16* Am, int arow0, const LAS bf16* Bm, int brow0, f32x4 acc, int lane) {
    const int r = lane & 15, kq = (lane >> 4) * 8;
#pragma unroll
    for (int ks = 0; ks < 2; ++ks) {
        const bf16x8_t a = *(const LAS bf16x8_t*)(Am + (arow0 + r) * RS + ks * 32 + kq);
        const bf16x8_t b = *(const LAS bf16x8_t*)(Bm + (brow0 + r) * RS + ks * 32 + kq);
        acc = __builtin_amdgcn_mfma_f32_16x16x32_bf16(a, b, acc, 0, 0, 0);
    }
    return acc;
}
constexpr int RA_BT = 0, RA_KT = 8704, RA_AT = 17408, RA_RT = 26112, RA_RABS = 34816, RA_BHT = 43520, RA_KHT = 52224, RA_VT = 60928, RA_AABS = 69632,
              RA_MBAT = 86272, RA_MKA = 103680, RA_NBRT = 121088, RA_GC = 129792, RA_WT = 130048, RA_NKRT = 132096, RA_END = 140800, RA_PRE = 94976;
constexpr int RA_Z = RA_BT, RA_QST = RA_AT, RA_QOT = RA_RT, RA_LO = 0, RA_RES = 34816;
constexpr size_t RWO_POT = 0, RWO_PST = 12 * MiB, RWO_GT = 24 * MiB, RWO_OLT = 48 * MiB, RWO_SC = 72 * MiB;

__device__ __forceinline__ void rwkvA_unit(ArgsP A, const Frame& F_in, int l, int unit) {
    Frame F = F_in; asm volatile("" : "+v"(F.tid)); F.lane = F.tid & 63;

    const int bh = unit >> 6, c = unit & 63, b = bh / RW_H, h = bh % RW_H, t0 = b * SEQ + c * 64, s0 = c * 64, tid = F.tid, lane = F.lane, w = F.wave;
    const float* proj = (const float*)(A->ws + WS_PROJ);
    const float* mu = A->in[11] + (size_t)l * RW_IN;
    LAS unsigned char* L = F.lds;
    const int n = lane, cc = h * 64 + n;
    const int rt1 = w >> 1, ct1 = (w & 1) * 2, li1 = lane & 15, lq1 = lane >> 4;
    f32x4 yc[8], yp[8];
#pragma unroll
    for (int it = 0; it < 8; ++it) { const int g = tid + it * NTHR, tok = g >> 6, j4 = (g & 63) * 4; const float* rp = proj + ((size_t)t0 + tok) * INWP + C_RW + 2304 + j4;
        yc[it] = *(const f32x4*)rp; yp[it] = (s0 + tok > 0) ? *(const f32x4*)(rp - INWP) : (f32x4){0.f, 0.f, 0.f, 0.f}; }
    bf16x8_t bw[2][8];
    { const bf16* LT = (const bf16*)(A->ws + WS_LORAT) + ((size_t)l * RW_W + h * 64) * 256;
#pragma unroll
        for (int j = 0; j < 2; ++j)
#pragma unroll
            for (int ks = 0; ks < 8; ++ks) bw[j][ks] = *(const bf16x8_t*)(LT + (size_t)((ct1 + j) * 16 + li1) * 256 + ks * 32 + lq1 * 8); }
    float rr[9], kr[9], vr[9];
#pragma unroll
    for (int i = 0; i < 9; ++i) { const int tok = w * 8 + i - 1; const bool ok = (s0 + tok >= 0); const float* row = proj + ((size_t)t0 + tok) * INWP + C_RW;
        rr[i] = ok ? row[cc] : 0.f; kr[i] = ok ? row[768 + cc] : 0.f; vr[i] = ok ? row[1536 + cc] : 0.f; }
    const float w0c = A->in[12][(size_t)l * RW_W + cc], a0c = A->in[14][(size_t)l * RW_W + cc], kkc = A->in[17][(size_t)l * RW_W + cc], kac = A->in[18][(size_t)l * RW_W + cc], rkc = A->in[19][(size_t)l * RW_W + cc];
    const float mur = mu[cc], muk = mu[768 + cc], muv = mu[1536 + cc];
    {   LAS bf16* lo = (LAS bf16*)(L + RA_LO);
#pragma unroll
        for (int it = 0; it < 8; ++it) { const int g = tid + it * NTHR, tok = g >> 6, j4 = (g & 63) * 4; const f32x4 m4 = *(const f32x4*)(mu + 2304 + j4);
            const f32x4 ym = yc[it] + (yp[it] - yc[it]) * m4;
            const float sc = j4 < 64 ? 2.f : 1.f; f32x4 sg; sg.x = sigmoidf_(ym.x * sc); sg.y = sigmoidf_(ym.y * sc); sg.z = sigmoidf_(ym.z * sc); sg.w = sigmoidf_(ym.w * sc);
            const f32x4 o = j4 < 64 ? sg * 2.f - 1.f : (j4 < 128 ? ym : sg);
            v2u pk; pk.x = pk2(o.x, o.y); pk.y = pk2(o.z, o.w); *(LAS v2u*)(lo + tok * 264 + j4) = pk; }
    }
    __syncthreads();
    {
        const int rt = rt1, ct0 = ct1, li = li1, lq = lq1;
        const LAS bf16* lo = (const LAS bf16*)(L + RA_LO);
        LAS float* res = (LAS float*)(L + RA_RES);
        f32x4 acc[3][2];
#pragma unroll
        for (int p = 0; p < 3; ++p)
#pragma unroll
            for (int j = 0; j < 2; ++j) acc[p][j] = (f32x4){0.f, 0.f, 0.f, 0.f};
#pragma unroll
        for (int ks = 0; ks < 8; ++ks) { const bf16x8_t a = *(const LAS bf16x8_t*)(lo + (rt * 16 + li) * 264 + ks * 32 + lq * 8);
            const int p = ks < 2 ? 0 : (ks < 4 ? 1 : 2);
#pragma unroll
            for (int j = 0; j < 2; ++j) acc[p][j] = __builtin_amdgcn_mfma_f32_16x16x32_bf16(a, bw[j][ks], acc[p][j], 0, 0, 0); }
#pragma unroll
        for (int p = 0; p < 3; ++p)
#pragma unroll
            for (int j = 0; j < 2; ++j) { LAS float* rp = res + p * 64 * 68 + (rt * 16 + lq * 4) * 68 + (ct0 + j) * 16 + li;
                rp[0] = acc[p][j].x; rp[68] = acc[p][j].y; rp[136] = acc[p][j].z; rp[204] = acc[p][j].w; }
    }
    __syncthreads();
    float r_[8], k_[8], v_[8], av_[8], bb_[8], lw_[8];
    {
        const LAS float* res = (const LAS float*)(L + RA_RES);
        float wl[8], al[8], gl[8];
#pragma unroll
        for (int i = 0; i < 8; ++i) { wl[i] = res[(w * 8 + i) * 68 + n]; al[i] = res[64 * 68 + (w * 8 + i) * 68 + n]; gl[i] = res[2 * 64 * 68 + (w * 8 + i) * 68 + n]; }
        float* GATE = (float*)(A->ws + WS_RGATE); float* BV = (float*)(A->ws + WS_RBV);
#pragma unroll
        for (int i = 0; i < 8; ++i) { const int tok = w * 8 + i; const size_t t = (size_t)t0 + tok;
            float r = rr[i + 1], k = kr[i + 1], v = vr[i + 1];
            r += (rr[i] - r) * mur; k += (kr[i] - k) * muk; v += (vr[i] - v) * muv;
            const float wraw = -softplusf_(-(w0c + wl[i])) - 0.5f;
            const float a = sigmoidf_(a0c + al[i]);
            float kk = k * kkc; kk = kk * __builtin_amdgcn_rsqf(fmaxf(wave_sum(kk * kk), 1e-24f));
            const float k2 = k * (1.f + (a - 1.f) * kac);
            const float bonus = wave_sum(r * k2 * rkc);
            r_[i] = r; k_[i] = k2; v_[i] = v; av_[i] = -kk; bb_[i] = kk * a; lw_[i] = -__expf(wraw);
            GATE[t * RW_W + cc] = gl[i]; BV[t * RW_W + cc] = bonus * v; }
    }
    LAS float* wt = (LAS float*)(L + RA_WT);
#pragma unroll
    for (int i = 1; i < 8; ++i) lw_[i] += lw_[i - 1];
    wt[w * 64 + n] = lw_[7];
    __syncthreads();
    float pre = 0.f, mid = 0.f, last = 0.f;
#pragma unroll
    for (int ww = 0; ww < 8; ++ww) { const float x = wt[ww * 64 + n]; pre += (ww < w) ? x : 0.f; mid += (ww < 4) ? x : 0.f; last += x; }
    {
        LAS bf16* Bt = (LAS bf16*)(L + RA_BT); LAS bf16* Kt = (LAS bf16*)(L + RA_KT); LAS bf16* At = (LAS bf16*)(L + RA_AT); LAS bf16* Rt = (LAS bf16*)(L + RA_RT);
        LAS bf16* Rab = (LAS bf16*)(L + RA_RABS); LAS bf16* BhT = (LAS bf16*)(L + RA_BHT); LAS bf16* KhT = (LAS bf16*)(L + RA_KHT); LAS bf16* VT = (LAS bf16*)(L + RA_VT);
        LAS float* AabT = (LAS float*)(L + RA_AABS);
#pragma unroll
        for (int i = 0; i < 8; ++i) { const int t = w * 8 + i; const float lw = pre + lw_[i], lwm1 = pre + (i > 0 ? lw_[i - 1] : 0.f);
            const float eg = __expf(lw - mid), egi = __expf(mid - lw), egm1 = __expf(lwm1 - mid), eh = __expf(last - lw);
            Bt[t * RS + n] = (bf16)f2bf(bb_[i] * egi); Kt[t * RS + n] = (bf16)f2bf(k_[i] * egi); At[t * RS + n] = (bf16)f2bf(av_[i] * egm1); Rt[t * RS + n] = (bf16)f2bf(r_[i] * eg);
            Rab[t * RS + n] = (bf16)f2bf(r_[i] * __expf(lw)); AabT[n * 65 + t] = av_[i] * __expf(lwm1);
            BhT[n * RS + t] = (bf16)f2bf(bb_[i] * eh); KhT[n * RS + t] = (bf16)f2bf(k_[i] * eh); VT[n * RS + t] = (bf16)f2bf(v_[i]); }
        if (w == 0) ((LAS float*)(L + RA_GC))[n] = __expf(last);
    }
    __syncthreads();
    const int rt = w >> 1, ct0 = (w & 1) * 2, li = lane & 15, lq = lane >> 4;
#define FRAG(mat_, row_, ks_) (*(const LAS bf16x8_t*)((mat_) + ((row_) + li) * RS + (ks_) * 32 + lq * 8))
#define MM(a_, b_, c_) __builtin_amdgcn_mfma_f32_16x16x32_bf16(a_, b_, c_, 0, 0, 0)
    {
        const LAS bf16* Bt = (const LAS bf16*)(L + RA_BT); const LAS bf16* Kt = (const LAS bf16*)(L + RA_KT); const LAS bf16* At = (const LAS bf16*)(L + RA_AT); const LAS bf16* Rt = (const LAS bf16*)(L + RA_RT);
        LAS bf16* MbaT = (LAS bf16*)(L + RA_MBAT); LAS float* Mka = (LAS float*)(L + RA_MKA); LAS bf16* NbrT = (LAS bf16*)(L + RA_NBRT);
        bf16x8_t aB[2], aK[2], bA[2][2], bR[2][2];
#pragma unroll
        for (int ks = 0; ks < 2; ++ks) { aB[ks] = FRAG(Bt, rt * 16, ks); aK[ks] = FRAG(Kt, rt * 16, ks);
#pragma unroll
            for (int j = 0; j < 2; ++j) { bA[j][ks] = FRAG(At, (ct0 + j) * 16, ks); bR[j][ks] = FRAG(Rt, (ct0 + j) * 16, ks); } }
#pragma unroll
        for (int j = 0; j < 2; ++j) { const int ct = ct0 + j, tcol = ct * 16 + li, srow = rt * 16 + lq * 4;
            const f32x4 z = {0.f, 0.f, 0.f, 0.f};
            f32x4 mba = MM(aB[1], bA[j][1], MM(aB[0], bA[j][0], z)), nbr = MM(aB[1], bR[j][1], MM(aB[0], bR[j][0], z));
            f32x4 mka = MM(aK[1], bA[j][1], MM(aK[0], bA[j][0], z)), nk = MM(aK[1], bR[j][1], MM(aK[0], bR[j][0], z));
            mba.x = (srow + 0 < tcol) ? mba.x : 0.f; mba.y = (srow + 1 < tcol) ? mba.y : 0.f; mba.z = (srow + 2 < tcol) ? mba.z : 0.f; mba.w = (srow + 3 < tcol) ? mba.w : 0.f;
            mka.x = (srow + 0 < tcol) ? mka.x : 0.f; mka.y = (srow + 1 < tcol) ? mka.y : 0.f; mka.z = (srow + 2 < tcol) ? mka.z : 0.f; mka.w = (srow + 3 < tcol) ? mka.w : 0.f;
            nbr.x = (srow + 0 <= tcol) ? nbr.x : 0.f; nbr.y = (srow + 1 <= tcol) ? nbr.y : 0.f; nbr.z = (srow + 2 <= tcol) ? nbr.z : 0.f; nbr.w = (srow + 3 <= tcol) ? nbr.w : 0.f;
            nk.x = (srow + 0 <= tcol) ? nk.x : 0.f; nk.y = (srow + 1 <= tcol) ? nk.y : 0.f; nk.z = (srow + 2 <= tcol) ? nk.z : 0.f; nk.w = (srow + 3 <= tcol) ? nk.w : 0.f;
            { v2u pm; pm.x = pk2(mba.x, mba.y); pm.y = pk2(mba.z, mba.w); *(LAS v2u*)(MbaT + tcol * RS + srow) = pm; }
            Mka[(srow + 0) * RS + tcol] = mka.x; Mka[(srow + 1) * RS + tcol] = mka.y; Mka[(srow + 2) * RS + tcol] = mka.z; Mka[(srow + 3) * RS + tcol] = mka.w;
            v2u pk; pk.x = pk2(nbr.x, nbr.y); pk.y = pk2(nbr.z, nbr.w); *(LAS v2u*)(NbrT + tcol * RS + srow) = pk;
            { v2u pn; pn.x = pk2(nk.x, nk.y); pn.y = pk2(nk.z, nk.w); *(LAS v2u*)((LAS bf16*)(L + RA_NKRT) + tcol * RS + srow) = pn; } }
    }
    __syncthreads();
    {
        int t4 = tid; asm volatile("" : "+v"(t4)); const int row = t4 >> 2, q = t4 & 3, l4 = t4 & 63, li4 = l4 & 15, lq4 = l4 >> 4;
        const LAS bf16* MbaT = (const LAS bf16*)(L + RA_MBAT);
        const LAS float* Yrow = (row < 64) ? ((const LAS float*)(L + RA_AABS) + row * 65) : ((const LAS float*)(L + RA_MKA) + (row - 64) * RS);
        LAS bf16* Z = (LAS bf16*)(L + RA_Z); LAS float* pre = (LAS float*)(L + RA_PRE);
        for (int i = t4; i < 1088; i += NTHR) ((LAS v4u*)Z)[i] = (v4u){0u, 0u, 0u, 0u};
        __syncthreads();
#pragma unroll 1
        for (int jb = 0; jb < 4; ++jb) {
            if (jb > 0) {
                f32x4 acc = {0.f, 0.f, 0.f, 0.f};
#pragma unroll
                for (int ks = 0; ks < 2; ++ks) { const bf16x8_t a = *(const LAS bf16x8_t*)(Z + (w * 16 + li4) * RS + ks * 32 + lq4 * 8);
                    const bf16x8_t bm = *(const LAS bf16x8_t*)(MbaT + (jb * 16 + li4) * RS + ks * 32 + lq4 * 8);
                    acc = __builtin_amdgcn_mfma_f32_16x16x32_bf16(a, bm, acc, 0, 0, 0); }
                LAS float* pp = pre + (w * 16 + lq4 * 4) * 16 + li4;
                pp[0] = acc.x; pp[16] = acc.y; pp[32] = acc.z; pp[48] = acc.w;
                __syncthreads();
            }
            float yv[16]; v2u mv[16];
#pragma unroll
            for (int u = 0; u < 16; ++u) { yv[u] = Yrow[jb * 16 + u] + (jb > 0 ? pre[row * 16 + u] : 0.f); mv[u] = *(const LAS v2u*)(MbaT + (jb * 16 + u) * RS + jb * 16 + q * 4); }
            float zb[4] = {0.f, 0.f, 0.f, 0.f};
#pragma unroll
            for (int u = 0; u < 16; ++u) {
                float part = (zb[0] * bflo(mv[u].x) + zb[1] * bfhi(mv[u].x)) + (zb[2] * bflo(mv[u].y) + zb[3] * bfhi(mv[u].y));
                part += dpp_xor1(part); part += dpp_xor2(part);
                const float zt = yv[u] + part;
                zb[u & 3] = (q == (u >> 2)) ? zt : zb[u & 3];
            }
            { v2u pk; pk.x = pk2(zb[0], zb[1]); pk.y = pk2(zb[2], zb[3]); *(LAS v2u*)(Z + row * RS + jb * 16 + q * 4) = pk; }
            __syncthreads();
        }
    }
    {
        int t5 = tid; asm volatile("" : "+v"(t5)); const int li = t5 & 15, lq = (t5 >> 4) & 3;
        const LAS bf16* Z = (const LAS bf16*)(L + RA_Z); const LAS bf16* NbrT = (const LAS bf16*)(L + RA_NBRT); const LAS bf16* BhT = (const LAS bf16*)(L + RA_BHT);
        const LAS bf16* Rab = (const LAS bf16*)(L + RA_RABS); const LAS bf16* KhT = (const LAS bf16*)(L + RA_KHT); const LAS float* gC = (const LAS float*)(L + RA_GC);
        LAS bf16* QsT = (LAS bf16*)(L + RA_QST); LAS bf16* QoT = (LAS bf16*)(L + RA_QOT);
        bf16* PoT = (bf16*)(A->ws + WS_RSC + RWO_POT) + (size_t)unit * 4096; bf16* PsT = (bf16*)(A->ws + WS_RSC + RWO_PST) + (size_t)unit * 4096;
        bf16x8_t zW[2], zX[2], bN[2][2], bH[2][2]; v2u rb[2], kb[2], nb2[2]; float gc[2];
#pragma unroll
        for (int ks = 0; ks < 2; ++ks) { zW[ks] = FRAG(Z, rt * 16, ks); zX[ks] = FRAG(Z, 64 + rt * 16, ks);
#pragma unroll
            for (int j = 0; j < 2; ++j) { bN[j][ks] = FRAG(NbrT, (ct0 + j) * 16, ks); bH[j][ks] = FRAG(BhT, (ct0 + j) * 16, ks); } }
#pragma unroll
        for (int j = 0; j < 2; ++j) { const int col = (ct0 + j) * 16 + li, rw = rt * 16 + lq * 4; rb[j] = *(const LAS v2u*)(Rab + col * RS + rw); kb[j] = *(const LAS v2u*)(KhT + col * RS + rw); nb2[j] = *(const LAS v2u*)((const LAS bf16*)(L + RA_NKRT) + col * RS + rw); gc[j] = gC[col]; }
#pragma unroll
        for (int j = 0; j < 2; ++j) { const int col = (ct0 + j) * 16 + li, rw = rt * 16 + lq * 4;
            { f32x4 acc = {bflo(rb[j].x), bfhi(rb[j].x), bflo(rb[j].y), bfhi(rb[j].y)};
                acc = MM(zW[1], bN[j][1], MM(zW[0], bN[j][0], acc));
                v2u pk; pk.x = pk2(acc.x, acc.y); pk.y = pk2(acc.z, acc.w); *(v2u*)(PoT + (size_t)col * 64 + rw) = pk; }
            { f32x4 acc = {(rw + 0 == col) ? gc[j] : 0.f, (rw + 1 == col) ? gc[j] : 0.f, (rw + 2 == col) ? gc[j] : 0.f, (rw + 3 == col) ? gc[j] : 0.f};
                acc = MM(zW[1], bH[j][1], MM(zW[0], bH[j][0], acc));
                v2u pk; pk.x = pk2(acc.x, acc.y); pk.y = pk2(acc.z, acc.w); *(v2u*)(PsT + (size_t)col * 64 + rw) = pk; }
            { f32x4 acc = {bflo(nb2[j].x), bfhi(nb2[j].x), bflo(nb2[j].y), bfhi(nb2[j].y)};
                acc = MM(zX[1], bN[j][1], MM(zX[0], bN[j][0], acc));
                v2u pk; pk.x = pk2(acc.x, acc.y); pk.y = pk2(acc.z, acc.w); *(LAS v2u*)(QoT + col * RS + rw) = pk; }
            { f32x4 acc = {bflo(kb[j].x), bfhi(kb[j].x), bflo(kb[j].y), bfhi(kb[j].y)};
                acc = MM(zX[1], bH[j][1], MM(zX[0], bH[j][0], acc));
                v2u pk; pk.x = pk2(acc.x, acc.y); pk.y = pk2(acc.z, acc.w); *(LAS v2u*)(QsT + col * RS + rw) = pk; }
        }
    }
    __syncthreads();
    {
        int t6 = tid; asm volatile("" : "+v"(t6)); const int li = t6 & 15, lq = (t6 >> 4) & 3;
        const LAS bf16* VT = (const LAS bf16*)(L + RA_VT);
        const bool isO = (w & 1);
        const LAS bf16* Bm = (const LAS bf16*)(L + (isO ? RA_QOT : RA_QST));
        float* dst = (float*)(A->ws + WS_RSC + (isO ? RWO_OLT : RWO_GT)) + (size_t)unit * 4096;
        bf16x8_t av[2], bq[4][2];
#pragma unroll
        for (int ks = 0; ks < 2; ++ks) { av[ks] = FRAG(VT, rt * 16, ks);
#pragma unroll
            for (int j = 0; j < 4; ++j) bq[j][ks] = FRAG(Bm, j * 16, ks); }
#pragma unroll
        for (int j = 0; j < 4; ++j) { const f32x4 z = {0.f, 0.f, 0.f, 0.f};
            const f32x4 acc = MM(av[1], bq[j][1], MM(av[0], bq[j][0], z));
            *(f32x4*)(dst + (size_t)(j * 16 + li) * 64 + rt * 16 + lq * 4) = acc; }
    }
#undef FRAG
#undef MM
    __syncthreads();
}

__device__ __forceinline__ void rwkvB_scan(ArgsP A, const Frame& F, int unit) {
    const int bh = unit >> 2, rq = unit & 3;
    const int tid = F.tid, lane = F.lane, w = F.wave, ct = w & 3, li = lane & 15, lq = lane >> 4;
    const bool writer = (w < 4);
    const bf16* PsT = (const bf16*)(A->ws + WS_RSC + RWO_PST) + (size_t)bh * 64 * 4096; const float* GT = (const float*)(A->ws + WS_RSC + RWO_GT) + (size_t)bh * 64 * 4096;
    bf16* SC = (bf16*)(A->ws + WS_RSC + RWO_SC) + (size_t)bh * 64 * 4096;
    f32x4 S = {0.f, 0.f, 0.f, 0.f};
    constexpr int PF = 4;
    bf16x8_t pb[PF][2]; f32x4 gq[PF];
    const int col = ct * 16 + li;
#define SLOAD(slot, cc_) do { _Pragma("unroll") for (int ks = 0; ks < 2; ++ks) pb[slot][ks] = *(const bf16x8_t*)(PsT + (size_t)(cc_) * 4096 + (size_t)col * 64 + ks * 32 + lq * 8); \
        gq[slot] = *(const f32x4*)(GT + (size_t)(cc_) * 4096 + (size_t)col * 64 + rq * 16 + lq * 4); } while (0)
#define SSTEP(slot, cc_) do { LAS bf16* Sl = (LAS bf16*)(F.lds + ((cc_) & 1) * 2176); \
        if (writer) { const int rw_ = lq * 4; Sl[(rw_ + 0) * RS + col] = (bf16)f2bf(S.x); Sl[(rw_ + 1) * RS + col] = (bf16)f2bf(S.y); Sl[(rw_ + 2) * RS + col] = (bf16)f2bf(S.z); Sl[(rw_ + 3) * RS + col] = (bf16)f2bf(S.w); } \
        asm volatile("s_waitcnt lgkmcnt(0)" ::: "memory"); __builtin_amdgcn_s_barrier(); asm volatile("" ::: "memory");        \
        if (tid < 128) { const int v_ = tid >> 3, k8_ = (tid & 7) * 8; *(v4u*)(SC + (size_t)(cc_) * 4096 + (rq * 16 + v_) * 64 + k8_) = *(const LAS v4u*)(Sl + v_ * RS + k8_); } \
        f32x4 acc_ = gq[slot]; \
        _Pragma("unroll") for (int ks = 0; ks < 2; ++ks) { const bf16x8_t a_ = *(const LAS bf16x8_t*)(Sl + li * RS + ks * 32 + lq * 8); \
            acc_ = __builtin_amdgcn_mfma_f32_16x16x32_bf16(a_, pb[slot][ks], acc_, 0, 0, 0); } \
        S = acc_; } while (0)
    SLOAD(0, 0); SLOAD(1, 1); SLOAD(2, 2); SLOAD(3, 3);
#pragma unroll 1
    for (int c = 0; c < 64; c += 4) {
        const int cn = (c + 4 < 64) ? c + 4 : 60;
        SSTEP(0, c);     SLOAD(0, cn);
        SSTEP(1, c + 1); SLOAD(1, cn + 1);
        SSTEP(2, c + 2); SLOAD(2, cn + 2);
        SSTEP(3, c + 3); SLOAD(3, cn + 3);
    }
#undef SLOAD
#undef SSTEP
    __syncthreads();
}

__device__ __forceinline__ void rwkvC_unit(ArgsP A, const Frame& F_in, int l, int unit) {
    Frame F = F_in; asm volatile("" : "+v"(F.tid)); F.lane = F.tid & 63;

    const int bh = unit >> 6, c = unit & 63, b = bh / RW_H, h = bh % RW_H, t0 = b * SEQ + c * 64, tid = F.tid, lane = F.lane, w = F.wave;
    const int rt = w >> 1, ct0 = (w & 1) * 2, li = lane & 15, lq = lane >> 4;
    LAS bf16* Sl = (LAS bf16*)F.lds; LAS bf16* Pl = (LAS bf16*)(F.lds + 8704); LAS float* ob = (LAS float*)(F.lds + 17408);
    { const int r = tid >> 3, k8 = (tid & 7) * 8;
        *(LAS v4u*)(Sl + r * RS + k8) = *(const v4u*)((const bf16*)(A->ws + WS_RSC + RWO_SC) + (size_t)unit * 4096 + r * 64 + k8);
        *(LAS v4u*)(Pl + r * RS + k8) = *(const v4u*)((const bf16*)(A->ws + WS_RSC + RWO_POT) + (size_t)unit * 4096 + r * 64 + k8); }
    __syncthreads();
    const float* OlT = (const float*)(A->ws + WS_RSC + RWO_OLT) + (size_t)unit * 4096;
#pragma unroll
    for (int j = 0; j < 2; ++j) { const int tcol = (ct0 + j) * 16 + li, vr = rt * 16 + lq * 4;
        f32x4 acc = *(const f32x4*)(OlT + (size_t)tcol * 64 + vr);
        acc = tile_mm64(Sl, rt * 16, Pl, (ct0 + j) * 16, acc, lane);
        *(LAS f32x4*)(ob + tcol * 68 + vr) = acc; }
    __syncthreads();
    { const int t = tid >> 3, q = tid & 7; const size_t tg = (size_t)t0 + t;
        const f32x4 o0 = *(const LAS f32x4*)(ob + t * 68 + q * 8), o1 = *(const LAS f32x4*)(ob + t * 68 + q * 8 + 4);
        const float mean = red8((o0.x + o0.y) + (o0.z + o0.w) + (o1.x + o1.y) + (o1.z + o1.w)) * (1.f / 64.f);
        const f32x4 d0 = o0 - mean, d1 = o1 - mean;
        const float var = red8((d0.x * d0.x + d0.y * d0.y) + (d0.z * d0.z + d0.w * d0.w) + (d1.x * d1.x + d1.y * d1.y) + (d1.z * d1.z + d1.w * d1.w)) * (1.f / 64.f);
        const float rs = rsqrtf(var + 64e-5f);
        const int cc = h * 64 + q * 8;
        const f32x4 g0 = *(const f32x4*)(A->in[20] + (size_t)l * RW_W + cc), g1 = *(const f32x4*)(A->in[20] + (size_t)l * RW_W + cc + 4);
        const f32x4 b0 = *(const f32x4*)(A->in[21] + (size_t)l * RW_W + cc), b1 = *(const f32x4*)(A->in[21] + (size_t)l * RW_W + cc + 4);
        const f32x4 bv0 = *(const f32x4*)((const float*)(A->ws + WS_RBV) + tg * RW_W + cc), bv1 = *(const f32x4*)((const float*)(A->ws + WS_RBV) + tg * RW_W + cc + 4);
        const f32x4 ga0 = *(const f32x4*)((const float*)(A->ws + WS_RGATE) + tg * RW_W + cc), ga1 = *(const f32x4*)((const float*)(A->ws + WS_RGATE) + tg * RW_W + cc + 4);
        const f32x4 y0 = (d0 * rs * g0 + b0 + bv0) * ga0, y1 = (d1 * rs * g1 + b1 + bv1) * ga1;
        v4u o; o.x = pk2(y0.x, y0.y); o.y = pk2(y0.z, y0.w); o.z = pk2(y1.x, y1.y); o.w = pk2(y1.z, y1.w);
        *(v4u*)((bf16*)(A->ws + WS_Y) + tg * DM + 1280 + cc) = o; }
    __syncthreads();
}

constexpr size_t RWO_GQ = 84 * MiB, RWO_GK = 92 * MiB, RWO_GVT = 100 * MiB, RWO_GEM = 116 * MiB;
constexpr int GQS = 104, GTS = 72;
template <int NKS> __device__ __forceinline__ f32x4 tile_mm(const LAS bf16* Am, int sa, int arow0, const LAS bf16* Bm, int sb, int brow0, f32x4 acc, int lane) {
    const int r = lane & 15, kq = (lane >> 4) * 8;
#pragma unroll
    for (int ks = 0; ks < NKS; ++ks) {
        const bf16x8_t a = *(const LAS bf16x8_t*)(Am + (arow0 + r) * sa + ks * 32 + kq);
        const bf16x8_t b = *(const LAS bf16x8_t*)(Bm + (brow0 + r) * sb + ks * 32 + kq);
        acc = __builtin_amdgcn_mfma_f32_16x16x32_bf16(a, b, acc, 0, 0, 0);
    }
    return acc;
}

__device__ __forceinline__ int gsw(int row) { return ((row >> 2) ^ (row >> 5)) & 7; }
__device__ __forceinline__ f32x4 tile_mm_sw(const LAS bf16* Am, int arow0, const LAS bf16* Bm, int brow0, f32x4 acc, int lane) {
    const int r = lane & 15, cq = lane >> 4, fa = gsw(arow0 + r), fb = gsw(brow0 + r);
#pragma unroll
    for (int ks = 0; ks < 2; ++ks) {
        const bf16x8_t a = *(const LAS bf16x8_t*)(Am + (arow0 + r) * GTS + (((ks * 4 + cq) ^ fa) << 3));
        const bf16x8_t b = *(const LAS bf16x8_t*)(Bm + (brow0 + r) * GTS + (((ks * 4 + cq) ^ fb) << 3));
        acc = __builtin_amdgcn_mfma_f32_16x16x32_bf16(a, b, acc, 0, 0, 0);
    }
    return acc;
}
__device__ __forceinline__ void gla1_unit(ArgsP A, const Frame& F_in, int l, int unit) {
    Frame F = F_in; asm volatile("" : "+v"(F.tid)); F.lane = F.tid & 63;
    const int bh = unit >> 6, c = unit & 63, b = bh >> 2, h = bh & 3, t0 = b * SEQ + c * 64, tid = F.tid, lane = F.lane, w = F.wave;
    const float* proj = (const float*)(A->ws + WS_PROJ);
    LAS float* bcum = (LAS float*)F.lds;
    LAS float* ad = bcum + 6144;
    LAS float* up = ad + 1024;
    LAS bf16* KtT = (LAS bf16*)(F.lds + 34816);
    LAS bf16* VT = (LAS bf16*)(F.lds + 48640);
    f32x4 qq[3], kq[3], vq[6];
#pragma unroll
    for (int it = 0; it < 3; ++it) { const int i = tid + it * NTHR, tok = i / 24, d4 = i % 24; const float* rp = proj + (size_t)(t0 + tok) * INWP + h * 96 + d4 * 4;
        qq[it] = *(const f32x4*)(rp + C_GQ); kq[it] = *(const f32x4*)(rp + C_GK); }
#pragma unroll
    for (int it = 0; it < 6; ++it) { const int i = tid + it * NTHR, tok = i / 48, e4 = i % 48; vq[it] = *(const f32x4*)(proj + (size_t)(t0 + tok) * INWP + C_GV + h * 192 + e4 * 4); }
    gla_bcum(A, F, l, h, t0, bcum, ad, up);
    const float qs = 0.10206207261596575f;
    bf16* Qg = (bf16*)(A->ws + WS_RSC + RWO_GQ) + (size_t)unit * 6144; bf16* Kg = (bf16*)(A->ws + WS_RSC + RWO_GK) + (size_t)unit * 6144;
#pragma unroll
    for (int it = 0; it < 3; ++it) { const int i = tid + it * NTHR, tok = i / 24, d = (i % 24) * 4;
        const float qv[4] = {qq[it].x, qq[it].y, qq[it].z, qq[it].w}, kv[4] = {kq[it].x, kq[it].y, kq[it].z, kq[it].w}; float qo[4], ko[4];
#pragma unroll
        for (int e = 0; e < 4; ++e) { const float m = bcum[31 * 96 + d + e], bb = bcum[tok * 96 + d + e];
            qo[e] = qv[e] * qs * __expf(bb - m); ko[e] = kv[e] * __expf(m - bb); KtT[(d + e) * GTS + ((((tok >> 3) ^ gsw(d + e)) << 3) | (tok & 7))] = (bf16)f2bf(ko[e]); }
        v2u pq, pk; pq.x = pk2(qo[0], qo[1]); pq.y = pk2(qo[2], qo[3]); pk.x = pk2(ko[0], ko[1]); pk.y = pk2(ko[2], ko[3]);
        *(v2u*)(Qg + tok * 96 + d) = pq; *(v2u*)(Kg + tok * 96 + d) = pk; }
#pragma unroll
    for (int it = 0; it < 6; ++it) { const int i = tid + it * NTHR, tok = i / 48, e = (i % 48) * 4;
        const int ts = tok >> 3, tl = tok & 7;
        VT[(e + 0) * GTS + (((ts ^ gsw(e + 0)) << 3) | tl)] = (bf16)f2bf(vq[it].x); VT[(e + 1) * GTS + (((ts ^ gsw(e + 1)) << 3) | tl)] = (bf16)f2bf(vq[it].y);
        VT[(e + 2) * GTS + (((ts ^ gsw(e + 2)) << 3) | tl)] = (bf16)f2bf(vq[it].z); VT[(e + 3) * GTS + (((ts ^ gsw(e + 3)) << 3) | tl)] = (bf16)f2bf(vq[it].w); }
    if (tid < 96) { ((float*)(A->ws + WS_RSC + RWO_GEM))[(size_t)unit * 96 + tid] = __expf(bcum[31 * 96 + tid]);
        ((float*)(A->ws + WS_GDEC))[(size_t)unit * 96 + tid] = __expf(bcum[63 * 96 + tid]); }
    __syncthreads();
    { bf16* VTg = (bf16*)(A->ws + WS_RSC + RWO_GVT) + (size_t)unit * 12288;
#pragma unroll
        for (int it = 0; it < 3; ++it) { const int i = tid + it * NTHR, e = i >> 3, t8 = (i & 7) * 8; *(v4u*)(VTg + e * 64 + t8) = *(const LAS v4u*)(VT + e * GTS + ((((i & 7) ^ gsw(e))) << 3)); } }
    { const int li = lane & 15, lq = lane >> 4;
        float* KVg = (float*)(A->ws + WS_GKV) + (size_t)unit * 18432;
#pragma unroll
        for (int a = 0; a < 3; ++a) { const int dt = (w & 1) * 3 + a, d0 = dt * 16 + lq * 4;
            const float s0 = __expf(bcum[63 * 96 + d0] - bcum[31 * 96 + d0]), s1 = __expf(bcum[63 * 96 + d0 + 1] - bcum[31 * 96 + d0 + 1]),
                        s2 = __expf(bcum[63 * 96 + d0 + 2] - bcum[31 * 96 + d0 + 2]), s3 = __expf(bcum[63 * 96 + d0 + 3] - bcum[31 * 96 + d0 + 3]);
#pragma unroll
            for (int bb = 0; bb < 3; ++bb) { const int et = (w >> 1) * 3 + bb; const f32x4 z = {0.f, 0.f, 0.f, 0.f};
                f32x4 acc = tile_mm_sw(KtT, dt * 16, VT, et * 16, z, lane);
                acc.x *= s0; acc.y *= s1; acc.z *= s2; acc.w *= s3;
                *(f32x4*)(KVg + (size_t)(et * 16 + li) * 96 + d0) = acc; } } }
    __syncthreads();
}

__device__ __forceinline__ void gla3_unit(ArgsP A, const Frame& F_in, int l, int unit) {
    Frame F = F_in; asm volatile("" : "+v"(F.tid)); F.lane = F.tid & 63;
    const int bh = unit >> 6, c = unit & 63, b = bh >> 2, h = bh & 3, t0 = b * SEQ + c * 64, tid = F.tid, lane = F.lane, w = F.wave;
    const int li = lane & 15, lq = lane >> 4;
    const float* proj = (const float*)(A->ws + WS_PROJ);
    LAS bf16* Qs = (LAS bf16*)F.lds;
    LAS bf16* Ks = (LAS bf16*)(F.lds + 13312);
    LAS bf16* VT = (LAS bf16*)(F.lds + 26624);
    LAS bf16* ST = (LAS bf16*)(F.lds + 54272);
    LAS bf16* att = (LAS bf16*)(F.lds + 94208);
    LAS float* ssq = (LAS float*)(F.lds + 103424);
    LAS float* em = (LAS float*)(F.lds + 103936);
    LAS float* ob = (LAS float*)(F.lds + 26624);
    {
        const v4u* Qg = (const v4u*)((const bf16*)(A->ws + WS_RSC + RWO_GQ) + (size_t)unit * 6144); const v4u* Kg = (const v4u*)((const bf16*)(A->ws + WS_RSC + RWO_GK) + (size_t)unit * 6144);
        const v4u* VTg = (const v4u*)((const bf16*)(A->ws + WS_RSC + RWO_GVT) + (size_t)unit * 12288);
        const f32x4* GS = (const f32x4*)((const float*)(A->ws + WS_GS) + (size_t)unit * 18432);
        v4u q0 = Qg[tid], k0 = Kg[tid], q1 = {0u, 0u, 0u, 0u}, k1 = {0u, 0u, 0u, 0u};
        if (tid < 256) { q1 = Qg[512 + tid]; k1 = Kg[512 + tid]; }
        v4u vt[3]; f32x4 sg[9];
#pragma unroll
        for (int it = 0; it < 3; ++it) vt[it] = VTg[tid + it * NTHR];
#pragma unroll
        for (int it = 0; it < 9; ++it) sg[it] = GS[tid + it * NTHR];
        if (tid < 96) em[tid] = ((const float*)(A->ws + WS_RSC + RWO_GEM))[(size_t)unit * 96 + tid];
        { const int i = tid, t = i / 12, c8 = (i % 12) * 8; *(LAS v4u*)(Qs + t * GQS + c8) = q0; *(LAS v4u*)(Ks + t * GQS + c8) = k0; }
        if (tid < 256) { const int i = 512 + tid, t = i / 12, c8 = (i % 12) * 8; *(LAS v4u*)(Qs + t * GQS + c8) = q1; *(LAS v4u*)(Ks + t * GQS + c8) = k1; }
#pragma unroll
        for (int it = 0; it < 3; ++it) { const int i = tid + it * NTHR, e = i >> 3, t8 = (i & 7) * 8; *(LAS v4u*)(VT + e * GTS + t8) = vt[it]; }
        __syncthreads();
#pragma unroll
        for (int it = 0; it < 9; ++it) { const int i = tid + it * NTHR, e = i / 24, d = (i % 24) * 4; const f32x4 m4 = *(const LAS f32x4*)(em + d);
            v2u pk; pk.x = pk2(sg[it].x * m4.x, sg[it].y * m4.y); pk.y = pk2(sg[it].z * m4.z, sg[it].w * m4.w); *(LAS v2u*)(ST + e * GQS + d) = pk; }
    }
    __syncthreads();
#pragma unroll
    for (int a = 0; a < 2; ++a) { const int jt = w >> 1, it = (w & 1) * 2 + a; const f32x4 z = {0.f, 0.f, 0.f, 0.f};
        f32x4 acc = z;
        if (jt <= it) acc = tile_mm<3>(Ks, GQS, jt * 16, Qs, GQS, it * 16, z, lane);
        const int i = it * 16 + li, j0 = jt * 16 + lq * 4;
        acc.x = (j0 + 0 <= i) ? acc.x : 0.f; acc.y = (j0 + 1 <= i) ? acc.y : 0.f; acc.z = (j0 + 2 <= i) ? acc.z : 0.f; acc.w = (j0 + 3 <= i) ? acc.w : 0.f;
        v2u pk; pk.x = pk2(acc.x, acc.y); pk.y = pk2(acc.z, acc.w); *(LAS v2u*)(att + i * GTS + j0) = pk; }
    __syncthreads();
    f32x4 o[6];
    { const int it = w >> 1;
#pragma unroll
        for (int a = 0; a < 6; ++a) { const int et = (w & 1) * 6 + a; const f32x4 z = {0.f, 0.f, 0.f, 0.f};
            f32x4 acc = tile_mm<2>(att, GTS, it * 16, VT, GTS, et * 16, z, lane);
            o[a] = tile_mm<3>(Qs, GQS, it * 16, ST, GQS, et * 16, acc, lane); }
        float s0 = 0.f, s1 = 0.f, s2 = 0.f, s3 = 0.f;
#pragma unroll
        for (int a = 0; a < 6; ++a) { s0 += o[a].x * o[a].x; s1 += o[a].y * o[a].y; s2 += o[a].z * o[a].z; s3 += o[a].w * o[a].w; }
        s0 = row16_sum(s0); s1 = row16_sum(s1); s2 = row16_sum(s2); s3 = row16_sum(s3);
        if (li == 0) { const int r0 = it * 16 + lq * 4; ssq[(r0 + 0) * 2 + (w & 1)] = s0; ssq[(r0 + 1) * 2 + (w & 1)] = s1; ssq[(r0 + 2) * 2 + (w & 1)] = s2; ssq[(r0 + 3) * 2 + (w & 1)] = s3; }
    }
    __syncthreads();
    { const int it = w >> 1, r0 = it * 16 + lq * 4;
#pragma unroll
        for (int a = 0; a < 6; ++a) { const int e = ((w & 1) * 6 + a) * 16 + li;
            ob[(r0 + 0) * 196 + e] = o[a].x; ob[(r0 + 1) * 196 + e] = o[a].y; ob[(r0 + 2) * 196 + e] = o[a].z; ob[(r0 + 3) * 196 + e] = o[a].w; } }
    __syncthreads();
    { bf16* Y = (bf16*)(A->ws + WS_Y);
        f32x4 gv[6];
#pragma unroll
        for (int k = 0; k < 6; ++k) { const int i = tid + k * NTHR, t = i / 48, e = (i % 48) * 4; gv[k] = *(const f32x4*)(proj + (size_t)(t0 + t) * INWP + C_GG + h * 192 + e); }
#pragma unroll
        for (int k = 0; k < 6; ++k) { const int i = tid + k * NTHR, t = i / 48, e = (i % 48) * 4;
            const float rstd = rsqrtf((ssq[t * 2] + ssq[t * 2 + 1]) * (1.f / 192.f) + NORM_EPS);
            const f32x4 ov = *(const LAS f32x4*)(ob + t * 196 + e); const f32x4 ng = *(const f32x4*)(A->in[10] + (size_t)l * 768 + h * 192 + e);
            f32x4 y; y.x = ov.x * rstd * ng.x * gv[k].x * sigmoidf_(gv[k].x); y.y = ov.y * rstd * ng.y * gv[k].y * sigmoidf_(gv[k].y);
            y.z = ov.z * rstd * ng.z * gv[k].z * sigmoidf_(gv[k].z); y.w = ov.w * rstd * ng.w * gv[k].w * sigmoidf_(gv[k].w);
            v2u pk; pk.x = pk2(y.x, y.y); pk.y = pk2(y.z, y.w); *(v2u*)(Y + (size_t)(t0 + t) * DM + 512 + h * 192 + e) = pk; } }
    __syncthreads();
}

#define INS16(L, P, x, px) do { { const bool c_ = (x) > L[15]; L[15] = c_ ? (x) : L[15]; P[15] = c_ ? (px) : P[15]; } \
    _Pragma("unroll") for (int r_ = 14; r_ >= 0; --r_) { const bool c_ = L[r_ + 1] > L[r_]; const float tl_ = L[r_]; const int tp_ = P[r_]; \
        L[r_] = c_ ? L[r_ + 1] : tl_; L[r_ + 1] = c_ ? tl_ : L[r_ + 1]; P[r_] = c_ ? P[r_ + 1] : tp_; P[r_ + 1] = c_ ? tp_ : P[r_ + 1]; } } while (0)

__device__ __forceinline__ float gelu_as(float v) {
    const float av = fabsf(v), t = __builtin_amdgcn_rcpf(av * 0.2316418882f + 1.0f);
    float q = t * 0.5307027145f + (-0.7265760135f); q = q * t + 0.7107068705f; q = q * t + (-0.142248368f); q = q * t + 0.127414796f; q = q * t;
    const float e = __builtin_amdgcn_exp2f((v * v) * (-0.72134752044f));
    const float m = v * (q * e);
    return v < 0.f ? m : v - m;
}
__device__ __forceinline__ int row16_sum_i(int v) {
    v += __builtin_amdgcn_update_dpp(0, v, 0xB1, 0xF, 0xF, true); v += __builtin_amdgcn_update_dpp(0, v, 0x4E, 0xF, 0xF, true);
    v += __builtin_amdgcn_update_dpp(0, v, 0x141, 0xF, 0xF, true); v += __builtin_amdgcn_update_dpp(0, v, 0x140, 0xF, 0xF, true); return v;
}
#ifndef PEER_SL_SHIFT
#define PEER_SL_SHIFT 10
#endif
__device__ __forceinline__ void ph_peer4(ArgsP A, LAS unsigned char* lds_, int wv_, int l, const float* g2, const float* sh2, const float* ngain, const float* nsh, const float* nsc, const bool last, const bool dry = false) {
    const Frame F = make_frame(lds_, wv_);
    const int lane = F.lane, li = lane & 15, lq = lane >> 4;
    const float* SCO = (const float*)(A->ws + WS_PROJ);
    const unsigned char* U4 = A->ws + WS_U + (size_t)l * PEER_N * (DM / 2); const unsigned char* V4 = A->ws + WS_V + (size_t)l * PEER_N * (DM / 2);
    const float* US = (const float*)(A->ws + WS_US) + (size_t)l * PEER_N; const float* VS = (const float*)(A->ws + WS_VS) + (size_t)l * PEER_N;
    float* X = (float*)(A->ws + WS_X); bf16* H = (bf16*)(A->ws + WS_H); const float* ssr = (const float*)(A->ws + WS_SSP) + (size_t)l * NT * 32;
    LAS unsigned char* wl = F.lds + F.wave * 15104;
    LAS int* es = (LAS int*)wl; LAS float* gs = (LAS float*)(wl + 4096);
    LAS v4u* hl = (LAS v4u*)wl;
    LAS int* se = (LAS int*)(wl + 8448);
    LAS float* sg = (LAS float*)(wl + 10496);
    LAS int* st = (LAS int*)(wl + 12544);
    LAS float* dl = (LAS float*)(wl + 14592);
    LAS float* hsl = dl + 64; LAS int* hsi = (LAS int*)(dl + 68);
    for (int tb = F.gw * 4; tb < NT; tb += F.ngw * 4) {
        {
            int P2[16]; float gt[16];
            const int prob = tb * 16 + lane, half = lane & 1;
            const f32x4* s4 = (const f32x4*)(SCO + (size_t)prob * 128);
            int KK[16];
#pragma unroll
            for (int r = 0; r < 16; ++r) KK[r] = (int)0x80000000;
            f32x4 nv[4];
#pragma unroll
            for (int i = 0; i < 4; ++i) nv[i] = s4[i];
#define KINS(x_, idx_) do { const int b_ = __builtin_bit_cast(int, (float)(x_)); int k_ = b_ ^ ((b_ >> 31) & 0x7fffffff); k_ = (k_ & ~127) | (127 - (idx_)); \
        _Pragma("unroll") for (int r_ = 0; r_ < 16; ++r_) { const int hi_ = KK[r_] > k_ ? KK[r_] : k_; k_ = KK[r_] > k_ ? k_ : KK[r_]; KK[r_] = hi_; } } while (0)
#pragma unroll 1
            for (int q = 0; q < 8; ++q) {
                f32x4 v[4];
#pragma unroll
                for (int i = 0; i < 4; ++i) v[i] = nv[i];
                if (q < 7) {
#pragma unroll
                    for (int i = 0; i < 4; ++i) nv[i] = s4[4 * (q + 1) + i]; }
                _Pragma("unroll") for (int r = 0; r < 16; ++r) asm volatile("" : "+v"(KK[r]));
#pragma unroll
                for (int i = 0; i < 4; ++i) { const int ib = 16 * q + 4 * i;
                    KINS(v[i].x, ib); KINS(v[i].y, ib + 1); KINS(v[i].z, ib + 2); KINS(v[i].w, ib + 3); }
            }
#undef KINS
            float v1[16], v2[16];
            LAS int* gsi = (LAS int*)gs;
#pragma unroll
            for (int r = 0; r < 16; ++r) { const int ok = __builtin_amdgcn_update_dpp(0, KK[r], 0xB1, 0xF, 0xF, true);
                const int k1 = half ? ok : KK[r], k2 = half ? KK[r] : ok; const int a1 = k1 & ~127, a2 = k2 & ~127;
                v1[r] = __builtin_bit_cast(float, a1 ^ ((a1 >> 31) & 0x7fffffff)); v2[r] = __builtin_bit_cast(float, a2 ^ ((a2 >> 31) & 0x7fffffff));
                es[r * 64 + lane] = 127 - (k1 & 127); gsi[r * 64 + lane] = 127 - (k2 & 127); }
            int Q[16];
#define MKKEY2(a_, b_) ({ const int bb_ = __builtin_bit_cast(int, v1[a_] + v2[b_]); const int kk_ = bb_ ^ ((bb_ >> 31) & 0x7fffffff); (kk_ & ~255) | (255 - ((a_) * 16 + (b_))); })
#pragma unroll
            for (int bq = 0; bq < 16; ++bq) Q[bq] = MKKEY2(0, bq);
#pragma unroll
            for (int a = 1; a < 16; ++a)
#pragma unroll
                for (int bq = 0; bq < 16; ++bq) if ((a + 1) * (bq + 1) <= 16) { int k_ = MKKEY2(a, bq);
#pragma unroll
                    for (int r = (a + 1) * (bq + 1) - 1; r < 16; ++r) { const int hi_ = Q[r] > k_ ? Q[r] : k_; k_ = Q[r] > k_ ? k_ : Q[r]; Q[r] = hi_; } }
#undef MKKEY2
            float L2[16];
#pragma unroll
            for (int r = 0; r < 16; ++r) { const int ab = 255 - (Q[r] & 255); const int qv = Q[r] & ~255; L2[r] = __builtin_bit_cast(float, qv ^ ((qv >> 31) & 0x7fffffff));
                P2[r] = es[(ab >> 4) * 64 + lane] * 128 + gsi[(ab & 15) * 64 + lane]; }
            float sum = 0.f;
#pragma unroll
            for (int r = 0; r < 16; ++r) { gt[r] = __expf(L2[r] - L2[0]); sum += gt[r]; }
            const float inv = 1.f / sum;
#pragma unroll
            for (int r = 0; r < 16; ++r) { es[r * 64 + lane] = P2[r]; gs[r * 64 + lane] = gt[r] * inv; }
            asm volatile("s_waitcnt lgkmcnt(0)" ::: "memory");
        }
        {
            int ee[8]; float gg[8];
#pragma unroll
            for (int j = 0; j < 8; ++j) { const int x = j * 64 + lane, k = x >> 7, y = x & 127; ee[j] = es[(y & 15) * 64 + k * 16 + 2 * (y >> 4)]; gg[j] = gs[(y & 15) * 64 + k * 16 + 2 * (y >> 4)]; }
            int base = 0;
#pragma unroll
            for (int p = 0; p < 2; ++p) {
#pragma unroll 1
                for (int s = 0; s < (16384 >> PEER_SL_SHIFT); ++s) {
#pragma unroll
                    for (int jj = 0; jj < 4; ++jj) { const int j = p * 4 + jj; const bool in = (ee[j] >> PEER_SL_SHIFT) == s; const unsigned long long m = __builtin_amdgcn_ballot_w64(in);
                        if (in) { const int pos = base + (int)__builtin_amdgcn_mbcnt_hi((unsigned)(m >> 32), __builtin_amdgcn_mbcnt_lo((unsigned)m, 0u)); se[pos] = ee[j]; sg[pos] = gg[j]; st[pos] = j >> 1; }
                        base += __builtin_popcountll(m); }
                }
            }
        }
        asm volatile("s_waitcnt lgkmcnt(0)" ::: "memory");
#pragma unroll 1
        for (int k = 0; k < 4; ++k) {
            const int t = tb + k, b = t >> 12;
            float hf[32]; float mx = 0.f;
            const v4u* hp = (const v4u*)(H + (size_t)t * DM);
#pragma unroll
            for (int jj = 0; jj < 2; ++jj)
#pragma unroll
                for (int c = 0; c < 2; ++c) { const v4u hv = hp[(jj * 64 + lane) * 2 + c]; const int o = jj * 16 + c * 8;
                    hf[o + 0] = bflo(hv.x); hf[o + 1] = bfhi(hv.x); hf[o + 2] = bflo(hv.y); hf[o + 3] = bfhi(hv.y); hf[o + 4] = bflo(hv.z); hf[o + 5] = bfhi(hv.z); hf[o + 6] = bflo(hv.w); hf[o + 7] = bfhi(hv.w); }
            { const float rstd = rsqrtf(wave_sum(lane < 32 ? ssr[(size_t)t * 32 + lane] : 0.f) * (1.f / DM) + NORM_EPS);
#pragma unroll
                for (int jj = 0; jj < 2; ++jj)
#pragma unroll
                    for (int q = 0; q < 4; ++q) { const f32x4 s4 = *(const f32x4*)(sh2 + (size_t)b * MODW + (jj * 64 + lane) * 16 + 4 * q);
                        hf[jj * 16 + 4 * q] = hf[jj * 16 + 4 * q] * rstd + s4.x; hf[jj * 16 + 4 * q + 1] = hf[jj * 16 + 4 * q + 1] * rstd + s4.y;
                        hf[jj * 16 + 4 * q + 2] = hf[jj * 16 + 4 * q + 2] * rstd + s4.z; hf[jj * 16 + 4 * q + 3] = hf[jj * 16 + 4 * q + 3] * rstd + s4.w; } }
#pragma unroll
            for (int i = 0; i < 32; ++i) mx = fmaxf(mx, fabsf(hf[i]));
            mx = wave_max(mx);
            const float inv = mx > 0.f ? 127.f / mx : 0.f;
            if (lane == 0) hsl[k] = mx * (1.f / 127.f);
            int hsum = 0;
#pragma unroll
            for (int jj = 0; jj < 2; ++jj) { unsigned qd[4];
#pragma unroll
                for (int d = 0; d < 4; ++d) { const int o = jj * 16 + 4 * d; const int q0 = (int)rintf(hf[o] * inv), q1 = (int)rintf(hf[o + 1] * inv), q2 = (int)rintf(hf[o + 2] * inv), q3 = (int)rintf(hf[o + 3] * inv);
                    qd[d] = (unsigned)(q0 & 255) | ((unsigned)(q1 & 255) << 8) | ((unsigned)(q2 & 255) << 16) | ((unsigned)(q3 & 255) << 24); hsum += (q0 + q1) + (q2 + q3); }
                v4u q; q.x = qd[0]; q.y = qd[1]; q.z = qd[2]; q.w = qd[3]; hl[k * 132 + jj * 64 + lane] = q; }
            { hsum = row16_sum_i(hsum); const int hs_all = __builtin_amdgcn_readlane(hsum, 0) + __builtin_amdgcn_readlane(hsum, 16) + __builtin_amdgcn_readlane(hsum, 32) + __builtin_amdgcn_readlane(hsum, 48);
                if (lane == 0) hsi[k] = hs_all; }
        }
        asm volatile("s_waitcnt lgkmcnt(0)" ::: "memory");
        {
            int lu = lane; asm volatile("" : "+v"(lu)); const int tq = lu & 3, pq = (lu >> 2) & 3, kq = lu >> 4;
            v4i hB[8];
            { const LAS v4u* hb = hl + tq * 132 + kq * 4 + pq;
#pragma unroll
                for (int s = 0; s < 4; ++s) { hB[2 * s] = *(const LAS v4i*)(hb + s * 16); hB[2 * s + 1] = *(const LAS v4i*)(hb + 64 + s * 16); } }
            const int hc = 8 * hsi[tq];
            const unsigned char* ubase = U4 + kq * 64 + tq * 16;
#define ULOAD4(buf, q_) do { const int e_ = se[(q_) * 4 + pq]; const unsigned char* up_ = ubase + (size_t)e_ * (DM / 2); \
    _Pragma("unroll") for (int s = 0; s < 4; ++s) buf[s] = *(const v4i*)(up_ + s * 256); } while (0)
#define UCONS4(buf, gi_) do { v4i acc = {0, 0, 0, 0}; \
    _Pragma("unroll") for (int s = 0; s < 4; ++s) { const v4i lo_ = buf[s] & 0x0F0F0F0F, hi_ = (buf[s] >> 4) & 0x0F0F0F0F; \
        acc = __builtin_amdgcn_mfma_i32_16x16x64_i8(lo_, hB[2 * s], acc, 0, 0, 0); acc = __builtin_amdgcn_mfma_i32_16x16x64_i8(hi_, hB[2 * s + 1], acc, 0, 0, 0); } \
    int v_ = pq == 0 ? acc.x : (pq == 1 ? acc.y : (pq == 2 ? acc.z : acc.w)); \
    v_ += __builtin_amdgcn_update_dpp(0, v_, 0x124, 0xF, 0xF, true); v_ += __builtin_amdgcn_update_dpp(0, v_, 0x128, 0xF, 0xF, true); \
    if (pq == 0) dl[((gi_) * 4 + kq) * 4 + tq] = (float)(v_ - hc); } while (0)
            float us_c, vs_c; { const int e0 = se[lu & 15]; us_c = US[e0]; vs_c = VS[e0]; }
            v4i ub0[4], ub1[4], ub2[4], ub3[4];
            ULOAD4(ub0, 0); ULOAD4(ub1, 1); ULOAD4(ub2, 2); ULOAD4(ub3, 3);
#pragma unroll 1
            for (int g = 0; g < 32; ++g) {
                const int gn = g + 1 < 32 ? g + 1 : 31;
                const int en = se[gn * 16 + (lu & 15)]; const float us_n = US[en], vs_n = VS[en];
                UCONS4(ub0, 0); ULOAD4(ub0, gn * 4 + 0);
                UCONS4(ub1, 1); ULOAD4(ub1, gn * 4 + 1);
                UCONS4(ub2, 2); ULOAD4(ub2, gn * 4 + 2);
                UCONS4(ub3, 3); ULOAD4(ub3, gn * 4 + 3);
                if (lu < 16) { const int x = g * 16 + lu; const int tk = st[x];
                    sg[x] = sg[x] * vs_c * gelu_as(dl[lu * 4 + tk] * (us_c * hsl[tk])); }
                us_c = us_n; vs_c = vs_n;
            }
#undef ULOAD4
#undef UCONS4
        }
        asm volatile("s_waitcnt lgkmcnt(0)" ::: "memory");
#define PEER_EPILOGUE(kk_, kt_) do { const int t = tb + (kt_), b = t >> 12; float (&out_k)[32] = out[kk_]; \
            f32x4 xn[2][4]; float ss = 0.f; \
            const f32x4* xr = (const f32x4*)(X + (size_t)t * DM); const f32x4* gr = (const f32x4*)(g2 + (size_t)b * MODW); \
            _Pragma("unroll") \
            for (int jj = 0; jj < 2; ++jj) \
            _Pragma("unroll") \
                for (int q = 0; q < 4; ++q) { const int ix = (jj * 64 + lane) * 4 + q; const f32x4 xv = xr[ix], gv = gr[ix]; f32x4 o4; o4.x = out_k[jj * 16 + 4 * q]; o4.y = out_k[jj * 16 + 4 * q + 1]; o4.z = out_k[jj * 16 + 4 * q + 2]; o4.w = out_k[jj * 16 + 4 * q + 3]; \
                    const f32x4 y = xv + gv * o4; xn[jj][q] = y; ss += (y.x * y.x + y.y * y.y) + (y.z * y.z + y.w * y.w); } \
            const float rstd = rsqrtf(wave_sum(ss) * (1.f / DM) + NORM_EPS); \
            if (!last) { \
                f32x4* xw = (f32x4*)((dry ? (float*)(A->ws + WS_DUMMY) : X) + (size_t)t * DM); v4u* hw = (v4u*)((dry ? (bf16*)(A->ws + WS_DUMMY + 64 * MiB) : H) + (size_t)t * DM); \
            _Pragma("unroll") \
                for (int jj = 0; jj < 2; ++jj) { f32x4 y[4]; \
            _Pragma("unroll") \
                    for (int q = 0; q < 4; ++q) { const int ix = (jj * 64 + lane) * 4 + q; xw[ix] = xn[jj][q]; \
                        const f32x4 g = ((const f32x4*)ngain)[ix], s1 = ((const f32x4*)(nsc + (size_t)b * MODW))[ix], s0 = ((const f32x4*)(nsh + (size_t)b * MODW))[ix]; \
                        y[q] = xn[jj][q] * rstd * g * (s1 + 1.f) + s0; } \
                    v4u o; o.x = pk2(y[0].x, y[0].y); o.y = pk2(y[0].z, y[0].w); o.z = pk2(y[1].x, y[1].y); o.w = pk2(y[1].z, y[1].w); hw[(jj * 64 + lane) * 2] = o; \
                    o.x = pk2(y[2].x, y[2].y); o.y = pk2(y[2].z, y[2].w); o.z = pk2(y[3].x, y[3].y); o.w = pk2(y[3].z, y[3].w); hw[(jj * 64 + lane) * 2 + 1] = o; } \
            } else { \
                f32x4* ow = (f32x4*)((dry ? (float*)(A->ws + WS_DUMMY) : A->out) + (size_t)t * DM); \
            _Pragma("unroll") \
                for (int jj = 0; jj < 2; ++jj) \
            _Pragma("unroll") \
                    for (int q = 0; q < 4; ++q) { const int ix = (jj * 64 + lane) * 4 + q; ow[ix] = xn[jj][q] * rstd * ((const f32x4*)ngain)[ix]; } \
            } \
        } while (0)
#define VLOAD(buf, cfb, tkb, bi_) do { _Pragma("unroll") for (int i = 0; i < 4; ++i) { const int x_ = (bi_) * 4 + i; const int e_ = __builtin_amdgcn_readfirstlane(se[x_]); \
        cfb[i] = __builtin_bit_cast(float, __builtin_amdgcn_readfirstlane(__builtin_bit_cast(int, sg[x_]))); tkb[i] = __builtin_amdgcn_readfirstlane(st[x_]) & 1; \
        const v2u* vp_ = (const v2u*)(V4 + (size_t)e_ * (DM / 2)) + lane_v; buf[i][0] = vp_[0]; buf[i][1] = vp_[64]; } } while (0)
#define VACC(kk_, bv_, cv_) do { const f32x2 c2_ = {cv_, cv_}; \
        _Pragma("unroll") for (int jj = 0; jj < 2; ++jj) { const unsigned wd_[2] = {bv_[jj].x, bv_[jj].y}; \
            _Pragma("unroll") for (int d = 0; d < 2; ++d) { const int o_ = jj * 16 + 8 * d; \
                const f32x2 f0_ = __builtin_amdgcn_cvt_scalef32_pk_f32_fp4((int)wd_[d], 1.0f, 0), f1_ = __builtin_amdgcn_cvt_scalef32_pk_f32_fp4((int)wd_[d], 1.0f, 1), \
                            f2_ = __builtin_amdgcn_cvt_scalef32_pk_f32_fp4((int)wd_[d], 1.0f, 2), f3_ = __builtin_amdgcn_cvt_scalef32_pk_f32_fp4((int)wd_[d], 1.0f, 3); \
                f32x2 a0_ = {out[kk_][o_], out[kk_][o_ + 1]}, a1_ = {out[kk_][o_ + 2], out[kk_][o_ + 3]}, a2_ = {out[kk_][o_ + 4], out[kk_][o_ + 5]}, a3_ = {out[kk_][o_ + 6], out[kk_][o_ + 7]}; \
                a0_ = __builtin_elementwise_fma(c2_, f0_, a0_); a1_ = __builtin_elementwise_fma(c2_, f1_, a1_); a2_ = __builtin_elementwise_fma(c2_, f2_, a2_); a3_ = __builtin_elementwise_fma(c2_, f3_, a3_); \
                out[kk_][o_] = a0_.x; out[kk_][o_ + 1] = a0_.y; out[kk_][o_ + 2] = a1_.x; out[kk_][o_ + 3] = a1_.y; out[kk_][o_ + 4] = a2_.x; out[kk_][o_ + 5] = a2_.y; out[kk_][o_ + 6] = a3_.x; out[kk_][o_ + 7] = a3_.y; } } } while (0)
#define VCONS(buf, cfb, tkb) do { _Pragma("unroll") for (int i = 0; i < 4; ++i) { if (tkb[i] == 0) VACC(0, buf[i], cfb[i]); else VACC(1, buf[i], cfb[i]); } } while (0)
#pragma unroll 1
        for (int p = 0; p < 2; ++p) {
            int lane_v = F.lane; asm volatile("" : "+v"(lane_v));
            float out[2][32];
#pragma unroll
            for (int k = 0; k < 2; ++k)
#pragma unroll
                for (int i = 0; i < 32; ++i) out[k][i] = 0.f;
            {
                v2u vb0[4][2], vb1[4][2]; float c0[4], c1[4]; int t0v[4], t1v[4];
                const int bb = p * 64;
                VLOAD(vb0, c0, t0v, bb); VLOAD(vb1, c1, t1v, bb + 1);
#pragma unroll 1
                for (int bi = 0; bi < 64; bi += 2) {
                    const int b2 = bb + (bi + 2 < 64 ? bi + 2 : 62), b3 = bb + (bi + 3 < 64 ? bi + 3 : 63);
                    VCONS(vb0, c0, t0v); VLOAD(vb0, c0, t0v, b2);
                    VCONS(vb1, c1, t1v); VLOAD(vb1, c1, t1v, b3);
                }
            }
            PEER_EPILOGUE(0, 2 * p); PEER_EPILOGUE(1, 2 * p + 1);
        }
#undef VLOAD
#undef VACC
#undef VCONS
#undef PEER_EPILOGUE
    }
}

__device__ __forceinline__ void PH_norm1_l0(LAS unsigned char* lds, int wv) { ArgsP A = args_ptr(); const float* MOD = (const float*)(A->ws + WS_MOD);
    ph_norm(A->in[0], A->in[4], MOD + 0 * DM, MOD + 1 * DM, (bf16*)(A->ws + WS_H), lds, wv);
    { const Frame F = make_frame(lds, wv); float* B3 = (float*)(A->ws + WS_BIAS3);
        for (int o = F.gw; o < DEPTH * 2 * DM; o += F.ngw) { const int l = o >> 12, b = (o >> 11) & 1, n = o & 2047;
            const float* sh = MOD + (size_t)(l * 2 + b) * MODW + 3 * DM; const v4u* wr = (const v4u*)((const bf16*)(A->ws + WS_WQK) + ((size_t)l * DM + n) * DM);
            float s = 0.f;
#pragma unroll
            for (int j = 0; j < 4; ++j) { const v4u wv4 = wr[j * 64 + F.lane]; const f32x4 s0 = *(const f32x4*)(sh + (j * 64 + F.lane) * 8), s1 = *(const f32x4*)(sh + (j * 64 + F.lane) * 8 + 4);
                s += bflo(wv4.x) * s0.x + bfhi(wv4.x) * s0.y + bflo(wv4.y) * s0.z + bfhi(wv4.y) * s0.w + bflo(wv4.z) * s1.x + bfhi(wv4.z) * s1.y + bflo(wv4.w) * s1.z + bfhi(wv4.w) * s1.w; }
            s = wave_sum(s);
            if (F.lane == 0) B3[o] = s; } } }
__device__ __forceinline__ void PH_gemm1(LAS unsigned char* lds, int wv, int l_) { ArgsP A = args_ptr(); const int l = opaque_i(l_);
    pg8::Gemm g{(const bf16*)(A->ws + WS_H), (const bf16*)(A->ws + WS_WIN) + (size_t)l * INWP * DM, NT, INWP, DM}; pg8::StaticOrder S; S.init(NT, INWP, gridDim.x, blockIdx.x);
    EpiStoreF32 E{(float*)(A->ws + WS_PROJ), INWP, wv};
    pg8::gemm_phase<EpiStoreF32, pg8::StaticOrder, true, true>(lds, g, S, E, wv); }
__device__ __forceinline__ void PH_mixA(LAS unsigned char* lds, int wv, int l_) { ArgsP A = args_ptr(); const int l = opaque_i(l_);
    const Frame F = make_frame(lds, wv);
#ifdef PROBE_A
    for (int u = F.bid; u < 2048; u += F.G) {
        if (u < 1536) { if (PROBE_A == 1) rwkvA_unit(A, F, l, u); }
        else { if (PROBE_A == 2) gla1_unit(A, F, l, u - 1536); }
    }
#endif
    for (int u = F.bid; u < 2048; u += F.G) {
        if (u < 1536) rwkvA_unit(A, F, l, u);
        else gla1_unit(A, F, l, u - 1536);
    }
    if (l + 1 < DEPTH) quant_tables(A, l + 1, F.gw, F.ngw, F.lane);
}
__device__ __forceinline__ void PH_mixB(LAS unsigned char* lds, int wv, int l_) { ArgsP A = args_ptr(); const int l = opaque_i(l_);
    const Frame F = make_frame(lds, wv);
    if (F.G >= 192) {
        if (F.bid < 96) rwkvB_scan(A, F, F.bid);
        else { const int nb = F.G - 96, b2 = F.bid - 96;
            for (int u = b2; u < 288; u += nb) gla_scan_unit(A, F, u);
            for (int u = b2; u < 1024; u += nb) pool_unit(A, F, l, u); }
    } else {
        for (int u = F.bid; u < 288; u += F.G) gla_scan_unit(A, F, u);
        for (int u = F.bid; u < 1024; u += F.G) pool_unit(A, F, l, u);
        for (int u = F.bid; u < 96; u += F.G) rwkvB_scan(A, F, u);
    } }
__device__ __forceinline__ void PH_mixC(LAS unsigned char* lds, int wv, int l_) { ArgsP A = args_ptr(); const int l = opaque_i(l_);
    const Frame F = make_frame(lds, wv);
#ifdef PROBE_C
    for (int u = F.bid; u < 2048; u += F.G) { if (u < 512) { if (PROBE_C == 1) gla3_unit(A, F, l, u); } else { if (PROBE_C == 2) rwkvC_unit(A, F, l, u - 512); } }
#endif
    for (int u = F.bid; u < 2048; u += F.G) { if (u < 512) gla3_unit(A, F, l, u); else rwkvC_unit(A, F, l, u - 512); } }
__device__ __forceinline__ void PH_gemm2(LAS unsigned char* lds, int wv, int l_, bool dry = false) { ArgsP A = args_ptr(); const int l = opaque_i(l_);
    const float* modl = (const float*)(A->ws + WS_MOD) + (size_t)l * 2 * MODW; float* X = (float*)(A->ws + WS_X);
    pg8::Gemm g{(const bf16*)(A->ws + WS_Y), (const bf16*)(A->ws + WS_WOUT) + (size_t)l * DM * DM, NT, DM, DM}; pg8::StaticOrder S; S.init(NT, DM, gridDim.x, blockIdx.x);
    EpiResid E{(l == 0) ? A->in[0] : (const float*)X, dry ? (float*)(A->ws + WS_DUMMY) : X, modl + 2 * DM, wv, A->in[23] + (size_t)l * DM, modl + 4 * DM,
               dry ? (bf16*)(A->ws + WS_DUMMY + 64 * MiB) : (bf16*)(A->ws + WS_H), (dry ? (float*)(A->ws + WS_DUMMY) : (float*)(A->ws + WS_SSP) + (size_t)l * NT * 32)};
    pg8::gemm_phase<EpiResid, pg8::StaticOrder, true, true>(lds, g, S, E, wv); }
__device__ __forceinline__ void PH_norm2(LAS unsigned char* lds, int wv, int l_) { ArgsP A = args_ptr(); const int l = opaque_i(l_);
    const float* modl = (const float*)(A->ws + WS_MOD) + (size_t)l * 2 * MODW;
    ph_norm((const float*)(A->ws + WS_X), A->in[23] + (size_t)l * DM, modl + 3 * DM, modl + 4 * DM, (bf16*)(A->ws + WS_H), lds, wv); }
__device__ __forceinline__ void PH_gemm3(LAS unsigned char* lds, int wv, int l_) { ArgsP A = args_ptr(); const int l = opaque_i(l_);
    pg8::Gemm g{(const bf16*)(A->ws + WS_H), (const bf16*)(A->ws + WS_WQK) + (size_t)l * DM * DM, NT, DM, DM}; pg8::StaticOrder S; S.init(NT, DM, gridDim.x, blockIdx.x);
    LAS float* rs = (LAS float*)(lds + 131072);
    { pg8::Unit u0; const int t = tid_from(wv); if (S.next(0, u0) && t < 256) { const f32x4* sp = (const f32x4*)((const float*)(A->ws + WS_SSP) + ((size_t)l * NT + u0.pm * 256 + t) * 32); float s = 0.f;
#pragma unroll
            for (int j = 0; j < 8; ++j) { const f32x4 v = sp[j]; s += (v.x + v.y) + (v.z + v.w); }
            rs[t] = rsqrtf(s * (1.f / DM) + NORM_EPS); }
        __syncthreads(); }
    EpiScore E{(float*)(A->ws + WS_PROJ), DM, wv, rs, (const float*)(A->ws + WS_BIAS3) + (size_t)l * 2 * DM};
    pg8::gemm_phase<EpiScore, pg8::StaticOrder, true, true>(lds, g, S, E, wv); }
__device__ __forceinline__ void PH_peer(LAS unsigned char* lds, int wv, int l_, bool dry = false) { ArgsP A = args_ptr(); const int l = opaque_i(l_);
    const float* MOD = (const float*)(A->ws + WS_MOD); const float* modl = MOD + (size_t)l * 2 * MODW;
    const bool last = (l == DEPTH - 1);
    const float* nmod = MOD + (size_t)(last ? l : l + 1) * 2 * MODW;
    ph_peer4(A, lds, wv, l, modl + 5 * DM, modl + 3 * DM, last ? A->in[29] : A->in[4] + (size_t)(l + 1) * DM, nmod + 0 * DM, nmod + 1 * DM, last, dry); }

__global__ void __launch_bounds__(NTHR, 2) mega_fwd(Args args) {
    extern __shared__ __attribute__((aligned(16))) unsigned char lds_raw[];
    LAS unsigned char* lds = (LAS unsigned char*)lds_raw;
    volatile LAS unsigned* MISC = (volatile LAS unsigned*)(lds + MISC_OFF);
    const int wv = __builtin_amdgcn_readfirstlane((int)(threadIdx.x >> 6));
    if (wv == 0) MISC[lane_id_()] = 0u;
    __syncthreads();
    XcdBarrier bar = xcd_barrier_post((unsigned*)(args_ptr()->ws + WS_CTL) + CW_BAR, MISC + 8, wv);
#define GRID_BAR() do { XcdBarrier b_ = bar; b_.bar = (unsigned*)(args_ptr()->ws + WS_CTL) + CW_BAR; asm volatile("" : "+s"(b_.x), "+s"(b_.w)); xcd_barrier(b_); if (PROBE & 512) xcd_barrier(b_); } while (0)

    ph_prologue(args_ptr(), lds, wv);
    GRID_BAR();
#if PROBE & 1
    ph_prologue(args_ptr(), lds, wv); GRID_BAR();
#endif
    PH_norm1_l0(lds, wv);
    GRID_BAR();
    for (int l = 0; l < DEPTH; ++l) {
#if PROBE & 2
        PH_gemm1(lds, wv, l); GRID_BAR();
#endif
        PH_gemm1(lds, wv, l); GRID_BAR();
#if PROBE & 4
        PH_mixA(lds, wv, l);  GRID_BAR();
#endif
        PH_mixA(lds, wv, l);  GRID_BAR();
#if PROBE & 8
        PH_mixB(lds, wv, l);  GRID_BAR();
#endif
        PH_mixB(lds, wv, l);  GRID_BAR();
#if PROBE & 16
        PH_mixC(lds, wv, l);  GRID_BAR();
#endif
        PH_mixC(lds, wv, l);  GRID_BAR();
#if PROBE & 32
        PH_gemm2(lds, wv, l, true); GRID_BAR();
#endif
        PH_gemm2(lds, wv, l); GRID_BAR();
#if PROBE & 128
        PH_gemm3(lds, wv, l); GRID_BAR();
#endif
        PH_gemm3(lds, wv, l); GRID_BAR();
#if PROBE & 256
        PH_peer(lds, wv, l, true); GRID_BAR();
#endif
        PH_peer(lds, wv, l);
        if (l + 1 < DEPTH) GRID_BAR();
    }
}

extern "C" void kernel_launch(void* const* d_in, const int* in_sizes, int n_in, void* d_out, int out_size, void* d_ws, size_t ws_size, hipStream_t stream) {
    static int grid = 0;
    if (grid == 0) {
        if (n_in != 30 || out_size != NT * DM || ws_size < WS_END + 96 * MiB) { fprintf(stderr, "kernel_launch: unexpected shapes (n_in %d out %d ws %zu)\n", n_in, out_size, ws_size); grid = -1; return; }
        int dev = 0, cus = 0, per_cu = 0;
        if (hipGetDevice(&dev) != hipSuccess || hipDeviceGetAttribute(&cus, hipDeviceAttributeMultiprocessorCount, dev) != hipSuccess) { grid = -1; return; }
        if (hipFuncSetAttribute((const void*)mega_fwd, hipFuncAttributeMaxDynamicSharedMemorySize, LDS_BYTES) != hipSuccess) { fprintf(stderr, "kernel_launch: hipFuncSetAttribute failed\n"); grid = -1; return; }
        if (hipOccupancyMaxActiveBlocksPerMultiprocessor(&per_cu, (const void*)mega_fwd, NTHR, LDS_BYTES) != hipSuccess || per_cu < 1) { fprintf(stderr, "kernel_launch: occupancy query says %d\n", per_cu); (void)hipGetLastError(); per_cu = 1; }
        grid = cus;
    }
    if (grid < 0) return;
    (void)in_sizes;
    if (hipMemsetAsync((char*)d_ws + WS_CTL, 0, CTL_ZERO_BYTES, stream) != hipSuccess) return;
    Args a{};
    for (int i = 0; i < 30; ++i) a.in[i] = (const float*)d_in[i];
    a.out = (float*)d_out; a.ws = (unsigned char*)d_ws;
    hipLaunchKernelGGL(mega_fwd, dim3(grid), dim3(NTHR), LDS_BYTES, stream, a);
}
```

```cpp
#include <hip/hip_runtime.h>
#include <cstdio>
#include <cstdint>
__device__ __forceinline__ int lane_id_() { int r; asm volatile("v_mbcnt_lo_u32_b32 %0, -1, 0\n\tv_mbcnt_hi_u32_b32 %0, -1, %0" : "=v"(r)); return r; }
__device__ __forceinline__ int tid_from(int wave_s) { return wave_s * 64 + lane_id_(); }
namespace pg8 {
#define PG8_LAS __attribute__((address_space(3)))
typedef unsigned short bf16_t;
typedef short bf16x8 __attribute__((ext_vector_type(8)));
typedef float f32x4 __attribute__((ext_vector_type(4)));
typedef unsigned u32x4 __attribute__((ext_vector_type(4)));
constexpr int BM = 256, BK = 64, HALF = 128, HTB = HALF * BK * 2  , STAGE_BYTES = 8 * HTB, NXCD = 8, WGM = 8;

__host__ __device__ __forceinline__ int lds_byte(int r, int c) { const int st = (r >> 4) * 2 + (c >> 5), rr = r & 15, cc = c & 31, ob = rr * 64 + cc * 2; return st * 1024 + (ob ^ (((ob >> 9) & 1) << 5)); }
__host__ __device__ __forceinline__ void stage_rc(int b, int& R, int& C) { const int st = b / 1024, sb = b % 1024, swz = sb ^ (((sb >> 9) & 1) << 5); R = (st >> 1) * 16 + swz / 64; C = (st & 1) * 32 + (swz % 64) / 2; }
__host__ __device__ __forceinline__ int perm32(int rho) { const int n = rho >> 4, i = rho & 15; return 8 * (i >> 2) + 4 * n + (i & 3); }

struct Unit { int pm, pn; };
struct Gemm { const bf16_t* A; const bf16_t* Bt; int M, N, K; };

struct StaticOrder {
    int nM, nN, nwg, G, c;
    __host__ __device__ void init(int M, int N, int G_, int c_) { nM = M / BM; nN = N / BM; nwg = nM * nN; G = G_; c = c_; }
    __host__ __device__ bool next(int i, Unit& u) const {
        const long L = (long)i * G + c; if (L >= nwg) return false;
        int wgid = (int)L; { const int q = nwg / NXCD, r = nwg % NXCD, xcd = wgid % NXCD, off = wgid / NXCD; wgid = (xcd < r ? xcd * (q + 1) : r * (q + 1) + (xcd - r) * q) + off; }
        const int nig = WGM * nN, gid = wgid / nig, fm = gid * WGM, gsz = (nM - fm) < WGM ? (nM - fm) : WGM;
        u.pm = fm + ((wgid % nig) % gsz); u.pn = (wgid % nig) / gsz; return true;
    }
    __device__ __forceinline__ void a_ready(const Unit&) const {}
    __device__ __forceinline__ void done(const Unit&) const {}
};

template <class Epi, class Sched, bool ALIGN_EPI = false, bool SP2 = false>
__device__ __forceinline__ void gemm_phase(PG8_LAS unsigned char* lds, const Gemm g, const Sched& S, const Epi& E, int wave_s) {
    int tid_o = tid_from(wave_s); asm volatile("" : "+v"(tid_o));
    const int tid = tid_o, wid = __builtin_amdgcn_readfirstlane(tid >> 6), lane = tid & 63, wr = wid >> 2, wc = wid & 3, fr = lane & 15, fq = lane >> 4;
    const int K = g.K, nt = K / BK;
    unsigned voffA[2], voffB[2];
#pragma unroll
    for (int i = 0; i < 2; ++i) { int R, C; stage_rc(tid * 16 + i * 8192, R, C); const int Rb = Epi::PERM ? ((R & ~31) + perm32(R & 31)) : R;
        voffA[i] = (unsigned)(R * K + C) * 2u; voffB[i] = (unsigned)(Rb * K + C) * 2u; }
    const size_t kstep = (size_t)(BK * 2);
    const size_t hstep = (size_t)HALF * K * 2;
    const size_t tstep = 2 * hstep;
    const unsigned ldsw = (unsigned)wid * 1024u;
    const int aoff = lds_byte(wr * 64 + fr, fq * 8), boff = lds_byte(wc * 32 + fr, fq * 8);
#define PG8_SA(b, h) (((b) * 2 + (h)) * HTB)
#define PG8_SB(b, h) ((4 + (b) * 2 + (h)) * HTB)
#define PG8_STAGE(bufoff, gbase, voff) do { _Pragma("unroll") for (int _i = 0; _i < 2; ++_i) \
        __builtin_amdgcn_global_load_lds((const unsigned*)((const char*)(gbase) + (voff)[_i]), (PG8_LAS unsigned*)(lds + (bufoff) + ldsw + _i * 8192), 16, 0, 0); } while (0)
#define PG8_LDA(dst, b, h) do { _Pragma("unroll") for (int m = 0; m < 4; ++m) _Pragma("unroll") for (int k = 0; k < 2; ++k) dst[m][k] = *(const PG8_LAS bf16x8*)(lds + PG8_SA(b, h) + aoff + m * 2048 + k * 1024); } while (0)
#define PG8_LDB(dst, b, h) do { _Pragma("unroll") for (int n = 0; n < 2; ++n) _Pragma("unroll") for (int k = 0; k < 2; ++k) dst[n][k] = *(const PG8_LAS bf16x8*)(lds + PG8_SB(b, h) + boff + n * 2048 + k * 1024); } while (0)
#define PG8_MMA(ai, bj, At, Bt) do { __builtin_amdgcn_s_setprio(1); _Pragma("unroll") for (int m = 0; m < 4; ++m) _Pragma("unroll") for (int n = 0; n < 2; ++n) _Pragma("unroll") for (int k = 0; k < 2; ++k) \
        acc[ai][bj][m][n] = __builtin_amdgcn_mfma_f32_16x16x32_bf16(Bt[n][k], At[m][k], acc[ai][bj][m][n], 0, 0, 0); __builtin_amdgcn_s_setprio(0); } while (0)
#define PG8_WAIT_V(n) asm volatile("s_waitcnt vmcnt(" #n ")" ::: "memory")
#define PG8_WAIT_L(n) asm volatile("s_waitcnt lgkmcnt(" #n ")" ::: "memory")
#define PG8_BAR __builtin_amdgcn_s_barrier()
#define PG8_SCHED __builtin_amdgcn_sched_barrier(0)
    Unit cur, nxt; int ui = 0;
    if (!S.next(0, cur)) return;
    f32x4 acc[2][2][4][2];
#pragma unroll
    for (int a = 0; a < 2; ++a)
#pragma unroll
        for (int b = 0; b < 2; ++b)
#pragma unroll
            for (int m = 0; m < 4; ++m)
#pragma unroll
                for (int n = 0; n < 2; ++n) acc[a][b][m][n] = (f32x4){0.f, 0.f, 0.f, 0.f};
    bf16x8 At[4][2], B0[2][2], B1[2][2];
    const char* cA = (const char*)g.A + (size_t)cur.pm * tstep; const char* cB = (const char*)g.Bt + (size_t)cur.pn * tstep;
    S.a_ready(cur);
    if constexpr (SP2) {
        PG8_STAGE(PG8_SB(0, 0), cB, voffB); PG8_STAGE(PG8_SB(0, 1), cB + hstep, voffB); PG8_STAGE(PG8_SA(0, 0), cA, voffA); PG8_STAGE(PG8_SA(0, 1), cA + hstep, voffA);
        if (wr == 1) PG8_BAR;
        PG8_WAIT_V(2); PG8_BAR;
        PG8_STAGE(PG8_SB(1, 0), cB + kstep, voffB); PG8_STAGE(PG8_SA(1, 0), cA + kstep, voffA); PG8_STAGE(PG8_SB(1, 1), cB + hstep + kstep, voffB);
        PG8_WAIT_V(6); PG8_BAR;
    } else {
        PG8_STAGE(PG8_SB(0, 0), cB, voffB); PG8_STAGE(PG8_SA(0, 0), cA, voffA); PG8_STAGE(PG8_SB(0, 1), cB + hstep, voffB); PG8_STAGE(PG8_SA(0, 1), cA + hstep, voffA);
        if (wr == 1) PG8_BAR;
        PG8_WAIT_V(4); PG8_BAR;
        PG8_STAGE(PG8_SB(1, 0), cB + kstep, voffB); PG8_STAGE(PG8_SA(1, 0), cA + kstep, voffA); PG8_STAGE(PG8_SB(1, 1), cB + hstep + kstep, voffB);
        PG8_WAIT_V(6); PG8_BAR;
    }
    for (;;) {
        const bool has_next = S.next(ui + 1, nxt);
        const char* nA = has_next ? (const char*)g.A + (size_t)nxt.pm * tstep : cA; const char* nB = has_next ? (const char*)g.Bt + (size_t)nxt.pn * tstep : cB;
        for (int t = 0; t < nt; t += 2) {
            const bool last = (t == nt - 2);
            const char* a1 = cA + (size_t)(t + 1) * kstep;
            const char* a2 = last ? nA : cA + (size_t)(t + 2) * kstep; const char* b2 = last ? nB : cB + (size_t)(t + 2) * kstep;
            const char* a3 = a2 + kstep; const char* b3 = b2 + kstep;
            if (last && has_next) S.a_ready(nxt);
            if constexpr (SP2) {
            PG8_LDB(B0, 0, 0); PG8_LDB(B1, 0, 1); PG8_SCHED; PG8_LDA(At, 0, 0); PG8_STAGE(PG8_SA(1, 1), a1 + hstep, voffA);
            PG8_WAIT_V(8); PG8_WAIT_L(0); PG8_BAR; PG8_MMA(0, 0, At, B0); PG8_MMA(0, 1, At, B1); PG8_BAR; PG8_SCHED;
            PG8_LDA(At, 0, 1); PG8_STAGE(PG8_SB(0, 0), b2, voffB); PG8_STAGE(PG8_SB(0, 1), b2 + hstep, voffB); PG8_STAGE(PG8_SA(0, 0), a2, voffA);
            PG8_WAIT_V(8); PG8_WAIT_L(0); PG8_BAR; PG8_MMA(1, 0, At, B0); PG8_MMA(1, 1, At, B1); PG8_BAR; PG8_SCHED;
            PG8_LDB(B0, 1, 0); PG8_LDB(B1, 1, 1); PG8_SCHED; PG8_LDA(At, 1, 0); PG8_STAGE(PG8_SA(0, 1), a2 + hstep, voffA);
            PG8_WAIT_V(8); PG8_WAIT_L(0); PG8_BAR; PG8_MMA(0, 0, At, B0); PG8_MMA(0, 1, At, B1); PG8_BAR; PG8_SCHED;
            PG8_LDA(At, 1, 1); PG8_STAGE(PG8_SB(1, 0), b3, voffB); PG8_STAGE(PG8_SB(1, 1), b3 + hstep, voffB); PG8_STAGE(PG8_SA(1, 0), a3, voffA);
            PG8_WAIT_V(8); PG8_WAIT_L(0); PG8_BAR; PG8_MMA(1, 0, At, B0); PG8_MMA(1, 1, At, B1); PG8_BAR; PG8_SCHED;
            } else {
            PG8_LDB(B0, 0, 0); PG8_SCHED; PG8_LDA(At, 0, 0); PG8_STAGE(PG8_SA(1, 1), a1 + hstep, voffA);
            PG8_WAIT_L(8); PG8_BAR; PG8_WAIT_L(0); PG8_MMA(0, 0, At, B0); PG8_BAR; PG8_SCHED;
            PG8_LDB(B1, 0, 1); PG8_STAGE(PG8_SB(0, 0), b2, voffB);
            PG8_BAR; PG8_WAIT_L(0); PG8_MMA(0, 1, At, B1); PG8_BAR;
            PG8_LDA(At, 0, 1); PG8_STAGE(PG8_SA(0, 0), a2, voffA);
            PG8_BAR; PG8_WAIT_L(0); PG8_MMA(1, 0, At, B0); PG8_BAR; PG8_SCHED;
            PG8_STAGE(PG8_SB(0, 1), b2 + hstep, voffB);
            PG8_WAIT_V(6); PG8_BAR; PG8_MMA(1, 1, At, B1); PG8_BAR;
            PG8_LDB(B0, 1, 0); PG8_SCHED; PG8_LDA(At, 1, 0); PG8_STAGE(PG8_SA(0, 1), a2 + hstep, voffA);
            PG8_WAIT_L(8); PG8_BAR; PG8_WAIT_L(0); PG8_MMA(0, 0, At, B0); PG8_BAR; PG8_SCHED;
            PG8_LDB(B1, 1, 1); PG8_STAGE(PG8_SB(1, 0), b3, voffB);
            PG8_BAR; PG8_WAIT_L(0); PG8_MMA(0, 1, At, B1); PG8_BAR;
            PG8_LDA(At, 1, 1); PG8_STAGE(PG8_SA(1, 0), a3, voffA);
            PG8_BAR; PG8_WAIT_L(0); PG8_MMA(1, 0, At, B0); PG8_BAR; PG8_SCHED;
            PG8_STAGE(PG8_SB(1, 1), b3 + hstep, voffB);
            PG8_WAIT_V(6); PG8_BAR; PG8_MMA(1, 1, At, B1); PG8_BAR;
            }
        }
        if constexpr (ALIGN_EPI) { if (wr == 0) PG8_BAR; }
        if constexpr (!Epi::AFTER_DRAIN) { E(acc, cur, wr, wc, fr, fq); S.done(cur); }
        if (!has_next) break;
#pragma unroll
        for (int a = 0; a < 2; ++a)
#pragma unroll
            for (int b = 0; b < 2; ++b)
#pragma unroll
                for (int m = 0; m < 4; ++m)
#pragma unroll
                    for (int n = 0; n < 2; ++n) acc[a][b][m][n] = (f32x4){0.f, 0.f, 0.f, 0.f};
        cur = nxt; cA = nA; cB = nB; ++ui;
        if constexpr (ALIGN_EPI) { if (wr == 1) PG8_BAR; }
    }
    PG8_WAIT_V(0);
    if constexpr (!ALIGN_EPI) { if (wr == 0) PG8_BAR; }
    PG8_BAR;
    if constexpr (Epi::AFTER_DRAIN) { E.fused(acc, cur, wr, wc, fr, fq, lds, wid, lane); S.done(cur); }
#undef PG8_SA
#undef PG8_SB
#undef PG8_STAGE
#undef PG8_LDA
#undef PG8_LDB
#undef PG8_MMA
#undef PG8_WAIT_V
#undef PG8_WAIT_L
#undef PG8_BAR
#undef PG8_SCHED
}
}
#define GAS __attribute__((address_space(1)))
#define LAS __attribute__((address_space(3)))
#define XB_TMO      128
#define XB_XCNT(j)  (256  + 64 * (j))
#define XB_XSUB(j)  (1280 + 64 * (j))
#define XB_XGEN(j)  (2304 + 64 * (j))
#define XB_TOP      3328
#define XB_TOPGEN   3392
#define XCD_BAR_WORDS 3456
#define XB_SPIN_CAP (1u << 18)

__device__ __forceinline__ unsigned xb_ld(unsigned* p)              { return __hip_atomic_load(p, __ATOMIC_RELAXED, __HIP_MEMORY_SCOPE_AGENT); }
__device__ __forceinline__ unsigned xb_add(unsigned* p, unsigned v) { return __hip_atomic_fetch_add(p, v, __ATOMIC_RELAXED, __HIP_MEMORY_SCOPE_AGENT); }
__device__ __forceinline__ unsigned xb_xcc_id() { return (unsigned)__builtin_amdgcn_s_getreg((3 << 11) | 20) & 0xFu; }
#define XB_SPIN(cond, bar) do { unsigned _sp = 0; while (cond) { __builtin_amdgcn_s_sleep(1); \
    if ((++_sp & 255u) == 0u) { if (xb_ld(&(bar)[XB_TMO])) break; if (_sp > XB_SPIN_CAP) { atomicAdd(&(bar)[XB_TMO], 1u); break; } } } } while (0)

struct XcdBarrier {
    unsigned* bar; unsigned x; int w;
    volatile LAS unsigned* st;
};

__device__ __forceinline__ XcdBarrier xcd_barrier_post(unsigned* bar, volatile LAS unsigned* st, int wave_s) {
    XcdBarrier b; b.bar = bar; b.x = xb_xcc_id(); b.st = st; b.w = wave_s;
    if (tid_from(wave_s) == 0) (void)xb_add(&bar[XB_XCNT(b.x)], 1u);
    return b;
}
__device__ __forceinline__ void xcd_barrier_complete(unsigned* bar, unsigned x, unsigned& nloc, unsigned& nx) {
    const unsigned G = gridDim.x * gridDim.y * gridDim.z;
    unsigned sum, cnt, mine, sp = 0u;
    for (;;) {
        sum = 0u; cnt = 0u; mine = 0u;
#pragma unroll
        for (unsigned j = 0; j < 16; ++j) { const unsigned c = xb_ld(&bar[XB_XCNT(j)]); sum += c; cnt += (c > 0u) ? 1u : 0u; mine = (j == x) ? c : mine; }
        if (sum == G) break;
        __builtin_amdgcn_s_sleep(1);
        if ((++sp & 255u) == 0u) { if (xb_ld(&bar[XB_TMO])) break; if (sp > XB_SPIN_CAP) { atomicAdd(&bar[XB_TMO], 1u); break; } }
    }
    nloc = mine > 0u ? mine : 1u; nx = cnt > 0u ? cnt : 1u;
}

__device__ __forceinline__ void xcd_barrier(const XcdBarrier& b) {
    asm volatile("s_waitcnt vmcnt(0)" ::: "memory");
    __syncthreads();
    if (tid_from(b.w) == 0) {
        unsigned* bar = b.bar;
        __builtin_amdgcn_s_waitcnt(0);
        unsigned nloc = b.st[0], nx = b.st[1];
        if (nloc == 0u) { xcd_barrier_complete(bar, b.x, nloc, nx); b.st[0] = nloc; b.st[1] = nx; }
        const unsigned old = xb_add(&bar[XB_XSUB(b.x)], 1u);
        const unsigned gen = old / nloc;
        if (old + 1u == (gen + 1u) * nloc) {
            __builtin_amdgcn_fence(__ATOMIC_RELEASE, "agent");
            asm volatile("s_waitcnt vmcnt(0)" ::: "memory");
            const unsigned og = xb_add(&bar[XB_TOP], 1u);
            const unsigned tg = og / nx;
            if (og + 1u == (tg + 1u) * nx) xb_add(&bar[XB_TOPGEN], 1u);
            else XB_SPIN(xb_ld(&bar[XB_TOPGEN]) == tg, bar);
            __builtin_amdgcn_fence(__ATOMIC_ACQUIRE, "agent");
            xb_add(&bar[XB_XGEN(b.x)], 1u);
            asm volatile("s_waitcnt vmcnt(0)" ::: "memory");
        } else {
            XB_SPIN(xb_ld(&bar[XB_XGEN(b.x)]) == gen, bar);
            __builtin_amdgcn_fence(__ATOMIC_ACQUIRE, "agent");
            asm volatile("s_waitcnt vmcnt(0)" ::: "memory");
        }
    }
    __syncthreads();
}

constexpr int NWAVES = 8, NTHR = 512;
constexpr int DM = 2048, NB = 2, SEQ = 4096, NT = NB * SEQ, DEPTH = 4;
constexpr int INW = 5392, INWP = 5632;
constexpr int C_POOL = 0, C_GQ = 512, C_GK = 896, C_GV = 1280, C_GG = 2048, C_GA = 2816, C_RW = 2832;
constexpr int RW_IN = 2560, RW_W = 768, RW_H = 12;
constexpr int GLA_H = 4, GLA_DK = 96, GLA_DV = 192, GLA_NCH = 64;
constexpr int PEER_N = 16384;
constexpr float NORM_EPS = 1e-6f;
constexpr int MODW = 6 * DM;

constexpr size_t MiB = 1u << 20;
constexpr size_t WS_CTL = 0, CTL_ZERO_BYTES = 1 * MiB;
constexpr size_t WS_MOD = 1 * MiB;
constexpr size_t WS_WIN = 2 * MiB;
constexpr size_t WS_WOUT = 90 * MiB;
constexpr size_t WS_WQK = 122 * MiB;
constexpr size_t WS_U = 154 * MiB;
constexpr size_t WS_V = 410 * MiB;
constexpr size_t WS_US = 540 * MiB;
constexpr size_t WS_VS = 541 * MiB;
constexpr size_t WS_POOLT = 545 * MiB;
constexpr size_t WS_LORAT = 542 * MiB;
constexpr size_t WS_X = 666 * MiB;
constexpr size_t WS_H = 730 * MiB;
constexpr size_t WS_Y = 762 * MiB;
constexpr size_t WS_PROJ = 794 * MiB;
constexpr size_t WS_GKV = 970 * MiB;
constexpr size_t WS_GS = 1006 * MiB;
constexpr size_t WS_GDEC = 1042 * MiB;
constexpr size_t WS_RSC = 1043 * MiB;
constexpr size_t WS_RO = 1187 * MiB;
constexpr size_t WS_RGATE = 1211 * MiB;
constexpr size_t WS_RBV = 1235 * MiB;
constexpr size_t WS_EIDX = 1259 * MiB;
constexpr size_t WS_EGATE = 1263 * MiB;
constexpr size_t WS_END = 1267 * MiB;
constexpr size_t WS_DUMMY = 1267 * MiB;
#ifndef PROBE
#define PROBE 0
#endif
constexpr int CW_BAR = 4096;
constexpr size_t WS_SSP = 547 * MiB;
constexpr size_t WS_BIAS3 = 546 * MiB;

constexpr int LDS_BYTES = 147456;
constexpr int MISC_OFF = 147456 - 256;

typedef unsigned short bf16;
typedef unsigned v4u __attribute__((ext_vector_type(4)));
typedef unsigned v2u __attribute__((ext_vector_type(2)));
typedef float f32x4 __attribute__((ext_vector_type(4)));
typedef float f32x2 __attribute__((ext_vector_type(2)));
typedef __bf16 bf16x2_t __attribute__((ext_vector_type(2)));
typedef int v4i __attribute__((ext_vector_type(4)));

__device__ __forceinline__ unsigned pk2(float lo, float hi) { const f32x2 f = {lo, hi}; return __builtin_bit_cast(unsigned, __builtin_convertvector(f, bf16x2_t)); }
__device__ __forceinline__ unsigned f2bf(float f) { return pk2(f, f) & 0xffffu; }
__device__ __forceinline__ float bflo(unsigned u) { return __builtin_bit_cast(float, u << 16); }
__device__ __forceinline__ float bfhi(unsigned u) { return __builtin_bit_cast(float, u & 0xffff0000u); }
__device__ __forceinline__ float dpp_xor1(float v) { return __builtin_bit_cast(float, __builtin_amdgcn_update_dpp(0, __builtin_bit_cast(int, v), 0xB1, 0xF, 0xF, true)); }
__device__ __forceinline__ float dpp_xor2(float v) { return __builtin_bit_cast(float, __builtin_amdgcn_update_dpp(0, __builtin_bit_cast(int, v), 0x4E, 0xF, 0xF, true)); }
__device__ __forceinline__ float dpp_hmir(float v) { return __builtin_bit_cast(float, __builtin_amdgcn_update_dpp(0, __builtin_bit_cast(int, v), 0x141, 0xF, 0xF, true)); }
__device__ __forceinline__ float dpp_rmir(float v) { return __builtin_bit_cast(float, __builtin_amdgcn_update_dpp(0, __builtin_bit_cast(int, v), 0x140, 0xF, 0xF, true)); }
__device__ __forceinline__ float rl_f(float v, int l) { return __builtin_bit_cast(float, __builtin_amdgcn_readlane(__builtin_bit_cast(int, v), l)); }
__device__ __forceinline__ float row16_sum(float v) { v += dpp_xor1(v); v += dpp_xor2(v); v += dpp_hmir(v); v += dpp_rmir(v); return v; }
__device__ __forceinline__ float row16_max(float v) { v = fmaxf(v, dpp_xor1(v)); v = fmaxf(v, dpp_xor2(v)); v = fmaxf(v, dpp_hmir(v)); v = fmaxf(v, dpp_rmir(v)); return v; }
__device__ __forceinline__ float wave_sum(float v) { v = row16_sum(v); return (rl_f(v, 0) + rl_f(v, 16)) + (rl_f(v, 32) + rl_f(v, 48)); }
__device__ __forceinline__ float wave_max(float v) { v = row16_max(v); return fmaxf(fmaxf(rl_f(v, 0), rl_f(v, 16)), fmaxf(rl_f(v, 32), rl_f(v, 48))); }
__device__ __forceinline__ float half32_sum(float v, int lane) { v = row16_sum(v); const float lo = rl_f(v, 0) + rl_f(v, 16), hi = rl_f(v, 32) + rl_f(v, 48); return lane < 32 ? lo : hi; }
__device__ __forceinline__ float red8(float v) { v += dpp_xor1(v); v += dpp_xor2(v); v += dpp_hmir(v); return v; }
__device__ __forceinline__ float sigmoidf_(float x) { return __builtin_amdgcn_rcpf(1.f + __builtin_amdgcn_exp2f(-1.4426950408889634f * x)); }
__device__ __forceinline__ float softplusf_(float x) { return fmaxf(x, 0.f) + 0.6931471805599453f * __builtin_amdgcn_logf(1.f + __builtin_amdgcn_exp2f(-1.4426950408889634f * fabsf(x))); }

struct Args { const float* in[30]; float* out; unsigned char* ws; };
typedef const __attribute__((address_space(4))) Args* ArgsP;
__device__ __forceinline__ ArgsP args_ptr() { ArgsP p = (ArgsP)__builtin_amdgcn_kernarg_segment_ptr(); asm volatile("" : "+s"(p)); return p; }
__device__ __forceinline__ int opaque_i(int v) { asm volatile("" : "+s"(v)); return v; }

struct Frame {
    LAS unsigned char* lds;
    int tid, lane, wave, G, bid, gw, ngw;
};
__device__ __forceinline__ Frame make_frame(LAS unsigned char* lds, int wave_s) {
    asm volatile("" : "+s"(wave_s)); Frame F; F.lds = lds; int t = tid_from(wave_s); asm volatile("" : "+v"(t));
    F.tid = t; F.lane = t & 63; F.wave = __builtin_amdgcn_readfirstlane(t >> 6); int g_ = gridDim.x, b_ = blockIdx.x; asm volatile("" : "+s"(g_), "+s"(b_)); F.G = g_; F.bid = b_; F.gw = F.bid * NWAVES + F.wave; F.ngw = F.G * NWAVES; return F;
}

struct EpiStoreF32 {
    static constexpr bool PERM = false, AFTER_DRAIN = false;
    float* C; int ldc; int ws_;
    __device__ __forceinline__ void operator()(const pg8::f32x4 (&acc)[2][2][4][2], const pg8::Unit& u, int, int, int, int) const {
        int tz = tid_from(ws_); asm volatile("" : "+v"(tz)); const int wid = tz >> 6, lane = tz & 63, wr = wid >> 2, wc = wid & 3, fr = lane & 15, fq = lane >> 4;
        const int row0 = u.pm * 256 + wr * 64 + fr, col0 = u.pn * 256 + wc * 32 + 4 * fq;
#pragma unroll
        for (int ai = 0; ai < 2; ++ai)
#pragma unroll
            for (int m = 0; m < 4; ++m) { float* rowp = C + (size_t)(row0 + ai * 128 + m * 16) * ldc + col0;
#pragma unroll
                for (int bj = 0; bj < 2; ++bj)
#pragma unroll
                    for (int n = 0; n < 2; ++n) *(pg8::f32x4*)(rowp + bj * 128 + n * 16) = acc[ai][bj][m][n]; }
    }
};
struct EpiResid {
    static constexpr bool PERM = false, AFTER_DRAIN = false;
    const float* xsrc; float* xdst; const float* gate; int ws_; const float* gain2; const float* sc2; bf16* hdst; float* ss;
    __device__ __forceinline__ void operator()(const pg8::f32x4 (&acc)[2][2][4][2], const pg8::Unit& u, int, int, int, int) const {
        int tz = tid_from(ws_); asm volatile("" : "+v"(tz)); const int wid = tz >> 6, lane = tz & 63, wr = wid >> 2, wc = wid & 3, fr = lane & 15, fq = lane >> 4;
        const int row0 = u.pm * 256 + wr * 64 + fr, col0 = u.pn * 256 + wc * 32 + 4 * fq;
        const float* gp = gate + (size_t)(u.pm >> 4) * MODW + col0; const float* sp = sc2 + (size_t)(u.pm >> 4) * MODW + col0;
        pg8::f32x4 gv[2][2], hv[2][2];
#pragma unroll
        for (int bj = 0; bj < 2; ++bj)
#pragma unroll
            for (int n = 0; n < 2; ++n) { gv[bj][n] = *(const pg8::f32x4*)(gp + bj * 128 + n * 16);
                hv[bj][n] = *(const pg8::f32x4*)(gain2 + col0 + bj * 128 + n * 16) * (*(const pg8::f32x4*)(sp + bj * 128 + n * 16) + 1.f); }
#pragma unroll
        for (int ai = 0; ai < 2; ++ai)
#pragma unroll
            for (int m = 0; m < 4; ++m) { const int row = row0 + ai * 128 + m * 16; const size_t ro = (size_t)row * DM + col0; float s = 0.f;
#pragma unroll
                for (int bj = 0; bj < 2; ++bj)
#pragma unroll
                    for (int n = 0; n < 2; ++n) { const pg8::f32x4 xv = *(const pg8::f32x4*)(xsrc + ro + bj * 128 + n * 16);
                        const pg8::f32x4 y = xv + gv[bj][n] * acc[ai][bj][m][n];
                        *(pg8::f32x4*)(xdst + ro + bj * 128 + n * 16) = y;
                        s += (y.x * y.x + y.y * y.y) + (y.z * y.z + y.w * y.w);
                        const pg8::f32x4 hh = y * hv[bj][n]; v2u pk; pk.x = pk2(hh.x, hh.y); pk.y = pk2(hh.z, hh.w); *(v2u*)(hdst + ro + bj * 128 + n * 16) = pk; }
                s += __builtin_bit_cast(float, __builtin_amdgcn_ds_bpermute((lane ^ 16) << 2, __builtin_bit_cast(int, s)));
                s += __builtin_bit_cast(float, __builtin_amdgcn_ds_bpermute((lane ^ 32) << 2, __builtin_bit_cast(int, s)));
                if (fq == 0) ss[(size_t)row * 32 + u.pn * 4 + wc] = s; }
    }
};
struct EpiScore {
    static constexpr bool PERM = false, AFTER_DRAIN = false;
    float* C; int ldc; int ws_; const LAS float* rs; const float* bias;
    __device__ __forceinline__ void operator()(const pg8::f32x4 (&acc)[2][2][4][2], const pg8::Unit& u, int, int, int, int) const {
        int tz = tid_from(ws_); asm volatile("" : "+v"(tz)); const int wid = tz >> 6, lane = tz & 63, wr = wid >> 2, wc = wid & 3, fr = lane & 15, fq = lane >> 4;
        const int row0 = u.pm * 256 + wr * 64 + fr, col0 = u.pn * 256 + wc * 32 + 4 * fq;
        const float* bp = bias + (size_t)(u.pm >> 4) * DM + col0;
        pg8::f32x4 bv[2][2];
#pragma unroll
        for (int bj = 0; bj < 2; ++bj)
#pragma unroll
            for (int n = 0; n < 2; ++n) bv[bj][n] = *(const pg8::f32x4*)(bp + bj * 128 + n * 16);
#pragma unroll
        for (int ai = 0; ai < 2; ++ai)
#pragma unroll
            for (int m = 0; m < 4; ++m) { const int row = row0 + ai * 128 + m * 16; float* rowp = C + (size_t)row * ldc + col0;
                const float rstd = rs[row & 255];
#pragma unroll
                for (int bj = 0; bj < 2; ++bj)
#pragma unroll
                    for (int n = 0; n < 2; ++n) *(pg8::f32x4*)(rowp + bj * 128 + n * 16) = acc[ai][bj][m][n] * rstd + bv[bj][n]; }
    }
};

__device__ __forceinline__ void quant_tables(ArgsP A, int l, int wvi, int nw, int lane) {
    for (int rr = wvi; rr < 2 * PEER_N; rr += nw) {
        const int tb = rr >= PEER_N, r = l * PEER_N + (rr - tb * PEER_N);
        const f32x4* src = (const f32x4*)(A->in[27 + tb] + (size_t)r * DM) + lane;
        f32x4 v[8]; float mx = 0.f;
        float ssq = 0.f;
#pragma unroll
        for (int j = 0; j < 8; ++j) { v[j] = src[64 * j]; mx = fmaxf(mx, fmaxf(fmaxf(fabsf(v[j].x), fabsf(v[j].y)), fmaxf(fabsf(v[j].z), fabsf(v[j].w)))); ssq += (v[j].x * v[j].x + v[j].y * v[j].y) + (v[j].z * v[j].z + v[j].w * v[j].w); }
        mx = wave_max(mx);
        mx = fminf(mx, (tb ? 3.0f : 2.5f) * sqrtf(wave_sum(ssq) * (1.f / DM)));
        unsigned* dst = (unsigned*)(A->ws + (tb ? WS_V : WS_U)) + (size_t)r * (DM / 4) + lane;
        if (!tb) { const float inv = mx > 0.f ? 7.f / mx : 0.f;
            unsigned* dst4 = (unsigned*)(A->ws + WS_U) + (size_t)r * (DM / 8) + lane;
#pragma unroll
            for (int j = 0; j < 4; ++j) { unsigned wd = 0u;
                const float lo4[4] = {v[j].x, v[j].y, v[j].z, v[j].w}, hi4[4] = {v[j + 4].x, v[j + 4].y, v[j + 4].z, v[j + 4].w};
#pragma unroll
                for (int i = 0; i < 4; ++i) { const unsigned nl = (unsigned)((int)rintf(fminf(fmaxf(lo4[i] * inv, -7.f), 7.f)) + 8), nh = (unsigned)((int)rintf(fminf(fmaxf(hi4[i] * inv, -7.f), 7.f)) + 8); wd |= (nl | (nh << 4)) << (8 * i); }
                dst4[64 * j] = wd; }
            if (lane == 0) ((float*)(A->ws + WS_US))[r] = mx * (1.f / 7.f);
        } else { const float inv = mx > 0.f ? 6.f / mx : 0.f;
            unsigned short* dstv = (unsigned short*)(A->ws + WS_V) + (size_t)r * (DM / 4) + (lane & 31) * 8;
#pragma unroll
            for (int j = 0; j < 8; ++j) { const f32x4 c4 = __builtin_elementwise_min(__builtin_elementwise_max(v[j] * inv, (f32x4){-6.f, -6.f, -6.f, -6.f}), (f32x4){6.f, 6.f, 6.f, 6.f});
                int p = __builtin_amdgcn_cvt_scalef32_pk_fp4_f32(0, c4.x, c4.y, 1.0f, 0); p = __builtin_amdgcn_cvt_scalef32_pk_fp4_f32(p, c4.z, c4.w, 1.0f, 1);
                dstv[(j >> 2) * 256 + (((j & 3) << 1) | (lane >> 5))] = (unsigned short)p; }
            if (lane == 0) ((float*)(A->ws + WS_VS))[r] = mx * (1.f / 6.f);
        }
    }
}

__device__ __forceinline__ void transpose_item(const float* W, int K, int N, bf16* WT, LAS float* scr, int kb, int nb, int lane) {
    const int k0 = 64 * kb, n0 = 64 * nb, nl = (lane & 15) * 4, kr = lane >> 4;
    f32x4 v[16];
#pragma unroll
    for (int it = 0; it < 16; ++it) v[it] = (n0 + nl < N) ? *(const f32x4*)(W + (size_t)(k0 + it * 4 + kr) * N + n0 + nl) : (f32x4){0.f, 0.f, 0.f, 0.f};
#pragma unroll
    for (int it = 0; it < 16; ++it) { LAS float* s = scr + (it * 4 + kr) * 65 + nl; s[0] = v[it].x; s[1] = v[it].y; s[2] = v[it].z; s[3] = v[it].w; }
    asm volatile("s_waitcnt lgkmcnt(0)" ::: "memory");
    const int c = lane & 7;
#pragma unroll
    for (int j = 0; j < 8; ++j) { const int n = (lane >> 3) + 8 * j; const LAS float* s = scr + (8 * c) * 65 + n;
        v4u o; o.x = pk2(s[0 * 65], s[1 * 65]); o.y = pk2(s[2 * 65], s[3 * 65]); o.z = pk2(s[4 * 65], s[5 * 65]); o.w = pk2(s[6 * 65], s[7 * 65]);
        if (n0 + n < N) *(v4u*)(WT + (size_t)(n0 + n) * K + k0 + 8 * c) = o; }
    asm volatile("s_waitcnt lgkmcnt(0)" ::: "memory");
}

__device__ __forceinline__ void ph_prologue(ArgsP A, LAS unsigned char* lds_, int wv_) {
    const Frame F = make_frame(lds_, wv_);
    LAS float* ldsf = (LAS float*)F.lds;
    const int tid = F.tid, lane = F.lane, wave = F.wave;
    for (int i = tid; i < NB * DM; i += NTHR) { const float c = A->in[1][i]; ldsf[i] = c / (1.f + __expf(-c)); }
    __syncthreads();
    {
        LAS float* red = ldsf + 4096;
        float* MOD = (float*)(A->ws + WS_MOD);
        for (int u = F.bid; u < DEPTH * 96; u += F.G) {
            const int l = u / 96, j0 = (u % 96) * 128;
            const float* W = A->in[2] + (size_t)l * DM * MODW + j0 + lane * 2;
            float a00 = 0.f, a01 = 0.f, a10 = 0.f, a11 = 0.f;
            const int k0 = wave * 256;
#pragma unroll 8
            for (int k = k0; k < k0 + 256; ++k) { const f32x2 w = *(const f32x2*)(W + (size_t)k * MODW); const float c0 = ldsf[k], c1 = ldsf[DM + k];
                a00 += c0 * w.x; a01 += c0 * w.y; a10 += c1 * w.x; a11 += c1 * w.y; }
            red[(wave * 2 + 0) * 128 + lane * 2] = a00; red[(wave * 2 + 0) * 128 + lane * 2 + 1] = a01;
            red[(wave * 2 + 1) * 128 + lane * 2] = a10; red[(wave * 2 + 1) * 128 + lane * 2 + 1] = a11;
            __syncthreads();
            if (tid < 256) { const int b = tid >> 7, j = tid & 127; float s = 0.f;
#pragma unroll
                for (int w = 0; w < 8; ++w) s += red[(w * 2 + b) * 128 + j];
                s += A->in[3][(size_t)l * MODW + j0 + j];
                MOD[(size_t)(l * 2 + b) * MODW + j0 + j] = s; }
            __syncthreads();
        }
    }
    {
        LAS float* scr = ldsf + wave * 4160;
        constexpr int NBI = (INW + 63) / 64;
        constexpr int I_IN = 32 * NBI, I_OUT = 32 * 32, I_L = I_IN + I_OUT;
        for (int it = F.gw; it < DEPTH * I_L; it += F.ngw) {
            const int l = it / I_L; int r = it % I_L;
            if (r < I_IN) transpose_item(A->in[5] + (size_t)l * DM * INW, DM, INW, (bf16*)(A->ws + WS_WIN) + (size_t)l * INWP * DM, scr, r / NBI, r % NBI, lane);
            else { r -= I_IN; transpose_item(A->in[22] + (size_t)l * DM * DM, DM, DM, (bf16*)(A->ws + WS_WOUT) + (size_t)l * DM * DM, scr, r / 32, r % 32, lane); }
        }
        constexpr int PADV = (INWP - INW) * DM / 8;
        for (int i = F.bid * NTHR + tid; i < DEPTH * PADV; i += F.G * NTHR) { const int l = i / PADV, r = i % PADV;
            ((v4u*)((bf16*)(A->ws + WS_WIN) + (size_t)l * INWP * DM + (size_t)INW * DM))[r] = (v4u){0u, 0u, 0u, 0u}; }
    }
    __syncthreads();
    {
        LAS float* Ks = ldsf;
        LAS float* Ws = ldsf + 128 * 132;
        for (int u = F.bid; u < DEPTH * 16 * 32; u += F.G) {
            const int l = u >> 9, hh = (u >> 5) & 15, jt = u & 31, h = hh >> 1, half = hh & 1, j0 = jt * 64;
            const float* ksrc = (half ? A->in[26] : A->in[25]) + ((size_t)l * 8 + h) * 128 * 128;
            const float* wsrc = A->in[24] + (size_t)l * DM * DM + h * 256 + half * 128;
            {   f32x4 kq[8], wq4[4];
#pragma unroll
                for (int it = 0; it < 8; ++it) { const int i = tid + it * NTHR, n = i >> 5, d4 = (i & 31) * 4; kq[it] = *(const f32x4*)(ksrc + n * 128 + d4); }
#pragma unroll
                for (int it = 0; it < 4; ++it) { const int i = tid + it * NTHR, jj = i >> 5, d4 = (i & 31) * 4; wq4[it] = *(const f32x4*)(wsrc + (size_t)(j0 + jj) * DM + d4); }
#pragma unroll
                for (int it = 0; it < 8; ++it) { const int i = tid + it * NTHR, n = i >> 5, d4 = (i & 31) * 4; *(LAS f32x4*)(Ks + n * 132 + d4) = kq[it]; }
#pragma unroll
                for (int it = 0; it < 4; ++it) { const int i = tid + it * NTHR, jj = i >> 5, d4 = (i & 31) * 4; *(LAS f32x4*)(Ws + jj * 132 + d4) = wq4[it]; }
            }
            __syncthreads();
            { const int li = lane & 15, lq = lane >> 4;
                f32x4 acc[4] = {{0.f, 0.f, 0.f, 0.f}, {0.f, 0.f, 0.f, 0.f}, {0.f, 0.f, 0.f, 0.f}, {0.f, 0.f, 0.f, 0.f}};
#pragma unroll 4
                for (int ks = 0; ks < 32; ++ks) { const float a = Ks[(wave * 16 + li) * 132 + 4 * ks + lq];
#pragma unroll
                    for (int jt = 0; jt < 4; ++jt) acc[jt] = __builtin_amdgcn_mfma_f32_16x16x4f32(a, Ws[(jt * 16 + li) * 132 + 4 * ks + lq], acc[jt], 0, 0, 0); }
                bf16* dst = (bf16*)(A->ws + WS_WQK) + (size_t)l * DM * DM + (size_t)(h * 256 + half * 128 + wave * 16 + lq * 4) * DM + j0 + li;
#pragma unroll
                for (int jt = 0; jt < 4; ++jt) { dst[(size_t)0 * DM + jt * 16] = (bf16)f2bf(acc[jt].x); dst[(size_t)1 * DM + jt * 16] = (bf16)f2bf(acc[jt].y); dst[(size_t)2 * DM + jt * 16] = (bf16)f2bf(acc[jt].z); dst[(size_t)3 * DM + jt * 16] = (bf16)f2bf(acc[jt].w); } }
            __syncthreads();
        }
    }
    {
        bf16* PT = (bf16*)(A->ws + WS_POOLT);
        for (int i = F.bid * NTHR + tid; i < DEPTH * 4 * 128 * 128; i += F.G * NTHR) { const int lg = i >> 14, r = i & 16383, dcol = r >> 7, c = r & 127;
            PT[i] = (bf16)f2bf(A->in[6][(size_t)lg * 16384 + c * 128 + dcol]); }
    }
    {
        bf16* LT = (bf16*)(A->ws + WS_LORAT);
        for (int i = F.bid * NTHR + tid; i < DEPTH * RW_W * 256; i += F.G * NTHR) { const int l = i / (RW_W * 256), r = i % (RW_W * 256), c = r >> 8, j = r & 255;
            const float v = j < 64 ? A->in[13][((size_t)l * 64 + j) * RW_W + c] : (j < 128 ? A->in[15][((size_t)l * 64 + (j - 64)) * RW_W + c] : A->in[16][((size_t)l * 128 + (j - 128)) * RW_W + c]);
            LT[i] = (bf16)f2bf(v); }
    }
    quant_tables(A, 0, F.gw, F.ngw, lane);
}

__device__ __forceinline__ void ph_norm(const float* xsrc, const float* gain, const float* sh, const float* sc, bf16* hout, LAS unsigned char* lds_, int wv_) {
    const Frame F = make_frame(lds_, wv_);
    for (int m = F.gw; m < NT; m += F.ngw) {
        const int b = m >> 12;
        const f32x4* xr = (const f32x4*)(xsrc + (size_t)m * DM) + F.lane;
        f32x4 v[8]; float ss = 0.f;
#pragma unroll
        for (int j = 0; j < 8; ++j) { v[j] = xr[64 * j]; ss += (v[j].x * v[j].x + v[j].y * v[j].y) + (v[j].z * v[j].z + v[j].w * v[j].w); }
        const float rstd = rsqrtf(wave_sum(ss) * (1.f / DM) + NORM_EPS);
        v2u* o8 = (v2u*)(hout + (size_t)m * DM) + F.lane;
#pragma unroll
        for (int j = 0; j < 8; ++j) { const int col = j * 256 + F.lane * 4;
            const f32x4 g = *(const f32x4*)(gain + col), s1 = *(const f32x4*)(sc + (size_t)b * MODW + col), s0 = *(const f32x4*)(sh + (size_t)b * MODW + col);
            const f32x4 y = v[j] * rstd * g * (s1 + 1.f) + s0;
            v2u o; o.x = pk2(y.x, y.y); o.y = pk2(y.z, y.w); o8[64 * j] = o; }
    }
}
__device__ __forceinline__ void ph_final(const float* xsrc, const float* gain, float* out, LAS unsigned char* lds_, int wv_) {
    const Frame F = make_frame(lds_, wv_);
    for (int m = F.gw; m < NT; m += F.ngw) {
        const f32x4* xr = (const f32x4*)(xsrc + (size_t)m * DM) + F.lane;
        f32x4 v[8]; float ss = 0.f;
#pragma unroll
        for (int j = 0; j < 8; ++j) { v[j] = xr[64 * j]; ss += (v[j].x * v[j].x + v[j].y * v[j].y) + (v[j].z * v[j].z + v[j].w * v[j].w); }
        const float rstd = rsqrtf(wave_sum(ss) * (1.f / DM) + NORM_EPS);
        f32x4* o = (f32x4*)(out + (size_t)m * DM) + F.lane;
#pragma unroll
        for (int j = 0; j < 8; ++j) { const f32x4 g = *(const f32x4*)(gain + j * 256 + F.lane * 4); o[64 * j] = v[j] * rstd * g; }
    }
}

__device__ __forceinline__ void pool_unit(ArgsP A, const Frame& F_in, int l, int unit) {
    Frame F = F_in; asm volatile("" : "+v"(F.tid)); F.lane = F.tid & 63;
    const int tile = unit >> 2, g = unit & 3, t0 = tile * 32, s0 = t0 & (SEQ - 1), tid = F.tid, lane = F.lane, w = F.wave;
    const int win = 2 << g;
    const float* proj = (const float*)(A->ws + WS_PROJ);
    LAS float* ps = (LAS float*)F.lds;
    LAS unsigned short* ds = (LAS unsigned short*)(F.lds + 24064);
    const int rt = w >> 2, ct0 = (w & 3) * 2, li = lane & 15, lq = lane >> 4;
    typedef short b8 __attribute__((ext_vector_type(8)));
    b8 bw[2][4];
    { const unsigned short* PT = (const unsigned short*)(A->ws + WS_POOLT) + ((size_t)l * 4 + g) * 16384;
#pragma unroll
        for (int j = 0; j < 2; ++j)
#pragma unroll
            for (int ks = 0; ks < 4; ++ks) bw[j][ks] = *(const b8*)(PT + (size_t)((ct0 + j) * 16 + li) * 128 + ks * 32 + lq * 8); }
    {   f32x4 pq[3];
#pragma unroll
        for (int it = 0; it < 3; ++it) { const int i = tid + it * NTHR, r = i >> 5, c4 = i & 31; const int s = s0 - 15 + r;
            pq[it] = (i < 47 * 32 && s >= 0) ? *(const f32x4*)(proj + (size_t)(t0 - 15 + r) * INWP + C_POOL + g * 128 + c4 * 4) : (f32x4){0.f, 0.f, 0.f, 0.f}; }
#pragma unroll
        for (int it = 0; it < 3; ++it) { const int i = tid + it * NTHR; if (i < 47 * 32) *(LAS f32x4*)(ps + i * 4) = pq[it]; }
    }
    __syncthreads();
    for (int i = tid; i < 32 * 128; i += NTHR) { const int tok = i >> 7, c = i & 127; float sum = 0.f;
        for (int ww = 0; ww < win; ++ww) sum += ps[(tok + 15 - ww) * 128 + c];
        const int cnt = (s0 + tok + 1) < win ? (s0 + tok + 1) : win;
        ds[tok * 136 + c] = (unsigned short)f2bf(sum * __builtin_amdgcn_rcpf((float)cnt) - ps[(tok + 15) * 128 + c]); }
    __syncthreads();
    f32x4 acc[2] = {{0.f, 0.f, 0.f, 0.f}, {0.f, 0.f, 0.f, 0.f}};
#pragma unroll
    for (int ks = 0; ks < 4; ++ks) { const b8 a = *(const LAS b8*)(ds + (rt * 16 + li) * 136 + ks * 32 + lq * 8);
#pragma unroll
        for (int j = 0; j < 2; ++j) acc[j] = __builtin_amdgcn_mfma_f32_16x16x32_bf16(a, bw[j][ks], acc[j], 0, 0, 0); }
    bf16* Y = (bf16*)(A->ws + WS_Y);
#pragma unroll
    for (int j = 0; j < 2; ++j) { const int dcol = (ct0 + j) * 16 + li; const float scale = A->in[7][(size_t)l * 512 + g * 128 + dcol]; const int tk = t0 + rt * 16 + lq * 4;
        Y[(size_t)(tk + 0) * DM + g * 128 + dcol] = (bf16)f2bf(acc[j].x * scale); Y[(size_t)(tk + 1) * DM + g * 128 + dcol] = (bf16)f2bf(acc[j].y * scale);
        Y[(size_t)(tk + 2) * DM + g * 128 + dcol] = (bf16)f2bf(acc[j].z * scale); Y[(size_t)(tk + 3) * DM + g * 128 + dcol] = (bf16)f2bf(acc[j].w * scale); }
    __syncthreads();
}

__device__ __forceinline__ void gla_bcum(ArgsP A, const Frame& F, int l, int h, int t0, LAS float* bcum, LAS float* ad, LAS float* up) {
    const float* proj = (const float*)(A->ws + WS_PROJ);
    const int tid = F.tid;
    {
        const float a0 = proj[(size_t)(t0 + (tid >> 4)) * INWP + C_GA + (tid & 15)], a1 = proj[(size_t)(t0 + 32 + (tid >> 4)) * INWP + C_GA + (tid & 15)];
        const float* upg = A->in[8] + (size_t)l * 16 * 384 + h * 96;
        const float u0 = upg[(tid / 96) * 384 + tid % 96], u1 = upg[((tid + 512) / 96) * 384 + (tid + 512) % 96], u2 = upg[((tid + 1024) / 96) * 384 + (tid + 1024) % 96];
        ad[tid] = a0; ad[tid + 512] = a1; up[tid] = u0; up[tid + 512] = u1; up[tid + 1024] = u2;
    }
    __syncthreads();
    for (int i = tid; i < 64 * 96; i += NTHR) { const int tok = i / 96, d = i % 96; float x = A->in[9][(size_t)l * 384 + h * 96 + d];
#pragma unroll
        for (int j = 0; j < 16; ++j) x += ad[tok * 16 + j] * up[j * 96 + d];
        bcum[i] = -softplusf_(-x) * (1.f / 16.f); }
    __syncthreads();
    if (tid < 384) { const int d = tid % 96, seg = tid / 96; float acc = 0.f;
#pragma unroll
        for (int k = 0; k < 16; ++k) { acc += bcum[(seg * 16 + k) * 96 + d]; bcum[(seg * 16 + k) * 96 + d] = acc; }
        ad[seg * 96 + d] = acc; }
    __syncthreads();
    if (tid < 384) { const int d = tid % 96, seg = tid / 96; float pre = 0.f;
#pragma unroll
        for (int s2 = 0; s2 < 3; ++s2) pre += (s2 < seg) ? ad[s2 * 96 + d] : 0.f;
        if (seg > 0) {
#pragma unroll
            for (int k = 0; k < 16; ++k) bcum[(seg * 16 + k) * 96 + d] += pre; } }
    __syncthreads();
}

__device__ __forceinline__ void gla_scan_unit(ArgsP A, const Frame& F, int unit) {
    const int idx = unit * NTHR + F.tid, bh = idx / 18432, rem = idx % 18432, d = rem % 96;
    const float* KV = (const float*)(A->ws + WS_GKV) + (size_t)bh * 64 * 18432 + rem;
    float* GS = (float*)(A->ws + WS_GS) + (size_t)bh * 64 * 18432 + rem;
    const float* DEC = (const float*)(A->ws + WS_GDEC) + (size_t)bh * 64 * 96 + d;
    float S = 0.f;
#pragma unroll 1
    for (int c0 = 0; c0 < 64; c0 += 16) {
        float kv[16], dc[16];
#pragma unroll
        for (int j = 0; j < 16; ++j) { kv[j] = KV[(size_t)(c0 + j) * 18432]; dc[j] = DEC[(c0 + j) * 96]; }
#pragma unroll
        for (int j = 0; j < 16; ++j) { GS[(size_t)(c0 + j) * 18432] = S; S = dc[j] * S + kv[j]; }
    }
}

typedef short bf16x8_t __attribute__((ext_vector_type(8)));
constexpr int RS = 68;
__device__ __forceinline__ f32x4 tile_mm64(const LAS bf16* Am, int arow0, const LAS bf16* Bm, int brow0, f32x4 acc, int lane) {
    const int r = lane & 15, kq = (lane >> 4) * 8;
#pragma unroll
    for (int ks = 0; ks < 2; ++ks) {
        const bf16x8_t a = *(const LAS bf16x8_t*)(Am + (arow0 + r) * RS + ks * 32 + kq);
        const bf16x8_t b = *(const LAS bf16x8_t*)(Bm + (brow0 + r) * RS + ks * 32 + kq);
        acc = __builtin_amdgcn_mfma_f32_16x16x32_bf16(a, b, acc, 0, 0, 0);
    }
    return acc;
}
constexpr int RA_BT = 0, RA_KT = 8704, RA_AT = 17408, RA_RT = 26112, RA_RABS = 34816, RA_BHT = 43520, RA_KHT = 52224, RA_VT = 60928, RA_AABS = 69632,
              RA_MBAT = 86272, RA_MKA = 103680, RA_NBRT = 121088, RA_GC = 129792, RA_WT = 130048, RA_NKRT = 132096, RA_END = 140800, RA_PRE = 94976;
constexpr int RA_Z = RA_BT, RA_QST = RA_AT, RA_QOT = RA_RT, RA_LO = 0, RA_RES = 34816;
constexpr size_t RWO_POT = 0, RWO_PST = 12 * MiB, RWO_GT = 24 * MiB, RWO_OLT = 48 * MiB, RWO_SC = 72 * MiB;

__device__ __forceinline__ void rwkvA_unit(ArgsP A, const Frame& F_in, int l, int unit) {
    Frame F = F_in; asm volatile("" : "+v"(F.tid)); F.lane = F.tid & 63;

    const int bh = unit >> 6, c = unit & 63, b = bh / RW_H, h = bh % RW_H, t0 = b * SEQ + c * 64, s0 = c * 64, tid = F.tid, lane = F.lane, w = F.wave;
    const float* proj = (const float*)(A->ws + WS_PROJ);
    const float* mu = A->in[11] + (size_t)l * RW_IN;
    LAS unsigned char* L = F.lds;
    const int n = lane, cc = h * 64 + n;
    const int rt1 = w >> 1, ct1 = (w & 1) * 2, li1 = lane & 15, lq1 = lane >> 4;
    f32x4 yc[8], yp[8];
#pragma unroll
    for (int it = 0; it < 8; ++it) { const int g = tid + it * NTHR, tok = g >> 6, j4 = (g & 63) * 4; const float* rp = proj + ((size_t)t0 + tok) * INWP + C_RW + 2304 + j4;
        yc[it] = *(const f32x4*)rp; yp[it] = (s0 + tok > 0) ? *(const f32x4*)(rp - INWP) : (f32x4){0.f, 0.f, 0.f, 0.f}; }
    bf16x8_t bw[2][8];
    { const bf16* LT = (const bf16*)(A->ws + WS_LORAT) + ((size_t)l * RW_W + h * 64) * 256;
#pragma unroll
        for (int j = 0; j < 2; ++j)
#pragma unroll
            for (int ks = 0; ks < 8; ++ks) bw[j][ks] = *(const bf16x8_t*)(LT + (size_t)((ct1 + j) * 16 + li1) * 256 + ks * 32 + lq1 * 8); }
    float rr[9], kr[9], vr[9];
#pragma unroll
    for (int i = 0; i < 9; ++i) { const int tok = w * 8 + i - 1; const bool ok = (s0 + tok >= 0); const float* row = proj + ((size_t)t0 + tok) * INWP + C_RW;
        rr[i] = ok ? row[cc] : 0.f; kr[i] = ok ? row[768 + cc] : 0.f; vr[i] = ok ? row[1536 + cc] : 0.f; }
    const float w0c = A->in[12][(size_t)l * RW_W + cc], a0c = A->in[14][(size_t)l * RW_W + cc], kkc = A->in[17][(size_t)l * RW_W + cc], kac = A->in[18][(size_t)l * RW_W + cc], rkc = A->in[19][(size_t)l * RW_W + cc];
    const float mur = mu[cc], muk = mu[768 + cc], muv = mu[1536 + cc];
    {   LAS bf16* lo = (LAS bf16*)(L + RA_LO);
#pragma unroll
        for (int it = 0; it < 8; ++it) { const int g = tid + it * NTHR, tok = g >> 6, j4 = (g & 63) * 4; const f32x4 m4 = *(const f32x4*)(mu + 2304 + j4);
            const f32x4 ym = yc[it] + (yp[it] - yc[it]) * m4;
            const float sc = j4 < 64 ? 2.f : 1.f; f32x4 sg; sg.x = sigmoidf_(ym.x * sc); sg.y = sigmoidf_(ym.y * sc); sg.z = sigmoidf_(ym.z * sc); sg.w = sigmoidf_(ym.w * sc);
            const f32x4 o = j4 < 64 ? sg * 2.f - 1.f : (j4 < 128 ? ym : sg);
            v2u pk; pk.x = pk2(o.x, o.y); pk.y = pk2(o.z, o.w); *(LAS v2u*)(lo + tok * 264 + j4) = pk; }
    }
    __syncthreads();
    {
        const int rt = rt1, ct0 = ct1, li = li1, lq = lq1;
        const LAS bf16* lo = (const LAS bf16*)(L + RA_LO);
        LAS float* res = (LAS float*)(L + RA_RES);
        f32x4 acc[3][2];
#pragma unroll
        for (int p = 0; p < 3; ++p)
#pragma unroll
            for (int j = 0; j < 2; ++j) acc[p][j] = (f32x4){0.f, 0.f, 0.f, 0.f};
#pragma unroll
        for (int ks = 0; ks < 8; ++ks) { const bf16x8_t a = *(const LAS bf16x8_t*)(lo + (rt * 16 + li) * 264 + ks * 32 + lq * 8);
            const int p = ks < 2 ? 0 : (ks < 4 ? 1 : 2);
#pragma unroll
            for (int j = 0; j < 2; ++j) acc[p][j] = __builtin_amdgcn_mfma_f32_16x16x32_bf16(a, bw[j][ks], acc[p][j], 0, 0, 0); }
#pragma unroll
        for (int p = 0; p < 3; ++p)
#pragma unroll
            for (int j = 0; j < 2; ++j) { LAS float* rp = res + p * 64 * 68 + (rt * 16 + lq * 4) * 68 + (ct0 + j) * 16 + li;
                rp[0] = acc[p][j].x; rp[68] = acc[p][j].y; rp[136] = acc[p][j].z; rp[204] = acc[p][j].w; }
    }
    __syncthreads();
    float r_[8], k_[8], v_[8], av_[8], bb_[8], lw_[8];
    {
        const LAS float* res = (const LAS float*)(L + RA_RES);
        float wl[8], al[8], gl[8];
#pragma unroll
        for (int i = 0; i < 8; ++i) { wl[i] = res[(w * 8 + i) * 68 + n]; al[i] = res[64 * 68 + (w * 8 + i) * 68 + n]; gl[i] = res[2 * 64 * 68 + (w * 8 + i) * 68 + n]; }
        float* GATE = (float*)(A->ws + WS_RGATE); float* BV = (float*)(A->ws + WS_RBV);
#pragma unroll
        for (int i = 0; i < 8; ++i) { const int tok = w * 8 + i; const size_t t = (size_t)t0 + tok;
            float r = rr[i + 1], k = kr[i + 1], v = vr[i + 1];
            r += (rr[i] - r) * mur; k += (kr[i] - k) * muk; v += (vr[i] - v) * muv;
            const float wraw = -softplusf_(-(w0c + wl[i])) - 0.5f;
            const float a = sigmoidf_(a0c + al[i]);
            float kk = k * kkc; kk = kk * __builtin_amdgcn_rsqf(fmaxf(wave_sum(kk * kk), 1e-24f));
            const float k2 = k * (1.f + (a - 1.f) * kac);
            const float bonus = wave_sum(r * k2 * rkc);
            r_[i] = r; k_[i] = k2; v_[i] = v; av_[i] = -kk; bb_[i] = kk * a; lw_[i] = -__expf(wraw);
            GATE[t * RW_W + cc] = gl[i]; BV[t * RW_W + cc] = bonus * v; }
    }
    LAS float* wt = (LAS float*)(L + RA_WT);
#pragma unroll
    for (int i = 1; i < 8; ++i) lw_[i] += lw_[i - 1];
    wt[w * 64 + n] = lw_[7];
    __syncthreads();
    float pre = 0.f, mid = 0.f, last = 0.f;
#pragma unroll
    for (int ww = 0; ww < 8; ++ww) { const float x = wt[ww * 64 + n]; pre += (ww < w) ? x : 0.f; mid += (ww < 4) ? x : 0.f; last += x; }
    {
        LAS bf16* Bt = (LAS bf16*)(L + RA_BT); LAS bf16* Kt = (LAS bf16*)(L + RA_KT); LAS bf16* At = (LAS bf16*)(L + RA_AT); LAS bf16* Rt = (LAS bf16*)(L + RA_RT);
        LAS bf16* Rab = (LAS bf16*)(L + RA_RABS); LAS bf16* BhT = (LAS bf16*)(L + RA_BHT); LAS bf16* KhT = (LAS bf16*)(L + RA_KHT); LAS bf16* VT = (LAS bf16*)(L + RA_VT);
        LAS float* AabT = (LAS float*)(L + RA_AABS);
#pragma unroll
        for (int i = 0; i < 8; ++i) { const int t = w * 8 + i; const float lw = pre + lw_[i], lwm1 = pre + (i > 0 ? lw_[i - 1] : 0.f);
            const float eg = __expf(lw - mid), egi = __expf(mid - lw), egm1 = __expf(lwm1 - mid), eh = __expf(last - lw);
            Bt[t * RS + n] = (bf16)f2bf(bb_[i] * egi); Kt[t * RS + n] = (bf16)f2bf(k_[i] * egi); At[t * RS + n] = (bf16)f2bf(av_[i] * egm1); Rt[t * RS + n] = (bf16)f2bf(r_[i] * eg);
            Rab[t * RS + n] = (bf16)f2bf(r_[i] * __expf(lw)); AabT[n * 65 + t] = av_[i] * __expf(lwm1);
            BhT[n * RS + t] = (bf16)f2bf(bb_[i] * eh); KhT[n * RS + t] = (bf16)f2bf(k_[i] * eh); VT[n * RS + t] = (bf16)f2bf(v_[i]); }
        if (w == 0) ((LAS float*)(L + RA_GC))[n] = __expf(last);
    }
    __syncthreads();
    const int rt = w >> 1, ct0 = (w & 1) * 2, li = lane & 15, lq = lane >> 4;
#define FRAG(mat_, row_, ks_) (*(const LAS bf16x8_t*)((mat_) + ((row_) + li) * RS + (ks_) * 32 + lq * 8))
#define MM(a_, b_, c_) __builtin_amdgcn_mfma_f32_16x16x32_bf16(a_, b_, c_, 0, 0, 0)
    {
        const LAS bf16* Bt = (const LAS bf16*)(L + RA_BT); const LAS bf16* Kt = (const LAS bf16*)(L + RA_KT); const LAS bf16* At = (const LAS bf16*)(L + RA_AT); const LAS bf16* Rt = (const LAS bf16*)(L + RA_RT);
        LAS bf16* MbaT = (LAS bf16*)(L + RA_MBAT); LAS float* Mka = (LAS float*)(L + RA_MKA); LAS bf16* NbrT = (LAS bf16*)(L + RA_NBRT);
        bf16x8_t aB[2], aK[2], bA[2][2], bR[2][2];
#pragma unroll
        for (int ks = 0; ks < 2; ++ks) { aB[ks] = FRAG(Bt, rt * 16, ks); aK[ks] = FRAG(Kt, rt * 16, ks);
#pragma unroll
            for (int j = 0; j < 2; ++j) { bA[j][ks] = FRAG(At, (ct0 + j) * 16, ks); bR[j][ks] = FRAG(Rt, (ct0 + j) * 16, ks); } }
#pragma unroll
        for (int j = 0; j < 2; ++j) { const int ct = ct0 + j, tcol = ct * 16 + li, srow = rt * 16 + lq * 4;
            const f32x4 z = {0.f, 0.f, 0.f, 0.f};
            f32x4 mba = MM(aB[1], bA[j][1], MM(aB[0], bA[j][0], z)), nbr = MM(aB[1], bR[j][1], MM(aB[0], bR[j][0], z));
            f32x4 mka = MM(aK[1], bA[j][1], MM(aK[0], bA[j][0], z)), nk = MM(aK[1], bR[j][1], MM(aK[0], bR[j][0], z));
            mba.x = (srow + 0 < tcol) ? mba.x : 0.f; mba.y = (srow + 1 < tcol) ? mba.y : 0.f; mba.z = (srow + 2 < tcol) ? mba.z : 0.f; mba.w = (srow + 3 < tcol) ? mba.w : 0.f;
            mka.x = (srow + 0 < tcol) ? mka.x : 0.f; mka.y = (srow + 1 < tcol) ? mka.y : 0.f; mka.z = (srow + 2 < tcol) ? mka.z : 0.f; mka.w = (srow + 3 < tcol) ? mka.w : 0.f;
            nbr.x = (srow + 0 <= tcol) ? nbr.x : 0.f; nbr.y = (srow + 1 <= tcol) ? nbr.y : 0.f; nbr.z = (srow + 2 <= tcol) ? nbr.z : 0.f; nbr.w = (srow + 3 <= tcol) ? nbr.w : 0.f;
            nk.x = (srow + 0 <= tcol) ? nk.x : 0.f; nk.y = (srow + 1 <= tcol) ? nk.y : 0.f; nk.z = (srow + 2 <= tcol) ? nk.z : 0.f; nk.w = (srow + 3 <= tcol) ? nk.w : 0.f;
            { v2u pm; pm.x = pk2(mba.x, mba.y); pm.y = pk2(mba.z, mba.w); *(LAS v2u*)(MbaT + tcol * RS + srow) = pm; }
            Mka[(srow + 0) * RS + tcol] = mka.x; Mka[(srow + 1) * RS + tcol] = mka.y; Mka[(srow + 2) * RS + tcol] = mka.z; Mka[(srow + 3) * RS + tcol] = mka.w;
            v2u pk; pk.x = pk2(nbr.x, nbr.y); pk.y = pk2(nbr.z, nbr.w); *(LAS v2u*)(NbrT + tcol * RS + srow) = pk;
            { v2u pn; pn.x = pk2(nk.x, nk.y); pn.y = pk2(nk.z, nk.w); *(LAS v2u*)((LAS bf16*)(L + RA_NKRT) + tcol * RS + srow) = pn; } }
    }
    __syncthreads();
    {
        int t4 = tid; asm volatile("" : "+v"(t4)); const int row = t4 >> 2, q = t4 & 3, l4 = t4 & 63, li4 = l4 & 15, lq4 = l4 >> 4;
        const LAS bf16* MbaT = (const LAS bf16*)(L + RA_MBAT);
        const LAS float* Yrow = (row < 64) ? ((const LAS float*)(L + RA_AABS) + row * 65) : ((const LAS float*)(L + RA_MKA) + (row - 64) * RS);
        LAS bf16* Z = (LAS bf16*)(L + RA_Z); LAS float* pre = (LAS float*)(L + RA_PRE);
        for (int i = t4; i < 1088; i += NTHR) ((LAS v4u*)Z)[i] = (v4u){0u, 0u, 0u, 0u};
        __syncthreads();
#pragma unroll 1
        for (int jb = 0; jb < 4; ++jb) {
            if (jb > 0) {
                f32x4 acc = {0.f, 0.f, 0.f, 0.f};
#pragma unroll
                for (int ks = 0; ks < 2; ++ks) { const bf16x8_t a = *(const LAS bf16x8_t*)(Z + (w * 16 + li4) * RS + ks * 32 + lq4 * 8);
                    const bf16x8_t bm = *(const LAS bf16x8_t*)(MbaT + (jb * 16 + li4) * RS + ks * 32 + lq4 * 8);
                    acc = __builtin_amdgcn_mfma_f32_16x16x32_bf16(a, bm, acc, 0, 0, 0); }
                LAS float* pp = pre + (w * 16 + lq4 * 4) * 16 + li4;
                pp[0] = acc.x; pp[16] = acc.y; pp[32] = acc.z; pp[48] = acc.w;
                __syncthreads();
            }
            float yv[16]; v2u mv[16];
#pragma unroll
            for (int u = 0; u < 16; ++u) { yv[u] = Yrow[jb * 16 + u] + (jb > 0 ? pre[row * 16 + u] : 0.f); mv[u] = *(const LAS v2u*)(MbaT + (jb * 16 + u) * RS + jb * 16 + q * 4); }
            float zb[4] = {0.f, 0.f, 0.f, 0.f};
#pragma unroll
            for (int u = 0; u < 16; ++u) {
                float part = (zb[0] * bflo(mv[u].x) + zb[1] * bfhi(mv[u].x)) + (zb[2] * bflo(mv[u].y) + zb[3] * bfhi(mv[u].y));
                part += dpp_xor1(part); part += dpp_xor2(part);
                const float zt = yv[u] + part;
                zb[u & 3] = (q == (u >> 2)) ? zt : zb[u & 3];
            }
            { v2u pk; pk.x = pk2(zb[0], zb[1]); pk.y = pk2(zb[2], zb[3]); *(LAS v2u*)(Z + row * RS + jb * 16 + q * 4) = pk; }
            __syncthreads();
        }
    }
    {
        int t5 = tid; asm volatile("" : "+v"(t5)); const int li = t5 & 15, lq = (t5 >> 4) & 3;
        const LAS bf16* Z = (const LAS bf16*)(L + RA_Z); const LAS bf16* NbrT = (const LAS bf16*)(L + RA_NBRT); const LAS bf16* BhT = (const LAS bf16*)(L + RA_BHT);
        const LAS bf16* Rab = (const LAS bf16*)(L + RA_RABS); const LAS bf16* KhT = (const LAS bf16*)(L + RA_KHT); const LAS float* gC = (const LAS float*)(L + RA_GC);
        LAS bf16* QsT = (LAS bf16*)(L + RA_QST); LAS bf16* QoT = (LAS bf16*)(L + RA_QOT);
        bf16* PoT = (bf16*)(A->ws + WS_RSC + RWO_POT) + (size_t)unit * 4096; bf16* PsT = (bf16*)(A->ws + WS_RSC + RWO_PST) + (size_t)unit * 4096;
        bf16x8_t zW[2], zX[2], bN[2][2], bH[2][2]; v2u rb[2], kb[2], nb2[2]; float gc[2];
#pragma unroll
        for (int ks = 0; ks < 2; ++ks) { zW[ks] = FRAG(Z, rt * 16, ks); zX[ks] = FRAG(Z, 64 + rt * 16, ks);
#pragma unroll
            for (int j = 0; j < 2; ++j) { bN[j][ks] = FRAG(NbrT, (ct0 + j) * 16, ks); bH[j][ks] = FRAG(BhT, (ct0 + j) * 16, ks); } }
#pragma unroll
        for (int j = 0; j < 2; ++j) { const int col = (ct0 + j) * 16 + li, rw = rt * 16 + lq * 4; rb[j] = *(const LAS v2u*)(Rab + col * RS + rw); kb[j] = *(const LAS v2u*)(KhT + col * RS + rw); nb2[j] = *(const LAS v2u*)((const LAS bf16*)(L + RA_NKRT) + col * RS + rw); gc[j] = gC[col]; }
#pragma unroll
        for (int j = 0; j < 2; ++j) { const int col = (ct0 + j) * 16 + li, rw = rt * 16 + lq * 4;
            { f32x4 acc = {bflo(rb[j].x), bfhi(rb[j].x), bflo(rb[j].y), bfhi(rb[j].y)};
                acc = MM(zW[1], bN[j][1], MM(zW[0], bN[j][0], acc));
                v2u pk; pk.x = pk2(acc.x, acc.y); pk.y = pk2(acc.z, acc.w); *(v2u*)(PoT + (size_t)col * 64 + rw) = pk; }
            { f32x4 acc = {(rw + 0 == col) ? gc[j] : 0.f, (rw + 1 == col) ? gc[j] : 0.f, (rw + 2 == col) ? gc[j] : 0.f, (rw + 3 == col) ? gc[j] : 0.f};
                acc = MM(zW[1], bH[j][1], MM(zW[0], bH[j][0], acc));
                v2u pk; pk.x = pk2(acc.x, acc.y); pk.y = pk2(acc.z, acc.w); *(v2u*)(PsT + (size_t)col * 64 + rw) = pk; }
            { f32x4 acc = {bflo(nb2[j].x), bfhi(nb2[j].x), bflo(nb2[j].y), bfhi(nb2[j].y)};
                acc = MM(zX[1], bN[j][1], MM(zX[0], bN[j][0], acc));
                v2u pk; pk.x = pk2(acc.x, acc.y); pk.y = pk2(acc.z, acc.w); *(LAS v2u*)(QoT + col * RS + rw) = pk; }
            { f32x4 acc = {bflo(kb[j].x), bfhi(kb[j].x), bflo(kb[j].y), bfhi(kb[j].y)};
                acc = MM(zX[1], bH[j][1], MM(zX[0], bH[j][0], acc));
                v2u pk; pk.x = pk2(acc.x, acc.y); pk.y = pk2(acc.z, acc.w); *(LAS v2u*)(QsT + col * RS + rw) = pk; }
        }
    }
    __syncthreads();
    {
        int t6 = tid; asm volatile("" : "+v"(t6)); const int li = t6 & 15, lq = (t6 >> 4) & 3;
        const LAS bf16* VT = (const LAS bf16*)(L + RA_VT);
        const bool isO = (w & 1);
        const LAS bf16* Bm = (const LAS bf16*)(L + (isO ? RA_QOT : RA_QST));
        float* dst = (float*)(A->ws + WS_RSC + (isO ? RWO_OLT : RWO_GT)) + (size_t)unit * 4096;
        bf16x8_t av[2], bq[4][2];
#pragma unroll
        for (int ks = 0; ks < 2; ++ks) { av[ks] = FRAG(VT, rt * 16, ks);
#pragma unroll
            for (int j = 0; j < 4; ++j) bq[j][ks] = FRAG(Bm, j * 16, ks); }
#pragma unroll
        for (int j = 0; j < 4; ++j) { const f32x4 z = {0.f, 0.f, 0.f, 0.f};
            const f32x4 acc = MM(av[1], bq[j][1], MM(av[0], bq[j][0], z));
            *(f32x4*)(dst + (size_t)(j * 16 + li) * 64 + rt * 16 + lq * 4) = acc; }
    }
#undef FRAG
#undef MM
    __syncthreads();
}

__device__ __forceinline__ void rwkvB_scan(ArgsP A, const Frame& F, int unit) {
    const int bh = unit >> 2, rq = unit & 3;
    const int tid = F.tid, lane = F.lane, w = F.wave, ct = w & 3, li = lane & 15, lq = lane >> 4;
    const bool writer = (w < 4);
    const bf16* PsT = (const bf16*)(A->ws + WS_RSC + RWO_PST) + (size_t)bh * 64 * 4096; const float* GT = (const float*)(A->ws + WS_RSC + RWO_GT) + (size_t)bh * 64 * 4096;
    bf16* SC = (bf16*)(A->ws + WS_RSC + RWO_SC) + (size_t)bh * 64 * 4096;
    f32x4 S = {0.f, 0.f, 0.f, 0.f};
    constexpr int PF = 4;
    bf16x8_t pb[PF][2]; f32x4 gq[PF];
    const int col = ct * 16 + li;
#define SLOAD(slot, cc_) do { _Pragma("unroll") for (int ks = 0; ks < 2; ++ks) pb[slot][ks] = *(const bf16x8_t*)(PsT + (size_t)(cc_) * 4096 + (size_t)col * 64 + ks * 32 + lq * 8); \
        gq[slot] = *(const f32x4*)(GT + (size_t)(cc_) * 4096 + (size_t)col * 64 + rq * 16 + lq * 4); } while (0)
#define SSTEP(slot, cc_) do { LAS bf16* Sl = (LAS bf16*)(F.lds + ((cc_) & 1) * 2176); \
        if (writer) { const int rw_ = lq * 4; Sl[(rw_ + 0) * RS + col] = (bf16)f2bf(S.x); Sl[(rw_ + 1) * RS + col] = (bf16)f2bf(S.y); Sl[(rw_ + 2) * RS + col] = (bf16)f2bf(S.z); Sl[(rw_ + 3) * RS + col] = (bf16)f2bf(S.w); } \
        asm volatile("s_waitcnt lgkmcnt(0)" ::: "memory"); __builtin_amdgcn_s_barrier(); asm volatile("" ::: "memory");        \
        if (tid < 128) { const int v_ = tid >> 3, k8_ = (tid & 7) * 8; *(v4u*)(SC + (size_t)(cc_) * 4096 + (rq * 16 + v_) * 64 + k8_) = *(const LAS v4u*)(Sl + v_ * RS + k8_); } \
        f32x4 acc_ = gq[slot]; \
        _Pragma("unroll") for (int ks = 0; ks < 2; ++ks) { const bf16x8_t a_ = *(const LAS bf16x8_t*)(Sl + li * RS + ks * 32 + lq * 8); \
            acc_ = __builtin_amdgcn_mfma_f32_16x16x32_bf16(a_, pb[slot][ks], acc_, 0, 0, 0); } \
        S = acc_; } while (0)
    SLOAD(0, 0); SLOAD(1, 1); SLOAD(2, 2); SLOAD(3, 3);
#pragma unroll 1
    for (int c = 0; c < 64; c += 4) {
        const int cn = (c + 4 < 64) ? c + 4 : 60;
        SSTEP(0, c);     SLOAD(0, cn);
        SSTEP(1, c + 1); SLOAD(1, cn + 1);
        SSTEP(2, c + 2); SLOAD(2, cn + 2);
        SSTEP(3, c + 3); SLOAD(3, cn + 3);
    }
#undef SLOAD
#undef SSTEP
    __syncthreads();
}

__device__ __forceinline__ void rwkvC_unit(ArgsP A, const Frame& F_in, int l, int unit) {
    Frame F = F_in; asm volatile("" : "+v"(F.tid)); F.lane = F.tid & 63;

    const int bh = unit >> 6, c = unit & 63, b = bh / RW_H, h = bh % RW_H, t0 = b * SEQ + c * 64, tid = F.tid, lane = F.lane, w = F.wave;
    const int rt = w >> 1, ct0 = (w & 1) * 2, li = lane & 15, lq = lane >> 4;
    LAS bf16* Sl = (LAS bf16*)F.lds; LAS bf16* Pl = (LAS bf16*)(F.lds + 8704); LAS float* ob = (LAS float*)(F.lds + 17408);
    { const int r = tid >> 3, k8 = (tid & 7) * 8;
        *(LAS v4u*)(Sl + r * RS + k8) = *(const v4u*)((const bf16*)(A->ws + WS_RSC + RWO_SC) + (size_t)unit * 4096 + r * 64 + k8);
        *(LAS v4u*)(Pl + r * RS + k8) = *(const v4u*)((const bf16*)(A->ws + WS_RSC + RWO_POT) + (size_t)unit * 4096 + r * 64 + k8); }
    __syncthreads();
    const float* OlT = (const float*)(A->ws + WS_RSC + RWO_OLT) + (size_t)unit * 4096;
#pragma unroll
    for (int j = 0; j < 2; ++j) { const int tcol = (ct0 + j) * 16 + li, vr = rt * 16 + lq * 4;
        f32x4 acc = *(const f32x4*)(OlT + (size_t)tcol * 64 + vr);
        acc = tile_mm64(Sl, rt * 16, Pl, (ct0 + j) * 16, acc, lane);
        *(LAS f32x4*)(ob + tcol * 68 + vr) = acc; }
    __syncthreads();
    { const int t = tid >> 3, q = tid & 7; const size_t tg = (size_t)t0 + t;
        const f32x4 o0 = *(const LAS f32x4*)(ob + t * 68 + q * 8), o1 = *(const LAS f32x4*)(ob + t * 68 + q * 8 + 4);
        const float mean = red8((o0.x + o0.y) + (o0.z + o0.w) + (o1.x + o1.y) + (o1.z + o1.w)) * (1.f / 64.f);
        const f32x4 d0 = o0 - mean, d1 = o1 - mean;
        const float var = red8((d0.x * d0.x + d0.y * d0.y) + (d0.z * d0.z + d0.w * d0.w) + (d1.x * d1.x + d1.y * d1.y) + (d1.z * d1.z + d1.w * d1.w)) * (1.f / 64.f);
        const float rs = rsqrtf(var + 64e-5f);
        const int cc = h * 64 + q * 8;
        const f32x4 g0 = *(const f32x4*)(A->in[20] + (size_t)l * RW_W + cc), g1 = *(const f32x4*)(A->in[20] + (size_t)l * RW_W + cc + 4);
        const f32x4 b0 = *(const f32x4*)(A->in[21] + (size_t)l * RW_W + cc), b1 = *(const f32x4*)(A->in[21] + (size_t)l * RW_W + cc + 4);
        const f32x4 bv0 = *(const f32x4*)((const float*)(A->ws + WS_RBV) + tg * RW_W + cc), bv1 = *(const f32x4*)((const float*)(A->ws + WS_RBV) + tg * RW_W + cc + 4);
        const f32x4 ga0 = *(const f32x4*)((const float*)(A->ws + WS_RGATE) + tg * RW_W + cc), ga1 = *(const f32x4*)((const float*)(A->ws + WS_RGATE) + tg * RW_W + cc + 4);
        const f32x4 y0 = (d0 * rs * g0 + b0 + bv0) * ga0, y1 = (d1 * rs * g1 + b1 + bv1) * ga1;
        v4u o; o.x = pk2(y0.x, y0.y); o.y = pk2(y0.z, y0.w); o.z = pk2(y1.x, y1.y); o.w = pk2(y1.z, y1.w);
        *(v4u*)((bf16*)(A->ws + WS_Y) + tg * DM + 1280 + cc) = o; }
    __syncthreads();
}

constexpr size_t RWO_GQ = 84 * MiB, RWO_GK = 92 * MiB, RWO_GVT = 100 * MiB, RWO_GEM = 116 * MiB;
constexpr int GQS = 104, GTS = 72;
template <int NKS> __device__ __forceinline__ f32x4 tile_mm(const LAS bf16* Am, int sa, int arow0, const LAS bf16* Bm, int sb, int brow0, f32x4 acc, int lane) {
    const int r = lane & 15, kq = (lane >> 4) * 8;
#pragma unroll
    for (int ks = 0; ks < NKS; ++ks) {
        const bf16x8_t a = *(const LAS bf16x8_t*)(Am + (arow0 + r) * sa + ks * 32 + kq);
        const bf16x8_t b = *(const LAS bf16x8_t*)(Bm + (brow0 + r) * sb + ks * 32 + kq);
        acc = __builtin_amdgcn_mfma_f32_16x16x32_bf16(a, b, acc, 0, 0, 0);
    }
    return acc;
}

__device__ __forceinline__ int gsw(int row) { return ((row >> 2) ^ (row >> 5)) & 7; }
__device__ __forceinline__ f32x4 tile_mm_sw(const LAS bf16* Am, int arow0, const LAS bf16* Bm, int brow0, f32x4 acc, int lane) {
    const int r = lane & 15, cq = lane >> 4, fa = gsw(arow0 + r), fb = gsw(brow0 + r);
#pragma unroll
    for (int ks = 0; ks < 2; ++ks) {
        const bf16x8_t a = *(const LAS bf16x8_t*)(Am + (arow0 + r) * GTS + (((ks * 4 + cq) ^ fa) << 3));
        const bf16x8_t b = *(const LAS bf16x8_t*)(Bm + (brow0 + r) * GTS + (((ks * 4 + cq) ^ fb) << 3));
        acc = __builtin_amdgcn_mfma_f32_16x16x32_bf16(a, b, acc, 0, 0, 0);
    }
    return acc;
}
__device__ __forceinline__ void gla1_unit(ArgsP A, const Frame& F_in, int l, int unit) {
    Frame F = F_in; asm volatile("" : "+v"(F.tid)); F.lane = F.tid & 63;
    const int bh = unit >> 6, c = unit & 63, b = bh >> 2, h = bh & 3, t0 = b * SEQ + c * 64, tid = F.tid, lane = F.lane, w = F.wave;
    const float* proj = (const float*)(A->ws + WS_PROJ);
    LAS float* bcum = (LAS float*)F.lds;
    LAS float* ad = bcum + 6144;
    LAS float* up = ad + 1024;
    LAS bf16* KtT = (LAS bf16*)(F.lds + 34816);
    LAS bf16* VT = (LAS bf16*)(F.lds + 48640);
    f32x4 qq[3], kq[3], vq[6];
#pragma unroll
    for (int it = 0; it < 3; ++it) { const int i = tid + it * NTHR, tok = i / 24, d4 = i % 24; const float* rp = proj + (size_t)(t0 + tok) * INWP + h * 96 + d4 * 4;
        qq[it] = *(const f32x4*)(rp + C_GQ); kq[it] = *(const f32x4*)(rp + C_GK); }
#pragma unroll
    for (int it = 0; it < 6; ++it) { const int i = tid + it * NTHR, tok = i / 48, e4 = i % 48; vq[it] = *(const f32x4*)(proj + (size_t)(t0 + tok) * INWP + C_GV + h * 192 + e4 * 4); }
    gla_bcum(A, F, l, h, t0, bcum, ad, up);
    const float qs = 0.10206207261596575f;
    bf16* Qg = (bf16*)(A->ws + WS_RSC + RWO_GQ) + (size_t)unit * 6144; bf16* Kg = (bf16*)(A->ws + WS_RSC + RWO_GK) + (size_t)unit * 6144;
#pragma unroll
    for (int it = 0; it < 3; ++it) { const int i = tid + it * NTHR, tok = i / 24, d = (i % 24) * 4;
        const float qv[4] = {qq[it].x, qq[it].y, qq[it].z, qq[it].w}, kv[4] = {kq[it].x, kq[it].y, kq[it].z, kq[it].w}; float qo[4], ko[4];
#pragma unroll
        for (int e = 0; e < 4; ++e) { const float m = bcum[31 * 96 + d + e], bb = bcum[tok * 96 + d + e];
            qo[e] = qv[e] * qs * __expf(bb - m); ko[e] = kv[e] * __expf(m - bb); KtT[(d + e) * GTS + ((((tok >> 3) ^ gsw(d + e)) << 3) | (tok & 7))] = (bf16)f2bf(ko[e]); }
        v2u pq, pk; pq.x = pk2(qo[0], qo[1]); pq.y = pk2(qo[2], qo[3]); pk.x = pk2(ko[0], ko[1]); pk.y = pk2(ko[2], ko[3]);
        *(v2u*)(Qg + tok * 96 + d) = pq; *(v2u*)(Kg + tok * 96 + d) = pk; }
#pragma unroll
    for (int it = 0; it < 6; ++it) { const int i = tid + it * NTHR, tok = i / 48, e = (i % 48) * 4;
        const int ts = tok >> 3, tl = tok & 7;
        VT[(e + 0) * GTS + (((ts ^ gsw(e + 0)) << 3) | tl)] = (bf16)f2bf(vq[it].x); VT[(e + 1) * GTS + (((ts ^ gsw(e + 1)) << 3) | tl)] = (bf16)f2bf(vq[it].y);
        VT[(e + 2) * GTS + (((ts ^ gsw(e + 2)) << 3) | tl)] = (bf16)f2bf(vq[it].z); VT[(e + 3) * GTS + (((ts ^ gsw(e + 3)) << 3) | tl)] = (bf16)f2bf(vq[it].w); }
    if (tid < 96) { ((float*)(A->ws + WS_RSC + RWO_GEM))[(size_t)unit * 96 + tid] = __expf(bcum[31 * 96 + tid]);
        ((float*)(A->ws + WS_GDEC))[(size_t)unit * 96 + tid] = __expf(bcum[63 * 96 + tid]); }
    __syncthreads();
    { bf16* VTg = (bf16*)(A->ws + WS_RSC + RWO_GVT) + (size_t)unit * 12288;
#pragma unroll
        for (int it = 0; it < 3; ++it) { const int i = tid + it * NTHR, e = i >> 3, t8 = (i & 7) * 8; *(v4u*)(VTg + e * 64 + t8) = *(const LAS v4u*)(VT + e * GTS + ((((i & 7) ^ gsw(e))) << 3)); } }
    { const int li = lane & 15, lq = lane >> 4;
        float* KVg = (float*)(A->ws + WS_GKV) + (size_t)unit * 18432;
#pragma unroll
        for (int a = 0; a < 3; ++a) { const int dt = (w & 1) * 3 + a, d0 = dt * 16 + lq * 4;
            const float s0 = __expf(bcum[63 * 96 + d0] - bcum[31 * 96 + d0]), s1 = __expf(bcum[63 * 96 + d0 + 1] - bcum[31 * 96 + d0 + 1]),
                        s2 = __expf(bcum[63 * 96 + d0 + 2] - bcum[31 * 96 + d0 + 2]), s3 = __expf(bcum[63 * 96 + d0 + 3] - bcum[31 * 96 + d0 + 3]);
#pragma unroll
            for (int bb = 0; bb < 3; ++bb) { const int et = (w >> 1) * 3 + bb; const f32x4 z = {0.f, 0.f, 0.f, 0.f};
                f32x4 acc = tile_mm_sw(KtT, dt * 16, VT, et * 16, z, lane);
                acc.x *= s0; acc.y *= s1; acc.z *= s2; acc.w *= s3;
                *(f32x4*)(KVg + (size_t)(et * 16 + li) * 96 + d0) = acc; } } }
    __syncthreads();
}

__device__ __forceinline__ void gla3_unit(ArgsP A, const Frame& F_in, int l, int unit) {
    Frame F = F_in; asm volatile("" : "+v"(F.tid)); F.lane = F.tid & 63;
    const int bh = unit >> 6, c = unit & 63, b = bh >> 2, h = bh & 3, t0 = b * SEQ + c * 64, tid = F.tid, lane = F.lane, w = F.wave;
    const int li = lane & 15, lq = lane >> 4;
    const float* proj = (const float*)(A->ws + WS_PROJ);
    LAS bf16* Qs = (LAS bf16*)F.lds;
    LAS bf16* Ks = (LAS bf16*)(F.lds + 13312);
    LAS bf16* VT = (LAS bf16*)(F.lds + 26624);
    LAS bf16* ST = (LAS bf16*)(F.lds + 54272);
    LAS bf16* att = (LAS bf16*)(F.lds + 94208);
    LAS float* ssq = (LAS float*)(F.lds + 103424);
    LAS float* em = (LAS float*)(F.lds + 103936);
    LAS float* ob = (LAS float*)(F.lds + 26624);
    {
        const v4u* Qg = (const v4u*)((const bf16*)(A->ws + WS_RSC + RWO_GQ) + (size_t)unit * 6144); const v4u* Kg = (const v4u*)((const bf16*)(A->ws + WS_RSC + RWO_GK) + (size_t)unit * 6144);
        const v4u* VTg = (const v4u*)((const bf16*)(A->ws + WS_RSC + RWO_GVT) + (size_t)unit * 12288);
        const f32x4* GS = (const f32x4*)((const float*)(A->ws + WS_GS) + (size_t)unit * 18432);
        v4u q0 = Qg[tid], k0 = Kg[tid], q1 = {0u, 0u, 0u, 0u}, k1 = {0u, 0u, 0u, 0u};
        if (tid < 256) { q1 = Qg[512 + tid]; k1 = Kg[512 + tid]; }
        v4u vt[3]; f32x4 sg[9];
#pragma unroll
        for (int it = 0; it < 3; ++it) vt[it] = VTg[tid + it * NTHR];
#pragma unroll
        for (int it = 0; it < 9; ++it) sg[it] = GS[tid + it * NTHR];
        if (tid < 96) em[tid] = ((const float*)(A->ws + WS_RSC + RWO_GEM))[(size_t)unit * 96 + tid];
        { const int i = tid, t = i / 12, c8 = (i % 12) * 8; *(LAS v4u*)(Qs + t * GQS + c8) = q0; *(LAS v4u*)(Ks + t * GQS + c8) = k0; }
        if (tid < 256) { const int i = 512 + tid, t = i / 12, c8 = (i % 12) * 8; *(LAS v4u*)(Qs + t * GQS + c8) = q1; *(LAS v4u*)(Ks + t * GQS + c8) = k1; }
#pragma unroll
        for (int it = 0; it < 3; ++it) { const int i = tid + it * NTHR, e = i >> 3, t8 = (i & 7) * 8; *(LAS v4u*)(VT + e * GTS + t8) = vt[it]; }
        __syncthreads();
#pragma unroll
        for (int it = 0; it < 9; ++it) { const int i = tid + it * NTHR, e = i / 24, d = (i % 24) * 4; const f32x4 m4 = *(const LAS f32x4*)(em + d);
            v2u pk; pk.x = pk2(sg[it].x * m4.x, sg[it].y * m4.y); pk.y = pk2(sg[it].z * m4.z, sg[it].w * m4.w); *(LAS v2u*)(ST + e * GQS + d) = pk; }
    }
    __syncthreads();
#pragma unroll
    for (int a = 0; a < 2; ++a) { const int jt = w >> 1, it = (w & 1) * 2 + a; const f32x4 z = {0.f, 0.f, 0.f, 0.f};
        f32x4 acc = z;
        if (jt <= it) acc = tile_mm<3>(Ks, GQS, jt * 16, Qs, GQS, it * 16, z, lane);
        const int i = it * 16 + li, j0 = jt * 16 + lq * 4;
        acc.x = (j0 + 0 <= i) ? acc.x : 0.f; acc.y = (j0 + 1 <= i) ? acc.y : 0.f; acc.z = (j0 + 2 <= i) ? acc.z : 0.f; acc.w = (j0 + 3 <= i) ? acc.w : 0.f;
        v2u pk; pk.x = pk2(acc.x, acc.y); pk.y = pk2(acc.z, acc.w); *(LAS v2u*)(att + i * GTS + j0) = pk; }
    __syncthreads();
    f32x4 o[6];
    { const int it = w >> 1;
#pragma unroll
        for (int a = 0; a < 6; ++a) { const int et = (w & 1) * 6 + a; const f32x4 z = {0.f, 0.f, 0.f, 0.f};
            f32x4 acc = tile_mm<2>(att, GTS, it * 16, VT, GTS, et * 16, z, lane);
            o[a] = tile_mm<3>(Qs, GQS, it * 16, ST, GQS, et * 16, acc, lane); }
        float s0 = 0.f, s1 = 0.f, s2 = 0.f, s3 = 0.f;
#pragma unroll
        for (int a = 0; a < 6; ++a) { s0 += o[a].x * o[a].x; s1 += o[a].y * o[a].y; s2 += o[a].z * o[a].z; s3 += o[a].w * o[a].w; }
        s0 = row16_sum(s0); s1 = row16_sum(s1); s2 = row16_sum(s2); s3 = row16_sum(s3);
        if (li == 0) { const int r0 = it * 16 + lq * 4; ssq[(r0 + 0) * 2 + (w & 1)] = s0; ssq[(r0 + 1) * 2 + (w & 1)] = s1; ssq[(r0 + 2) * 2 + (w & 1)] = s2; ssq[(r0 + 3) * 2 + (w & 1)] = s3; }
    }
    __syncthreads();
    { const int it = w >> 1, r0 = it * 16 + lq * 4;
#pragma unroll
        for (int a = 0; a < 6; ++a) { const int e = ((w & 1) * 6 + a) * 16 + li;
            ob[(r0 + 0) * 196 + e] = o[a].x; ob[(r0 + 1) * 196 + e] = o[a].y; ob[(r0 + 2) * 196 + e] = o[a].z; ob[(r0 + 3) * 196 + e] = o[a].w; } }
    __syncthreads();
    { bf16* Y = (bf16*)(A->ws + WS_Y);
        f32x4 gv[6];
#pragma unroll
        for (int k = 0; k < 6; ++k) { const int i = tid + k * NTHR, t = i / 48, e = (i % 48) * 4; gv[k] = *(const f32x4*)(proj + (size_t)(t0 + t) * INWP + C_GG + h * 192 + e); }
#pragma unroll
        for (int k = 0; k < 6; ++k) { const int i = tid + k * NTHR, t = i / 48, e = (i % 48) * 4;
            const float rstd = rsqrtf((ssq[t * 2] + ssq[t * 2 + 1]) * (1.f / 192.f) + NORM_EPS);
            const f32x4 ov = *(const LAS f32x4*)(ob + t * 196 + e); const f32x4 ng = *(const f32x4*)(A->in[10] + (size_t)l * 768 + h * 192 + e);
            f32x4 y; y.x = ov.x * rstd * ng.x * gv[k].x * sigmoidf_(gv[k].x); y.y = ov.y * rstd * ng.y * gv[k].y * sigmoidf_(gv[k].y);
            y.z = ov.z * rstd * ng.z * gv[k].z * sigmoidf_(gv[k].z); y.w = ov.w * rstd * ng.w * gv[k].w * sigmoidf_(gv[k].w);
            v2u pk; pk.x = pk2(y.x, y.y); pk.y = pk2(y.z, y.w); *(v2u*)(Y + (size_t)(t0 + t) * DM + 512 + h * 192 + e) = pk; } }
    __syncthreads();
}

#define INS16(L, P, x, px) do { { const bool c_ = (x) > L[15]; L[15] = c_ ? (x) : L[15]; P[15] = c_ ? (px) : P[15]; } \
    _Pragma("unroll") for (int r_ = 14; r_ >= 0; --r_) { const bool c_ = L[r_ + 1] > L[r_]; const float tl_ = L[r_]; const int tp_ = P[r_]; \
        L[r_] = c_ ? L[r_ + 1] : tl_; L[r_ + 1] = c_ ? tl_ : L[r_ + 1]; P[r_] = c_ ? P[r_ + 1] : tp_; P[r_ + 1] = c_ ? tp_ : P[r_ + 1]; } } while (0)

__device__ __forceinline__ float gelu_as(float v) {
    const float av = fabsf(v), t = __builtin_amdgcn_rcpf(av * 0.2316418882f + 1.0f);
    float q = t * 0.5307027145f + (-0.7265760135f); q = q * t + 0.7107068705f; q = q * t + (-0.142248368f); q = q * t + 0.127414796f; q = q * t;
    const float e = __builtin_amdgcn_exp2f((v * v) * (-0.72134752044f));
    const float m = v * (q * e);
    return v < 0.f ? m : v - m;
}
__device__ __forceinline__ int row16_sum_i(int v) {
    v += __builtin_amdgcn_update_dpp(0, v, 0xB1, 0xF, 0xF, true); v += __builtin_amdgcn_update_dpp(0, v, 0x4E, 0xF, 0xF, true);
    v += __builtin_amdgcn_update_dpp(0, v, 0x141, 0xF, 0xF, true); v += __builtin_amdgcn_update_dpp(0, v, 0x140, 0xF, 0xF, true); return v;
}
#ifndef PEER_SL_SHIFT
#define PEER_SL_SHIFT 10
#endif
__device__ __forceinline__ void ph_peer4(ArgsP A, LAS unsigned char* lds_, int wv_, int l, const float* g2, const float* sh2, const float* ngain, const float* nsh, const float* nsc, const bool last, const bool dry = false) {
    const Frame F = make_frame(lds_, wv_);
    const int lane = F.lane, li = lane & 15, lq = lane >> 4;
    const float* SCO = (const float*)(A->ws + WS_PROJ);
    const unsigned char* U4 = A->ws + WS_U + (size_t)l * PEER_N * (DM / 2); const unsigned char* V4 = A->ws + WS_V + (size_t)l * PEER_N * (DM / 2);
    const float* US = (const float*)(A->ws + WS_US) + (size_t)l * PEER_N; const float* VS = (const float*)(A->ws + WS_VS) + (size_t)l * PEER_N;
    float* X = (float*)(A->ws + WS_X); bf16* H = (bf16*)(A->ws + WS_H); const float* ssr = (const float*)(A->ws + WS_SSP) + (size_t)l * NT * 32;
    LAS unsigned char* wl = F.lds + F.wave * 15104;
    LAS int* es = (LAS int*)wl; LAS float* gs = (LAS float*)(wl + 4096);
    LAS v4u* hl = (LAS v4u*)wl;
    LAS int* se = (LAS int*)(wl + 8448);
    LAS float* sg = (LAS float*)(wl + 10496);
    LAS int* st = (LAS int*)(wl + 12544);
    LAS float* dl = (LAS float*)(wl + 14592);
    LAS float* hsl = dl + 64; LAS int* hsi = (LAS int*)(dl + 68);
    for (int tb = F.gw * 4; tb < NT; tb += F.ngw * 4) {
        {
            int P2[16]; float gt[16];
            const int prob = tb * 16 + lane, half = lane & 1;
            const f32x4* s4 = (const f32x4*)(SCO + (size_t)prob * 128);
            int KK[16];
#pragma unroll
            for (int r = 0; r < 16; ++r) KK[r] = (int)0x80000000;
            f32x4 nv[4];
#pragma unroll
            for (int i = 0; i < 4; ++i) nv[i] = s4[i];
#define KINS(x_, idx_) do { const int b_ = __builtin_bit_cast(int, (float)(x_)); int k_ = b_ ^ ((b_ >> 31) & 0x7fffffff); k_ = (k_ & ~127) | (127 - (idx_)); \
        _Pragma("unroll") for (int r_ = 0; r_ < 16; ++r_) { const int hi_ = KK[r_] > k_ ? KK[r_] : k_; k_ = KK[r_] > k_ ? k_ : KK[r_]; KK[r_] = hi_; } } while (0)
#pragma unroll 1
            for (int q = 0; q < 8; ++q) {
                f32x4 v[4];
#pragma unroll
                for (int i = 0; i < 4; ++i) v[i] = nv[i];
                if (q < 7) {
#pragma unroll
                    for (int i = 0; i < 4; ++i) nv[i] = s4[4 * (q + 1) + i]; }
                _Pragma("unroll") for (int r = 0; r < 16; ++r) asm volatile("" : "+v"(KK[r]));
#pragma unroll
                for (int i = 0; i < 4; ++i) { const int ib = 16 * q + 4 * i;
                    KINS(v[i].x, ib); KINS(v[i].y, ib + 1); KINS(v[i].z, ib + 2); KINS(v[i].w, ib + 3); }
            }
#undef KINS
            float v1[16], v2[16];
            LAS int* gsi = (LAS int*)gs;
#pragma unroll
            for (int r = 0; r < 16; ++r) { const int ok = __builtin_amdgcn_update_dpp(0, KK[r], 0xB1, 0xF, 0xF, true);
                const int k1 = half ? ok : KK[r], k2 = half ? KK[r] : ok; const int a1 = k1 & ~127, a2 = k2 & ~127;
                v1[r] = __builtin_bit_cast(float, a1 ^ ((a1 >> 31) & 0x7fffffff)); v2[r] = __builtin_bit_cast(float, a2 ^ ((a2 >> 31) & 0x7fffffff));
                es[r * 64 + lane] = 127 - (k1 & 127); gsi[r * 64 + lane] = 127 - (k2 & 127); }
            int Q[16];
#define MKKEY2(a_, b_) ({ const int bb_ = __builtin_bit_cast(int, v1[a_] + v2[b_]); const int kk_ = bb_ ^ ((bb_ >> 31) & 0x7fffffff); (kk_ & ~255) | (255 - ((a_) * 16 + (b_))); })
#pragma unroll
            for (int bq = 0; bq < 16; ++bq) Q[bq] = MKKEY2(0, bq);
#pragma unroll
            for (int a = 1; a < 16; ++a)
#pragma unroll
                for (int bq = 0; bq < 16; ++bq) if ((a + 1) * (bq + 1) <= 16) { int k_ = MKKEY2(a, bq);
#pragma unroll
                    for (int r = (a + 1) * (bq + 1) - 1; r < 16; ++r) { const int hi_ = Q[r] > k_ ? Q[r] : k_; k_ = Q[r] > k_ ? k_ : Q[r]; Q[r] = hi_; } }
#undef MKKEY2
            float L2[16];
#pragma unroll
            for (int r = 0; r < 16; ++r) { const int ab = 255 - (Q[r] & 255); const int qv = Q[r] & ~255; L2[r] = __builtin_bit_cast(float, qv ^ ((qv >> 31) & 0x7fffffff));
                P2[r] = es[(ab >> 4) * 64 + lane] * 128 + gsi[(ab & 15) * 64 + lane]; }
            float sum = 0.f;
#pragma unroll
            for (int r = 0; r < 16; ++r) { gt[r] = __expf(L2[r] - L2[0]); sum += gt[r]; }
            const float inv = 1.f / sum;
#pragma unroll
            for (int r = 0; r < 16; ++r) { es[r * 64 + lane] = P2[r]; gs[r * 64 + lane] = gt[r] * inv; }
            asm volatile("s_waitcnt lgkmcnt(0)" ::: "memory");
        }
        {
            int ee[8]; float gg[8];
#pragma unroll
            for (int j = 0; j < 8; ++j) { const int x = j * 64 + lane, k = x >> 7, y = x & 127; ee[j] = es[(y & 15) * 64 + k * 16 + 2 * (y >> 4)]; gg[j] = gs[(y & 15) * 64 + k * 16 + 2 * (y >> 4)]; }
            int base = 0;
#pragma unroll
            for (int k = 0; k < 4; ++k) {
#pragma unroll 1
                for (int s = 0; s < (16384 >> PEER_SL_SHIFT); ++s) {
#pragma unroll
                    for (int jj = 0; jj < 2; ++jj) { const int j = k * 2 + jj; const bool in = (ee[j] >> PEER_SL_SHIFT) == s; const unsigned long long m = __builtin_amdgcn_ballot_w64(in);
                        if (in) { const int pos = base + (int)__builtin_amdgcn_mbcnt_hi((unsigned)(m >> 32), __builtin_amdgcn_mbcnt_lo((unsigned)m, 0u)); se[pos] = ee[j]; sg[pos] = gg[j]; }
                        base += __builtin_popcountll(m); }
                }
            }
        }
        asm volatile("s_waitcnt lgkmcnt(0)" ::: "memory");
#pragma unroll 1
        for (int k = 0; k < 4; ++k) {
            const int t = tb + k, b = t >> 12;
            float hf[32]; float mx = 0.f;
            const v4u* hp = (const v4u*)(H + (size_t)t * DM);
#pragma unroll
            for (int jj = 0; jj < 2; ++jj)
#pragma unroll
                for (int c = 0; c < 2; ++c) { const v4u hv = hp[(jj * 64 + lane) * 2 + c]; const int o = jj * 16 + c * 8;
                    hf[o + 0] = bflo(hv.x); hf[o + 1] = bfhi(hv.x); hf[o + 2] = bflo(hv.y); hf[o + 3] = bfhi(hv.y); hf[o + 4] = bflo(hv.z); hf[o + 5] = bfhi(hv.z); hf[o + 6] = bflo(hv.w); hf[o + 7] = bfhi(hv.w); }
            { const float rstd = rsqrtf(wave_sum(lane < 32 ? ssr[(size_t)t * 32 + lane] : 0.f) * (1.f / DM) + NORM_EPS);
#pragma unroll
                for (int jj = 0; jj < 2; ++jj)
#pragma unroll
                    for (int q = 0; q < 4; ++q) { const f32x4 s4 = *(const f32x4*)(sh2 + (size_t)b * MODW + (jj * 64 + lane) * 16 + 4 * q);
                        hf[jj * 16 + 4 * q] = hf[jj * 16 + 4 * q] * rstd + s4.x; hf[jj * 16 + 4 * q + 1] = hf[jj * 16 + 4 * q + 1] * rstd + s4.y;
                        hf[jj * 16 + 4 * q + 2] = hf[jj * 16 + 4 * q + 2] * rstd + s4.z; hf[jj * 16 + 4 * q + 3] = hf[jj * 16 + 4 * q + 3] * rstd + s4.w; } }
#pragma unroll
            for (int i = 0; i < 32; ++i) mx = fmaxf(mx, fabsf(hf[i]));
            mx = wave_max(mx);
            const float inv = mx > 0.f ? 127.f / mx : 0.f;
            if (lane == 0) hsl[k] = mx * (1.f / 127.f);
            int hsum = 0;
#pragma unroll
            for (int jj = 0; jj < 2; ++jj) { unsigned qd[4];
#pragma unroll
                for (int d = 0; d < 4; ++d) { const int o = jj * 16 + 4 * d; const int q0 = (int)rintf(hf[o] * inv), q1 = (int)rintf(hf[o + 1] * inv), q2 = (int)rintf(hf[o + 2] * inv), q3 = (int)rintf(hf[o + 3] * inv);
                    qd[d] = (unsigned)(q0 & 255) | ((unsigned)(q1 & 255) << 8) | ((unsigned)(q2 & 255) << 16) | ((unsigned)(q3 & 255) << 24); hsum += (q0 + q1) + (q2 + q3); }
                v4u q; q.x = qd[0]; q.y = qd[1]; q.z = qd[2]; q.w = qd[3]; hl[k * 132 + jj * 64 + lane] = q; }
            { hsum = row16_sum_i(hsum); const int hs_all = __builtin_amdgcn_readlane(hsum, 0) + __builtin_amdgcn_readlane(hsum, 16) + __builtin_amdgcn_readlane(hsum, 32) + __builtin_amdgcn_readlane(hsum, 48);
                if (lane == 0) hsi[k] = hs_all; }
        }
        asm volatile("s_waitcnt lgkmcnt(0)" ::: "memory");
        {
            int lu = lane; asm volatile("" : "+v"(lu)); const int tq = lu & 3, pq = (lu >> 2) & 3, kq = lu >> 4;
            v4i hB[8];
            { const LAS v4u* hb = hl + tq * 132 + kq * 4 + pq;
#pragma unroll
                for (int s = 0; s < 4; ++s) { hB[2 * s] = *(const LAS v4i*)(hb + s * 16); hB[2 * s + 1] = *(const LAS v4i*)(hb + 64 + s * 16); } }
            const int hc = 8 * hsi[tq];
            const unsigned char* ubase = U4 + kq * 64 + tq * 16;
#define ULOAD4(buf, q_) do { const int e_ = se[(q_) * 4 + pq]; const unsigned char* up_ = ubase + (size_t)e_ * (DM / 2); \
    _Pragma("unroll") for (int s = 0; s < 4; ++s) buf[s] = *(const v4i*)(up_ + s * 256); } while (0)
#define UCONS4(buf, gi_) do { v4i acc = {0, 0, 0, 0}; \
    _Pragma("unroll") for (int s = 0; s < 4; ++s) { const v4i lo_ = buf[s] & 0x0F0F0F0F, hi_ = (buf[s] >> 4) & 0x0F0F0F0F; \
        acc = __builtin_amdgcn_mfma_i32_16x16x64_i8(lo_, hB[2 * s], acc, 0, 0, 0); acc = __builtin_amdgcn_mfma_i32_16x16x64_i8(hi_, hB[2 * s + 1], acc, 0, 0, 0); } \
    int v_ = pq == 0 ? acc.x : (pq == 1 ? acc.y : (pq == 2 ? acc.z : acc.w)); \
    v_ += __builtin_amdgcn_update_dpp(0, v_, 0x124, 0xF, 0xF, true); v_ += __builtin_amdgcn_update_dpp(0, v_, 0x128, 0xF, 0xF, true); \
    if (pq == 0) dl[((gi_) * 4 + kq) * 4 + tq] = (float)(v_ - hc); } while (0)
            float us_c, vs_c; { const int e0 = se[lu & 15]; us_c = US[e0]; vs_c = VS[e0]; }
            v4i ub0[4], ub1[4], ub2[4], ub3[4];
            ULOAD4(ub0, 0); ULOAD4(ub1, 1); ULOAD4(ub2, 2); ULOAD4(ub3, 3);
#pragma unroll 1
            for (int g = 0; g < 32; ++g) {
                const int gn = g + 1 < 32 ? g + 1 : 31;
                const int en = se[gn * 16 + (lu & 15)]; const float us_n = US[en], vs_n = VS[en];
                UCONS4(ub0, 0); ULOAD4(ub0, gn * 4 + 0);
                UCONS4(ub1, 1); ULOAD4(ub1, gn * 4 + 1);
                UCONS4(ub2, 2); ULOAD4(ub2, gn * 4 + 2);
                UCONS4(ub3, 3); ULOAD4(ub3, gn * 4 + 3);
                if (lu < 16) { const int x = g * 16 + lu; const int tk = x >> 7;
                    sg[x] = sg[x] * vs_c * gelu_as(dl[lu * 4 + tk] * (us_c * hsl[tk])); }
                us_c = us_n; vs_c = vs_n;
            }
#undef ULOAD4
#undef UCONS4
        }
        asm volatile("s_waitcnt lgkmcnt(0)" ::: "memory");
#define VLOAD(buf, cfb, bi_) do { const v4i e4_ = *(const LAS v4i*)(se + xb + (bi_) * 4); const f32x4 g4_ = *(const LAS f32x4*)(sg + xb + (bi_) * 4); \
        cfb[0] = g4_.x; cfb[1] = g4_.y; cfb[2] = g4_.z; cfb[3] = g4_.w; const int ee_[4] = {e4_.x, e4_.y, e4_.z, e4_.w}; \
        _Pragma("unroll") for (int i = 0; i < 4; ++i) { const unsigned char* vp_ = vbase + (size_t)ee_[i] * (DM / 2); buf[i][0] = *(const v4u*)vp_; buf[i][1] = *(const v4u*)(vp_ + 512); } } while (0)
#define VACC(bv_, cv_) do { const f32x2 c2_ = {cv_, cv_}; \
        _Pragma("unroll") for (int jj = 0; jj < 2; ++jj) { const unsigned wd_[4] = {bv_[jj].x, bv_[jj].y, bv_[jj].z, bv_[jj].w}; \
            _Pragma("unroll") for (int d = 0; d < 4; ++d) { const int o_ = jj * 16 + 4 * d; \
                const f32x2 f0_ = __builtin_amdgcn_cvt_scalef32_pk_f32_fp4((int)wd_[d], 1.0f, 0), f1_ = __builtin_amdgcn_cvt_scalef32_pk_f32_fp4((int)wd_[d], 1.0f, 1), \
                            f2_ = __builtin_amdgcn_cvt_scalef32_pk_f32_fp4((int)wd_[d], 1.0f, 2), f3_ = __builtin_amdgcn_cvt_scalef32_pk_f32_fp4((int)wd_[d], 1.0f, 3); \
                out[o_] = __builtin_elementwise_fma(c2_, f0_, out[o_]); out[o_ + 1] = __builtin_elementwise_fma(c2_, f1_, out[o_ + 1]); \
                out[o_ + 2] = __builtin_elementwise_fma(c2_, f2_, out[o_ + 2]); out[o_ + 3] = __builtin_elementwise_fma(c2_, f3_, out[o_ + 3]); } } } while (0)
#define VCONS(buf, cfb) do { _Pragma("unroll") for (int i = 0; i < 4; ++i) VACC(buf[i], cfb[i]); } while (0)
#pragma unroll 1
        for (int p = 0; p < 2; ++p) {
            int lane_v = F.lane; asm volatile("" : "+v"(lane_v)); const int hv = lane_v >> 5, mv = lane_v & 31;
            const int xb = (2 * p + hv) * 128;
            const unsigned char* vbase = V4 + mv * 16;
            f32x2 out[32];
#pragma unroll
            for (int i = 0; i < 32; ++i) out[i] = (f32x2){0.f, 0.f};
            {
                v4u vb0[4][2], vb1[4][2]; float c0[4], c1[4];
                VLOAD(vb0, c0, 0); VLOAD(vb1, c1, 1);
#pragma unroll 1
                for (int bi = 0; bi < 32; bi += 2) {
                    const int b2 = bi + 2 < 32 ? bi + 2 : 30, b3 = bi + 3 < 32 ? bi + 3 : 31;
                    asm volatile("" ::: "memory"); VCONS(vb0, c0); asm volatile("" ::: "memory"); VLOAD(vb0, c0, b2);
                    asm volatile("" ::: "memory"); VCONS(vb1, c1); asm volatile("" ::: "memory"); VLOAD(vb1, c1, b3);
                }
            }
            {
                const int t = tb + 2 * p + hv, b = t >> 12;
                f32x4 xn[2][8]; float ss = 0.f;
                const f32x4* xr = (const f32x4*)(X + (size_t)t * DM) + mv; const f32x4* gr = (const f32x4*)(g2 + (size_t)b * MODW) + mv;
#pragma unroll
                for (int jj = 0; jj < 2; ++jj)
#pragma unroll
                    for (int q = 0; q < 8; ++q) { const int ix = jj * 256 + q * 32; const f32x4 xv = xr[ix], gv = gr[ix];
                        f32x4 o4; o4.x = out[jj * 16 + 2 * q].x; o4.y = out[jj * 16 + 2 * q].y; o4.z = out[jj * 16 + 2 * q + 1].x; o4.w = out[jj * 16 + 2 * q + 1].y;
                        const f32x4 y = xv + gv * o4; xn[jj][q] = y; ss += (y.x * y.x + y.y * y.y) + (y.z * y.z + y.w * y.w); }
                float rstd; { const float v = row16_sum(ss); const float s0 = rl_f(v, 0) + rl_f(v, 16), s1 = rl_f(v, 32) + rl_f(v, 48); rstd = rsqrtf((hv ? s1 : s0) * (1.f / DM) + NORM_EPS); }
                if (!last) {
                    f32x4* xw = (f32x4*)((dry ? (float*)(A->ws + WS_DUMMY) : X) + (size_t)t * DM) + mv; v2u* hw = (v2u*)((dry ? (bf16*)(A->ws + WS_DUMMY + 64 * MiB) : H) + (size_t)t * DM) + mv;
                    const f32x4* ngp = (const f32x4*)ngain + mv; const f32x4* s1p = (const f32x4*)(nsc + (size_t)b * MODW) + mv; const f32x4* s0p = (const f32x4*)(nsh + (size_t)b * MODW) + mv;
#pragma unroll
                    for (int jj = 0; jj < 2; ++jj)
#pragma unroll
                        for (int q = 0; q < 8; ++q) { const int ix = jj * 256 + q * 32; xw[ix] = xn[jj][q];
                            const f32x4 g = ngp[ix], s1 = s1p[ix], s0 = s0p[ix];
                            const f32x4 y = xn[jj][q] * rstd * g * (s1 + 1.f) + s0;
                            v2u o; o.x = pk2(y.x, y.y); o.y = pk2(y.z, y.w); hw[ix] = o; }
                } else {
                    f32x4* ow = (f32x4*)((dry ? (float*)(A->ws + WS_DUMMY) : A->out) + (size_t)t * DM) + mv; const f32x4* ngp = (const f32x4*)ngain + mv;
#pragma unroll
                    for (int jj = 0; jj < 2; ++jj)
#pragma unroll
                        for (int q = 0; q < 8; ++q) { const int ix = jj * 256 + q * 32; ow[ix] = xn[jj][q] * rstd * ngp[ix]; }
                }
            }
        }
#undef VLOAD
#undef VACC
#undef VCONS
    }
}

__device__ __forceinline__ void PH_norm1_l0(LAS unsigned char* lds, int wv) { ArgsP A = args_ptr(); const float* MOD = (const float*)(A->ws + WS_MOD);
    ph_norm(A->in[0], A->in[4], MOD + 0 * DM, MOD + 1 * DM, (bf16*)(A->ws + WS_H), lds, wv);
    { const Frame F = make_frame(lds, wv); float* B3 = (float*)(A->ws + WS_BIAS3);
        for (int o = F.gw; o < DEPTH * 2 * DM; o += F.ngw) { const int l = o >> 12, b = (o >> 11) & 1, n = o & 2047;
            const float* sh = MOD + (size_t)(l * 2 + b) * MODW + 3 * DM; const v4u* wr = (const v4u*)((const bf16*)(A->ws + WS_WQK) + ((size_t)l * DM + n) * DM);
            float s = 0.f;
#pragma unroll
            for (int j = 0; j < 4; ++j) { const v4u wv4 = wr[j * 64 + F.lane]; const f32x4 s0 = *(const f32x4*)(sh + (j * 64 + F.lane) * 8), s1 = *(const f32x4*)(sh + (j * 64 + F.lane) * 8 + 4);
                s += bflo(wv4.x) * s0.x + bfhi(wv4.x) * s0.y + bflo(wv4.y) * s0.z + bfhi(wv4.y) * s0.w + bflo(wv4.z) * s1.x + bfhi(wv4.z) * s1.y + bflo(wv4.w) * s1.z + bfhi(wv4.w) * s1.w; }
            s = wave_sum(s);
            if (F.lane == 0) B3[o] = s; } } }
__device__ __forceinline__ void PH_gemm1(LAS unsigned char* lds, int wv, int l_) { ArgsP A = args_ptr(); const int l = opaque_i(l_);
    pg8::Gemm g{(const bf16*)(A->ws + WS_H), (const bf16*)(A->ws + WS_WIN) + (size_t)l * INWP * DM, NT, INWP, DM}; pg8::StaticOrder S; S.init(NT, INWP, gridDim.x, blockIdx.x);
    EpiStoreF32 E{(float*)(A->ws + WS_PROJ), INWP, wv};
    pg8::gemm_phase<EpiStoreF32, pg8::StaticOrder, true, true>(lds, g, S, E, wv); }
__device__ __forceinline__ void PH_mixA(LAS unsigned char* lds, int wv, int l_) { ArgsP A = args_ptr(); const int l = opaque_i(l_);
    const Frame F = make_frame(lds, wv);
#ifdef PROBE_A
    for (int u = F.bid; u < 2048; u += F.G) {
        if (u < 1536) { if (PROBE_A == 1) rwkvA_unit(A, F, l, u); }
        else { if (PROBE_A == 2) gla1_unit(A, F, l, u - 1536); }
    }
#endif
    for (int u = F.bid; u < 2048; u += F.G) {
        if (u < 1536) rwkvA_unit(A, F, l, u);
        else gla1_unit(A, F, l, u - 1536);
    }
    if (l + 1 < DEPTH) quant_tables(A, l + 1, F.gw, F.ngw, F.lane);
}
__device__ __forceinline__ void PH_mixB(LAS unsigned char* lds, int wv, int l_) { ArgsP A = args_ptr(); const int l = opaque_i(l_);
    const Frame F = make_frame(lds, wv);
    if (F.G >= 192) {
        if (F.bid < 96) rwkvB_scan(A, F, F.bid);
        else { const int nb = F.G - 96, b2 = F.bid - 96;
            for (int u = b2; u < 288; u += nb) gla_scan_unit(A, F, u);
            for (int u = b2; u < 1024; u += nb) pool_unit(A, F, l, u); }
    } else {
        for (int u = F.bid; u < 288; u += F.G) gla_scan_unit(A, F, u);
        for (int u = F.bid; u < 1024; u += F.G) pool_unit(A, F, l, u);
        for (int u = F.bid; u < 96; u += F.G) rwkvB_scan(A, F, u);
    } }
__device__ __forceinline__ void PH_mixC(LAS unsigned char* lds, int wv, int l_) { ArgsP A = args_ptr(); const int l = opaque_i(l_);
    const Frame F = make_frame(lds, wv);
#ifdef PROBE_C
    for (int u = F.bid; u < 2048; u += F.G) { if (u < 512) { if (PROBE_C == 1) gla3_unit(A, F, l, u); } else { if (PROBE_C == 2) rwkvC_unit(A, F, l, u - 512); } }
#endif
    for (int u = F.bid; u < 2048; u += F.G) { if (u < 512) gla3_unit(A, F, l, u); else rwkvC_unit(A, F, l, u - 512); } }
__device__ __forceinline__ void PH_gemm2(LAS unsigned char* lds, int wv, int l_, bool dry = false) { ArgsP A = args_ptr(); const int l = opaque_i(l_);
    const float* modl = (const float*)(A->ws + WS_MOD) + (size_t)l * 2 * MODW; float* X = (float*)(A->ws + WS_X);
    pg8::Gemm g{(const bf16*)(A->ws + WS_Y), (const bf16*)(A->ws + WS_WOUT) + (size_t)l * DM * DM, NT, DM, DM}; pg8::StaticOrder S; S.init(NT, DM, gridDim.x, blockIdx.x);
    EpiResid E{(l == 0) ? A->in[0] : (const float*)X, dry ? (float*)(A->ws + WS_DUMMY) : X, modl + 2 * DM, wv, A->in[23] + (size_t)l * DM, modl + 4 * DM,
               dry ? (bf16*)(A->ws + WS_DUMMY + 64 * MiB) : (bf16*)(A->ws + WS_H), (dry ? (float*)(A->ws + WS_DUMMY) : (float*)(A->ws + WS_SSP) + (size_t)l * NT * 32)};
    pg8::gemm_phase<EpiResid, pg8::StaticOrder, true, true>(lds, g, S, E, wv); }
__device__ __forceinline__ void PH_norm2(LAS unsigned char* lds, int wv, int l_) { ArgsP A = args_ptr(); const int l = opaque_i(l_);
    const float* modl = (const float*)(A->ws + WS_MOD) + (size_t)l * 2 * MODW;
    ph_norm((const float*)(A->ws + WS_X), A->in[23] + (size_t)l * DM, modl + 3 * DM, modl + 4 * DM, (bf16*)(A->ws + WS_H), lds, wv); }
__device__ __forceinline__ void PH_gemm3(LAS unsigned char* lds, int wv, int l_) { ArgsP A = args_ptr(); const int l = opaque_i(l_);
    pg8::Gemm g{(const bf16*)(A->ws + WS_H), (const bf16*)(A->ws + WS_WQK) + (size_t)l * DM * DM, NT, DM, DM}; pg8::StaticOrder S; S.init(NT, DM, gridDim.x, blockIdx.x);
    LAS float* rs = (LAS float*)(lds + 131072);
    { pg8::Unit u0; const int t = tid_from(wv); if (S.next(0, u0) && t < 256) { const f32x4* sp = (const f32x4*)((const float*)(A->ws + WS_SSP) + ((size_t)l * NT + u0.pm * 256 + t) * 32); float s = 0.f;
#pragma unroll
            for (int j = 0; j < 8; ++j) { const f32x4 v = sp[j]; s += (v.x + v.y) + (v.z + v.w); }
            rs[t] = rsqrtf(s * (1.f / DM) + NORM_EPS); }
        __syncthreads(); }
    EpiScore E{(float*)(A->ws + WS_PROJ), DM, wv, rs, (const float*)(A->ws + WS_BIAS3) + (size_t)l * 2 * DM};
    pg8::gemm_phase<EpiScore, pg8::StaticOrder, true, true>(lds, g, S, E, wv); }
__device__ __forceinline__ void PH_peer(LAS unsigned char* lds, int wv, int l_, bool dry = false) { ArgsP A = args_ptr(); const int l = opaque_i(l_);
    const float* MOD = (const float*)(A->ws + WS_MOD); const float* modl = MOD + (size_t)l * 2 * MODW;
    const bool last = (l == DEPTH - 1);
    const float* nmod = MOD + (size_t)(last ? l : l + 1) * 2 * MODW;
    ph_peer4(A, lds, wv, l, modl + 5 * DM, modl + 3 * DM, last ? A->in[29] : A->in[4] + (size_t)(l + 1) * DM, nmod + 0 * DM, nmod + 1 * DM, last, dry); }

__global__ void __launch_bounds__(NTHR, 2) mega_fwd(Args args) {
    extern __shared__ __attribute__((aligned(16))) unsigned char lds_raw[];
    LAS unsigned char* lds = (LAS unsigned char*)lds_raw;
    volatile LAS unsigned* MISC = (volatile LAS unsigned*)(lds + MISC_OFF);
    const int wv = __builtin_amdgcn_readfirstlane((int)(threadIdx.x >> 6));
    if (wv == 0) MISC[lane_id_()] = 0u;
    __syncthreads();
    XcdBarrier bar = xcd_barrier_post((unsigned*)(args_ptr()->ws + WS_CTL) + CW_BAR, MISC + 8, wv);
#define GRID_BAR() do { XcdBarrier b_ = bar; b_.bar = (unsigned*)(args_ptr()->ws + WS_CTL) + CW_BAR; asm volatile("" : "+s"(b_.x), "+s"(b_.w)); xcd_barrier(b_); if (PROBE & 512) xcd_barrier(b_); } while (0)

    ph_prologue(args_ptr(), lds, wv);
    GRID_BAR();
#if PROBE & 1
    ph_prologue(args_ptr(), lds, wv); GRID_BAR();
#endif
    PH_norm1_l0(lds, wv);
    GRID_BAR();
    for (int l = 0; l < DEPTH; ++l) {
#if PROBE & 2
        PH_gemm1(lds, wv, l); GRID_BAR();
#endif
        PH_gemm1(lds, wv, l); GRID_BAR();
#if PROBE & 4
        PH_mixA(lds, wv, l);  GRID_BAR();
#endif
        PH_mixA(lds, wv, l);  GRID_BAR();
#if PROBE & 8
        PH_mixB(lds, wv, l);  GRID_BAR();
#endif
        PH_mixB(lds, wv, l);  GRID_BAR();
#if PROBE & 16
        PH_mixC(lds, wv, l);  GRID_BAR();
#endif
        PH_mixC(lds, wv, l);  GRID_BAR();
#if PROBE & 32
        PH_gemm2(lds, wv, l, true); GRID_BAR();
#endif
        PH_gemm2(lds, wv, l); GRID_BAR();
#if PROBE & 128
        PH_gemm3(lds, wv, l); GRID_BAR();
#endif
        PH_gemm3(lds, wv, l); GRID_BAR();
#if PROBE & 256
        PH_peer(lds, wv, l, true); GRID_BAR();
#endif
        PH_peer(lds, wv, l);
        if (l + 1 < DEPTH) GRID_BAR();
    }
}

extern "C" void kernel_launch(void* const* d_in, const int* in_sizes, int n_in, void* d_out, int out_size, void* d_ws, size_t ws_size, hipStream_t stream) {
    static int grid = 0;
    if (grid == 0) {
        if (n_in != 30 || out_size != NT * DM || ws_size < WS_END + 96 * MiB) { fprintf(stderr, "kernel_launch: unexpected shapes (n_in %d out %d ws %zu)\n", n_in, out_size, ws_size); grid = -1; return; }
        int dev = 0, cus = 0, per_cu = 0;
        if (hipGetDevice(&dev) != hipSuccess || hipDeviceGetAttribute(&cus, hipDeviceAttributeMultiprocessorCount, dev) != hipSuccess) { grid = -1; return; }
        if (hipFuncSetAttribute((const void*)mega_fwd, hipFuncAttributeMaxDynamicSharedMemorySize, LDS_BYTES) != hipSuccess) { fprintf(stderr, "kernel_launch: hipFuncSetAttribute failed\n"); grid = -1; return; }
        if (hipOccupancyMaxActiveBlocksPerMultiprocessor(&per_cu, (const void*)mega_fwd, NTHR, LDS_BYTES) != hipSuccess || per_cu < 1) { fprintf(stderr, "kernel_launch: occupancy query says %d\n", per_cu); (void)hipGetLastError(); per_cu = 1; }
        grid = cus;
    }
    if (grid < 0) return;
    (void)in_sizes;
    if (hipMemsetAsync((char*)d_ws + WS_CTL, 0, CTL_ZERO_BYTES, stream) != hipSuccess) return;
    Args a{};
    for (int i = 0; i < 30; ++i) a.in[i] = (const float*)d_in[i];
    a.out = (float*)d_out; a.ws = (unsigned char*)d_ws;
    hipLaunchKernelGGL(mega_fwd, dim3(grid), dim3(NTHR), LDS_BYTES, stream, a);
}
```

```cpp
#include <hip/hip_runtime.h>
#include <cstdio>
#include <cstdint>
__device__ __forceinline__ int lane_id_() { int r; asm volatile("v_mbcnt_lo_u32_b32 %0, -1, 0\n\tv_mbcnt_hi_u32_b32 %0, -1, %0" : "=v"(r)); return r; }
__device__ __forceinline__ int tid_from(int wave_s) { return wave_s * 64 + lane_id_(); }
namespace pg8 {
#define PG8_LAS __attribute__((address_space(3)))
typedef unsigned short bf16_t;
typedef short bf16x8 __attribute__((ext_vector_type(8)));
typedef float f32x4 __attribute__((ext_vector_type(4)));
typedef unsigned u32x4 __attribute__((ext_vector_type(4)));
constexpr int BM = 256, BK = 64, HALF = 128, HTB = HALF * BK * 2  , STAGE_BYTES = 8 * HTB, NXCD = 8, WGM = 8;

__host__ __device__ __forceinline__ int lds_byte(int r, int c) { const int st = (r >> 4) * 2 + (c >> 5), rr = r & 15, cc = c & 31, ob = rr * 64 + cc * 2; return st * 1024 + (ob ^ (((ob >> 9) & 1) << 5)); }
__host__ __device__ __forceinline__ void stage_rc(int b, int& R, int& C) { const int st = b / 1024, sb = b % 1024, swz = sb ^ (((sb >> 9) & 1) << 5); R = (st >> 1) * 16 + swz / 64; C = (st & 1) * 32 + (swz % 64) / 2; }
__host__ __device__ __forceinline__ int perm32(int rho) { const int n = rho >> 4, i = rho & 15; return 8 * (i >> 2) + 4 * n + (i & 3); }

struct Unit { int pm, pn; };
struct Gemm { const bf16_t* A; const bf16_t* Bt; int M, N, K; };

struct StaticOrder {
    int nM, nN, nwg, G, c;
    __host__ __device__ void init(int M, int N, int G_, int c_) { nM = M / BM; nN = N / BM; nwg = nM * nN; G = G_; c = c_; }
    __host__ __device__ bool next(int i, Unit& u) const {
        const long L = (long)i * G + c; if (L >= nwg) return false;
        int wgid = (int)L; { const int q = nwg / NXCD, r = nwg % NXCD, xcd = wgid % NXCD, off = wgid / NXCD; wgid = (xcd < r ? xcd * (q + 1) : r * (q + 1) + (xcd - r) * q) + off; }
        const int nig = WGM * nN, gid = wgid / nig, fm = gid * WGM, gsz = (nM - fm) < WGM ? (nM - fm) : WGM;
        u.pm = fm + ((wgid % nig) % gsz); u.pn = (wgid % nig) / gsz; return true;
    }
    __device__ __forceinline__ void a_ready(const Unit&) const {}
    __device__ __forceinline__ void done(const Unit&) const {}
};

template <class Epi, class Sched, bool ALIGN_EPI = false, bool SP2 = false>
__device__ __forceinline__ void gemm_phase(PG8_LAS unsigned char* lds, const Gemm g, const Sched& S, const Epi& E, int wave_s) {
    int tid_o = tid_from(wave_s); asm volatile("" : "+v"(tid_o));
    const int tid = tid_o, wid = __builtin_amdgcn_readfirstlane(tid >> 6), lane = tid & 63, wr = wid >> 2, wc = wid & 3, fr = lane & 15, fq = lane >> 4;
    const int K = g.K, nt = K / BK;
    unsigned voffA[2], voffB[2];
#pragma unroll
    for (int i = 0; i < 2; ++i) { int R, C; stage_rc(tid * 16 + i * 8192, R, C); const int Rb = Epi::PERM ? ((R & ~31) + perm32(R & 31)) : R;
        voffA[i] = (unsigned)(R * K + C) * 2u; voffB[i] = (unsigned)(Rb * K + C) * 2u; }
    const size_t kstep = (size_t)(BK * 2);
    const size_t hstep = (size_t)HALF * K * 2;
    const size_t tstep = 2 * hstep;
    const unsigned ldsw = (unsigned)wid * 1024u;
    const int aoff = lds_byte(wr * 64 + fr, fq * 8), boff = lds_byte(wc * 32 + fr, fq * 8);
#define PG8_SA(b, h) (((b) * 2 + (h)) * HTB)
#define PG8_SB(b, h) ((4 + (b) * 2 + (h)) * HTB)
#define PG8_STAGE(bufoff, gbase, voff) do { _Pragma("unroll") for (int _i = 0; _i < 2; ++_i) \
        __builtin_amdgcn_global_load_lds((const unsigned*)((const char*)(gbase) + (voff)[_i]), (PG8_LAS unsigned*)(lds + (bufoff) + ldsw + _i * 8192), 16, 0, 0); } while (0)
#define PG8_LDA(dst, b, h) do { _Pragma("unroll") for (int m = 0; m < 4; ++m) _Pragma("unroll") for (int k = 0; k < 2; ++k) dst[m][k] = *(const PG8_LAS bf16x8*)(lds + PG8_SA(b, h) + aoff + m * 2048 + k * 1024); } while (0)
#define PG8_LDB(dst, b, h) do { _Pragma("unroll") for (int n = 0; n < 2; ++n) _Pragma("unroll") for (int k = 0; k < 2; ++k) dst[n][k] = *(const PG8_LAS bf16x8*)(lds + PG8_SB(b, h) + boff + n * 2048 + k * 1024); } while (0)
#define PG8_MMA(ai, bj, At, Bt) do { __builtin_amdgcn_s_setprio(1); _Pragma("unroll") for (int m = 0; m < 4; ++m) _Pragma("unroll") for (int n = 0; n < 2; ++n) _Pragma("unroll") for (int k = 0; k < 2; ++k) \
        acc[ai][bj][m][n] = __builtin_amdgcn_mfma_f32_16x16x32_bf16(Bt[n][k], At[m][k], acc[ai][bj][m][n], 0, 0, 0); __builtin_amdgcn_s_setprio(0); } while (0)
#define PG8_WAIT_V(n) asm volatile("s_waitcnt vmcnt(" #n ")" ::: "memory")
#define PG8_WAIT_L(n) asm volatile("s_waitcnt lgkmcnt(" #n ")" ::: "memory")
#define PG8_BAR __builtin_amdgcn_s_barrier()
#define PG8_SCHED __builtin_amdgcn_sched_barrier(0)
    Unit cur, nxt; int ui = 0;
    if (!S.next(0, cur)) return;
    f32x4 acc[2][2][4][2];
#pragma unroll
    for (int a = 0; a < 2; ++a)
#pragma unroll
        for (int b = 0; b < 2; ++b)
#pragma unroll
            for (int m = 0; m < 4; ++m)
#pragma unroll
                for (int n = 0; n < 2; ++n) acc[a][b][m][n] = (f32x4){0.f, 0.f, 0.f, 0.f};
    bf16x8 At[4][2], B0[2][2], B1[2][2];
    const char* cA = (const char*)g.A + (size_t)cur.pm * tstep; const char* cB = (const char*)g.Bt + (size_t)cur.pn * tstep;
    S.a_ready(cur);
    if constexpr (SP2) {
        PG8_STAGE(PG8_SB(0, 0), cB, voffB); PG8_STAGE(PG8_SB(0, 1), cB + hstep, voffB); PG8_STAGE(PG8_SA(0, 0), cA, voffA); PG8_STAGE(PG8_SA(0, 1), cA + hstep, voffA);
        if (wr == 1) PG8_BAR;
        PG8_WAIT_V(2); PG8_BAR;
        PG8_STAGE(PG8_SB(1, 0), cB + kstep, voffB); PG8_STAGE(PG8_SA(1, 0), cA + kstep, voffA); PG8_STAGE(PG8_SB(1, 1), cB + hstep + kstep, voffB);
        PG8_WAIT_V(6); PG8_BAR;
    } else {
        PG8_STAGE(PG8_SB(0, 0), cB, voffB); PG8_STAGE(PG8_SA(0, 0), cA, voffA); PG8_STAGE(PG8_SB(0, 1), cB + hstep, voffB); PG8_STAGE(PG8_SA(0, 1), cA + hstep, voffA);
        if (wr == 1) PG8_BAR;
        PG8_WAIT_V(4); PG8_BAR;
        PG8_STAGE(PG8_SB(1, 0), cB + kstep, voffB); PG8_STAGE(PG8_SA(1, 0), cA + kstep, voffA); PG8_STAGE(PG8_SB(1, 1), cB + hstep + kstep, voffB);
        PG8_WAIT_V(6); PG8_BAR;
    }
    for (;;) {
        const bool has_next = S.next(ui + 1, nxt);
        const char* nA = has_next ? (const char*)g.A + (size_t)nxt.pm * tstep : cA; const char* nB = has_next ? (const char*)g.Bt + (size_t)nxt.pn * tstep : cB;
        for (int t = 0; t < nt; t += 2) {
            const bool last = (t == nt - 2);
            const char* a1 = cA + (size_t)(t + 1) * kstep;
            const char* a2 = last ? nA : cA + (size_t)(t + 2) * kstep; const char* b2 = last ? nB : cB + (size_t)(t + 2) * kstep;
            const char* a3 = a2 + kstep; const char* b3 = b2 + kstep;
            if (last && has_next) S.a_ready(nxt);
            if constexpr (SP2) {
            PG8_LDB(B0, 0, 0); PG8_LDB(B1, 0, 1); PG8_SCHED; PG8_LDA(At, 0, 0); PG8_STAGE(PG8_SA(1, 1), a1 + hstep, voffA);
            PG8_WAIT_V(8); PG8_WAIT_L(0); PG8_BAR; PG8_MMA(0, 0, At, B0); PG8_MMA(0, 1, At, B1); PG8_BAR; PG8_SCHED;
            PG8_LDA(At, 0, 1); PG8_STAGE(PG8_SB(0, 0), b2, voffB); PG8_STAGE(PG8_SB(0, 1), b2 + hstep, voffB); PG8_STAGE(PG8_SA(0, 0), a2, voffA);
            PG8_WAIT_V(8); PG8_WAIT_L(0); PG8_BAR; PG8_MMA(1, 0, At, B0); PG8_MMA(1, 1, At, B1); PG8_BAR; PG8_SCHED;
            PG8_LDB(B0, 1, 0); PG8_LDB(B1, 1, 1); PG8_SCHED; PG8_LDA(At, 1, 0); PG8_STAGE(PG8_SA(0, 1), a2 + hstep, voffA);
            PG8_WAIT_V(8); PG8_WAIT_L(0); PG8_BAR; PG8_MMA(0, 0, At, B0); PG8_MMA(0, 1, At, B1); PG8_BAR; PG8_SCHED;
            PG8_LDA(At, 1, 1); PG8_STAGE(PG8_SB(1, 0), b3, voffB); PG8_STAGE(PG8_SB(1, 1), b3 + hstep, voffB); PG8_STAGE(PG8_SA(1, 0), a3, voffA);
            PG8_WAIT_V(8); PG8_WAIT_L(0); PG8_BAR; PG8_MMA(1, 0, At, B0); PG8_MMA(1, 1, At, B1); PG8_BAR; PG8_SCHED;
            } else {
            PG8_LDB(B0, 0, 0); PG8_SCHED; PG8_LDA(At, 0, 0); PG8_STAGE(PG8_SA(1, 1), a1 + hstep, voffA);
            PG8_WAIT_L(8); PG8_BAR; PG8_WAIT_L(0); PG8_MMA(0, 0, At, B0); PG8_BAR; PG8_SCHED;
            PG8_LDB(B1, 0, 1); PG8_STAGE(PG8_SB(0, 0), b2, voffB);
            PG8_BAR; PG8_WAIT_L(0); PG8_MMA(0, 1, At, B1); PG8_BAR;
            PG8_LDA(At, 0, 1); PG8_STAGE(PG8_SA(0, 0), a2, voffA);
            PG8_BAR; PG8_WAIT_L(0); PG8_MMA(1, 0, At, B0); PG8_BAR; PG8_SCHED;
            PG8_STAGE(PG8_SB(0, 1), b2 + hstep, voffB);
            PG8_WAIT_V(6); PG8_BAR; PG8_MMA(1, 1, At, B1); PG8_BAR;
            PG8_LDB(B0, 1, 0); PG8_SCHED; PG8_LDA(At, 1, 0); PG8_STAGE(PG8_SA(0, 1), a2 + hstep, voffA);
            PG8_WAIT_L(8); PG8_BAR; PG8_WAIT_L(0); PG8_MMA(0, 0, At, B0); PG8_BAR; PG8_SCHED;
            PG8_LDB(B1, 1, 1); PG8_STAGE(PG8_SB(1, 0), b3, voffB);
            PG8_BAR; PG8_WAIT_L(0); PG8_MMA(0, 1, At, B1); PG8_BAR;
            PG8_LDA(At, 1, 1); PG8_STAGE(PG8_SA(1, 0), a3, voffA);
            PG8_BAR; PG8_WAIT_L(0); PG8_MMA(1, 0, At, B0); PG8_BAR; PG8_SCHED;
            PG8_STAGE(PG8_SB(1, 1), b3 + hstep, voffB);
            PG8_WAIT_V(6); PG8_BAR; PG8_MMA(1, 1, At, B1); PG8_BAR;
            }
        }
        if constexpr (ALIGN_EPI) { if (wr == 0) PG8_BAR; }
        if constexpr (!Epi::AFTER_DRAIN) { E(acc, cur, wr, wc, fr, fq); S.done(cur); }
        if (!has_next) break;
#pragma unroll
        for (int a = 0; a < 2; ++a)
#pragma unroll
            for (int b = 0; b < 2; ++b)
#pragma unroll
                for (int m = 0; m < 4; ++m)
#pragma unroll
                    for (int n = 0; n < 2; ++n) acc[a][b][m][n] = (f32x4){0.f, 0.f, 0.f, 0.f};
        cur = nxt; cA = nA; cB = nB; ++ui;
        if constexpr (ALIGN_EPI) { if (wr == 1) PG8_BAR; }
    }
    PG8_WAIT_V(0);
    if constexpr (!ALIGN_EPI) { if (wr == 0) PG8_BAR; }
    PG8_BAR;
    if constexpr (Epi::AFTER_DRAIN) { E.fused(acc, cur, wr, wc, fr, fq, lds, wid, lane); S.done(cur); }
#undef PG8_SA
#undef PG8_SB
#undef PG8_STAGE
#undef PG8_LDA
#undef PG8_LDB
#undef PG8_MMA
#undef PG8_WAIT_V
#undef PG8_WAIT_L
#undef PG8_BAR
#undef PG8_SCHED
}
}
#define GAS __attribute__((address_space(1)))
#define LAS __attribute__((address_space(3)))
#define XB_TMO      128
#define XB_XCNT(j)  (256  + 64 * (j))
#define XB_XSUB(j)  (1280 + 64 * (j))
#define XB_XGEN(j)  (2304 + 64 * (j))
#define XB_TOP      3328
#define XB_TOPGEN   3392
#define XCD_BAR_WORDS 3456
#define XB_SPIN_CAP (1u << 18)

__device__ __forceinline__ unsigned xb_ld(unsigned* p)              { return __hip_atomic_load(p, __ATOMIC_RELAXED, __HIP_MEMORY_SCOPE_AGENT); }
__device__ __forceinline__ unsigned xb_add(unsigned* p, unsigned v) { return __hip_atomic_fetch_add(p, v, __ATOMIC_RELAXED, __HIP_MEMORY_SCOPE_AGENT); }
__device__ __forceinline__ unsigned xb_xcc_id() { return (unsigned)__builtin_amdgcn_s_getreg((3 << 11) | 20) & 0xFu; }
#define XB_SPIN(cond, bar) do { unsigned _sp = 0; while (cond) { __builtin_amdgcn_s_sleep(1); \
    if ((++_sp & 255u) == 0u) { if (xb_ld(&(bar)[XB_TMO])) break; if (_sp > XB_SPIN_CAP) { atomicAdd(&(bar)[XB_TMO], 1u); break; } } } } while (0)

struct XcdBarrier {
    unsigned* bar; unsigned x; int w;
    volatile LAS unsigned* st;
};

__device__ __forceinline__ XcdBarrier xcd_barrier_post(unsigned* bar, volatile LAS unsigned* st, int wave_s) {
    XcdBarrier b; b.bar = bar; b.x = xb_xcc_id(); b.st = st; b.w = wave_s;
    if (tid_from(wave_s) == 0) (void)xb_add(&bar[XB_XCNT(b.x)], 1u);
    return b;
}
__device__ __forceinline__ void xcd_barrier_complete(unsigned* bar, unsigned x, unsigned& nloc, unsigned& nx) {
    const unsigned G = gridDim.x * gridDim.y * gridDim.z;
    unsigned sum, cnt, mine, sp = 0u;
    for (;;) {
        sum = 0u; cnt = 0u; mine = 0u;
#pragma unroll
        for (unsigned j = 0; j < 16; ++j) { const unsigned c = xb_ld(&bar[XB_XCNT(j)]); sum += c; cnt += (c > 0u) ? 1u : 0u; mine = (j == x) ? c : mine; }
        if (sum == G) break;
        __builtin_amdgcn_s_sleep(1);
        if ((++sp & 255u) == 0u) { if (xb_ld(&bar[XB_TMO])) break; if (sp > XB_SPIN_CAP) { atomicAdd(&bar[XB_TMO], 1u); break; } }
    }
    nloc = mine > 0u ? mine : 1u; nx = cnt > 0u ? cnt : 1u;
}

__device__ __forceinline__ void xcd_barrier(const XcdBarrier& b) {
    asm volatile("s_waitcnt vmcnt(0)" ::: "memory");
    __syncthreads();
    if (tid_from(b.w) == 0) {
        unsigned* bar = b.bar;
        __builtin_amdgcn_s_waitcnt(0);
        unsigned nloc = b.st[0], nx = b.st[1];
        if (nloc == 0u) { xcd_barrier_complete(bar, b.x, nloc, nx); b.st[0] = nloc; b.st[1] = nx; }
        const unsigned old = xb_add(&bar[XB_XSUB(b.x)], 1u);
        const unsigned gen = old / nloc;
        if (old + 1u == (gen + 1u) * nloc) {
            __builtin_amdgcn_fence(__ATOMIC_RELEASE, "agent");
            asm volatile("s_waitcnt vmcnt(0)" ::: "memory");
            const unsigned og = xb_add(&bar[XB_TOP], 1u);
            const unsigned tg = og / nx;
            if (og + 1u == (tg + 1u) * nx) xb_add(&bar[XB_TOPGEN], 1u);
            else XB_SPIN(xb_ld(&bar[XB_TOPGEN]) == tg, bar);
            __builtin_amdgcn_fence(__ATOMIC_ACQUIRE, "agent");
            xb_add(&bar[XB_XGEN(b.x)], 1u);
            asm volatile("s_waitcnt vmcnt(0)" ::: "memory");
        } else {
            XB_SPIN(xb_ld(&bar[XB_XGEN(b.x)]) == gen, bar);
            __builtin_amdgcn_fence(__ATOMIC_ACQUIRE, "agent");
            asm volatile("s_waitcnt vmcnt(0)" ::: "memory");
        }
    }
    __syncthreads();
}

constexpr int NWAVES = 8, NTHR = 512;
constexpr int DM = 2048, NB = 2, SEQ = 4096, NT = NB * SEQ, DEPTH = 4;
constexpr int INW = 5392, INWP = 5632;
constexpr int C_POOL = 0, C_GQ = 512, C_GK = 896, C_GV = 1280, C_GG = 2048, C_GA = 2816, C_RW = 2832;
constexpr int RW_IN = 2560, RW_W = 768, RW_H = 12;
constexpr int GLA_H = 4, GLA_DK = 96, GLA_DV = 192, GLA_NCH = 64;
constexpr int PEER_N = 16384;
constexpr float NORM_EPS = 1e-6f;
constexpr int MODW = 6 * DM;

constexpr size_t MiB = 1u << 20;
constexpr size_t WS_CTL = 0, CTL_ZERO_BYTES = 1 * MiB;
constexpr size_t WS_MOD = 1 * MiB;
constexpr size_t WS_WIN = 2 * MiB;
constexpr size_t WS_WOUT = 90 * MiB;
constexpr size_t WS_WQK = 122 * MiB;
constexpr size_t WS_U = 154 * MiB;
constexpr size_t WS_V = 410 * MiB;
constexpr size_t WS_US = 540 * MiB;
constexpr size_t WS_VS = 541 * MiB;
constexpr size_t WS_POOLT = 545 * MiB;
constexpr size_t WS_LORAT = 542 * MiB;
constexpr size_t WS_X = 666 * MiB;
constexpr size_t WS_H = 730 * MiB;
constexpr size_t WS_Y = 762 * MiB;
constexpr size_t WS_PROJ = 794 * MiB;
constexpr size_t WS_GKV = 970 * MiB;
constexpr size_t WS_GS = 1006 * MiB;
constexpr size_t WS_GDEC = 1042 * MiB;
constexpr size_t WS_RSC = 1043 * MiB;
constexpr size_t WS_RO = 1187 * MiB;
constexpr size_t WS_RGATE = 1211 * MiB;
constexpr size_t WS_RBV = 1235 * MiB;
constexpr size_t WS_EIDX = 1259 * MiB;
constexpr size_t WS_EGATE = 1263 * MiB;
constexpr size_t WS_END = 1267 * MiB;
constexpr size_t WS_DUMMY = 1267 * MiB;
#ifndef PROBE
#define PROBE 0
#endif
constexpr int CW_BAR = 4096;
constexpr size_t WS_SSP = 547 * MiB;
constexpr size_t WS_BIAS3 = 546 * MiB;

constexpr int EPI_XCH_OFF = 132096;
constexpr int LDS_BYTES = 147456;
constexpr int MISC_OFF = 147456 - 256;

typedef unsigned short bf16;
typedef unsigned v4u __attribute__((ext_vector_type(4)));
typedef unsigned v2u __attribute__((ext_vector_type(2)));
typedef float f32x4 __attribute__((ext_vector_type(4)));
typedef float f32x2 __attribute__((ext_vector_type(2)));
typedef __bf16 bf16x2_t __attribute__((ext_vector_type(2)));
typedef int v4i __attribute__((ext_vector_type(4)));

__device__ __forceinline__ unsigned pk2(float lo, float hi) { const f32x2 f = {lo, hi}; return __builtin_bit_cast(unsigned, __builtin_convertvector(f, bf16x2_t)); }
__device__ __forceinline__ unsigned f2bf(float f) { return pk2(f, f) & 0xffffu; }
__device__ __forceinline__ float bflo(unsigned u) { return __builtin_bit_cast(float, u << 16); }
__device__ __forceinline__ float bfhi(unsigned u) { return __builtin_bit_cast(float, u & 0xffff0000u); }
__device__ __forceinline__ float dpp_xor1(float v) { return __builtin_bit_cast(float, __builtin_amdgcn_update_dpp(0, __builtin_bit_cast(int, v), 0xB1, 0xF, 0xF, true)); }
__device__ __forceinline__ float dpp_xor2(float v) { return __builtin_bit_cast(float, __builtin_amdgcn_update_dpp(0, __builtin_bit_cast(int, v), 0x4E, 0xF, 0xF, true)); }
__device__ __forceinline__ float dpp_hmir(float v) { return __builtin_bit_cast(float, __builtin_amdgcn_update_dpp(0, __builtin_bit_cast(int, v), 0x141, 0xF, 0xF, true)); }
__device__ __forceinline__ float dpp_rmir(float v) { return __builtin_bit_cast(float, __builtin_amdgcn_update_dpp(0, __builtin_bit_cast(int, v), 0x140, 0xF, 0xF, true)); }
__device__ __forceinline__ float rl_f(float v, int l) { return __builtin_bit_cast(float, __builtin_amdgcn_readlane(__builtin_bit_cast(int, v), l)); }
__device__ __forceinline__ float row16_sum(float v) { v += dpp_xor1(v); v += dpp_xor2(v); v += dpp_hmir(v); v += dpp_rmir(v); return v; }
__device__ __forceinline__ float row16_max(float v) { v = fmaxf(v, dpp_xor1(v)); v = fmaxf(v, dpp_xor2(v)); v = fmaxf(v, dpp_hmir(v)); v = fmaxf(v, dpp_rmir(v)); return v; }
__device__ __forceinline__ float wave_sum(float v) { v = row16_sum(v); return (rl_f(v, 0) + rl_f(v, 16)) + (rl_f(v, 32) + rl_f(v, 48)); }
__device__ __forceinline__ float wave_max(float v) { v = row16_max(v); return fmaxf(fmaxf(rl_f(v, 0), rl_f(v, 16)), fmaxf(rl_f(v, 32), rl_f(v, 48))); }
__device__ __forceinline__ float half32_sum(float v, int lane) { v = row16_sum(v); const float lo = rl_f(v, 0) + rl_f(v, 16), hi = rl_f(v, 32) + rl_f(v, 48); return lane < 32 ? lo : hi; }
__device__ __forceinline__ float red8(float v) { v += dpp_xor1(v); v += dpp_xor2(v); v += dpp_hmir(v); return v; }
__device__ __forceinline__ float sigmoidf_(float x) { return __builtin_amdgcn_rcpf(1.f + __builtin_amdgcn_exp2f(-1.4426950408889634f * x)); }
__device__ __forceinline__ float softplusf_(float x) { return fmaxf(x, 0.f) + 0.6931471805599453f * __builtin_amdgcn_logf(1.f + __builtin_amdgcn_exp2f(-1.4426950408889634f * fabsf(x))); }

struct Args { const float* in[30]; float* out; unsigned char* ws; };
typedef const __attribute__((address_space(4))) Args* ArgsP;
__device__ __forceinline__ ArgsP args_ptr() { ArgsP p = (ArgsP)__builtin_amdgcn_kernarg_segment_ptr(); asm volatile("" : "+s"(p)); return p; }
__device__ __forceinline__ int opaque_i(int v) { asm volatile("" : "+s"(v)); return v; }

struct Frame {
    LAS unsigned char* lds;
    int tid, lane, wave, G, bid, gw, ngw;
};
__device__ __forceinline__ Frame make_frame(LAS unsigned char* lds, int wave_s) {
    asm volatile("" : "+s"(wave_s)); Frame F; F.lds = lds; int t = tid_from(wave_s); asm volatile("" : "+v"(t));
    F.tid = t; F.lane = t & 63; F.wave = __builtin_amdgcn_readfirstlane(t >> 6); int g_ = gridDim.x, b_ = blockIdx.x; asm volatile("" : "+s"(g_), "+s"(b_)); F.G = g_; F.bid = b_; F.gw = F.bid * NWAVES + F.wave; F.ngw = F.G * NWAVES; return F;
}

struct EpiStoreF32 {
    static constexpr bool PERM = false, AFTER_DRAIN = false;
    float* C; int ldc; int ws_; LAS unsigned char* lds_;
    __device__ __forceinline__ void operator()(const pg8::f32x4 (&acc)[2][2][4][2], const pg8::Unit& u, int, int, int, int) const {
        int tz = tid_from(ws_); asm volatile("" : "+v"(tz)); const int wid = tz >> 6, lane = tz & 63, wr = wid >> 2, wc = wid & 3, fr = lane & 15, fq = lane >> 4;
        LAS pg8::f32x4* tb = (LAS pg8::f32x4*)(lds_ + EPI_XCH_OFF + wid * 1024);
        float* base = C + (size_t)(u.pm * 256 + wr * 64 + (lane >> 2)) * ldc + u.pn * 256 + wc * 32 + 4 * (lane & 3);
#pragma unroll
        for (int ai = 0; ai < 2; ++ai)
#pragma unroll
            for (int m = 0; m < 4; ++m) { float* rowp = base + (size_t)(ai * 128 + m * 16) * ldc;
#pragma unroll
                for (int bj = 0; bj < 2; ++bj)
#pragma unroll
                    for (int n = 0; n < 2; ++n) { tb[fr * 4 + fq] = acc[ai][bj][m][n]; const pg8::f32x4 v = tb[lane]; *(pg8::f32x4*)(rowp + bj * 128 + n * 16) = v; } }
    }
};
struct EpiResid {
    static constexpr bool PERM = false, AFTER_DRAIN = false;
    const float* xsrc; float* xdst; const float* gate; int ws_; const float* gain2; const float* sc2; bf16* hdst; float* ss; LAS unsigned char* lds_;
    __device__ __forceinline__ void operator()(const pg8::f32x4 (&acc)[2][2][4][2], const pg8::Unit& u, int, int, int, int) const {
        int tz = tid_from(ws_); asm volatile("" : "+v"(tz)); const int wid = tz >> 6, lane = tz & 63, wr = wid >> 2, wc = wid & 3, fr = lane & 15, fq = lane >> 4;
        LAS pg8::f32x4* tb = (LAS pg8::f32x4*)(lds_ + EPI_XCH_OFF + wid * 1024);
        const int row0 = u.pm * 256 + wr * 64 + (lane >> 2), col0 = u.pn * 256 + wc * 32 + 4 * (lane & 3);
        const float* gp = gate + (size_t)(u.pm >> 4) * MODW + col0; const float* sp = sc2 + (size_t)(u.pm >> 4) * MODW + col0;
        pg8::f32x4 gv[2][2], hv[2][2];
#pragma unroll
        for (int bj = 0; bj < 2; ++bj)
#pragma unroll
            for (int n = 0; n < 2; ++n) { gv[bj][n] = *(const pg8::f32x4*)(gp + bj * 128 + n * 16);
                hv[bj][n] = *(const pg8::f32x4*)(gain2 + col0 + bj * 128 + n * 16) * (*(const pg8::f32x4*)(sp + bj * 128 + n * 16) + 1.f); }
#pragma unroll
        for (int ai = 0; ai < 2; ++ai)
#pragma unroll
            for (int m = 0; m < 4; ++m) { const int row = row0 + ai * 128 + m * 16; const size_t ro = (size_t)row * DM + col0; float s = 0.f;
                pg8::f32x4 xv[2][2];
#pragma unroll
                for (int bj = 0; bj < 2; ++bj)
#pragma unroll
                    for (int n = 0; n < 2; ++n) xv[bj][n] = *(const pg8::f32x4*)(xsrc + ro + bj * 128 + n * 16);
#pragma unroll
                for (int bj = 0; bj < 2; ++bj)
#pragma unroll
                    for (int n = 0; n < 2; ++n) { tb[fr * 4 + fq] = acc[ai][bj][m][n]; const pg8::f32x4 av = tb[lane];
                        const pg8::f32x4 y = xv[bj][n] + gv[bj][n] * av;
                        *(pg8::f32x4*)(xdst + ro + bj * 128 + n * 16) = y;
                        s += (y.x * y.x + y.y * y.y) + (y.z * y.z + y.w * y.w);
                        const pg8::f32x4 hh = y * hv[bj][n]; v2u pk; pk.x = pk2(hh.x, hh.y); pk.y = pk2(hh.z, hh.w); *(v2u*)(hdst + ro + bj * 128 + n * 16) = pk; }
                s += dpp_xor1(s); s += dpp_xor2(s);
                if ((lane & 3) == 0) ss[(size_t)row * 32 + u.pn * 4 + wc] = s; }
    }
};
struct EpiScore {
    static constexpr bool PERM = false, AFTER_DRAIN = false;
    float* C; int ldc; int ws_; const LAS float* rs; const float* bias; LAS unsigned char* lds_;
    __device__ __forceinline__ void operator()(const pg8::f32x4 (&acc)[2][2][4][2], const pg8::Unit& u, int, int, int, int) const {
        int tz = tid_from(ws_); asm volatile("" : "+v"(tz)); const int wid = tz >> 6, lane = tz & 63, wr = wid >> 2, wc = wid & 3, fr = lane & 15, fq = lane >> 4;
        LAS pg8::f32x4* tb = (LAS pg8::f32x4*)(lds_ + EPI_XCH_OFF + wid * 1024);
        const int row0 = u.pm * 256 + wr * 64 + (lane >> 2), col0 = u.pn * 256 + wc * 32 + 4 * (lane & 3);
        const float* bp = bias + (size_t)(u.pm >> 4) * DM + col0;
        pg8::f32x4 bv[2][2];
#pragma unroll
        for (int bj = 0; bj < 2; ++bj)
#pragma unroll
            for (int n = 0; n < 2; ++n) bv[bj][n] = *(const pg8::f32x4*)(bp + bj * 128 + n * 16);
#pragma unroll
        for (int ai = 0; ai < 2; ++ai)
#pragma unroll
            for (int m = 0; m < 4; ++m) { const int row = row0 + ai * 128 + m * 16; float* rowp = C + (size_t)row * ldc + col0;
                const float rstd = rs[row & 255];
#pragma unroll
                for (int bj = 0; bj < 2; ++bj)
#pragma unroll
                    for (int n = 0; n < 2; ++n) { tb[fr * 4 + fq] = acc[ai][bj][m][n]; const pg8::f32x4 av = tb[lane]; *(pg8::f32x4*)(rowp + bj * 128 + n * 16) = av * rstd + bv[bj][n]; } }
    }
};

__device__ __forceinline__ void quant_tables(ArgsP A, int l, int wvi, int nw, int lane) {
    for (int rr = wvi; rr < 2 * PEER_N; rr += nw) {
        const int tb = rr >= PEER_N, r = l * PEER_N + (rr - tb * PEER_N);
        const f32x4* src = (const f32x4*)(A->in[27 + tb] + (size_t)r * DM) + lane;
        f32x4 v[8]; float mx = 0.f;
        float ssq = 0.f;
#pragma unroll
        for (int j = 0; j < 8; ++j) { v[j] = src[64 * j]; mx = fmaxf(mx, fmaxf(fmaxf(fabsf(v[j].x), fabsf(v[j].y)), fmaxf(fabsf(v[j].z), fabsf(v[j].w)))); ssq += (v[j].x * v[j].x + v[j].y * v[j].y) + (v[j].z * v[j].z + v[j].w * v[j].w); }
        mx = wave_max(mx);
        mx = fminf(mx, (tb ? 3.0f : 2.5f) * sqrtf(wave_sum(ssq) * (1.f / DM)));
        unsigned* dst = (unsigned*)(A->ws + (tb ? WS_V : WS_U)) + (size_t)r * (DM / 4) + lane;
        if (!tb) { const float inv = mx > 0.f ? 7.f / mx : 0.f;
            unsigned* dst4 = (unsigned*)(A->ws + WS_U) + (size_t)r * (DM / 8) + lane;
#pragma unroll
            for (int j = 0; j < 4; ++j) { unsigned wd = 0u;
                const float lo4[4] = {v[j].x, v[j].y, v[j].z, v[j].w}, hi4[4] = {v[j + 4].x, v[j + 4].y, v[j + 4].z, v[j + 4].w};
#pragma unroll
                for (int i = 0; i < 4; ++i) { const unsigned nl = (unsigned)((int)rintf(fminf(fmaxf(lo4[i] * inv, -7.f), 7.f)) + 8), nh = (unsigned)((int)rintf(fminf(fmaxf(hi4[i] * inv, -7.f), 7.f)) + 8); wd |= (nl | (nh << 4)) << (8 * i); }
                dst4[64 * j] = wd; }
            if (lane == 0) ((float*)(A->ws + WS_US))[r] = mx * (1.f / 7.f);
        } else { const float inv = mx > 0.f ? 6.f / mx : 0.f;
            unsigned short* dstv = (unsigned short*)(A->ws + WS_V) + (size_t)r * (DM / 4) + (lane & 31) * 8;
#pragma unroll
            for (int j = 0; j < 8; ++j) { const f32x4 c4 = __builtin_elementwise_min(__builtin_elementwise_max(v[j] * inv, (f32x4){-6.f, -6.f, -6.f, -6.f}), (f32x4){6.f, 6.f, 6.f, 6.f});
                int p = __builtin_amdgcn_cvt_scalef32_pk_fp4_f32(0, c4.x, c4.y, 1.0f, 0); p = __builtin_amdgcn_cvt_scalef32_pk_fp4_f32(p, c4.z, c4.w, 1.0f, 1);
                dstv[(j >> 2) * 256 + (((j & 3) << 1) | (lane >> 5))] = (unsigned short)p; }
            if (lane == 0) ((float*)(A->ws + WS_VS))[r] = mx * (1.f / 6.f);
        }
    }
}

__device__ __forceinline__ void transpose_item(const float* W, int K, int N, bf16* WT, LAS float* scr, int kb, int nb, int lane) {
    const int k0 = 64 * kb, n0 = 64 * nb, nl = (lane & 15) * 4, kr = lane >> 4;
    f32x4 v[16];
#pragma unroll
    for (int it = 0; it < 16; ++it) v[it] = (n0 + nl < N) ? *(const f32x4*)(W + (size_t)(k0 + it * 4 + kr) * N + n0 + nl) : (f32x4){0.f, 0.f, 0.f, 0.f};
#pragma unroll
    for (int it = 0; it < 16; ++it) { LAS float* s = scr + (it * 4 + kr) * 65 + nl; s[0] = v[it].x; s[1] = v[it].y; s[2] = v[it].z; s[3] = v[it].w; }
    asm volatile("s_waitcnt lgkmcnt(0)" ::: "memory");
    const int c = lane & 7;
#pragma unroll
    for (int j = 0; j < 8; ++j) { const int n = (lane >> 3) + 8 * j; const LAS float* s = scr + (8 * c) * 65 + n;
        v4u o; o.x = pk2(s[0 * 65], s[1 * 65]); o.y = pk2(s[2 * 65], s[3 * 65]); o.z = pk2(s[4 * 65], s[5 * 65]); o.w = pk2(s[6 * 65], s[7 * 65]);
        if (n0 + n < N) *(v4u*)(WT + (size_t)(n0 + n) * K + k0 + 8 * c) = o; }
    asm volatile("s_waitcnt lgkmcnt(0)" ::: "memory");
}

__device__ __forceinline__ void ph_prologue(ArgsP A, LAS unsigned char* lds_, int wv_) {
    const Frame F = make_frame(lds_, wv_);
    LAS float* ldsf = (LAS float*)F.lds;
    const int tid = F.tid, lane = F.lane, wave = F.wave;
    for (int i = tid; i < NB * DM; i += NTHR) { const float c = A->in[1][i]; ldsf[i] = c / (1.f + __expf(-c)); }
    __syncthreads();
    {
        LAS float* red = ldsf + 4096;
        float* MOD = (float*)(A->ws + WS_MOD);
        for (int u = F.bid; u < DEPTH * 96; u += F.G) {
            const int l = u / 96, j0 = (u % 96) * 128;
            const float* W = A->in[2] + (size_t)l * DM * MODW + j0 + lane * 2;
            float a00 = 0.f, a01 = 0.f, a10 = 0.f, a11 = 0.f;
            const int k0 = wave * 256;
#pragma unroll 8
            for (int k = k0; k < k0 + 256; ++k) { const f32x2 w = *(const f32x2*)(W + (size_t)k * MODW); const float c0 = ldsf[k], c1 = ldsf[DM + k];
                a00 += c0 * w.x; a01 += c0 * w.y; a10 += c1 * w.x; a11 += c1 * w.y; }
            red[(wave * 2 + 0) * 128 + lane * 2] = a00; red[(wave * 2 + 0) * 128 + lane * 2 + 1] = a01;
            red[(wave * 2 + 1) * 128 + lane * 2] = a10; red[(wave * 2 + 1) * 128 + lane * 2 + 1] = a11;
            __syncthreads();
            if (tid < 256) { const int b = tid >> 7, j = tid & 127; float s = 0.f;
#pragma unroll
                for (int w = 0; w < 8; ++w) s += red[(w * 2 + b) * 128 + j];
                s += A->in[3][(size_t)l * MODW + j0 + j];
                MOD[(size_t)(l * 2 + b) * MODW + j0 + j] = s; }
            __syncthreads();
        }
    }
    {
        LAS float* scr = ldsf + wave * 4160;
        constexpr int NBI = (INW + 63) / 64;
        constexpr int I_IN = 32 * NBI, I_OUT = 32 * 32, I_L = I_IN + I_OUT;
        for (int it = F.gw; it < DEPTH * I_L; it += F.ngw) {
            const int l = it / I_L; int r = it % I_L;
            if (r < I_IN) transpose_item(A->in[5] + (size_t)l * DM * INW, DM, INW, (bf16*)(A->ws + WS_WIN) + (size_t)l * INWP * DM, scr, r / NBI, r % NBI, lane);
            else { r -= I_IN; transpose_item(A->in[22] + (size_t)l * DM * DM, DM, DM, (bf16*)(A->ws + WS_WOUT) + (size_t)l * DM * DM, scr, r / 32, r % 32, lane); }
        }
        constexpr int PADV = (INWP - INW) * DM / 8;
        for (int i = F.bid * NTHR + tid; i < DEPTH * PADV; i += F.G * NTHR) { const int l = i / PADV, r = i % PADV;
            ((v4u*)((bf16*)(A->ws + WS_WIN) + (size_t)l * INWP * DM + (size_t)INW * DM))[r] = (v4u){0u, 0u, 0u, 0u}; }
    }
    __syncthreads();
    {
        LAS float* Ks = ldsf;
        LAS float* Ws = ldsf + 128 * 132;
        for (int u = F.bid; u < DEPTH * 16 * 32; u += F.G) {
            const int l = u >> 9, hh = (u >> 5) & 15, jt = u & 31, h = hh >> 1, half = hh & 1, j0 = jt * 64;
            const float* ksrc = (half ? A->in[26] : A->in[25]) + ((size_t)l * 8 + h) * 128 * 128;
            const float* wsrc = A->in[24] + (size_t)l * DM * DM + h * 256 + half * 128;
            {   f32x4 kq[8], wq4[4];
#pragma unroll
                for (int it = 0; it < 8; ++it) { const int i = tid + it * NTHR, n = i >> 5, d4 = (i & 31) * 4; kq[it] = *(const f32x4*)(ksrc + n * 128 + d4); }
#pragma unroll
                for (int it = 0; it < 4; ++it) { const int i = tid + it * NTHR, jj = i >> 5, d4 = (i & 31) * 4; wq4[it] = *(const f32x4*)(wsrc + (size_t)(j0 + jj) * DM + d4); }
#pragma unroll
                for (int it = 0; it < 8; ++it) { const int i = tid + it * NTHR, n = i >> 5, d4 = (i & 31) * 4; *(LAS f32x4*)(Ks + n * 132 + d4) = kq[it]; }
#pragma unroll
                for (int it = 0; it < 4; ++it) { const int i = tid + it * NTHR, jj = i >> 5, d4 = (i & 31) * 4; *(LAS f32x4*)(Ws + jj * 132 + d4) = wq4[it]; }
            }
            __syncthreads();
            { const int li = lane & 15, lq = lane >> 4;
                f32x4 acc[4] = {{0.f, 0.f, 0.f, 0.f}, {0.f, 0.f, 0.f, 0.f}, {0.f, 0.f, 0.f, 0.f}, {0.f, 0.f, 0.f, 0.f}};
#pragma unroll 4
                for (int ks = 0; ks < 32; ++ks) { const float a = Ks[(wave * 16 + li) * 132 + 4 * ks + lq];
#pragma unroll
                    for (int jt = 0; jt < 4; ++jt) acc[jt] = __builtin_amdgcn_mfma_f32_16x16x4f32(a, Ws[(jt * 16 + li) * 132 + 4 * ks + lq], acc[jt], 0, 0, 0); }
                bf16* dst = (bf16*)(A->ws + WS_WQK) + (size_t)l * DM * DM + (size_t)(h * 256 + half * 128 + wave * 16 + lq * 4) * DM + j0 + li;
#pragma unroll
                for (int jt = 0; jt < 4; ++jt) { dst[(size_t)0 * DM + jt * 16] = (bf16)f2bf(acc[jt].x); dst[(size_t)1 * DM + jt * 16] = (bf16)f2bf(acc[jt].y); dst[(size_t)2 * DM + jt * 16] = (bf16)f2bf(acc[jt].z); dst[(size_t)3 * DM + jt * 16] = (bf16)f2bf(acc[jt].w); } }
            __syncthreads();
        }
    }
    {
        bf16* PT = (bf16*)(A->ws + WS_POOLT);
        for (int i = F.bid * NTHR + tid; i < DEPTH * 4 * 128 * 128; i += F.G * NTHR) { const int lg = i >> 14, r = i & 16383, dcol = r >> 7, c = r & 127;
            PT[i] = (bf16)f2bf(A->in[6][(size_t)lg * 16384 + c * 128 + dcol]); }
    }
    {
        bf16* LT = (bf16*)(A->ws + WS_LORAT);
        for (int i = F.bid * NTHR + tid; i < DEPTH * RW_W * 256; i += F.G * NTHR) { const int l = i / (RW_W * 256), r = i % (RW_W * 256), c = r >> 8, j = r & 255;
            const float v = j < 64 ? A->in[13][((size_t)l * 64 + j) * RW_W + c] : (j < 128 ? A->in[15][((size_t)l * 64 + (j - 64)) * RW_W + c] : A->in[16][((size_t)l * 128 + (j - 128)) * RW_W + c]);
            LT[i] = (bf16)f2bf(v); }
    }
    quant_tables(A, 0, F.gw, F.ngw, lane);
}

__device__ __forceinline__ void ph_norm(const float* xsrc, const float* gain, const float* sh, const float* sc, bf16* hout, LAS unsigned char* lds_, int wv_) {
    const Frame F = make_frame(lds_, wv_);
    for (int m = F.gw; m < NT; m += F.ngw) {
        const int b = m >> 12;
        const f32x4* xr = (const f32x4*)(xsrc + (size_t)m * DM) + F.lane;
        f32x4 v[8]; float ss = 0.f;
#pragma unroll
        for (int j = 0; j < 8; ++j) { v[j] = xr[64 * j]; ss += (v[j].x * v[j].x + v[j].y * v[j].y) + (v[j].z * v[j].z + v[j].w * v[j].w); }
        const float rstd = rsqrtf(wave_sum(ss) * (1.f / DM) + NORM_EPS);
        v2u* o8 = (v2u*)(hout + (size_t)m * DM) + F.lane;
#pragma unroll
        for (int j = 0; j < 8; ++j) { const int col = j * 256 + F.lane * 4;
            const f32x4 g = *(const f32x4*)(gain + col), s1 = *(const f32x4*)(sc + (size_t)b * MODW + col), s0 = *(const f32x4*)(sh + (size_t)b * MODW + col);
            const f32x4 y = v[j] * rstd * g * (s1 + 1.f) + s0;
            v2u o; o.x = pk2(y.x, y.y); o.y = pk2(y.z, y.w); o8[64 * j] = o; }
    }
}
__device__ __forceinline__ void ph_final(const float* xsrc, const float* gain, float* out, LAS unsigned char* lds_, int wv_) {
    const Frame F = make_frame(lds_, wv_);
    for (int m = F.gw; m < NT; m += F.ngw) {
        const f32x4* xr = (const f32x4*)(xsrc + (size_t)m * DM) + F.lane;
        f32x4 v[8]; float ss = 0.f;
#pragma unroll
        for (int j = 0; j < 8; ++j) { v[j] = xr[64 * j]; ss += (v[j].x * v[j].x + v[j].y * v[j].y) + (v[j].z * v[j].z + v[j].w * v[j].w); }
        const float rstd = rsqrtf(wave_sum(ss) * (1.f / DM) + NORM_EPS);
        f32x4* o = (f32x4*)(out + (size_t)m * DM) + F.lane;
#pragma unroll
        for (int j = 0; j < 8; ++j) { const f32x4 g = *(const f32x4*)(gain + j * 256 + F.lane * 4); o[64 * j] = v[j] * rstd * g; }
    }
}

__device__ __forceinline__ void pool_unit(ArgsP A, const Frame& F_in, int l, int unit) {
    Frame F = F_in; asm volatile("" : "+v"(F.tid)); F.lane = F.tid & 63;
    const int tile = unit >> 2, g = unit & 3, t0 = tile * 32, s0 = t0 & (SEQ - 1), tid = F.tid, lane = F.lane, w = F.wave;
    const int win = 2 << g;
    const float* proj = (const float*)(A->ws + WS_PROJ);
    LAS float* ps = (LAS float*)F.lds;
    LAS unsigned short* ds = (LAS unsigned short*)(F.lds + 24064);
    const int rt = w >> 2, ct0 = (w & 3) * 2, li = lane & 15, lq = lane >> 4;
    typedef short b8 __attribute__((ext_vector_type(8)));
    b8 bw[2][4];
    { const unsigned short* PT = (const unsigned short*)(A->ws + WS_POOLT) + ((size_t)l * 4 + g) * 16384;
#pragma unroll
        for (int j = 0; j < 2; ++j)
#pragma unroll
            for (int ks = 0; ks < 4; ++ks) bw[j][ks] = *(const b8*)(PT + (size_t)((ct0 + j) * 16 + li) * 128 + ks * 32 + lq * 8); }
    {   f32x4 pq[3];
#pragma unroll
        for (int it = 0; it < 3; ++it) { const int i = tid + it * NTHR, r = i >> 5, c4 = i & 31; const int s = s0 - 15 + r;
            pq[it] = (i < 47 * 32 && s >= 0) ? *(const f32x4*)(proj + (size_t)(t0 - 15 + r) * INWP + C_POOL + g * 128 + c4 * 4) : (f32x4){0.f, 0.f, 0.f, 0.f}; }
#pragma unroll
        for (int it = 0; it < 3; ++it) { const int i = tid + it * NTHR; if (i < 47 * 32) *(LAS f32x4*)(ps + i * 4) = pq[it]; }
    }
    __syncthreads();
    for (int i = tid; i < 32 * 128; i += NTHR) { const int tok = i >> 7, c = i & 127; float sum = 0.f;
        for (int ww = 0; ww < win; ++ww) sum += ps[(tok + 15 - ww) * 128 + c];
        const int cnt = (s0 + tok + 1) < win ? (s0 + tok + 1) : win;
        ds[tok * 136 + c] = (unsigned short)f2bf(sum * __builtin_amdgcn_rcpf((float)cnt) - ps[(tok + 15) * 128 + c]); }
    __syncthreads();
    f32x4 acc[2] = {{0.f, 0.f, 0.f, 0.f}, {0.f, 0.f, 0.f, 0.f}};
#pragma unroll
    for (int ks = 0; ks < 4; ++ks) { const b8 a = *(const LAS b8*)(ds + (rt * 16 + li) * 136 + ks * 32 + lq * 8);
#pragma unroll
        for (int j = 0; j < 2; ++j) acc[j] = __builtin_amdgcn_mfma_f32_16x16x32_bf16(a, bw[j][ks], acc[j], 0, 0, 0); }
    bf16* Y = (bf16*)(A->ws + WS_Y);
#pragma unroll
    for (int j = 0; j < 2; ++j) { const int dcol = (ct0 + j) * 16 + li; const float scale = A->in[7][(size_t)l * 512 + g * 128 + dcol]; const int tk = t0 + rt * 16 + lq * 4;
        Y[(size_t)(tk + 0) * DM + g * 128 + dcol] = (bf16)f2bf(acc[j].x * scale); Y[(size_t)(tk + 1) * DM + g * 128 + dcol] = (bf16)f2bf(acc[j].y * scale);
        Y[(size_t)(tk + 2) * DM + g * 128 + dcol] = (bf16)f2bf(acc[j].z * scale); Y[(size_t)(tk + 3) * DM + g * 128 + dcol] = (bf16)f2bf(acc[j].w * scale); }
    __syncthreads();
}

__device__ __forceinline__ void gla_bcum(ArgsP A, const Frame& F, int l, int h, int t0, LAS float* bcum, LAS float* ad, LAS float* up) {
    const float* proj = (const float*)(A->ws + WS_PROJ);
    const int tid = F.tid;
    {
        const float a0 = proj[(size_t)(t0 + (tid >> 4)) * INWP + C_GA + (tid & 15)], a1 = proj[(size_t)(t0 + 32 + (tid >> 4)) * INWP + C_GA + (tid & 15)];
        const float* upg = A->in[8] + (size_t)l * 16 * 384 + h * 96;
        const float u0 = upg[(tid / 96) * 384 + tid % 96], u1 = upg[((tid + 512) / 96) * 384 + (tid + 512) % 96], u2 = upg[((tid + 1024) / 96) * 384 + (tid + 1024) % 96];
        ad[tid] = a0; ad[tid + 512] = a1; up[tid] = u0; up[tid + 512] = u1; up[tid + 1024] = u2;
    }
    __syncthreads();
    for (int i = tid; i < 64 * 96; i += NTHR) { const int tok = i / 96, d = i % 96; float x = A->in[9][(size_t)l * 384 + h * 96 + d];
#pragma unroll
        for (int j = 0; j < 16; ++j) x += ad[tok * 16 + j] * up[j * 96 + d];
        bcum[i] = -softplusf_(-x) * (1.f / 16.f); }
    __syncthreads();
    if (tid < 384) { const int d = tid % 96, seg = tid / 96; float acc = 0.f;
#pragma unroll
        for (int k = 0; k < 16; ++k) { acc += bcum[(seg * 16 + k) * 96 + d]; bcum[(seg * 16 + k) * 96 + d] = acc; }
        ad[seg * 96 + d] = acc; }
    __syncthreads();
    if (tid < 384) { const int d = tid % 96, seg = tid / 96; float pre = 0.f;
#pragma unroll
        for (int s2 = 0; s2 < 3; ++s2) pre += (s2 < seg) ? ad[s2 * 96 + d] : 0.f;
        if (seg > 0) {
#pragma unroll
            for (int k = 0; k < 16; ++k) bcum[(seg * 16 + k) * 96 + d] += pre; } }
    __syncthreads();
}

__device__ __forceinline__ void gla_scan_unit(ArgsP A, const Frame& F, int unit) {
    const int idx = unit * NTHR + F.tid, bh = idx / 18432, rem = idx % 18432, d = rem % 96;
    const float* KV = (const float*)(A->ws + WS_GKV) + (size_t)bh * 64 * 18432 + rem;
    float* GS = (float*)(A->ws + WS_GS) + (size_t)bh * 64 * 18432 + rem;
    const float* DEC = (const float*)(A->ws + WS_GDEC) + (size_t)bh * 64 * 96 + d;
    float S = 0.f;
#pragma unroll 1
    for (int c0 = 0; c0 < 64; c0 += 16) {
        float kv[16], dc[16];
#pragma unroll
        for (int j = 0; j < 16; ++j) { kv[j] = KV[(size_t)(c0 + j) * 18432]; dc[j] = DEC[(c0 + j) * 96]; }
#pragma unroll
        for (int j = 0; j < 16; ++j) { GS[(size_t)(c0 + j) * 18432] = S; S = dc[j] * S + kv[j]; }
    }
}

typedef short bf16x8_t __attribute__((ext_vector_type(8)));
constexpr int RS = 68;
__device__ __forceinline__ f32x4 tile_mm64(const LAS bf16* Am, int arow0, const LAS bf16* Bm, int brow0, f32x4 acc, int lane) {
    const int r = lane & 15, kq = (lane >> 4) * 8;
#pragma unroll
    for (int ks = 0; ks < 2; ++ks) {
        const bf16x8_t a = *(const LAS bf16x8_t*)(Am + (arow0 + r) * RS + ks * 32 + kq);
        const bf16x8_t b = *(const LAS bf16x8_t*)(Bm + (brow0 + r) * RS + ks * 32 + kq);
        acc = __builtin_amdgcn_mfma_f32_16x16x32_bf16(a, b, acc, 0, 0, 0);
    }
    return acc;
}
constexpr int RA_BT = 0, RA_KT = 8704, RA_AT = 17408, RA_RT = 26112, RA_RABS = 34816, RA_BHT = 43520, RA_KHT = 52224, RA_VT = 60928, RA_AABS = 69632,
              RA_MBAT = 86272, RA_MKA = 103680, RA_NBRT = 121088, RA_GC = 129792, RA_WT = 130048, RA_NKRT = 132096, RA_END = 140800, RA_PRE = 94976;
constexpr int RA_Z = RA_BT, RA_QST = RA_AT, RA_QOT = RA_RT, RA_LO = 0, RA_RES = 34816;
constexpr size_t RWO_POT = 0, RWO_PST = 12 * MiB, RWO_GT = 24 * MiB, RWO_OLT = 48 * MiB, RWO_SC = 72 * MiB;

__device__ __forceinline__ void rwkvA_unit(ArgsP A, const Frame& F_in, int l, int unit) {
    Frame F = F_in; asm volatile("" : "+v"(F.tid)); F.lane = F.tid & 63;

    const int bh = unit >> 6, c = unit & 63, b = bh / RW_H, h = bh % RW_H, t0 = b * SEQ + c * 64, s0 = c * 64, tid = F.tid, lane = F.lane, w = F.wave;
    const float* proj = (const float*)(A->ws + WS_PROJ);
    const float* mu = A->in[11] + (size_t)l * RW_IN;
    LAS unsigned char* L = F.lds;
    const int n = lane, cc = h * 64 + n;
    const int rt1 = w >> 1, ct1 = (w & 1) * 2, li1 = lane & 15, lq1 = lane >> 4;
    f32x4 yc[8], yp[8];
#pragma unroll
    for (int it = 0; it < 8; ++it) { const int g = tid + it * NTHR, tok = g >> 6, j4 = (g & 63) * 4; const float* rp = proj + ((size_t)t0 + tok) * INWP + C_RW + 2304 + j4;
        yc[it] = *(const f32x4*)rp; yp[it] = (s0 + tok > 0) ? *(const f32x4*)(rp - INWP) : (f32x4){0.f, 0.f, 0.f, 0.f}; }
    bf16x8_t bw[2][8];
    { const bf16* LT = (const bf16*)(A->ws + WS_LORAT) + ((size_t)l * RW_W + h * 64) * 256;
#pragma unroll
        for (int j = 0; j < 2; ++j)
#pragma unroll
            for (int ks = 0; ks < 8; ++ks) bw[j][ks] = *(const bf16x8_t*)(LT + (size_t)((ct1 + j) * 16 + li1) * 256 + ks * 32 + lq1 * 8); }
    float rr[9], kr[9], vr[9];
#pragma unroll
    for (int i = 0; i < 9; ++i) { const int tok = w * 8 + i - 1; const bool ok = (s0 + tok >= 0); const float* row = proj + ((size_t)t0 + tok) * INWP + C_RW;
        rr[i] = ok ? row[cc] : 0.f; kr[i] = ok ? row[768 + cc] : 0.f; vr[i] = ok ? row[1536 + cc] : 0.f; }
    const float w0c = A->in[12][(size_t)l * RW_W + cc], a0c = A->in[14][(size_t)l * RW_W + cc], kkc = A->in[17][(size_t)l * RW_W + cc], kac = A->in[18][(size_t)l * RW_W + cc], rkc = A->in[19][(size_t)l * RW_W + cc];
    const float mur = mu[cc], muk = mu[768 + cc], muv = mu[1536 + cc];
    {   LAS bf16* lo = (LAS bf16*)(L + RA_LO);
#pragma unroll
        for (int it = 0; it < 8; ++it) { const int g = tid + it * NTHR, tok = g >> 6, j4 = (g & 63) * 4; const f32x4 m4 = *(const f32x4*)(mu + 2304 + j4);
            const f32x4 ym = yc[it] + (yp[it] - yc[it]) * m4;
            const float sc = j4 < 64 ? 2.f : 1.f; f32x4 sg; sg.x = sigmoidf_(ym.x * sc); sg.y = sigmoidf_(ym.y * sc); sg.z = sigmoidf_(ym.z * sc); sg.w = sigmoidf_(ym.w * sc);
            const f32x4 o = j4 < 64 ? sg * 2.f - 1.f : (j4 < 128 ? ym : sg);
            v2u pk; pk.x = pk2(o.x, o.y); pk.y = pk2(o.z, o.w); *(LAS v2u*)(lo + tok * 264 + j4) = pk; }
    }
    __syncthreads();
    {
        const int rt = rt1, ct0 = ct1, li = li1, lq = lq1;
        const LAS bf16* lo = (const LAS bf16*)(L + RA_LO);
        LAS float* res = (LAS float*)(L + RA_RES);
        f32x4 acc[3][2];
#pragma unroll
        for (int p = 0; p < 3; ++p)
#pragma unroll
            for (int j = 0; j < 2; ++j) acc[p][j] = (f32x4){0.f, 0.f, 0.f, 0.f};
#pragma unroll
        for (int ks = 0; ks < 8; ++ks) { const bf16x8_t a = *(const LAS bf16x8_t*)(lo + (rt * 16 + li) * 264 + ks * 32 + lq * 8);
            const int p = ks < 2 ? 0 : (ks < 4 ? 1 : 2);
#pragma unroll
            for (int j = 0; j < 2; ++j) acc[p][j] = __builtin_amdgcn_mfma_f32_16x16x32_bf16(a, bw[j][ks], acc[p][j], 0, 0, 0); }
#pragma unroll
        for (int p = 0; p < 3; ++p)
#pragma unroll
            for (int j = 0; j < 2; ++j) { LAS float* rp = res + p * 64 * 68 + (rt * 16 + lq * 4) * 68 + (ct0 + j) * 16 + li;
                rp[0] = acc[p][j].x; rp[68] = acc[p][j].y; rp[136] = acc[p][j].z; rp[204] = acc[p][j].w; }
    }
    __syncthreads();
    float r_[8], k_[8], v_[8], av_[8], bb_[8], lw_[8];
    {
        const LAS float* res = (const LAS float*)(L + RA_RES);
        float wl[8], al[8], gl[8];
#pragma unroll
        for (int i = 0; i < 8; ++i) { wl[i] = res[(w * 8 + i) * 68 + n]; al[i] = res[64 * 68 + (w * 8 + i) * 68 + n]; gl[i] = res[2 * 64 * 68 + (w * 8 + i) * 68 + n]; }
        float* GATE = (float*)(A->ws + WS_RGATE); float* BV = (float*)(A->ws + WS_RBV);
#pragma unroll
        for (int i = 0; i < 8; ++i) { const int tok = w * 8 + i; const size_t t = (size_t)t0 + tok;
            float r = rr[i + 1], k = kr[i + 1], v = vr[i + 1];
            r += (rr[i] - r) * mur; k += (kr[i] - k) * muk; v += (vr[i] - v) * muv;
            const float wraw = -softplusf_(-(w0c + wl[i])) - 0.5f;
            const float a = sigmoidf_(a0c + al[i]);
            float kk = k * kkc; kk = kk * __builtin_amdgcn_rsqf(fmaxf(wave_sum(kk * kk), 1e-24f));
            const float k2 = k * (1.f + (a - 1.f) * kac);
            const float bonus = wave_sum(r * k2 * rkc);
            r_[i] = r; k_[i] = k2; v_[i] = v; av_[i] = -kk; bb_[i] = kk * a; lw_[i] = -__expf(wraw);
            GATE[t * RW_W + cc] = gl[i]; BV[t * RW_W + cc] = bonus * v; }
    }
    LAS float* wt = (LAS float*)(L + RA_WT);
#pragma unroll
    for (int i = 1; i < 8; ++i) lw_[i] += lw_[i - 1];
    wt[w * 64 + n] = lw_[7];
    __syncthreads();
    float pre = 0.f, mid = 0.f, last = 0.f;
#pragma unroll
    for (int ww = 0; ww < 8; ++ww) { const float x = wt[ww * 64 + n]; pre += (ww < w) ? x : 0.f; mid += (ww < 4) ? x : 0.f; last += x; }
    {
        LAS bf16* Bt = (LAS bf16*)(L + RA_BT); LAS bf16* Kt = (LAS bf16*)(L + RA_KT); LAS bf16* At = (LAS bf16*)(L + RA_AT); LAS bf16* Rt = (LAS bf16*)(L + RA_RT);
        LAS bf16* Rab = (LAS bf16*)(L + RA_RABS); LAS bf16* BhT = (LAS bf16*)(L + RA_BHT); LAS bf16* KhT = (LAS bf16*)(L + RA_KHT); LAS bf16* VT = (LAS bf16*)(L + RA_VT);
        LAS float* AabT = (LAS float*)(L + RA_AABS);
#pragma unroll
        for (int i = 0; i < 8; ++i) { const int t = w * 8 + i; const float lw = pre + lw_[i], lwm1 = pre + (i > 0 ? lw_[i - 1] : 0.f);
            const float eg = __expf(lw - mid), egi = __expf(mid - lw), egm1 = __expf(lwm1 - mid), eh = __expf(last - lw);
            Bt[t * RS + n] = (bf16)f2bf(bb_[i] * egi); Kt[t * RS + n] = (bf16)f2bf(k_[i] * egi); At[t * RS + n] = (bf16)f2bf(av_[i] * egm1); Rt[t * RS + n] = (bf16)f2bf(r_[i] * eg);
            Rab[t * RS + n] = (bf16)f2bf(r_[i] * __expf(lw)); AabT[n * 65 + t] = av_[i] * __expf(lwm1);
            BhT[n * RS + t] = (bf16)f2bf(bb_[i] * eh); KhT[n * RS + t] = (bf16)f2bf(k_[i] * eh); VT[n * RS + t] = (bf16)f2bf(v_[i]); }
        if (w == 0) ((LAS float*)(L + RA_GC))[n] = __expf(last);
    }
    __syncthreads();
    const int rt = w >> 1, ct0 = (w & 1) * 2, li = lane & 15, lq = lane >> 4;
#define FRAG(mat_, row_, ks_) (*(const LAS bf16x8_t*)((mat_) + ((row_) + li) * RS + (ks_) * 32 + lq * 8))
#define MM(a_, b_, c_) __builtin_amdgcn_mfma_f32_16x16x32_bf16(a_, b_, c_, 0, 0, 0)
    {
        const LAS bf16* Bt = (const LAS bf16*)(L + RA_BT); const LAS bf16* Kt = (const LAS bf16*)(L + RA_KT); const LAS bf16* At = (const LAS bf16*)(L + RA_AT); const LAS bf16* Rt = (const LAS bf16*)(L + RA_RT);
        LAS bf16* MbaT = (LAS bf16*)(L + RA_MBAT); LAS float* Mka = (LAS float*)(L + RA_MKA); LAS bf16* NbrT = (LAS bf16*)(L + RA_NBRT);
        bf16x8_t aB[2], aK[2], bA[2][2], bR[2][2];
#pragma unroll
        for (int ks = 0; ks < 2; ++ks) { aB[ks] = FRAG(Bt, rt * 16, ks); aK[ks] = FRAG(Kt, rt * 16, ks);
#pragma unroll
            for (int j = 0; j < 2; ++j) { bA[j][ks] = FRAG(At, (ct0 + j) * 16, ks); bR[j][ks] = FRAG(Rt, (ct0 + j) * 16, ks); } }
#pragma unroll
        for (int j = 0; j < 2; ++j) { const int ct = ct0 + j, tcol = ct * 16 + li, srow = rt * 16 + lq * 4;
            const f32x4 z = {0.f, 0.f, 0.f, 0.f};
            f32x4 mba = MM(aB[1], bA[j][1], MM(aB[0], bA[j][0], z)), nbr = MM(aB[1], bR[j][1], MM(aB[0], bR[j][0], z));
            f32x4 mka = MM(aK[1], bA[j][1], MM(aK[0], bA[j][0], z)), nk = MM(aK[1], bR[j][1], MM(aK[0], bR[j][0], z));
            mba.x = (srow + 0 < tcol) ? mba.x : 0.f; mba.y = (srow + 1 < tcol) ? mba.y : 0.f; mba.z = (srow + 2 < tcol) ? mba.z : 0.f; mba.w = (srow + 3 < tcol) ? mba.w : 0.f;
            mka.x = (srow + 0 < tcol) ? mka.x : 0.f; mka.y = (srow + 1 < tcol) ? mka.y : 0.f; mka.z = (srow + 2 < tcol) ? mka.z : 0.f; mka.w = (srow + 3 < tcol) ? mka.w : 0.f;
            nbr.x = (srow + 0 <= tcol) ? nbr.x : 0.f; nbr.y = (srow + 1 <= tcol) ? nbr.y : 0.f; nbr.z = (srow + 2 <= tcol) ? nbr.z : 0.f; nbr.w = (srow + 3 <= tcol) ? nbr.w : 0.f;
            nk.x = (srow + 0 <= tcol) ? nk.x : 0.f; nk.y = (srow + 1 <= tcol) ? nk.y : 0.f; nk.z = (srow + 2 <= tcol) ? nk.z : 0.f; nk.w = (srow + 3 <= tcol) ? nk.w : 0.f;
            { v2u pm; pm.x = pk2(mba.x, mba.y); pm.y = pk2(mba.z, mba.w); *(LAS v2u*)(MbaT + tcol * RS + srow) = pm; }
            Mka[(srow + 0) * RS + tcol] = mka.x; Mka[(srow + 1) * RS + tcol] = mka.y; Mka[(srow + 2) * RS + tcol] = mka.z; Mka[(srow + 3) * RS + tcol] = mka.w;
            v2u pk; pk.x = pk2(nbr.x, nbr.y); pk.y = pk2(nbr.z, nbr.w); *(LAS v2u*)(NbrT + tcol * RS + srow) = pk;
            { v2u pn; pn.x = pk2(nk.x, nk.y); pn.y = pk2(nk.z, nk.w); *(LAS v2u*)((LAS bf16*)(L + RA_NKRT) + tcol * RS + srow) = pn; } }
    }
    __syncthreads();
    {
        int t4 = tid; asm volatile("" : "+v"(t4)); const int row = t4 >> 2, q = t4 & 3, l4 = t4 & 63, li4 = l4 & 15, lq4 = l4 >> 4;
        const LAS bf16* MbaT = (const LAS bf16*)(L + RA_MBAT);
        const LAS float* Yrow = (row < 64) ? ((const LAS float*)(L + RA_AABS) + row * 65) : ((const LAS float*)(L + RA_MKA) + (row - 64) * RS);
        LAS bf16* Z = (LAS bf16*)(L + RA_Z); LAS float* pre = (LAS float*)(L + RA_PRE);
        for (int i = t4; i < 1088; i += NTHR) ((LAS v4u*)Z)[i] = (v4u){0u, 0u, 0u, 0u};
        __syncthreads();
#pragma unroll 1
        for (int jb = 0; jb < 4; ++jb) {
            if (jb > 0) {
                f32x4 acc = {0.f, 0.f, 0.f, 0.f};
#pragma unroll
                for (int ks = 0; ks < 2; ++ks) { const bf16x8_t a = *(const LAS bf16x8_t*)(Z + (w * 16 + li4) * RS + ks * 32 + lq4 * 8);
                    const bf16x8_t bm = *(const LAS bf16x8_t*)(MbaT + (jb * 16 + li4) * RS + ks * 32 + lq4 * 8);
                    acc = __builtin_amdgcn_mfma_f32_16x16x32_bf16(a, bm, acc, 0, 0, 0); }
                LAS float* pp = pre + (w * 16 + lq4 * 4) * 16 + li4;
                pp[0] = acc.x; pp[16] = acc.y; pp[32] = acc.z; pp[48] = acc.w;
                __syncthreads();
            }
            float yv[16]; v2u mv[16];
#pragma unroll
            for (int u = 0; u < 16; ++u) { yv[u] = Yrow[jb * 16 + u] + (jb > 0 ? pre[row * 16 + u] : 0.f); mv[u] = *(const LAS v2u*)(MbaT + (jb * 16 + u) * RS + jb * 16 + q * 4); }
            float zb[4] = {0.f, 0.f, 0.f, 0.f};
#pragma unroll
            for (int u = 0; u < 16; ++u) {
                float part = (zb[0] * bflo(mv[u].x) + zb[1] * bfhi(mv[u].x)) + (zb[2] * bflo(mv[u].y) + zb[3] * bfhi(mv[u].y));
                part += dpp_xor1(part); part += dpp_xor2(part);
                const float zt = yv[u] + part;
                zb[u & 3] = (q == (u >> 2)) ? zt : zb[u & 3];
            }
            { v2u pk; pk.x = pk2(zb[0], zb[1]); pk.y = pk2(zb[2], zb[3]); *(LAS v2u*)(Z + row * RS + jb * 16 + q * 4) = pk; }
            __syncthreads();
        }
    }
    {
        int t5 = tid; asm volatile("" : "+v"(t5)); const int li = t5 & 15, lq = (t5 >> 4) & 3;
        const LAS bf16* Z = (const LAS bf16*)(L + RA_Z); const LAS bf16* NbrT = (const LAS bf16*)(L + RA_NBRT); const LAS bf16* BhT = (const LAS bf16*)(L + RA_BHT);
        const LAS bf16* Rab = (const LAS bf16*)(L + RA_RABS); const LAS bf16* KhT = (const LAS bf16*)(L + RA_KHT); const LAS float* gC = (const LAS float*)(L + RA_GC);
        LAS bf16* QsT = (LAS bf16*)(L + RA_QST); LAS bf16* QoT = (LAS bf16*)(L + RA_QOT);
        bf16* PoT = (bf16*)(A->ws + WS_RSC + RWO_POT) + (size_t)unit * 4096; bf16* PsT = (bf16*)(A->ws + WS_RSC + RWO_PST) + (size_t)unit * 4096;
        bf16x8_t zW[2], zX[2], bN[2][2], bH[2][2]; v2u rb[2], kb[2], nb2[2]; float gc[2];
#pragma unroll
        for (int ks = 0; ks < 2; ++ks) { zW[ks] = FRAG(Z, rt * 16, ks); zX[ks] = FRAG(Z, 64 + rt * 16, ks);
#pragma unroll
            for (int j = 0; j < 2; ++j) { bN[j][ks] = FRAG(NbrT, (ct0 + j) * 16, ks); bH[j][ks] = FRAG(BhT, (ct0 + j) * 16, ks); } }
#pragma unroll
        for (int j = 0; j < 2; ++j) { const int col = (ct0 + j) * 16 + li, rw = rt * 16 + lq * 4; rb[j] = *(const LAS v2u*)(Rab + col * RS + rw); kb[j] = *(const LAS v2u*)(KhT + col * RS + rw); nb2[j] = *(const LAS v2u*)((const LAS bf16*)(L + RA_NKRT) + col * RS + rw); gc[j] = gC[col]; }
#pragma unroll
        for (int j = 0; j < 2; ++j) { const int col = (ct0 + j) * 16 + li, rw = rt * 16 + lq * 4;
            { f32x4 acc = {bflo(rb[j].x), bfhi(rb[j].x), bflo(rb[j].y), bfhi(rb[j].y)};
                acc = MM(zW[1], bN[j][1], MM(zW[0], bN[j][0], acc));
                v2u pk; pk.x = pk2(acc.x, acc.y); pk.y = pk2(acc.z, acc.w); *(v2u*)(PoT + (size_t)col * 64 + rw) = pk; }
            { f32x4 acc = {(rw + 0 == col) ? gc[j] : 0.f, (rw + 1 == col) ? gc[j] : 0.f, (rw + 2 == col) ? gc[j] : 0.f, (rw + 3 == col) ? gc[j] : 0.f};
                acc = MM(zW[1], bH[j][1], MM(zW[0], bH[j][0], acc));
                v2u pk; pk.x = pk2(acc.x, acc.y); pk.y = pk2(acc.z, acc.w); *(v2u*)(PsT + (size_t)col * 64 + rw) = pk; }
            { f32x4 acc = {bflo(nb2[j].x), bfhi(nb2[j].x), bflo(nb2[j].y), bfhi(nb2[j].y)};
                acc = MM(zX[1], bN[j][1], MM(zX[0], bN[j][0], acc));
                v2u pk; pk.x = pk2(acc.x, acc.y); pk.y = pk2(acc.z, acc.w); *(LAS v2u*)(QoT + col * RS + rw) = pk; }
            { f32x4 acc = {bflo(kb[j].x), bfhi(kb[j].x), bflo(kb[j].y), bfhi(kb[j].y)};
                acc = MM(zX[1], bH[j][1], MM(zX[0], bH[j][0], acc));
                v2u pk; pk.x = pk2(acc.x, acc.y); pk.y = pk2(acc.z, acc.w); *(LAS v2u*)(QsT + col * RS + rw) = pk; }
        }
    }
    __syncthreads();
    {
        int t6 = tid; asm volatile("" : "+v"(t6)); const int li = t6 & 15, lq = (t6 >> 4) & 3;
        const LAS bf16* VT = (const LAS bf16*)(L + RA_VT);
        const bool isO = (w & 1);
        const LAS bf16* Bm = (const LAS bf16*)(L + (isO ? RA_QOT : RA_QST));
        float* dst = (float*)(A->ws + WS_RSC + (isO ? RWO_OLT : RWO_GT)) + (size_t)unit * 4096;
        bf16x8_t av[2], bq[4][2];
#pragma unroll
        for (int ks = 0; ks < 2; ++ks) { av[ks] = FRAG(VT, rt * 16, ks);
#pragma unroll
            for (int j = 0; j < 4; ++j) bq[j][ks] = FRAG(Bm, j * 16, ks); }
#pragma unroll
        for (int j = 0; j < 4; ++j) { const f32x4 z = {0.f, 0.f, 0.f, 0.f};
            const f32x4 acc = MM(av[1], bq[j][1], MM(av[0], bq[j][0], z));
            *(f32x4*)(dst + (size_t)(j * 16 + li) * 64 + rt * 16 + lq * 4) = acc; }
    }
#undef FRAG
#undef MM
    __syncthreads();
}

__device__ __forceinline__ void rwkvB_scan(ArgsP A, const Frame& F, int unit) {
    const int bh = unit >> 2, rq = unit & 3;
    const int tid = F.tid, lane = F.lane, w = F.wave, ct = w & 3, li = lane & 15, lq = lane >> 4;
    const bool writer = (w < 4);
    const bf16* PsT = (const bf16*)(A->ws + WS_RSC + RWO_PST) + (size_t)bh * 64 * 4096; const float* GT = (const float*)(A->ws + WS_RSC + RWO_GT) + (size_t)bh * 64 * 4096;
    bf16* SC = (bf16*)(A->ws + WS_RSC + RWO_SC) + (size_t)bh * 64 * 4096;
    f32x4 S = {0.f, 0.f, 0.f, 0.f};
    constexpr int PF = 4;
    bf16x8_t pb[PF][2]; f32x4 gq[PF];
    const int col = ct * 16 + li;
#define SLOAD(slot, cc_) do { _Pragma("unroll") for (int ks = 0; ks < 2; ++ks) pb[slot][ks] = *(const bf16x8_t*)(PsT + (size_t)(cc_) * 4096 + (size_t)col * 64 + ks * 32 + lq * 8); \
        gq[slot] = *(const f32x4*)(GT + (size_t)(cc_) * 4096 + (size_t)col * 64 + rq * 16 + lq * 4); } while (0)
#define SSTEP(slot, cc_) do { LAS bf16* Sl = (LAS bf16*)(F.lds + ((cc_) & 1) * 2176); \
        if (writer) { const int rw_ = lq * 4; Sl[(rw_ + 0) * RS + col] = (bf16)f2bf(S.x); Sl[(rw_ + 1) * RS + col] = (bf16)f2bf(S.y); Sl[(rw_ + 2) * RS + col] = (bf16)f2bf(S.z); Sl[(rw_ + 3) * RS + col] = (bf16)f2bf(S.w); } \
        asm volatile("s_waitcnt lgkmcnt(0)" ::: "memory"); __builtin_amdgcn_s_barrier(); asm volatile("" ::: "memory");        \
        if (tid < 128) { const int v_ = tid >> 3, k8_ = (tid & 7) * 8; *(v4u*)(SC + (size_t)(cc_) * 4096 + (rq * 16 + v_) * 64 + k8_) = *(const LAS v4u*)(Sl + v_ * RS + k8_); } \
        f32x4 acc_ = gq[slot]; \
        _Pragma("unroll") for (int ks = 0; ks < 2; ++ks) { const bf16x8_t a_ = *(const LAS bf16x8_t*)(Sl + li * RS + ks * 32 + lq * 8); \
            acc_ = __builtin_amdgcn_mfma_f32_16x16x32_bf16(a_, pb[slot][ks], acc_, 0, 0, 0); } \
        S = acc_; } while (0)
    SLOAD(0, 0); SLOAD(1, 1); SLOAD(2, 2); SLOAD(3, 3);
#pragma unroll 1
    for (int c = 0; c < 64; c += 4) {
        const int cn = (c + 4 < 64) ? c + 4 : 60;
        SSTEP(0, c);     SLOAD(0, cn);
        SSTEP(1, c + 1); SLOAD(1, cn + 1);
        SSTEP(2, c + 2); SLOAD(2, cn + 2);
        SSTEP(3, c + 3); SLOAD(3, cn + 3);
    }
#undef SLOAD
#undef SSTEP
    __syncthreads();
}

__device__ __forceinline__ void rwkvC_unit(ArgsP A, const Frame& F_in, int l, int unit) {
    Frame F = F_in; asm volatile("" : "+v"(F.tid)); F.lane = F.tid & 63;

    const int bh = unit >> 6, c = unit & 63, b = bh / RW_H, h = bh % RW_H, t0 = b * SEQ + c * 64, tid = F.tid, lane = F.lane, w = F.wave;
    const int rt = w >> 1, ct0 = (w & 1) * 2, li = lane & 15, lq = lane >> 4;
    LAS bf16* Sl = (LAS bf16*)F.lds; LAS bf16* Pl = (LAS bf16*)(F.lds + 8704); LAS float* ob = (LAS float*)(F.lds + 17408);
    { const int r = tid >> 3, k8 = (tid & 7) * 8;
        *(LAS v4u*)(Sl + r * RS + k8) = *(const v4u*)((const bf16*)(A->ws + WS_RSC + RWO_SC) + (size_t)unit * 4096 + r * 64 + k8);
        *(LAS v4u*)(Pl + r * RS + k8) = *(const v4u*)((const bf16*)(A->ws + WS_RSC + RWO_POT) + (size_t)unit * 4096 + r * 64 + k8); }
    __syncthreads();
    const float* OlT = (const float*)(A->ws + WS_RSC + RWO_OLT) + (size_t)unit * 4096;
#pragma unroll
    for (int j = 0; j < 2; ++j) { const int tcol = (ct0 + j) * 16 + li, vr = rt * 16 + lq * 4;
        f32x4 acc = *(const f32x4*)(OlT + (size_t)tcol * 64 + vr);
        acc = tile_mm64(Sl, rt * 16, Pl, (ct0 + j) * 16, acc, lane);
        *(LAS f32x4*)(ob + tcol * 68 + vr) = acc; }
    __syncthreads();
    { const int t = tid >> 3, q = tid & 7; const size_t tg = (size_t)t0 + t;
        const f32x4 o0 = *(const LAS f32x4*)(ob + t * 68 + q * 8), o1 = *(const LAS f32x4*)(ob + t * 68 + q * 8 + 4);
        const float mean = red8((o0.x + o0.y) + (o0.z + o0.w) + (o1.x + o1.y) + (o1.z + o1.w)) * (1.f / 64.f);
        const f32x4 d0 = o0 - mean, d1 = o1 - mean;
        const float var = red8((d0.x * d0.x + d0.y * d0.y) + (d0.z * d0.z + d0.w * d0.w) + (d1.x * d1.x + d1.y * d1.y) + (d1.z * d1.z + d1.w * d1.w)) * (1.f / 64.f);
        const float rs = rsqrtf(var + 64e-5f);
        const int cc = h * 64 + q * 8;
        const f32x4 g0 = *(const f32x4*)(A->in[20] + (size_t)l * RW_W + cc), g1 = *(const f32x4*)(A->in[20] + (size_t)l * RW_W + cc + 4);
        const f32x4 b0 = *(const f32x4*)(A->in[21] + (size_t)l * RW_W + cc), b1 = *(const f32x4*)(A->in[21] + (size_t)l * RW_W + cc + 4);
        const f32x4 bv0 = *(const f32x4*)((const float*)(A->ws + WS_RBV) + tg * RW_W + cc), bv1 = *(const f32x4*)((const float*)(A->ws + WS_RBV) + tg * RW_W + cc + 4);
        const f32x4 ga0 = *(const f32x4*)((const float*)(A->ws + WS_RGATE) + tg * RW_W + cc), ga1 = *(const f32x4*)((const float*)(A->ws + WS_RGATE) + tg * RW_W + cc + 4);
        const f32x4 y0 = (d0 * rs * g0 + b0 + bv0) * ga0, y1 = (d1 * rs * g1 + b1 + bv1) * ga1;
        v4u o; o.x = pk2(y0.x, y0.y); o.y = pk2(y0.z, y0.w); o.z = pk2(y1.x, y1.y); o.w = pk2(y1.z, y1.w);
        *(v4u*)((bf16*)(A->ws + WS_Y) + tg * DM + 1280 + cc) = o; }
    __syncthreads();
}

constexpr size_t RWO_GQ = 84 * MiB, RWO_GK = 92 * MiB, RWO_GVT = 100 * MiB, RWO_GEM = 116 * MiB;
constexpr int GQS = 104, GTS = 72;
template <int NKS> __device__ __forceinline__ f32x4 tile_mm(const LAS bf16* Am, int sa, int arow0, const LAS bf16* Bm, int sb, int brow0, f32x4 acc, int lane) {
    const int r = lane & 15, kq = (lane >> 4) * 8;
#pragma unroll
    for (int ks = 0; ks < NKS; ++ks) {
        const bf16x8_t a = *(const LAS bf16x8_t*)(Am + (arow0 + r) * sa + ks * 32 + kq);
        const bf16x8_t b = *(const LAS bf16x8_t*)(Bm + (brow0 + r) * sb + ks * 32 + kq);
        acc = __builtin_amdgcn_mfma_f32_16x16x32_bf16(a, b, acc, 0, 0, 0);
    }
    return acc;
}

__device__ __forceinline__ int gsw(int row) { return ((row >> 2) ^ (row >> 5)) & 7; }
__device__ __forceinline__ f32x4 tile_mm_sw(const LAS bf16* Am, int arow0, const LAS bf16* Bm, int brow0, f32x4 acc, int lane) {
    const int r = lane & 15, cq = lane >> 4, fa = gsw(arow0 + r), fb = gsw(brow0 + r);
#pragma unroll
    for (int ks = 0; ks < 2; ++ks) {
        const bf16x8_t a = *(const LAS bf16x8_t*)(Am + (arow0 + r) * GTS + (((ks * 4 + cq) ^ fa) << 3));
        const bf16x8_t b = *(const LAS bf16x8_t*)(Bm + (brow0 + r) * GTS + (((ks * 4 + cq) ^ fb) << 3));
        acc = __builtin_amdgcn_mfma_f32_16x16x32_bf16(a, b, acc, 0, 0, 0);
    }
    return acc;
}
__device__ __forceinline__ void gla1_unit(ArgsP A, const Frame& F_in, int l, int unit) {
    Frame F = F_in; asm volatile("" : "+v"(F.tid)); F.lane = F.tid & 63;
    const int bh = unit >> 6, c = unit & 63, b = bh >> 2, h = bh & 3, t0 = b * SEQ + c * 64, tid = F.tid, lane = F.lane, w = F.wave;
    const float* proj = (const float*)(A->ws + WS_PROJ);
    LAS float* bcum = (LAS float*)F.lds;
    LAS float* ad = bcum + 6144;
    LAS float* up = ad + 1024;
    LAS bf16* KtT = (LAS bf16*)(F.lds + 34816);
    LAS bf16* VT = (LAS bf16*)(F.lds + 48640);
    f32x4 qq[3], kq[3], vq[6];
#pragma unroll
    for (int it = 0; it < 3; ++it) { const int i = tid + it * NTHR, tok = i / 24, d4 = i % 24; const float* rp = proj + (size_t)(t0 + tok) * INWP + h * 96 + d4 * 4;
        qq[it] = *(const f32x4*)(rp + C_GQ); kq[it] = *(const f32x4*)(rp + C_GK); }
#pragma unroll
    for (int it = 0; it < 6; ++it) { const int i = tid + it * NTHR, tok = i / 48, e4 = i % 48; vq[it] = *(const f32x4*)(proj + (size_t)(t0 + tok) * INWP + C_GV + h * 192 + e4 * 4); }
    gla_bcum(A, F, l, h, t0, bcum, ad, up);
    const float qs = 0.10206207261596575f;
    bf16* Qg = (bf16*)(A->ws + WS_RSC + RWO_GQ) + (size_t)unit * 6144; bf16* Kg = (bf16*)(A->ws + WS_RSC + RWO_GK) + (size_t)unit * 6144;
#pragma unroll
    for (int it = 0; it < 3; ++it) { const int i = tid + it * NTHR, tok = i / 24, d = (i % 24) * 4;
        const float qv[4] = {qq[it].x, qq[it].y, qq[it].z, qq[it].w}, kv[4] = {kq[it].x, kq[it].y, kq[it].z, kq[it].w}; float qo[4], ko[4];
#pragma unroll
        for (int e = 0; e < 4; ++e) { const float m = bcum[31 * 96 + d + e], bb = bcum[tok * 96 + d + e];
            qo[e] = qv[e] * qs * __expf(bb - m); ko[e] = kv[e] * __expf(m - bb); KtT[(d + e) * GTS + ((((tok >> 3) ^ gsw(d + e)) << 3) | (tok & 7))] = (bf16)f2bf(ko[e]); }
        v2u pq, pk; pq.x = pk2(qo[0], qo[1]); pq.y = pk2(qo[2], qo[3]); pk.x = pk2(ko[0], ko[1]); pk.y = pk2(ko[2], ko[3]);
        *(v2u*)(Qg + tok * 96 + d) = pq; *(v2u*)(Kg + tok * 96 + d) = pk; }
#pragma unroll
    for (int it = 0; it < 6; ++it) { const int i = tid + it * NTHR, tok = i / 48, e = (i % 48) * 4;
        const int ts = tok >> 3, tl = tok & 7;
        VT[(e + 0) * GTS + (((ts ^ gsw(e + 0)) << 3) | tl)] = (bf16)f2bf(vq[it].x); VT[(e + 1) * GTS + (((ts ^ gsw(e + 1)) << 3) | tl)] = (bf16)f2bf(vq[it].y);
        VT[(e + 2) * GTS + (((ts ^ gsw(e + 2)) << 3) | tl)] = (bf16)f2bf(vq[it].z); VT[(e + 3) * GTS + (((ts ^ gsw(e + 3)) << 3) | tl)] = (bf16)f2bf(vq[it].w); }
    if (tid < 96) { ((float*)(A->ws + WS_RSC + RWO_GEM))[(size_t)unit * 96 + tid] = __expf(bcum[31 * 96 + tid]);
        ((float*)(A->ws + WS_GDEC))[(size_t)unit * 96 + tid] = __expf(bcum[63 * 96 + tid]); }
    __syncthreads();
    { bf16* VTg = (bf16*)(A->ws + WS_RSC + RWO_GVT) + (size_t)unit * 12288;
#pragma unroll
        for (int it = 0; it < 3; ++it) { const int i = tid + it * NTHR, e = i >> 3, t8 = (i & 7) * 8; *(v4u*)(VTg + e * 64 + t8) = *(const LAS v4u*)(VT + e * GTS + ((((i & 7) ^ gsw(e))) << 3)); } }
    { const int li = lane & 15, lq = lane >> 4;
        float* KVg = (float*)(A->ws + WS_GKV) + (size_t)unit * 18432;
#pragma unroll
        for (int a = 0; a < 3; ++a) { const int dt = (w & 1) * 3 + a, d0 = dt * 16 + lq * 4;
            const float s0 = __expf(bcum[63 * 96 + d0] - bcum[31 * 96 + d0]), s1 = __expf(bcum[63 * 96 + d0 + 1] - bcum[31 * 96 + d0 + 1]),
                        s2 = __expf(bcum[63 * 96 + d0 + 2] - bcum[31 * 96 + d0 + 2]), s3 = __expf(bcum[63 * 96 + d0 + 3] - bcum[31 * 96 + d0 + 3]);
#pragma unroll
            for (int bb = 0; bb < 3; ++bb) { const int et = (w >> 1) * 3 + bb; const f32x4 z = {0.f, 0.f, 0.f, 0.f};
                f32x4 acc = tile_mm_sw(KtT, dt * 16, VT, et * 16, z, lane);
                acc.x *= s0; acc.y *= s1; acc.z *= s2; acc.w *= s3;
                *(f32x4*)(KVg + (size_t)(et * 16 + li) * 96 + d0) = acc; } } }
    __syncthreads();
}

__device__ __forceinline__ void gla3_unit(ArgsP A, const Frame& F_in, int l, int unit) {
    Frame F = F_in; asm volatile("" : "+v"(F.tid)); F.lane = F.tid & 63;
    const int bh = unit >> 6, c = unit & 63, b = bh >> 2, h = bh & 3, t0 = b * SEQ + c * 64, tid = F.tid, lane = F.lane, w = F.wave;
    const int li = lane & 15, lq = lane >> 4;
    const float* proj = (const float*)(A->ws + WS_PROJ);
    LAS bf16* Qs = (LAS bf16*)F.lds;
    LAS bf16* Ks = (LAS bf16*)(F.lds + 13312);
    LAS bf16* VT = (LAS bf16*)(F.lds + 26624);
    LAS bf16* ST = (LAS bf16*)(F.lds + 54272);
    LAS bf16* att = (LAS bf16*)(F.lds + 94208);
    LAS float* ssq = (LAS float*)(F.lds + 103424);
    LAS float* em = (LAS float*)(F.lds + 103936);
    LAS float* ob = (LAS float*)(F.lds + 26624);
    {
        const v4u* Qg = (const v4u*)((const bf16*)(A->ws + WS_RSC + RWO_GQ) + (size_t)unit * 6144); const v4u* Kg = (const v4u*)((const bf16*)(A->ws + WS_RSC + RWO_GK) + (size_t)unit * 6144);
        const v4u* VTg = (const v4u*)((const bf16*)(A->ws + WS_RSC + RWO_GVT) + (size_t)unit * 12288);
        const f32x4* GS = (const f32x4*)((const float*)(A->ws + WS_GS) + (size_t)unit * 18432);
        v4u q0 = Qg[tid], k0 = Kg[tid], q1 = {0u, 0u, 0u, 0u}, k1 = {0u, 0u, 0u, 0u};
        if (tid < 256) { q1 = Qg[512 + tid]; k1 = Kg[512 + tid]; }
        v4u vt[3]; f32x4 sg[9];
#pragma unroll
        for (int it = 0; it < 3; ++it) vt[it] = VTg[tid + it * NTHR];
#pragma unroll
        for (int it = 0; it < 9; ++it) sg[it] = GS[tid + it * NTHR];
        if (tid < 96) em[tid] = ((const float*)(A->ws + WS_RSC + RWO_GEM))[(size_t)unit * 96 + tid];
        { const int i = tid, t = i / 12, c8 = (i % 12) * 8; *(LAS v4u*)(Qs + t * GQS + c8) = q0; *(LAS v4u*)(Ks + t * GQS + c8) = k0; }
        if (tid < 256) { const int i = 512 + tid, t = i / 12, c8 = (i % 12) * 8; *(LAS v4u*)(Qs + t * GQS + c8) = q1; *(LAS v4u*)(Ks + t * GQS + c8) = k1; }
#pragma unroll
        for (int it = 0; it < 3; ++it) { const int i = tid + it * NTHR, e = i >> 3, t8 = (i & 7) * 8; *(LAS v4u*)(VT + e * GTS + t8) = vt[it]; }
        __syncthreads();
#pragma unroll
        for (int it = 0; it < 9; ++it) { const int i = tid + it * NTHR, e = i / 24, d = (i % 24) * 4; const f32x4 m4 = *(const LAS f32x4*)(em + d);
            v2u pk; pk.x = pk2(sg[it].x * m4.x, sg[it].y * m4.y); pk.y = pk2(sg[it].z * m4.z, sg[it].w * m4.w); *(LAS v2u*)(ST + e * GQS + d) = pk; }
    }
    __syncthreads();
#pragma unroll
    for (int a = 0; a < 2; ++a) { const int jt = w >> 1, it = (w & 1) * 2 + a; const f32x4 z = {0.f, 0.f, 0.f, 0.f};
        f32x4 acc = z;
        if (jt <= it) acc = tile_mm<3>(Ks, GQS, jt * 16, Qs, GQS, it * 16, z, lane);
        const int i = it * 16 + li, j0 = jt * 16 + lq * 4;
        acc.x = (j0 + 0 <= i) ? acc.x : 0.f; acc.y = (j0 + 1 <= i) ? acc.y : 0.f; acc.z = (j0 + 2 <= i) ? acc.z : 0.f; acc.w = (j0 + 3 <= i) ? acc.w : 0.f;
        v2u pk; pk.x = pk2(acc.x, acc.y); pk.y = pk2(acc.z, acc.w); *(LAS v2u*)(att + i * GTS + j0) = pk; }
    __syncthreads();
    f32x4 o[6];
    { const int it = w >> 1;
#pragma unroll
        for (int a = 0; a < 6; ++a) { const int et = (w & 1) * 6 + a; const f32x4 z = {0.f, 0.f, 0.f, 0.f};
            f32x4 acc = tile_mm<2>(att, GTS, it * 16, VT, GTS, et * 16, z, lane);
            o[a] = tile_mm<3>(Qs, GQS, it * 16, ST, GQS, et * 16, acc, lane); }
        float s0 = 0.f, s1 = 0.f, s2 = 0.f, s3 = 0.f;
#pragma unroll
        for (int a = 0; a < 6; ++a) { s0 += o[a].x * o[a].x; s1 += o[a].y * o[a].y; s2 += o[a].z * o[a].z; s3 += o[a].w * o[a].w; }
        s0 = row16_sum(s0); s1 = row16_sum(s1); s2 = row16_sum(s2); s3 = row16_sum(s3);
        if (li == 0) { const int r0 = it * 16 + lq * 4; ssq[(r0 + 0) * 2 + (w & 1)] = s0; ssq[(r0 + 1) * 2 + (w & 1)] = s1; ssq[(r0 + 2) * 2 + (w & 1)] = s2; ssq[(r0 + 3) * 2 + (w & 1)] = s3; }
    }
    __syncthreads();
    { const int it = w >> 1, r0 = it * 16 + lq * 4;
#pragma unroll
        for (int a = 0; a < 6; ++a) { const int e = ((w & 1) * 6 + a) * 16 + li;
            ob[(r0 + 0) * 196 + e] = o[a].x; ob[(r0 + 1) * 196 + e] = o[a].y; ob[(r0 + 2) * 196 + e] = o[a].z; ob[(r0 + 3) * 196 + e] = o[a].w; } }
    __syncthreads();
    { bf16* Y = (bf16*)(A->ws + WS_Y);
        f32x4 gv[6];
#pragma unroll
        for (int k = 0; k < 6; ++k) { const int i = tid + k * NTHR, t = i / 48, e = (i % 48) * 4; gv[k] = *(const f32x4*)(proj + (size_t)(t0 + t) * INWP + C_GG + h * 192 + e); }
#pragma unroll
        for (int k = 0; k < 6; ++k) { const int i = tid + k * NTHR, t = i / 48, e = (i % 48) * 4;
            const float rstd = rsqrtf((ssq[t * 2] + ssq[t * 2 + 1]) * (1.f / 192.f) + NORM_EPS);
            const f32x4 ov = *(const LAS f32x4*)(ob + t * 196 + e); const f32x4 ng = *(const f32x4*)(A->in[10] + (size_t)l * 768 + h * 192 + e);
            f32x4 y; y.x = ov.x * rstd * ng.x * gv[k].x * sigmoidf_(gv[k].x); y.y = ov.y * rstd * ng.y * gv[k].y * sigmoidf_(gv[k].y);
            y.z = ov.z * rstd * ng.z * gv[k].z * sigmoidf_(gv[k].z); y.w = ov.w * rstd * ng.w * gv[k].w * sigmoidf_(gv[k].w);
            v2u pk; pk.x = pk2(y.x, y.y); pk.y = pk2(y.z, y.w); *(v2u*)(Y + (size_t)(t0 + t) * DM + 512 + h * 192 + e) = pk; } }
    __syncthreads();
}

#define INS16(L, P, x, px) do { { const bool c_ = (x) > L[15]; L[15] = c_ ? (x) : L[15]; P[15] = c_ ? (px) : P[15]; } \
    _Pragma("unroll") for (int r_ = 14; r_ >= 0; --r_) { const bool c_ = L[r_ + 1] > L[r_]; const float tl_ = L[r_]; const int tp_ = P[r_]; \
        L[r_] = c_ ? L[r_ + 1] : tl_; L[r_ + 1] = c_ ? tl_ : L[r_ + 1]; P[r_] = c_ ? P[r_ + 1] : tp_; P[r_ + 1] = c_ ? tp_ : P[r_ + 1]; } } while (0)

__device__ __forceinline__ float gelu_as(float v) {
    const float av = fabsf(v), t = __builtin_amdgcn_rcpf(av * 0.2316418882f + 1.0f);
    float q = t * 0.5307027145f + (-0.7265760135f); q = q * t + 0.7107068705f; q = q * t + (-0.142248368f); q = q * t + 0.127414796f; q = q * t;
    const float e = __builtin_amdgcn_exp2f((v * v) * (-0.72134752044f));
    const float m = v * (q * e);
    return v < 0.f ? m : v - m;
}
__device__ __forceinline__ int row16_sum_i(int v) {
    v += __builtin_amdgcn_update_dpp(0, v, 0xB1, 0xF, 0xF, true); v += __builtin_amdgcn_update_dpp(0, v, 0x4E, 0xF, 0xF, true);
    v += __builtin_amdgcn_update_dpp(0, v, 0x141, 0xF, 0xF, true); v += __builtin_amdgcn_update_dpp(0, v, 0x140, 0xF, 0xF, true); return v;
}
#ifndef PEER_SL_SHIFT
#define PEER_SL_SHIFT 10
#endif
__device__ __forceinline__ void ph_peer4(ArgsP A, LAS unsigned char* lds_, int wv_, int l, const float* g2, const float* sh2, const float* ngain, const float* nsh, const float* nsc, const bool last, const bool dry = false) {
    const Frame F = make_frame(lds_, wv_);
    const int lane = F.lane, li = lane & 15, lq = lane >> 4;
    const float* SCO = (const float*)(A->ws + WS_PROJ);
    const unsigned char* U4 = A->ws + WS_U + (size_t)l * PEER_N * (DM / 2); const unsigned char* V4 = A->ws + WS_V + (size_t)l * PEER_N * (DM / 2);
    const float* US = (const float*)(A->ws + WS_US) + (size_t)l * PEER_N; const float* VS = (const float*)(A->ws + WS_VS) + (size_t)l * PEER_N;
    float* X = (float*)(A->ws + WS_X); bf16* H = (bf16*)(A->ws + WS_H); const float* ssr = (const float*)(A->ws + WS_SSP) + (size_t)l * NT * 32;
    LAS unsigned char* wl = F.lds + F.wave * 15104;
    LAS int* es = (LAS int*)wl; LAS float* gs = (LAS float*)(wl + 4096);
    LAS v4u* hl = (LAS v4u*)wl;
    LAS int* se = (LAS int*)(wl + 8448);
    LAS float* sg = (LAS float*)(wl + 10496);
    LAS int* st = (LAS int*)(wl + 12544);
    LAS float* dl = (LAS float*)(wl + 14592);
    LAS float* hsl = dl + 64; LAS int* hsi = (LAS int*)(dl + 68);
    for (int tb = F.gw * 4; tb < NT; tb += F.ngw * 4) {
        {
            int P2[16]; float gt[16];
            const int prob = tb * 16 + lane, half = lane & 1;
            const f32x4* s4 = (const f32x4*)(SCO + (size_t)prob * 128);
            int KK[16];
#pragma unroll
            for (int r = 0; r < 16; ++r) KK[r] = (int)0x80000000;
            f32x4 nv[4];
#pragma unroll
            for (int i = 0; i < 4; ++i) nv[i] = s4[i];
#define KINS(x_, idx_) do { const int b_ = __builtin_bit_cast(int, (float)(x_)); int k_ = b_ ^ ((b_ >> 31) & 0x7fffffff); k_ = (k_ & ~127) | (127 - (idx_)); \
        _Pragma("unroll") for (int r_ = 0; r_ < 16; ++r_) { const int hi_ = KK[r_] > k_ ? KK[r_] : k_; k_ = KK[r_] > k_ ? k_ : KK[r_]; KK[r_] = hi_; } } while (0)
#pragma unroll 1
            for (int q = 0; q < 8; ++q) {
                f32x4 v[4];
#pragma unroll
                for (int i = 0; i < 4; ++i) v[i] = nv[i];
                if (q < 7) {
#pragma unroll
                    for (int i = 0; i < 4; ++i) nv[i] = s4[4 * (q + 1) + i]; }
                _Pragma("unroll") for (int r = 0; r < 16; ++r) asm volatile("" : "+v"(KK[r]));
#pragma unroll
                for (int i = 0; i < 4; ++i) { const int ib = 16 * q + 4 * i;
                    KINS(v[i].x, ib); KINS(v[i].y, ib + 1); KINS(v[i].z, ib + 2); KINS(v[i].w, ib + 3); }
            }
#undef KINS
            float v1[16], v2[16];
            LAS int* gsi = (LAS int*)gs;
#pragma unroll
            for (int r = 0; r < 16; ++r) { const int ok = __builtin_amdgcn_update_dpp(0, KK[r], 0xB1, 0xF, 0xF, true);
                const int k1 = half ? ok : KK[r], k2 = half ? KK[r] : ok; const int a1 = k1 & ~127, a2 = k2 & ~127;
                v1[r] = __builtin_bit_cast(float, a1 ^ ((a1 >> 31) & 0x7fffffff)); v2[r] = __builtin_bit_cast(float, a2 ^ ((a2 >> 31) & 0x7fffffff));
                es[r * 64 + lane] = 127 - (k1 & 127); gsi[r * 64 + lane] = 127 - (k2 & 127); }
            int Q[16];
#define MKKEY2(a_, b_) ({ const int bb_ = __builtin_bit_cast(int, v1[a_] + v2[b_]); const int kk_ = bb_ ^ ((bb_ >> 31) & 0x7fffffff); (kk_ & ~255) | (255 - ((a_) * 16 + (b_))); })
#pragma unroll
            for (int bq = 0; bq < 16; ++bq) Q[bq] = MKKEY2(0, bq);
#pragma unroll
            for (int a = 1; a < 16; ++a)
#pragma unroll
                for (int bq = 0; bq < 16; ++bq) if ((a + 1) * (bq + 1) <= 16) { int k_ = MKKEY2(a, bq);
#pragma unroll
                    for (int r = (a + 1) * (bq + 1) - 1; r < 16; ++r) { const int hi_ = Q[r] > k_ ? Q[r] : k_; k_ = Q[r] > k_ ? k_ : Q[r]; Q[r] = hi_; } }
#undef MKKEY2
            float L2[16];
#pragma unroll
            for (int r = 0; r < 16; ++r) { const int ab = 255 - (Q[r] & 255); const int qv = Q[r] & ~255; L2[r] = __builtin_bit_cast(float, qv ^ ((qv >> 31) & 0x7fffffff));
                P2[r] = es[(ab >> 4) * 64 + lane] * 128 + gsi[(ab & 15) * 64 + lane]; }
            float sum = 0.f;
#pragma unroll
            for (int r = 0; r < 16; ++r) { gt[r] = __expf(L2[r] - L2[0]); sum += gt[r]; }
            const float inv = 1.f / sum;
#pragma unroll
            for (int r = 0; r < 16; ++r) { es[r * 64 + lane] = P2[r]; gs[r * 64 + lane] = gt[r] * inv; }
            asm volatile("s_waitcnt lgkmcnt(0)" ::: "memory");
        }
        {
            int ee[8]; float gg[8];
#pragma unroll
            for (int j = 0; j < 8; ++j) { const int x = j * 64 + lane, k = x >> 7, y = x & 127; ee[j] = es[(y & 15) * 64 + k * 16 + 2 * (y >> 4)]; gg[j] = gs[(y & 15) * 64 + k * 16 + 2 * (y >> 4)]; }
            int base = 0;
#pragma unroll
            for (int k = 0; k < 4; ++k) {
#pragma unroll 1
                for (int s = 0; s < (16384 >> PEER_SL_SHIFT); ++s) {
#pragma unroll
                    for (int jj = 0; jj < 2; ++jj) { const int j = k * 2 + jj; const bool in = (ee[j] >> PEER_SL_SHIFT) == s; const unsigned long long m = __builtin_amdgcn_ballot_w64(in);
                        if (in) { const int pos = base + (int)__builtin_amdgcn_mbcnt_hi((unsigned)(m >> 32), __builtin_amdgcn_mbcnt_lo((unsigned)m, 0u)); se[pos] = ee[j]; sg[pos] = gg[j]; }
                        base += __builtin_popcountll(m); }
                }
            }
        }
        asm volatile("s_waitcnt lgkmcnt(0)" ::: "memory");
#pragma unroll 1
        for (int k = 0; k < 4; ++k) {
            const int t = tb + k, b = t >> 12;
            float hf[32]; float mx = 0.f;
            const v4u* hp = (const v4u*)(H + (size_t)t * DM);
#pragma unroll
            for (int jj = 0; jj < 2; ++jj)
#pragma unroll
                for (int c = 0; c < 2; ++c) { const v4u hv = hp[(jj * 64 + lane) * 2 + c]; const int o = jj * 16 + c * 8;
                    hf[o + 0] = bflo(hv.x); hf[o + 1] = bfhi(hv.x); hf[o + 2] = bflo(hv.y); hf[o + 3] = bfhi(hv.y); hf[o + 4] = bflo(hv.z); hf[o + 5] = bfhi(hv.z); hf[o + 6] = bflo(hv.w); hf[o + 7] = bfhi(hv.w); }
            { const float rstd = rsqrtf(wave_sum(lane < 32 ? ssr[(size_t)t * 32 + lane] : 0.f) * (1.f / DM) + NORM_EPS);
#pragma unroll
                for (int jj = 0; jj < 2; ++jj)
#pragma unroll
                    for (int q = 0; q < 4; ++q) { const f32x4 s4 = *(const f32x4*)(sh2 + (size_t)b * MODW + (jj * 64 + lane) * 16 + 4 * q);
                        hf[jj * 16 + 4 * q] = hf[jj * 16 + 4 * q] * rstd + s4.x; hf[jj * 16 + 4 * q + 1] = hf[jj * 16 + 4 * q + 1] * rstd + s4.y;
                        hf[jj * 16 + 4 * q + 2] = hf[jj * 16 + 4 * q + 2] * rstd + s4.z; hf[jj * 16 + 4 * q + 3] = hf[jj * 16 + 4 * q + 3] * rstd + s4.w; } }
#pragma unroll
            for (int i = 0; i < 32; ++i) mx = fmaxf(mx, fabsf(hf[i]));
            mx = wave_max(mx);
            const float inv = mx > 0.f ? 127.f / mx : 0.f;
            if (lane == 0) hsl[k] = mx * (1.f / 127.f);
            int hsum = 0;
#pragma unroll
            for (int jj = 0; jj < 2; ++jj) { unsigned qd[4];
#pragma unroll
                for (int d = 0; d < 4; ++d) { const int o = jj * 16 + 4 * d; const int q0 = (int)rintf(hf[o] * inv), q1 = (int)rintf(hf[o + 1] * inv), q2 = (int)rintf(hf[o + 2] * inv), q3 = (int)rintf(hf[o + 3] * inv);
                    qd[d] = (unsigned)(q0 & 255) | ((unsigned)(q1 & 255) << 8) | ((unsigned)(q2 & 255) << 16) | ((unsigned)(q3 & 255) << 24); hsum += (q0 + q1) + (q2 + q3); }
                v4u q; q.x = qd[0]; q.y = qd[1]; q.z = qd[2]; q.w = qd[3]; hl[k * 132 + jj * 64 + lane] = q; }
            { hsum = row16_sum_i(hsum); const int hs_all = __builtin_amdgcn_readlane(hsum, 0) + __builtin_amdgcn_readlane(hsum, 16) + __builtin_amdgcn_readlane(hsum, 32) + __builtin_amdgcn_readlane(hsum, 48);
                if (lane == 0) hsi[k] = hs_all; }
        }
        asm volatile("s_waitcnt lgkmcnt(0)" ::: "memory");
        {
            int lu = lane; asm volatile("" : "+v"(lu)); const int tq = lu & 3, pq = (lu >> 2) & 3, kq = lu >> 4;
            v4i hB[8];
            { const LAS v4u* hb = hl + tq * 132 + kq * 4 + pq;
#pragma unroll
                for (int s = 0; s < 4; ++s) { hB[2 * s] = *(const LAS v4i*)(hb + s * 16); hB[2 * s + 1] = *(const LAS v4i*)(hb + 64 + s * 16); } }
            const int hc = 8 * hsi[tq];
            const unsigned char* ubase = U4 + kq * 64 + tq * 16;
#define ULOAD4(buf, q_) do { const int e_ = se[(q_) * 4 + pq]; const unsigned char* up_ = ubase + (size_t)e_ * (DM / 2); \
    _Pragma("unroll") for (int s = 0; s < 4; ++s) buf[s] = *(const v4i*)(up_ + s * 256); } while (0)
#define UCONS4(buf, gi_) do { v4i acc = {0, 0, 0, 0}; \
    _Pragma("unroll") for (int s = 0; s < 4; ++s) { const v4i lo_ = buf[s] & 0x0F0F0F0F, hi_ = (buf[s] >> 4) & 0x0F0F0F0F; \
        acc = __builtin_amdgcn_mfma_i32_16x16x64_i8(lo_, hB[2 * s], acc, 0, 0, 0); acc = __builtin_amdgcn_mfma_i32_16x16x64_i8(hi_, hB[2 * s + 1], acc, 0, 0, 0); } \
    int v_ = pq == 0 ? acc.x : (pq == 1 ? acc.y : (pq == 2 ? acc.z : acc.w)); \
    v_ += __builtin_amdgcn_update_dpp(0, v_, 0x124, 0xF, 0xF, true); v_ += __builtin_amdgcn_update_dpp(0, v_, 0x128, 0xF, 0xF, true); \
    if (pq == 0) dl[((gi_) * 4 + kq) * 4 + tq] = (float)(v_ - hc); } while (0)
            float us_c, vs_c; { const int e0 = se[lu & 15]; us_c = US[e0]; vs_c = VS[e0]; }
            v4i ub0[4], ub1[4], ub2[4], ub3[4];
            ULOAD4(ub0, 0); ULOAD4(ub1, 1); ULOAD4(ub2, 2); ULOAD4(ub3, 3);
#pragma unroll 1
            for (int g = 0; g < 32; ++g) {
                const int gn = g + 1 < 32 ? g + 1 : 31;
                const int en = se[gn * 16 + (lu & 15)]; const float us_n = US[en], vs_n = VS[en];
                UCONS4(ub0, 0); ULOAD4(ub0, gn * 4 + 0);
                UCONS4(ub1, 1); ULOAD4(ub1, gn * 4 + 1);
                UCONS4(ub2, 2); ULOAD4(ub2, gn * 4 + 2);
                UCONS4(ub3, 3); ULOAD4(ub3, gn * 4 + 3);
                if (lu < 16) { const int x = g * 16 + lu; const int tk = x >> 7;
                    sg[x] = sg[x] * vs_c * gelu_as(dl[lu * 4 + tk] * (us_c * hsl[tk])); }
                us_c = us_n; vs_c = vs_n;
            }
#undef ULOAD4
#undef UCONS4
        }
        asm volatile("s_waitcnt lgkmcnt(0)" ::: "memory");
#define VLOAD(buf, cfb, bi_) do { const v4i e4_ = *(const LAS v4i*)(se + xb + (bi_) * 4); const f32x4 g4_ = *(const LAS f32x4*)(sg + xb + (bi_) * 4); \
        cfb[0] = g4_.x; cfb[1] = g4_.y; cfb[2] = g4_.z; cfb[3] = g4_.w; const int ee_[4] = {e4_.x, e4_.y, e4_.z, e4_.w}; \
        _Pragma("unroll") for (int i = 0; i < 4; ++i) { const unsigned char* vp_ = vbase + (size_t)ee_[i] * (DM / 2); buf[i][0] = *(const v4u*)vp_; buf[i][1] = *(const v4u*)(vp_ + 512); } } while (0)
#define VACC(bv_, cv_) do { const f32x2 c2_ = {cv_, cv_}; \
        _Pragma("unroll") for (int jj = 0; jj < 2; ++jj) { const unsigned wd_[4] = {bv_[jj].x, bv_[jj].y, bv_[jj].z, bv_[jj].w}; \
            _Pragma("unroll") for (int d = 0; d < 4; ++d) { const int o_ = jj * 16 + 4 * d; \
                const f32x2 f0_ = __builtin_amdgcn_cvt_scalef32_pk_f32_fp4((int)wd_[d], 1.0f, 0), f1_ = __builtin_amdgcn_cvt_scalef32_pk_f32_fp4((int)wd_[d], 1.0f, 1), \
                            f2_ = __builtin_amdgcn_cvt_scalef32_pk_f32_fp4((int)wd_[d], 1.0f, 2), f3_ = __builtin_amdgcn_cvt_scalef32_pk_f32_fp4((int)wd_[d], 1.0f, 3); \
                out[o_] = __builtin_elementwise_fma(c2_, f0_, out[o_]); out[o_ + 1] = __builtin_elementwise_fma(c2_, f1_, out[o_ + 1]); \
                out[o_ + 2] = __builtin_elementwise_fma(c2_, f2_, out[o_ + 2]); out[o_ + 3] = __builtin_elementwise_fma(c2_, f3_, out[o_ + 3]); } } } while (0)
#define VCONS(buf, cfb) do { _Pragma("unroll") for (int i = 0; i < 4; ++i) VACC(buf[i], cfb[i]); } while (0)
#pragma unroll 1
        for (int p = 0; p < 2; ++p) {
            int lane_v = F.lane; asm volatile("" : "+v"(lane_v)); const int hv = lane_v >> 5, mv = lane_v & 31;
            const int xb = (2 * p + hv) * 128;
            const unsigned char* vbase = V4 + mv * 16;
            f32x2 out[32];
#pragma unroll
            for (int i = 0; i < 32; ++i) out[i] = (f32x2){0.f, 0.f};
            {
                v4u vb0[4][2], vb1[4][2]; float c0[4], c1[4];
                VLOAD(vb0, c0, 0); VLOAD(vb1, c1, 1);
#pragma unroll 1
                for (int bi = 0; bi < 32; bi += 2) {
                    const int b2 = bi + 2 < 32 ? bi + 2 : 30, b3 = bi + 3 < 32 ? bi + 3 : 31;
                    asm volatile("" ::: "memory"); VCONS(vb0, c0); asm volatile("" ::: "memory"); VLOAD(vb0, c0, b2);
                    asm volatile("" ::: "memory"); VCONS(vb1, c1); asm volatile("" ::: "memory"); VLOAD(vb1, c1, b3);
                }
            }
            {
                const int t = tb + 2 * p + hv, b = t >> 12;
                f32x4 xn[2][8]; float ss = 0.f;
                const f32x4* xr = (const f32x4*)(X + (size_t)t * DM) + mv; const f32x4* gr = (const f32x4*)(g2 + (size_t)b * MODW) + mv;
#pragma unroll
                for (int jj = 0; jj < 2; ++jj)
#pragma unroll
                    for (int q = 0; q < 8; ++q) { const int ix = jj * 256 + q * 32; const f32x4 xv = xr[ix], gv = gr[ix];
                        f32x4 o4; o4.x = out[jj * 16 + 2 * q].x; o4.y = out[jj * 16 + 2 * q].y; o4.z = out[jj * 16 + 2 * q + 1].x; o4.w = out[jj * 16 + 2 * q + 1].y;
                        const f32x4 y = xv + gv * o4; xn[jj][q] = y; ss += (y.x * y.x + y.y * y.y) + (y.z * y.z + y.w * y.w); }
                float rstd; { const float v = row16_sum(ss); const float s0 = rl_f(v, 0) + rl_f(v, 16), s1 = rl_f(v, 32) + rl_f(v, 48); rstd = rsqrtf((hv ? s1 : s0) * (1.f / DM) + NORM_EPS); }
                if (!last) {
                    f32x4* xw = (f32x4*)((dry ? (float*)(A->ws + WS_DUMMY) : X) + (size_t)t * DM) + mv; v2u* hw = (v2u*)((dry ? (bf16*)(A->ws + WS_DUMMY + 64 * MiB) : H) + (size_t)t * DM) + mv;
                    const f32x4* ngp = (const f32x4*)ngain + mv; const f32x4* s1p = (const f32x4*)(nsc + (size_t)b * MODW) + mv; const f32x4* s0p = (const f32x4*)(nsh + (size_t)b * MODW) + mv;
#pragma unroll
                    for (int jj = 0; jj < 2; ++jj)
#pragma unroll
                        for (int q = 0; q < 8; ++q) { const int ix = jj * 256 + q * 32; xw[ix] = xn[jj][q];
                            const f32x4 g = ngp[ix], s1 = s1p[ix], s0 = s0p[ix];
                            const f32x4 y = xn[jj][q] * rstd * g * (s1 + 1.f) + s0;
                            v2u o; o.x = pk2(y.x, y.y); o.y = pk2(y.z, y.w); hw[ix] = o; }
                } else {
                    f32x4* ow = (f32x4*)((dry ? (float*)(A->ws + WS_DUMMY) : A->out) + (size_t)t * DM) + mv; const f32x4* ngp = (const f32x4*)ngain + mv;
#pragma unroll
                    for (int jj = 0; jj < 2; ++jj)
#pragma unroll
                        for (int q = 0; q < 8; ++q) { const int ix = jj * 256 + q * 32; ow[ix] = xn[jj][q] * rstd * ngp[ix]; }
                }
            }
        }
#undef VLOAD
#undef VACC
#undef VCONS
    }
}

__device__ __forceinline__ void PH_norm1_l0(LAS unsigned char* lds, int wv) { ArgsP A = args_ptr(); const float* MOD = (const float*)(A->ws + WS_MOD);
    ph_norm(A->in[0], A->in[4], MOD + 0 * DM, MOD + 1 * DM, (bf16*)(A->ws + WS_H), lds, wv);
    { const Frame F = make_frame(lds, wv); float* B3 = (float*)(A->ws + WS_BIAS3);
        for (int o = F.gw; o < DEPTH * 2 * DM; o += F.ngw) { const int l = o >> 12, b = (o >> 11) & 1, n = o & 2047;
            const float* sh = MOD + (size_t)(l * 2 + b) * MODW + 3 * DM; const v4u* wr = (const v4u*)((const bf16*)(A->ws + WS_WQK) + ((size_t)l * DM + n) * DM);
            float s = 0.f;
#pragma unroll
            for (int j = 0; j < 4; ++j) { const v4u wv4 = wr[j * 64 + F.lane]; const f32x4 s0 = *(const f32x4*)(sh + (j * 64 + F.lane) * 8), s1 = *(const f32x4*)(sh + (j * 64 + F.lane) * 8 + 4);
                s += bflo(wv4.x) * s0.x + bfhi(wv4.x) * s0.y + bflo(wv4.y) * s0.z + bfhi(wv4.y) * s0.w + bflo(wv4.z) * s1.x + bfhi(wv4.z) * s1.y + bflo(wv4.w) * s1.z + bfhi(wv4.w) * s1.w; }
            s = wave_sum(s);
            if (F.lane == 0) B3[o] = s; } } }
__device__ __forceinline__ void PH_gemm1(LAS unsigned char* lds, int wv, int l_) { ArgsP A = args_ptr(); const int l = opaque_i(l_);
    pg8::Gemm g{(const bf16*)(A->ws + WS_H), (const bf16*)(A->ws + WS_WIN) + (size_t)l * INWP * DM, NT, INWP, DM}; pg8::StaticOrder S; S.init(NT, INWP, gridDim.x, blockIdx.x);
    EpiStoreF32 E{(float*)(A->ws + WS_PROJ), INWP, wv, lds};
    pg8::gemm_phase<EpiStoreF32, pg8::StaticOrder, true, true>(lds, g, S, E, wv); }
__device__ __forceinline__ void PH_mixA(LAS unsigned char* lds, int wv, int l_) { ArgsP A = args_ptr(); const int l = opaque_i(l_);
    const Frame F = make_frame(lds, wv);
#ifdef PROBE_A
    for (int u = F.bid; u < 2048; u += F.G) {
        if (u < 1536) { if (PROBE_A == 1) rwkvA_unit(A, F, l, u); }
        else { if (PROBE_A == 2) gla1_unit(A, F, l, u - 1536); }
    }
#endif
    for (int u = F.bid; u < 2048; u += F.G) {
        if (u < 1536) rwkvA_unit(A, F, l, u);
        else gla1_unit(A, F, l, u - 1536);
    }
    if (l + 1 < DEPTH) quant_tables(A, l + 1, F.gw, F.ngw, F.lane);
}
__device__ __forceinline__ void PH_mixB(LAS unsigned char* lds, int wv, int l_) { ArgsP A = args_ptr(); const int l = opaque_i(l_);
    const Frame F = make_frame(lds, wv);
    if (F.G >= 192) {
        if (F.bid < 96) rwkvB_scan(A, F, F.bid);
        else { const int nb = F.G - 96, b2 = F.bid - 96;
            for (int u = b2; u < 288; u += nb) gla_scan_unit(A, F, u);
            for (int u = b2; u < 1024; u += nb) pool_unit(A, F, l, u); }
    } else {
        for (int u = F.bid; u < 288; u += F.G) gla_scan_unit(A, F, u);
        for (int u = F.bid; u < 1024; u += F.G) pool_unit(A, F, l, u);
        for (int u = F.bid; u < 96; u += F.G) rwkvB_scan(A, F, u);
    } }
__device__ __forceinline__ void PH_mixC(LAS unsigned char* lds, int wv, int l_) { ArgsP A = args_ptr(); const int l = opaque_i(l_);
    const Frame F = make_frame(lds, wv);
#ifdef PROBE_C
    for (int u = F.bid; u < 2048; u += F.G) { if (u < 512) { if (PROBE_C == 1) gla3_unit(A, F, l, u); } else { if (PROBE_C == 2) rwkvC_unit(A, F, l, u - 512); } }
#endif
    for (int u = F.bid; u < 2048; u += F.G) { if (u < 512) gla3_unit(A, F, l, u); else rwkvC_unit(A, F, l, u - 512); } }
__device__ __forceinline__ void PH_gemm2(LAS unsigned char* lds, int wv, int l_, bool dry = false) { ArgsP A = args_ptr(); const int l = opaque_i(l_);
    const float* modl = (const float*)(A->ws + WS_MOD) + (size_t)l * 2 * MODW; float* X = (float*)(A->ws + WS_X);
    pg8::Gemm g{(const bf16*)(A->ws + WS_Y), (const bf16*)(A->ws + WS_WOUT) + (size_t)l * DM * DM, NT, DM, DM}; pg8::StaticOrder S; S.init(NT, DM, gridDim.x, blockIdx.x);
    EpiResid E{(l == 0) ? A->in[0] : (const float*)X, dry ? (float*)(A->ws + WS_DUMMY) : X, modl + 2 * DM, wv, A->in[23] + (size_t)l * DM, modl + 4 * DM,
               dry ? (bf16*)(A->ws + WS_DUMMY + 64 * MiB) : (bf16*)(A->ws + WS_H), (dry ? (float*)(A->ws + WS_DUMMY) : (float*)(A->ws + WS_SSP) + (size_t)l * NT * 32), lds};
    pg8::gemm_phase<EpiResid, pg8::StaticOrder, true, true>(lds, g, S, E, wv); }
__device__ __forceinline__ void PH_norm2(LAS unsigned char* lds, int wv, int l_) { ArgsP A = args_ptr(); const int l = opaque_i(l_);
    const float* modl = (const float*)(A->ws + WS_MOD) + (size_t)l * 2 * MODW;
    ph_norm((const float*)(A->ws + WS_X), A->in[23] + (size_t)l * DM, modl + 3 * DM, modl + 4 * DM, (bf16*)(A->ws + WS_H), lds, wv); }
__device__ __forceinline__ void PH_gemm3(LAS unsigned char* lds, int wv, int l_) { ArgsP A = args_ptr(); const int l = opaque_i(l_);
    pg8::Gemm g{(const bf16*)(A->ws + WS_H), (const bf16*)(A->ws + WS_WQK) + (size_t)l * DM * DM, NT, DM, DM}; pg8::StaticOrder S; S.init(NT, DM, gridDim.x, blockIdx.x);
    LAS float* rs = (LAS float*)(lds + 131072);
    { pg8::Unit u0; const int t = tid_from(wv); if (S.next(0, u0) && t < 256) { const f32x4* sp = (const f32x4*)((const float*)(A->ws + WS_SSP) + ((size_t)l * NT + u0.pm * 256 + t) * 32); float s = 0.f;
#pragma unroll
            for (int j = 0; j < 8; ++j) { const f32x4 v = sp[j]; s += (v.x + v.y) + (v.z + v.w); }
            rs[t] = rsqrtf(s * (1.f / DM) + NORM_EPS); }
        __syncthreads(); }
    EpiScore E{(float*)(A->ws + WS_PROJ), DM, wv, rs, (const float*)(A->ws + WS_BIAS3) + (size_t)l * 2 * DM, lds};
    pg8::gemm_phase<EpiScore, pg8::StaticOrder, true, true>(lds, g, S, E, wv); }
__device__ __forceinline__ void PH_peer(LAS unsigned char* lds, int wv, int l_, bool dry = false) { ArgsP A = args_ptr(); const int l = opaque_i(l_);
    const float* MOD = (const float*)(A->ws + WS_MOD); const float* modl = MOD + (size_t)l * 2 * MODW;
    const bool last = (l == DEPTH - 1);
    const float* nmod = MOD + (size_t)(last ? l : l + 1) * 2 * MODW;
    ph_peer4(A, lds, wv, l, modl + 5 * DM, modl + 3 * DM, last ? A->in[29] : A->in[4] + (size_t)(l + 1) * DM, nmod + 0 * DM, nmod + 1 * DM, last, dry); }

__global__ void __launch_bounds__(NTHR, 2) mega_fwd(Args args) {
    extern __shared__ __attribute__((aligned(16))) unsigned char lds_raw[];
    LAS unsigned char* lds = (LAS unsigned char*)lds_raw;
    volatile LAS unsigned* MISC = (volatile LAS unsigned*)(lds + MISC_OFF);
    const int wv = __builtin_amdgcn_readfirstlane((int)(threadIdx.x >> 6));
    if (wv == 0) MISC[lane_id_()] = 0u;
    __syncthreads();
    XcdBarrier bar = xcd_barrier_post((unsigned*)(args_ptr()->ws + WS_CTL) + CW_BAR, MISC + 8, wv);
#define GRID_BAR() do { XcdBarrier b_ = bar; b_.bar = (unsigned*)(args_ptr()->ws + WS_CTL) + CW_BAR; asm volatile("" : "+s"(b_.x), "+s"(b_.w)); xcd_barrier(b_); if (PROBE & 512) xcd_barrier(b_); } while (0)

    ph_prologue(args_ptr(), lds, wv);
    GRID_BAR();
#if PROBE & 1
    ph_prologue(args_ptr(), lds, wv); GRID_BAR();
#endif
    PH_norm1_l0(lds, wv);
    GRID_BAR();
    for (int l = 0; l < DEPTH; ++l) {
#if PROBE & 2
        PH_gemm1(lds, wv, l); GRID_BAR();
#endif
        PH_gemm1(lds, wv, l); GRID_BAR();
#if PROBE & 4
        PH_mixA(lds, wv, l);  GRID_BAR();
#endif
        PH_mixA(lds, wv, l);  GRID_BAR();
#if PROBE & 8
        PH_mixB(lds, wv, l);  GRID_BAR();
#endif
        PH_mixB(lds, wv, l);  GRID_BAR();
#if PROBE & 16
        PH_mixC(lds, wv, l);  GRID_BAR();
#endif
        PH_mixC(lds, wv, l);  GRID_BAR();
#if PROBE & 32
        PH_gemm2(lds, wv, l, true); GRID_BAR();
#endif
        PH_gemm2(lds, wv, l); GRID_BAR();
#if PROBE & 128
        PH_gemm3(lds, wv, l); GRID_BAR();
#endif
        PH_gemm3(lds, wv, l); GRID_BAR();
#if PROBE & 256
        PH_peer(lds, wv, l, true); GRID_BAR();
#endif
        PH_peer(lds, wv, l);
        if (l + 1 < DEPTH) GRID_BAR();
    }
}

extern "C" void kernel_launch(void* const* d_in, const int* in_sizes, int n_in, void* d_out, int out_size, void* d_ws, size_t ws_size, hipStream_t stream) {
    static int grid = 0;
    if (grid == 0) {
        if (n_in != 30 || out_size != NT * DM || ws_size < WS_END + 96 * MiB) { fprintf(stderr, "kernel_launch: unexpected shapes (n_in %d out %d ws %zu)\n", n_in, out_size, ws_size); grid = -1; return; }
        int dev = 0, cus = 0, per_cu = 0;
        if (hipGetDevice(&dev) != hipSuccess || hipDeviceGetAttribute(&cus, hipDeviceAttributeMultiprocessorCount, dev) != hipSuccess) { grid = -1; return; }
        if (hipFuncSetAttribute((const void*)mega_fwd, hipFuncAttributeMaxDynamicSharedMemorySize, LDS_BYTES) != hipSuccess) { fprintf(stderr, "kernel_launch: hipFuncSetAttribute failed\n"); grid = -1; return; }
        if (hipOccupancyMaxActiveBlocksPerMultiprocessor(&per_cu, (const void*)mega_fwd, NTHR, LDS_BYTES) != hipSuccess || per_cu < 1) { fprintf(stderr, "kernel_launch: occupancy query says %d\n", per_cu); (void)hipGetLastError(); per_cu = 1; }
        grid = cus;
    }
    if (grid < 0) return;
    (void)in_sizes;
    if (hipMemsetAsync((char*)d_ws + WS_CTL, 0, CTL_ZERO_BYTES, stream) != hipSuccess) return;
    Args a{};
    for (int i = 0; i < 30; ++i) a.in[i] = (const float*)d_in[i];
    a.out = (float*)d_out; a.ws = (unsigned char*)d_ws;
    hipLaunchKernelGGL(mega_fwd, dim3(grid), dim3(NTHR), LDS_BYTES, stream, a);
}
```

```cpp
#include <hip/hip_runtime.h>
#include <cstdio>
#include <cstdint>
__device__ __forceinline__ int lane_id_() { int r; asm volatile("v_mbcnt_lo_u32_b32 %0, -1, 0\n\tv_mbcnt_hi_u32_b32 %0, -1, %0" : "=v"(r)); return r; }
__device__ __forceinline__ int tid_from(int wave_s) { return wave_s * 64 + lane_id_(); }
namespace pg8 {
#define PG8_LAS __attribute__((address_space(3)))
typedef unsigned short bf16_t;
typedef short bf16x8 __attribute__((ext_vector_type(8)));
typedef float f32x4 __attribute__((ext_vector_type(4)));
typedef unsigned u32x4 __attribute__((ext_vector_type(4)));
constexpr int BM = 256, BK = 64, HALF = 128, HTB = HALF * BK * 2  , STAGE_BYTES = 8 * HTB, NXCD = 8, WGM = 8;

__host__ __device__ __forceinline__ int lds_byte(int r, int c) { const int st = (r >> 4) * 2 + (c >> 5), rr = r & 15, cc = c & 31, ob = rr * 64 + cc * 2; return st * 1024 + (ob ^ (((ob >> 9) & 1) << 5)); }
__host__ __device__ __forceinline__ void stage_rc(int b, int& R, int& C) { const int st = b / 1024, sb = b % 1024, swz = sb ^ (((sb >> 9) & 1) << 5); R = (st >> 1) * 16 + swz / 64; C = (st & 1) * 32 + (swz % 64) / 2; }
__host__ __device__ __forceinline__ int perm32(int rho) { const int n = rho >> 4, i = rho & 15; return 8 * (i >> 2) + 4 * n + (i & 3); }

struct Unit { int pm, pn; };
struct Gemm { const bf16_t* A; const bf16_t* Bt; int M, N, K; };

struct StaticOrder {
    int nM, nN, nwg, G, c;
    __host__ __device__ void init(int M, int N, int G_, int c_) { nM = M / BM; nN = N / BM; nwg = nM * nN; G = G_; c = c_; }
    __host__ __device__ bool next(int i, Unit& u) const {
        const long L = (long)i * G + c; if (L >= nwg) return false;
        int wgid = (int)L; { const int q = nwg / NXCD, r = nwg % NXCD, xcd = wgid % NXCD, off = wgid / NXCD; wgid = (xcd < r ? xcd * (q + 1) : r * (q + 1) + (xcd - r) * q) + off; }
        const int nig = WGM * nN, gid = wgid / nig, fm = gid * WGM, gsz = (nM - fm) < WGM ? (nM - fm) : WGM;
        u.pm = fm + ((wgid % nig) % gsz); u.pn = (wgid % nig) / gsz; return true;
    }
    __device__ __forceinline__ void a_ready(const Unit&) const {}
    __device__ __forceinline__ void done(const Unit&) const {}
};

template <class Epi, class Sched, bool ALIGN_EPI = false, bool SP2 = false>
__device__ __forceinline__ void gemm_phase(PG8_LAS unsigned char* lds, const Gemm g, const Sched& S, const Epi& E, int wave_s) {
    int tid_o = tid_from(wave_s); asm volatile("" : "+v"(tid_o));
    const int tid = tid_o, wid = __builtin_amdgcn_readfirstlane(tid >> 6), lane = tid & 63, wr = wid >> 2, wc = wid & 3, fr = lane & 15, fq = lane >> 4;
    const int K = g.K, nt = K / BK;
    unsigned voffA[2], voffB[2];
#pragma unroll
    for (int i = 0; i < 2; ++i) { int R, C; stage_rc(tid * 16 + i * 8192, R, C); const int Rb = Epi::PERM ? ((R & ~31) + perm32(R & 31)) : R;
        voffA[i] = (unsigned)(R * K + C) * 2u; voffB[i] = (unsigned)(Rb * K + C) * 2u; }
    const size_t kstep = (size_t)(BK * 2);
    const size_t hstep = (size_t)HALF * K * 2;
    const size_t tstep = 2 * hstep;
    const unsigned ldsw = (unsigned)wid * 1024u;
    const int aoff = lds_byte(wr * 64 + fr, fq * 8), boff = lds_byte(wc * 32 + fr, fq * 8);
#define PG8_SA(b, h) (((b) * 2 + (h)) * HTB)
#define PG8_SB(b, h) ((4 + (b) * 2 + (h)) * HTB)
#define PG8_STAGE(bufoff, gbase, voff) do { _Pragma("unroll") for (int _i = 0; _i < 2; ++_i) \
        __builtin_amdgcn_global_load_lds((const unsigned*)((const char*)(gbase) + (voff)[_i]), (PG8_LAS unsigned*)(lds + (bufoff) + ldsw + _i * 8192), 16, 0, 0); } while (0)
#define PG8_LDA(dst, b, h) do { _Pragma("unroll") for (int m = 0; m < 4; ++m) _Pragma("unroll") for (int k = 0; k < 2; ++k) dst[m][k] = *(const PG8_LAS bf16x8*)(lds + PG8_SA(b, h) + aoff + m * 2048 + k * 1024); } while (0)
#define PG8_LDB(dst, b, h) do { _Pragma("unroll") for (int n = 0; n < 2; ++n) _Pragma("unroll") for (int k = 0; k < 2; ++k) dst[n][k] = *(const PG8_LAS bf16x8*)(lds + PG8_SB(b, h) + boff + n * 2048 + k * 1024); } while (0)
#define PG8_MMA(ai, bj, At, Bt) do { __builtin_amdgcn_s_setprio(1); _Pragma("unroll") for (int m = 0; m < 4; ++m) _Pragma("unroll") for (int n = 0; n < 2; ++n) _Pragma("unroll") for (int k = 0; k < 2; ++k) \
        acc[ai][bj][m][n] = __builtin_amdgcn_mfma_f32_16x16x32_bf16(Bt[n][k], At[m][k], acc[ai][bj][m][n], 0, 0, 0); __builtin_amdgcn_s_setprio(0); } while (0)
#define PG8_WAIT_V(n) asm volatile("s_waitcnt vmcnt(" #n ")" ::: "memory")
#define PG8_WAIT_L(n) asm volatile("s_waitcnt lgkmcnt(" #n ")" ::: "memory")
#define PG8_BAR __builtin_amdgcn_s_barrier()
#define PG8_SCHED __builtin_amdgcn_sched_barrier(0)
    Unit cur, nxt; int ui = 0;
    if (!S.next(0, cur)) return;
    f32x4 acc[2][2][4][2];
#pragma unroll
    for (int a = 0; a < 2; ++a)
#pragma unroll
        for (int b = 0; b < 2; ++b)
#pragma unroll
            for (int m = 0; m < 4; ++m)
#pragma unroll
                for (int n = 0; n < 2; ++n) acc[a][b][m][n] = (f32x4){0.f, 0.f, 0.f, 0.f};
    bf16x8 At[4][2], B0[2][2], B1[2][2];
    const char* cA = (const char*)g.A + (size_t)cur.pm * tstep; const char* cB = (const char*)g.Bt + (size_t)cur.pn * tstep;
    S.a_ready(cur);
    if constexpr (SP2) {
        PG8_STAGE(PG8_SB(0, 0), cB, voffB); PG8_STAGE(PG8_SB(0, 1), cB + hstep, voffB); PG8_STAGE(PG8_SA(0, 0), cA, voffA); PG8_STAGE(PG8_SA(0, 1), cA + hstep, voffA);
        if (wr == 1) PG8_BAR;
        PG8_WAIT_V(2); PG8_BAR;
        PG8_STAGE(PG8_SB(1, 0), cB + kstep, voffB); PG8_STAGE(PG8_SA(1, 0), cA + kstep, voffA); PG8_STAGE(PG8_SB(1, 1), cB + hstep + kstep, voffB);
        PG8_WAIT_V(6); PG8_BAR;
    } else {
        PG8_STAGE(PG8_SB(0, 0), cB, voffB); PG8_STAGE(PG8_SA(0, 0), cA, voffA); PG8_STAGE(PG8_SB(0, 1), cB + hstep, voffB); PG8_STAGE(PG8_SA(0, 1), cA + hstep, voffA);
        if (wr == 1) PG8_BAR;
        PG8_WAIT_V(4); PG8_BAR;
        PG8_STAGE(PG8_SB(1, 0), cB + kstep, voffB); PG8_STAGE(PG8_SA(1, 0), cA + kstep, voffA); PG8_STAGE(PG8_SB(1, 1), cB + hstep + kstep, voffB);
        PG8_WAIT_V(6); PG8_BAR;
    }
    for (;;) {
        const bool has_next = S.next(ui + 1, nxt);
        const char* nA = has_next ? (const char*)g.A + (size_t)nxt.pm * tstep : cA; const char* nB = has_next ? (const char*)g.Bt + (size_t)nxt.pn * tstep : cB;
        for (int t = 0; t < nt; t += 2) {
            const bool last = (t == nt - 2);
            const char* a1 = cA + (size_t)(t + 1) * kstep;
            const char* a2 = last ? nA : cA + (size_t)(t + 2) * kstep; const char* b2 = last ? nB : cB + (size_t)(t + 2) * kstep;
            const char* a3 = a2 + kstep; const char* b3 = b2 + kstep;
            if (last && has_next) S.a_ready(nxt);
            if constexpr (SP2) {
            PG8_LDB(B0, 0, 0); PG8_LDB(B1, 0, 1); PG8_SCHED; PG8_LDA(At, 0, 0); PG8_STAGE(PG8_SA(1, 1), a1 + hstep, voffA);
            PG8_WAIT_V(8); PG8_WAIT_L(0); PG8_BAR; PG8_MMA(0, 0, At, B0); PG8_MMA(0, 1, At, B1); PG8_BAR; PG8_SCHED;
            PG8_LDA(At, 0, 1); PG8_STAGE(PG8_SB(0, 0), b2, voffB); PG8_STAGE(PG8_SB(0, 1), b2 + hstep, voffB); PG8_STAGE(PG8_SA(0, 0), a2, voffA);
            PG8_WAIT_V(8); PG8_WAIT_L(0); PG8_BAR; PG8_MMA(1, 0, At, B0); PG8_MMA(1, 1, At, B1); PG8_BAR; PG8_SCHED;
            PG8_LDB(B0, 1, 0); PG8_LDB(B1, 1, 1); PG8_SCHED; PG8_LDA(At, 1, 0); PG8_STAGE(PG8_SA(0, 1), a2 + hstep, voffA);
            PG8_WAIT_V(8); PG8_WAIT_L(0); PG8_BAR; PG8_MMA(0, 0, At, B0); PG8_MMA(0, 1, At, B1); PG8_BAR; PG8_SCHED;
            PG8_LDA(At, 1, 1); PG8_STAGE(PG8_SB(1, 0), b3, voffB); PG8_STAGE(PG8_SB(1, 1), b3 + hstep, voffB); PG8_STAGE(PG8_SA(1, 0), a3, voffA);
            PG8_WAIT_V(8); PG8_WAIT_L(0); PG8_BAR; PG8_MMA(1, 0, At, B0); PG8_MMA(1, 1, At, B1); PG8_BAR; PG8_SCHED;
            } else {
            PG8_LDB(B0, 0, 0); PG8_SCHED; PG8_LDA(At, 0, 0); PG8_STAGE(PG8_SA(1, 1), a1 + hstep, voffA);
            PG8_WAIT_L(8); PG8_BAR; PG8_WAIT_L(0); PG8_MMA(0, 0, At, B0); PG8_BAR; PG8_SCHED;
            PG8_LDB(B1, 0, 1); PG8_STAGE(PG8_SB(0, 0), b2, voffB);
            PG8_BAR; PG8_WAIT_L(0); PG8_MMA(0, 1, At, B1); PG8_BAR;
            PG8_LDA(At, 0, 1); PG8_STAGE(PG8_SA(0, 0), a2, voffA);
            PG8_BAR; PG8_WAIT_L(0); PG8_MMA(1, 0, At, B0); PG8_BAR; PG8_SCHED;
            PG8_STAGE(PG8_SB(0, 1), b2 + hstep, voffB);
            PG8_WAIT_V(6); PG8_BAR; PG8_MMA(1, 1, At, B1); PG8_BAR;
            PG8_LDB(B0, 1, 0); PG8_SCHED; PG8_LDA(At, 1, 0); PG8_STAGE(PG8_SA(0, 1), a2 + hstep, voffA);
            PG8_WAIT_L(8); PG8_BAR; PG8_WAIT_L(0); PG8_MMA(0, 0, At, B0); PG8_BAR; PG8_SCHED;
            PG8_LDB(B1, 1, 1); PG8_STAGE(PG8_SB(1, 0), b3, voffB);
            PG8_BAR; PG8_WAIT_L(0); PG8_MMA(0, 1, At, B1); PG8_BAR;
            PG8_LDA(At, 1, 1); PG8_STAGE(PG8_SA(1, 0), a3, voffA);
            PG8_BAR; PG8_WAIT_L(0); PG8_MMA(1, 0, At, B0); PG8_BAR; PG8_SCHED;
            PG8_STAGE(PG8_SB(1, 1), b3 + hstep, voffB);
            PG8_WAIT_V(6); PG8_BAR; PG8_MMA(1, 1, At, B1); PG8_BAR;
            }
        }
        if constexpr (ALIGN_EPI) { if (wr == 0) PG8_BAR; }
        if constexpr (!Epi::AFTER_DRAIN) { E(acc, cur, wr, wc, fr, fq); S.done(cur); }
        if (!has_next) break;
#pragma unroll
        for (int a = 0; a < 2; ++a)
#pragma unroll
            for (int b = 0; b < 2; ++b)
#pragma unroll
                for (int m = 0; m < 4; ++m)
#pragma unroll
                    for (int n = 0; n < 2; ++n) acc[a][b][m][n] = (f32x4){0.f, 0.f, 0.f, 0.f};
        cur = nxt; cA = nA; cB = nB; ++ui;
        if constexpr (ALIGN_EPI) { if (wr == 1) PG8_BAR; }
    }
    PG8_WAIT_V(0);
    if constexpr (!ALIGN_EPI) { if (wr == 0) PG8_BAR; }
    PG8_BAR;
    if constexpr (Epi::AFTER_DRAIN) { E.fused(acc, cur, wr, wc, fr, fq, lds, wid, lane); S.done(cur); }
#undef PG8_SA
#undef PG8_SB
#undef PG8_STAGE
#undef PG8_LDA
#undef PG8_LDB
#undef PG8_MMA
#undef PG8_WAIT_V
#undef PG8_WAIT_L
#undef PG8_BAR
#undef PG8_SCHED
}
}
#define GAS __attribute__((address_space(1)))
#define LAS __attribute__((address_space(3)))
#define XB_TMO      128
#define XB_XCNT(j)  (256  + 64 * (j))
#define XB_XSUB(j)  (1280 + 64 * (j))
#define XB_XGEN(j)  (2304 + 64 * (j))
#define XB_TOP      3328
#define XB_TOPGEN   3392
#define XCD_BAR_WORDS 3456
#define XB_SPIN_CAP (1u << 18)

__device__ __forceinline__ unsigned xb_ld(unsigned* p)              { return __hip_atomic_load(p, __ATOMIC_RELAXED, __HIP_MEMORY_SCOPE_AGENT); }
__device__ __forceinline__ unsigned xb_add(unsigned* p, unsigned v) { return __hip_atomic_fetch_add(p, v, __ATOMIC_RELAXED, __HIP_MEMORY_SCOPE_AGENT); }
__device__ __forceinline__ unsigned xb_xcc_id() { return (unsigned)__builtin_amdgcn_s_getreg((3 << 11) | 20) & 0xFu; }
#define XB_SPIN(cond, bar) do { unsigned _sp = 0; while (cond) { __builtin_amdgcn_s_sleep(1); \
    if ((++_sp & 255u) == 0u) { if (xb_ld(&(bar)[XB_TMO])) break; if (_sp > XB_SPIN_CAP) { atomicAdd(&(bar)[XB_TMO], 1u); break; } } } } while (0)

struct XcdBarrier {
    unsigned* bar; unsigned x; int w;
    volatile LAS unsigned* st;
};

__device__ __forceinline__ XcdBarrier xcd_barrier_post(unsigned* bar, volatile LAS unsigned* st, int wave_s) {
    XcdBarrier b; b.bar = bar; b.x = xb_xcc_id(); b.st = st; b.w = wave_s;
    if (tid_from(wave_s) == 0) (void)xb_add(&bar[XB_XCNT(b.x)], 1u);
    return b;
}
__device__ __forceinline__ void xcd_barrier_complete(unsigned* bar, unsigned x, unsigned& nloc, unsigned& nx) {
    const unsigned G = gridDim.x * gridDim.y * gridDim.z;
    unsigned sum, cnt, mine, sp = 0u;
    for (;;) {
        sum = 0u; cnt = 0u; mine = 0u;
#pragma unroll
        for (unsigned j = 0; j < 16; ++j) { const unsigned c = xb_ld(&bar[XB_XCNT(j)]); sum += c; cnt += (c > 0u) ? 1u : 0u; mine = (j == x) ? c : mine; }
        if (sum == G) break;
        __builtin_amdgcn_s_sleep(1);
        if ((++sp & 255u) == 0u) { if (xb_ld(&bar[XB_TMO])) break; if (sp > XB_SPIN_CAP) { atomicAdd(&bar[XB_TMO], 1u); break; } }
    }
    nloc = mine > 0u ? mine : 1u; nx = cnt > 0u ? cnt : 1u;
}

__device__ __forceinline__ void xcd_barrier(const XcdBarrier& b) {
    asm volatile("s_waitcnt vmcnt(0)" ::: "memory");
    __syncthreads();
    if (tid_from(b.w) == 0) {
        unsigned* bar = b.bar;
        __builtin_amdgcn_s_waitcnt(0);
        unsigned nloc = b.st[0], nx = b.st[1];
        if (nloc == 0u) { xcd_barrier_complete(bar, b.x, nloc, nx); b.st[0] = nloc; b.st[1] = nx; }
        const unsigned old = xb_add(&bar[XB_XSUB(b.x)], 1u);
        const unsigned gen = old / nloc;
        if (old + 1u == (gen + 1u) * nloc) {
            __builtin_amdgcn_fence(__ATOMIC_RELEASE, "agent");
            asm volatile("s_waitcnt vmcnt(0)" ::: "memory");
            const unsigned og = xb_add(&bar[XB_TOP], 1u);
            const unsigned tg = og / nx;
            if (og + 1u == (tg + 1u) * nx) xb_add(&bar[XB_TOPGEN], 1u);
            else XB_SPIN(xb_ld(&bar[XB_TOPGEN]) == tg, bar);
            __builtin_amdgcn_fence(__ATOMIC_ACQUIRE, "agent");
            xb_add(&bar[XB_XGEN(b.x)], 1u);
            asm volatile("s_waitcnt vmcnt(0)" ::: "memory");
        } else {
            XB_SPIN(xb_ld(&bar[XB_XGEN(b.x)]) == gen, bar);
            __builtin_amdgcn_fence(__ATOMIC_ACQUIRE, "agent");
            asm volatile("s_waitcnt vmcnt(0)" ::: "memory");
        }
    }
    __syncthreads();
}

constexpr int NWAVES = 8, NTHR = 512;
constexpr int DM = 2048, NB = 2, SEQ = 4096, NT = NB * SEQ, DEPTH = 4;
constexpr int INW = 5392, INWP = 5632;
constexpr int C_POOL = 0, C_GQ = 512, C_GK = 896, C_GV = 1280, C_GG = 2048, C_GA = 2816, C_RW = 2832;
constexpr int RW_IN = 2560, RW_W = 768, RW_H = 12;
constexpr int GLA_H = 4, GLA_DK = 96, GLA_DV = 192, GLA_NCH = 64;
constexpr int PEER_N = 16384;
constexpr float NORM_EPS = 1e-6f;
constexpr int MODW = 6 * DM;

constexpr size_t MiB = 1u << 20;
constexpr size_t WS_CTL = 0, CTL_ZERO_BYTES = 1 * MiB;
constexpr size_t WS_MOD = 1 * MiB;
constexpr size_t WS_WIN = 2 * MiB;
constexpr size_t WS_WOUT = 90 * MiB;
constexpr size_t WS_WQK = 122 * MiB;
constexpr size_t WS_U = 154 * MiB;
constexpr size_t WS_V = 410 * MiB;
constexpr size_t WS_US = 540 * MiB;
constexpr size_t WS_VS = 541 * MiB;
constexpr size_t WS_POOLT = 545 * MiB;
constexpr size_t WS_LORAT = 542 * MiB;
constexpr size_t WS_X = 666 * MiB;
constexpr size_t WS_H = 730 * MiB;
constexpr size_t WS_Y = 762 * MiB;
constexpr size_t WS_PROJ = 794 * MiB;
constexpr size_t WS_GKV = 970 * MiB;
constexpr size_t WS_GS = 1006 * MiB;
constexpr size_t WS_GDEC = 1042 * MiB;
constexpr size_t WS_RSC = 1043 * MiB;
constexpr size_t WS_RO = 1187 * MiB;
constexpr size_t WS_RGATE = 1211 * MiB;
constexpr size_t WS_RBV = 1235 * MiB;
constexpr size_t WS_EIDX = 1259 * MiB;
constexpr size_t WS_EGATE = 1263 * MiB;
constexpr size_t WS_END = 1267 * MiB;
constexpr size_t WS_DUMMY = 1267 * MiB;
#ifndef PROBE
#define PROBE 0
#endif
constexpr int CW_BAR = 4096;
constexpr size_t WS_SSP = 547 * MiB;
constexpr size_t WS_BIAS3 = 546 * MiB;

#ifndef QUANT_EARLY
#define QUANT_EARLY 10240
#endif
constexpr int EPI_XCH_OFF = 132096;
constexpr int LDS_BYTES = 147456;
constexpr int MISC_OFF = 147456 - 256;

typedef unsigned short bf16;
typedef unsigned v4u __attribute__((ext_vector_type(4)));
typedef unsigned v2u __attribute__((ext_vector_type(2)));
typedef float f32x4 __attribute__((ext_vector_type(4)));
typedef float f32x2 __attribute__((ext_vector_type(2)));
typedef __bf16 bf16x2_t __attribute__((ext_vector_type(2)));
typedef int v4i __attribute__((ext_vector_type(4)));

__device__ __forceinline__ unsigned pk2(float lo, float hi) { const f32x2 f = {lo, hi}; return __builtin_bit_cast(unsigned, __builtin_convertvector(f, bf16x2_t)); }
__device__ __forceinline__ unsigned f2bf(float f) { return pk2(f, f) & 0xffffu; }
__device__ __forceinline__ float bflo(unsigned u) { return __builtin_bit_cast(float, u << 16); }
__device__ __forceinline__ float bfhi(unsigned u) { return __builtin_bit_cast(float, u & 0xffff0000u); }
__device__ __forceinline__ float dpp_xor1(float v) { return __builtin_bit_cast(float, __builtin_amdgcn_update_dpp(0, __builtin_bit_cast(int, v), 0xB1, 0xF, 0xF, true)); }
__device__ __forceinline__ float dpp_xor2(float v) { return __builtin_bit_cast(float, __builtin_amdgcn_update_dpp(0, __builtin_bit_cast(int, v), 0x4E, 0xF, 0xF, true)); }
__device__ __forceinline__ float dpp_hmir(float v) { return __builtin_bit_cast(float, __builtin_amdgcn_update_dpp(0, __builtin_bit_cast(int, v), 0x141, 0xF, 0xF, true)); }
__device__ __forceinline__ float dpp_rmir(float v) { return __builtin_bit_cast(float, __builtin_amdgcn_update_dpp(0, __builtin_bit_cast(int, v), 0x140, 0xF, 0xF, true)); }
__device__ __forceinline__ float rl_f(float v, int l) { return __builtin_bit_cast(float, __builtin_amdgcn_readlane(__builtin_bit_cast(int, v), l)); }
__device__ __forceinline__ float row16_sum(float v) { v += dpp_xor1(v); v += dpp_xor2(v); v += dpp_hmir(v); v += dpp_rmir(v); return v; }
__device__ __forceinline__ float row16_max(float v) { v = fmaxf(v, dpp_xor1(v)); v = fmaxf(v, dpp_xor2(v)); v = fmaxf(v, dpp_hmir(v)); v = fmaxf(v, dpp_rmir(v)); return v; }
__device__ __forceinline__ float wave_sum(float v) { v = row16_sum(v); return (rl_f(v, 0) + rl_f(v, 16)) + (rl_f(v, 32) + rl_f(v, 48)); }
__device__ __forceinline__ float wave_max(float v) { v = row16_max(v); return fmaxf(fmaxf(rl_f(v, 0), rl_f(v, 16)), fmaxf(rl_f(v, 32), rl_f(v, 48))); }
__device__ __forceinline__ float half32_sum(float v, int lane) { v = row16_sum(v); const float lo = rl_f(v, 0) + rl_f(v, 16), hi = rl_f(v, 32) + rl_f(v, 48); return lane < 32 ? lo : hi; }
__device__ __forceinline__ float red8(float v) { v += dpp_xor1(v); v += dpp_xor2(v); v += dpp_hmir(v); return v; }
__device__ __forceinline__ float sigmoidf_(float x) { return __builtin_amdgcn_rcpf(1.f + __builtin_amdgcn_exp2f(-1.4426950408889634f * x)); }
__device__ __forceinline__ float softplusf_(float x) { return fmaxf(x, 0.f) + 0.6931471805599453f * __builtin_amdgcn_logf(1.f + __builtin_amdgcn_exp2f(-1.4426950408889634f * fabsf(x))); }

struct Args { const float* in[30]; float* out; unsigned char* ws; };
typedef const __attribute__((address_space(4))) Args* ArgsP;
__device__ __forceinline__ ArgsP args_ptr() { ArgsP p = (ArgsP)__builtin_amdgcn_kernarg_segment_ptr(); asm volatile("" : "+s"(p)); return p; }
__device__ __forceinline__ int opaque_i(int v) { asm volatile("" : "+s"(v)); return v; }

struct Frame {
    LAS unsigned char* lds;
    int tid, lane, wave, G, bid, gw, ngw;
};
__device__ __forceinline__ Frame make_frame(LAS unsigned char* lds, int wave_s) {
    asm volatile("" : "+s"(wave_s)); Frame F; F.lds = lds; int t = tid_from(wave_s); asm volatile("" : "+v"(t));
    F.tid = t; F.lane = t & 63; F.wave = __builtin_amdgcn_readfirstlane(t >> 6); int g_ = gridDim.x, b_ = blockIdx.x; asm volatile("" : "+s"(g_), "+s"(b_)); F.G = g_; F.bid = b_; F.gw = F.bid * NWAVES + F.wave; F.ngw = F.G * NWAVES; return F;
}

struct EpiStoreF32 {
    static constexpr bool PERM = false, AFTER_DRAIN = false;
    float* C; int ldc; int ws_; LAS unsigned char* lds_;
    __device__ __forceinline__ void operator()(const pg8::f32x4 (&acc)[2][2][4][2], const pg8::Unit& u, int, int, int, int) const {
        int tz = tid_from(ws_); asm volatile("" : "+v"(tz)); const int wid = tz >> 6, lane = tz & 63, wr = wid >> 2, wc = wid & 3, fr = lane & 15, fq = lane >> 4;
        LAS pg8::f32x4* tb = (LAS pg8::f32x4*)(lds_ + EPI_XCH_OFF + wid * 1024);
        float* base = C + (size_t)(u.pm * 256 + wr * 64 + (lane >> 2)) * ldc + u.pn * 256 + wc * 32 + 4 * (lane & 3);
#pragma unroll
        for (int ai = 0; ai < 2; ++ai)
#pragma unroll
            for (int m = 0; m < 4; ++m) { float* rowp = base + (size_t)(ai * 128 + m * 16) * ldc;
#pragma unroll
                for (int bj = 0; bj < 2; ++bj)
#pragma unroll
                    for (int n = 0; n < 2; ++n) { tb[fr * 4 + fq] = acc[ai][bj][m][n]; const pg8::f32x4 v = tb[lane]; *(pg8::f32x4*)(rowp + bj * 128 + n * 16) = v; } }
    }
};
struct EpiResid {
    static constexpr bool PERM = false, AFTER_DRAIN = false;
    const float* xsrc; float* xdst; const float* gate; int ws_; const float* gain2; const float* sc2; bf16* hdst; float* ss; LAS unsigned char* lds_;
    __device__ __forceinline__ void operator()(const pg8::f32x4 (&acc)[2][2][4][2], const pg8::Unit& u, int, int, int, int) const {
        int tz = tid_from(ws_); asm volatile("" : "+v"(tz)); const int wid = tz >> 6, lane = tz & 63, wr = wid >> 2, wc = wid & 3, fr = lane & 15, fq = lane >> 4;
        LAS pg8::f32x4* tb = (LAS pg8::f32x4*)(lds_ + EPI_XCH_OFF + wid * 1024);
        const int row0 = u.pm * 256 + wr * 64 + (lane >> 2), col0 = u.pn * 256 + wc * 32 + 4 * (lane & 3);
        const float* gp = gate + (size_t)(u.pm >> 4) * MODW + col0; const float* sp = sc2 + (size_t)(u.pm >> 4) * MODW + col0;
        pg8::f32x4 gv[2][2], hv[2][2];
#pragma unroll
        for (int bj = 0; bj < 2; ++bj)
#pragma unroll
            for (int n = 0; n < 2; ++n) { gv[bj][n] = *(const pg8::f32x4*)(gp + bj * 128 + n * 16);
                hv[bj][n] = *(const pg8::f32x4*)(gain2 + col0 + bj * 128 + n * 16) * (*(const pg8::f32x4*)(sp + bj * 128 + n * 16) + 1.f); }
#pragma unroll
        for (int ai = 0; ai < 2; ++ai)
#pragma unroll
            for (int m = 0; m < 4; ++m) { const int row = row0 + ai * 128 + m * 16; const size_t ro = (size_t)row * DM + col0; float s = 0.f;
                pg8::f32x4 xv[2][2];
#pragma unroll
                for (int bj = 0; bj < 2; ++bj)
#pragma unroll
                    for (int n = 0; n < 2; ++n) xv[bj][n] = *(const pg8::f32x4*)(xsrc + ro + bj * 128 + n * 16);
#pragma unroll
                for (int bj = 0; bj < 2; ++bj)
#pragma unroll
                    for (int n = 0; n < 2; ++n) { tb[fr * 4 + fq] = acc[ai][bj][m][n]; const pg8::f32x4 av = tb[lane];
                        const pg8::f32x4 y = xv[bj][n] + gv[bj][n] * av;
                        *(pg8::f32x4*)(xdst + ro + bj * 128 + n * 16) = y;
                        s += (y.x * y.x + y.y * y.y) + (y.z * y.z + y.w * y.w);
                        const pg8::f32x4 hh = y * hv[bj][n]; v2u pk; pk.x = pk2(hh.x, hh.y); pk.y = pk2(hh.z, hh.w); *(v2u*)(hdst + ro + bj * 128 + n * 16) = pk; }
                s += dpp_xor1(s); s += dpp_xor2(s);
                if ((lane & 3) == 0) ss[(size_t)row * 32 + u.pn * 4 + wc] = s; }
    }
};
struct EpiScore {
    static constexpr bool PERM = false, AFTER_DRAIN = false;
    float* C; int ldc; int ws_; const LAS float* rs; const float* bias; LAS unsigned char* lds_;
    __device__ __forceinline__ void operator()(const pg8::f32x4 (&acc)[2][2][4][2], const pg8::Unit& u, int, int, int, int) const {
        int tz = tid_from(ws_); asm volatile("" : "+v"(tz)); const int wid = tz >> 6, lane = tz & 63, wr = wid >> 2, wc = wid & 3, fr = lane & 15, fq = lane >> 4;
        LAS pg8::f32x4* tb = (LAS pg8::f32x4*)(lds_ + EPI_XCH_OFF + wid * 1024);
        const int row0 = u.pm * 256 + wr * 64 + (lane >> 2), col0 = u.pn * 256 + wc * 32 + 4 * (lane & 3);
        const float* bp = bias + (size_t)(u.pm >> 4) * DM + col0;
        pg8::f32x4 bv[2][2];
#pragma unroll
        for (int bj = 0; bj < 2; ++bj)
#pragma unroll
            for (int n = 0; n < 2; ++n) bv[bj][n] = *(const pg8::f32x4*)(bp + bj * 128 + n * 16);
#pragma unroll
        for (int ai = 0; ai < 2; ++ai)
#pragma unroll
            for (int m = 0; m < 4; ++m) { const int row = row0 + ai * 128 + m * 16; float* rowp = C + (size_t)row * ldc + col0;
                const float rstd = rs[row & 255];
#pragma unroll
                for (int bj = 0; bj < 2; ++bj)
#pragma unroll
                    for (int n = 0; n < 2; ++n) { tb[fr * 4 + fq] = acc[ai][bj][m][n]; const pg8::f32x4 av = tb[lane]; *(pg8::f32x4*)(rowp + bj * 128 + n * 16) = av * rstd + bv[bj][n]; } }
    }
};

__device__ __forceinline__ void quant_tables(ArgsP A, int l, int wvi, int nw, int lane, int r_begin = 0, int r_end = 2 * PEER_N) {
    int rr = r_begin + wvi;
    if (rr >= r_end) return;
    f32x4 nv[8];
    { const int tb0 = rr >= PEER_N; const f32x4* s0 = (const f32x4*)(A->in[27 + tb0] + (size_t)(l * PEER_N + (rr - tb0 * PEER_N)) * DM) + lane;
#pragma unroll
        for (int j = 0; j < 8; ++j) nv[j] = s0[64 * j]; }
#pragma unroll 1
    for (; rr < r_end; rr += nw) {
        const int tb = rr >= PEER_N, r = l * PEER_N + (rr - tb * PEER_N);
        f32x4 v[8]; float mx = 0.f;
        float ssq = 0.f;
#pragma unroll
        for (int j = 0; j < 8; ++j) v[j] = nv[j];
        { const int rn = rr + nw < r_end ? rr + nw : rr, tbn = rn >= PEER_N;
            const f32x4* sn = (const f32x4*)(A->in[27 + tbn] + (size_t)(l * PEER_N + (rn - tbn * PEER_N)) * DM) + lane;
#pragma unroll
            for (int j = 0; j < 8; ++j) nv[j] = sn[64 * j]; }
#pragma unroll
        for (int j = 0; j < 8; ++j) { mx = fmaxf(mx, fmaxf(fmaxf(fabsf(v[j].x), fabsf(v[j].y)), fmaxf(fabsf(v[j].z), fabsf(v[j].w)))); ssq += (v[j].x * v[j].x + v[j].y * v[j].y) + (v[j].z * v[j].z + v[j].w * v[j].w); }
        mx = wave_max(mx);
        mx = fminf(mx, (tb ? 3.0f : 2.5f) * sqrtf(wave_sum(ssq) * (1.f / DM)));
        unsigned* dst = (unsigned*)(A->ws + (tb ? WS_V : WS_U)) + (size_t)r * (DM / 4) + lane;
        if (!tb) { const float inv = mx > 0.f ? 7.f / mx : 0.f;
            unsigned* dst4 = (unsigned*)(A->ws + WS_U) + (size_t)r * (DM / 8) + lane;
#pragma unroll
            for (int j = 0; j < 4; ++j) { unsigned wd = 0u;
                const float lo4[4] = {v[j].x, v[j].y, v[j].z, v[j].w}, hi4[4] = {v[j + 4].x, v[j + 4].y, v[j + 4].z, v[j + 4].w};
#pragma unroll
                for (int i = 0; i < 4; ++i) { const unsigned nl = (unsigned)((int)rintf(fminf(fmaxf(lo4[i] * inv, -7.f), 7.f)) + 8), nh = (unsigned)((int)rintf(fminf(fmaxf(hi4[i] * inv, -7.f), 7.f)) + 8); wd |= (nl | (nh << 4)) << (8 * i); }
                dst4[64 * j] = wd; }
            if (lane == 0) ((float*)(A->ws + WS_US))[r] = mx * (1.f / 7.f);
        } else { const float inv = mx > 0.f ? 6.f / mx : 0.f;
            unsigned short* dstv = (unsigned short*)(A->ws + WS_V) + (size_t)r * (DM / 4) + (lane & 31) * 8;
#pragma unroll
            for (int j = 0; j < 8; ++j) { const f32x4 c4 = __builtin_elementwise_min(__builtin_elementwise_max(v[j] * inv, (f32x4){-6.f, -6.f, -6.f, -6.f}), (f32x4){6.f, 6.f, 6.f, 6.f});
                int p = __builtin_amdgcn_cvt_scalef32_pk_fp4_f32(0, c4.x, c4.y, 1.0f, 0); p = __builtin_amdgcn_cvt_scalef32_pk_fp4_f32(p, c4.z, c4.w, 1.0f, 1);
                dstv[(j >> 2) * 256 + (((j & 3) << 1) | (lane >> 5))] = (unsigned short)p; }
            if (lane == 0) ((float*)(A->ws + WS_VS))[r] = mx * (1.f / 6.f);
        }
    }
}

__device__ __forceinline__ void transpose_item(const float* W, int K, int N, bf16* WT, LAS float* scr, int kb, int nb, int lane) {
    const int k0 = 64 * kb, n0 = 64 * nb, nl = (lane & 15) * 4, kr = lane >> 4;
    f32x4 v[16];
#pragma unroll
    for (int it = 0; it < 16; ++it) v[it] = (n0 + nl < N) ? *(const f32x4*)(W + (size_t)(k0 + it * 4 + kr) * N + n0 + nl) : (f32x4){0.f, 0.f, 0.f, 0.f};
#pragma unroll
    for (int it = 0; it < 16; ++it) { LAS float* s = scr + (it * 4 + kr) * 65 + nl; s[0] = v[it].x; s[1] = v[it].y; s[2] = v[it].z; s[3] = v[it].w; }
    asm volatile("s_waitcnt lgkmcnt(0)" ::: "memory");
    const int c = lane & 7;
#pragma unroll
    for (int j = 0; j < 8; ++j) { const int n = (lane >> 3) + 8 * j; const LAS float* s = scr + (8 * c) * 65 + n;
        v4u o; o.x = pk2(s[0 * 65], s[1 * 65]); o.y = pk2(s[2 * 65], s[3 * 65]); o.z = pk2(s[4 * 65], s[5 * 65]); o.w = pk2(s[6 * 65], s[7 * 65]);
        if (n0 + n < N) *(v4u*)(WT + (size_t)(n0 + n) * K + k0 + 8 * c) = o; }
    asm volatile("s_waitcnt lgkmcnt(0)" ::: "memory");
}

__device__ __forceinline__ void ph_prologue(ArgsP A, LAS unsigned char* lds_, int wv_) {
    const Frame F = make_frame(lds_, wv_);
    LAS float* ldsf = (LAS float*)F.lds;
    const int tid = F.tid, lane = F.lane, wave = F.wave;
    for (int i = tid; i < NB * DM; i += NTHR) { const float c = A->in[1][i]; ldsf[i] = c / (1.f + __expf(-c)); }
    __syncthreads();
    {
        LAS float* red = ldsf + 4096;
        float* MOD = (float*)(A->ws + WS_MOD);
        for (int u = F.bid; u < DEPTH * 96; u += F.G) {
            const int l = u / 96, j0 = (u % 96) * 128;
            const float* W = A->in[2] + (size_t)l * DM * MODW + j0 + lane * 2;
            float a00 = 0.f, a01 = 0.f, a10 = 0.f, a11 = 0.f;
            const int k0 = wave * 256;
#pragma unroll 8
            for (int k = k0; k < k0 + 256; ++k) { const f32x2 w = *(const f32x2*)(W + (size_t)k * MODW); const float c0 = ldsf[k], c1 = ldsf[DM + k];
                a00 += c0 * w.x; a01 += c0 * w.y; a10 += c1 * w.x; a11 += c1 * w.y; }
            red[(wave * 2 + 0) * 128 + lane * 2] = a00; red[(wave * 2 + 0) * 128 + lane * 2 + 1] = a01;
            red[(wave * 2 + 1) * 128 + lane * 2] = a10; red[(wave * 2 + 1) * 128 + lane * 2 + 1] = a11;
            __syncthreads();
            if (tid < 256) { const int b = tid >> 7, j = tid & 127; float s = 0.f;
#pragma unroll
                for (int w = 0; w < 8; ++w) s += red[(w * 2 + b) * 128 + j];
                s += A->in[3][(size_t)l * MODW + j0 + j];
                MOD[(size_t)(l * 2 + b) * MODW + j0 + j] = s; }
            __syncthreads();
        }
    }
    {
        LAS float* scr = ldsf + wave * 4160;
        constexpr int NBI = (INW + 63) / 64;
        constexpr int I_IN = 32 * NBI, I_OUT = 32 * 32, I_L = I_IN + I_OUT;
        for (int it = F.gw; it < DEPTH * I_L; it += F.ngw) {
            const int l = it / I_L; int r = it % I_L;
            if (r < I_IN) transpose_item(A->in[5] + (size_t)l * DM * INW, DM, INW, (bf16*)(A->ws + WS_WIN) + (size_t)l * INWP * DM, scr, r / NBI, r % NBI, lane);
            else { r -= I_IN; transpose_item(A->in[22] + (size_t)l * DM * DM, DM, DM, (bf16*)(A->ws + WS_WOUT) + (size_t)l * DM * DM, scr, r / 32, r % 32, lane); }
        }
        constexpr int PADV = (INWP - INW) * DM / 8;
        for (int i = F.bid * NTHR + tid; i < DEPTH * PADV; i += F.G * NTHR) { const int l = i / PADV, r = i % PADV;
            ((v4u*)((bf16*)(A->ws + WS_WIN) + (size_t)l * INWP * DM + (size_t)INW * DM))[r] = (v4u){0u, 0u, 0u, 0u}; }
    }
    __syncthreads();
    {
        LAS float* Ks = ldsf;
        LAS float* Ws = ldsf + 128 * 132;
        for (int u = F.bid; u < DEPTH * 16 * 32; u += F.G) {
            const int l = u >> 9, hh = (u >> 5) & 15, jt = u & 31, h = hh >> 1, half = hh & 1, j0 = jt * 64;
            const float* ksrc = (half ? A->in[26] : A->in[25]) + ((size_t)l * 8 + h) * 128 * 128;
            const float* wsrc = A->in[24] + (size_t)l * DM * DM + h * 256 + half * 128;
            {   f32x4 kq[8], wq4[4];
#pragma unroll
                for (int it = 0; it < 8; ++it) { const int i = tid + it * NTHR, n = i >> 5, d4 = (i & 31) * 4; kq[it] = *(const f32x4*)(ksrc + n * 128 + d4); }
#pragma unroll
                for (int it = 0; it < 4; ++it) { const int i = tid + it * NTHR, jj = i >> 5, d4 = (i & 31) * 4; wq4[it] = *(const f32x4*)(wsrc + (size_t)(j0 + jj) * DM + d4); }
#pragma unroll
                for (int it = 0; it < 8; ++it) { const int i = tid + it * NTHR, n = i >> 5, d4 = (i & 31) * 4; *(LAS f32x4*)(Ks + n * 132 + d4) = kq[it]; }
#pragma unroll
                for (int it = 0; it < 4; ++it) { const int i = tid + it * NTHR, jj = i >> 5, d4 = (i & 31) * 4; *(LAS f32x4*)(Ws + jj * 132 + d4) = wq4[it]; }
            }
            __syncthreads();
            { const int li = lane & 15, lq = lane >> 4;
                f32x4 acc[4] = {{0.f, 0.f, 0.f, 0.f}, {0.f, 0.f, 0.f, 0.f}, {0.f, 0.f, 0.f, 0.f}, {0.f, 0.f, 0.f, 0.f}};
#pragma unroll 4
                for (int ks = 0; ks < 32; ++ks) { const float a = Ks[(wave * 16 + li) * 132 + 4 * ks + lq];
#pragma unroll
                    for (int jt = 0; jt < 4; ++jt) acc[jt] = __builtin_amdgcn_mfma_f32_16x16x4f32(a, Ws[(jt * 16 + li) * 132 + 4 * ks + lq], acc[jt], 0, 0, 0); }
                bf16* dst = (bf16*)(A->ws + WS_WQK) + (size_t)l * DM * DM + (size_t)(h * 256 + half * 128 + wave * 16 + lq * 4) * DM + j0 + li;
#pragma unroll
                for (int jt = 0; jt < 4; ++jt) { dst[(size_t)0 * DM + jt * 16] = (bf16)f2bf(acc[jt].x); dst[(size_t)1 * DM + jt * 16] = (bf16)f2bf(acc[jt].y); dst[(size_t)2 * DM + jt * 16] = (bf16)f2bf(acc[jt].z); dst[(size_t)3 * DM + jt * 16] = (bf16)f2bf(acc[jt].w); } }
            __syncthreads();
        }
    }
    {
        bf16* PT = (bf16*)(A->ws + WS_POOLT);
        for (int i = F.bid * NTHR + tid; i < DEPTH * 4 * 128 * 128; i += F.G * NTHR) { const int lg = i >> 14, r = i & 16383, dcol = r >> 7, c = r & 127;
            PT[i] = (bf16)f2bf(A->in[6][(size_t)lg * 16384 + c * 128 + dcol]); }
    }
    {
        bf16* LT = (bf16*)(A->ws + WS_LORAT);
        for (int i = F.bid * NTHR + tid; i < DEPTH * RW_W * 256; i += F.G * NTHR) { const int l = i / (RW_W * 256), r = i % (RW_W * 256), c = r >> 8, j = r & 255;
            const float v = j < 64 ? A->in[13][((size_t)l * 64 + j) * RW_W + c] : (j < 128 ? A->in[15][((size_t)l * 64 + (j - 64)) * RW_W + c] : A->in[16][((size_t)l * 128 + (j - 128)) * RW_W + c]);
            LT[i] = (bf16)f2bf(v); }
    }
    quant_tables(A, 0, F.gw, F.ngw, lane);
}

__device__ __forceinline__ void ph_norm(const float* xsrc, const float* gain, const float* sh, const float* sc, bf16* hout, LAS unsigned char* lds_, int wv_) {
    const Frame F = make_frame(lds_, wv_);
    for (int m = F.gw; m < NT; m += F.ngw) {
        const int b = m >> 12;
        const f32x4* xr = (const f32x4*)(xsrc + (size_t)m * DM) + F.lane;
        f32x4 v[8]; float ss = 0.f;
#pragma unroll
        for (int j = 0; j < 8; ++j) { v[j] = xr[64 * j]; ss += (v[j].x * v[j].x + v[j].y * v[j].y) + (v[j].z * v[j].z + v[j].w * v[j].w); }
        const float rstd = rsqrtf(wave_sum(ss) * (1.f / DM) + NORM_EPS);
        v2u* o8 = (v2u*)(hout + (size_t)m * DM) + F.lane;
#pragma unroll
        for (int j = 0; j < 8; ++j) { const int col = j * 256 + F.lane * 4;
            const f32x4 g = *(const f32x4*)(gain + col), s1 = *(const f32x4*)(sc + (size_t)b * MODW + col), s0 = *(const f32x4*)(sh + (size_t)b * MODW + col);
            const f32x4 y = v[j] * rstd * g * (s1 + 1.f) + s0;
            v2u o; o.x = pk2(y.x, y.y); o.y = pk2(y.z, y.w); o8[64 * j] = o; }
    }
}
__device__ __forceinline__ void ph_final(const float* xsrc, const float* gain, float* out, LAS unsigned char* lds_, int wv_) {
    const Frame F = make_frame(lds_, wv_);
    for (int m = F.gw; m < NT; m += F.ngw) {
        const f32x4* xr = (const f32x4*)(xsrc + (size_t)m * DM) + F.lane;
        f32x4 v[8]; float ss = 0.f;
#pragma unroll
        for (int j = 0; j < 8; ++j) { v[j] = xr[64 * j]; ss += (v[j].x * v[j].x + v[j].y * v[j].y) + (v[j].z * v[j].z + v[j].w * v[j].w); }
        const float rstd = rsqrtf(wave_sum(ss) * (1.f / DM) + NORM_EPS);
        f32x4* o = (f32x4*)(out + (size_t)m * DM) + F.lane;
#pragma unroll
        for (int j = 0; j < 8; ++j) { const f32x4 g = *(const f32x4*)(gain + j * 256 + F.lane * 4); o[64 * j] = v[j] * rstd * g; }
    }
}

__device__ __forceinline__ void pool_unit(ArgsP A, const Frame& F_in, int l, int unit) {
    Frame F = F_in; asm volatile("" : "+v"(F.tid)); F.lane = F.tid & 63;
    const int tile = unit >> 2, g = unit & 3, t0 = tile * 32, s0 = t0 & (SEQ - 1), tid = F.tid, lane = F.lane, w = F.wave;
    const int win = 2 << g;
    const float* proj = (const float*)(A->ws + WS_PROJ);
    LAS float* ps = (LAS float*)F.lds;
    LAS unsigned short* ds = (LAS unsigned short*)(F.lds + 24064);
    const int rt = w >> 2, ct0 = (w & 3) * 2, li = lane & 15, lq = lane >> 4;
    typedef short b8 __attribute__((ext_vector_type(8)));
    b8 bw[2][4];
    { const unsigned short* PT = (const unsigned short*)(A->ws + WS_POOLT) + ((size_t)l * 4 + g) * 16384;
#pragma unroll
        for (int j = 0; j < 2; ++j)
#pragma unroll
            for (int ks = 0; ks < 4; ++ks) bw[j][ks] = *(const b8*)(PT + (size_t)((ct0 + j) * 16 + li) * 128 + ks * 32 + lq * 8); }
    {   f32x4 pq[3];
#pragma unroll
        for (int it = 0; it < 3; ++it) { const int i = tid + it * NTHR, r = i >> 5, c4 = i & 31; const int s = s0 - 15 + r;
            pq[it] = (i < 47 * 32 && s >= 0) ? *(const f32x4*)(proj + (size_t)(t0 - 15 + r) * INWP + C_POOL + g * 128 + c4 * 4) : (f32x4){0.f, 0.f, 0.f, 0.f}; }
#pragma unroll
        for (int it = 0; it < 3; ++it) { const int i = tid + it * NTHR; if (i < 47 * 32) *(LAS f32x4*)(ps + i * 4) = pq[it]; }
    }
    __syncthreads();
    for (int i = tid; i < 32 * 128; i += NTHR) { const int tok = i >> 7, c = i & 127; float sum = 0.f;
        for (int ww = 0; ww < win; ++ww) sum += ps[(tok + 15 - ww) * 128 + c];
        const int cnt = (s0 + tok + 1) < win ? (s0 + tok + 1) : win;
        ds[tok * 136 + c] = (unsigned short)f2bf(sum * __builtin_amdgcn_rcpf((float)cnt) - ps[(tok + 15) * 128 + c]); }
    __syncthreads();
    f32x4 acc[2] = {{0.f, 0.f, 0.f, 0.f}, {0.f, 0.f, 0.f, 0.f}};
#pragma unroll
    for (int ks = 0; ks < 4; ++ks) { const b8 a = *(const LAS b8*)(ds + (rt * 16 + li) * 136 + ks * 32 + lq * 8);
#pragma unroll
        for (int j = 0; j < 2; ++j) acc[j] = __builtin_amdgcn_mfma_f32_16x16x32_bf16(a, bw[j][ks], acc[j], 0, 0, 0); }
    bf16* Y = (bf16*)(A->ws + WS_Y);
#pragma unroll
    for (int j = 0; j < 2; ++j) { const int dcol = (ct0 + j) * 16 + li; const float scale = A->in[7][(size_t)l * 512 + g * 128 + dcol]; const int tk = t0 + rt * 16 + lq * 4;
        Y[(size_t)(tk + 0) * DM + g * 128 + dcol] = (bf16)f2bf(acc[j].x * scale); Y[(size_t)(tk + 1) * DM + g * 128 + dcol] = (bf16)f2bf(acc[j].y * scale);
        Y[(size_t)(tk + 2) * DM + g * 128 + dcol] = (bf16)f2bf(acc[j].z * scale); Y[(size_t)(tk + 3) * DM + g * 128 + dcol] = (bf16)f2bf(acc[j].w * scale); }
    __syncthreads();
}

__device__ __forceinline__ void gla_bcum(ArgsP A, const Frame& F, int l, int h, int t0, LAS float* bcum, LAS float* ad, LAS float* up) {
    const float* proj = (const float*)(A->ws + WS_PROJ);
    const int tid = F.tid;
    {
        const float a0 = proj[(size_t)(t0 + (tid >> 4)) * INWP + C_GA + (tid & 15)], a1 = proj[(size_t)(t0 + 32 + (tid >> 4)) * INWP + C_GA + (tid & 15)];
        const float* upg = A->in[8] + (size_t)l * 16 * 384 + h * 96;
        const float u0 = upg[(tid / 96) * 384 + tid % 96], u1 = upg[((tid + 512) / 96) * 384 + (tid + 512) % 96], u2 = upg[((tid + 1024) / 96) * 384 + (tid + 1024) % 96];
        ad[tid] = a0; ad[tid + 512] = a1; up[tid] = u0; up[tid + 512] = u1; up[tid + 1024] = u2;
    }
    __syncthreads();
    for (int i = tid; i < 64 * 96; i += NTHR) { const int tok = i / 96, d = i % 96; float x = A->in[9][(size_t)l * 384 + h * 96 + d];
#pragma unroll
        for (int j = 0; j < 16; ++j) x += ad[tok * 16 + j] * up[j * 96 + d];
        bcum[i] = -softplusf_(-x) * (1.f / 16.f); }
    __syncthreads();
    if (tid < 384) { const int d = tid % 96, seg = tid / 96; float acc = 0.f;
#pragma unroll
        for (int k = 0; k < 16; ++k) { acc += bcum[(seg * 16 + k) * 96 + d]; bcum[(seg * 16 + k) * 96 + d] = acc; }
        ad[seg * 96 + d] = acc; }
    __syncthreads();
    if (tid < 384) { const int d = tid % 96, seg = tid / 96; float pre = 0.f;
#pragma unroll
        for (int s2 = 0; s2 < 3; ++s2) pre += (s2 < seg) ? ad[s2 * 96 + d] : 0.f;
        if (seg > 0) {
#pragma unroll
            for (int k = 0; k < 16; ++k) bcum[(seg * 16 + k) * 96 + d] += pre; } }
    __syncthreads();
}

__device__ __forceinline__ void gla_scan_unit(ArgsP A, const Frame& F, int unit) {
    const int idx = unit * NTHR + F.tid, bh = idx / 18432, rem = idx % 18432, d = rem % 96;
    const float* KV = (const float*)(A->ws + WS_GKV) + (size_t)bh * 64 * 18432 + rem;
    float* GS = (float*)(A->ws + WS_GS) + (size_t)bh * 64 * 18432 + rem;
    const float* DEC = (const float*)(A->ws + WS_GDEC) + (size_t)bh * 64 * 96 + d;
    float S = 0.f;
#pragma unroll 1
    for (int c0 = 0; c0 < 64; c0 += 16) {
        float kv[16], dc[16];
#pragma unroll
        for (int j = 0; j < 16; ++j) { kv[j] = KV[(size_t)(c0 + j) * 18432]; dc[j] = DEC[(c0 + j) * 96]; }
#pragma unroll
        for (int j = 0; j < 16; ++j) { GS[(size_t)(c0 + j) * 18432] = S; S = dc[j] * S + kv[j]; }
    }
}

typedef short bf16x8_t __attribute__((ext_vector_type(8)));
constexpr int RS = 68;
__device__ __forceinline__ f32x4 tile_mm64(const LAS bf16* Am, int arow0, const LAS bf16* Bm, int brow0, f32x4 acc, int lane) {
    const int r = lane & 15, kq = (lane >> 4) * 8;
#pragma unroll
    for (int ks = 0; ks < 2; ++ks) {
        const bf16x8_t a = *(const LAS bf16x8_t*)(Am + (arow0 + r) * RS + ks * 32 + kq);
        const bf16x8_t b = *(const LAS bf16x8_t*)(Bm + (brow0 + r) * RS + ks * 32 + kq);
        acc = __builtin_amdgcn_mfma_f32_16x16x32_bf16(a, b, acc, 0, 0, 0);
    }
    return acc;
}
constexpr int RA_BT = 0, RA_KT = 8704, RA_AT = 17408, RA_RT = 26112, RA_RABS = 34816, RA_BHT = 43520, RA_KHT = 52224, RA_VT = 60928, RA_AABS = 69632,
              RA_MBAT = 86272, RA_MKA = 103680, RA_NBRT = 121088, RA_GC = 129792, RA_WT = 130048, RA_NKRT = 132096, RA_END = 140800, RA_PRE = 94976;
constexpr int RA_Z = RA_BT, RA_QST = RA_AT, RA_QOT = RA_RT, RA_LO = 0, RA_RES = 34816;
constexpr size_t RWO_POT = 0, RWO_PST = 12 * MiB, RWO_GT = 24 * MiB, RWO_OLT = 48 * MiB, RWO_SC = 72 * MiB;

__device__ __forceinline__ void rwkvA_unit(ArgsP A, const Frame& F_in, int l, int unit) {
    Frame F = F_in; asm volatile("" : "+v"(F.tid)); F.lane = F.tid & 63;

    const int bh = unit >> 6, c = unit & 63, b = bh / RW_H, h = bh % RW_H, t0 = b * SEQ + c * 64, s0 = c * 64, tid = F.tid, lane = F.lane, w = F.wave;
    const float* proj = (const float*)(A->ws + WS_PROJ);
    const float* mu = A->in[11] + (size_t)l * RW_IN;
    LAS unsigned char* L = F.lds;
    const int n = lane, cc = h * 64 + n;
    const int rt1 = w >> 1, ct1 = (w & 1) * 2, li1 = lane & 15, lq1 = lane >> 4;
    f32x4 yc[8], yp[8];
#pragma unroll
    for (int it = 0; it < 8; ++it) { const int g = tid + it * NTHR, tok = g >> 6, j4 = (g & 63) * 4; const float* rp = proj + ((size_t)t0 + tok) * INWP + C_RW + 2304 + j4;
        yc[it] = *(const f32x4*)rp; yp[it] = (s0 + tok > 0) ? *(const f32x4*)(rp - INWP) : (f32x4){0.f, 0.f, 0.f, 0.f}; }
    bf16x8_t bw[2][8];
    { const bf16* LT = (const bf16*)(A->ws + WS_LORAT) + ((size_t)l * RW_W + h * 64) * 256;
#pragma unroll
        for (int j = 0; j < 2; ++j)
#pragma unroll
            for (int ks = 0; ks < 8; ++ks) bw[j][ks] = *(const bf16x8_t*)(LT + (size_t)((ct1 + j) * 16 + li1) * 256 + ks * 32 + lq1 * 8); }
    float rr[9], kr[9], vr[9];
#pragma unroll
    for (int i = 0; i < 9; ++i) { const int tok = w * 8 + i - 1; const bool ok = (s0 + tok >= 0); const float* row = proj + ((size_t)t0 + tok) * INWP + C_RW;
        rr[i] = ok ? row[cc] : 0.f; kr[i] = ok ? row[768 + cc] : 0.f; vr[i] = ok ? row[1536 + cc] : 0.f; }
    const float w0c = A->in[12][(size_t)l * RW_W + cc], a0c = A->in[14][(size_t)l * RW_W + cc], kkc = A->in[17][(size_t)l * RW_W + cc], kac = A->in[18][(size_t)l * RW_W + cc], rkc = A->in[19][(size_t)l * RW_W + cc];
    const float mur = mu[cc], muk = mu[768 + cc], muv = mu[1536 + cc];
    {   LAS bf16* lo = (LAS bf16*)(L + RA_LO);
#pragma unroll
        for (int it = 0; it < 8; ++it) { const int g = tid + it * NTHR, tok = g >> 6, j4 = (g & 63) * 4; const f32x4 m4 = *(const f32x4*)(mu + 2304 + j4);
            const f32x4 ym = yc[it] + (yp[it] - yc[it]) * m4;
            const float sc = j4 < 64 ? 2.f : 1.f; f32x4 sg; sg.x = sigmoidf_(ym.x * sc); sg.y = sigmoidf_(ym.y * sc); sg.z = sigmoidf_(ym.z * sc); sg.w = sigmoidf_(ym.w * sc);
            const f32x4 o = j4 < 64 ? sg * 2.f - 1.f : (j4 < 128 ? ym : sg);
            v2u pk; pk.x = pk2(o.x, o.y); pk.y = pk2(o.z, o.w); *(LAS v2u*)(lo + tok * 264 + j4) = pk; }
    }
    __syncthreads();
    {
        const int rt = rt1, ct0 = ct1, li = li1, lq = lq1;
        const LAS bf16* lo = (const LAS bf16*)(L + RA_LO);
        LAS float* res = (LAS float*)(L + RA_RES);
        f32x4 acc[3][2];
#pragma unroll
        for (int p = 0; p < 3; ++p)
#pragma unroll
            for (int j = 0; j < 2; ++j) acc[p][j] = (f32x4){0.f, 0.f, 0.f, 0.f};
#pragma unroll
        for (int ks = 0; ks < 8; ++ks) { const bf16x8_t a = *(const LAS bf16x8_t*)(lo + (rt * 16 + li) * 264 + ks * 32 + lq * 8);
            const int p = ks < 2 ? 0 : (ks < 4 ? 1 : 2);
#pragma unroll
            for (int j = 0; j < 2; ++j) acc[p][j] = __builtin_amdgcn_mfma_f32_16x16x32_bf16(a, bw[j][ks], acc[p][j], 0, 0, 0); }
#pragma unroll
        for (int p = 0; p < 3; ++p)
#pragma unroll
            for (int j = 0; j < 2; ++j) { LAS float* rp = res + p * 64 * 68 + (rt * 16 + lq * 4) * 68 + (ct0 + j) * 16 + li;
                rp[0] = acc[p][j].x; rp[68] = acc[p][j].y; rp[136] = acc[p][j].z; rp[204] = acc[p][j].w; }
    }
    __syncthreads();
    float r_[8], k_[8], v_[8], av_[8], bb_[8], lw_[8];
    {
        const LAS float* res = (const LAS float*)(L + RA_RES);
        float wl[8], al[8], gl[8];
#pragma unroll
        for (int i = 0; i < 8; ++i) { wl[i] = res[(w * 8 + i) * 68 + n]; al[i] = res[64 * 68 + (w * 8 + i) * 68 + n]; gl[i] = res[2 * 64 * 68 + (w * 8 + i) * 68 + n]; }
        float* GATE = (float*)(A->ws + WS_RGATE); float* BV = (float*)(A->ws + WS_RBV);
#pragma unroll
        for (int i = 0; i < 8; ++i) { const int tok = w * 8 + i; const size_t t = (size_t)t0 + tok;
            float r = rr[i + 1], k = kr[i + 1], v = vr[i + 1];
            r += (rr[i] - r) * mur; k += (kr[i] - k) * muk; v += (vr[i] - v) * muv;
            const float wraw = -softplusf_(-(w0c + wl[i])) - 0.5f;
            const float a = sigmoidf_(a0c + al[i]);
            float kk = k * kkc; kk = kk * __builtin_amdgcn_rsqf(fmaxf(wave_sum(kk * kk), 1e-24f));
            const float k2 = k * (1.f + (a - 1.f) * kac);
            const float bonus = wave_sum(r * k2 * rkc);
            r_[i] = r; k_[i] = k2; v_[i] = v; av_[i] = -kk; bb_[i] = kk * a; lw_[i] = -__expf(wraw);
            GATE[t * RW_W + cc] = gl[i]; BV[t * RW_W + cc] = bonus * v; }
    }
    LAS float* wt = (LAS float*)(L + RA_WT);
#pragma unroll
    for (int i = 1; i < 8; ++i) lw_[i] += lw_[i - 1];
    wt[w * 64 + n] = lw_[7];
    __syncthreads();
    float pre = 0.f, mid = 0.f, last = 0.f;
#pragma unroll
    for (int ww = 0; ww < 8; ++ww) { const float x = wt[ww * 64 + n]; pre += (ww < w) ? x : 0.f; mid += (ww < 4) ? x : 0.f; last += x; }
    {
        LAS bf16* Bt = (LAS bf16*)(L + RA_BT); LAS bf16* Kt = (LAS bf16*)(L + RA_KT); LAS bf16* At = (LAS bf16*)(L + RA_AT); LAS bf16* Rt = (LAS bf16*)(L + RA_RT);
        LAS bf16* Rab = (LAS bf16*)(L + RA_RABS); LAS bf16* BhT = (LAS bf16*)(L + RA_BHT); LAS bf16* KhT = (LAS bf16*)(L + RA_KHT); LAS bf16* VT = (LAS bf16*)(L + RA_VT);
        LAS float* AabT = (LAS float*)(L + RA_AABS);
#pragma unroll
        for (int i = 0; i < 8; ++i) { const int t = w * 8 + i; const float lw = pre + lw_[i], lwm1 = pre + (i > 0 ? lw_[i - 1] : 0.f);
            const float eg = __expf(lw - mid), egi = __expf(mid - lw), egm1 = __expf(lwm1 - mid), eh = __expf(last - lw);
            Bt[t * RS + n] = (bf16)f2bf(bb_[i] * egi); Kt[t * RS + n] = (bf16)f2bf(k_[i] * egi); At[t * RS + n] = (bf16)f2bf(av_[i] * egm1); Rt[t * RS + n] = (bf16)f2bf(r_[i] * eg);
            Rab[t * RS + n] = (bf16)f2bf(r_[i] * __expf(lw)); AabT[n * 65 + t] = av_[i] * __expf(lwm1);
            BhT[n * RS + t] = (bf16)f2bf(bb_[i] * eh); KhT[n * RS + t] = (bf16)f2bf(k_[i] * eh); VT[n * RS + t] = (bf16)f2bf(v_[i]); }
        if (w == 0) ((LAS float*)(L + RA_GC))[n] = __expf(last);
    }
    __syncthreads();
    const int rt = w >> 1, ct0 = (w & 1) * 2, li = lane & 15, lq = lane >> 4;
#define FRAG(mat_, row_, ks_) (*(const LAS bf16x8_t*)((mat_) + ((row_) + li) * RS + (ks_) * 32 + lq * 8))
#define MM(a_, b_, c_) __builtin_amdgcn_mfma_f32_16x16x32_bf16(a_, b_, c_, 0, 0, 0)
    {
        const LAS bf16* Bt = (const LAS bf16*)(L + RA_BT); const LAS bf16* Kt = (const LAS bf16*)(L + RA_KT); const LAS bf16* At = (const LAS bf16*)(L + RA_AT); const LAS bf16* Rt = (const LAS bf16*)(L + RA_RT);
        LAS bf16* MbaT = (LAS bf16*)(L + RA_MBAT); LAS float* Mka = (LAS float*)(L + RA_MKA); LAS bf16* NbrT = (LAS bf16*)(L + RA_NBRT);
        bf16x8_t aB[2], aK[2], bA[2][2], bR[2][2];
#pragma unroll
        for (int ks = 0; ks < 2; ++ks) { aB[ks] = FRAG(Bt, rt * 16, ks); aK[ks] = FRAG(Kt, rt * 16, ks);
#pragma unroll
            for (int j = 0; j < 2; ++j) { bA[j][ks] = FRAG(At, (ct0 + j) * 16, ks); bR[j][ks] = FRAG(Rt, (ct0 + j) * 16, ks); } }
#pragma unroll
        for (int j = 0; j < 2; ++j) { const int ct = ct0 + j, tcol = ct * 16 + li, srow = rt * 16 + lq * 4;
            const f32x4 z = {0.f, 0.f, 0.f, 0.f};
            f32x4 mba = MM(aB[1], bA[j][1], MM(aB[0], bA[j][0], z)), nbr = MM(aB[1], bR[j][1], MM(aB[0], bR[j][0], z));
            f32x4 mka = MM(aK[1], bA[j][1], MM(aK[0], bA[j][0], z)), nk = MM(aK[1], bR[j][1], MM(aK[0], bR[j][0], z));
            mba.x = (srow + 0 < tcol) ? mba.x : 0.f; mba.y = (srow + 1 < tcol) ? mba.y : 0.f; mba.z = (srow + 2 < tcol) ? mba.z : 0.f; mba.w = (srow + 3 < tcol) ? mba.w : 0.f;
            mka.x = (srow + 0 < tcol) ? mka.x : 0.f; mka.y = (srow + 1 < tcol) ? mka.y : 0.f; mka.z = (srow + 2 < tcol) ? mka.z : 0.f; mka.w = (srow + 3 < tcol) ? mka.w : 0.f;
            nbr.x = (srow + 0 <= tcol) ? nbr.x : 0.f; nbr.y = (srow + 1 <= tcol) ? nbr.y : 0.f; nbr.z = (srow + 2 <= tcol) ? nbr.z : 0.f; nbr.w = (srow + 3 <= tcol) ? nbr.w : 0.f;
            nk.x = (srow + 0 <= tcol) ? nk.x : 0.f; nk.y = (srow + 1 <= tcol) ? nk.y : 0.f; nk.z = (srow + 2 <= tcol) ? nk.z : 0.f; nk.w = (srow + 3 <= tcol) ? nk.w : 0.f;
            { v2u pm; pm.x = pk2(mba.x, mba.y); pm.y = pk2(mba.z, mba.w); *(LAS v2u*)(MbaT + tcol * RS + srow) = pm; }
            Mka[(srow + 0) * RS + tcol] = mka.x; Mka[(srow + 1) * RS + tcol] = mka.y; Mka[(srow + 2) * RS + tcol] = mka.z; Mka[(srow + 3) * RS + tcol] = mka.w;
            v2u pk; pk.x = pk2(nbr.x, nbr.y); pk.y = pk2(nbr.z, nbr.w); *(LAS v2u*)(NbrT + tcol * RS + srow) = pk;
            { v2u pn; pn.x = pk2(nk.x, nk.y); pn.y = pk2(nk.z, nk.w); *(LAS v2u*)((LAS bf16*)(L + RA_NKRT) + tcol * RS + srow) = pn; } }
    }
    __syncthreads();
    {
        int t4 = tid; asm volatile("" : "+v"(t4)); const int row = t4 >> 2, q = t4 & 3, l4 = t4 & 63, li4 = l4 & 15, lq4 = l4 >> 4;
        const LAS bf16* MbaT = (const LAS bf16*)(L + RA_MBAT);
        const LAS float* Yrow = (row < 64) ? ((const LAS float*)(L + RA_AABS) + row * 65) : ((const LAS float*)(L + RA_MKA) + (row - 64) * RS);
        LAS bf16* Z = (LAS bf16*)(L + RA_Z); LAS float* pre = (LAS float*)(L + RA_PRE);
        for (int i = t4; i < 1088; i += NTHR) ((LAS v4u*)Z)[i] = (v4u){0u, 0u, 0u, 0u};
        __syncthreads();
#pragma unroll 1
        for (int jb = 0; jb < 4; ++jb) {
            if (jb > 0) {
                f32x4 acc = {0.f, 0.f, 0.f, 0.f};
#pragma unroll
                for (int ks = 0; ks < 2; ++ks) { const bf16x8_t a = *(const LAS bf16x8_t*)(Z + (w * 16 + li4) * RS + ks * 32 + lq4 * 8);
                    const bf16x8_t bm = *(const LAS bf16x8_t*)(MbaT + (jb * 16 + li4) * RS + ks * 32 + lq4 * 8);
                    acc = __builtin_amdgcn_mfma_f32_16x16x32_bf16(a, bm, acc, 0, 0, 0); }
                LAS float* pp = pre + (w * 16 + lq4 * 4) * 16 + li4;
                pp[0] = acc.x; pp[16] = acc.y; pp[32] = acc.z; pp[48] = acc.w;
                __syncthreads();
            }
            float yv[16]; v2u mv[16];
#pragma unroll
            for (int u = 0; u < 16; ++u) { yv[u] = Yrow[jb * 16 + u] + (jb > 0 ? pre[row * 16 + u] : 0.f); mv[u] = *(const LAS v2u*)(MbaT + (jb * 16 + u) * RS + jb * 16 + q * 4); }
            float zb[4] = {0.f, 0.f, 0.f, 0.f};
#pragma unroll
            for (int u = 0; u < 16; ++u) {
                float part = (zb[0] * bflo(mv[u].x) + zb[1] * bfhi(mv[u].x)) + (zb[2] * bflo(mv[u].y) + zb[3] * bfhi(mv[u].y));
                part += dpp_xor1(part); part += dpp_xor2(part);
                const float zt = yv[u] + part;
                zb[u & 3] = (q == (u >> 2)) ? zt : zb[u & 3];
            }
            { v2u pk; pk.x = pk2(zb[0], zb[1]); pk.y = pk2(zb[2], zb[3]); *(LAS v2u*)(Z + row * RS + jb * 16 + q * 4) = pk; }
            __syncthreads();
        }
    }
    {
        int t5 = tid; asm volatile("" : "+v"(t5)); const int li = t5 & 15, lq = (t5 >> 4) & 3;
        const LAS bf16* Z = (const LAS bf16*)(L + RA_Z); const LAS bf16* NbrT = (const LAS bf16*)(L + RA_NBRT); const LAS bf16* BhT = (const LAS bf16*)(L + RA_BHT);
        const LAS bf16* Rab = (const LAS bf16*)(L + RA_RABS); const LAS bf16* KhT = (const LAS bf16*)(L + RA_KHT); const LAS float* gC = (const LAS float*)(L + RA_GC);
        LAS bf16* QsT = (LAS bf16*)(L + RA_QST); LAS bf16* QoT = (LAS bf16*)(L + RA_QOT);
        bf16* PoT = (bf16*)(A->ws + WS_RSC + RWO_POT) + (size_t)unit * 4096; bf16* PsT = (bf16*)(A->ws + WS_RSC + RWO_PST) + (size_t)unit * 4096;
        bf16x8_t zW[2], zX[2], bN[2][2], bH[2][2]; v2u rb[2], kb[2], nb2[2]; float gc[2];
#pragma unroll
        for (int ks = 0; ks < 2; ++ks) { zW[ks] = FRAG(Z, rt * 16, ks); zX[ks] = FRAG(Z, 64 + rt * 16, ks);
#pragma unroll
            for (int j = 0; j < 2; ++j) { bN[j][ks] = FRAG(NbrT, (ct0 + j) * 16, ks); bH[j][ks] = FRAG(BhT, (ct0 + j) * 16, ks); } }
#pragma unroll
        for (int j = 0; j < 2; ++j) { const int col = (ct0 + j) * 16 + li, rw = rt * 16 + lq * 4; rb[j] = *(const LAS v2u*)(Rab + col * RS + rw); kb[j] = *(const LAS v2u*)(KhT + col * RS + rw); nb2[j] = *(const LAS v2u*)((const LAS bf16*)(L + RA_NKRT) + col * RS + rw); gc[j] = gC[col]; }
#pragma unroll
        for (int j = 0; j < 2; ++j) { const int col = (ct0 + j) * 16 + li, rw = rt * 16 + lq * 4;
            { f32x4 acc = {bflo(rb[j].x), bfhi(rb[j].x), bflo(rb[j].y), bfhi(rb[j].y)};
                acc = MM(zW[1], bN[j][1], MM(zW[0], bN[j][0], acc));
                v2u pk; pk.x = pk2(acc.x, acc.y); pk.y = pk2(acc.z, acc.w); *(v2u*)(PoT + (size_t)col * 64 + rw) = pk; }
            { f32x4 acc = {(rw + 0 == col) ? gc[j] : 0.f, (rw + 1 == col) ? gc[j] : 0.f, (rw + 2 == col) ? gc[j] : 0.f, (rw + 3 == col) ? gc[j] : 0.f};
                acc = MM(zW[1], bH[j][1], MM(zW[0], bH[j][0], acc));
                v2u pk; pk.x = pk2(acc.x, acc.y); pk.y = pk2(acc.z, acc.w); *(v2u*)(PsT + (size_t)col * 64 + rw) = pk; }
            { f32x4 acc = {bflo(nb2[j].x), bfhi(nb2[j].x), bflo(nb2[j].y), bfhi(nb2[j].y)};
                acc = MM(zX[1], bN[j][1], MM(zX[0], bN[j][0], acc));
                v2u pk; pk.x = pk2(acc.x, acc.y); pk.y = pk2(acc.z, acc.w); *(LAS v2u*)(QoT + col * RS + rw) = pk; }
            { f32x4 acc = {bflo(kb[j].x), bfhi(kb[j].x), bflo(kb[j].y), bfhi(kb[j].y)};
                acc = MM(zX[1], bH[j][1], MM(zX[0], bH[j][0], acc));
                v2u pk; pk.x = pk2(acc.x, acc.y); pk.y = pk2(acc.z, acc.w); *(LAS v2u*)(QsT + col * RS + rw) = pk; }
        }
    }
    __syncthreads();
    {
        int t6 = tid; asm volatile("" : "+v"(t6)); const int li = t6 & 15, lq = (t6 >> 4) & 3;
        const LAS bf16* VT = (const LAS bf16*)(L + RA_VT);
        const bool isO = (w & 1);
        const LAS bf16* Bm = (const LAS bf16*)(L + (isO ? RA_QOT : RA_QST));
        float* dst = (float*)(A->ws + WS_RSC + (isO ? RWO_OLT : RWO_GT)) + (size_t)unit * 4096;
        bf16x8_t av[2], bq[4][2];
#pragma unroll
        for (int ks = 0; ks < 2; ++ks) { av[ks] = FRAG(VT, rt * 16, ks);
#pragma unroll
            for (int j = 0; j < 4; ++j) bq[j][ks] = FRAG(Bm, j * 16, ks); }
#pragma unroll
        for (int j = 0; j < 4; ++j) { const f32x4 z = {0.f, 0.f, 0.f, 0.f};
            const f32x4 acc = MM(av[1], bq[j][1], MM(av[0], bq[j][0], z));
            *(f32x4*)(dst + (size_t)(j * 16 + li) * 64 + rt * 16 + lq * 4) = acc; }
    }
#undef FRAG
#undef MM
    __syncthreads();
}

__device__ __forceinline__ void rwkvB_scan(ArgsP A, const Frame& F, int unit) {
    const int bh = unit >> 2, rq = unit & 3;
    const int tid = F.tid, lane = F.lane, w = F.wave, ct = w & 3, li = lane & 15, lq = lane >> 4;
    const bool writer = (w < 4);
    const bf16* PsT = (const bf16*)(A->ws + WS_RSC + RWO_PST) + (size_t)bh * 64 * 4096; const float* GT = (const float*)(A->ws + WS_RSC + RWO_GT) + (size_t)bh * 64 * 4096;
    bf16* SC = (bf16*)(A->ws + WS_RSC + RWO_SC) + (size_t)bh * 64 * 4096;
    f32x4 S = {0.f, 0.f, 0.f, 0.f};
    constexpr int PF = 4;
    bf16x8_t pb[PF][2]; f32x4 gq[PF];
    const int col = ct * 16 + li;
#define SLOAD(slot, cc_) do { _Pragma("unroll") for (int ks = 0; ks < 2; ++ks) pb[slot][ks] = *(const bf16x8_t*)(PsT + (size_t)(cc_) * 4096 + (size_t)col * 64 + ks * 32 + lq * 8); \
        gq[slot] = *(const f32x4*)(GT + (size_t)(cc_) * 4096 + (size_t)col * 64 + rq * 16 + lq * 4); } while (0)
#define SSTEP(slot, cc_) do { LAS bf16* Sl = (LAS bf16*)(F.lds + ((cc_) & 1) * 2176); \
        if (writer) { const int rw_ = lq * 4; Sl[(rw_ + 0) * RS + col] = (bf16)f2bf(S.x); Sl[(rw_ + 1) * RS + col] = (bf16)f2bf(S.y); Sl[(rw_ + 2) * RS + col] = (bf16)f2bf(S.z); Sl[(rw_ + 3) * RS + col] = (bf16)f2bf(S.w); } \
        asm volatile("s_waitcnt lgkmcnt(0)" ::: "memory"); __builtin_amdgcn_s_barrier(); asm volatile("" ::: "memory");        \
        if (tid < 128) { const int v_ = tid >> 3, k8_ = (tid & 7) * 8; *(v4u*)(SC + (size_t)(cc_) * 4096 + (rq * 16 + v_) * 64 + k8_) = *(const LAS v4u*)(Sl + v_ * RS + k8_); } \
        f32x4 acc_ = gq[slot]; \
        _Pragma("unroll") for (int ks = 0; ks < 2; ++ks) { const bf16x8_t a_ = *(const LAS bf16x8_t*)(Sl + li * RS + ks * 32 + lq * 8); \
            acc_ = __builtin_amdgcn_mfma_f32_16x16x32_bf16(a_, pb[slot][ks], acc_, 0, 0, 0); } \
        S = acc_; } while (0)
    SLOAD(0, 0); SLOAD(1, 1); SLOAD(2, 2); SLOAD(3, 3);
#pragma unroll 1
    for (int c = 0; c < 64; c += 4) {
        const int cn = (c + 4 < 64) ? c + 4 : 60;
        SSTEP(0, c);     SLOAD(0, cn);
        SSTEP(1, c + 1); SLOAD(1, cn + 1);
        SSTEP(2, c + 2); SLOAD(2, cn + 2);
        SSTEP(3, c + 3); SLOAD(3, cn + 3);
    }
#undef SLOAD
#undef SSTEP
    __syncthreads();
}

__device__ __forceinline__ void rwkvC_unit(ArgsP A, const Frame& F_in, int l, int unit) {
    Frame F = F_in; asm volatile("" : "+v"(F.tid)); F.lane = F.tid & 63;

    const int bh = unit >> 6, c = unit & 63, b = bh / RW_H, h = bh % RW_H, t0 = b * SEQ + c * 64, tid = F.tid, lane = F.lane, w = F.wave;
    const int rt = w >> 1, ct0 = (w & 1) * 2, li = lane & 15, lq = lane >> 4;
    LAS bf16* Sl = (LAS bf16*)F.lds; LAS bf16* Pl = (LAS bf16*)(F.lds + 8704); LAS float* ob = (LAS float*)(F.lds + 17408);
    { const int r = tid >> 3, k8 = (tid & 7) * 8;
        *(LAS v4u*)(Sl + r * RS + k8) = *(const v4u*)((const bf16*)(A->ws + WS_RSC + RWO_SC) + (size_t)unit * 4096 + r * 64 + k8);
        *(LAS v4u*)(Pl + r * RS + k8) = *(const v4u*)((const bf16*)(A->ws + WS_RSC + RWO_POT) + (size_t)unit * 4096 + r * 64 + k8); }
    __syncthreads();
    const float* OlT = (const float*)(A->ws + WS_RSC + RWO_OLT) + (size_t)unit * 4096;
#pragma unroll
    for (int j = 0; j < 2; ++j) { const int tcol = (ct0 + j) * 16 + li, vr = rt * 16 + lq * 4;
        f32x4 acc = *(const f32x4*)(OlT + (size_t)tcol * 64 + vr);
        acc = tile_mm64(Sl, rt * 16, Pl, (ct0 + j) * 16, acc, lane);
        *(LAS f32x4*)(ob + tcol * 68 + vr) = acc; }
    __syncthreads();
    { const int t = tid >> 3, q = tid & 7; const size_t tg = (size_t)t0 + t;
        const f32x4 o0 = *(const LAS f32x4*)(ob + t * 68 + q * 8), o1 = *(const LAS f32x4*)(ob + t * 68 + q * 8 + 4);
        const float mean = red8((o0.x + o0.y) + (o0.z + o0.w) + (o1.x + o1.y) + (o1.z + o1.w)) * (1.f / 64.f);
        const f32x4 d0 = o0 - mean, d1 = o1 - mean;
        const float var = red8((d0.x * d0.x + d0.y * d0.y) + (d0.z * d0.z + d0.w * d0.w) + (d1.x * d1.x + d1.y * d1.y) + (d1.z * d1.z + d1.w * d1.w)) * (1.f / 64.f);
        const float rs = rsqrtf(var + 64e-5f);
        const int cc = h * 64 + q * 8;
        const f32x4 g0 = *(const f32x4*)(A->in[20] + (size_t)l * RW_W + cc), g1 = *(const f32x4*)(A->in[20] + (size_t)l * RW_W + cc + 4);
        const f32x4 b0 = *(const f32x4*)(A->in[21] + (size_t)l * RW_W + cc), b1 = *(const f32x4*)(A->in[21] + (size_t)l * RW_W + cc + 4);
        const f32x4 bv0 = *(const f32x4*)((const float*)(A->ws + WS_RBV) + tg * RW_W + cc), bv1 = *(const f32x4*)((const float*)(A->ws + WS_RBV) + tg * RW_W + cc + 4);
        const f32x4 ga0 = *(const f32x4*)((const float*)(A->ws + WS_RGATE) + tg * RW_W + cc), ga1 = *(const f32x4*)((const float*)(A->ws + WS_RGATE) + tg * RW_W + cc + 4);
        const f32x4 y0 = (d0 * rs * g0 + b0 + bv0) * ga0, y1 = (d1 * rs * g1 + b1 + bv1) * ga1;
        v4u o; o.x = pk2(y0.x, y0.y); o.y = pk2(y0.z, y0.w); o.z = pk2(y1.x, y1.y); o.w = pk2(y1.z, y1.w);
        *(v4u*)((bf16*)(A->ws + WS_Y) + tg * DM + 1280 + cc) = o; }
    __syncthreads();
}

constexpr size_t RWO_GQ = 84 * MiB, RWO_GK = 92 * MiB, RWO_GVT = 100 * MiB, RWO_GEM = 116 * MiB;
constexpr int GQS = 104, GTS = 72;
template <int NKS> __device__ __forceinline__ f32x4 tile_mm(const LAS bf16* Am, int sa, int arow0, const LAS bf16* Bm, int sb, int brow0, f32x4 acc, int lane) {
    const int r = lane & 15, kq = (lane >> 4) * 8;
#pragma unroll
    for (int ks = 0; ks < NKS; ++ks) {
        const bf16x8_t a = *(const LAS bf16x8_t*)(Am + (arow0 + r) * sa + ks * 32 + kq);
        const bf16x8_t b = *(const LAS bf16x8_t*)(Bm + (brow0 + r) * sb + ks * 32 + kq);
        acc = __builtin_amdgcn_mfma_f32_16x16x32_bf16(a, b, acc, 0, 0, 0);
    }
    return acc;
}

__device__ __forceinline__ int gsw(int row) { return ((row >> 2) ^ (row >> 5)) & 7; }
__device__ __forceinline__ f32x4 tile_mm_sw(const LAS bf16* Am, int arow0, const LAS bf16* Bm, int brow0, f32x4 acc, int lane) {
    const int r = lane & 15, cq = lane >> 4, fa = gsw(arow0 + r), fb = gsw(brow0 + r);
#pragma unroll
    for (int ks = 0; ks < 2; ++ks) {
        const bf16x8_t a = *(const LAS bf16x8_t*)(Am + (arow0 + r) * GTS + (((ks * 4 + cq) ^ fa) << 3));
        const bf16x8_t b = *(const LAS bf16x8_t*)(Bm + (brow0 + r) * GTS + (((ks * 4 + cq) ^ fb) << 3));
        acc = __builtin_amdgcn_mfma_f32_16x16x32_bf16(a, b, acc, 0, 0, 0);
    }
    return acc;
}
__device__ __forceinline__ void gla1_unit(ArgsP A, const Frame& F_in, int l, int unit) {
    Frame F = F_in; asm volatile("" : "+v"(F.tid)); F.lane = F.tid & 63;
    const int bh = unit >> 6, c = unit & 63, b = bh >> 2, h = bh & 3, t0 = b * SEQ + c * 64, tid = F.tid, lane = F.lane, w = F.wave;
    const float* proj = (const float*)(A->ws + WS_PROJ);
    LAS float* bcum = (LAS float*)F.lds;
    LAS float* ad = bcum + 6144;
    LAS float* up = ad + 1024;
    LAS bf16* KtT = (LAS bf16*)(F.lds + 34816);
    LAS bf16* VT = (LAS bf16*)(F.lds + 48640);
    f32x4 qq[3], kq[3], vq[6];
#pragma unroll
    for (int it = 0; it < 3; ++it) { const int i = tid + it * NTHR, tok = i / 24, d4 = i % 24; const float* rp = proj + (size_t)(t0 + tok) * INWP + h * 96 + d4 * 4;
        qq[it] = *(const f32x4*)(rp + C_GQ); kq[it] = *(const f32x4*)(rp + C_GK); }
#pragma unroll
    for (int it = 0; it < 6; ++it) { const int i = tid + it * NTHR, tok = i / 48, e4 = i % 48; vq[it] = *(const f32x4*)(proj + (size_t)(t0 + tok) * INWP + C_GV + h * 192 + e4 * 4); }
    gla_bcum(A, F, l, h, t0, bcum, ad, up);
    const float qs = 0.10206207261596575f;
    bf16* Qg = (bf16*)(A->ws + WS_RSC + RWO_GQ) + (size_t)unit * 6144; bf16* Kg = (bf16*)(A->ws + WS_RSC + RWO_GK) + (size_t)unit * 6144;
#pragma unroll
    for (int it = 0; it < 3; ++it) { const int i = tid + it * NTHR, tok = i / 24, d = (i % 24) * 4;
        const float qv[4] = {qq[it].x, qq[it].y, qq[it].z, qq[it].w}, kv[4] = {kq[it].x, kq[it].y, kq[it].z, kq[it].w}; float qo[4], ko[4];
#pragma unroll
        for (int e = 0; e < 4; ++e) { const float m = bcum[31 * 96 + d + e], bb = bcum[tok * 96 + d + e];
            qo[e] = qv[e] * qs * __expf(bb - m); ko[e] = kv[e] * __expf(m - bb); KtT[(d + e) * GTS + ((((tok >> 3) ^ gsw(d + e)) << 3) | (tok & 7))] = (bf16)f2bf(ko[e]); }
        v2u pq, pk; pq.x = pk2(qo[0], qo[1]); pq.y = pk2(qo[2], qo[3]); pk.x = pk2(ko[0], ko[1]); pk.y = pk2(ko[2], ko[3]);
        *(v2u*)(Qg + tok * 96 + d) = pq; *(v2u*)(Kg + tok * 96 + d) = pk; }
#pragma unroll
    for (int it = 0; it < 6; ++it) { const int i = tid + it * NTHR, tok = i / 48, e = (i % 48) * 4;
        const int ts = tok >> 3, tl = tok & 7;
        VT[(e + 0) * GTS + (((ts ^ gsw(e + 0)) << 3) | tl)] = (bf16)f2bf(vq[it].x); VT[(e + 1) * GTS + (((ts ^ gsw(e + 1)) << 3) | tl)] = (bf16)f2bf(vq[it].y);
        VT[(e + 2) * GTS + (((ts ^ gsw(e + 2)) << 3) | tl)] = (bf16)f2bf(vq[it].z); VT[(e + 3) * GTS + (((ts ^ gsw(e + 3)) << 3) | tl)] = (bf16)f2bf(vq[it].w); }
    if (tid < 96) { ((float*)(A->ws + WS_RSC + RWO_GEM))[(size_t)unit * 96 + tid] = __expf(bcum[31 * 96 + tid]);
        ((float*)(A->ws + WS_GDEC))[(size_t)unit * 96 + tid] = __expf(bcum[63 * 96 + tid]); }
    __syncthreads();
    { bf16* VTg = (bf16*)(A->ws + WS_RSC + RWO_GVT) + (size_t)unit * 12288;
#pragma unroll
        for (int it = 0; it < 3; ++it) { const int i = tid + it * NTHR, e = i >> 3, t8 = (i & 7) * 8; *(v4u*)(VTg + e * 64 + t8) = *(const LAS v4u*)(VT + e * GTS + ((((i & 7) ^ gsw(e))) << 3)); } }
    { const int li = lane & 15, lq = lane >> 4;
        float* KVg = (float*)(A->ws + WS_GKV) + (size_t)unit * 18432;
#pragma unroll
        for (int a = 0; a < 3; ++a) { const int dt = (w & 1) * 3 + a, d0 = dt * 16 + lq * 4;
            const float s0 = __expf(bcum[63 * 96 + d0] - bcum[31 * 96 + d0]), s1 = __expf(bcum[63 * 96 + d0 + 1] - bcum[31 * 96 + d0 + 1]),
                        s2 = __expf(bcum[63 * 96 + d0 + 2] - bcum[31 * 96 + d0 + 2]), s3 = __expf(bcum[63 * 96 + d0 + 3] - bcum[31 * 96 + d0 + 3]);
#pragma unroll
            for (int bb = 0; bb < 3; ++bb) { const int et = (w >> 1) * 3 + bb; const f32x4 z = {0.f, 0.f, 0.f, 0.f};
                f32x4 acc = tile_mm_sw(KtT, dt * 16, VT, et * 16, z, lane);
                acc.x *= s0; acc.y *= s1; acc.z *= s2; acc.w *= s3;
                *(f32x4*)(KVg + (size_t)(et * 16 + li) * 96 + d0) = acc; } } }
    __syncthreads();
}

__device__ __forceinline__ void gla3_unit(ArgsP A, const Frame& F_in, int l, int unit) {
    Frame F = F_in; asm volatile("" : "+v"(F.tid)); F.lane = F.tid & 63;
    const int bh = unit >> 6, c = unit & 63, b = bh >> 2, h = bh & 3, t0 = b * SEQ + c * 64, tid = F.tid, lane = F.lane, w = F.wave;
    const int li = lane & 15, lq = lane >> 4;
    const float* proj = (const float*)(A->ws + WS_PROJ);
    LAS bf16* Qs = (LAS bf16*)F.lds;
    LAS bf16* Ks = (LAS bf16*)(F.lds + 13312);
    LAS bf16* VT = (LAS bf16*)(F.lds + 26624);
    LAS bf16* ST = (LAS bf16*)(F.lds + 54272);
    LAS bf16* att = (LAS bf16*)(F.lds + 94208);
    LAS float* ssq = (LAS float*)(F.lds + 103424);
    LAS float* em = (LAS float*)(F.lds + 103936);
    LAS float* ob = (LAS float*)(F.lds + 26624);
    {
        const v4u* Qg = (const v4u*)((const bf16*)(A->ws + WS_RSC + RWO_GQ) + (size_t)unit * 6144); const v4u* Kg = (const v4u*)((const bf16*)(A->ws + WS_RSC + RWO_GK) + (size_t)unit * 6144);
        const v4u* VTg = (const v4u*)((const bf16*)(A->ws + WS_RSC + RWO_GVT) + (size_t)unit * 12288);
        const f32x4* GS = (const f32x4*)((const float*)(A->ws + WS_GS) + (size_t)unit * 18432);
        v4u q0 = Qg[tid], k0 = Kg[tid], q1 = {0u, 0u, 0u, 0u}, k1 = {0u, 0u, 0u, 0u};
        if (tid < 256) { q1 = Qg[512 + tid]; k1 = Kg[512 + tid]; }
        v4u vt[3]; f32x4 sg[9];
#pragma unroll
        for (int it = 0; it < 3; ++it) vt[it] = VTg[tid + it * NTHR];
#pragma unroll
        for (int it = 0; it < 9; ++it) sg[it] = GS[tid + it * NTHR];
        if (tid < 96) em[tid] = ((const float*)(A->ws + WS_RSC + RWO_GEM))[(size_t)unit * 96 + tid];
        { const int i = tid, t = i / 12, c8 = (i % 12) * 8; *(LAS v4u*)(Qs + t * GQS + c8) = q0; *(LAS v4u*)(Ks + t * GQS + c8) = k0; }
        if (tid < 256) { const int i = 512 + tid, t = i / 12, c8 = (i % 12) * 8; *(LAS v4u*)(Qs + t * GQS + c8) = q1; *(LAS v4u*)(Ks + t * GQS + c8) = k1; }
#pragma unroll
        for (int it = 0; it < 3; ++it) { const int i = tid + it * NTHR, e = i >> 3, t8 = (i & 7) * 8; *(LAS v4u*)(VT + e * GTS + t8) = vt[it]; }
        __syncthreads();
#pragma unroll
        for (int it = 0; it < 9; ++it) { const int i = tid + it * NTHR, e = i / 24, d = (i % 24) * 4; const f32x4 m4 = *(const LAS f32x4*)(em + d);
            v2u pk; pk.x = pk2(sg[it].x * m4.x, sg[it].y * m4.y); pk.y = pk2(sg[it].z * m4.z, sg[it].w * m4.w); *(LAS v2u*)(ST + e * GQS + d) = pk; }
    }
    __syncthreads();
#pragma unroll
    for (int a = 0; a < 2; ++a) { const int jt = w >> 1, it = (w & 1) * 2 + a; const f32x4 z = {0.f, 0.f, 0.f, 0.f};
        f32x4 acc = z;
        if (jt <= it) acc = tile_mm<3>(Ks, GQS, jt * 16, Qs, GQS, it * 16, z, lane);
        const int i = it * 16 + li, j0 = jt * 16 + lq * 4;
        acc.x = (j0 + 0 <= i) ? acc.x : 0.f; acc.y = (j0 + 1 <= i) ? acc.y : 0.f; acc.z = (j0 + 2 <= i) ? acc.z : 0.f; acc.w = (j0 + 3 <= i) ? acc.w : 0.f;
        v2u pk; pk.x = pk2(acc.x, acc.y); pk.y = pk2(acc.z, acc.w); *(LAS v2u*)(att + i * GTS + j0) = pk; }
    __syncthreads();
    f32x4 o[6];
    { const int it = w >> 1;
#pragma unroll
        for (int a = 0; a < 6; ++a) { const int et = (w & 1) * 6 + a; const f32x4 z = {0.f, 0.f, 0.f, 0.f};
            f32x4 acc = tile_mm<2>(att, GTS, it * 16, VT, GTS, et * 16, z, lane);
            o[a] = tile_mm<3>(Qs, GQS, it * 16, ST, GQS, et * 16, acc, lane); }
        float s0 = 0.f, s1 = 0.f, s2 = 0.f, s3 = 0.f;
#pragma unroll
        for (int a = 0; a < 6; ++a) { s0 += o[a].x * o[a].x; s1 += o[a].y * o[a].y; s2 += o[a].z * o[a].z; s3 += o[a].w * o[a].w; }
        s0 = row16_sum(s0); s1 = row16_sum(s1); s2 = row16_sum(s2); s3 = row16_sum(s3);
        if (li == 0) { const int r0 = it * 16 + lq * 4; ssq[(r0 + 0) * 2 + (w & 1)] = s0; ssq[(r0 + 1) * 2 + (w & 1)] = s1; ssq[(r0 + 2) * 2 + (w & 1)] = s2; ssq[(r0 + 3) * 2 + (w & 1)] = s3; }
    }
    __syncthreads();
    { const int it = w >> 1, r0 = it * 16 + lq * 4;
#pragma unroll
        for (int a = 0; a < 6; ++a) { const int e = ((w & 1) * 6 + a) * 16 + li;
            ob[(r0 + 0) * 196 + e] = o[a].x; ob[(r0 + 1) * 196 + e] = o[a].y; ob[(r0 + 2) * 196 + e] = o[a].z; ob[(r0 + 3) * 196 + e] = o[a].w; } }
    __syncthreads();
    { bf16* Y = (bf16*)(A->ws + WS_Y);
        f32x4 gv[6];
#pragma unroll
        for (int k = 0; k < 6; ++k) { const int i = tid + k * NTHR, t = i / 48, e = (i % 48) * 4; gv[k] = *(const f32x4*)(proj + (size_t)(t0 + t) * INWP + C_GG + h * 192 + e); }
#pragma unroll
        for (int k = 0; k < 6; ++k) { const int i = tid + k * NTHR, t = i / 48, e = (i % 48) * 4;
            const float rstd = rsqrtf((ssq[t * 2] + ssq[t * 2 + 1]) * (1.f / 192.f) + NORM_EPS);
            const f32x4 ov = *(const LAS f32x4*)(ob + t * 196 + e); const f32x4 ng = *(const f32x4*)(A->in[10] + (size_t)l * 768 + h * 192 + e);
            f32x4 y; y.x = ov.x * rstd * ng.x * gv[k].x * sigmoidf_(gv[k].x); y.y = ov.y * rstd * ng.y * gv[k].y * sigmoidf_(gv[k].y);
            y.z = ov.z * rstd * ng.z * gv[k].z * sigmoidf_(gv[k].z); y.w = ov.w * rstd * ng.w * gv[k].w * sigmoidf_(gv[k].w);
            v2u pk; pk.x = pk2(y.x, y.y); pk.y = pk2(y.z, y.w); *(v2u*)(Y + (size_t)(t0 + t) * DM + 512 + h * 192 + e) = pk; } }
    __syncthreads();
}

#define INS16(L, P, x, px) do { { const bool c_ = (x) > L[15]; L[15] = c_ ? (x) : L[15]; P[15] = c_ ? (px) : P[15]; } \
    _Pragma("unroll") for (int r_ = 14; r_ >= 0; --r_) { const bool c_ = L[r_ + 1] > L[r_]; const float tl_ = L[r_]; const int tp_ = P[r_]; \
        L[r_] = c_ ? L[r_ + 1] : tl_; L[r_ + 1] = c_ ? tl_ : L[r_ + 1]; P[r_] = c_ ? P[r_ + 1] : tp_; P[r_ + 1] = c_ ? tp_ : P[r_ + 1]; } } while (0)

__device__ __forceinline__ float gelu_as(float v) {
    const float av = fabsf(v), t = __builtin_amdgcn_rcpf(av * 0.2316418882f + 1.0f);
    float q = t * 0.5307027145f + (-0.7265760135f); q = q * t + 0.7107068705f; q = q * t + (-0.142248368f); q = q * t + 0.127414796f; q = q * t;
    const float e = __builtin_amdgcn_exp2f((v * v) * (-0.72134752044f));
    const float m = v * (q * e);
    return v < 0.f ? m : v - m;
}
__device__ __forceinline__ int row16_sum_i(int v) {
    v += __builtin_amdgcn_update_dpp(0, v, 0xB1, 0xF, 0xF, true); v += __builtin_amdgcn_update_dpp(0, v, 0x4E, 0xF, 0xF, true);
    v += __builtin_amdgcn_update_dpp(0, v, 0x141, 0xF, 0xF, true); v += __builtin_amdgcn_update_dpp(0, v, 0x140, 0xF, 0xF, true); return v;
}
#ifndef PEER_SL_SHIFT
#define PEER_SL_SHIFT 10
#endif
__device__ __forceinline__ void ph_peer4(ArgsP A, LAS unsigned char* lds_, int wv_, int l, const float* g2, const float* sh2, const float* ngain, const float* nsh, const float* nsc, const bool last, const bool dry = false) {
    const Frame F = make_frame(lds_, wv_);
    const int lane = F.lane, li = lane & 15, lq = lane >> 4;
    const float* SCO = (const float*)(A->ws + WS_PROJ);
    const unsigned char* U4 = A->ws + WS_U + (size_t)l * PEER_N * (DM / 2); const unsigned char* V4 = A->ws + WS_V + (size_t)l * PEER_N * (DM / 2);
    const float* US = (const float*)(A->ws + WS_US) + (size_t)l * PEER_N; const float* VS = (const float*)(A->ws + WS_VS) + (size_t)l * PEER_N;
    float* X = (float*)(A->ws + WS_X); bf16* H = (bf16*)(A->ws + WS_H); const float* ssr = (const float*)(A->ws + WS_SSP) + (size_t)l * NT * 32;
    LAS unsigned char* wl = F.lds + F.wave * 15104;
    LAS int* es = (LAS int*)wl; LAS float* gs = (LAS float*)(wl + 4096);
    LAS v4u* hl = (LAS v4u*)wl;
    LAS int* se = (LAS int*)(wl + 8448);
    LAS float* sg = (LAS float*)(wl + 10496);
    LAS int* st = (LAS int*)(wl + 12544);
    LAS float* dl = (LAS float*)(wl + 14592);
    LAS float* hsl = dl + 64; LAS int* hsi = (LAS int*)(dl + 68);
    for (int tb = F.gw * 4; tb < NT; tb += F.ngw * 4) {
        {
            int P2[16]; float gt[16];
            const int prob = tb * 16 + lane, half = lane & 1;
            const f32x4* s4 = (const f32x4*)(SCO + (size_t)prob * 128);
            int KK[16];
#pragma unroll
            for (int r = 0; r < 16; ++r) KK[r] = (int)0x80000000;
            f32x4 nv[4];
#pragma unroll
            for (int i = 0; i < 4; ++i) nv[i] = s4[i];
#define KINS(x_, idx_) do { const int b_ = __builtin_bit_cast(int, (float)(x_)); int k_ = b_ ^ ((b_ >> 31) & 0x7fffffff); k_ = (k_ & ~127) | (127 - (idx_)); \
        _Pragma("unroll") for (int r_ = 0; r_ < 16; ++r_) { const int hi_ = KK[r_] > k_ ? KK[r_] : k_; k_ = KK[r_] > k_ ? k_ : KK[r_]; KK[r_] = hi_; } } while (0)
#pragma unroll 1
            for (int q = 0; q < 8; ++q) {
                f32x4 v[4];
#pragma unroll
                for (int i = 0; i < 4; ++i) v[i] = nv[i];
                if (q < 7) {
#pragma unroll
                    for (int i = 0; i < 4; ++i) nv[i] = s4[4 * (q + 1) + i]; }
                _Pragma("unroll") for (int r = 0; r < 16; ++r) asm volatile("" : "+v"(KK[r]));
#pragma unroll
                for (int i = 0; i < 4; ++i) { const int ib = 16 * q + 4 * i;
                    KINS(v[i].x, ib); KINS(v[i].y, ib + 1); KINS(v[i].z, ib + 2); KINS(v[i].w, ib + 3); }
            }
#undef KINS
            float v1[16], v2[16];
            LAS int* gsi = (LAS int*)gs;
#pragma unroll
            for (int r = 0; r < 16; ++r) { const int ok = __builtin_amdgcn_update_dpp(0, KK[r], 0xB1, 0xF, 0xF, true);
                const int k1 = half ? ok : KK[r], k2 = half ? KK[r] : ok; const int a1 = k1 & ~127, a2 = k2 & ~127;
                v1[r] = __builtin_bit_cast(float, a1 ^ ((a1 >> 31) & 0x7fffffff)); v2[r] = __builtin_bit_cast(float, a2 ^ ((a2 >> 31) & 0x7fffffff));
                es[r * 64 + lane] = 127 - (k1 & 127); gsi[r * 64 + lane] = 127 - (k2 & 127); }
            int Q[16];
#define MKKEY2(a_, b_) ({ const int bb_ = __builtin_bit_cast(int, v1[a_] + v2[b_]); const int kk_ = bb_ ^ ((bb_ >> 31) & 0x7fffffff); (kk_ & ~255) | (255 - ((a_) * 16 + (b_))); })
#pragma unroll
            for (int bq = 0; bq < 16; ++bq) Q[bq] = MKKEY2(0, bq);
#pragma unroll
            for (int a = 1; a < 16; ++a)
#pragma unroll
                for (int bq = 0; bq < 16; ++bq) if ((a + 1) * (bq + 1) <= 16) { int k_ = MKKEY2(a, bq);
#pragma unroll
                    for (int r = (a + 1) * (bq + 1) - 1; r < 16; ++r) { const int hi_ = Q[r] > k_ ? Q[r] : k_; k_ = Q[r] > k_ ? k_ : Q[r]; Q[r] = hi_; } }
#undef MKKEY2
            float L2[16];
#pragma unroll
            for (int r = 0; r < 16; ++r) { const int ab = 255 - (Q[r] & 255); const int qv = Q[r] & ~255; L2[r] = __builtin_bit_cast(float, qv ^ ((qv >> 31) & 0x7fffffff));
                P2[r] = es[(ab >> 4) * 64 + lane] * 128 + gsi[(ab & 15) * 64 + lane]; }
            float sum = 0.f;
#pragma unroll
            for (int r = 0; r < 16; ++r) { gt[r] = __expf(L2[r] - L2[0]); sum += gt[r]; }
            const float inv = 1.f / sum;
#pragma unroll
            for (int r = 0; r < 16; ++r) { es[r * 64 + lane] = P2[r]; gs[r * 64 + lane] = gt[r] * inv; }
            asm volatile("s_waitcnt lgkmcnt(0)" ::: "memory");
        }
        {
            int ee[8]; float gg[8];
#pragma unroll
            for (int j = 0; j < 8; ++j) { const int x = j * 64 + lane, k = x >> 7, y = x & 127; ee[j] = es[(y & 15) * 64 + k * 16 + 2 * (y >> 4)]; gg[j] = gs[(y & 15) * 64 + k * 16 + 2 * (y >> 4)]; }
            int base = 0;
#pragma unroll
            for (int k = 0; k < 4; ++k) {
#pragma unroll 1
                for (int s = 0; s < (16384 >> PEER_SL_SHIFT); ++s) {
#pragma unroll
                    for (int jj = 0; jj < 2; ++jj) { const int j = k * 2 + jj; const bool in = (ee[j] >> PEER_SL_SHIFT) == s; const unsigned long long m = __builtin_amdgcn_ballot_w64(in);
                        if (in) { const int pos = base + (int)__builtin_amdgcn_mbcnt_hi((unsigned)(m >> 32), __builtin_amdgcn_mbcnt_lo((unsigned)m, 0u)); se[pos] = ee[j]; sg[pos] = gg[j]; }
                        base += __builtin_popcountll(m); }
                }
            }
        }
        asm volatile("s_waitcnt lgkmcnt(0)" ::: "memory");
#pragma unroll 1
        for (int k = 0; k < 4; ++k) {
            const int t = tb + k, b = t >> 12;
            float hf[32]; float mx = 0.f;
            const v4u* hp = (const v4u*)(H + (size_t)t * DM);
#pragma unroll
            for (int jj = 0; jj < 2; ++jj)
#pragma unroll
                for (int c = 0; c < 2; ++c) { const v4u hv = hp[(jj * 64 + lane) * 2 + c]; const int o = jj * 16 + c * 8;
                    hf[o + 0] = bflo(hv.x); hf[o + 1] = bfhi(hv.x); hf[o + 2] = bflo(hv.y); hf[o + 3] = bfhi(hv.y); hf[o + 4] = bflo(hv.z); hf[o + 5] = bfhi(hv.z); hf[o + 6] = bflo(hv.w); hf[o + 7] = bfhi(hv.w); }
            { const float rstd = rsqrtf(wave_sum(lane < 32 ? ssr[(size_t)t * 32 + lane] : 0.f) * (1.f / DM) + NORM_EPS);
#pragma unroll
                for (int jj = 0; jj < 2; ++jj)
#pragma unroll
                    for (int q = 0; q < 4; ++q) { const f32x4 s4 = *(const f32x4*)(sh2 + (size_t)b * MODW + (jj * 64 + lane) * 16 + 4 * q);
                        hf[jj * 16 + 4 * q] = hf[jj * 16 + 4 * q] * rstd + s4.x; hf[jj * 16 + 4 * q + 1] = hf[jj * 16 + 4 * q + 1] * rstd + s4.y;
                        hf[jj * 16 + 4 * q + 2] = hf[jj * 16 + 4 * q + 2] * rstd + s4.z; hf[jj * 16 + 4 * q + 3] = hf[jj * 16 + 4 * q + 3] * rstd + s4.w; } }
#pragma unroll
            for (int i = 0; i < 32; ++i) mx = fmaxf(mx, fabsf(hf[i]));
            mx = wave_max(mx);
            const float inv = mx > 0.f ? 127.f / mx : 0.f;
            if (lane == 0) hsl[k] = mx * (1.f / 127.f);
            int hsum = 0;
#pragma unroll
            for (int jj = 0; jj < 2; ++jj) { unsigned qd[4];
#pragma unroll
                for (int d = 0; d < 4; ++d) { const int o = jj * 16 + 4 * d; const int q0 = (int)rintf(hf[o] * inv), q1 = (int)rintf(hf[o + 1] * inv), q2 = (int)rintf(hf[o + 2] * inv), q3 = (int)rintf(hf[o + 3] * inv);
                    qd[d] = (unsigned)(q0 & 255) | ((unsigned)(q1 & 255) << 8) | ((unsigned)(q2 & 255) << 16) | ((unsigned)(q3 & 255) << 24); hsum += (q0 + q1) + (q2 + q3); }
                v4u q; q.x = qd[0]; q.y = qd[1]; q.z = qd[2]; q.w = qd[3]; hl[k * 132 + jj * 64 + lane] = q; }
            { hsum = row16_sum_i(hsum); const int hs_all = __builtin_amdgcn_readlane(hsum, 0) + __builtin_amdgcn_readlane(hsum, 16) + __builtin_amdgcn_readlane(hsum, 32) + __builtin_amdgcn_readlane(hsum, 48);
                if (lane == 0) hsi[k] = hs_all; }
        }
        asm volatile("s_waitcnt lgkmcnt(0)" ::: "memory");
        {
            int lu = lane; asm volatile("" : "+v"(lu)); const int tq = lu & 3, pq = (lu >> 2) & 3, kq = lu >> 4;
            v4i hB[8];
            { const LAS v4u* hb = hl + tq * 132 + kq * 4 + pq;
#pragma unroll
                for (int s = 0; s < 4; ++s) { hB[2 * s] = *(const LAS v4i*)(hb + s * 16); hB[2 * s + 1] = *(const LAS v4i*)(hb + 64 + s * 16); } }
            const int hc = 8 * hsi[tq];
            const unsigned char* ubase = U4 + kq * 64 + tq * 16;
#define ULOAD4(buf, q_) do { const int e_ = se[(q_) * 4 + pq]; const unsigned char* up_ = ubase + (size_t)e_ * (DM / 2); \
    _Pragma("unroll") for (int s = 0; s < 4; ++s) buf[s] = *(const v4i*)(up_ + s * 256); } while (0)
#define UCONS4(buf, gi_) do { v4i acc = {0, 0, 0, 0}; \
    _Pragma("unroll") for (int s = 0; s < 4; ++s) { const v4i lo_ = buf[s] & 0x0F0F0F0F, hi_ = (buf[s] >> 4) & 0x0F0F0F0F; \
        acc = __builtin_amdgcn_mfma_i32_16x16x64_i8(lo_, hB[2 * s], acc, 0, 0, 0); acc = __builtin_amdgcn_mfma_i32_16x16x64_i8(hi_, hB[2 * s + 1], acc, 0, 0, 0); } \
    int v_ = pq == 0 ? acc.x : (pq == 1 ? acc.y : (pq == 2 ? acc.z : acc.w)); \
    v_ += __builtin_amdgcn_update_dpp(0, v_, 0x124, 0xF, 0xF, true); v_ += __builtin_amdgcn_update_dpp(0, v_, 0x128, 0xF, 0xF, true); \
    if (pq == 0) dl[((gi_) * 4 + kq) * 4 + tq] = (float)(v_ - hc); } while (0)
            float us_c, vs_c; { const int e0 = se[lu & 15]; us_c = US[e0]; vs_c = VS[e0]; }
            v4i ub0[4], ub1[4], ub2[4], ub3[4];
            ULOAD4(ub0, 0); ULOAD4(ub1, 1); ULOAD4(ub2, 2); ULOAD4(ub3, 3);
#pragma unroll 1
            for (int g = 0; g < 32; ++g) {
                const int gn = g + 1 < 32 ? g + 1 : 31;
                const int en = se[gn * 16 + (lu & 15)]; const float us_n = US[en], vs_n = VS[en];
                UCONS4(ub0, 0); ULOAD4(ub0, gn * 4 + 0);
                UCONS4(ub1, 1); ULOAD4(ub1, gn * 4 + 1);
                UCONS4(ub2, 2); ULOAD4(ub2, gn * 4 + 2);
                UCONS4(ub3, 3); ULOAD4(ub3, gn * 4 + 3);
                if (lu < 16) { const int x = g * 16 + lu; const int tk = x >> 7;
                    sg[x] = sg[x] * vs_c * gelu_as(dl[lu * 4 + tk] * (us_c * hsl[tk])); }
                us_c = us_n; vs_c = vs_n;
            }
#undef ULOAD4
#undef UCONS4
        }
        asm volatile("s_waitcnt lgkmcnt(0)" ::: "memory");
#define VLOAD(buf, cfb, bi_) do { const v4i e4_ = *(const LAS v4i*)(se + xb + (bi_) * 4); const f32x4 g4_ = *(const LAS f32x4*)(sg + xb + (bi_) * 4); \
        cfb[0] = g4_.x; cfb[1] = g4_.y; cfb[2] = g4_.z; cfb[3] = g4_.w; const int ee_[4] = {e4_.x, e4_.y, e4_.z, e4_.w}; \
        _Pragma("unroll") for (int i = 0; i < 4; ++i) { const unsigned char* vp_ = vbase + (size_t)ee_[i] * (DM / 2); buf[i][0] = *(const v4u*)vp_; buf[i][1] = *(const v4u*)(vp_ + 512); } } while (0)
#define VACC(bv_, cv_) do { const f32x2 c2_ = {cv_, cv_}; \
        _Pragma("unroll") for (int jj = 0; jj < 2; ++jj) { const unsigned wd_[4] = {bv_[jj].x, bv_[jj].y, bv_[jj].z, bv_[jj].w}; \
            _Pragma("unroll") for (int d = 0; d < 4; ++d) { const int o_ = jj * 16 + 4 * d; \
                const f32x2 f0_ = __builtin_amdgcn_cvt_scalef32_pk_f32_fp4((int)wd_[d], 1.0f, 0), f1_ = __builtin_amdgcn_cvt_scalef32_pk_f32_fp4((int)wd_[d], 1.0f, 1), \
                            f2_ = __builtin_amdgcn_cvt_scalef32_pk_f32_fp4((int)wd_[d], 1.0f, 2), f3_ = __builtin_amdgcn_cvt_scalef32_pk_f32_fp4((int)wd_[d], 1.0f, 3); \
                out[o_] = __builtin_elementwise_fma(c2_, f0_, out[o_]); out[o_ + 1] = __builtin_elementwise_fma(c2_, f1_, out[o_ + 1]); \
                out[o_ + 2] = __builtin_elementwise_fma(c2_, f2_, out[o_ + 2]); out[o_ + 3] = __builtin_elementwise_fma(c2_, f3_, out[o_ + 3]); } } } while (0)
#define VCONS(buf, cfb) do { _Pragma("unroll") for (int i = 0; i < 4; ++i) VACC(buf[i], cfb[i]); } while (0)
#pragma unroll 1
        for (int p = 0; p < 2; ++p) {
            int lane_v = F.lane; asm volatile("" : "+v"(lane_v)); const int hv = lane_v >> 5, mv = lane_v & 31;
            const int xb = (2 * p + hv) * 128;
            const unsigned char* vbase = V4 + mv * 16;
            f32x2 out[32];
#pragma unroll
            for (int i = 0; i < 32; ++i) out[i] = (f32x2){0.f, 0.f};
            {
                v4u vb0[4][2], vb1[4][2]; float c0[4], c1[4];
                VLOAD(vb0, c0, 0); VLOAD(vb1, c1, 1);
#pragma unroll 1
                for (int bi = 0; bi < 32; bi += 2) {
                    const int b2 = bi + 2 < 32 ? bi + 2 : 30, b3 = bi + 3 < 32 ? bi + 3 : 31;
                    asm volatile("" ::: "memory"); VCONS(vb0, c0); asm volatile("" ::: "memory"); VLOAD(vb0, c0, b2);
                    asm volatile("" ::: "memory"); VCONS(vb1, c1); asm volatile("" ::: "memory"); VLOAD(vb1, c1, b3);
                }
            }
            {
                const int t = tb + 2 * p + hv, b = t >> 12;
                f32x4 xn[2][8]; float ss = 0.f;
                const f32x4* xr = (const f32x4*)(X + (size_t)t * DM) + mv; const f32x4* gr = (const f32x4*)(g2 + (size_t)b * MODW) + mv;
#pragma unroll
                for (int jj = 0; jj < 2; ++jj)
#pragma unroll
                    for (int q = 0; q < 8; ++q) { const int ix = jj * 256 + q * 32; const f32x4 xv = xr[ix], gv = gr[ix];
                        f32x4 o4; o4.x = out[jj * 16 + 2 * q].x; o4.y = out[jj * 16 + 2 * q].y; o4.z = out[jj * 16 + 2 * q + 1].x; o4.w = out[jj * 16 + 2 * q + 1].y;
                        const f32x4 y = xv + gv * o4; xn[jj][q] = y; ss += (y.x * y.x + y.y * y.y) + (y.z * y.z + y.w * y.w); }
                float rstd; { const float v = row16_sum(ss); const float s0 = rl_f(v, 0) + rl_f(v, 16), s1 = rl_f(v, 32) + rl_f(v, 48); rstd = rsqrtf((hv ? s1 : s0) * (1.f / DM) + NORM_EPS); }
                if (!last) {
                    f32x4* xw = (f32x4*)((dry ? (float*)(A->ws + WS_DUMMY) : X) + (size_t)t * DM) + mv; v2u* hw = (v2u*)((dry ? (bf16*)(A->ws + WS_DUMMY + 64 * MiB) : H) + (size_t)t * DM) + mv;
                    const f32x4* ngp = (const f32x4*)ngain + mv; const f32x4* s1p = (const f32x4*)(nsc + (size_t)b * MODW) + mv; const f32x4* s0p = (const f32x4*)(nsh + (size_t)b * MODW) + mv;
#pragma unroll
                    for (int jj = 0; jj < 2; ++jj)
#pragma unroll
                        for (int q = 0; q < 8; ++q) { const int ix = jj * 256 + q * 32; xw[ix] = xn[jj][q];
                            const f32x4 g = ngp[ix], s1 = s1p[ix], s0 = s0p[ix];
                            const f32x4 y = xn[jj][q] * rstd * g * (s1 + 1.f) + s0;
                            v2u o; o.x = pk2(y.x, y.y); o.y = pk2(y.z, y.w); hw[ix] = o; }
                } else {
                    f32x4* ow = (f32x4*)((dry ? (float*)(A->ws + WS_DUMMY) : A->out) + (size_t)t * DM) + mv; const f32x4* ngp = (const f32x4*)ngain + mv;
#pragma unroll
                    for (int jj = 0; jj < 2; ++jj)
#pragma unroll
                        for (int q = 0; q < 8; ++q) { const int ix = jj * 256 + q * 32; ow[ix] = xn[jj][q] * rstd * ngp[ix]; }
                }
            }
        }
#undef VLOAD
#undef VACC
#undef VCONS
    }
}

__device__ __forceinline__ void PH_norm1_l0(LAS unsigned char* lds, int wv) { ArgsP A = args_ptr(); const float* MOD = (const float*)(A->ws + WS_MOD);
    ph_norm(A->in[0], A->in[4], MOD + 0 * DM, MOD + 1 * DM, (bf16*)(A->ws + WS_H), lds, wv);
    { const Frame F = make_frame(lds, wv); float* B3 = (float*)(A->ws + WS_BIAS3);
        for (int o = F.gw; o < DEPTH * 2 * DM; o += F.ngw) { const int l = o >> 12, b = (o >> 11) & 1, n = o & 2047;
            const float* sh = MOD + (size_t)(l * 2 + b) * MODW + 3 * DM; const v4u* wr = (const v4u*)((const bf16*)(A->ws + WS_WQK) + ((size_t)l * DM + n) * DM);
            float s = 0.f;
#pragma unroll
            for (int j = 0; j < 4; ++j) { const v4u wv4 = wr[j * 64 + F.lane]; const f32x4 s0 = *(const f32x4*)(sh + (j * 64 + F.lane) * 8), s1 = *(const f32x4*)(sh + (j * 64 + F.lane) * 8 + 4);
                s += bflo(wv4.x) * s0.x + bfhi(wv4.x) * s0.y + bflo(wv4.y) * s0.z + bfhi(wv4.y) * s0.w + bflo(wv4.z) * s1.x + bfhi(wv4.z) * s1.y + bflo(wv4.w) * s1.z + bfhi(wv4.w) * s1.w; }
            s = wave_sum(s);
            if (F.lane == 0) B3[o] = s; } } }
__device__ __forceinline__ void PH_gemm1(LAS unsigned char* lds, int wv, int l_) { ArgsP A = args_ptr(); const int l = opaque_i(l_);
    pg8::Gemm g{(const bf16*)(A->ws + WS_H), (const bf16*)(A->ws + WS_WIN) + (size_t)l * INWP * DM, NT, INWP, DM}; pg8::StaticOrder S; S.init(NT, INWP, gridDim.x, blockIdx.x);
    EpiStoreF32 E{(float*)(A->ws + WS_PROJ), INWP, wv, lds};
    pg8::gemm_phase<EpiStoreF32, pg8::StaticOrder, true, true>(lds, g, S, E, wv);
    { const Frame F = make_frame(lds, wv); if (F.G == 256 && l + 1 < DEPTH && F.bid >= 192) quant_tables(A, l + 1, (F.bid - 192) * NWAVES + F.wave, 64 * NWAVES, F.lane, 0, QUANT_EARLY); } }
__device__ __forceinline__ void PH_mixA(LAS unsigned char* lds, int wv, int l_) { ArgsP A = args_ptr(); const int l = opaque_i(l_);
    const Frame F = make_frame(lds, wv);
#ifdef PROBE_A
    for (int u = F.bid; u < 2048; u += F.G) {
        if (u < 1536) { if (PROBE_A == 1) rwkvA_unit(A, F, l, u); }
        else { if (PROBE_A == 2) gla1_unit(A, F, l, u - 1536); }
    }
#endif
    for (int u = F.bid; u < 2048; u += F.G) {
        if (u < 1536) rwkvA_unit(A, F, l, u);
        else gla1_unit(A, F, l, u - 1536);
    }
    if (l + 1 < DEPTH) quant_tables(A, l + 1, F.gw, F.ngw, F.lane, F.G == 256 ? QUANT_EARLY : 0);
}
__device__ __forceinline__ void PH_mixB(LAS unsigned char* lds, int wv, int l_) { ArgsP A = args_ptr(); const int l = opaque_i(l_);
    const Frame F = make_frame(lds, wv);
    if (F.G >= 192) {
        if (F.bid < 96) rwkvB_scan(A, F, F.bid);
        else { const int nb = F.G - 96, b2 = F.bid - 96;
            for (int u = b2; u < 288; u += nb) gla_scan_unit(A, F, u);
            for (int u = b2; u < 1024; u += nb) pool_unit(A, F, l, u); }
    } else {
        for (int u = F.bid; u < 288; u += F.G) gla_scan_unit(A, F, u);
        for (int u = F.bid; u < 1024; u += F.G) pool_unit(A, F, l, u);
        for (int u = F.bid; u < 96; u += F.G) rwkvB_scan(A, F, u);
    } }
__device__ __forceinline__ void PH_mixC(LAS unsigned char* lds, int wv, int l_) { ArgsP A = args_ptr(); const int l = opaque_i(l_);
    const Frame F = make_frame(lds, wv);
#ifdef PROBE_C
    for (int u = F.bid; u < 2048; u += F.G) { if (u < 512) { if (PROBE_C == 1) gla3_unit(A, F, l, u); } else { if (PROBE_C == 2) rwkvC_unit(A, F, l, u - 512); } }
#endif
    for (int u = F.bid; u < 2048; u += F.G) { if (u < 512) gla3_unit(A, F, l, u); else rwkvC_unit(A, F, l, u - 512); } }
__device__ __forceinline__ void PH_gemm2(LAS unsigned char* lds, int wv, int l_, bool dry = false) { ArgsP A = args_ptr(); const int l = opaque_i(l_);
    const float* modl = (const float*)(A->ws + WS_MOD) + (size_t)l * 2 * MODW; float* X = (float*)(A->ws + WS_X);
    pg8::Gemm g{(const bf16*)(A->ws + WS_Y), (const bf16*)(A->ws + WS_WOUT) + (size_t)l * DM * DM, NT, DM, DM}; pg8::StaticOrder S; S.init(NT, DM, gridDim.x, blockIdx.x);
    EpiResid E{(l == 0) ? A->in[0] : (const float*)X, dry ? (float*)(A->ws + WS_DUMMY) : X, modl + 2 * DM, wv, A->in[23] + (size_t)l * DM, modl + 4 * DM,
               dry ? (bf16*)(A->ws + WS_DUMMY + 64 * MiB) : (bf16*)(A->ws + WS_H), (dry ? (float*)(A->ws + WS_DUMMY) : (float*)(A->ws + WS_SSP) + (size_t)l * NT * 32), lds};
    pg8::gemm_phase<EpiResid, pg8::StaticOrder, true, true>(lds, g, S, E, wv); }
__device__ __forceinline__ void PH_norm2(LAS unsigned char* lds, int wv, int l_) { ArgsP A = args_ptr(); const int l = opaque_i(l_);
    const float* modl = (const float*)(A->ws + WS_MOD) + (size_t)l * 2 * MODW;
    ph_norm((const float*)(A->ws + WS_X), A->in[23] + (size_t)l * DM, modl + 3 * DM, modl + 4 * DM, (bf16*)(A->ws + WS_H), lds, wv); }
__device__ __forceinline__ void PH_gemm3(LAS unsigned char* lds, int wv, int l_) { ArgsP A = args_ptr(); const int l = opaque_i(l_);
    pg8::Gemm g{(const bf16*)(A->ws + WS_H), (const bf16*)(A->ws + WS_WQK) + (size_t)l * DM * DM, NT, DM, DM}; pg8::StaticOrder S; S.init(NT, DM, gridDim.x, blockIdx.x);
    LAS float* rs = (LAS float*)(lds + 131072);
    { pg8::Unit u0; const int t = tid_from(wv); if (S.next(0, u0) && t < 256) { const f32x4* sp = (const f32x4*)((const float*)(A->ws + WS_SSP) + ((size_t)l * NT + u0.pm * 256 + t) * 32); float s = 0.f;
#pragma unroll
            for (int j = 0; j < 8; ++j) { const f32x4 v = sp[j]; s += (v.x + v.y) + (v.z + v.w); }
            rs[t] = rsqrtf(s * (1.f / DM) + NORM_EPS); }
        __syncthreads(); }
    EpiScore E{(float*)(A->ws + WS_PROJ), DM, wv, rs, (const float*)(A->ws + WS_BIAS3) + (size_t)l * 2 * DM, lds};
    pg8::gemm_phase<EpiScore, pg8::StaticOrder, true, true>(lds, g, S, E, wv); }
__device__ __forceinline__ void PH_peer(LAS unsigned char* lds, int wv, int l_, bool dry = false) { ArgsP A = args_ptr(); const int l = opaque_i(l_);
    const float* MOD = (const float*)(A->ws + WS_MOD); const float* modl = MOD + (size_t)l * 2 * MODW;
    const bool last = (l == DEPTH - 1);
    const float* nmod = MOD + (size_t)(last ? l : l + 1) * 2 * MODW;
    ph_peer4(A, lds, wv, l, modl + 5 * DM, modl + 3 * DM, last ? A->in[29] : A->in[4] + (size_t)(l + 1) * DM, nmod + 0 * DM, nmod + 1 * DM, last, dry); }

__global__ void __launch_bounds__(NTHR, 2) mega_fwd(Args args) {
    extern __shared__ __attribute__((aligned(16))) unsigned char lds_raw[];
    LAS unsigned char* lds = (LAS unsigned char*)lds_raw;
    volatile LAS unsigned* MISC = (volatile LAS unsigned*)(lds + MISC_OFF);
    const int wv = __builtin_amdgcn_readfirstlane((int)(threadIdx.x >> 6));
    if (wv == 0) MISC[lane_id_()] = 0u;
    __syncthreads();
    XcdBarrier bar = xcd_barrier_post((unsigned*)(args_ptr()->ws + WS_CTL) + CW_BAR, MISC + 8, wv);
#define GRID_BAR() do { XcdBarrier b_ = bar; b_.bar = (unsigned*)(args_ptr()->ws + WS_CTL) + CW_BAR; asm volatile("" : "+s"(b_.x), "+s"(b_.w)); xcd_barrier(b_); if (PROBE & 512) xcd_barrier(b_); } while (0)

    ph_prologue(args_ptr(), lds, wv);
    GRID_BAR();
#if PROBE & 1
    ph_prologue(args_ptr(), lds, wv); GRID_BAR();
#endif
    PH_norm1_l0(lds, wv);
    GRID_BAR();
    for (int l = 0; l < DEPTH; ++l) {
#if PROBE & 2
        PH_gemm1(lds, wv, l); GRID_BAR();
#endif
        PH_gemm1(lds, wv, l); GRID_BAR();
#if PROBE & 4
        PH_mixA(lds, wv, l);  GRID_BAR();
#endif
        PH_mixA(lds, wv, l);  GRID_BAR();
#if PROBE & 8
        PH_mixB(lds, wv, l);  GRID_BAR();
#endif
        PH_mixB(lds, wv, l);  GRID_BAR();
#if PROBE & 16
        PH_mixC(lds, wv, l);  GRID_BAR();
#endif
        PH_mixC(lds, wv, l);  GRID_BAR();
#if PROBE & 32
        PH_gemm2(lds, wv, l, true); GRID_BAR();
#endif
        PH_gemm2(lds, wv, l); GRID_BAR();
#if PROBE & 128
        PH_gemm3(lds, wv, l); GRID_BAR();
#endif
        PH_gemm3(lds, wv, l); GRID_BAR();
#if PROBE & 256
        PH_peer(lds, wv, l, true); GRID_BAR();
#endif
        PH_peer(lds, wv, l);
        if (l + 1 < DEPTH) GRID_BAR();
    }
}

extern "C" void kernel_launch(void* const* d_in, const int* in_sizes, int n_in, void* d_out, int out_size, void* d_ws, size_t ws_size, hipStream_t stream) {
    static int grid = 0;
    if (grid == 0) {
        if (n_in != 30 || out_size != NT * DM || ws_size < WS_END + 96 * MiB) { fprintf(stderr, "kernel_launch: unexpected shapes (n_in %d out %d ws %zu)\n", n_in, out_size, ws_size); grid = -1; return; }
        int dev = 0, cus = 0, per_cu = 0;
        if (hipGetDevice(&dev) != hipSuccess || hipDeviceGetAttribute(&cus, hipDeviceAttributeMultiprocessorCount, dev) != hipSuccess) { grid = -1; return; }
        if (hipFuncSetAttribute((const void*)mega_fwd, hipFuncAttributeMaxDynamicSharedMemorySize, LDS_BYTES) != hipSuccess) { fprintf(stderr, "kernel_launch: hipFuncSetAttribute failed\n"); grid = -1; return; }
        if (hipOccupancyMaxActiveBlocksPerMultiprocessor(&per_cu, (const void*)mega_fwd, NTHR, LDS_BYTES) != hipSuccess || per_cu < 1) { fprintf(stderr, "kernel_launch: occupancy query says %d\n", per_cu); (void)hipGetLastError(); per_cu = 1; }
        grid = cus;
    }
    if (grid < 0) return;
    (void)in_sizes;
    if (hipMemsetAsync((char*)d_ws + WS_CTL, 0, CTL_ZERO_BYTES, stream) != hipSuccess) return;
    Args a{};
    for (int i = 0; i < 30; ++i) a.in[i] = (const float*)d_in[i];
    a.out = (float*)d_out; a.ws = (unsigned char*)d_ws;
    hipLaunchKernelGGL(mega_fwd, dim3(grid), dim3(NTHR), LDS_BYTES, stream, a);
}
```

```cpp
#include <hip/hip_runtime.h>
#include <cstdio>
#include <cstdint>
__device__ __forceinline__ int lane_id_() { int r; asm volatile("v_mbcnt_lo_u32_b32 %0, -1, 0\n\tv_mbcnt_hi_u32_b32 %0, -1, %0" : "=v"(r)); return r; }
__device__ __forceinline__ int tid_from(int wave_s) { return wave_s * 64 + lane_id_(); }
namespace pg8 {
#define PG8_LAS __attribute__((address_space(3)))
typedef unsigned short bf16_t;
typedef short bf16x8 __attribute__((ext_vector_type(8)));
typedef float f32x4 __attribute__((ext_vector_type(4)));
typedef unsigned u32x4 __attribute__((ext_vector_type(4)));
constexpr int BM = 256, BK = 64, HALF = 128, HTB = HALF * BK * 2  , STAGE_BYTES = 8 * HTB, NXCD = 8, WGM = 8;

__host__ __device__ __forceinline__ int lds_byte(int r, int c) { const int st = (r >> 4) * 2 + (c >> 5), rr = r & 15, cc = c & 31, ob = rr * 64 + cc * 2; return st * 1024 + (ob ^ (((ob >> 9) & 1) << 5)); }
__host__ __device__ __forceinline__ void stage_rc(int b, int& R, int& C) { const int st = b / 1024, sb = b % 1024, swz = sb ^ (((sb >> 9) & 1) << 5); R = (st >> 1) * 16 + swz / 64; C = (st & 1) * 32 + (swz % 64) / 2; }
__host__ __device__ __forceinline__ int perm32(int rho) { const int n = rho >> 4, i = rho & 15; return 8 * (i >> 2) + 4 * n + (i & 3); }

struct Unit { int pm, pn; };
struct Gemm { const bf16_t* A; const bf16_t* Bt; int M, N, K; };

struct StaticOrder {
    int nM, nN, nwg, G, c;
    __host__ __device__ void init(int M, int N, int G_, int c_) { nM = M / BM; nN = N / BM; nwg = nM * nN; G = G_; c = c_; }
    __host__ __device__ bool next(int i, Unit& u) const {
        const long L = (long)i * G + c; if (L >= nwg) return false;
        int wgid = (int)L; { const int q = nwg / NXCD, r = nwg % NXCD, xcd = wgid % NXCD, off = wgid / NXCD; wgid = (xcd < r ? xcd * (q + 1) : r * (q + 1) + (xcd - r) * q) + off; }
        const int nig = WGM * nN, gid = wgid / nig, fm = gid * WGM, gsz = (nM - fm) < WGM ? (nM - fm) : WGM;
        u.pm = fm + ((wgid % nig) % gsz); u.pn = (wgid % nig) / gsz; return true;
    }
    __device__ __forceinline__ void a_ready(const Unit&) const {}
    __device__ __forceinline__ void done(const Unit&) const {}
};

template <class Epi, class Sched, bool ALIGN_EPI = false, bool SP2 = false>
__device__ __forceinline__ void gemm_phase(PG8_LAS unsigned char* lds, const Gemm g, const Sched& S, const Epi& E, int wave_s) {
    int tid_o = tid_from(wave_s); asm volatile("" : "+v"(tid_o));
    const int tid = tid_o, wid = __builtin_amdgcn_readfirstlane(tid >> 6), lane = tid & 63, wr = wid >> 2, wc = wid & 3, fr = lane & 15, fq = lane >> 4;
    const int K = g.K, nt = K / BK;
    unsigned voffA[2], voffB[2];
#pragma unroll
    for (int i = 0; i < 2; ++i) { int R, C; stage_rc(tid * 16 + i * 8192, R, C); const int Rb = Epi::PERM ? ((R & ~31) + perm32(R & 31)) : R;
        voffA[i] = (unsigned)(R * K + C) * 2u; voffB[i] = (unsigned)(Rb * K + C) * 2u; }
    const size_t kstep = (size_t)(BK * 2);
    const size_t hstep = (size_t)HALF * K * 2;
    const size_t tstep = 2 * hstep;
    const unsigned ldsw = (unsigned)wid * 1024u;
    const int aoff = lds_byte(wr * 64 + fr, fq * 8), boff = lds_byte(wc * 32 + fr, fq * 8);
#define PG8_SA(b, h) (((b) * 2 + (h)) * HTB)
#define PG8_SB(b, h) ((4 + (b) * 2 + (h)) * HTB)
#define PG8_STAGE(bufoff, gbase, voff) do { _Pragma("unroll") for (int _i = 0; _i < 2; ++_i) \
        __builtin_amdgcn_global_load_lds((const unsigned*)((const char*)(gbase) + (voff)[_i]), (PG8_LAS unsigned*)(lds + (bufoff) + ldsw + _i * 8192), 16, 0, 0); } while (0)
#define PG8_LDA(dst, b, h) do { _Pragma("unroll") for (int m = 0; m < 4; ++m) _Pragma("unroll") for (int k = 0; k < 2; ++k) dst[m][k] = *(const PG8_LAS bf16x8*)(lds + PG8_SA(b, h) + aoff + m * 2048 + k * 1024); } while (0)
#define PG8_LDB(dst, b, h) do { _Pragma("unroll") for (int n = 0; n < 2; ++n) _Pragma("unroll") for (int k = 0; k < 2; ++k) dst[n][k] = *(const PG8_LAS bf16x8*)(lds + PG8_SB(b, h) + boff + n * 2048 + k * 1024); } while (0)
#define PG8_MMA(ai, bj, At, Bt) do { __builtin_amdgcn_s_setprio(1); _Pragma("unroll") for (int m = 0; m < 4; ++m) _Pragma("unroll") for (int n = 0; n < 2; ++n) _Pragma("unroll") for (int k = 0; k < 2; ++k) \
        acc[ai][bj][m][n] = __builtin_amdgcn_mfma_f32_16x16x32_bf16(Bt[n][k], At[m][k], acc[ai][bj][m][n], 0, 0, 0); __builtin_amdgcn_s_setprio(0); } while (0)
#define PG8_WAIT_V(n) asm volatile("s_waitcnt vmcnt(" #n ")" ::: "memory")
#define PG8_WAIT_L(n) asm volatile("s_waitcnt lgkmcnt(" #n ")" ::: "memory")
#define PG8_BAR __builtin_amdgcn_s_barrier()
#define PG8_SCHED __builtin_amdgcn_sched_barrier(0)
    Unit cur, nxt; int ui = 0;
    if (!S.next(0, cur)) return;
    f32x4 acc[2][2][4][2];
#pragma unroll
    for (int a = 0; a < 2; ++a)
#pragma unroll
        for (int b = 0; b < 2; ++b)
#pragma unroll
            for (int m = 0; m < 4; ++m)
#pragma unroll
                for (int n = 0; n < 2; ++n) acc[a][b][m][n] = (f32x4){0.f, 0.f, 0.f, 0.f};
    bf16x8 At[4][2], B0[2][2], B1[2][2];
    const char* cA = (const char*)g.A + (size_t)cur.pm * tstep; const char* cB = (const char*)g.Bt + (size_t)cur.pn * tstep;
    S.a_ready(cur);
    if constexpr (SP2) {
        PG8_STAGE(PG8_SB(0, 0), cB, voffB); PG8_STAGE(PG8_SB(0, 1), cB + hstep, voffB); PG8_STAGE(PG8_SA(0, 0), cA, voffA); PG8_STAGE(PG8_SA(0, 1), cA + hstep, voffA);
        if (wr == 1) PG8_BAR;
        PG8_WAIT_V(2); PG8_BAR;
        PG8_STAGE(PG8_SB(1, 0), cB + kstep, voffB); PG8_STAGE(PG8_SA(1, 0), cA + kstep, voffA); PG8_STAGE(PG8_SB(1, 1), cB + hstep + kstep, voffB);
        PG8_WAIT_V(6); PG8_BAR;
    } else {
        PG8_STAGE(PG8_SB(0, 0), cB, voffB); PG8_STAGE(PG8_SA(0, 0), cA, voffA); PG8_STAGE(PG8_SB(0, 1), cB + hstep, voffB); PG8_STAGE(PG8_SA(0, 1), cA + hstep, voffA);
        if (wr == 1) PG8_BAR;
        PG8_WAIT_V(4); PG8_BAR;
        PG8_STAGE(PG8_SB(1, 0), cB + kstep, voffB); PG8_STAGE(PG8_SA(1, 0), cA + kstep, voffA); PG8_STAGE(PG8_SB(1, 1), cB + hstep + kstep, voffB);
        PG8_WAIT_V(6); PG8_BAR;
    }
    for (;;) {
        const bool has_next = S.next(ui + 1, nxt);
        const char* nA = has_next ? (const char*)g.A + (size_t)nxt.pm * tstep : cA; const char* nB = has_next ? (const char*)g.Bt + (size_t)nxt.pn * tstep : cB;
        for (int t = 0; t < nt; t += 2) {
            const bool last = (t == nt - 2);
            const char* a1 = cA + (size_t)(t + 1) * kstep;
            const char* a2 = last ? nA : cA + (size_t)(t + 2) * kstep; const char* b2 = last ? nB : cB + (size_t)(t + 2) * kstep;
            const char* a3 = a2 + kstep; const char* b3 = b2 + kstep;
            if (last && has_next) S.a_ready(nxt);
            if constexpr (SP2) {
            PG8_LDB(B0, 0, 0); PG8_LDB(B1, 0, 1); PG8_SCHED; PG8_LDA(At, 0, 0); PG8_STAGE(PG8_SA(1, 1), a1 + hstep, voffA);
            PG8_WAIT_V(8); PG8_WAIT_L(0); PG8_BAR; PG8_MMA(0, 0, At, B0); PG8_MMA(0, 1, At, B1); PG8_BAR; PG8_SCHED;
            PG8_LDA(At, 0, 1); PG8_STAGE(PG8_SB(0, 0), b2, voffB); PG8_STAGE(PG8_SB(0, 1), b2 + hstep, voffB); PG8_STAGE(PG8_SA(0, 0), a2, voffA);
            PG8_WAIT_V(8); PG8_WAIT_L(0); PG8_BAR; PG8_MMA(1, 0, At, B0); PG8_MMA(1, 1, At, B1); PG8_BAR; PG8_SCHED;
            PG8_LDB(B0, 1, 0); PG8_LDB(B1, 1, 1); PG8_SCHED; PG8_LDA(At, 1, 0); PG8_STAGE(PG8_SA(0, 1), a2 + hstep, voffA);
            PG8_WAIT_V(8); PG8_WAIT_L(0); PG8_BAR; PG8_MMA(0, 0, At, B0); PG8_MMA(0, 1, At, B1); PG8_BAR; PG8_SCHED;
            PG8_LDA(At, 1, 1); PG8_STAGE(PG8_SB(1, 0), b3, voffB); PG8_STAGE(PG8_SB(1, 1), b3 + hstep, voffB); PG8_STAGE(PG8_SA(1, 0), a3, voffA);
            PG8_WAIT_V(8); PG8_WAIT_L(0); PG8_BAR; PG8_MMA(1, 0, At, B0); PG8_MMA(1, 1, At, B1); PG8_BAR; PG8_SCHED;
            } else {
            PG8_LDB(B0, 0, 0); PG8_SCHED; PG8_LDA(At, 0, 0); PG8_STAGE(PG8_SA(1, 1), a1 + hstep, voffA);
            PG8_WAIT_L(8); PG8_BAR; PG8_WAIT_L(0); PG8_MMA(0, 0, At, B0); PG8_BAR; PG8_SCHED;
            PG8_LDB(B1, 0, 1); PG8_STAGE(PG8_SB(0, 0), b2, voffB);
            PG8_BAR; PG8_WAIT_L(0); PG8_MMA(0, 1, At, B1); PG8_BAR;
            PG8_LDA(At, 0, 1); PG8_STAGE(PG8_SA(0, 0), a2, voffA);
            PG8_BAR; PG8_WAIT_L(0); PG8_MMA(1, 0, At, B0); PG8_BAR; PG8_SCHED;
            PG8_STAGE(PG8_SB(0, 1), b2 + hstep, voffB);
            PG8_WAIT_V(6); PG8_BAR; PG8_MMA(1, 1, At, B1); PG8_BAR;
            PG8_LDB(B0, 1, 0); PG8_SCHED; PG8_LDA(At, 1, 0); PG8_STAGE(PG8_SA(0, 1), a2 + hstep, voffA);
            PG8_WAIT_L(8); PG8_BAR; PG8_WAIT_L(0); PG8_MMA(0, 0, At, B0); PG8_BAR; PG8_SCHED;
            PG8_LDB(B1, 1, 1); PG8_STAGE(PG8_SB(1, 0), b3, voffB);
            PG8_BAR; PG8_WAIT_L(0); PG8_MMA(0, 1, At, B1); PG8_BAR;
            PG8_LDA(At, 1, 1); PG8_STAGE(PG8_SA(1, 0), a3, voffA);
            PG8_BAR; PG8_WAIT_L(0); PG8_MMA(1, 0, At, B0); PG8_BAR; PG8_SCHED;
            PG8_STAGE(PG8_SB(1, 1), b3 + hstep, voffB);
            PG8_WAIT_V(6); PG8_BAR; PG8_MMA(1, 1, At, B1); PG8_BAR;
            }
        }
        if constexpr (ALIGN_EPI) { if (wr == 0) PG8_BAR; }
        if constexpr (!Epi::AFTER_DRAIN) { E(acc, cur, wr, wc, fr, fq); S.done(cur); }
        if (!has_next) break;
#pragma unroll
        for (int a = 0; a < 2; ++a)
#pragma unroll
            for (int b = 0; b < 2; ++b)
#pragma unroll
                for (int m = 0; m < 4; ++m)
#pragma unroll
                    for (int n = 0; n < 2; ++n) acc[a][b][m][n] = (f32x4){0.f, 0.f, 0.f, 0.f};
        cur = nxt; cA = nA; cB = nB; ++ui;
        if constexpr (ALIGN_EPI) { if (wr == 1) PG8_BAR; }
    }
    PG8_WAIT_V(0);
    if constexpr (!ALIGN_EPI) { if (wr == 0) PG8_BAR; }
    PG8_BAR;
    if constexpr (Epi::AFTER_DRAIN) { E.fused(acc, cur, wr, wc, fr, fq, lds, wid, lane); S.done(cur); }
#undef PG8_SA
#undef PG8_SB
#undef PG8_STAGE
#undef PG8_LDA
#undef PG8_LDB
#undef PG8_MMA
#undef PG8_WAIT_V
#undef PG8_WAIT_L
#undef PG8_BAR
#undef PG8_SCHED
}
}
#define GAS __attribute__((address_space(1)))
#define LAS __attribute__((address_space(3)))
#define XB_TMO      128
#define XB_XCNT(j)  (256  + 64 * (j))
#define XB_XSUB(j)  (1280 + 64 * (j))
#define XB_XGEN(j)  (2304 + 64 * (j))
#define XB_TOP      3328
#define XB_TOPGEN   3392
#define XCD_BAR_WORDS 3456
#define XB_SPIN_CAP (1u << 18)

__device__ __forceinline__ unsigned xb_ld(unsigned* p)              { return __hip_atomic_load(p, __ATOMIC_RELAXED, __HIP_MEMORY_SCOPE_AGENT); }
__device__ __forceinline__ unsigned xb_add(unsigned* p, unsigned v) { return __hip_atomic_fetch_add(p, v, __ATOMIC_RELAXED, __HIP_MEMORY_SCOPE_AGENT); }
__device__ __forceinline__ unsigned xb_xcc_id() { return (unsigned)__builtin_amdgcn_s_getreg((3 << 11) | 20) & 0xFu; }
#define XB_SPIN(cond, bar) do { unsigned _sp = 0; while (cond) { __builtin_amdgcn_s_sleep(1); \
    if ((++_sp & 255u) == 0u) { if (xb_ld(&(bar)[XB_TMO])) break; if (_sp > XB_SPIN_CAP) { atomicAdd(&(bar)[XB_TMO], 1u); break; } } } } while (0)

struct XcdBarrier {
    unsigned* bar; unsigned x; int w;
    volatile LAS unsigned* st;
};

__device__ __forceinline__ XcdBarrier xcd_barrier_post(unsigned* bar, volatile LAS unsigned* st, int wave_s) {
    XcdBarrier b; b.bar = bar; b.x = xb_xcc_id(); b.st = st; b.w = wave_s;
    if (tid_from(wave_s) == 0) (void)xb_add(&bar[XB_XCNT(b.x)], 1u);
    return b;
}
__device__ __forceinline__ void xcd_barrier_complete(unsigned* bar, unsigned x, unsigned& nloc, unsigned& nx) {
    const unsigned G = gridDim.x * gridDim.y * gridDim.z;
    unsigned sum, cnt, mine, sp = 0u;
    for (;;) {
        sum = 0u; cnt = 0u; mine = 0u;
#pragma unroll
        for (unsigned j = 0; j < 16; ++j) { const unsigned c = xb_ld(&bar[XB_XCNT(j)]); sum += c; cnt += (c > 0u) ? 1u : 0u; mine = (j == x) ? c : mine; }
        if (sum == G) break;
        __builtin_amdgcn_s_sleep(1);
        if ((++sp & 255u) == 0u) { if (xb_ld(&bar[XB_TMO])) break; if (sp > XB_SPIN_CAP) { atomicAdd(&bar[XB_TMO], 1u); break; } }
    }
    nloc = mine > 0u ? mine : 1u; nx = cnt > 0u ? cnt : 1u;
}

__device__ __forceinline__ void xcd_barrier(const XcdBarrier& b) {
    asm volatile("s_waitcnt vmcnt(0)" ::: "memory");
    __syncthreads();
    if (tid_from(b.w) == 0) {
        unsigned* bar = b.bar;
        __builtin_amdgcn_s_waitcnt(0);
        unsigned nloc = b.st[0], nx = b.st[1];
        if (nloc == 0u) { xcd_barrier_complete(bar, b.x, nloc, nx); b.st[0] = nloc; b.st[1] = nx; }
        const unsigned old = xb_add(&bar[XB_XSUB(b.x)], 1u);
        const unsigned gen = old / nloc;
        if (old + 1u == (gen + 1u) * nloc) {
            __builtin_amdgcn_fence(__ATOMIC_RELEASE, "agent");
            asm volatile("s_waitcnt vmcnt(0)" ::: "memory");
            const unsigned og = xb_add(&bar[XB_TOP], 1u);
            const unsigned tg = og / nx;
            if (og + 1u == (tg + 1u) * nx) xb_add(&bar[XB_TOPGEN], 1u);
            else XB_SPIN(xb_ld(&bar[XB_TOPGEN]) == tg, bar);
            __builtin_amdgcn_fence(__ATOMIC_ACQUIRE, "agent");
            xb_add(&bar[XB_XGEN(b.x)], 1u);
            asm volatile("s_waitcnt vmcnt(0)" ::: "memory");
        } else {
            XB_SPIN(xb_ld(&bar[XB_XGEN(b.x)]) == gen, bar);
            __builtin_amdgcn_fence(__ATOMIC_ACQUIRE, "agent");
            asm volatile("s_waitcnt vmcnt(0)" ::: "memory");
        }
    }
    __syncthreads();
}

constexpr int NWAVES = 8, NTHR = 512;
constexpr int DM = 2048, NB = 2, SEQ = 4096, NT = NB * SEQ, DEPTH = 4;
constexpr int INW = 5392, INWP = 5632;
constexpr int C_POOL = 0, C_GQ = 512, C_GK = 896, C_GV = 1280, C_GG = 2048, C_GA = 2816, C_RW = 2832;
constexpr int RW_IN = 2560, RW_W = 768, RW_H = 12;
constexpr int GLA_H = 4, GLA_DK = 96, GLA_DV = 192, GLA_NCH = 64;
constexpr int PEER_N = 16384;
constexpr float NORM_EPS = 1e-6f;
constexpr int MODW = 6 * DM;

constexpr size_t MiB = 1u << 20;
constexpr size_t WS_CTL = 0, CTL_ZERO_BYTES = 1 * MiB;
constexpr size_t WS_MOD = 1 * MiB;
constexpr size_t WS_WIN = 2 * MiB;
constexpr size_t WS_WOUT = 90 * MiB;
constexpr size_t WS_WQK = 122 * MiB;
constexpr size_t WS_U = 154 * MiB;
constexpr size_t WS_V = 410 * MiB;
constexpr size_t WS_US = 540 * MiB;
constexpr size_t WS_VS = 541 * MiB;
constexpr size_t WS_POOLT = 545 * MiB;
constexpr size_t WS_LORAT = 542 * MiB;
constexpr size_t WS_X = 666 * MiB;
constexpr size_t WS_H = 730 * MiB;
constexpr size_t WS_Y = 762 * MiB;
constexpr size_t WS_PROJ = 794 * MiB;
constexpr size_t WS_GKV = 970 * MiB;
constexpr size_t WS_GS = 1006 * MiB;
constexpr size_t WS_GDEC = 1042 * MiB;
constexpr size_t WS_RSC = 1043 * MiB;
constexpr size_t WS_RO = 1187 * MiB;
constexpr size_t WS_RGATE = 1211 * MiB;
constexpr size_t WS_RBV = 1235 * MiB;
constexpr size_t WS_EIDX = 1259 * MiB;
constexpr size_t WS_EGATE = 1263 * MiB;
constexpr size_t WS_END = 1267 * MiB;
constexpr size_t WS_DUMMY = 1267 * MiB;
#ifndef PROBE
#define PROBE 0
#endif
constexpr int CW_BAR = 4096;
constexpr size_t WS_SSP = 547 * MiB;
constexpr size_t WS_BIAS3 = 546 * MiB;

#ifndef QUANT_EARLY
#define QUANT_EARLY 10240
#endif
constexpr int EPI_XCH_OFF = 132096;
constexpr int LDS_BYTES = 147456;
constexpr int MISC_OFF = 147456 - 256;

typedef unsigned short bf16;
typedef unsigned v4u __attribute__((ext_vector_type(4)));
typedef unsigned v2u __attribute__((ext_vector_type(2)));
typedef float f32x4 __attribute__((ext_vector_type(4)));
typedef float f32x2 __attribute__((ext_vector_type(2)));
typedef __bf16 bf16x2_t __attribute__((ext_vector_type(2)));
typedef int v4i __attribute__((ext_vector_type(4)));

__device__ __forceinline__ unsigned pk2(float lo, float hi) { const f32x2 f = {lo, hi}; return __builtin_bit_cast(unsigned, __builtin_convertvector(f, bf16x2_t)); }
__device__ __forceinline__ unsigned f2bf(float f) { return pk2(f, f) & 0xffffu; }
__device__ __forceinline__ float bflo(unsigned u) { return __builtin_bit_cast(float, u << 16); }
__device__ __forceinline__ float bfhi(unsigned u) { return __builtin_bit_cast(float, u & 0xffff0000u); }
__device__ __forceinline__ float dpp_xor1(float v) { return __builtin_bit_cast(float, __builtin_amdgcn_update_dpp(0, __builtin_bit_cast(int, v), 0xB1, 0xF, 0xF, true)); }
__device__ __forceinline__ float dpp_xor2(float v) { return __builtin_bit_cast(float, __builtin_amdgcn_update_dpp(0, __builtin_bit_cast(int, v), 0x4E, 0xF, 0xF, true)); }
__device__ __forceinline__ float dpp_hmir(float v) { return __builtin_bit_cast(float, __builtin_amdgcn_update_dpp(0, __builtin_bit_cast(int, v), 0x141, 0xF, 0xF, true)); }
__device__ __forceinline__ float dpp_rmir(float v) { return __builtin_bit_cast(float, __builtin_amdgcn_update_dpp(0, __builtin_bit_cast(int, v), 0x140, 0xF, 0xF, true)); }
__device__ __forceinline__ float rl_f(float v, int l) { return __builtin_bit_cast(float, __builtin_amdgcn_readlane(__builtin_bit_cast(int, v), l)); }
__device__ __forceinline__ float row16_sum(float v) { v += dpp_xor1(v); v += dpp_xor2(v); v += dpp_hmir(v); v += dpp_rmir(v); return v; }
__device__ __forceinline__ float row16_max(float v) { v = fmaxf(v, dpp_xor1(v)); v = fmaxf(v, dpp_xor2(v)); v = fmaxf(v, dpp_hmir(v)); v = fmaxf(v, dpp_rmir(v)); return v; }
__device__ __forceinline__ float wave_sum(float v) { v = row16_sum(v); return (rl_f(v, 0) + rl_f(v, 16)) + (rl_f(v, 32) + rl_f(v, 48)); }
__device__ __forceinline__ float wave_max(float v) { v = row16_max(v); return fmaxf(fmaxf(rl_f(v, 0), rl_f(v, 16)), fmaxf(rl_f(v, 32), rl_f(v, 48))); }
__device__ __forceinline__ float half32_sum(float v, int lane) { v = row16_sum(v); const float lo = rl_f(v, 0) + rl_f(v, 16), hi = rl_f(v, 32) + rl_f(v, 48); return lane < 32 ? lo : hi; }
__device__ __forceinline__ float red8(float v) { v += dpp_xor1(v); v += dpp_xor2(v); v += dpp_hmir(v); return v; }
__device__ __forceinline__ float sigmoidf_(float x) { return __builtin_amdgcn_rcpf(1.f + __builtin_amdgcn_exp2f(-1.4426950408889634f * x)); }
__device__ __forceinline__ float softplusf_(float x) { return fmaxf(x, 0.f) + 0.6931471805599453f * __builtin_amdgcn_logf(1.f + __builtin_amdgcn_exp2f(-1.4426950408889634f * fabsf(x))); }

struct Args { const float* in[30]; float* out; unsigned char* ws; };
typedef const __attribute__((address_space(4))) Args* ArgsP;
__device__ __forceinline__ ArgsP args_ptr() { ArgsP p = (ArgsP)__builtin_amdgcn_kernarg_segment_ptr(); asm volatile("" : "+s"(p)); return p; }
__device__ __forceinline__ int opaque_i(int v) { asm volatile("" : "+s"(v)); return v; }

struct Frame {
    LAS unsigned char* lds;
    int tid, lane, wave, G, bid, gw, ngw;
};
__device__ __forceinline__ Frame make_frame(LAS unsigned char* lds, int wave_s) {
    asm volatile("" : "+s"(wave_s)); Frame F; F.lds = lds; int t = tid_from(wave_s); asm volatile("" : "+v"(t));
    F.tid = t; F.lane = t & 63; F.wave = __builtin_amdgcn_readfirstlane(t >> 6); int g_ = gridDim.x, b_ = blockIdx.x; asm volatile("" : "+s"(g_), "+s"(b_)); F.G = g_; F.bid = b_; F.gw = F.bid * NWAVES + F.wave; F.ngw = F.G * NWAVES; return F;
}

struct EpiStoreF32 {
    static constexpr bool PERM = false, AFTER_DRAIN = false;
    float* C; int ldc; int ws_; LAS unsigned char* lds_;
    __device__ __forceinline__ void operator()(const pg8::f32x4 (&acc)[2][2][4][2], const pg8::Unit& u, int, int, int, int) const {
        int tz = tid_from(ws_); asm volatile("" : "+v"(tz)); const int wid = tz >> 6, lane = tz & 63, wr = wid >> 2, wc = wid & 3, fr = lane & 15, fq = lane >> 4;
        LAS pg8::f32x4* tb = (LAS pg8::f32x4*)(lds_ + EPI_XCH_OFF + wid * 1024);
        float* base = C + (size_t)(u.pm * 256 + wr * 64 + (lane >> 2)) * ldc + u.pn * 256 + wc * 32 + 4 * (lane & 3);
#pragma unroll
        for (int ai = 0; ai < 2; ++ai)
#pragma unroll
            for (int m = 0; m < 4; ++m) { float* rowp = base + (size_t)(ai * 128 + m * 16) * ldc;
#pragma unroll
                for (int bj = 0; bj < 2; ++bj)
#pragma unroll
                    for (int n = 0; n < 2; ++n) { tb[fr * 4 + fq] = acc[ai][bj][m][n]; const pg8::f32x4 v = tb[lane]; *(pg8::f32x4*)(rowp + bj * 128 + n * 16) = v; } }
    }
};
struct EpiResid {
    static constexpr bool PERM = false, AFTER_DRAIN = false;
    const float* xsrc; float* xdst; const float* gate; int ws_; const float* gain2; const float* sc2; bf16* hdst; float* ss; LAS unsigned char* lds_;
    __device__ __forceinline__ void operator()(const pg8::f32x4 (&acc)[2][2][4][2], const pg8::Unit& u, int, int, int, int) const {
        int tz = tid_from(ws_); asm volatile("" : "+v"(tz)); const int wid = tz >> 6, lane = tz & 63, wr = wid >> 2, wc = wid & 3, fr = lane & 15, fq = lane >> 4;
        LAS pg8::f32x4* tb = (LAS pg8::f32x4*)(lds_ + EPI_XCH_OFF + wid * 1024);
        const int row0 = u.pm * 256 + wr * 64 + (lane >> 2), col0 = u.pn * 256 + wc * 32 + 4 * (lane & 3);
        const float* gp = gate + (size_t)(u.pm >> 4) * MODW + col0; const float* sp = sc2 + (size_t)(u.pm >> 4) * MODW + col0;
        pg8::f32x4 gv[2][2], hv[2][2];
#pragma unroll
        for (int bj = 0; bj < 2; ++bj)
#pragma unroll
            for (int n = 0; n < 2; ++n) { gv[bj][n] = *(const pg8::f32x4*)(gp + bj * 128 + n * 16);
                hv[bj][n] = *(const pg8::f32x4*)(gain2 + col0 + bj * 128 + n * 16) * (*(const pg8::f32x4*)(sp + bj * 128 + n * 16) + 1.f); }
#pragma unroll
        for (int ai = 0; ai < 2; ++ai)
#pragma unroll
            for (int m = 0; m < 4; ++m) { const int row = row0 + ai * 128 + m * 16; const size_t ro = (size_t)row * DM + col0; float s = 0.f;
                pg8::f32x4 xv[2][2];
#pragma unroll
                for (int bj = 0; bj < 2; ++bj)
#pragma unroll
                    for (int n = 0; n < 2; ++n) xv[bj][n] = *(const pg8::f32x4*)(xsrc + ro + bj * 128 + n * 16);
#pragma unroll
                for (int bj = 0; bj < 2; ++bj)
#pragma unroll
                    for (int n = 0; n < 2; ++n) { tb[fr * 4 + fq] = acc[ai][bj][m][n]; const pg8::f32x4 av = tb[lane];
                        const pg8::f32x4 y = xv[bj][n] + gv[bj][n] * av;
                        *(pg8::f32x4*)(xdst + ro + bj * 128 + n * 16) = y;
                        s += (y.x * y.x + y.y * y.y) + (y.z * y.z + y.w * y.w);
                        const pg8::f32x4 hh = y * hv[bj][n]; v2u pk; pk.x = pk2(hh.x, hh.y); pk.y = pk2(hh.z, hh.w); *(v2u*)(hdst + ro + bj * 128 + n * 16) = pk; }
                s += dpp_xor1(s); s += dpp_xor2(s);
                if ((lane & 3) == 0) ss[(size_t)row * 32 + u.pn * 4 + wc] = s; }
    }
};
struct EpiScore {
    static constexpr bool PERM = false, AFTER_DRAIN = false;
    float* C; int ldc; int ws_; const LAS float* rs; const float* bias; LAS unsigned char* lds_;
    __device__ __forceinline__ void operator()(const pg8::f32x4 (&acc)[2][2][4][2], const pg8::Unit& u, int, int, int, int) const {
        int tz = tid_from(ws_); asm volatile("" : "+v"(tz)); const int wid = tz >> 6, lane = tz & 63, wr = wid >> 2, wc = wid & 3, fr = lane & 15, fq = lane >> 4;
        LAS pg8::f32x4* tb = (LAS pg8::f32x4*)(lds_ + EPI_XCH_OFF + wid * 1024);
        const int row0 = u.pm * 256 + wr * 64 + (lane >> 2), col0 = u.pn * 256 + wc * 32 + 4 * (lane & 3);
        const float* bp = bias + (size_t)(u.pm >> 4) * DM + col0;
        pg8::f32x4 bv[2][2];
#pragma unroll
        for (int bj = 0; bj < 2; ++bj)
#pragma unroll
            for (int n = 0; n < 2; ++n) bv[bj][n] = *(const pg8::f32x4*)(bp + bj * 128 + n * 16);
#pragma unroll
        for (int ai = 0; ai < 2; ++ai)
#pragma unroll
            for (int m = 0; m < 4; ++m) { const int row = row0 + ai * 128 + m * 16; float* rowp = C + (size_t)row * ldc + col0;
                const float rstd = rs[row & 255];
#pragma unroll
                for (int bj = 0; bj < 2; ++bj)
#pragma unroll
                    for (int n = 0; n < 2; ++n) { tb[fr * 4 + fq] = acc[ai][bj][m][n]; const pg8::f32x4 av = tb[lane]; *(pg8::f32x4*)(rowp + bj * 128 + n * 16) = av * rstd + bv[bj][n]; } }
    }
};

__device__ __forceinline__ void quant_tables(ArgsP A, int l, int wvi, int nw, int lane, int r_begin = 0, int r_end = 2 * PEER_N) {
    int rr = r_begin + wvi;
    if (rr >= r_end) return;
    f32x4 nv[8];
    { const int tb0 = rr >= PEER_N; const f32x4* s0 = (const f32x4*)(A->in[27 + tb0] + (size_t)(l * PEER_N + (rr - tb0 * PEER_N)) * DM) + lane;
#pragma unroll
        for (int j = 0; j < 8; ++j) nv[j] = __builtin_nontemporal_load(s0 + 64 * j); }
#pragma unroll 1
    for (; rr < r_end; rr += nw) {
        const int tb = rr >= PEER_N, r = l * PEER_N + (rr - tb * PEER_N);
        f32x4 v[8]; float mx = 0.f;
        float ssq = 0.f;
#pragma unroll
        for (int j = 0; j < 8; ++j) v[j] = nv[j];
        { const int rn = rr + nw < r_end ? rr + nw : rr, tbn = rn >= PEER_N;
            const f32x4* sn = (const f32x4*)(A->in[27 + tbn] + (size_t)(l * PEER_N + (rn - tbn * PEER_N)) * DM) + lane;
#pragma unroll
            for (int j = 0; j < 8; ++j) nv[j] = __builtin_nontemporal_load(sn + 64 * j); }
#pragma unroll
        for (int j = 0; j < 8; ++j) { mx = fmaxf(mx, fmaxf(fmaxf(fabsf(v[j].x), fabsf(v[j].y)), fmaxf(fabsf(v[j].z), fabsf(v[j].w)))); ssq += (v[j].x * v[j].x + v[j].y * v[j].y) + (v[j].z * v[j].z + v[j].w * v[j].w); }
        mx = wave_max(mx);
        mx = fminf(mx, (tb ? 3.0f : 2.5f) * sqrtf(wave_sum(ssq) * (1.f / DM)));
        unsigned* dst = (unsigned*)(A->ws + (tb ? WS_V : WS_U)) + (size_t)r * (DM / 4) + lane;
        if (!tb) { const float inv = mx > 0.f ? 7.f / mx : 0.f;
            unsigned* dst4 = (unsigned*)(A->ws + WS_U) + (size_t)r * (DM / 8) + lane;
#pragma unroll
            for (int j = 0; j < 4; ++j) { unsigned wd = 0u;
                const float lo4[4] = {v[j].x, v[j].y, v[j].z, v[j].w}, hi4[4] = {v[j + 4].x, v[j + 4].y, v[j + 4].z, v[j + 4].w};
#pragma unroll
                for (int i = 0; i < 4; ++i) { const unsigned nl = (unsigned)((int)rintf(fminf(fmaxf(lo4[i] * inv, -7.f), 7.f)) + 8), nh = (unsigned)((int)rintf(fminf(fmaxf(hi4[i] * inv, -7.f), 7.f)) + 8); wd |= (nl | (nh << 4)) << (8 * i); }
                dst4[64 * j] = wd; }
            if (lane == 0) ((float*)(A->ws + WS_US))[r] = mx * (1.f / 7.f);
        } else { const float inv = mx > 0.f ? 6.f / mx : 0.f;
            unsigned short* dstv = (unsigned short*)(A->ws + WS_V) + (size_t)r * (DM / 4) + (lane & 31) * 8;
#pragma unroll
            for (int j = 0; j < 8; ++j) { const f32x4 c4 = __builtin_elementwise_min(__builtin_elementwise_max(v[j] * inv, (f32x4){-6.f, -6.f, -6.f, -6.f}), (f32x4){6.f, 6.f, 6.f, 6.f});
                int p = __builtin_amdgcn_cvt_scalef32_pk_fp4_f32(0, c4.x, c4.y, 1.0f, 0); p = __builtin_amdgcn_cvt_scalef32_pk_fp4_f32(p, c4.z, c4.w, 1.0f, 1);
                dstv[(j >> 2) * 256 + (((j & 3) << 1) | (lane >> 5))] = (unsigned short)p; }
            if (lane == 0) ((float*)(A->ws + WS_VS))[r] = mx * (1.f / 6.f);
        }
    }
}

__device__ __forceinline__ void transpose_item(const float* W, int K, int N, bf16* WT, LAS float* scr, int kb, int nb, int lane) {
    const int k0 = 64 * kb, n0 = 64 * nb, nl = (lane & 15) * 4, kr = lane >> 4;
    f32x4 v[16];
#pragma unroll
    for (int it = 0; it < 16; ++it) v[it] = (n0 + nl < N) ? *(const f32x4*)(W + (size_t)(k0 + it * 4 + kr) * N + n0 + nl) : (f32x4){0.f, 0.f, 0.f, 0.f};
#pragma unroll
    for (int it = 0; it < 16; ++it) { LAS float* s = scr + (it * 4 + kr) * 65 + nl; s[0] = v[it].x; s[1] = v[it].y; s[2] = v[it].z; s[3] = v[it].w; }
    asm volatile("s_waitcnt lgkmcnt(0)" ::: "memory");
    const int c = lane & 7;
#pragma unroll
    for (int j = 0; j < 8; ++j) { const int n = (lane >> 3) + 8 * j; const LAS float* s = scr + (8 * c) * 65 + n;
        v4u o; o.x = pk2(s[0 * 65], s[1 * 65]); o.y = pk2(s[2 * 65], s[3 * 65]); o.z = pk2(s[4 * 65], s[5 * 65]); o.w = pk2(s[6 * 65], s[7 * 65]);
        if (n0 + n < N) *(v4u*)(WT + (size_t)(n0 + n) * K + k0 + 8 * c) = o; }
    asm volatile("s_waitcnt lgkmcnt(0)" ::: "memory");
}

__device__ __forceinline__ void ph_prologue(ArgsP A, LAS unsigned char* lds_, int wv_) {
    const Frame F = make_frame(lds_, wv_);
    LAS float* ldsf = (LAS float*)F.lds;
    const int tid = F.tid, lane = F.lane, wave = F.wave;
    for (int i = tid; i < NB * DM; i += NTHR) { const float c = A->in[1][i]; ldsf[i] = c / (1.f + __expf(-c)); }
    __syncthreads();
    {
        LAS float* red = ldsf + 4096;
        float* MOD = (float*)(A->ws + WS_MOD);
        for (int u = F.bid; u < DEPTH * 96; u += F.G) {
            const int l = u / 96, j0 = (u % 96) * 128;
            const float* W = A->in[2] + (size_t)l * DM * MODW + j0 + lane * 2;
            float a00 = 0.f, a01 = 0.f, a10 = 0.f, a11 = 0.f;
            const int k0 = wave * 256;
#pragma unroll 8
            for (int k = k0; k < k0 + 256; ++k) { const f32x2 w = *(const f32x2*)(W + (size_t)k * MODW); const float c0 = ldsf[k], c1 = ldsf[DM + k];
                a00 += c0 * w.x; a01 += c0 * w.y; a10 += c1 * w.x; a11 += c1 * w.y; }
            red[(wave * 2 + 0) * 128 + lane * 2] = a00; red[(wave * 2 + 0) * 128 + lane * 2 + 1] = a01;
            red[(wave * 2 + 1) * 128 + lane * 2] = a10; red[(wave * 2 + 1) * 128 + lane * 2 + 1] = a11;
            __syncthreads();
            if (tid < 256) { const int b = tid >> 7, j = tid & 127; float s = 0.f;
#pragma unroll
                for (int w = 0; w < 8; ++w) s += red[(w * 2 + b) * 128 + j];
                s += A->in[3][(size_t)l * MODW + j0 + j];
                MOD[(size_t)(l * 2 + b) * MODW + j0 + j] = s; }
            __syncthreads();
        }
    }
    {
        LAS float* scr = ldsf + wave * 4160;
        constexpr int NBI = (INW + 63) / 64;
        constexpr int I_IN = 32 * NBI, I_OUT = 32 * 32, I_L = I_IN + I_OUT;
        for (int it = F.gw; it < DEPTH * I_L; it += F.ngw) {
            const int l = it / I_L; int r = it % I_L;
            if (r < I_IN) transpose_item(A->in[5] + (size_t)l * DM * INW, DM, INW, (bf16*)(A->ws + WS_WIN) + (size_t)l * INWP * DM, scr, r / NBI, r % NBI, lane);
            else { r -= I_IN; transpose_item(A->in[22] + (size_t)l * DM * DM, DM, DM, (bf16*)(A->ws + WS_WOUT) + (size_t)l * DM * DM, scr, r / 32, r % 32, lane); }
        }
        constexpr int PADV = (INWP - INW) * DM / 8;
        for (int i = F.bid * NTHR + tid; i < DEPTH * PADV; i += F.G * NTHR) { const int l = i / PADV, r = i % PADV;
            ((v4u*)((bf16*)(A->ws + WS_WIN) + (size_t)l * INWP * DM + (size_t)INW * DM))[r] = (v4u){0u, 0u, 0u, 0u}; }
    }
    __syncthreads();
    {
        LAS float* Ks = ldsf;
        LAS float* Ws = ldsf + 128 * 132;
        for (int u = F.bid; u < DEPTH * 16 * 32; u += F.G) {
            const int l = u >> 9, hh = (u >> 5) & 15, jt = u & 31, h = hh >> 1, half = hh & 1, j0 = jt * 64;
            const float* ksrc = (half ? A->in[26] : A->in[25]) + ((size_t)l * 8 + h) * 128 * 128;
            const float* wsrc = A->in[24] + (size_t)l * DM * DM + h * 256 + half * 128;
            {   f32x4 kq[8], wq4[4];
#pragma unroll
                for (int it = 0; it < 8; ++it) { const int i = tid + it * NTHR, n = i >> 5, d4 = (i & 31) * 4; kq[it] = *(const f32x4*)(ksrc + n * 128 + d4); }
#pragma unroll
                for (int it = 0; it < 4; ++it) { const int i = tid + it * NTHR, jj = i >> 5, d4 = (i & 31) * 4; wq4[it] = *(const f32x4*)(wsrc + (size_t)(j0 + jj) * DM + d4); }
#pragma unroll
                for (int it = 0; it < 8; ++it) { const int i = tid + it * NTHR, n = i >> 5, d4 = (i & 31) * 4; *(LAS f32x4*)(Ks + n * 132 + d4) = kq[it]; }
#pragma unroll
                for (int it = 0; it < 4; ++it) { const int i = tid + it * NTHR, jj = i >> 5, d4 = (i & 31) * 4; *(LAS f32x4*)(Ws + jj * 132 + d4) = wq4[it]; }
            }
            __syncthreads();
            { const int li = lane & 15, lq = lane >> 4;
                f32x4 acc[4] = {{0.f, 0.f, 0.f, 0.f}, {0.f, 0.f, 0.f, 0.f}, {0.f, 0.f, 0.f, 0.f}, {0.f, 0.f, 0.f, 0.f}};
#pragma unroll 4
                for (int ks = 0; ks < 32; ++ks) { const float a = Ks[(wave * 16 + li) * 132 + 4 * ks + lq];
#pragma unroll
                    for (int jt = 0; jt < 4; ++jt) acc[jt] = __builtin_amdgcn_mfma_f32_16x16x4f32(a, Ws[(jt * 16 + li) * 132 + 4 * ks + lq], acc[jt], 0, 0, 0); }
                bf16* dst = (bf16*)(A->ws + WS_WQK) + (size_t)l * DM * DM + (size_t)(h * 256 + half * 128 + wave * 16 + lq * 4) * DM + j0 + li;
#pragma unroll
                for (int jt = 0; jt < 4; ++jt) { dst[(size_t)0 * DM + jt * 16] = (bf16)f2bf(acc[jt].x); dst[(size_t)1 * DM + jt * 16] = (bf16)f2bf(acc[jt].y); dst[(size_t)2 * DM + jt * 16] = (bf16)f2bf(acc[jt].z); dst[(size_t)3 * DM + jt * 16] = (bf16)f2bf(acc[jt].w); } }
            __syncthreads();
        }
    }
    {
        bf16* PT = (bf16*)(A->ws + WS_POOLT);
        for (int i = F.bid * NTHR + tid; i < DEPTH * 4 * 128 * 128; i += F.G * NTHR) { const int lg = i >> 14, r = i & 16383, dcol = r >> 7, c = r & 127;
            PT[i] = (bf16)f2bf(A->in[6][(size_t)lg * 16384 + c * 128 + dcol]); }
    }
    {
        bf16* LT = (bf16*)(A->ws + WS_LORAT);
        for (int i = F.bid * NTHR + tid; i < DEPTH * RW_W * 256; i += F.G * NTHR) { const int l = i / (RW_W * 256), r = i % (RW_W * 256), c = r >> 8, j = r & 255;
            const float v = j < 64 ? A->in[13][((size_t)l * 64 + j) * RW_W + c] : (j < 128 ? A->in[15][((size_t)l * 64 + (j - 64)) * RW_W + c] : A->in[16][((size_t)l * 128 + (j - 128)) * RW_W + c]);
            LT[i] = (bf16)f2bf(v); }
    }
    quant_tables(A, 0, F.gw, F.ngw, lane);
}

__device__ __forceinline__ void ph_norm(const float* xsrc, const float* gain, const float* sh, const float* sc, bf16* hout, LAS unsigned char* lds_, int wv_) {
    const Frame F = make_frame(lds_, wv_);
    for (int m = F.gw; m < NT; m += F.ngw) {
        const int b = m >> 12;
        const f32x4* xr = (const f32x4*)(xsrc + (size_t)m * DM) + F.lane;
        f32x4 v[8]; float ss = 0.f;
#pragma unroll
        for (int j = 0; j < 8; ++j) { v[j] = xr[64 * j]; ss += (v[j].x * v[j].x + v[j].y * v[j].y) + (v[j].z * v[j].z + v[j].w * v[j].w); }
        const float rstd = rsqrtf(wave_sum(ss) * (1.f / DM) + NORM_EPS);
        v2u* o8 = (v2u*)(hout + (size_t)m * DM) + F.lane;
#pragma unroll
        for (int j = 0; j < 8; ++j) { const int col = j * 256 + F.lane * 4;
            const f32x4 g = *(const f32x4*)(gain + col), s1 = *(const f32x4*)(sc + (size_t)b * MODW + col), s0 = *(const f32x4*)(sh + (size_t)b * MODW + col);
            const f32x4 y = v[j] * rstd * g * (s1 + 1.f) + s0;
            v2u o; o.x = pk2(y.x, y.y); o.y = pk2(y.z, y.w); o8[64 * j] = o; }
    }
}
__device__ __forceinline__ void ph_final(const float* xsrc, const float* gain, float* out, LAS unsigned char* lds_, int wv_) {
    const Frame F = make_frame(lds_, wv_);
    for (int m = F.gw; m < NT; m += F.ngw) {
        const f32x4* xr = (const f32x4*)(xsrc + (size_t)m * DM) + F.lane;
        f32x4 v[8]; float ss = 0.f;
#pragma unroll
        for (int j = 0; j < 8; ++j) { v[j] = xr[64 * j]; ss += (v[j].x * v[j].x + v[j].y * v[j].y) + (v[j].z * v[j].z + v[j].w * v[j].w); }
        const float rstd = rsqrtf(wave_sum(ss) * (1.f / DM) + NORM_EPS);
        f32x4* o = (f32x4*)(out + (size_t)m * DM) + F.lane;
#pragma unroll
        for (int j = 0; j < 8; ++j) { const f32x4 g = *(const f32x4*)(gain + j * 256 + F.lane * 4); o[64 * j] = v[j] * rstd * g; }
    }
}

__device__ __forceinline__ void pool_unit(ArgsP A, const Frame& F_in, int l, int unit) {
    Frame F = F_in; asm volatile("" : "+v"(F.tid)); F.lane = F.tid & 63;
    const int tile = unit >> 2, g = unit & 3, t0 = tile * 32, s0 = t0 & (SEQ - 1), tid = F.tid, lane = F.lane, w = F.wave;
    const int win = 2 << g;
    const float* proj = (const float*)(A->ws + WS_PROJ);
    LAS float* ps = (LAS float*)F.lds;
    LAS unsigned short* ds = (LAS unsigned short*)(F.lds + 24064);
    const int rt = w >> 2, ct0 = (w & 3) * 2, li = lane & 15, lq = lane >> 4;
    typedef short b8 __attribute__((ext_vector_type(8)));
    b8 bw[2][4];
    { const unsigned short* PT = (const unsigned short*)(A->ws + WS_POOLT) + ((size_t)l * 4 + g) * 16384;
#pragma unroll
        for (int j = 0; j < 2; ++j)
#pragma unroll
            for (int ks = 0; ks < 4; ++ks) bw[j][ks] = *(const b8*)(PT + (size_t)((ct0 + j) * 16 + li) * 128 + ks * 32 + lq * 8); }
    {   f32x4 pq[3];
#pragma unroll
        for (int it = 0; it < 3; ++it) { const int i = tid + it * NTHR, r = i >> 5, c4 = i & 31; const int s = s0 - 15 + r;
            pq[it] = (i < 47 * 32 && s >= 0) ? *(const f32x4*)(proj + (size_t)(t0 - 15 + r) * INWP + C_POOL + g * 128 + c4 * 4) : (f32x4){0.f, 0.f, 0.f, 0.f}; }
#pragma unroll
        for (int it = 0; it < 3; ++it) { const int i = tid + it * NTHR; if (i < 47 * 32) *(LAS f32x4*)(ps + i * 4) = pq[it]; }
    }
    __syncthreads();
    for (int i = tid; i < 32 * 128; i += NTHR) { const int tok = i >> 7, c = i & 127; float sum = 0.f;
        for (int ww = 0; ww < win; ++ww) sum += ps[(tok + 15 - ww) * 128 + c];
        const int cnt = (s0 + tok + 1) < win ? (s0 + tok + 1) : win;
        ds[tok * 136 + c] = (unsigned short)f2bf(sum * __builtin_amdgcn_rcpf((float)cnt) - ps[(tok + 15) * 128 + c]); }
    __syncthreads();
    f32x4 acc[2] = {{0.f, 0.f, 0.f, 0.f}, {0.f, 0.f, 0.f, 0.f}};
#pragma unroll
    for (int ks = 0; ks < 4; ++ks) { const b8 a = *(const LAS b8*)(ds + (rt * 16 + li) * 136 + ks * 32 + lq * 8);
#pragma unroll
        for (int j = 0; j < 2; ++j) acc[j] = __builtin_amdgcn_mfma_f32_16x16x32_bf16(a, bw[j][ks], acc[j], 0, 0, 0); }
    bf16* Y = (bf16*)(A->ws + WS_Y);
#pragma unroll
    for (int j = 0; j < 2; ++j) { const int dcol = (ct0 + j) * 16 + li; const float scale = A->in[7][(size_t)l * 512 + g * 128 + dcol]; const int tk = t0 + rt * 16 + lq * 4;
        Y[(size_t)(tk + 0) * DM + g * 128 + dcol] = (bf16)f2bf(acc[j].x * scale); Y[(size_t)(tk + 1) * DM + g * 128 + dcol] = (bf16)f2bf(acc[j].y * scale);
        Y[(size_t)(tk + 2) * DM + g * 128 + dcol] = (bf16)f2bf(acc[j].z * scale); Y[(size_t)(tk + 3) * DM + g * 128 + dcol] = (bf16)f2bf(acc[j].w * scale); }
    __syncthreads();
}

__device__ __forceinline__ void gla_bcum(ArgsP A, const Frame& F, int l, int h, int t0, LAS float* bcum, LAS float* ad, LAS float* up) {
    const float* proj = (const float*)(A->ws + WS_PROJ);
    const int tid = F.tid;
    {
        const float a0 = proj[(size_t)(t0 + (tid >> 4)) * INWP + C_GA + (tid & 15)], a1 = proj[(size_t)(t0 + 32 + (tid >> 4)) * INWP + C_GA + (tid & 15)];
        const float* upg = A->in[8] + (size_t)l * 16 * 384 + h * 96;
        const float u0 = upg[(tid / 96) * 384 + tid % 96], u1 = upg[((tid + 512) / 96) * 384 + (tid + 512) % 96], u2 = upg[((tid + 1024) / 96) * 384 + (tid + 1024) % 96];
        ad[tid] = a0; ad[tid + 512] = a1; up[tid] = u0; up[tid + 512] = u1; up[tid + 1024] = u2;
    }
    __syncthreads();
    for (int i = tid; i < 64 * 96; i += NTHR) { const int tok = i / 96, d = i % 96; float x = A->in[9][(size_t)l * 384 + h * 96 + d];
#pragma unroll
        for (int j = 0; j < 16; ++j) x += ad[tok * 16 + j] * up[j * 96 + d];
        bcum[i] = -softplusf_(-x) * (1.f / 16.f); }
    __syncthreads();
    if (tid < 384) { const int d = tid % 96, seg = tid / 96; float acc = 0.f;
#pragma unroll
        for (int k = 0; k < 16; ++k) { acc += bcum[(seg * 16 + k) * 96 + d]; bcum[(seg * 16 + k) * 96 + d] = acc; }
        ad[seg * 96 + d] = acc; }
    __syncthreads();
    if (tid < 384) { const int d = tid % 96, seg = tid / 96; float pre = 0.f;
#pragma unroll
        for (int s2 = 0; s2 < 3; ++s2) pre += (s2 < seg) ? ad[s2 * 96 + d] : 0.f;
        if (seg > 0) {
#pragma unroll
            for (int k = 0; k < 16; ++k) bcum[(seg * 16 + k) * 96 + d] += pre; } }
    __syncthreads();
}

__device__ __forceinline__ void gla_scan_unit(ArgsP A, const Frame& F, int unit) {
    const int idx = unit * NTHR + F.tid, bh = idx / 18432, rem = idx % 18432, d = rem % 96;
    const float* KV = (const float*)(A->ws + WS_GKV) + (size_t)bh * 64 * 18432 + rem;
    float* GS = (float*)(A->ws + WS_GS) + (size_t)bh * 64 * 18432 + rem;
    const float* DEC = (const float*)(A->ws + WS_GDEC) + (size_t)bh * 64 * 96 + d;
    float S = 0.f;
#pragma unroll 1
    for (int c0 = 0; c0 < 64; c0 += 16) {
        float kv[16], dc[16];
#pragma unroll
        for (int j = 0; j < 16; ++j) { kv[j] = KV[(size_t)(c0 + j) * 18432]; dc[j] = DEC[(c0 + j) * 96]; }
#pragma unroll
        for (int j = 0; j < 16; ++j) { GS[(size_t)(c0 + j) * 18432] = S; S = dc[j] * S + kv[j]; }
    }
}

typedef short bf16x8_t __attribute__((ext_vector_type(8)));
constexpr int RS = 68;
__device__ __forceinline__ f32x4 tile_mm64(const LAS bf16* Am, int arow0, const LAS bf16* Bm, int brow0, f32x4 acc, int lane) {
    const int r = lane & 15, kq = (lane >> 4) * 8;
#pragma unroll
    for (int ks = 0; ks < 2; ++ks) {
        const bf16x8_t a = *(const LAS bf16x8_t*)(Am + (arow0 + r) * RS + ks * 32 + kq);
        const bf16x8_t b = *(const LAS bf16x8_t*)(Bm + (brow0 + r) * RS + ks * 32 + kq);
        acc = __builtin_amdgcn_mfma_f32_16x16x32_bf16(a, b, acc, 0, 0, 0);
    }
    return acc;
}
constexpr int RA_BT = 0, RA_KT = 8704, RA_AT = 17408, RA_RT = 26112, RA_RABS = 34816, RA_BHT = 43520, RA_KHT = 52224, RA_VT = 60928, RA_AABS = 69632,
              RA_MBAT = 86272, RA_MKA = 103680, RA_NBRT = 121088, RA_GC = 129792, RA_WT = 130048, RA_NKRT = 132096, RA_END = 140800, RA_PRE = 94976;
constexpr int RA_Z = RA_BT, RA_QST = RA_AT, RA_QOT = RA_RT, RA_LO = 0, RA_RES = 34816;
constexpr size_t RWO_POT = 0, RWO_PST = 12 * MiB, RWO_GT = 24 * MiB, RWO_OLT = 48 * MiB, RWO_SC = 72 * MiB;

__device__ __forceinline__ void rwkvA_unit(ArgsP A, const Frame& F_in, int l, int unit) {
    Frame F = F_in; asm volatile("" : "+v"(F.tid)); F.lane = F.tid & 63;

    const int bh = unit >> 6, c = unit & 63, b = bh / RW_H, h = bh % RW_H, t0 = b * SEQ + c * 64, s0 = c * 64, tid = F.tid, lane = F.lane, w = F.wave;
    const float* proj = (const float*)(A->ws + WS_PROJ);
    const float* mu = A->in[11] + (size_t)l * RW_IN;
    LAS unsigned char* L = F.lds;
    const int n = lane, cc = h * 64 + n;
    const int rt1 = w >> 1, ct1 = (w & 1) * 2, li1 = lane & 15, lq1 = lane >> 4;
    f32x4 yc[8], yp[8];
#pragma unroll
    for (int it = 0; it < 8; ++it) { const int g = tid + it * NTHR, tok = g >> 6, j4 = (g & 63) * 4; const float* rp = proj + ((size_t)t0 + tok) * INWP + C_RW + 2304 + j4;
        yc[it] = *(const f32x4*)rp; yp[it] = (s0 + tok > 0) ? *(const f32x4*)(rp - INWP) : (f32x4){0.f, 0.f, 0.f, 0.f}; }
    bf16x8_t bw[2][8];
    { const bf16* LT = (const bf16*)(A->ws + WS_LORAT) + ((size_t)l * RW_W + h * 64) * 256;
#pragma unroll
        for (int j = 0; j < 2; ++j)
#pragma unroll
            for (int ks = 0; ks < 8; ++ks) bw[j][ks] = *(const bf16x8_t*)(LT + (size_t)((ct1 + j) * 16 + li1) * 256 + ks * 32 + lq1 * 8); }
    float rr[9], kr[9], vr[9];
#pragma unroll
    for (int i = 0; i < 9; ++i) { const int tok = w * 8 + i - 1; const bool ok = (s0 + tok >= 0); const float* row = proj + ((size_t)t0 + tok) * INWP + C_RW;
        rr[i] = ok ? row[cc] : 0.f; kr[i] = ok ? row[768 + cc] : 0.f; vr[i] = ok ? row[1536 + cc] : 0.f; }
    const float w0c = A->in[12][(size_t)l * RW_W + cc], a0c = A->in[14][(size_t)l * RW_W + cc], kkc = A->in[17][(size_t)l * RW_W + cc], kac = A->in[18][(size_t)l * RW_W + cc], rkc = A->in[19][(size_t)l * RW_W + cc];
    const float mur = mu[cc], muk = mu[768 + cc], muv = mu[1536 + cc];
    {   LAS bf16* lo = (LAS bf16*)(L + RA_LO);
#pragma unroll
        for (int it = 0; it < 8; ++it) { const int g = tid + it * NTHR, tok = g >> 6, j4 = (g & 63) * 4; const f32x4 m4 = *(const f32x4*)(mu + 2304 + j4);
            const f32x4 ym = yc[it] + (yp[it] - yc[it]) * m4;
            const float sc = j4 < 64 ? 2.f : 1.f; f32x4 sg; sg.x = sigmoidf_(ym.x * sc); sg.y = sigmoidf_(ym.y * sc); sg.z = sigmoidf_(ym.z * sc); sg.w = sigmoidf_(ym.w * sc);
            const f32x4 o = j4 < 64 ? sg * 2.f - 1.f : (j4 < 128 ? ym : sg);
            v2u pk; pk.x = pk2(o.x, o.y); pk.y = pk2(o.z, o.w); *(LAS v2u*)(lo + tok * 264 + j4) = pk; }
    }
    __syncthreads();
    {
        const int rt = rt1, ct0 = ct1, li = li1, lq = lq1;
        const LAS bf16* lo = (const LAS bf16*)(L + RA_LO);
        LAS float* res = (LAS float*)(L + RA_RES);
        f32x4 acc[3][2];
#pragma unroll
        for (int p = 0; p < 3; ++p)
#pragma unroll
            for (int j = 0; j < 2; ++j) acc[p][j] = (f32x4){0.f, 0.f, 0.f, 0.f};
#pragma unroll
        for (int ks = 0; ks < 8; ++ks) { const bf16x8_t a = *(const LAS bf16x8_t*)(lo + (rt * 16 + li) * 264 + ks * 32 + lq * 8);
            const int p = ks < 2 ? 0 : (ks < 4 ? 1 : 2);
#pragma unroll
            for (int j = 0; j < 2; ++j) acc[p][j] = __builtin_amdgcn_mfma_f32_16x16x32_bf16(a, bw[j][ks], acc[p][j], 0, 0, 0); }
#pragma unroll
        for (int p = 0; p < 3; ++p)
#pragma unroll
            for (int j = 0; j < 2; ++j) { LAS float* rp = res + p * 64 * 68 + (rt * 16 + lq * 4) * 68 + (ct0 + j) * 16 + li;
                rp[0] = acc[p][j].x; rp[68] = acc[p][j].y; rp[136] = acc[p][j].z; rp[204] = acc[p][j].w; }
    }
    __syncthreads();
    float r_[8], k_[8], v_[8], av_[8], bb_[8], lw_[8];
    {
        const LAS float* res = (const LAS float*)(L + RA_RES);
        float wl[8], al[8], gl[8];
#pragma unroll
        for (int i = 0; i < 8; ++i) { wl[i] = res[(w * 8 + i) * 68 + n]; al[i] = res[64 * 68 + (w * 8 + i) * 68 + n]; gl[i] = res[2 * 64 * 68 + (w * 8 + i) * 68 + n]; }
        float* GATE = (float*)(A->ws + WS_RGATE); float* BV = (float*)(A->ws + WS_RBV);
#pragma unroll
        for (int i = 0; i < 8; ++i) { const int tok = w * 8 + i; const size_t t = (size_t)t0 + tok;
            float r = rr[i + 1], k = kr[i + 1], v = vr[i + 1];
            r += (rr[i] - r) * mur; k += (kr[i] - k) * muk; v += (vr[i] - v) * muv;
            const float wraw = -softplusf_(-(w0c + wl[i])) - 0.5f;
            const float a = sigmoidf_(a0c + al[i]);
            float kk = k * kkc; kk = kk * __builtin_amdgcn_rsqf(fmaxf(wave_sum(kk * kk), 1e-24f));
            const float k2 = k * (1.f + (a - 1.f) * kac);
            const float bonus = wave_sum(r * k2 * rkc);
            r_[i] = r; k_[i] = k2; v_[i] = v; av_[i] = -kk; bb_[i] = kk * a; lw_[i] = -__expf(wraw);
            GATE[t * RW_W + cc] = gl[i]; BV[t * RW_W + cc] = bonus * v; }
    }
    LAS float* wt = (LAS float*)(L + RA_WT);
#pragma unroll
    for (int i = 1; i < 8; ++i) lw_[i] += lw_[i - 1];
    wt[w * 64 + n] = lw_[7];
    __syncthreads();
    float pre = 0.f, mid = 0.f, last = 0.f;
#pragma unroll
    for (int ww = 0; ww < 8; ++ww) { const float x = wt[ww * 64 + n]; pre += (ww < w) ? x : 0.f; mid += (ww < 4) ? x : 0.f; last += x; }
    {
        LAS bf16* Bt = (LAS bf16*)(L + RA_BT); LAS bf16* Kt = (LAS bf16*)(L + RA_KT); LAS bf16* At = (LAS bf16*)(L + RA_AT); LAS bf16* Rt = (LAS bf16*)(L + RA_RT);
        LAS bf16* Rab = (LAS bf16*)(L + RA_RABS); LAS bf16* BhT = (LAS bf16*)(L + RA_BHT); LAS bf16* KhT = (LAS bf16*)(L + RA_KHT); LAS bf16* VT = (LAS bf16*)(L + RA_VT);
        LAS float* AabT = (LAS float*)(L + RA_AABS);
#pragma unroll
        for (int i = 0; i < 8; ++i) { const int t = w * 8 + i; const float lw = pre + lw_[i], lwm1 = pre + (i > 0 ? lw_[i - 1] : 0.f);
            const float eg = __expf(lw - mid), egi = __expf(mid - lw), egm1 = __expf(lwm1 - mid), eh = __expf(last - lw);
            Bt[t * RS + n] = (bf16)f2bf(bb_[i] * egi); Kt[t * RS + n] = (bf16)f2bf(k_[i] * egi); At[t * RS + n] = (bf16)f2bf(av_[i] * egm1); Rt[t * RS + n] = (bf16)f2bf(r_[i] * eg);
            Rab[t * RS + n] = (bf16)f2bf(r_[i] * __expf(lw)); AabT[n * 65 + t] = av_[i] * __expf(lwm1);
            BhT[n * RS + t] = (bf16)f2bf(bb_[i] * eh); KhT[n * RS + t] = (bf16)f2bf(k_[i] * eh); VT[n * RS + t] = (bf16)f2bf(v_[i]); }
        if (w == 0) ((LAS float*)(L + RA_GC))[n] = __expf(last);
    }
    __syncthreads();
    const int rt = w >> 1, ct0 = (w & 1) * 2, li = lane & 15, lq = lane >> 4;
#define FRAG(mat_, row_, ks_) (*(const LAS bf16x8_t*)((mat_) + ((row_) + li) * RS + (ks_) * 32 + lq * 8))
#define MM(a_, b_, c_) __builtin_amdgcn_mfma_f32_16x16x32_bf16(a_, b_, c_, 0, 0, 0)
    {
        const LAS bf16* Bt = (const LAS bf16*)(L + RA_BT); const LAS bf16* Kt = (const LAS bf16*)(L + RA_KT); const LAS bf16* At = (const LAS bf16*)(L + RA_AT); const LAS bf16* Rt = (const LAS bf16*)(L + RA_RT);
        LAS bf16* MbaT = (LAS bf16*)(L + RA_MBAT); LAS float* Mka = (LAS float*)(L + RA_MKA); LAS bf16* NbrT = (LAS bf16*)(L + RA_NBRT);
        bf16x8_t aB[2], aK[2], bA[2][2], bR[2][2];
#pragma unroll
        for (int ks = 0; ks < 2; ++ks) { aB[ks] = FRAG(Bt, rt * 16, ks); aK[ks] = FRAG(Kt, rt * 16, ks);
#pragma unroll
            for (int j = 0; j < 2; ++j) { bA[j][ks] = FRAG(At, (ct0 + j) * 16, ks); bR[j][ks] = FRAG(Rt, (ct0 + j) * 16, ks); } }
#pragma unroll
        for (int j = 0; j < 2; ++j) { const int ct = ct0 + j, tcol = ct * 16 + li, srow = rt * 16 + lq * 4;
            const f32x4 z = {0.f, 0.f, 0.f, 0.f};
            f32x4 mba = MM(aB[1], bA[j][1], MM(aB[0], bA[j][0], z)), nbr = MM(aB[1], bR[j][1], MM(aB[0], bR[j][0], z));
            f32x4 mka = MM(aK[1], bA[j][1], MM(aK[0], bA[j][0], z)), nk = MM(aK[1], bR[j][1], MM(aK[0], bR[j][0], z));
            mba.x = (srow + 0 < tcol) ? mba.x : 0.f; mba.y = (srow + 1 < tcol) ? mba.y : 0.f; mba.z = (srow + 2 < tcol) ? mba.z : 0.f; mba.w = (srow + 3 < tcol) ? mba.w : 0.f;
            mka.x = (srow + 0 < tcol) ? mka.x : 0.f; mka.y = (srow + 1 < tcol) ? mka.y : 0.f; mka.z = (srow + 2 < tcol) ? mka.z : 0.f; mka.w = (srow + 3 < tcol) ? mka.w : 0.f;
            nbr.x = (srow + 0 <= tcol) ? nbr.x : 0.f; nbr.y = (srow + 1 <= tcol) ? nbr.y : 0.f; nbr.z = (srow + 2 <= tcol) ? nbr.z : 0.f; nbr.w = (srow + 3 <= tcol) ? nbr.w : 0.f;
            nk.x = (srow + 0 <= tcol) ? nk.x : 0.f; nk.y = (srow + 1 <= tcol) ? nk.y : 0.f; nk.z = (srow + 2 <= tcol) ? nk.z : 0.f; nk.w = (srow + 3 <= tcol) ? nk.w : 0.f;
            { v2u pm; pm.x = pk2(mba.x, mba.y); pm.y = pk2(mba.z, mba.w); *(LAS v2u*)(MbaT + tcol * RS + srow) = pm; }
            Mka[(srow + 0) * RS + tcol] = mka.x; Mka[(srow + 1) * RS + tcol] = mka.y; Mka[(srow + 2) * RS + tcol] = mka.z; Mka[(srow + 3) * RS + tcol] = mka.w;
            v2u pk; pk.x = pk2(nbr.x, nbr.y); pk.y = pk2(nbr.z, nbr.w); *(LAS v2u*)(NbrT + tcol * RS + srow) = pk;
            { v2u pn; pn.x = pk2(nk.x, nk.y); pn.y = pk2(nk.z, nk.w); *(LAS v2u*)((LAS bf16*)(L + RA_NKRT) + tcol * RS + srow) = pn; } }
    }
    __syncthreads();
    {
        int t4 = tid; asm volatile("" : "+v"(t4)); const int row = t4 >> 2, q = t4 & 3, l4 = t4 & 63, li4 = l4 & 15, lq4 = l4 >> 4;
        const LAS bf16* MbaT = (const LAS bf16*)(L + RA_MBAT);
        const LAS float* Yrow = (row < 64) ? ((const LAS float*)(L + RA_AABS) + row * 65) : ((const LAS float*)(L + RA_MKA) + (row - 64) * RS);
        LAS bf16* Z = (LAS bf16*)(L + RA_Z); LAS float* pre = (LAS float*)(L + RA_PRE);
        for (int i = t4; i < 1088; i += NTHR) ((LAS v4u*)Z)[i] = (v4u){0u, 0u, 0u, 0u};
        __syncthreads();
#pragma unroll 1
        for (int jb = 0; jb < 4; ++jb) {
            if (jb > 0) {
                f32x4 acc = {0.f, 0.f, 0.f, 0.f};
#pragma unroll
                for (int ks = 0; ks < 2; ++ks) { const bf16x8_t a = *(const LAS bf16x8_t*)(Z + (w * 16 + li4) * RS + ks * 32 + lq4 * 8);
                    const bf16x8_t bm = *(const LAS bf16x8_t*)(MbaT + (jb * 16 + li4) * RS + ks * 32 + lq4 * 8);
                    acc = __builtin_amdgcn_mfma_f32_16x16x32_bf16(a, bm, acc, 0, 0, 0); }
                LAS float* pp = pre + (w * 16 + lq4 * 4) * 16 + li4;
                pp[0] = acc.x; pp[16] = acc.y; pp[32] = acc.z; pp[48] = acc.w;
                __syncthreads();
            }
            float yv[16]; v2u mv[16];
#pragma unroll
            for (int u = 0; u < 16; ++u) { yv[u] = Yrow[jb * 16 + u] + (jb > 0 ? pre[row * 16 + u] : 0.f); mv[u] = *(const LAS v2u*)(MbaT + (jb * 16 + u) * RS + jb * 16 + q * 4); }
            float zb[4] = {0.f, 0.f, 0.f, 0.f};
#pragma unroll
            for (int u = 0; u < 16; ++u) {
                float part = (zb[0] * bflo(mv[u].x) + zb[1] * bfhi(mv[u].x)) + (zb[2] * bflo(mv[u].y) + zb[3] * bfhi(mv[u].y));
                part += dpp_xor1(part); part += dpp_xor2(part);
                const float zt = yv[u] + part;
                zb[u & 3] = (q == (u >> 2)) ? zt : zb[u & 3];
            }
            { v2u pk; pk.x = pk2(zb[0], zb[1]); pk.y = pk2(zb[2], zb[3]); *(LAS v2u*)(Z + row * RS + jb * 16 + q * 4) = pk; }
            __syncthreads();
        }
    }
    {
        int t5 = tid; asm volatile("" : "+v"(t5)); const int li = t5 & 15, lq = (t5 >> 4) & 3;
        const LAS bf16* Z = (const LAS bf16*)(L + RA_Z); const LAS bf16* NbrT = (const LAS bf16*)(L + RA_NBRT); const LAS bf16* BhT = (const LAS bf16*)(L + RA_BHT);
        const LAS bf16* Rab = (const LAS bf16*)(L + RA_RABS); const LAS bf16* KhT = (const LAS bf16*)(L + RA_KHT); const LAS float* gC = (const LAS float*)(L + RA_GC);
        LAS bf16* QsT = (LAS bf16*)(L + RA_QST); LAS bf16* QoT = (LAS bf16*)(L + RA_QOT);
        bf16* PoT = (bf16*)(A->ws + WS_RSC + RWO_POT) + (size_t)unit * 4096; bf16* PsT = (bf16*)(A->ws + WS_RSC + RWO_PST) + (size_t)unit * 4096;
        bf16x8_t zW[2], zX[2], bN[2][2], bH[2][2]; v2u rb[2], kb[2], nb2[2]; float gc[2];
#pragma unroll
        for (int ks = 0; ks < 2; ++ks) { zW[ks] = FRAG(Z, rt * 16, ks); zX[ks] = FRAG(Z, 64 + rt * 16, ks);
#pragma unroll
            for (int j = 0; j < 2; ++j) { bN[j][ks] = FRAG(NbrT, (ct0 + j) * 16, ks); bH[j][ks] = FRAG(BhT, (ct0 + j) * 16, ks); } }
#pragma unroll
        for (int j = 0; j < 2; ++j) { const int col = (ct0 + j) * 16 + li, rw = rt * 16 + lq * 4; rb[j] = *(const LAS v2u*)(Rab + col * RS + rw); kb[j] = *(const LAS v2u*)(KhT + col * RS + rw); nb2[j] = *(const LAS v2u*)((const LAS bf16*)(L + RA_NKRT) + col * RS + rw); gc[j] = gC[col]; }
#pragma unroll
        for (int j = 0; j < 2; ++j) { const int col = (ct0 + j) * 16 + li, rw = rt * 16 + lq * 4;
            { f32x4 acc = {bflo(rb[j].x), bfhi(rb[j].x), bflo(rb[j].y), bfhi(rb[j].y)};
                acc = MM(zW[1], bN[j][1], MM(zW[0], bN[j][0], acc));
                v2u pk; pk.x = pk2(acc.x, acc.y); pk.y = pk2(acc.z, acc.w); *(v2u*)(PoT + (size_t)col * 64 + rw) = pk; }
            { f32x4 acc = {(rw + 0 == col) ? gc[j] : 0.f, (rw + 1 == col) ? gc[j] : 0.f, (rw + 2 == col) ? gc[j] : 0.f, (rw + 3 == col) ? gc[j] : 0.f};
                acc = MM(zW[1], bH[j][1], MM(zW[0], bH[j][0], acc));
                v2u pk; pk.x = pk2(acc.x, acc.y); pk.y = pk2(acc.z, acc.w); *(v2u*)(PsT + (size_t)col * 64 + rw) = pk; }
            { f32x4 acc = {bflo(nb2[j].x), bfhi(nb2[j].x), bflo(nb2[j].y), bfhi(nb2[j].y)};
                acc = MM(zX[1], bN[j][1], MM(zX[0], bN[j][0], acc));
                v2u pk; pk.x = pk2(acc.x, acc.y); pk.y = pk2(acc.z, acc.w); *(LAS v2u*)(QoT + col * RS + rw) = pk; }
            { f32x4 acc = {bflo(kb[j].x), bfhi(kb[j].x), bflo(kb[j].y), bfhi(kb[j].y)};
                acc = MM(zX[1], bH[j][1], MM(zX[0], bH[j][0], acc));
                v2u pk; pk.x = pk2(acc.x, acc.y); pk.y = pk2(acc.z, acc.w); *(LAS v2u*)(QsT + col * RS + rw) = pk; }
        }
    }
    __syncthreads();
    {
        int t6 = tid; asm volatile("" : "+v"(t6)); const int li = t6 & 15, lq = (t6 >> 4) & 3;
        const LAS bf16* VT = (const LAS bf16*)(L + RA_VT);
        const bool isO = (w & 1);
        const LAS bf16* Bm = (const LAS bf16*)(L + (isO ? RA_QOT : RA_QST));
        float* dst = (float*)(A->ws + WS_RSC + (isO ? RWO_OLT : RWO_GT)) + (size_t)unit * 4096;
        bf16x8_t av[2], bq[4][2];
#pragma unroll
        for (int ks = 0; ks < 2; ++ks) { av[ks] = FRAG(VT, rt * 16, ks);
#pragma unroll
            for (int j = 0; j < 4; ++j) bq[j][ks] = FRAG(Bm, j * 16, ks); }
#pragma unroll
        for (int j = 0; j < 4; ++j) { const f32x4 z = {0.f, 0.f, 0.f, 0.f};
            const f32x4 acc = MM(av[1], bq[j][1], MM(av[0], bq[j][0], z));
            *(f32x4*)(dst + (size_t)(j * 16 + li) * 64 + rt * 16 + lq * 4) = acc; }
    }
#undef FRAG
#undef MM
    __syncthreads();
}

__device__ __forceinline__ void rwkvB_scan(ArgsP A, const Frame& F, int unit) {
    const int bh = unit >> 2, rq = unit & 3;
    const int tid = F.tid, lane = F.lane, w = F.wave, ct = w & 3, li = lane & 15, lq = lane >> 4;
    const bool writer = (w < 4);
    const bf16* PsT = (const bf16*)(A->ws + WS_RSC + RWO_PST) + (size_t)bh * 64 * 4096; const float* GT = (const float*)(A->ws + WS_RSC + RWO_GT) + (size_t)bh * 64 * 4096;
    bf16* SC = (bf16*)(A->ws + WS_RSC + RWO_SC) + (size_t)bh * 64 * 4096;
    f32x4 S = {0.f, 0.f, 0.f, 0.f};
    constexpr int PF = 4;
    bf16x8_t pb[PF][2]; f32x4 gq[PF];
    const int col = ct * 16 + li;
#define SLOAD(slot, cc_) do { _Pragma("unroll") for (int ks = 0; ks < 2; ++ks) pb[slot][ks] = *(const bf16x8_t*)(PsT + (size_t)(cc_) * 4096 + (size_t)col * 64 + ks * 32 + lq * 8); \
        gq[slot] = *(const f32x4*)(GT + (size_t)(cc_) * 4096 + (size_t)col * 64 + rq * 16 + lq * 4); } while (0)
#define SSTEP(slot, cc_) do { LAS bf16* Sl = (LAS bf16*)(F.lds + ((cc_) & 1) * 2176); \
        if (writer) { const int rw_ = lq * 4; Sl[(rw_ + 0) * RS + col] = (bf16)f2bf(S.x); Sl[(rw_ + 1) * RS + col] = (bf16)f2bf(S.y); Sl[(rw_ + 2) * RS + col] = (bf16)f2bf(S.z); Sl[(rw_ + 3) * RS + col] = (bf16)f2bf(S.w); } \
        asm volatile("s_waitcnt lgkmcnt(0)" ::: "memory"); __builtin_amdgcn_s_barrier(); asm volatile("" ::: "memory");        \
        if (tid < 128) { const int v_ = tid >> 3, k8_ = (tid & 7) * 8; *(v4u*)(SC + (size_t)(cc_) * 4096 + (rq * 16 + v_) * 64 + k8_) = *(const LAS v4u*)(Sl + v_ * RS + k8_); } \
        f32x4 acc_ = gq[slot]; \
        _Pragma("unroll") for (int ks = 0; ks < 2; ++ks) { const bf16x8_t a_ = *(const LAS bf16x8_t*)(Sl + li * RS + ks * 32 + lq * 8); \
            acc_ = __builtin_amdgcn_mfma_f32_16x16x32_bf16(a_, pb[slot][ks], acc_, 0, 0, 0); } \
        S = acc_; } while (0)
    SLOAD(0, 0); SLOAD(1, 1); SLOAD(2, 2); SLOAD(3, 3);
#pragma unroll 1
    for (int c = 0; c < 64; c += 4) {
        const int cn = (c + 4 < 64) ? c + 4 : 60;
        SSTEP(0, c);     SLOAD(0, cn);
        SSTEP(1, c + 1); SLOAD(1, cn + 1);
        SSTEP(2, c + 2); SLOAD(2, cn + 2);
        SSTEP(3, c + 3); SLOAD(3, cn + 3);
    }
#undef SLOAD
#undef SSTEP
    __syncthreads();
}

__device__ __forceinline__ void rwkvC_unit(ArgsP A, const Frame& F_in, int l, int unit) {
    Frame F = F_in; asm volatile("" : "+v"(F.tid)); F.lane = F.tid & 63;

    const int bh = unit >> 6, c = unit & 63, b = bh / RW_H, h = bh % RW_H, t0 = b * SEQ + c * 64, tid = F.tid, lane = F.lane, w = F.wave;
    const int rt = w >> 1, ct0 = (w & 1) * 2, li = lane & 15, lq = lane >> 4;
    LAS bf16* Sl = (LAS bf16*)F.lds; LAS bf16* Pl = (LAS bf16*)(F.lds + 8704); LAS float* ob = (LAS float*)(F.lds + 17408);
    { const int r = tid >> 3, k8 = (tid & 7) * 8;
        *(LAS v4u*)(Sl + r * RS + k8) = *(const v4u*)((const bf16*)(A->ws + WS_RSC + RWO_SC) + (size_t)unit * 4096 + r * 64 + k8);
        *(LAS v4u*)(Pl + r * RS + k8) = *(const v4u*)((const bf16*)(A->ws + WS_RSC + RWO_POT) + (size_t)unit * 4096 + r * 64 + k8); }
    __syncthreads();
    const float* OlT = (const float*)(A->ws + WS_RSC + RWO_OLT) + (size_t)unit * 4096;
#pragma unroll
    for (int j = 0; j < 2; ++j) { const int tcol = (ct0 + j) * 16 + li, vr = rt * 16 + lq * 4;
        f32x4 acc = *(const f32x4*)(OlT + (size_t)tcol * 64 + vr);
        acc = tile_mm64(Sl, rt * 16, Pl, (ct0 + j) * 16, acc, lane);
        *(LAS f32x4*)(ob + tcol * 68 + vr) = acc; }
    __syncthreads();
    { const int t = tid >> 3, q = tid & 7; const size_t tg = (size_t)t0 + t;
        const f32x4 o0 = *(const LAS f32x4*)(ob + t * 68 + q * 8), o1 = *(const LAS f32x4*)(ob + t * 68 + q * 8 + 4);
        const float mean = red8((o0.x + o0.y) + (o0.z + o0.w) + (o1.x + o1.y) + (o1.z + o1.w)) * (1.f / 64.f);
        const f32x4 d0 = o0 - mean, d1 = o1 - mean;
        const float var = red8((d0.x * d0.x + d0.y * d0.y) + (d0.z * d0.z + d0.w * d0.w) + (d1.x * d1.x + d1.y * d1.y) + (d1.z * d1.z + d1.w * d1.w)) * (1.f / 64.f);
        const float rs = rsqrtf(var + 64e-5f);
        const int cc = h * 64 + q * 8;
        const f32x4 g0 = *(const f32x4*)(A->in[20] + (size_t)l * RW_W + cc), g1 = *(const f32x4*)(A->in[20] + (size_t)l * RW_W + cc + 4);
        const f32x4 b0 = *(const f32x4*)(A->in[21] + (size_t)l * RW_W + cc), b1 = *(const f32x4*)(A->in[21] + (size_t)l * RW_W + cc + 4);
        const f32x4 bv0 = *(const f32x4*)((const float*)(A->ws + WS_RBV) + tg * RW_W + cc), bv1 = *(const f32x4*)((const float*)(A->ws + WS_RBV) + tg * RW_W + cc + 4);
        const f32x4 ga0 = *(const f32x4*)((const float*)(A->ws + WS_RGATE) + tg * RW_W + cc), ga1 = *(const f32x4*)((const float*)(A->ws + WS_RGATE) + tg * RW_W + cc + 4);
        const f32x4 y0 = (d0 * rs * g0 + b0 + bv0) * ga0, y1 = (d1 * rs * g1 + b1 + bv1) * ga1;
        v4u o; o.x = pk2(y0.x, y0.y); o.y = pk2(y0.z, y0.w); o.z = pk2(y1.x, y1.y); o.w = pk2(y1.z, y1.w);
        *(v4u*)((bf16*)(A->ws + WS_Y) + tg * DM + 1280 + cc) = o; }
    __syncthreads();
}

constexpr size_t RWO_GQ = 84 * MiB, RWO_GK = 92 * MiB, RWO_GVT = 100 * MiB, RWO_GEM = 116 * MiB;
constexpr int GQS = 104, GTS = 72;
template <int NKS> __device__ __forceinline__ f32x4 tile_mm(const LAS bf16* Am, int sa, int arow0, const LAS bf16* Bm, int sb, int brow0, f32x4 acc, int lane) {
    const int r = lane & 15, kq = (lane >> 4) * 8;
#pragma unroll
    for (int ks = 0; ks < NKS; ++ks) {
        const bf16x8_t a = *(const LAS bf16x8_t*)(Am + (arow0 + r) * sa + ks * 32 + kq);
        const bf16x8_t b = *(const LAS bf16x8_t*)(Bm + (brow0 + r) * sb + ks * 32 + kq);
        acc = __builtin_amdgcn_mfma_f32_16x16x32_bf16(a, b, acc, 0, 0, 0);
    }
    return acc;
}

__device__ __forceinline__ int gsw(int row) { return ((row >> 2) ^ (row >> 5)) & 7; }
__device__ __forceinline__ f32x4 tile_mm_sw(const LAS bf16* Am, int arow0, const LAS bf16* Bm, int brow0, f32x4 acc, int lane) {
    const int r = lane & 15, cq = lane >> 4, fa = gsw(arow0 + r), fb = gsw(brow0 + r);
#pragma unroll
    for (int ks = 0; ks < 2; ++ks) {
        const bf16x8_t a = *(const LAS bf16x8_t*)(Am + (arow0 + r) * GTS + (((ks * 4 + cq) ^ fa) << 3));
        const bf16x8_t b = *(const LAS bf16x8_t*)(Bm + (brow0 + r) * GTS + (((ks * 4 + cq) ^ fb) << 3));
        acc = __builtin_amdgcn_mfma_f32_16x16x32_bf16(a, b, acc, 0, 0, 0);
    }
    return acc;
}
__device__ __forceinline__ void gla1_unit(ArgsP A, const Frame& F_in, int l, int unit) {
    Frame F = F_in; asm volatile("" : "+v"(F.tid)); F.lane = F.tid & 63;
    const int bh = unit >> 6, c = unit & 63, b = bh >> 2, h = bh & 3, t0 = b * SEQ + c * 64, tid = F.tid, lane = F.lane, w = F.wave;
    const float* proj = (const float*)(A->ws + WS_PROJ);
    LAS float* bcum = (LAS float*)F.lds;
    LAS float* ad = bcum + 6144;
    LAS float* up = ad + 1024;
    LAS bf16* KtT = (LAS bf16*)(F.lds + 34816);
    LAS bf16* VT = (LAS bf16*)(F.lds + 48640);
    f32x4 qq[3], kq[3], vq[6];
#pragma unroll
    for (int it = 0; it < 3; ++it) { const int i = tid + it * NTHR, tok = i / 24, d4 = i % 24; const float* rp = proj + (size_t)(t0 + tok) * INWP + h * 96 + d4 * 4;
        qq[it] = *(const f32x4*)(rp + C_GQ); kq[it] = *(const f32x4*)(rp + C_GK); }
#pragma unroll
    for (int it = 0; it < 6; ++it) { const int i = tid + it * NTHR, tok = i / 48, e4 = i % 48; vq[it] = *(const f32x4*)(proj + (size_t)(t0 + tok) * INWP + C_GV + h * 192 + e4 * 4); }
    gla_bcum(A, F, l, h, t0, bcum, ad, up);
    const float qs = 0.10206207261596575f;
    bf16* Qg = (bf16*)(A->ws + WS_RSC + RWO_GQ) + (size_t)unit * 6144; bf16* Kg = (bf16*)(A->ws + WS_RSC + RWO_GK) + (size_t)unit * 6144;
#pragma unroll
    for (int it = 0; it < 3; ++it) { const int i = tid + it * NTHR, tok = i / 24, d = (i % 24) * 4;
        const float qv[4] = {qq[it].x, qq[it].y, qq[it].z, qq[it].w}, kv[4] = {kq[it].x, kq[it].y, kq[it].z, kq[it].w}; float qo[4], ko[4];
#pragma unroll
        for (int e = 0; e < 4; ++e) { const float m = bcum[31 * 96 + d + e], bb = bcum[tok * 96 + d + e];
            qo[e] = qv[e] * qs * __expf(bb - m); ko[e] = kv[e] * __expf(m - bb); KtT[(d + e) * GTS + ((((tok >> 3) ^ gsw(d + e)) << 3) | (tok & 7))] = (bf16)f2bf(ko[e]); }
        v2u pq, pk; pq.x = pk2(qo[0], qo[1]); pq.y = pk2(qo[2], qo[3]); pk.x = pk2(ko[0], ko[1]); pk.y = pk2(ko[2], ko[3]);
        *(v2u*)(Qg + tok * 96 + d) = pq; *(v2u*)(Kg + tok * 96 + d) = pk; }
#pragma unroll
    for (int it = 0; it < 6; ++it) { const int i = tid + it * NTHR, tok = i / 48, e = (i % 48) * 4;
        const int ts = tok >> 3, tl = tok & 7;
        VT[(e + 0) * GTS + (((ts ^ gsw(e + 0)) << 3) | tl)] = (bf16)f2bf(vq[it].x); VT[(e + 1) * GTS + (((ts ^ gsw(e + 1)) << 3) | tl)] = (bf16)f2bf(vq[it].y);
        VT[(e + 2) * GTS + (((ts ^ gsw(e + 2)) << 3) | tl)] = (bf16)f2bf(vq[it].z); VT[(e + 3) * GTS + (((ts ^ gsw(e + 3)) << 3) | tl)] = (bf16)f2bf(vq[it].w); }
    if (tid < 96) { ((float*)(A->ws + WS_RSC + RWO_GEM))[(size_t)unit * 96 + tid] = __expf(bcum[31 * 96 + tid]);
        ((float*)(A->ws + WS_GDEC))[(size_t)unit * 96 + tid] = __expf(bcum[63 * 96 + tid]); }
    __syncthreads();
    { bf16* VTg = (bf16*)(A->ws + WS_RSC + RWO_GVT) + (size_t)unit * 12288;
#pragma unroll
        for (int it = 0; it < 3; ++it) { const int i = tid + it * NTHR, e = i >> 3, t8 = (i & 7) * 8; *(v4u*)(VTg + e * 64 + t8) = *(const LAS v4u*)(VT + e * GTS + ((((i & 7) ^ gsw(e))) << 3)); } }
    { const int li = lane & 15, lq = lane >> 4;
        float* KVg = (float*)(A->ws + WS_GKV) + (size_t)unit * 18432;
#pragma unroll
        for (int a = 0; a < 3; ++a) { const int dt = (w & 1) * 3 + a, d0 = dt * 16 + lq * 4;
            const float s0 = __expf(bcum[63 * 96 + d0] - bcum[31 * 96 + d0]), s1 = __expf(bcum[63 * 96 + d0 + 1] - bcum[31 * 96 + d0 + 1]),
                        s2 = __expf(bcum[63 * 96 + d0 + 2] - bcum[31 * 96 + d0 + 2]), s3 = __expf(bcum[63 * 96 + d0 + 3] - bcum[31 * 96 + d0 + 3]);
#pragma unroll
            for (int bb = 0; bb < 3; ++bb) { const int et = (w >> 1) * 3 + bb; const f32x4 z = {0.f, 0.f, 0.f, 0.f};
                f32x4 acc = tile_mm_sw(KtT, dt * 16, VT, et * 16, z, lane);
                acc.x *= s0; acc.y *= s1; acc.z *= s2; acc.w *= s3;
                *(f32x4*)(KVg + (size_t)(et * 16 + li) * 96 + d0) = acc; } } }
    __syncthreads();
}

__device__ __forceinline__ void gla3_unit(ArgsP A, const Frame& F_in, int l, int unit) {
    Frame F = F_in; asm volatile("" : "+v"(F.tid)); F.lane = F.tid & 63;
    const int bh = unit >> 6, c = unit & 63, b = bh >> 2, h = bh & 3, t0 = b * SEQ + c * 64, tid = F.tid, lane = F.lane, w = F.wave;
    const int li = lane & 15, lq = lane >> 4;
    const float* proj = (const float*)(A->ws + WS_PROJ);
    LAS bf16* Qs = (LAS bf16*)F.lds;
    LAS bf16* Ks = (LAS bf16*)(F.lds + 13312);
    LAS bf16* VT = (LAS bf16*)(F.lds + 26624);
    LAS bf16* ST = (LAS bf16*)(F.lds + 54272);
    LAS bf16* att = (LAS bf16*)(F.lds + 94208);
    LAS float* ssq = (LAS float*)(F.lds + 103424);
    LAS float* em = (LAS float*)(F.lds + 103936);
    LAS float* ob = (LAS float*)(F.lds + 26624);
    {
        const v4u* Qg = (const v4u*)((const bf16*)(A->ws + WS_RSC + RWO_GQ) + (size_t)unit * 6144); const v4u* Kg = (const v4u*)((const bf16*)(A->ws + WS_RSC + RWO_GK) + (size_t)unit * 6144);
        const v4u* VTg = (const v4u*)((const bf16*)(A->ws + WS_RSC + RWO_GVT) + (size_t)unit * 12288);
        const f32x4* GS = (const f32x4*)((const float*)(A->ws + WS_GS) + (size_t)unit * 18432);
        v4u q0 = Qg[tid], k0 = Kg[tid], q1 = {0u, 0u, 0u, 0u}, k1 = {0u, 0u, 0u, 0u};
        if (tid < 256) { q1 = Qg[512 + tid]; k1 = Kg[512 + tid]; }
        v4u vt[3]; f32x4 sg[9];
#pragma unroll
        for (int it = 0; it < 3; ++it) vt[it] = VTg[tid + it * NTHR];
#pragma unroll
        for (int it = 0; it < 9; ++it) sg[it] = GS[tid + it * NTHR];
        if (tid < 96) em[tid] = ((const float*)(A->ws + WS_RSC + RWO_GEM))[(size_t)unit * 96 + tid];
        { const int i = tid, t = i / 12, c8 = (i % 12) * 8; *(LAS v4u*)(Qs + t * GQS + c8) = q0; *(LAS v4u*)(Ks + t * GQS + c8) = k0; }
        if (tid < 256) { const int i = 512 + tid, t = i / 12, c8 = (i % 12) * 8; *(LAS v4u*)(Qs + t * GQS + c8) = q1; *(LAS v4u*)(Ks + t * GQS + c8) = k1; }
#pragma unroll
        for (int it = 0; it < 3; ++it) { const int i = tid + it * NTHR, e = i >> 3, t8 = (i & 7) * 8; *(LAS v4u*)(VT + e * GTS + t8) = vt[it]; }
        __syncthreads();
#pragma unroll
        for (int it = 0; it < 9; ++it) { const int i = tid + it * NTHR, e = i / 24, d = (i % 24) * 4; const f32x4 m4 = *(const LAS f32x4*)(em + d);
            v2u pk; pk.x = pk2(sg[it].x * m4.x, sg[it].y * m4.y); pk.y = pk2(sg[it].z * m4.z, sg[it].w * m4.w); *(LAS v2u*)(ST + e * GQS + d) = pk; }
    }
    __syncthreads();
#pragma unroll
    for (int a = 0; a < 2; ++a) { const int jt = w >> 1, it = (w & 1) * 2 + a; const f32x4 z = {0.f, 0.f, 0.f, 0.f};
        f32x4 acc = z;
        if (jt <= it) acc = tile_mm<3>(Ks, GQS, jt * 16, Qs, GQS, it * 16, z, lane);
        const int i = it * 16 + li, j0 = jt * 16 + lq * 4;
        acc.x = (j0 + 0 <= i) ? acc.x : 0.f; acc.y = (j0 + 1 <= i) ? acc.y : 0.f; acc.z = (j0 + 2 <= i) ? acc.z : 0.f; acc.w = (j0 + 3 <= i) ? acc.w : 0.f;
        v2u pk; pk.x = pk2(acc.x, acc.y); pk.y = pk2(acc.z, acc.w); *(LAS v2u*)(att + i * GTS + j0) = pk; }
    __syncthreads();
    f32x4 o[6];
    { const int it = w >> 1;
#pragma unroll
        for (int a = 0; a < 6; ++a) { const int et = (w & 1) * 6 + a; const f32x4 z = {0.f, 0.f, 0.f, 0.f};
            f32x4 acc = tile_mm<2>(att, GTS, it * 16, VT, GTS, et * 16, z, lane);
            o[a] = tile_mm<3>(Qs, GQS, it * 16, ST, GQS, et * 16, acc, lane); }
        float s0 = 0.f, s1 = 0.f, s2 = 0.f, s3 = 0.f;
#pragma unroll
        for (int a = 0; a < 6; ++a) { s0 += o[a].x * o[a].x; s1 += o[a].y * o[a].y; s2 += o[a].z * o[a].z; s3 += o[a].w * o[a].w; }
        s0 = row16_sum(s0); s1 = row16_sum(s1); s2 = row16_sum(s2); s3 = row16_sum(s3);
        if (li == 0) { const int r0 = it * 16 + lq * 4; ssq[(r0 + 0) * 2 + (w & 1)] = s0; ssq[(r0 + 1) * 2 + (w & 1)] = s1; ssq[(r0 + 2) * 2 + (w & 1)] = s2; ssq[(r0 + 3) * 2 + (w & 1)] = s3; }
    }
    __syncthreads();
    { const int it = w >> 1, r0 = it * 16 + lq * 4;
#pragma unroll
        for (int a = 0; a < 6; ++a) { const int e = ((w & 1) * 6 + a) * 16 + li;
            ob[(r0 + 0) * 196 + e] = o[a].x; ob[(r0 + 1) * 196 + e] = o[a].y; ob[(r0 + 2) * 196 + e] = o[a].z; ob[(r0 + 3) * 196 + e] = o[a].w; } }
    __syncthreads();
    { bf16* Y = (bf16*)(A->ws + WS_Y);
        f32x4 gv[6];
#pragma unroll
        for (int k = 0; k < 6; ++k) { const int i = tid + k * NTHR, t = i / 48, e = (i % 48) * 4; gv[k] = *(const f32x4*)(proj + (size_t)(t0 + t) * INWP + C_GG + h * 192 + e); }
#pragma unroll
        for (int k = 0; k < 6; ++k) { const int i = tid + k * NTHR, t = i / 48, e = (i % 48) * 4;
            const float rstd = rsqrtf((ssq[t * 2] + ssq[t * 2 + 1]) * (1.f / 192.f) + NORM_EPS);
            const f32x4 ov = *(const LAS f32x4*)(ob + t * 196 + e); const f32x4 ng = *(const f32x4*)(A->in[10] + (size_t)l * 768 + h * 192 + e);
            f32x4 y; y.x = ov.x * rstd * ng.x * gv[k].x * sigmoidf_(gv[k].x); y.y = ov.y * rstd * ng.y * gv[k].y * sigmoidf_(gv[k].y);
            y.z = ov.z * rstd * ng.z * gv[k].z * sigmoidf_(gv[k].z); y.w = ov.w * rstd * ng.w * gv[k].w * sigmoidf_(gv[k].w);
            v2u pk; pk.x = pk2(y.x, y.y); pk.y = pk2(y.z, y.w); *(v2u*)(Y + (size_t)(t0 + t) * DM + 512 + h * 192 + e) = pk; } }
    __syncthreads();
}

#define INS16(L, P, x, px) do { { const bool c_ = (x) > L[15]; L[15] = c_ ? (x) : L[15]; P[15] = c_ ? (px) : P[15]; } \
    _Pragma("unroll") for (int r_ = 14; r_ >= 0; --r_) { const bool c_ = L[r_ + 1] > L[r_]; const float tl_ = L[r_]; const int tp_ = P[r_]; \
        L[r_] = c_ ? L[r_ + 1] : tl_; L[r_ + 1] = c_ ? tl_ : L[r_ + 1]; P[r_] = c_ ? P[r_ + 1] : tp_; P[r_ + 1] = c_ ? tp_ : P[r_ + 1]; } } while (0)

__device__ __forceinline__ float gelu_as(float v) {
    const float av = fabsf(v), t = __builtin_amdgcn_rcpf(av * 0.2316418882f + 1.0f);
    float q = t * 0.5307027145f + (-0.7265760135f); q = q * t + 0.7107068705f; q = q * t + (-0.142248368f); q = q * t + 0.127414796f; q = q * t;
    const float e = __builtin_amdgcn_exp2f((v * v) * (-0.72134752044f));
    const float m = v * (q * e);
    return v < 0.f ? m : v - m;
}
__device__ __forceinline__ int row16_sum_i(int v) {
    v += __builtin_amdgcn_update_dpp(0, v, 0xB1, 0xF, 0xF, true); v += __builtin_amdgcn_update_dpp(0, v, 0x4E, 0xF, 0xF, true);
    v += __builtin_amdgcn_update_dpp(0, v, 0x141, 0xF, 0xF, true); v += __builtin_amdgcn_update_dpp(0, v, 0x140, 0xF, 0xF, true); return v;
}
#ifndef PEER_SL_SHIFT
#define PEER_SL_SHIFT 10
#endif
__device__ __forceinline__ void ph_peer4(ArgsP A, LAS unsigned char* lds_, int wv_, int l, const float* g2, const float* sh2, const float* ngain, const float* nsh, const float* nsc, const bool last, const bool dry = false) {
    const Frame F = make_frame(lds_, wv_);
    const int lane = F.lane, li = lane & 15, lq = lane >> 4;
    const float* SCO = (const float*)(A->ws + WS_PROJ);
    const unsigned char* U4 = A->ws + WS_U + (size_t)l * PEER_N * (DM / 2); const unsigned char* V4 = A->ws + WS_V + (size_t)l * PEER_N * (DM / 2);
    const float* US = (const float*)(A->ws + WS_US) + (size_t)l * PEER_N; const float* VS = (const float*)(A->ws + WS_VS) + (size_t)l * PEER_N;
    float* X = (float*)(A->ws + WS_X); bf16* H = (bf16*)(A->ws + WS_H); const float* ssr = (const float*)(A->ws + WS_SSP) + (size_t)l * NT * 32;
    LAS unsigned char* wl = F.lds + F.wave * 15104;
    LAS int* es = (LAS int*)wl; LAS float* gs = (LAS float*)(wl + 4096);
    LAS v4u* hl = (LAS v4u*)wl;
    LAS int* se = (LAS int*)(wl + 8448);
    LAS float* sg = (LAS float*)(wl + 10496);
    LAS int* st = (LAS int*)(wl + 12544);
    LAS float* dl = (LAS float*)(wl + 14592);
    LAS float* hsl = dl + 64; LAS int* hsi = (LAS int*)(dl + 68);
    for (int tb = F.gw * 4; tb < NT; tb += F.ngw * 4) {
        {
            int P2[16]; float gt[16];
            const int prob = tb * 16 + lane, half = lane & 1;
            const f32x4* s4 = (const f32x4*)(SCO + (size_t)prob * 128);
            int KK[16];
#pragma unroll
            for (int r = 0; r < 16; ++r) KK[r] = (int)0x80000000;
            f32x4 nv[4];
#pragma unroll
            for (int i = 0; i < 4; ++i) nv[i] = s4[i];
#define KINS(x_, idx_) do { const int b_ = __builtin_bit_cast(int, (float)(x_)); int k_ = b_ ^ ((b_ >> 31) & 0x7fffffff); k_ = (k_ & ~127) | (127 - (idx_)); \
        _Pragma("unroll") for (int r_ = 0; r_ < 16; ++r_) { const int hi_ = KK[r_] > k_ ? KK[r_] : k_; k_ = KK[r_] > k_ ? k_ : KK[r_]; KK[r_] = hi_; } } while (0)
#pragma unroll 1
            for (int q = 0; q < 8; ++q) {
                f32x4 v[4];
#pragma unroll
                for (int i = 0; i < 4; ++i) v[i] = nv[i];
                if (q < 7) {
#pragma unroll
                    for (int i = 0; i < 4; ++i) nv[i] = s4[4 * (q + 1) + i]; }
                _Pragma("unroll") for (int r = 0; r < 16; ++r) asm volatile("" : "+v"(KK[r]));
#pragma unroll
                for (int i = 0; i < 4; ++i) { const int ib = 16 * q + 4 * i;
                    KINS(v[i].x, ib); KINS(v[i].y, ib + 1); KINS(v[i].z, ib + 2); KINS(v[i].w, ib + 3); }
            }
#undef KINS
            float v1[16], v2[16];
            LAS int* gsi = (LAS int*)gs;
#pragma unroll
            for (int r = 0; r < 16; ++r) { const int ok = __builtin_amdgcn_update_dpp(0, KK[r], 0xB1, 0xF, 0xF, true);
                const int k1 = half ? ok : KK[r], k2 = half ? KK[r] : ok; const int a1 = k1 & ~127, a2 = k2 & ~127;
                v1[r] = __builtin_bit_cast(float, a1 ^ ((a1 >> 31) & 0x7fffffff)); v2[r] = __builtin_bit_cast(float, a2 ^ ((a2 >> 31) & 0x7fffffff));
                es[r * 64 + lane] = 127 - (k1 & 127); gsi[r * 64 + lane] = 127 - (k2 & 127); }
            int Q[16];
#define MKKEY2(a_, b_) ({ const int bb_ = __builtin_bit_cast(int, v1[a_] + v2[b_]); const int kk_ = bb_ ^ ((bb_ >> 31) & 0x7fffffff); (kk_ & ~255) | (255 - ((a_) * 16 + (b_))); })
#pragma unroll
            for (int bq = 0; bq < 16; ++bq) Q[bq] = MKKEY2(0, bq);
#pragma unroll
            for (int a = 1; a < 16; ++a)
#pragma unroll
                for (int bq = 0; bq < 16; ++bq) if ((a + 1) * (bq + 1) <= 16) { int k_ = MKKEY2(a, bq);
#pragma unroll
                    for (int r = (a + 1) * (bq + 1) - 1; r < 16; ++r) { const int hi_ = Q[r] > k_ ? Q[r] : k_; k_ = Q[r] > k_ ? k_ : Q[r]; Q[r] = hi_; } }
#undef MKKEY2
            float L2[16];
#pragma unroll
            for (int r = 0; r < 16; ++r) { const int ab = 255 - (Q[r] & 255); const int qv = Q[r] & ~255; L2[r] = __builtin_bit_cast(float, qv ^ ((qv >> 31) & 0x7fffffff));
                P2[r] = es[(ab >> 4) * 64 + lane] * 128 + gsi[(ab & 15) * 64 + lane]; }
            float sum = 0.f;
#pragma unroll
            for (int r = 0; r < 16; ++r) { gt[r] = __expf(L2[r] - L2[0]); sum += gt[r]; }
            const float inv = 1.f / sum;
#pragma unroll
            for (int r = 0; r < 16; ++r) { es[r * 64 + lane] = P2[r]; gs[r * 64 + lane] = gt[r] * inv; }
            asm volatile("s_waitcnt lgkmcnt(0)" ::: "memory");
        }
        {
            int ee[8]; float gg[8];
#pragma unroll
            for (int j = 0; j < 8; ++j) { const int x = j * 64 + lane, k = x >> 7, y = x & 127; ee[j] = es[(y & 15) * 64 + k * 16 + 2 * (y >> 4)]; gg[j] = gs[(y & 15) * 64 + k * 16 + 2 * (y >> 4)]; }
            int base = 0;
#pragma unroll
            for (int k = 0; k < 4; ++k) {
#pragma unroll 1
                for (int s = 0; s < (16384 >> PEER_SL_SHIFT); ++s) {
#pragma unroll
                    for (int jj = 0; jj < 2; ++jj) { const int j = k * 2 + jj; const bool in = (ee[j] >> PEER_SL_SHIFT) == s; const unsigned long long m = __builtin_amdgcn_ballot_w64(in);
                        if (in) { const int pos = base + (int)__builtin_amdgcn_mbcnt_hi((unsigned)(m >> 32), __builtin_amdgcn_mbcnt_lo((unsigned)m, 0u)); se[pos] = ee[j]; sg[pos] = gg[j]; }
                        base += __builtin_popcountll(m); }
                }
            }
        }
        asm volatile("s_waitcnt lgkmcnt(0)" ::: "memory");
#pragma unroll 1
        for (int k = 0; k < 4; ++k) {
            const int t = tb + k, b = t >> 12;
            float hf[32]; float mx = 0.f;
            const v4u* hp = (const v4u*)(H + (size_t)t * DM);
#pragma unroll
            for (int jj = 0; jj < 2; ++jj)
#pragma unroll
                for (int c = 0; c < 2; ++c) { const v4u hv = hp[(jj * 64 + lane) * 2 + c]; const int o = jj * 16 + c * 8;
                    hf[o + 0] = bflo(hv.x); hf[o + 1] = bfhi(hv.x); hf[o + 2] = bflo(hv.y); hf[o + 3] = bfhi(hv.y); hf[o + 4] = bflo(hv.z); hf[o + 5] = bfhi(hv.z); hf[o + 6] = bflo(hv.w); hf[o + 7] = bfhi(hv.w); }
            { const float rstd = rsqrtf(wave_sum(lane < 32 ? ssr[(size_t)t * 32 + lane] : 0.f) * (1.f / DM) + NORM_EPS);
#pragma unroll
                for (int jj = 0; jj < 2; ++jj)
#pragma unroll
                    for (int q = 0; q < 4; ++q) { const f32x4 s4 = *(const f32x4*)(sh2 + (size_t)b * MODW + (jj * 64 + lane) * 16 + 4 * q);
                        hf[jj * 16 + 4 * q] = hf[jj * 16 + 4 * q] * rstd + s4.x; hf[jj * 16 + 4 * q + 1] = hf[jj * 16 + 4 * q + 1] * rstd + s4.y;
                        hf[jj * 16 + 4 * q + 2] = hf[jj * 16 + 4 * q + 2] * rstd + s4.z; hf[jj * 16 + 4 * q + 3] = hf[jj * 16 + 4 * q + 3] * rstd + s4.w; } }
#pragma unroll
            for (int i = 0; i < 32; ++i) mx = fmaxf(mx, fabsf(hf[i]));
            mx = wave_max(mx);
            const float inv = mx > 0.f ? 127.f / mx : 0.f;
            if (lane == 0) hsl[k] = mx * (1.f / 127.f);
            int hsum = 0;
#pragma unroll
            for (int jj = 0; jj < 2; ++jj) { unsigned qd[4];
#pragma unroll
                for (int d = 0; d < 4; ++d) { const int o = jj * 16 + 4 * d; const int q0 = (int)rintf(hf[o] * inv), q1 = (int)rintf(hf[o + 1] * inv), q2 = (int)rintf(hf[o + 2] * inv), q3 = (int)rintf(hf[o + 3] * inv);
                    qd[d] = (unsigned)(q0 & 255) | ((unsigned)(q1 & 255) << 8) | ((unsigned)(q2 & 255) << 16) | ((unsigned)(q3 & 255) << 24); hsum += (q0 + q1) + (q2 + q3); }
                v4u q; q.x = qd[0]; q.y = qd[1]; q.z = qd[2]; q.w = qd[3]; hl[k * 132 + jj * 64 + lane] = q; }
            { hsum = row16_sum_i(hsum); const int hs_all = __builtin_amdgcn_readlane(hsum, 0) + __builtin_amdgcn_readlane(hsum, 16) + __builtin_amdgcn_readlane(hsum, 32) + __builtin_amdgcn_readlane(hsum, 48);
                if (lane == 0) hsi[k] = hs_all; }
        }
        asm volatile("s_waitcnt lgkmcnt(0)" ::: "memory");
        {
            int lu = lane; asm volatile("" : "+v"(lu)); const int tq = lu & 3, pq = (lu >> 2) & 3, kq = lu >> 4;
            v4i hB[8];
            { const LAS v4u* hb = hl + tq * 132 + kq * 4 + pq;
#pragma unroll
                for (int s = 0; s < 4; ++s) { hB[2 * s] = *(const LAS v4i*)(hb + s * 16); hB[2 * s + 1] = *(const LAS v4i*)(hb + 64 + s * 16); } }
            const int hc = 8 * hsi[tq];
            const unsigned char* ubase = U4 + kq * 64 + tq * 16;
#define ULOAD4(buf, q_) do { const int e_ = se[(q_) * 4 + pq]; const unsigned char* up_ = ubase + (size_t)e_ * (DM / 2); \
    _Pragma("unroll") for (int s = 0; s < 4; ++s) buf[s] = *(const v4i*)(up_ + s * 256); } while (0)
#define UCONS4(buf, gi_) do { v4i acc = {0, 0, 0, 0}; \
    _Pragma("unroll") for (int s = 0; s < 4; ++s) { const v4i lo_ = buf[s] & 0x0F0F0F0F, hi_ = (buf[s] >> 4) & 0x0F0F0F0F; \
        acc = __builtin_amdgcn_mfma_i32_16x16x64_i8(lo_, hB[2 * s], acc, 0, 0, 0); acc = __builtin_amdgcn_mfma_i32_16x16x64_i8(hi_, hB[2 * s + 1], acc, 0, 0, 0); } \
    int v_ = pq == 0 ? acc.x : (pq == 1 ? acc.y : (pq == 2 ? acc.z : acc.w)); \
    v_ += __builtin_amdgcn_update_dpp(0, v_, 0x124, 0xF, 0xF, true); v_ += __builtin_amdgcn_update_dpp(0, v_, 0x128, 0xF, 0xF, true); \
    if (pq == 0) dl[((gi_) * 4 + kq) * 4 + tq] = (float)(v_ - hc); } while (0)
            float us_c, vs_c; { const int e0 = se[lu & 15]; us_c = US[e0]; vs_c = VS[e0]; }
            v4i ub0[4], ub1[4], ub2[4], ub3[4];
            ULOAD4(ub0, 0); ULOAD4(ub1, 1); ULOAD4(ub2, 2); ULOAD4(ub3, 3);
#pragma unroll 1
            for (int g = 0; g < 32; ++g) {
                const int gn = g + 1 < 32 ? g + 1 : 31;
                const int en = se[gn * 16 + (lu & 15)]; const float us_n = US[en], vs_n = VS[en];
                UCONS4(ub0, 0); ULOAD4(ub0, gn * 4 + 0);
                UCONS4(ub1, 1); ULOAD4(ub1, gn * 4 + 1);
                UCONS4(ub2, 2); ULOAD4(ub2, gn * 4 + 2);
                UCONS4(ub3, 3); ULOAD4(ub3, gn * 4 + 3);
                if (lu < 16) { const int x = g * 16 + lu; const int tk = x >> 7;
                    sg[x] = sg[x] * vs_c * gelu_as(dl[lu * 4 + tk] * (us_c * hsl[tk])); }
                us_c = us_n; vs_c = vs_n;
            }
#undef ULOAD4
#undef UCONS4
        }
        asm volatile("s_waitcnt lgkmcnt(0)" ::: "memory");
#define VLOAD(buf, cfb, bi_) do { const v4i e4_ = *(const LAS v4i*)(se + xb + (bi_) * 4); const f32x4 g4_ = *(const LAS f32x4*)(sg + xb + (bi_) * 4); \
        cfb[0] = g4_.x; cfb[1] = g4_.y; cfb[2] = g4_.z; cfb[3] = g4_.w; const int ee_[4] = {e4_.x, e4_.y, e4_.z, e4_.w}; \
        _Pragma("unroll") for (int i = 0; i < 4; ++i) { const unsigned char* vp_ = vbase + (size_t)ee_[i] * (DM / 2); buf[i][0] = *(const v4u*)vp_; buf[i][1] = *(const v4u*)(vp_ + 512); } } while (0)
#define VACC(bv_, cv_) do { const f32x2 c2_ = {cv_, cv_}; \
        _Pragma("unroll") for (int jj = 0; jj < 2; ++jj) { const unsigned wd_[4] = {bv_[jj].x, bv_[jj].y, bv_[jj].z, bv_[jj].w}; \
            _Pragma("unroll") for (int d = 0; d < 4; ++d) { const int o_ = jj * 16 + 4 * d; \
                const f32x2 f0_ = __builtin_amdgcn_cvt_scalef32_pk_f32_fp4((int)wd_[d], 1.0f, 0), f1_ = __builtin_amdgcn_cvt_scalef32_pk_f32_fp4((int)wd_[d], 1.0f, 1), \
                            f2_ = __builtin_amdgcn_cvt_scalef32_pk_f32_fp4((int)wd_[d], 1.0f, 2), f3_ = __builtin_amdgcn_cvt_scalef32_pk_f32_fp4((int)wd_[d], 1.0f, 3); \
                out[o_] = __builtin_elementwise_fma(c2_, f0_, out[o_]); out[o_ + 1] = __builtin_elementwise_fma(c2_, f1_, out[o_ + 1]); \
                out[o_ + 2] = __builtin_elementwise_fma(c2_, f2_, out[o_ + 2]); out[o_ + 3] = __builtin_elementwise_fma(c2_, f3_, out[o_ + 3]); } } } while (0)
#define VCONS(buf, cfb) do { _Pragma("unroll") for (int i = 0; i < 4; ++i) VACC(buf[i], cfb[i]); } while (0)
#pragma unroll 1
        for (int p = 0; p < 2; ++p) {
            int lane_v = F.lane; asm volatile("" : "+v"(lane_v)); const int hv = lane_v >> 5, mv = lane_v & 31;
            const int xb = (2 * p + hv) * 128;
            const unsigned char* vbase = V4 + mv * 16;
            f32x2 out[32];
#pragma unroll
            for (int i = 0; i < 32; ++i) out[i] = (f32x2){0.f, 0.f};
            {
                v4u vb0[4][2], vb1[4][2]; float c0[4], c1[4];
                VLOAD(vb0, c0, 0); VLOAD(vb1, c1, 1);
#pragma unroll 1
                for (int bi = 0; bi < 32; bi += 2) {
                    const int b2 = bi + 2 < 32 ? bi + 2 : 30, b3 = bi + 3 < 32 ? bi + 3 : 31;
                    asm volatile("" ::: "memory"); VCONS(vb0, c0); asm volatile("" ::: "memory"); VLOAD(vb0, c0, b2);
                    asm volatile("" ::: "memory"); VCONS(vb1, c1); asm volatile("" ::: "memory"); VLOAD(vb1, c1, b3);
                }
            }
            {
                const int t = tb + 2 * p + hv, b = t >> 12;
                f32x4 xn[2][8]; float ss = 0.f;
                const f32x4* xr = (const f32x4*)(X + (size_t)t * DM) + mv; const f32x4* gr = (const f32x4*)(g2 + (size_t)b * MODW) + mv;
#pragma unroll
                for (int jj = 0; jj < 2; ++jj)
#pragma unroll
                    for (int q = 0; q < 8; ++q) { const int ix = jj * 256 + q * 32; const f32x4 xv = xr[ix], gv = gr[ix];
                        f32x4 o4; o4.x = out[jj * 16 + 2 * q].x; o4.y = out[jj * 16 + 2 * q].y; o4.z = out[jj * 16 + 2 * q + 1].x; o4.w = out[jj * 16 + 2 * q + 1].y;
                        const f32x4 y = xv + gv * o4; xn[jj][q] = y; ss += (y.x * y.x + y.y * y.y) + (y.z * y.z + y.w * y.w); }
                float rstd; { const float v = row16_sum(ss); const float s0 = rl_f(v, 0) + rl_f(v, 16), s1 = rl_f(v, 32) + rl_f(v, 48); rstd = rsqrtf((hv ? s1 : s0) * (1.f / DM) + NORM_EPS); }
                if (!last) {
                    f32x4* xw = (f32x4*)((dry ? (float*)(A->ws + WS_DUMMY) : X) + (size_t)t * DM) + mv; v2u* hw = (v2u*)((dry ? (bf16*)(A->ws + WS_DUMMY + 64 * MiB) : H) + (size_t)t * DM) + mv;
                    const f32x4* ngp = (const f32x4*)ngain + mv; const f32x4* s1p = (const f32x4*)(nsc + (size_t)b * MODW) + mv; const f32x4* s0p = (const f32x4*)(nsh + (size_t)b * MODW) + mv;
#pragma unroll
                    for (int jj = 0; jj < 2; ++jj)
#pragma unroll
                        for (int q = 0; q < 8; ++q) { const int ix = jj * 256 + q * 32; xw[ix] = xn[jj][q];
                            const f32x4 g = ngp[ix], s1 = s1p[ix], s0 = s0p[ix];
                            const f32x4 y = xn[jj][q] * rstd * g * (s1 + 1.f) + s0;
                            v2u o; o.x = pk2(y.x, y.y); o.y = pk2(y.z, y.w); hw[ix] = o; }
                } else {
                    f32x4* ow = (f32x4*)((dry ? (float*)(A->ws + WS_DUMMY) : A->out) + (size_t)t * DM) + mv; const f32x4* ngp = (const f32x4*)ngain + mv;
#pragma unroll
                    for (int jj = 0; jj < 2; ++jj)
#pragma unroll
                        for (int q = 0; q < 8; ++q) { const int ix = jj * 256 + q * 32; ow[ix] = xn[jj][q] * rstd * ngp[ix]; }
                }
            }
        }
#undef VLOAD
#undef VACC
#undef VCONS
    }
}

__device__ __forceinline__ void PH_norm1_l0(LAS unsigned char* lds, int wv) { ArgsP A = args_ptr(); const float* MOD = (const float*)(A->ws + WS_MOD);
    ph_norm(A->in[0], A->in[4], MOD + 0 * DM, MOD + 1 * DM, (bf16*)(A->ws + WS_H), lds, wv);
    { const Frame F = make_frame(lds, wv); float* B3 = (float*)(A->ws + WS_BIAS3);
        for (int o = F.gw; o < DEPTH * 2 * DM; o += F.ngw) { const int l = o >> 12, b = (o >> 11) & 1, n = o & 2047;
            const float* sh = MOD + (size_t)(l * 2 + b) * MODW + 3 * DM; const v4u* wr = (const v4u*)((const bf16*)(A->ws + WS_WQK) + ((size_t)l * DM + n) * DM);
            float s = 0.f;
#pragma unroll
            for (int j = 0; j < 4; ++j) { const v4u wv4 = wr[j * 64 + F.lane]; const f32x4 s0 = *(const f32x4*)(sh + (j * 64 + F.lane) * 8), s1 = *(const f32x4*)(sh + (j * 64 + F.lane) * 8 + 4);
                s += bflo(wv4.x) * s0.x + bfhi(wv4.x) * s0.y + bflo(wv4.y) * s0.z + bfhi(wv4.y) * s0.w + bflo(wv4.z) * s1.x + bfhi(wv4.z) * s1.y + bflo(wv4.w) * s1.z + bfhi(wv4.w) * s1.w; }
            s = wave_sum(s);
            if (F.lane == 0) B3[o] = s; } } }
__device__ __forceinline__ void PH_gemm1(LAS unsigned char* lds, int wv, int l_) { ArgsP A = args_ptr(); const int l = opaque_i(l_);
    pg8::Gemm g{(const bf16*)(A->ws + WS_H), (const bf16*)(A->ws + WS_WIN) + (size_t)l * INWP * DM, NT, INWP, DM}; pg8::StaticOrder S; S.init(NT, INWP, gridDim.x, blockIdx.x);
    EpiStoreF32 E{(float*)(A->ws + WS_PROJ), INWP, wv, lds};
    pg8::gemm_phase<EpiStoreF32, pg8::StaticOrder, true, true>(lds, g, S, E, wv);
    { const Frame F = make_frame(lds, wv); if (F.G == 256 && l + 1 < DEPTH && F.bid >= 192) quant_tables(A, l + 1, (F.bid - 192) * NWAVES + F.wave, 64 * NWAVES, F.lane, 0, QUANT_EARLY); } }
__device__ __forceinline__ void PH_mixA(LAS unsigned char* lds, int wv, int l_) { ArgsP A = args_ptr(); const int l = opaque_i(l_);
    const Frame F = make_frame(lds, wv);
#ifdef PROBE_A
    for (int u = F.bid; u < 2048; u += F.G) {
        if (u < 1536) { if (PROBE_A == 1) rwkvA_unit(A, F, l, u); }
        else { if (PROBE_A == 2) gla1_unit(A, F, l, u - 1536); }
    }
#endif
    for (int u = F.bid; u < 2048; u += F.G) {
        if (u < 1536) rwkvA_unit(A, F, l, u);
        else gla1_unit(A, F, l, u - 1536);
    }
    if (l + 1 < DEPTH) quant_tables(A, l + 1, F.gw, F.ngw, F.lane, F.G == 256 ? QUANT_EARLY : 0);
}
__device__ __forceinline__ void PH_mixB(LAS unsigned char* lds, int wv, int l_) { ArgsP A = args_ptr(); const int l = opaque_i(l_);
    const Frame F = make_frame(lds, wv);
    if (F.G >= 192) {
        if (F.bid < 96) rwkvB_scan(A, F, F.bid);
        else { const int nb = F.G - 96, b2 = F.bid - 96;
            for (int u = b2; u < 288; u += nb) gla_scan_unit(A, F, u);
            for (int u = b2; u < 1024; u += nb) pool_unit(A, F, l, u); }
    } else {
        for (int u = F.bid; u < 288; u += F.G) gla_scan_unit(A, F, u);
        for (int u = F.bid; u < 1024; u += F.G) pool_unit(A, F, l, u);
        for (int u = F.bid; u < 96; u += F.G) rwkvB_scan(A, F, u);
    } }
__device__ __forceinline__ void PH_mixC(LAS unsigned char* lds, int wv, int l_) { ArgsP A = args_ptr(); const int l = opaque_i(l_);
    const Frame F = make_frame(lds, wv);
#ifdef PROBE_C
    for (int u = F.bid; u < 2048; u += F.G) { if (u < 512) { if (PROBE_C == 1) gla3_unit(A, F, l, u); } else { if (PROBE_C == 2) rwkvC_unit(A, F, l, u - 512); } }
#endif
    for (int u = F.bid; u < 2048; u += F.G) { if (u < 512) gla3_unit(A, F, l, u); else rwkvC_unit(A, F, l, u - 512); } }
__device__ __forceinline__ void PH_gemm2(LAS unsigned char* lds, int wv, int l_, bool dry = false) { ArgsP A = args_ptr(); const int l = opaque_i(l_);
    const float* modl = (const float*)(A->ws + WS_MOD) + (size_t)l * 2 * MODW; float* X = (float*)(A->ws + WS_X);
    pg8::Gemm g{(const bf16*)(A->ws + WS_Y), (const bf16*)(A->ws + WS_WOUT) + (size_t)l * DM * DM, NT, DM, DM}; pg8::StaticOrder S; S.init(NT, DM, gridDim.x, blockIdx.x);
    EpiResid E{(l == 0) ? A->in[0] : (const float*)X, dry ? (float*)(A->ws + WS_DUMMY) : X, modl + 2 * DM, wv, A->in[23] + (size_t)l * DM, modl + 4 * DM,
               dry ? (bf16*)(A->ws + WS_DUMMY + 64 * MiB) : (bf16*)(A->ws + WS_H), (dry ? (float*)(A->ws + WS_DUMMY) : (float*)(A->ws + WS_SSP) + (size_t)l * NT * 32), lds};
    pg8::gemm_phase<EpiResid, pg8::StaticOrder, true, true>(lds, g, S, E, wv); }
__device__ __forceinline__ void PH_norm2(LAS unsigned char* lds, int wv, int l_) { ArgsP A = args_ptr(); const int l = opaque_i(l_);
    const float* modl = (const float*)(A->ws + WS_MOD) + (size_t)l * 2 * MODW;
    ph_norm((const float*)(A->ws + WS_X), A->in[23] + (size_t)l * DM, modl + 3 * DM, modl + 4 * DM, (bf16*)(A->ws + WS_H), lds, wv); }
__device__ __forceinline__ void PH_gemm3(LAS unsigned char* lds, int wv, int l_) { ArgsP A = args_ptr(); const int l = opaque_i(l_);
    pg8::Gemm g{(const bf16*)(A->ws + WS_H), (const bf16*)(A->ws + WS_WQK) + (size_t)l * DM * DM, NT, DM, DM}; pg8::StaticOrder S; S.init(NT, DM, gridDim.x, blockIdx.x);
    LAS float* rs = (LAS float*)(lds + 131072);
    { pg8::Unit u0; const int t = tid_from(wv); if (S.next(0, u0) && t < 256) { const f32x4* sp = (const f32x4*)((const float*)(A->ws + WS_SSP) + ((size_t)l * NT + u0.pm * 256 + t) * 32); float s = 0.f;
#pragma unroll
            for (int j = 0; j < 8; ++j) { const f32x4 v = sp[j]; s += (v.x + v.y) + (v.z + v.w); }
            rs[t] = rsqrtf(s * (1.f / DM) + NORM_EPS); }
        __syncthreads(); }
    EpiScore E{(float*)(A->ws + WS_PROJ), DM, wv, rs, (const float*)(A->ws + WS_BIAS3) + (size_t)l * 2 * DM, lds};
    pg8::gemm_phase<EpiScore, pg8::StaticOrder, true, true>(lds, g, S, E, wv); }
__device__ __forceinline__ void PH_peer(LAS unsigned char* lds, int wv, int l_, bool dry = false) { ArgsP A = args_ptr(); const int l = opaque_i(l_);
    const float* MOD = (const float*)(A->ws + WS_MOD); const float* modl = MOD + (size_t)l * 2 * MODW;
    const bool last = (l == DEPTH - 1);
    const float* nmod = MOD + (size_t)(last ? l : l + 1) * 2 * MODW;
    ph_peer4(A, lds, wv, l, modl + 5 * DM, modl + 3 * DM, last ? A->in[29] : A->in[4] + (size_t)(l + 1) * DM, nmod + 0 * DM, nmod + 1 * DM, last, dry); }

__global__ void __launch_bounds__(NTHR, 2) mega_fwd(Args args) {
    extern __shared__ __attribute__((aligned(16))) unsigned char lds_raw[];
    LAS unsigned char* lds = (LAS unsigned char*)lds_raw;
    volatile LAS unsigned* MISC = (volatile LAS unsigned*)(lds + MISC_OFF);
    const int wv = __builtin_amdgcn_readfirstlane((int)(threadIdx.x >> 6));
    if (wv == 0) MISC[lane_id_()] = 0u;
    __syncthreads();
    XcdBarrier bar = xcd_barrier_post((unsigned*)(args_ptr()->ws + WS_CTL) + CW_BAR, MISC + 8, wv);
#define GRID_BAR() do { XcdBarrier b_ = bar; b_.bar = (unsigned*)(args_ptr()->ws + WS_CTL) + CW_BAR; asm volatile("" : "+s"(b_.x), "+s"(b_.w)); xcd_barrier(b_); if (PROBE & 512) xcd_barrier(b_); } while (0)

    ph_prologue(args_ptr(), lds, wv);
    GRID_BAR();
#if PROBE & 1
    ph_prologue(args_ptr(), lds, wv); GRID_BAR();
#endif
    PH_norm1_l0(lds, wv);
    GRID_BAR();
    for (int l = 0; l < DEPTH; ++l) {
#if PROBE & 2
        PH_gemm1(lds, wv, l); GRID_BAR();
#endif
        PH_gemm1(lds, wv, l); GRID_BAR();
#if PROBE & 4
        PH_mixA(lds, wv, l);  GRID_BAR();
#endif
        PH_mixA(lds, wv, l);  GRID_BAR();
#if PROBE & 8
        PH_mixB(lds, wv, l);  GRID_BAR();
#endif
        PH_mixB(lds, wv, l);  GRID_BAR();
#if PROBE & 16
        PH_mixC(lds, wv, l);  GRID_BAR();
#endif
        PH_mixC(lds, wv, l);  GRID_BAR();
#if PROBE & 32
        PH_gemm2(lds, wv, l, true); GRID_BAR();
#endif
        PH_gemm2(lds, wv, l); GRID_BAR();
#if PROBE & 128
        PH_gemm3(lds, wv, l); GRID_BAR();
#endif
        PH_gemm3(lds, wv, l); GRID_BAR();
#if PROBE & 256
        PH_peer(lds, wv, l, true); GRID_BAR();
#endif
        PH_peer(lds, wv, l);
        if (l + 1 < DEPTH) GRID_BAR();
    }
}

extern "C" void kernel_launch(void* const* d_in, const int* in_sizes, int n_in, void* d_out, int out_size, void* d_ws, size_t ws_size, hipStream_t stream) {
    static int grid = 0;
    if (grid == 0) {
        if (n_in != 30 || out_size != NT * DM || ws_size < WS_END + 96 * MiB) { fprintf(stderr, "kernel_launch: unexpected shapes (n_in %d out %d ws %zu)\n", n_in, out_size, ws_size); grid = -1; return; }
        int dev = 0, cus = 0, per_cu = 0;
        if (hipGetDevice(&dev) != hipSuccess || hipDeviceGetAttribute(&cus, hipDeviceAttributeMultiprocessorCount, dev) != hipSuccess) { grid = -1; return; }
        if (hipFuncSetAttribute((const void*)mega_fwd, hipFuncAttributeMaxDynamicSharedMemorySize, LDS_BYTES) != hipSuccess) { fprintf(stderr, "kernel_launch: hipFuncSetAttribute failed\n"); grid = -1; return; }
        if (hipOccupancyMaxActiveBlocksPerMultiprocessor(&per_cu, (const void*)mega_fwd, NTHR, LDS_BYTES) != hipSuccess || per_cu < 1) { fprintf(stderr, "kernel_launch: occupancy query says %d\n", per_cu); (void)hipGetLastError(); per_cu = 1; }
        grid = cus;
    }
    if (grid < 0) return;
    (void)in_sizes;
    if (hipMemsetAsync((char*)d_ws + WS_CTL, 0, CTL_ZERO_BYTES, stream) != hipSuccess) return;
    Args a{};
    for (int i = 0; i < 30; ++i) a.in[i] = (const float*)d_in[i];
    a.out = (float*)d_out; a.ws = (unsigned char*)d_ws;
    hipLaunchKernelGGL(mega_fwd, dim3(grid), dim3(NTHR), LDS_BYTES, stream, a);
}
```

```cpp
#define PEER_SL_SHIFT 11
#include <hip/hip_runtime.h>
#include <cstdio>
#include <cstdint>
__device__ __forceinline__ int lane_id_() { int r; asm volatile("v_mbcnt_lo_u32_b32 %0, -1, 0\n\tv_mbcnt_hi_u32_b32 %0, -1, %0" : "=v"(r)); return r; }
__device__ __forceinline__ int tid_from(int wave_s) { return wave_s * 64 + lane_id_(); }
namespace pg8 {
#define PG8_LAS __attribute__((address_space(3)))
typedef unsigned short bf16_t;
typedef short bf16x8 __attribute__((ext_vector_type(8)));
typedef float f32x4 __attribute__((ext_vector_type(4)));
typedef unsigned u32x4 __attribute__((ext_vector_type(4)));
constexpr int BM = 256, BK = 64, HALF = 128, HTB = HALF * BK * 2  , STAGE_BYTES = 8 * HTB, NXCD = 8, WGM = 8;

__host__ __device__ __forceinline__ int lds_byte(int r, int c) { const int st = (r >> 4) * 2 + (c >> 5), rr = r & 15, cc = c & 31, ob = rr * 64 + cc * 2; return st * 1024 + (ob ^ (((ob >> 9) & 1) << 5)); }
__host__ __device__ __forceinline__ void stage_rc(int b, int& R, int& C) { const int st = b / 1024, sb = b % 1024, swz = sb ^ (((sb >> 9) & 1) << 5); R = (st >> 1) * 16 + swz / 64; C = (st & 1) * 32 + (swz % 64) / 2; }
__host__ __device__ __forceinline__ int perm32(int rho) { const int n = rho >> 4, i = rho & 15; return 8 * (i >> 2) + 4 * n + (i & 3); }

struct Unit { int pm, pn; };
struct Gemm { const bf16_t* A; const bf16_t* Bt; int M, N, K; };

struct StaticOrder {
    int nM, nN, nwg, G, c;
    __host__ __device__ void init(int M, int N, int G_, int c_) { nM = M / BM; nN = N / BM; nwg = nM * nN; G = G_; c = c_; }
    __host__ __device__ bool next(int i, Unit& u) const {
        const long L = (long)i * G + c; if (L >= nwg) return false;
        int wgid = (int)L; { const int q = nwg / NXCD, r = nwg % NXCD, xcd = wgid % NXCD, off = wgid / NXCD; wgid = (xcd < r ? xcd * (q + 1) : r * (q + 1) + (xcd - r) * q) + off; }
        const int nig = WGM * nN, gid = wgid / nig, fm = gid * WGM, gsz = (nM - fm) < WGM ? (nM - fm) : WGM;
        u.pm = fm + ((wgid % nig) % gsz); u.pn = (wgid % nig) / gsz; return true;
    }
    __device__ __forceinline__ void a_ready(const Unit&) const {}
    __device__ __forceinline__ void done(const Unit&) const {}
};

template <class Epi, class Sched, bool ALIGN_EPI = false, bool SP2 = false>
__device__ __forceinline__ void gemm_phase(PG8_LAS unsigned char* lds, const Gemm g, const Sched& S, const Epi& E, int wave_s) {
    int tid_o = tid_from(wave_s); asm volatile("" : "+v"(tid_o));
    const int tid = tid_o, wid = __builtin_amdgcn_readfirstlane(tid >> 6), lane = tid & 63, wr = wid >> 2, wc = wid & 3, fr = lane & 15, fq = lane >> 4;
    const int K = g.K, nt = K / BK;
    unsigned voffA[2], voffB[2];
#pragma unroll
    for (int i = 0; i < 2; ++i) { int R, C; stage_rc(tid * 16 + i * 8192, R, C); const int Rb = Epi::PERM ? ((R & ~31) + perm32(R & 31)) : R;
        voffA[i] = (unsigned)(R * K + C) * 2u; voffB[i] = (unsigned)(Rb * K + C) * 2u; }
    const size_t kstep = (size_t)(BK * 2);
    const size_t hstep = (size_t)HALF * K * 2;
    const size_t tstep = 2 * hstep;
    const unsigned ldsw = (unsigned)wid * 1024u;
    const int aoff = lds_byte(wr * 64 + fr, fq * 8), boff = lds_byte(wc * 32 + fr, fq * 8);
#define PG8_SA(b, h) (((b) * 2 + (h)) * HTB)
#define PG8_SB(b, h) ((4 + (b) * 2 + (h)) * HTB)
#define PG8_STAGE(bufoff, gbase, voff) do { _Pragma("unroll") for (int _i = 0; _i < 2; ++_i) \
        __builtin_amdgcn_global_load_lds((const unsigned*)((const char*)(gbase) + (voff)[_i]), (PG8_LAS unsigned*)(lds + (bufoff) + ldsw + _i * 8192), 16, 0, 0); } while (0)
#define PG8_LDA(dst, b, h) do { _Pragma("unroll") for (int m = 0; m < 4; ++m) _Pragma("unroll") for (int k = 0; k < 2; ++k) dst[m][k] = *(const PG8_LAS bf16x8*)(lds + PG8_SA(b, h) + aoff + m * 2048 + k * 1024); } while (0)
#define PG8_LDB(dst, b, h) do { _Pragma("unroll") for (int n = 0; n < 2; ++n) _Pragma("unroll") for (int k = 0; k < 2; ++k) dst[n][k] = *(const PG8_LAS bf16x8*)(lds + PG8_SB(b, h) + boff + n * 2048 + k * 1024); } while (0)
#define PG8_MMA(ai, bj, At, Bt) do { __builtin_amdgcn_s_setprio(1); _Pragma("unroll") for (int m = 0; m < 4; ++m) _Pragma("unroll") for (int n = 0; n < 2; ++n) _Pragma("unroll") for (int k = 0; k < 2; ++k) \
        acc[ai][bj][m][n] = __builtin_amdgcn_mfma_f32_16x16x32_bf16(Bt[n][k], At[m][k], acc[ai][bj][m][n], 0, 0, 0); __builtin_amdgcn_s_setprio(0); } while (0)
#define PG8_WAIT_V(n) asm volatile("s_waitcnt vmcnt(" #n ")" ::: "memory")
#define PG8_WAIT_L(n) asm volatile("s_waitcnt lgkmcnt(" #n ")" ::: "memory")
#define PG8_BAR __builtin_amdgcn_s_barrier()
#define PG8_SCHED __builtin_amdgcn_sched_barrier(0)
    Unit cur, nxt; int ui = 0;
    if (!S.next(0, cur)) return;
    f32x4 acc[2][2][4][2];
#pragma unroll
    for (int a = 0; a < 2; ++a)
#pragma unroll
        for (int b = 0; b < 2; ++b)
#pragma unroll
            for (int m = 0; m < 4; ++m)
#pragma unroll
                for (int n = 0; n < 2; ++n) acc[a][b][m][n] = (f32x4){0.f, 0.f, 0.f, 0.f};
    bf16x8 At[4][2], B0[2][2], B1[2][2];
    const char* cA = (const char*)g.A + (size_t)cur.pm * tstep; const char* cB = (const char*)g.Bt + (size_t)cur.pn * tstep;
    S.a_ready(cur);
    if constexpr (SP2) {
        PG8_STAGE(PG8_SB(0, 0), cB, voffB); PG8_STAGE(PG8_SB(0, 1), cB + hstep, voffB); PG8_STAGE(PG8_SA(0, 0), cA, voffA); PG8_STAGE(PG8_SA(0, 1), cA + hstep, voffA);
        if (wr == 1) PG8_BAR;
        PG8_WAIT_V(2); PG8_BAR;
        PG8_STAGE(PG8_SB(1, 0), cB + kstep, voffB); PG8_STAGE(PG8_SA(1, 0), cA + kstep, voffA); PG8_STAGE(PG8_SB(1, 1), cB + hstep + kstep, voffB);
        PG8_WAIT_V(6); PG8_BAR;
    } else {
        PG8_STAGE(PG8_SB(0, 0), cB, voffB); PG8_STAGE(PG8_SA(0, 0), cA, voffA); PG8_STAGE(PG8_SB(0, 1), cB + hstep, voffB); PG8_STAGE(PG8_SA(0, 1), cA + hstep, voffA);
        if (wr == 1) PG8_BAR;
        PG8_WAIT_V(4); PG8_BAR;
        PG8_STAGE(PG8_SB(1, 0), cB + kstep, voffB); PG8_STAGE(PG8_SA(1, 0), cA + kstep, voffA); PG8_STAGE(PG8_SB(1, 1), cB + hstep + kstep, voffB);
        PG8_WAIT_V(6); PG8_BAR;
    }
    for (;;) {
        const bool has_next = S.next(ui + 1, nxt);
        const char* nA = has_next ? (const char*)g.A + (size_t)nxt.pm * tstep : cA; const char* nB = has_next ? (const char*)g.Bt + (size_t)nxt.pn * tstep : cB;
        for (int t = 0; t < nt; t += 2) {
            const bool last = (t == nt - 2);
            const char* a1 = cA + (size_t)(t + 1) * kstep;
            const char* a2 = last ? nA : cA + (size_t)(t + 2) * kstep; const char* b2 = last ? nB : cB + (size_t)(t + 2) * kstep;
            const char* a3 = a2 + kstep; const char* b3 = b2 + kstep;
            if (last && has_next) S.a_ready(nxt);
            if constexpr (SP2) {
            PG8_LDB(B0, 0, 0); PG8_LDB(B1, 0, 1); PG8_SCHED; PG8_LDA(At, 0, 0); PG8_STAGE(PG8_SA(1, 1), a1 + hstep, voffA);
            PG8_WAIT_V(8); PG8_WAIT_L(0); PG8_BAR; PG8_MMA(0, 0, At, B0); PG8_MMA(0, 1, At, B1); PG8_BAR; PG8_SCHED;
            PG8_LDA(At, 0, 1); PG8_STAGE(PG8_SB(0, 0), b2, voffB); PG8_STAGE(PG8_SB(0, 1), b2 + hstep, voffB); PG8_STAGE(PG8_SA(0, 0), a2, voffA);
            PG8_WAIT_V(8); PG8_WAIT_L(0); PG8_BAR; PG8_MMA(1, 0, At, B0); PG8_MMA(1, 1, At, B1); PG8_BAR; PG8_SCHED;
            PG8_LDB(B0, 1, 0); PG8_LDB(B1, 1, 1); PG8_SCHED; PG8_LDA(At, 1, 0); PG8_STAGE(PG8_SA(0, 1), a2 + hstep, voffA);
            PG8_WAIT_V(8); PG8_WAIT_L(0); PG8_BAR; PG8_MMA(0, 0, At, B0); PG8_MMA(0, 1, At, B1); PG8_BAR; PG8_SCHED;
            PG8_LDA(At, 1, 1); PG8_STAGE(PG8_SB(1, 0), b3, voffB); PG8_STAGE(PG8_SB(1, 1), b3 + hstep, voffB); PG8_STAGE(PG8_SA(1, 0), a3, voffA);
            PG8_WAIT_V(8); PG8_WAIT_L(0); PG8_BAR; PG8_MMA(1, 0, At, B0); PG8_MMA(1, 1, At, B1); PG8_BAR; PG8_SCHED;
            } else {
            PG8_LDB(B0, 0, 0); PG8_SCHED; PG8_LDA(At, 0, 0); PG8_STAGE(PG8_SA(1, 1), a1 + hstep, voffA);
            PG8_WAIT_L(8); PG8_BAR; PG8_WAIT_L(0); PG8_MMA(0, 0, At, B0); PG8_BAR; PG8_SCHED;
            PG8_LDB(B1, 0, 1); PG8_STAGE(PG8_SB(0, 0), b2, voffB);
            PG8_BAR; PG8_WAIT_L(0); PG8_MMA(0, 1, At, B1); PG8_BAR;
            PG8_LDA(At, 0, 1); PG8_STAGE(PG8_SA(0, 0), a2, voffA);
            PG8_BAR; PG8_WAIT_L(0); PG8_MMA(1, 0, At, B0); PG8_BAR; PG8_SCHED;
            PG8_STAGE(PG8_SB(0, 1), b2 + hstep, voffB);
            PG8_WAIT_V(6); PG8_BAR; PG8_MMA(1, 1, At, B1); PG8_BAR;
            PG8_LDB(B0, 1, 0); PG8_SCHED; PG8_LDA(At, 1, 0); PG8_STAGE(PG8_SA(0, 1), a2 + hstep, voffA);
            PG8_WAIT_L(8); PG8_BAR; PG8_WAIT_L(0); PG8_MMA(0, 0, At, B0); PG8_BAR; PG8_SCHED;
            PG8_LDB(B1, 1, 1); PG8_STAGE(PG8_SB(1, 0), b3, voffB);
            PG8_BAR; PG8_WAIT_L(0); PG8_MMA(0, 1, At, B1); PG8_BAR;
            PG8_LDA(At, 1, 1); PG8_STAGE(PG8_SA(1, 0), a3, voffA);
            PG8_BAR; PG8_WAIT_L(0); PG8_MMA(1, 0, At, B0); PG8_BAR; PG8_SCHED;
            PG8_STAGE(PG8_SB(1, 1), b3 + hstep, voffB);
            PG8_WAIT_V(6); PG8_BAR; PG8_MMA(1, 1, At, B1); PG8_BAR;
            }
        }
        if constexpr (ALIGN_EPI) { if (wr == 0) PG8_BAR; }
        if constexpr (!Epi::AFTER_DRAIN) { E(acc, cur, wr, wc, fr, fq); S.done(cur); }
        if (!has_next) break;
#pragma unroll
        for (int a = 0; a < 2; ++a)
#pragma unroll
            for (int b = 0; b < 2; ++b)
#pragma unroll
                for (int m = 0; m < 4; ++m)
#pragma unroll
                    for (int n = 0; n < 2; ++n) acc[a][b][m][n] = (f32x4){0.f, 0.f, 0.f, 0.f};
        cur = nxt; cA = nA; cB = nB; ++ui;
        if constexpr (ALIGN_EPI) { if (wr == 1) PG8_BAR; }
    }
    PG8_WAIT_V(0);
    if constexpr (!ALIGN_EPI) { if (wr == 0) PG8_BAR; }
    PG8_BAR;
    if constexpr (Epi::AFTER_DRAIN) { E.fused(acc, cur, wr, wc, fr, fq, lds, wid, lane); S.done(cur); }
#undef PG8_SA
#undef PG8_SB
#undef PG8_STAGE
#undef PG8_LDA
#undef PG8_LDB
#undef PG8_MMA
#undef PG8_WAIT_V
#undef PG8_WAIT_L
#undef PG8_BAR
#undef PG8_SCHED
}
}
#define GAS __attribute__((address_space(1)))
#define LAS __attribute__((address_space(3)))
#define XB_TMO      128
#define XB_XCNT(j)  (256  + 64 * (j))
#define XB_XSUB(j)  (1280 + 64 * (j))
#define XB_XGEN(j)  (2304 + 64 * (j))
#define XB_TOP      3328
#define XB_TOPGEN   3392
#define XCD_BAR_WORDS 3456
#define XB_SPIN_CAP (1u << 18)

__device__ __forceinline__ unsigned xb_ld(unsigned* p)              { return __hip_atomic_load(p, __ATOMIC_RELAXED, __HIP_MEMORY_SCOPE_AGENT); }
__device__ __forceinline__ unsigned xb_add(unsigned* p, unsigned v) { return __hip_atomic_fetch_add(p, v, __ATOMIC_RELAXED, __HIP_MEMORY_SCOPE_AGENT); }
__device__ __forceinline__ unsigned xb_xcc_id() { return (unsigned)__builtin_amdgcn_s_getreg((3 << 11) | 20) & 0xFu; }
#define XB_SPIN(cond, bar) do { unsigned _sp = 0; while (cond) { __builtin_amdgcn_s_sleep(1); \
    if ((++_sp & 255u) == 0u) { if (xb_ld(&(bar)[XB_TMO])) break; if (_sp > XB_SPIN_CAP) { atomicAdd(&(bar)[XB_TMO], 1u); break; } } } } while (0)

struct XcdBarrier {
    unsigned* bar; unsigned x; int w;
    volatile LAS unsigned* st;
};

__device__ __forceinline__ XcdBarrier xcd_barrier_post(unsigned* bar, volatile LAS unsigned* st, int wave_s) {
    XcdBarrier b; b.bar = bar; b.x = xb_xcc_id(); b.st = st; b.w = wave_s;
    if (tid_from(wave_s) == 0) (void)xb_add(&bar[XB_XCNT(b.x)], 1u);
    return b;
}
__device__ __forceinline__ void xcd_barrier_complete(unsigned* bar, unsigned x, unsigned& nloc, unsigned& nx) {
    const unsigned G = gridDim.x * gridDim.y * gridDim.z;
    unsigned sum, cnt, mine, sp = 0u;
    for (;;) {
        sum = 0u; cnt = 0u; mine = 0u;
#pragma unroll
        for (unsigned j = 0; j < 16; ++j) { const unsigned c = xb_ld(&bar[XB_XCNT(j)]); sum += c; cnt += (c > 0u) ? 1u : 0u; mine = (j == x) ? c : mine; }
        if (sum == G) break;
        __builtin_amdgcn_s_sleep(1);
        if ((++sp & 255u) == 0u) { if (xb_ld(&bar[XB_TMO])) break; if (sp > XB_SPIN_CAP) { atomicAdd(&bar[XB_TMO], 1u); break; } }
    }
    nloc = mine > 0u ? mine : 1u; nx = cnt > 0u ? cnt : 1u;
}

__device__ __forceinline__ void xcd_barrier(const XcdBarrier& b) {
    asm volatile("s_waitcnt vmcnt(0)" ::: "memory");
    __syncthreads();
    if (tid_from(b.w) == 0) {
        unsigned* bar = b.bar;
        __builtin_amdgcn_s_waitcnt(0);
        unsigned nloc = b.st[0], nx = b.st[1];
        if (nloc == 0u) { xcd_barrier_complete(bar, b.x, nloc, nx); b.st[0] = nloc; b.st[1] = nx; }
        const unsigned old = xb_add(&bar[XB_XSUB(b.x)], 1u);
        const unsigned gen = old / nloc;
        if (old + 1u == (gen + 1u) * nloc) {
            __builtin_amdgcn_fence(__ATOMIC_RELEASE, "agent");
            asm volatile("s_waitcnt vmcnt(0)" ::: "memory");
            const unsigned og = xb_add(&bar[XB_TOP], 1u);
            const unsigned tg = og / nx;
            if (og + 1u == (tg + 1u) * nx) xb_add(&bar[XB_TOPGEN], 1u);
            else XB_SPIN(xb_ld(&bar[XB_TOPGEN]) == tg, bar);
            __builtin_amdgcn_fence(__ATOMIC_ACQUIRE, "agent");
            xb_add(&bar[XB_XGEN(b.x)], 1u);
            asm volatile("s_waitcnt vmcnt(0)" ::: "memory");
        } else {
            XB_SPIN(xb_ld(&bar[XB_XGEN(b.x)]) == gen, bar);
            __builtin_amdgcn_fence(__ATOMIC_ACQUIRE, "agent");
            asm volatile("s_waitcnt vmcnt(0)" ::: "memory");
        }
    }
    __syncthreads();
}

constexpr int NWAVES = 8, NTHR = 512;
constexpr int DM = 2048, NB = 2, SEQ = 4096, NT = NB * SEQ, DEPTH = 4;
constexpr int INW = 5392, INWP = 5632;
constexpr int C_POOL = 0, C_GQ = 512, C_GK = 896, C_GV = 1280, C_GG = 2048, C_GA = 2816, C_RW = 2832;
constexpr int RW_IN = 2560, RW_W = 768, RW_H = 12;
constexpr int GLA_H = 4, GLA_DK = 96, GLA_DV = 192, GLA_NCH = 64;
constexpr int PEER_N = 16384;
constexpr float NORM_EPS = 1e-6f;
constexpr int MODW = 6 * DM;

constexpr size_t MiB = 1u << 20;
constexpr size_t WS_CTL = 0, CTL_ZERO_BYTES = 1 * MiB;
constexpr size_t WS_MOD = 1 * MiB;
constexpr size_t WS_WIN = 2 * MiB;
constexpr size_t WS_WOUT = 90 * MiB;
constexpr size_t WS_WQK = 122 * MiB;
constexpr size_t WS_U = 154 * MiB;
constexpr size_t WS_V = 410 * MiB;
constexpr size_t WS_US = 540 * MiB;
constexpr size_t WS_VS = 541 * MiB;
constexpr size_t WS_POOLT = 545 * MiB;
constexpr size_t WS_LORAT = 542 * MiB;
constexpr size_t WS_X = 666 * MiB;
constexpr size_t WS_H = 730 * MiB;
constexpr size_t WS_Y = 762 * MiB;
constexpr size_t WS_PROJ = 794 * MiB;
constexpr size_t WS_GKV = 970 * MiB;
constexpr size_t WS_GS = 1006 * MiB;
constexpr size_t WS_GDEC = 1042 * MiB;
constexpr size_t WS_RSC = 1043 * MiB;
constexpr size_t WS_RO = 1187 * MiB;
constexpr size_t WS_RGATE = 1211 * MiB;
constexpr size_t WS_RBV = 1235 * MiB;
constexpr size_t WS_EIDX = 1259 * MiB;
constexpr size_t WS_EGATE = 1263 * MiB;
constexpr size_t WS_END = 1267 * MiB;
constexpr size_t WS_DUMMY = 1267 * MiB;
#ifndef PROBE
#define PROBE 0
#endif
constexpr int CW_BAR = 4096;
constexpr size_t WS_SSP = 547 * MiB;
constexpr size_t WS_BIAS3 = 546 * MiB;

#ifndef QUANT_MID
#define QUANT_MID 6144
#endif
#ifndef QUANT_EARLY
#define QUANT_EARLY 10240
#endif
constexpr int EPI_XCH_OFF = 132096;
constexpr int LDS_BYTES = 147456;
constexpr int MISC_OFF = 147456 - 256;

typedef unsigned short bf16;
typedef unsigned v4u __attribute__((ext_vector_type(4)));
typedef unsigned v2u __attribute__((ext_vector_type(2)));
typedef float f32x4 __attribute__((ext_vector_type(4)));
typedef float f32x2 __attribute__((ext_vector_type(2)));
typedef __bf16 bf16x2_t __attribute__((ext_vector_type(2)));
typedef int v4i __attribute__((ext_vector_type(4)));

__device__ __forceinline__ unsigned pk2(float lo, float hi) { const f32x2 f = {lo, hi}; return __builtin_bit_cast(unsigned, __builtin_convertvector(f, bf16x2_t)); }
__device__ __forceinline__ unsigned f2bf(float f) { return pk2(f, f) & 0xffffu; }
__device__ __forceinline__ float bflo(unsigned u) { return __builtin_bit_cast(float, u << 16); }
__device__ __forceinline__ float bfhi(unsigned u) { return __builtin_bit_cast(float, u & 0xffff0000u); }
__device__ __forceinline__ float dpp_xor1(float v) { return __builtin_bit_cast(float, __builtin_amdgcn_update_dpp(0, __builtin_bit_cast(int, v), 0xB1, 0xF, 0xF, true)); }
__device__ __forceinline__ float dpp_xor2(float v) { return __builtin_bit_cast(float, __builtin_amdgcn_update_dpp(0, __builtin_bit_cast(int, v), 0x4E, 0xF, 0xF, true)); }
__device__ __forceinline__ float dpp_hmir(float v) { return __builtin_bit_cast(float, __builtin_amdgcn_update_dpp(0, __builtin_bit_cast(int, v), 0x141, 0xF, 0xF, true)); }
__device__ __forceinline__ float dpp_rmir(float v) { return __builtin_bit_cast(float, __builtin_amdgcn_update_dpp(0, __builtin_bit_cast(int, v), 0x140, 0xF, 0xF, true)); }
__device__ __forceinline__ float rl_f(float v, int l) { return __builtin_bit_cast(float, __builtin_amdgcn_readlane(__builtin_bit_cast(int, v), l)); }
__device__ __forceinline__ float row16_sum(float v) { v += dpp_xor1(v); v += dpp_xor2(v); v += dpp_hmir(v); v += dpp_rmir(v); return v; }
__device__ __forceinline__ float row16_max(float v) { v = fmaxf(v, dpp_xor1(v)); v = fmaxf(v, dpp_xor2(v)); v = fmaxf(v, dpp_hmir(v)); v = fmaxf(v, dpp_rmir(v)); return v; }
__device__ __forceinline__ float wave_sum(float v) { v = row16_sum(v); return (rl_f(v, 0) + rl_f(v, 16)) + (rl_f(v, 32) + rl_f(v, 48)); }
__device__ __forceinline__ float wave_max(float v) { v = row16_max(v); return fmaxf(fmaxf(rl_f(v, 0), rl_f(v, 16)), fmaxf(rl_f(v, 32), rl_f(v, 48))); }
__device__ __forceinline__ float half32_sum(float v, int lane) { v = row16_sum(v); const float lo = rl_f(v, 0) + rl_f(v, 16), hi = rl_f(v, 32) + rl_f(v, 48); return lane < 32 ? lo : hi; }
__device__ __forceinline__ float red8(float v) { v += dpp_xor1(v); v += dpp_xor2(v); v += dpp_hmir(v); return v; }
__device__ __forceinline__ float sigmoidf_(float x) { return __builtin_amdgcn_rcpf(1.f + __builtin_amdgcn_exp2f(-1.4426950408889634f * x)); }
__device__ __forceinline__ float softplusf_(float x) { return fmaxf(x, 0.f) + 0.6931471805599453f * __builtin_amdgcn_logf(1.f + __builtin_amdgcn_exp2f(-1.4426950408889634f * fabsf(x))); }

struct Args { const float* in[30]; float* out; unsigned char* ws; };
typedef const __attribute__((address_space(4))) Args* ArgsP;
__device__ __forceinline__ ArgsP args_ptr() { ArgsP p = (ArgsP)__builtin_amdgcn_kernarg_segment_ptr(); asm volatile("" : "+s"(p)); return p; }
__device__ __forceinline__ int opaque_i(int v) { asm volatile("" : "+s"(v)); return v; }

struct Frame {
    LAS unsigned char* lds;
    int tid, lane, wave, G, bid, gw, ngw;
};
__device__ __forceinline__ Frame make_frame(LAS unsigned char* lds, int wave_s) {
    asm volatile("" : "+s"(wave_s)); Frame F; F.lds = lds; int t = tid_from(wave_s); asm volatile("" : "+v"(t));
    F.tid = t; F.lane = t & 63; F.wave = __builtin_amdgcn_readfirstlane(t >> 6); int g_ = gridDim.x, b_ = blockIdx.x; asm volatile("" : "+s"(g_), "+s"(b_)); F.G = g_; F.bid = b_; F.gw = F.bid * NWAVES + F.wave; F.ngw = F.G * NWAVES; return F;
}

struct EpiStoreF32 {
    static constexpr bool PERM = false, AFTER_DRAIN = false;
    float* C; int ldc; int ws_; LAS unsigned char* lds_;
    __device__ __forceinline__ void operator()(const pg8::f32x4 (&acc)[2][2][4][2], const pg8::Unit& u, int, int, int, int) const {
        int tz = tid_from(ws_); asm volatile("" : "+v"(tz)); const int wid = tz >> 6, lane = tz & 63, wr = wid >> 2, wc = wid & 3, fr = lane & 15, fq = lane >> 4;
        LAS pg8::f32x4* tb = (LAS pg8::f32x4*)(lds_ + EPI_XCH_OFF + wid * 1024);
        float* base = C + (size_t)(u.pm * 256 + wr * 64 + (lane >> 2)) * ldc + u.pn * 256 + wc * 32 + 4 * (lane & 3);
#pragma unroll
        for (int ai = 0; ai < 2; ++ai)
#pragma unroll
            for (int m = 0; m < 4; ++m) { float* rowp = base + (size_t)(ai * 128 + m * 16) * ldc;
#pragma unroll
                for (int bj = 0; bj < 2; ++bj)
#pragma unroll
                    for (int n = 0; n < 2; ++n) { tb[fr * 4 + fq] = acc[ai][bj][m][n]; const pg8::f32x4 v = tb[lane]; *(pg8::f32x4*)(rowp + bj * 128 + n * 16) = v; } }
    }
};
struct EpiResid {
    static constexpr bool PERM = false, AFTER_DRAIN = false;
    const float* xsrc; float* xdst; const float* gate; int ws_; const float* gain2; const float* sc2; bf16* hdst; float* ss; LAS unsigned char* lds_;
    __device__ __forceinline__ void operator()(const pg8::f32x4 (&acc)[2][2][4][2], const pg8::Unit& u, int, int, int, int) const {
        int tz = tid_from(ws_); asm volatile("" : "+v"(tz)); const int wid = tz >> 6, lane = tz & 63, wr = wid >> 2, wc = wid & 3, fr = lane & 15, fq = lane >> 4;
        LAS pg8::f32x4* tb = (LAS pg8::f32x4*)(lds_ + EPI_XCH_OFF + wid * 1024);
        const int row0 = u.pm * 256 + wr * 64 + (lane >> 2), col0 = u.pn * 256 + wc * 32 + 4 * (lane & 3);
        const float* gp = gate + (size_t)(u.pm >> 4) * MODW + col0; const float* sp = sc2 + (size_t)(u.pm >> 4) * MODW + col0;
        pg8::f32x4 gv[2][2], hv[2][2];
#pragma unroll
        for (int bj = 0; bj < 2; ++bj)
#pragma unroll
            for (int n = 0; n < 2; ++n) { gv[bj][n] = *(const pg8::f32x4*)(gp + bj * 128 + n * 16);
                hv[bj][n] = *(const pg8::f32x4*)(gain2 + col0 + bj * 128 + n * 16) * (*(const pg8::f32x4*)(sp + bj * 128 + n * 16) + 1.f); }
#pragma unroll
        for (int ai = 0; ai < 2; ++ai)
#pragma unroll
            for (int m = 0; m < 4; ++m) { const int row = row0 + ai * 128 + m * 16; const size_t ro = (size_t)row * DM + col0; float s = 0.f;
                pg8::f32x4 xv[2][2];
#pragma unroll
                for (int bj = 0; bj < 2; ++bj)
#pragma unroll
                    for (int n = 0; n < 2; ++n) xv[bj][n] = *(const pg8::f32x4*)(xsrc + ro + bj * 128 + n * 16);
#pragma unroll
                for (int bj = 0; bj < 2; ++bj)
#pragma unroll
                    for (int n = 0; n < 2; ++n) { tb[fr * 4 + fq] = acc[ai][bj][m][n]; const pg8::f32x4 av = tb[lane];
                        const pg8::f32x4 y = xv[bj][n] + gv[bj][n] * av;
                        *(pg8::f32x4*)(xdst + ro + bj * 128 + n * 16) = y;
                        s += (y.x * y.x + y.y * y.y) + (y.z * y.z + y.w * y.w);
                        const pg8::f32x4 hh = y * hv[bj][n]; v2u pk; pk.x = pk2(hh.x, hh.y); pk.y = pk2(hh.z, hh.w); *(v2u*)(hdst + ro + bj * 128 + n * 16) = pk; }
                s += dpp_xor1(s); s += dpp_xor2(s);
                if ((lane & 3) == 0) ss[(size_t)row * 32 + u.pn * 4 + wc] = s; }
    }
};
struct EpiScore {
    static constexpr bool PERM = false, AFTER_DRAIN = false;
    float* C; int ldc; int ws_; const LAS float* rs; const float* bias; LAS unsigned char* lds_;
    __device__ __forceinline__ void operator()(const pg8::f32x4 (&acc)[2][2][4][2], const pg8::Unit& u, int, int, int, int) const {
        int tz = tid_from(ws_); asm volatile("" : "+v"(tz)); const int wid = tz >> 6, lane = tz & 63, wr = wid >> 2, wc = wid & 3, fr = lane & 15, fq = lane >> 4;
        const int row0 = u.pm * 256 + wr * 64 + fr, col0 = u.pn * 256 + wc * 32 + 4 * fq;
        const float* bp = bias + (size_t)(u.pm >> 4) * DM + col0;
        pg8::f32x4 bv[2][2];
#pragma unroll
        for (int bj = 0; bj < 2; ++bj)
#pragma unroll
            for (int n = 0; n < 2; ++n) bv[bj][n] = *(const pg8::f32x4*)(bp + bj * 128 + n * 16);
#pragma unroll
        for (int ai = 0; ai < 2; ++ai)
#pragma unroll
            for (int m = 0; m < 4; ++m) { const int row = row0 + ai * 128 + m * 16;
                float* tp = C + (size_t)(row >> 2) * 8192 + (wc * 8 + fq) * 256 + (u.pn * 8 + (row & 3)) * 4;
                const float rstd = rs[row & 255];
#pragma unroll
                for (int bj = 0; bj < 2; ++bj)
#pragma unroll
                    for (int n = 0; n < 2; ++n) *(pg8::f32x4*)(tp + bj * 16 + n * 1024) = acc[ai][bj][m][n] * rstd + bv[bj][n]; }
    }
};

__device__ __forceinline__ void quant_row_load(ArgsP A, int l, int rr, int lane, f32x4 (&nv)[8]) {
    const int tb = rr >= PEER_N; const f32x4* s0 = (const f32x4*)(A->in[27 + tb] + (size_t)(l * PEER_N + (rr - tb * PEER_N)) * DM) + lane;
#pragma unroll
    for (int j = 0; j < 8; ++j) nv[j] = __builtin_nontemporal_load(s0 + 64 * j);
}
__device__ __forceinline__ void quant_row_finish(ArgsP A, int l, int rr, int lane, const f32x4 (&v)[8], bool store) {
    const int tb = rr >= PEER_N, r = l * PEER_N + (rr - tb * PEER_N);
    float mx = 0.f, ssq = 0.f;
#pragma unroll
    for (int j = 0; j < 8; ++j) { mx = fmaxf(mx, fmaxf(fmaxf(fabsf(v[j].x), fabsf(v[j].y)), fmaxf(fabsf(v[j].z), fabsf(v[j].w)))); ssq += (v[j].x * v[j].x + v[j].y * v[j].y) + (v[j].z * v[j].z + v[j].w * v[j].w); }
    mx = wave_max(mx);
    mx = fminf(mx, (tb ? 3.0f : 2.5f) * sqrtf(wave_sum(ssq) * (1.f / DM)));
    if (!store) return;
    if (!tb) { const float inv = mx > 0.f ? 7.f / mx : 0.f;
        unsigned* dst4 = (unsigned*)(A->ws + WS_U) + (size_t)r * (DM / 8) + lane;
#pragma unroll
        for (int j = 0; j < 4; ++j) { unsigned wd = 0u;
            const float lo4[4] = {v[j].x, v[j].y, v[j].z, v[j].w}, hi4[4] = {v[j + 4].x, v[j + 4].y, v[j + 4].z, v[j + 4].w};
#pragma unroll
            for (int i = 0; i < 4; ++i) { const unsigned nl = (unsigned)((int)rintf(fminf(fmaxf(lo4[i] * inv, -7.f), 7.f)) + 8), nh = (unsigned)((int)rintf(fminf(fmaxf(hi4[i] * inv, -7.f), 7.f)) + 8); wd |= (nl | (nh << 4)) << (8 * i); }
            dst4[64 * j] = wd; }
        if (lane == 0) ((float*)(A->ws + WS_US))[r] = mx * (1.f / 7.f);
    } else { const float inv = mx > 0.f ? 6.f / mx : 0.f;
        unsigned short* dstv = (unsigned short*)(A->ws + WS_V) + (size_t)r * (DM / 4) + (lane & 31) * 8;
#pragma unroll
        for (int j = 0; j < 8; ++j) { const f32x4 c4 = __builtin_elementwise_min(__builtin_elementwise_max(v[j] * inv, (f32x4){-6.f, -6.f, -6.f, -6.f}), (f32x4){6.f, 6.f, 6.f, 6.f});
            int p = __builtin_amdgcn_cvt_scalef32_pk_fp4_f32(0, c4.x, c4.y, 1.0f, 0); p = __builtin_amdgcn_cvt_scalef32_pk_fp4_f32(p, c4.z, c4.w, 1.0f, 1);
            dstv[(j >> 2) * 256 + (((j & 3) << 1) | (lane >> 5))] = (unsigned short)p; }
        if (lane == 0) ((float*)(A->ws + WS_VS))[r] = mx * (1.f / 6.f);
    }
}
__device__ __forceinline__ void quant_tables(ArgsP A, int l, int wvi, int nw, int lane, int r_begin = 0, int r_end = 2 * PEER_N) {
    int rr = r_begin + wvi;
    if (rr >= r_end) return;
    f32x4 nv[8];
    { const int tb0 = rr >= PEER_N; const f32x4* s0 = (const f32x4*)(A->in[27 + tb0] + (size_t)(l * PEER_N + (rr - tb0 * PEER_N)) * DM) + lane;
#pragma unroll
        for (int j = 0; j < 8; ++j) nv[j] = __builtin_nontemporal_load(s0 + 64 * j); }
#pragma unroll 1
    for (; rr < r_end; rr += nw) {
        const int tb = rr >= PEER_N, r = l * PEER_N + (rr - tb * PEER_N);
        f32x4 v[8]; float mx = 0.f;
        float ssq = 0.f;
#pragma unroll
        for (int j = 0; j < 8; ++j) v[j] = nv[j];
        { const int rn = rr + nw < r_end ? rr + nw : rr, tbn = rn >= PEER_N;
            const f32x4* sn = (const f32x4*)(A->in[27 + tbn] + (size_t)(l * PEER_N + (rn - tbn * PEER_N)) * DM) + lane;
#pragma unroll
            for (int j = 0; j < 8; ++j) nv[j] = __builtin_nontemporal_load(sn + 64 * j); }
#pragma unroll
        for (int j = 0; j < 8; ++j) { mx = fmaxf(mx, fmaxf(fmaxf(fabsf(v[j].x), fabsf(v[j].y)), fmaxf(fabsf(v[j].z), fabsf(v[j].w)))); ssq += (v[j].x * v[j].x + v[j].y * v[j].y) + (v[j].z * v[j].z + v[j].w * v[j].w); }
        mx = wave_max(mx);
        mx = fminf(mx, (tb ? 3.0f : 2.5f) * sqrtf(wave_sum(ssq) * (1.f / DM)));
        unsigned* dst = (unsigned*)(A->ws + (tb ? WS_V : WS_U)) + (size_t)r * (DM / 4) + lane;
        if (!tb) { const float inv = mx > 0.f ? 7.f / mx : 0.f;
            unsigned* dst4 = (unsigned*)(A->ws + WS_U) + (size_t)r * (DM / 8) + lane;
#pragma unroll
            for (int j = 0; j < 4; ++j) { unsigned wd = 0u;
                const float lo4[4] = {v[j].x, v[j].y, v[j].z, v[j].w}, hi4[4] = {v[j + 4].x, v[j + 4].y, v[j + 4].z, v[j + 4].w};
#pragma unroll
                for (int i = 0; i < 4; ++i) { const unsigned nl = (unsigned)((int)rintf(fminf(fmaxf(lo4[i] * inv, -7.f), 7.f)) + 8), nh = (unsigned)((int)rintf(fminf(fmaxf(hi4[i] * inv, -7.f), 7.f)) + 8); wd |= (nl | (nh << 4)) << (8 * i); }
                dst4[64 * j] = wd; }
            if (lane == 0) ((float*)(A->ws + WS_US))[r] = mx * (1.f / 7.f);
        } else { const float inv = mx > 0.f ? 6.f / mx : 0.f;
            unsigned short* dstv = (unsigned short*)(A->ws + WS_V) + (size_t)r * (DM / 4) + (lane & 31) * 8;
#pragma unroll
            for (int j = 0; j < 8; ++j) { const f32x4 c4 = __builtin_elementwise_min(__builtin_elementwise_max(v[j] * inv, (f32x4){-6.f, -6.f, -6.f, -6.f}), (f32x4){6.f, 6.f, 6.f, 6.f});
                int p = __builtin_amdgcn_cvt_scalef32_pk_fp4_f32(0, c4.x, c4.y, 1.0f, 0); p = __builtin_amdgcn_cvt_scalef32_pk_fp4_f32(p, c4.z, c4.w, 1.0f, 1);
                dstv[(j >> 2) * 256 + (((j & 3) << 1) | (lane >> 5))] = (unsigned short)p; }
            if (lane == 0) ((float*)(A->ws + WS_VS))[r] = mx * (1.f / 6.f);
        }
    }
}

__device__ __forceinline__ void transpose_item(const float* W, int K, int N, bf16* WT, LAS float* scr, int kb, int nb, int lane) {
    const int k0 = 64 * kb, n0 = 64 * nb, nl = (lane & 15) * 4, kr = lane >> 4;
    f32x4 v[16];
#pragma unroll
    for (int it = 0; it < 16; ++it) v[it] = (n0 + nl < N) ? *(const f32x4*)(W + (size_t)(k0 + it * 4 + kr) * N + n0 + nl) : (f32x4){0.f, 0.f, 0.f, 0.f};
#pragma unroll
    for (int it = 0; it < 16; ++it) { LAS float* s = scr + (it * 4 + kr) * 65 + nl; s[0] = v[it].x; s[1] = v[it].y; s[2] = v[it].z; s[3] = v[it].w; }
    asm volatile("s_waitcnt lgkmcnt(0)" ::: "memory");
    const int c = lane & 7;
#pragma unroll
    for (int j = 0; j < 8; ++j) { const int n = (lane >> 3) + 8 * j; const LAS float* s = scr + (8 * c) * 65 + n;
        v4u o; o.x = pk2(s[0 * 65], s[1 * 65]); o.y = pk2(s[2 * 65], s[3 * 65]); o.z = pk2(s[4 * 65], s[5 * 65]); o.w = pk2(s[6 * 65], s[7 * 65]);
        if (n0 + n < N) *(v4u*)(WT + (size_t)(n0 + n) * K + k0 + 8 * c) = o; }
    asm volatile("s_waitcnt lgkmcnt(0)" ::: "memory");
}

__device__ __forceinline__ void ph_prologue(ArgsP A, LAS unsigned char* lds_, int wv_) {
    const Frame F = make_frame(lds_, wv_);
    LAS float* ldsf = (LAS float*)F.lds;
    const int tid = F.tid, lane = F.lane, wave = F.wave;
    for (int i = tid; i < NB * DM; i += NTHR) { const float c = A->in[1][i]; ldsf[i] = c / (1.f + __expf(-c)); }
    __syncthreads();
    {
        LAS float* red = ldsf + 4096;
        float* MOD = (float*)(A->ws + WS_MOD);
        for (int u = F.bid; u < DEPTH * 96; u += F.G) {
            const int l = u / 96, j0 = (u % 96) * 128;
            const float* W = A->in[2] + (size_t)l * DM * MODW + j0 + lane * 2;
            float a00 = 0.f, a01 = 0.f, a10 = 0.f, a11 = 0.f;
            const int k0 = wave * 256;
#pragma unroll 8
            for (int k = k0; k < k0 + 256; ++k) { const f32x2 w = *(const f32x2*)(W + (size_t)k * MODW); const float c0 = ldsf[k], c1 = ldsf[DM + k];
                a00 += c0 * w.x; a01 += c0 * w.y; a10 += c1 * w.x; a11 += c1 * w.y; }
            red[(wave * 2 + 0) * 128 + lane * 2] = a00; red[(wave * 2 + 0) * 128 + lane * 2 + 1] = a01;
            red[(wave * 2 + 1) * 128 + lane * 2] = a10; red[(wave * 2 + 1) * 128 + lane * 2 + 1] = a11;
            __syncthreads();
            if (tid < 256) { const int b = tid >> 7, j = tid & 127; float s = 0.f;
#pragma unroll
                for (int w = 0; w < 8; ++w) s += red[(w * 2 + b) * 128 + j];
                s += A->in[3][(size_t)l * MODW + j0 + j];
                MOD[(size_t)(l * 2 + b) * MODW + j0 + j] = s; }
            __syncthreads();
        }
    }
    {
        LAS float* scr = ldsf + wave * 4160;
        constexpr int NBI = (INW + 63) / 64;
        constexpr int I_IN = 32 * NBI, I_OUT = 32 * 32, I_L = I_IN + I_OUT;
        for (int it = F.gw; it < DEPTH * I_L; it += F.ngw) {
            const int l = it / I_L; int r = it % I_L;
            if (r < I_IN) transpose_item(A->in[5] + (size_t)l * DM * INW, DM, INW, (bf16*)(A->ws + WS_WIN) + (size_t)l * INWP * DM, scr, r / NBI, r % NBI, lane);
            else { r -= I_IN; transpose_item(A->in[22] + (size_t)l * DM * DM, DM, DM, (bf16*)(A->ws + WS_WOUT) + (size_t)l * DM * DM, scr, r / 32, r % 32, lane); }
        }
        constexpr int PADV = (INWP - INW) * DM / 8;
        for (int i = F.bid * NTHR + tid; i < DEPTH * PADV; i += F.G * NTHR) { const int l = i / PADV, r = i % PADV;
            ((v4u*)((bf16*)(A->ws + WS_WIN) + (size_t)l * INWP * DM + (size_t)INW * DM))[r] = (v4u){0u, 0u, 0u, 0u}; }
    }
    __syncthreads();
    {
        LAS float* Ks = ldsf;
        LAS float* Ws = ldsf + 128 * 132;
        for (int u = F.bid; u < DEPTH * 16 * 32; u += F.G) {
            const int l = u >> 9, hh = (u >> 5) & 15, jt = u & 31, h = hh >> 1, half = hh & 1, j0 = jt * 64;
            const float* ksrc = (half ? A->in[26] : A->in[25]) + ((size_t)l * 8 + h) * 128 * 128;
            const float* wsrc = A->in[24] + (size_t)l * DM * DM + h * 256 + half * 128;
            {   f32x4 kq[8], wq4[4];
#pragma unroll
                for (int it = 0; it < 8; ++it) { const int i = tid + it * NTHR, n = i >> 5, d4 = (i & 31) * 4; kq[it] = *(const f32x4*)(ksrc + n * 128 + d4); }
#pragma unroll
                for (int it = 0; it < 4; ++it) { const int i = tid + it * NTHR, jj = i >> 5, d4 = (i & 31) * 4; wq4[it] = *(const f32x4*)(wsrc + (size_t)(j0 + jj) * DM + d4); }
#pragma unroll
                for (int it = 0; it < 8; ++it) { const int i = tid + it * NTHR, n = i >> 5, d4 = (i & 31) * 4; *(LAS f32x4*)(Ks + n * 132 + d4) = kq[it]; }
#pragma unroll
                for (int it = 0; it < 4; ++it) { const int i = tid + it * NTHR, jj = i >> 5, d4 = (i & 31) * 4; *(LAS f32x4*)(Ws + jj * 132 + d4) = wq4[it]; }
            }
            __syncthreads();
            { const int li = lane & 15, lq = lane >> 4;
                f32x4 acc[4] = {{0.f, 0.f, 0.f, 0.f}, {0.f, 0.f, 0.f, 0.f}, {0.f, 0.f, 0.f, 0.f}, {0.f, 0.f, 0.f, 0.f}};
#pragma unroll 4
                for (int ks = 0; ks < 32; ++ks) { const float a = Ks[(wave * 16 + li) * 132 + 4 * ks + lq];
#pragma unroll
                    for (int jt = 0; jt < 4; ++jt) acc[jt] = __builtin_amdgcn_mfma_f32_16x16x4f32(a, Ws[(jt * 16 + li) * 132 + 4 * ks + lq], acc[jt], 0, 0, 0); }
                bf16* dst = (bf16*)(A->ws + WS_WQK) + (size_t)l * DM * DM + (size_t)(h * 256 + half * 128 + wave * 16 + lq * 4) * DM + j0 + li;
#pragma unroll
                for (int jt = 0; jt < 4; ++jt) { dst[(size_t)0 * DM + jt * 16] = (bf16)f2bf(acc[jt].x); dst[(size_t)1 * DM + jt * 16] = (bf16)f2bf(acc[jt].y); dst[(size_t)2 * DM + jt * 16] = (bf16)f2bf(acc[jt].z); dst[(size_t)3 * DM + jt * 16] = (bf16)f2bf(acc[jt].w); } }
            __syncthreads();
        }
    }
    {
        bf16* PT = (bf16*)(A->ws + WS_POOLT);
        for (int i = F.bid * NTHR + tid; i < DEPTH * 4 * 128 * 128; i += F.G * NTHR) { const int lg = i >> 14, r = i & 16383, dcol = r >> 7, c = r & 127;
            PT[(size_t)lg * 16384 + (((((dcol >> 4) * 4 + (c >> 5)) * 64 + (dcol & 15) + 16 * ((c >> 3) & 3)) * 8) + (c & 7))] = (bf16)f2bf(A->in[6][(size_t)lg * 16384 + c * 128 + dcol]); }
    }
    {
        bf16* LT = (bf16*)(A->ws + WS_LORAT);
        for (int i = F.bid * NTHR + tid; i < DEPTH * RW_W * 256; i += F.G * NTHR) { const int l = i / (RW_W * 256), r = i % (RW_W * 256), c = r >> 8, j = r & 255;
            const float v = j < 64 ? A->in[13][((size_t)l * 64 + j) * RW_W + c] : (j < 128 ? A->in[15][((size_t)l * 64 + (j - 64)) * RW_W + c] : A->in[16][((size_t)l * 128 + (j - 128)) * RW_W + c]);
            const int hh = c >> 6, ct = (c >> 4) & 3, li = c & 15, ks = j >> 5, lq = (j >> 3) & 3, e = j & 7;
            LT[(size_t)l * (RW_W * 256) + ((((hh * 4 + ct) * 8 + ks) * 64 + li + 16 * lq) * 8) + e] = (bf16)f2bf(v); }
    }
}

__device__ __forceinline__ void ph_norm(const float* xsrc, const float* gain, const float* sh, const float* sc, bf16* hout, LAS unsigned char* lds_, int wv_) {
    const Frame F = make_frame(lds_, wv_);
    for (int m = F.gw; m < NT; m += F.ngw) {
        const int b = m >> 12;
        const f32x4* xr = (const f32x4*)(xsrc + (size_t)m * DM) + F.lane;
        f32x4 v[8]; float ss = 0.f;
#pragma unroll
        for (int j = 0; j < 8; ++j) { v[j] = xr[64 * j]; ss += (v[j].x * v[j].x + v[j].y * v[j].y) + (v[j].z * v[j].z + v[j].w * v[j].w); }
        const float rstd = rsqrtf(wave_sum(ss) * (1.f / DM) + NORM_EPS);
        v2u* o8 = (v2u*)(hout + (size_t)m * DM) + F.lane;
#pragma unroll
        for (int j = 0; j < 8; ++j) { const int col = j * 256 + F.lane * 4;
            const f32x4 g = *(const f32x4*)(gain + col), s1 = *(const f32x4*)(sc + (size_t)b * MODW + col), s0 = *(const f32x4*)(sh + (size_t)b * MODW + col);
            const f32x4 y = v[j] * rstd * g * (s1 + 1.f) + s0;
            v2u o; o.x = pk2(y.x, y.y); o.y = pk2(y.z, y.w); o8[64 * j] = o; }
    }
}
__device__ __forceinline__ void ph_final(const float* xsrc, const float* gain, float* out, LAS unsigned char* lds_, int wv_) {
    const Frame F = make_frame(lds_, wv_);
    for (int m = F.gw; m < NT; m += F.ngw) {
        const f32x4* xr = (const f32x4*)(xsrc + (size_t)m * DM) + F.lane;
        f32x4 v[8]; float ss = 0.f;
#pragma unroll
        for (int j = 0; j < 8; ++j) { v[j] = xr[64 * j]; ss += (v[j].x * v[j].x + v[j].y * v[j].y) + (v[j].z * v[j].z + v[j].w * v[j].w); }
        const float rstd = rsqrtf(wave_sum(ss) * (1.f / DM) + NORM_EPS);
        f32x4* o = (f32x4*)(out + (size_t)m * DM) + F.lane;
#pragma unroll
        for (int j = 0; j < 8; ++j) { const f32x4 g = *(const f32x4*)(gain + j * 256 + F.lane * 4); o[64 * j] = v[j] * rstd * g; }
    }
}

__device__ __forceinline__ void pool_unit(ArgsP A, const Frame& F_in, int l, int unit) {
    Frame F = F_in; asm volatile("" : "+v"(F.tid)); F.lane = F.tid & 63;
    const int tile = unit >> 2, g = unit & 3, t0 = tile * 32, s0 = t0 & (SEQ - 1), tid = F.tid, lane = F.lane, w = F.wave;
    const int win = 2 << g;
    const float* proj = (const float*)(A->ws + WS_PROJ);
    LAS float* ps = (LAS float*)F.lds;
    LAS unsigned short* ds = (LAS unsigned short*)(F.lds + 24064);
    const int rt = w >> 2, ct0 = (w & 3) * 2, li = lane & 15, lq = lane >> 4;
    typedef short b8 __attribute__((ext_vector_type(8)));
    b8 bw[2][4];
    { const unsigned short* PT = (const unsigned short*)(A->ws + WS_POOLT) + ((size_t)l * 4 + g) * 16384;
#pragma unroll
        for (int j = 0; j < 2; ++j)
#pragma unroll
            for (int ks = 0; ks < 4; ++ks) bw[j][ks] = *(const b8*)(PT + (((ct0 + j) * 4 + ks) * 64 + lane) * 8); }
    {   f32x4 pq[3];
#pragma unroll
        for (int it = 0; it < 3; ++it) { const int i = tid + it * NTHR, r = i >> 5, c4 = i & 31; const int s = s0 - 15 + r;
            pq[it] = (i < 47 * 32 && s >= 0) ? *(const f32x4*)(proj + (size_t)(t0 - 15 + r) * INWP + C_POOL + g * 128 + c4 * 4) : (f32x4){0.f, 0.f, 0.f, 0.f}; }
#pragma unroll
        for (int it = 0; it < 3; ++it) { const int i = tid + it * NTHR; if (i < 47 * 32) *(LAS f32x4*)(ps + i * 4) = pq[it]; }
    }
    __syncthreads();
    for (int i = tid; i < 32 * 128; i += NTHR) { const int tok = i >> 7, c = i & 127; float sum = 0.f;
        for (int ww = 0; ww < win; ++ww) sum += ps[(tok + 15 - ww) * 128 + c];
        const int cnt = (s0 + tok + 1) < win ? (s0 + tok + 1) : win;
        ds[tok * 136 + c] = (unsigned short)f2bf(sum * __builtin_amdgcn_rcpf((float)cnt) - ps[(tok + 15) * 128 + c]); }
    __syncthreads();
    f32x4 acc[2] = {{0.f, 0.f, 0.f, 0.f}, {0.f, 0.f, 0.f, 0.f}};
#pragma unroll
    for (int ks = 0; ks < 4; ++ks) { const b8 a = *(const LAS b8*)(ds + (rt * 16 + li) * 136 + ks * 32 + lq * 8);
#pragma unroll
        for (int j = 0; j < 2; ++j) acc[j] = __builtin_amdgcn_mfma_f32_16x16x32_bf16(a, bw[j][ks], acc[j], 0, 0, 0); }
    bf16* Y = (bf16*)(A->ws + WS_Y);
#pragma unroll
    for (int j = 0; j < 2; ++j) { const int dcol = (ct0 + j) * 16 + li; const float scale = A->in[7][(size_t)l * 512 + g * 128 + dcol]; const int tk = t0 + rt * 16 + lq * 4;
        Y[(size_t)(tk + 0) * DM + g * 128 + dcol] = (bf16)f2bf(acc[j].x * scale); Y[(size_t)(tk + 1) * DM + g * 128 + dcol] = (bf16)f2bf(acc[j].y * scale);
        Y[(size_t)(tk + 2) * DM + g * 128 + dcol] = (bf16)f2bf(acc[j].z * scale); Y[(size_t)(tk + 3) * DM + g * 128 + dcol] = (bf16)f2bf(acc[j].w * scale); }
    __syncthreads();
}

__device__ __forceinline__ void gla_bcum(ArgsP A, const Frame& F, int l, int h, int t0, LAS float* bcum, LAS float* ad, LAS float* up) {
    const float* proj = (const float*)(A->ws + WS_PROJ);
    const int tid = F.tid;
    {
        const float a0 = proj[(size_t)(t0 + (tid >> 4)) * INWP + C_GA + (tid & 15)], a1 = proj[(size_t)(t0 + 32 + (tid >> 4)) * INWP + C_GA + (tid & 15)];
        const float* upg = A->in[8] + (size_t)l * 16 * 384 + h * 96;
        const float u0 = upg[(tid / 96) * 384 + tid % 96], u1 = upg[((tid + 512) / 96) * 384 + (tid + 512) % 96], u2 = upg[((tid + 1024) / 96) * 384 + (tid + 1024) % 96];
        ad[tid] = a0; ad[tid + 512] = a1; up[tid] = u0; up[tid + 512] = u1; up[tid + 1024] = u2;
    }
    __syncthreads();
    for (int i = tid; i < 64 * 96; i += NTHR) { const int tok = i / 96, d = i % 96; float x = A->in[9][(size_t)l * 384 + h * 96 + d];
#pragma unroll
        for (int j = 0; j < 16; ++j) x += ad[tok * 16 + j] * up[j * 96 + d];
        bcum[i] = -softplusf_(-x) * (1.f / 16.f); }
    __syncthreads();
    if (tid < 384) { const int d = tid % 96, seg = tid / 96; float acc = 0.f;
#pragma unroll
        for (int k = 0; k < 16; ++k) { acc += bcum[(seg * 16 + k) * 96 + d]; bcum[(seg * 16 + k) * 96 + d] = acc; }
        ad[seg * 96 + d] = acc; }
    __syncthreads();
    if (tid < 384) { const int d = tid % 96, seg = tid / 96; float pre = 0.f;
#pragma unroll
        for (int s2 = 0; s2 < 3; ++s2) pre += (s2 < seg) ? ad[s2 * 96 + d] : 0.f;
        if (seg > 0) {
#pragma unroll
            for (int k = 0; k < 16; ++k) bcum[(seg * 16 + k) * 96 + d] += pre; } }
    __syncthreads();
}

__device__ __forceinline__ void gla_scan_unit(ArgsP A, const Frame& F, int unit) {
    const int idx = unit * NTHR + F.tid, bh = idx / 18432, rem = idx % 18432, d = rem % 96;
    const float* KV = (const float*)(A->ws + WS_GKV) + (size_t)bh * 64 * 18432 + rem;
    float* GS = (float*)(A->ws + WS_GS) + (size_t)bh * 64 * 18432 + rem;
    const float* DEC = (const float*)(A->ws + WS_GDEC) + (size_t)bh * 64 * 96 + d;
    float S = 0.f;
#pragma unroll 1
    for (int c0 = 0; c0 < 64; c0 += 16) {
        float kv[16], dc[16];
#pragma unroll
        for (int j = 0; j < 16; ++j) { kv[j] = KV[(size_t)(c0 + j) * 18432]; dc[j] = DEC[(c0 + j) * 96]; }
#pragma unroll
        for (int j = 0; j < 16; ++j) { GS[(size_t)(c0 + j) * 18432] = S; S = dc[j] * S + kv[j]; }
    }
}

typedef short bf16x8_t __attribute__((ext_vector_type(8)));
constexpr int RS = 68;
__device__ __forceinline__ f32x4 tile_mm64(const LAS bf16* Am, int arow0, const LAS bf16* Bm, int brow0, f32x4 acc, int lane) {
    const int r = lane & 15, kq = (lane >> 4) * 8;
#pragma unroll
    for (int ks = 0; ks < 2; ++ks) {
        const bf16x8_t a = *(const LAS bf16x8_t*)(Am + (arow0 + r) * RS + ks * 32 + kq);
        const bf16x8_t b = *(const LAS bf16x8_t*)(Bm + (brow0 + r) * RS + ks * 32 + kq);
        acc = __builtin_amdgcn_mfma_f32_16x16x32_bf16(a, b, acc, 0, 0, 0);
    }
    return acc;
}
constexpr int RA_BT = 0, RA_KT = 8704, RA_AT = 17408, RA_RT = 26112, RA_RABS = 34816, RA_BHT = 43520, RA_KHT = 52224, RA_VT = 60928, RA_AABS = 69632,
              RA_MBAT = 86272, RA_MKA = 103680, RA_NBRT = 121088, RA_GC = 129792, RA_WT = 130048, RA_NKRT = 132096, RA_END = 140800, RA_PRE = 94976;
constexpr int RA_Z = RA_BT, RA_QST = RA_AT, RA_QOT = RA_RT, RA_LO = 0, RA_RES = 34816;
constexpr size_t RWO_POT = 0, RWO_PST = 12 * MiB, RWO_GT = 24 * MiB, RWO_OLT = 48 * MiB, RWO_SC = 72 * MiB;

__device__ __forceinline__ void rwkvA_unit(ArgsP A, const Frame& F_in, int l, int unit, int qrow = -1) {
    Frame F = F_in; asm volatile("" : "+v"(F.tid)); F.lane = F.tid & 63;

    const int bh = unit >> 6, c = unit & 63, b = bh / RW_H, h = bh % RW_H, t0 = b * SEQ + c * 64, s0 = c * 64, tid = F.tid, lane = F.lane, w = F.wave;
    const float* proj = (const float*)(A->ws + WS_PROJ);
    const float* mu = A->in[11] + (size_t)l * RW_IN;
    LAS unsigned char* L = F.lds;
    const int n = lane, cc = h * 64 + n;
    const int rt1 = w >> 1, ct1 = (w & 1) * 2, li1 = lane & 15, lq1 = lane >> 4;
    f32x4 yc[8], yp[8];
#pragma unroll
    for (int it = 0; it < 8; ++it) { const int g = tid + it * NTHR, tok = g >> 6, j4 = (g & 63) * 4; const float* rp = proj + ((size_t)t0 + tok) * INWP + C_RW + 2304 + j4;
        yc[it] = *(const f32x4*)rp; yp[it] = (s0 + tok > 0) ? *(const f32x4*)(rp - INWP) : (f32x4){0.f, 0.f, 0.f, 0.f}; }
    bf16x8_t bw[2][8];
    { const bf16* LT = (const bf16*)(A->ws + WS_LORAT) + (size_t)l * RW_W * 256 + (size_t)h * (4 * 8 * 64 * 8) + lane * 8;
#pragma unroll
        for (int j = 0; j < 2; ++j)
#pragma unroll
            for (int ks = 0; ks < 8; ++ks) bw[j][ks] = *(const bf16x8_t*)(LT + ((ct1 + j) * 8 + ks) * 512); }
    float rr[9], kr[9], vr[9];
#pragma unroll
    for (int i = 0; i < 9; ++i) { const int tok = w * 8 + i - 1; const bool ok = (s0 + tok >= 0); const float* row = proj + ((size_t)t0 + tok) * INWP + C_RW;
        rr[i] = ok ? row[cc] : 0.f; kr[i] = ok ? row[768 + cc] : 0.f; vr[i] = ok ? row[1536 + cc] : 0.f; }
    const float w0c = A->in[12][(size_t)l * RW_W + cc], a0c = A->in[14][(size_t)l * RW_W + cc], kkc = A->in[17][(size_t)l * RW_W + cc], kac = A->in[18][(size_t)l * RW_W + cc], rkc = A->in[19][(size_t)l * RW_W + cc];
    const float mur = mu[cc], muk = mu[768 + cc], muv = mu[1536 + cc];
    f32x4 qv[8];
    if (qrow >= 0) quant_row_load(A, l, qrow, lane, qv);
    {   LAS bf16* lo = (LAS bf16*)(L + RA_LO);
#pragma unroll
        for (int it = 0; it < 8; ++it) { const int g = tid + it * NTHR, tok = g >> 6, j4 = (g & 63) * 4; const f32x4 m4 = *(const f32x4*)(mu + 2304 + j4);
            const f32x4 ym = yc[it] + (yp[it] - yc[it]) * m4;
            const float sc = j4 < 64 ? 2.f : 1.f; f32x4 sg; sg.x = sigmoidf_(ym.x * sc); sg.y = sigmoidf_(ym.y * sc); sg.z = sigmoidf_(ym.z * sc); sg.w = sigmoidf_(ym.w * sc);
            const f32x4 o = j4 < 64 ? sg * 2.f - 1.f : (j4 < 128 ? ym : sg);
            v2u pk; pk.x = pk2(o.x, o.y); pk.y = pk2(o.z, o.w); *(LAS v2u*)(lo + tok * 264 + j4) = pk; }
    }
    __syncthreads();
    {
        const int rt = rt1, ct0 = ct1, li = li1, lq = lq1;
        const LAS bf16* lo = (const LAS bf16*)(L + RA_LO);
        LAS float* res = (LAS float*)(L + RA_RES);
        f32x4 acc[3][2];
#pragma unroll
        for (int p = 0; p < 3; ++p)
#pragma unroll
            for (int j = 0; j < 2; ++j) acc[p][j] = (f32x4){0.f, 0.f, 0.f, 0.f};
#pragma unroll
        for (int ks = 0; ks < 8; ++ks) { const bf16x8_t a = *(const LAS bf16x8_t*)(lo + (rt * 16 + li) * 264 + ks * 32 + lq * 8);
            const int p = ks < 2 ? 0 : (ks < 4 ? 1 : 2);
#pragma unroll
            for (int j = 0; j < 2; ++j) acc[p][j] = __builtin_amdgcn_mfma_f32_16x16x32_bf16(a, bw[j][ks], acc[p][j], 0, 0, 0); }
#pragma unroll
        for (int p = 0; p < 3; ++p)
#pragma unroll
            for (int j = 0; j < 2; ++j) { LAS float* rp = res + p * 64 * 68 + (rt * 16 + lq * 4) * 68 + (ct0 + j) * 16 + li;
                rp[0] = acc[p][j].x; rp[68] = acc[p][j].y; rp[136] = acc[p][j].z; rp[204] = acc[p][j].w; }
    }
    __syncthreads();
    float r_[8], k_[8], v_[8], av_[8], bb_[8], lw_[8];
    {
        const LAS float* res = (const LAS float*)(L + RA_RES);
        float wl[8], al[8], gl[8];
#pragma unroll
        for (int i = 0; i < 8; ++i) { wl[i] = res[(w * 8 + i) * 68 + n]; al[i] = res[64 * 68 + (w * 8 + i) * 68 + n]; gl[i] = res[2 * 64 * 68 + (w * 8 + i) * 68 + n]; }
        float* GATE = (float*)(A->ws + WS_RGATE); float* BV = (float*)(A->ws + WS_RBV);
#pragma unroll
        for (int i = 0; i < 8; ++i) { const int tok = w * 8 + i; const size_t t = (size_t)t0 + tok;
            float r = rr[i + 1], k = kr[i + 1], v = vr[i + 1];
            r += (rr[i] - r) * mur; k += (kr[i] - k) * muk; v += (vr[i] - v) * muv;
            const float wraw = -softplusf_(-(w0c + wl[i])) - 0.5f;
            const float a = sigmoidf_(a0c + al[i]);
            float kk = k * kkc; kk = kk * __builtin_amdgcn_rsqf(fmaxf(wave_sum(kk * kk), 1e-24f));
            const float k2 = k * (1.f + (a - 1.f) * kac);
            const float bonus = wave_sum(r * k2 * rkc);
            r_[i] = r; k_[i] = k2; v_[i] = v; av_[i] = -kk; bb_[i] = kk * a; lw_[i] = -__expf(wraw);
            GATE[t * RW_W + cc] = gl[i]; BV[t * RW_W + cc] = bonus * v; }
    }
    LAS float* wt = (LAS float*)(L + RA_WT);
#pragma unroll
    for (int i = 1; i < 8; ++i) lw_[i] += lw_[i - 1];
    wt[w * 64 + n] = lw_[7];
    __syncthreads();
    float pre = 0.f, mid = 0.f, last = 0.f;
#pragma unroll
    for (int ww = 0; ww < 8; ++ww) { const float x = wt[ww * 64 + n]; pre += (ww < w) ? x : 0.f; mid += (ww < 4) ? x : 0.f; last += x; }
    {
        LAS bf16* Bt = (LAS bf16*)(L + RA_BT); LAS bf16* Kt = (LAS bf16*)(L + RA_KT); LAS bf16* At = (LAS bf16*)(L + RA_AT); LAS bf16* Rt = (LAS bf16*)(L + RA_RT);
        LAS bf16* Rab = (LAS bf16*)(L + RA_RABS); LAS bf16* BhT = (LAS bf16*)(L + RA_BHT); LAS bf16* KhT = (LAS bf16*)(L + RA_KHT); LAS bf16* VT = (LAS bf16*)(L + RA_VT);
        LAS float* AabT = (LAS float*)(L + RA_AABS);
        const float emid = __expf(mid), elm = __expf(last - mid); float egp = __expf(pre - mid);
#pragma unroll
        for (int i = 0; i < 8; ++i) { const int t = w * 8 + i; const float lw = pre + lw_[i];
            const float eg = __expf(lw - mid), egi = __builtin_amdgcn_rcpf(eg), egm1 = egp, eh = elm * egi; egp = eg;
            Bt[t * RS + n] = (bf16)f2bf(bb_[i] * egi); Kt[t * RS + n] = (bf16)f2bf(k_[i] * egi); At[t * RS + n] = (bf16)f2bf(av_[i] * egm1); Rt[t * RS + n] = (bf16)f2bf(r_[i] * eg);
            Rab[t * RS + n] = (bf16)f2bf(r_[i] * (eg * emid)); AabT[n * 65 + t] = av_[i] * (egm1 * emid);
            BhT[n * RS + t] = (bf16)f2bf(bb_[i] * eh); KhT[n * RS + t] = (bf16)f2bf(k_[i] * eh); VT[n * RS + t] = (bf16)f2bf(v_[i]); }
        if (w == 0) ((LAS float*)(L + RA_GC))[n] = __expf(last);
    }
    __syncthreads();
    const int rt = w >> 1, ct0 = (w & 1) * 2, li = lane & 15, lq = lane >> 4;
#define FRAG(mat_, row_, ks_) (*(const LAS bf16x8_t*)((mat_) + ((row_) + li) * RS + (ks_) * 32 + lq * 8))
#define MM(a_, b_, c_) __builtin_amdgcn_mfma_f32_16x16x32_bf16(a_, b_, c_, 0, 0, 0)
    {
        const LAS bf16* Bt = (const LAS bf16*)(L + RA_BT); const LAS bf16* Kt = (const LAS bf16*)(L + RA_KT); const LAS bf16* At = (const LAS bf16*)(L + RA_AT); const LAS bf16* Rt = (const LAS bf16*)(L + RA_RT);
        LAS bf16* MbaT = (LAS bf16*)(L + RA_MBAT); LAS float* Mka = (LAS float*)(L + RA_MKA); LAS bf16* NbrT = (LAS bf16*)(L + RA_NBRT);
        bf16x8_t aB[2], aK[2], bA[2][2], bR[2][2];
#pragma unroll
        for (int ks = 0; ks < 2; ++ks) { aB[ks] = FRAG(Bt, rt * 16, ks); aK[ks] = FRAG(Kt, rt * 16, ks);
#pragma unroll
            for (int j = 0; j < 2; ++j) { bA[j][ks] = FRAG(At, (ct0 + j) * 16, ks); bR[j][ks] = FRAG(Rt, (ct0 + j) * 16, ks); } }
#pragma unroll
        for (int j = 0; j < 2; ++j) { const int ct = ct0 + j, tcol = ct * 16 + li, srow = rt * 16 + lq * 4;
            const f32x4 z = {0.f, 0.f, 0.f, 0.f};
            f32x4 mba = MM(aB[1], bA[j][1], MM(aB[0], bA[j][0], z)), nbr = MM(aB[1], bR[j][1], MM(aB[0], bR[j][0], z));
            f32x4 mka = MM(aK[1], bA[j][1], MM(aK[0], bA[j][0], z)), nk = MM(aK[1], bR[j][1], MM(aK[0], bR[j][0], z));
            mba.x = (srow + 0 < tcol) ? mba.x : 0.f; mba.y = (srow + 1 < tcol) ? mba.y : 0.f; mba.z = (srow + 2 < tcol) ? mba.z : 0.f; mba.w = (srow + 3 < tcol) ? mba.w : 0.f;
            mka.x = (srow + 0 < tcol) ? mka.x : 0.f; mka.y = (srow + 1 < tcol) ? mka.y : 0.f; mka.z = (srow + 2 < tcol) ? mka.z : 0.f; mka.w = (srow + 3 < tcol) ? mka.w : 0.f;
            nbr.x = (srow + 0 <= tcol) ? nbr.x : 0.f; nbr.y = (srow + 1 <= tcol) ? nbr.y : 0.f; nbr.z = (srow + 2 <= tcol) ? nbr.z : 0.f; nbr.w = (srow + 3 <= tcol) ? nbr.w : 0.f;
            nk.x = (srow + 0 <= tcol) ? nk.x : 0.f; nk.y = (srow + 1 <= tcol) ? nk.y : 0.f; nk.z = (srow + 2 <= tcol) ? nk.z : 0.f; nk.w = (srow + 3 <= tcol) ? nk.w : 0.f;
            { v2u pm; pm.x = pk2(mba.x, mba.y); pm.y = pk2(mba.z, mba.w); *(LAS v2u*)(MbaT + tcol * RS + srow) = pm; }
            Mka[(srow + 0) * RS + tcol] = mka.x; Mka[(srow + 1) * RS + tcol] = mka.y; Mka[(srow + 2) * RS + tcol] = mka.z; Mka[(srow + 3) * RS + tcol] = mka.w;
            v2u pk; pk.x = pk2(nbr.x, nbr.y); pk.y = pk2(nbr.z, nbr.w); *(LAS v2u*)(NbrT + tcol * RS + srow) = pk;
            { v2u pn; pn.x = pk2(nk.x, nk.y); pn.y = pk2(nk.z, nk.w); *(LAS v2u*)((LAS bf16*)(L + RA_NKRT) + tcol * RS + srow) = pn; } }
    }
    __syncthreads();
    {
        int t4 = tid; asm volatile("" : "+v"(t4)); const int row = t4 >> 2, q = t4 & 3, l4 = t4 & 63, li4 = l4 & 15, lq4 = l4 >> 4;
        const LAS bf16* MbaT = (const LAS bf16*)(L + RA_MBAT);
        const LAS float* Yrow = (row < 64) ? ((const LAS float*)(L + RA_AABS) + row * 65) : ((const LAS float*)(L + RA_MKA) + (row - 64) * RS);
        LAS bf16* Z = (LAS bf16*)(L + RA_Z); LAS float* pre = (LAS float*)(L + RA_PRE);
        for (int i = l4; i < 136; i += 64) ((LAS v4u*)(Z + w * 16 * RS))[i] = (v4u){0u, 0u, 0u, 0u};
        asm volatile("s_waitcnt lgkmcnt(0)" ::: "memory");
#pragma unroll 1
        for (int jb = 0; jb < 4; ++jb) {
            if (jb > 0) {
                f32x4 acc = {0.f, 0.f, 0.f, 0.f};
#pragma unroll
                for (int ks = 0; ks < 2; ++ks) { const bf16x8_t a = *(const LAS bf16x8_t*)(Z + (w * 16 + li4) * RS + ks * 32 + lq4 * 8);
                    const bf16x8_t bm = *(const LAS bf16x8_t*)(MbaT + (jb * 16 + li4) * RS + ks * 32 + lq4 * 8);
                    acc = __builtin_amdgcn_mfma_f32_16x16x32_bf16(a, bm, acc, 0, 0, 0); }
                LAS float* pp = pre + (w * 16 + lq4 * 4) * 16 + li4;
                pp[0] = acc.x; pp[16] = acc.y; pp[32] = acc.z; pp[48] = acc.w;
                asm volatile("s_waitcnt lgkmcnt(0)" ::: "memory");
            }
            float yv[16]; v2u mv[16];
#pragma unroll
            for (int u = 0; u < 16; ++u) { yv[u] = Yrow[jb * 16 + u] + (jb > 0 ? pre[row * 16 + u] : 0.f); mv[u] = *(const LAS v2u*)(MbaT + (jb * 16 + u) * RS + jb * 16 + q * 4); }
            float zb[4] = {0.f, 0.f, 0.f, 0.f};
#pragma unroll
            for (int u = 0; u < 16; ++u) {
                float part = (zb[0] * bflo(mv[u].x) + zb[1] * bfhi(mv[u].x)) + (zb[2] * bflo(mv[u].y) + zb[3] * bfhi(mv[u].y));
                part += dpp_xor1(part); part += dpp_xor2(part);
                const float zt = yv[u] + part;
                zb[u & 3] = (q == (u >> 2)) ? zt : zb[u & 3];
            }
            { v2u pk; pk.x = pk2(zb[0], zb[1]); pk.y = pk2(zb[2], zb[3]); *(LAS v2u*)(Z + row * RS + jb * 16 + q * 4) = pk; }
            asm volatile("s_waitcnt lgkmcnt(0)" ::: "memory");
        }
    }
    __syncthreads();
    {
        int t5 = tid; asm volatile("" : "+v"(t5)); const int li = t5 & 15, lq = (t5 >> 4) & 3;
        const LAS bf16* Z = (const LAS bf16*)(L + RA_Z); const LAS bf16* NbrT = (const LAS bf16*)(L + RA_NBRT); const LAS bf16* BhT = (const LAS bf16*)(L + RA_BHT);
        const LAS bf16* Rab = (const LAS bf16*)(L + RA_RABS); const LAS bf16* KhT = (const LAS bf16*)(L + RA_KHT); const LAS float* gC = (const LAS float*)(L + RA_GC);
        LAS bf16* QsT = (LAS bf16*)(L + RA_QST); LAS bf16* QoT = (LAS bf16*)(L + RA_QOT);
        bf16* PoT = (bf16*)(A->ws + WS_RSC + RWO_POT) + (size_t)unit * 4096; bf16* PsT = (bf16*)(A->ws + WS_RSC + RWO_PST) + (size_t)unit * 4096;
        bf16x8_t zW[2], zX[2], bN[2][2], bH[2][2]; v2u rb[2], kb[2], nb2[2]; float gc[2];
#pragma unroll
        for (int ks = 0; ks < 2; ++ks) { zW[ks] = FRAG(Z, rt * 16, ks); zX[ks] = FRAG(Z, 64 + rt * 16, ks);
#pragma unroll
            for (int j = 0; j < 2; ++j) { bN[j][ks] = FRAG(NbrT, (ct0 + j) * 16, ks); bH[j][ks] = FRAG(BhT, (ct0 + j) * 16, ks); } }
#pragma unroll
        for (int j = 0; j < 2; ++j) { const int col = (ct0 + j) * 16 + li, rw = rt * 16 + lq * 4; rb[j] = *(const LAS v2u*)(Rab + col * RS + rw); kb[j] = *(const LAS v2u*)(KhT + col * RS + rw); nb2[j] = *(const LAS v2u*)((const LAS bf16*)(L + RA_NKRT) + col * RS + rw); gc[j] = gC[col]; }
#pragma unroll
        for (int j = 0; j < 2; ++j) { const int col = (ct0 + j) * 16 + li, rw = rt * 16 + lq * 4;
            const int fro = ((((ct0 + j) * 2 + (rt >> 1)) * 64 + li + 16 * ((rt & 1) * 2 + (lq >> 1))) * 8) + (lq & 1) * 4;
            { f32x4 acc = {bflo(rb[j].x), bfhi(rb[j].x), bflo(rb[j].y), bfhi(rb[j].y)};
                acc = MM(zW[1], bN[j][1], MM(zW[0], bN[j][0], acc));
                v2u pk; pk.x = pk2(acc.x, acc.y); pk.y = pk2(acc.z, acc.w); *(v2u*)(PoT + fro) = pk; }
            { f32x4 acc = {(rw + 0 == col) ? gc[j] : 0.f, (rw + 1 == col) ? gc[j] : 0.f, (rw + 2 == col) ? gc[j] : 0.f, (rw + 3 == col) ? gc[j] : 0.f};
                acc = MM(zW[1], bH[j][1], MM(zW[0], bH[j][0], acc));
                v2u pk; pk.x = pk2(acc.x, acc.y); pk.y = pk2(acc.z, acc.w); *(v2u*)(PsT + fro) = pk; }
            { f32x4 acc = {bflo(nb2[j].x), bfhi(nb2[j].x), bflo(nb2[j].y), bfhi(nb2[j].y)};
                acc = MM(zX[1], bN[j][1], MM(zX[0], bN[j][0], acc));
                v2u pk; pk.x = pk2(acc.x, acc.y); pk.y = pk2(acc.z, acc.w); *(LAS v2u*)(QoT + col * RS + rw) = pk; }
            { f32x4 acc = {bflo(kb[j].x), bfhi(kb[j].x), bflo(kb[j].y), bfhi(kb[j].y)};
                acc = MM(zX[1], bH[j][1], MM(zX[0], bH[j][0], acc));
                v2u pk; pk.x = pk2(acc.x, acc.y); pk.y = pk2(acc.z, acc.w); *(LAS v2u*)(QsT + col * RS + rw) = pk; }
        }
    }
    __syncthreads();
    {
        int t6 = tid; asm volatile("" : "+v"(t6)); const int li = t6 & 15, lq = (t6 >> 4) & 3;
        const LAS bf16* VT = (const LAS bf16*)(L + RA_VT);
        const bool isO = (w & 1);
        const LAS bf16* Bm = (const LAS bf16*)(L + (isO ? RA_QOT : RA_QST));
        float* dst = (float*)(A->ws + WS_RSC + (isO ? RWO_OLT : RWO_GT)) + (size_t)unit * 4096;
        bf16x8_t av[2], bq[4][2];
#pragma unroll
        for (int ks = 0; ks < 2; ++ks) { av[ks] = FRAG(VT, rt * 16, ks);
#pragma unroll
            for (int j = 0; j < 4; ++j) bq[j][ks] = FRAG(Bm, j * 16, ks); }
#pragma unroll
        for (int j = 0; j < 4; ++j) { const f32x4 z = {0.f, 0.f, 0.f, 0.f};
            const f32x4 acc = MM(av[1], bq[j][1], MM(av[0], bq[j][0], z));
            *(f32x4*)(dst + (size_t)(((rt * 4 + j) * 64 + li + 16 * lq) * 4)) = acc; }
    }
#undef FRAG
#undef MM
    if (qrow >= 0) quant_row_finish(A, l, qrow, lane, qv, true);
    __syncthreads();
}

__device__ __forceinline__ void rwkvB_scan(ArgsP A, const Frame& F, int unit) {
    const int bh = unit >> 2, rq = unit & 3;
    const int tid = F.tid, lane = F.lane, w = F.wave, ct = w & 3, li = lane & 15, lq = lane >> 4;
    const bool writer = (w < 4);
    const bf16* PsT = (const bf16*)(A->ws + WS_RSC + RWO_PST) + (size_t)bh * 64 * 4096; const float* GT = (const float*)(A->ws + WS_RSC + RWO_GT) + (size_t)bh * 64 * 4096;
    bf16* SC = (bf16*)(A->ws + WS_RSC + RWO_SC) + (size_t)bh * 64 * 4096;
    f32x4 S = {0.f, 0.f, 0.f, 0.f};
    constexpr int PF = 4;
    bf16x8_t pb[PF][2]; f32x4 gq[PF];
    const int col = ct * 16 + li;
#define SLOAD(slot, cc_) do { _Pragma("unroll") for (int ks = 0; ks < 2; ++ks) pb[slot][ks] = *(const bf16x8_t*)(PsT + (size_t)(cc_) * 4096 + ((ct * 2 + ks) * 64 + lane) * 8); \
        gq[slot] = *(const f32x4*)(GT + (size_t)(cc_) * 4096 + ((rq * 4 + ct) * 64 + lane) * 4); } while (0)
#define SSTEP(slot, cc_) do { LAS bf16* Sl = (LAS bf16*)(F.lds + ((cc_) & 1) * 2176); \
        if (writer) { const int rw_ = lq * 4; Sl[(rw_ + 0) * RS + col] = (bf16)f2bf(S.x); Sl[(rw_ + 1) * RS + col] = (bf16)f2bf(S.y); Sl[(rw_ + 2) * RS + col] = (bf16)f2bf(S.z); Sl[(rw_ + 3) * RS + col] = (bf16)f2bf(S.w); } \
        asm volatile("s_waitcnt lgkmcnt(0)" ::: "memory"); __builtin_amdgcn_s_barrier(); asm volatile("" ::: "memory");        \
        if (tid < 128) { const int v_ = tid >> 3, k8_ = (tid & 7) * 8; *(v4u*)(SC + (size_t)(cc_) * 4096 + (rq * 16 + v_) * 64 + k8_) = *(const LAS v4u*)(Sl + v_ * RS + k8_); } \
        f32x4 acc_ = gq[slot]; \
        _Pragma("unroll") for (int ks = 0; ks < 2; ++ks) { const bf16x8_t a_ = *(const LAS bf16x8_t*)(Sl + li * RS + ks * 32 + lq * 8); \
            acc_ = __builtin_amdgcn_mfma_f32_16x16x32_bf16(a_, pb[slot][ks], acc_, 0, 0, 0); } \
        S = acc_; } while (0)
    SLOAD(0, 0); SLOAD(1, 1); SLOAD(2, 2); SLOAD(3, 3);
#pragma unroll 1
    for (int c = 0; c < 64; c += 4) {
        const int cn = (c + 4 < 64) ? c + 4 : 60;
        SSTEP(0, c);     SLOAD(0, cn);
        SSTEP(1, c + 1); SLOAD(1, cn + 1);
        SSTEP(2, c + 2); SLOAD(2, cn + 2);
        SSTEP(3, c + 3); SLOAD(3, cn + 3);
    }
#undef SLOAD
#undef SSTEP
    __syncthreads();
}

__device__ __forceinline__ void rwkvC_unit(ArgsP A, const Frame& F_in, int l, int unit) {
    Frame F = F_in; asm volatile("" : "+v"(F.tid)); F.lane = F.tid & 63;

    const int bh = unit >> 6, c = unit & 63, b = bh / RW_H, h = bh % RW_H, t0 = b * SEQ + c * 64, tid = F.tid, lane = F.lane, w = F.wave;
    const int rt = w >> 1, ct0 = (w & 1) * 2, li = lane & 15, lq = lane >> 4;
    LAS bf16* Sl = (LAS bf16*)F.lds; LAS bf16* Pl = (LAS bf16*)(F.lds + 8704); LAS float* ob = (LAS float*)(F.lds + 17408);
    { const int r = tid >> 3, k8 = (tid & 7) * 8;
        *(LAS v4u*)(Sl + r * RS + k8) = *(const v4u*)((const bf16*)(A->ws + WS_RSC + RWO_SC) + (size_t)unit * 4096 + r * 64 + k8); }
    const float* OlT = (const float*)(A->ws + WS_RSC + RWO_OLT) + (size_t)unit * 4096;
    const bf16* PoF = (const bf16*)(A->ws + WS_RSC + RWO_POT) + (size_t)unit * 4096 + lane * 8;
    f32x4 oacc[2]; bf16x8_t pof[2][2];
#pragma unroll
    for (int j = 0; j < 2; ++j) { oacc[j] = *(const f32x4*)(OlT + ((rt * 4 + ct0 + j) * 64 + lane) * 4);
#pragma unroll
        for (int ks = 0; ks < 2; ++ks) pof[j][ks] = *(const bf16x8_t*)(PoF + ((ct0 + j) * 2 + ks) * 512); }
    __syncthreads();
#pragma unroll
    for (int j = 0; j < 2; ++j) { const int tcol = (ct0 + j) * 16 + li, vr = rt * 16 + lq * 4;
        f32x4 acc = oacc[j];
#pragma unroll
        for (int ks = 0; ks < 2; ++ks) { const bf16x8_t a = *(const LAS bf16x8_t*)(Sl + (rt * 16 + li) * RS + ks * 32 + lq * 8);
            acc = __builtin_amdgcn_mfma_f32_16x16x32_bf16(a, pof[j][ks], acc, 0, 0, 0); }
        *(LAS f32x4*)(ob + tcol * 68 + vr) = acc; }
    __syncthreads();
    { const int t = tid >> 3, q = tid & 7; const size_t tg = (size_t)t0 + t;
        const f32x4 o0 = *(const LAS f32x4*)(ob + t * 68 + q * 8), o1 = *(const LAS f32x4*)(ob + t * 68 + q * 8 + 4);
        const float mean = red8((o0.x + o0.y) + (o0.z + o0.w) + (o1.x + o1.y) + (o1.z + o1.w)) * (1.f / 64.f);
        const f32x4 d0 = o0 - mean, d1 = o1 - mean;
        const float var = red8((d0.x * d0.x + d0.y * d0.y) + (d0.z * d0.z + d0.w * d0.w) + (d1.x * d1.x + d1.y * d1.y) + (d1.z * d1.z + d1.w * d1.w)) * (1.f / 64.f);
        const float rs = rsqrtf(var + 64e-5f);
        const int cc = h * 64 + q * 8;
        const f32x4 g0 = *(const f32x4*)(A->in[20] + (size_t)l * RW_W + cc), g1 = *(const f32x4*)(A->in[20] + (size_t)l * RW_W + cc + 4);
        const f32x4 b0 = *(const f32x4*)(A->in[21] + (size_t)l * RW_W + cc), b1 = *(const f32x4*)(A->in[21] + (size_t)l * RW_W + cc + 4);
        const f32x4 bv0 = *(const f32x4*)((const float*)(A->ws + WS_RBV) + tg * RW_W + cc), bv1 = *(const f32x4*)((const float*)(A->ws + WS_RBV) + tg * RW_W + cc + 4);
        const f32x4 ga0 = *(const f32x4*)((const float*)(A->ws + WS_RGATE) + tg * RW_W + cc), ga1 = *(const f32x4*)((const float*)(A->ws + WS_RGATE) + tg * RW_W + cc + 4);
        const f32x4 y0 = (d0 * rs * g0 + b0 + bv0) * ga0, y1 = (d1 * rs * g1 + b1 + bv1) * ga1;
        v4u o; o.x = pk2(y0.x, y0.y); o.y = pk2(y0.z, y0.w); o.z = pk2(y1.x, y1.y); o.w = pk2(y1.z, y1.w);
        *(v4u*)((bf16*)(A->ws + WS_Y) + tg * DM + 1280 + cc) = o; }
    __syncthreads();
}

constexpr size_t RWO_GQ = 84 * MiB, RWO_GK = 92 * MiB, RWO_GVT = 100 * MiB, RWO_GEM = 116 * MiB;
constexpr int GQS = 104, GTS = 72;
template <int NKS> __device__ __forceinline__ f32x4 tile_mm(const LAS bf16* Am, int sa, int arow0, const LAS bf16* Bm, int sb, int brow0, f32x4 acc, int lane) {
    const int r = lane & 15, kq = (lane >> 4) * 8;
#pragma unroll
    for (int ks = 0; ks < NKS; ++ks) {
        const bf16x8_t a = *(const LAS bf16x8_t*)(Am + (arow0 + r) * sa + ks * 32 + kq);
        const bf16x8_t b = *(const LAS bf16x8_t*)(Bm + (brow0 + r) * sb + ks * 32 + kq);
        acc = __builtin_amdgcn_mfma_f32_16x16x32_bf16(a, b, acc, 0, 0, 0);
    }
    return acc;
}

__device__ __forceinline__ int gsw(int row) { return ((row >> 2) ^ (row >> 5)) & 7; }
__device__ __forceinline__ f32x4 tile_mm_sw(const LAS bf16* Am, int arow0, const LAS bf16* Bm, int brow0, f32x4 acc, int lane) {
    const int r = lane & 15, cq = lane >> 4, fa = gsw(arow0 + r), fb = gsw(brow0 + r);
#pragma unroll
    for (int ks = 0; ks < 2; ++ks) {
        const bf16x8_t a = *(const LAS bf16x8_t*)(Am + (arow0 + r) * GTS + (((ks * 4 + cq) ^ fa) << 3));
        const bf16x8_t b = *(const LAS bf16x8_t*)(Bm + (brow0 + r) * GTS + (((ks * 4 + cq) ^ fb) << 3));
        acc = __builtin_amdgcn_mfma_f32_16x16x32_bf16(a, b, acc, 0, 0, 0);
    }
    return acc;
}
__device__ __forceinline__ void gla1_unit(ArgsP A, const Frame& F_in, int l, int unit, int qrow = -1) {
    Frame F = F_in; asm volatile("" : "+v"(F.tid)); F.lane = F.tid & 63;
    const int bh = unit >> 6, c = unit & 63, b = bh >> 2, h = bh & 3, t0 = b * SEQ + c * 64, tid = F.tid, lane = F.lane, w = F.wave;
    const float* proj = (const float*)(A->ws + WS_PROJ);
    LAS float* bcum = (LAS float*)F.lds;
    LAS float* ad = bcum + 6144;
    LAS float* up = ad + 1024;
    LAS bf16* KtT = (LAS bf16*)(F.lds + 34816);
    LAS bf16* VT = (LAS bf16*)(F.lds + 48640);
    f32x4 qq[3], kq[3], vq[6];
#pragma unroll
    for (int it = 0; it < 3; ++it) { const int i = tid + it * NTHR, tok = i / 24, d4 = i % 24; const float* rp = proj + (size_t)(t0 + tok) * INWP + h * 96 + d4 * 4;
        qq[it] = *(const f32x4*)(rp + C_GQ); kq[it] = *(const f32x4*)(rp + C_GK); }
#pragma unroll
    for (int it = 0; it < 6; ++it) { const int i = tid + it * NTHR, tok = i / 48, e4 = i % 48; vq[it] = *(const f32x4*)(proj + (size_t)(t0 + tok) * INWP + C_GV + h * 192 + e4 * 4); }
    f32x4 qv[8];
    if (qrow >= 0) quant_row_load(A, l, qrow, lane, qv);
    gla_bcum(A, F, l, h, t0, bcum, ad, up);
    const float qs = 0.10206207261596575f;
    bf16* Qg = (bf16*)(A->ws + WS_RSC + RWO_GQ) + (size_t)unit * 6144; bf16* Kg = (bf16*)(A->ws + WS_RSC + RWO_GK) + (size_t)unit * 6144;
#pragma unroll
    for (int it = 0; it < 3; ++it) { const int i = tid + it * NTHR, tok = i / 24, d = (i % 24) * 4;
        const float qv[4] = {qq[it].x, qq[it].y, qq[it].z, qq[it].w}, kv[4] = {kq[it].x, kq[it].y, kq[it].z, kq[it].w}; float qo[4], ko[4];
#pragma unroll
        for (int e = 0; e < 4; ++e) { const float m = bcum[31 * 96 + d + e], bb = bcum[tok * 96 + d + e];
            qo[e] = qv[e] * qs * __expf(bb - m); ko[e] = kv[e] * __expf(m - bb); KtT[(d + e) * GTS + ((((tok >> 3) ^ gsw(d + e)) << 3) | (tok & 7))] = (bf16)f2bf(ko[e]); }
        v2u pq, pk; pq.x = pk2(qo[0], qo[1]); pq.y = pk2(qo[2], qo[3]); pk.x = pk2(ko[0], ko[1]); pk.y = pk2(ko[2], ko[3]);
        *(v2u*)(Qg + tok * 96 + d) = pq; *(v2u*)(Kg + tok * 96 + d) = pk; }
#pragma unroll
    for (int it = 0; it < 6; ++it) { const int i = tid + it * NTHR, tok = i / 48, e = (i % 48) * 4;
        const int ts = tok >> 3, tl = tok & 7;
        VT[(e + 0) * GTS + (((ts ^ gsw(e + 0)) << 3) | tl)] = (bf16)f2bf(vq[it].x); VT[(e + 1) * GTS + (((ts ^ gsw(e + 1)) << 3) | tl)] = (bf16)f2bf(vq[it].y);
        VT[(e + 2) * GTS + (((ts ^ gsw(e + 2)) << 3) | tl)] = (bf16)f2bf(vq[it].z); VT[(e + 3) * GTS + (((ts ^ gsw(e + 3)) << 3) | tl)] = (bf16)f2bf(vq[it].w); }
    if (tid < 96) { ((float*)(A->ws + WS_RSC + RWO_GEM))[(size_t)unit * 96 + tid] = __expf(bcum[31 * 96 + tid]);
        ((float*)(A->ws + WS_GDEC))[(size_t)unit * 96 + tid] = __expf(bcum[63 * 96 + tid]); }
    __syncthreads();
    { bf16* VTg = (bf16*)(A->ws + WS_RSC + RWO_GVT) + (size_t)unit * 12288;
#pragma unroll
        for (int it = 0; it < 3; ++it) { const int i = tid + it * NTHR, e = i >> 3, t8 = (i & 7) * 8; *(v4u*)(VTg + e * 64 + t8) = *(const LAS v4u*)(VT + e * GTS + ((((i & 7) ^ gsw(e))) << 3)); } }
    { const int li = lane & 15, lq = lane >> 4;
        float* KVg = (float*)(A->ws + WS_GKV) + (size_t)unit * 18432;
#pragma unroll
        for (int a = 0; a < 3; ++a) { const int dt = (w & 1) * 3 + a, d0 = dt * 16 + lq * 4;
            const float s0 = __expf(bcum[63 * 96 + d0] - bcum[31 * 96 + d0]), s1 = __expf(bcum[63 * 96 + d0 + 1] - bcum[31 * 96 + d0 + 1]),
                        s2 = __expf(bcum[63 * 96 + d0 + 2] - bcum[31 * 96 + d0 + 2]), s3 = __expf(bcum[63 * 96 + d0 + 3] - bcum[31 * 96 + d0 + 3]);
#pragma unroll
            for (int bb = 0; bb < 3; ++bb) { const int et = (w >> 1) * 3 + bb; const f32x4 z = {0.f, 0.f, 0.f, 0.f};
                f32x4 acc = tile_mm_sw(KtT, dt * 16, VT, et * 16, z, lane);
                acc.x *= s0; acc.y *= s1; acc.z *= s2; acc.w *= s3;
                *(f32x4*)(KVg + (size_t)(et * 16 + li) * 96 + d0) = acc; } } }
    if (qrow >= 0) quant_row_finish(A, l, qrow, lane, qv, true);
    __syncthreads();
}

__device__ __forceinline__ void gla3_unit(ArgsP A, const Frame& F_in, int l, int unit) {
    Frame F = F_in; asm volatile("" : "+v"(F.tid)); F.lane = F.tid & 63;
    const int bh = unit >> 6, c = unit & 63, b = bh >> 2, h = bh & 3, t0 = b * SEQ + c * 64, tid = F.tid, lane = F.lane, w = F.wave;
    const int li = lane & 15, lq = lane >> 4;
    const float* proj = (const float*)(A->ws + WS_PROJ);
    LAS bf16* Qs = (LAS bf16*)F.lds;
    LAS bf16* Ks = (LAS bf16*)(F.lds + 13312);
    LAS bf16* VT = (LAS bf16*)(F.lds + 26624);
    LAS bf16* ST = (LAS bf16*)(F.lds + 54272);
    LAS bf16* att = (LAS bf16*)(F.lds + 94208);
    LAS float* ssq = (LAS float*)(F.lds + 103424);
    LAS float* em = (LAS float*)(F.lds + 103936);
    LAS float* ob = (LAS float*)(F.lds + 26624);
    {
        const v4u* Qg = (const v4u*)((const bf16*)(A->ws + WS_RSC + RWO_GQ) + (size_t)unit * 6144); const v4u* Kg = (const v4u*)((const bf16*)(A->ws + WS_RSC + RWO_GK) + (size_t)unit * 6144);
        const v4u* VTg = (const v4u*)((const bf16*)(A->ws + WS_RSC + RWO_GVT) + (size_t)unit * 12288);
        const f32x4* GS = (const f32x4*)((const float*)(A->ws + WS_GS) + (size_t)unit * 18432);
        v4u q0 = Qg[tid], k0 = Kg[tid], q1 = {0u, 0u, 0u, 0u}, k1 = {0u, 0u, 0u, 0u};
        if (tid < 256) { q1 = Qg[512 + tid]; k1 = Kg[512 + tid]; }
        v4u vt[3]; f32x4 sg[9];
#pragma unroll
        for (int it = 0; it < 3; ++it) vt[it] = VTg[tid + it * NTHR];
#pragma unroll
        for (int it = 0; it < 9; ++it) sg[it] = GS[tid + it * NTHR];
        if (tid < 96) em[tid] = ((const float*)(A->ws + WS_RSC + RWO_GEM))[(size_t)unit * 96 + tid];
        { const int i = tid, t = i / 12, c8 = (i % 12) * 8; *(LAS v4u*)(Qs + t * GQS + c8) = q0; *(LAS v4u*)(Ks + t * GQS + c8) = k0; }
        if (tid < 256) { const int i = 512 + tid, t = i / 12, c8 = (i % 12) * 8; *(LAS v4u*)(Qs + t * GQS + c8) = q1; *(LAS v4u*)(Ks + t * GQS + c8) = k1; }
#pragma unroll
        for (int it = 0; it < 3; ++it) { const int i = tid + it * NTHR, e = i >> 3, t8 = (i & 7) * 8; *(LAS v4u*)(VT + e * GTS + t8) = vt[it]; }
        __syncthreads();
#pragma unroll
        for (int it = 0; it < 9; ++it) { const int i = tid + it * NTHR, e = i / 24, d = (i % 24) * 4; const f32x4 m4 = *(const LAS f32x4*)(em + d);
            v2u pk; pk.x = pk2(sg[it].x * m4.x, sg[it].y * m4.y); pk.y = pk2(sg[it].z * m4.z, sg[it].w * m4.w); *(LAS v2u*)(ST + e * GQS + d) = pk; }
    }
    __syncthreads();
#pragma unroll
    for (int a = 0; a < 2; ++a) { const int jt = w >> 1, it = (w & 1) * 2 + a; const f32x4 z = {0.f, 0.f, 0.f, 0.f};
        f32x4 acc = z;
        if (jt <= it) acc = tile_mm<3>(Ks, GQS, jt * 16, Qs, GQS, it * 16, z, lane);
        const int i = it * 16 + li, j0 = jt * 16 + lq * 4;
        acc.x = (j0 + 0 <= i) ? acc.x : 0.f; acc.y = (j0 + 1 <= i) ? acc.y : 0.f; acc.z = (j0 + 2 <= i) ? acc.z : 0.f; acc.w = (j0 + 3 <= i) ? acc.w : 0.f;
        v2u pk; pk.x = pk2(acc.x, acc.y); pk.y = pk2(acc.z, acc.w); *(LAS v2u*)(att + i * GTS + j0) = pk; }
    __syncthreads();
    f32x4 o[6];
    { const int it = w >> 1;
#pragma unroll
        for (int a = 0; a < 6; ++a) { const int et = (w & 1) * 6 + a; const f32x4 z = {0.f, 0.f, 0.f, 0.f};
            f32x4 acc = tile_mm<2>(att, GTS, it * 16, VT, GTS, et * 16, z, lane);
            o[a] = tile_mm<3>(Qs, GQS, it * 16, ST, GQS, et * 16, acc, lane); }
        float s0 = 0.f, s1 = 0.f, s2 = 0.f, s3 = 0.f;
#pragma unroll
        for (int a = 0; a < 6; ++a) { s0 += o[a].x * o[a].x; s1 += o[a].y * o[a].y; s2 += o[a].z * o[a].z; s3 += o[a].w * o[a].w; }
        s0 = row16_sum(s0); s1 = row16_sum(s1); s2 = row16_sum(s2); s3 = row16_sum(s3);
        if (li == 0) { const int r0 = it * 16 + lq * 4; ssq[(r0 + 0) * 2 + (w & 1)] = s0; ssq[(r0 + 1) * 2 + (w & 1)] = s1; ssq[(r0 + 2) * 2 + (w & 1)] = s2; ssq[(r0 + 3) * 2 + (w & 1)] = s3; }
    }
    __syncthreads();
    { const int it = w >> 1, r0 = it * 16 + lq * 4;
#pragma unroll
        for (int a = 0; a < 6; ++a) { const int e = ((w & 1) * 6 + a) * 16 + li;
            ob[(r0 + 0) * 196 + e] = o[a].x; ob[(r0 + 1) * 196 + e] = o[a].y; ob[(r0 + 2) * 196 + e] = o[a].z; ob[(r0 + 3) * 196 + e] = o[a].w; } }
    __syncthreads();
    { bf16* Y = (bf16*)(A->ws + WS_Y);
        f32x4 gv[6];
#pragma unroll
        for (int k = 0; k < 6; ++k) { const int i = tid + k * NTHR, t = i / 48, e = (i % 48) * 4; gv[k] = *(const f32x4*)(proj + (size_t)(t0 + t) * INWP + C_GG + h * 192 + e); }
#pragma unroll
        for (int k = 0; k < 6; ++k) { const int i = tid + k * NTHR, t = i / 48, e = (i % 48) * 4;
            const float rstd = rsqrtf((ssq[t * 2] + ssq[t * 2 + 1]) * (1.f / 192.f) + NORM_EPS);
            const f32x4 ov = *(const LAS f32x4*)(ob + t * 196 + e); const f32x4 ng = *(const f32x4*)(A->in[10] + (size_t)l * 768 + h * 192 + e);
            f32x4 y; y.x = ov.x * rstd * ng.x * gv[k].x * sigmoidf_(gv[k].x); y.y = ov.y * rstd * ng.y * gv[k].y * sigmoidf_(gv[k].y);
            y.z = ov.z * rstd * ng.z * gv[k].z * sigmoidf_(gv[k].z); y.w = ov.w * rstd * ng.w * gv[k].w * sigmoidf_(gv[k].w);
            v2u pk; pk.x = pk2(y.x, y.y); pk.y = pk2(y.z, y.w); *(v2u*)(Y + (size_t)(t0 + t) * DM + 512 + h * 192 + e) = pk; } }
    __syncthreads();
}

#define INS16(L, P, x, px) do { { const bool c_ = (x) > L[15]; L[15] = c_ ? (x) : L[15]; P[15] = c_ ? (px) : P[15]; } \
    _Pragma("unroll") for (int r_ = 14; r_ >= 0; --r_) { const bool c_ = L[r_ + 1] > L[r_]; const float tl_ = L[r_]; const int tp_ = P[r_]; \
        L[r_] = c_ ? L[r_ + 1] : tl_; L[r_ + 1] = c_ ? tl_ : L[r_ + 1]; P[r_] = c_ ? P[r_ + 1] : tp_; P[r_ + 1] = c_ ? tp_ : P[r_ + 1]; } } while (0)

__device__ __forceinline__ float gelu_as(float v) {
    const float av = fabsf(v), t = __builtin_amdgcn_rcpf(av * 0.2316418882f + 1.0f);
    float q = t * 0.5307027145f + (-0.7265760135f); q = q * t + 0.7107068705f; q = q * t + (-0.142248368f); q = q * t + 0.127414796f; q = q * t;
    const float e = __builtin_amdgcn_exp2f((v * v) * (-0.72134752044f));
    const float m = v * (q * e);
    return v < 0.f ? m : v - m;
}
__device__ __forceinline__ int row16_sum_i(int v) {
    v += __builtin_amdgcn_update_dpp(0, v, 0xB1, 0xF, 0xF, true); v += __builtin_amdgcn_update_dpp(0, v, 0x4E, 0xF, 0xF, true);
    v += __builtin_amdgcn_update_dpp(0, v, 0x141, 0xF, 0xF, true); v += __builtin_amdgcn_update_dpp(0, v, 0x140, 0xF, 0xF, true); return v;
}
#ifndef PEER_SL_SHIFT
#define PEER_SL_SHIFT 10
#endif
__device__ __forceinline__ void ph_peer4(ArgsP A, LAS unsigned char* lds_, int wv_, int l, const float* g2, const float* sh2, const float* ngain, const float* nsh, const float* nsc, const bool last, const bool dry = false) {
    const Frame F = make_frame(lds_, wv_);
    const int lane = F.lane, li = lane & 15, lq = lane >> 4;
    const float* SCO = (const float*)(A->ws + WS_PROJ);
    const unsigned char* U4 = A->ws + WS_U + (size_t)l * PEER_N * (DM / 2); const unsigned char* V4 = A->ws + WS_V + (size_t)l * PEER_N * (DM / 2);
    const float* US = (const float*)(A->ws + WS_US) + (size_t)l * PEER_N; const float* VS = (const float*)(A->ws + WS_VS) + (size_t)l * PEER_N;
    float* X = (float*)(A->ws + WS_X); bf16* H = (bf16*)(A->ws + WS_H); const float* ssr = (const float*)(A->ws + WS_SSP) + (size_t)l * NT * 32;
    LAS unsigned char* wl = F.lds + F.wave * 15104;
    LAS int* es = (LAS int*)wl; LAS float* gs = (LAS float*)(wl + 4096);
    LAS v4u* hl = (LAS v4u*)wl;
    LAS int* se = (LAS int*)(wl + 8448);
    LAS float* sg = (LAS float*)(wl + 10496);
    LAS int* st = (LAS int*)(wl + 12544);
    LAS float* dl = (LAS float*)(wl + 14592);
    LAS float* hsl = dl + 64; LAS int* hsi = (LAS int*)(dl + 68);
    for (int tb = F.gw * 4; tb < NT; tb += F.ngw * 4) {
        {
            int P2[16]; float gt[16];
            const int half = (lane >> 2) & 1;
            const f32x4* s4 = (const f32x4*)(SCO + (size_t)(tb >> 2) * 8192) + lane;
            int KK[16];
#pragma unroll
            for (int r = 0; r < 16; ++r) KK[r] = (int)0x80000000;
            f32x4 nv[4];
#pragma unroll
            for (int i = 0; i < 4; ++i) nv[i] = s4[i * 64];
#define CE_DESC(a_, b_) do { const int hi_ = (a_) > (b_) ? (a_) : (b_); const int lo_ = (a_) > (b_) ? (b_) : (a_); (a_) = hi_; (b_) = lo_; } while (0)
#pragma unroll 1
            for (int q = 0; q < 8; ++q) {
                f32x4 v[4];
#pragma unroll
                for (int i = 0; i < 4; ++i) v[i] = nv[i];
                if (q < 7) {
#pragma unroll
                    for (int i = 0; i < 4; ++i) nv[i] = s4[(4 * (q + 1) + i) * 64]; }
                _Pragma("unroll") for (int r = 0; r < 16; ++r) asm volatile("" : "+v"(KK[r]));
                int NN[16]; const int ib = 127 - 16 * q;
#pragma unroll
                for (int i = 0; i < 4; ++i) { const float x4[4] = {v[i].x, v[i].y, v[i].z, v[i].w};
#pragma unroll
                    for (int c = 0; c < 4; ++c) { const int b_ = __builtin_bit_cast(int, x4[c]); const int k_ = b_ ^ ((b_ >> 31) & 0x7fffffff); NN[4 * i + c] = (k_ & ~127) | (ib - (4 * i + c)); } }
#pragma unroll
                for (int k = 2; k <= 16; k <<= 1)
#pragma unroll
                    for (int j = k >> 1; j > 0; j >>= 1)
#pragma unroll
                        for (int i = 0; i < 16; ++i) { const int l_ = i ^ j; if (l_ > i) { if ((i & k) == 0) CE_DESC(NN[i], NN[l_]); else CE_DESC(NN[l_], NN[i]); } }
#pragma unroll
                for (int r = 0; r < 16; ++r) KK[r] = KK[r] > NN[15 - r] ? KK[r] : NN[15 - r];
#pragma unroll
                for (int j = 8; j > 0; j >>= 1)
#pragma unroll
                    for (int i = 0; i < 16; ++i) { const int l_ = i ^ j; if (l_ > i) CE_DESC(KK[i], KK[l_]); }
            }
#undef CE_DESC
            float v1[16], v2[16];
            LAS int* gsi = (LAS int*)gs;
#pragma unroll
            for (int r = 0; r < 16; ++r) { const int ok = __builtin_amdgcn_ds_swizzle(KK[r], 0x101F);
                const int k1 = half ? ok : KK[r], k2 = half ? KK[r] : ok; const int a1 = k1 & ~127, a2 = k2 & ~127;
                v1[r] = __builtin_bit_cast(float, a1 ^ ((a1 >> 31) & 0x7fffffff)); v2[r] = __builtin_bit_cast(float, a2 ^ ((a2 >> 31) & 0x7fffffff));
                es[r * 64 + lane] = 127 - (k1 & 127); gsi[r * 64 + lane] = 127 - (k2 & 127); }
            int Q[16];
#define MKKEY2(a_, b_) ({ const int bb_ = __builtin_bit_cast(int, v1[a_] + v2[b_]); const int kk_ = bb_ ^ ((bb_ >> 31) & 0x7fffffff); (kk_ & ~255) | (255 - ((a_) * 16 + (b_))); })
#pragma unroll
            for (int bq = 0; bq < 16; ++bq) Q[bq] = MKKEY2(0, bq);
#pragma unroll
            for (int a = 1; a < 16; ++a)
#pragma unroll
                for (int bq = 0; bq < 16; ++bq) if ((a + 1) * (bq + 1) <= 16) { int k_ = MKKEY2(a, bq);
#pragma unroll
                    for (int r = (a + 1) * (bq + 1) - 1; r < 16; ++r) { const int hi_ = Q[r] > k_ ? Q[r] : k_; k_ = Q[r] > k_ ? k_ : Q[r]; Q[r] = hi_; } }
#undef MKKEY2
            float L2[16];
#pragma unroll
            for (int r = 0; r < 16; ++r) { const int ab = 255 - (Q[r] & 255); const int qv = Q[r] & ~255; L2[r] = __builtin_bit_cast(float, qv ^ ((qv >> 31) & 0x7fffffff));
                P2[r] = es[(ab >> 4) * 64 + lane] * 128 + gsi[(ab & 15) * 64 + lane]; }
            float sum = 0.f;
#pragma unroll
            for (int r = 0; r < 16; ++r) { gt[r] = __expf(L2[r] - L2[0]); sum += gt[r]; }
            const float inv = 1.f / sum;
#pragma unroll
            for (int r = 0; r < 16; ++r) { es[r * 64 + lane] = P2[r]; gs[r * 64 + lane] = gt[r] * inv; }
            asm volatile("s_waitcnt lgkmcnt(0)" ::: "memory");
        }
        {
            int ee[8]; float gg[8];
#pragma unroll
            for (int j = 0; j < 8; ++j) { const int x = j * 64 + lane, k = x >> 7, y = x & 127; ee[j] = es[(y & 15) * 64 + (y >> 4) * 8 + k]; gg[j] = gs[(y & 15) * 64 + (y >> 4) * 8 + k]; }
            int base = 0;
#pragma unroll
            for (int k = 0; k < 4; ++k) {
#pragma unroll 1
                for (int s = 0; s < (16384 >> PEER_SL_SHIFT); ++s) {
#pragma unroll
                    for (int jj = 0; jj < 2; ++jj) { const int j = k * 2 + jj; const bool in = (ee[j] >> PEER_SL_SHIFT) == s; const unsigned long long m = __builtin_amdgcn_ballot_w64(in);
                        if (in) { const int pos = base + (int)__builtin_amdgcn_mbcnt_hi((unsigned)(m >> 32), __builtin_amdgcn_mbcnt_lo((unsigned)m, 0u)); se[pos] = ee[j]; sg[pos] = gg[j]; }
                        base += __builtin_popcountll(m); }
                }
            }
        }
        asm volatile("s_waitcnt lgkmcnt(0)" ::: "memory");
        v4u hn[4]; float ssn; f32x4 shv[8];
        { const v4u* hp = (const v4u*)(H + (size_t)tb * DM);
#pragma unroll
            for (int jj = 0; jj < 2; ++jj)
#pragma unroll
                for (int c = 0; c < 2; ++c) hn[jj * 2 + c] = hp[(jj * 64 + lane) * 2 + c];
            ssn = lane < 32 ? ssr[(size_t)tb * 32 + lane] : 0.f;
#pragma unroll
            for (int jj = 0; jj < 2; ++jj)
#pragma unroll
                for (int q = 0; q < 4; ++q) shv[jj * 4 + q] = *(const f32x4*)(sh2 + (size_t)(tb >> 12) * MODW + (jj * 64 + lane) * 16 + 4 * q); }
#pragma unroll 1
        for (int k = 0; k < 4; ++k) {
            float hf[32]; float mx = 0.f;
#pragma unroll
            for (int jj = 0; jj < 2; ++jj)
#pragma unroll
                for (int c = 0; c < 2; ++c) { const v4u hv = hn[jj * 2 + c]; const int o = jj * 16 + c * 8;
                    hf[o + 0] = bflo(hv.x); hf[o + 1] = bfhi(hv.x); hf[o + 2] = bflo(hv.y); hf[o + 3] = bfhi(hv.y); hf[o + 4] = bflo(hv.z); hf[o + 5] = bfhi(hv.z); hf[o + 6] = bflo(hv.w); hf[o + 7] = bfhi(hv.w); }
            const float ssc = ssn;
            { const int tn = tb + (k + 1 < 4 ? k + 1 : 3); const v4u* hp = (const v4u*)(H + (size_t)tn * DM);
#pragma unroll
                for (int jj = 0; jj < 2; ++jj)
#pragma unroll
                    for (int c = 0; c < 2; ++c) hn[jj * 2 + c] = hp[(jj * 64 + lane) * 2 + c];
                ssn = lane < 32 ? ssr[(size_t)tn * 32 + lane] : 0.f; }
            { const float rstd = rsqrtf(wave_sum(ssc) * (1.f / DM) + NORM_EPS);
#pragma unroll
                for (int jj = 0; jj < 2; ++jj)
#pragma unroll
                    for (int q = 0; q < 4; ++q) { const f32x4 s4 = shv[jj * 4 + q];
                        hf[jj * 16 + 4 * q] = hf[jj * 16 + 4 * q] * rstd + s4.x; hf[jj * 16 + 4 * q + 1] = hf[jj * 16 + 4 * q + 1] * rstd + s4.y;
                        hf[jj * 16 + 4 * q + 2] = hf[jj * 16 + 4 * q + 2] * rstd + s4.z; hf[jj * 16 + 4 * q + 3] = hf[jj * 16 + 4 * q + 3] * rstd + s4.w; } }
#pragma unroll
            for (int i = 0; i < 32; ++i) mx = fmaxf(mx, fabsf(hf[i]));
            mx = wave_max(mx);
            const float inv = mx > 0.f ? 127.f / mx : 0.f;
            if (lane == 0) hsl[k] = mx * (1.f / 127.f);
            int hsum = 0;
#pragma unroll
            for (int jj = 0; jj < 2; ++jj) { unsigned qd[4];
#pragma unroll
                for (int d = 0; d < 4; ++d) { const int o = jj * 16 + 4 * d; const int q0 = (int)rintf(hf[o] * inv), q1 = (int)rintf(hf[o + 1] * inv), q2 = (int)rintf(hf[o + 2] * inv), q3 = (int)rintf(hf[o + 3] * inv);
                    qd[d] = (unsigned)(q0 & 255) | ((unsigned)(q1 & 255) << 8) | ((unsigned)(q2 & 255) << 16) | ((unsigned)(q3 & 255) << 24); hsum += (q0 + q1) + (q2 + q3); }
                v4u q; q.x = qd[0]; q.y = qd[1]; q.z = qd[2]; q.w = qd[3]; hl[k * 132 + jj * 64 + lane] = q; }
            { hsum = row16_sum_i(hsum); const int hs_all = __builtin_amdgcn_readlane(hsum, 0) + __builtin_amdgcn_readlane(hsum, 16) + __builtin_amdgcn_readlane(hsum, 32) + __builtin_amdgcn_readlane(hsum, 48);
                if (lane == 0) hsi[k] = hs_all; }
        }
        asm volatile("s_waitcnt lgkmcnt(0)" ::: "memory");
        {
            int lu = lane; asm volatile("" : "+v"(lu)); const int tq = lu & 3, pq = (lu >> 2) & 3, kq = lu >> 4;
            v4i hB[8];
            { const LAS v4u* hb = hl + tq * 132 + kq * 4 + pq;
#pragma unroll
                for (int s = 0; s < 4; ++s) { hB[2 * s] = *(const LAS v4i*)(hb + s * 16); hB[2 * s + 1] = *(const LAS v4i*)(hb + 64 + s * 16); } }
            const int hc = 8 * hsi[tq];
            const unsigned char* ubase = U4 + kq * 64 + tq * 16;
#define ULOAD4(buf, q_) do { const int e_ = se[pq * 128 + (q_)];        const unsigned char* up_ = ubase + (size_t)e_ * (DM / 2); \
    _Pragma("unroll") for (int s = 0; s < 4; ++s) buf[s] = *(const v4i*)(up_ + s * 256); } while (0)
#define UCONS4(buf, gi_) do { v4i acc = {0, 0, 0, 0}; \
    _Pragma("unroll") for (int s = 0; s < 4; ++s) { const v4i lo_ = buf[s] & 0x0F0F0F0F, hi_ = (buf[s] >> 4) & 0x0F0F0F0F; \
        acc = __builtin_amdgcn_mfma_i32_16x16x64_i8(lo_, hB[2 * s], acc, 0, 0, 0); acc = __builtin_amdgcn_mfma_i32_16x16x64_i8(hi_, hB[2 * s + 1], acc, 0, 0, 0); } \
    int v_ = pq == 0 ? acc.x : (pq == 1 ? acc.y : (pq == 2 ? acc.z : acc.w)); \
    v_ += __builtin_amdgcn_update_dpp(0, v_, 0x124, 0xF, 0xF, true); v_ += __builtin_amdgcn_update_dpp(0, v_, 0x128, 0xF, 0xF, true); \
    if (pq == 0) dl[((gi_) * 4 + kq) * 4 + tq] = (float)(v_ - hc); } while (0)
            const int xl = (lu & 3) * 128 + ((lu >> 2) & 3);
            float us_c, vs_c; { const int e0 = se[xl]; us_c = US[e0]; vs_c = VS[e0]; }
            v4i ub0[4], ub1[4];
            ULOAD4(ub0, 0); ULOAD4(ub1, 1);
#pragma unroll 1
            for (int g = 0; g < 32; ++g) {
                const int gn = g + 1 < 32 ? g + 1 : 31;
                const int en = se[xl + 4 * gn]; const float us_n = US[en], vs_n = VS[en];
                UCONS4(ub0, 0); ULOAD4(ub0, g * 4 + 2);
                UCONS4(ub1, 1); ULOAD4(ub1, g * 4 + 3);
                UCONS4(ub0, 2); ULOAD4(ub0, gn * 4 + 0);
                UCONS4(ub1, 3); ULOAD4(ub1, gn * 4 + 1);
                if (lu < 16) { const int x = xl + 4 * g; const int tk = lu & 3;
                    sg[x] = sg[x] * vs_c * gelu_as(dl[lu * 4 + tk] * (us_c * hsl[tk])); }
                us_c = us_n; vs_c = vs_n;
            }
#undef ULOAD4
#undef UCONS4
        }
        asm volatile("s_waitcnt lgkmcnt(0)" ::: "memory");
#define VLOAD(buf, cfb, bi_) do { const v2u e2_ = *(const LAS v2u*)(se + xb + (bi_) * 2); const f32x2 g2_ = *(const LAS f32x2*)(sg + xb + (bi_) * 2); \
        cfb[0] = g2_.x; cfb[1] = g2_.y; const unsigned ee_[2] = {e2_.x, e2_.y}; \
        _Pragma("unroll") for (int i = 0; i < 2; ++i) { const unsigned char* vp_ = vbase + (size_t)ee_[i] * (DM / 2); buf[i][0] = *(const v4u*)vp_; buf[i][1] = *(const v4u*)(vp_ + 512); } } while (0)
#define VACC(bv_, cv_) do { const f32x2 c2_ = {cv_, cv_}; \
        _Pragma("unroll") for (int jj = 0; jj < 2; ++jj) { const unsigned wd_[4] = {bv_[jj].x, bv_[jj].y, bv_[jj].z, bv_[jj].w}; \
            _Pragma("unroll") for (int d = 0; d < 4; ++d) { const int o_ = jj * 16 + 4 * d; \
                const f32x2 f0_ = __builtin_amdgcn_cvt_scalef32_pk_f32_fp4((int)wd_[d], 1.0f, 0), f1_ = __builtin_amdgcn_cvt_scalef32_pk_f32_fp4((int)wd_[d], 1.0f, 1), \
                            f2_ = __builtin_amdgcn_cvt_scalef32_pk_f32_fp4((int)wd_[d], 1.0f, 2), f3_ = __builtin_amdgcn_cvt_scalef32_pk_f32_fp4((int)wd_[d], 1.0f, 3); \
                out[o_] = __builtin_elementwise_fma(c2_, f0_, out[o_]); out[o_ + 1] = __builtin_elementwise_fma(c2_, f1_, out[o_ + 1]); \
                out[o_ + 2] = __builtin_elementwise_fma(c2_, f2_, out[o_ + 2]); out[o_ + 3] = __builtin_elementwise_fma(c2_, f3_, out[o_ + 3]); } } } while (0)
#define VCONS(buf, cfb) do { _Pragma("unroll") for (int i = 0; i < 2; ++i) VACC(buf[i], cfb[i]); } while (0)
#pragma unroll 1
        for (int p = 0; p < 2; ++p) {
            int lane_v = F.lane; asm volatile("" : "+v"(lane_v)); const int hv = lane_v >> 5, mv = lane_v & 31;
            const int xb = (2 * p + hv) * 128;
            const unsigned char* vbase = V4 + mv * 16;
            f32x2 out[32];
#pragma unroll
            for (int i = 0; i < 32; ++i) out[i] = (f32x2){0.f, 0.f};
            {
                v4u vb0[2][2], vb1[2][2]; float c0[2], c1[2];
                VLOAD(vb0, c0, 0); VLOAD(vb1, c1, 1);
#pragma unroll 1
                for (int bi = 0; bi < 64; bi += 2) {
                    const int b2 = bi + 2 < 64 ? bi + 2 : 62, b3 = bi + 3 < 64 ? bi + 3 : 63;
                    asm volatile("" ::: "memory"); VCONS(vb0, c0); asm volatile("" ::: "memory"); VLOAD(vb0, c0, b2);
                    asm volatile("" ::: "memory"); VCONS(vb1, c1); asm volatile("" ::: "memory"); VLOAD(vb1, c1, b3);
                }
            }
            {
                const int t = tb + 2 * p + hv, b = t >> 12;
                f32x4 xn[2][8]; float ss = 0.f;
                const f32x4* xr = (const f32x4*)(X + (size_t)t * DM) + mv; const f32x4* gr = (const f32x4*)(g2 + (size_t)b * MODW) + mv;
#pragma unroll
                for (int jj = 0; jj < 2; ++jj)
#pragma unroll
                    for (int q = 0; q < 8; ++q) { const int ix = jj * 256 + q * 32; const f32x4 xv = xr[ix], gv = gr[ix];
                        f32x4 o4; o4.x = out[jj * 16 + 2 * q].x; o4.y = out[jj * 16 + 2 * q].y; o4.z = out[jj * 16 + 2 * q + 1].x; o4.w = out[jj * 16 + 2 * q + 1].y;
                        const f32x4 y = xv + gv * o4; xn[jj][q] = y; ss += (y.x * y.x + y.y * y.y) + (y.z * y.z + y.w * y.w); }
                float rstd; { const float v = row16_sum(ss); const float s0 = rl_f(v, 0) + rl_f(v, 16), s1 = rl_f(v, 32) + rl_f(v, 48); rstd = rsqrtf((hv ? s1 : s0) * (1.f / DM) + NORM_EPS); }
                if (!last) {
                    f32x4* xw = (f32x4*)((dry ? (float*)(A->ws + WS_DUMMY) : X) + (size_t)t * DM) + mv; v2u* hw = (v2u*)((dry ? (bf16*)(A->ws + WS_DUMMY + 64 * MiB) : H) + (size_t)t * DM) + mv;
                    const f32x4* ngp = (const f32x4*)ngain + mv; const f32x4* s1p = (const f32x4*)(nsc + (size_t)b * MODW) + mv; const f32x4* s0p = (const f32x4*)(nsh + (size_t)b * MODW) + mv;
#pragma unroll
                    for (int jj = 0; jj < 2; ++jj)
#pragma unroll
                        for (int q = 0; q < 8; ++q) { const int ix = jj * 256 + q * 32; xw[ix] = xn[jj][q];
                            const f32x4 g = ngp[ix], s1 = s1p[ix], s0 = s0p[ix];
                            const f32x4 y = xn[jj][q] * rstd * g * (s1 + 1.f) + s0;
                            v2u o; o.x = pk2(y.x, y.y); o.y = pk2(y.z, y.w); hw[ix] = o; }
                } else {
                    f32x4* ow = (f32x4*)((dry ? (float*)(A->ws + WS_DUMMY) : A->out) + (size_t)t * DM) + mv; const f32x4* ngp = (const f32x4*)ngain + mv;
#pragma unroll
                    for (int jj = 0; jj < 2; ++jj)
#pragma unroll
                        for (int q = 0; q < 8; ++q) { const int ix = jj * 256 + q * 32; ow[ix] = xn[jj][q] * rstd * ngp[ix]; }
                }
            }
        }
#undef VLOAD
#undef VACC
#undef VCONS
    }
}

__device__ __forceinline__ void PH_norm1_l0(LAS unsigned char* lds, int wv) { ArgsP A = args_ptr(); const float* MOD = (const float*)(A->ws + WS_MOD);
    ph_norm(A->in[0], A->in[4], MOD + 0 * DM, MOD + 1 * DM, (bf16*)(A->ws + WS_H), lds, wv);
    { const Frame F = make_frame(lds, wv); float* B3 = (float*)(A->ws + WS_BIAS3);
        for (int o = F.gw; o < DEPTH * 2 * DM; o += F.ngw) { const int l = o >> 12, b = (o >> 11) & 1, n = o & 2047;
            const float* sh = MOD + (size_t)(l * 2 + b) * MODW + 3 * DM; const v4u* wr = (const v4u*)((const bf16*)(A->ws + WS_WQK) + ((size_t)l * DM + n) * DM);
            float s = 0.f;
#pragma unroll
            for (int j = 0; j < 4; ++j) { const v4u wv4 = wr[j * 64 + F.lane]; const f32x4 s0 = *(const f32x4*)(sh + (j * 64 + F.lane) * 8), s1 = *(const f32x4*)(sh + (j * 64 + F.lane) * 8 + 4);
                s += bflo(wv4.x) * s0.x + bfhi(wv4.x) * s0.y + bflo(wv4.y) * s0.z + bfhi(wv4.y) * s0.w + bflo(wv4.z) * s1.x + bfhi(wv4.z) * s1.y + bflo(wv4.w) * s1.z + bfhi(wv4.w) * s1.w; }
            s = wave_sum(s);
            if (F.lane == 0) B3[o] = s; } } }
__device__ __forceinline__ void PH_gemm1(LAS unsigned char* lds, int wv, int l_) { ArgsP A = args_ptr(); const int l = opaque_i(l_);
    pg8::Gemm g{(const bf16*)(A->ws + WS_H), (const bf16*)(A->ws + WS_WIN) + (size_t)l * INWP * DM, NT, INWP, DM}; pg8::StaticOrder S; S.init(NT, INWP, gridDim.x, blockIdx.x);
    EpiStoreF32 E{(float*)(A->ws + WS_PROJ), INWP, wv, lds};
    pg8::gemm_phase<EpiStoreF32, pg8::StaticOrder, true, true>(lds, g, S, E, wv);
    { const Frame F = make_frame(lds, wv); if (F.G == 256 && F.bid >= 192) quant_tables(A, l, (F.bid - 192) * NWAVES + F.wave, 64 * NWAVES, F.lane, 0, QUANT_EARLY); } }
__device__ __forceinline__ void PH_mixA(LAS unsigned char* lds, int wv, int l_) { ArgsP A = args_ptr(); const int l = opaque_i(l_);
    const Frame F = make_frame(lds, wv);
#ifdef PROBE_A
    for (int u = F.bid; u < 2048; u += F.G) {
        if (u < 1536) { if (PROBE_A == 1) rwkvA_unit(A, F, l, u); }
        else { if (PROBE_A == 2) gla1_unit(A, F, l, u - 1536); }
    }
#endif
    const bool ride = (F.G == 256); constexpr int R0 = QUANT_EARLY + QUANT_MID;
    int kq = 0;
    for (int u = F.bid; u < 2048; u += F.G) {
        if (u < 1536) rwkvA_unit(A, F, l, u, ride ? R0 + F.gw + 2048 * kq : -1);
        else gla1_unit(A, F, l, u - 1536, ride ? R0 + F.gw + 2048 * kq : -1);
        ++kq;
    }
    if (F.G != 256) quant_tables(A, l, F.gw, F.ngw, F.lane);
}
__device__ __forceinline__ void PH_mixB(LAS unsigned char* lds, int wv, int l_) { ArgsP A = args_ptr(); const int l = opaque_i(l_);
    const Frame F = make_frame(lds, wv);
    if (F.G >= 192) {
        if (F.bid < 96) { rwkvB_scan(A, F, F.bid); if (F.G == 256) quant_tables(A, l, F.bid * NWAVES + F.wave, 96 * NWAVES, F.lane, QUANT_EARLY, QUANT_EARLY + QUANT_MID); }
        else { const int nb = F.G - 96, b2 = F.bid - 96;
            for (int u = b2; u < 288; u += nb) gla_scan_unit(A, F, u);
            for (int u = b2; u < 1024; u += nb) pool_unit(A, F, l, u); }
    } else {
        for (int u = F.bid; u < 288; u += F.G) gla_scan_unit(A, F, u);
        for (int u = F.bid; u < 1024; u += F.G) pool_unit(A, F, l, u);
        for (int u = F.bid; u < 96; u += F.G) rwkvB_scan(A, F, u);
    } }
__device__ __forceinline__ void PH_mixC(LAS unsigned char* lds, int wv, int l_) { ArgsP A = args_ptr(); const int l = opaque_i(l_);
    const Frame F = make_frame(lds, wv);
#ifdef PROBE_C
    for (int u = F.bid; u < 2048; u += F.G) { if (u < 512) { if (PROBE_C == 1) gla3_unit(A, F, l, u); } else { if (PROBE_C == 2) rwkvC_unit(A, F, l, u - 512); } }
#endif
    for (int u = F.bid; u < 2048; u += F.G) { if (u < 512) gla3_unit(A, F, l, u); else rwkvC_unit(A, F, l, u - 512); } }
__device__ __forceinline__ void PH_gemm2(LAS unsigned char* lds, int wv, int l_, bool dry = false) { ArgsP A = args_ptr(); const int l = opaque_i(l_);
    const float* modl = (const float*)(A->ws + WS_MOD) + (size_t)l * 2 * MODW; float* X = (float*)(A->ws + WS_X);
    pg8::Gemm g{(const bf16*)(A->ws + WS_Y), (const bf16*)(A->ws + WS_WOUT) + (size_t)l * DM * DM, NT, DM, DM}; pg8::StaticOrder S; S.init(NT, DM, gridDim.x, blockIdx.x);
    EpiResid E{(l == 0) ? A->in[0] : (const float*)X, dry ? (float*)(A->ws + WS_DUMMY) : X, modl + 2 * DM, wv, A->in[23] + (size_t)l * DM, modl + 4 * DM,
               dry ? (bf16*)(A->ws + WS_DUMMY + 64 * MiB) : (bf16*)(A->ws + WS_H), (dry ? (float*)(A->ws + WS_DUMMY) : (float*)(A->ws + WS_SSP) + (size_t)l * NT * 32), lds};
    pg8::gemm_phase<EpiResid, pg8::StaticOrder, true, true>(lds, g, S, E, wv); }
__device__ __forceinline__ void PH_norm2(LAS unsigned char* lds, int wv, int l_) { ArgsP A = args_ptr(); const int l = opaque_i(l_);
    const float* modl = (const float*)(A->ws + WS_MOD) + (size_t)l * 2 * MODW;
    ph_norm((const float*)(A->ws + WS_X), A->in[23] + (size_t)l * DM, modl + 3 * DM, modl + 4 * DM, (bf16*)(A->ws + WS_H), lds, wv); }
__device__ __forceinline__ void PH_gemm3(LAS unsigned char* lds, int wv, int l_) { ArgsP A = args_ptr(); const int l = opaque_i(l_);
    pg8::Gemm g{(const bf16*)(A->ws + WS_H), (const bf16*)(A->ws + WS_WQK) + (size_t)l * DM * DM, NT, DM, DM}; pg8::StaticOrder S; S.init(NT, DM, gridDim.x, blockIdx.x);
    LAS float* rs = (LAS float*)(lds + 131072);
    { pg8::Unit u0; const int t = tid_from(wv); if (S.next(0, u0) && t < 256) { const f32x4* sp = (const f32x4*)((const float*)(A->ws + WS_SSP) + ((size_t)l * NT + u0.pm * 256 + t) * 32); float s = 0.f;
#pragma unroll
            for (int j = 0; j < 8; ++j) { const f32x4 v = sp[j]; s += (v.x + v.y) + (v.z + v.w); }
            rs[t] = rsqrtf(s * (1.f / DM) + NORM_EPS); }
        __syncthreads(); }
    EpiScore E{(float*)(A->ws + WS_PROJ), DM, wv, rs, (const float*)(A->ws + WS_BIAS3) + (size_t)l * 2 * DM, lds};
    pg8::gemm_phase<EpiScore, pg8::StaticOrder, true, true>(lds, g, S, E, wv); }
__device__ __forceinline__ void PH_peer(LAS unsigned char* lds, int wv, int l_, bool dry = false) { ArgsP A = args_ptr(); const int l = opaque_i(l_);
    const float* MOD = (const float*)(A->ws + WS_MOD); const float* modl = MOD + (size_t)l * 2 * MODW;
    const bool last = (l == DEPTH - 1);
    const float* nmod = MOD + (size_t)(last ? l : l + 1) * 2 * MODW;
    ph_peer4(A, lds, wv, l, modl + 5 * DM, modl + 3 * DM, last ? A->in[29] : A->in[4] + (size_t)(l + 1) * DM, nmod + 0 * DM, nmod + 1 * DM, last, dry); }

__global__ void __launch_bounds__(NTHR, 2) mega_fwd(Args args) {
    extern __shared__ __attribute__((aligned(16))) unsigned char lds_raw[];
    LAS unsigned char* lds = (LAS unsigned char*)lds_raw;
    volatile LAS unsigned* MISC = (volatile LAS unsigned*)(lds + MISC_OFF);
    const int wv = __builtin_amdgcn_readfirstlane((int)(threadIdx.x >> 6));
    if (wv == 0) MISC[lane_id_()] = 0u;
    __syncthreads();
    XcdBarrier bar = xcd_barrier_post((unsigned*)(args_ptr()->ws + WS_CTL) + CW_BAR, MISC + 8, wv);
#define GRID_BAR() do { XcdBarrier b_ = bar; b_.bar = (unsigned*)(args_ptr()->ws + WS_CTL) + CW_BAR; asm volatile("" : "+s"(b_.x), "+s"(b_.w)); xcd_barrier(b_); if (PROBE & 512) xcd_barrier(b_); } while (0)

    ph_prologue(args_ptr(), lds, wv);
    GRID_BAR();
#if PROBE & 1
    ph_prologue(args_ptr(), lds, wv); GRID_BAR();
#endif
    PH_norm1_l0(lds, wv);
    GRID_BAR();
    for (int l = 0; l < DEPTH; ++l) {
#if PROBE & 2
        PH_gemm1(lds, wv, l); GRID_BAR();
#endif
        PH_gemm1(lds, wv, l); GRID_BAR();
#if PROBE & 4
        PH_mixA(lds, wv, l);  GRID_BAR();
#endif
        PH_mixA(lds, wv, l);  GRID_BAR();
#if PROBE & 8
        PH_mixB(lds, wv, l);  GRID_BAR();
#endif
        PH_mixB(lds, wv, l);  GRID_BAR();
#if PROBE & 16
        PH_mixC(lds, wv, l);  GRID_BAR();
#endif
        PH_mixC(lds, wv, l);  GRID_BAR();
#if PROBE & 32
        PH_gemm2(lds, wv, l, true); GRID_BAR();
#endif
        PH_gemm2(lds, wv, l); GRID_BAR();
#if PROBE & 128
        PH_gemm3(lds, wv, l); GRID_BAR();
#endif
        PH_gemm3(lds, wv, l); GRID_BAR();
#if PROBE & 256
        PH_peer(lds, wv, l, true); GRID_BAR();
#endif
        PH_peer(lds, wv, l);
        if (l + 1 < DEPTH) GRID_BAR();
    }
}

extern "C" void kernel_launch(void* const* d_in, const int* in_sizes, int n_in, void* d_out, int out_size, void* d_ws, size_t ws_size, hipStream_t stream) {
    static int grid = 0;
    if (grid == 0) {
        if (n_in != 30 || out_size != NT * DM || ws_size < WS_END + 96 * MiB) { fprintf(stderr, "kernel_launch: unexpected shapes (n_in %d out %d ws %zu)\n", n_in, out_size, ws_size); grid = -1; return; }
        int dev = 0, cus = 0, per_cu = 0;
        if (hipGetDevice(&dev) != hipSuccess || hipDeviceGetAttribute(&cus, hipDeviceAttributeMultiprocessorCount, dev) != hipSuccess) { grid = -1; return; }
        if (hipFuncSetAttribute((const void*)mega_fwd, hipFuncAttributeMaxDynamicSharedMemorySize, LDS_BYTES) != hipSuccess) { fprintf(stderr, "kernel_launch: hipFuncSetAttribute failed\n"); grid = -1; return; }
        if (hipOccupancyMaxActiveBlocksPerMultiprocessor(&per_cu, (const void*)mega_fwd, NTHR, LDS_BYTES) != hipSuccess || per_cu < 1) { fprintf(stderr, "kernel_launch: occupancy query says %d\n", per_cu); (void)hipGetLastError(); per_cu = 1; }
        grid = cus;
    }
    if (grid < 0) return;
    (void)in_sizes;
    if (hipMemsetAsync((char*)d_ws + WS_CTL, 0, CTL_ZERO_BYTES, stream) != hipSuccess) return;
    Args a{};
    for (int i = 0; i < 30; ++i) a.in[i] = (const float*)d_in[i];
    a.out = (float*)d_out; a.ws = (unsigned char*)d_ws;
    hipLaunchKernelGGL(mega_fwd, dim3(grid), dim3(NTHR), LDS_BYTES, stream, a);
}
```
